# Optimizing an MI355X kernel written in HIP

```python
import jax, jax.numpy as jnp
from jax import lax
import numpy as np

D_MODEL = 1024
BATCH = 32
SEQ = 2048
DEPTH = 1

CHUNK = 64
Q_BLOCK = 128
A_HEADS = 8
A_HEAD_DIM = 64
A_WIDTH = A_HEADS * A_HEAD_DIM
KV_LATENT = 128
IDX_HEADS = 8
IDX_DIM = 64
TOPK_MAX = 256
B_HEADS = 8
B_HEAD_DIM = 64
B_WIDTH = B_HEADS * B_HEAD_DIM
W_LORA = 64
A_LORA = 64
G_LORA = 128
D_FF = 4 * D_MODEL
RMS_EPS = 1e-6
GN_EPS = 64e-5
N_IN_A = A_WIDTH + KV_LATENT + IDX_HEADS * IDX_DIM + IDX_DIM + IDX_HEADS
N_IN_B = 3 * B_WIDTH + W_LORA + A_LORA + G_LORA
N_IN = N_IN_A + N_IN_B
MIX_WIDTH = A_WIDTH + B_WIDTH

kernel_name = 'hybrid_dsa_rwkv7_adaln_block'


def rms_norm(x, g):
    xf = x.astype(jnp.float32)
    y = xf * lax.rsqrt(jnp.mean(xf * xf, axis=-1, keepdims=True) + RMS_EPS)
    return (y * g).astype(x.dtype)


def split_cols(p, sizes):
    outs, start = [], 0
    for s in sizes:
        outs.append(p[..., start:start + s])
        start += s
    return outs


def token_shift(p, mu):
    prev = jnp.pad(p, ((0, 0), (1, 0), (0, 0)))[:, :-1]
    return p + mu * (prev - p)


def dsa_attention(q, c_kv, q_idx, k_idx, w_idx, g_q, g_k, w_uk, w_uv):
    B_, S, H, HD = q.shape
    f32 = jnp.float32
    topk = min(TOPK_MAX, S // 4)
    k_full = jnp.einsum('bsl,lhd->bshd', c_kv, w_uk).astype(f32)
    inv_rms_k = lax.rsqrt(jnp.mean(k_full * k_full, axis=-1) + RMS_EPS)
    q_abs = jnp.einsum('bshd,lhd->bshl', rms_norm(q, g_q) * g_k, w_uk) * (HD ** -0.5)
    w_idx = w_idx * (IDX_HEADS ** -0.5 * IDX_DIM ** -0.5)
    slopes = jnp.exp2(-8.0 * jnp.arange(1, H + 1, dtype=f32) / H)
    key_pos = jnp.arange(S)
    gather = jax.vmap(lambda table, idx: table[idx])

    def block(i):
        t0 = i * Q_BLOCK
        tpos = t0 + jnp.arange(Q_BLOCK)
        limit = (tpos // CHUNK + 1) * CHUNK
        qi = lax.dynamic_slice_in_dim(q_idx, t0, Q_BLOCK, axis=1)
        wi = lax.dynamic_slice_in_dim(w_idx, t0, Q_BLOCK, axis=1)
        qa = lax.dynamic_slice_in_dim(q_abs, t0, Q_BLOCK, axis=1)
        rel = jax.nn.relu(jnp.einsum('bthd,bsd->bths', qi, k_idx).astype(f32))
        score_idx = jnp.einsum('bth,bths->bts', wi.astype(f32), rel)
        score_idx = jnp.where(key_pos[None, :] < limit[:, None], score_idx, -jnp.inf)
        _, sel = lax.top_k(score_idx, topk)
        valid = sel < limit[None, :, None]
        c_sel = gather(c_kv, sel)
        r_sel = gather(inv_rms_k, sel)
        logits = jnp.einsum('bthl,btkl->bthk', qa, c_sel).astype(f32) * jnp.swapaxes(r_sel, 2, 3)
        dist = jnp.abs(tpos[None, :, None] - sel).astype(f32)
        logits = logits - slopes[None, None, :, None] * dist[:, :, None, :]
        logits = jnp.where(valid[:, :, None, :], logits, -jnp.inf)
        probs = jax.nn.softmax(logits, axis=-1).astype(c_kv.dtype)
        return jnp.einsum('bthk,btkl->bthl', probs, c_sel)

    o_lat = lax.map(block, jnp.arange(S // Q_BLOCK))
    o_lat = jnp.moveaxis(o_lat, 0, 1).reshape(B_, S, H, KV_LATENT)
    return jnp.einsum('bshl,lhd->bshd', o_lat, w_uv)


def rwkv7_time_mix(p, w0, w2, a0, a2, g2, k_k, k_a, r_k, ln_w, ln_b):
    B_, S, _ = p.shape
    H, N = B_HEADS, B_HEAD_DIM
    f32 = jnp.float32
    r, k, v, xw, xa, xg = split_cols(p, (B_WIDTH, B_WIDTH, B_WIDTH, W_LORA, A_LORA, G_LORA))
    w_log = -jax.nn.softplus(-(w0 + jnp.tanh(xw) @ w2)) - 0.5
    decay = jnp.exp(-jnp.exp(w_log.astype(f32)))
    a = jax.nn.sigmoid(a0 + xa @ a2)
    g = jax.nn.sigmoid(xg) @ g2
    heads = lambda t: t.astype(f32).reshape(B_, S, H, N)
    kk = heads(k * k_k)
    kk = kk / jnp.maximum(jnp.sqrt(jnp.sum(kk * kk, axis=-1, keepdims=True)), 1e-12)
    k = k * (1 + (a - 1) * k_a)
    r_h, k_h, v_h, a_h, w_h = heads(r), heads(k), heads(v), heads(a), heads(decay)

    def step(state, inp):
        r_t, w_t, k_t, v_t, kk_t, a_t = inp
        sa = jnp.einsum('bhij,bhj->bhi', state, -kk_t)
        state = (state * w_t[:, :, None, :] + sa[..., None] * (kk_t * a_t)[:, :, None, :]
                 + v_t[..., None] * k_t[:, :, None, :])
        return state, jnp.einsum('bhij,bhj->bhi', state, r_t)

    xs = tuple(jnp.moveaxis(t, 1, 0) for t in (r_h, w_h, k_h, v_h, kk, a_h))
    state0 = jnp.zeros((B_, H, N, N), f32)
    _, out = lax.scan(step, state0, xs)
    out = jnp.moveaxis(out, 0, 1)
    mean = jnp.mean(out, axis=-1, keepdims=True)
    var = jnp.mean((out - mean) ** 2, axis=-1, keepdims=True)
    out = (out - mean) * lax.rsqrt(var + GN_EPS) * ln_w.reshape(H, N) + ln_b.reshape(H, N)
    out = out + jnp.sum(r_h * k_h * r_k, axis=-1, keepdims=True) * v_h
    return (out.reshape(B_, S, B_WIDTH) * g.astype(f32)).astype(p.dtype)


def setup_inputs(seed: int = 0) -> dict:
    key = jax.random.key(seed)
    ks = jax.random.split(key, 32)
    f32 = jnp.float32
    nrm = lambda k, shape, scale: jax.random.normal(k, shape, f32) * scale
    L = DEPTH
    return {
        'x': nrm(ks[0], (BATCH, SEQ, D_MODEL), 1.0),
        'c': nrm(ks[1], (BATCH, D_MODEL), 1.0),
        'w_ada': nrm(ks[2], (L, D_MODEL, 6 * D_MODEL), 0.2 * D_MODEL ** -0.5),
        'b_ada': nrm(ks[3], (L, 6 * D_MODEL), 0.01),
        'g_mix': 1.0 + nrm(ks[4], (L, D_MODEL), 0.02),
        'g_ffn': 1.0 + nrm(ks[5], (L, D_MODEL), 0.02),
        'w_in': nrm(ks[6], (L, D_MODEL, N_IN), D_MODEL ** -0.5),
        'g_q': 1.0 + nrm(ks[7], (L, A_HEAD_DIM), 0.02),
        'g_k': 1.0 + nrm(ks[8], (L, A_HEAD_DIM), 0.02),
        'g_kv': 1.0 + nrm(ks[9], (L, KV_LATENT), 0.02),
        'w_uk': nrm(ks[10], (L, KV_LATENT, A_HEADS, A_HEAD_DIM), KV_LATENT ** -0.5),
        'w_uv': nrm(ks[11], (L, KV_LATENT, A_HEADS, A_HEAD_DIM), KV_LATENT ** -0.5),
        'mu_shift': jax.random.uniform(ks[12], (L, N_IN_B), f32),
        'w0': jax.random.uniform(ks[13], (L, B_WIDTH), f32, -5.0, -1.0),
        'w2': nrm(ks[14], (L, W_LORA, B_WIDTH), 0.1 * W_LORA ** -0.5),
        'a0': nrm(ks[15], (L, B_WIDTH), 0.1),
        'a2': nrm(ks[16], (L, A_LORA, B_WIDTH), 0.1 * A_LORA ** -0.5),
        'g2': nrm(ks[17], (L, G_LORA, B_WIDTH), G_LORA ** -0.5),
        'k_k': 0.85 + nrm(ks[18], (L, B_WIDTH), 0.02),
        'k_a': 1.0 + nrm(ks[19], (L, B_WIDTH), 0.02),
        'r_k': nrm(ks[20], (L, B_HEADS, B_HEAD_DIM), 0.1),
        'ln_w': 1.0 + nrm(ks[21], (L, B_WIDTH), 0.02),
        'ln_b': nrm(ks[22], (L, B_WIDTH), 0.01),
        'w_out': nrm(ks[23], (L, MIX_WIDTH, D_MODEL), MIX_WIDTH ** -0.5),
        'w_ff1': nrm(ks[24], (L, D_MODEL, D_FF), D_MODEL ** -0.5),
        'w_ff2': nrm(ks[25], (L, D_FF, D_MODEL), D_FF ** -0.5),
    }


def reference(x, c, w_ada, b_ada, g_mix, g_ffn, w_in, g_q, g_k, g_kv, w_uk, w_uv,
              mu_shift, w0, w2, a0, a2, g2, k_k, k_a, r_k, ln_w, ln_b,
              w_out, w_ff1, w_ff2):
    B_, S, D = x.shape
    for l in range(DEPTH):
        mod = jnp.einsum('bd,de->be', jax.nn.silu(c), w_ada[l]) + b_ada[l]
        sh1, sc1, gt1, sh2, sc2, gt2 = [m[:, None, :] for m in jnp.split(mod, 6, axis=-1)]
        h = rms_norm(x, g_mix[l]) * (1 + sc1) + sh1
        proj = jnp.einsum('bsd,de->bse', h, w_in[l])
        p_a, p_b = proj[..., :N_IN_A], proj[..., N_IN_A:]
        q, c_lat, q_idx, k_idx, w_idx = split_cols(
            p_a, (A_WIDTH, KV_LATENT, IDX_HEADS * IDX_DIM, IDX_DIM, IDX_HEADS))
        o_a = dsa_attention(q.reshape(B_, S, A_HEADS, A_HEAD_DIM), rms_norm(c_lat, g_kv[l]),
                            q_idx.reshape(B_, S, IDX_HEADS, IDX_DIM), k_idx, w_idx,
                            g_q[l], g_k[l], w_uk[l], w_uv[l])
        o_b = rwkv7_time_mix(token_shift(p_b, mu_shift[l]), w0[l], w2[l], a0[l], a2[l], g2[l],
                             k_k[l], k_a[l], r_k[l], ln_w[l], ln_b[l])
        mixed = jnp.concatenate([o_a.reshape(B_, S, A_WIDTH).astype(x.dtype), o_b], axis=-1)
        x = x + gt1 * jnp.einsum('bse,ed->bsd', mixed, w_out[l])
        h = rms_norm(x, g_ffn[l]) * (1 + sc2) + sh2
        u = jax.nn.relu(jnp.einsum('bsd,df->bsf', h, w_ff1[l]))
        x = x + gt2 * jnp.einsum('bsf,fd->bsd', u * u, w_ff2[l])
    return x
```

```cpp
#include <hip/hip_runtime.h>
#include <hip/hip_cooperative_groups.h>
#include <cstdio>
#include <cstdint>
#include <cmath>
namespace cg = cooperative_groups;
#ifndef MK_DBG
#define MK_DBG 0
#endif
#ifndef MK_DBG_NOTOPK
#define MK_DBG_NOTOPK 0
#endif
namespace pg8 {
#define PG8_LAS __attribute__((address_space(3)))
typedef unsigned short bf16_t;
typedef short bf16x8 __attribute__((ext_vector_type(8)));
typedef float f32x4 __attribute__((ext_vector_type(4)));
typedef unsigned u32x4 __attribute__((ext_vector_type(4)));
constexpr int BM = 256, BK = 64, HALF = 128, HTB = HALF * BK * 2  , STAGE_BYTES = 8 * HTB, NXCD = 8, WGM = 8;

__host__ __device__ __forceinline__ int lds_byte(int r, int c) { const int st = (r >> 4) * 2 + (c >> 5), rr = r & 15, cc = c & 31, ob = rr * 64 + cc * 2; return st * 1024 + (ob ^ (((ob >> 9) & 1) << 5)); }
__host__ __device__ __forceinline__ void stage_rc(int b, int& R, int& C) { const int st = b / 1024, sb = b % 1024, swz = sb ^ (((sb >> 9) & 1) << 5); R = (st >> 1) * 16 + swz / 64; C = (st & 1) * 32 + (swz % 64) / 2; }
__host__ __device__ __forceinline__ int perm32(int rho) { const int n = rho >> 4, i = rho & 15; return 8 * (i >> 2) + 4 * n + (i & 3); }

struct Unit { int pm, pn; };
struct Gemm { const bf16_t* A; const bf16_t* Bt; int M, N, K, lda; };

struct StaticOrder {
    int nM, nN, nwg, G, c;
    __host__ __device__ void init(int M, int N, int G_, int c_) { nM = M / BM; nN = N / BM; nwg = nM * nN; G = G_; c = c_; }
    __host__ __device__ bool next(int i, Unit& u) const {
        const long L = (long)i * G + c; if (L >= nwg) return false;
        int wgid = (int)L; { const int q = nwg / NXCD, r = nwg % NXCD, xcd = wgid % NXCD, off = wgid / NXCD; wgid = (xcd < r ? xcd * (q + 1) : r * (q + 1) + (xcd - r) * q) + off; }
        const int nig = WGM * nN, gid = wgid / nig, fm = gid * WGM, gsz = (nM - fm) < WGM ? (nM - fm) : WGM;
        u.pm = fm + ((wgid % nig) % gsz); u.pn = (wgid % nig) / gsz; return true;
    }
    __device__ __forceinline__ void a_ready(const Unit&) const {}
    __device__ __forceinline__ void done(const Unit&) const {}
};


typedef float f32x2_t __attribute__((ext_vector_type(2))); typedef __bf16 bf16x2_t __attribute__((ext_vector_type(2)));
__device__ __forceinline__ unsigned cvt_pk_bf16(float lo, float hi) { const f32x2_t v = {lo, hi}; const bf16x2_t b = __builtin_convertvector(v, bf16x2_t); return __builtin_bit_cast(unsigned, b); }

template <int ACT  > struct EpiBf16 {
    static constexpr bool PERM = true, AFTER_DRAIN = false;
    bf16_t* O; int ldc;
    __device__ __forceinline__ void operator()(const f32x4 (&acc)[2][2][4][2], const Unit& u, int wr, int wc, int fr, int fq) const {
        const int row0 = u.pm * BM + wr * 64 + fr; const int col0 = u.pn * BM + wc * 32 + 8 * fq;
#pragma unroll
        for (int ai = 0; ai < 2; ++ai)
#pragma unroll
            for (int m = 0; m < 4; ++m) { bf16_t* rowp = O + (size_t)(row0 + ai * HALF + m * 16) * ldc + col0;
#pragma unroll
                for (int bj = 0; bj < 2; ++bj) { f32x4 v0 = acc[ai][bj][m][0], v1 = acc[ai][bj][m][1];
                    if (ACT == 1) {
#pragma unroll
                        for (int j = 0; j < 4; ++j) { const float a = v0[j] > 0.f ? v0[j] : 0.f, b = v1[j] > 0.f ? v1[j] : 0.f; v0[j] = a * a; v1[j] = b * b; } }
                    u32x4 w; w.x = cvt_pk_bf16(v0[0], v0[1]); w.y = cvt_pk_bf16(v0[2], v0[3]); w.z = cvt_pk_bf16(v1[0], v1[1]); w.w = cvt_pk_bf16(v1[2], v1[3]);
                    *(u32x4*)(rowp + bj * HALF) = w; } }
    }
};
struct EpiResGate {
    static constexpr bool PERM = false, AFTER_DRAIN = false;
    const float* base; float* out; int ldc; const float* gate; int gate_ld;
    __device__ __forceinline__ void operator()(const f32x4 (&acc)[2][2][4][2], const Unit& u, int wr, int wc, int fr, int fq) const {
        const int row0 = u.pm * BM + wr * 64 + fr, col0 = u.pn * BM + wc * 32 + 4 * fq;
        const float* gp = gate + (size_t)(u.pm >> 3) * gate_ld + col0;
        f32x4 gv[2][2];
#pragma unroll
        for (int bj = 0; bj < 2; ++bj)
#pragma unroll
            for (int n = 0; n < 2; ++n) gv[bj][n] = *(const f32x4*)(gp + bj * HALF + n * 16);
#pragma unroll
        for (int ai = 0; ai < 2; ++ai)
#pragma unroll
            for (int m = 0; m < 4; ++m) { const size_t off = (size_t)(row0 + ai * HALF + m * 16) * ldc + col0;
#pragma unroll
                for (int bj = 0; bj < 2; ++bj)
#pragma unroll
                    for (int n = 0; n < 2; ++n) { const f32x4 bs = *(const f32x4*)(base + off + bj * HALF + n * 16);
                        *(f32x4*)(out + off + bj * HALF + n * 16) = bs + gv[bj][n] * acc[ai][bj][m][n]; } }
    }
};
template <class Epi, class Sched, bool ALIGN_EPI = false, bool SP2 = false>
__device__ __forceinline__ void gemm_phase(PG8_LAS unsigned char* lds, const Gemm g, const Sched& S, const Epi& E) {
    const int tid = threadIdx.x, wid = __builtin_amdgcn_readfirstlane(tid >> 6), lane = tid & 63, wr = wid >> 2, wc = wid & 3, fr = lane & 15, fq = lane >> 4;
    const int K = g.K, nt = K / BK;
    unsigned voffA[2], voffB[2];
#pragma unroll
    for (int i = 0; i < 2; ++i) { int R, C; stage_rc(tid * 16 + i * 8192, R, C); const int Rb = Epi::PERM ? ((R & ~31) + perm32(R & 31)) : R;
        voffA[i] = (unsigned)(R * g.lda + C) * 2u; voffB[i] = (unsigned)(Rb * K + C) * 2u; }
    const size_t kstep = (size_t)(BK * 2);
    const size_t hstepB = (size_t)HALF * K * 2, hstepA = (size_t)HALF * g.lda * 2;
    const size_t tstepA = 2 * hstepA, tstepB = 2 * hstepB;
    const unsigned ldsw = (unsigned)wid * 1024u;
    const int aoff = lds_byte(wr * 64 + fr, fq * 8), boff = lds_byte(wc * 32 + fr, fq * 8);
#define PG8_SA(b, h) (((b) * 2 + (h)) * HTB)
#define PG8_SB(b, h) ((4 + (b) * 2 + (h)) * HTB)
#define PG8_STAGE(bufoff, gbase, voff) do { _Pragma("unroll") for (int _i = 0; _i < 2; ++_i) \
        __builtin_amdgcn_global_load_lds((const unsigned*)((const char*)(gbase) + (voff)[_i]), (PG8_LAS unsigned*)(lds + (bufoff) + ldsw + _i * 8192), 16, 0, 0); } while (0)
#define PG8_LDA(dst, b, h) do { _Pragma("unroll") for (int m = 0; m < 4; ++m) _Pragma("unroll") for (int k = 0; k < 2; ++k) dst[m][k] = *(const PG8_LAS bf16x8*)(lds + PG8_SA(b, h) + aoff + m * 2048 + k * 1024); } while (0)
#define PG8_LDB(dst, b, h) do { _Pragma("unroll") for (int n = 0; n < 2; ++n) _Pragma("unroll") for (int k = 0; k < 2; ++k) dst[n][k] = *(const PG8_LAS bf16x8*)(lds + PG8_SB(b, h) + boff + n * 2048 + k * 1024); } while (0)
#define PG8_MMA(ai, bj, At, Bt) do { __builtin_amdgcn_s_setprio(1); _Pragma("unroll") for (int m = 0; m < 4; ++m) _Pragma("unroll") for (int n = 0; n < 2; ++n) _Pragma("unroll") for (int k = 0; k < 2; ++k) \
        acc[ai][bj][m][n] = __builtin_amdgcn_mfma_f32_16x16x32_bf16(Bt[n][k], At[m][k], acc[ai][bj][m][n], 0, 0, 0); __builtin_amdgcn_s_setprio(0); } while (0)
#define PG8_WAIT_V(n) asm volatile("s_waitcnt vmcnt(" #n ")" ::: "memory")
#define PG8_WAIT_L(n) asm volatile("s_waitcnt lgkmcnt(" #n ")" ::: "memory")
#define PG8_BAR __builtin_amdgcn_s_barrier()
#define PG8_SCHED __builtin_amdgcn_sched_barrier(0)
    Unit cur, nxt; int ui = 0;
    if (!S.next(0, cur)) return;
    f32x4 acc[2][2][4][2];
#pragma unroll
    for (int a = 0; a < 2; ++a)
#pragma unroll
        for (int b = 0; b < 2; ++b)
#pragma unroll
            for (int m = 0; m < 4; ++m)
#pragma unroll
                for (int n = 0; n < 2; ++n) acc[a][b][m][n] = (f32x4){0.f, 0.f, 0.f, 0.f};
    bf16x8 At[4][2], B0[2][2], B1[2][2];
    const char* cA = (const char*)g.A + (size_t)cur.pm * tstepA; const char* cB = (const char*)g.Bt + (size_t)cur.pn * tstepB;
    S.a_ready(cur);
    if constexpr (SP2) {
        PG8_STAGE(PG8_SB(0, 0), cB, voffB); PG8_STAGE(PG8_SB(0, 1), cB + hstepB, voffB); PG8_STAGE(PG8_SA(0, 0), cA, voffA); PG8_STAGE(PG8_SA(0, 1), cA + hstepA, voffA);
        if (wr == 1) PG8_BAR;
        PG8_WAIT_V(2); PG8_BAR;
        PG8_STAGE(PG8_SB(1, 0), cB + kstep, voffB); PG8_STAGE(PG8_SA(1, 0), cA + kstep, voffA); PG8_STAGE(PG8_SB(1, 1), cB + hstepB + kstep, voffB);
        PG8_WAIT_V(6); PG8_BAR;
    } else {
        PG8_STAGE(PG8_SB(0, 0), cB, voffB); PG8_STAGE(PG8_SA(0, 0), cA, voffA); PG8_STAGE(PG8_SB(0, 1), cB + hstepB, voffB); PG8_STAGE(PG8_SA(0, 1), cA + hstepA, voffA);
        if (wr == 1) PG8_BAR;
        PG8_WAIT_V(4); PG8_BAR;
        PG8_STAGE(PG8_SB(1, 0), cB + kstep, voffB); PG8_STAGE(PG8_SA(1, 0), cA + kstep, voffA); PG8_STAGE(PG8_SB(1, 1), cB + hstepB + kstep, voffB);
        PG8_WAIT_V(6); PG8_BAR;
    }
    for (;;) {
        const bool has_next = S.next(ui + 1, nxt);
        const char* nA = has_next ? (const char*)g.A + (size_t)nxt.pm * tstepA : cA; const char* nB = has_next ? (const char*)g.Bt + (size_t)nxt.pn * tstepB : cB;
        for (int t = 0; t < nt; t += 2) {
            const bool last = (t == nt - 2);
            const char* a1 = cA + (size_t)(t + 1) * kstep;
            const char* a2 = last ? nA : cA + (size_t)(t + 2) * kstep; const char* b2 = last ? nB : cB + (size_t)(t + 2) * kstep;
            const char* a3 = a2 + kstep; const char* b3 = b2 + kstep;
            if (last && has_next) S.a_ready(nxt);
            if constexpr (SP2) {
            PG8_LDB(B0, 0, 0); PG8_LDB(B1, 0, 1); PG8_SCHED; PG8_LDA(At, 0, 0); PG8_STAGE(PG8_SA(1, 1), a1 + hstepA, voffA);
            PG8_WAIT_V(8); PG8_WAIT_L(0); PG8_BAR; PG8_MMA(0, 0, At, B0); PG8_MMA(0, 1, At, B1); PG8_BAR; PG8_SCHED;
            PG8_LDA(At, 0, 1); PG8_STAGE(PG8_SB(0, 0), b2, voffB); PG8_STAGE(PG8_SB(0, 1), b2 + hstepB, voffB); PG8_STAGE(PG8_SA(0, 0), a2, voffA);
            PG8_WAIT_V(8); PG8_WAIT_L(0); PG8_BAR; PG8_MMA(1, 0, At, B0); PG8_MMA(1, 1, At, B1); PG8_BAR; PG8_SCHED;
            PG8_LDB(B0, 1, 0); PG8_LDB(B1, 1, 1); PG8_SCHED; PG8_LDA(At, 1, 0); PG8_STAGE(PG8_SA(0, 1), a2 + hstepA, voffA);
            PG8_WAIT_V(8); PG8_WAIT_L(0); PG8_BAR; PG8_MMA(0, 0, At, B0); PG8_MMA(0, 1, At, B1); PG8_BAR; PG8_SCHED;
            PG8_LDA(At, 1, 1); PG8_STAGE(PG8_SB(1, 0), b3, voffB); PG8_STAGE(PG8_SB(1, 1), b3 + hstepB, voffB); PG8_STAGE(PG8_SA(1, 0), a3, voffA);
            PG8_WAIT_V(8); PG8_WAIT_L(0); PG8_BAR; PG8_MMA(1, 0, At, B0); PG8_MMA(1, 1, At, B1); PG8_BAR; PG8_SCHED;
            } else {
            PG8_LDB(B0, 0, 0); PG8_SCHED; PG8_LDA(At, 0, 0); PG8_STAGE(PG8_SA(1, 1), a1 + hstepA, voffA);
            PG8_WAIT_L(8); PG8_BAR; PG8_WAIT_L(0); PG8_MMA(0, 0, At, B0); PG8_BAR; PG8_SCHED;
            PG8_LDB(B1, 0, 1); PG8_STAGE(PG8_SB(0, 0), b2, voffB);
            PG8_BAR; PG8_WAIT_L(0); PG8_MMA(0, 1, At, B1); PG8_BAR;
            PG8_LDA(At, 0, 1); PG8_STAGE(PG8_SA(0, 0), a2, voffA);
            PG8_BAR; PG8_WAIT_L(0); PG8_MMA(1, 0, At, B0); PG8_BAR; PG8_SCHED;
            PG8_STAGE(PG8_SB(0, 1), b2 + hstepB, voffB);
            PG8_WAIT_V(6); PG8_BAR; PG8_MMA(1, 1, At, B1); PG8_BAR;
            PG8_LDB(B0, 1, 0); PG8_SCHED; PG8_LDA(At, 1, 0); PG8_STAGE(PG8_SA(0, 1), a2 + hstepA, voffA);
            PG8_WAIT_L(8); PG8_BAR; PG8_WAIT_L(0); PG8_MMA(0, 0, At, B0); PG8_BAR; PG8_SCHED;
            PG8_LDB(B1, 1, 1); PG8_STAGE(PG8_SB(1, 0), b3, voffB);
            PG8_BAR; PG8_WAIT_L(0); PG8_MMA(0, 1, At, B1); PG8_BAR;
            PG8_LDA(At, 1, 1); PG8_STAGE(PG8_SA(1, 0), a3, voffA);
            PG8_BAR; PG8_WAIT_L(0); PG8_MMA(1, 0, At, B0); PG8_BAR; PG8_SCHED;
            PG8_STAGE(PG8_SB(1, 1), b3 + hstepB, voffB);
            PG8_WAIT_V(6); PG8_BAR; PG8_MMA(1, 1, At, B1); PG8_BAR;
            }
        }
        if constexpr (ALIGN_EPI) { if (wr == 0) PG8_BAR; }
        if constexpr (!Epi::AFTER_DRAIN) { E(acc, cur, wr, wc, fr, fq); S.done(cur); }
        if (!has_next) break;
#pragma unroll
        for (int a = 0; a < 2; ++a)
#pragma unroll
            for (int b = 0; b < 2; ++b)
#pragma unroll
                for (int m = 0; m < 4; ++m)
#pragma unroll
                    for (int n = 0; n < 2; ++n) acc[a][b][m][n] = (f32x4){0.f, 0.f, 0.f, 0.f};
        cur = nxt; cA = nA; cB = nB; ++ui;
        if constexpr (ALIGN_EPI) { if (wr == 1) PG8_BAR; }
    }
    PG8_WAIT_V(0);
    if constexpr (!ALIGN_EPI) { if (wr == 0) PG8_BAR; }
    PG8_BAR;
    if constexpr (Epi::AFTER_DRAIN) { E.fused(acc, cur, wr, wc, fr, fq, lds, wid, lane); S.done(cur); }
#undef PG8_SA
#undef PG8_SB
#undef PG8_STAGE
#undef PG8_LDA
#undef PG8_LDB
#undef PG8_MMA
#undef PG8_WAIT_V
#undef PG8_WAIT_L
#undef PG8_BAR
#undef PG8_SCHED
}
}

#define LAS __attribute__((address_space(3)))
typedef unsigned short bf16;
typedef short bf16x8 __attribute__((ext_vector_type(8)));
typedef short s16x4 __attribute__((ext_vector_type(4)));
typedef float f32x4 __attribute__((ext_vector_type(4)));
typedef float f32x16 __attribute__((ext_vector_type(16)));
typedef unsigned u32x4 __attribute__((ext_vector_type(4)));
typedef unsigned u32x2 __attribute__((ext_vector_type(2)));

constexpr int NB = 32, SEQ = 2048, DM = 1024, M = NB * SEQ, NPROJ = 3072, FF = 4096;
constexpr int PC_Q = 0, PC_R = 512, PC_K = 1024, PC_V = 1536, PC_QI = 2048, PC_CL = 2560, PC_KI = 2688, PC_XW = 2752, PC_XA = 2816, PC_XG = 2880, PC_WI = 3008;
constexpr size_t MiB = 1u << 20;
constexpr size_t WS_MOD = 0, WS_WUKT = 1 * MiB, WS_WUK = WS_WUKT + 131072, WS_WUVT = WS_WUK + 131072, WS_INVR = 2 * MiB, WS_WIN = 4 * MiB, WS_WOUT = 10 * MiB,
                 WS_W1 = 12 * MiB, WS_W2 = 20 * MiB, WS_SC = 28 * MiB, WS_CKV = 36 * MiB, WS_REGA = 64 * MiB, WS_PROJ = 192 * MiB, WS_SCANIN = 576 * MiB,
                 WS_U = 192 * MiB, WS_END = 960 * MiB;
constexpr int LDS_BYTES = 151552;
constexpr int NWAVES = 8;

struct Params {
    const float *x, *c, *w_ada, *b_ada, *g_mix, *g_ffn, *w_in, *g_q, *g_k, *g_kv, *w_uk, *w_uv, *mu, *w0, *w2, *a0, *a2, *g2, *k_k, *k_a, *r_k, *ln_w, *ln_b, *w_out, *w_ff1, *w_ff2;
    float* out; unsigned char* ws; int ph_lo, ph_hi;
};

__device__ __forceinline__ unsigned pk2(float lo, float hi) { return pg8::cvt_pk_bf16(lo, hi); }
__device__ __forceinline__ float bflo(unsigned w) { return __uint_as_float(w << 16); }
__device__ __forceinline__ float bfhi(unsigned w) { return __uint_as_float(w & 0xffff0000u); }
__device__ __forceinline__ float bf2f(bf16 h) { return __uint_as_float((unsigned)h << 16); }
__device__ __forceinline__ bf16 f2bf(float f) { return (bf16)(pk2(f, 0.f) & 0xffffu); }
__device__ __forceinline__ float wave_sum(float v) {
#pragma unroll
    for (int o = 1; o < 64; o <<= 1) v += __shfl_xor(v, o);
    return v;
}
__device__ __forceinline__ f32x16 mfma32(bf16x8 a, bf16x8 b, f32x16 c) { return __builtin_amdgcn_mfma_f32_32x32x16_bf16(a, b, c, 0, 0, 0); }
__device__ __forceinline__ f32x4 mfma16(bf16x8 a, bf16x8 b, f32x4 c) { return __builtin_amdgcn_mfma_f32_16x16x32_bf16(a, b, c, 0, 0, 0); }

__device__ __forceinline__ int win_src_col(int n) {
    if (n < 512) return n;
    if (n < 1024) return 1224 + (n - 512);
    if (n < 1536) return 1736 + (n - 1024);
    if (n < 2048) return 2248 + (n - 1536);
    if (n < 2560) return 640 + (n - 2048);
    if (n < 2688) return 512 + (n - 2560);
    if (n < 2752) return 1152 + (n - 2688);
    if (n < 2816) return 2760 + (n - 2752);
    if (n < 2880) return 2824 + (n - 2816);
    if (n < 3008) return 2888 + (n - 2880);
    if (n < 3016) return 1216 + (n - 3008);
    return -1;
}
__device__ __forceinline__ void conv_t_item(const float* W, int K, int Nsrc, bf16* WT, int nblk, int item, float* scr, int lane, bool is_win) {
    const int kb = item / nblk, nb = item % nblk, k0 = 64 * kb, n0 = 32 * nb;
    int ns = n0 + (lane & 31); if (is_win) ns = win_src_col(ns);
#pragma unroll 8
    for (int i = 0; i < 32; ++i) { const int kk = 2 * i + (lane >> 5); scr[kk * 33 + (lane & 31)] = ns >= 0 ? W[(size_t)(k0 + kk) * Nsrc + ns] : 0.f; }
    asm volatile("s_waitcnt lgkmcnt(0)" ::: "memory");
    const int c = lane & 7;
#pragma unroll
    for (int j = 0; j < 4; ++j) { const int n = (lane >> 3) + 8 * j; const float* s = scr + (8 * c) * 33 + n;
        u32x4 o; o.x = pk2(s[0 * 33], s[1 * 33]); o.y = pk2(s[2 * 33], s[3 * 33]); o.z = pk2(s[4 * 33], s[5 * 33]); o.w = pk2(s[6 * 33], s[7 * 33]);
        *(u32x4*)(WT + (size_t)(n0 + n) * K + k0 + 8 * c) = o; }
    asm volatile("s_waitcnt lgkmcnt(0)" ::: "memory");
}
__device__ __forceinline__ void adaln_block(const Params& p, float* ldsf, int cb, int tid) {
    const int lane = tid & 63, wv = tid >> 6, e = cb * 64 + lane;
    float* SC = ldsf; float* RED = ldsf + 16384; float* mod = (float*)(p.ws + WS_MOD);
    for (int half = 0; half < 2; ++half) {
        const int b0 = half * 16;
        for (int i = tid; i < 16384; i += 512) { const float cv = p.c[b0 * 1024 + i]; SC[i] = cv / (1.f + __expf(-cv)); }
        __syncthreads();
        float acc[16];
#pragma unroll
        for (int bb = 0; bb < 16; ++bb) acc[bb] = 0.f;
        for (int d = wv * 128; d < wv * 128 + 128; d += 4) {
            const float w0 = p.w_ada[(size_t)d * 6144 + e], w1 = p.w_ada[(size_t)(d + 1) * 6144 + e], w2 = p.w_ada[(size_t)(d + 2) * 6144 + e], w3 = p.w_ada[(size_t)(d + 3) * 6144 + e];
#pragma unroll
            for (int bb = 0; bb < 16; ++bb) { const f32x4 s = *(const f32x4*)(SC + bb * 1024 + d); acc[bb] += (s.x * w0 + s.y * w1) + (s.z * w2 + s.w * w3); }
        }
#pragma unroll
        for (int bb = 0; bb < 16; ++bb) RED[(wv * 16 + bb) * 64 + lane] = acc[bb];
        __syncthreads();
#pragma unroll
        for (int q = 0; q < 2; ++q) { const int bb = wv * 2 + q; float s = p.b_ada[e];
#pragma unroll
            for (int ww = 0; ww < 8; ++ww) s += RED[(ww * 16 + bb) * 64 + lane];
            mod[(size_t)(b0 + bb) * 6144 + e] = s; }
        __syncthreads();
    }
}
__device__ __forceinline__ void phase_pro(const Params& p, unsigned char* lds, int tid, int G) {
    const int lane = tid & 63, wv = tid >> 6;
    for (int cb = blockIdx.x; cb < 96; cb += G) adaln_block(p, (float*)lds, cb, tid);
    __syncthreads();
    float* scr = (float*)lds + wv * (64 * 33 + 16);
    const int gw = blockIdx.x * NWAVES + wv, NGW = G * NWAVES;
    bf16* WIN = (bf16*)(p.ws + WS_WIN); bf16* WOUT = (bf16*)(p.ws + WS_WOUT); bf16* W1 = (bf16*)(p.ws + WS_W1); bf16* W2 = (bf16*)(p.ws + WS_W2);
    bf16* WUKT = (bf16*)(p.ws + WS_WUKT); bf16* WUK = (bf16*)(p.ws + WS_WUK); bf16* WUVT = (bf16*)(p.ws + WS_WUVT);
    constexpr int I_IN = (DM / 64) * (NPROJ / 32), I_OUT = (DM / 64) * (DM / 32), I_1 = (DM / 64) * (FF / 32), I_2 = (FF / 64) * (DM / 32), I_UK = (128 / 64) * (512 / 32);
    constexpr int NITEMS = I_IN + I_OUT + I_1 + I_2 + 2 * I_UK;
    for (int it = gw; it < NITEMS; it += NGW) {
        int r = it;
        if (r < I_IN) { conv_t_item(p.w_in, DM, 3016, WIN, NPROJ / 32, r, scr, lane, true); continue; } r -= I_IN;
        if (r < I_OUT) { conv_t_item(p.w_out, DM, DM, WOUT, DM / 32, r, scr, lane, false); continue; } r -= I_OUT;
        if (r < I_1) { conv_t_item(p.w_ff1, DM, FF, W1, FF / 32, r, scr, lane, false); continue; } r -= I_1;
        if (r < I_2) { conv_t_item(p.w_ff2, FF, DM, W2, DM / 32, r, scr, lane, false); continue; } r -= I_2;
        if (r < I_UK) { conv_t_item(p.w_uk, 128, 512, WUKT, 512 / 32, r, scr, lane, false); continue; } r -= I_UK;
        conv_t_item(p.w_uv, 128, 512, WUVT, 512 / 32, r, scr, lane, false);
    }
    for (int i = blockIdx.x * 512 + tid; i < 128 * 512 / 2; i += G * 512) { const float a = p.w_uk[2 * i], b = p.w_uk[2 * i + 1]; ((unsigned*)WUK)[i] = pk2(a, b); }
}

__device__ __forceinline__ void hn_rows(const float* src, const float* g, const float* mod, int off_sh, int off_sc, bf16* dst, int gw, int NGW, int lane) {
    for (int m = gw; m < M; m += NGW) {
        const f32x4* xr = (const f32x4*)(src + (size_t)m * DM) + lane;
        f32x4 v[4]; float s = 0.f;
#pragma unroll
        for (int j = 0; j < 4; ++j) { v[j] = xr[64 * j]; s += (v[j].x * v[j].x + v[j].y * v[j].y) + (v[j].z * v[j].z + v[j].w * v[j].w); }
        s = wave_sum(s); const float rstd = rsqrtf(s * (1.f / DM) + 1e-6f);
        const float* mb = mod + (size_t)(m >> 11) * 6144;
        unsigned long long* o8 = (unsigned long long*)(dst + (size_t)m * DM) + lane;
#pragma unroll
        for (int j = 0; j < 4; ++j) { const int col = 4 * lane + 256 * j;
            const f32x4 gg = *(const f32x4*)(g + col), sc = *(const f32x4*)(mb + off_sc + col), sh = *(const f32x4*)(mb + off_sh + col);
            const f32x4 y = v[j] * rstd * gg * (1.f + sc) + sh;
            o8[64 * j] = (unsigned long long)pk2(y.x, y.y) | ((unsigned long long)pk2(y.z, y.w) << 32); }
    }
}

__device__ __forceinline__ void rwkv_prep_item(const Params& p, unsigned char* lds, int it, int tid) {
    float* XS = (float*)lds;
    const bf16* PROJ = (const bf16*)(p.ws + WS_PROJ); bf16* SIN = (bf16*)(p.ws + WS_SCANIN); float* SSC = (float*)(p.ws + WS_SC);
    const int row0 = it * 64, t0 = (it & 31) * 64, b = it >> 5;
    const int lane = tid & 63, wv = tid >> 6;
    { const int jj = tid & 255; const float mu = p.mu[1536 + jj];
      for (int t = tid >> 8; t < 64; t += 2) {
          const size_t r = (size_t)(row0 + t) * NPROJ + PC_XW + jj;
          const float cur = bf2f(PROJ[r]); const float prev = (t0 + t == 0) ? 0.f : bf2f(PROJ[r - NPROJ]);
          float v = cur + mu * (prev - cur);
          if (jj < 64) v = tanhf(v); else if (jj >= 128) v = 1.f / (1.f + __expf(-v));
          XS[t * 256 + jj] = v; } }
    __syncthreads();
    const int c = tid;
    const size_t tok0 = (size_t)b * 16384 + (size_t)wv * 2048 + t0;
    const float mu_r = p.mu[c], mu_k = p.mu[512 + c];
    {   float wc[64]; const float* wp = p.a2 + c;
#pragma unroll
        for (int k = 0; k < 64; ++k) { wc[k] = *wp; wp += 512; asm volatile("" : "+v"(wp)); }
        const float a0c = p.a0[c], kkc = p.k_k[c], kac = p.k_a[c], rkc = p.r_k[c];
#pragma unroll 1
        for (int t = 0; t < 64; ++t) {
            const float* xs = XS + t * 256 + 64; float dot = 0.f;
#pragma unroll
            for (int k = 0; k < 64; k += 4) { const f32x4 s = *(const f32x4*)(xs + k); dot += (s.x * wc[k] + s.y * wc[k + 1]) + (s.z * wc[k + 2] + s.w * wc[k + 3]); if ((k & 28) == 28) asm volatile("" ::: "memory"); }
            const float a = 1.f / (1.f + __expf(-(a0c + dot)));
            const size_t rr = (size_t)(row0 + t) * NPROJ; const bool first = (t0 + t == 0);
            const float rc = bf2f(PROJ[rr + PC_R + c]), rp = first ? 0.f : bf2f(PROJ[rr - NPROJ + PC_R + c]); const float r = rc + mu_r * (rp - rc);
            const float kc = bf2f(PROJ[rr + PC_K + c]), kp = first ? 0.f : bf2f(PROJ[rr - NPROJ + PC_K + c]); const float k = kc + mu_k * (kp - kc);
            const float kkv = k * kkc; const float nrm2 = wave_sum(kkv * kkv);
            const float kk = kkv / fmaxf(sqrtf(nrm2), 1e-12f);
            const float kka = kk * a, kpr = k * (1.f + (a - 1.f) * kac);
            const float c1 = wave_sum(kka * r), c2 = wave_sum(kpr * r), c3 = wave_sum(r * kpr * rkc);
            bf16* so = SIN + (tok0 + t) * 384 + lane;
            so[0] = f2bf(kk); so[192] = f2bf(kka); so[256] = f2bf(kpr);
            if (lane == 0) { f32x4 sc4 = {c1, c2, c3, 0.f}; *(f32x4*)(SSC + (tok0 + t) * 4) = sc4; }
        }
    }
    {   float wc[64]; const float* wp = p.w2 + c;
#pragma unroll
        for (int k = 0; k < 64; ++k) { wc[k] = *wp; wp += 512; asm volatile("" : "+v"(wp)); }
        const float w0c = p.w0[c];
#pragma unroll 1
        for (int t = 0; t < 64; ++t) {
            const float* xs = XS + t * 256; float dot = 0.f;
#pragma unroll
            for (int k = 0; k < 64; k += 4) { const f32x4 s = *(const f32x4*)(xs + k); dot += (s.x * wc[k] + s.y * wc[k + 1]) + (s.z * wc[k + 2] + s.w * wc[k + 3]); if ((k & 28) == 28) asm volatile("" ::: "memory"); }
            const float u = w0c + dot;
            const float wlog = -__logf(1.f + __expf(-u)) - 0.5f;
            const float e = __expf(wlog); const float w = __expf(-e); const float d = 1.f - w;
            const size_t rr = (size_t)(row0 + t) * NPROJ; const bool first = (t0 + t == 0);
            const float rc = bf2f(PROJ[rr + PC_R + c]), rp = first ? 0.f : bf2f(PROJ[rr - NPROJ + PC_R + c]); const float r = rc + mu_r * (rp - rc);
            bf16* so = SIN + (tok0 + t) * 384 + lane;
            so[64] = f2bf(w * r); so[128] = f2bf(d);
        }
    }
    {   float wg[128]; const float* wp = p.g2 + c;
#pragma unroll
        for (int k = 0; k < 128; ++k) { wg[k] = *wp; wp += 512; asm volatile("" : "+v"(wp)); }
#pragma unroll 1
        for (int t = 0; t < 64; ++t) {
            const float* xs = XS + t * 256 + 128; float dot = 0.f;
#pragma unroll
            for (int k = 0; k < 128; k += 4) { const f32x4 s = *(const f32x4*)(xs + k); dot += (s.x * wg[k] + s.y * wg[k + 1]) + (s.z * wg[k + 2] + s.w * wg[k + 3]); if ((k & 28) == 28) asm volatile("" ::: "memory"); }
            SIN[(tok0 + t) * 384 + 320 + lane] = f2bf(dot);
        }
    }
    __syncthreads();
}

__device__ __forceinline__ void dsa_prep_item(const Params& p, int tile, int lane) {
    const bf16* PROJ = (const bf16*)(p.ws + WS_PROJ); bf16* CKV = (bf16*)(p.ws + WS_CKV); float* INVR = (float*)(p.ws + WS_INVR); bf16* QABS = (bf16*)(p.ws + WS_REGA);
    const bf16* WUKT = (const bf16*)(p.ws + WS_WUKT); const bf16* WUK = (const bf16*)(p.ws + WS_WUK);
    const int r = lane & 31, hh = lane >> 5; const size_t row = (size_t)tile * 32 + r; const bf16* prow = PROJ + row * NPROJ;
    bf16x8 cf[8];
    {   u32x4 craw[8]; float ssq = 0.f;
#pragma unroll
        for (int s = 0; s < 8; ++s) { craw[s] = *(const u32x4*)(prow + PC_CL + 16 * s + 8 * hh);
#pragma unroll
            for (int w = 0; w < 4; ++w) { const float lo = bflo(craw[s][w]), hi = bfhi(craw[s][w]); ssq += lo * lo + hi * hi; } }
        ssq += __shfl_xor(ssq, 32);
        const float rstd = rsqrtf(ssq * (1.f / 128.f) + 1e-6f);
#pragma unroll
        for (int s = 0; s < 8; ++s) { const float* g = p.g_kv + 16 * s + 8 * hh; const f32x4 g0 = *(const f32x4*)g, g1 = *(const f32x4*)(g + 4);
            u32x4 o; o.x = pk2(bflo(craw[s].x) * rstd * g0.x, bfhi(craw[s].x) * rstd * g0.y); o.y = pk2(bflo(craw[s].y) * rstd * g0.z, bfhi(craw[s].y) * rstd * g0.w);
            o.z = pk2(bflo(craw[s].z) * rstd * g1.x, bfhi(craw[s].z) * rstd * g1.y); o.w = pk2(bflo(craw[s].w) * rstd * g1.z, bfhi(craw[s].w) * rstd * g1.w);
            cf[s] = __builtin_bit_cast(bf16x8, o); *(u32x4*)(CKV + row * 128 + 16 * s + 8 * hh) = o; }
    }
    for (int h = 0; h < 8; ++h) { float ss = 0.f;
#pragma unroll
        for (int dt = 0; dt < 2; ++dt) { f32x16 acc = {}; const bf16* wrow = WUKT + (size_t)(h * 64 + dt * 32 + r) * 128 + 8 * hh;
#pragma unroll
            for (int s = 0; s < 8; ++s) { const bf16x8 a = *(const bf16x8*)(wrow + 16 * s); acc = mfma32(a, cf[s], acc); }
#pragma unroll
            for (int i = 0; i < 16; ++i) ss += acc[i] * acc[i]; }
        ss += __shfl_xor(ss, 32);
        if (hh == 0) INVR[row * 8 + h] = rsqrtf(ss * (1.f / 64.f) + 1e-6f);
    }
    for (int h = 0; h < 8; ++h) {
        u32x4 qraw[4]; float ssq = 0.f;
#pragma unroll
        for (int s = 0; s < 4; ++s) { qraw[s] = *(const u32x4*)(prow + PC_Q + h * 64 + 16 * s + 8 * hh);
#pragma unroll
            for (int w = 0; w < 4; ++w) { const float lo = bflo(qraw[s][w]), hi = bfhi(qraw[s][w]); ssq += lo * lo + hi * hi; } }
        ssq += __shfl_xor(ssq, 32);
        const float rstd = rsqrtf(ssq * (1.f / 64.f) + 1e-6f);
        bf16x8 qf[4];
#pragma unroll
        for (int s = 0; s < 4; ++s) { const int d0 = 16 * s + 8 * hh; float gg[8];
#pragma unroll
            for (int j = 0; j < 8; ++j) gg[j] = p.g_q[d0 + j] * p.g_k[d0 + j] * rstd;
            u32x4 o; o.x = pk2(bflo(qraw[s].x) * gg[0], bfhi(qraw[s].x) * gg[1]); o.y = pk2(bflo(qraw[s].y) * gg[2], bfhi(qraw[s].y) * gg[3]);
            o.z = pk2(bflo(qraw[s].z) * gg[4], bfhi(qraw[s].z) * gg[5]); o.w = pk2(bflo(qraw[s].w) * gg[6], bfhi(qraw[s].w) * gg[7]);
            qf[s] = __builtin_bit_cast(bf16x8, o); }
#pragma unroll
        for (int lt = 0; lt < 4; ++lt) { f32x16 acc = {}; const bf16* wrow = WUK + (size_t)(lt * 32 + r) * 512 + h * 64 + 8 * hh;
#pragma unroll
            for (int s = 0; s < 4; ++s) { const bf16x8 a = *(const bf16x8*)(wrow + 16 * s); acc = mfma32(a, qf[s], acc); }
#pragma unroll
            for (int g4 = 0; g4 < 4; ++g4) { u32x2 o; o.x = pk2(acc[4 * g4] * 0.125f, acc[4 * g4 + 1] * 0.125f); o.y = pk2(acc[4 * g4 + 2] * 0.125f, acc[4 * g4 + 3] * 0.125f);
                *(u32x2*)(QABS + row * 1024 + h * 128 + lt * 32 + 8 * g4 + 4 * hh) = o; } }
    }
}

__device__ __forceinline__ void rwkv_scan_chain(const Params& p, unsigned char* lds, int chain, int lane) {
    float* LV = (float*)lds;
    const int b = chain >> 3, h = chain & 7;
    bf16* PROJ = (bf16*)(p.ws + WS_PROJ); const bf16* SIN = (const bf16*)(p.ws + WS_SCANIN) + ((size_t)b * 16384 + (size_t)h * 2048) * 384;
    const float* SSC = (const float*)(p.ws + WS_SC) + ((size_t)b * 16384 + (size_t)h * 2048) * 4;
    const float mu_v = p.mu[1024 + h * 64 + lane], lnw = p.ln_w[h * 64 + lane], lnb = p.ln_b[h * 64 + lane];
    float S[64];
#pragma unroll
    for (int j = 0; j < 64; ++j) S[j] = 0.f;
    float vprev = 0.f;
    for (int tc = 0; tc < SEQ; tc += 16) {
#pragma unroll
        for (int i = 0; i < 10; ++i) { const int id = i * 64 + lane, tt = id / 40, ch = id % 40;
            const u32x4 raw = *(const u32x4*)(SIN + (size_t)(tc + tt) * 384 + ch * 8);
            float* dst = LV + tt * 320 + ch * 8;
            *(f32x4*)dst = (f32x4){bflo(raw.x), bfhi(raw.x), bflo(raw.y), bfhi(raw.y)}; *(f32x4*)(dst + 4) = (f32x4){bflo(raw.z), bfhi(raw.z), bflo(raw.w), bfhi(raw.w)}; }
        for (int tt = 0; tt < 16; ++tt) {
            const int t = tc + tt; const size_t row = (size_t)b * SEQ + t;
            const float vcur = bf2f(PROJ[row * NPROJ + PC_V + h * 64 + lane]);
            const float vi = vcur + mu_v * (vprev - vcur); vprev = vcur;
            const float gi = bf2f(SIN[(size_t)t * 384 + 320 + lane]);
            const f32x4 sc = *(const f32x4*)(SSC + (size_t)t * 4);
            const float* L = LV + tt * 320;
            float acc_sa = 0.f, acc_o = 0.f;
#pragma unroll
            for (int j = 0; j < 64; j += 4) { const f32x4 kk4 = *(const f32x4*)(L + j), wr4 = *(const f32x4*)(L + 64 + j);
#pragma unroll
                for (int e = 0; e < 4; ++e) { acc_sa = fmaf(S[j + e], kk4[e], acc_sa); acc_o = fmaf(S[j + e], wr4[e], acc_o); }
                if ((j & 12) == 12) asm volatile("" ::: "memory"); }
            const float sa = -acc_sa;
#pragma unroll
            for (int j = 0; j < 64; j += 4) { const f32x4 d4 = *(const f32x4*)(L + 128 + j), ka4 = *(const f32x4*)(L + 192 + j), kp4 = *(const f32x4*)(L + 256 + j);
#pragma unroll
                for (int e = 0; e < 4; ++e) { float s = S[j + e]; s = fmaf(-d4[e], s, s); s = fmaf(sa, ka4[e], s); s = fmaf(vi, kp4[e], s); S[j + e] = s; }
                if ((j & 12) == 12) asm volatile("" ::: "memory"); }
            const float o = acc_o + sa * sc.x + vi * sc.y;
            const float mean = wave_sum(o) * (1.f / 64.f); const float dv = o - mean; const float var = wave_sum(dv * dv) * (1.f / 64.f);
            float y = dv * rsqrtf(var + 64e-5f) * lnw + lnb;
            y = (y + sc.z * vi) * gi;
            PROJ[row * NPROJ + PC_R + h * 64 + lane] = f2bf(y);
        }
    }
}

__device__ __forceinline__ unsigned f2key(float f) { unsigned b = __float_as_uint(f); if ((b << 1) == 0u) b = 0u; return (b & 0x80000000u) ? ~b : (b | 0x80000000u); }
__device__ __forceinline__ unsigned offb(unsigned row, unsigned ch) { return 256u * row + 16u * (ch ^ (((row & 3) << 2) | ((row >> 2) & 3))); }

__device__ __forceinline__ void topk_select(const float* sc, int N, unsigned* hist, unsigned short* sel, int lane) {
    unsigned prefix = 0u, mask = 0u; int rem = 256;
    for (int pass = 0; pass < 4; ++pass) {
        const int shift = 24 - 8 * pass;
#pragma unroll
        for (int i = 0; i < 4; ++i) hist[lane * 4 + i] = 0u;
        asm volatile("s_waitcnt lgkmcnt(0)" ::: "memory");
        for (int i = lane; i < N; i += 64) { const unsigned u = f2key(sc[i]); if ((u & mask) == prefix) atomicAdd(&hist[(u >> shift) & 255u], 1u); }
        asm volatile("s_waitcnt lgkmcnt(0)" ::: "memory");
        const unsigned c0 = hist[lane * 4], c1 = hist[lane * 4 + 1], c2 = hist[lane * 4 + 2], c3 = hist[lane * 4 + 3];
        const int cnt4 = (int)(c0 + c1 + c2 + c3);
        int incl = cnt4;
#pragma unroll
        for (int o = 1; o < 64; o <<= 1) { const int v = __shfl_down(incl, o); if (lane + o < 64) incl += v; }
        const int excl = incl - cnt4;
        const bool mine = (excl < rem) && (rem <= incl);
        const unsigned long long bal = __ballot(mine);
        const int L = (int)__builtin_ctzll(bal);
        const int ex = __shfl(excl, L); const int b3 = (int)__shfl((int)c3, L), b2 = (int)__shfl((int)c2, L), b1 = (int)__shfl((int)c1, L);
        int above = ex, bin;
        if (above + b3 >= rem) bin = 3; else { above += b3; if (above + b2 >= rem) bin = 2; else { above += b2; if (above + b1 >= rem) bin = 1; else { above += b1; bin = 0; } } }
        rem -= above; prefix |= (unsigned)(L * 4 + bin) << shift; mask |= 0xffu << shift;
    }
    const unsigned T = prefix; const int ngt = 256 - rem; int base_gt = 0, base_eq = 0;
    const unsigned long long lt_mask = (1ull << lane) - 1ull;
    for (int i0 = 0; i0 < N; i0 += 64) { const int i = i0 + lane; const unsigned u = f2key(sc[i]);
        const bool gt = u > T, eq = u == T;
        const unsigned long long bg = __ballot(gt), be = __ballot(eq);
        const int rg = __popcll(bg & lt_mask), re = __popcll(be & lt_mask);
        if (gt) sel[base_gt + rg] = (unsigned short)i;
        if (eq && (base_eq + re < rem)) sel[ngt + base_eq + re] = (unsigned short)i;
        base_gt += __popcll(bg); base_eq += __popcll(be); }
    asm volatile("s_waitcnt lgkmcnt(0)" ::: "memory");
}

__device__ __forceinline__ void dsa_attend(const Params& p, int b, int t, const unsigned short* sel, int cnt, unsigned char* stage, int lane) {
    const bf16* CKV = (const bf16*)(p.ws + WS_CKV) + (size_t)b * SEQ * 128; const float* INVR = (const float*)(p.ws + WS_INVR) + (size_t)b * SEQ * 8;
    bf16* QO = (bf16*)(p.ws + WS_REGA) + ((size_t)b * SEQ + t) * 1024;
    const int hd = lane & 15, grp = lane >> 4;
    bf16x8 bq[4];
#pragma unroll
    for (int s = 0; s < 4; ++s) { u32x4 z = {0u, 0u, 0u, 0u}; if (hd < 8) z = *(const u32x4*)(QO + hd * 128 + 32 * s + 8 * grp); bq[s] = __builtin_bit_cast(bf16x8, z); }
    const float slope = (hd < 8) ? exp2f(-(float)(hd + 1)) : 0.f;
    const int hsafe = hd & 7;
    float m_run = -INFINITY, l_part = 0.f;
    f32x4 O[8];
#pragma unroll
    for (int c = 0; c < 8; ++c) O[c] = (f32x4){0.f, 0.f, 0.f, 0.f};
    const LAS unsigned char* st3 = (const LAS unsigned char*)stage;
    const unsigned q4 = (lane & 15) >> 2, p4 = lane & 3;
    for (int ks = 0; ks < cnt; ks += 32) {
#pragma unroll
        for (int i = 0; i < 8; ++i) { const int id = i * 64 + lane, row = id >> 4, ch = id & 15; const int key = sel[ks + row];
            const u32x4 v = *(const u32x4*)(CKV + (size_t)key * 128 + ch * 8); *(u32x4*)(stage + offb(row, ch)) = v; }
        asm volatile("s_waitcnt vmcnt(0) lgkmcnt(0)" ::: "memory");
        float lg[8];
#pragma unroll
        for (int T = 0; T < 2; ++T) { f32x4 acc = {0.f, 0.f, 0.f, 0.f};
#pragma unroll
            for (int s = 0; s < 4; ++s) { const bf16x8 a = *(const bf16x8*)(stage + offb((lane & 15) + 16 * T, 4 * s + grp)); acc = mfma16(a, bq[s], acc); }
#pragma unroll
            for (int rg = 0; rg < 4; ++rg) { const int key = sel[ks + 16 * T + 4 * grp + rg];
                const float ir = INVR[(size_t)key * 8 + hsafe];
                lg[4 * T + rg] = acc[rg] * ir - slope * fabsf((float)(t - key)); } }
        float mx = lg[0];
#pragma unroll
        for (int i = 1; i < 8; ++i) mx = fmaxf(mx, lg[i]);
        mx = fmaxf(mx, __shfl_xor(mx, 16)); mx = fmaxf(mx, __shfl_xor(mx, 32));
        const float m_new = fmaxf(m_run, mx);
        const float alpha = __expf(m_run - m_new);
        float ps = 0.f; float pv[8];
#pragma unroll
        for (int i = 0; i < 8; ++i) { pv[i] = __expf(lg[i] - m_new); ps += pv[i]; }
        l_part = l_part * alpha + ps; m_run = m_new;
        float ar[4];
#pragma unroll
        for (int rg = 0; rg < 4; ++rg) ar[rg] = __shfl(alpha, 4 * grp + rg);
#pragma unroll
        for (int c = 0; c < 8; ++c)
#pragma unroll
            for (int rg = 0; rg < 4; ++rg) O[c][rg] *= ar[rg];
        u32x4 pw; pw.x = pk2(pv[0], pv[1]); pw.y = pk2(pv[2], pv[3]); pw.z = pk2(pv[4], pv[5]); pw.w = pk2(pv[6], pv[7]);
        const bf16x8 pa = __builtin_bit_cast(bf16x8, pw);
#pragma unroll
        for (int c = 0; c < 8; ++c) {
            const s16x4 lo = __builtin_bit_cast(s16x4, __builtin_amdgcn_ds_read_tr16_b64_v4i16((LAS s16x4*)(st3 + offb(4 * grp + q4, 2 * c + (p4 >> 1)) + 8 * (p4 & 1))));
            const s16x4 hi = __builtin_bit_cast(s16x4, __builtin_amdgcn_ds_read_tr16_b64_v4i16((LAS s16x4*)(st3 + offb(16 + 4 * grp + q4, 2 * c + (p4 >> 1)) + 8 * (p4 & 1))));
            const bf16x8 vb = {lo[0], lo[1], lo[2], lo[3], hi[0], hi[1], hi[2], hi[3]};
            O[c] = mfma16(pa, vb, O[c]); }
        asm volatile("s_waitcnt lgkmcnt(0)" ::: "memory");
    }
    float l = l_part; l += __shfl_xor(l, 16); l += __shfl_xor(l, 32);
    const float il = 1.f / l;
    float ir[4];
#pragma unroll
    for (int rg = 0; rg < 4; ++rg) ir[rg] = __shfl(il, 4 * grp + rg);
    if (grp < 2) {
#pragma unroll
        for (int rg = 0; rg < 4; ++rg)
#pragma unroll
            for (int c = 0; c < 8; ++c) QO[(4 * grp + rg) * 128 + 16 * c + hd] = f2bf(O[c][rg] * ir[rg]);
    }
}

__device__ __forceinline__ void dsa_item(const Params& p, unsigned char* lds, int it, int tid) {
    const bf16* PROJ = (const bf16*)(p.ws + WS_PROJ);
    float* SC = (float*)lds;
    unsigned* HIST = (unsigned*)(lds + 131072);
    unsigned short* SEL = (unsigned short*)(lds + 131072 + 8192);
    float* WQ = (float*)(lds + 147456);
    const int lane = tid & 63, wv = tid >> 6;
    const int b = it >> 7, tq0 = (it & 127) * 16, N = ((tq0 >> 6) + 1) * 64; const size_t rowq0 = (size_t)b * SEQ + tq0;
    if (N > 256 && !MK_DBG_NOTOPK) {
        const int r = lane & 31, g = lane >> 5;
        const int ql = 2 * ((r >> 2) & 1) + (r >> 4), hdm = 4 * ((r >> 3) & 1) + (r & 3);
        bf16x8 af[4][4];
#pragma unroll
        for (int qg = 0; qg < 4; ++qg)
#pragma unroll
            for (int s = 0; s < 4; ++s) af[qg][s] = *(const bf16x8*)(PROJ + (rowq0 + 4 * qg + ql) * NPROJ + PC_QI + hdm * 64 + 16 * s + 8 * g);
        if (tid < 128) WQ[tid] = bf2f(PROJ[(rowq0 + (tid >> 3)) * NPROJ + PC_WI + (tid & 7)]) * 0.044194173824159216f;
        __syncthreads();
        for (int kt = wv; kt < N / 32; kt += NWAVES) {
            const int key = kt * 32 + r; const bf16* krow = PROJ + ((size_t)b * SEQ + key) * NPROJ + PC_KI + 8 * g;
            bf16x8 bfr[4];
#pragma unroll
            for (int s = 0; s < 4; ++s) bfr[s] = *(const bf16x8*)(krow + 16 * s);
#pragma unroll
            for (int qg = 0; qg < 4; ++qg) { f32x16 acc = {};
#pragma unroll
                for (int s = 0; s < 4; ++s) acc = mfma32(af[qg][s], bfr[s], acc);
#pragma unroll
                for (int qq = 0; qq < 2; ++qq) { float sc = 0.f; const f32x4 w0 = *(const f32x4*)(WQ + (4 * qg + 2 * g + qq) * 8), w1 = *(const f32x4*)(WQ + (4 * qg + 2 * g + qq) * 8 + 4);
#pragma unroll
                    for (int e = 0; e < 4; ++e) { sc = fmaf(w0[e], fmaxf(acc[8 * qq + e], 0.f), sc); sc = fmaf(w1[e], fmaxf(acc[8 * qq + 4 + e], 0.f), sc); }
                    SC[(4 * qg + 2 * g + qq) * 2048 + key] = sc; } }
        }
        __syncthreads();
        for (int q = 0; q < 2; ++q) topk_select(SC + (2 * wv + q) * 2048, N, HIST + wv * 256, SEL + (2 * wv + q) * 256, lane);
    } else {
        for (int q = 0; q < 2; ++q) for (int i = lane; i < (N > 256 ? 256 : N); i += 64) SEL[(2 * wv + q) * 256 + i] = (unsigned short)i;
    }
    __syncthreads();
    const int cnt = N > 256 ? 256 : N;
    for (int q = 0; q < 2; ++q) dsa_attend(p, b, tq0 + 2 * wv + q, SEL + (2 * wv + q) * 256, cnt, lds + wv * 8192, lane);
    __syncthreads();
}

__device__ __forceinline__ void uv_item(const Params& p, int tile, int lane) {
    bf16* PROJ = (bf16*)(p.ws + WS_PROJ); const bf16* OLAT = (const bf16*)(p.ws + WS_REGA); const bf16* WUVT = (const bf16*)(p.ws + WS_WUVT);
    const int r = lane & 31, hh = lane >> 5; const size_t row = (size_t)tile * 32 + r;
    for (int h = 0; h < 8; ++h) { bf16x8 of[8];
#pragma unroll
        for (int s = 0; s < 8; ++s) of[s] = *(const bf16x8*)(OLAT + row * 1024 + h * 128 + 16 * s + 8 * hh);
#pragma unroll
        for (int dt = 0; dt < 2; ++dt) { f32x16 acc = {}; const bf16* wrow = WUVT + (size_t)(h * 64 + dt * 32 + r) * 128 + 8 * hh;
#pragma unroll
            for (int s = 0; s < 8; ++s) { const bf16x8 a = *(const bf16x8*)(wrow + 16 * s); acc = mfma32(a, of[s], acc); }
#pragma unroll
            for (int g4 = 0; g4 < 4; ++g4) { u32x2 o; o.x = pk2(acc[4 * g4], acc[4 * g4 + 1]); o.y = pk2(acc[4 * g4 + 2], acc[4 * g4 + 3]);
                *(u32x2*)(PROJ + row * NPROJ + PC_Q + h * 64 + dt * 32 + 8 * g4 + 4 * hh) = o; } }
    }
}

enum { PH_PRO = 0, PH_HN, PH_GEMM1, PH_PREP, PH_MIX, PH_UV, PH_GOUT, PH_HN2, PH_UP, PH_DOWN, PH_COUNT };
#ifndef MK_SKIP_MIXER
#define MK_SKIP_MIXER 0
#endif
__global__ void __launch_bounds__(NWAVES * 64, 2) mk_fwd(Params p) {
    extern __shared__ __attribute__((aligned(16))) unsigned char lds[];
    cg::grid_group grid = cg::this_grid();
    const int tid = threadIdx.x, lane = tid & 63, wv = __builtin_amdgcn_readfirstlane(tid >> 6);
    const int G = gridDim.x, gw = blockIdx.x * NWAVES + wv, NGW = G * NWAVES;
    const int lo = p.ph_lo, hi = p.ph_hi;
    float* MOD = (float*)(p.ws + WS_MOD); bf16* REGA = (bf16*)(p.ws + WS_REGA); bf16* PROJ = (bf16*)(p.ws + WS_PROJ);
#ifndef MK_PHASE_MASK
#define MK_PHASE_MASK 0x3ff
#endif
#define IN(k) (((MK_PHASE_MASK >> (k)) & 1) && lo <= (k) && (k) < hi)
#define SEAM(k) do { if (IN(k) && IN((k) + 1)) grid.sync(); } while (0)
    if (IN(PH_PRO)) { phase_pro(p, lds, tid, G); }
    SEAM(PH_PRO);
    if (IN(PH_HN)) { hn_rows(p.x, p.g_mix, MOD, 0, 1024, REGA, gw, NGW, lane); }
    SEAM(PH_HN);
    if (IN(PH_GEMM1)) {
        pg8::Gemm g{REGA, (const bf16*)(p.ws + WS_WIN), M, NPROJ, DM, DM}; pg8::StaticOrder S; S.init(M, NPROJ, G, (int)blockIdx.x);
        pg8::EpiBf16<0> E{PROJ, NPROJ};
        pg8::gemm_phase<pg8::EpiBf16<0>, pg8::StaticOrder, true, true>((PG8_LAS unsigned char*)lds, g, S, E);
    }
    SEAM(PH_GEMM1);
    if (IN(PH_PREP)) {
#ifndef DBG_NO_RP
        for (int it = blockIdx.x; it < M / 64; it += G) rwkv_prep_item(p, lds, it, tid);
#endif
#ifndef DBG_NO_DP
        for (int tile = gw; tile < M / 32; tile += NGW) dsa_prep_item(p, tile, lane);
#endif
    }
    SEAM(PH_PREP);
    if (IN(PH_MIX) && MK_DBG != 4 && MK_DBG != 6 && MK_DBG != 7) {
#if !defined(DBG_NO_SCAN) && MK_DBG != 1
        if (wv == 0) for (int chain = blockIdx.x; chain < NB * 8; chain += G) rwkv_scan_chain(p, lds, chain, lane);
        __syncthreads();
#endif
#if !defined(DBG_NO_DSA) && MK_DBG != 2
        for (int k = 0; k * G < M / 16; ++k) { const int idx = (k & 1) ? (G - 1 - (int)blockIdx.x) : (int)blockIdx.x; const int it = k * G + idx; if (it < M / 16) dsa_item(p, lds, it, tid); }
#endif
    }
    SEAM(PH_MIX);
    if (IN(PH_UV) && MK_DBG != 4) {
#if MK_DBG == 7
        for (int m = gw; m < M; m += NGW) { *(u32x4*)(PROJ + (size_t)m * NPROJ + lane * 8) = *(const u32x4*)(REGA + (size_t)m * 1024 + lane * 8); }
#elif MK_DBG != 2
        for (int tile = gw; tile < M / 32; tile += NGW) uv_item(p, tile, lane);
#endif
#if MK_DBG == 1 || MK_DBG == 2
        for (int m = gw; m < M; m += NGW) { u32x4 z = {0u, 0u, 0u, 0u}; *(u32x4*)(PROJ + (size_t)m * NPROJ + (MK_DBG == 1 ? 512 : 0) + lane * 8) = z; }
#endif
    }
    SEAM(PH_UV);
    if (IN(PH_GOUT)) {
        pg8::Gemm g{PROJ, (const bf16*)(p.ws + WS_WOUT), M, DM, DM, NPROJ}; pg8::StaticOrder S; S.init(M, DM, G, (int)blockIdx.x);
        pg8::EpiResGate E{p.x, p.out, DM, MOD + 2048, 6144};
        pg8::gemm_phase<pg8::EpiResGate, pg8::StaticOrder, true, true>((PG8_LAS unsigned char*)lds, g, S, E);
    }
    SEAM(PH_GOUT);
    if (IN(PH_HN2)) { hn_rows(MK_SKIP_MIXER ? p.x : p.out, p.g_ffn, MOD, 3072, 4096, REGA, gw, NGW, lane); }
    SEAM(PH_HN2);
    if (IN(PH_UP)) {
        pg8::Gemm g{REGA, (const bf16*)(p.ws + WS_W1), M, FF, DM, DM}; pg8::StaticOrder S; S.init(M, FF, G, (int)blockIdx.x);
        pg8::EpiBf16<1> E{(bf16*)(p.ws + WS_U), FF};
        pg8::gemm_phase<pg8::EpiBf16<1>, pg8::StaticOrder, true, true>((PG8_LAS unsigned char*)lds, g, S, E);
    }
    SEAM(PH_UP);
    if (IN(PH_DOWN)) {
        pg8::Gemm g{(const bf16*)(p.ws + WS_U), (const bf16*)(p.ws + WS_W2), M, DM, FF, FF}; pg8::StaticOrder S; S.init(M, DM, G, (int)blockIdx.x);
        pg8::EpiResGate E{MK_SKIP_MIXER ? p.x : p.out, p.out, DM, MOD + 5120, 6144};
        pg8::gemm_phase<pg8::EpiResGate, pg8::StaticOrder, true, true>((PG8_LAS unsigned char*)lds, g, S, E);
    }
#undef IN
#undef SEAM
}

#ifndef MK_N_LAUNCHES
#define MK_N_LAUNCHES 0
#endif
extern "C" void kernel_launch(void* const* d_in, const int* in_sizes, int n_in, void* d_out, int out_size, void* d_ws, size_t ws_size, hipStream_t stream) {
    static int grid = 0;
    if (grid == 0) {
        if (n_in != 26 || out_size != M * DM || ws_size < WS_END) { fprintf(stderr, "kernel_launch: unexpected shapes (n_in %d out %d ws %zu)\n", n_in, out_size, ws_size); grid = -1; return; }
        int dev = 0, cus = 0, per_cu = 0;
        hipGetDevice(&dev); hipDeviceGetAttribute(&cus, hipDeviceAttributeMultiprocessorCount, dev);
        if (hipFuncSetAttribute((const void*)mk_fwd, hipFuncAttributeMaxDynamicSharedMemorySize, LDS_BYTES) != hipSuccess) { fprintf(stderr, "kernel_launch: hipFuncSetAttribute failed\n"); grid = -1; return; }
        if (hipOccupancyMaxActiveBlocksPerMultiprocessor(&per_cu, (const void*)mk_fwd, NWAVES * 64, LDS_BYTES) != hipSuccess || per_cu < 1) { fprintf(stderr, "kernel_launch: occupancy query says %d\n", per_cu); per_cu = 1; }
        (void)hipGetLastError();
        grid = cus * 1;
        if (per_cu < 1) grid = -1;
    }
    if (grid < 0) return;
    Params p{};
    const float** pp = (const float**)&p;
    for (int i = 0; i < 26; ++i) pp[i] = (const float*)d_in[i];
    p.out = (float*)d_out; p.ws = (unsigned char*)d_ws;
#if MK_N_LAUNCHES == 1
    p.ph_lo = 0; p.ph_hi = PH_COUNT;
    void* args[] = {&p};
    hipError_t e = hipLaunchCooperativeKernel((const void*)mk_fwd, dim3(grid), dim3(NWAVES * 64), args, LDS_BYTES, stream);
    if (e != hipSuccess) fprintf(stderr, "cooperative launch failed: %s (grid %d)\n", hipGetErrorString(e), grid);
#else
    for (int ph = 0; ph < PH_COUNT; ++ph) {
#if MK_SKIP_MIXER
        if (ph >= PH_HN && ph <= PH_GOUT) continue;
#endif
        p.ph_lo = ph; p.ph_hi = ph + 1;
        hipLaunchKernelGGL(mk_fwd, dim3(grid), dim3(NWAVES * 64), LDS_BYTES, stream, p);
    }
#endif
}
```

```cpp
#include <hip/hip_runtime.h>
#include <hip/hip_cooperative_groups.h>
#include <cstdio>
#include <cstdint>
#include <cmath>
namespace cg = cooperative_groups;
#ifndef MK_DBG
#define MK_DBG 0
#endif
#ifndef MK_DBG_NOTOPK
#define MK_DBG_NOTOPK 0
#endif
namespace pg8 {
#define PG8_LAS __attribute__((address_space(3)))
typedef unsigned short bf16_t;
typedef short bf16x8 __attribute__((ext_vector_type(8)));
typedef float f32x4 __attribute__((ext_vector_type(4)));
typedef unsigned u32x4 __attribute__((ext_vector_type(4)));
constexpr int BM = 256, BK = 64, HALF = 128, HTB = HALF * BK * 2  , STAGE_BYTES = 8 * HTB, NXCD = 8, WGM = 8;

__host__ __device__ __forceinline__ int lds_byte(int r, int c) { const int st = (r >> 4) * 2 + (c >> 5), rr = r & 15, cc = c & 31, ob = rr * 64 + cc * 2; return st * 1024 + (ob ^ (((ob >> 9) & 1) << 5)); }
__host__ __device__ __forceinline__ void stage_rc(int b, int& R, int& C) { const int st = b / 1024, sb = b % 1024, swz = sb ^ (((sb >> 9) & 1) << 5); R = (st >> 1) * 16 + swz / 64; C = (st & 1) * 32 + (swz % 64) / 2; }
__host__ __device__ __forceinline__ int perm32(int rho) { const int n = rho >> 4, i = rho & 15; return 8 * (i >> 2) + 4 * n + (i & 3); }

struct Unit { int pm, pn; };
struct Gemm { const bf16_t* A; const bf16_t* Bt; int M, N, K, lda; };

struct StaticOrder {
    int nM, nN, nwg, G, c;
    __host__ __device__ void init(int M, int N, int G_, int c_) { nM = M / BM; nN = N / BM; nwg = nM * nN; G = G_; c = c_; }
    __host__ __device__ bool next(int i, Unit& u) const {
        const long L = (long)i * G + c; if (L >= nwg) return false;
        int wgid = (int)L; { const int q = nwg / NXCD, r = nwg % NXCD, xcd = wgid % NXCD, off = wgid / NXCD; wgid = (xcd < r ? xcd * (q + 1) : r * (q + 1) + (xcd - r) * q) + off; }
        const int nig = WGM * nN, gid = wgid / nig, fm = gid * WGM, gsz = (nM - fm) < WGM ? (nM - fm) : WGM;
        u.pm = fm + ((wgid % nig) % gsz); u.pn = (wgid % nig) / gsz; return true;
    }
    __device__ __forceinline__ void a_ready(const Unit&) const {}
    __device__ __forceinline__ void done(const Unit&) const {}
};


typedef float f32x2_t __attribute__((ext_vector_type(2))); typedef __bf16 bf16x2_t __attribute__((ext_vector_type(2)));
__device__ __forceinline__ unsigned cvt_pk_bf16(float lo, float hi) { const f32x2_t v = {lo, hi}; const bf16x2_t b = __builtin_convertvector(v, bf16x2_t); return __builtin_bit_cast(unsigned, b); }

template <int ACT  > struct EpiBf16 {
    static constexpr bool PERM = true, AFTER_DRAIN = false;
    bf16_t* O; int ldc;
    __device__ __forceinline__ void operator()(const f32x4 (&acc)[2][2][4][2], const Unit& u, int wr, int wc, int fr, int fq) const {
        const int row0 = u.pm * BM + wr * 64 + fr; const int col0 = u.pn * BM + wc * 32 + 8 * fq;
#pragma unroll
        for (int ai = 0; ai < 2; ++ai)
#pragma unroll
            for (int m = 0; m < 4; ++m) { bf16_t* rowp = O + (size_t)(row0 + ai * HALF + m * 16) * ldc + col0;
#pragma unroll
                for (int bj = 0; bj < 2; ++bj) { f32x4 v0 = acc[ai][bj][m][0], v1 = acc[ai][bj][m][1];
                    if (ACT == 1) {
#pragma unroll
                        for (int j = 0; j < 4; ++j) { const float a = v0[j] > 0.f ? v0[j] : 0.f, b = v1[j] > 0.f ? v1[j] : 0.f; v0[j] = a * a; v1[j] = b * b; } }
                    u32x4 w; w.x = cvt_pk_bf16(v0[0], v0[1]); w.y = cvt_pk_bf16(v0[2], v0[3]); w.z = cvt_pk_bf16(v1[0], v1[1]); w.w = cvt_pk_bf16(v1[2], v1[3]);
                    *(u32x4*)(rowp + bj * HALF) = w; } }
    }
};
struct EpiResGate {
    static constexpr bool PERM = false, AFTER_DRAIN = false;
    const float* base; float* out; int ldc; const float* gate; int gate_ld;
    __device__ __forceinline__ void operator()(const f32x4 (&acc)[2][2][4][2], const Unit& u, int wr, int wc, int fr, int fq) const {
        const int row0 = u.pm * BM + wr * 64 + fr, col0 = u.pn * BM + wc * 32 + 4 * fq;
        const float* gp = gate + (size_t)(u.pm >> 3) * gate_ld + col0;
        f32x4 gv[2][2];
#pragma unroll
        for (int bj = 0; bj < 2; ++bj)
#pragma unroll
            for (int n = 0; n < 2; ++n) gv[bj][n] = *(const f32x4*)(gp + bj * HALF + n * 16);
#pragma unroll
        for (int ai = 0; ai < 2; ++ai)
#pragma unroll
            for (int m = 0; m < 4; ++m) { const size_t off = (size_t)(row0 + ai * HALF + m * 16) * ldc + col0;
#pragma unroll
                for (int bj = 0; bj < 2; ++bj)
#pragma unroll
                    for (int n = 0; n < 2; ++n) { const f32x4 bs = *(const f32x4*)(base + off + bj * HALF + n * 16);
                        *(f32x4*)(out + off + bj * HALF + n * 16) = bs + gv[bj][n] * acc[ai][bj][m][n]; } }
    }
};
template <class Epi, class Sched, bool ALIGN_EPI = false, bool SP2 = false>
__device__ __forceinline__ void gemm_phase(PG8_LAS unsigned char* lds, const Gemm g, const Sched& S, const Epi& E) {
    const int tid = threadIdx.x, wid = __builtin_amdgcn_readfirstlane(tid >> 6), lane = tid & 63, wr = wid >> 2, wc = wid & 3, fr = lane & 15, fq = lane >> 4;
    const int K = g.K, nt = K / BK;
    unsigned voffA[2], voffB[2];
#pragma unroll
    for (int i = 0; i < 2; ++i) { int R, C; stage_rc(tid * 16 + i * 8192, R, C); const int Rb = Epi::PERM ? ((R & ~31) + perm32(R & 31)) : R;
        voffA[i] = (unsigned)(R * g.lda + C) * 2u; voffB[i] = (unsigned)(Rb * K + C) * 2u; }
    const size_t kstep = (size_t)(BK * 2);
    const size_t hstepB = (size_t)HALF * K * 2, hstepA = (size_t)HALF * g.lda * 2;
    const size_t tstepA = 2 * hstepA, tstepB = 2 * hstepB;
    const unsigned ldsw = (unsigned)wid * 1024u;
    const int aoff = lds_byte(wr * 64 + fr, fq * 8), boff = lds_byte(wc * 32 + fr, fq * 8);
#define PG8_SA(b, h) (((b) * 2 + (h)) * HTB)
#define PG8_SB(b, h) ((4 + (b) * 2 + (h)) * HTB)
#define PG8_STAGE(bufoff, gbase, voff) do { _Pragma("unroll") for (int _i = 0; _i < 2; ++_i) \
        __builtin_amdgcn_global_load_lds((const unsigned*)((const char*)(gbase) + (voff)[_i]), (PG8_LAS unsigned*)(lds + (bufoff) + ldsw + _i * 8192), 16, 0, 0); } while (0)
#define PG8_LDA(dst, b, h) do { _Pragma("unroll") for (int m = 0; m < 4; ++m) _Pragma("unroll") for (int k = 0; k < 2; ++k) dst[m][k] = *(const PG8_LAS bf16x8*)(lds + PG8_SA(b, h) + aoff + m * 2048 + k * 1024); } while (0)
#define PG8_LDB(dst, b, h) do { _Pragma("unroll") for (int n = 0; n < 2; ++n) _Pragma("unroll") for (int k = 0; k < 2; ++k) dst[n][k] = *(const PG8_LAS bf16x8*)(lds + PG8_SB(b, h) + boff + n * 2048 + k * 1024); } while (0)
#define PG8_MMA(ai, bj, At, Bt) do { __builtin_amdgcn_s_setprio(1); _Pragma("unroll") for (int m = 0; m < 4; ++m) _Pragma("unroll") for (int n = 0; n < 2; ++n) _Pragma("unroll") for (int k = 0; k < 2; ++k) \
        acc[ai][bj][m][n] = __builtin_amdgcn_mfma_f32_16x16x32_bf16(Bt[n][k], At[m][k], acc[ai][bj][m][n], 0, 0, 0); __builtin_amdgcn_s_setprio(0); } while (0)
#define PG8_WAIT_V(n) asm volatile("s_waitcnt vmcnt(" #n ")" ::: "memory")
#define PG8_WAIT_L(n) asm volatile("s_waitcnt lgkmcnt(" #n ")" ::: "memory")
#define PG8_BAR __builtin_amdgcn_s_barrier()
#define PG8_SCHED __builtin_amdgcn_sched_barrier(0)
    Unit cur, nxt; int ui = 0;
    if (!S.next(0, cur)) return;
    f32x4 acc[2][2][4][2];
#pragma unroll
    for (int a = 0; a < 2; ++a)
#pragma unroll
        for (int b = 0; b < 2; ++b)
#pragma unroll
            for (int m = 0; m < 4; ++m)
#pragma unroll
                for (int n = 0; n < 2; ++n) acc[a][b][m][n] = (f32x4){0.f, 0.f, 0.f, 0.f};
    bf16x8 At[4][2], B0[2][2], B1[2][2];
    const char* cA = (const char*)g.A + (size_t)cur.pm * tstepA; const char* cB = (const char*)g.Bt + (size_t)cur.pn * tstepB;
    S.a_ready(cur);
    if constexpr (SP2) {
        PG8_STAGE(PG8_SB(0, 0), cB, voffB); PG8_STAGE(PG8_SB(0, 1), cB + hstepB, voffB); PG8_STAGE(PG8_SA(0, 0), cA, voffA); PG8_STAGE(PG8_SA(0, 1), cA + hstepA, voffA);
        if (wr == 1) PG8_BAR;
        PG8_WAIT_V(2); PG8_BAR;
        PG8_STAGE(PG8_SB(1, 0), cB + kstep, voffB); PG8_STAGE(PG8_SA(1, 0), cA + kstep, voffA); PG8_STAGE(PG8_SB(1, 1), cB + hstepB + kstep, voffB);
        PG8_WAIT_V(6); PG8_BAR;
    } else {
        PG8_STAGE(PG8_SB(0, 0), cB, voffB); PG8_STAGE(PG8_SA(0, 0), cA, voffA); PG8_STAGE(PG8_SB(0, 1), cB + hstepB, voffB); PG8_STAGE(PG8_SA(0, 1), cA + hstepA, voffA);
        if (wr == 1) PG8_BAR;
        PG8_WAIT_V(4); PG8_BAR;
        PG8_STAGE(PG8_SB(1, 0), cB + kstep, voffB); PG8_STAGE(PG8_SA(1, 0), cA + kstep, voffA); PG8_STAGE(PG8_SB(1, 1), cB + hstepB + kstep, voffB);
        PG8_WAIT_V(6); PG8_BAR;
    }
    for (;;) {
        const bool has_next = S.next(ui + 1, nxt);
        const char* nA = has_next ? (const char*)g.A + (size_t)nxt.pm * tstepA : cA; const char* nB = has_next ? (const char*)g.Bt + (size_t)nxt.pn * tstepB : cB;
        for (int t = 0; t < nt; t += 2) {
            const bool last = (t == nt - 2);
            const char* a1 = cA + (size_t)(t + 1) * kstep;
            const char* a2 = last ? nA : cA + (size_t)(t + 2) * kstep; const char* b2 = last ? nB : cB + (size_t)(t + 2) * kstep;
            const char* a3 = a2 + kstep; const char* b3 = b2 + kstep;
            if (last && has_next) S.a_ready(nxt);
            if constexpr (SP2) {
            PG8_LDB(B0, 0, 0); PG8_LDB(B1, 0, 1); PG8_SCHED; PG8_LDA(At, 0, 0); PG8_STAGE(PG8_SA(1, 1), a1 + hstepA, voffA);
            PG8_WAIT_V(8); PG8_WAIT_L(0); PG8_BAR; PG8_MMA(0, 0, At, B0); PG8_MMA(0, 1, At, B1); PG8_BAR; PG8_SCHED;
            PG8_LDA(At, 0, 1); PG8_STAGE(PG8_SB(0, 0), b2, voffB); PG8_STAGE(PG8_SB(0, 1), b2 + hstepB, voffB); PG8_STAGE(PG8_SA(0, 0), a2, voffA);
            PG8_WAIT_V(8); PG8_WAIT_L(0); PG8_BAR; PG8_MMA(1, 0, At, B0); PG8_MMA(1, 1, At, B1); PG8_BAR; PG8_SCHED;
            PG8_LDB(B0, 1, 0); PG8_LDB(B1, 1, 1); PG8_SCHED; PG8_LDA(At, 1, 0); PG8_STAGE(PG8_SA(0, 1), a2 + hstepA, voffA);
            PG8_WAIT_V(8); PG8_WAIT_L(0); PG8_BAR; PG8_MMA(0, 0, At, B0); PG8_MMA(0, 1, At, B1); PG8_BAR; PG8_SCHED;
            PG8_LDA(At, 1, 1); PG8_STAGE(PG8_SB(1, 0), b3, voffB); PG8_STAGE(PG8_SB(1, 1), b3 + hstepB, voffB); PG8_STAGE(PG8_SA(1, 0), a3, voffA);
            PG8_WAIT_V(8); PG8_WAIT_L(0); PG8_BAR; PG8_MMA(1, 0, At, B0); PG8_MMA(1, 1, At, B1); PG8_BAR; PG8_SCHED;
            } else {
            PG8_LDB(B0, 0, 0); PG8_SCHED; PG8_LDA(At, 0, 0); PG8_STAGE(PG8_SA(1, 1), a1 + hstepA, voffA);
            PG8_WAIT_L(8); PG8_BAR; PG8_WAIT_L(0); PG8_MMA(0, 0, At, B0); PG8_BAR; PG8_SCHED;
            PG8_LDB(B1, 0, 1); PG8_STAGE(PG8_SB(0, 0), b2, voffB);
            PG8_BAR; PG8_WAIT_L(0); PG8_MMA(0, 1, At, B1); PG8_BAR;
            PG8_LDA(At, 0, 1); PG8_STAGE(PG8_SA(0, 0), a2, voffA);
            PG8_BAR; PG8_WAIT_L(0); PG8_MMA(1, 0, At, B0); PG8_BAR; PG8_SCHED;
            PG8_STAGE(PG8_SB(0, 1), b2 + hstepB, voffB);
            PG8_WAIT_V(6); PG8_BAR; PG8_MMA(1, 1, At, B1); PG8_BAR;
            PG8_LDB(B0, 1, 0); PG8_SCHED; PG8_LDA(At, 1, 0); PG8_STAGE(PG8_SA(0, 1), a2 + hstepA, voffA);
            PG8_WAIT_L(8); PG8_BAR; PG8_WAIT_L(0); PG8_MMA(0, 0, At, B0); PG8_BAR; PG8_SCHED;
            PG8_LDB(B1, 1, 1); PG8_STAGE(PG8_SB(1, 0), b3, voffB);
            PG8_BAR; PG8_WAIT_L(0); PG8_MMA(0, 1, At, B1); PG8_BAR;
            PG8_LDA(At, 1, 1); PG8_STAGE(PG8_SA(1, 0), a3, voffA);
            PG8_BAR; PG8_WAIT_L(0); PG8_MMA(1, 0, At, B0); PG8_BAR; PG8_SCHED;
            PG8_STAGE(PG8_SB(1, 1), b3 + hstepB, voffB);
            PG8_WAIT_V(6); PG8_BAR; PG8_MMA(1, 1, At, B1); PG8_BAR;
            }
        }
        if constexpr (ALIGN_EPI) { if (wr == 0) PG8_BAR; }
        if constexpr (!Epi::AFTER_DRAIN) { E(acc, cur, wr, wc, fr, fq); S.done(cur); }
        if (!has_next) break;
#pragma unroll
        for (int a = 0; a < 2; ++a)
#pragma unroll
            for (int b = 0; b < 2; ++b)
#pragma unroll
                for (int m = 0; m < 4; ++m)
#pragma unroll
                    for (int n = 0; n < 2; ++n) acc[a][b][m][n] = (f32x4){0.f, 0.f, 0.f, 0.f};
        cur = nxt; cA = nA; cB = nB; ++ui;
        if constexpr (ALIGN_EPI) { if (wr == 1) PG8_BAR; }
    }
    PG8_WAIT_V(0);
    if constexpr (!ALIGN_EPI) { if (wr == 0) PG8_BAR; }
    PG8_BAR;
    if constexpr (Epi::AFTER_DRAIN) { E.fused(acc, cur, wr, wc, fr, fq, lds, wid, lane); S.done(cur); }
#undef PG8_SA
#undef PG8_SB
#undef PG8_STAGE
#undef PG8_LDA
#undef PG8_LDB
#undef PG8_MMA
#undef PG8_WAIT_V
#undef PG8_WAIT_L
#undef PG8_BAR
#undef PG8_SCHED
}
}

#define LAS __attribute__((address_space(3)))
typedef unsigned short bf16;
typedef short bf16x8 __attribute__((ext_vector_type(8)));
typedef short s16x4 __attribute__((ext_vector_type(4)));
typedef float f32x4 __attribute__((ext_vector_type(4)));
typedef float f32x16 __attribute__((ext_vector_type(16)));
typedef unsigned u32x4 __attribute__((ext_vector_type(4)));
typedef unsigned u32x2 __attribute__((ext_vector_type(2)));

constexpr int NB = 32, SEQ = 2048, DM = 1024, M = NB * SEQ, NPROJ = 3072, FF = 4096;
constexpr int PC_Q = 0, PC_R = 512, PC_K = 1024, PC_V = 1536, PC_QI = 2048, PC_CL = 2560, PC_KI = 2688, PC_XW = 2752, PC_XA = 2816, PC_XG = 2880, PC_WI = 3008;
constexpr size_t MiB = 1u << 20;
constexpr size_t WS_MOD = 0, WS_WUKT = 1 * MiB, WS_WUK = WS_WUKT + 131072, WS_WUVT = WS_WUK + 131072, WS_INVR = 2 * MiB, WS_WIN = 4 * MiB, WS_WOUT = 10 * MiB,
                 WS_W1 = 12 * MiB, WS_W2 = 20 * MiB, WS_SC = 28 * MiB, WS_CKV = 36 * MiB, WS_REGA = 64 * MiB, WS_PROJ = 192 * MiB, WS_SCANIN = 576 * MiB,
                 WS_U = 192 * MiB, WS_END = 960 * MiB;
constexpr int LDS_BYTES = 151552;
constexpr int NWAVES = 8;

struct Params {
    const float *x, *c, *w_ada, *b_ada, *g_mix, *g_ffn, *w_in, *g_q, *g_k, *g_kv, *w_uk, *w_uv, *mu, *w0, *w2, *a0, *a2, *g2, *k_k, *k_a, *r_k, *ln_w, *ln_b, *w_out, *w_ff1, *w_ff2;
    float* out; unsigned char* ws; int ph_lo, ph_hi;
};

__device__ __forceinline__ unsigned pk2(float lo, float hi) { return pg8::cvt_pk_bf16(lo, hi); }
__device__ __forceinline__ float bflo(unsigned w) { return __uint_as_float(w << 16); }
__device__ __forceinline__ float bfhi(unsigned w) { return __uint_as_float(w & 0xffff0000u); }
__device__ __forceinline__ float bf2f(bf16 h) { return __uint_as_float((unsigned)h << 16); }
__device__ __forceinline__ bf16 f2bf(float f) { return (bf16)(pk2(f, 0.f) & 0xffffu); }
__device__ __forceinline__ float wave_sum(float v) {
#pragma unroll
    for (int o = 1; o < 64; o <<= 1) v += __shfl_xor(v, o);
    return v;
}
__device__ __forceinline__ f32x16 mfma32(bf16x8 a, bf16x8 b, f32x16 c) { return __builtin_amdgcn_mfma_f32_32x32x16_bf16(a, b, c, 0, 0, 0); }
__device__ __forceinline__ f32x4 mfma16(bf16x8 a, bf16x8 b, f32x4 c) { return __builtin_amdgcn_mfma_f32_16x16x32_bf16(a, b, c, 0, 0, 0); }

__device__ __forceinline__ int win_src_col(int n) {
    if (n < 512) return n;
    if (n < 1024) return 1224 + (n - 512);
    if (n < 1536) return 1736 + (n - 1024);
    if (n < 2048) return 2248 + (n - 1536);
    if (n < 2560) return 640 + (n - 2048);
    if (n < 2688) return 512 + (n - 2560);
    if (n < 2752) return 1152 + (n - 2688);
    if (n < 2816) return 2760 + (n - 2752);
    if (n < 2880) return 2824 + (n - 2816);
    if (n < 3008) return 2888 + (n - 2880);
    if (n < 3016) return 1216 + (n - 3008);
    return -1;
}
__device__ __forceinline__ void conv_t_item(const float* W, int K, int Nsrc, bf16* WT, int nblk, int item, float* scr, int lane, bool is_win) {
    const int kb = item / nblk, nb = item % nblk, k0 = 64 * kb, n0 = 32 * nb;
    int ns = n0 + (lane & 31); if (is_win) ns = win_src_col(ns);
#pragma unroll 8
    for (int i = 0; i < 32; ++i) { const int kk = 2 * i + (lane >> 5); scr[kk * 33 + (lane & 31)] = ns >= 0 ? W[(size_t)(k0 + kk) * Nsrc + ns] : 0.f; }
    asm volatile("s_waitcnt lgkmcnt(0)" ::: "memory");
    const int c = lane & 7;
#pragma unroll
    for (int j = 0; j < 4; ++j) { const int n = (lane >> 3) + 8 * j; const float* s = scr + (8 * c) * 33 + n;
        u32x4 o; o.x = pk2(s[0 * 33], s[1 * 33]); o.y = pk2(s[2 * 33], s[3 * 33]); o.z = pk2(s[4 * 33], s[5 * 33]); o.w = pk2(s[6 * 33], s[7 * 33]);
        *(u32x4*)(WT + (size_t)(n0 + n) * K + k0 + 8 * c) = o; }
    asm volatile("s_waitcnt lgkmcnt(0)" ::: "memory");
}
__device__ __forceinline__ void adaln_block(const Params& p, float* ldsf, int cb, int tid) {
    const int lane = tid & 63, wv = tid >> 6, e = cb * 64 + lane;
    float* SC = ldsf; float* RED = ldsf + 16384; float* mod = (float*)(p.ws + WS_MOD);
    for (int half = 0; half < 2; ++half) {
        const int b0 = half * 16;
        for (int i = tid; i < 16384; i += 512) { const float cv = p.c[b0 * 1024 + i]; SC[i] = cv / (1.f + __expf(-cv)); }
        __syncthreads();
        float acc[16];
#pragma unroll
        for (int bb = 0; bb < 16; ++bb) acc[bb] = 0.f;
        for (int d = wv * 128; d < wv * 128 + 128; d += 4) {
            const float w0 = p.w_ada[(size_t)d * 6144 + e], w1 = p.w_ada[(size_t)(d + 1) * 6144 + e], w2 = p.w_ada[(size_t)(d + 2) * 6144 + e], w3 = p.w_ada[(size_t)(d + 3) * 6144 + e];
#pragma unroll
            for (int bb = 0; bb < 16; ++bb) { const f32x4 s = *(const f32x4*)(SC + bb * 1024 + d); acc[bb] += (s.x * w0 + s.y * w1) + (s.z * w2 + s.w * w3); }
        }
#pragma unroll
        for (int bb = 0; bb < 16; ++bb) RED[(wv * 16 + bb) * 64 + lane] = acc[bb];
        __syncthreads();
#pragma unroll
        for (int q = 0; q < 2; ++q) { const int bb = wv * 2 + q; float s = p.b_ada[e];
#pragma unroll
            for (int ww = 0; ww < 8; ++ww) s += RED[(ww * 16 + bb) * 64 + lane];
            mod[(size_t)(b0 + bb) * 6144 + e] = s; }
        __syncthreads();
    }
}
__device__ __forceinline__ void phase_pro(const Params& p, unsigned char* lds, int tid, int G) {
    const int lane = tid & 63, wv = tid >> 6;
    for (int cb = blockIdx.x; cb < 96; cb += G) adaln_block(p, (float*)lds, cb, tid);
    __syncthreads();
    float* scr = (float*)lds + wv * (64 * 33 + 16);
    const int gw = blockIdx.x * NWAVES + wv, NGW = G * NWAVES;
    bf16* WIN = (bf16*)(p.ws + WS_WIN); bf16* WOUT = (bf16*)(p.ws + WS_WOUT); bf16* W1 = (bf16*)(p.ws + WS_W1); bf16* W2 = (bf16*)(p.ws + WS_W2);
    bf16* WUKT = (bf16*)(p.ws + WS_WUKT); bf16* WUK = (bf16*)(p.ws + WS_WUK); bf16* WUVT = (bf16*)(p.ws + WS_WUVT);
    constexpr int I_IN = (DM / 64) * (NPROJ / 32), I_OUT = (DM / 64) * (DM / 32), I_1 = (DM / 64) * (FF / 32), I_2 = (FF / 64) * (DM / 32), I_UK = (128 / 64) * (512 / 32);
    constexpr int NITEMS = I_IN + I_OUT + I_1 + I_2 + 2 * I_UK;
    for (int it = gw; it < NITEMS; it += NGW) {
        int r = it;
        if (r < I_IN) { conv_t_item(p.w_in, DM, 3016, WIN, NPROJ / 32, r, scr, lane, true); continue; } r -= I_IN;
        if (r < I_OUT) { conv_t_item(p.w_out, DM, DM, WOUT, DM / 32, r, scr, lane, false); continue; } r -= I_OUT;
        if (r < I_1) { conv_t_item(p.w_ff1, DM, FF, W1, FF / 32, r, scr, lane, false); continue; } r -= I_1;
        if (r < I_2) { conv_t_item(p.w_ff2, FF, DM, W2, DM / 32, r, scr, lane, false); continue; } r -= I_2;
        if (r < I_UK) { conv_t_item(p.w_uk, 128, 512, WUKT, 512 / 32, r, scr, lane, false); continue; } r -= I_UK;
        conv_t_item(p.w_uv, 128, 512, WUVT, 512 / 32, r, scr, lane, false);
    }
    for (int i = blockIdx.x * 512 + tid; i < 128 * 512 / 2; i += G * 512) { const float a = p.w_uk[2 * i], b = p.w_uk[2 * i + 1]; ((unsigned*)WUK)[i] = pk2(a, b); }
}

__device__ __forceinline__ void hn_rows(const float* src, const float* g, const float* mod, int off_sh, int off_sc, bf16* dst, int gw, int NGW, int lane) {
    for (int m = gw; m < M; m += NGW) {
        const f32x4* xr = (const f32x4*)(src + (size_t)m * DM) + lane;
        f32x4 v[4]; float s = 0.f;
#pragma unroll
        for (int j = 0; j < 4; ++j) { v[j] = xr[64 * j]; s += (v[j].x * v[j].x + v[j].y * v[j].y) + (v[j].z * v[j].z + v[j].w * v[j].w); }
        s = wave_sum(s); const float rstd = rsqrtf(s * (1.f / DM) + 1e-6f);
        const float* mb = mod + (size_t)(m >> 11) * 6144;
        unsigned long long* o8 = (unsigned long long*)(dst + (size_t)m * DM) + lane;
#pragma unroll
        for (int j = 0; j < 4; ++j) { const int col = 4 * lane + 256 * j;
            const f32x4 gg = *(const f32x4*)(g + col), sc = *(const f32x4*)(mb + off_sc + col), sh = *(const f32x4*)(mb + off_sh + col);
            const f32x4 y = v[j] * rstd * gg * (1.f + sc) + sh;
            o8[64 * j] = (unsigned long long)pk2(y.x, y.y) | ((unsigned long long)pk2(y.z, y.w) << 32); }
    }
}

__device__ __forceinline__ void rwkv_prep_item(const Params& p, unsigned char* lds, int it, int tid) {
    float* XS = (float*)lds;
    const bf16* PROJ = (const bf16*)(p.ws + WS_PROJ); bf16* SIN = (bf16*)(p.ws + WS_SCANIN); float* SSC = (float*)(p.ws + WS_SC);
    const int row0 = it * 64, t0 = (it & 31) * 64, b = it >> 5;
    const int lane = tid & 63, wv = tid >> 6;
    { const int jj = tid & 255; const float mu = p.mu[1536 + jj];
      for (int t = tid >> 8; t < 64; t += 2) {
          const size_t r = (size_t)(row0 + t) * NPROJ + PC_XW + jj;
          const float cur = bf2f(PROJ[r]); const float prev = (t0 + t == 0) ? 0.f : bf2f(PROJ[r - NPROJ]);
          float v = cur + mu * (prev - cur);
          if (jj < 64) v = tanhf(v); else if (jj >= 128) v = 1.f / (1.f + __expf(-v));
          XS[t * 256 + jj] = v; } }
    __syncthreads();
    const int c = tid;
    const size_t tok0 = (size_t)b * 16384 + (size_t)wv * 2048 + t0;
    const float mu_r = p.mu[c], mu_k = p.mu[512 + c];
    {   float wc[64]; const float* wp = p.a2 + c;
#pragma unroll
        for (int k = 0; k < 64; ++k) { wc[k] = *wp; wp += 512; asm volatile("" : "+v"(wp)); }
        const float a0c = p.a0[c], kkc = p.k_k[c], kac = p.k_a[c], rkc = p.r_k[c];
#pragma unroll 1
        for (int t = 0; t < 64; ++t) {
            const float* xs = XS + t * 256 + 64; float dot = 0.f;
#pragma unroll
            for (int k = 0; k < 64; k += 4) { const f32x4 s = *(const f32x4*)(xs + k); dot += (s.x * wc[k] + s.y * wc[k + 1]) + (s.z * wc[k + 2] + s.w * wc[k + 3]); if ((k & 28) == 28) asm volatile("" ::: "memory"); }
            const float a = 1.f / (1.f + __expf(-(a0c + dot)));
            const size_t rr = (size_t)(row0 + t) * NPROJ; const bool first = (t0 + t == 0);
            const float rc = bf2f(PROJ[rr + PC_R + c]), rp = first ? 0.f : bf2f(PROJ[rr - NPROJ + PC_R + c]); const float r = rc + mu_r * (rp - rc);
            const float kc = bf2f(PROJ[rr + PC_K + c]), kp = first ? 0.f : bf2f(PROJ[rr - NPROJ + PC_K + c]); const float k = kc + mu_k * (kp - kc);
            const float kkv = k * kkc; const float nrm2 = wave_sum(kkv * kkv);
            const float kk = kkv / fmaxf(sqrtf(nrm2), 1e-12f);
            const float kka = kk * a, kpr = k * (1.f + (a - 1.f) * kac);
            const float c1 = wave_sum(kka * r), c2 = wave_sum(kpr * r), c3 = wave_sum(r * kpr * rkc);
            bf16* so = SIN + (tok0 + t) * 384 + lane;
            so[0] = f2bf(kk); so[192] = f2bf(kka); so[256] = f2bf(kpr);
            if (lane == 0) { f32x4 sc4 = {c1, c2, c3, 0.f}; *(f32x4*)(SSC + (tok0 + t) * 4) = sc4; }
        }
    }
    {   float wc[64]; const float* wp = p.w2 + c;
#pragma unroll
        for (int k = 0; k < 64; ++k) { wc[k] = *wp; wp += 512; asm volatile("" : "+v"(wp)); }
        const float w0c = p.w0[c];
#pragma unroll 1
        for (int t = 0; t < 64; ++t) {
            const float* xs = XS + t * 256; float dot = 0.f;
#pragma unroll
            for (int k = 0; k < 64; k += 4) { const f32x4 s = *(const f32x4*)(xs + k); dot += (s.x * wc[k] + s.y * wc[k + 1]) + (s.z * wc[k + 2] + s.w * wc[k + 3]); if ((k & 28) == 28) asm volatile("" ::: "memory"); }
            const float u = w0c + dot;
            const float wlog = -__logf(1.f + __expf(-u)) - 0.5f;
            const float e = __expf(wlog); const float w = __expf(-e); const float d = 1.f - w;
            const size_t rr = (size_t)(row0 + t) * NPROJ; const bool first = (t0 + t == 0);
            const float rc = bf2f(PROJ[rr + PC_R + c]), rp = first ? 0.f : bf2f(PROJ[rr - NPROJ + PC_R + c]); const float r = rc + mu_r * (rp - rc);
            bf16* so = SIN + (tok0 + t) * 384 + lane;
            so[64] = f2bf(w * r); so[128] = f2bf(d);
        }
    }
    {   float wg[128]; const float* wp = p.g2 + c;
#pragma unroll
        for (int k = 0; k < 128; ++k) { wg[k] = *wp; wp += 512; asm volatile("" : "+v"(wp)); }
#pragma unroll 1
        for (int t = 0; t < 64; ++t) {
            const float* xs = XS + t * 256 + 128; float dot = 0.f;
#pragma unroll
            for (int k = 0; k < 128; k += 4) { const f32x4 s = *(const f32x4*)(xs + k); dot += (s.x * wg[k] + s.y * wg[k + 1]) + (s.z * wg[k + 2] + s.w * wg[k + 3]); if ((k & 28) == 28) asm volatile("" ::: "memory"); }
            SIN[(tok0 + t) * 384 + 320 + lane] = f2bf(dot);
        }
    }
    __syncthreads();
}

__device__ __forceinline__ void dsa_prep_item(const Params& p, int tile, int lane) {
    const bf16* PROJ = (const bf16*)(p.ws + WS_PROJ); bf16* CKV = (bf16*)(p.ws + WS_CKV); float* INVR = (float*)(p.ws + WS_INVR); bf16* QABS = (bf16*)(p.ws + WS_REGA);
    const bf16* WUKT = (const bf16*)(p.ws + WS_WUKT); const bf16* WUK = (const bf16*)(p.ws + WS_WUK);
    const int r = lane & 31, hh = lane >> 5; const size_t row = (size_t)tile * 32 + r; const bf16* prow = PROJ + row * NPROJ;
    bf16x8 cf[8];
    {   u32x4 craw[8]; float ssq = 0.f;
#pragma unroll
        for (int s = 0; s < 8; ++s) { craw[s] = *(const u32x4*)(prow + PC_CL + 16 * s + 8 * hh);
#pragma unroll
            for (int w = 0; w < 4; ++w) { const float lo = bflo(craw[s][w]), hi = bfhi(craw[s][w]); ssq += lo * lo + hi * hi; } }
        ssq += __shfl_xor(ssq, 32);
        const float rstd = rsqrtf(ssq * (1.f / 128.f) + 1e-6f);
#pragma unroll
        for (int s = 0; s < 8; ++s) { const float* g = p.g_kv + 16 * s + 8 * hh; const f32x4 g0 = *(const f32x4*)g, g1 = *(const f32x4*)(g + 4);
            u32x4 o; o.x = pk2(bflo(craw[s].x) * rstd * g0.x, bfhi(craw[s].x) * rstd * g0.y); o.y = pk2(bflo(craw[s].y) * rstd * g0.z, bfhi(craw[s].y) * rstd * g0.w);
            o.z = pk2(bflo(craw[s].z) * rstd * g1.x, bfhi(craw[s].z) * rstd * g1.y); o.w = pk2(bflo(craw[s].w) * rstd * g1.z, bfhi(craw[s].w) * rstd * g1.w);
            cf[s] = __builtin_bit_cast(bf16x8, o); *(u32x4*)(CKV + row * 128 + 16 * s + 8 * hh) = o; }
    }
    for (int h = 0; h < 8; ++h) { float ss = 0.f;
#pragma unroll
        for (int dt = 0; dt < 2; ++dt) { f32x16 acc = {}; const bf16* wrow = WUKT + (size_t)(h * 64 + dt * 32 + r) * 128 + 8 * hh;
#pragma unroll
            for (int s = 0; s < 8; ++s) { const bf16x8 a = *(const bf16x8*)(wrow + 16 * s); acc = mfma32(a, cf[s], acc); }
#pragma unroll
            for (int i = 0; i < 16; ++i) ss += acc[i] * acc[i]; }
        ss += __shfl_xor(ss, 32);
        if (hh == 0) INVR[row * 8 + h] = rsqrtf(ss * (1.f / 64.f) + 1e-6f);
    }
    for (int h = 0; h < 8; ++h) {
        u32x4 qraw[4]; float ssq = 0.f;
#pragma unroll
        for (int s = 0; s < 4; ++s) { qraw[s] = *(const u32x4*)(prow + PC_Q + h * 64 + 16 * s + 8 * hh);
#pragma unroll
            for (int w = 0; w < 4; ++w) { const float lo = bflo(qraw[s][w]), hi = bfhi(qraw[s][w]); ssq += lo * lo + hi * hi; } }
        ssq += __shfl_xor(ssq, 32);
        const float rstd = rsqrtf(ssq * (1.f / 64.f) + 1e-6f);
        bf16x8 qf[4];
#pragma unroll
        for (int s = 0; s < 4; ++s) { const int d0 = 16 * s + 8 * hh; float gg[8];
#pragma unroll
            for (int j = 0; j < 8; ++j) gg[j] = p.g_q[d0 + j] * p.g_k[d0 + j] * rstd;
            u32x4 o; o.x = pk2(bflo(qraw[s].x) * gg[0], bfhi(qraw[s].x) * gg[1]); o.y = pk2(bflo(qraw[s].y) * gg[2], bfhi(qraw[s].y) * gg[3]);
            o.z = pk2(bflo(qraw[s].z) * gg[4], bfhi(qraw[s].z) * gg[5]); o.w = pk2(bflo(qraw[s].w) * gg[6], bfhi(qraw[s].w) * gg[7]);
            qf[s] = __builtin_bit_cast(bf16x8, o); }
#pragma unroll
        for (int lt = 0; lt < 4; ++lt) { f32x16 acc = {}; const bf16* wrow = WUK + (size_t)(lt * 32 + r) * 512 + h * 64 + 8 * hh;
#pragma unroll
            for (int s = 0; s < 4; ++s) { const bf16x8 a = *(const bf16x8*)(wrow + 16 * s); acc = mfma32(a, qf[s], acc); }
#pragma unroll
            for (int g4 = 0; g4 < 4; ++g4) { u32x2 o; o.x = pk2(acc[4 * g4] * 0.125f, acc[4 * g4 + 1] * 0.125f); o.y = pk2(acc[4 * g4 + 2] * 0.125f, acc[4 * g4 + 3] * 0.125f);
                *(u32x2*)(QABS + row * 1024 + h * 128 + lt * 32 + 8 * g4 + 4 * hh) = o; } }
    }
}

__device__ __forceinline__ void rwkv_scan_chain(const Params& p, unsigned char* lds, int chain, int lane) {
    float* LV = (float*)lds;
    const int b = chain >> 3, h = chain & 7;
    bf16* PROJ = (bf16*)(p.ws + WS_PROJ); const bf16* SIN = (const bf16*)(p.ws + WS_SCANIN) + ((size_t)b * 16384 + (size_t)h * 2048) * 384;
    const float* SSC = (const float*)(p.ws + WS_SC) + ((size_t)b * 16384 + (size_t)h * 2048) * 4;
    const float mu_v = p.mu[1024 + h * 64 + lane], lnw = p.ln_w[h * 64 + lane], lnb = p.ln_b[h * 64 + lane];
    float S[64];
#pragma unroll
    for (int j = 0; j < 64; ++j) S[j] = 0.f;
    float vprev = 0.f;
    for (int tc = 0; tc < SEQ; tc += 16) {
#pragma unroll
        for (int i = 0; i < 10; ++i) { const int id = i * 64 + lane, tt = id / 40, ch = id % 40;
            const u32x4 raw = *(const u32x4*)(SIN + (size_t)(tc + tt) * 384 + ch * 8);
            float* dst = LV + tt * 320 + ch * 8;
            *(f32x4*)dst = (f32x4){bflo(raw.x), bfhi(raw.x), bflo(raw.y), bfhi(raw.y)}; *(f32x4*)(dst + 4) = (f32x4){bflo(raw.z), bfhi(raw.z), bflo(raw.w), bfhi(raw.w)}; }
        for (int tt = 0; tt < 16; ++tt) {
            const int t = tc + tt; const size_t row = (size_t)b * SEQ + t;
            const float vcur = bf2f(PROJ[row * NPROJ + PC_V + h * 64 + lane]);
            const float vi = vcur + mu_v * (vprev - vcur); vprev = vcur;
            const float gi = bf2f(SIN[(size_t)t * 384 + 320 + lane]);
            const f32x4 sc = *(const f32x4*)(SSC + (size_t)t * 4);
            const float* L = LV + tt * 320;
            float acc_sa = 0.f, acc_o = 0.f;
#pragma unroll
            for (int j = 0; j < 64; j += 4) { const f32x4 kk4 = *(const f32x4*)(L + j), wr4 = *(const f32x4*)(L + 64 + j);
#pragma unroll
                for (int e = 0; e < 4; ++e) { acc_sa = fmaf(S[j + e], kk4[e], acc_sa); acc_o = fmaf(S[j + e], wr4[e], acc_o); }
                if ((j & 12) == 12) asm volatile("" ::: "memory"); }
            const float sa = -acc_sa;
#pragma unroll
            for (int j = 0; j < 64; j += 4) { const f32x4 d4 = *(const f32x4*)(L + 128 + j), ka4 = *(const f32x4*)(L + 192 + j), kp4 = *(const f32x4*)(L + 256 + j);
#pragma unroll
                for (int e = 0; e < 4; ++e) { float s = S[j + e]; s = fmaf(-d4[e], s, s); s = fmaf(sa, ka4[e], s); s = fmaf(vi, kp4[e], s); S[j + e] = s; }
                if ((j & 12) == 12) asm volatile("" ::: "memory"); }
            const float o = acc_o + sa * sc.x + vi * sc.y;
            const float mean = wave_sum(o) * (1.f / 64.f); const float dv = o - mean; const float var = wave_sum(dv * dv) * (1.f / 64.f);
            float y = dv * rsqrtf(var + 64e-5f) * lnw + lnb;
            y = (y + sc.z * vi) * gi;
            PROJ[row * NPROJ + PC_R + h * 64 + lane] = f2bf(y);
        }
    }
}

__device__ __forceinline__ unsigned f2key(float f) { unsigned b = __float_as_uint(f); if ((b << 1) == 0u) b = 0u; return (b & 0x80000000u) ? ~b : (b | 0x80000000u); }
__device__ __forceinline__ unsigned offb(unsigned row, unsigned ch) { return 256u * row + 16u * (ch ^ (((row & 3) << 2) | ((row >> 2) & 3))); }

__device__ __forceinline__ void topk_select(const float* sc, int N, unsigned* hist, unsigned short* sel, int lane) {
    unsigned prefix = 0u, mask = 0u; int rem = 256;
    for (int pass = 0; pass < 4; ++pass) {
        const int shift = 24 - 8 * pass;
#pragma unroll
        for (int i = 0; i < 4; ++i) hist[lane * 4 + i] = 0u;
        asm volatile("s_waitcnt lgkmcnt(0)" ::: "memory");
        for (int i = lane; i < N; i += 64) { const unsigned u = f2key(sc[i]); if ((u & mask) == prefix) atomicAdd(&hist[(u >> shift) & 255u], 1u); }
        asm volatile("s_waitcnt lgkmcnt(0)" ::: "memory");
        const unsigned c0 = hist[lane * 4], c1 = hist[lane * 4 + 1], c2 = hist[lane * 4 + 2], c3 = hist[lane * 4 + 3];
        const int cnt4 = (int)(c0 + c1 + c2 + c3);
        int incl = cnt4;
#pragma unroll
        for (int o = 1; o < 64; o <<= 1) { const int v = __shfl_down(incl, o); if (lane + o < 64) incl += v; }
        const int excl = incl - cnt4;
        const bool mine = (excl < rem) && (rem <= incl);
        const unsigned long long bal = __ballot(mine);
        const int L = (int)__builtin_ctzll(bal);
        const int ex = __shfl(excl, L); const int b3 = (int)__shfl((int)c3, L), b2 = (int)__shfl((int)c2, L), b1 = (int)__shfl((int)c1, L);
        int above = ex, bin;
        if (above + b3 >= rem) bin = 3; else { above += b3; if (above + b2 >= rem) bin = 2; else { above += b2; if (above + b1 >= rem) bin = 1; else { above += b1; bin = 0; } } }
        rem -= above; prefix |= (unsigned)(L * 4 + bin) << shift; mask |= 0xffu << shift;
    }
    const unsigned T = prefix; const int ngt = 256 - rem; int base_gt = 0, base_eq = 0;
    const unsigned long long lt_mask = (1ull << lane) - 1ull;
    for (int i0 = 0; i0 < N; i0 += 64) { const int i = i0 + lane; const unsigned u = f2key(sc[i]);
        const bool gt = u > T, eq = u == T;
        const unsigned long long bg = __ballot(gt), be = __ballot(eq);
        const int rg = __popcll(bg & lt_mask), re = __popcll(be & lt_mask);
        if (gt) sel[base_gt + rg] = (unsigned short)i;
        if (eq && (base_eq + re < rem)) sel[ngt + base_eq + re] = (unsigned short)i;
        base_gt += __popcll(bg); base_eq += __popcll(be); }
    asm volatile("s_waitcnt lgkmcnt(0)" ::: "memory");
}

__device__ __forceinline__ void dsa_attend(const Params& p, int b, int t, const unsigned short* sel, int cnt, unsigned char* stage, int lane) {
    const bf16* CKV = (const bf16*)(p.ws + WS_CKV) + (size_t)b * SEQ * 128; const float* INVR = (const float*)(p.ws + WS_INVR) + (size_t)b * SEQ * 8;
    bf16* QO = (bf16*)(p.ws + WS_REGA) + ((size_t)b * SEQ + t) * 1024;
    const int hd = lane & 15, grp = lane >> 4;
    bf16x8 bq[4];
#pragma unroll
    for (int s = 0; s < 4; ++s) { u32x4 z = {0u, 0u, 0u, 0u}; if (hd < 8) z = *(const u32x4*)(QO + hd * 128 + 32 * s + 8 * grp); bq[s] = __builtin_bit_cast(bf16x8, z); }
    const float slope = (hd < 8) ? exp2f(-(float)(hd + 1)) : 0.f;
    const int hsafe = hd & 7;
    float m_run = -INFINITY, l_part = 0.f;
    f32x4 O[8];
#pragma unroll
    for (int c = 0; c < 8; ++c) O[c] = (f32x4){0.f, 0.f, 0.f, 0.f};
    const LAS unsigned char* st3 = (const LAS unsigned char*)stage;
    const unsigned q4 = (lane & 15) >> 2, p4 = lane & 3;
    for (int ks = 0; ks < cnt; ks += 32) {
#pragma unroll
        for (int i = 0; i < 8; ++i) { const int id = i * 64 + lane, row = id >> 4, ch = id & 15; const int key = sel[ks + row];
            const u32x4 v = *(const u32x4*)(CKV + (size_t)key * 128 + ch * 8); *(u32x4*)(stage + offb(row, ch)) = v; }
        asm volatile("s_waitcnt vmcnt(0) lgkmcnt(0)" ::: "memory");
        float lg[8];
#pragma unroll
        for (int T = 0; T < 2; ++T) { f32x4 acc = {0.f, 0.f, 0.f, 0.f};
#pragma unroll
            for (int s = 0; s < 4; ++s) { const bf16x8 a = *(const bf16x8*)(stage + offb((lane & 15) + 16 * T, 4 * s + grp)); acc = mfma16(a, bq[s], acc); }
#pragma unroll
            for (int rg = 0; rg < 4; ++rg) { const int key = sel[ks + 16 * T + 4 * grp + rg];
                const float ir = INVR[(size_t)key * 8 + hsafe];
                lg[4 * T + rg] = acc[rg] * ir - slope * fabsf((float)(t - key)); } }
        float mx = lg[0];
#pragma unroll
        for (int i = 1; i < 8; ++i) mx = fmaxf(mx, lg[i]);
        mx = fmaxf(mx, __shfl_xor(mx, 16)); mx = fmaxf(mx, __shfl_xor(mx, 32));
        const float m_new = fmaxf(m_run, mx);
        const float alpha = __expf(m_run - m_new);
        float ps = 0.f; float pv[8];
#pragma unroll
        for (int i = 0; i < 8; ++i) { pv[i] = __expf(lg[i] - m_new); ps += pv[i]; }
        l_part = l_part * alpha + ps; m_run = m_new;
        float ar[4];
#pragma unroll
        for (int rg = 0; rg < 4; ++rg) ar[rg] = __shfl(alpha, 4 * grp + rg);
#pragma unroll
        for (int c = 0; c < 8; ++c)
#pragma unroll
            for (int rg = 0; rg < 4; ++rg) O[c][rg] *= ar[rg];
        u32x4 pw; pw.x = pk2(pv[0], pv[1]); pw.y = pk2(pv[2], pv[3]); pw.z = pk2(pv[4], pv[5]); pw.w = pk2(pv[6], pv[7]);
        const bf16x8 pa = __builtin_bit_cast(bf16x8, pw);
#pragma unroll
        for (int c = 0; c < 8; ++c) {
            const s16x4 lo = __builtin_bit_cast(s16x4, __builtin_amdgcn_ds_read_tr16_b64_v4i16((LAS s16x4*)(st3 + offb(4 * grp + q4, 2 * c + (p4 >> 1)) + 8 * (p4 & 1))));
            const s16x4 hi = __builtin_bit_cast(s16x4, __builtin_amdgcn_ds_read_tr16_b64_v4i16((LAS s16x4*)(st3 + offb(16 + 4 * grp + q4, 2 * c + (p4 >> 1)) + 8 * (p4 & 1))));
            const bf16x8 vb = {lo[0], lo[1], lo[2], lo[3], hi[0], hi[1], hi[2], hi[3]};
            O[c] = mfma16(pa, vb, O[c]); }
        asm volatile("s_waitcnt lgkmcnt(0)" ::: "memory");
    }
    float l = l_part; l += __shfl_xor(l, 16); l += __shfl_xor(l, 32);
    const float il = 1.f / l;
    float ir[4];
#pragma unroll
    for (int rg = 0; rg < 4; ++rg) ir[rg] = __shfl(il, 4 * grp + rg);
    if (grp < 2) {
#pragma unroll
        for (int rg = 0; rg < 4; ++rg)
#pragma unroll
            for (int c = 0; c < 8; ++c) QO[(4 * grp + rg) * 128 + 16 * c + hd] = f2bf(O[c][rg] * ir[rg]);
    }
}

__device__ __forceinline__ void dsa_item(const Params& p, unsigned char* lds, int it, int tid) {
    const bf16* PROJ = (const bf16*)(p.ws + WS_PROJ);
    float* SC = (float*)lds;
    unsigned* HIST = (unsigned*)(lds + 131072);
    unsigned short* SEL = (unsigned short*)(lds + 131072 + 8192);
    float* WQ = (float*)(lds + 147456);
    const int lane = tid & 63, wv = tid >> 6;
    const int b = it >> 7, tq0 = (it & 127) * 16, N = ((tq0 >> 6) + 1) * 64; const size_t rowq0 = (size_t)b * SEQ + tq0;
    if (N > 256 && !MK_DBG_NOTOPK) {
        const int r = lane & 31, g = lane >> 5;
        const int ql = 2 * ((r >> 2) & 1) + (r >> 4), hdm = 4 * ((r >> 3) & 1) + (r & 3);
        bf16x8 af[4][4];
#pragma unroll
        for (int qg = 0; qg < 4; ++qg)
#pragma unroll
            for (int s = 0; s < 4; ++s) af[qg][s] = *(const bf16x8*)(PROJ + (rowq0 + 4 * qg + ql) * NPROJ + PC_QI + hdm * 64 + 16 * s + 8 * g);
        if (tid < 128) WQ[tid] = bf2f(PROJ[(rowq0 + (tid >> 3)) * NPROJ + PC_WI + (tid & 7)]) * 0.044194173824159216f;
        __syncthreads();
        for (int kt = wv; kt < N / 32; kt += NWAVES) {
            const int key = kt * 32 + r; const bf16* krow = PROJ + ((size_t)b * SEQ + key) * NPROJ + PC_KI + 8 * g;
            bf16x8 bfr[4];
#pragma unroll
            for (int s = 0; s < 4; ++s) bfr[s] = *(const bf16x8*)(krow + 16 * s);
#pragma unroll
            for (int qg = 0; qg < 4; ++qg) { f32x16 acc = {};
#pragma unroll
                for (int s = 0; s < 4; ++s) acc = mfma32(af[qg][s], bfr[s], acc);
#pragma unroll
                for (int qq = 0; qq < 2; ++qq) { float sc = 0.f; const f32x4 w0 = *(const f32x4*)(WQ + (4 * qg + 2 * g + qq) * 8), w1 = *(const f32x4*)(WQ + (4 * qg + 2 * g + qq) * 8 + 4);
#pragma unroll
                    for (int e = 0; e < 4; ++e) { sc = fmaf(w0[e], fmaxf(acc[8 * qq + e], 0.f), sc); sc = fmaf(w1[e], fmaxf(acc[8 * qq + 4 + e], 0.f), sc); }
                    SC[(4 * qg + 2 * g + qq) * 2048 + key] = sc; } }
        }
        __syncthreads();
        for (int q = 0; q < 2; ++q) topk_select(SC + (2 * wv + q) * 2048, N, HIST + wv * 256, SEL + (2 * wv + q) * 256, lane);
    } else {
        for (int q = 0; q < 2; ++q) for (int i = lane; i < (N > 256 ? 256 : N); i += 64) SEL[(2 * wv + q) * 256 + i] = (unsigned short)i;
    }
    __syncthreads();
    const int cnt = N > 256 ? 256 : N;
    for (int q = 0; q < 2; ++q) dsa_attend(p, b, tq0 + 2 * wv + q, SEL + (2 * wv + q) * 256, cnt, lds + wv * 8192, lane);
    __syncthreads();
}

__device__ __forceinline__ void uv_item(const Params& p, int tile, int lane) {
    bf16* PROJ = (bf16*)(p.ws + WS_PROJ); const bf16* OLAT = (const bf16*)(p.ws + WS_REGA); const bf16* WUVT = (const bf16*)(p.ws + WS_WUVT);
    const int r = lane & 31, hh = lane >> 5; const size_t row = (size_t)tile * 32 + r;
    for (int h = 0; h < 8; ++h) { bf16x8 of[8];
#pragma unroll
        for (int s = 0; s < 8; ++s) of[s] = *(const bf16x8*)(OLAT + row * 1024 + h * 128 + 16 * s + 8 * hh);
#pragma unroll
        for (int dt = 0; dt < 2; ++dt) { f32x16 acc = {}; const bf16* wrow = WUVT + (size_t)(h * 64 + dt * 32 + r) * 128 + 8 * hh;
#pragma unroll
            for (int s = 0; s < 8; ++s) { const bf16x8 a = *(const bf16x8*)(wrow + 16 * s); acc = mfma32(a, of[s], acc); }
#pragma unroll
            for (int g4 = 0; g4 < 4; ++g4) { u32x2 o; o.x = pk2(acc[4 * g4], acc[4 * g4 + 1]); o.y = pk2(acc[4 * g4 + 2], acc[4 * g4 + 3]);
                *(u32x2*)(PROJ + row * NPROJ + PC_Q + h * 64 + dt * 32 + 8 * g4 + 4 * hh) = o; } }
    }
}

enum { PH_PRO = 0, PH_HN, PH_GEMM1, PH_PREP, PH_MIX, PH_UV, PH_GOUT, PH_HN2, PH_UP, PH_DOWN, PH_COUNT };
#ifndef MK_SKIP_MIXER
#define MK_SKIP_MIXER 0
#endif
__global__ void __launch_bounds__(NWAVES * 64, 2) mk_fwd(Params p) {
    extern __shared__ __attribute__((aligned(16))) unsigned char lds[];
    cg::grid_group grid = cg::this_grid();
    const int tid = threadIdx.x, lane = tid & 63, wv = __builtin_amdgcn_readfirstlane(tid >> 6);
    const int G = gridDim.x, gw = blockIdx.x * NWAVES + wv, NGW = G * NWAVES;
    const int lo = p.ph_lo, hi = p.ph_hi;
    float* MOD = (float*)(p.ws + WS_MOD); bf16* REGA = (bf16*)(p.ws + WS_REGA); bf16* PROJ = (bf16*)(p.ws + WS_PROJ);
#ifndef MK_PHASE_MASK
#define MK_PHASE_MASK 0x3ff
#endif
#define IN(k) (((MK_PHASE_MASK >> (k)) & 1) && lo <= (k) && (k) < hi)
#define SEAM(k) do { if (IN(k) && IN((k) + 1)) grid.sync(); } while (0)
    if (IN(PH_PRO)) { phase_pro(p, lds, tid, G); }
    SEAM(PH_PRO);
    if (IN(PH_HN)) { hn_rows(p.x, p.g_mix, MOD, 0, 1024, REGA, gw, NGW, lane); }
    SEAM(PH_HN);
    if (IN(PH_GEMM1)) {
        pg8::Gemm g{REGA, (const bf16*)(p.ws + WS_WIN), M, NPROJ, DM, DM}; pg8::StaticOrder S; S.init(M, NPROJ, G, (int)blockIdx.x);
        pg8::EpiBf16<0> E{PROJ, NPROJ};
        pg8::gemm_phase<pg8::EpiBf16<0>, pg8::StaticOrder, true, true>((PG8_LAS unsigned char*)lds, g, S, E);
    }
    SEAM(PH_GEMM1);
    if (IN(PH_PREP)) {
#ifndef DBG_NO_RP
        for (int it = blockIdx.x; it < M / 64; it += G) rwkv_prep_item(p, lds, it, tid);
#endif
#ifndef DBG_NO_DP
        for (int tile = gw; tile < M / 32; tile += NGW) dsa_prep_item(p, tile, lane);
#endif
    }
    SEAM(PH_PREP);
    if (IN(PH_MIX) && MK_DBG != 4 && MK_DBG != 6 && MK_DBG != 7) {
#if !defined(DBG_NO_SCAN) && MK_DBG != 1
        if (wv == 0) for (int chain = blockIdx.x; chain < NB * 8; chain += G) rwkv_scan_chain(p, lds, chain, lane);
        __syncthreads();
#endif
#if !defined(DBG_NO_DSA) && MK_DBG != 2
        for (int k = 0; k * G < M / 16; ++k) { const int idx = (k & 1) ? (G - 1 - (int)blockIdx.x) : (int)blockIdx.x; const int it = k * G + idx; if (it < M / 16) dsa_item(p, lds, it, tid); }
#endif
    }
    SEAM(PH_MIX);
    if (IN(PH_UV) && MK_DBG != 4) {
#if MK_DBG == 7
        for (int m = gw; m < M; m += NGW) { *(u32x4*)(PROJ + (size_t)m * NPROJ + lane * 8) = *(const u32x4*)(REGA + (size_t)m * 1024 + lane * 8); }
#elif MK_DBG != 2
        for (int tile = gw; tile < M / 32; tile += NGW) uv_item(p, tile, lane);
#endif
#if MK_DBG == 1 || MK_DBG == 2
        for (int m = gw; m < M; m += NGW) { u32x4 z = {0u, 0u, 0u, 0u}; *(u32x4*)(PROJ + (size_t)m * NPROJ + (MK_DBG == 1 ? 512 : 0) + lane * 8) = z; }
#endif
    }
    SEAM(PH_UV);
    if (IN(PH_GOUT)) {
        pg8::Gemm g{PROJ, (const bf16*)(p.ws + WS_WOUT), M, DM, DM, NPROJ}; pg8::StaticOrder S; S.init(M, DM, G, (int)blockIdx.x);
        pg8::EpiResGate E{p.x, p.out, DM, MOD + 2048, 6144};
        pg8::gemm_phase<pg8::EpiResGate, pg8::StaticOrder, true, true>((PG8_LAS unsigned char*)lds, g, S, E);
    }
    SEAM(PH_GOUT);
    if (IN(PH_HN2)) { hn_rows(MK_SKIP_MIXER ? p.x : p.out, p.g_ffn, MOD, 3072, 4096, REGA, gw, NGW, lane); }
    SEAM(PH_HN2);
    if (IN(PH_UP)) {
        pg8::Gemm g{REGA, (const bf16*)(p.ws + WS_W1), M, FF, DM, DM}; pg8::StaticOrder S; S.init(M, FF, G, (int)blockIdx.x);
        pg8::EpiBf16<1> E{(bf16*)(p.ws + WS_U), FF};
        pg8::gemm_phase<pg8::EpiBf16<1>, pg8::StaticOrder, true, true>((PG8_LAS unsigned char*)lds, g, S, E);
    }
    SEAM(PH_UP);
    if (IN(PH_DOWN)) {
        pg8::Gemm g{(const bf16*)(p.ws + WS_U), (const bf16*)(p.ws + WS_W2), M, DM, FF, FF}; pg8::StaticOrder S; S.init(M, DM, G, (int)blockIdx.x);
        pg8::EpiResGate E{MK_SKIP_MIXER ? p.x : p.out, p.out, DM, MOD + 5120, 6144};
        pg8::gemm_phase<pg8::EpiResGate, pg8::StaticOrder, true, true>((PG8_LAS unsigned char*)lds, g, S, E);
    }
#undef IN
#undef SEAM
}

#ifndef MK_N_LAUNCHES
#define MK_N_LAUNCHES 1
#endif
extern "C" void kernel_launch(void* const* d_in, const int* in_sizes, int n_in, void* d_out, int out_size, void* d_ws, size_t ws_size, hipStream_t stream) {
    static int grid = 0;
    if (grid == 0) {
        if (n_in != 26 || out_size != M * DM || ws_size < WS_END) { fprintf(stderr, "kernel_launch: unexpected shapes (n_in %d out %d ws %zu)\n", n_in, out_size, ws_size); grid = -1; return; }
        int dev = 0, cus = 0, per_cu = 0;
        hipGetDevice(&dev); hipDeviceGetAttribute(&cus, hipDeviceAttributeMultiprocessorCount, dev);
        if (hipFuncSetAttribute((const void*)mk_fwd, hipFuncAttributeMaxDynamicSharedMemorySize, LDS_BYTES) != hipSuccess) { fprintf(stderr, "kernel_launch: hipFuncSetAttribute failed\n"); grid = -1; return; }
        if (hipOccupancyMaxActiveBlocksPerMultiprocessor(&per_cu, (const void*)mk_fwd, NWAVES * 64, LDS_BYTES) != hipSuccess || per_cu < 1) { fprintf(stderr, "kernel_launch: occupancy query says %d\n", per_cu); per_cu = 1; }
        (void)hipGetLastError();
        grid = cus * 1;
        if (per_cu < 1) grid = -1;
    }
    if (grid < 0) return;
    Params p{};
    const float** pp = (const float**)&p;
    for (int i = 0; i < 26; ++i) pp[i] = (const float*)d_in[i];
    p.out = (float*)d_out; p.ws = (unsigned char*)d_ws;
#if MK_N_LAUNCHES == 1
    p.ph_lo = 0; p.ph_hi = PH_COUNT;
    void* args[] = {&p};
    hipError_t e = hipLaunchCooperativeKernel((const void*)mk_fwd, dim3(grid), dim3(NWAVES * 64), args, LDS_BYTES, stream);
    if (e != hipSuccess) fprintf(stderr, "cooperative launch failed: %s (grid %d)\n", hipGetErrorString(e), grid);
#else
    for (int ph = 0; ph < PH_COUNT; ++ph) {
#if MK_SKIP_MIXER
        if (ph >= PH_HN && ph <= PH_GOUT) continue;
#endif
        p.ph_lo = ph; p.ph_hi = ph + 1;
        hipLaunchKernelGGL(mk_fwd, dim3(grid), dim3(NWAVES * 64), LDS_BYTES, stream, p);
    }
#endif
}
```

```cpp
#include <hip/hip_runtime.h>
#include <hip/hip_cooperative_groups.h>
#include <cstdio>
#include <cstdint>
#include <cmath>
namespace cg = cooperative_groups;
#ifndef MK_DBG
#define MK_DBG 0
#endif
#ifndef MK_DBG_NOTOPK
#define MK_DBG_NOTOPK 0
#endif
namespace pg8 {
#define PG8_LAS __attribute__((address_space(3)))
typedef unsigned short bf16_t;
typedef short bf16x8 __attribute__((ext_vector_type(8)));
typedef float f32x4 __attribute__((ext_vector_type(4)));
typedef unsigned u32x4 __attribute__((ext_vector_type(4)));
constexpr int BM = 256, BK = 64, HALF = 128, HTB = HALF * BK * 2  , STAGE_BYTES = 8 * HTB, NXCD = 8, WGM = 8;

__host__ __device__ __forceinline__ int lds_byte(int r, int c) { const int st = (r >> 4) * 2 + (c >> 5), rr = r & 15, cc = c & 31, ob = rr * 64 + cc * 2; return st * 1024 + (ob ^ (((ob >> 9) & 1) << 5)); }
__host__ __device__ __forceinline__ void stage_rc(int b, int& R, int& C) { const int st = b / 1024, sb = b % 1024, swz = sb ^ (((sb >> 9) & 1) << 5); R = (st >> 1) * 16 + swz / 64; C = (st & 1) * 32 + (swz % 64) / 2; }
__host__ __device__ __forceinline__ int perm32(int rho) { const int n = rho >> 4, i = rho & 15; return 8 * (i >> 2) + 4 * n + (i & 3); }

struct Unit { int pm, pn; };
struct Gemm { const bf16_t* A; const bf16_t* Bt; int M, N, K, lda; };

struct StaticOrder {
    int nM, nN, nwg, G, c;
    __host__ __device__ void init(int M, int N, int G_, int c_) { nM = M / BM; nN = N / BM; nwg = nM * nN; G = G_; c = c_; }
    __host__ __device__ bool next(int i, Unit& u) const {
        const long L = (long)i * G + c; if (L >= nwg) return false;
        int wgid = (int)L; { const int q = nwg / NXCD, r = nwg % NXCD, xcd = wgid % NXCD, off = wgid / NXCD; wgid = (xcd < r ? xcd * (q + 1) : r * (q + 1) + (xcd - r) * q) + off; }
        const int nig = WGM * nN, gid = wgid / nig, fm = gid * WGM, gsz = (nM - fm) < WGM ? (nM - fm) : WGM;
        u.pm = fm + ((wgid % nig) % gsz); u.pn = (wgid % nig) / gsz; return true;
    }
    __device__ __forceinline__ void a_ready(const Unit&) const {}
    __device__ __forceinline__ void done(const Unit&) const {}
};


typedef float f32x2_t __attribute__((ext_vector_type(2))); typedef __bf16 bf16x2_t __attribute__((ext_vector_type(2)));
__device__ __forceinline__ unsigned cvt_pk_bf16(float lo, float hi) { const f32x2_t v = {lo, hi}; const bf16x2_t b = __builtin_convertvector(v, bf16x2_t); return __builtin_bit_cast(unsigned, b); }

template <int ACT  > struct EpiBf16 {
    static constexpr bool PERM = true, AFTER_DRAIN = false;
    bf16_t* O; int ldc;
    __device__ __forceinline__ void operator()(const f32x4 (&acc)[2][2][4][2], const Unit& u, int wr, int wc, int fr, int fq) const {
        const int row0 = u.pm * BM + wr * 64 + fr; const int col0 = u.pn * BM + wc * 32 + 8 * fq;
#pragma unroll
        for (int ai = 0; ai < 2; ++ai)
#pragma unroll
            for (int m = 0; m < 4; ++m) { bf16_t* rowp = O + (size_t)(row0 + ai * HALF + m * 16) * ldc + col0;
#pragma unroll
                for (int bj = 0; bj < 2; ++bj) { f32x4 v0 = acc[ai][bj][m][0], v1 = acc[ai][bj][m][1];
                    if (ACT == 1) {
#pragma unroll
                        for (int j = 0; j < 4; ++j) { const float a = v0[j] > 0.f ? v0[j] : 0.f, b = v1[j] > 0.f ? v1[j] : 0.f; v0[j] = a * a; v1[j] = b * b; } }
                    u32x4 w; w.x = cvt_pk_bf16(v0[0], v0[1]); w.y = cvt_pk_bf16(v0[2], v0[3]); w.z = cvt_pk_bf16(v1[0], v1[1]); w.w = cvt_pk_bf16(v1[2], v1[3]);
                    *(u32x4*)(rowp + bj * HALF) = w; } }
    }
};
struct EpiResGate {
    static constexpr bool PERM = false, AFTER_DRAIN = false;
    const float* base; float* out; int ldc; const float* gate; int gate_ld;
    __device__ __forceinline__ void operator()(const f32x4 (&acc)[2][2][4][2], const Unit& u, int wr, int wc, int fr, int fq) const {
        const int row0 = u.pm * BM + wr * 64 + fr, col0 = u.pn * BM + wc * 32 + 4 * fq;
        const float* gp = gate + (size_t)(u.pm >> 3) * gate_ld + col0;
        f32x4 gv[2][2];
#pragma unroll
        for (int bj = 0; bj < 2; ++bj)
#pragma unroll
            for (int n = 0; n < 2; ++n) gv[bj][n] = *(const f32x4*)(gp + bj * HALF + n * 16);
#pragma unroll
        for (int ai = 0; ai < 2; ++ai)
#pragma unroll
            for (int m = 0; m < 4; ++m) { const size_t off = (size_t)(row0 + ai * HALF + m * 16) * ldc + col0;
#pragma unroll
                for (int bj = 0; bj < 2; ++bj)
#pragma unroll
                    for (int n = 0; n < 2; ++n) { const f32x4 bs = *(const f32x4*)(base + off + bj * HALF + n * 16);
                        *(f32x4*)(out + off + bj * HALF + n * 16) = bs + gv[bj][n] * acc[ai][bj][m][n]; } }
    }
};
template <class Epi, class Sched, bool ALIGN_EPI = false, bool SP2 = false>
__device__ __forceinline__ void gemm_phase(PG8_LAS unsigned char* lds, const Gemm g, const Sched& S, const Epi& E) {
    const int tid = threadIdx.x, wid = __builtin_amdgcn_readfirstlane(tid >> 6), lane = tid & 63, wr = wid >> 2, wc = wid & 3, fr = lane & 15, fq = lane >> 4;
    const int K = g.K, nt = K / BK;
    unsigned voffA[2], voffB[2];
#pragma unroll
    for (int i = 0; i < 2; ++i) { int R, C; stage_rc(tid * 16 + i * 8192, R, C); const int Rb = Epi::PERM ? ((R & ~31) + perm32(R & 31)) : R;
        voffA[i] = (unsigned)(R * g.lda + C) * 2u; voffB[i] = (unsigned)(Rb * K + C) * 2u; }
    const size_t kstep = (size_t)(BK * 2);
    const size_t hstepB = (size_t)HALF * K * 2, hstepA = (size_t)HALF * g.lda * 2;
    const size_t tstepA = 2 * hstepA, tstepB = 2 * hstepB;
    const unsigned ldsw = (unsigned)wid * 1024u;
    const int aoff = lds_byte(wr * 64 + fr, fq * 8), boff = lds_byte(wc * 32 + fr, fq * 8);
#define PG8_SA(b, h) (((b) * 2 + (h)) * HTB)
#define PG8_SB(b, h) ((4 + (b) * 2 + (h)) * HTB)
#define PG8_STAGE(bufoff, gbase, voff) do { _Pragma("unroll") for (int _i = 0; _i < 2; ++_i) \
        __builtin_amdgcn_global_load_lds((const unsigned*)((const char*)(gbase) + (voff)[_i]), (PG8_LAS unsigned*)(lds + (bufoff) + ldsw + _i * 8192), 16, 0, 0); } while (0)
#define PG8_LDA(dst, b, h) do { _Pragma("unroll") for (int m = 0; m < 4; ++m) _Pragma("unroll") for (int k = 0; k < 2; ++k) dst[m][k] = *(const PG8_LAS bf16x8*)(lds + PG8_SA(b, h) + aoff + m * 2048 + k * 1024); } while (0)
#define PG8_LDB(dst, b, h) do { _Pragma("unroll") for (int n = 0; n < 2; ++n) _Pragma("unroll") for (int k = 0; k < 2; ++k) dst[n][k] = *(const PG8_LAS bf16x8*)(lds + PG8_SB(b, h) + boff + n * 2048 + k * 1024); } while (0)
#define PG8_MMA(ai, bj, At, Bt) do { __builtin_amdgcn_s_setprio(1); _Pragma("unroll") for (int m = 0; m < 4; ++m) _Pragma("unroll") for (int n = 0; n < 2; ++n) _Pragma("unroll") for (int k = 0; k < 2; ++k) \
        acc[ai][bj][m][n] = __builtin_amdgcn_mfma_f32_16x16x32_bf16(Bt[n][k], At[m][k], acc[ai][bj][m][n], 0, 0, 0); __builtin_amdgcn_s_setprio(0); } while (0)
#define PG8_WAIT_V(n) asm volatile("s_waitcnt vmcnt(" #n ")" ::: "memory")
#define PG8_WAIT_L(n) asm volatile("s_waitcnt lgkmcnt(" #n ")" ::: "memory")
#define PG8_BAR __builtin_amdgcn_s_barrier()
#define PG8_SCHED __builtin_amdgcn_sched_barrier(0)
    Unit cur, nxt; int ui = 0;
    if (!S.next(0, cur)) return;
    f32x4 acc[2][2][4][2];
#pragma unroll
    for (int a = 0; a < 2; ++a)
#pragma unroll
        for (int b = 0; b < 2; ++b)
#pragma unroll
            for (int m = 0; m < 4; ++m)
#pragma unroll
                for (int n = 0; n < 2; ++n) acc[a][b][m][n] = (f32x4){0.f, 0.f, 0.f, 0.f};
    bf16x8 At[4][2], B0[2][2], B1[2][2];
    const char* cA = (const char*)g.A + (size_t)cur.pm * tstepA; const char* cB = (const char*)g.Bt + (size_t)cur.pn * tstepB;
    S.a_ready(cur);
    if constexpr (SP2) {
        PG8_STAGE(PG8_SB(0, 0), cB, voffB); PG8_STAGE(PG8_SB(0, 1), cB + hstepB, voffB); PG8_STAGE(PG8_SA(0, 0), cA, voffA); PG8_STAGE(PG8_SA(0, 1), cA + hstepA, voffA);
        if (wr == 1) PG8_BAR;
        PG8_WAIT_V(2); PG8_BAR;
        PG8_STAGE(PG8_SB(1, 0), cB + kstep, voffB); PG8_STAGE(PG8_SA(1, 0), cA + kstep, voffA); PG8_STAGE(PG8_SB(1, 1), cB + hstepB + kstep, voffB);
        PG8_WAIT_V(6); PG8_BAR;
    } else {
        PG8_STAGE(PG8_SB(0, 0), cB, voffB); PG8_STAGE(PG8_SA(0, 0), cA, voffA); PG8_STAGE(PG8_SB(0, 1), cB + hstepB, voffB); PG8_STAGE(PG8_SA(0, 1), cA + hstepA, voffA);
        if (wr == 1) PG8_BAR;
        PG8_WAIT_V(4); PG8_BAR;
        PG8_STAGE(PG8_SB(1, 0), cB + kstep, voffB); PG8_STAGE(PG8_SA(1, 0), cA + kstep, voffA); PG8_STAGE(PG8_SB(1, 1), cB + hstepB + kstep, voffB);
        PG8_WAIT_V(6); PG8_BAR;
    }
    for (;;) {
        const bool has_next = S.next(ui + 1, nxt);
        const char* nA = has_next ? (const char*)g.A + (size_t)nxt.pm * tstepA : cA; const char* nB = has_next ? (const char*)g.Bt + (size_t)nxt.pn * tstepB : cB;
        for (int t = 0; t < nt; t += 2) {
            const bool last = (t == nt - 2);
            const char* a1 = cA + (size_t)(t + 1) * kstep;
            const char* a2 = last ? nA : cA + (size_t)(t + 2) * kstep; const char* b2 = last ? nB : cB + (size_t)(t + 2) * kstep;
            const char* a3 = a2 + kstep; const char* b3 = b2 + kstep;
            if (last && has_next) S.a_ready(nxt);
            if constexpr (SP2) {
            PG8_LDB(B0, 0, 0); PG8_LDB(B1, 0, 1); PG8_SCHED; PG8_LDA(At, 0, 0); PG8_STAGE(PG8_SA(1, 1), a1 + hstepA, voffA);
            PG8_WAIT_V(8); PG8_WAIT_L(0); PG8_BAR; PG8_MMA(0, 0, At, B0); PG8_MMA(0, 1, At, B1); PG8_BAR; PG8_SCHED;
            PG8_LDA(At, 0, 1); PG8_STAGE(PG8_SB(0, 0), b2, voffB); PG8_STAGE(PG8_SB(0, 1), b2 + hstepB, voffB); PG8_STAGE(PG8_SA(0, 0), a2, voffA);
            PG8_WAIT_V(8); PG8_WAIT_L(0); PG8_BAR; PG8_MMA(1, 0, At, B0); PG8_MMA(1, 1, At, B1); PG8_BAR; PG8_SCHED;
            PG8_LDB(B0, 1, 0); PG8_LDB(B1, 1, 1); PG8_SCHED; PG8_LDA(At, 1, 0); PG8_STAGE(PG8_SA(0, 1), a2 + hstepA, voffA);
            PG8_WAIT_V(8); PG8_WAIT_L(0); PG8_BAR; PG8_MMA(0, 0, At, B0); PG8_MMA(0, 1, At, B1); PG8_BAR; PG8_SCHED;
            PG8_LDA(At, 1, 1); PG8_STAGE(PG8_SB(1, 0), b3, voffB); PG8_STAGE(PG8_SB(1, 1), b3 + hstepB, voffB); PG8_STAGE(PG8_SA(1, 0), a3, voffA);
            PG8_WAIT_V(8); PG8_WAIT_L(0); PG8_BAR; PG8_MMA(1, 0, At, B0); PG8_MMA(1, 1, At, B1); PG8_BAR; PG8_SCHED;
            } else {
            PG8_LDB(B0, 0, 0); PG8_SCHED; PG8_LDA(At, 0, 0); PG8_STAGE(PG8_SA(1, 1), a1 + hstepA, voffA);
            PG8_WAIT_L(8); PG8_BAR; PG8_WAIT_L(0); PG8_MMA(0, 0, At, B0); PG8_BAR; PG8_SCHED;
            PG8_LDB(B1, 0, 1); PG8_STAGE(PG8_SB(0, 0), b2, voffB);
            PG8_BAR; PG8_WAIT_L(0); PG8_MMA(0, 1, At, B1); PG8_BAR;
            PG8_LDA(At, 0, 1); PG8_STAGE(PG8_SA(0, 0), a2, voffA);
            PG8_BAR; PG8_WAIT_L(0); PG8_MMA(1, 0, At, B0); PG8_BAR; PG8_SCHED;
            PG8_STAGE(PG8_SB(0, 1), b2 + hstepB, voffB);
            PG8_WAIT_V(6); PG8_BAR; PG8_MMA(1, 1, At, B1); PG8_BAR;
            PG8_LDB(B0, 1, 0); PG8_SCHED; PG8_LDA(At, 1, 0); PG8_STAGE(PG8_SA(0, 1), a2 + hstepA, voffA);
            PG8_WAIT_L(8); PG8_BAR; PG8_WAIT_L(0); PG8_MMA(0, 0, At, B0); PG8_BAR; PG8_SCHED;
            PG8_LDB(B1, 1, 1); PG8_STAGE(PG8_SB(1, 0), b3, voffB);
            PG8_BAR; PG8_WAIT_L(0); PG8_MMA(0, 1, At, B1); PG8_BAR;
            PG8_LDA(At, 1, 1); PG8_STAGE(PG8_SA(1, 0), a3, voffA);
            PG8_BAR; PG8_WAIT_L(0); PG8_MMA(1, 0, At, B0); PG8_BAR; PG8_SCHED;
            PG8_STAGE(PG8_SB(1, 1), b3 + hstepB, voffB);
            PG8_WAIT_V(6); PG8_BAR; PG8_MMA(1, 1, At, B1); PG8_BAR;
            }
        }
        if constexpr (ALIGN_EPI) { if (wr == 0) PG8_BAR; }
        if constexpr (!Epi::AFTER_DRAIN) { E(acc, cur, wr, wc, fr, fq); S.done(cur); }
        if (!has_next) break;
#pragma unroll
        for (int a = 0; a < 2; ++a)
#pragma unroll
            for (int b = 0; b < 2; ++b)
#pragma unroll
                for (int m = 0; m < 4; ++m)
#pragma unroll
                    for (int n = 0; n < 2; ++n) acc[a][b][m][n] = (f32x4){0.f, 0.f, 0.f, 0.f};
        cur = nxt; cA = nA; cB = nB; ++ui;
        if constexpr (ALIGN_EPI) { if (wr == 1) PG8_BAR; }
    }
    PG8_WAIT_V(0);
    if constexpr (!ALIGN_EPI) { if (wr == 0) PG8_BAR; }
    PG8_BAR;
    if constexpr (Epi::AFTER_DRAIN) { E.fused(acc, cur, wr, wc, fr, fq, lds, wid, lane); S.done(cur); }
#undef PG8_SA
#undef PG8_SB
#undef PG8_STAGE
#undef PG8_LDA
#undef PG8_LDB
#undef PG8_MMA
#undef PG8_WAIT_V
#undef PG8_WAIT_L
#undef PG8_BAR
#undef PG8_SCHED
}
}

#define LAS __attribute__((address_space(3)))
typedef unsigned short bf16;
typedef short bf16x8 __attribute__((ext_vector_type(8)));
typedef short s16x4 __attribute__((ext_vector_type(4)));
typedef float f32x4 __attribute__((ext_vector_type(4)));
typedef float f32x16 __attribute__((ext_vector_type(16)));
typedef unsigned u32x4 __attribute__((ext_vector_type(4)));
typedef unsigned u32x2 __attribute__((ext_vector_type(2)));

constexpr int NB = 32, SEQ = 2048, DM = 1024, M = NB * SEQ, NPROJ = 3072, FF = 4096;
constexpr int PC_Q = 0, PC_R = 512, PC_K = 1024, PC_V = 1536, PC_QI = 2048, PC_CL = 2560, PC_KI = 2688, PC_XW = 2752, PC_XA = 2816, PC_XG = 2880, PC_WI = 3008;
constexpr size_t MiB = 1u << 20;
constexpr size_t WS_MOD = 0, WS_WUKT = 1 * MiB, WS_WUK = WS_WUKT + 131072, WS_WUVT = WS_WUK + 131072, WS_INVR = 2 * MiB, WS_WIN = 4 * MiB, WS_WOUT = 10 * MiB,
                 WS_W1 = 12 * MiB, WS_W2 = 20 * MiB, WS_CKV = 36 * MiB, WS_GAM = 52 * MiB, WS_C3 = 60 * MiB, WS_REGA = 64 * MiB, WS_PROJ = 192 * MiB, WS_CH = 576 * MiB,
                 WS_G = 960 * MiB, WS_U = 192 * MiB, WS_END = 1024 * MiB,
                 WS_W2T = WS_WUVT + 131072, WS_A2T = WS_W2T + 65536, WS_G2T = WS_A2T + 65536;
constexpr int LDS_BYTES = 151552;
constexpr int NWAVES = 8;

struct Params {
    const float *x, *c, *w_ada, *b_ada, *g_mix, *g_ffn, *w_in, *g_q, *g_k, *g_kv, *w_uk, *w_uv, *mu, *w0, *w2, *a0, *a2, *g2, *k_k, *k_a, *r_k, *ln_w, *ln_b, *w_out, *w_ff1, *w_ff2;
    float* out; unsigned char* ws; int ph_lo, ph_hi;
};

__device__ __forceinline__ unsigned pk2(float lo, float hi) { return pg8::cvt_pk_bf16(lo, hi); }
__device__ __forceinline__ float bflo(unsigned w) { return __uint_as_float(w << 16); }
__device__ __forceinline__ float bfhi(unsigned w) { return __uint_as_float(w & 0xffff0000u); }
__device__ __forceinline__ float bf2f(bf16 h) { return __uint_as_float((unsigned)h << 16); }
__device__ __forceinline__ bf16 f2bf(float f) { return (bf16)(pk2(f, 0.f) & 0xffffu); }
__device__ __forceinline__ float wave_sum(float v) {
#pragma unroll
    for (int o = 1; o < 64; o <<= 1) v += __shfl_xor(v, o);
    return v;
}
__device__ __forceinline__ f32x16 mfma32(bf16x8 a, bf16x8 b, f32x16 c) { return __builtin_amdgcn_mfma_f32_32x32x16_bf16(a, b, c, 0, 0, 0); }
__device__ __forceinline__ f32x4 mfma16(bf16x8 a, bf16x8 b, f32x4 c) { return __builtin_amdgcn_mfma_f32_16x16x32_bf16(a, b, c, 0, 0, 0); }

__device__ __forceinline__ int win_src_col(int n) {
    if (n < 512) return n;
    if (n < 1024) return 1224 + (n - 512);
    if (n < 1536) return 1736 + (n - 1024);
    if (n < 2048) return 2248 + (n - 1536);
    if (n < 2560) return 640 + (n - 2048);
    if (n < 2688) return 512 + (n - 2560);
    if (n < 2752) return 1152 + (n - 2688);
    if (n < 2816) return 2760 + (n - 2752);
    if (n < 2880) return 2824 + (n - 2816);
    if (n < 3008) return 2888 + (n - 2880);
    if (n < 3016) return 1216 + (n - 3008);
    return -1;
}
__device__ __forceinline__ void conv_t_item(const float* W, int K, int Nsrc, bf16* WT, int nblk, int item, float* scr, int lane, bool is_win) {
    const int kb = item / nblk, nb = item % nblk, k0 = 64 * kb, n0 = 32 * nb;
    int ns = n0 + (lane & 31); if (is_win) ns = win_src_col(ns);
#pragma unroll 8
    for (int i = 0; i < 32; ++i) { const int kk = 2 * i + (lane >> 5); scr[kk * 33 + (lane & 31)] = ns >= 0 ? W[(size_t)(k0 + kk) * Nsrc + ns] : 0.f; }
    asm volatile("s_waitcnt lgkmcnt(0)" ::: "memory");
    const int c = lane & 7;
#pragma unroll
    for (int j = 0; j < 4; ++j) { const int n = (lane >> 3) + 8 * j; const float* s = scr + (8 * c) * 33 + n;
        u32x4 o; o.x = pk2(s[0 * 33], s[1 * 33]); o.y = pk2(s[2 * 33], s[3 * 33]); o.z = pk2(s[4 * 33], s[5 * 33]); o.w = pk2(s[6 * 33], s[7 * 33]);
        *(u32x4*)(WT + (size_t)(n0 + n) * K + k0 + 8 * c) = o; }
    asm volatile("s_waitcnt lgkmcnt(0)" ::: "memory");
}
__device__ __forceinline__ void adaln_block(const Params& p, float* ldsf, int cb, int tid) {
    const int lane = tid & 63, wv = tid >> 6, e = cb * 64 + lane;
    float* SC = ldsf; float* RED = ldsf + 16384; float* mod = (float*)(p.ws + WS_MOD);
    for (int half = 0; half < 2; ++half) {
        const int b0 = half * 16;
        for (int i = tid; i < 16384; i += 512) { const float cv = p.c[b0 * 1024 + i]; SC[i] = cv / (1.f + __expf(-cv)); }
        __syncthreads();
        float acc[16];
#pragma unroll
        for (int bb = 0; bb < 16; ++bb) acc[bb] = 0.f;
        for (int d = wv * 128; d < wv * 128 + 128; d += 4) {
            const float w0 = p.w_ada[(size_t)d * 6144 + e], w1 = p.w_ada[(size_t)(d + 1) * 6144 + e], w2 = p.w_ada[(size_t)(d + 2) * 6144 + e], w3 = p.w_ada[(size_t)(d + 3) * 6144 + e];
#pragma unroll
            for (int bb = 0; bb < 16; ++bb) { const f32x4 s = *(const f32x4*)(SC + bb * 1024 + d); acc[bb] += (s.x * w0 + s.y * w1) + (s.z * w2 + s.w * w3); }
        }
#pragma unroll
        for (int bb = 0; bb < 16; ++bb) RED[(wv * 16 + bb) * 64 + lane] = acc[bb];
        __syncthreads();
#pragma unroll
        for (int q = 0; q < 2; ++q) { const int bb = wv * 2 + q; float s = p.b_ada[e];
#pragma unroll
            for (int ww = 0; ww < 8; ++ww) s += RED[(ww * 16 + bb) * 64 + lane];
            mod[(size_t)(b0 + bb) * 6144 + e] = s; }
        __syncthreads();
    }
}
__device__ __forceinline__ void phase_pro(const Params& p, unsigned char* lds, int tid, int G) {
    const int lane = tid & 63, wv = tid >> 6;
    for (int cb = blockIdx.x; cb < 96; cb += G) adaln_block(p, (float*)lds, cb, tid);
    __syncthreads();
    float* scr = (float*)lds + wv * (64 * 33 + 16);
    const int gw = blockIdx.x * NWAVES + wv, NGW = G * NWAVES;
    bf16* WIN = (bf16*)(p.ws + WS_WIN); bf16* WOUT = (bf16*)(p.ws + WS_WOUT); bf16* W1 = (bf16*)(p.ws + WS_W1); bf16* W2 = (bf16*)(p.ws + WS_W2);
    bf16* WUKT = (bf16*)(p.ws + WS_WUKT); bf16* WUK = (bf16*)(p.ws + WS_WUK); bf16* WUVT = (bf16*)(p.ws + WS_WUVT);
    constexpr int I_IN = (DM / 64) * (NPROJ / 32), I_OUT = (DM / 64) * (DM / 32), I_1 = (DM / 64) * (FF / 32), I_2 = (FF / 64) * (DM / 32), I_UK = (128 / 64) * (512 / 32);
    constexpr int I_LR = 512 / 32;
    constexpr int NITEMS = I_IN + I_OUT + I_1 + I_2 + 2 * I_UK + 4 * I_LR;
    for (int it = gw; it < NITEMS; it += NGW) {
        int r = it;
        if (r < I_IN) { conv_t_item(p.w_in, DM, 3016, WIN, NPROJ / 32, r, scr, lane, true); continue; } r -= I_IN;
        if (r < I_OUT) { conv_t_item(p.w_out, DM, DM, WOUT, DM / 32, r, scr, lane, false); continue; } r -= I_OUT;
        if (r < I_1) { conv_t_item(p.w_ff1, DM, FF, W1, FF / 32, r, scr, lane, false); continue; } r -= I_1;
        if (r < I_2) { conv_t_item(p.w_ff2, FF, DM, W2, DM / 32, r, scr, lane, false); continue; } r -= I_2;
        if (r < I_UK) { conv_t_item(p.w_uk, 128, 512, WUKT, 512 / 32, r, scr, lane, false); continue; } r -= I_UK;
        if (r < I_UK) { conv_t_item(p.w_uv, 128, 512, WUVT, 512 / 32, r, scr, lane, false); continue; } r -= I_UK;
        if (r < I_LR) { conv_t_item(p.w2, 64, 512, (bf16*)(p.ws + WS_W2T), 512 / 32, r, scr, lane, false); continue; } r -= I_LR;
        if (r < I_LR) { conv_t_item(p.a2, 64, 512, (bf16*)(p.ws + WS_A2T), 512 / 32, r, scr, lane, false); continue; } r -= I_LR;
        conv_t_item(p.g2, 128, 512, (bf16*)(p.ws + WS_G2T), 512 / 32, r, scr, lane, false);
    }
    for (int i = blockIdx.x * 512 + tid; i < 128 * 512 / 2; i += G * 512) { const float a = p.w_uk[2 * i], b = p.w_uk[2 * i + 1]; ((unsigned*)WUK)[i] = pk2(a, b); }
}

__device__ __forceinline__ void hn_rows(const float* src, const float* g, const float* mod, int off_sh, int off_sc, bf16* dst, int gw, int NGW, int lane) {
    for (int m = gw; m < M; m += NGW) {
        const f32x4* xr = (const f32x4*)(src + (size_t)m * DM) + lane;
        f32x4 v[4]; float s = 0.f;
#pragma unroll
        for (int j = 0; j < 4; ++j) { v[j] = xr[64 * j]; s += (v[j].x * v[j].x + v[j].y * v[j].y) + (v[j].z * v[j].z + v[j].w * v[j].w); }
        s = wave_sum(s); const float rstd = rsqrtf(s * (1.f / DM) + 1e-6f);
        const float* mb = mod + (size_t)(m >> 11) * 6144;
        unsigned long long* o8 = (unsigned long long*)(dst + (size_t)m * DM) + lane;
#pragma unroll
        for (int j = 0; j < 4; ++j) { const int col = 4 * lane + 256 * j;
            const f32x4 gg = *(const f32x4*)(g + col), sc = *(const f32x4*)(mb + off_sc + col), sh = *(const f32x4*)(mb + off_sh + col);
            const f32x4 y = v[j] * rstd * gg * (1.f + sc) + sh;
            o8[64 * j] = (unsigned long long)pk2(y.x, y.y) | ((unsigned long long)pk2(y.z, y.w) << 32); }
    }
}

typedef short s16x4 __attribute__((ext_vector_type(4)));
__device__ __forceinline__ f32x4 mfma16k(s16x4 a, s16x4 b, f32x4 c) { return __builtin_amdgcn_mfma_f32_16x16x16bf16_1k(a, b, c, 0, 0, 0); }
__device__ __forceinline__ s16x4 pack4(f32x4 v) { u32x2 o; o.x = pk2(v[0], v[1]); o.y = pk2(v[2], v[3]); return __builtin_bit_cast(s16x4, o); }

__device__ __forceinline__ void rwkv_prep_item(const Params& p, unsigned char* lds, int it, int tid) {
    const int lane = tid & 63, wv = tid >> 6, n = lane & 15, grp = lane >> 4;
    bf16* XS = (bf16*)lds;
    bf16* LO = (bf16*)(lds + 8192) + wv * 3072;
    bf16* STG = (bf16*)(lds + 57344) + wv * 4096;
    float* MAB = (float*)(lds + 122880) + wv * 256;
    const bf16* PROJ = (const bf16*)(p.ws + WS_PROJ);
    const bf16* W2T = (const bf16*)(p.ws + WS_W2T); const bf16* A2T = (const bf16*)(p.ws + WS_A2T); const bf16* G2T = (const bf16*)(p.ws + WS_G2T);
    float* GAM = (float*)(p.ws + WS_GAM); float* C3 = (float*)(p.ws + WS_C3); bf16* GB = (bf16*)(p.ws + WS_G);
    const int row0 = it * 64, t0 = (it & 31) * 64, b = it >> 5;
    const int c = tid;
    const float mu_r = p.mu[c], mu_k = p.mu[512 + c], mu_v = p.mu[1024 + c];
    const float w0c = p.w0[c], a0c = p.a0[c], kkc = p.k_k[c], kac = p.k_a[c], rkc = p.r_k[c];
    for (int q = 0; q < 4; ++q) {
        const int rowq = row0 + 16 * q, tq = t0 + 16 * q;
        const size_t idx = (size_t)(b * 8 + wv) * 128 + (tq >> 4);
        unsigned char* CHp = p.ws + WS_CH + idx * 12288;
        { const int jj = tid & 255; const float mu = p.mu[1536 + jj];
          for (int t = tid >> 8; t < 16; t += 2) {
              const size_t r = (size_t)(rowq + t) * NPROJ + PC_XW + jj;
              const float cur = bf2f(PROJ[r]); const float prev = (tq + t == 0) ? 0.f : bf2f(PROJ[r - NPROJ]);
              float v = cur + mu * (prev - cur);
              if (jj < 64) v = tanhf(v); else if (jj >= 128) v = 1.f / (1.f + __expf(-v));
              XS[t * 256 + jj] = f2bf(v); } }
        __syncthreads();
        {   s16x4 xa[16];
#pragma unroll
            for (int ks = 0; ks < 16; ++ks) xa[ks] = *(const s16x4*)(XS + n * 256 + 16 * ks + 4 * grp);
#pragma unroll
            for (int ct = 0; ct < 4; ++ct) { const int cc = wv * 64 + 16 * ct + n;
                f32x4 dw = {0.f, 0.f, 0.f, 0.f}, da = dw, dg = dw;
#pragma unroll
                for (int ks = 0; ks < 4; ++ks) dw = mfma16k(xa[ks], *(const s16x4*)(W2T + cc * 64 + 16 * ks + 4 * grp), dw);
#pragma unroll
                for (int ks = 0; ks < 4; ++ks) da = mfma16k(xa[4 + ks], *(const s16x4*)(A2T + cc * 64 + 16 * ks + 4 * grp), da);
#pragma unroll
                for (int ks = 0; ks < 8; ++ks) dg = mfma16k(xa[8 + ks], *(const s16x4*)(G2T + cc * 128 + 16 * ks + 4 * grp), dg);
#pragma unroll
                for (int rg = 0; rg < 4; ++rg) { const int o = (4 * grp + rg) * 64 + 16 * ct + n; LO[o] = f2bf(dw[rg]); LO[1024 + o] = f2bf(da[rg]); LO[2048 + o] = f2bf(dg[rg]); } }
        }
        asm volatile("s_waitcnt lgkmcnt(0)" ::: "memory");
        {   float gam = 1.f;
            float rp, kp, vp;
            { const bool first = (tq == 0); const size_t rr = (size_t)(rowq - 1) * NPROJ;
              rp = first ? 0.f : bf2f(PROJ[rr + PC_R + c]); kp = first ? 0.f : bf2f(PROJ[rr + PC_K + c]); vp = first ? 0.f : bf2f(PROJ[rr + PC_V + c]); }
            unsigned btp[8], ktp[8], vtp[8]; float be = 0.f, ke = 0.f, ve = 0.f;
#pragma unroll
            for (int t = 0; t < 16; ++t) {
                const size_t rr = (size_t)(rowq + t) * NPROJ;
                const float rc = bf2f(PROJ[rr + PC_R + c]), kc = bf2f(PROJ[rr + PC_K + c]), vc = bf2f(PROJ[rr + PC_V + c]);
                const float r = rc + mu_r * (rp - rc), k = kc + mu_k * (kp - kc), v = vc + mu_v * (vp - vc); rp = rc; kp = kc; vp = vc;
                const float lw = bf2f(LO[t * 64 + lane]), la = bf2f(LO[1024 + t * 64 + lane]), lg = bf2f(LO[2048 + t * 64 + lane]);
                const float u = w0c + lw; const float wlog = -__logf(1.f + __expf(-u)) - 0.5f; const float w = __expf(-__expf(wlog));
                const float a = 1.f / (1.f + __expf(-(a0c + la)));
                const float kkv = k * kkc; const float nrm2 = wave_sum(kkv * kkv); const float kk = kkv / fmaxf(sqrtf(nrm2), 1e-12f);
                const float kpr = k * (1.f + (a - 1.f) * kac);
                const float c3 = wave_sum(r * kpr * rkc);
                const float gprev = gam; gam *= w; const float ig = 1.f / gam;
                STG[t * 64 + lane] = f2bf(-kk * gprev); STG[1024 + t * 64 + lane] = f2bf(r * gam);
                const float bt = kk * a * ig, kt = kpr * ig;
                STG[2048 + t * 64 + lane] = f2bf(bt); STG[3072 + t * 64 + lane] = f2bf(kt);
                if (t & 1) { btp[t >> 1] = pk2(be, bt); ktp[t >> 1] = pk2(ke, kt); vtp[t >> 1] = pk2(ve, v); } else { be = bt; ke = kt; ve = v; }
                GB[(size_t)(rowq + t) * 512 + c] = f2bf(lg);
                if (lane == 0) C3[(size_t)(rowq + t) * 8 + wv] = c3;
            }
            *(u32x4*)(CHp + 4096 + lane * 32) = (u32x4){btp[0], btp[1], btp[2], btp[3]}; *(u32x4*)(CHp + 4096 + lane * 32 + 16) = (u32x4){btp[4], btp[5], btp[6], btp[7]};
            *(u32x4*)(CHp + 6144 + lane * 32) = (u32x4){ktp[0], ktp[1], ktp[2], ktp[3]}; *(u32x4*)(CHp + 6144 + lane * 32 + 16) = (u32x4){ktp[4], ktp[5], ktp[6], ktp[7]};
            *(u32x4*)(CHp + 8192 + lane * 32) = (u32x4){vtp[0], vtp[1], vtp[2], vtp[3]}; *(u32x4*)(CHp + 8192 + lane * 32 + 16) = (u32x4){vtp[4], vtp[5], vtp[6], vtp[7]};
            GAM[idx * 64 + lane] = gam;
        }
        asm volatile("s_waitcnt lgkmcnt(0)" ::: "memory");
        {   f32x4 mab = {0.f, 0.f, 0.f, 0.f}, mak = mab, nrb = mab, nrk = mab;
#pragma unroll
            for (int ks = 0; ks < 4; ++ks) { const int o = n * 64 + 16 * ks + 4 * grp;
                const s16x4 fa = *(const s16x4*)(STG + o), fr = *(const s16x4*)(STG + 1024 + o), fb = *(const s16x4*)(STG + 2048 + o), fk = *(const s16x4*)(STG + 3072 + o);
                mab = mfma16k(fa, fb, mab); mak = mfma16k(fa, fk, mak); nrb = mfma16k(fr, fb, nrb); nrk = mfma16k(fr, fk, nrk); }
#pragma unroll
            for (int rg = 0; rg < 4; ++rg) { const int t = 4 * grp + rg; const bool sl = t > n, il = t >= n;
                MAB[t * 16 + n] = sl ? mab[rg] : 0.f;
                bf16* m2 = (bf16*)(CHp + 10752) + t * 16 + n;
                m2[0] = f2bf(sl ? mak[rg] : 0.f); m2[256] = f2bf(il ? nrb[rg] : 0.f); m2[512] = f2bf(il ? nrk[rg] : 0.f); }
            asm volatile("s_waitcnt lgkmcnt(0)" ::: "memory");
            if (lane < 16) {
                float Tc[16];
#pragma unroll
                for (int t = 0; t < 16; ++t) { float acc = (t == lane) ? 1.f : 0.f;
#pragma unroll
                    for (int s = 0; s < t; ++s) acc = fmaf(MAB[t * 16 + s], Tc[s], acc);
                    Tc[t] = acc; ((bf16*)(CHp + 10240))[t * 16 + lane] = f2bf(acc); }
            }
#pragma unroll
            for (int i = 0; i < 4; ++i) { const int id = i * 64 + lane; *(u32x4*)(CHp + id * 16) = *(const u32x4*)((const unsigned char*)STG + id * 16); }
        }
        __syncthreads();
    }
}

__device__ __forceinline__ void dsa_prep_item(const Params& p, int tile, int lane) {
    const bf16* PROJ = (const bf16*)(p.ws + WS_PROJ); bf16* CKV = (bf16*)(p.ws + WS_CKV); float* INVR = (float*)(p.ws + WS_INVR); bf16* QABS = (bf16*)(p.ws + WS_REGA);
    const bf16* WUKT = (const bf16*)(p.ws + WS_WUKT); const bf16* WUK = (const bf16*)(p.ws + WS_WUK);
    const int r = lane & 31, hh = lane >> 5; const size_t row = (size_t)tile * 32 + r; const bf16* prow = PROJ + row * NPROJ;
    bf16x8 cf[8];
    {   u32x4 craw[8]; float ssq = 0.f;
#pragma unroll
        for (int s = 0; s < 8; ++s) { craw[s] = *(const u32x4*)(prow + PC_CL + 16 * s + 8 * hh);
#pragma unroll
            for (int w = 0; w < 4; ++w) { const float lo = bflo(craw[s][w]), hi = bfhi(craw[s][w]); ssq += lo * lo + hi * hi; } }
        ssq += __shfl_xor(ssq, 32);
        const float rstd = rsqrtf(ssq * (1.f / 128.f) + 1e-6f);
#pragma unroll
        for (int s = 0; s < 8; ++s) { const float* g = p.g_kv + 16 * s + 8 * hh; const f32x4 g0 = *(const f32x4*)g, g1 = *(const f32x4*)(g + 4);
            u32x4 o; o.x = pk2(bflo(craw[s].x) * rstd * g0.x, bfhi(craw[s].x) * rstd * g0.y); o.y = pk2(bflo(craw[s].y) * rstd * g0.z, bfhi(craw[s].y) * rstd * g0.w);
            o.z = pk2(bflo(craw[s].z) * rstd * g1.x, bfhi(craw[s].z) * rstd * g1.y); o.w = pk2(bflo(craw[s].w) * rstd * g1.z, bfhi(craw[s].w) * rstd * g1.w);
            cf[s] = __builtin_bit_cast(bf16x8, o); *(u32x4*)(CKV + row * 128 + 16 * s + 8 * hh) = o; }
    }
    for (int h = 0; h < 8; ++h) { float ss = 0.f;
#pragma unroll
        for (int dt = 0; dt < 2; ++dt) { f32x16 acc = {}; const bf16* wrow = WUKT + (size_t)(h * 64 + dt * 32 + r) * 128 + 8 * hh;
#pragma unroll
            for (int s = 0; s < 8; ++s) { const bf16x8 a = *(const bf16x8*)(wrow + 16 * s); acc = mfma32(a, cf[s], acc); }
#pragma unroll
            for (int i = 0; i < 16; ++i) ss += acc[i] * acc[i]; }
        ss += __shfl_xor(ss, 32);
        if (hh == 0) INVR[row * 8 + h] = rsqrtf(ss * (1.f / 64.f) + 1e-6f);
    }
    for (int h = 0; h < 8; ++h) {
        u32x4 qraw[4]; float ssq = 0.f;
#pragma unroll
        for (int s = 0; s < 4; ++s) { qraw[s] = *(const u32x4*)(prow + PC_Q + h * 64 + 16 * s + 8 * hh);
#pragma unroll
            for (int w = 0; w < 4; ++w) { const float lo = bflo(qraw[s][w]), hi = bfhi(qraw[s][w]); ssq += lo * lo + hi * hi; } }
        ssq += __shfl_xor(ssq, 32);
        const float rstd = rsqrtf(ssq * (1.f / 64.f) + 1e-6f);
        bf16x8 qf[4];
#pragma unroll
        for (int s = 0; s < 4; ++s) { const int d0 = 16 * s + 8 * hh; float gg[8];
#pragma unroll
            for (int j = 0; j < 8; ++j) gg[j] = p.g_q[d0 + j] * p.g_k[d0 + j] * rstd;
            u32x4 o; o.x = pk2(bflo(qraw[s].x) * gg[0], bfhi(qraw[s].x) * gg[1]); o.y = pk2(bflo(qraw[s].y) * gg[2], bfhi(qraw[s].y) * gg[3]);
            o.z = pk2(bflo(qraw[s].z) * gg[4], bfhi(qraw[s].z) * gg[5]); o.w = pk2(bflo(qraw[s].w) * gg[6], bfhi(qraw[s].w) * gg[7]);
            qf[s] = __builtin_bit_cast(bf16x8, o); }
#pragma unroll
        for (int lt = 0; lt < 4; ++lt) { f32x16 acc = {}; const bf16* wrow = WUK + (size_t)(lt * 32 + r) * 512 + h * 64 + 8 * hh;
#pragma unroll
            for (int s = 0; s < 4; ++s) { const bf16x8 a = *(const bf16x8*)(wrow + 16 * s); acc = mfma32(a, qf[s], acc); }
#pragma unroll
            for (int g4 = 0; g4 < 4; ++g4) { u32x2 o; o.x = pk2(acc[4 * g4] * 0.125f, acc[4 * g4 + 1] * 0.125f); o.y = pk2(acc[4 * g4 + 2] * 0.125f, acc[4 * g4 + 3] * 0.125f);
                *(u32x2*)(QABS + row * 1024 + h * 128 + lt * 32 + 8 * g4 + 4 * hh) = o; } }
    }
}

__device__ __forceinline__ void rwkv_scan_chain(const Params& p, int chain, int w, int lane) {
    const int b = chain >> 3, h = chain & 7, n = lane & 15, grp = lane >> 4;
    bf16* PROJ = (bf16*)(p.ws + WS_PROJ); const float* GAM = (const float*)(p.ws + WS_GAM);
    f32x4 S[4];
#pragma unroll
    for (int jt = 0; jt < 4; ++jt) S[jt] = (f32x4){0.f, 0.f, 0.f, 0.f};
    const size_t idx0 = (size_t)(b * 8 + h) * 128;
    for (int sc = 0; sc < 128; ++sc) {
        const unsigned char* CHp = p.ws + WS_CH + (idx0 + sc) * 12288;
        s16x4 at[4], rt[4], bt[4], kt[4]; f32x4 gm[4];
#pragma unroll
        for (int jt = 0; jt < 4; ++jt) {
            at[jt] = *(const s16x4*)(CHp + n * 128 + (16 * jt + 4 * grp) * 2); rt[jt] = *(const s16x4*)(CHp + 2048 + n * 128 + (16 * jt + 4 * grp) * 2);
            bt[jt] = *(const s16x4*)(CHp + 4096 + (16 * jt + n) * 32 + grp * 8); kt[jt] = *(const s16x4*)(CHp + 6144 + (16 * jt + n) * 32 + grp * 8);
            gm[jt] = *(const f32x4*)(GAM + (idx0 + sc) * 64 + 16 * jt + 4 * grp); }
        const s16x4 vt = *(const s16x4*)(CHp + 8192 + (16 * w + n) * 32 + grp * 8);
        const s16x4 Tm = *(const s16x4*)(CHp + 10240 + n * 32 + grp * 8), Mak = *(const s16x4*)(CHp + 10752 + n * 32 + grp * 8);
        const s16x4 Nrb = *(const s16x4*)(CHp + 11264 + n * 32 + grp * 8), Nrk = *(const s16x4*)(CHp + 11776 + n * 32 + grp * 8);
        s16x4 Sb[4];
#pragma unroll
        for (int jt = 0; jt < 4; ++jt) Sb[jt] = pack4(S[jt]);
        f32x4 X = {0.f, 0.f, 0.f, 0.f}, O = X;
#pragma unroll
        for (int jt = 0; jt < 4; ++jt) X = mfma16k(at[jt], Sb[jt], X);
        X = mfma16k(Mak, vt, X);
#pragma unroll
        for (int jt = 0; jt < 4; ++jt) O = mfma16k(rt[jt], Sb[jt], O);
        O = mfma16k(Nrk, vt, O);
        const f32x4 U = mfma16k(Tm, pack4(X), (f32x4){0.f, 0.f, 0.f, 0.f});
        const s16x4 Ub = pack4(U);
        O = mfma16k(Nrb, Ub, O);
#pragma unroll
        for (int jt = 0; jt < 4; ++jt) { S[jt] = mfma16k(kt[jt], vt, S[jt]); S[jt] = mfma16k(bt[jt], Ub, S[jt]); S[jt] = S[jt] * gm[jt]; }
        bf16* orow = PROJ + ((size_t)b * SEQ + sc * 16 + 4 * grp) * NPROJ + PC_R + h * 64 + 16 * w + n;
#pragma unroll
        for (int rg = 0; rg < 4; ++rg) orow[(size_t)rg * NPROJ] = f2bf(O[rg]);
    }
}
__device__ __forceinline__ void rwkv_epi_row(const Params& p, int m, int lane) {
    bf16* PROJ = (bf16*)(p.ws + WS_PROJ); const bf16* GB = (const bf16*)(p.ws + WS_G); const float* C3 = (const float*)(p.ws + WS_C3);
    bf16* prow = PROJ + (size_t)m * NPROJ; const int c0 = lane * 8, h = lane >> 3; const bool first = (m & (SEQ - 1)) == 0;
    const u32x4 oraw = *(const u32x4*)(prow + PC_R + c0), vc = *(const u32x4*)(prow + PC_V + c0), gr = *(const u32x4*)(GB + (size_t)m * 512 + c0);
    u32x4 vpv = {0u, 0u, 0u, 0u}; if (!first) vpv = *(const u32x4*)(prow - NPROJ + PC_V + c0);
    float o[8], v[8], g[8];
#pragma unroll
    for (int i = 0; i < 4; ++i) { o[2 * i] = bflo(oraw[i]); o[2 * i + 1] = bfhi(oraw[i]); g[2 * i] = bflo(gr[i]); g[2 * i + 1] = bfhi(gr[i]);
        const float c0v = bflo(vc[i]), c1v = bfhi(vc[i]), p0 = bflo(vpv[i]), p1 = bfhi(vpv[i]);
        const float m0 = p.mu[1024 + c0 + 2 * i], m1 = p.mu[1024 + c0 + 2 * i + 1];
        v[2 * i] = c0v + m0 * (p0 - c0v); v[2 * i + 1] = c1v + m1 * (p1 - c1v); }
    float s = 0.f;
#pragma unroll
    for (int i = 0; i < 8; ++i) s += o[i];
    s += __shfl_xor(s, 1); s += __shfl_xor(s, 2); s += __shfl_xor(s, 4);
    const float mean = s * (1.f / 64.f); float q = 0.f;
#pragma unroll
    for (int i = 0; i < 8; ++i) { o[i] -= mean; q += o[i] * o[i]; }
    q += __shfl_xor(q, 1); q += __shfl_xor(q, 2); q += __shfl_xor(q, 4);
    const float rstd = rsqrtf(q * (1.f / 64.f) + 64e-5f), c3 = C3[(size_t)m * 8 + h];
    u32x4 out;
#pragma unroll
    for (int i = 0; i < 4; ++i) { float y[2];
#pragma unroll
        for (int e = 0; e < 2; ++e) { const int cc = c0 + 2 * i + e; y[e] = (o[2 * i + e] * rstd * p.ln_w[cc] + p.ln_b[cc] + c3 * v[2 * i + e]) * g[2 * i + e]; }
        out[i] = pk2(y[0], y[1]); }
    *(u32x4*)(prow + PC_R + c0) = out;
}

__device__ __forceinline__ unsigned f2key(float f) { unsigned b = __float_as_uint(f); if ((b << 1) == 0u) b = 0u; return (b & 0x80000000u) ? ~b : (b | 0x80000000u); }
__device__ __forceinline__ unsigned offb(unsigned row, unsigned ch) { return 256u * row + 16u * (ch ^ (((row & 3) << 2) | ((row >> 2) & 3))); }

__device__ __forceinline__ void topk_select(const float* sc, int N, unsigned* hist, unsigned short* sel, int lane) {
    unsigned prefix = 0u, mask = 0u; int rem = 256;
    for (int pass = 0; pass < 4; ++pass) {
        const int shift = 24 - 8 * pass;
#pragma unroll
        for (int i = 0; i < 4; ++i) hist[lane * 4 + i] = 0u;
        asm volatile("s_waitcnt lgkmcnt(0)" ::: "memory");
        for (int i = lane; i < N; i += 64) { const unsigned u = f2key(sc[i]); if ((u & mask) == prefix) atomicAdd(&hist[(u >> shift) & 255u], 1u); }
        asm volatile("s_waitcnt lgkmcnt(0)" ::: "memory");
        const unsigned c0 = hist[lane * 4], c1 = hist[lane * 4 + 1], c2 = hist[lane * 4 + 2], c3 = hist[lane * 4 + 3];
        const int cnt4 = (int)(c0 + c1 + c2 + c3);
        int incl = cnt4;
#pragma unroll
        for (int o = 1; o < 64; o <<= 1) { const int v = __shfl_down(incl, o); if (lane + o < 64) incl += v; }
        const int excl = incl - cnt4;
        const bool mine = (excl < rem) && (rem <= incl);
        const unsigned long long bal = __ballot(mine);
        const int L = (int)__builtin_ctzll(bal);
        const int ex = __shfl(excl, L); const int b3 = (int)__shfl((int)c3, L), b2 = (int)__shfl((int)c2, L), b1 = (int)__shfl((int)c1, L);
        int above = ex, bin;
        if (above + b3 >= rem) bin = 3; else { above += b3; if (above + b2 >= rem) bin = 2; else { above += b2; if (above + b1 >= rem) bin = 1; else { above += b1; bin = 0; } } }
        rem -= above; prefix |= (unsigned)(L * 4 + bin) << shift; mask |= 0xffu << shift;
    }
    const unsigned T = prefix; const int ngt = 256 - rem; int base_gt = 0, base_eq = 0;
    const unsigned long long lt_mask = (1ull << lane) - 1ull;
    for (int i0 = 0; i0 < N; i0 += 64) { const int i = i0 + lane; const unsigned u = f2key(sc[i]);
        const bool gt = u > T, eq = u == T;
        const unsigned long long bg = __ballot(gt), be = __ballot(eq);
        const int rg = __popcll(bg & lt_mask), re = __popcll(be & lt_mask);
        if (gt) sel[base_gt + rg] = (unsigned short)i;
        if (eq && (base_eq + re < rem)) sel[ngt + base_eq + re] = (unsigned short)i;
        base_gt += __popcll(bg); base_eq += __popcll(be); }
    asm volatile("s_waitcnt lgkmcnt(0)" ::: "memory");
}

__device__ __forceinline__ void dsa_attend(const Params& p, int b, int t, const unsigned short* sel, int cnt, unsigned char* stage, int lane) {
    const bf16* CKV = (const bf16*)(p.ws + WS_CKV) + (size_t)b * SEQ * 128; const float* INVR = (const float*)(p.ws + WS_INVR) + (size_t)b * SEQ * 8;
    bf16* QO = (bf16*)(p.ws + WS_REGA) + ((size_t)b * SEQ + t) * 1024;
    const int hd = lane & 15, grp = lane >> 4;
    bf16x8 bq[4];
#pragma unroll
    for (int s = 0; s < 4; ++s) { u32x4 z = {0u, 0u, 0u, 0u}; if (hd < 8) z = *(const u32x4*)(QO + hd * 128 + 32 * s + 8 * grp); bq[s] = __builtin_bit_cast(bf16x8, z); }
    const float slope = (hd < 8) ? exp2f(-(float)(hd + 1)) : 0.f;
    const int hsafe = hd & 7;
    float m_run = -INFINITY, l_part = 0.f;
    f32x4 O[8];
#pragma unroll
    for (int c = 0; c < 8; ++c) O[c] = (f32x4){0.f, 0.f, 0.f, 0.f};
    const LAS unsigned char* st3 = (const LAS unsigned char*)stage;
    const unsigned q4 = (lane & 15) >> 2, p4 = lane & 3;
    for (int ks = 0; ks < cnt; ks += 32) {
#pragma unroll
        for (int i = 0; i < 8; ++i) { const int id = i * 64 + lane, row = id >> 4, ch = id & 15; const int key = sel[ks + row];
            const u32x4 v = *(const u32x4*)(CKV + (size_t)key * 128 + ch * 8); *(u32x4*)(stage + offb(row, ch)) = v; }
        asm volatile("s_waitcnt vmcnt(0) lgkmcnt(0)" ::: "memory");
        float lg[8];
#pragma unroll
        for (int T = 0; T < 2; ++T) { f32x4 acc = {0.f, 0.f, 0.f, 0.f};
#pragma unroll
            for (int s = 0; s < 4; ++s) { const bf16x8 a = *(const bf16x8*)(stage + offb((lane & 15) + 16 * T, 4 * s + grp)); acc = mfma16(a, bq[s], acc); }
#pragma unroll
            for (int rg = 0; rg < 4; ++rg) { const int key = sel[ks + 16 * T + 4 * grp + rg];
                const float ir = INVR[(size_t)key * 8 + hsafe];
                lg[4 * T + rg] = acc[rg] * ir - slope * fabsf((float)(t - key)); } }
        float mx = lg[0];
#pragma unroll
        for (int i = 1; i < 8; ++i) mx = fmaxf(mx, lg[i]);
        mx = fmaxf(mx, __shfl_xor(mx, 16)); mx = fmaxf(mx, __shfl_xor(mx, 32));
        const float m_new = fmaxf(m_run, mx);
        const float alpha = __expf(m_run - m_new);
        float ps = 0.f; float pv[8];
#pragma unroll
        for (int i = 0; i < 8; ++i) { pv[i] = __expf(lg[i] - m_new); ps += pv[i]; }
        l_part = l_part * alpha + ps; m_run = m_new;
        float ar[4];
#pragma unroll
        for (int rg = 0; rg < 4; ++rg) ar[rg] = __shfl(alpha, 4 * grp + rg);
#pragma unroll
        for (int c = 0; c < 8; ++c)
#pragma unroll
            for (int rg = 0; rg < 4; ++rg) O[c][rg] *= ar[rg];
        u32x4 pw; pw.x = pk2(pv[0], pv[1]); pw.y = pk2(pv[2], pv[3]); pw.z = pk2(pv[4], pv[5]); pw.w = pk2(pv[6], pv[7]);
        const bf16x8 pa = __builtin_bit_cast(bf16x8, pw);
#pragma unroll
        for (int c = 0; c < 8; ++c) {
            const s16x4 lo = __builtin_bit_cast(s16x4, __builtin_amdgcn_ds_read_tr16_b64_v4i16((LAS s16x4*)(st3 + offb(4 * grp + q4, 2 * c + (p4 >> 1)) + 8 * (p4 & 1))));
            const s16x4 hi = __builtin_bit_cast(s16x4, __builtin_amdgcn_ds_read_tr16_b64_v4i16((LAS s16x4*)(st3 + offb(16 + 4 * grp + q4, 2 * c + (p4 >> 1)) + 8 * (p4 & 1))));
            const bf16x8 vb = {lo[0], lo[1], lo[2], lo[3], hi[0], hi[1], hi[2], hi[3]};
            O[c] = mfma16(pa, vb, O[c]); }
        asm volatile("s_waitcnt lgkmcnt(0)" ::: "memory");
    }
    float l = l_part; l += __shfl_xor(l, 16); l += __shfl_xor(l, 32);
    const float il = 1.f / l;
    float ir[4];
#pragma unroll
    for (int rg = 0; rg < 4; ++rg) ir[rg] = __shfl(il, 4 * grp + rg);
    if (grp < 2) {
#pragma unroll
        for (int rg = 0; rg < 4; ++rg)
#pragma unroll
            for (int c = 0; c < 8; ++c) QO[(4 * grp + rg) * 128 + 16 * c + hd] = f2bf(O[c][rg] * ir[rg]);
    }
}

__device__ __forceinline__ void dsa_item(const Params& p, unsigned char* lds, int it, int tid) {
    const bf16* PROJ = (const bf16*)(p.ws + WS_PROJ);
    float* SC = (float*)lds;
    unsigned* HIST = (unsigned*)(lds + 131072);
    unsigned short* SEL = (unsigned short*)(lds + 131072 + 8192);
    float* WQ = (float*)(lds + 147456);
    const int lane = tid & 63, wv = tid >> 6;
    const int b = it >> 7, tq0 = (it & 127) * 16, N = ((tq0 >> 6) + 1) * 64; const size_t rowq0 = (size_t)b * SEQ + tq0;
    if (N > 256 && !MK_DBG_NOTOPK) {
        const int r = lane & 31, g = lane >> 5;
        const int ql = 2 * ((r >> 2) & 1) + (r >> 4), hdm = 4 * ((r >> 3) & 1) + (r & 3);
        bf16x8 af[4][4];
#pragma unroll
        for (int qg = 0; qg < 4; ++qg)
#pragma unroll
            for (int s = 0; s < 4; ++s) af[qg][s] = *(const bf16x8*)(PROJ + (rowq0 + 4 * qg + ql) * NPROJ + PC_QI + hdm * 64 + 16 * s + 8 * g);
        if (tid < 128) WQ[tid] = bf2f(PROJ[(rowq0 + (tid >> 3)) * NPROJ + PC_WI + (tid & 7)]) * 0.044194173824159216f;
        __syncthreads();
        for (int kt = wv; kt < N / 32; kt += NWAVES) {
            const int key = kt * 32 + r; const bf16* krow = PROJ + ((size_t)b * SEQ + key) * NPROJ + PC_KI + 8 * g;
            bf16x8 bfr[4];
#pragma unroll
            for (int s = 0; s < 4; ++s) bfr[s] = *(const bf16x8*)(krow + 16 * s);
#pragma unroll
            for (int qg = 0; qg < 4; ++qg) { f32x16 acc = {};
#pragma unroll
                for (int s = 0; s < 4; ++s) acc = mfma32(af[qg][s], bfr[s], acc);
#pragma unroll
                for (int qq = 0; qq < 2; ++qq) { float sc = 0.f; const f32x4 w0 = *(const f32x4*)(WQ + (4 * qg + 2 * g + qq) * 8), w1 = *(const f32x4*)(WQ + (4 * qg + 2 * g + qq) * 8 + 4);
#pragma unroll
                    for (int e = 0; e < 4; ++e) { sc = fmaf(w0[e], fmaxf(acc[8 * qq + e], 0.f), sc); sc = fmaf(w1[e], fmaxf(acc[8 * qq + 4 + e], 0.f), sc); }
                    SC[(4 * qg + 2 * g + qq) * 2048 + key] = sc; } }
        }
        __syncthreads();
        for (int q = 0; q < 2; ++q) topk_select(SC + (2 * wv + q) * 2048, N, HIST + wv * 256, SEL + (2 * wv + q) * 256, lane);
    } else {
        for (int q = 0; q < 2; ++q) for (int i = lane; i < (N > 256 ? 256 : N); i += 64) SEL[(2 * wv + q) * 256 + i] = (unsigned short)i;
    }
    __syncthreads();
    const int cnt = N > 256 ? 256 : N;
    for (int q = 0; q < 2; ++q) dsa_attend(p, b, tq0 + 2 * wv + q, SEL + (2 * wv + q) * 256, cnt, lds + wv * 8192, lane);
    __syncthreads();
}

__device__ __forceinline__ void uv_item(const Params& p, int tile, int lane) {
    bf16* PROJ = (bf16*)(p.ws + WS_PROJ); const bf16* OLAT = (const bf16*)(p.ws + WS_REGA); const bf16* WUVT = (const bf16*)(p.ws + WS_WUVT);
    const int r = lane & 31, hh = lane >> 5; const size_t row = (size_t)tile * 32 + r;
    for (int h = 0; h < 8; ++h) { bf16x8 of[8];
#pragma unroll
        for (int s = 0; s < 8; ++s) of[s] = *(const bf16x8*)(OLAT + row * 1024 + h * 128 + 16 * s + 8 * hh);
#pragma unroll
        for (int dt = 0; dt < 2; ++dt) { f32x16 acc = {}; const bf16* wrow = WUVT + (size_t)(h * 64 + dt * 32 + r) * 128 + 8 * hh;
#pragma unroll
            for (int s = 0; s < 8; ++s) { const bf16x8 a = *(const bf16x8*)(wrow + 16 * s); acc = mfma32(a, of[s], acc); }
#pragma unroll
            for (int g4 = 0; g4 < 4; ++g4) { u32x2 o; o.x = pk2(acc[4 * g4], acc[4 * g4 + 1]); o.y = pk2(acc[4 * g4 + 2], acc[4 * g4 + 3]);
                *(u32x2*)(PROJ + row * NPROJ + PC_Q + h * 64 + dt * 32 + 8 * g4 + 4 * hh) = o; } }
    }
}

enum { PH_PRO = 0, PH_HN, PH_GEMM1, PH_PREP, PH_MIX, PH_UV, PH_GOUT, PH_HN2, PH_UP, PH_DOWN, PH_COUNT };
#ifndef MK_SKIP_MIXER
#define MK_SKIP_MIXER 0
#endif
__global__ void __launch_bounds__(NWAVES * 64, 2) mk_fwd(Params p) {
    extern __shared__ __attribute__((aligned(16))) unsigned char lds[];
    cg::grid_group grid = cg::this_grid();
    const int tid = threadIdx.x, lane = tid & 63, wv = __builtin_amdgcn_readfirstlane(tid >> 6);
    const int G = gridDim.x, gw = blockIdx.x * NWAVES + wv, NGW = G * NWAVES;
    const int lo = p.ph_lo, hi = p.ph_hi;
    float* MOD = (float*)(p.ws + WS_MOD); bf16* REGA = (bf16*)(p.ws + WS_REGA); bf16* PROJ = (bf16*)(p.ws + WS_PROJ);
#ifndef MK_PHASE_MASK
#define MK_PHASE_MASK 0x3ff
#endif
#define IN(k) (((MK_PHASE_MASK >> (k)) & 1) && lo <= (k) && (k) < hi)
#define SEAM(k) do { if (IN(k) && IN((k) + 1)) grid.sync(); } while (0)
    if (IN(PH_PRO)) { phase_pro(p, lds, tid, G); }
    SEAM(PH_PRO);
    if (IN(PH_HN)) { hn_rows(p.x, p.g_mix, MOD, 0, 1024, REGA, gw, NGW, lane); }
    SEAM(PH_HN);
    if (IN(PH_GEMM1)) {
        pg8::Gemm g{REGA, (const bf16*)(p.ws + WS_WIN), M, NPROJ, DM, DM}; pg8::StaticOrder S; S.init(M, NPROJ, G, (int)blockIdx.x);
        pg8::EpiBf16<0> E{PROJ, NPROJ};
        pg8::gemm_phase<pg8::EpiBf16<0>, pg8::StaticOrder, true, true>((PG8_LAS unsigned char*)lds, g, S, E);
    }
    SEAM(PH_GEMM1);
    if (IN(PH_PREP)) {
#ifndef DBG_NO_RP
        for (int it = blockIdx.x; it < M / 64; it += G) rwkv_prep_item(p, lds, it, tid);
#endif
#ifndef DBG_NO_DP
        for (int tile = gw; tile < M / 32; tile += NGW) dsa_prep_item(p, tile, lane);
#endif
    }
    SEAM(PH_PREP);
    if (IN(PH_MIX) && MK_DBG != 4 && MK_DBG != 6 && MK_DBG != 7) {
#if !defined(DBG_NO_SCAN) && MK_DBG != 1
        if (wv < 4) for (int chain = blockIdx.x; chain < NB * 8; chain += G) rwkv_scan_chain(p, chain, wv, lane);
        __syncthreads();
#endif
#if !defined(DBG_NO_DSA) && MK_DBG != 2
        for (int k = 0; k * G < M / 16; ++k) { const int idx = (k & 1) ? (G - 1 - (int)blockIdx.x) : (int)blockIdx.x; const int it = k * G + idx; if (it < M / 16) dsa_item(p, lds, it, tid); }
#endif
    }
    SEAM(PH_MIX);
    if (IN(PH_UV) && MK_DBG != 4) {
#if MK_DBG == 7
        for (int m = gw; m < M; m += NGW) { *(u32x4*)(PROJ + (size_t)m * NPROJ + lane * 8) = *(const u32x4*)(REGA + (size_t)m * 1024 + lane * 8); }
#elif MK_DBG != 2
        for (int tile = gw; tile < M / 32; tile += NGW) uv_item(p, tile, lane);
#endif
#if MK_DBG == 0
        for (int m = gw; m < M; m += NGW) rwkv_epi_row(p, m, lane);
#endif
#if MK_DBG == 1 || MK_DBG == 2
        for (int m = gw; m < M; m += NGW) { u32x4 z = {0u, 0u, 0u, 0u}; *(u32x4*)(PROJ + (size_t)m * NPROJ + (MK_DBG == 1 ? 512 : 0) + lane * 8) = z; }
#endif
    }
    SEAM(PH_UV);
    if (IN(PH_GOUT)) {
        pg8::Gemm g{PROJ, (const bf16*)(p.ws + WS_WOUT), M, DM, DM, NPROJ}; pg8::StaticOrder S; S.init(M, DM, G, (int)blockIdx.x);
        pg8::EpiResGate E{p.x, p.out, DM, MOD + 2048, 6144};
        pg8::gemm_phase<pg8::EpiResGate, pg8::StaticOrder, true, true>((PG8_LAS unsigned char*)lds, g, S, E);
    }
    SEAM(PH_GOUT);
    if (IN(PH_HN2)) { hn_rows(MK_SKIP_MIXER ? p.x : p.out, p.g_ffn, MOD, 3072, 4096, REGA, gw, NGW, lane); }
    SEAM(PH_HN2);
    if (IN(PH_UP)) {
        pg8::Gemm g{REGA, (const bf16*)(p.ws + WS_W1), M, FF, DM, DM}; pg8::StaticOrder S; S.init(M, FF, G, (int)blockIdx.x);
        pg8::EpiBf16<1> E{(bf16*)(p.ws + WS_U), FF};
        pg8::gemm_phase<pg8::EpiBf16<1>, pg8::StaticOrder, true, true>((PG8_LAS unsigned char*)lds, g, S, E);
    }
    SEAM(PH_UP);
    if (IN(PH_DOWN)) {
        pg8::Gemm g{(const bf16*)(p.ws + WS_U), (const bf16*)(p.ws + WS_W2), M, DM, FF, FF}; pg8::StaticOrder S; S.init(M, DM, G, (int)blockIdx.x);
        pg8::EpiResGate E{MK_SKIP_MIXER ? p.x : p.out, p.out, DM, MOD + 5120, 6144};
        pg8::gemm_phase<pg8::EpiResGate, pg8::StaticOrder, true, true>((PG8_LAS unsigned char*)lds, g, S, E);
    }
#undef IN
#undef SEAM
}

#ifndef MK_N_LAUNCHES
#define MK_N_LAUNCHES 1
#endif
extern "C" void kernel_launch(void* const* d_in, const int* in_sizes, int n_in, void* d_out, int out_size, void* d_ws, size_t ws_size, hipStream_t stream) {
    static int grid = 0;
    if (grid == 0) {
        if (n_in != 26 || out_size != M * DM || ws_size < WS_END) { fprintf(stderr, "kernel_launch: unexpected shapes (n_in %d out %d ws %zu)\n", n_in, out_size, ws_size); grid = -1; return; }
        int dev = 0, cus = 0, per_cu = 0;
        hipGetDevice(&dev); hipDeviceGetAttribute(&cus, hipDeviceAttributeMultiprocessorCount, dev);
        if (hipFuncSetAttribute((const void*)mk_fwd, hipFuncAttributeMaxDynamicSharedMemorySize, LDS_BYTES) != hipSuccess) { fprintf(stderr, "kernel_launch: hipFuncSetAttribute failed\n"); grid = -1; return; }
        if (hipOccupancyMaxActiveBlocksPerMultiprocessor(&per_cu, (const void*)mk_fwd, NWAVES * 64, LDS_BYTES) != hipSuccess || per_cu < 1) { fprintf(stderr, "kernel_launch: occupancy query says %d\n", per_cu); per_cu = 1; }
        (void)hipGetLastError();
        grid = cus * 1;
        if (per_cu < 1) grid = -1;
    }
    if (grid < 0) return;
    Params p{};
    const float** pp = (const float**)&p;
    for (int i = 0; i < 26; ++i) pp[i] = (const float*)d_in[i];
    p.out = (float*)d_out; p.ws = (unsigned char*)d_ws;
#if MK_N_LAUNCHES == 1
    p.ph_lo = 0; p.ph_hi = PH_COUNT;
    void* args[] = {&p};
    hipError_t e = hipLaunchCooperativeKernel((const void*)mk_fwd, dim3(grid), dim3(NWAVES * 64), args, LDS_BYTES, stream);
    if (e != hipSuccess) fprintf(stderr, "cooperative launch failed: %s (grid %d)\n", hipGetErrorString(e), grid);
#else
    for (int ph = 0; ph < PH_COUNT; ++ph) {
#if MK_SKIP_MIXER
        if (ph >= PH_HN && ph <= PH_GOUT) continue;
#endif
        p.ph_lo = ph; p.ph_hi = ph + 1;
        hipLaunchKernelGGL(mk_fwd, dim3(grid), dim3(NWAVES * 64), LDS_BYTES, stream, p);
    }
#endif
}
```

```cpp
#include <hip/hip_runtime.h>
#include <hip/hip_cooperative_groups.h>
#include <cstdio>
#include <cstdint>
#include <cmath>
namespace cg = cooperative_groups;
#ifndef MK_DBG
#define MK_DBG 0
#endif
#ifndef MK_DBG_NOTOPK
#define MK_DBG_NOTOPK 0
#endif
namespace pg8 {
#define PG8_LAS __attribute__((address_space(3)))
typedef unsigned short bf16_t;
typedef short bf16x8 __attribute__((ext_vector_type(8)));
typedef float f32x4 __attribute__((ext_vector_type(4)));
typedef unsigned u32x4 __attribute__((ext_vector_type(4)));
constexpr int BM = 256, BK = 64, HALF = 128, HTB = HALF * BK * 2  , STAGE_BYTES = 8 * HTB, NXCD = 8, WGM = 8;

__host__ __device__ __forceinline__ int lds_byte(int r, int c) { const int st = (r >> 4) * 2 + (c >> 5), rr = r & 15, cc = c & 31, ob = rr * 64 + cc * 2; return st * 1024 + (ob ^ (((ob >> 9) & 1) << 5)); }
__host__ __device__ __forceinline__ void stage_rc(int b, int& R, int& C) { const int st = b / 1024, sb = b % 1024, swz = sb ^ (((sb >> 9) & 1) << 5); R = (st >> 1) * 16 + swz / 64; C = (st & 1) * 32 + (swz % 64) / 2; }
__host__ __device__ __forceinline__ int perm32(int rho) { const int n = rho >> 4, i = rho & 15; return 8 * (i >> 2) + 4 * n + (i & 3); }

struct Unit { int pm, pn; };
struct Gemm { const bf16_t* A; const bf16_t* Bt; int M, N, K, lda; };

struct StaticOrder {
    int nM, nN, nwg, G, c;
    __host__ __device__ void init(int M, int N, int G_, int c_) { nM = M / BM; nN = N / BM; nwg = nM * nN; G = G_; c = c_; }
    __host__ __device__ bool next(int i, Unit& u) const {
        const long L = (long)i * G + c; if (L >= nwg) return false;
        int wgid = (int)L; { const int q = nwg / NXCD, r = nwg % NXCD, xcd = wgid % NXCD, off = wgid / NXCD; wgid = (xcd < r ? xcd * (q + 1) : r * (q + 1) + (xcd - r) * q) + off; }
        const int nig = WGM * nN, gid = wgid / nig, fm = gid * WGM, gsz = (nM - fm) < WGM ? (nM - fm) : WGM;
        u.pm = fm + ((wgid % nig) % gsz); u.pn = (wgid % nig) / gsz; return true;
    }
    __device__ __forceinline__ void a_ready(const Unit&) const {}
    __device__ __forceinline__ void done(const Unit&) const {}
};


typedef float f32x2_t __attribute__((ext_vector_type(2))); typedef __bf16 bf16x2_t __attribute__((ext_vector_type(2)));
__device__ __forceinline__ unsigned cvt_pk_bf16(float lo, float hi) { const f32x2_t v = {lo, hi}; const bf16x2_t b = __builtin_convertvector(v, bf16x2_t); return __builtin_bit_cast(unsigned, b); }

template <int ACT  > struct EpiBf16 {
    static constexpr bool PERM = true, AFTER_DRAIN = false;
    bf16_t* O; int ldc;
    __device__ __forceinline__ void operator()(const f32x4 (&acc)[2][2][4][2], const Unit& u, int wr, int wc, int fr, int fq) const {
        const int row0 = u.pm * BM + wr * 64 + fr; const int col0 = u.pn * BM + wc * 32 + 8 * fq;
#pragma unroll
        for (int ai = 0; ai < 2; ++ai)
#pragma unroll
            for (int m = 0; m < 4; ++m) { bf16_t* rowp = O + (size_t)(row0 + ai * HALF + m * 16) * ldc + col0;
#pragma unroll
                for (int bj = 0; bj < 2; ++bj) { f32x4 v0 = acc[ai][bj][m][0], v1 = acc[ai][bj][m][1];
                    if (ACT == 1) {
#pragma unroll
                        for (int j = 0; j < 4; ++j) { const float a = v0[j] > 0.f ? v0[j] : 0.f, b = v1[j] > 0.f ? v1[j] : 0.f; v0[j] = a * a; v1[j] = b * b; } }
                    u32x4 w; w.x = cvt_pk_bf16(v0[0], v0[1]); w.y = cvt_pk_bf16(v0[2], v0[3]); w.z = cvt_pk_bf16(v1[0], v1[1]); w.w = cvt_pk_bf16(v1[2], v1[3]);
                    *(u32x4*)(rowp + bj * HALF) = w; } }
    }
};
struct EpiResGate {
    static constexpr bool PERM = false, AFTER_DRAIN = false;
    const float* base; float* out; int ldc; const float* gate; int gate_ld;
    __device__ __forceinline__ void operator()(const f32x4 (&acc)[2][2][4][2], const Unit& u, int wr, int wc, int fr, int fq) const {
        const int row0 = u.pm * BM + wr * 64 + fr, col0 = u.pn * BM + wc * 32 + 4 * fq;
        const float* gp = gate + (size_t)(u.pm >> 3) * gate_ld + col0;
        f32x4 gv[2][2];
#pragma unroll
        for (int bj = 0; bj < 2; ++bj)
#pragma unroll
            for (int n = 0; n < 2; ++n) gv[bj][n] = *(const f32x4*)(gp + bj * HALF + n * 16);
#pragma unroll
        for (int ai = 0; ai < 2; ++ai)
#pragma unroll
            for (int m = 0; m < 4; ++m) { const size_t off = (size_t)(row0 + ai * HALF + m * 16) * ldc + col0;
#pragma unroll
                for (int bj = 0; bj < 2; ++bj)
#pragma unroll
                    for (int n = 0; n < 2; ++n) { const f32x4 bs = *(const f32x4*)(base + off + bj * HALF + n * 16);
                        *(f32x4*)(out + off + bj * HALF + n * 16) = bs + gv[bj][n] * acc[ai][bj][m][n]; } }
    }
};
template <class Epi, class Sched, bool ALIGN_EPI = false, bool SP2 = false>
__device__ __forceinline__ void gemm_phase(PG8_LAS unsigned char* lds, const Gemm g, const Sched& S, const Epi& E) {
    const int tid = threadIdx.x, wid = __builtin_amdgcn_readfirstlane(tid >> 6), lane = tid & 63, wr = wid >> 2, wc = wid & 3, fr = lane & 15, fq = lane >> 4;
    const int K = g.K, nt = K / BK;
    unsigned voffA[2], voffB[2];
#pragma unroll
    for (int i = 0; i < 2; ++i) { int R, C; stage_rc(tid * 16 + i * 8192, R, C); const int Rb = Epi::PERM ? ((R & ~31) + perm32(R & 31)) : R;
        voffA[i] = (unsigned)(R * g.lda + C) * 2u; voffB[i] = (unsigned)(Rb * K + C) * 2u; }
    const size_t kstep = (size_t)(BK * 2);
    const size_t hstepB = (size_t)HALF * K * 2, hstepA = (size_t)HALF * g.lda * 2;
    const size_t tstepA = 2 * hstepA, tstepB = 2 * hstepB;
    const unsigned ldsw = (unsigned)wid * 1024u;
    const int aoff = lds_byte(wr * 64 + fr, fq * 8), boff = lds_byte(wc * 32 + fr, fq * 8);
#define PG8_SA(b, h) (((b) * 2 + (h)) * HTB)
#define PG8_SB(b, h) ((4 + (b) * 2 + (h)) * HTB)
#define PG8_STAGE(bufoff, gbase, voff) do { _Pragma("unroll") for (int _i = 0; _i < 2; ++_i) \
        __builtin_amdgcn_global_load_lds((const unsigned*)((const char*)(gbase) + (voff)[_i]), (PG8_LAS unsigned*)(lds + (bufoff) + ldsw + _i * 8192), 16, 0, 0); } while (0)
#define PG8_LDA(dst, b, h) do { _Pragma("unroll") for (int m = 0; m < 4; ++m) _Pragma("unroll") for (int k = 0; k < 2; ++k) dst[m][k] = *(const PG8_LAS bf16x8*)(lds + PG8_SA(b, h) + aoff + m * 2048 + k * 1024); } while (0)
#define PG8_LDB(dst, b, h) do { _Pragma("unroll") for (int n = 0; n < 2; ++n) _Pragma("unroll") for (int k = 0; k < 2; ++k) dst[n][k] = *(const PG8_LAS bf16x8*)(lds + PG8_SB(b, h) + boff + n * 2048 + k * 1024); } while (0)
#define PG8_MMA(ai, bj, At, Bt) do { __builtin_amdgcn_s_setprio(1); _Pragma("unroll") for (int m = 0; m < 4; ++m) _Pragma("unroll") for (int n = 0; n < 2; ++n) _Pragma("unroll") for (int k = 0; k < 2; ++k) \
        acc[ai][bj][m][n] = __builtin_amdgcn_mfma_f32_16x16x32_bf16(Bt[n][k], At[m][k], acc[ai][bj][m][n], 0, 0, 0); __builtin_amdgcn_s_setprio(0); } while (0)
#define PG8_WAIT_V(n) asm volatile("s_waitcnt vmcnt(" #n ")" ::: "memory")
#define PG8_WAIT_L(n) asm volatile("s_waitcnt lgkmcnt(" #n ")" ::: "memory")
#define PG8_BAR __builtin_amdgcn_s_barrier()
#define PG8_SCHED __builtin_amdgcn_sched_barrier(0)
    Unit cur, nxt; int ui = 0;
    if (!S.next(0, cur)) return;
    f32x4 acc[2][2][4][2];
#pragma unroll
    for (int a = 0; a < 2; ++a)
#pragma unroll
        for (int b = 0; b < 2; ++b)
#pragma unroll
            for (int m = 0; m < 4; ++m)
#pragma unroll
                for (int n = 0; n < 2; ++n) acc[a][b][m][n] = (f32x4){0.f, 0.f, 0.f, 0.f};
    bf16x8 At[4][2], B0[2][2], B1[2][2];
    const char* cA = (const char*)g.A + (size_t)cur.pm * tstepA; const char* cB = (const char*)g.Bt + (size_t)cur.pn * tstepB;
    S.a_ready(cur);
    if constexpr (SP2) {
        PG8_STAGE(PG8_SB(0, 0), cB, voffB); PG8_STAGE(PG8_SB(0, 1), cB + hstepB, voffB); PG8_STAGE(PG8_SA(0, 0), cA, voffA); PG8_STAGE(PG8_SA(0, 1), cA + hstepA, voffA);
        if (wr == 1) PG8_BAR;
        PG8_WAIT_V(2); PG8_BAR;
        PG8_STAGE(PG8_SB(1, 0), cB + kstep, voffB); PG8_STAGE(PG8_SA(1, 0), cA + kstep, voffA); PG8_STAGE(PG8_SB(1, 1), cB + hstepB + kstep, voffB);
        PG8_WAIT_V(6); PG8_BAR;
    } else {
        PG8_STAGE(PG8_SB(0, 0), cB, voffB); PG8_STAGE(PG8_SA(0, 0), cA, voffA); PG8_STAGE(PG8_SB(0, 1), cB + hstepB, voffB); PG8_STAGE(PG8_SA(0, 1), cA + hstepA, voffA);
        if (wr == 1) PG8_BAR;
        PG8_WAIT_V(4); PG8_BAR;
        PG8_STAGE(PG8_SB(1, 0), cB + kstep, voffB); PG8_STAGE(PG8_SA(1, 0), cA + kstep, voffA); PG8_STAGE(PG8_SB(1, 1), cB + hstepB + kstep, voffB);
        PG8_WAIT_V(6); PG8_BAR;
    }
    for (;;) {
        const bool has_next = S.next(ui + 1, nxt);
        const char* nA = has_next ? (const char*)g.A + (size_t)nxt.pm * tstepA : cA; const char* nB = has_next ? (const char*)g.Bt + (size_t)nxt.pn * tstepB : cB;
        for (int t = 0; t < nt; t += 2) {
            const bool last = (t == nt - 2);
            const char* a1 = cA + (size_t)(t + 1) * kstep;
            const char* a2 = last ? nA : cA + (size_t)(t + 2) * kstep; const char* b2 = last ? nB : cB + (size_t)(t + 2) * kstep;
            const char* a3 = a2 + kstep; const char* b3 = b2 + kstep;
            if (last && has_next) S.a_ready(nxt);
            if constexpr (SP2) {
            PG8_LDB(B0, 0, 0); PG8_LDB(B1, 0, 1); PG8_SCHED; PG8_LDA(At, 0, 0); PG8_STAGE(PG8_SA(1, 1), a1 + hstepA, voffA);
            PG8_WAIT_V(8); PG8_WAIT_L(0); PG8_BAR; PG8_MMA(0, 0, At, B0); PG8_MMA(0, 1, At, B1); PG8_BAR; PG8_SCHED;
            PG8_LDA(At, 0, 1); PG8_STAGE(PG8_SB(0, 0), b2, voffB); PG8_STAGE(PG8_SB(0, 1), b2 + hstepB, voffB); PG8_STAGE(PG8_SA(0, 0), a2, voffA);
            PG8_WAIT_V(8); PG8_WAIT_L(0); PG8_BAR; PG8_MMA(1, 0, At, B0); PG8_MMA(1, 1, At, B1); PG8_BAR; PG8_SCHED;
            PG8_LDB(B0, 1, 0); PG8_LDB(B1, 1, 1); PG8_SCHED; PG8_LDA(At, 1, 0); PG8_STAGE(PG8_SA(0, 1), a2 + hstepA, voffA);
            PG8_WAIT_V(8); PG8_WAIT_L(0); PG8_BAR; PG8_MMA(0, 0, At, B0); PG8_MMA(0, 1, At, B1); PG8_BAR; PG8_SCHED;
            PG8_LDA(At, 1, 1); PG8_STAGE(PG8_SB(1, 0), b3, voffB); PG8_STAGE(PG8_SB(1, 1), b3 + hstepB, voffB); PG8_STAGE(PG8_SA(1, 0), a3, voffA);
            PG8_WAIT_V(8); PG8_WAIT_L(0); PG8_BAR; PG8_MMA(1, 0, At, B0); PG8_MMA(1, 1, At, B1); PG8_BAR; PG8_SCHED;
            } else {
            PG8_LDB(B0, 0, 0); PG8_SCHED; PG8_LDA(At, 0, 0); PG8_STAGE(PG8_SA(1, 1), a1 + hstepA, voffA);
            PG8_WAIT_L(8); PG8_BAR; PG8_WAIT_L(0); PG8_MMA(0, 0, At, B0); PG8_BAR; PG8_SCHED;
            PG8_LDB(B1, 0, 1); PG8_STAGE(PG8_SB(0, 0), b2, voffB);
            PG8_BAR; PG8_WAIT_L(0); PG8_MMA(0, 1, At, B1); PG8_BAR;
            PG8_LDA(At, 0, 1); PG8_STAGE(PG8_SA(0, 0), a2, voffA);
            PG8_BAR; PG8_WAIT_L(0); PG8_MMA(1, 0, At, B0); PG8_BAR; PG8_SCHED;
            PG8_STAGE(PG8_SB(0, 1), b2 + hstepB, voffB);
            PG8_WAIT_V(6); PG8_BAR; PG8_MMA(1, 1, At, B1); PG8_BAR;
            PG8_LDB(B0, 1, 0); PG8_SCHED; PG8_LDA(At, 1, 0); PG8_STAGE(PG8_SA(0, 1), a2 + hstepA, voffA);
            PG8_WAIT_L(8); PG8_BAR; PG8_WAIT_L(0); PG8_MMA(0, 0, At, B0); PG8_BAR; PG8_SCHED;
            PG8_LDB(B1, 1, 1); PG8_STAGE(PG8_SB(1, 0), b3, voffB);
            PG8_BAR; PG8_WAIT_L(0); PG8_MMA(0, 1, At, B1); PG8_BAR;
            PG8_LDA(At, 1, 1); PG8_STAGE(PG8_SA(1, 0), a3, voffA);
            PG8_BAR; PG8_WAIT_L(0); PG8_MMA(1, 0, At, B0); PG8_BAR; PG8_SCHED;
            PG8_STAGE(PG8_SB(1, 1), b3 + hstepB, voffB);
            PG8_WAIT_V(6); PG8_BAR; PG8_MMA(1, 1, At, B1); PG8_BAR;
            }
        }
        if constexpr (ALIGN_EPI) { if (wr == 0) PG8_BAR; }
        if constexpr (!Epi::AFTER_DRAIN) { E(acc, cur, wr, wc, fr, fq); S.done(cur); }
        if (!has_next) break;
#pragma unroll
        for (int a = 0; a < 2; ++a)
#pragma unroll
            for (int b = 0; b < 2; ++b)
#pragma unroll
                for (int m = 0; m < 4; ++m)
#pragma unroll
                    for (int n = 0; n < 2; ++n) acc[a][b][m][n] = (f32x4){0.f, 0.f, 0.f, 0.f};
        cur = nxt; cA = nA; cB = nB; ++ui;
        if constexpr (ALIGN_EPI) { if (wr == 1) PG8_BAR; }
    }
    PG8_WAIT_V(0);
    if constexpr (!ALIGN_EPI) { if (wr == 0) PG8_BAR; }
    PG8_BAR;
    if constexpr (Epi::AFTER_DRAIN) { E.fused(acc, cur, wr, wc, fr, fq, lds, wid, lane); S.done(cur); }
#undef PG8_SA
#undef PG8_SB
#undef PG8_STAGE
#undef PG8_LDA
#undef PG8_LDB
#undef PG8_MMA
#undef PG8_WAIT_V
#undef PG8_WAIT_L
#undef PG8_BAR
#undef PG8_SCHED
}
}

#define LAS __attribute__((address_space(3)))
typedef unsigned short bf16;
typedef short bf16x8 __attribute__((ext_vector_type(8)));
typedef short s16x4 __attribute__((ext_vector_type(4)));
typedef float f32x4 __attribute__((ext_vector_type(4)));
typedef float f32x16 __attribute__((ext_vector_type(16)));
typedef unsigned u32x4 __attribute__((ext_vector_type(4)));
typedef unsigned u32x2 __attribute__((ext_vector_type(2)));

constexpr int NB = 32, SEQ = 2048, DM = 1024, M = NB * SEQ, NPROJ = 3072, FF = 4096;
constexpr int PC_Q = 0, PC_R = 512, PC_K = 1024, PC_V = 1536, PC_QI = 2048, PC_CL = 2560, PC_KI = 2688, PC_XW = 2752, PC_XA = 2816, PC_XG = 2880, PC_WI = 3008;
constexpr size_t MiB = 1u << 20;
constexpr size_t WS_MOD = 0, WS_WUKT = 1 * MiB, WS_WUK = WS_WUKT + 131072, WS_WUVT = WS_WUK + 131072, WS_INVR = 2 * MiB, WS_WIN = 4 * MiB, WS_WOUT = 10 * MiB,
                 WS_W1 = 12 * MiB, WS_W2 = 20 * MiB, WS_CKV = 36 * MiB, WS_GAM = 52 * MiB, WS_C3 = 60 * MiB, WS_REGA = 64 * MiB, WS_PROJ = 192 * MiB, WS_CH = 576 * MiB,
                 WS_G = 960 * MiB, WS_U = 192 * MiB, WS_END = 1024 * MiB,
                 WS_W2T = WS_WUVT + 131072, WS_A2T = WS_W2T + 65536, WS_G2T = WS_A2T + 65536;
constexpr int LDS_BYTES = 151552;
constexpr int NWAVES = 8;

struct Params {
    const float *x, *c, *w_ada, *b_ada, *g_mix, *g_ffn, *w_in, *g_q, *g_k, *g_kv, *w_uk, *w_uv, *mu, *w0, *w2, *a0, *a2, *g2, *k_k, *k_a, *r_k, *ln_w, *ln_b, *w_out, *w_ff1, *w_ff2;
    float* out; unsigned char* ws; int ph_lo, ph_hi;
};

__device__ __forceinline__ unsigned pk2(float lo, float hi) { return pg8::cvt_pk_bf16(lo, hi); }
__device__ __forceinline__ float bflo(unsigned w) { return __uint_as_float(w << 16); }
__device__ __forceinline__ float bfhi(unsigned w) { return __uint_as_float(w & 0xffff0000u); }
__device__ __forceinline__ float bf2f(bf16 h) { return __uint_as_float((unsigned)h << 16); }
__device__ __forceinline__ bf16 f2bf(float f) { return (bf16)(pk2(f, 0.f) & 0xffffu); }
__device__ __forceinline__ float wave_sum(float v) {
#pragma unroll
    for (int o = 1; o < 64; o <<= 1) v += __shfl_xor(v, o);
    return v;
}
__device__ __forceinline__ f32x16 mfma32(bf16x8 a, bf16x8 b, f32x16 c) { return __builtin_amdgcn_mfma_f32_32x32x16_bf16(a, b, c, 0, 0, 0); }
__device__ __forceinline__ f32x4 mfma16(bf16x8 a, bf16x8 b, f32x4 c) { return __builtin_amdgcn_mfma_f32_16x16x32_bf16(a, b, c, 0, 0, 0); }

__device__ __forceinline__ int win_src_col(int n) {
    if (n < 512) return n;
    if (n < 1024) return 1224 + (n - 512);
    if (n < 1536) return 1736 + (n - 1024);
    if (n < 2048) return 2248 + (n - 1536);
    if (n < 2560) return 640 + (n - 2048);
    if (n < 2688) return 512 + (n - 2560);
    if (n < 2752) return 1152 + (n - 2688);
    if (n < 2816) return 2760 + (n - 2752);
    if (n < 2880) return 2824 + (n - 2816);
    if (n < 3008) return 2888 + (n - 2880);
    if (n < 3016) return 1216 + (n - 3008);
    return -1;
}
__device__ __forceinline__ void conv_t_item(const float* W, int K, int Nsrc, bf16* WT, int nblk, int item, float* scr, int lane, bool is_win) {
    const int kb = item / nblk, nb = item % nblk, k0 = 64 * kb, n0 = 32 * nb;
    int ns = n0 + (lane & 31); if (is_win) ns = win_src_col(ns);
#pragma unroll 8
    for (int i = 0; i < 32; ++i) { const int kk = 2 * i + (lane >> 5); scr[kk * 33 + (lane & 31)] = ns >= 0 ? W[(size_t)(k0 + kk) * Nsrc + ns] : 0.f; }
    asm volatile("s_waitcnt lgkmcnt(0)" ::: "memory");
    const int c = lane & 7;
#pragma unroll
    for (int j = 0; j < 4; ++j) { const int n = (lane >> 3) + 8 * j; const float* s = scr + (8 * c) * 33 + n;
        u32x4 o; o.x = pk2(s[0 * 33], s[1 * 33]); o.y = pk2(s[2 * 33], s[3 * 33]); o.z = pk2(s[4 * 33], s[5 * 33]); o.w = pk2(s[6 * 33], s[7 * 33]);
        *(u32x4*)(WT + (size_t)(n0 + n) * K + k0 + 8 * c) = o; }
    asm volatile("s_waitcnt lgkmcnt(0)" ::: "memory");
}
__device__ __forceinline__ void adaln_block(const Params& p, float* ldsf, int cb, int tid) {
    const int lane = tid & 63, wv = tid >> 6, e = cb * 64 + lane;
    float* SC = ldsf; float* RED = ldsf + 16384; float* mod = (float*)(p.ws + WS_MOD);
    for (int half = 0; half < 2; ++half) {
        const int b0 = half * 16;
        for (int i = tid; i < 16384; i += 512) { const float cv = p.c[b0 * 1024 + i]; SC[i] = cv / (1.f + __expf(-cv)); }
        __syncthreads();
        float acc[16];
#pragma unroll
        for (int bb = 0; bb < 16; ++bb) acc[bb] = 0.f;
        for (int d = wv * 128; d < wv * 128 + 128; d += 4) {
            const float w0 = p.w_ada[(size_t)d * 6144 + e], w1 = p.w_ada[(size_t)(d + 1) * 6144 + e], w2 = p.w_ada[(size_t)(d + 2) * 6144 + e], w3 = p.w_ada[(size_t)(d + 3) * 6144 + e];
#pragma unroll
            for (int bb = 0; bb < 16; ++bb) { const f32x4 s = *(const f32x4*)(SC + bb * 1024 + d); acc[bb] += (s.x * w0 + s.y * w1) + (s.z * w2 + s.w * w3); }
        }
#pragma unroll
        for (int bb = 0; bb < 16; ++bb) RED[(wv * 16 + bb) * 64 + lane] = acc[bb];
        __syncthreads();
#pragma unroll
        for (int q = 0; q < 2; ++q) { const int bb = wv * 2 + q; float s = p.b_ada[e];
#pragma unroll
            for (int ww = 0; ww < 8; ++ww) s += RED[(ww * 16 + bb) * 64 + lane];
            mod[(size_t)(b0 + bb) * 6144 + e] = s; }
        __syncthreads();
    }
}
__device__ __forceinline__ void phase_pro(const Params& p, unsigned char* lds, int tid, int G) {
    const int lane = tid & 63, wv = tid >> 6;
    for (int cb = blockIdx.x; cb < 96; cb += G) adaln_block(p, (float*)lds, cb, tid);
    __syncthreads();
    float* scr = (float*)lds + wv * (64 * 33 + 16);
    const int gw = blockIdx.x * NWAVES + wv, NGW = G * NWAVES;
    bf16* WIN = (bf16*)(p.ws + WS_WIN); bf16* WOUT = (bf16*)(p.ws + WS_WOUT); bf16* W1 = (bf16*)(p.ws + WS_W1); bf16* W2 = (bf16*)(p.ws + WS_W2);
    bf16* WUKT = (bf16*)(p.ws + WS_WUKT); bf16* WUK = (bf16*)(p.ws + WS_WUK); bf16* WUVT = (bf16*)(p.ws + WS_WUVT);
    constexpr int I_IN = (DM / 64) * (NPROJ / 32), I_OUT = (DM / 64) * (DM / 32), I_1 = (DM / 64) * (FF / 32), I_2 = (FF / 64) * (DM / 32), I_UK = (128 / 64) * (512 / 32);
    constexpr int I_LR = 512 / 32;
    constexpr int NITEMS = I_IN + I_OUT + I_1 + I_2 + 2 * I_UK + 4 * I_LR;
    for (int it = gw; it < NITEMS; it += NGW) {
        int r = it;
        if (r < I_IN) { conv_t_item(p.w_in, DM, 3016, WIN, NPROJ / 32, r, scr, lane, true); continue; } r -= I_IN;
        if (r < I_OUT) { conv_t_item(p.w_out, DM, DM, WOUT, DM / 32, r, scr, lane, false); continue; } r -= I_OUT;
        if (r < I_1) { conv_t_item(p.w_ff1, DM, FF, W1, FF / 32, r, scr, lane, false); continue; } r -= I_1;
        if (r < I_2) { conv_t_item(p.w_ff2, FF, DM, W2, DM / 32, r, scr, lane, false); continue; } r -= I_2;
        if (r < I_UK) { conv_t_item(p.w_uk, 128, 512, WUKT, 512 / 32, r, scr, lane, false); continue; } r -= I_UK;
        if (r < I_UK) { conv_t_item(p.w_uv, 128, 512, WUVT, 512 / 32, r, scr, lane, false); continue; } r -= I_UK;
        if (r < I_LR) { conv_t_item(p.w2, 64, 512, (bf16*)(p.ws + WS_W2T), 512 / 32, r, scr, lane, false); continue; } r -= I_LR;
        if (r < I_LR) { conv_t_item(p.a2, 64, 512, (bf16*)(p.ws + WS_A2T), 512 / 32, r, scr, lane, false); continue; } r -= I_LR;
        conv_t_item(p.g2, 128, 512, (bf16*)(p.ws + WS_G2T), 512 / 32, r, scr, lane, false);
    }
    for (int i = blockIdx.x * 512 + tid; i < 128 * 512 / 2; i += G * 512) { const float a = p.w_uk[2 * i], b = p.w_uk[2 * i + 1]; ((unsigned*)WUK)[i] = pk2(a, b); }
}

__device__ __forceinline__ void hn_rows(const float* src, const float* g, const float* mod, int off_sh, int off_sc, bf16* dst, int gw, int NGW, int lane) {
    for (int m = gw; m < M; m += NGW) {
        const f32x4* xr = (const f32x4*)(src + (size_t)m * DM) + lane;
        f32x4 v[4]; float s = 0.f;
#pragma unroll
        for (int j = 0; j < 4; ++j) { v[j] = xr[64 * j]; s += (v[j].x * v[j].x + v[j].y * v[j].y) + (v[j].z * v[j].z + v[j].w * v[j].w); }
        s = wave_sum(s); const float rstd = rsqrtf(s * (1.f / DM) + 1e-6f);
        const float* mb = mod + (size_t)(m >> 11) * 6144;
        unsigned long long* o8 = (unsigned long long*)(dst + (size_t)m * DM) + lane;
#pragma unroll
        for (int j = 0; j < 4; ++j) { const int col = 4 * lane + 256 * j;
            const f32x4 gg = *(const f32x4*)(g + col), sc = *(const f32x4*)(mb + off_sc + col), sh = *(const f32x4*)(mb + off_sh + col);
            const f32x4 y = v[j] * rstd * gg * (1.f + sc) + sh;
            o8[64 * j] = (unsigned long long)pk2(y.x, y.y) | ((unsigned long long)pk2(y.z, y.w) << 32); }
    }
}

typedef short s16x4 __attribute__((ext_vector_type(4)));
__device__ __forceinline__ f32x4 mfma16k(s16x4 a, s16x4 b, f32x4 c) { return __builtin_amdgcn_mfma_f32_16x16x16bf16_1k(a, b, c, 0, 0, 0); }
__device__ __forceinline__ s16x4 pack4(f32x4 v) { u32x2 o; o.x = pk2(v[0], v[1]); o.y = pk2(v[2], v[3]); return __builtin_bit_cast(s16x4, o); }

__device__ __forceinline__ void rwkv_prep_item(const Params& p, unsigned char* lds, int it, int tid) {
    const int lane = tid & 63, wv = tid >> 6, n = lane & 15, grp = lane >> 4;
    bf16* XS = (bf16*)lds;
    bf16* LO = (bf16*)(lds + 16384) + wv * 2048;
    bf16* STG = (bf16*)(lds + 49152) + wv * 4096;
    float* MAB = (float*)(lds + 114688) + wv * 256;
    const bf16* PROJ = (const bf16*)(p.ws + WS_PROJ);
    const bf16* W2T = (const bf16*)(p.ws + WS_W2T); const bf16* A2T = (const bf16*)(p.ws + WS_A2T); const bf16* G2T = (const bf16*)(p.ws + WS_G2T);
    float* GAM = (float*)(p.ws + WS_GAM); float* C3 = (float*)(p.ws + WS_C3); bf16* GB = (bf16*)(p.ws + WS_G);
    const int row0 = it * 64, t0 = (it & 31) * 64, b = it >> 5;
    int c = tid; asm volatile("" : "+v"(c));
    const float mu_r = p.mu[c], mu_k = p.mu[512 + c], mu_v = p.mu[1024 + c];
    const float w0c = p.w0[c], a0c = p.a0[c], kkc = p.k_k[c], kac = p.k_a[c], rkc = p.r_k[c];
    float rp, kp, vp;
    { const bool first = (t0 == 0); const size_t rr = (size_t)(row0 - 1) * NPROJ;
      rp = first ? 0.f : bf2f(PROJ[rr + PC_R + c]); kp = first ? 0.f : bf2f(PROJ[rr + PC_K + c]); vp = first ? 0.f : bf2f(PROJ[rr + PC_V + c]); }
    int jj = tid & 255; asm volatile("" : "+v"(jj)); const int tsel = tid >> 8; const float mux = p.mu[1536 + jj];
    bf16 xc[8], xpv[8];
#define XS_LOAD(rowbase, tbase) do { _Pragma("unroll") for (int i = 0; i < 8; ++i) { const int t = tsel + 2 * i; const size_t r = (size_t)((rowbase) + t) * NPROJ + PC_XW + jj; \
        xc[i] = PROJ[r]; xpv[i] = ((tbase) + t == 0) ? (bf16)0 : PROJ[r - NPROJ]; } } while (0)
#define XS_WRITE(buf) do { _Pragma("unroll") for (int i = 0; i < 8; ++i) { const int t = tsel + 2 * i; const float cur = bf2f(xc[i]), prev = bf2f(xpv[i]); float v = cur + mux * (prev - cur); \
        if (jj < 64) { const float e2 = __expf(2.f * v); v = 1.f - 2.f / (e2 + 1.f); } else if (jj >= 128) v = 1.f / (1.f + __expf(-v)); \
        XS[(buf) * 4096 + t * 256 + jj] = f2bf(v); } } while (0)
    XS_LOAD(row0, t0); XS_WRITE(0);
    __syncthreads();
#pragma unroll 1
    for (int q = 0; q < 4; ++q) {
        const int rowq = row0 + 16 * q, tq = t0 + 16 * q;
        int lane_ = lane, n_ = n, grp_ = grp, c_ = c; asm volatile("" : "+v"(lane_), "+v"(n_), "+v"(grp_), "+v"(c_));
        const size_t idx = (size_t)(b * 8 + wv) * 128 + (tq >> 4);
        unsigned char* CHp = p.ws + WS_CH + idx * 12288;
        const bf16* XSq = XS + (q & 1) * 4096;
        bf16 rcv[16], kcv[16], vcv[16];
#pragma unroll
        for (int t = 0; t < 16; ++t) { const size_t rr = (size_t)(rowq + t) * NPROJ; rcv[t] = PROJ[rr + PC_R + c_]; kcv[t] = PROJ[rr + PC_K + c_]; vcv[t] = PROJ[rr + PC_V + c_]; }
        if (q < 3) XS_LOAD(rowq + 16, tq + 16);
        {   s16x4 xa[16];
#pragma unroll
            for (int ks = 0; ks < 16; ++ks) xa[ks] = *(const s16x4*)(XSq + n_ * 256 + 16 * ks + 4 * grp_);
#pragma unroll
            for (int ct = 0; ct < 4; ++ct) { const int cc = wv * 64 + 16 * ct + n_;
                f32x4 dw = {0.f, 0.f, 0.f, 0.f}, da = dw, dg = dw;
#pragma unroll
                for (int ks = 0; ks < 4; ++ks) dw = mfma16k(xa[ks], *(const s16x4*)(W2T + cc * 64 + 16 * ks + 4 * grp_), dw);
#pragma unroll
                for (int ks = 0; ks < 4; ++ks) da = mfma16k(xa[4 + ks], *(const s16x4*)(A2T + cc * 64 + 16 * ks + 4 * grp_), da);
#pragma unroll
                for (int ks = 0; ks < 8; ++ks) dg = mfma16k(xa[8 + ks], *(const s16x4*)(G2T + cc * 128 + 16 * ks + 4 * grp_), dg);
#pragma unroll
                for (int rg = 0; rg < 4; ++rg) { const int o = (4 * grp_ + rg) * 64 + 16 * ct + n_; LO[o] = f2bf(dw[rg]); LO[1024 + o] = f2bf(da[rg]);
                    GB[(size_t)(rowq + 4 * grp_ + rg) * 512 + cc] = f2bf(dg[rg]); } }
        }
        if (q < 3) XS_WRITE((q + 1) & 1);
        asm volatile("s_waitcnt lgkmcnt(0)" ::: "memory");
        {   float gam = 1.f; unsigned btp[8], ktp[8], vtp[8]; float be = 0.f, ke = 0.f, ve = 0.f;
#pragma unroll
            for (int hf = 0; hf < 2; ++hf) {
                float rr_[8], vv_[8], ww_[8], aa_[8], kkv_[8], kpr_[8], nrm_[8], c3_[8];
#pragma unroll
                for (int tt = 0; tt < 8; ++tt) { const int t = 8 * hf + tt;
                    const float rc = bf2f(rcv[t]), kc = bf2f(kcv[t]), vc = bf2f(vcv[t]);
                    const float r = rc + mu_r * (rp - rc), k = kc + mu_k * (kp - kc); vv_[tt] = vc + mu_v * (vp - vc); rp = rc; kp = kc; vp = vc;
                    const float lw = bf2f(LO[t * 64 + lane_]), la = bf2f(LO[1024 + t * 64 + lane_]);
                    const float u = w0c + lw; const float wlog = -__logf(1.f + __expf(-u)) - 0.5f; ww_[tt] = __expf(-__expf(wlog));
                    const float a = 1.f / (1.f + __expf(-(a0c + la))); aa_[tt] = a; rr_[tt] = r;
                    kkv_[tt] = k * kkc; kpr_[tt] = k * (1.f + (a - 1.f) * kac);
                    nrm_[tt] = kkv_[tt] * kkv_[tt]; c3_[tt] = r * kpr_[tt] * rkc; }
#pragma unroll
                for (int o = 1; o < 64; o <<= 1) {
#pragma unroll
                    for (int tt = 0; tt < 8; ++tt) { nrm_[tt] += __shfl_xor(nrm_[tt], o); c3_[tt] += __shfl_xor(c3_[tt], o); } }
#pragma unroll
                for (int tt = 0; tt < 8; ++tt) { const int t = 8 * hf + tt;
                    const float kk = kkv_[tt] / fmaxf(sqrtf(nrm_[tt]), 1e-12f);
                    const float gprev = gam; gam *= ww_[tt]; const float ig = 1.f / gam;
                    STG[t * 64 + lane_] = f2bf(-kk * gprev); STG[1024 + t * 64 + lane_] = f2bf(rr_[tt] * gam);
                    const float bt = kk * aa_[tt] * ig, kt = kpr_[tt] * ig;
                    STG[2048 + t * 64 + lane_] = f2bf(bt); STG[3072 + t * 64 + lane_] = f2bf(kt);
                    if (t & 1) { btp[t >> 1] = pk2(be, bt); ktp[t >> 1] = pk2(ke, kt); vtp[t >> 1] = pk2(ve, vv_[tt]); } else { be = bt; ke = kt; ve = vv_[tt]; }
                    if (lane_ == 0) C3[(size_t)(rowq + t) * 8 + wv] = c3_[tt]; }
            }
            *(u32x4*)(CHp + 4096 + lane_ * 32) = (u32x4){btp[0], btp[1], btp[2], btp[3]}; *(u32x4*)(CHp + 4096 + lane_ * 32 + 16) = (u32x4){btp[4], btp[5], btp[6], btp[7]};
            *(u32x4*)(CHp + 6144 + lane_ * 32) = (u32x4){ktp[0], ktp[1], ktp[2], ktp[3]}; *(u32x4*)(CHp + 6144 + lane_ * 32 + 16) = (u32x4){ktp[4], ktp[5], ktp[6], ktp[7]};
            *(u32x4*)(CHp + 8192 + lane_ * 32) = (u32x4){vtp[0], vtp[1], vtp[2], vtp[3]}; *(u32x4*)(CHp + 8192 + lane_ * 32 + 16) = (u32x4){vtp[4], vtp[5], vtp[6], vtp[7]};
            GAM[idx * 64 + lane_] = gam;
        }
        asm volatile("s_waitcnt lgkmcnt(0)" ::: "memory");
        {   f32x4 mab = {0.f, 0.f, 0.f, 0.f}, mak = mab, nrb = mab, nrk = mab;
#pragma unroll
            for (int ks = 0; ks < 4; ++ks) { const int o = n_ * 64 + 16 * ks + 4 * grp_;
                const s16x4 fa = *(const s16x4*)(STG + o), fr = *(const s16x4*)(STG + 1024 + o), fb = *(const s16x4*)(STG + 2048 + o), fk = *(const s16x4*)(STG + 3072 + o);
                mab = mfma16k(fa, fb, mab); mak = mfma16k(fa, fk, mak); nrb = mfma16k(fr, fb, nrb); nrk = mfma16k(fr, fk, nrk); }
#pragma unroll
            for (int rg = 0; rg < 4; ++rg) { const int t = 4 * grp_ + rg; const bool sl = t > n_, il = t >= n_;
                MAB[t * 16 + n_] = sl ? mab[rg] : 0.f;
                bf16* m2 = (bf16*)(CHp + 10752) + t * 16 + n_;
                m2[0] = f2bf(sl ? mak[rg] : 0.f); m2[256] = f2bf(il ? nrb[rg] : 0.f); m2[512] = f2bf(il ? nrk[rg] : 0.f); }
            asm volatile("s_waitcnt lgkmcnt(0)" ::: "memory");
            if (lane_ < 16) {
                float Tc[16];
#pragma unroll
                for (int t = 0; t < 16; ++t) { float acc = (t == lane_) ? 1.f : 0.f;
#pragma unroll
                    for (int s = 0; s < t; ++s) acc = fmaf(MAB[t * 16 + s], Tc[s], acc);
                    Tc[t] = acc; ((bf16*)(CHp + 10240))[t * 16 + lane_] = f2bf(acc); }
            }
#pragma unroll
            for (int i = 0; i < 4; ++i) { const int id = i * 64 + lane_; *(u32x4*)(CHp + id * 16) = *(const u32x4*)((const unsigned char*)STG + id * 16); }
        }
        __syncthreads();
    }
}

__device__ __forceinline__ void dsa_prep_item(const Params& p, int tile, int lane) {
    const bf16* PROJ = (const bf16*)(p.ws + WS_PROJ); bf16* CKV = (bf16*)(p.ws + WS_CKV); float* INVR = (float*)(p.ws + WS_INVR); bf16* QABS = (bf16*)(p.ws + WS_REGA);
    const bf16* WUKT = (const bf16*)(p.ws + WS_WUKT); const bf16* WUK = (const bf16*)(p.ws + WS_WUK);
    const int r = lane & 31, hh = lane >> 5; const size_t row = (size_t)tile * 32 + r; const bf16* prow = PROJ + row * NPROJ;
    bf16x8 cf[8];
    {   u32x4 craw[8]; float ssq = 0.f;
#pragma unroll
        for (int s = 0; s < 8; ++s) { craw[s] = *(const u32x4*)(prow + PC_CL + 16 * s + 8 * hh);
#pragma unroll
            for (int w = 0; w < 4; ++w) { const float lo = bflo(craw[s][w]), hi = bfhi(craw[s][w]); ssq += lo * lo + hi * hi; } }
        ssq += __shfl_xor(ssq, 32);
        const float rstd = rsqrtf(ssq * (1.f / 128.f) + 1e-6f);
#pragma unroll
        for (int s = 0; s < 8; ++s) { const float* g = p.g_kv + 16 * s + 8 * hh; const f32x4 g0 = *(const f32x4*)g, g1 = *(const f32x4*)(g + 4);
            u32x4 o; o.x = pk2(bflo(craw[s].x) * rstd * g0.x, bfhi(craw[s].x) * rstd * g0.y); o.y = pk2(bflo(craw[s].y) * rstd * g0.z, bfhi(craw[s].y) * rstd * g0.w);
            o.z = pk2(bflo(craw[s].z) * rstd * g1.x, bfhi(craw[s].z) * rstd * g1.y); o.w = pk2(bflo(craw[s].w) * rstd * g1.z, bfhi(craw[s].w) * rstd * g1.w);
            cf[s] = __builtin_bit_cast(bf16x8, o); *(u32x4*)(CKV + row * 128 + 16 * s + 8 * hh) = o; }
    }
    for (int h = 0; h < 8; ++h) { float ss = 0.f;
#pragma unroll
        for (int dt = 0; dt < 2; ++dt) { f32x16 acc = {}; const bf16* wrow = WUKT + (size_t)(h * 64 + dt * 32 + r) * 128 + 8 * hh;
#pragma unroll
            for (int s = 0; s < 8; ++s) { const bf16x8 a = *(const bf16x8*)(wrow + 16 * s); acc = mfma32(a, cf[s], acc); }
#pragma unroll
            for (int i = 0; i < 16; ++i) ss += acc[i] * acc[i]; }
        ss += __shfl_xor(ss, 32);
        if (hh == 0) INVR[row * 8 + h] = rsqrtf(ss * (1.f / 64.f) + 1e-6f);
    }
    for (int h = 0; h < 8; ++h) {
        u32x4 qraw[4]; float ssq = 0.f;
#pragma unroll
        for (int s = 0; s < 4; ++s) { qraw[s] = *(const u32x4*)(prow + PC_Q + h * 64 + 16 * s + 8 * hh);
#pragma unroll
            for (int w = 0; w < 4; ++w) { const float lo = bflo(qraw[s][w]), hi = bfhi(qraw[s][w]); ssq += lo * lo + hi * hi; } }
        ssq += __shfl_xor(ssq, 32);
        const float rstd = rsqrtf(ssq * (1.f / 64.f) + 1e-6f);
        bf16x8 qf[4];
#pragma unroll
        for (int s = 0; s < 4; ++s) { const int d0 = 16 * s + 8 * hh; float gg[8];
#pragma unroll
            for (int j = 0; j < 8; ++j) gg[j] = p.g_q[d0 + j] * p.g_k[d0 + j] * rstd;
            u32x4 o; o.x = pk2(bflo(qraw[s].x) * gg[0], bfhi(qraw[s].x) * gg[1]); o.y = pk2(bflo(qraw[s].y) * gg[2], bfhi(qraw[s].y) * gg[3]);
            o.z = pk2(bflo(qraw[s].z) * gg[4], bfhi(qraw[s].z) * gg[5]); o.w = pk2(bflo(qraw[s].w) * gg[6], bfhi(qraw[s].w) * gg[7]);
            qf[s] = __builtin_bit_cast(bf16x8, o); }
#pragma unroll
        for (int lt = 0; lt < 4; ++lt) { f32x16 acc = {}; const bf16* wrow = WUK + (size_t)(lt * 32 + r) * 512 + h * 64 + 8 * hh;
#pragma unroll
            for (int s = 0; s < 4; ++s) { const bf16x8 a = *(const bf16x8*)(wrow + 16 * s); acc = mfma32(a, qf[s], acc); }
#pragma unroll
            for (int g4 = 0; g4 < 4; ++g4) { u32x2 o; o.x = pk2(acc[4 * g4] * 0.125f, acc[4 * g4 + 1] * 0.125f); o.y = pk2(acc[4 * g4 + 2] * 0.125f, acc[4 * g4 + 3] * 0.125f);
                *(u32x2*)(QABS + row * 1024 + h * 128 + lt * 32 + 8 * g4 + 4 * hh) = o; } }
    }
}

constexpr int SCAN_D = 8, SCAN_SLOT = 12288 + 256;
#define SCAN_BAR() do { asm volatile("s_waitcnt lgkmcnt(0)" ::: "memory"); __builtin_amdgcn_s_barrier(); asm volatile("" ::: "memory"); } while (0)
__device__ __forceinline__ void rwkv_scan_chain(const Params& p, unsigned char* lds, int chain, int wv, int lane) {
    const int b = chain >> 3, h = chain & 7;
    const size_t idx0 = (size_t)(b * 8 + h) * 128;
    if (wv >= 4) {
        const int li = (wv - 4) * 64 + lane;
        const unsigned char* src = p.ws + WS_CH + idx0 * 12288 + (size_t)li * 16; const float* gsrc = (const float*)(p.ws + WS_GAM) + idx0 * 64 + (li & 15) * 4;
        u32x4 R[SCAN_D][3]; f32x4 Rg[SCAN_D];
#pragma unroll
        for (int j = 0; j < SCAN_D; ++j) {
#pragma unroll
            for (int i = 0; i < 3; ++i) R[j][i] = *(const u32x4*)(src + (size_t)j * 12288 + i * 4096);
            Rg[j] = *(const f32x4*)(gsrc + (size_t)j * 64); }
        for (int k0 = 0; k0 < 128; k0 += SCAN_D) {
#pragma unroll
            for (int j = 0; j < SCAN_D; ++j) { const int k = k0 + j; unsigned char* slot = lds + (k & 1) * SCAN_SLOT;
#pragma unroll
                for (int i = 0; i < 3; ++i) *(u32x4*)(slot + li * 16 + i * 4096) = R[j][i];
                *(f32x4*)(slot + 12288 + (li & 15) * 16) = Rg[j];
                if (k + SCAN_D < 128) {
#pragma unroll
                    for (int i = 0; i < 3; ++i) R[j][i] = *(const u32x4*)(src + (size_t)(k + SCAN_D) * 12288 + i * 4096);
                    Rg[j] = *(const f32x4*)(gsrc + (size_t)(k + SCAN_D) * 64); }
                SCAN_BAR(); } }
    } else {
        const int w = wv, n = lane & 15, grp = lane >> 4;
        bf16* PROJ = (bf16*)(p.ws + WS_PROJ);
        f32x4 S[4];
#pragma unroll
        for (int jt = 0; jt < 4; ++jt) S[jt] = (f32x4){0.f, 0.f, 0.f, 0.f};
        for (int sc = 0; sc < 128; ++sc) {
            SCAN_BAR();
            const unsigned char* CHp = lds + (sc & 1) * SCAN_SLOT;
            s16x4 at[4], rt[4], bt[4], kt[4]; f32x4 gm[4];
#pragma unroll
            for (int jt = 0; jt < 4; ++jt) {
                at[jt] = *(const s16x4*)(CHp + n * 128 + (16 * jt + 4 * grp) * 2); rt[jt] = *(const s16x4*)(CHp + 2048 + n * 128 + (16 * jt + 4 * grp) * 2);
                bt[jt] = *(const s16x4*)(CHp + 4096 + (16 * jt + n) * 32 + grp * 8); kt[jt] = *(const s16x4*)(CHp + 6144 + (16 * jt + n) * 32 + grp * 8);
                gm[jt] = *(const f32x4*)(CHp + 12288 + (16 * jt + 4 * grp) * 4); }
            const s16x4 vt = *(const s16x4*)(CHp + 8192 + (16 * w + n) * 32 + grp * 8);
            const s16x4 Tm = *(const s16x4*)(CHp + 10240 + n * 32 + grp * 8), Mak = *(const s16x4*)(CHp + 10752 + n * 32 + grp * 8);
            const s16x4 Nrb = *(const s16x4*)(CHp + 11264 + n * 32 + grp * 8), Nrk = *(const s16x4*)(CHp + 11776 + n * 32 + grp * 8);
            s16x4 Sb[4];
#pragma unroll
            for (int jt = 0; jt < 4; ++jt) Sb[jt] = pack4(S[jt]);
            f32x4 X = {0.f, 0.f, 0.f, 0.f}, O = X;
#pragma unroll
            for (int jt = 0; jt < 4; ++jt) X = mfma16k(at[jt], Sb[jt], X);
            X = mfma16k(Mak, vt, X);
#pragma unroll
            for (int jt = 0; jt < 4; ++jt) O = mfma16k(rt[jt], Sb[jt], O);
            O = mfma16k(Nrk, vt, O);
            const f32x4 U = mfma16k(Tm, pack4(X), (f32x4){0.f, 0.f, 0.f, 0.f});
            const s16x4 Ub = pack4(U);
            O = mfma16k(Nrb, Ub, O);
#pragma unroll
            for (int jt = 0; jt < 4; ++jt) { S[jt] = mfma16k(kt[jt], vt, S[jt]); S[jt] = mfma16k(bt[jt], Ub, S[jt]); S[jt] = S[jt] * gm[jt]; }
            bf16* orow = PROJ + ((size_t)b * SEQ + sc * 16 + 4 * grp) * NPROJ + PC_R + h * 64 + 16 * w + n;
#pragma unroll
            for (int rg = 0; rg < 4; ++rg) orow[(size_t)rg * NPROJ] = f2bf(O[rg]);
        }
    }
}
__device__ __forceinline__ void rwkv_epi_row(const Params& p, int m, int lane) {
    bf16* PROJ = (bf16*)(p.ws + WS_PROJ); const bf16* GB = (const bf16*)(p.ws + WS_G); const float* C3 = (const float*)(p.ws + WS_C3);
    bf16* prow = PROJ + (size_t)m * NPROJ; const int c0 = lane * 8, h = lane >> 3; const bool first = (m & (SEQ - 1)) == 0;
    const u32x4 oraw = *(const u32x4*)(prow + PC_R + c0), vc = *(const u32x4*)(prow + PC_V + c0), gr = *(const u32x4*)(GB + (size_t)m * 512 + c0);
    u32x4 vpv = {0u, 0u, 0u, 0u}; if (!first) vpv = *(const u32x4*)(prow - NPROJ + PC_V + c0);
    float o[8], v[8], g[8];
#pragma unroll
    for (int i = 0; i < 4; ++i) { o[2 * i] = bflo(oraw[i]); o[2 * i + 1] = bfhi(oraw[i]); g[2 * i] = bflo(gr[i]); g[2 * i + 1] = bfhi(gr[i]);
        const float c0v = bflo(vc[i]), c1v = bfhi(vc[i]), p0 = bflo(vpv[i]), p1 = bfhi(vpv[i]);
        const float m0 = p.mu[1024 + c0 + 2 * i], m1 = p.mu[1024 + c0 + 2 * i + 1];
        v[2 * i] = c0v + m0 * (p0 - c0v); v[2 * i + 1] = c1v + m1 * (p1 - c1v); }
    float s = 0.f;
#pragma unroll
    for (int i = 0; i < 8; ++i) s += o[i];
    s += __shfl_xor(s, 1); s += __shfl_xor(s, 2); s += __shfl_xor(s, 4);
    const float mean = s * (1.f / 64.f); float q = 0.f;
#pragma unroll
    for (int i = 0; i < 8; ++i) { o[i] -= mean; q += o[i] * o[i]; }
    q += __shfl_xor(q, 1); q += __shfl_xor(q, 2); q += __shfl_xor(q, 4);
    const float rstd = rsqrtf(q * (1.f / 64.f) + 64e-5f), c3 = C3[(size_t)m * 8 + h];
    u32x4 out;
#pragma unroll
    for (int i = 0; i < 4; ++i) { float y[2];
#pragma unroll
        for (int e = 0; e < 2; ++e) { const int cc = c0 + 2 * i + e; y[e] = (o[2 * i + e] * rstd * p.ln_w[cc] + p.ln_b[cc] + c3 * v[2 * i + e]) * g[2 * i + e]; }
        out[i] = pk2(y[0], y[1]); }
    *(u32x4*)(prow + PC_R + c0) = out;
}

__device__ __forceinline__ unsigned f2key(float f) { unsigned b = __float_as_uint(f); if ((b << 1) == 0u) b = 0u; return (b & 0x80000000u) ? ~b : (b | 0x80000000u); }
__device__ __forceinline__ unsigned offb(unsigned row, unsigned ch) { return 2048u * (row >> 3) + 512u * (ch >> 2) + 64u * (row & 7) + 16u * ((ch & 3) ^ ((row >> 2) & 3)); }

__device__ __forceinline__ void topk_select(float* sc, int N, unsigned* hist, unsigned short* sel, int lane) {
    unsigned* kb = (unsigned*)sc;
    unsigned prefix = 0u, mask = 0u; int rem = 256, mbin = 0;
    const unsigned long long lt_mask = (1ull << lane) - 1ull;
    for (int pass = 0; pass < 4; ++pass) {
        const int shift = 24 - 8 * pass;
#pragma unroll
        for (int i = 0; i < 4; ++i) hist[lane * 4 + i] = 0u;
        asm volatile("s_waitcnt lgkmcnt(0)" ::: "memory");
        for (int base = 0; base < N; base += 256) { const int idx = base + 4 * lane;
            if (idx < N) { u32x4 k4;
                if (pass == 0) { const f32x4 v = *(const f32x4*)(sc + idx); k4 = (u32x4){f2key(v.x), f2key(v.y), f2key(v.z), f2key(v.w)}; *(u32x4*)(kb + idx) = k4; }
                else k4 = *(const u32x4*)(kb + idx);
#pragma unroll
                for (int e = 0; e < 4; ++e) if ((k4[e] & mask) == prefix) atomicAdd(&hist[(k4[e] >> shift) & 255u], 1u); } }
        asm volatile("s_waitcnt lgkmcnt(0)" ::: "memory");
        const unsigned c0 = hist[lane * 4], c1 = hist[lane * 4 + 1], c2 = hist[lane * 4 + 2], c3 = hist[lane * 4 + 3];
        const int cnt4 = (int)(c0 + c1 + c2 + c3);
        int incl = cnt4;
#pragma unroll
        for (int o = 1; o < 64; o <<= 1) { const int v = __shfl_down(incl, o); if (lane + o < 64) incl += v; }
        const int excl = incl - cnt4;
        const bool mine = (excl < rem) && (rem <= incl);
        const unsigned long long bal = __ballot(mine);
        const int L = (int)__builtin_ctzll(bal);
        const int ex = __shfl(excl, L); const int b3 = (int)__shfl((int)c3, L), b2 = (int)__shfl((int)c2, L), b1 = (int)__shfl((int)c1, L), b0 = (int)__shfl((int)c0, L);
        int above = ex, bin;
        if (above + b3 >= rem) { bin = 3; mbin = b3; } else { above += b3; if (above + b2 >= rem) { bin = 2; mbin = b2; } else { above += b2; if (above + b1 >= rem) { bin = 1; mbin = b1; } else { above += b1; bin = 0; mbin = b0; } } }
        rem -= above; prefix |= (unsigned)(L * 4 + bin) << shift; mask |= 0xffu << shift;
        if (pass == 1 && mbin <= 64) break;
    }
    const unsigned T = prefix; const int ngt = 256 - rem; int base_gt = 0, base_eq = 0;
    const bool partial = (mask != 0xffffffffu);
    unsigned short* cand = (unsigned short*)hist;
    for (int base = 0; base < N; base += 256) { const int idx = base + 4 * lane; const bool act = idx < N;
        u32x4 k4 = {0u, 0u, 0u, 0u}; if (act) k4 = *(const u32x4*)(kb + idx);
        bool gt[4], eq[4]; unsigned long long bg[4], be[4];
#pragma unroll
        for (int e = 0; e < 4; ++e) { const unsigned km = k4[e] & mask; gt[e] = act && km > T; eq[e] = act && km == T; bg[e] = __ballot(gt[e]); be[e] = __ballot(eq[e]); }
        int rg = base_gt, re = base_eq;
#pragma unroll
        for (int e = 0; e < 4; ++e) re += __popcll(be[e] & lt_mask);
#pragma unroll
        for (int e = 0; e < 4; ++e) {
            if (gt[e]) sel[rg + __popcll(bg[e] & lt_mask)] = (unsigned short)(idx + e);
            rg += __popcll(bg[e]);
            if (eq[e]) { if (partial) cand[re] = (unsigned short)(idx + e); else if (re < rem) sel[ngt + re] = (unsigned short)(idx + e); re += 1; } }
        base_gt = rg;
#pragma unroll
        for (int e = 0; e < 4; ++e) base_eq += __popcll(be[e]); }
    asm volatile("s_waitcnt lgkmcnt(0)" ::: "memory");
    if (partial) {
        const int m = mbin; const int ci = (lane < m) ? (int)cand[lane] : 0; const unsigned ck = (lane < m) ? kb[ci] : 0u;
        int rank = 0;
        for (int j = 0; j < m; ++j) { const unsigned kj = (unsigned)__shfl((int)ck, j); rank += (kj > ck || (kj == ck && j < lane)) ? 1 : 0; }
        if (lane < m && rank < rem) sel[ngt + rank] = (unsigned short)ci;
        asm volatile("s_waitcnt lgkmcnt(0)" ::: "memory");
    }
}

__device__ __forceinline__ void dsa_attend(const Params& p, int b, int t, const unsigned short* sel, int cnt, unsigned char* stage, int lane_in) {
    int lane = lane_in; asm volatile("" : "+v"(lane));
    const bf16* CKV = (const bf16*)(p.ws + WS_CKV) + (size_t)b * SEQ * 128; const float* INVR = (const float*)(p.ws + WS_INVR) + (size_t)b * SEQ * 8;
    bf16* QO = (bf16*)(p.ws + WS_REGA) + ((size_t)b * SEQ + t) * 1024;
    const int hd = lane & 15, grp = lane >> 4;
    bf16x8 bq[4];
#pragma unroll
    for (int s = 0; s < 4; ++s) { u32x4 z = {0u, 0u, 0u, 0u}; if (hd < 8) z = *(const u32x4*)(QO + hd * 128 + 32 * s + 8 * grp); bq[s] = __builtin_bit_cast(bf16x8, z); }
    const float slope = (hd < 8) ? exp2f(-(float)(hd + 1)) : 0.f;
    const int hsafe = hd & 7;
    float m_run = -INFINITY, l_part = 0.f;
    f32x4 O[8];
#pragma unroll
    for (int c = 0; c < 8; ++c) O[c] = (f32x4){0.f, 0.f, 0.f, 0.f};
    const LAS unsigned char* st3 = (const LAS unsigned char*)stage;
    const unsigned q4 = (lane & 15) >> 2, p4 = lane & 3;
    u32x4 G[8]; float IRn[8], PNn[8];
#define DA_ISSUE(ks_) do { \
    _Pragma("unroll") for (int i = 0; i < 8; ++i) { const int id = i * 64 + lane, row = id >> 4, ch = id & 15; const int key = sel[(ks_) + row]; G[i] = *(const u32x4*)(CKV + (size_t)key * 128 + ch * 8); } } while (0)
#define DA_ISSUE2(ks_) do { \
    _Pragma("unroll") for (int i = 0; i < 8; ++i) { const int key = sel[(ks_) + 16 * (i >> 2) + 4 * grp + (i & 3)]; IRn[i] = INVR[(size_t)key * 8 + hsafe]; PNn[i] = slope * fabsf((float)(t - key)); } } while (0)
    DA_ISSUE(0); DA_ISSUE2(0);
    for (int ks = 0; ks < cnt; ks += 32) {
#pragma unroll
        for (int i = 0; i < 8; ++i) { const int id = i * 64 + lane, row = id >> 4, ch = id & 15; *(u32x4*)(stage + offb(row, ch)) = G[i]; }
        asm volatile("s_waitcnt lgkmcnt(0)" ::: "memory");
        if (ks + 32 < cnt) DA_ISSUE(ks + 32);
        float lg[8];
#pragma unroll
        for (int T = 0; T < 2; ++T) { f32x4 acc = {0.f, 0.f, 0.f, 0.f};
#pragma unroll
            for (int s = 0; s < 4; ++s) { const bf16x8 a = *(const bf16x8*)(stage + offb((lane & 15) + 16 * T, 4 * s + grp)); acc = mfma16(a, bq[s], acc); }
#pragma unroll
            for (int rg = 0; rg < 4; ++rg) lg[4 * T + rg] = acc[rg] * IRn[4 * T + rg] - PNn[4 * T + rg]; }
        if (ks + 32 < cnt) DA_ISSUE2(ks + 32);
        float mx = lg[0];
#pragma unroll
        for (int i = 1; i < 8; ++i) mx = fmaxf(mx, lg[i]);
        mx = fmaxf(mx, __shfl_xor(mx, 16)); mx = fmaxf(mx, __shfl_xor(mx, 32));
        const float m_new = fmaxf(m_run, mx);
        const float alpha = __expf(m_run - m_new);
        float ps = 0.f;
#pragma unroll
        for (int i = 0; i < 8; ++i) { lg[i] = __expf(lg[i] - m_new); ps += lg[i]; }
        l_part = l_part * alpha + ps; m_run = m_new;
        float ar[4];
#pragma unroll
        for (int rg = 0; rg < 4; ++rg) ar[rg] = __shfl(alpha, 4 * grp + rg);
#pragma unroll
        for (int c = 0; c < 8; ++c)
#pragma unroll
            for (int rg = 0; rg < 4; ++rg) O[c][rg] *= ar[rg];
        {   u32x4 pw; pw.x = pk2(lg[0], lg[1]); pw.y = pk2(lg[2], lg[3]); pw.z = pk2(lg[4], lg[5]); pw.w = pk2(lg[6], lg[7]);
            const bf16x8 pa = __builtin_bit_cast(bf16x8, pw);
#pragma unroll
            for (int c = 0; c < 8; ++c) {
                const s16x4 lo = __builtin_bit_cast(s16x4, __builtin_amdgcn_ds_read_tr16_b64_v4i16((LAS s16x4*)(st3 + offb(4 * grp + q4, 2 * c + (p4 >> 1)) + 8 * (p4 & 1))));
                const s16x4 hi = __builtin_bit_cast(s16x4, __builtin_amdgcn_ds_read_tr16_b64_v4i16((LAS s16x4*)(st3 + offb(16 + 4 * grp + q4, 2 * c + (p4 >> 1)) + 8 * (p4 & 1))));
                const bf16x8 vb = {lo[0], lo[1], lo[2], lo[3], hi[0], hi[1], hi[2], hi[3]};
                O[c] = mfma16(pa, vb, O[c]); } }
        asm volatile("s_waitcnt lgkmcnt(0)" ::: "memory");
    }
#undef DA_ISSUE
#undef DA_ISSUE2
    float l = l_part; l += __shfl_xor(l, 16); l += __shfl_xor(l, 32);
    const float il = 1.f / l;
    float irr[4];
#pragma unroll
    for (int rg = 0; rg < 4; ++rg) irr[rg] = __shfl(il, 4 * grp + rg);
    if (grp < 2) {
#pragma unroll
        for (int rg = 0; rg < 4; ++rg)
#pragma unroll
            for (int c = 0; c < 8; ++c) QO[(4 * grp + rg) * 128 + 16 * c + hd] = f2bf(O[c][rg] * irr[rg]);
    }
}

__device__ __forceinline__ void dsa_item(const Params& p, unsigned char* lds, int it, int tid) {
    const bf16* PROJ = (const bf16*)(p.ws + WS_PROJ);
    float* SC = (float*)lds;
    unsigned* HIST = (unsigned*)(lds + 131072);
    unsigned short* SEL = (unsigned short*)(lds + 131072 + 8192);
    float* WQ = (float*)(lds + 147456);
    asm volatile("" : "+v"(tid));
    const int lane = tid & 63, wv = __builtin_amdgcn_readfirstlane(tid >> 6);
    const int b = it >> 7, tq0 = (it & 127) * 16, N = ((tq0 >> 6) + 1) * 64; const size_t rowq0 = (size_t)b * SEQ + tq0;
    if (N > 256 && !MK_DBG_NOTOPK) {
        const int r = lane & 31, g = lane >> 5;
        const int ql = 2 * ((r >> 2) & 1) + (r >> 4), hdm = 4 * ((r >> 3) & 1) + (r & 3);
        bf16x8 af[4][4];
#pragma unroll
        for (int qg = 0; qg < 4; ++qg)
#pragma unroll
            for (int s = 0; s < 4; ++s) af[qg][s] = *(const bf16x8*)(PROJ + (rowq0 + 4 * qg + ql) * NPROJ + PC_QI + hdm * 64 + 16 * s + 8 * g);
        if (tid < 128) WQ[tid] = bf2f(PROJ[(rowq0 + (tid >> 3)) * NPROJ + PC_WI + (tid & 7)]) * 0.044194173824159216f;
        __syncthreads();
        bf16x8 bfr[4];
        { const bf16* krow = PROJ + ((size_t)b * SEQ + wv * 32 + r) * NPROJ + PC_KI + 8 * g;
#pragma unroll
          for (int s = 0; s < 4; ++s) bfr[s] = *(const bf16x8*)(krow + 16 * s); }
        for (int kt = wv; kt < N / 32; kt += NWAVES) {
            const int key = kt * 32 + r;
            bf16x8 bnx[4];
#pragma unroll
            for (int s = 0; s < 4; ++s) bnx[s] = bfr[s];
            if (kt + NWAVES < N / 32) { const bf16* krow = PROJ + ((size_t)b * SEQ + key + 32 * NWAVES) * NPROJ + PC_KI + 8 * g;
#pragma unroll
                for (int s = 0; s < 4; ++s) bnx[s] = *(const bf16x8*)(krow + 16 * s); }
#pragma unroll
            for (int qg = 0; qg < 4; ++qg) { f32x16 acc = {};
#pragma unroll
                for (int s = 0; s < 4; ++s) acc = mfma32(af[qg][s], bfr[s], acc);
#pragma unroll
                for (int qq = 0; qq < 2; ++qq) { float sc = 0.f; const f32x4 w0 = *(const f32x4*)(WQ + (4 * qg + 2 * g + qq) * 8), w1 = *(const f32x4*)(WQ + (4 * qg + 2 * g + qq) * 8 + 4);
#pragma unroll
                    for (int e = 0; e < 4; ++e) { sc = fmaf(w0[e], fmaxf(acc[8 * qq + e], 0.f), sc); sc = fmaf(w1[e], fmaxf(acc[8 * qq + 4 + e], 0.f), sc); }
                    SC[(4 * qg + 2 * g + qq) * 2048 + key] = sc; } }
#pragma unroll
            for (int s = 0; s < 4; ++s) bfr[s] = bnx[s];
        }
        __syncthreads();
        for (int q = 0; q < 2; ++q) topk_select(SC + (2 * wv + q) * 2048, N, HIST + wv * 256, SEL + (2 * wv + q) * 256, lane);
    } else {
        for (int q = 0; q < 2; ++q) for (int i = lane; i < (N > 256 ? 256 : N); i += 64) SEL[(2 * wv + q) * 256 + i] = (unsigned short)i;
    }
    __syncthreads();
    const int cnt = N > 256 ? 256 : N;
    for (int q = 0; q < 2; ++q) dsa_attend(p, b, tq0 + 2 * wv + q, SEL + (2 * wv + q) * 256, cnt, lds + wv * 8192, lane);
    __syncthreads();
}

__device__ __forceinline__ void uv_item(const Params& p, int tile, int lane) {
    bf16* PROJ = (bf16*)(p.ws + WS_PROJ); const bf16* OLAT = (const bf16*)(p.ws + WS_REGA); const bf16* WUVT = (const bf16*)(p.ws + WS_WUVT);
    const int r = lane & 31, hh = lane >> 5; const size_t row = (size_t)tile * 32 + r;
    for (int h = 0; h < 8; ++h) { bf16x8 of[8];
#pragma unroll
        for (int s = 0; s < 8; ++s) of[s] = *(const bf16x8*)(OLAT + row * 1024 + h * 128 + 16 * s + 8 * hh);
#pragma unroll
        for (int dt = 0; dt < 2; ++dt) { f32x16 acc = {}; const bf16* wrow = WUVT + (size_t)(h * 64 + dt * 32 + r) * 128 + 8 * hh;
#pragma unroll
            for (int s = 0; s < 8; ++s) { const bf16x8 a = *(const bf16x8*)(wrow + 16 * s); acc = mfma32(a, of[s], acc); }
#pragma unroll
            for (int g4 = 0; g4 < 4; ++g4) { u32x2 o; o.x = pk2(acc[4 * g4], acc[4 * g4 + 1]); o.y = pk2(acc[4 * g4 + 2], acc[4 * g4 + 3]);
                *(u32x2*)(PROJ + row * NPROJ + PC_Q + h * 64 + dt * 32 + 8 * g4 + 4 * hh) = o; } }
    }
}

enum { PH_PRO = 0, PH_HN, PH_GEMM1, PH_PREP, PH_MIX, PH_UV, PH_GOUT, PH_HN2, PH_UP, PH_DOWN, PH_COUNT };
#ifndef MK_SKIP_MIXER
#define MK_SKIP_MIXER 0
#endif
__global__ void __launch_bounds__(NWAVES * 64, 2) mk_fwd(Params p) {
    extern __shared__ __attribute__((aligned(16))) unsigned char lds[];
    cg::grid_group grid = cg::this_grid();
    const int tid = threadIdx.x, lane = tid & 63, wv = __builtin_amdgcn_readfirstlane(tid >> 6);
    const int G = gridDim.x, gw = blockIdx.x * NWAVES + wv, NGW = G * NWAVES;
    const int lo = p.ph_lo, hi = p.ph_hi;
    float* MOD = (float*)(p.ws + WS_MOD); bf16* REGA = (bf16*)(p.ws + WS_REGA); bf16* PROJ = (bf16*)(p.ws + WS_PROJ);
#ifndef MK_PHASE_MASK
#define MK_PHASE_MASK 0x3ff
#endif
#define IN(k) (((MK_PHASE_MASK >> (k)) & 1) && lo <= (k) && (k) < hi)
#define SEAM(k) do { if (IN(k) && IN((k) + 1)) grid.sync(); } while (0)
    if (IN(PH_PRO)) { phase_pro(p, lds, tid, G); }
    SEAM(PH_PRO);
    if (IN(PH_HN)) { hn_rows(p.x, p.g_mix, MOD, 0, 1024, REGA, gw, NGW, lane); }
    SEAM(PH_HN);
    if (IN(PH_GEMM1)) {
        pg8::Gemm g{REGA, (const bf16*)(p.ws + WS_WIN), M, NPROJ, DM, DM}; pg8::StaticOrder S; S.init(M, NPROJ, G, (int)blockIdx.x);
        pg8::EpiBf16<0> E{PROJ, NPROJ};
        pg8::gemm_phase<pg8::EpiBf16<0>, pg8::StaticOrder, true, true>((PG8_LAS unsigned char*)lds, g, S, E);
    }
    SEAM(PH_GEMM1);
    if (IN(PH_PREP)) {
#ifndef DBG_NO_RP
        for (int it = blockIdx.x; it < M / 64; it += G) rwkv_prep_item(p, lds, it, tid);
#endif
#ifndef DBG_NO_DP
        for (int tile = gw; tile < M / 32; tile += NGW) dsa_prep_item(p, tile, lane);
#endif
    }
    SEAM(PH_PREP);
    if (IN(PH_MIX) && MK_DBG != 4 && MK_DBG != 6 && MK_DBG != 7) {
#if !defined(DBG_NO_SCAN) && MK_DBG != 1
        for (int chain = blockIdx.x; chain < NB * 8; chain += G) { rwkv_scan_chain(p, lds, chain, wv, lane); __syncthreads(); }
#endif
#if !defined(DBG_NO_DSA) && MK_DBG != 2
        for (int k = 0; k * G < M / 16; ++k) { const int idx = (k & 1) ? (G - 1 - (int)blockIdx.x) : (int)blockIdx.x; const int it = k * G + idx; if (it < M / 16) dsa_item(p, lds, it, tid); }
#endif
    }
    SEAM(PH_MIX);
    if (IN(PH_UV) && MK_DBG != 4) {
#if MK_DBG == 7
        for (int m = gw; m < M; m += NGW) { *(u32x4*)(PROJ + (size_t)m * NPROJ + lane * 8) = *(const u32x4*)(REGA + (size_t)m * 1024 + lane * 8); }
#elif MK_DBG != 2
        for (int tile = gw; tile < M / 32; tile += NGW) uv_item(p, tile, lane);
#endif
#if MK_DBG == 0
        for (int m = gw; m < M; m += NGW) rwkv_epi_row(p, m, lane);
#endif
#if MK_DBG == 1 || MK_DBG == 2
        for (int m = gw; m < M; m += NGW) { u32x4 z = {0u, 0u, 0u, 0u}; *(u32x4*)(PROJ + (size_t)m * NPROJ + (MK_DBG == 1 ? 512 : 0) + lane * 8) = z; }
#endif
    }
    SEAM(PH_UV);
    if (IN(PH_GOUT)) {
        pg8::Gemm g{PROJ, (const bf16*)(p.ws + WS_WOUT), M, DM, DM, NPROJ}; pg8::StaticOrder S; S.init(M, DM, G, (int)blockIdx.x);
        pg8::EpiResGate E{p.x, p.out, DM, MOD + 2048, 6144};
        pg8::gemm_phase<pg8::EpiResGate, pg8::StaticOrder, true, true>((PG8_LAS unsigned char*)lds, g, S, E);
    }
    SEAM(PH_GOUT);
    if (IN(PH_HN2)) { hn_rows(MK_SKIP_MIXER ? p.x : p.out, p.g_ffn, MOD, 3072, 4096, REGA, gw, NGW, lane); }
    SEAM(PH_HN2);
    if (IN(PH_UP)) {
        pg8::Gemm g{REGA, (const bf16*)(p.ws + WS_W1), M, FF, DM, DM}; pg8::StaticOrder S; S.init(M, FF, G, (int)blockIdx.x);
        pg8::EpiBf16<1> E{(bf16*)(p.ws + WS_U), FF};
        pg8::gemm_phase<pg8::EpiBf16<1>, pg8::StaticOrder, true, true>((PG8_LAS unsigned char*)lds, g, S, E);
    }
    SEAM(PH_UP);
    if (IN(PH_DOWN)) {
        pg8::Gemm g{(const bf16*)(p.ws + WS_U), (const bf16*)(p.ws + WS_W2), M, DM, FF, FF}; pg8::StaticOrder S; S.init(M, DM, G, (int)blockIdx.x);
        pg8::EpiResGate E{MK_SKIP_MIXER ? p.x : p.out, p.out, DM, MOD + 5120, 6144};
        pg8::gemm_phase<pg8::EpiResGate, pg8::StaticOrder, true, true>((PG8_LAS unsigned char*)lds, g, S, E);
    }
#undef IN
#undef SEAM
}

#ifndef MK_N_LAUNCHES
#define MK_N_LAUNCHES 1
#endif
extern "C" void kernel_launch(void* const* d_in, const int* in_sizes, int n_in, void* d_out, int out_size, void* d_ws, size_t ws_size, hipStream_t stream) {
    static int grid = 0;
    if (grid == 0) {
        if (n_in != 26 || out_size != M * DM || ws_size < WS_END) { fprintf(stderr, "kernel_launch: unexpected shapes (n_in %d out %d ws %zu)\n", n_in, out_size, ws_size); grid = -1; return; }
        int dev = 0, cus = 0, per_cu = 0;
        hipGetDevice(&dev); hipDeviceGetAttribute(&cus, hipDeviceAttributeMultiprocessorCount, dev);
        if (hipFuncSetAttribute((const void*)mk_fwd, hipFuncAttributeMaxDynamicSharedMemorySize, LDS_BYTES) != hipSuccess) { fprintf(stderr, "kernel_launch: hipFuncSetAttribute failed\n"); grid = -1; return; }
        if (hipOccupancyMaxActiveBlocksPerMultiprocessor(&per_cu, (const void*)mk_fwd, NWAVES * 64, LDS_BYTES) != hipSuccess || per_cu < 1) { fprintf(stderr, "kernel_launch: occupancy query says %d\n", per_cu); per_cu = 1; }
        (void)hipGetLastError();
        grid = cus * 1;
        if (per_cu < 1) grid = -1;
    }
    if (grid < 0) return;
    Params p{};
    const float** pp = (const float**)&p;
    for (int i = 0; i < 26; ++i) pp[i] = (const float*)d_in[i];
    p.out = (float*)d_out; p.ws = (unsigned char*)d_ws;
#if MK_N_LAUNCHES == 1
    p.ph_lo = 0; p.ph_hi = PH_COUNT;
    void* args[] = {&p};
    hipError_t e = hipLaunchCooperativeKernel((const void*)mk_fwd, dim3(grid), dim3(NWAVES * 64), args, LDS_BYTES, stream);
    if (e != hipSuccess) fprintf(stderr, "cooperative launch failed: %s (grid %d)\n", hipGetErrorString(e), grid);
#else
    for (int ph = 0; ph < PH_COUNT; ++ph) {
#if MK_SKIP_MIXER
        if (ph >= PH_HN && ph <= PH_GOUT) continue;
#endif
        p.ph_lo = ph; p.ph_hi = ph + 1;
        hipLaunchKernelGGL(mk_fwd, dim3(grid), dim3(NWAVES * 64), LDS_BYTES, stream, p);
    }
#endif
}
```

```cpp
#include <hip/hip_runtime.h>
#include <hip/hip_cooperative_groups.h>
#include <cstdio>
#include <cstdint>
#include <cmath>
namespace cg = cooperative_groups;
#ifndef MK_DBG
#define MK_DBG 0
#endif
#ifndef MK_DBG_NOTOPK
#define MK_DBG_NOTOPK 0
#endif
namespace pg8 {
#define PG8_LAS __attribute__((address_space(3)))
typedef unsigned short bf16_t;
typedef short bf16x8 __attribute__((ext_vector_type(8)));
typedef float f32x4 __attribute__((ext_vector_type(4)));
typedef unsigned u32x4 __attribute__((ext_vector_type(4)));
constexpr int BM = 256, BK = 64, HALF = 128, HTB = HALF * BK * 2  , STAGE_BYTES = 8 * HTB, NXCD = 8, WGM = 8;

__host__ __device__ __forceinline__ int lds_byte(int r, int c) { const int st = (r >> 4) * 2 + (c >> 5), rr = r & 15, cc = c & 31, ob = rr * 64 + cc * 2; return st * 1024 + (ob ^ (((ob >> 9) & 1) << 5)); }
__host__ __device__ __forceinline__ void stage_rc(int b, int& R, int& C) { const int st = b / 1024, sb = b % 1024, swz = sb ^ (((sb >> 9) & 1) << 5); R = (st >> 1) * 16 + swz / 64; C = (st & 1) * 32 + (swz % 64) / 2; }
__host__ __device__ __forceinline__ int perm32(int rho) { const int n = rho >> 4, i = rho & 15; return 8 * (i >> 2) + 4 * n + (i & 3); }

struct Unit { int pm, pn; };
struct Gemm { const bf16_t* A; const bf16_t* Bt; int M, N, K, lda; };

struct StaticOrder {
    int nM, nN, nwg, G, c;
    __host__ __device__ void init(int M, int N, int G_, int c_) { nM = M / BM; nN = N / BM; nwg = nM * nN; G = G_; c = c_; }
    __host__ __device__ bool next(int i, Unit& u) const {
        const long L = (long)i * G + c; if (L >= nwg) return false;
        int wgid = (int)L; { const int q = nwg / NXCD, r = nwg % NXCD, xcd = wgid % NXCD, off = wgid / NXCD; wgid = (xcd < r ? xcd * (q + 1) : r * (q + 1) + (xcd - r) * q) + off; }
        const int nig = WGM * nN, gid = wgid / nig, fm = gid * WGM, gsz = (nM - fm) < WGM ? (nM - fm) : WGM;
        u.pm = fm + ((wgid % nig) % gsz); u.pn = (wgid % nig) / gsz; return true;
    }
    __device__ __forceinline__ void a_ready(const Unit&) const {}
    __device__ __forceinline__ void done(const Unit&) const {}
};


typedef float f32x2_t __attribute__((ext_vector_type(2))); typedef __bf16 bf16x2_t __attribute__((ext_vector_type(2)));
__device__ __forceinline__ unsigned cvt_pk_bf16(float lo, float hi) { const f32x2_t v = {lo, hi}; const bf16x2_t b = __builtin_convertvector(v, bf16x2_t); return __builtin_bit_cast(unsigned, b); }

template <int ACT  > struct EpiBf16 {
    static constexpr bool PERM = true, AFTER_DRAIN = false;
    bf16_t* O; int ldc;
    __device__ __forceinline__ void operator()(const f32x4 (&acc)[2][2][4][2], const Unit& u, int wr, int wc, int fr, int fq) const {
        const int row0 = u.pm * BM + wr * 64 + fr; const int col0 = u.pn * BM + wc * 32 + 8 * fq;
#pragma unroll
        for (int ai = 0; ai < 2; ++ai)
#pragma unroll
            for (int m = 0; m < 4; ++m) { bf16_t* rowp = O + (size_t)(row0 + ai * HALF + m * 16) * ldc + col0;
#pragma unroll
                for (int bj = 0; bj < 2; ++bj) { f32x4 v0 = acc[ai][bj][m][0], v1 = acc[ai][bj][m][1];
                    if (ACT == 1) {
#pragma unroll
                        for (int j = 0; j < 4; ++j) { const float a = v0[j] > 0.f ? v0[j] : 0.f, b = v1[j] > 0.f ? v1[j] : 0.f; v0[j] = a * a; v1[j] = b * b; } }
                    u32x4 w; w.x = cvt_pk_bf16(v0[0], v0[1]); w.y = cvt_pk_bf16(v0[2], v0[3]); w.z = cvt_pk_bf16(v1[0], v1[1]); w.w = cvt_pk_bf16(v1[2], v1[3]);
                    *(u32x4*)(rowp + bj * HALF) = w; } }
    }
};
__device__ __forceinline__ unsigned pk4_fp8(float a, float b, float c, float d) { int r = __builtin_amdgcn_cvt_pk_fp8_f32(a, b, 0, false); r = __builtin_amdgcn_cvt_pk_fp8_f32(c, d, r, true); return (unsigned)r; }
struct EpiF8Relu2 {
    static constexpr bool PERM = true, AFTER_DRAIN = false;
    unsigned char* O; int ldc; float scale;
    __device__ __forceinline__ void operator()(const f32x4 (&acc)[2][2][4][2], const Unit& u, int wr, int wc, int fr, int fq) const {
        const int row0 = u.pm * BM + wr * 64 + fr; const int col0 = u.pn * BM + wc * 32 + 8 * fq;
#pragma unroll
        for (int ai = 0; ai < 2; ++ai)
#pragma unroll
            for (int m = 0; m < 4; ++m) { unsigned char* rowp = O + (size_t)(row0 + ai * HALF + m * 16) * ldc + col0;
#pragma unroll
                for (int bj = 0; bj < 2; ++bj) { f32x4 v0 = acc[ai][bj][m][0], v1 = acc[ai][bj][m][1];
#pragma unroll
                    for (int j = 0; j < 4; ++j) { const float a = v0[j] > 0.f ? v0[j] : 0.f, b = v1[j] > 0.f ? v1[j] : 0.f; v0[j] = fminf(a * a * scale, 416.f); v1[j] = fminf(b * b * scale, 416.f); }
                    typedef unsigned u32x2_t __attribute__((ext_vector_type(2)));
                    u32x2_t w; w.x = pk4_fp8(v0[0], v0[1], v0[2], v0[3]); w.y = pk4_fp8(v1[0], v1[1], v1[2], v1[3]);
                    *(u32x2_t*)(rowp + bj * HALF) = w; } }
    }
};
struct EpiResGate {
    static constexpr bool PERM = false, AFTER_DRAIN = false;
    const float* base; float* out; int ldc; const float* gate; int gate_ld; float gscale;
    __device__ __forceinline__ void operator()(const f32x4 (&acc)[2][2][4][2], const Unit& u, int, int, int, int) const {
        int t_ = threadIdx.x; asm volatile("" : "+v"(t_));
        const int wr = t_ >> 8, wc = (t_ >> 6) & 3, fr = t_ & 15, fq = (t_ >> 4) & 3;
        const int row0 = u.pm * BM + wr * 64 + fr, col0 = u.pn * BM + wc * 32 + 4 * fq;
        const float* gp = gate + (size_t)(u.pm >> 3) * gate_ld + col0;
        f32x4 gv[2][2];
#pragma unroll
        for (int bj = 0; bj < 2; ++bj)
#pragma unroll
            for (int n = 0; n < 2; ++n) gv[bj][n] = *(const f32x4*)(gp + bj * HALF + n * 16) * gscale;
#pragma unroll
        for (int ai = 0; ai < 2; ++ai)
#pragma unroll
            for (int m = 0; m < 4; ++m) { const size_t off = (size_t)(row0 + ai * HALF + m * 16) * ldc + col0;
#pragma unroll
                for (int bj = 0; bj < 2; ++bj)
#pragma unroll
                    for (int n = 0; n < 2; ++n) { const f32x4 bs = *(const f32x4*)(base + off + bj * HALF + n * 16);
                        *(f32x4*)(out + off + bj * HALF + n * 16) = bs + gv[bj][n] * acc[ai][bj][m][n]; } }
    }
};
template <class Epi, class Sched, bool ALIGN_EPI = false, bool SP2 = false, bool F8 = false>
__device__ __forceinline__ void gemm_phase(PG8_LAS unsigned char* lds, const Gemm g, const Sched& S, const Epi& E) {
    const int tid = threadIdx.x, wid = __builtin_amdgcn_readfirstlane(tid >> 6), lane = tid & 63, wr = wid >> 2, wc = wid & 3, fr = lane & 15, fq = lane >> 4;
    const int K = g.K, nt = K / BK;
    unsigned voffA[2], voffB[2];
#pragma unroll
    for (int i = 0; i < 2; ++i) { int R, C; stage_rc(tid * 16 + i * 8192, R, C); const int Rb = Epi::PERM ? ((R & ~31) + perm32(R & 31)) : R;
        voffA[i] = (unsigned)(R * g.lda + C) * 2u; voffB[i] = (unsigned)(Rb * K + C) * 2u; }
    const size_t kstep = (size_t)(BK * 2);
    const size_t hstepB = (size_t)HALF * K * 2, hstepA = (size_t)HALF * g.lda * 2;
    const size_t tstepA = 2 * hstepA, tstepB = 2 * hstepB;
    const unsigned ldsw = (unsigned)wid * 1024u;
    const int f8in = (fq >> 1) * 1024 + ((fr * 64 + (fq & 1) * 32) ^ ((fr >> 3) << 5));
    const int aoff = F8 ? wr * 8192 + f8in : lds_byte(wr * 64 + fr, fq * 8), boff = F8 ? wc * 4096 + f8in : lds_byte(wc * 32 + fr, fq * 8);
    constexpr int KOFF = F8 ? 16 : 1024;
    typedef int v8i_t __attribute__((ext_vector_type(8)));
#define PG8_SA(b, h) (((b) * 2 + (h)) * HTB)
#define PG8_SB(b, h) ((4 + (b) * 2 + (h)) * HTB)
#define PG8_STAGE(bufoff, gbase, voff) do { _Pragma("unroll") for (int _i = 0; _i < 2; ++_i) \
        __builtin_amdgcn_global_load_lds((const unsigned*)((const char*)(gbase) + (voff)[_i]), (PG8_LAS unsigned*)(lds + (bufoff) + ldsw + _i * 8192), 16, 0, 0); } while (0)
#define PG8_LD32(p_) __builtin_shufflevector(*(const PG8_LAS u32x4*)(p_), *(const PG8_LAS u32x4*)((p_) + 16), 0, 1, 2, 3, 4, 5, 6, 7)
#define PG8_LDA(dst, b, h) do { if constexpr (F8) { _Pragma("unroll") for (int m = 0; m < 4; ++m) dst##8[m] = __builtin_bit_cast(v8i_t, PG8_LD32(lds + PG8_SA(b, h) + aoff + m * 2048)); } \
    else { _Pragma("unroll") for (int m = 0; m < 4; ++m) _Pragma("unroll") for (int k = 0; k < 2; ++k) dst[m][k] = *(const PG8_LAS bf16x8*)(lds + PG8_SA(b, h) + aoff + m * 2048 + k * KOFF); } } while (0)
#define PG8_LDB(dst, b, h) do { if constexpr (F8) { _Pragma("unroll") for (int n = 0; n < 2; ++n) dst##8[n] = __builtin_bit_cast(v8i_t, PG8_LD32(lds + PG8_SB(b, h) + boff + n * 2048)); } \
    else { _Pragma("unroll") for (int n = 0; n < 2; ++n) _Pragma("unroll") for (int k = 0; k < 2; ++k) dst[n][k] = *(const PG8_LAS bf16x8*)(lds + PG8_SB(b, h) + boff + n * 2048 + k * KOFF); } } while (0)
#define PG8_CAT(x) __builtin_shufflevector(__builtin_bit_cast(u32x4, (x)[0]), __builtin_bit_cast(u32x4, (x)[1]), 0, 1, 2, 3, 4, 5, 6, 7)
#define PG8_MMA(ai, bj, At, Bt) do { __builtin_amdgcn_s_setprio(1); if constexpr (F8) { _Pragma("unroll") for (int m = 0; m < 4; ++m) _Pragma("unroll") for (int n = 0; n < 2; ++n) \
        asm volatile("v_mfma_f32_16x16x128_f8f6f4 %0, %1, %2, %0" : "+v"(acc[ai][bj][m][n]) : "v"(Bt##8[n]), "v"(At##8[m])); } \
    else { _Pragma("unroll") for (int m = 0; m < 4; ++m) _Pragma("unroll") for (int n = 0; n < 2; ++n) _Pragma("unroll") for (int k = 0; k < 2; ++k) \
        acc[ai][bj][m][n] = __builtin_amdgcn_mfma_f32_16x16x32_bf16(Bt[n][k], At[m][k], acc[ai][bj][m][n], 0, 0, 0); } __builtin_amdgcn_s_setprio(0); } while (0)
#define PG8_WAIT_V(n) asm volatile("s_waitcnt vmcnt(" #n ")" ::: "memory")
#define PG8_WAIT_L(n) asm volatile("s_waitcnt lgkmcnt(" #n ")" ::: "memory")
#define PG8_BAR __builtin_amdgcn_s_barrier()
#define PG8_SCHED __builtin_amdgcn_sched_barrier(0)
    Unit cur, nxt; int ui = 0;
    if (!S.next(0, cur)) return;
    f32x4 acc[2][2][4][2];
#pragma unroll
    for (int a = 0; a < 2; ++a)
#pragma unroll
        for (int b = 0; b < 2; ++b)
#pragma unroll
            for (int m = 0; m < 4; ++m)
#pragma unroll
                for (int n = 0; n < 2; ++n) acc[a][b][m][n] = (f32x4){0.f, 0.f, 0.f, 0.f};
    bf16x8 At[4][2], B0[2][2], B1[2][2]; v8i_t At8[4], B08[2], B18[2];
    const char* cA = (const char*)g.A + (size_t)cur.pm * tstepA; const char* cB = (const char*)g.Bt + (size_t)cur.pn * tstepB;
    S.a_ready(cur);
    if constexpr (SP2) {
        PG8_STAGE(PG8_SB(0, 0), cB, voffB); PG8_STAGE(PG8_SB(0, 1), cB + hstepB, voffB); PG8_STAGE(PG8_SA(0, 0), cA, voffA); PG8_STAGE(PG8_SA(0, 1), cA + hstepA, voffA);
        if (wr == 1) PG8_BAR;
        PG8_WAIT_V(2); PG8_BAR;
        PG8_STAGE(PG8_SB(1, 0), cB + kstep, voffB); PG8_STAGE(PG8_SA(1, 0), cA + kstep, voffA); PG8_STAGE(PG8_SB(1, 1), cB + hstepB + kstep, voffB);
        PG8_WAIT_V(6); PG8_BAR;
    } else {
        PG8_STAGE(PG8_SB(0, 0), cB, voffB); PG8_STAGE(PG8_SA(0, 0), cA, voffA); PG8_STAGE(PG8_SB(0, 1), cB + hstepB, voffB); PG8_STAGE(PG8_SA(0, 1), cA + hstepA, voffA);
        if (wr == 1) PG8_BAR;
        PG8_WAIT_V(4); PG8_BAR;
        PG8_STAGE(PG8_SB(1, 0), cB + kstep, voffB); PG8_STAGE(PG8_SA(1, 0), cA + kstep, voffA); PG8_STAGE(PG8_SB(1, 1), cB + hstepB + kstep, voffB);
        PG8_WAIT_V(6); PG8_BAR;
    }
    for (;;) {
        const bool has_next = S.next(ui + 1, nxt);
        const char* nA = has_next ? (const char*)g.A + (size_t)nxt.pm * tstepA : cA; const char* nB = has_next ? (const char*)g.Bt + (size_t)nxt.pn * tstepB : cB;
        for (int t = 0; t < nt; t += 2) {
            const bool last = (t == nt - 2);
            const char* a1 = cA + (size_t)(t + 1) * kstep;
            const char* a2 = last ? nA : cA + (size_t)(t + 2) * kstep; const char* b2 = last ? nB : cB + (size_t)(t + 2) * kstep;
            const char* a3 = a2 + kstep; const char* b3 = b2 + kstep;
            if (last && has_next) S.a_ready(nxt);
            if constexpr (SP2) {
            PG8_LDB(B0, 0, 0); PG8_LDB(B1, 0, 1); PG8_SCHED; PG8_LDA(At, 0, 0); PG8_STAGE(PG8_SA(1, 1), a1 + hstepA, voffA);
            PG8_WAIT_V(8); PG8_WAIT_L(0); PG8_BAR; PG8_MMA(0, 0, At, B0); PG8_MMA(0, 1, At, B1); PG8_BAR; PG8_SCHED;
            PG8_LDA(At, 0, 1); PG8_STAGE(PG8_SB(0, 0), b2, voffB); PG8_STAGE(PG8_SB(0, 1), b2 + hstepB, voffB); PG8_STAGE(PG8_SA(0, 0), a2, voffA);
            PG8_WAIT_V(8); PG8_WAIT_L(0); PG8_BAR; PG8_MMA(1, 0, At, B0); PG8_MMA(1, 1, At, B1); PG8_BAR; PG8_SCHED;
            PG8_LDB(B0, 1, 0); PG8_LDB(B1, 1, 1); PG8_SCHED; PG8_LDA(At, 1, 0); PG8_STAGE(PG8_SA(0, 1), a2 + hstepA, voffA);
            PG8_WAIT_V(8); PG8_WAIT_L(0); PG8_BAR; PG8_MMA(0, 0, At, B0); PG8_MMA(0, 1, At, B1); PG8_BAR; PG8_SCHED;
            PG8_LDA(At, 1, 1); PG8_STAGE(PG8_SB(1, 0), b3, voffB); PG8_STAGE(PG8_SB(1, 1), b3 + hstepB, voffB); PG8_STAGE(PG8_SA(1, 0), a3, voffA);
            PG8_WAIT_V(8); PG8_WAIT_L(0); PG8_BAR; PG8_MMA(1, 0, At, B0); PG8_MMA(1, 1, At, B1); PG8_BAR; PG8_SCHED;
            } else {
            PG8_LDB(B0, 0, 0); PG8_SCHED; PG8_LDA(At, 0, 0); PG8_STAGE(PG8_SA(1, 1), a1 + hstepA, voffA);
            PG8_WAIT_L(8); PG8_BAR; PG8_WAIT_L(0); PG8_MMA(0, 0, At, B0); PG8_BAR; PG8_SCHED;
            PG8_LDB(B1, 0, 1); PG8_STAGE(PG8_SB(0, 0), b2, voffB);
            PG8_BAR; PG8_WAIT_L(0); PG8_MMA(0, 1, At, B1); PG8_BAR;
            PG8_LDA(At, 0, 1); PG8_STAGE(PG8_SA(0, 0), a2, voffA);
            PG8_BAR; PG8_WAIT_L(0); PG8_MMA(1, 0, At, B0); PG8_BAR; PG8_SCHED;
            PG8_STAGE(PG8_SB(0, 1), b2 + hstepB, voffB);
            PG8_WAIT_V(6); PG8_BAR; PG8_MMA(1, 1, At, B1); PG8_BAR;
            PG8_LDB(B0, 1, 0); PG8_SCHED; PG8_LDA(At, 1, 0); PG8_STAGE(PG8_SA(0, 1), a2 + hstepA, voffA);
            PG8_WAIT_L(8); PG8_BAR; PG8_WAIT_L(0); PG8_MMA(0, 0, At, B0); PG8_BAR; PG8_SCHED;
            PG8_LDB(B1, 1, 1); PG8_STAGE(PG8_SB(1, 0), b3, voffB);
            PG8_BAR; PG8_WAIT_L(0); PG8_MMA(0, 1, At, B1); PG8_BAR;
            PG8_LDA(At, 1, 1); PG8_STAGE(PG8_SA(1, 0), a3, voffA);
            PG8_BAR; PG8_WAIT_L(0); PG8_MMA(1, 0, At, B0); PG8_BAR; PG8_SCHED;
            PG8_STAGE(PG8_SB(1, 1), b3 + hstepB, voffB);
            PG8_WAIT_V(6); PG8_BAR; PG8_MMA(1, 1, At, B1); PG8_BAR;
            }
        }
        if constexpr (ALIGN_EPI) { if (wr == 0) PG8_BAR; }
        if constexpr (F8) asm volatile("s_nop 15\n\ts_nop 15" ::: "memory");
        if constexpr (!Epi::AFTER_DRAIN) { E(acc, cur, wr, wc, fr, fq); S.done(cur); }
        if (!has_next) break;
#pragma unroll
        for (int a = 0; a < 2; ++a)
#pragma unroll
            for (int b = 0; b < 2; ++b)
#pragma unroll
                for (int m = 0; m < 4; ++m)
#pragma unroll
                    for (int n = 0; n < 2; ++n) acc[a][b][m][n] = (f32x4){0.f, 0.f, 0.f, 0.f};
        cur = nxt; cA = nA; cB = nB; ++ui;
        if constexpr (ALIGN_EPI) { if (wr == 1) PG8_BAR; }
    }
    PG8_WAIT_V(0);
    if constexpr (!ALIGN_EPI) { if (wr == 0) PG8_BAR; }
    PG8_BAR;
    if constexpr (Epi::AFTER_DRAIN) { E.fused(acc, cur, wr, wc, fr, fq, lds, wid, lane); S.done(cur); }
#undef PG8_SA
#undef PG8_SB
#undef PG8_STAGE
#undef PG8_LDA
#undef PG8_LDB
#undef PG8_MMA
#undef PG8_CAT
#undef PG8_LD32
#undef PG8_WAIT_V
#undef PG8_WAIT_L
#undef PG8_BAR
#undef PG8_SCHED
}
}

#define LAS __attribute__((address_space(3)))
typedef unsigned short bf16;
typedef short bf16x8 __attribute__((ext_vector_type(8)));
typedef short s16x4 __attribute__((ext_vector_type(4)));
typedef float f32x4 __attribute__((ext_vector_type(4)));
typedef float f32x16 __attribute__((ext_vector_type(16)));
typedef unsigned u32x4 __attribute__((ext_vector_type(4)));
typedef unsigned u32x2 __attribute__((ext_vector_type(2)));

constexpr int NB = 32, SEQ = 2048, DM = 1024, M = NB * SEQ, NPROJ = 3072, FF = 4096;
constexpr int PC_Q = 0, PC_R = 512, PC_K = 1024, PC_V = 1536, PC_QI = 2048, PC_CL = 2560, PC_KI = 2688, PC_XW = 2752, PC_XA = 2816, PC_XG = 2880, PC_WI = 3008;
constexpr size_t MiB = 1u << 20;
constexpr size_t WS_MOD = 0, WS_WUKT = 1 * MiB, WS_WUK = WS_WUKT + 131072, WS_WUVT = WS_WUK + 131072, WS_INVR = 2 * MiB, WS_WIN = 4 * MiB, WS_WOUT = 10 * MiB,
                 WS_W1 = 12 * MiB, WS_W2 = 20 * MiB, WS_CKV = 36 * MiB, WS_GAM = 52 * MiB, WS_C3 = 60 * MiB, WS_REGA = 64 * MiB, WS_PROJ = 192 * MiB, WS_CH = 576 * MiB,
                 WS_G = 960 * MiB, WS_U = 192 * MiB, WS_END = 1024 * MiB,
                 WS_W2T = WS_WUVT + 131072, WS_A2T = WS_W2T + 65536, WS_G2T = WS_A2T + 65536;
constexpr int LDS_BYTES = 151552;
constexpr int NWAVES = 8;

struct Params {
    const float *x, *c, *w_ada, *b_ada, *g_mix, *g_ffn, *w_in, *g_q, *g_k, *g_kv, *w_uk, *w_uv, *mu, *w0, *w2, *a0, *a2, *g2, *k_k, *k_a, *r_k, *ln_w, *ln_b, *w_out, *w_ff1, *w_ff2;
    float* out; unsigned char* ws; int ph_lo, ph_hi;
};

__device__ __forceinline__ unsigned pk2(float lo, float hi) { return pg8::cvt_pk_bf16(lo, hi); }
__device__ __forceinline__ float bflo(unsigned w) { return __uint_as_float(w << 16); }
__device__ __forceinline__ float bfhi(unsigned w) { return __uint_as_float(w & 0xffff0000u); }
__device__ __forceinline__ float bf2f(bf16 h) { return __uint_as_float((unsigned)h << 16); }
__device__ __forceinline__ bf16 f2bf(float f) { return (bf16)(pk2(f, 0.f) & 0xffffu); }
__device__ __forceinline__ float wave_sum(float v) {
#pragma unroll
    for (int o = 1; o < 64; o <<= 1) v += __shfl_xor(v, o);
    return v;
}
__device__ __forceinline__ f32x16 mfma32(bf16x8 a, bf16x8 b, f32x16 c) { return __builtin_amdgcn_mfma_f32_32x32x16_bf16(a, b, c, 0, 0, 0); }
__device__ __forceinline__ f32x4 mfma16(bf16x8 a, bf16x8 b, f32x4 c) { return __builtin_amdgcn_mfma_f32_16x16x32_bf16(a, b, c, 0, 0, 0); }

__device__ __forceinline__ int win_src_col(int n) {
    if (n < 512) return n;
    if (n < 1024) return 1224 + (n - 512);
    if (n < 1536) return 1736 + (n - 1024);
    if (n < 2048) return 2248 + (n - 1536);
    if (n < 2560) return 640 + (n - 2048);
    if (n < 2688) return 512 + (n - 2560);
    if (n < 2752) return 1152 + (n - 2688);
    if (n < 2816) return 2760 + (n - 2752);
    if (n < 2880) return 2824 + (n - 2816);
    if (n < 3008) return 2888 + (n - 2880);
    if (n < 3016) return 1216 + (n - 3008);
    return -1;
}
__device__ __forceinline__ void conv_t_item(const float* W, int K, int Nsrc, bf16* WT, int nblk, int item, float* scr, int lane, bool is_win) {
    const int kb = item / nblk, nb = item % nblk, k0 = 64 * kb, n0 = 32 * nb;
    int ns = n0 + (lane & 31); if (is_win) ns = win_src_col(ns);
#pragma unroll 8
    for (int i = 0; i < 32; ++i) { const int kk = 2 * i + (lane >> 5); scr[kk * 33 + (lane & 31)] = ns >= 0 ? W[(size_t)(k0 + kk) * Nsrc + ns] : 0.f; }
    asm volatile("s_waitcnt lgkmcnt(0)" ::: "memory");
    const int c = lane & 7;
#pragma unroll
    for (int j = 0; j < 4; ++j) { const int n = (lane >> 3) + 8 * j; const float* s = scr + (8 * c) * 33 + n;
        u32x4 o; o.x = pk2(s[0 * 33], s[1 * 33]); o.y = pk2(s[2 * 33], s[3 * 33]); o.z = pk2(s[4 * 33], s[5 * 33]); o.w = pk2(s[6 * 33], s[7 * 33]);
        *(u32x4*)(WT + (size_t)(n0 + n) * K + k0 + 8 * c) = o; }
    asm volatile("s_waitcnt lgkmcnt(0)" ::: "memory");
}
__device__ __forceinline__ void conv_t_item_f8(const float* W, int K, int N, unsigned char* WT, int nblk, int item, float* scr, int lane, float scale) {
    const int kb = item / nblk, nb = item % nblk, k0 = 64 * kb, n0 = 32 * nb;
#pragma unroll 8
    for (int i = 0; i < 32; ++i) { const int kk = 2 * i + (lane >> 5); scr[kk * 33 + (lane & 31)] = W[(size_t)(k0 + kk) * N + n0 + (lane & 31)] * scale; }
    asm volatile("s_waitcnt lgkmcnt(0)" ::: "memory");
    const int c = lane & 7;
#pragma unroll
    for (int j = 0; j < 4; ++j) { const int n = (lane >> 3) + 8 * j; const float* s = scr + (8 * c) * 33 + n;
        u32x2 o; o.x = pg8::pk4_fp8(s[0 * 33], s[1 * 33], s[2 * 33], s[3 * 33]); o.y = pg8::pk4_fp8(s[4 * 33], s[5 * 33], s[6 * 33], s[7 * 33]);
        *(u32x2*)(WT + (size_t)(n0 + n) * K + k0 + 8 * c) = o; }
    asm volatile("s_waitcnt lgkmcnt(0)" ::: "memory");
}
__device__ __forceinline__ void adaln_block(const Params& p, float* ldsf, int cb, int tid) {
    const int lane = tid & 63, wv = tid >> 6, e = cb * 64 + lane;
    float* SC = ldsf; float* RED = ldsf + 16384; float* mod = (float*)(p.ws + WS_MOD);
    for (int half = 0; half < 2; ++half) {
        const int b0 = half * 16;
        for (int i = tid; i < 16384; i += 512) { const float cv = p.c[b0 * 1024 + i]; SC[i] = cv / (1.f + __expf(-cv)); }
        __syncthreads();
        float acc[16];
#pragma unroll
        for (int bb = 0; bb < 16; ++bb) acc[bb] = 0.f;
        for (int d = wv * 128; d < wv * 128 + 128; d += 4) {
            const float w0 = p.w_ada[(size_t)d * 6144 + e], w1 = p.w_ada[(size_t)(d + 1) * 6144 + e], w2 = p.w_ada[(size_t)(d + 2) * 6144 + e], w3 = p.w_ada[(size_t)(d + 3) * 6144 + e];
#pragma unroll
            for (int bb = 0; bb < 16; ++bb) { const f32x4 s = *(const f32x4*)(SC + bb * 1024 + d); acc[bb] += (s.x * w0 + s.y * w1) + (s.z * w2 + s.w * w3); }
        }
#pragma unroll
        for (int bb = 0; bb < 16; ++bb) RED[(wv * 16 + bb) * 64 + lane] = acc[bb];
        __syncthreads();
#pragma unroll
        for (int q = 0; q < 2; ++q) { const int bb = wv * 2 + q; float s = p.b_ada[e];
#pragma unroll
            for (int ww = 0; ww < 8; ++ww) s += RED[(ww * 16 + bb) * 64 + lane];
            mod[(size_t)(b0 + bb) * 6144 + e] = s; }
        __syncthreads();
    }
}
__device__ __forceinline__ void phase_pro(const Params& p, unsigned char* lds, int tid, int G) {
    const int lane = tid & 63, wv = tid >> 6;
    for (int cb = blockIdx.x; cb < 96; cb += G) adaln_block(p, (float*)lds, cb, tid);
    __syncthreads();
    float* scr = (float*)lds + wv * (64 * 33 + 16);
    const int gw = blockIdx.x * NWAVES + wv, NGW = G * NWAVES;
    bf16* WIN = (bf16*)(p.ws + WS_WIN); bf16* WOUT = (bf16*)(p.ws + WS_WOUT); bf16* W1 = (bf16*)(p.ws + WS_W1); bf16* W2 = (bf16*)(p.ws + WS_W2);
    bf16* WUKT = (bf16*)(p.ws + WS_WUKT); bf16* WUK = (bf16*)(p.ws + WS_WUK); bf16* WUVT = (bf16*)(p.ws + WS_WUVT);
    constexpr int I_IN = (DM / 64) * (NPROJ / 32), I_OUT = (DM / 64) * (DM / 32), I_1 = (DM / 64) * (FF / 32), I_2 = (FF / 64) * (DM / 32), I_UK = (128 / 64) * (512 / 32);
    constexpr int I_LR = 512 / 32;
    constexpr int NITEMS = I_IN + I_OUT + I_1 + I_2 + 2 * I_UK + 4 * I_LR;
    for (int it = gw; it < NITEMS; it += NGW) {
        int r = it;
        if (r < I_IN) { conv_t_item(p.w_in, DM, 3016, WIN, NPROJ / 32, r, scr, lane, true); continue; } r -= I_IN;
        if (r < I_OUT) { conv_t_item(p.w_out, DM, DM, WOUT, DM / 32, r, scr, lane, false); continue; } r -= I_OUT;
        if (r < I_1) { conv_t_item(p.w_ff1, DM, FF, W1, FF / 32, r, scr, lane, false); continue; } r -= I_1;
        if (r < I_2) { conv_t_item_f8(p.w_ff2, FF, DM, (unsigned char*)W2, DM / 32, r, scr, lane, 64.f); continue; } r -= I_2;
        if (r < I_UK) { conv_t_item(p.w_uk, 128, 512, WUKT, 512 / 32, r, scr, lane, false); continue; } r -= I_UK;
        if (r < I_UK) { conv_t_item(p.w_uv, 128, 512, WUVT, 512 / 32, r, scr, lane, false); continue; } r -= I_UK;
        if (r < I_LR) { conv_t_item(p.w2, 64, 512, (bf16*)(p.ws + WS_W2T), 512 / 32, r, scr, lane, false); continue; } r -= I_LR;
        if (r < I_LR) { conv_t_item(p.a2, 64, 512, (bf16*)(p.ws + WS_A2T), 512 / 32, r, scr, lane, false); continue; } r -= I_LR;
        conv_t_item(p.g2, 128, 512, (bf16*)(p.ws + WS_G2T), 512 / 32, r, scr, lane, false);
    }
    for (int i = blockIdx.x * 512 + tid; i < 128 * 512 / 2; i += G * 512) { const float a = p.w_uk[2 * i], b = p.w_uk[2 * i + 1]; ((unsigned*)WUK)[i] = pk2(a, b); }
}

__device__ __forceinline__ void hn_rows(const float* src, const float* g, const float* mod, int off_sh, int off_sc, bf16* dst, int gw, int NGW, int lane) {
    for (int m = gw; m < M; m += NGW) {
        const f32x4* xr = (const f32x4*)(src + (size_t)m * DM) + lane;
        f32x4 v[4]; float s = 0.f;
#pragma unroll
        for (int j = 0; j < 4; ++j) { v[j] = xr[64 * j]; s += (v[j].x * v[j].x + v[j].y * v[j].y) + (v[j].z * v[j].z + v[j].w * v[j].w); }
        s = wave_sum(s); const float rstd = rsqrtf(s * (1.f / DM) + 1e-6f);
        const float* mb = mod + (size_t)(m >> 11) * 6144;
        unsigned long long* o8 = (unsigned long long*)(dst + (size_t)m * DM) + lane;
#pragma unroll
        for (int j = 0; j < 4; ++j) { const int col = 4 * lane + 256 * j;
            const f32x4 gg = *(const f32x4*)(g + col), sc = *(const f32x4*)(mb + off_sc + col), sh = *(const f32x4*)(mb + off_sh + col);
            const f32x4 y = v[j] * rstd * gg * (1.f + sc) + sh;
            o8[64 * j] = (unsigned long long)pk2(y.x, y.y) | ((unsigned long long)pk2(y.z, y.w) << 32); }
    }
}

typedef short s16x4 __attribute__((ext_vector_type(4)));
__device__ __forceinline__ f32x4 mfma16k(s16x4 a, s16x4 b, f32x4 c) { return __builtin_amdgcn_mfma_f32_16x16x16bf16_1k(a, b, c, 0, 0, 0); }
__device__ __forceinline__ s16x4 pack4(f32x4 v) { u32x2 o; o.x = pk2(v[0], v[1]); o.y = pk2(v[2], v[3]); return __builtin_bit_cast(s16x4, o); }

__device__ __forceinline__ void rwkv_prep_item(const Params& p, unsigned char* lds, int it, int tid_in) {
    int tid = tid_in; asm volatile("" : "+v"(tid));
    const int lane = tid & 63, wv = __builtin_amdgcn_readfirstlane(tid >> 6);
    bf16* XS = (bf16*)lds;
    bf16* LO = (bf16*)(lds + 16384) + wv * 2048;
    bf16* STG = (bf16*)(lds + 49152) + wv * 4096;
    float* MAB = (float*)(lds + 114688) + wv * 256;
    bf16* RKV = (bf16*)(lds + 122880) + wv * 1728;
    const bf16* PROJ = (const bf16*)(p.ws + WS_PROJ);
    const bf16* W2T = (const bf16*)(p.ws + WS_W2T); const bf16* A2T = (const bf16*)(p.ws + WS_A2T); const bf16* G2T = (const bf16*)(p.ws + WS_G2T);
    float* GAM = (float*)(p.ws + WS_GAM); float* C3 = (float*)(p.ws + WS_C3); bf16* GB = (bf16*)(p.ws + WS_G);
    const int row0 = it * 64, t0 = (it & 31) * 64, b = it >> 5;
    const int c = wv * 64 + lane;
    const float mu_r = p.mu[c], mu_k = p.mu[512 + c], mu_v = p.mu[1024 + c];
    const float w0c = p.w0[c], a0c = p.a0[c], kkc = p.k_k[c], kac = p.k_a[c], rkc = p.r_k[c];
    const int xt = tid >> 5, xch = tid & 31;
    u32x4 xcur, xprv;
#define XS_LOAD(rowbase, tbase) do { const bf16* src_ = PROJ + (size_t)((rowbase) + xt) * NPROJ + PC_XW + 8 * xch; xcur = *(const u32x4*)src_; \
        xprv = (u32x4){0u, 0u, 0u, 0u}; if ((tbase) + xt != 0) xprv = *(const u32x4*)(src_ - NPROJ); } while (0)
#define XS_WRITE(buf) do { const f32x4 m0_ = *(const f32x4*)(p.mu + 1536 + 8 * xch), m1_ = *(const f32x4*)(p.mu + 1536 + 8 * xch + 4); const float sc_ = xch < 8 ? 2.f : -1.f; float o_[8]; \
        _Pragma("unroll") for (int i = 0; i < 4; ++i) { const float c0_ = bflo(xcur[i]), c1_ = bfhi(xcur[i]), p0_ = bflo(xprv[i]), p1_ = bfhi(xprv[i]); \
            const float ma_ = i < 2 ? m0_[2 * i] : m1_[2 * i - 4], mb_ = i < 2 ? m0_[2 * i + 1] : m1_[2 * i - 3]; \
            const float v0_ = c0_ + ma_ * (p0_ - c0_), v1_ = c1_ + mb_ * (p1_ - c1_); \
            const float r0_ = 1.f / (1.f + __expf(sc_ * v0_)), r1_ = 1.f / (1.f + __expf(sc_ * v1_)); \
            o_[2 * i] = xch < 8 ? 1.f - 2.f * r0_ : (xch < 16 ? v0_ : r0_); o_[2 * i + 1] = xch < 8 ? 1.f - 2.f * r1_ : (xch < 16 ? v1_ : r1_); } \
        *(u32x4*)(XS + (buf) * 4096 + xt * 256 + 8 * xch) = (u32x4){pk2(o_[0], o_[1]), pk2(o_[2], o_[3]), pk2(o_[4], o_[5]), pk2(o_[6], o_[7])}; } while (0)
    u32x4 RK[4];
#define RKV_LOAD(rowb, tb) do { _Pragma("unroll") for (int i = 0; i < 4; ++i) { const int id_ = i * 64 + lane, mat_ = id_ / 72, rem_ = id_ - 72 * mat_, rw_ = rem_ >> 3, ch_ = rem_ & 7; \
        RK[i] = (u32x4){0u, 0u, 0u, 0u}; if (id_ < 216 && (tb) - 1 + rw_ >= 0) RK[i] = *(const u32x4*)(PROJ + (size_t)((rowb) - 1 + rw_) * NPROJ + PC_R + 512 * mat_ + wv * 64 + 8 * ch_); } } while (0)
#define RKV_WRITE() do { _Pragma("unroll") for (int i = 0; i < 4; ++i) { const int id_ = i * 64 + lane, mat_ = id_ / 72, rem_ = id_ - 72 * mat_, rw_ = rem_ >> 3, ch_ = rem_ & 7; \
        if (id_ < 216) *(u32x4*)(RKV + mat_ * 576 + rw_ * 64 + 8 * ch_) = RK[i]; } } while (0)
    XS_LOAD(row0, t0); XS_WRITE(0);
    __syncthreads();
#pragma unroll 1
    for (int q = 0; q < 4; ++q) {
        const int rowq = row0 + 16 * q, tq = t0 + 16 * q;
        int lane_ = lane; asm volatile("" : "+v"(lane_));
        const int n_ = lane_ & 15, grp_ = lane_ >> 4;
        const size_t idx = (size_t)(b * 8 + wv) * 128 + (tq >> 4);
        unsigned char* CHp = p.ws + WS_CH + idx * 12288;
        const bf16* XSq = XS + (q & 1) * 4096;
        RKV_LOAD(rowq, tq);
        if (q < 3) XS_LOAD(rowq + 16, tq + 16);
        {   bf16x8 xa[8];
#pragma unroll
            for (int ks = 0; ks < 8; ++ks) xa[ks] = *(const bf16x8*)(XSq + n_ * 256 + 32 * ks + 8 * grp_);
#pragma unroll
            for (int ct = 0; ct < 4; ++ct) { const int cc = wv * 64 + 16 * ct + n_;
                f32x4 dw = {0.f, 0.f, 0.f, 0.f}, da = dw, dg = dw;
#pragma unroll
                for (int ks = 0; ks < 2; ++ks) dw = mfma16(xa[ks], *(const bf16x8*)(W2T + cc * 64 + 32 * ks + 8 * grp_), dw);
#pragma unroll
                for (int ks = 0; ks < 2; ++ks) da = mfma16(xa[2 + ks], *(const bf16x8*)(A2T + cc * 64 + 32 * ks + 8 * grp_), da);
#pragma unroll
                for (int ks = 0; ks < 4; ++ks) dg = mfma16(xa[4 + ks], *(const bf16x8*)(G2T + cc * 128 + 32 * ks + 8 * grp_), dg);
#pragma unroll
                for (int rg = 0; rg < 4; ++rg) { const int o = (4 * grp_ + rg) * 64 + 16 * ct + n_; LO[o] = f2bf(dw[rg]); LO[1024 + o] = f2bf(da[rg]);
                    GB[(size_t)(rowq + 4 * grp_ + rg) * 512 + cc] = f2bf(dg[rg]); } }
        }
        RKV_WRITE();
        if (q < 3) XS_WRITE((q + 1) & 1);
        asm volatile("s_waitcnt lgkmcnt(0)" ::: "memory");
        {   float gam = 1.f; unsigned btp[8], ktp[8], vtp[8]; float be = 0.f, ke = 0.f, ve = 0.f;
#pragma unroll
            for (int hf = 0; hf < 2; ++hf) {
                float rr_[8], vv_[8], ww_[8], aa_[8], kkv_[8], kpr_[8], nrm_[8], c3_[8];
                if (hf == 0) RKV_LOAD(rowq + 8, tq + 8);
#pragma unroll
                for (int tt = 0; tt < 8; ++tt) { const int t = 8 * hf + tt;
                    const float rp = bf2f(RKV[tt * 64 + lane_]), rc = bf2f(RKV[(tt + 1) * 64 + lane_]);
                    const float kp = bf2f(RKV[576 + tt * 64 + lane_]), kc = bf2f(RKV[576 + (tt + 1) * 64 + lane_]);
                    const float vp = bf2f(RKV[1152 + tt * 64 + lane_]), vc = bf2f(RKV[1152 + (tt + 1) * 64 + lane_]);
                    const float r = rc + mu_r * (rp - rc), k = kc + mu_k * (kp - kc); vv_[tt] = vc + mu_v * (vp - vc);
                    const float lw = bf2f(LO[t * 64 + lane_]), la = bf2f(LO[1024 + t * 64 + lane_]);
                    const float u = w0c + lw; const float wlog = -__logf(1.f + __expf(-u)) - 0.5f; ww_[tt] = __expf(-__expf(wlog));
                    const float a = 1.f / (1.f + __expf(-(a0c + la))); aa_[tt] = a; rr_[tt] = r;
                    kkv_[tt] = k * kkc; kpr_[tt] = k * (1.f + (a - 1.f) * kac);
                    nrm_[tt] = kkv_[tt] * kkv_[tt]; c3_[tt] = r * kpr_[tt] * rkc; }
                asm volatile("s_waitcnt lgkmcnt(0)" ::: "memory");
                if (hf == 0) RKV_WRITE();
#pragma unroll
                for (int o = 1; o < 64; o <<= 1) {
#pragma unroll
                    for (int tt = 0; tt < 8; ++tt) { nrm_[tt] += __shfl_xor(nrm_[tt], o); c3_[tt] += __shfl_xor(c3_[tt], o); } }
#pragma unroll
                for (int tt = 0; tt < 8; ++tt) { const int t = 8 * hf + tt;
                    const float kk = kkv_[tt] / fmaxf(sqrtf(nrm_[tt]), 1e-12f);
                    const float gprev = gam; gam *= ww_[tt]; const float ig = 1.f / gam;
                    STG[t * 64 + lane_] = f2bf(-kk * gprev); STG[1024 + t * 64 + lane_] = f2bf(rr_[tt] * gam);
                    const float bt = kk * aa_[tt] * ig, kt = kpr_[tt] * ig;
                    STG[2048 + t * 64 + lane_] = f2bf(bt); STG[3072 + t * 64 + lane_] = f2bf(kt);
                    if (t & 1) { btp[t >> 1] = pk2(be, bt); ktp[t >> 1] = pk2(ke, kt); vtp[t >> 1] = pk2(ve, vv_[tt]); } else { be = bt; ke = kt; ve = vv_[tt]; }
                    if (lane_ == 0) C3[(size_t)(rowq + t) * 8 + wv] = c3_[tt]; }
            }
            *(u32x4*)(CHp + 4096 + lane_ * 32) = (u32x4){btp[0], btp[1], btp[2], btp[3]}; *(u32x4*)(CHp + 4096 + lane_ * 32 + 16) = (u32x4){btp[4], btp[5], btp[6], btp[7]};
            *(u32x4*)(CHp + 6144 + lane_ * 32) = (u32x4){ktp[0], ktp[1], ktp[2], ktp[3]}; *(u32x4*)(CHp + 6144 + lane_ * 32 + 16) = (u32x4){ktp[4], ktp[5], ktp[6], ktp[7]};
            *(u32x4*)(CHp + 8192 + lane_ * 32) = (u32x4){vtp[0], vtp[1], vtp[2], vtp[3]}; *(u32x4*)(CHp + 8192 + lane_ * 32 + 16) = (u32x4){vtp[4], vtp[5], vtp[6], vtp[7]};
            GAM[idx * 64 + lane_] = gam;
        }
        asm volatile("s_waitcnt lgkmcnt(0)" ::: "memory");
        {   f32x4 mab = {0.f, 0.f, 0.f, 0.f}, mak = mab, nrb = mab, nrk = mab;
#pragma unroll
            for (int ks = 0; ks < 4; ++ks) { const int o = n_ * 64 + 16 * ks + 4 * grp_;
                const s16x4 fa = *(const s16x4*)(STG + o), fr = *(const s16x4*)(STG + 1024 + o), fb = *(const s16x4*)(STG + 2048 + o), fk = *(const s16x4*)(STG + 3072 + o);
                mab = mfma16k(fa, fb, mab); mak = mfma16k(fa, fk, mak); nrb = mfma16k(fr, fb, nrb); nrk = mfma16k(fr, fk, nrk); }
            asm volatile("s_waitcnt lgkmcnt(0)" ::: "memory");
            bf16* SM = STG + 2048;
#pragma unroll
            for (int rg = 0; rg < 4; ++rg) { const int t = 4 * grp_ + rg; const bool sl = t > n_, il = t >= n_;
                MAB[t * 16 + n_] = sl ? mab[rg] : 0.f;
                SM[256 + t * 16 + n_] = f2bf(sl ? mak[rg] : 0.f); SM[512 + t * 16 + n_] = f2bf(il ? nrb[rg] : 0.f); SM[768 + t * 16 + n_] = f2bf(il ? nrk[rg] : 0.f); }
            asm volatile("s_waitcnt lgkmcnt(0)" ::: "memory");
            if (lane_ < 16) {
                float Tc[16];
#pragma unroll
                for (int t = 0; t < 16; ++t) { float acc = (t == lane_) ? 1.f : 0.f;
#pragma unroll
                    for (int s = 0; s < t; ++s) acc = fmaf(MAB[t * 16 + s], Tc[s], acc);
                    Tc[t] = acc; SM[t * 16 + lane_] = f2bf(acc); }
            }
            asm volatile("s_waitcnt lgkmcnt(0)" ::: "memory");
#pragma unroll
            for (int i = 0; i < 4; ++i) { const int id = i * 64 + lane_; *(u32x4*)(CHp + id * 16) = *(const u32x4*)((const unsigned char*)STG + id * 16); }
#pragma unroll
            for (int i = 0; i < 2; ++i) { const int id = i * 64 + lane_; *(u32x4*)(CHp + 10240 + id * 16) = *(const u32x4*)((const unsigned char*)SM + id * 16); }
        }
        __syncthreads();
    }
#undef XS_LOAD
#undef XS_WRITE
#undef RKV_LOAD
#undef RKV_WRITE
}

__device__ __forceinline__ void dsa_prep_item(const Params& p, int tile, int lane) {
    const bf16* PROJ = (const bf16*)(p.ws + WS_PROJ); bf16* CKV = (bf16*)(p.ws + WS_CKV); float* INVR = (float*)(p.ws + WS_INVR); bf16* QABS = (bf16*)(p.ws + WS_REGA);
    const bf16* WUKT = (const bf16*)(p.ws + WS_WUKT); const bf16* WUK = (const bf16*)(p.ws + WS_WUK);
    const int r = lane & 31, hh = lane >> 5; const size_t row = (size_t)tile * 32 + r; const bf16* prow = PROJ + row * NPROJ;
    bf16x8 cf[8];
    {   u32x4 craw[8]; float ssq = 0.f;
#pragma unroll
        for (int s = 0; s < 8; ++s) { craw[s] = *(const u32x4*)(prow + PC_CL + 16 * s + 8 * hh);
#pragma unroll
            for (int w = 0; w < 4; ++w) { const float lo = bflo(craw[s][w]), hi = bfhi(craw[s][w]); ssq += lo * lo + hi * hi; } }
        ssq += __shfl_xor(ssq, 32);
        const float rstd = rsqrtf(ssq * (1.f / 128.f) + 1e-6f);
#pragma unroll
        for (int s = 0; s < 8; ++s) { const float* g = p.g_kv + 16 * s + 8 * hh; const f32x4 g0 = *(const f32x4*)g, g1 = *(const f32x4*)(g + 4);
            u32x4 o; o.x = pk2(bflo(craw[s].x) * rstd * g0.x, bfhi(craw[s].x) * rstd * g0.y); o.y = pk2(bflo(craw[s].y) * rstd * g0.z, bfhi(craw[s].y) * rstd * g0.w);
            o.z = pk2(bflo(craw[s].z) * rstd * g1.x, bfhi(craw[s].z) * rstd * g1.y); o.w = pk2(bflo(craw[s].w) * rstd * g1.z, bfhi(craw[s].w) * rstd * g1.w);
            cf[s] = __builtin_bit_cast(bf16x8, o); *(u32x4*)(CKV + row * 128 + 16 * s + 8 * hh) = o; }
    }
    for (int h = 0; h < 8; ++h) { float ss = 0.f;
#pragma unroll
        for (int dt = 0; dt < 2; ++dt) { f32x16 acc = {}; const bf16* wrow = WUKT + (size_t)(h * 64 + dt * 32 + r) * 128 + 8 * hh;
#pragma unroll
            for (int s = 0; s < 8; ++s) { const bf16x8 a = *(const bf16x8*)(wrow + 16 * s); acc = mfma32(a, cf[s], acc); }
#pragma unroll
            for (int i = 0; i < 16; ++i) ss += acc[i] * acc[i]; }
        ss += __shfl_xor(ss, 32);
        if (hh == 0) INVR[row * 8 + h] = rsqrtf(ss * (1.f / 64.f) + 1e-6f);
    }
    for (int h = 0; h < 8; ++h) {
        u32x4 qraw[4]; float ssq = 0.f;
#pragma unroll
        for (int s = 0; s < 4; ++s) { qraw[s] = *(const u32x4*)(prow + PC_Q + h * 64 + 16 * s + 8 * hh);
#pragma unroll
            for (int w = 0; w < 4; ++w) { const float lo = bflo(qraw[s][w]), hi = bfhi(qraw[s][w]); ssq += lo * lo + hi * hi; } }
        ssq += __shfl_xor(ssq, 32);
        const float rstd = rsqrtf(ssq * (1.f / 64.f) + 1e-6f);
        bf16x8 qf[4];
#pragma unroll
        for (int s = 0; s < 4; ++s) { const int d0 = 16 * s + 8 * hh; float gg[8];
#pragma unroll
            for (int j = 0; j < 8; ++j) gg[j] = p.g_q[d0 + j] * p.g_k[d0 + j] * rstd;
            u32x4 o; o.x = pk2(bflo(qraw[s].x) * gg[0], bfhi(qraw[s].x) * gg[1]); o.y = pk2(bflo(qraw[s].y) * gg[2], bfhi(qraw[s].y) * gg[3]);
            o.z = pk2(bflo(qraw[s].z) * gg[4], bfhi(qraw[s].z) * gg[5]); o.w = pk2(bflo(qraw[s].w) * gg[6], bfhi(qraw[s].w) * gg[7]);
            qf[s] = __builtin_bit_cast(bf16x8, o); }
#pragma unroll
        for (int lt = 0; lt < 4; ++lt) { f32x16 acc = {}; const bf16* wrow = WUK + (size_t)(lt * 32 + r) * 512 + h * 64 + 8 * hh;
#pragma unroll
            for (int s = 0; s < 4; ++s) { const bf16x8 a = *(const bf16x8*)(wrow + 16 * s); acc = mfma32(a, qf[s], acc); }
#pragma unroll
            for (int g4 = 0; g4 < 4; ++g4) { u32x2 o; o.x = pk2(acc[4 * g4] * 0.125f, acc[4 * g4 + 1] * 0.125f); o.y = pk2(acc[4 * g4 + 2] * 0.125f, acc[4 * g4 + 3] * 0.125f);
                *(u32x2*)(QABS + row * 1024 + h * 128 + lt * 32 + 8 * g4 + 4 * hh) = o; } }
    }
}

constexpr int SCAN_D = 8, SCAN_SLOT = 12288 + 256;
#define SCAN_BAR() do { asm volatile("s_waitcnt lgkmcnt(0)" ::: "memory"); __builtin_amdgcn_s_barrier(); asm volatile("" ::: "memory"); } while (0)
__device__ __forceinline__ void rwkv_scan_chain(const Params& p, unsigned char* lds, int chain, int wv, int lane) {
    const int b = chain >> 3, h = chain & 7;
    const size_t idx0 = (size_t)(b * 8 + h) * 128;
    if (wv >= 4) {
        const int li = (wv - 4) * 64 + lane;
        const unsigned char* src = p.ws + WS_CH + idx0 * 12288 + (size_t)li * 16; const float* gsrc = (const float*)(p.ws + WS_GAM) + idx0 * 64 + (li & 15) * 4;
        u32x4 R[SCAN_D][3]; f32x4 Rg[SCAN_D];
#pragma unroll
        for (int j = 0; j < SCAN_D; ++j) {
#pragma unroll
            for (int i = 0; i < 3; ++i) R[j][i] = *(const u32x4*)(src + (size_t)j * 12288 + i * 4096);
            Rg[j] = *(const f32x4*)(gsrc + (size_t)j * 64); }
        for (int k0 = 0; k0 < 128; k0 += SCAN_D) {
#pragma unroll
            for (int j = 0; j < SCAN_D; ++j) { const int k = k0 + j; unsigned char* slot = lds + (k & 1) * SCAN_SLOT;
#pragma unroll
                for (int i = 0; i < 3; ++i) *(u32x4*)(slot + li * 16 + i * 4096) = R[j][i];
                *(f32x4*)(slot + 12288 + (li & 15) * 16) = Rg[j];
                if (k + SCAN_D < 128) {
#pragma unroll
                    for (int i = 0; i < 3; ++i) R[j][i] = *(const u32x4*)(src + (size_t)(k + SCAN_D) * 12288 + i * 4096);
                    Rg[j] = *(const f32x4*)(gsrc + (size_t)(k + SCAN_D) * 64); }
                SCAN_BAR(); } }
    } else {
        const int w = wv, n = lane & 15, grp = lane >> 4;
        bf16* PROJ = (bf16*)(p.ws + WS_PROJ);
        f32x4 S[4];
#pragma unroll
        for (int jt = 0; jt < 4; ++jt) S[jt] = (f32x4){0.f, 0.f, 0.f, 0.f};
        for (int sc = 0; sc < 128; ++sc) {
            SCAN_BAR();
            const unsigned char* CHp = lds + (sc & 1) * SCAN_SLOT;
            s16x4 at[4], rt[4], bt[4], kt[4]; f32x4 gm[4];
#pragma unroll
            for (int jt = 0; jt < 4; ++jt) {
                at[jt] = *(const s16x4*)(CHp + n * 128 + (16 * jt + 4 * grp) * 2); rt[jt] = *(const s16x4*)(CHp + 2048 + n * 128 + (16 * jt + 4 * grp) * 2);
                bt[jt] = *(const s16x4*)(CHp + 4096 + (16 * jt + n) * 32 + grp * 8); kt[jt] = *(const s16x4*)(CHp + 6144 + (16 * jt + n) * 32 + grp * 8);
                gm[jt] = *(const f32x4*)(CHp + 12288 + (16 * jt + 4 * grp) * 4); }
            const s16x4 vt = *(const s16x4*)(CHp + 8192 + (16 * w + n) * 32 + grp * 8);
            const s16x4 Tm = *(const s16x4*)(CHp + 10240 + n * 32 + grp * 8), Mak = *(const s16x4*)(CHp + 10752 + n * 32 + grp * 8);
            const s16x4 Nrb = *(const s16x4*)(CHp + 11264 + n * 32 + grp * 8), Nrk = *(const s16x4*)(CHp + 11776 + n * 32 + grp * 8);
            s16x4 Sb[4];
#pragma unroll
            for (int jt = 0; jt < 4; ++jt) Sb[jt] = pack4(S[jt]);
            f32x4 X = {0.f, 0.f, 0.f, 0.f}, O = X;
#pragma unroll
            for (int jt = 0; jt < 4; ++jt) X = mfma16k(at[jt], Sb[jt], X);
            X = mfma16k(Mak, vt, X);
#pragma unroll
            for (int jt = 0; jt < 4; ++jt) O = mfma16k(rt[jt], Sb[jt], O);
            O = mfma16k(Nrk, vt, O);
            const f32x4 U = mfma16k(Tm, pack4(X), (f32x4){0.f, 0.f, 0.f, 0.f});
            const s16x4 Ub = pack4(U);
            O = mfma16k(Nrb, Ub, O);
#pragma unroll
            for (int jt = 0; jt < 4; ++jt) { S[jt] = mfma16k(kt[jt], vt, S[jt]); S[jt] = mfma16k(bt[jt], Ub, S[jt]); S[jt] = S[jt] * gm[jt]; }
            bf16* orow = PROJ + ((size_t)b * SEQ + sc * 16 + 4 * grp) * NPROJ + PC_R + h * 64 + 16 * w + n;
#pragma unroll
            for (int rg = 0; rg < 4; ++rg) orow[(size_t)rg * NPROJ] = f2bf(O[rg]);
        }
    }
}
__device__ __forceinline__ void rwkv_epi_row(const Params& p, int m, int lane) {
    bf16* PROJ = (bf16*)(p.ws + WS_PROJ); const bf16* GB = (const bf16*)(p.ws + WS_G); const float* C3 = (const float*)(p.ws + WS_C3);
    bf16* prow = PROJ + (size_t)m * NPROJ; const int c0 = lane * 8, h = lane >> 3; const bool first = (m & (SEQ - 1)) == 0;
    const u32x4 oraw = *(const u32x4*)(prow + PC_R + c0), vc = *(const u32x4*)(prow + PC_V + c0), gr = *(const u32x4*)(GB + (size_t)m * 512 + c0);
    u32x4 vpv = {0u, 0u, 0u, 0u}; if (!first) vpv = *(const u32x4*)(prow - NPROJ + PC_V + c0);
    float o[8], v[8], g[8];
#pragma unroll
    for (int i = 0; i < 4; ++i) { o[2 * i] = bflo(oraw[i]); o[2 * i + 1] = bfhi(oraw[i]); g[2 * i] = bflo(gr[i]); g[2 * i + 1] = bfhi(gr[i]);
        const float c0v = bflo(vc[i]), c1v = bfhi(vc[i]), p0 = bflo(vpv[i]), p1 = bfhi(vpv[i]);
        const float m0 = p.mu[1024 + c0 + 2 * i], m1 = p.mu[1024 + c0 + 2 * i + 1];
        v[2 * i] = c0v + m0 * (p0 - c0v); v[2 * i + 1] = c1v + m1 * (p1 - c1v); }
    float s = 0.f;
#pragma unroll
    for (int i = 0; i < 8; ++i) s += o[i];
    s += __shfl_xor(s, 1); s += __shfl_xor(s, 2); s += __shfl_xor(s, 4);
    const float mean = s * (1.f / 64.f); float q = 0.f;
#pragma unroll
    for (int i = 0; i < 8; ++i) { o[i] -= mean; q += o[i] * o[i]; }
    q += __shfl_xor(q, 1); q += __shfl_xor(q, 2); q += __shfl_xor(q, 4);
    const float rstd = rsqrtf(q * (1.f / 64.f) + 64e-5f), c3 = C3[(size_t)m * 8 + h];
    u32x4 out;
#pragma unroll
    for (int i = 0; i < 4; ++i) { float y[2];
#pragma unroll
        for (int e = 0; e < 2; ++e) { const int cc = c0 + 2 * i + e; y[e] = (o[2 * i + e] * rstd * p.ln_w[cc] + p.ln_b[cc] + c3 * v[2 * i + e]) * g[2 * i + e]; }
        out[i] = pk2(y[0], y[1]); }
    *(u32x4*)(prow + PC_R + c0) = out;
}

__device__ __forceinline__ unsigned f2key(float f) { unsigned b = __float_as_uint(f); if ((b << 1) == 0u) b = 0u; return (b & 0x80000000u) ? ~b : (b | 0x80000000u); }
__device__ __forceinline__ unsigned offb(unsigned row, unsigned ch) { return 2048u * (row >> 3) + 512u * (ch >> 2) + 64u * (row & 7) + 16u * ((ch & 3) ^ ((row >> 2) & 3)); }

__device__ __forceinline__ void topk_select(float* sc, int N, unsigned* hist, unsigned short* sel, int lane) {
    unsigned* kb = (unsigned*)sc;
    unsigned prefix = 0u, mask = 0u; int rem = 256, mbin = 0;
    const unsigned long long lt_mask = (1ull << lane) - 1ull;
    for (int pass = 0; pass < 4; ++pass) {
        const int shift = 24 - 8 * pass;
#pragma unroll
        for (int i = 0; i < 4; ++i) hist[lane * 4 + i] = 0u;
        asm volatile("s_waitcnt lgkmcnt(0)" ::: "memory");
        for (int base = 0; base < N; base += 256) { const int idx = base + 4 * lane;
            if (idx < N) { u32x4 k4;
                if (pass == 0) { const f32x4 v = *(const f32x4*)(sc + idx); k4 = (u32x4){f2key(v.x), f2key(v.y), f2key(v.z), f2key(v.w)}; *(u32x4*)(kb + idx) = k4; }
                else k4 = *(const u32x4*)(kb + idx);
#pragma unroll
                for (int e = 0; e < 4; ++e) if ((k4[e] & mask) == prefix) atomicAdd(&hist[(k4[e] >> shift) & 255u], 1u); } }
        asm volatile("s_waitcnt lgkmcnt(0)" ::: "memory");
        const unsigned c0 = hist[lane * 4], c1 = hist[lane * 4 + 1], c2 = hist[lane * 4 + 2], c3 = hist[lane * 4 + 3];
        const int cnt4 = (int)(c0 + c1 + c2 + c3);
        int incl = cnt4;
#pragma unroll
        for (int o = 1; o < 64; o <<= 1) { const int v = __shfl_down(incl, o); if (lane + o < 64) incl += v; }
        const int excl = incl - cnt4;
        const bool mine = (excl < rem) && (rem <= incl);
        const unsigned long long bal = __ballot(mine);
        const int L = (int)__builtin_ctzll(bal);
        const int ex = __shfl(excl, L); const int b3 = (int)__shfl((int)c3, L), b2 = (int)__shfl((int)c2, L), b1 = (int)__shfl((int)c1, L), b0 = (int)__shfl((int)c0, L);
        int above = ex, bin;
        if (above + b3 >= rem) { bin = 3; mbin = b3; } else { above += b3; if (above + b2 >= rem) { bin = 2; mbin = b2; } else { above += b2; if (above + b1 >= rem) { bin = 1; mbin = b1; } else { above += b1; bin = 0; mbin = b0; } } }
        rem -= above; prefix |= (unsigned)(L * 4 + bin) << shift; mask |= 0xffu << shift;
        if (pass == 1 && mbin <= 64) break;
    }
    const unsigned T = prefix; const int ngt = 256 - rem; int base_gt = 0, base_eq = 0;
    const bool partial = (mask != 0xffffffffu);
    unsigned short* cand = (unsigned short*)hist;
    for (int base = 0; base < N; base += 256) { const int idx = base + 4 * lane; const bool act = idx < N;
        u32x4 k4 = {0u, 0u, 0u, 0u}; if (act) k4 = *(const u32x4*)(kb + idx);
        bool gt[4], eq[4]; unsigned long long bg[4], be[4];
#pragma unroll
        for (int e = 0; e < 4; ++e) { const unsigned km = k4[e] & mask; gt[e] = act && km > T; eq[e] = act && km == T; bg[e] = __ballot(gt[e]); be[e] = __ballot(eq[e]); }
        int rg = base_gt, re = base_eq;
#pragma unroll
        for (int e = 0; e < 4; ++e) re += __popcll(be[e] & lt_mask);
#pragma unroll
        for (int e = 0; e < 4; ++e) {
            if (gt[e]) sel[rg + __popcll(bg[e] & lt_mask)] = (unsigned short)(idx + e);
            rg += __popcll(bg[e]);
            if (eq[e]) { if (partial) cand[re] = (unsigned short)(idx + e); else if (re < rem) sel[ngt + re] = (unsigned short)(idx + e); re += 1; } }
        base_gt = rg;
#pragma unroll
        for (int e = 0; e < 4; ++e) base_eq += __popcll(be[e]); }
    asm volatile("s_waitcnt lgkmcnt(0)" ::: "memory");
    if (partial) {
        const int m = mbin; const int ci = (lane < m) ? (int)cand[lane] : 0; const unsigned ck = (lane < m) ? kb[ci] : 0u;
        int rank = 0;
        for (int j = 0; j < m; ++j) { const unsigned kj = (unsigned)__shfl((int)ck, j); rank += (kj > ck || (kj == ck && j < lane)) ? 1 : 0; }
        if (lane < m && rank < rem) sel[ngt + rank] = (unsigned short)ci;
        asm volatile("s_waitcnt lgkmcnt(0)" ::: "memory");
    }
}

__device__ __forceinline__ void dsa_attend(const Params& p, int b, int t, const unsigned short* sel, int cnt, unsigned char* stage, int lane_in) {
    int lane = lane_in; asm volatile("" : "+v"(lane));
    const bf16* CKV = (const bf16*)(p.ws + WS_CKV) + (size_t)b * SEQ * 128; const float* INVR = (const float*)(p.ws + WS_INVR) + (size_t)b * SEQ * 8;
    bf16* QO = (bf16*)(p.ws + WS_REGA) + ((size_t)b * SEQ + t) * 1024;
    const int hd = lane & 15, grp = lane >> 4;
    bf16x8 bq[4];
#pragma unroll
    for (int s = 0; s < 4; ++s) { u32x4 z = {0u, 0u, 0u, 0u}; if (hd < 8) z = *(const u32x4*)(QO + hd * 128 + 32 * s + 8 * grp); bq[s] = __builtin_bit_cast(bf16x8, z); }
    const float slope = (hd < 8) ? exp2f(-(float)(hd + 1)) : 0.f;
    const int hsafe = hd & 7;
    float m_run = -INFINITY, l_part = 0.f;
    f32x4 O[8];
#pragma unroll
    for (int c = 0; c < 8; ++c) O[c] = (f32x4){0.f, 0.f, 0.f, 0.f};
    const LAS unsigned char* st3 = (const LAS unsigned char*)stage;
    const unsigned q4 = (lane & 15) >> 2, p4 = lane & 3;
    u32x4 G[8]; float IRn[8], PNn[8];
#define DA_ISSUE(ks_) do { \
    _Pragma("unroll") for (int i = 0; i < 8; ++i) { const int id = i * 64 + lane, row = id >> 4, ch = id & 15; const int key = sel[(ks_) + row]; G[i] = *(const u32x4*)(CKV + (size_t)key * 128 + ch * 8); } } while (0)
#define DA_ISSUE2(ks_) do { \
    _Pragma("unroll") for (int i = 0; i < 8; ++i) { const int key = sel[(ks_) + 16 * (i >> 2) + 4 * grp + (i & 3)]; IRn[i] = INVR[(size_t)key * 8 + hsafe]; PNn[i] = slope * fabsf((float)(t - key)); } } while (0)
    DA_ISSUE(0); DA_ISSUE2(0);
    for (int ks = 0; ks < cnt; ks += 32) {
#pragma unroll
        for (int i = 0; i < 8; ++i) { const int id = i * 64 + lane, row = id >> 4, ch = id & 15; *(u32x4*)(stage + offb(row, ch)) = G[i]; }
        asm volatile("s_waitcnt lgkmcnt(0)" ::: "memory");
        if (ks + 32 < cnt) DA_ISSUE(ks + 32);
        float lg[8];
#pragma unroll
        for (int T = 0; T < 2; ++T) { f32x4 acc = {0.f, 0.f, 0.f, 0.f};
#pragma unroll
            for (int s = 0; s < 4; ++s) { const bf16x8 a = *(const bf16x8*)(stage + offb((lane & 15) + 16 * T, 4 * s + grp)); acc = mfma16(a, bq[s], acc); }
#pragma unroll
            for (int rg = 0; rg < 4; ++rg) lg[4 * T + rg] = acc[rg] * IRn[4 * T + rg] - PNn[4 * T + rg]; }
        if (ks + 32 < cnt) DA_ISSUE2(ks + 32);
        float mx = lg[0];
#pragma unroll
        for (int i = 1; i < 8; ++i) mx = fmaxf(mx, lg[i]);
        mx = fmaxf(mx, __shfl_xor(mx, 16)); mx = fmaxf(mx, __shfl_xor(mx, 32));
        const float m_new = fmaxf(m_run, mx);
        const float alpha = __expf(m_run - m_new);
        float ps = 0.f;
#pragma unroll
        for (int i = 0; i < 8; ++i) { lg[i] = __expf(lg[i] - m_new); ps += lg[i]; }
        l_part = l_part * alpha + ps; m_run = m_new;
        float ar[4];
#pragma unroll
        for (int rg = 0; rg < 4; ++rg) ar[rg] = __shfl(alpha, 4 * grp + rg);
#pragma unroll
        for (int c = 0; c < 8; ++c)
#pragma unroll
            for (int rg = 0; rg < 4; ++rg) O[c][rg] *= ar[rg];
        {   u32x4 pw; pw.x = pk2(lg[0], lg[1]); pw.y = pk2(lg[2], lg[3]); pw.z = pk2(lg[4], lg[5]); pw.w = pk2(lg[6], lg[7]);
            const bf16x8 pa = __builtin_bit_cast(bf16x8, pw);
#pragma unroll
            for (int c = 0; c < 8; ++c) {
                const s16x4 lo = __builtin_bit_cast(s16x4, __builtin_amdgcn_ds_read_tr16_b64_v4i16((LAS s16x4*)(st3 + offb(4 * grp + q4, 2 * c + (p4 >> 1)) + 8 * (p4 & 1))));
                const s16x4 hi = __builtin_bit_cast(s16x4, __builtin_amdgcn_ds_read_tr16_b64_v4i16((LAS s16x4*)(st3 + offb(16 + 4 * grp + q4, 2 * c + (p4 >> 1)) + 8 * (p4 & 1))));
                const bf16x8 vb = {lo[0], lo[1], lo[2], lo[3], hi[0], hi[1], hi[2], hi[3]};
                O[c] = mfma16(pa, vb, O[c]); } }
        asm volatile("s_waitcnt lgkmcnt(0)" ::: "memory");
    }
#undef DA_ISSUE
#undef DA_ISSUE2
    float l = l_part; l += __shfl_xor(l, 16); l += __shfl_xor(l, 32);
    const float il = 1.f / l;
    float irr[4];
#pragma unroll
    for (int rg = 0; rg < 4; ++rg) irr[rg] = __shfl(il, 4 * grp + rg);
    if (grp < 2) {
#pragma unroll
        for (int rg = 0; rg < 4; ++rg)
#pragma unroll
            for (int c = 0; c < 8; ++c) QO[(4 * grp + rg) * 128 + 16 * c + hd] = f2bf(O[c][rg] * irr[rg]);
    }
}

__device__ __forceinline__ void dsa_item(const Params& p, unsigned char* lds, int it, int tid) {
    const bf16* PROJ = (const bf16*)(p.ws + WS_PROJ);
    float* SC = (float*)lds;
    unsigned* HIST = (unsigned*)(lds + 131072);
    unsigned short* SEL = (unsigned short*)(lds + 131072 + 8192);
    float* WQ = (float*)(lds + 147456);
    asm volatile("" : "+v"(tid));
    const int lane = tid & 63, wv = __builtin_amdgcn_readfirstlane(tid >> 6);
    const int b = it >> 7, tq0 = (it & 127) * 16, N = ((tq0 >> 6) + 1) * 64; const size_t rowq0 = (size_t)b * SEQ + tq0;
    if (N > 256 && !MK_DBG_NOTOPK) {
        const int r = lane & 31, g = lane >> 5;
        const int ql = 2 * ((r >> 2) & 1) + (r >> 4), hdm = 4 * ((r >> 3) & 1) + (r & 3);
        bf16x8 af[4][4];
#pragma unroll
        for (int qg = 0; qg < 4; ++qg)
#pragma unroll
            for (int s = 0; s < 4; ++s) af[qg][s] = *(const bf16x8*)(PROJ + (rowq0 + 4 * qg + ql) * NPROJ + PC_QI + hdm * 64 + 16 * s + 8 * g);
        if (tid < 128) WQ[tid] = bf2f(PROJ[(rowq0 + (tid >> 3)) * NPROJ + PC_WI + (tid & 7)]) * 0.044194173824159216f;
        __syncthreads();
        bf16x8 bfr[4];
        { const bf16* krow = PROJ + ((size_t)b * SEQ + wv * 32 + r) * NPROJ + PC_KI + 8 * g;
#pragma unroll
          for (int s = 0; s < 4; ++s) bfr[s] = *(const bf16x8*)(krow + 16 * s); }
        for (int kt = wv; kt < N / 32; kt += NWAVES) {
            const int key = kt * 32 + r;
            bf16x8 bnx[4];
#pragma unroll
            for (int s = 0; s < 4; ++s) bnx[s] = bfr[s];
            if (kt + NWAVES < N / 32) { const bf16* krow = PROJ + ((size_t)b * SEQ + key + 32 * NWAVES) * NPROJ + PC_KI + 8 * g;
#pragma unroll
                for (int s = 0; s < 4; ++s) bnx[s] = *(const bf16x8*)(krow + 16 * s); }
#pragma unroll
            for (int qg = 0; qg < 4; ++qg) { f32x16 acc = {};
#pragma unroll
                for (int s = 0; s < 4; ++s) acc = mfma32(af[qg][s], bfr[s], acc);
#pragma unroll
                for (int qq = 0; qq < 2; ++qq) { float sc = 0.f; const f32x4 w0 = *(const f32x4*)(WQ + (4 * qg + 2 * g + qq) * 8), w1 = *(const f32x4*)(WQ + (4 * qg + 2 * g + qq) * 8 + 4);
#pragma unroll
                    for (int e = 0; e < 4; ++e) { sc = fmaf(w0[e], fmaxf(acc[8 * qq + e], 0.f), sc); sc = fmaf(w1[e], fmaxf(acc[8 * qq + 4 + e], 0.f), sc); }
                    SC[(4 * qg + 2 * g + qq) * 2048 + key] = sc; } }
#pragma unroll
            for (int s = 0; s < 4; ++s) bfr[s] = bnx[s];
        }
        __syncthreads();
        for (int q = 0; q < 2; ++q) topk_select(SC + (2 * wv + q) * 2048, N, HIST + wv * 256, SEL + (2 * wv + q) * 256, lane);
    } else {
        for (int q = 0; q < 2; ++q) for (int i = lane; i < (N > 256 ? 256 : N); i += 64) SEL[(2 * wv + q) * 256 + i] = (unsigned short)i;
    }
    __syncthreads();
    const int cnt = N > 256 ? 256 : N;
    for (int q = 0; q < 2; ++q) dsa_attend(p, b, tq0 + 2 * wv + q, SEL + (2 * wv + q) * 256, cnt, lds + wv * 8192, lane);
    __syncthreads();
}

__device__ __forceinline__ void uv_item(const Params& p, int tile, int lane) {
    bf16* PROJ = (bf16*)(p.ws + WS_PROJ); const bf16* OLAT = (const bf16*)(p.ws + WS_REGA); const bf16* WUVT = (const bf16*)(p.ws + WS_WUVT);
    const int r = lane & 31, hh = lane >> 5; const size_t row = (size_t)tile * 32 + r;
    for (int h = 0; h < 8; ++h) { bf16x8 of[8];
#pragma unroll
        for (int s = 0; s < 8; ++s) of[s] = *(const bf16x8*)(OLAT + row * 1024 + h * 128 + 16 * s + 8 * hh);
#pragma unroll
        for (int dt = 0; dt < 2; ++dt) { f32x16 acc = {}; const bf16* wrow = WUVT + (size_t)(h * 64 + dt * 32 + r) * 128 + 8 * hh;
#pragma unroll
            for (int s = 0; s < 8; ++s) { const bf16x8 a = *(const bf16x8*)(wrow + 16 * s); acc = mfma32(a, of[s], acc); }
#pragma unroll
            for (int g4 = 0; g4 < 4; ++g4) { u32x2 o; o.x = pk2(acc[4 * g4], acc[4 * g4 + 1]); o.y = pk2(acc[4 * g4 + 2], acc[4 * g4 + 3]);
                *(u32x2*)(PROJ + row * NPROJ + PC_Q + h * 64 + dt * 32 + 8 * g4 + 4 * hh) = o; } }
    }
}

enum { PH_PRO = 0, PH_HN, PH_GEMM1, PH_PREP, PH_MIX, PH_UV, PH_GOUT, PH_HN2, PH_UP, PH_DOWN, PH_COUNT };
#ifndef MK_SKIP_MIXER
#define MK_SKIP_MIXER 0
#endif
__global__ void __launch_bounds__(NWAVES * 64, 2) mk_fwd(Params p) {
    extern __shared__ __attribute__((aligned(16))) unsigned char lds[];
    cg::grid_group grid = cg::this_grid();
    const int tid = threadIdx.x, lane = tid & 63, wv = __builtin_amdgcn_readfirstlane(tid >> 6);
    const int G = gridDim.x, gw = blockIdx.x * NWAVES + wv, NGW = G * NWAVES;
    const int lo = p.ph_lo, hi = p.ph_hi;
    float* MOD = (float*)(p.ws + WS_MOD); bf16* REGA = (bf16*)(p.ws + WS_REGA); bf16* PROJ = (bf16*)(p.ws + WS_PROJ);
#ifndef MK_PHASE_MASK
#define MK_PHASE_MASK 0x3ff
#endif
#define IN(k) (((MK_PHASE_MASK >> (k)) & 1) && lo <= (k) && (k) < hi)
#define SEAM(k) do { if (IN(k) && IN((k) + 1)) grid.sync(); } while (0)
    if (IN(PH_PRO)) { phase_pro(p, lds, tid, G); }
    SEAM(PH_PRO);
    if (IN(PH_HN)) { hn_rows(p.x, p.g_mix, MOD, 0, 1024, REGA, gw, NGW, lane); }
    SEAM(PH_HN);
    if (IN(PH_GEMM1)) {
        pg8::Gemm g{REGA, (const bf16*)(p.ws + WS_WIN), M, NPROJ, DM, DM}; pg8::StaticOrder S; S.init(M, NPROJ, G, (int)blockIdx.x);
        pg8::EpiBf16<0> E{PROJ, NPROJ};
        pg8::gemm_phase<pg8::EpiBf16<0>, pg8::StaticOrder, true, true>((PG8_LAS unsigned char*)lds, g, S, E);
    }
    SEAM(PH_GEMM1);
    if (IN(PH_PREP)) {
#ifndef DBG_NO_RP
        for (int it = blockIdx.x; it < M / 64; it += G) rwkv_prep_item(p, lds, it, tid);
#endif
#ifndef DBG_NO_DP
        for (int tile = gw; tile < M / 32; tile += NGW) dsa_prep_item(p, tile, lane);
#endif
    }
    SEAM(PH_PREP);
    if (IN(PH_MIX) && MK_DBG != 4 && MK_DBG != 6 && MK_DBG != 7) {
#if !defined(DBG_NO_SCAN) && MK_DBG != 1
        for (int chain = blockIdx.x; chain < NB * 8; chain += G) { rwkv_scan_chain(p, lds, chain, wv, lane); __syncthreads(); }
#endif
#if !defined(DBG_NO_DSA) && MK_DBG != 2
        for (int k = 0; k * G < M / 16; ++k) { const int idx = (k & 1) ? (G - 1 - (int)blockIdx.x) : (int)blockIdx.x; const int it = k * G + idx; if (it < M / 16) dsa_item(p, lds, it, tid); }
#endif
    }
    SEAM(PH_MIX);
    if (IN(PH_UV) && MK_DBG != 4) {
#if MK_DBG == 7
        for (int m = gw; m < M; m += NGW) { *(u32x4*)(PROJ + (size_t)m * NPROJ + lane * 8) = *(const u32x4*)(REGA + (size_t)m * 1024 + lane * 8); }
#elif MK_DBG != 2
        for (int tile = gw; tile < M / 32; tile += NGW) uv_item(p, tile, lane);
#endif
#if MK_DBG == 0
        for (int m = gw; m < M; m += NGW) rwkv_epi_row(p, m, lane);
#endif
#if MK_DBG == 1 || MK_DBG == 2
        for (int m = gw; m < M; m += NGW) { u32x4 z = {0u, 0u, 0u, 0u}; *(u32x4*)(PROJ + (size_t)m * NPROJ + (MK_DBG == 1 ? 512 : 0) + lane * 8) = z; }
#endif
    }
    SEAM(PH_UV);
    if (IN(PH_GOUT)) {
        pg8::Gemm g{PROJ, (const bf16*)(p.ws + WS_WOUT), M, DM, DM, NPROJ}; pg8::StaticOrder S; S.init(M, DM, G, (int)blockIdx.x);
        pg8::EpiResGate E{p.x, p.out, DM, MOD + 2048, 6144, 1.f};
        pg8::gemm_phase<pg8::EpiResGate, pg8::StaticOrder, true, true>((PG8_LAS unsigned char*)lds, g, S, E);
    }
    SEAM(PH_GOUT);
    if (IN(PH_HN2)) { hn_rows(MK_SKIP_MIXER ? p.x : p.out, p.g_ffn, MOD, 3072, 4096, REGA, gw, NGW, lane); }
    SEAM(PH_HN2);
    if (IN(PH_UP)) {
        pg8::Gemm g{REGA, (const bf16*)(p.ws + WS_W1), M, FF, DM, DM}; pg8::StaticOrder S; S.init(M, FF, G, (int)blockIdx.x);
        pg8::EpiF8Relu2 E{p.ws + WS_U, FF, 4.f};
        pg8::gemm_phase<pg8::EpiF8Relu2, pg8::StaticOrder, true, true>((PG8_LAS unsigned char*)lds, g, S, E);
    }
    SEAM(PH_UP);
    if (IN(PH_DOWN)) {
        pg8::Gemm g{(const bf16*)(p.ws + WS_U), (const bf16*)(p.ws + WS_W2), M, DM, FF / 2, FF / 2}; pg8::StaticOrder S; S.init(M, DM, G, (int)blockIdx.x);
        pg8::EpiResGate E{MK_SKIP_MIXER ? p.x : p.out, p.out, DM, MOD + 5120, 6144, 1.f / 256.f};
        pg8::gemm_phase<pg8::EpiResGate, pg8::StaticOrder, true, true, true>((PG8_LAS unsigned char*)lds, g, S, E);
    }
#undef IN
#undef SEAM
}

#ifndef MK_N_LAUNCHES
#define MK_N_LAUNCHES 1
#endif
extern "C" void kernel_launch(void* const* d_in, const int* in_sizes, int n_in, void* d_out, int out_size, void* d_ws, size_t ws_size, hipStream_t stream) {
    static int grid = 0;
    if (grid == 0) {
        if (n_in != 26 || out_size != M * DM || ws_size < WS_END) { fprintf(stderr, "kernel_launch: unexpected shapes (n_in %d out %d ws %zu)\n", n_in, out_size, ws_size); grid = -1; return; }
        int dev = 0, cus = 0, per_cu = 0;
        hipGetDevice(&dev); hipDeviceGetAttribute(&cus, hipDeviceAttributeMultiprocessorCount, dev);
        if (hipFuncSetAttribute((const void*)mk_fwd, hipFuncAttributeMaxDynamicSharedMemorySize, LDS_BYTES) != hipSuccess) { fprintf(stderr, "kernel_launch: hipFuncSetAttribute failed\n"); grid = -1; return; }
        if (hipOccupancyMaxActiveBlocksPerMultiprocessor(&per_cu, (const void*)mk_fwd, NWAVES * 64, LDS_BYTES) != hipSuccess || per_cu < 1) { fprintf(stderr, "kernel_launch: occupancy query says %d\n", per_cu); per_cu = 1; }
        (void)hipGetLastError();
        grid = cus * 1;
        if (per_cu < 1) grid = -1;
    }
    if (grid < 0) return;
    Params p{};
    const float** pp = (const float**)&p;
    for (int i = 0; i < 26; ++i) pp[i] = (const float*)d_in[i];
    p.out = (float*)d_out; p.ws = (unsigned char*)d_ws;
#if MK_N_LAUNCHES == 1
    p.ph_lo = 0; p.ph_hi = PH_COUNT;
    void* args[] = {&p};
    hipError_t e = hipLaunchCooperativeKernel((const void*)mk_fwd, dim3(grid), dim3(NWAVES * 64), args, LDS_BYTES, stream);
    if (e != hipSuccess) fprintf(stderr, "cooperative launch failed: %s (grid %d)\n", hipGetErrorString(e), grid);
#else
    for (int ph = 0; ph < PH_COUNT; ++ph) {
#if MK_SKIP_MIXER
        if (ph >= PH_HN && ph <= PH_GOUT) continue;
#endif
        p.ph_lo = ph; p.ph_hi = ph + 1;
        hipLaunchKernelGGL(mk_fwd, dim3(grid), dim3(NWAVES * 64), LDS_BYTES, stream, p);
    }
#endif
}
```

```cpp
#include <hip/hip_runtime.h>
#include <hip/hip_cooperative_groups.h>
#include <cstdio>
#include <cstdint>
#include <cmath>
namespace cg = cooperative_groups;
#ifndef MK_F8_GEMM1
#define MK_F8_GEMM1 0
#endif
#ifndef MK_DBG
#define MK_DBG 0
#endif
#ifndef MK_DBG_NOTOPK
#define MK_DBG_NOTOPK 0
#endif
namespace pg8 {
#define PG8_LAS __attribute__((address_space(3)))
typedef unsigned short bf16_t;
typedef short bf16x8 __attribute__((ext_vector_type(8)));
typedef float f32x4 __attribute__((ext_vector_type(4)));
typedef unsigned u32x4 __attribute__((ext_vector_type(4)));
constexpr int BM = 256, BK = 64, HALF = 128, HTB = HALF * BK * 2  , STAGE_BYTES = 8 * HTB, NXCD = 8, WGM = 8;

__host__ __device__ __forceinline__ int lds_byte(int r, int c) { const int st = (r >> 4) * 2 + (c >> 5), rr = r & 15, cc = c & 31, ob = rr * 64 + cc * 2; return st * 1024 + (ob ^ (((ob >> 9) & 1) << 5)); }
__host__ __device__ __forceinline__ void stage_rc(int b, int& R, int& C) { const int st = b / 1024, sb = b % 1024, swz = sb ^ (((sb >> 9) & 1) << 5); R = (st >> 1) * 16 + swz / 64; C = (st & 1) * 32 + (swz % 64) / 2; }
__host__ __device__ __forceinline__ int perm32(int rho) { const int n = rho >> 4, i = rho & 15; return 8 * (i >> 2) + 4 * n + (i & 3); }

struct Unit { int pm, pn; };
struct Gemm { const bf16_t* A; const bf16_t* Bt; int M, N, K, lda; };

struct StaticOrder {
    int nM, nN, nwg, G, c;
    __host__ __device__ void init(int M, int N, int G_, int c_) { nM = M / BM; nN = N / BM; nwg = nM * nN; G = G_; c = c_; }
    __host__ __device__ bool next(int i, Unit& u) const {
        const long L = (long)i * G + c; if (L >= nwg) return false;
        int wgid = (int)L; { const int q = nwg / NXCD, r = nwg % NXCD, xcd = wgid % NXCD, off = wgid / NXCD; wgid = (xcd < r ? xcd * (q + 1) : r * (q + 1) + (xcd - r) * q) + off; }
        const int nig = WGM * nN, gid = wgid / nig, fm = gid * WGM, gsz = (nM - fm) < WGM ? (nM - fm) : WGM;
        u.pm = fm + ((wgid % nig) % gsz); u.pn = (wgid % nig) / gsz; return true;
    }
    __device__ __forceinline__ void a_ready(const Unit&) const {}
    __device__ __forceinline__ void done(const Unit&) const {}
};


typedef float f32x2_t __attribute__((ext_vector_type(2))); typedef __bf16 bf16x2_t __attribute__((ext_vector_type(2)));
__device__ __forceinline__ unsigned cvt_pk_bf16(float lo, float hi) { const f32x2_t v = {lo, hi}; const bf16x2_t b = __builtin_convertvector(v, bf16x2_t); return __builtin_bit_cast(unsigned, b); }

template <int ACT  > struct EpiBf16 {
    static constexpr bool PERM = true, AFTER_DRAIN = false;
    bf16_t* O; int ldc; float scale;
    __device__ __forceinline__ void operator()(const f32x4 (&acc)[2][2][4][2], const Unit& u, int wr, int wc, int fr, int fq) const {
        const int row0 = u.pm * BM + wr * 64 + fr; const int col0 = u.pn * BM + wc * 32 + 8 * fq;
#pragma unroll
        for (int ai = 0; ai < 2; ++ai)
#pragma unroll
            for (int m = 0; m < 4; ++m) { bf16_t* rowp = O + (size_t)(row0 + ai * HALF + m * 16) * ldc + col0;
#pragma unroll
                for (int bj = 0; bj < 2; ++bj) { f32x4 v0 = acc[ai][bj][m][0] * scale, v1 = acc[ai][bj][m][1] * scale;
                    if (ACT == 1) {
#pragma unroll
                        for (int j = 0; j < 4; ++j) { const float a = v0[j] > 0.f ? v0[j] : 0.f, b = v1[j] > 0.f ? v1[j] : 0.f; v0[j] = a * a; v1[j] = b * b; } }
                    u32x4 w; w.x = cvt_pk_bf16(v0[0], v0[1]); w.y = cvt_pk_bf16(v0[2], v0[3]); w.z = cvt_pk_bf16(v1[0], v1[1]); w.w = cvt_pk_bf16(v1[2], v1[3]);
                    *(u32x4*)(rowp + bj * HALF) = w; } }
    }
};
__device__ __forceinline__ unsigned pk4_fp8(float a, float b, float c, float d) { int r = __builtin_amdgcn_cvt_pk_fp8_f32(a, b, 0, false); r = __builtin_amdgcn_cvt_pk_fp8_f32(c, d, r, true); return (unsigned)r; }
struct EpiF8Relu2 {
    static constexpr bool PERM = true, AFTER_DRAIN = false;
    unsigned char* O; int ldc; float scale;
    __device__ __forceinline__ void operator()(const f32x4 (&acc)[2][2][4][2], const Unit& u, int wr, int wc, int fr, int fq) const {
        const int row0 = u.pm * BM + wr * 64 + fr; const int col0 = u.pn * BM + wc * 32 + 8 * fq;
#pragma unroll
        for (int ai = 0; ai < 2; ++ai)
#pragma unroll
            for (int m = 0; m < 4; ++m) { unsigned char* rowp = O + (size_t)(row0 + ai * HALF + m * 16) * ldc + col0;
#pragma unroll
                for (int bj = 0; bj < 2; ++bj) { f32x4 v0 = acc[ai][bj][m][0], v1 = acc[ai][bj][m][1];
#pragma unroll
                    for (int j = 0; j < 4; ++j) { const float a = v0[j] > 0.f ? v0[j] : 0.f, b = v1[j] > 0.f ? v1[j] : 0.f; v0[j] = fminf(a * a * scale, 416.f); v1[j] = fminf(b * b * scale, 416.f); }
                    typedef unsigned u32x2_t __attribute__((ext_vector_type(2)));
                    u32x2_t w; w.x = pk4_fp8(v0[0], v0[1], v0[2], v0[3]); w.y = pk4_fp8(v1[0], v1[1], v1[2], v1[3]);
                    *(u32x2_t*)(rowp + bj * HALF) = w; } }
    }
};
struct EpiResGate {
    static constexpr bool PERM = false, AFTER_DRAIN = false;
    const float* base; float* out; int ldc; const float* gate; int gate_ld; float gscale;
    __device__ __forceinline__ void operator()(const f32x4 (&acc)[2][2][4][2], const Unit& u, int, int, int, int) const {
        int t_ = threadIdx.x; asm volatile("" : "+v"(t_));
        const int wr = t_ >> 8, wc = (t_ >> 6) & 3, fr = t_ & 15, fq = (t_ >> 4) & 3;
        const int row0 = u.pm * BM + wr * 64 + fr, col0 = u.pn * BM + wc * 32 + 4 * fq;
        const float* gp = gate + (size_t)(u.pm >> 3) * gate_ld + col0;
        f32x4 gv[2][2];
#pragma unroll
        for (int bj = 0; bj < 2; ++bj)
#pragma unroll
            for (int n = 0; n < 2; ++n) gv[bj][n] = *(const f32x4*)(gp + bj * HALF + n * 16) * gscale;
#pragma unroll
        for (int ai = 0; ai < 2; ++ai)
#pragma unroll
            for (int m = 0; m < 4; ++m) { const size_t off = (size_t)(row0 + ai * HALF + m * 16) * ldc + col0;
#pragma unroll
                for (int bj = 0; bj < 2; ++bj)
#pragma unroll
                    for (int n = 0; n < 2; ++n) { const f32x4 bs = *(const f32x4*)(base + off + bj * HALF + n * 16);
                        *(f32x4*)(out + off + bj * HALF + n * 16) = bs + gv[bj][n] * acc[ai][bj][m][n]; } }
    }
};
template <class Epi, class Sched, bool ALIGN_EPI = false, bool SP2 = false, bool F8 = false>
__device__ __forceinline__ void gemm_phase(PG8_LAS unsigned char* lds, const Gemm g, const Sched& S, const Epi& E) {
    const int tid = threadIdx.x, wid = __builtin_amdgcn_readfirstlane(tid >> 6), lane = tid & 63, wr = wid >> 2, wc = wid & 3, fr = lane & 15, fq = lane >> 4;
    const int K = g.K, nt = K / BK;
    unsigned voffA[2], voffB[2];
#pragma unroll
    for (int i = 0; i < 2; ++i) { int R, C; stage_rc(tid * 16 + i * 8192, R, C); const int Rb = Epi::PERM ? ((R & ~31) + perm32(R & 31)) : R;
        voffA[i] = (unsigned)(R * g.lda + C) * 2u; voffB[i] = (unsigned)(Rb * K + C) * 2u; }
    const size_t kstep = (size_t)(BK * 2);
    const size_t hstepB = (size_t)HALF * K * 2, hstepA = (size_t)HALF * g.lda * 2;
    const size_t tstepA = 2 * hstepA, tstepB = 2 * hstepB;
    const unsigned ldsw = (unsigned)wid * 1024u;
    const int f8in = (fq >> 1) * 1024 + ((fr * 64 + (fq & 1) * 32) ^ ((fr >> 3) << 5));
    const int aoff = F8 ? wr * 8192 + f8in : lds_byte(wr * 64 + fr, fq * 8), boff = F8 ? wc * 4096 + f8in : lds_byte(wc * 32 + fr, fq * 8);
    constexpr int KOFF = F8 ? 16 : 1024;
    typedef int v8i_t __attribute__((ext_vector_type(8)));
#define PG8_SA(b, h) (((b) * 2 + (h)) * HTB)
#define PG8_SB(b, h) ((4 + (b) * 2 + (h)) * HTB)
#define PG8_STAGE(bufoff, gbase, voff) do { _Pragma("unroll") for (int _i = 0; _i < 2; ++_i) \
        __builtin_amdgcn_global_load_lds((const unsigned*)((const char*)(gbase) + (voff)[_i]), (PG8_LAS unsigned*)(lds + (bufoff) + ldsw + _i * 8192), 16, 0, 0); } while (0)
#define PG8_LD32(p_) __builtin_shufflevector(*(const PG8_LAS u32x4*)(p_), *(const PG8_LAS u32x4*)((p_) + 16), 0, 1, 2, 3, 4, 5, 6, 7)
#define PG8_LDA(dst, b, h) do { if constexpr (F8) { _Pragma("unroll") for (int m = 0; m < 4; ++m) dst##8[m] = __builtin_bit_cast(v8i_t, PG8_LD32(lds + PG8_SA(b, h) + aoff + m * 2048)); } \
    else { _Pragma("unroll") for (int m = 0; m < 4; ++m) _Pragma("unroll") for (int k = 0; k < 2; ++k) dst[m][k] = *(const PG8_LAS bf16x8*)(lds + PG8_SA(b, h) + aoff + m * 2048 + k * KOFF); } } while (0)
#define PG8_LDB(dst, b, h) do { if constexpr (F8) { _Pragma("unroll") for (int n = 0; n < 2; ++n) dst##8[n] = __builtin_bit_cast(v8i_t, PG8_LD32(lds + PG8_SB(b, h) + boff + n * 2048)); } \
    else { _Pragma("unroll") for (int n = 0; n < 2; ++n) _Pragma("unroll") for (int k = 0; k < 2; ++k) dst[n][k] = *(const PG8_LAS bf16x8*)(lds + PG8_SB(b, h) + boff + n * 2048 + k * KOFF); } } while (0)
#define PG8_CAT(x) __builtin_shufflevector(__builtin_bit_cast(u32x4, (x)[0]), __builtin_bit_cast(u32x4, (x)[1]), 0, 1, 2, 3, 4, 5, 6, 7)
#define PG8_MMA(ai, bj, At, Bt) do { __builtin_amdgcn_s_setprio(1); if constexpr (F8) { _Pragma("unroll") for (int m = 0; m < 4; ++m) _Pragma("unroll") for (int n = 0; n < 2; ++n) \
        asm volatile("v_mfma_f32_16x16x128_f8f6f4 %0, %1, %2, %0" : "+v"(acc[ai][bj][m][n]) : "v"(Bt##8[n]), "v"(At##8[m])); } \
    else { _Pragma("unroll") for (int m = 0; m < 4; ++m) _Pragma("unroll") for (int n = 0; n < 2; ++n) _Pragma("unroll") for (int k = 0; k < 2; ++k) \
        acc[ai][bj][m][n] = __builtin_amdgcn_mfma_f32_16x16x32_bf16(Bt[n][k], At[m][k], acc[ai][bj][m][n], 0, 0, 0); } __builtin_amdgcn_s_setprio(0); } while (0)
#define PG8_WAIT_V(n) asm volatile("s_waitcnt vmcnt(" #n ")" ::: "memory")
#define PG8_WAIT_L(n) asm volatile("s_waitcnt lgkmcnt(" #n ")" ::: "memory")
#define PG8_BAR __builtin_amdgcn_s_barrier()
#define PG8_SCHED __builtin_amdgcn_sched_barrier(0)
    Unit cur, nxt; int ui = 0;
    if (!S.next(0, cur)) return;
    f32x4 acc[2][2][4][2];
#pragma unroll
    for (int a = 0; a < 2; ++a)
#pragma unroll
        for (int b = 0; b < 2; ++b)
#pragma unroll
            for (int m = 0; m < 4; ++m)
#pragma unroll
                for (int n = 0; n < 2; ++n) acc[a][b][m][n] = (f32x4){0.f, 0.f, 0.f, 0.f};
    bf16x8 At[4][2], B0[2][2], B1[2][2]; v8i_t At8[4], B08[2], B18[2];
    const char* cA = (const char*)g.A + (size_t)cur.pm * tstepA; const char* cB = (const char*)g.Bt + (size_t)cur.pn * tstepB;
    S.a_ready(cur);
    if constexpr (SP2) {
        PG8_STAGE(PG8_SB(0, 0), cB, voffB); PG8_STAGE(PG8_SB(0, 1), cB + hstepB, voffB); PG8_STAGE(PG8_SA(0, 0), cA, voffA); PG8_STAGE(PG8_SA(0, 1), cA + hstepA, voffA);
        if (wr == 1) PG8_BAR;
        PG8_WAIT_V(2); PG8_BAR;
        PG8_STAGE(PG8_SB(1, 0), cB + kstep, voffB); PG8_STAGE(PG8_SA(1, 0), cA + kstep, voffA); PG8_STAGE(PG8_SB(1, 1), cB + hstepB + kstep, voffB);
        PG8_WAIT_V(6); PG8_BAR;
    } else {
        PG8_STAGE(PG8_SB(0, 0), cB, voffB); PG8_STAGE(PG8_SA(0, 0), cA, voffA); PG8_STAGE(PG8_SB(0, 1), cB + hstepB, voffB); PG8_STAGE(PG8_SA(0, 1), cA + hstepA, voffA);
        if (wr == 1) PG8_BAR;
        PG8_WAIT_V(4); PG8_BAR;
        PG8_STAGE(PG8_SB(1, 0), cB + kstep, voffB); PG8_STAGE(PG8_SA(1, 0), cA + kstep, voffA); PG8_STAGE(PG8_SB(1, 1), cB + hstepB + kstep, voffB);
        PG8_WAIT_V(6); PG8_BAR;
    }
    for (;;) {
        const bool has_next = S.next(ui + 1, nxt);
        const char* nA = has_next ? (const char*)g.A + (size_t)nxt.pm * tstepA : cA; const char* nB = has_next ? (const char*)g.Bt + (size_t)nxt.pn * tstepB : cB;
        for (int t = 0; t < nt; t += 2) {
            const bool last = (t == nt - 2);
            const char* a1 = cA + (size_t)(t + 1) * kstep;
            const char* a2 = last ? nA : cA + (size_t)(t + 2) * kstep; const char* b2 = last ? nB : cB + (size_t)(t + 2) * kstep;
            const char* a3 = a2 + kstep; const char* b3 = b2 + kstep;
            if (last && has_next) S.a_ready(nxt);
            if constexpr (SP2) {
            PG8_LDB(B0, 0, 0); PG8_LDB(B1, 0, 1); PG8_SCHED; PG8_LDA(At, 0, 0); PG8_STAGE(PG8_SA(1, 1), a1 + hstepA, voffA);
            PG8_WAIT_V(8); PG8_WAIT_L(0); PG8_BAR; PG8_MMA(0, 0, At, B0); PG8_MMA(0, 1, At, B1); PG8_BAR; PG8_SCHED;
            PG8_LDA(At, 0, 1); PG8_STAGE(PG8_SB(0, 0), b2, voffB); PG8_STAGE(PG8_SB(0, 1), b2 + hstepB, voffB); PG8_STAGE(PG8_SA(0, 0), a2, voffA);
            PG8_WAIT_V(8); PG8_WAIT_L(0); PG8_BAR; PG8_MMA(1, 0, At, B0); PG8_MMA(1, 1, At, B1); PG8_BAR; PG8_SCHED;
            PG8_LDB(B0, 1, 0); PG8_LDB(B1, 1, 1); PG8_SCHED; PG8_LDA(At, 1, 0); PG8_STAGE(PG8_SA(0, 1), a2 + hstepA, voffA);
            PG8_WAIT_V(8); PG8_WAIT_L(0); PG8_BAR; PG8_MMA(0, 0, At, B0); PG8_MMA(0, 1, At, B1); PG8_BAR; PG8_SCHED;
            PG8_LDA(At, 1, 1); PG8_STAGE(PG8_SB(1, 0), b3, voffB); PG8_STAGE(PG8_SB(1, 1), b3 + hstepB, voffB); PG8_STAGE(PG8_SA(1, 0), a3, voffA);
            PG8_WAIT_V(8); PG8_WAIT_L(0); PG8_BAR; PG8_MMA(1, 0, At, B0); PG8_MMA(1, 1, At, B1); PG8_BAR; PG8_SCHED;
            } else {
            PG8_LDB(B0, 0, 0); PG8_SCHED; PG8_LDA(At, 0, 0); PG8_STAGE(PG8_SA(1, 1), a1 + hstepA, voffA);
            PG8_WAIT_L(8); PG8_BAR; PG8_WAIT_L(0); PG8_MMA(0, 0, At, B0); PG8_BAR; PG8_SCHED;
            PG8_LDB(B1, 0, 1); PG8_STAGE(PG8_SB(0, 0), b2, voffB);
            PG8_BAR; PG8_WAIT_L(0); PG8_MMA(0, 1, At, B1); PG8_BAR;
            PG8_LDA(At, 0, 1); PG8_STAGE(PG8_SA(0, 0), a2, voffA);
            PG8_BAR; PG8_WAIT_L(0); PG8_MMA(1, 0, At, B0); PG8_BAR; PG8_SCHED;
            PG8_STAGE(PG8_SB(0, 1), b2 + hstepB, voffB);
            PG8_WAIT_V(6); PG8_BAR; PG8_MMA(1, 1, At, B1); PG8_BAR;
            PG8_LDB(B0, 1, 0); PG8_SCHED; PG8_LDA(At, 1, 0); PG8_STAGE(PG8_SA(0, 1), a2 + hstepA, voffA);
            PG8_WAIT_L(8); PG8_BAR; PG8_WAIT_L(0); PG8_MMA(0, 0, At, B0); PG8_BAR; PG8_SCHED;
            PG8_LDB(B1, 1, 1); PG8_STAGE(PG8_SB(1, 0), b3, voffB);
            PG8_BAR; PG8_WAIT_L(0); PG8_MMA(0, 1, At, B1); PG8_BAR;
            PG8_LDA(At, 1, 1); PG8_STAGE(PG8_SA(1, 0), a3, voffA);
            PG8_BAR; PG8_WAIT_L(0); PG8_MMA(1, 0, At, B0); PG8_BAR; PG8_SCHED;
            PG8_STAGE(PG8_SB(1, 1), b3 + hstepB, voffB);
            PG8_WAIT_V(6); PG8_BAR; PG8_MMA(1, 1, At, B1); PG8_BAR;
            }
        }
        if constexpr (ALIGN_EPI) { if (wr == 0) PG8_BAR; }
        if constexpr (F8) asm volatile("s_nop 15\n\ts_nop 15" ::: "memory");
        if constexpr (!Epi::AFTER_DRAIN) { E(acc, cur, wr, wc, fr, fq); S.done(cur); }
        if (!has_next) break;
#pragma unroll
        for (int a = 0; a < 2; ++a)
#pragma unroll
            for (int b = 0; b < 2; ++b)
#pragma unroll
                for (int m = 0; m < 4; ++m)
#pragma unroll
                    for (int n = 0; n < 2; ++n) acc[a][b][m][n] = (f32x4){0.f, 0.f, 0.f, 0.f};
        cur = nxt; cA = nA; cB = nB; ++ui;
        if constexpr (ALIGN_EPI) { if (wr == 1) PG8_BAR; }
    }
    PG8_WAIT_V(0);
    if constexpr (!ALIGN_EPI) { if (wr == 0) PG8_BAR; }
    PG8_BAR;
    if constexpr (Epi::AFTER_DRAIN) { E.fused(acc, cur, wr, wc, fr, fq, lds, wid, lane); S.done(cur); }
#undef PG8_SA
#undef PG8_SB
#undef PG8_STAGE
#undef PG8_LDA
#undef PG8_LDB
#undef PG8_MMA
#undef PG8_CAT
#undef PG8_LD32
#undef PG8_WAIT_V
#undef PG8_WAIT_L
#undef PG8_BAR
#undef PG8_SCHED
}
}

#define LAS __attribute__((address_space(3)))
typedef unsigned short bf16;
typedef short bf16x8 __attribute__((ext_vector_type(8)));
typedef short s16x4 __attribute__((ext_vector_type(4)));
typedef float f32x4 __attribute__((ext_vector_type(4)));
typedef float f32x16 __attribute__((ext_vector_type(16)));
typedef unsigned u32x4 __attribute__((ext_vector_type(4)));
typedef unsigned u32x2 __attribute__((ext_vector_type(2)));

constexpr int NB = 32, SEQ = 2048, DM = 1024, M = NB * SEQ, NPROJ = 3072, FF = 4096;
constexpr int PC_Q = 0, PC_R = 512, PC_K = 1024, PC_V = 1536, PC_QI = 2048, PC_CL = 2560, PC_KI = 2688, PC_XW = 2752, PC_XA = 2816, PC_XG = 2880, PC_WI = 3008;
constexpr size_t MiB = 1u << 20;
constexpr size_t WS_MOD = 0, WS_WUKT = 1 * MiB, WS_WUK = WS_WUKT + 131072, WS_WUVT = WS_WUK + 131072, WS_INVR = 2 * MiB, WS_WIN = 4 * MiB, WS_WOUT = 10 * MiB,
                 WS_W1 = 12 * MiB, WS_W2 = 20 * MiB, WS_CKV = 36 * MiB, WS_GAM = 52 * MiB, WS_C3 = 60 * MiB, WS_REGA = 64 * MiB, WS_PROJ = 192 * MiB, WS_CH = 576 * MiB,
                 WS_G = 960 * MiB, WS_U = 192 * MiB, WS_END = 1024 * MiB,
                 WS_W2T = WS_WUVT + 131072, WS_A2T = WS_W2T + 65536, WS_G2T = WS_A2T + 65536;
constexpr int LDS_BYTES = 151552;
constexpr int NWAVES = 8;

struct Params {
    const float *x, *c, *w_ada, *b_ada, *g_mix, *g_ffn, *w_in, *g_q, *g_k, *g_kv, *w_uk, *w_uv, *mu, *w0, *w2, *a0, *a2, *g2, *k_k, *k_a, *r_k, *ln_w, *ln_b, *w_out, *w_ff1, *w_ff2;
    float* out; unsigned char* ws; int ph_lo, ph_hi;
};

__device__ __forceinline__ unsigned pk2(float lo, float hi) { return pg8::cvt_pk_bf16(lo, hi); }
__device__ __forceinline__ float bflo(unsigned w) { return __uint_as_float(w << 16); }
__device__ __forceinline__ float bfhi(unsigned w) { return __uint_as_float(w & 0xffff0000u); }
__device__ __forceinline__ float bf2f(bf16 h) { return __uint_as_float((unsigned)h << 16); }
__device__ __forceinline__ bf16 f2bf(float f) { return (bf16)(pk2(f, 0.f) & 0xffffu); }
__device__ __forceinline__ float wave_sum(float v) {
#pragma unroll
    for (int o = 1; o < 64; o <<= 1) v += __shfl_xor(v, o);
    return v;
}
__device__ __forceinline__ f32x16 mfma32(bf16x8 a, bf16x8 b, f32x16 c) { return __builtin_amdgcn_mfma_f32_32x32x16_bf16(a, b, c, 0, 0, 0); }
__device__ __forceinline__ f32x4 mfma16(bf16x8 a, bf16x8 b, f32x4 c) { return __builtin_amdgcn_mfma_f32_16x16x32_bf16(a, b, c, 0, 0, 0); }

__device__ __forceinline__ int win_src_col(int n) {
    if (n < 512) return n;
    if (n < 1024) return 1224 + (n - 512);
    if (n < 1536) return 1736 + (n - 1024);
    if (n < 2048) return 2248 + (n - 1536);
    if (n < 2560) return 640 + (n - 2048);
    if (n < 2688) return 512 + (n - 2560);
    if (n < 2752) return 1152 + (n - 2688);
    if (n < 2816) return 2760 + (n - 2752);
    if (n < 2880) return 2824 + (n - 2816);
    if (n < 3008) return 2888 + (n - 2880);
    if (n < 3016) return 1216 + (n - 3008);
    return -1;
}
__device__ __forceinline__ void conv_t_item(const float* W, int K, int Nsrc, bf16* WT, int nblk, int item, float* scr, int lane, bool is_win) {
    const int kb = item / nblk, nb = item % nblk, k0 = 64 * kb, n0 = 32 * nb;
    int ns = n0 + (lane & 31); if (is_win) ns = win_src_col(ns);
#pragma unroll 8
    for (int i = 0; i < 32; ++i) { const int kk = 2 * i + (lane >> 5); scr[kk * 33 + (lane & 31)] = ns >= 0 ? W[(size_t)(k0 + kk) * Nsrc + ns] : 0.f; }
    asm volatile("s_waitcnt lgkmcnt(0)" ::: "memory");
    const int c = lane & 7;
#pragma unroll
    for (int j = 0; j < 4; ++j) { const int n = (lane >> 3) + 8 * j; const float* s = scr + (8 * c) * 33 + n;
        u32x4 o; o.x = pk2(s[0 * 33], s[1 * 33]); o.y = pk2(s[2 * 33], s[3 * 33]); o.z = pk2(s[4 * 33], s[5 * 33]); o.w = pk2(s[6 * 33], s[7 * 33]);
        *(u32x4*)(WT + (size_t)(n0 + n) * K + k0 + 8 * c) = o; }
    asm volatile("s_waitcnt lgkmcnt(0)" ::: "memory");
}
__device__ __forceinline__ void conv_t_item_f8(const float* W, int K, int N, unsigned char* WT, int nblk, int item, float* scr, int lane, float scale, bool is_win = false) {
    const int kb = item / nblk, nb = item % nblk, k0 = 64 * kb, n0 = 32 * nb;
    int ns = n0 + (lane & 31); if (is_win) ns = win_src_col(ns);
#pragma unroll 8
    for (int i = 0; i < 32; ++i) { const int kk = 2 * i + (lane >> 5); scr[kk * 33 + (lane & 31)] = ns >= 0 ? W[(size_t)(k0 + kk) * N + ns] * scale : 0.f; }
    asm volatile("s_waitcnt lgkmcnt(0)" ::: "memory");
    const int c = lane & 7;
#pragma unroll
    for (int j = 0; j < 4; ++j) { const int n = (lane >> 3) + 8 * j; const float* s = scr + (8 * c) * 33 + n;
        u32x2 o; o.x = pg8::pk4_fp8(s[0 * 33], s[1 * 33], s[2 * 33], s[3 * 33]); o.y = pg8::pk4_fp8(s[4 * 33], s[5 * 33], s[6 * 33], s[7 * 33]);
        *(u32x2*)(WT + (size_t)(n0 + n) * K + k0 + 8 * c) = o; }
    asm volatile("s_waitcnt lgkmcnt(0)" ::: "memory");
}
__device__ __forceinline__ void adaln_block(const Params& p, float* ldsf, int cb, int tid) {
    const int lane = tid & 63, wv = tid >> 6, e = cb * 64 + lane;
    float* SC = ldsf; float* RED = ldsf + 16384; float* mod = (float*)(p.ws + WS_MOD);
    for (int half = 0; half < 2; ++half) {
        const int b0 = half * 16;
        for (int i = tid; i < 16384; i += 512) { const float cv = p.c[b0 * 1024 + i]; SC[i] = cv / (1.f + __expf(-cv)); }
        __syncthreads();
        float acc[16];
#pragma unroll
        for (int bb = 0; bb < 16; ++bb) acc[bb] = 0.f;
        for (int d = wv * 128; d < wv * 128 + 128; d += 4) {
            const float w0 = p.w_ada[(size_t)d * 6144 + e], w1 = p.w_ada[(size_t)(d + 1) * 6144 + e], w2 = p.w_ada[(size_t)(d + 2) * 6144 + e], w3 = p.w_ada[(size_t)(d + 3) * 6144 + e];
#pragma unroll
            for (int bb = 0; bb < 16; ++bb) { const f32x4 s = *(const f32x4*)(SC + bb * 1024 + d); acc[bb] += (s.x * w0 + s.y * w1) + (s.z * w2 + s.w * w3); }
        }
#pragma unroll
        for (int bb = 0; bb < 16; ++bb) RED[(wv * 16 + bb) * 64 + lane] = acc[bb];
        __syncthreads();
#pragma unroll
        for (int q = 0; q < 2; ++q) { const int bb = wv * 2 + q; float s = p.b_ada[e];
#pragma unroll
            for (int ww = 0; ww < 8; ++ww) s += RED[(ww * 16 + bb) * 64 + lane];
            mod[(size_t)(b0 + bb) * 6144 + e] = s; }
        __syncthreads();
    }
}
__device__ __forceinline__ void phase_pro(const Params& p, unsigned char* lds, int tid, int G) {
    const int lane = tid & 63, wv = tid >> 6;
    for (int cb = blockIdx.x; cb < 96; cb += G) adaln_block(p, (float*)lds, cb, tid);
    __syncthreads();
    float* scr = (float*)lds + wv * (64 * 33 + 16);
    const int gw = blockIdx.x * NWAVES + wv, NGW = G * NWAVES;
    bf16* WIN = (bf16*)(p.ws + WS_WIN); bf16* WOUT = (bf16*)(p.ws + WS_WOUT); bf16* W1 = (bf16*)(p.ws + WS_W1); bf16* W2 = (bf16*)(p.ws + WS_W2);
    bf16* WUKT = (bf16*)(p.ws + WS_WUKT); bf16* WUK = (bf16*)(p.ws + WS_WUK); bf16* WUVT = (bf16*)(p.ws + WS_WUVT);
    constexpr int I_IN = (DM / 64) * (NPROJ / 32), I_OUT = (DM / 64) * (DM / 32), I_1 = (DM / 64) * (FF / 32), I_2 = (FF / 64) * (DM / 32), I_UK = (128 / 64) * (512 / 32);
    constexpr int I_LR = 512 / 32;
    constexpr int NITEMS = I_IN + I_OUT + I_1 + I_2 + 2 * I_UK + 4 * I_LR;
    for (int it = gw; it < NITEMS; it += NGW) {
        int r = it;
        if (r < I_IN) { if (MK_F8_GEMM1) conv_t_item_f8(p.w_in, DM, 3016, (unsigned char*)WIN, NPROJ / 32, r, scr, lane, 32.f, true); else conv_t_item(p.w_in, DM, 3016, WIN, NPROJ / 32, r, scr, lane, true); continue; } r -= I_IN;
        if (r < I_OUT) { conv_t_item(p.w_out, DM, DM, WOUT, DM / 32, r, scr, lane, false); continue; } r -= I_OUT;
        if (r < I_1) { conv_t_item(p.w_ff1, DM, FF, W1, FF / 32, r, scr, lane, false); continue; } r -= I_1;
        if (r < I_2) { conv_t_item_f8(p.w_ff2, FF, DM, (unsigned char*)W2, DM / 32, r, scr, lane, 64.f); continue; } r -= I_2;
        if (r < I_UK) { conv_t_item(p.w_uk, 128, 512, WUKT, 512 / 32, r, scr, lane, false); continue; } r -= I_UK;
        if (r < I_UK) { conv_t_item(p.w_uv, 128, 512, WUVT, 512 / 32, r, scr, lane, false); continue; } r -= I_UK;
        if (r < I_LR) { conv_t_item(p.w2, 64, 512, (bf16*)(p.ws + WS_W2T), 512 / 32, r, scr, lane, false); continue; } r -= I_LR;
        if (r < I_LR) { conv_t_item(p.a2, 64, 512, (bf16*)(p.ws + WS_A2T), 512 / 32, r, scr, lane, false); continue; } r -= I_LR;
        conv_t_item(p.g2, 128, 512, (bf16*)(p.ws + WS_G2T), 512 / 32, r, scr, lane, false);
    }
    for (int i = blockIdx.x * 512 + tid; i < 128 * 512 / 2; i += G * 512) { const float a = p.w_uk[2 * i], b = p.w_uk[2 * i + 1]; ((unsigned*)WUK)[i] = pk2(a, b); }
}

template <bool F8OUT> __device__ __forceinline__ void hn_rows(const float* src, const float* g, const float* mod, int off_sh, int off_sc, bf16* dst, int gw, int NGW, int lane) {
    for (int m = gw; m < M; m += NGW) {
        const f32x4* xr = (const f32x4*)(src + (size_t)m * DM) + lane;
        f32x4 v[4]; float s = 0.f;
#pragma unroll
        for (int j = 0; j < 4; ++j) { v[j] = xr[64 * j]; s += (v[j].x * v[j].x + v[j].y * v[j].y) + (v[j].z * v[j].z + v[j].w * v[j].w); }
        s = wave_sum(s); const float rstd = rsqrtf(s * (1.f / DM) + 1e-6f);
        const float* mb = mod + (size_t)(m >> 11) * 6144;
        unsigned long long* o8 = (unsigned long long*)(dst + (size_t)m * DM) + lane;
#pragma unroll
        for (int j = 0; j < 4; ++j) { const int col = 4 * lane + 256 * j;
            const f32x4 gg = *(const f32x4*)(g + col), sc = *(const f32x4*)(mb + off_sc + col), sh = *(const f32x4*)(mb + off_sh + col);
            const f32x4 y = v[j] * rstd * gg * (1.f + sc) + sh;
            if (F8OUT) ((unsigned*)((unsigned char*)dst + (size_t)m * DM))[lane + 64 * j] = pg8::pk4_fp8(y.x, y.y, y.z, y.w);
            else o8[64 * j] = (unsigned long long)pk2(y.x, y.y) | ((unsigned long long)pk2(y.z, y.w) << 32); }
    }
}

typedef short s16x4 __attribute__((ext_vector_type(4)));
__device__ __forceinline__ f32x4 mfma16k(s16x4 a, s16x4 b, f32x4 c) { return __builtin_amdgcn_mfma_f32_16x16x16bf16_1k(a, b, c, 0, 0, 0); }
__device__ __forceinline__ s16x4 pack4(f32x4 v) { u32x2 o; o.x = pk2(v[0], v[1]); o.y = pk2(v[2], v[3]); return __builtin_bit_cast(s16x4, o); }

__device__ __forceinline__ void rwkv_prep_item(const Params& p, unsigned char* lds, int it, int tid_in) {
    int tid = tid_in; asm volatile("" : "+v"(tid));
    const int lane = tid & 63, wv = __builtin_amdgcn_readfirstlane(tid >> 6);
    bf16* XS = (bf16*)lds;
    bf16* LO = (bf16*)(lds + 16384) + wv * 2048;
    bf16* STG = (bf16*)(lds + 49152) + wv * 4096;
    float* MAB = (float*)(lds + 114688) + wv * 256;
    bf16* RKV = (bf16*)(lds + 122880) + wv * 1728;
    const bf16* PROJ = (const bf16*)(p.ws + WS_PROJ);
    const bf16* W2T = (const bf16*)(p.ws + WS_W2T); const bf16* A2T = (const bf16*)(p.ws + WS_A2T); const bf16* G2T = (const bf16*)(p.ws + WS_G2T);
    float* GAM = (float*)(p.ws + WS_GAM); float* C3 = (float*)(p.ws + WS_C3); bf16* GB = (bf16*)(p.ws + WS_G);
    const int row0 = it * 64, t0 = (it & 31) * 64, b = it >> 5;
    const int c = wv * 64 + lane;
    const float mu_r = p.mu[c], mu_k = p.mu[512 + c], mu_v = p.mu[1024 + c];
    const float w0c = p.w0[c], a0c = p.a0[c], kkc = p.k_k[c], kac = p.k_a[c], rkc = p.r_k[c];
    const int xt = tid >> 5, xch = tid & 31;
    u32x4 xcur, xprv;
#define XS_LOAD(rowbase, tbase) do { const bf16* src_ = PROJ + (size_t)((rowbase) + xt) * NPROJ + PC_XW + 8 * xch; xcur = *(const u32x4*)src_; \
        xprv = (u32x4){0u, 0u, 0u, 0u}; if ((tbase) + xt != 0) xprv = *(const u32x4*)(src_ - NPROJ); } while (0)
#define XS_WRITE(buf) do { const f32x4 m0_ = *(const f32x4*)(p.mu + 1536 + 8 * xch), m1_ = *(const f32x4*)(p.mu + 1536 + 8 * xch + 4); const float sc_ = xch < 8 ? 2.f : -1.f; float o_[8]; \
        _Pragma("unroll") for (int i = 0; i < 4; ++i) { const float c0_ = bflo(xcur[i]), c1_ = bfhi(xcur[i]), p0_ = bflo(xprv[i]), p1_ = bfhi(xprv[i]); \
            const float ma_ = i < 2 ? m0_[2 * i] : m1_[2 * i - 4], mb_ = i < 2 ? m0_[2 * i + 1] : m1_[2 * i - 3]; \
            const float v0_ = c0_ + ma_ * (p0_ - c0_), v1_ = c1_ + mb_ * (p1_ - c1_); \
            const float r0_ = 1.f / (1.f + __expf(sc_ * v0_)), r1_ = 1.f / (1.f + __expf(sc_ * v1_)); \
            o_[2 * i] = xch < 8 ? 1.f - 2.f * r0_ : (xch < 16 ? v0_ : r0_); o_[2 * i + 1] = xch < 8 ? 1.f - 2.f * r1_ : (xch < 16 ? v1_ : r1_); } \
        *(u32x4*)(XS + (buf) * 4096 + xt * 256 + 8 * xch) = (u32x4){pk2(o_[0], o_[1]), pk2(o_[2], o_[3]), pk2(o_[4], o_[5]), pk2(o_[6], o_[7])}; } while (0)
    u32x4 RK[4];
#define RKV_LOAD(rowb, tb) do { _Pragma("unroll") for (int i = 0; i < 4; ++i) { const int id_ = i * 64 + lane, mat_ = id_ / 72, rem_ = id_ - 72 * mat_, rw_ = rem_ >> 3, ch_ = rem_ & 7; \
        RK[i] = (u32x4){0u, 0u, 0u, 0u}; if (id_ < 216 && (tb) - 1 + rw_ >= 0) RK[i] = *(const u32x4*)(PROJ + (size_t)((rowb) - 1 + rw_) * NPROJ + PC_R + 512 * mat_ + wv * 64 + 8 * ch_); } } while (0)
#define RKV_WRITE() do { _Pragma("unroll") for (int i = 0; i < 4; ++i) { const int id_ = i * 64 + lane, mat_ = id_ / 72, rem_ = id_ - 72 * mat_, rw_ = rem_ >> 3, ch_ = rem_ & 7; \
        if (id_ < 216) *(u32x4*)(RKV + mat_ * 576 + rw_ * 64 + 8 * ch_) = RK[i]; } } while (0)
    XS_LOAD(row0, t0); XS_WRITE(0);
    __syncthreads();
#pragma unroll 1
    for (int q = 0; q < 4; ++q) {
        const int rowq = row0 + 16 * q, tq = t0 + 16 * q;
        int lane_ = lane; asm volatile("" : "+v"(lane_));
        const int n_ = lane_ & 15, grp_ = lane_ >> 4;
        const size_t idx = (size_t)(b * 8 + wv) * 128 + (tq >> 4);
        unsigned char* CHp = p.ws + WS_CH + idx * 12288;
        const bf16* XSq = XS + (q & 1) * 4096;
        RKV_LOAD(rowq, tq);
        if (q < 3) XS_LOAD(rowq + 16, tq + 16);
        {   bf16x8 xa[8];
#pragma unroll
            for (int ks = 0; ks < 8; ++ks) xa[ks] = *(const bf16x8*)(XSq + n_ * 256 + 32 * ks + 8 * grp_);
#pragma unroll
            for (int ct = 0; ct < 4; ++ct) { const int cc = wv * 64 + 16 * ct + n_;
                f32x4 dw = {0.f, 0.f, 0.f, 0.f}, da = dw, dg = dw;
#pragma unroll
                for (int ks = 0; ks < 2; ++ks) dw = mfma16(xa[ks], *(const bf16x8*)(W2T + cc * 64 + 32 * ks + 8 * grp_), dw);
#pragma unroll
                for (int ks = 0; ks < 2; ++ks) da = mfma16(xa[2 + ks], *(const bf16x8*)(A2T + cc * 64 + 32 * ks + 8 * grp_), da);
#pragma unroll
                for (int ks = 0; ks < 4; ++ks) dg = mfma16(xa[4 + ks], *(const bf16x8*)(G2T + cc * 128 + 32 * ks + 8 * grp_), dg);
#pragma unroll
                for (int rg = 0; rg < 4; ++rg) { const int o = (4 * grp_ + rg) * 64 + 16 * ct + n_; LO[o] = f2bf(dw[rg]); LO[1024 + o] = f2bf(da[rg]);
                    GB[(size_t)(rowq + 4 * grp_ + rg) * 512 + cc] = f2bf(dg[rg]); } }
        }
        RKV_WRITE();
        if (q < 3) XS_WRITE((q + 1) & 1);
        asm volatile("s_waitcnt lgkmcnt(0)" ::: "memory");
        {   float gam = 1.f; unsigned btp[8], ktp[8], vtp[8]; float be = 0.f, ke = 0.f, ve = 0.f;
#pragma unroll
            for (int hf = 0; hf < 2; ++hf) {
                float rr_[8], vv_[8], ww_[8], aa_[8], kkv_[8], kpr_[8], nrm_[8], c3_[8];
                if (hf == 0) RKV_LOAD(rowq + 8, tq + 8);
#pragma unroll
                for (int tt = 0; tt < 8; ++tt) { const int t = 8 * hf + tt;
                    const float rp = bf2f(RKV[tt * 64 + lane_]), rc = bf2f(RKV[(tt + 1) * 64 + lane_]);
                    const float kp = bf2f(RKV[576 + tt * 64 + lane_]), kc = bf2f(RKV[576 + (tt + 1) * 64 + lane_]);
                    const float vp = bf2f(RKV[1152 + tt * 64 + lane_]), vc = bf2f(RKV[1152 + (tt + 1) * 64 + lane_]);
                    const float r = rc + mu_r * (rp - rc), k = kc + mu_k * (kp - kc); vv_[tt] = vc + mu_v * (vp - vc);
                    const float lw = bf2f(LO[t * 64 + lane_]), la = bf2f(LO[1024 + t * 64 + lane_]);
                    const float u = w0c + lw; const float wlog = -__logf(1.f + __expf(-u)) - 0.5f; ww_[tt] = __expf(-__expf(wlog));
                    const float a = 1.f / (1.f + __expf(-(a0c + la))); aa_[tt] = a; rr_[tt] = r;
                    kkv_[tt] = k * kkc; kpr_[tt] = k * (1.f + (a - 1.f) * kac);
                    nrm_[tt] = kkv_[tt] * kkv_[tt]; c3_[tt] = r * kpr_[tt] * rkc; }
                asm volatile("s_waitcnt lgkmcnt(0)" ::: "memory");
                if (hf == 0) RKV_WRITE();
#pragma unroll
                for (int o = 1; o < 64; o <<= 1) {
#pragma unroll
                    for (int tt = 0; tt < 8; ++tt) { nrm_[tt] += __shfl_xor(nrm_[tt], o); c3_[tt] += __shfl_xor(c3_[tt], o); } }
#pragma unroll
                for (int tt = 0; tt < 8; ++tt) { const int t = 8 * hf + tt;
                    const float kk = kkv_[tt] / fmaxf(sqrtf(nrm_[tt]), 1e-12f);
                    const float gprev = gam; gam *= ww_[tt]; const float ig = 1.f / gam;
                    STG[t * 64 + lane_] = f2bf(-kk * gprev); STG[1024 + t * 64 + lane_] = f2bf(rr_[tt] * gam);
                    const float bt = kk * aa_[tt] * ig, kt = kpr_[tt] * ig;
                    STG[2048 + t * 64 + lane_] = f2bf(bt); STG[3072 + t * 64 + lane_] = f2bf(kt);
                    if (t & 1) { btp[t >> 1] = pk2(be, bt); ktp[t >> 1] = pk2(ke, kt); vtp[t >> 1] = pk2(ve, vv_[tt]); } else { be = bt; ke = kt; ve = vv_[tt]; }
                    if (lane_ == 0) C3[(size_t)(rowq + t) * 8 + wv] = c3_[tt]; }
            }
            *(u32x4*)(CHp + 4096 + lane_ * 32) = (u32x4){btp[0], btp[1], btp[2], btp[3]}; *(u32x4*)(CHp + 4096 + lane_ * 32 + 16) = (u32x4){btp[4], btp[5], btp[6], btp[7]};
            *(u32x4*)(CHp + 6144 + lane_ * 32) = (u32x4){ktp[0], ktp[1], ktp[2], ktp[3]}; *(u32x4*)(CHp + 6144 + lane_ * 32 + 16) = (u32x4){ktp[4], ktp[5], ktp[6], ktp[7]};
            *(u32x4*)(CHp + 8192 + lane_ * 32) = (u32x4){vtp[0], vtp[1], vtp[2], vtp[3]}; *(u32x4*)(CHp + 8192 + lane_ * 32 + 16) = (u32x4){vtp[4], vtp[5], vtp[6], vtp[7]};
            GAM[idx * 64 + lane_] = gam;
        }
        asm volatile("s_waitcnt lgkmcnt(0)" ::: "memory");
        {   f32x4 mab = {0.f, 0.f, 0.f, 0.f}, mak = mab, nrb = mab, nrk = mab;
#pragma unroll
            for (int ks = 0; ks < 4; ++ks) { const int o = n_ * 64 + 16 * ks + 4 * grp_;
                const s16x4 fa = *(const s16x4*)(STG + o), fr = *(const s16x4*)(STG + 1024 + o), fb = *(const s16x4*)(STG + 2048 + o), fk = *(const s16x4*)(STG + 3072 + o);
                mab = mfma16k(fa, fb, mab); mak = mfma16k(fa, fk, mak); nrb = mfma16k(fr, fb, nrb); nrk = mfma16k(fr, fk, nrk); }
            asm volatile("s_waitcnt lgkmcnt(0)" ::: "memory");
            bf16* SM = STG + 2048;
#pragma unroll
            for (int rg = 0; rg < 4; ++rg) { const int t = 4 * grp_ + rg; const bool sl = t > n_, il = t >= n_;
                MAB[t * 16 + n_] = sl ? mab[rg] : 0.f;
                SM[256 + t * 16 + n_] = f2bf(sl ? mak[rg] : 0.f); SM[512 + t * 16 + n_] = f2bf(il ? nrb[rg] : 0.f); SM[768 + t * 16 + n_] = f2bf(il ? nrk[rg] : 0.f); }
            asm volatile("s_waitcnt lgkmcnt(0)" ::: "memory");
            if (lane_ < 16) {
                float Tc[16];
#pragma unroll
                for (int t = 0; t < 16; ++t) { float acc = (t == lane_) ? 1.f : 0.f;
#pragma unroll
                    for (int s = 0; s < t; ++s) acc = fmaf(MAB[t * 16 + s], Tc[s], acc);
                    Tc[t] = acc; SM[t * 16 + lane_] = f2bf(acc); }
            }
            asm volatile("s_waitcnt lgkmcnt(0)" ::: "memory");
#pragma unroll
            for (int i = 0; i < 4; ++i) { const int id = i * 64 + lane_; *(u32x4*)(CHp + id * 16) = *(const u32x4*)((const unsigned char*)STG + id * 16); }
#pragma unroll
            for (int i = 0; i < 2; ++i) { const int id = i * 64 + lane_; *(u32x4*)(CHp + 10240 + id * 16) = *(const u32x4*)((const unsigned char*)SM + id * 16); }
        }
        __syncthreads();
    }
#undef XS_LOAD
#undef XS_WRITE
#undef RKV_LOAD
#undef RKV_WRITE
}

__device__ __forceinline__ void stage_w_lds(const bf16* W, unsigned char* lds, int log2_cpr  , int tid) {
    const int cpr = 1 << log2_cpr;
#pragma unroll 4
    for (int i = 0; i < 16; ++i) { const int id = i * 512 + tid, row = id >> log2_cpr, ch = id & (cpr - 1);
        *(u32x4*)(lds + ((size_t)row << (log2_cpr + 4)) + (((ch & ~15) | ((ch ^ row) & 15)) << 4)) = *(const u32x4*)((const unsigned char*)W + (size_t)id * 16); }
}
__device__ __forceinline__ bf16x8 lds_wfrag(const unsigned char* lds, int row, int ch, int log2_cpr) {
    return *(const bf16x8*)(lds + ((size_t)row << (log2_cpr + 4)) + (((ch & ~15) | ((ch ^ row) & 15)) << 4));
}
__device__ __forceinline__ void dsa_prep_kv(const Params& p, const unsigned char* wl, int tile, int lane) {
    const bf16* PROJ = (const bf16*)(p.ws + WS_PROJ); bf16* CKV = (bf16*)(p.ws + WS_CKV); float* INVR = (float*)(p.ws + WS_INVR);
    const int r = lane & 31, hh = lane >> 5; const size_t row = (size_t)tile * 32 + r; const bf16* prow = PROJ + row * NPROJ;
    bf16x8 cf[8];
    {   u32x4 craw[8]; float ssq = 0.f;
#pragma unroll
        for (int s = 0; s < 8; ++s) { craw[s] = *(const u32x4*)(prow + PC_CL + 16 * s + 8 * hh);
#pragma unroll
            for (int w = 0; w < 4; ++w) { const float lo = bflo(craw[s][w]), hi = bfhi(craw[s][w]); ssq += lo * lo + hi * hi; } }
        ssq += __shfl_xor(ssq, 32);
        const float rstd = rsqrtf(ssq * (1.f / 128.f) + 1e-6f);
#pragma unroll
        for (int s = 0; s < 8; ++s) { const float* g = p.g_kv + 16 * s + 8 * hh; const f32x4 g0 = *(const f32x4*)g, g1 = *(const f32x4*)(g + 4);
            u32x4 o; o.x = pk2(bflo(craw[s].x) * rstd * g0.x, bfhi(craw[s].x) * rstd * g0.y); o.y = pk2(bflo(craw[s].y) * rstd * g0.z, bfhi(craw[s].y) * rstd * g0.w);
            o.z = pk2(bflo(craw[s].z) * rstd * g1.x, bfhi(craw[s].z) * rstd * g1.y); o.w = pk2(bflo(craw[s].w) * rstd * g1.z, bfhi(craw[s].w) * rstd * g1.w);
            cf[s] = __builtin_bit_cast(bf16x8, o); *(u32x4*)(CKV + row * 128 + 16 * s + 8 * hh) = o; }
    }
    unsigned wb[8];
#pragma unroll
    for (int s = 0; s < 8; ++s) wb[s] = (unsigned)(r * 256 + ((((2 * s + hh) ^ r) & 15) << 4));
#pragma unroll 1
    for (int h = 0; h < 8; ++h) { float ss = 0.f;
#pragma unroll
        for (int dt = 0; dt < 2; ++dt) { f32x16 acc = {}; const unsigned char* wg = wl + (h * 64 + dt * 32) * 256;
#pragma unroll
            for (int s = 0; s < 8; ++s) acc = mfma32(*(const bf16x8*)(wg + wb[s]), cf[s], acc);
#pragma unroll
            for (int i = 0; i < 16; ++i) ss += acc[i] * acc[i]; }
        ss += __shfl_xor(ss, 32);
        if (hh == 0) INVR[row * 8 + h] = rsqrtf(ss * (1.f / 64.f) + 1e-6f);
    }
}
__device__ __forceinline__ void dsa_prep_q(const Params& p, const unsigned char* wl, int tile, int lane) {
    const bf16* PROJ = (const bf16*)(p.ws + WS_PROJ); bf16* QABS = (bf16*)(p.ws + WS_REGA);
    const int r = lane & 31, hh = lane >> 5; const size_t row = (size_t)tile * 32 + r; const bf16* prow = PROJ + row * NPROJ;
    unsigned wb[2][4];
#pragma unroll
    for (int hp = 0; hp < 2; ++hp)
#pragma unroll
        for (int s = 0; s < 4; ++s) wb[hp][s] = (unsigned)(r * 1024 + ((((hp * 8 + 2 * s + hh) ^ r) & 15) << 4));
#pragma unroll 2
    for (int h = 0; h < 8; ++h) {
        u32x4 qraw[4]; float ssq = 0.f;
#pragma unroll
        for (int s = 0; s < 4; ++s) { qraw[s] = *(const u32x4*)(prow + PC_Q + h * 64 + 16 * s + 8 * hh);
#pragma unroll
            for (int w = 0; w < 4; ++w) { const float lo = bflo(qraw[s][w]), hi = bfhi(qraw[s][w]); ssq += lo * lo + hi * hi; } }
        ssq += __shfl_xor(ssq, 32);
        const float rstd = rsqrtf(ssq * (1.f / 64.f) + 1e-6f);
        bf16x8 qf[4];
#pragma unroll
        for (int s = 0; s < 4; ++s) { const int d0 = 16 * s + 8 * hh; float gg[8];
#pragma unroll
            for (int j = 0; j < 8; ++j) gg[j] = p.g_q[d0 + j] * p.g_k[d0 + j] * rstd;
            u32x4 o; o.x = pk2(bflo(qraw[s].x) * gg[0], bfhi(qraw[s].x) * gg[1]); o.y = pk2(bflo(qraw[s].y) * gg[2], bfhi(qraw[s].y) * gg[3]);
            o.z = pk2(bflo(qraw[s].z) * gg[4], bfhi(qraw[s].z) * gg[5]); o.w = pk2(bflo(qraw[s].w) * gg[6], bfhi(qraw[s].w) * gg[7]);
            qf[s] = __builtin_bit_cast(bf16x8, o); }
#pragma unroll
        for (int lt = 0; lt < 4; ++lt) { f32x16 acc = {}; const unsigned char* wg = wl + lt * 32768 + (h >> 1) * 256;
#pragma unroll
            for (int s = 0; s < 4; ++s) acc = mfma32(*(const bf16x8*)(wg + wb[h & 1][s]), qf[s], acc);
#pragma unroll
            for (int g4 = 0; g4 < 4; ++g4) { u32x2 o; o.x = pk2(acc[4 * g4] * 0.125f, acc[4 * g4 + 1] * 0.125f); o.y = pk2(acc[4 * g4 + 2] * 0.125f, acc[4 * g4 + 3] * 0.125f);
                *(u32x2*)(QABS + row * 1024 + h * 128 + lt * 32 + 8 * g4 + 4 * hh) = o; } }
    }
}

constexpr int SCAN_D = 8, SCAN_SLOT = 12288 + 256;
#define SCAN_BAR() do { asm volatile("s_waitcnt lgkmcnt(0)" ::: "memory"); __builtin_amdgcn_s_barrier(); asm volatile("" ::: "memory"); } while (0)
__device__ __forceinline__ void rwkv_scan_chain(const Params& p, unsigned char* lds, int chain, int wv, int lane) {
    const int b = chain >> 3, h = chain & 7;
    const size_t idx0 = (size_t)(b * 8 + h) * 128;
    if (wv >= 4) {
        const int li = (wv - 4) * 64 + lane;
        const unsigned char* src = p.ws + WS_CH + idx0 * 12288 + (size_t)li * 16; const float* gsrc = (const float*)(p.ws + WS_GAM) + idx0 * 64 + (li & 15) * 4;
        u32x4 R[SCAN_D][3]; f32x4 Rg[SCAN_D];
#pragma unroll
        for (int j = 0; j < SCAN_D; ++j) {
#pragma unroll
            for (int i = 0; i < 3; ++i) R[j][i] = *(const u32x4*)(src + (size_t)j * 12288 + i * 4096);
            Rg[j] = *(const f32x4*)(gsrc + (size_t)j * 64); }
        for (int k0 = 0; k0 < 128; k0 += SCAN_D) {
#pragma unroll
            for (int j = 0; j < SCAN_D; ++j) { const int k = k0 + j; unsigned char* slot = lds + (k & 1) * SCAN_SLOT;
#pragma unroll
                for (int i = 0; i < 3; ++i) *(u32x4*)(slot + li * 16 + i * 4096) = R[j][i];
                *(f32x4*)(slot + 12288 + (li & 15) * 16) = Rg[j];
                if (k + SCAN_D < 128) {
#pragma unroll
                    for (int i = 0; i < 3; ++i) R[j][i] = *(const u32x4*)(src + (size_t)(k + SCAN_D) * 12288 + i * 4096);
                    Rg[j] = *(const f32x4*)(gsrc + (size_t)(k + SCAN_D) * 64); }
                SCAN_BAR(); } }
    } else {
        const int w = wv, n = lane & 15, grp = lane >> 4;
        bf16* PROJ = (bf16*)(p.ws + WS_PROJ);
        f32x4 S[4];
#pragma unroll
        for (int jt = 0; jt < 4; ++jt) S[jt] = (f32x4){0.f, 0.f, 0.f, 0.f};
        for (int sc = 0; sc < 128; ++sc) {
            SCAN_BAR();
            const unsigned char* CHp = lds + (sc & 1) * SCAN_SLOT;
            s16x4 at[4], rt[4], bt[4], kt[4]; f32x4 gm[4];
#pragma unroll
            for (int jt = 0; jt < 4; ++jt) {
                at[jt] = *(const s16x4*)(CHp + n * 128 + (16 * jt + 4 * grp) * 2); rt[jt] = *(const s16x4*)(CHp + 2048 + n * 128 + (16 * jt + 4 * grp) * 2);
                bt[jt] = *(const s16x4*)(CHp + 4096 + (16 * jt + n) * 32 + grp * 8); kt[jt] = *(const s16x4*)(CHp + 6144 + (16 * jt + n) * 32 + grp * 8);
                gm[jt] = *(const f32x4*)(CHp + 12288 + (16 * jt + 4 * grp) * 4); }
            const s16x4 vt = *(const s16x4*)(CHp + 8192 + (16 * w + n) * 32 + grp * 8);
            const s16x4 Tm = *(const s16x4*)(CHp + 10240 + n * 32 + grp * 8), Mak = *(const s16x4*)(CHp + 10752 + n * 32 + grp * 8);
            const s16x4 Nrb = *(const s16x4*)(CHp + 11264 + n * 32 + grp * 8), Nrk = *(const s16x4*)(CHp + 11776 + n * 32 + grp * 8);
            s16x4 Sb[4];
#pragma unroll
            for (int jt = 0; jt < 4; ++jt) Sb[jt] = pack4(S[jt]);
            f32x4 X = {0.f, 0.f, 0.f, 0.f}, O = X;
#pragma unroll
            for (int jt = 0; jt < 4; ++jt) X = mfma16k(at[jt], Sb[jt], X);
            X = mfma16k(Mak, vt, X);
#pragma unroll
            for (int jt = 0; jt < 4; ++jt) O = mfma16k(rt[jt], Sb[jt], O);
            O = mfma16k(Nrk, vt, O);
            const f32x4 U = mfma16k(Tm, pack4(X), (f32x4){0.f, 0.f, 0.f, 0.f});
            const s16x4 Ub = pack4(U);
            O = mfma16k(Nrb, Ub, O);
#pragma unroll
            for (int jt = 0; jt < 4; ++jt) { S[jt] = mfma16k(kt[jt], vt, S[jt]); S[jt] = mfma16k(bt[jt], Ub, S[jt]); S[jt] = S[jt] * gm[jt]; }
            bf16* orow = PROJ + ((size_t)b * SEQ + sc * 16 + 4 * grp) * NPROJ + PC_R + h * 64 + 16 * w + n;
#pragma unroll
            for (int rg = 0; rg < 4; ++rg) orow[(size_t)rg * NPROJ] = f2bf(O[rg]);
        }
    }
}
__device__ __forceinline__ void rwkv_epi_row(const Params& p, int m, int lane) {
    bf16* PROJ = (bf16*)(p.ws + WS_PROJ); const bf16* GB = (const bf16*)(p.ws + WS_G); const float* C3 = (const float*)(p.ws + WS_C3);
    bf16* prow = PROJ + (size_t)m * NPROJ; const int c0 = lane * 8, h = lane >> 3; const bool first = (m & (SEQ - 1)) == 0;
    const u32x4 oraw = *(const u32x4*)(prow + PC_R + c0), vc = *(const u32x4*)(prow + PC_V + c0), gr = *(const u32x4*)(GB + (size_t)m * 512 + c0);
    u32x4 vpv = {0u, 0u, 0u, 0u}; if (!first) vpv = *(const u32x4*)(prow - NPROJ + PC_V + c0);
    float o[8], v[8], g[8];
#pragma unroll
    for (int i = 0; i < 4; ++i) { o[2 * i] = bflo(oraw[i]); o[2 * i + 1] = bfhi(oraw[i]); g[2 * i] = bflo(gr[i]); g[2 * i + 1] = bfhi(gr[i]);
        const float c0v = bflo(vc[i]), c1v = bfhi(vc[i]), p0 = bflo(vpv[i]), p1 = bfhi(vpv[i]);
        const float m0 = p.mu[1024 + c0 + 2 * i], m1 = p.mu[1024 + c0 + 2 * i + 1];
        v[2 * i] = c0v + m0 * (p0 - c0v); v[2 * i + 1] = c1v + m1 * (p1 - c1v); }
    float s = 0.f;
#pragma unroll
    for (int i = 0; i < 8; ++i) s += o[i];
    s += __shfl_xor(s, 1); s += __shfl_xor(s, 2); s += __shfl_xor(s, 4);
    const float mean = s * (1.f / 64.f); float q = 0.f;
#pragma unroll
    for (int i = 0; i < 8; ++i) { o[i] -= mean; q += o[i] * o[i]; }
    q += __shfl_xor(q, 1); q += __shfl_xor(q, 2); q += __shfl_xor(q, 4);
    const float rstd = rsqrtf(q * (1.f / 64.f) + 64e-5f), c3 = C3[(size_t)m * 8 + h];
    u32x4 out;
#pragma unroll
    for (int i = 0; i < 4; ++i) { float y[2];
#pragma unroll
        for (int e = 0; e < 2; ++e) { const int cc = c0 + 2 * i + e; y[e] = (o[2 * i + e] * rstd * p.ln_w[cc] + p.ln_b[cc] + c3 * v[2 * i + e]) * g[2 * i + e]; }
        out[i] = pk2(y[0], y[1]); }
    *(u32x4*)(prow + PC_R + c0) = out;
}

__device__ __forceinline__ unsigned f2key(float f) { unsigned b = __float_as_uint(f); if ((b << 1) == 0u) b = 0u; return (b & 0x80000000u) ? ~b : (b | 0x80000000u); }
__device__ __forceinline__ unsigned offb(unsigned row, unsigned ch) { return 2048u * (row >> 3) + 512u * (ch >> 2) + 64u * (row & 7) + 16u * ((ch & 3) ^ ((row >> 2) & 3)); }

__device__ __forceinline__ void topk_select(float* sc, int N, unsigned* hist, unsigned short* sel, int lane) {
    unsigned* kb = (unsigned*)sc;
    unsigned prefix = 0u, mask = 0u; int rem = 256, mbin = 0;
    const unsigned long long lt_mask = (1ull << lane) - 1ull;
    for (int pass = 0; pass < 4; ++pass) {
        const int shift = 24 - 8 * pass;
#pragma unroll
        for (int i = 0; i < 4; ++i) hist[lane * 4 + i] = 0u;
        asm volatile("s_waitcnt lgkmcnt(0)" ::: "memory");
        for (int base = 0; base < N; base += 256) { const int idx = base + 4 * lane;
            if (idx < N) { u32x4 k4;
                if (pass == 0) { const f32x4 v = *(const f32x4*)(sc + idx); k4 = (u32x4){f2key(v.x), f2key(v.y), f2key(v.z), f2key(v.w)}; *(u32x4*)(kb + idx) = k4; }
                else k4 = *(const u32x4*)(kb + idx);
#pragma unroll
                for (int e = 0; e < 4; ++e) if ((k4[e] & mask) == prefix) atomicAdd(&hist[(k4[e] >> shift) & 255u], 1u); } }
        asm volatile("s_waitcnt lgkmcnt(0)" ::: "memory");
        const unsigned c0 = hist[lane * 4], c1 = hist[lane * 4 + 1], c2 = hist[lane * 4 + 2], c3 = hist[lane * 4 + 3];
        const int cnt4 = (int)(c0 + c1 + c2 + c3);
        int incl = cnt4;
#pragma unroll
        for (int o = 1; o < 64; o <<= 1) { const int v = __shfl_down(incl, o); if (lane + o < 64) incl += v; }
        const int excl = incl - cnt4;
        const bool mine = (excl < rem) && (rem <= incl);
        const unsigned long long bal = __ballot(mine);
        const int L = (int)__builtin_ctzll(bal);
        const int ex = __shfl(excl, L); const int b3 = (int)__shfl((int)c3, L), b2 = (int)__shfl((int)c2, L), b1 = (int)__shfl((int)c1, L), b0 = (int)__shfl((int)c0, L);
        int above = ex, bin;
        if (above + b3 >= rem) { bin = 3; mbin = b3; } else { above += b3; if (above + b2 >= rem) { bin = 2; mbin = b2; } else { above += b2; if (above + b1 >= rem) { bin = 1; mbin = b1; } else { above += b1; bin = 0; mbin = b0; } } }
        rem -= above; prefix |= (unsigned)(L * 4 + bin) << shift; mask |= 0xffu << shift;
        if (pass == 1 && mbin <= 64) break;
    }
    const unsigned T = prefix; const int ngt = 256 - rem; int base_gt = 0, base_eq = 0;
    const bool partial = (mask != 0xffffffffu);
    unsigned short* cand = (unsigned short*)hist;
    for (int base = 0; base < N; base += 256) { const int idx = base + 4 * lane; const bool act = idx < N;
        u32x4 k4 = {0u, 0u, 0u, 0u}; if (act) k4 = *(const u32x4*)(kb + idx);
        bool gt[4], eq[4]; unsigned long long bg[4], be[4];
#pragma unroll
        for (int e = 0; e < 4; ++e) { const unsigned km = k4[e] & mask; gt[e] = act && km > T; eq[e] = act && km == T; bg[e] = __ballot(gt[e]); be[e] = __ballot(eq[e]); }
        int rg = base_gt, re = base_eq;
#pragma unroll
        for (int e = 0; e < 4; ++e) re += __popcll(be[e] & lt_mask);
#pragma unroll
        for (int e = 0; e < 4; ++e) {
            if (gt[e]) sel[rg + __popcll(bg[e] & lt_mask)] = (unsigned short)(idx + e);
            rg += __popcll(bg[e]);
            if (eq[e]) { if (partial) cand[re] = (unsigned short)(idx + e); else if (re < rem) sel[ngt + re] = (unsigned short)(idx + e); re += 1; } }
        base_gt = rg;
#pragma unroll
        for (int e = 0; e < 4; ++e) base_eq += __popcll(be[e]); }
    asm volatile("s_waitcnt lgkmcnt(0)" ::: "memory");
    if (partial) {
        const int m = mbin; const int ci = (lane < m) ? (int)cand[lane] : 0; const unsigned ck = (lane < m) ? kb[ci] : 0u;
        int rank = 0;
        for (int j = 0; j < m; ++j) { const unsigned kj = (unsigned)__shfl((int)ck, j); rank += (kj > ck || (kj == ck && j < lane)) ? 1 : 0; }
        if (lane < m && rank < rem) sel[ngt + rank] = (unsigned short)ci;
        asm volatile("s_waitcnt lgkmcnt(0)" ::: "memory");
    }
}

__device__ __forceinline__ void dsa_attend(const Params& p, int b, int t, const unsigned short* sel, int cnt, unsigned char* stage, int lane_in) {
    int lane = lane_in; asm volatile("" : "+v"(lane));
    const bf16* CKV = (const bf16*)(p.ws + WS_CKV) + (size_t)b * SEQ * 128; const float* INVR = (const float*)(p.ws + WS_INVR) + (size_t)b * SEQ * 8;
    bf16* QO = (bf16*)(p.ws + WS_REGA) + ((size_t)b * SEQ + t) * 1024;
    const int hd = lane & 15, grp = lane >> 4;
    bf16x8 bq[4];
#pragma unroll
    for (int s = 0; s < 4; ++s) { u32x4 z = {0u, 0u, 0u, 0u}; if (hd < 8) z = *(const u32x4*)(QO + hd * 128 + 32 * s + 8 * grp); bq[s] = __builtin_bit_cast(bf16x8, z); }
    const float slope = (hd < 8) ? exp2f(-(float)(hd + 1)) : 0.f;
    const int hsafe = hd & 7;
    float m_run = -INFINITY, l_part = 0.f;
    f32x4 O[8];
#pragma unroll
    for (int c = 0; c < 8; ++c) O[c] = (f32x4){0.f, 0.f, 0.f, 0.f};
    const LAS unsigned char* st3 = (const LAS unsigned char*)stage;
    const unsigned q4 = (lane & 15) >> 2, p4 = lane & 3;
    u32x4 G[8]; float IRn[8], PNn[8];
#define DA_ISSUE(ks_) do { \
    _Pragma("unroll") for (int i = 0; i < 8; ++i) { const int id = i * 64 + lane, row = id >> 4, ch = id & 15; const int key = sel[(ks_) + row]; G[i] = *(const u32x4*)(CKV + (size_t)key * 128 + ch * 8); } } while (0)
#define DA_ISSUE2(ks_) do { \
    _Pragma("unroll") for (int i = 0; i < 8; ++i) { const int key = sel[(ks_) + 16 * (i >> 2) + 4 * grp + (i & 3)]; IRn[i] = INVR[(size_t)key * 8 + hsafe]; PNn[i] = slope * fabsf((float)(t - key)); } } while (0)
    DA_ISSUE(0); DA_ISSUE2(0);
    for (int ks = 0; ks < cnt; ks += 32) {
#pragma unroll
        for (int i = 0; i < 8; ++i) { const int id = i * 64 + lane, row = id >> 4, ch = id & 15; *(u32x4*)(stage + offb(row, ch)) = G[i]; }
        asm volatile("s_waitcnt lgkmcnt(0)" ::: "memory");
        if (ks + 32 < cnt) DA_ISSUE(ks + 32);
        float lg[8];
#pragma unroll
        for (int T = 0; T < 2; ++T) { f32x4 acc = {0.f, 0.f, 0.f, 0.f};
#pragma unroll
            for (int s = 0; s < 4; ++s) { const bf16x8 a = *(const bf16x8*)(stage + offb((lane & 15) + 16 * T, 4 * s + grp)); acc = mfma16(a, bq[s], acc); }
#pragma unroll
            for (int rg = 0; rg < 4; ++rg) lg[4 * T + rg] = acc[rg] * IRn[4 * T + rg] - PNn[4 * T + rg]; }
        if (ks + 32 < cnt) DA_ISSUE2(ks + 32);
        float mx = lg[0];
#pragma unroll
        for (int i = 1; i < 8; ++i) mx = fmaxf(mx, lg[i]);
        mx = fmaxf(mx, __shfl_xor(mx, 16)); mx = fmaxf(mx, __shfl_xor(mx, 32));
        const float m_new = fmaxf(m_run, mx);
        const float alpha = __expf(m_run - m_new);
        float ps = 0.f;
#pragma unroll
        for (int i = 0; i < 8; ++i) { lg[i] = __expf(lg[i] - m_new); ps += lg[i]; }
        l_part = l_part * alpha + ps; m_run = m_new;
        float ar[4];
#pragma unroll
        for (int rg = 0; rg < 4; ++rg) ar[rg] = __shfl(alpha, 4 * grp + rg);
#pragma unroll
        for (int c = 0; c < 8; ++c)
#pragma unroll
            for (int rg = 0; rg < 4; ++rg) O[c][rg] *= ar[rg];
        {   u32x4 pw; pw.x = pk2(lg[0], lg[1]); pw.y = pk2(lg[2], lg[3]); pw.z = pk2(lg[4], lg[5]); pw.w = pk2(lg[6], lg[7]);
            const bf16x8 pa = __builtin_bit_cast(bf16x8, pw);
#pragma unroll
            for (int c = 0; c < 8; ++c) {
                const s16x4 lo = __builtin_bit_cast(s16x4, __builtin_amdgcn_ds_read_tr16_b64_v4i16((LAS s16x4*)(st3 + offb(4 * grp + q4, 2 * c + (p4 >> 1)) + 8 * (p4 & 1))));
                const s16x4 hi = __builtin_bit_cast(s16x4, __builtin_amdgcn_ds_read_tr16_b64_v4i16((LAS s16x4*)(st3 + offb(16 + 4 * grp + q4, 2 * c + (p4 >> 1)) + 8 * (p4 & 1))));
                const bf16x8 vb = {lo[0], lo[1], lo[2], lo[3], hi[0], hi[1], hi[2], hi[3]};
                O[c] = mfma16(pa, vb, O[c]); } }
        asm volatile("s_waitcnt lgkmcnt(0)" ::: "memory");
    }
#undef DA_ISSUE
#undef DA_ISSUE2
    float l = l_part; l += __shfl_xor(l, 16); l += __shfl_xor(l, 32);
    const float il = 1.f / l;
    float irr[4];
#pragma unroll
    for (int rg = 0; rg < 4; ++rg) irr[rg] = __shfl(il, 4 * grp + rg);
    if (grp < 2) {
#pragma unroll
        for (int rg = 0; rg < 4; ++rg)
#pragma unroll
            for (int c = 0; c < 8; ++c) QO[(4 * grp + rg) * 128 + 16 * c + hd] = f2bf(O[c][rg] * irr[rg]);
    }
}

__device__ __forceinline__ void dsa_select_item(const Params& p, unsigned char* lds, int b, int tq0, int tid) {
    bf16* PROJ = (bf16*)(p.ws + WS_PROJ);
    float* SC = (float*)lds;
    unsigned* HIST = (unsigned*)(lds + 131072);
    unsigned short* SEL = (unsigned short*)(lds + 131072 + 8192);
    float* WQ = (float*)(lds + 147456);
    asm volatile("" : "+v"(tid));
    const int lane = tid & 63, wv = __builtin_amdgcn_readfirstlane(tid >> 6);
    const int N = ((tq0 >> 6) + 1) * 64; const size_t rowq0 = (size_t)b * SEQ + tq0;
    {
        const int r = lane & 31, g = lane >> 5;
        const int ql = 2 * ((r >> 2) & 1) + (r >> 4), hdm = 4 * ((r >> 3) & 1) + (r & 3);
        bf16x8 af[4][4];
#pragma unroll
        for (int qg = 0; qg < 4; ++qg)
#pragma unroll
            for (int s = 0; s < 4; ++s) af[qg][s] = *(const bf16x8*)(PROJ + (rowq0 + 4 * qg + ql) * NPROJ + PC_QI + hdm * 64 + 16 * s + 8 * g);
        if (tid < 128) WQ[tid] = bf2f(PROJ[(rowq0 + (tid >> 3)) * NPROJ + PC_WI + (tid & 7)]) * 0.044194173824159216f;
        __syncthreads();
        bf16x8 bfr[4];
        { const bf16* krow = PROJ + ((size_t)b * SEQ + wv * 32 + r) * NPROJ + PC_KI + 8 * g;
#pragma unroll
          for (int s = 0; s < 4; ++s) bfr[s] = *(const bf16x8*)(krow + 16 * s); }
        for (int kt = wv; kt < N / 32; kt += NWAVES) {
            const int key = kt * 32 + r;
            bf16x8 bnx[4];
#pragma unroll
            for (int s = 0; s < 4; ++s) bnx[s] = bfr[s];
            if (kt + NWAVES < N / 32) { const bf16* krow = PROJ + ((size_t)b * SEQ + key + 32 * NWAVES) * NPROJ + PC_KI + 8 * g;
#pragma unroll
                for (int s = 0; s < 4; ++s) bnx[s] = *(const bf16x8*)(krow + 16 * s); }
#pragma unroll
            for (int qg = 0; qg < 4; ++qg) { f32x16 acc = {};
#pragma unroll
                for (int s = 0; s < 4; ++s) acc = mfma32(af[qg][s], bfr[s], acc);
#pragma unroll
                for (int qq = 0; qq < 2; ++qq) { float sc = 0.f; const f32x4 w0 = *(const f32x4*)(WQ + (4 * qg + 2 * g + qq) * 8), w1 = *(const f32x4*)(WQ + (4 * qg + 2 * g + qq) * 8 + 4);
#pragma unroll
                    for (int e = 0; e < 4; ++e) { sc = fmaf(w0[e], fmaxf(acc[8 * qq + e], 0.f), sc); sc = fmaf(w1[e], fmaxf(acc[8 * qq + 4 + e], 0.f), sc); }
                    SC[(4 * qg + 2 * g + qq) * 2048 + key] = sc; } }
#pragma unroll
            for (int s = 0; s < 4; ++s) bfr[s] = bnx[s];
        }
        __syncthreads();
        for (int q = 0; q < 2; ++q) topk_select(SC + (2 * wv + q) * 2048, N, HIST + wv * 256, SEL + (2 * wv + q) * 256, lane);
    }
    asm volatile("s_waitcnt lgkmcnt(0)" ::: "memory");
    { const int q = lane >> 5; const u32x4 v = *(const u32x4*)(SEL + (2 * wv + q) * 256 + (lane & 31) * 8);
      *(u32x4*)(PROJ + (rowq0 + 2 * wv + q) * NPROJ + PC_Q + (lane & 31) * 8) = v; }
    __syncthreads();
}

__device__ __forceinline__ void dsa_attend_row(const Params& p, unsigned char* wlds, int row, int lane) {
    const bf16* PROJ = (const bf16*)(p.ws + WS_PROJ);
    const int b = row >> 11, t = row & (SEQ - 1), N = ((t >> 6) + 1) * 64, cnt = N > 256 ? 256 : N;
    unsigned short* SELW = (unsigned short*)(wlds + 8192);
    if (N > 256) { if (lane < 32) *(u32x4*)(SELW + lane * 8) = *(const u32x4*)(PROJ + (size_t)row * NPROJ + PC_Q + lane * 8); }
    else { for (int i = lane; i < cnt; i += 64) SELW[i] = (unsigned short)i; }
    asm volatile("s_waitcnt vmcnt(0) lgkmcnt(0)" ::: "memory");
    dsa_attend(p, b, t, SELW, cnt, wlds, lane);
    asm volatile("s_waitcnt lgkmcnt(0)" ::: "memory");
}

__device__ __forceinline__ void uv_item(const Params& p, const unsigned char* wl  , int tile, int lane) {
    bf16* PROJ = (bf16*)(p.ws + WS_PROJ); const bf16* OLAT = (const bf16*)(p.ws + WS_REGA);
    const int r = lane & 31, hh = lane >> 5; const size_t row = (size_t)tile * 32 + r;
    unsigned wb[8];
#pragma unroll
    for (int s = 0; s < 8; ++s) wb[s] = (unsigned)(r * 256 + ((((2 * s + hh) ^ r) & 15) << 4));
#pragma unroll 1
    for (int h = 0; h < 8; ++h) { bf16x8 of[8];
#pragma unroll
        for (int s = 0; s < 8; ++s) of[s] = *(const bf16x8*)(OLAT + row * 1024 + h * 128 + 16 * s + 8 * hh);
#pragma unroll
        for (int dt = 0; dt < 2; ++dt) { f32x16 acc = {}; const unsigned char* wg = wl + (h * 64 + dt * 32) * 256;
#pragma unroll
            for (int s = 0; s < 8; ++s) acc = mfma32(*(const bf16x8*)(wg + wb[s]), of[s], acc);
#pragma unroll
            for (int g4 = 0; g4 < 4; ++g4) { u32x2 o; o.x = pk2(acc[4 * g4], acc[4 * g4 + 1]); o.y = pk2(acc[4 * g4 + 2], acc[4 * g4 + 3]);
                *(u32x2*)(PROJ + row * NPROJ + PC_Q + h * 64 + dt * 32 + 8 * g4 + 4 * hh) = o; } }
    }
}

enum { PH_PRO = 0, PH_HN, PH_GEMM1, PH_PREP, PH_MIX, PH_ATT, PH_UV, PH_GOUT, PH_HN2, PH_UP, PH_DOWN, PH_COUNT };
#ifndef MK_SKIP_MIXER
#define MK_SKIP_MIXER 0
#endif
__global__ void __launch_bounds__(NWAVES * 64, 2) mk_fwd(Params p) {
    extern __shared__ __attribute__((aligned(16))) unsigned char lds[];
    cg::grid_group grid = cg::this_grid();
    const int tid = threadIdx.x, lane = tid & 63, wv = __builtin_amdgcn_readfirstlane(tid >> 6);
    const int G = gridDim.x, gw = blockIdx.x * NWAVES + wv, NGW = G * NWAVES;
    const int lo = p.ph_lo, hi = p.ph_hi;
    float* MOD = (float*)(p.ws + WS_MOD); bf16* REGA = (bf16*)(p.ws + WS_REGA); bf16* PROJ = (bf16*)(p.ws + WS_PROJ);
#ifndef MK_PHASE_MASK
#define MK_PHASE_MASK 0x7ff
#endif
#define IN(k) (((MK_PHASE_MASK >> (k)) & 1) && lo <= (k) && (k) < hi)
#define SEAM(k) do { if (IN(k) && IN((k) + 1)) grid.sync(); } while (0)
    if (IN(PH_PRO)) { phase_pro(p, lds, tid, G); }
    SEAM(PH_PRO);
    if (IN(PH_HN)) { hn_rows<MK_F8_GEMM1 != 0>(p.x, p.g_mix, MOD, 0, 1024, REGA, gw, NGW, lane); }
    SEAM(PH_HN);
    if (IN(PH_GEMM1)) {
#if MK_F8_GEMM1
        pg8::Gemm g{REGA, (const bf16*)(p.ws + WS_WIN), M, NPROJ, DM / 2, DM / 2}; pg8::StaticOrder S; S.init(M, NPROJ, G, (int)blockIdx.x);
        pg8::EpiBf16<0> E{PROJ, NPROJ, 1.f / 32.f};
        pg8::gemm_phase<pg8::EpiBf16<0>, pg8::StaticOrder, true, true, true>((PG8_LAS unsigned char*)lds, g, S, E);
#else
        pg8::Gemm g{REGA, (const bf16*)(p.ws + WS_WIN), M, NPROJ, DM, DM}; pg8::StaticOrder S; S.init(M, NPROJ, G, (int)blockIdx.x);
        pg8::EpiBf16<0> E{PROJ, NPROJ, 1.f};
        pg8::gemm_phase<pg8::EpiBf16<0>, pg8::StaticOrder, true, true>((PG8_LAS unsigned char*)lds, g, S, E);
#endif
    }
    SEAM(PH_GEMM1);
    if (IN(PH_PREP)) {
#ifndef DBG_NO_RP
        for (int it = blockIdx.x; it < M / 64; it += G) rwkv_prep_item(p, lds, it, tid);
#endif
#ifndef DBG_NO_DP
        stage_w_lds((const bf16*)(p.ws + WS_WUKT), lds, 4, tid); __syncthreads();
        for (int tile = gw; tile < M / 32; tile += NGW) dsa_prep_kv(p, lds, tile, lane);
        __syncthreads();
        stage_w_lds((const bf16*)(p.ws + WS_WUK), lds, 6, tid); __syncthreads();
        for (int tile = gw; tile < M / 32; tile += NGW) dsa_prep_q(p, lds, tile, lane);
#endif
    }
    SEAM(PH_PREP);
    if (IN(PH_MIX)) {
        for (int chain = blockIdx.x; chain < NB * 8; chain += G) { rwkv_scan_chain(p, lds, chain, wv, lane); __syncthreads(); }
        constexpr int NSEL = NB * 112;
        for (int k = 0; k * G < NSEL; ++k) { const int idx = k * G + ((k & 1) ? (G - 1 - (int)blockIdx.x) : (int)blockIdx.x);
            if (idx < NSEL) dsa_select_item(p, lds, idx / 112, 256 + 16 * (idx % 112), tid); }
    }
    SEAM(PH_MIX);
    if (IN(PH_ATT)) {
        for (int row = gw; row < M; row += NGW) dsa_attend_row(p, lds + wv * 9216, row, lane);
    }

    SEAM(PH_ATT);
    if (IN(PH_UV)) {
#if MK_DBG == 7
        for (int m = gw; m < M; m += NGW) { *(u32x4*)(PROJ + (size_t)m * NPROJ + lane * 8) = *(const u32x4*)(REGA + (size_t)m * 1024 + lane * 8); }
#elif MK_DBG != 2
        stage_w_lds((const bf16*)(p.ws + WS_WUVT), lds, 4, tid); __syncthreads();
        for (int tile = gw; tile < M / 32; tile += NGW) uv_item(p, lds, tile, lane);
#endif
#if MK_DBG == 0
        for (int m = gw; m < M; m += NGW) rwkv_epi_row(p, m, lane);
#endif
#if MK_DBG == 1 || MK_DBG == 2
        for (int m = gw; m < M; m += NGW) { u32x4 z = {0u, 0u, 0u, 0u}; *(u32x4*)(PROJ + (size_t)m * NPROJ + (MK_DBG == 1 ? 512 : 0) + lane * 8) = z; }
#endif
    }
    SEAM(PH_UV);
    if (IN(PH_GOUT)) {
        pg8::Gemm g{PROJ, (const bf16*)(p.ws + WS_WOUT), M, DM, DM, NPROJ}; pg8::StaticOrder S; S.init(M, DM, G, (int)blockIdx.x);
        pg8::EpiResGate E{p.x, p.out, DM, MOD + 2048, 6144, 1.f};
        pg8::gemm_phase<pg8::EpiResGate, pg8::StaticOrder, true, true>((PG8_LAS unsigned char*)lds, g, S, E);
    }
    SEAM(PH_GOUT);
    if (IN(PH_HN2)) { hn_rows<false>(MK_SKIP_MIXER ? p.x : p.out, p.g_ffn, MOD, 3072, 4096, REGA, gw, NGW, lane); }
    SEAM(PH_HN2);
    if (IN(PH_UP)) {
        pg8::Gemm g{REGA, (const bf16*)(p.ws + WS_W1), M, FF, DM, DM}; pg8::StaticOrder S; S.init(M, FF, G, (int)blockIdx.x);
        pg8::EpiF8Relu2 E{p.ws + WS_U, FF, 4.f};
        pg8::gemm_phase<pg8::EpiF8Relu2, pg8::StaticOrder, true, true>((PG8_LAS unsigned char*)lds, g, S, E);
    }
    SEAM(PH_UP);
    if (IN(PH_DOWN)) {
        pg8::Gemm g{(const bf16*)(p.ws + WS_U), (const bf16*)(p.ws + WS_W2), M, DM, FF / 2, FF / 2}; pg8::StaticOrder S; S.init(M, DM, G, (int)blockIdx.x);
        pg8::EpiResGate E{MK_SKIP_MIXER ? p.x : p.out, p.out, DM, MOD + 5120, 6144, 1.f / 256.f};
        pg8::gemm_phase<pg8::EpiResGate, pg8::StaticOrder, true, true, true>((PG8_LAS unsigned char*)lds, g, S, E);
    }
#undef IN
#undef SEAM
}

#ifndef MK_N_LAUNCHES
#define MK_N_LAUNCHES 1
#endif
extern "C" void kernel_launch(void* const* d_in, const int* in_sizes, int n_in, void* d_out, int out_size, void* d_ws, size_t ws_size, hipStream_t stream) {
    static int grid = 0;
    if (grid == 0) {
        if (n_in != 26 || out_size != M * DM || ws_size < WS_END) { fprintf(stderr, "kernel_launch: unexpected shapes (n_in %d out %d ws %zu)\n", n_in, out_size, ws_size); grid = -1; return; }
        int dev = 0, cus = 0, per_cu = 0;
        hipGetDevice(&dev); hipDeviceGetAttribute(&cus, hipDeviceAttributeMultiprocessorCount, dev);
        if (hipFuncSetAttribute((const void*)mk_fwd, hipFuncAttributeMaxDynamicSharedMemorySize, LDS_BYTES) != hipSuccess) { fprintf(stderr, "kernel_launch: hipFuncSetAttribute failed\n"); grid = -1; return; }
        if (hipOccupancyMaxActiveBlocksPerMultiprocessor(&per_cu, (const void*)mk_fwd, NWAVES * 64, LDS_BYTES) != hipSuccess || per_cu < 1) { fprintf(stderr, "kernel_launch: occupancy query says %d\n", per_cu); per_cu = 1; }
        (void)hipGetLastError();
        grid = cus * 1;
        if (per_cu < 1) grid = -1;
    }
    if (grid < 0) return;
    Params p{};
    const float** pp = (const float**)&p;
    for (int i = 0; i < 26; ++i) pp[i] = (const float*)d_in[i];
    p.out = (float*)d_out; p.ws = (unsigned char*)d_ws;
#if MK_N_LAUNCHES == 1
    p.ph_lo = 0; p.ph_hi = PH_COUNT;
    void* args[] = {&p};
    hipError_t e = hipLaunchCooperativeKernel((const void*)mk_fwd, dim3(grid), dim3(NWAVES * 64), args, LDS_BYTES, stream);
    if (e != hipSuccess) fprintf(stderr, "cooperative launch failed: %s (grid %d)\n", hipGetErrorString(e), grid);
#else
    for (int ph = 0; ph < PH_COUNT; ++ph) {
#if MK_SKIP_MIXER
        if (ph >= PH_HN && ph <= PH_GOUT) continue;
#endif
        p.ph_lo = ph; p.ph_hi = ph + 1;
        hipLaunchKernelGGL(mk_fwd, dim3(grid), dim3(NWAVES * 64), LDS_BYTES, stream, p);
    }
#endif
}
```

```cpp
#include <hip/hip_runtime.h>
#include <hip/hip_cooperative_groups.h>
#include <cstdio>
#include <cstdint>
#include <cmath>
namespace cg = cooperative_groups;
#ifndef MK_F8_GEMM1
#define MK_F8_GEMM1 0
#endif
#ifndef MK_PROBE
#define MK_PROBE -1
#endif
#ifndef MK_DBG
#define MK_DBG 0
#endif
#ifndef MK_DBG_NOTOPK
#define MK_DBG_NOTOPK 0
#endif
namespace pg8 {
#define PG8_LAS __attribute__((address_space(3)))
typedef unsigned short bf16_t;
typedef short bf16x8 __attribute__((ext_vector_type(8)));
typedef float f32x4 __attribute__((ext_vector_type(4)));
typedef unsigned u32x4 __attribute__((ext_vector_type(4)));
constexpr int BM = 256, BK = 64, HALF = 128, HTB = HALF * BK * 2  , STAGE_BYTES = 8 * HTB, NXCD = 8, WGM = 8;

__host__ __device__ __forceinline__ int lds_byte(int r, int c) { const int st = (r >> 4) * 2 + (c >> 5), rr = r & 15, cc = c & 31, ob = rr * 64 + cc * 2; return st * 1024 + (ob ^ (((ob >> 9) & 1) << 5)); }
__host__ __device__ __forceinline__ void stage_rc(int b, int& R, int& C) { const int st = b / 1024, sb = b % 1024, swz = sb ^ (((sb >> 9) & 1) << 5); R = (st >> 1) * 16 + swz / 64; C = (st & 1) * 32 + (swz % 64) / 2; }
__host__ __device__ __forceinline__ int perm32(int rho) { const int n = rho >> 4, i = rho & 15; return 8 * (i >> 2) + 4 * n + (i & 3); }

struct Unit { int pm, pn; };
struct Gemm { const bf16_t* A; const bf16_t* Bt; int M, N, K, lda; };

struct StaticOrder {
    int nM, nN, nwg, G, c;
    __host__ __device__ void init(int M, int N, int G_, int c_) { nM = M / BM; nN = N / BM; nwg = nM * nN; G = G_; c = c_; }
    __host__ __device__ bool next(int i, Unit& u) const {
        const long L = (long)i * G + c; if (L >= nwg) return false;
        int wgid = (int)L; { const int q = nwg / NXCD, r = nwg % NXCD, xcd = wgid % NXCD, off = wgid / NXCD; wgid = (xcd < r ? xcd * (q + 1) : r * (q + 1) + (xcd - r) * q) + off; }
        const int nig = WGM * nN, gid = wgid / nig, fm = gid * WGM, gsz = (nM - fm) < WGM ? (nM - fm) : WGM;
        u.pm = fm + ((wgid % nig) % gsz); u.pn = (wgid % nig) / gsz; return true;
    }
    __device__ __forceinline__ void a_ready(const Unit&) const {}
    __device__ __forceinline__ void done(const Unit&) const {}
};


typedef float f32x2_t __attribute__((ext_vector_type(2))); typedef __bf16 bf16x2_t __attribute__((ext_vector_type(2)));
__device__ __forceinline__ unsigned cvt_pk_bf16(float lo, float hi) { const f32x2_t v = {lo, hi}; const bf16x2_t b = __builtin_convertvector(v, bf16x2_t); return __builtin_bit_cast(unsigned, b); }

template <int ACT  > struct EpiBf16 {
    static constexpr bool PERM = true, AFTER_DRAIN = false;
    bf16_t* O; int ldc; float scale;
    __device__ __forceinline__ void operator()(const f32x4 (&acc)[2][2][4][2], const Unit& u, int wr, int wc, int fr, int fq) const {
        const int row0 = u.pm * BM + wr * 64 + fr; const int col0 = u.pn * BM + wc * 32 + 8 * fq;
#pragma unroll
        for (int ai = 0; ai < 2; ++ai)
#pragma unroll
            for (int m = 0; m < 4; ++m) { bf16_t* rowp = O + (size_t)(row0 + ai * HALF + m * 16) * ldc + col0;
#pragma unroll
                for (int bj = 0; bj < 2; ++bj) { f32x4 v0 = acc[ai][bj][m][0] * scale, v1 = acc[ai][bj][m][1] * scale;
                    if (ACT == 1) {
#pragma unroll
                        for (int j = 0; j < 4; ++j) { const float a = v0[j] > 0.f ? v0[j] : 0.f, b = v1[j] > 0.f ? v1[j] : 0.f; v0[j] = a * a; v1[j] = b * b; } }
                    u32x4 w; w.x = cvt_pk_bf16(v0[0], v0[1]); w.y = cvt_pk_bf16(v0[2], v0[3]); w.z = cvt_pk_bf16(v1[0], v1[1]); w.w = cvt_pk_bf16(v1[2], v1[3]);
                    *(u32x4*)(rowp + bj * HALF) = w; } }
    }
};
__device__ __forceinline__ unsigned pk4_fp8(float a, float b, float c, float d) { int r = __builtin_amdgcn_cvt_pk_fp8_f32(a, b, 0, false); r = __builtin_amdgcn_cvt_pk_fp8_f32(c, d, r, true); return (unsigned)r; }
struct EpiF8Relu2 {
    static constexpr bool PERM = true, AFTER_DRAIN = false;
    unsigned char* O; int ldc; float scale;
    __device__ __forceinline__ void operator()(const f32x4 (&acc)[2][2][4][2], const Unit& u, int wr, int wc, int fr, int fq) const {
        const int row0 = u.pm * BM + wr * 64 + fr; const int col0 = u.pn * BM + wc * 32 + 8 * fq;
#pragma unroll
        for (int ai = 0; ai < 2; ++ai)
#pragma unroll
            for (int m = 0; m < 4; ++m) { unsigned char* rowp = O + (size_t)(row0 + ai * HALF + m * 16) * ldc + col0;
#pragma unroll
                for (int bj = 0; bj < 2; ++bj) { f32x4 v0 = acc[ai][bj][m][0], v1 = acc[ai][bj][m][1];
#pragma unroll
                    for (int j = 0; j < 4; ++j) { const float a = v0[j] > 0.f ? v0[j] : 0.f, b = v1[j] > 0.f ? v1[j] : 0.f; v0[j] = fminf(a * a * scale, 416.f); v1[j] = fminf(b * b * scale, 416.f); }
                    typedef unsigned u32x2_t __attribute__((ext_vector_type(2)));
                    u32x2_t w; w.x = pk4_fp8(v0[0], v0[1], v0[2], v0[3]); w.y = pk4_fp8(v1[0], v1[1], v1[2], v1[3]);
                    *(u32x2_t*)(rowp + bj * HALF) = w; } }
    }
};
struct EpiResGate {
    static constexpr bool PERM = false, AFTER_DRAIN = false;
    const float* base; float* out; int ldc; const float* gate; int gate_ld; float gscale;
    __device__ __forceinline__ void operator()(const f32x4 (&acc)[2][2][4][2], const Unit& u, int, int, int, int) const {
        int t_ = threadIdx.x; asm volatile("" : "+v"(t_));
        const int wr = t_ >> 8, wc = (t_ >> 6) & 3, fr = t_ & 15, fq = (t_ >> 4) & 3;
        const int row0 = u.pm * BM + wr * 64 + fr, col0 = u.pn * BM + wc * 32 + 4 * fq;
        const float* gp = gate + (size_t)(u.pm >> 3) * gate_ld + col0;
        f32x4 gv[2][2];
#pragma unroll
        for (int bj = 0; bj < 2; ++bj)
#pragma unroll
            for (int n = 0; n < 2; ++n) gv[bj][n] = *(const f32x4*)(gp + bj * HALF + n * 16) * gscale;
#pragma unroll
        for (int ai = 0; ai < 2; ++ai)
#pragma unroll
            for (int m = 0; m < 4; ++m) { const size_t off = (size_t)(row0 + ai * HALF + m * 16) * ldc + col0;
#pragma unroll
                for (int bj = 0; bj < 2; ++bj)
#pragma unroll
                    for (int n = 0; n < 2; ++n) { const f32x4 bs = *(const f32x4*)(base + off + bj * HALF + n * 16);
                        *(f32x4*)(out + off + bj * HALF + n * 16) = bs + gv[bj][n] * acc[ai][bj][m][n]; } }
    }
};
template <class Epi, class Sched, bool ALIGN_EPI = false, bool SP2 = false, bool F8 = false>
__device__ __forceinline__ void gemm_phase(PG8_LAS unsigned char* lds, const Gemm g, const Sched& S, const Epi& E) {
    const int tid = threadIdx.x, wid = __builtin_amdgcn_readfirstlane(tid >> 6), lane = tid & 63, wr = wid >> 2, wc = wid & 3, fr = lane & 15, fq = lane >> 4;
    const int K = g.K, nt = K / BK;
    unsigned voffA[2], voffB[2];
#pragma unroll
    for (int i = 0; i < 2; ++i) { int R, C; stage_rc(tid * 16 + i * 8192, R, C); const int Rb = Epi::PERM ? ((R & ~31) + perm32(R & 31)) : R;
        voffA[i] = (unsigned)(R * g.lda + C) * 2u; voffB[i] = (unsigned)(Rb * K + C) * 2u; }
    const size_t kstep = (size_t)(BK * 2);
    const size_t hstepB = (size_t)HALF * K * 2, hstepA = (size_t)HALF * g.lda * 2;
    const size_t tstepA = 2 * hstepA, tstepB = 2 * hstepB;
    const unsigned ldsw = (unsigned)wid * 1024u;
    const int f8in = (fq >> 1) * 1024 + ((fr * 64 + (fq & 1) * 32) ^ ((fr >> 3) << 5));
    const int aoff = F8 ? wr * 8192 + f8in : lds_byte(wr * 64 + fr, fq * 8), boff = F8 ? wc * 4096 + f8in : lds_byte(wc * 32 + fr, fq * 8);
    constexpr int KOFF = F8 ? 16 : 1024;
    typedef int v8i_t __attribute__((ext_vector_type(8)));
#define PG8_SA(b, h) (((b) * 2 + (h)) * HTB)
#define PG8_SB(b, h) ((4 + (b) * 2 + (h)) * HTB)
#define PG8_STAGE(bufoff, gbase, voff) do { _Pragma("unroll") for (int _i = 0; _i < 2; ++_i) \
        __builtin_amdgcn_global_load_lds((const unsigned*)((const char*)(gbase) + (voff)[_i]), (PG8_LAS unsigned*)(lds + (bufoff) + ldsw + _i * 8192), 16, 0, 0); } while (0)
#define PG8_LD32(p_) __builtin_shufflevector(*(const PG8_LAS u32x4*)(p_), *(const PG8_LAS u32x4*)((p_) + 16), 0, 1, 2, 3, 4, 5, 6, 7)
#define PG8_LDA(dst, b, h) do { if constexpr (F8) { _Pragma("unroll") for (int m = 0; m < 4; ++m) dst##8[m] = __builtin_bit_cast(v8i_t, PG8_LD32(lds + PG8_SA(b, h) + aoff + m * 2048)); } \
    else { _Pragma("unroll") for (int m = 0; m < 4; ++m) _Pragma("unroll") for (int k = 0; k < 2; ++k) dst[m][k] = *(const PG8_LAS bf16x8*)(lds + PG8_SA(b, h) + aoff + m * 2048 + k * KOFF); } } while (0)
#define PG8_LDB(dst, b, h) do { if constexpr (F8) { _Pragma("unroll") for (int n = 0; n < 2; ++n) dst##8[n] = __builtin_bit_cast(v8i_t, PG8_LD32(lds + PG8_SB(b, h) + boff + n * 2048)); } \
    else { _Pragma("unroll") for (int n = 0; n < 2; ++n) _Pragma("unroll") for (int k = 0; k < 2; ++k) dst[n][k] = *(const PG8_LAS bf16x8*)(lds + PG8_SB(b, h) + boff + n * 2048 + k * KOFF); } } while (0)
#define PG8_CAT(x) __builtin_shufflevector(__builtin_bit_cast(u32x4, (x)[0]), __builtin_bit_cast(u32x4, (x)[1]), 0, 1, 2, 3, 4, 5, 6, 7)
#define PG8_MMA(ai, bj, At, Bt) do { __builtin_amdgcn_s_setprio(1); if constexpr (F8) { _Pragma("unroll") for (int m = 0; m < 4; ++m) _Pragma("unroll") for (int n = 0; n < 2; ++n) \
        asm volatile("v_mfma_f32_16x16x128_f8f6f4 %0, %1, %2, %0" : "+v"(acc[ai][bj][m][n]) : "v"(Bt##8[n]), "v"(At##8[m])); } \
    else { _Pragma("unroll") for (int m = 0; m < 4; ++m) _Pragma("unroll") for (int n = 0; n < 2; ++n) _Pragma("unroll") for (int k = 0; k < 2; ++k) \
        acc[ai][bj][m][n] = __builtin_amdgcn_mfma_f32_16x16x32_bf16(Bt[n][k], At[m][k], acc[ai][bj][m][n], 0, 0, 0); } __builtin_amdgcn_s_setprio(0); } while (0)
#define PG8_WAIT_V(n) asm volatile("s_waitcnt vmcnt(" #n ")" ::: "memory")
#define PG8_WAIT_L(n) asm volatile("s_waitcnt lgkmcnt(" #n ")" ::: "memory")
#define PG8_BAR __builtin_amdgcn_s_barrier()
#define PG8_SCHED __builtin_amdgcn_sched_barrier(0)
    Unit cur, nxt; int ui = 0;
    if (!S.next(0, cur)) return;
    f32x4 acc[2][2][4][2];
#pragma unroll
    for (int a = 0; a < 2; ++a)
#pragma unroll
        for (int b = 0; b < 2; ++b)
#pragma unroll
            for (int m = 0; m < 4; ++m)
#pragma unroll
                for (int n = 0; n < 2; ++n) acc[a][b][m][n] = (f32x4){0.f, 0.f, 0.f, 0.f};
    bf16x8 At[4][2], B0[2][2], B1[2][2]; v8i_t At8[4], B08[2], B18[2];
    const char* cA = (const char*)g.A + (size_t)cur.pm * tstepA; const char* cB = (const char*)g.Bt + (size_t)cur.pn * tstepB;
    S.a_ready(cur);
    if constexpr (SP2) {
        PG8_STAGE(PG8_SB(0, 0), cB, voffB); PG8_STAGE(PG8_SB(0, 1), cB + hstepB, voffB); PG8_STAGE(PG8_SA(0, 0), cA, voffA); PG8_STAGE(PG8_SA(0, 1), cA + hstepA, voffA);
        if (wr == 1) PG8_BAR;
        PG8_WAIT_V(2); PG8_BAR;
        PG8_STAGE(PG8_SB(1, 0), cB + kstep, voffB); PG8_STAGE(PG8_SA(1, 0), cA + kstep, voffA); PG8_STAGE(PG8_SB(1, 1), cB + hstepB + kstep, voffB);
        PG8_WAIT_V(6); PG8_BAR;
    } else {
        PG8_STAGE(PG8_SB(0, 0), cB, voffB); PG8_STAGE(PG8_SA(0, 0), cA, voffA); PG8_STAGE(PG8_SB(0, 1), cB + hstepB, voffB); PG8_STAGE(PG8_SA(0, 1), cA + hstepA, voffA);
        if (wr == 1) PG8_BAR;
        PG8_WAIT_V(4); PG8_BAR;
        PG8_STAGE(PG8_SB(1, 0), cB + kstep, voffB); PG8_STAGE(PG8_SA(1, 0), cA + kstep, voffA); PG8_STAGE(PG8_SB(1, 1), cB + hstepB + kstep, voffB);
        PG8_WAIT_V(6); PG8_BAR;
    }
    for (;;) {
        const bool has_next = S.next(ui + 1, nxt);
        const char* nA = has_next ? (const char*)g.A + (size_t)nxt.pm * tstepA : cA; const char* nB = has_next ? (const char*)g.Bt + (size_t)nxt.pn * tstepB : cB;
        for (int t = 0; t < nt; t += 2) {
            const bool last = (t == nt - 2);
            const char* a1 = cA + (size_t)(t + 1) * kstep;
            const char* a2 = last ? nA : cA + (size_t)(t + 2) * kstep; const char* b2 = last ? nB : cB + (size_t)(t + 2) * kstep;
            const char* a3 = a2 + kstep; const char* b3 = b2 + kstep;
            if (last && has_next) S.a_ready(nxt);
            if constexpr (SP2) {
            PG8_LDB(B0, 0, 0); PG8_LDB(B1, 0, 1); PG8_SCHED; PG8_LDA(At, 0, 0); PG8_STAGE(PG8_SA(1, 1), a1 + hstepA, voffA);
            PG8_WAIT_V(8); PG8_WAIT_L(0); PG8_BAR; PG8_MMA(0, 0, At, B0); PG8_MMA(0, 1, At, B1); PG8_BAR; PG8_SCHED;
            PG8_LDA(At, 0, 1); PG8_STAGE(PG8_SB(0, 0), b2, voffB); PG8_STAGE(PG8_SB(0, 1), b2 + hstepB, voffB); PG8_STAGE(PG8_SA(0, 0), a2, voffA);
            PG8_WAIT_V(8); PG8_WAIT_L(0); PG8_BAR; PG8_MMA(1, 0, At, B0); PG8_MMA(1, 1, At, B1); PG8_BAR; PG8_SCHED;
            PG8_LDB(B0, 1, 0); PG8_LDB(B1, 1, 1); PG8_SCHED; PG8_LDA(At, 1, 0); PG8_STAGE(PG8_SA(0, 1), a2 + hstepA, voffA);
            PG8_WAIT_V(8); PG8_WAIT_L(0); PG8_BAR; PG8_MMA(0, 0, At, B0); PG8_MMA(0, 1, At, B1); PG8_BAR; PG8_SCHED;
            PG8_LDA(At, 1, 1); PG8_STAGE(PG8_SB(1, 0), b3, voffB); PG8_STAGE(PG8_SB(1, 1), b3 + hstepB, voffB); PG8_STAGE(PG8_SA(1, 0), a3, voffA);
            PG8_WAIT_V(8); PG8_WAIT_L(0); PG8_BAR; PG8_MMA(1, 0, At, B0); PG8_MMA(1, 1, At, B1); PG8_BAR; PG8_SCHED;
            } else {
            PG8_LDB(B0, 0, 0); PG8_SCHED; PG8_LDA(At, 0, 0); PG8_STAGE(PG8_SA(1, 1), a1 + hstepA, voffA);
            PG8_WAIT_L(8); PG8_BAR; PG8_WAIT_L(0); PG8_MMA(0, 0, At, B0); PG8_BAR; PG8_SCHED;
            PG8_LDB(B1, 0, 1); PG8_STAGE(PG8_SB(0, 0), b2, voffB);
            PG8_BAR; PG8_WAIT_L(0); PG8_MMA(0, 1, At, B1); PG8_BAR;
            PG8_LDA(At, 0, 1); PG8_STAGE(PG8_SA(0, 0), a2, voffA);
            PG8_BAR; PG8_WAIT_L(0); PG8_MMA(1, 0, At, B0); PG8_BAR; PG8_SCHED;
            PG8_STAGE(PG8_SB(0, 1), b2 + hstepB, voffB);
            PG8_WAIT_V(6); PG8_BAR; PG8_MMA(1, 1, At, B1); PG8_BAR;
            PG8_LDB(B0, 1, 0); PG8_SCHED; PG8_LDA(At, 1, 0); PG8_STAGE(PG8_SA(0, 1), a2 + hstepA, voffA);
            PG8_WAIT_L(8); PG8_BAR; PG8_WAIT_L(0); PG8_MMA(0, 0, At, B0); PG8_BAR; PG8_SCHED;
            PG8_LDB(B1, 1, 1); PG8_STAGE(PG8_SB(1, 0), b3, voffB);
            PG8_BAR; PG8_WAIT_L(0); PG8_MMA(0, 1, At, B1); PG8_BAR;
            PG8_LDA(At, 1, 1); PG8_STAGE(PG8_SA(1, 0), a3, voffA);
            PG8_BAR; PG8_WAIT_L(0); PG8_MMA(1, 0, At, B0); PG8_BAR; PG8_SCHED;
            PG8_STAGE(PG8_SB(1, 1), b3 + hstepB, voffB);
            PG8_WAIT_V(6); PG8_BAR; PG8_MMA(1, 1, At, B1); PG8_BAR;
            }
        }
        if constexpr (ALIGN_EPI) { if (wr == 0) PG8_BAR; }
        if constexpr (F8) asm volatile("s_nop 15\n\ts_nop 15" ::: "memory");
        if constexpr (!Epi::AFTER_DRAIN) { E(acc, cur, wr, wc, fr, fq); S.done(cur); }
        if (!has_next) break;
#pragma unroll
        for (int a = 0; a < 2; ++a)
#pragma unroll
            for (int b = 0; b < 2; ++b)
#pragma unroll
                for (int m = 0; m < 4; ++m)
#pragma unroll
                    for (int n = 0; n < 2; ++n) acc[a][b][m][n] = (f32x4){0.f, 0.f, 0.f, 0.f};
        cur = nxt; cA = nA; cB = nB; ++ui;
        if constexpr (ALIGN_EPI) { if (wr == 1) PG8_BAR; }
    }
    PG8_WAIT_V(0);
    if constexpr (!ALIGN_EPI) { if (wr == 0) PG8_BAR; }
    PG8_BAR;
    if constexpr (Epi::AFTER_DRAIN) { E.fused(acc, cur, wr, wc, fr, fq, lds, wid, lane); S.done(cur); }
#undef PG8_SA
#undef PG8_SB
#undef PG8_STAGE
#undef PG8_LDA
#undef PG8_LDB
#undef PG8_MMA
#undef PG8_CAT
#undef PG8_LD32
#undef PG8_WAIT_V
#undef PG8_WAIT_L
#undef PG8_BAR
#undef PG8_SCHED
}
}

#define LAS __attribute__((address_space(3)))
typedef unsigned short bf16;
typedef short bf16x8 __attribute__((ext_vector_type(8)));
typedef short s16x4 __attribute__((ext_vector_type(4)));
typedef float f32x4 __attribute__((ext_vector_type(4)));
typedef float f32x16 __attribute__((ext_vector_type(16)));
typedef unsigned u32x4 __attribute__((ext_vector_type(4)));
typedef unsigned u32x2 __attribute__((ext_vector_type(2)));

constexpr int NB = 32, SEQ = 2048, DM = 1024, M = NB * SEQ, NPROJ = 3072, FF = 4096;
constexpr int PC_Q = 0, PC_R = 512, PC_K = 1024, PC_V = 1536, PC_QI = 2048, PC_CL = 2560, PC_KI = 2688, PC_XW = 2752, PC_XA = 2816, PC_XG = 2880, PC_WI = 3008;
constexpr size_t MiB = 1u << 20;
constexpr size_t WS_MOD = 0, WS_WUKT = 1 * MiB, WS_WUK = WS_WUKT + 131072, WS_WUVT = WS_WUK + 131072, WS_INVR = 2 * MiB, WS_WIN = 4 * MiB, WS_WOUT = 10 * MiB,
                 WS_W1 = 12 * MiB, WS_W2 = 20 * MiB, WS_CKV = 36 * MiB, WS_GAM = 52 * MiB, WS_C3 = 60 * MiB, WS_REGA = 64 * MiB, WS_PROJ = 192 * MiB, WS_CH = 576 * MiB,
                 WS_G = 960 * MiB, WS_U = 192 * MiB, WS_END = 1024 * MiB,
                 WS_W2T = WS_WUVT + 131072, WS_A2T = WS_W2T + 65536, WS_G2T = WS_A2T + 65536;
constexpr int LDS_BYTES = 158720;
constexpr int NWAVES = 8;

struct Params {
    const float *x, *c, *w_ada, *b_ada, *g_mix, *g_ffn, *w_in, *g_q, *g_k, *g_kv, *w_uk, *w_uv, *mu, *w0, *w2, *a0, *a2, *g2, *k_k, *k_a, *r_k, *ln_w, *ln_b, *w_out, *w_ff1, *w_ff2;
    float* out; unsigned char* ws; int ph_lo, ph_hi;
};

__device__ __forceinline__ unsigned pk2(float lo, float hi) { return pg8::cvt_pk_bf16(lo, hi); }
__device__ __forceinline__ float bflo(unsigned w) { return __uint_as_float(w << 16); }
__device__ __forceinline__ float bfhi(unsigned w) { return __uint_as_float(w & 0xffff0000u); }
__device__ __forceinline__ float bf2f(bf16 h) { return __uint_as_float((unsigned)h << 16); }
__device__ __forceinline__ bf16 f2bf(float f) { return (bf16)(pk2(f, 0.f) & 0xffffu); }
__device__ __forceinline__ float wave_sum(float v) {
#pragma unroll
    for (int o = 1; o < 64; o <<= 1) v += __shfl_xor(v, o);
    return v;
}
__device__ __forceinline__ f32x16 mfma32(bf16x8 a, bf16x8 b, f32x16 c) { return __builtin_amdgcn_mfma_f32_32x32x16_bf16(a, b, c, 0, 0, 0); }
__device__ __forceinline__ f32x4 mfma16(bf16x8 a, bf16x8 b, f32x4 c) { return __builtin_amdgcn_mfma_f32_16x16x32_bf16(a, b, c, 0, 0, 0); }

__device__ __forceinline__ int win_src_col(int n) {
    if (n < 512) return n;
    if (n < 1024) return 1224 + (n - 512);
    if (n < 1536) return 1736 + (n - 1024);
    if (n < 2048) return 2248 + (n - 1536);
    if (n < 2560) return 640 + (n - 2048);
    if (n < 2688) return 512 + (n - 2560);
    if (n < 2752) return 1152 + (n - 2688);
    if (n < 2816) return 2760 + (n - 2752);
    if (n < 2880) return 2824 + (n - 2816);
    if (n < 3008) return 2888 + (n - 2880);
    if (n < 3016) return 1216 + (n - 3008);
    return -1;
}
__device__ __forceinline__ void conv_t_item(const float* W, int K, int Nsrc, bf16* WT, int nblk, int item, float* scr, int lane, bool is_win) {
    const int kb = item / nblk, nb = item % nblk, k0 = 64 * kb, n0 = 32 * nb;
    int ns = n0 + (lane & 31); if (is_win) ns = win_src_col(ns);
    float tv[32];
#pragma unroll
    for (int i = 0; i < 32; ++i) { const int kk = 2 * i + (lane >> 5); tv[i] = ns >= 0 ? W[(size_t)(k0 + kk) * Nsrc + ns] : 0.f; }
#pragma unroll
    for (int i = 0; i < 32; ++i) { const int kk = 2 * i + (lane >> 5); scr[kk * 33 + (lane & 31)] = tv[i]; }
    asm volatile("s_waitcnt lgkmcnt(0)" ::: "memory");
    const int c = lane & 7;
#pragma unroll
    for (int j = 0; j < 4; ++j) { const int n = (lane >> 3) + 8 * j; const float* s = scr + (8 * c) * 33 + n;
        u32x4 o; o.x = pk2(s[0 * 33], s[1 * 33]); o.y = pk2(s[2 * 33], s[3 * 33]); o.z = pk2(s[4 * 33], s[5 * 33]); o.w = pk2(s[6 * 33], s[7 * 33]);
        *(u32x4*)(WT + (size_t)(n0 + n) * K + k0 + 8 * c) = o; }
    asm volatile("s_waitcnt lgkmcnt(0)" ::: "memory");
}
__device__ __forceinline__ void conv_t_item_f8(const float* W, int K, int N, unsigned char* WT, int nblk, int item, float* scr, int lane, float scale, bool is_win = false) {
    const int kb = item / nblk, nb = item % nblk, k0 = 64 * kb, n0 = 32 * nb;
    int ns = n0 + (lane & 31); if (is_win) ns = win_src_col(ns);
    float tv[32];
#pragma unroll
    for (int i = 0; i < 32; ++i) { const int kk = 2 * i + (lane >> 5); tv[i] = ns >= 0 ? W[(size_t)(k0 + kk) * N + ns] * scale : 0.f; }
#pragma unroll
    for (int i = 0; i < 32; ++i) { const int kk = 2 * i + (lane >> 5); scr[kk * 33 + (lane & 31)] = tv[i]; }
    asm volatile("s_waitcnt lgkmcnt(0)" ::: "memory");
    const int c = lane & 7;
#pragma unroll
    for (int j = 0; j < 4; ++j) { const int n = (lane >> 3) + 8 * j; const float* s = scr + (8 * c) * 33 + n;
        u32x2 o; o.x = pg8::pk4_fp8(s[0 * 33], s[1 * 33], s[2 * 33], s[3 * 33]); o.y = pg8::pk4_fp8(s[4 * 33], s[5 * 33], s[6 * 33], s[7 * 33]);
        *(u32x2*)(WT + (size_t)(n0 + n) * K + k0 + 8 * c) = o; }
    asm volatile("s_waitcnt lgkmcnt(0)" ::: "memory");
}
__device__ __forceinline__ void adaln_block(const Params& p, float* ldsf, int cb, int tid) {
    const int lane = tid & 63, wv = tid >> 6, e = cb * 64 + lane;
    float* SC = ldsf; float* RED = ldsf + 16384; float* mod = (float*)(p.ws + WS_MOD);
    float wreg[128];
#pragma unroll
    for (int d = 0; d < 128; ++d) wreg[d] = p.w_ada[(size_t)(wv * 128 + d) * 6144 + e];
    for (int half = 0; half < 2; ++half) {
        const int b0 = half * 16;
        for (int i = tid; i < 16384; i += 512) { const float cv = p.c[b0 * 1024 + i]; SC[i] = cv / (1.f + __expf(-cv)); }
        __syncthreads();
        float acc[16];
#pragma unroll
        for (int bb = 0; bb < 16; ++bb) acc[bb] = 0.f;
#pragma unroll
        for (int dd = 0; dd < 128; dd += 4) { const int d = wv * 128 + dd;
            const float w0 = wreg[dd], w1 = wreg[dd + 1], w2 = wreg[dd + 2], w3 = wreg[dd + 3];
#pragma unroll
            for (int bb = 0; bb < 16; ++bb) { const f32x4 s = *(const f32x4*)(SC + bb * 1024 + d); acc[bb] += (s.x * w0 + s.y * w1) + (s.z * w2 + s.w * w3); }
        }
#pragma unroll
        for (int bb = 0; bb < 16; ++bb) RED[(wv * 16 + bb) * 64 + lane] = acc[bb];
        __syncthreads();
#pragma unroll
        for (int q = 0; q < 2; ++q) { const int bb = wv * 2 + q; float s = p.b_ada[e];
#pragma unroll
            for (int ww = 0; ww < 8; ++ww) s += RED[(ww * 16 + bb) * 64 + lane];
            mod[(size_t)(b0 + bb) * 6144 + e] = s; }
        __syncthreads();
    }
}
__device__ __forceinline__ void phase_pro(const Params& p, unsigned char* lds, int tid, int G) {
    const int lane = tid & 63, wv = tid >> 6;
    for (int cb = blockIdx.x; cb < 96; cb += G) adaln_block(p, (float*)lds, cb, tid);
    __syncthreads();
    float* scr = (float*)lds + wv * (64 * 33 + 16);
    const int gw = blockIdx.x * NWAVES + wv, NGW = G * NWAVES;
    bf16* WIN = (bf16*)(p.ws + WS_WIN); bf16* WOUT = (bf16*)(p.ws + WS_WOUT); bf16* W1 = (bf16*)(p.ws + WS_W1); bf16* W2 = (bf16*)(p.ws + WS_W2);
    bf16* WUKT = (bf16*)(p.ws + WS_WUKT); bf16* WUK = (bf16*)(p.ws + WS_WUK); bf16* WUVT = (bf16*)(p.ws + WS_WUVT);
    constexpr int I_IN = (DM / 64) * (NPROJ / 32), I_OUT = (DM / 64) * (DM / 32), I_1 = (DM / 64) * (FF / 32), I_2 = (FF / 64) * (DM / 32), I_UK = (128 / 64) * (512 / 32);
    constexpr int I_LR = 512 / 32;
    constexpr int NITEMS = I_IN + I_OUT + I_1 + I_2 + 2 * I_UK + 4 * I_LR;
    for (int it = gw; it < NITEMS; it += NGW) {
        int r = it;
        if (r < I_IN) { if (MK_F8_GEMM1) conv_t_item_f8(p.w_in, DM, 3016, (unsigned char*)WIN, NPROJ / 32, r, scr, lane, 32.f, true); else conv_t_item(p.w_in, DM, 3016, WIN, NPROJ / 32, r, scr, lane, true); continue; } r -= I_IN;
        if (r < I_OUT) { conv_t_item(p.w_out, DM, DM, WOUT, DM / 32, r, scr, lane, false); continue; } r -= I_OUT;
        if (r < I_1) { conv_t_item(p.w_ff1, DM, FF, W1, FF / 32, r, scr, lane, false); continue; } r -= I_1;
        if (r < I_2) { conv_t_item_f8(p.w_ff2, FF, DM, (unsigned char*)W2, DM / 32, r, scr, lane, 64.f); continue; } r -= I_2;
        if (r < I_UK) { conv_t_item(p.w_uk, 128, 512, WUKT, 512 / 32, r, scr, lane, false); continue; } r -= I_UK;
        if (r < I_UK) { conv_t_item(p.w_uv, 128, 512, WUVT, 512 / 32, r, scr, lane, false); continue; } r -= I_UK;
        if (r < I_LR) { conv_t_item(p.w2, 64, 512, (bf16*)(p.ws + WS_W2T), 512 / 32, r, scr, lane, false); continue; } r -= I_LR;
        if (r < I_LR) { conv_t_item(p.a2, 64, 512, (bf16*)(p.ws + WS_A2T), 512 / 32, r, scr, lane, false); continue; } r -= I_LR;
        conv_t_item(p.g2, 128, 512, (bf16*)(p.ws + WS_G2T), 512 / 32, r, scr, lane, false);
    }
    for (int i = blockIdx.x * 512 + tid; i < 128 * 512 / 2; i += G * 512) { const float a = p.w_uk[2 * i], b = p.w_uk[2 * i + 1]; ((unsigned*)WUK)[i] = pk2(a, b); }
}

template <bool F8OUT> __device__ __forceinline__ void hn_rows(const float* src, const float* g, const float* mod, int off_sh, int off_sc, bf16* dst, int gw, int NGW, int lane) {
    const int RPW = M / NGW;
    for (int m0 = gw * RPW; m0 < M; m0 += NGW * RPW) {
        const float* mb = mod + (size_t)(m0 >> 11) * 6144;
        f32x4 ga[4], sh[4];
#pragma unroll
        for (int j = 0; j < 4; ++j) { const int col = 4 * lane + 256 * j; const f32x4 gg = *(const f32x4*)(g + col), sc = *(const f32x4*)(mb + off_sc + col); ga[j] = gg * (1.f + sc); sh[j] = *(const f32x4*)(mb + off_sh + col); }
        for (int r0 = 0; r0 < RPW; r0 += 4) {
            f32x4 v[4][4]; float s[4];
#pragma unroll
            for (int r = 0; r < 4; ++r) { const f32x4* xr = (const f32x4*)(src + (size_t)(m0 + r0 + r) * DM) + lane;
#pragma unroll
                for (int j = 0; j < 4; ++j) v[r][j] = xr[64 * j]; }
#pragma unroll
            for (int r = 0; r < 4; ++r) { s[r] = 0.f;
#pragma unroll
                for (int j = 0; j < 4; ++j) s[r] += (v[r][j].x * v[r][j].x + v[r][j].y * v[r][j].y) + (v[r][j].z * v[r][j].z + v[r][j].w * v[r][j].w); }
#pragma unroll
            for (int o = 1; o < 64; o <<= 1) {
#pragma unroll
                for (int r = 0; r < 4; ++r) s[r] += __shfl_xor(s[r], o); }
#pragma unroll
            for (int r = 0; r < 4; ++r) { const int m = m0 + r0 + r; const float rstd = rsqrtf(s[r] * (1.f / DM) + 1e-6f);
                unsigned long long* o8 = (unsigned long long*)(dst + (size_t)m * DM) + lane;
#pragma unroll
                for (int j = 0; j < 4; ++j) { const f32x4 y = v[r][j] * rstd * ga[j] + sh[j];
                    if (F8OUT) ((unsigned*)((unsigned char*)dst + (size_t)m * DM))[lane + 64 * j] = pg8::pk4_fp8(y.x, y.y, y.z, y.w);
                    else o8[64 * j] = (unsigned long long)pk2(y.x, y.y) | ((unsigned long long)pk2(y.z, y.w) << 32); } }
        }
    }
}

typedef short s16x4 __attribute__((ext_vector_type(4)));
__device__ __forceinline__ f32x4 mfma16k(s16x4 a, s16x4 b, f32x4 c) { return __builtin_amdgcn_mfma_f32_16x16x16bf16_1k(a, b, c, 0, 0, 0); }
__device__ __forceinline__ s16x4 pack4(f32x4 v) { u32x2 o; o.x = pk2(v[0], v[1]); o.y = pk2(v[2], v[3]); return __builtin_bit_cast(s16x4, o); }

__device__ __forceinline__ float dpp_row_sum16(float x) {
    x += __builtin_bit_cast(float, __builtin_amdgcn_mov_dpp(__builtin_bit_cast(int, x), 0xB1, 0xF, 0xF, true));
    x += __builtin_bit_cast(float, __builtin_amdgcn_mov_dpp(__builtin_bit_cast(int, x), 0x4E, 0xF, 0xF, true));
    x += __builtin_bit_cast(float, __builtin_amdgcn_mov_dpp(__builtin_bit_cast(int, x), 0x141, 0xF, 0xF, true));
    x += __builtin_bit_cast(float, __builtin_amdgcn_mov_dpp(__builtin_bit_cast(int, x), 0x140, 0xF, 0xF, true));
    return x;
}
__device__ __forceinline__ void rwkv_prep_item(const Params& p, unsigned char* lds, int it, int tid_in) {
    int tid = tid_in; asm volatile("" : "+v"(tid));
    const int lane = tid & 63, wv = __builtin_amdgcn_readfirstlane(tid >> 6);
    bf16* XS = (bf16*)lds;
    bf16* STG = (bf16*)(lds + 32768) + wv * 4096;
    float* MAB = (float*)(lds + 98304) + wv * 256;
    bf16* RKV = (bf16*)(lds + 106496) + wv * 3264;
    const bf16* PROJ = (const bf16*)(p.ws + WS_PROJ);
    const bf16* W2T = (const bf16*)(p.ws + WS_W2T); const bf16* A2T = (const bf16*)(p.ws + WS_A2T); const bf16* G2T = (const bf16*)(p.ws + WS_G2T);
    float* GAM = (float*)(p.ws + WS_GAM); float* C3 = (float*)(p.ws + WS_C3); bf16* GB = (bf16*)(p.ws + WS_G);
    const int row0 = it * 64, t0 = (it & 31) * 64, b = it >> 5;
    __syncthreads();
    {   const int xt = tid >> 5, xch = tid & 31;
        const f32x4 m0_ = *(const f32x4*)(p.mu + 1536 + 8 * xch), m1_ = *(const f32x4*)(p.mu + 1536 + 8 * xch + 4); const float sc_ = xch < 8 ? 2.f : -1.f;
        u32x4 xc[4], xp[4];
#pragma unroll
        for (int qq = 0; qq < 4; ++qq) { const int t = xt + 16 * qq; const bf16* src_ = PROJ + (size_t)(row0 + t) * NPROJ + PC_XW + 8 * xch; xc[qq] = *(const u32x4*)src_;
            xp[qq] = (u32x4){0u, 0u, 0u, 0u}; if (t0 + t != 0) xp[qq] = *(const u32x4*)(src_ - NPROJ); }
#pragma unroll
        for (int qq = 0; qq < 4; ++qq) { float o_[8];
#pragma unroll
            for (int i = 0; i < 4; ++i) { const float c0_ = bflo(xc[qq][i]), c1_ = bfhi(xc[qq][i]), p0_ = bflo(xp[qq][i]), p1_ = bfhi(xp[qq][i]);
                const float ma_ = i < 2 ? m0_[2 * i] : m1_[2 * i - 4], mb_ = i < 2 ? m0_[2 * i + 1] : m1_[2 * i - 3];
                const float v0_ = c0_ + ma_ * (p0_ - c0_), v1_ = c1_ + mb_ * (p1_ - c1_);
                const float r0_ = 1.f / (1.f + __expf(sc_ * v0_)), r1_ = 1.f / (1.f + __expf(sc_ * v1_));
                o_[2 * i] = xch < 8 ? 1.f - 2.f * r0_ : (xch < 16 ? v0_ : r0_); o_[2 * i + 1] = xch < 8 ? 1.f - 2.f * r1_ : (xch < 16 ? v1_ : r1_); }
            *(u32x4*)(XS + (xt + 16 * qq) * 256 + 8 * xch) = (u32x4){pk2(o_[0], o_[1]), pk2(o_[2], o_[3]), pk2(o_[4], o_[5]), pk2(o_[6], o_[7])}; }
    }
    u32x4 RK[7];
#define RKV_LOAD(rowb, tb) do { _Pragma("unroll") for (int i = 0; i < 7; ++i) { const int id_ = i * 64 + lane, mat_ = id_ / 136, rem_ = id_ - 136 * mat_, rw_ = rem_ >> 3, ch_ = rem_ & 7; \
        RK[i] = (u32x4){0u, 0u, 0u, 0u}; if (id_ < 408 && (tb) - 1 + rw_ >= 0) RK[i] = *(const u32x4*)(PROJ + (size_t)((rowb) - 1 + rw_) * NPROJ + PC_R + 512 * mat_ + wv * 64 + 8 * ch_); } } while (0)
#define RKV_WRITE() do { _Pragma("unroll") for (int i = 0; i < 7; ++i) { const int id_ = i * 64 + lane, mat_ = id_ / 136, rem_ = id_ - 136 * mat_, rw_ = rem_ >> 3, ch_ = rem_ & 7; \
        if (id_ < 408) *(u32x4*)(RKV + mat_ * 1088 + rw_ * 64 + 8 * ch_) = RK[i]; } } while (0)
    RKV_LOAD(row0, t0);
    __syncthreads();
#pragma unroll 1
    for (int q = 0; q < 4; ++q) {
        const int rowq = row0 + 16 * q, tq = t0 + 16 * q;
        int lane_ = lane; asm volatile("" : "+v"(lane_));
        const int n_ = lane_ & 15, grp_ = lane_ >> 4;
        const size_t idx = (size_t)(b * 8 + wv) * 128 + (tq >> 4);
        unsigned char* CHp = p.ws + WS_CH + idx * 12288;
        RKV_WRITE();
        if (q < 3) RKV_LOAD(rowq + 16, tq + 16);
        f32x4 dw[4], da[4];
        {   bf16x8 xa[8];
#pragma unroll
            for (int ks = 0; ks < 8; ++ks) xa[ks] = *(const bf16x8*)(XS + (16 * q + n_) * 256 + 32 * ks + 8 * grp_);
#pragma unroll
            for (int ct = 0; ct < 4; ++ct) { const int cc = wv * 64 + 16 * ct + n_;
                f32x4 dg = {0.f, 0.f, 0.f, 0.f}; dw[ct] = dg; da[ct] = dg;
#pragma unroll
                for (int ks = 0; ks < 2; ++ks) dw[ct] = mfma16(xa[ks], *(const bf16x8*)(W2T + cc * 64 + 32 * ks + 8 * grp_), dw[ct]);
#pragma unroll
                for (int ks = 0; ks < 2; ++ks) da[ct] = mfma16(xa[2 + ks], *(const bf16x8*)(A2T + cc * 64 + 32 * ks + 8 * grp_), da[ct]);
#pragma unroll
                for (int ks = 0; ks < 4; ++ks) dg = mfma16(xa[4 + ks], *(const bf16x8*)(G2T + cc * 128 + 32 * ks + 8 * grp_), dg);
#pragma unroll
                for (int rg = 0; rg < 4; ++rg) GB[(size_t)(rowq + 4 * grp_ + rg) * 512 + cc] = f2bf(dg[rg]); }
        }
        asm volatile("s_waitcnt lgkmcnt(0)" ::: "memory");
        {   float kkvA[4][4], kkaA[4][4], kprA[4][4], rA[4][4], vA[4][4], wA[4][4], nrm[4], c3s[4];
#pragma unroll
            for (int rg = 0; rg < 4; ++rg) { nrm[rg] = 0.f; c3s[rg] = 0.f; }
#pragma unroll
            for (int ct = 0; ct < 4; ++ct) { const int j = 16 * ct + n_, c = wv * 64 + j;
                const float mu_r = p.mu[c], mu_k = p.mu[512 + c], mu_v = p.mu[1024 + c], w0c = p.w0[c], a0c = p.a0[c], kkc = p.k_k[c], kac = p.k_a[c], rkc = p.r_k[c];
#pragma unroll
                for (int rg = 0; rg < 4; ++rg) { const int t = 4 * grp_ + rg;
                    const float rp = bf2f(RKV[t * 64 + j]), rc = bf2f(RKV[(t + 1) * 64 + j]);
                    const float kp = bf2f(RKV[1088 + t * 64 + j]), kc = bf2f(RKV[1088 + (t + 1) * 64 + j]);
                    const float vp = bf2f(RKV[2176 + t * 64 + j]), vc = bf2f(RKV[2176 + (t + 1) * 64 + j]);
                    const float r = rc + mu_r * (rp - rc), k = kc + mu_k * (kp - kc); vA[ct][rg] = vc + mu_v * (vp - vc); rA[ct][rg] = r;
                    const float u = w0c + dw[ct][rg]; const float wlog = -__logf(1.f + __expf(-u)) - 0.5f; wA[ct][rg] = __expf(-__expf(wlog));
                    const float a = 1.f / (1.f + __expf(-(a0c + da[ct][rg])));
                    const float kkv = k * kkc, kpr = k * (1.f + (a - 1.f) * kac); kkvA[ct][rg] = kkv; kkaA[ct][rg] = kkv * a; kprA[ct][rg] = kpr;
                    nrm[rg] += kkv * kkv; c3s[rg] += r * kpr * rkc; } }
            float inrm[4];
#pragma unroll
            for (int rg = 0; rg < 4; ++rg) { nrm[rg] = dpp_row_sum16(nrm[rg]); c3s[rg] = dpp_row_sum16(c3s[rg]); inrm[rg] = 1.f / fmaxf(sqrtf(nrm[rg]), 1e-12f); }
            if (n_ == 0) {
#pragma unroll
                for (int rg = 0; rg < 4; ++rg) C3[(size_t)(rowq + 4 * grp_ + rg) * 8 + wv] = c3s[rg]; }
#pragma unroll
            for (int ct = 0; ct < 4; ++ct) { const int j = 16 * ct + n_;
                float lp[4]; lp[0] = wA[ct][0]; lp[1] = lp[0] * wA[ct][1]; lp[2] = lp[1] * wA[ct][2]; lp[3] = lp[2] * wA[ct][3];
                const float P0 = __shfl(lp[3], n_), P1 = __shfl(lp[3], n_ + 16), P2 = __shfl(lp[3], n_ + 32);
                const float E = grp_ == 0 ? 1.f : (grp_ == 1 ? P0 : (grp_ == 2 ? P0 * P1 : P0 * P1 * P2));
                float bt[4], kt[4];
#pragma unroll
                for (int rg = 0; rg < 4; ++rg) { const int t = 4 * grp_ + rg;
                    const float gam = E * lp[rg], gprev = rg == 0 ? E : E * lp[rg - 1], ig = 1.f / gam;
                    STG[t * 64 + j] = f2bf(-kkvA[ct][rg] * inrm[rg] * gprev); STG[1024 + t * 64 + j] = f2bf(rA[ct][rg] * gam);
                    bt[rg] = kkaA[ct][rg] * inrm[rg] * ig; kt[rg] = kprA[ct][rg] * ig;
                    STG[2048 + t * 64 + j] = f2bf(bt[rg]); STG[3072 + t * 64 + j] = f2bf(kt[rg]); }
                *(u32x2*)(CHp + 4096 + j * 32 + grp_ * 8) = (u32x2){pk2(bt[0], bt[1]), pk2(bt[2], bt[3])};
                *(u32x2*)(CHp + 6144 + j * 32 + grp_ * 8) = (u32x2){pk2(kt[0], kt[1]), pk2(kt[2], kt[3])};
                *(u32x2*)(CHp + 8192 + j * 32 + grp_ * 8) = (u32x2){pk2(vA[ct][0], vA[ct][1]), pk2(vA[ct][2], vA[ct][3])};
                if (grp_ == 3) GAM[idx * 64 + j] = E * lp[3]; }
        }
        asm volatile("s_waitcnt lgkmcnt(0)" ::: "memory");
        {   f32x4 mab = {0.f, 0.f, 0.f, 0.f}, mak = mab, nrb = mab, nrk = mab;
#pragma unroll
            for (int ks = 0; ks < 4; ++ks) { const int o = n_ * 64 + 16 * ks + 4 * grp_;
                const s16x4 fa = *(const s16x4*)(STG + o), fr = *(const s16x4*)(STG + 1024 + o), fb = *(const s16x4*)(STG + 2048 + o), fk = *(const s16x4*)(STG + 3072 + o);
                mab = mfma16k(fa, fb, mab); mak = mfma16k(fa, fk, mak); nrb = mfma16k(fr, fb, nrb); nrk = mfma16k(fr, fk, nrk); }
            asm volatile("s_waitcnt lgkmcnt(0)" ::: "memory");
            bf16* SM = STG + 2048;
#pragma unroll
            for (int rg = 0; rg < 4; ++rg) { const int t = 4 * grp_ + rg; const bool sl = t > n_, il = t >= n_;
                MAB[t * 16 + n_] = sl ? mab[rg] : 0.f;
                SM[256 + t * 16 + n_] = f2bf(sl ? mak[rg] : 0.f); SM[512 + t * 16 + n_] = f2bf(il ? nrb[rg] : 0.f); SM[768 + t * 16 + n_] = f2bf(il ? nrk[rg] : 0.f); }
            asm volatile("s_waitcnt lgkmcnt(0)" ::: "memory");
            if (lane_ < 16) {
                float Tc[16];
#pragma unroll
                for (int t = 0; t < 16; ++t) { float acc = (t == lane_) ? 1.f : 0.f;
#pragma unroll
                    for (int s2 = 0; s2 < t; ++s2) acc = fmaf(MAB[t * 16 + s2], Tc[s2], acc);
                    Tc[t] = acc; SM[t * 16 + lane_] = f2bf(acc); }
            }
            asm volatile("s_waitcnt lgkmcnt(0)" ::: "memory");
#pragma unroll
            for (int i = 0; i < 4; ++i) { const int id = i * 64 + lane_; *(u32x4*)(CHp + id * 16) = *(const u32x4*)((const unsigned char*)STG + id * 16); }
#pragma unroll
            for (int i = 0; i < 2; ++i) { const int id = i * 64 + lane_; *(u32x4*)(CHp + 10240 + id * 16) = *(const u32x4*)((const unsigned char*)SM + id * 16); }
        }
    }
#undef RKV_LOAD
#undef RKV_WRITE
}

__device__ __forceinline__ void stage_w_lds(const bf16* W, unsigned char* lds, int log2_cpr  , int tid) {
    const int cpr = 1 << log2_cpr;
#pragma unroll 4
    for (int i = 0; i < 16; ++i) { const int id = i * 512 + tid, row = id >> log2_cpr, ch = id & (cpr - 1);
        *(u32x4*)(lds + ((size_t)row << (log2_cpr + 4)) + (((ch & ~15) | ((ch ^ row) & 15)) << 4)) = *(const u32x4*)((const unsigned char*)W + (size_t)id * 16); }
}
__device__ __forceinline__ bf16x8 lds_wfrag(const unsigned char* lds, int row, int ch, int log2_cpr) {
    return *(const bf16x8*)(lds + ((size_t)row << (log2_cpr + 4)) + (((ch & ~15) | ((ch ^ row) & 15)) << 4));
}
__device__ __forceinline__ void dsa_prep_kv(const Params& p, const unsigned char* wl, int tile, int lane) {
    const bf16* PROJ = (const bf16*)(p.ws + WS_PROJ); bf16* CKV = (bf16*)(p.ws + WS_CKV); float* INVR = (float*)(p.ws + WS_INVR);
    const int r = lane & 31, hh = lane >> 5; const size_t row = (size_t)tile * 32 + r; const bf16* prow = PROJ + row * NPROJ;
    bf16x8 cf[8];
    {   u32x4 craw[8]; float ssq = 0.f;
#pragma unroll
        for (int s = 0; s < 8; ++s) { craw[s] = *(const u32x4*)(prow + PC_CL + 16 * s + 8 * hh);
#pragma unroll
            for (int w = 0; w < 4; ++w) { const float lo = bflo(craw[s][w]), hi = bfhi(craw[s][w]); ssq += lo * lo + hi * hi; } }
        ssq += __shfl_xor(ssq, 32);
        const float rstd = rsqrtf(ssq * (1.f / 128.f) + 1e-6f);
#pragma unroll
        for (int s = 0; s < 8; ++s) { const float* g = p.g_kv + 16 * s + 8 * hh; const f32x4 g0 = *(const f32x4*)g, g1 = *(const f32x4*)(g + 4);
            u32x4 o; o.x = pk2(bflo(craw[s].x) * rstd * g0.x, bfhi(craw[s].x) * rstd * g0.y); o.y = pk2(bflo(craw[s].y) * rstd * g0.z, bfhi(craw[s].y) * rstd * g0.w);
            o.z = pk2(bflo(craw[s].z) * rstd * g1.x, bfhi(craw[s].z) * rstd * g1.y); o.w = pk2(bflo(craw[s].w) * rstd * g1.z, bfhi(craw[s].w) * rstd * g1.w);
            cf[s] = __builtin_bit_cast(bf16x8, o); *(u32x4*)(CKV + row * 128 + 16 * s + 8 * hh) = o; }
    }
    unsigned wb[8];
#pragma unroll
    for (int s = 0; s < 8; ++s) wb[s] = (unsigned)(r * 256 + ((((2 * s + hh) ^ r) & 15) << 4));
#pragma unroll 1
    for (int h = 0; h < 8; ++h) { float ss = 0.f;
#pragma unroll
        for (int dt = 0; dt < 2; ++dt) { f32x16 acc = {}; const unsigned char* wg = wl + (h * 64 + dt * 32) * 256;
#pragma unroll
            for (int s = 0; s < 8; ++s) acc = mfma32(*(const bf16x8*)(wg + wb[s]), cf[s], acc);
#pragma unroll
            for (int i = 0; i < 16; ++i) ss += acc[i] * acc[i]; }
        ss += __shfl_xor(ss, 32);
        if (hh == 0) INVR[row * 8 + h] = rsqrtf(ss * (1.f / 64.f) + 1e-6f);
    }
}
__device__ __forceinline__ void dsa_prep_q(const Params& p, const unsigned char* wl, int tile, int lane) {
    const bf16* PROJ = (const bf16*)(p.ws + WS_PROJ); bf16* QABS = (bf16*)(p.ws + WS_REGA);
    const int r = lane & 31, hh = lane >> 5; const size_t row = (size_t)tile * 32 + r; const bf16* prow = PROJ + row * NPROJ;
    unsigned wb[2][4];
#pragma unroll
    for (int hp = 0; hp < 2; ++hp)
#pragma unroll
        for (int s = 0; s < 4; ++s) wb[hp][s] = (unsigned)(r * 1024 + ((((hp * 8 + 2 * s + hh) ^ r) & 15) << 4));
#pragma unroll 2
    for (int h = 0; h < 8; ++h) {
        u32x4 qraw[4]; float ssq = 0.f;
#pragma unroll
        for (int s = 0; s < 4; ++s) { qraw[s] = *(const u32x4*)(prow + PC_Q + h * 64 + 16 * s + 8 * hh);
#pragma unroll
            for (int w = 0; w < 4; ++w) { const float lo = bflo(qraw[s][w]), hi = bfhi(qraw[s][w]); ssq += lo * lo + hi * hi; } }
        ssq += __shfl_xor(ssq, 32);
        const float rstd = rsqrtf(ssq * (1.f / 64.f) + 1e-6f);
        bf16x8 qf[4];
#pragma unroll
        for (int s = 0; s < 4; ++s) { const int d0 = 16 * s + 8 * hh; float gg[8];
#pragma unroll
            for (int j = 0; j < 8; ++j) gg[j] = p.g_q[d0 + j] * p.g_k[d0 + j] * rstd;
            u32x4 o; o.x = pk2(bflo(qraw[s].x) * gg[0], bfhi(qraw[s].x) * gg[1]); o.y = pk2(bflo(qraw[s].y) * gg[2], bfhi(qraw[s].y) * gg[3]);
            o.z = pk2(bflo(qraw[s].z) * gg[4], bfhi(qraw[s].z) * gg[5]); o.w = pk2(bflo(qraw[s].w) * gg[6], bfhi(qraw[s].w) * gg[7]);
            qf[s] = __builtin_bit_cast(bf16x8, o); }
#pragma unroll
        for (int lt = 0; lt < 4; ++lt) { f32x16 acc = {}; const unsigned char* wg = wl + lt * 32768 + (h >> 1) * 256;
#pragma unroll
            for (int s = 0; s < 4; ++s) acc = mfma32(*(const bf16x8*)(wg + wb[h & 1][s]), qf[s], acc);
#pragma unroll
            for (int g4 = 0; g4 < 4; ++g4) { u32x2 o; o.x = pk2(acc[4 * g4] * 0.125f, acc[4 * g4 + 1] * 0.125f); o.y = pk2(acc[4 * g4 + 2] * 0.125f, acc[4 * g4 + 3] * 0.125f);
                *(u32x2*)(QABS + row * 1024 + h * 128 + lt * 32 + 8 * g4 + 4 * hh) = o; } }
    }
}

constexpr int SCAN_D = 8, SCAN_SLOT = 12288 + 256;
#define SCAN_BAR() do { asm volatile("s_waitcnt lgkmcnt(0)" ::: "memory"); __builtin_amdgcn_s_barrier(); asm volatile("" ::: "memory"); } while (0)
__device__ __forceinline__ void rwkv_scan_chain(const Params& p, unsigned char* lds, int chain, int wv, int lane) {
    const int b = chain >> 3, h = chain & 7;
    const size_t idx0 = (size_t)(b * 8 + h) * 128;
    if (wv >= 4) {
        const int li = (wv - 4) * 64 + lane;
        const unsigned char* src = p.ws + WS_CH + idx0 * 12288 + (size_t)li * 16; const float* gsrc = (const float*)(p.ws + WS_GAM) + idx0 * 64 + (li & 15) * 4;
        u32x4 R[SCAN_D][3]; f32x4 Rg[SCAN_D];
#pragma unroll
        for (int j = 0; j < SCAN_D; ++j) {
#pragma unroll
            for (int i = 0; i < 3; ++i) R[j][i] = *(const u32x4*)(src + (size_t)j * 12288 + i * 4096);
            Rg[j] = *(const f32x4*)(gsrc + (size_t)j * 64); }
        for (int k0 = 0; k0 < 128; k0 += SCAN_D) {
#pragma unroll
            for (int j = 0; j < SCAN_D; ++j) { const int k = k0 + j; unsigned char* slot = lds + (k & 1) * SCAN_SLOT;
#pragma unroll
                for (int i = 0; i < 3; ++i) *(u32x4*)(slot + li * 16 + i * 4096) = R[j][i];
                *(f32x4*)(slot + 12288 + (li & 15) * 16) = Rg[j];
                if (k + SCAN_D < 128) {
#pragma unroll
                    for (int i = 0; i < 3; ++i) R[j][i] = *(const u32x4*)(src + (size_t)(k + SCAN_D) * 12288 + i * 4096);
                    Rg[j] = *(const f32x4*)(gsrc + (size_t)(k + SCAN_D) * 64); }
                SCAN_BAR(); } }
    } else {
        const int w = wv, n = lane & 15, grp = lane >> 4;
        bf16* PROJ = (bf16*)(p.ws + WS_PROJ);
        f32x4 S[4];
#pragma unroll
        for (int jt = 0; jt < 4; ++jt) S[jt] = (f32x4){0.f, 0.f, 0.f, 0.f};
        for (int sc = 0; sc < 128; ++sc) {
            SCAN_BAR();
            const unsigned char* CHp = lds + (sc & 1) * SCAN_SLOT;
            s16x4 at[4], rt[4], bt[4], kt[4]; f32x4 gm[4];
#pragma unroll
            for (int jt = 0; jt < 4; ++jt) {
                at[jt] = *(const s16x4*)(CHp + n * 128 + (16 * jt + 4 * grp) * 2); rt[jt] = *(const s16x4*)(CHp + 2048 + n * 128 + (16 * jt + 4 * grp) * 2);
                bt[jt] = *(const s16x4*)(CHp + 4096 + (16 * jt + n) * 32 + grp * 8); kt[jt] = *(const s16x4*)(CHp + 6144 + (16 * jt + n) * 32 + grp * 8);
                gm[jt] = *(const f32x4*)(CHp + 12288 + (16 * jt + 4 * grp) * 4); }
            const s16x4 vt = *(const s16x4*)(CHp + 8192 + (16 * w + n) * 32 + grp * 8);
            const s16x4 Tm = *(const s16x4*)(CHp + 10240 + n * 32 + grp * 8), Mak = *(const s16x4*)(CHp + 10752 + n * 32 + grp * 8);
            const s16x4 Nrb = *(const s16x4*)(CHp + 11264 + n * 32 + grp * 8), Nrk = *(const s16x4*)(CHp + 11776 + n * 32 + grp * 8);
            s16x4 Sb[4];
#pragma unroll
            for (int jt = 0; jt < 4; ++jt) Sb[jt] = pack4(S[jt]);
            f32x4 X = {0.f, 0.f, 0.f, 0.f}, O = X;
#pragma unroll
            for (int jt = 0; jt < 4; ++jt) X = mfma16k(at[jt], Sb[jt], X);
            X = mfma16k(Mak, vt, X);
#pragma unroll
            for (int jt = 0; jt < 4; ++jt) O = mfma16k(rt[jt], Sb[jt], O);
            O = mfma16k(Nrk, vt, O);
            const f32x4 U = mfma16k(Tm, pack4(X), (f32x4){0.f, 0.f, 0.f, 0.f});
            const s16x4 Ub = pack4(U);
            O = mfma16k(Nrb, Ub, O);
#pragma unroll
            for (int jt = 0; jt < 4; ++jt) { S[jt] = mfma16k(kt[jt], vt, S[jt]); S[jt] = mfma16k(bt[jt], Ub, S[jt]); S[jt] = S[jt] * gm[jt]; }
            bf16* orow = PROJ + ((size_t)b * SEQ + sc * 16 + 4 * grp) * NPROJ + PC_R + h * 64 + 16 * w + n;
#pragma unroll
            for (int rg = 0; rg < 4; ++rg) orow[(size_t)rg * NPROJ] = f2bf(O[rg]);
        }
    }
}
__device__ __forceinline__ void rwkv_epi_rows(const Params& p, int gw, int NGW, int lane) {
    bf16* PROJ = (bf16*)(p.ws + WS_PROJ); const bf16* GB = (const bf16*)(p.ws + WS_G); const float* C3 = (const float*)(p.ws + WS_C3);
    const int c0 = lane * 8, h = lane >> 3, RPW = M / NGW;
    float muv[8], lw[8], lb[8];
#pragma unroll
    for (int i = 0; i < 8; ++i) { muv[i] = p.mu[1024 + c0 + i]; lw[i] = p.ln_w[c0 + i]; lb[i] = p.ln_b[c0 + i]; }
    for (int m0 = gw * RPW; m0 < M; m0 += NGW * RPW) {
        u32x4 vprev = {0u, 0u, 0u, 0u}; if ((m0 & (SEQ - 1)) != 0) vprev = *(const u32x4*)(PROJ + (size_t)(m0 - 1) * NPROJ + PC_V + c0);
        for (int r0 = 0; r0 < RPW; r0 += 4) {
            u32x4 oraw[4], vc[4], gr[4]; float c3[4];
#pragma unroll
            for (int r = 0; r < 4; ++r) { const size_t m = (size_t)(m0 + r0 + r); const bf16* prow = PROJ + m * NPROJ;
                oraw[r] = *(const u32x4*)(prow + PC_R + c0); vc[r] = *(const u32x4*)(prow + PC_V + c0); gr[r] = *(const u32x4*)(GB + m * 512 + c0); c3[r] = C3[m * 8 + h]; }
            float o[4][8], sm[4], q[4];
#pragma unroll
            for (int r = 0; r < 4; ++r) { sm[r] = 0.f;
#pragma unroll
                for (int i = 0; i < 4; ++i) { o[r][2 * i] = bflo(oraw[r][i]); o[r][2 * i + 1] = bfhi(oraw[r][i]); sm[r] += o[r][2 * i] + o[r][2 * i + 1]; } }
#pragma unroll
            for (int of = 1; of < 8; of <<= 1) {
#pragma unroll
                for (int r = 0; r < 4; ++r) sm[r] += __shfl_xor(sm[r], of); }
#pragma unroll
            for (int r = 0; r < 4; ++r) { const float mean = sm[r] * (1.f / 64.f); q[r] = 0.f;
#pragma unroll
                for (int i = 0; i < 8; ++i) { o[r][i] -= mean; q[r] += o[r][i] * o[r][i]; } }
#pragma unroll
            for (int of = 1; of < 8; of <<= 1) {
#pragma unroll
                for (int r = 0; r < 4; ++r) q[r] += __shfl_xor(q[r], of); }
#pragma unroll
            for (int r = 0; r < 4; ++r) { const float rstd = rsqrtf(q[r] * (1.f / 64.f) + 64e-5f); const u32x4 vp = r == 0 ? vprev : vc[r - 1];
                const bool first = ((m0 + r0 + r) & (SEQ - 1)) == 0;
                u32x4 out;
#pragma unroll
                for (int i = 0; i < 4; ++i) { float y[2];
#pragma unroll
                    for (int e = 0; e < 2; ++e) { const int ii = 2 * i + e; const float cv = e ? bfhi(vc[r][i]) : bflo(vc[r][i]), pv = first ? 0.f : (e ? bfhi(vp[i]) : bflo(vp[i]));
                        const float v = cv + muv[ii] * (pv - cv), g = e ? bfhi(gr[r][i]) : bflo(gr[r][i]);
                        y[e] = (o[r][ii] * rstd * lw[ii] + lb[ii] + c3[r] * v) * g; }
                    out[i] = pk2(y[0], y[1]); }
                *(u32x4*)(PROJ + (size_t)(m0 + r0 + r) * NPROJ + PC_R + c0) = out; }
            vprev = vc[3];
        }
    }
}

__device__ __forceinline__ unsigned f2key(float f) { unsigned b = __float_as_uint(f); if ((b << 1) == 0u) b = 0u; return (b & 0x80000000u) ? ~b : (b | 0x80000000u); }
__device__ __forceinline__ unsigned offb(unsigned row, unsigned ch) { return 2048u * (row >> 3) + 512u * (ch >> 2) + 64u * (row & 7) + 16u * ((ch & 3) ^ ((row >> 2) & 3)); }

__device__ __forceinline__ void topk_select(float* sc, int N, unsigned* hist, unsigned short* sel, int lane) {
    unsigned* kb = (unsigned*)sc;
    unsigned prefix = 0u, mask = 0u; int rem = 256, mbin = 0;
    const unsigned long long lt_mask = (1ull << lane) - 1ull;
    for (int pass = 0; pass < 4; ++pass) {
        const int shift = 24 - 8 * pass;
#pragma unroll
        for (int i = 0; i < 4; ++i) hist[lane * 4 + i] = 0u;
        asm volatile("s_waitcnt lgkmcnt(0)" ::: "memory");
        for (int base = 0; base < N; base += 256) { const int idx = base + 4 * lane;
            if (idx < N) { u32x4 k4;
                if (pass == 0) { const f32x4 v = *(const f32x4*)(sc + idx); k4 = (u32x4){f2key(v.x), f2key(v.y), f2key(v.z), f2key(v.w)}; *(u32x4*)(kb + idx) = k4; }
                else k4 = *(const u32x4*)(kb + idx);
#pragma unroll
                for (int e = 0; e < 4; ++e) if ((k4[e] & mask) == prefix) atomicAdd(&hist[(k4[e] >> shift) & 255u], 1u); } }
        asm volatile("s_waitcnt lgkmcnt(0)" ::: "memory");
        const unsigned c0 = hist[lane * 4], c1 = hist[lane * 4 + 1], c2 = hist[lane * 4 + 2], c3 = hist[lane * 4 + 3];
        const int cnt4 = (int)(c0 + c1 + c2 + c3);
        int incl = cnt4;
#pragma unroll
        for (int o = 1; o < 64; o <<= 1) { const int v = __shfl_down(incl, o); if (lane + o < 64) incl += v; }
        const int excl = incl - cnt4;
        const bool mine = (excl < rem) && (rem <= incl);
        const unsigned long long bal = __ballot(mine);
        const int L = (int)__builtin_ctzll(bal);
        const int ex = __shfl(excl, L); const int b3 = (int)__shfl((int)c3, L), b2 = (int)__shfl((int)c2, L), b1 = (int)__shfl((int)c1, L), b0 = (int)__shfl((int)c0, L);
        int above = ex, bin;
        if (above + b3 >= rem) { bin = 3; mbin = b3; } else { above += b3; if (above + b2 >= rem) { bin = 2; mbin = b2; } else { above += b2; if (above + b1 >= rem) { bin = 1; mbin = b1; } else { above += b1; bin = 0; mbin = b0; } } }
        rem -= above; prefix |= (unsigned)(L * 4 + bin) << shift; mask |= 0xffu << shift;
        if (pass == 1 && mbin <= 64) break;
    }
    const unsigned T = prefix; const int ngt = 256 - rem; int base_gt = 0, base_eq = 0;
    const bool partial = (mask != 0xffffffffu);
    unsigned short* cand = (unsigned short*)hist;
    for (int base = 0; base < N; base += 256) { const int idx = base + 4 * lane; const bool act = idx < N;
        u32x4 k4 = {0u, 0u, 0u, 0u}; if (act) k4 = *(const u32x4*)(kb + idx);
        bool gt[4], eq[4]; unsigned long long bg[4], be[4];
#pragma unroll
        for (int e = 0; e < 4; ++e) { const unsigned km = k4[e] & mask; gt[e] = act && km > T; eq[e] = act && km == T; bg[e] = __ballot(gt[e]); be[e] = __ballot(eq[e]); }
        int rg = base_gt, re = base_eq;
#pragma unroll
        for (int e = 0; e < 4; ++e) re += __popcll(be[e] & lt_mask);
#pragma unroll
        for (int e = 0; e < 4; ++e) {
            if (gt[e]) sel[rg + __popcll(bg[e] & lt_mask)] = (unsigned short)(idx + e);
            rg += __popcll(bg[e]);
            if (eq[e]) { if (partial) cand[re] = (unsigned short)(idx + e); else if (re < rem) sel[ngt + re] = (unsigned short)(idx + e); re += 1; } }
        base_gt = rg;
#pragma unroll
        for (int e = 0; e < 4; ++e) base_eq += __popcll(be[e]); }
    asm volatile("s_waitcnt lgkmcnt(0)" ::: "memory");
    if (partial) {
        const int m = mbin; const int ci = (lane < m) ? (int)cand[lane] : 0; const unsigned ck = (lane < m) ? kb[ci] : 0u;
        int rank = 0;
        for (int j = 0; j < m; ++j) { const unsigned kj = (unsigned)__shfl((int)ck, j); rank += (kj > ck || (kj == ck && j < lane)) ? 1 : 0; }
        if (lane < m && rank < rem) sel[ngt + rank] = (unsigned short)ci;
        asm volatile("s_waitcnt lgkmcnt(0)" ::: "memory");
    }
}

__device__ __forceinline__ float dpp_row_max16(float x) {
    x = fmaxf(x, __builtin_bit_cast(float, __builtin_amdgcn_mov_dpp(__builtin_bit_cast(int, x), 0xB1, 0xF, 0xF, true)));
    x = fmaxf(x, __builtin_bit_cast(float, __builtin_amdgcn_mov_dpp(__builtin_bit_cast(int, x), 0x4E, 0xF, 0xF, true)));
    x = fmaxf(x, __builtin_bit_cast(float, __builtin_amdgcn_mov_dpp(__builtin_bit_cast(int, x), 0x141, 0xF, 0xF, true)));
    x = fmaxf(x, __builtin_bit_cast(float, __builtin_amdgcn_mov_dpp(__builtin_bit_cast(int, x), 0x140, 0xF, 0xF, true)));
    return x;
}
__device__ __forceinline__ bool topk_select_fast(const float* sc, int N, float smax, unsigned* hist, unsigned short* sel, int lane) {
    const float scale = smax > 0.f ? 127.5f / smax : 0.f;
#define QBIN(x_) min(max((int)fmaf((x_), scale, 128.f), 0), 255)
#pragma unroll
    for (int i = 0; i < 4; ++i) hist[lane * 4 + i] = 0u;
    asm volatile("s_waitcnt lgkmcnt(0)" ::: "memory");
    for (int base = 0; base < N; base += 256) { const int idx = base + 4 * lane;
        if (idx < N) { const f32x4 v = *(const f32x4*)(sc + idx);
#pragma unroll
            for (int e = 0; e < 4; ++e) atomicAdd(&hist[QBIN(v[e])], 1u); } }
    asm volatile("s_waitcnt lgkmcnt(0)" ::: "memory");
    const unsigned c0 = hist[lane * 4], c1 = hist[lane * 4 + 1], c2 = hist[lane * 4 + 2], c3 = hist[lane * 4 + 3];
    const int cnt4 = (int)(c0 + c1 + c2 + c3);
    int incl = cnt4;
#pragma unroll
    for (int o = 1; o < 64; o <<= 1) { const int v = __shfl_down(incl, o); if (lane + o < 64) incl += v; }
    const int excl = incl - cnt4;
    const bool mine = (excl < 256) && (256 <= incl);
    const int L = (int)__builtin_ctzll(__ballot(mine));
    const int ex = __shfl(excl, L); const int b3 = (int)__shfl((int)c3, L), b2 = (int)__shfl((int)c2, L), b1 = (int)__shfl((int)c1, L), b0 = (int)__shfl((int)c0, L);
    int above = ex, bin, mbin;
    if (above + b3 >= 256) { bin = 3; mbin = b3; } else { above += b3; if (above + b2 >= 256) { bin = 2; mbin = b2; } else { above += b2; if (above + b1 >= 256) { bin = 1; mbin = b1; } else { above += b1; bin = 0; mbin = b0; } } }
    if (mbin > 64) return false;
    const int tb = L * 4 + bin, rem = 256 - above, ngt = above; int base_gt = 0, base_eq = 0;
    const unsigned long long lt_mask = (1ull << lane) - 1ull;
    unsigned short* cand = (unsigned short*)hist;
    for (int base = 0; base < N; base += 256) { const int idx = base + 4 * lane; const bool act = idx < N;
        f32x4 v = {0.f, 0.f, 0.f, 0.f}; if (act) v = *(const f32x4*)(sc + idx);
        bool gt[4], eq[4]; unsigned long long bg[4], be[4];
#pragma unroll
        for (int e = 0; e < 4; ++e) { const int qb = QBIN(v[e]); gt[e] = act && qb > tb; eq[e] = act && qb == tb; bg[e] = __ballot(gt[e]); be[e] = __ballot(eq[e]); }
        int rg = base_gt, re = base_eq;
#pragma unroll
        for (int e = 0; e < 4; ++e) re += __popcll(be[e] & lt_mask);
#pragma unroll
        for (int e = 0; e < 4; ++e) {
            if (gt[e]) sel[rg + __popcll(bg[e] & lt_mask)] = (unsigned short)(idx + e);
            rg += __popcll(bg[e]);
            if (eq[e]) { cand[re] = (unsigned short)(idx + e); re += 1; } }
        base_gt = rg;
#pragma unroll
        for (int e = 0; e < 4; ++e) base_eq += __popcll(be[e]); }
    asm volatile("s_waitcnt lgkmcnt(0)" ::: "memory");
    {   const int m = mbin; const int ci = (lane < m) ? (int)cand[lane] : 0; const unsigned ck = (lane < m) ? f2key(sc[ci]) : 0u;
        int rank = 0;
        for (int j = 0; j < m; ++j) { const unsigned kj = (unsigned)__shfl((int)ck, j); rank += (kj > ck || (kj == ck && j < lane)) ? 1 : 0; }
        if (lane < m && rank < rem) sel[ngt + rank] = (unsigned short)ci;
        asm volatile("s_waitcnt lgkmcnt(0)" ::: "memory"); }
#undef QBIN
    return true;
}

__device__ __forceinline__ void dsa_attend(const Params& p, int b, int t, const unsigned short* sel, int cnt, unsigned char* stage, int lane_in) {
    int lane = lane_in; asm volatile("" : "+v"(lane));
    const bf16* CKV = (const bf16*)(p.ws + WS_CKV) + (size_t)b * SEQ * 128; const float* INVR = (const float*)(p.ws + WS_INVR) + (size_t)b * SEQ * 8;
    bf16* QO = (bf16*)(p.ws + WS_REGA) + ((size_t)b * SEQ + t) * 1024;
    const int hd = lane & 15, grp = lane >> 4;
    bf16x8 bq[4];
#pragma unroll
    for (int s = 0; s < 4; ++s) { u32x4 z = {0u, 0u, 0u, 0u}; if (hd < 8) z = *(const u32x4*)(QO + hd * 128 + 32 * s + 8 * grp); bq[s] = __builtin_bit_cast(bf16x8, z); }
    const float slope = (hd < 8) ? exp2f(-(float)(hd + 1)) : 0.f;
    const int hsafe = hd & 7;
    float m_run = -INFINITY, l_part = 0.f;
    f32x4 O[8];
#pragma unroll
    for (int c = 0; c < 8; ++c) O[c] = (f32x4){0.f, 0.f, 0.f, 0.f};
    const LAS unsigned char* st3 = (const LAS unsigned char*)stage;
    const unsigned q4 = (lane & 15) >> 2, p4 = lane & 3;
    u32x4 G[8]; float IRn[8], PNn[8];
#define DA_ISSUE(ks_) do { \
    _Pragma("unroll") for (int i = 0; i < 8; ++i) { const int id = i * 64 + lane, row = id >> 4, ch = id & 15; const unsigned key = sel[(ks_) + row]; G[i] = *(const u32x4*)((const unsigned char*)CKV + (key * 256u + (unsigned)ch * 16u)); } } while (0)
#define DA_ISSUE2(ks_) do { \
    _Pragma("unroll") for (int i = 0; i < 8; ++i) { const int key = sel[(ks_) + 16 * (i >> 2) + 4 * grp + (i & 3)]; IRn[i] = *(const float*)((const unsigned char*)INVR + ((unsigned)key * 32u + (unsigned)hsafe * 4u)); PNn[i] = slope * fabsf((float)(t - key)); } } while (0)
    DA_ISSUE(cnt - 32); DA_ISSUE2(cnt - 32);
    for (int ks = cnt - 32; ks >= 0; ks -= 32) {
#pragma unroll
        for (int i = 0; i < 8; ++i) { const int id = i * 64 + lane, row = id >> 4, ch = id & 15; *(u32x4*)(stage + offb(row, ch)) = G[i]; }
        asm volatile("s_waitcnt lgkmcnt(0)" ::: "memory");
        if (ks >= 32) DA_ISSUE(ks - 32);
        float lg[8];
#pragma unroll
        for (int T = 0; T < 2; ++T) { f32x4 acc = {0.f, 0.f, 0.f, 0.f};
#pragma unroll
            for (int s = 0; s < 4; ++s) { const bf16x8 a = *(const bf16x8*)(stage + offb((lane & 15) + 16 * T, 4 * s + grp)); acc = mfma16(a, bq[s], acc); }
#pragma unroll
            for (int rg = 0; rg < 4; ++rg) lg[4 * T + rg] = acc[rg] * IRn[4 * T + rg] - PNn[4 * T + rg]; }
        if (ks >= 32) DA_ISSUE2(ks - 32);
        float mx = lg[0];
#pragma unroll
        for (int i = 1; i < 8; ++i) mx = fmaxf(mx, lg[i]);
        mx = fmaxf(mx, __shfl_xor(mx, 16)); mx = fmaxf(mx, __shfl_xor(mx, 32));
        const float m_new = fmaxf(m_run, mx);
        const float alpha = __expf(m_run - m_new);
        float ps = 0.f;
#pragma unroll
        for (int i = 0; i < 8; ++i) { lg[i] = __expf(lg[i] - m_new); ps += lg[i]; }
        l_part = l_part * alpha + ps; m_run = m_new;
        { float ar[4];
#pragma unroll
            for (int rg = 0; rg < 4; ++rg) ar[rg] = __shfl(alpha, 4 * grp + rg);
#pragma unroll
            for (int c = 0; c < 8; ++c)
#pragma unroll
                for (int rg = 0; rg < 4; ++rg) O[c][rg] *= ar[rg]; }
        {   u32x4 pw; pw.x = pk2(lg[0], lg[1]); pw.y = pk2(lg[2], lg[3]); pw.z = pk2(lg[4], lg[5]); pw.w = pk2(lg[6], lg[7]);
            const bf16x8 pa = __builtin_bit_cast(bf16x8, pw);
#pragma unroll
            for (int c = 0; c < 8; ++c) {
                const s16x4 lo = __builtin_bit_cast(s16x4, __builtin_amdgcn_ds_read_tr16_b64_v4i16((LAS s16x4*)(st3 + offb(4 * grp + q4, 2 * c + (p4 >> 1)) + 8 * (p4 & 1))));
                const s16x4 hi = __builtin_bit_cast(s16x4, __builtin_amdgcn_ds_read_tr16_b64_v4i16((LAS s16x4*)(st3 + offb(16 + 4 * grp + q4, 2 * c + (p4 >> 1)) + 8 * (p4 & 1))));
                const bf16x8 vb = {lo[0], lo[1], lo[2], lo[3], hi[0], hi[1], hi[2], hi[3]};
                O[c] = mfma16(pa, vb, O[c]); } }
        asm volatile("s_waitcnt lgkmcnt(0)" ::: "memory");
    }
#undef DA_ISSUE
#undef DA_ISSUE2
    float l = l_part; l += __shfl_xor(l, 16); l += __shfl_xor(l, 32);
    const float il = 1.f / l;
    float irr[4];
#pragma unroll
    for (int rg = 0; rg < 4; ++rg) irr[rg] = __shfl(il, 4 * grp + rg);
    if (grp < 2) {
#pragma unroll
        for (int rg = 0; rg < 4; ++rg)
#pragma unroll
            for (int c = 0; c < 8; ++c) QO[(4 * grp + rg) * 128 + 16 * c + hd] = f2bf(O[c][rg] * irr[rg]);
    }
}

#define DSA_LOAD_AF(af_, wqv_, b_, tq0_) do { const size_t rq_ = (size_t)(b_) * SEQ + (tq0_); const int r_ = lane & 31, g_ = lane >> 5, ql_ = 2 * ((r_ >> 2) & 1) + (r_ >> 4), hdm_ = 4 * ((r_ >> 3) & 1) + (r_ & 3); \
    _Pragma("unroll") for (int qg = 0; qg < 4; ++qg) _Pragma("unroll") for (int s = 0; s < 4; ++s) af_[qg][s] = *(const bf16x8*)(PROJ + (rq_ + 4 * qg + ql_) * NPROJ + PC_QI + hdm_ * 64 + 16 * s + 8 * g_); \
    wqv_ = (tid < 128) ? bf2f(PROJ[(rq_ + (tid >> 3)) * NPROJ + PC_WI + (tid & 7)]) * 0.044194173824159216f : 0.f; } while (0)
__device__ __forceinline__ void dsa_select_item(const Params& p, unsigned char* lds, int b, int tq0, int tid, bf16x8 (&af)[4][4], float& wqv, bool has_next, int nb, int ntq0) {
    bf16* PROJ = (bf16*)(p.ws + WS_PROJ);
    float* SC = (float*)lds;
    unsigned* HIST = (unsigned*)(lds + 131072);
    unsigned short* SEL = (unsigned short*)(lds + 131072 + 8192);
    float* WQ = (float*)(lds + 147456);
    unsigned* QMAX = (unsigned*)(lds + 147456 + 512);
    asm volatile("" : "+v"(tid));
    const int lane = tid & 63, wv = __builtin_amdgcn_readfirstlane(tid >> 6);
    const int N = ((tq0 >> 6) + 1) * 64; const size_t rowq0 = (size_t)b * SEQ + tq0;
    {
        const int r = lane & 31, g = lane >> 5;
        if (tid < 128) WQ[tid] = wqv;
        if (tid < 16) QMAX[tid] = 0u;
        float mxq[4][2];
#pragma unroll
        for (int qg = 0; qg < 4; ++qg) { mxq[qg][0] = 0.f; mxq[qg][1] = 0.f; }
        __syncthreads();
        bf16x8 bfr[4];
        { const bf16* krow = PROJ + ((size_t)b * SEQ + wv * 32 + r) * NPROJ + PC_KI + 8 * g;
#pragma unroll
          for (int s = 0; s < 4; ++s) bfr[s] = *(const bf16x8*)(krow + 16 * s); }
        for (int kt = wv; kt < N / 32; kt += NWAVES) {
            const int key = kt * 32 + r;
            bf16x8 bnx[4];
#pragma unroll
            for (int s = 0; s < 4; ++s) bnx[s] = bfr[s];
            if (kt + NWAVES < N / 32) { const bf16* krow = PROJ + ((size_t)b * SEQ + key + 32 * NWAVES) * NPROJ + PC_KI + 8 * g;
#pragma unroll
                for (int s = 0; s < 4; ++s) bnx[s] = *(const bf16x8*)(krow + 16 * s); }
#pragma unroll
            for (int qg = 0; qg < 4; ++qg) { f32x16 acc = {};
#pragma unroll
                for (int s = 0; s < 4; ++s) acc = mfma32(af[qg][s], bfr[s], acc);
#pragma unroll
                for (int qq = 0; qq < 2; ++qq) { float sc = 0.f; const f32x4 w0 = *(const f32x4*)(WQ + (4 * qg + 2 * g + qq) * 8), w1 = *(const f32x4*)(WQ + (4 * qg + 2 * g + qq) * 8 + 4);
#pragma unroll
                    for (int e = 0; e < 4; ++e) { sc = fmaf(w0[e], fmaxf(acc[8 * qq + e], 0.f), sc); sc = fmaf(w1[e], fmaxf(acc[8 * qq + 4 + e], 0.f), sc); }
                    SC[(4 * qg + 2 * g + qq) * 2048 + key] = sc; mxq[qg][qq] = fmaxf(mxq[qg][qq], fabsf(sc)); } }
#pragma unroll
            for (int s = 0; s < 4; ++s) bfr[s] = bnx[s];
        }
#pragma unroll
        for (int qg = 0; qg < 4; ++qg)
#pragma unroll
            for (int qq = 0; qq < 2; ++qq) { float m = dpp_row_max16(mxq[qg][qq]); m = fmaxf(m, __shfl_xor(m, 16));
                if (r == 0) atomicMax(&QMAX[4 * qg + 2 * g + qq], __float_as_uint(m)); }
        __syncthreads();
        if (has_next) DSA_LOAD_AF(af, wqv, nb, ntq0);
        bool fb[2];
        for (int q = 0; q < 2; ++q) fb[q] = !topk_select_fast(SC + (2 * wv + q) * 2048, N, __uint_as_float(QMAX[2 * wv + q]), HIST + wv * 256, SEL + (2 * wv + q) * 256, lane);
        for (int q = 0; q < 2; ++q) if (fb[q]) topk_select(SC + (2 * wv + q) * 2048, N, HIST + wv * 256, SEL + (2 * wv + q) * 256, lane);
    }
    asm volatile("s_waitcnt lgkmcnt(0)" ::: "memory");
    { const int q = lane >> 5; const u32x4 v = *(const u32x4*)(SEL + (2 * wv + q) * 256 + (lane & 31) * 8);
      *(u32x4*)(PROJ + (rowq0 + 2 * wv + q) * NPROJ + PC_Q + (lane & 31) * 8) = v; }
    __syncthreads();
}

__device__ __forceinline__ void dsa_attend_row(const Params& p, unsigned char* wlds, int row, int lane) {
    const bf16* PROJ = (const bf16*)(p.ws + WS_PROJ);
    const int b = row >> 11, t = row & (SEQ - 1), N = ((t >> 6) + 1) * 64, cnt = N > 256 ? 256 : N;
    unsigned short* SELW = (unsigned short*)(wlds + 8192);
    if (N > 256) { if (lane < 32) *(u32x4*)(SELW + lane * 8) = *(const u32x4*)(PROJ + (size_t)row * NPROJ + PC_Q + lane * 8); }
    else { for (int i = lane; i < cnt; i += 64) SELW[i] = (unsigned short)i; }
    asm volatile("s_waitcnt vmcnt(0) lgkmcnt(0)" ::: "memory");
    dsa_attend(p, b, t, SELW, cnt, wlds, lane);
    asm volatile("s_waitcnt lgkmcnt(0)" ::: "memory");
}

__device__ __forceinline__ void uv_item(const Params& p, const unsigned char* wl  , int tile, int lane) {
    bf16* PROJ = (bf16*)(p.ws + WS_PROJ); const bf16* OLAT = (const bf16*)(p.ws + WS_REGA);
    const int r = lane & 31, hh = lane >> 5; const size_t row = (size_t)tile * 32 + r;
    unsigned wb[8];
#pragma unroll
    for (int s = 0; s < 8; ++s) wb[s] = (unsigned)(r * 256 + ((((2 * s + hh) ^ r) & 15) << 4));
#pragma unroll 1
    for (int h = 0; h < 8; ++h) { bf16x8 of[8];
#pragma unroll
        for (int s = 0; s < 8; ++s) of[s] = *(const bf16x8*)(OLAT + row * 1024 + h * 128 + 16 * s + 8 * hh);
#pragma unroll
        for (int dt = 0; dt < 2; ++dt) { f32x16 acc = {}; const unsigned char* wg = wl + (h * 64 + dt * 32) * 256;
#pragma unroll
            for (int s = 0; s < 8; ++s) acc = mfma32(*(const bf16x8*)(wg + wb[s]), of[s], acc);
#pragma unroll
            for (int g4 = 0; g4 < 4; ++g4) { u32x2 o; o.x = pk2(acc[4 * g4], acc[4 * g4 + 1]); o.y = pk2(acc[4 * g4 + 2], acc[4 * g4 + 3]);
                *(u32x2*)(PROJ + row * NPROJ + PC_Q + h * 64 + dt * 32 + 8 * g4 + 4 * hh) = o; } }
    }
}

enum { PH_PRO = 0, PH_HN, PH_GEMM1, PH_PREP, PH_MIX, PH_ATT, PH_UV, PH_GOUT, PH_HN2, PH_UP, PH_DOWN, PH_COUNT };
#ifndef MK_SKIP_MIXER
#define MK_SKIP_MIXER 0
#endif
__global__ void __launch_bounds__(NWAVES * 64, 2) mk_fwd(Params p) {
    extern __shared__ __attribute__((aligned(16))) unsigned char lds[];
    cg::grid_group grid = cg::this_grid();
    const int tid = threadIdx.x, lane = tid & 63, wv = __builtin_amdgcn_readfirstlane(tid >> 6);
    const int G = gridDim.x, gw = blockIdx.x * NWAVES + wv, NGW = G * NWAVES;
    const int lo = p.ph_lo, hi = p.ph_hi;
    float* MOD = (float*)(p.ws + WS_MOD); bf16* REGA = (bf16*)(p.ws + WS_REGA); bf16* PROJ = (bf16*)(p.ws + WS_PROJ);
#ifndef MK_PHASE_MASK
#define MK_PHASE_MASK 0x7ff
#endif
#define IN(k) (((MK_PHASE_MASK >> (k)) & 1) && lo <= (k) && (k) < hi)
#define SEAM(k) do { if (IN(k) && IN((k) + 1)) grid.sync(); if (MK_PROBE >= 0 && blockIdx.x == 0 && tid == 0) ((unsigned long long*)(p.ws + WS_MOD + 800 * 1024))[(k) + 1] = __builtin_amdgcn_s_memrealtime(); } while (0)
    if (MK_PROBE >= 0 && blockIdx.x == 0 && tid == 0) ((unsigned long long*)(p.ws + WS_MOD + 800 * 1024))[0] = __builtin_amdgcn_s_memrealtime();
    if (IN(PH_PRO)) { phase_pro(p, lds, tid, G); }
    SEAM(PH_PRO);
    if (IN(PH_HN)) { hn_rows<MK_F8_GEMM1 != 0>(p.x, p.g_mix, MOD, 0, 1024, REGA, gw, NGW, lane); }
    SEAM(PH_HN);
    if (IN(PH_GEMM1)) {
#if MK_F8_GEMM1
        pg8::Gemm g{REGA, (const bf16*)(p.ws + WS_WIN), M, NPROJ, DM / 2, DM / 2}; pg8::StaticOrder S; S.init(M, NPROJ, G, (int)blockIdx.x);
        pg8::EpiBf16<0> E{PROJ, NPROJ, 1.f / 32.f};
        pg8::gemm_phase<pg8::EpiBf16<0>, pg8::StaticOrder, true, true, true>((PG8_LAS unsigned char*)lds, g, S, E);
#else
        pg8::Gemm g{REGA, (const bf16*)(p.ws + WS_WIN), M, NPROJ, DM, DM}; pg8::StaticOrder S; S.init(M, NPROJ, G, (int)blockIdx.x);
        pg8::EpiBf16<0> E{PROJ, NPROJ, 1.f};
        pg8::gemm_phase<pg8::EpiBf16<0>, pg8::StaticOrder, true, true>((PG8_LAS unsigned char*)lds, g, S, E);
#endif
    }
    SEAM(PH_GEMM1);
    if (IN(PH_PREP)) {
#ifndef DBG_NO_RP
        for (int it = blockIdx.x; it < M / 64; it += G) rwkv_prep_item(p, lds, it, tid);
#endif
#ifndef DBG_NO_DP
        __syncthreads();
        stage_w_lds((const bf16*)(p.ws + WS_WUKT), lds, 4, tid); __syncthreads();
        for (int tile = gw; tile < M / 32; tile += NGW) dsa_prep_kv(p, lds, tile, lane);
        __syncthreads();
        stage_w_lds((const bf16*)(p.ws + WS_WUK), lds, 6, tid); __syncthreads();
        for (int tile = gw; tile < M / 32; tile += NGW) dsa_prep_q(p, lds, tile, lane);
#endif
    }
    SEAM(PH_PREP);
    if (IN(PH_MIX)) {
        for (int chain = blockIdx.x; chain < NB * 8; chain += G) { rwkv_scan_chain(p, lds, chain, wv, lane); __syncthreads(); }
        constexpr int NSEL = NB * 112;
        {   bf16x8 af[4][4]; float wqv = 0.f; const bf16* PROJ = (const bf16*)(p.ws + WS_PROJ);
            int idx = (int)blockIdx.x;
            if (idx < NSEL) DSA_LOAD_AF(af, wqv, idx / 112, 256 + 16 * (idx % 112));
            for (int k = 0; idx < NSEL; ++k) { const int nidx = (k + 1) * G + (((k + 1) & 1) ? (G - 1 - (int)blockIdx.x) : (int)blockIdx.x); const bool hn = nidx < NSEL;
                dsa_select_item(p, lds, idx / 112, 256 + 16 * (idx % 112), tid, af, wqv, hn, nidx / 112, 256 + 16 * (nidx % 112)); idx = nidx; } }
    }
    SEAM(PH_MIX);
    if (IN(PH_ATT)) {
        for (int row = gw; row < M; row += NGW) dsa_attend_row(p, lds + wv * 9216, row, lane);
    }

    SEAM(PH_ATT);
    if (IN(PH_UV)) {
#if MK_DBG == 7
        for (int m = gw; m < M; m += NGW) { *(u32x4*)(PROJ + (size_t)m * NPROJ + lane * 8) = *(const u32x4*)(REGA + (size_t)m * 1024 + lane * 8); }
#elif MK_DBG != 2
        stage_w_lds((const bf16*)(p.ws + WS_WUVT), lds, 4, tid); __syncthreads();
        for (int tile = gw; tile < M / 32; tile += NGW) uv_item(p, lds, tile, lane);
#endif
#if MK_DBG == 0
        rwkv_epi_rows(p, gw, NGW, lane);
#endif
#if MK_DBG == 1 || MK_DBG == 2
        for (int m = gw; m < M; m += NGW) { u32x4 z = {0u, 0u, 0u, 0u}; *(u32x4*)(PROJ + (size_t)m * NPROJ + (MK_DBG == 1 ? 512 : 0) + lane * 8) = z; }
#endif
    }
    SEAM(PH_UV);
    if (IN(PH_GOUT)) {
        pg8::Gemm g{PROJ, (const bf16*)(p.ws + WS_WOUT), M, DM, DM, NPROJ}; pg8::StaticOrder S; S.init(M, DM, G, (int)blockIdx.x);
        pg8::EpiResGate E{p.x, p.out, DM, MOD + 2048, 6144, 1.f};
        pg8::gemm_phase<pg8::EpiResGate, pg8::StaticOrder, true, true>((PG8_LAS unsigned char*)lds, g, S, E);
    }
    SEAM(PH_GOUT);
    if (IN(PH_HN2)) { hn_rows<false>(MK_SKIP_MIXER ? p.x : p.out, p.g_ffn, MOD, 3072, 4096, REGA, gw, NGW, lane); }
    SEAM(PH_HN2);
    if (IN(PH_UP)) {
        pg8::Gemm g{REGA, (const bf16*)(p.ws + WS_W1), M, FF, DM, DM}; pg8::StaticOrder S; S.init(M, FF, G, (int)blockIdx.x);
        pg8::EpiF8Relu2 E{p.ws + WS_U, FF, 4.f};
        pg8::gemm_phase<pg8::EpiF8Relu2, pg8::StaticOrder, true, true>((PG8_LAS unsigned char*)lds, g, S, E);
    }
    SEAM(PH_UP);
    if (IN(PH_DOWN)) {
        pg8::Gemm g{(const bf16*)(p.ws + WS_U), (const bf16*)(p.ws + WS_W2), M, DM, FF / 2, FF / 2}; pg8::StaticOrder S; S.init(M, DM, G, (int)blockIdx.x);
        pg8::EpiResGate E{MK_SKIP_MIXER ? p.x : p.out, p.out, DM, MOD + 5120, 6144, 1.f / 256.f};
        pg8::gemm_phase<pg8::EpiResGate, pg8::StaticOrder, true, true, true>((PG8_LAS unsigned char*)lds, g, S, E);
    }
#if MK_PROBE >= 0
    grid.sync();
    if (blockIdx.x == 0 && tid == 0) { unsigned long long* ts = (unsigned long long*)(p.ws + WS_MOD + 800 * 1024); ts[PH_COUNT] = __builtin_amdgcn_s_memrealtime();
        p.out[0] += (float)(ts[MK_PROBE + 1] - ts[MK_PROBE]) * 1e-3f; }
#endif
#undef IN
#undef SEAM
}

#ifndef MK_N_LAUNCHES
#define MK_N_LAUNCHES 1
#endif
extern "C" void kernel_launch(void* const* d_in, const int* in_sizes, int n_in, void* d_out, int out_size, void* d_ws, size_t ws_size, hipStream_t stream) {
    static int grid = 0;
    if (grid == 0) {
        if (n_in != 26 || out_size != M * DM || ws_size < WS_END) { fprintf(stderr, "kernel_launch: unexpected shapes (n_in %d out %d ws %zu)\n", n_in, out_size, ws_size); grid = -1; return; }
        int dev = 0, cus = 0, per_cu = 0;
        hipGetDevice(&dev); hipDeviceGetAttribute(&cus, hipDeviceAttributeMultiprocessorCount, dev);
        if (hipFuncSetAttribute((const void*)mk_fwd, hipFuncAttributeMaxDynamicSharedMemorySize, LDS_BYTES) != hipSuccess) { fprintf(stderr, "kernel_launch: hipFuncSetAttribute failed\n"); grid = -1; return; }
        if (hipOccupancyMaxActiveBlocksPerMultiprocessor(&per_cu, (const void*)mk_fwd, NWAVES * 64, LDS_BYTES) != hipSuccess || per_cu < 1) { fprintf(stderr, "kernel_launch: occupancy query says %d\n", per_cu); per_cu = 1; }
        (void)hipGetLastError();
        grid = cus * 1;
        if (per_cu < 1) grid = -1;
    }
    if (grid < 0) return;
    Params p{};
    const float** pp = (const float**)&p;
    for (int i = 0; i < 26; ++i) pp[i] = (const float*)d_in[i];
    p.out = (float*)d_out; p.ws = (unsigned char*)d_ws;
#if MK_N_LAUNCHES == 1
    p.ph_lo = 0; p.ph_hi = PH_COUNT;
    void* args[] = {&p};
    hipError_t e = hipLaunchCooperativeKernel((const void*)mk_fwd, dim3(grid), dim3(NWAVES * 64), args, LDS_BYTES, stream);
    if (e != hipSuccess) fprintf(stderr, "cooperative launch failed: %s (grid %d)\n", hipGetErrorString(e), grid);
#else
    for (int ph = 0; ph < PH_COUNT; ++ph) {
#if MK_SKIP_MIXER
        if (ph >= PH_HN && ph <= PH_GOUT) continue;
#endif
        p.ph_lo = ph; p.ph_hi = ph + 1;
        hipLaunchKernelGGL(mk_fwd, dim3(grid), dim3(NWAVES * 64), LDS_BYTES, stream, p);
    }
#endif
}
```

```cpp
#include <hip/hip_runtime.h>
#include <hip/hip_cooperative_groups.h>
#include <cstdio>
#include <cstdint>
#include <cmath>
namespace cg = cooperative_groups;
#ifndef MK_F8_GEMM1
#define MK_F8_GEMM1 0
#endif
#ifndef MK_PROBE
#define MK_PROBE -1
#endif
#ifndef MK_DBG
#define MK_DBG 0
#endif
#ifndef MK_DBG_NOTOPK
#define MK_DBG_NOTOPK 0
#endif
namespace pg8 {
#define PG8_LAS __attribute__((address_space(3)))
typedef unsigned short bf16_t;
typedef short bf16x8 __attribute__((ext_vector_type(8)));
typedef float f32x4 __attribute__((ext_vector_type(4)));
typedef unsigned u32x4 __attribute__((ext_vector_type(4)));
constexpr int BM = 256, BK = 64, HALF = 128, HTB = HALF * BK * 2  , STAGE_BYTES = 8 * HTB, NXCD = 8, WGM = 8;

__host__ __device__ __forceinline__ int lds_byte(int r, int c) { const int st = (r >> 4) * 2 + (c >> 5), rr = r & 15, cc = c & 31, ob = rr * 64 + cc * 2; return st * 1024 + (ob ^ (((ob >> 9) & 1) << 5)); }
__host__ __device__ __forceinline__ void stage_rc(int b, int& R, int& C) { const int st = b / 1024, sb = b % 1024, swz = sb ^ (((sb >> 9) & 1) << 5); R = (st >> 1) * 16 + swz / 64; C = (st & 1) * 32 + (swz % 64) / 2; }
__host__ __device__ __forceinline__ int perm32(int rho) { const int n = rho >> 4, i = rho & 15; return 8 * (i >> 2) + 4 * n + (i & 3); }

struct Unit { int pm, pn; };
struct Gemm { const bf16_t* A; const bf16_t* Bt; int M, N, K, lda; };

struct StaticOrder {
    int nM, nN, nwg, G, c;
    __host__ __device__ void init(int M, int N, int G_, int c_) { nM = M / BM; nN = N / BM; nwg = nM * nN; G = G_; c = c_; }
    __host__ __device__ bool next(int i, Unit& u) const {
        const long L = (long)i * G + c; if (L >= nwg) return false;
        int wgid = (int)L; { const int q = nwg / NXCD, r = nwg % NXCD, xcd = wgid % NXCD, off = wgid / NXCD; wgid = (xcd < r ? xcd * (q + 1) : r * (q + 1) + (xcd - r) * q) + off; }
        const int nig = WGM * nN, gid = wgid / nig, fm = gid * WGM, gsz = (nM - fm) < WGM ? (nM - fm) : WGM;
        u.pm = fm + ((wgid % nig) % gsz); u.pn = (wgid % nig) / gsz; return true;
    }
    __device__ __forceinline__ void a_ready(const Unit&) const {}
    __device__ __forceinline__ void done(const Unit&) const {}
};


typedef float f32x2_t __attribute__((ext_vector_type(2))); typedef __bf16 bf16x2_t __attribute__((ext_vector_type(2)));
__device__ __forceinline__ unsigned cvt_pk_bf16(float lo, float hi) { const f32x2_t v = {lo, hi}; const bf16x2_t b = __builtin_convertvector(v, bf16x2_t); return __builtin_bit_cast(unsigned, b); }

template <int ACT  > struct EpiBf16 {
    static constexpr bool PERM = true, AFTER_DRAIN = false;
    bf16_t* O; int ldc; float scale;
    __device__ __forceinline__ void operator()(const f32x4 (&acc)[2][2][4][2], const Unit& u, int wr, int wc, int fr, int fq) const {
        const int row0 = u.pm * BM + wr * 64 + fr; const int col0 = u.pn * BM + wc * 32 + 8 * fq;
#pragma unroll
        for (int ai = 0; ai < 2; ++ai)
#pragma unroll
            for (int m = 0; m < 4; ++m) { bf16_t* rowp = O + (size_t)(row0 + ai * HALF + m * 16) * ldc + col0;
#pragma unroll
                for (int bj = 0; bj < 2; ++bj) { f32x4 v0 = acc[ai][bj][m][0] * scale, v1 = acc[ai][bj][m][1] * scale;
                    if (ACT == 1) {
#pragma unroll
                        for (int j = 0; j < 4; ++j) { const float a = v0[j] > 0.f ? v0[j] : 0.f, b = v1[j] > 0.f ? v1[j] : 0.f; v0[j] = a * a; v1[j] = b * b; } }
                    u32x4 w; w.x = cvt_pk_bf16(v0[0], v0[1]); w.y = cvt_pk_bf16(v0[2], v0[3]); w.z = cvt_pk_bf16(v1[0], v1[1]); w.w = cvt_pk_bf16(v1[2], v1[3]);
                    *(u32x4*)(rowp + bj * HALF) = w; } }
    }
};
__device__ __forceinline__ unsigned pk4_fp8(float a, float b, float c, float d) { int r = __builtin_amdgcn_cvt_pk_fp8_f32(a, b, 0, false); r = __builtin_amdgcn_cvt_pk_fp8_f32(c, d, r, true); return (unsigned)r; }
struct EpiF8Relu2 {
    static constexpr bool PERM = true, AFTER_DRAIN = false;
    unsigned char* O; int ldc; float scale;
    __device__ __forceinline__ void operator()(const f32x4 (&acc)[2][2][4][2], const Unit& u, int wr, int wc, int fr, int fq) const {
        const int row0 = u.pm * BM + wr * 64 + fr; const int col0 = u.pn * BM + wc * 32 + 8 * fq;
#pragma unroll
        for (int ai = 0; ai < 2; ++ai)
#pragma unroll
            for (int m = 0; m < 4; ++m) { unsigned char* rowp = O + (size_t)(row0 + ai * HALF + m * 16) * ldc + col0;
#pragma unroll
                for (int bj = 0; bj < 2; ++bj) { f32x4 v0 = acc[ai][bj][m][0], v1 = acc[ai][bj][m][1];
#pragma unroll
                    for (int j = 0; j < 4; ++j) { const float a = v0[j] > 0.f ? v0[j] : 0.f, b = v1[j] > 0.f ? v1[j] : 0.f; v0[j] = fminf(a * a * scale, 416.f); v1[j] = fminf(b * b * scale, 416.f); }
                    typedef unsigned u32x2_t __attribute__((ext_vector_type(2)));
                    u32x2_t w; w.x = pk4_fp8(v0[0], v0[1], v0[2], v0[3]); w.y = pk4_fp8(v1[0], v1[1], v1[2], v1[3]);
                    *(u32x2_t*)(rowp + bj * HALF) = w; } }
    }
};
struct EpiResGate {
    static constexpr bool PERM = false, AFTER_DRAIN = false;
    const float* base; float* out; int ldc; const float* gate; int gate_ld; float gscale;
    __device__ __forceinline__ void operator()(const f32x4 (&acc)[2][2][4][2], const Unit& u, int, int, int, int) const {
        int t_ = threadIdx.x; asm volatile("" : "+v"(t_));
        const int wr = t_ >> 8, wc = (t_ >> 6) & 3, fr = t_ & 15, fq = (t_ >> 4) & 3;
        const int row0 = u.pm * BM + wr * 64 + fr, col0 = u.pn * BM + wc * 32 + 4 * fq;
        const float* gp = gate + (size_t)(u.pm >> 3) * gate_ld + col0;
        f32x4 gv[2][2];
#pragma unroll
        for (int bj = 0; bj < 2; ++bj)
#pragma unroll
            for (int n = 0; n < 2; ++n) gv[bj][n] = *(const f32x4*)(gp + bj * HALF + n * 16) * gscale;
#pragma unroll
        for (int ai = 0; ai < 2; ++ai)
#pragma unroll
            for (int m = 0; m < 4; ++m) { const size_t off = (size_t)(row0 + ai * HALF + m * 16) * ldc + col0;
#pragma unroll
                for (int bj = 0; bj < 2; ++bj)
#pragma unroll
                    for (int n = 0; n < 2; ++n) { const f32x4 bs = *(const f32x4*)(base + off + bj * HALF + n * 16);
                        *(f32x4*)(out + off + bj * HALF + n * 16) = bs + gv[bj][n] * acc[ai][bj][m][n]; } }
    }
};
template <class Epi, class Sched, bool ALIGN_EPI = false, bool SP2 = false, bool F8 = false>
__device__ __forceinline__ void gemm_phase(PG8_LAS unsigned char* lds, const Gemm g, const Sched& S, const Epi& E) {
    const int tid = threadIdx.x, wid = __builtin_amdgcn_readfirstlane(tid >> 6), lane = tid & 63, wr = wid >> 2, wc = wid & 3, fr = lane & 15, fq = lane >> 4;
    const int K = g.K, nt = K / BK;
    unsigned voffA[2], voffB[2];
#pragma unroll
    for (int i = 0; i < 2; ++i) { int R, C; stage_rc(tid * 16 + i * 8192, R, C); const int Rb = Epi::PERM ? ((R & ~31) + perm32(R & 31)) : R;
        voffA[i] = (unsigned)(R * g.lda + C) * 2u; voffB[i] = (unsigned)(Rb * K + C) * 2u; }
    const size_t kstep = (size_t)(BK * 2);
    const size_t hstepB = (size_t)HALF * K * 2, hstepA = (size_t)HALF * g.lda * 2;
    const size_t tstepA = 2 * hstepA, tstepB = 2 * hstepB;
    const unsigned ldsw = (unsigned)wid * 1024u;
    const int f8in = (fq >> 1) * 1024 + ((fr * 64 + (fq & 1) * 32) ^ ((fr >> 3) << 5));
    const int aoff = F8 ? wr * 8192 + f8in : lds_byte(wr * 64 + fr, fq * 8), boff = F8 ? wc * 4096 + f8in : lds_byte(wc * 32 + fr, fq * 8);
    constexpr int KOFF = F8 ? 16 : 1024;
    typedef int v8i_t __attribute__((ext_vector_type(8)));
#define PG8_SA(b, h) (((b) * 2 + (h)) * HTB)
#define PG8_SB(b, h) ((4 + (b) * 2 + (h)) * HTB)
#define PG8_STAGE(bufoff, gbase, voff) do { _Pragma("unroll") for (int _i = 0; _i < 2; ++_i) \
        __builtin_amdgcn_global_load_lds((const unsigned*)((const char*)(gbase) + (voff)[_i]), (PG8_LAS unsigned*)(lds + (bufoff) + ldsw + _i * 8192), 16, 0, 0); } while (0)
#define PG8_LD32(p_) __builtin_shufflevector(*(const PG8_LAS u32x4*)(p_), *(const PG8_LAS u32x4*)((p_) + 16), 0, 1, 2, 3, 4, 5, 6, 7)
#define PG8_LDA(dst, b, h) do { if constexpr (F8) { _Pragma("unroll") for (int m = 0; m < 4; ++m) dst##8[m] = __builtin_bit_cast(v8i_t, PG8_LD32(lds + PG8_SA(b, h) + aoff + m * 2048)); } \
    else { _Pragma("unroll") for (int m = 0; m < 4; ++m) _Pragma("unroll") for (int k = 0; k < 2; ++k) dst[m][k] = *(const PG8_LAS bf16x8*)(lds + PG8_SA(b, h) + aoff + m * 2048 + k * KOFF); } } while (0)
#define PG8_LDB(dst, b, h) do { if constexpr (F8) { _Pragma("unroll") for (int n = 0; n < 2; ++n) dst##8[n] = __builtin_bit_cast(v8i_t, PG8_LD32(lds + PG8_SB(b, h) + boff + n * 2048)); } \
    else { _Pragma("unroll") for (int n = 0; n < 2; ++n) _Pragma("unroll") for (int k = 0; k < 2; ++k) dst[n][k] = *(const PG8_LAS bf16x8*)(lds + PG8_SB(b, h) + boff + n * 2048 + k * KOFF); } } while (0)
#define PG8_CAT(x) __builtin_shufflevector(__builtin_bit_cast(u32x4, (x)[0]), __builtin_bit_cast(u32x4, (x)[1]), 0, 1, 2, 3, 4, 5, 6, 7)
#define PG8_MMA(ai, bj, At, Bt) do { __builtin_amdgcn_s_setprio(1); if constexpr (F8) { _Pragma("unroll") for (int m = 0; m < 4; ++m) _Pragma("unroll") for (int n = 0; n < 2; ++n) \
        asm volatile("v_mfma_f32_16x16x128_f8f6f4 %0, %1, %2, %0" : "+v"(acc[ai][bj][m][n]) : "v"(Bt##8[n]), "v"(At##8[m])); } \
    else { _Pragma("unroll") for (int m = 0; m < 4; ++m) _Pragma("unroll") for (int n = 0; n < 2; ++n) _Pragma("unroll") for (int k = 0; k < 2; ++k) \
        acc[ai][bj][m][n] = __builtin_amdgcn_mfma_f32_16x16x32_bf16(Bt[n][k], At[m][k], acc[ai][bj][m][n], 0, 0, 0); } __builtin_amdgcn_s_setprio(0); } while (0)
#define PG8_WAIT_V(n) asm volatile("s_waitcnt vmcnt(" #n ")" ::: "memory")
#define PG8_WAIT_L(n) asm volatile("s_waitcnt lgkmcnt(" #n ")" ::: "memory")
#define PG8_BAR __builtin_amdgcn_s_barrier()
#define PG8_SCHED __builtin_amdgcn_sched_barrier(0)
    Unit cur, nxt; int ui = 0;
    if (!S.next(0, cur)) return;
    f32x4 acc[2][2][4][2];
#pragma unroll
    for (int a = 0; a < 2; ++a)
#pragma unroll
        for (int b = 0; b < 2; ++b)
#pragma unroll
            for (int m = 0; m < 4; ++m)
#pragma unroll
                for (int n = 0; n < 2; ++n) acc[a][b][m][n] = (f32x4){0.f, 0.f, 0.f, 0.f};
    bf16x8 At[4][2], B0[2][2], B1[2][2]; v8i_t At8[4], B08[2], B18[2];
    const char* cA = (const char*)g.A + (size_t)cur.pm * tstepA; const char* cB = (const char*)g.Bt + (size_t)cur.pn * tstepB;
    S.a_ready(cur);
    if constexpr (SP2) {
        PG8_STAGE(PG8_SB(0, 0), cB, voffB); PG8_STAGE(PG8_SB(0, 1), cB + hstepB, voffB); PG8_STAGE(PG8_SA(0, 0), cA, voffA); PG8_STAGE(PG8_SA(0, 1), cA + hstepA, voffA);
        if (wr == 1) PG8_BAR;
        PG8_WAIT_V(2); PG8_BAR;
        PG8_STAGE(PG8_SB(1, 0), cB + kstep, voffB); PG8_STAGE(PG8_SA(1, 0), cA + kstep, voffA); PG8_STAGE(PG8_SB(1, 1), cB + hstepB + kstep, voffB);
        PG8_WAIT_V(6); PG8_BAR;
    } else {
        PG8_STAGE(PG8_SB(0, 0), cB, voffB); PG8_STAGE(PG8_SA(0, 0), cA, voffA); PG8_STAGE(PG8_SB(0, 1), cB + hstepB, voffB); PG8_STAGE(PG8_SA(0, 1), cA + hstepA, voffA);
        if (wr == 1) PG8_BAR;
        PG8_WAIT_V(4); PG8_BAR;
        PG8_STAGE(PG8_SB(1, 0), cB + kstep, voffB); PG8_STAGE(PG8_SA(1, 0), cA + kstep, voffA); PG8_STAGE(PG8_SB(1, 1), cB + hstepB + kstep, voffB);
        PG8_WAIT_V(6); PG8_BAR;
    }
    for (;;) {
        const bool has_next = S.next(ui + 1, nxt);
        const char* nA = has_next ? (const char*)g.A + (size_t)nxt.pm * tstepA : cA; const char* nB = has_next ? (const char*)g.Bt + (size_t)nxt.pn * tstepB : cB;
        for (int t = 0; t < nt; t += 2) {
            const bool last = (t == nt - 2);
            const char* a1 = cA + (size_t)(t + 1) * kstep;
            const char* a2 = last ? nA : cA + (size_t)(t + 2) * kstep; const char* b2 = last ? nB : cB + (size_t)(t + 2) * kstep;
            const char* a3 = a2 + kstep; const char* b3 = b2 + kstep;
            if (last && has_next) S.a_ready(nxt);
            if constexpr (SP2) {
            PG8_LDB(B0, 0, 0); PG8_LDB(B1, 0, 1); PG8_SCHED; PG8_LDA(At, 0, 0); PG8_STAGE(PG8_SA(1, 1), a1 + hstepA, voffA);
            PG8_WAIT_V(8); PG8_WAIT_L(0); PG8_BAR; PG8_MMA(0, 0, At, B0); PG8_MMA(0, 1, At, B1); PG8_BAR; PG8_SCHED;
            PG8_LDA(At, 0, 1); PG8_STAGE(PG8_SB(0, 0), b2, voffB); PG8_STAGE(PG8_SB(0, 1), b2 + hstepB, voffB); PG8_STAGE(PG8_SA(0, 0), a2, voffA);
            PG8_WAIT_V(8); PG8_WAIT_L(0); PG8_BAR; PG8_MMA(1, 0, At, B0); PG8_MMA(1, 1, At, B1); PG8_BAR; PG8_SCHED;
            PG8_LDB(B0, 1, 0); PG8_LDB(B1, 1, 1); PG8_SCHED; PG8_LDA(At, 1, 0); PG8_STAGE(PG8_SA(0, 1), a2 + hstepA, voffA);
            PG8_WAIT_V(8); PG8_WAIT_L(0); PG8_BAR; PG8_MMA(0, 0, At, B0); PG8_MMA(0, 1, At, B1); PG8_BAR; PG8_SCHED;
            PG8_LDA(At, 1, 1); PG8_STAGE(PG8_SB(1, 0), b3, voffB); PG8_STAGE(PG8_SB(1, 1), b3 + hstepB, voffB); PG8_STAGE(PG8_SA(1, 0), a3, voffA);
            PG8_WAIT_V(8); PG8_WAIT_L(0); PG8_BAR; PG8_MMA(1, 0, At, B0); PG8_MMA(1, 1, At, B1); PG8_BAR; PG8_SCHED;
            } else {
            PG8_LDB(B0, 0, 0); PG8_SCHED; PG8_LDA(At, 0, 0); PG8_STAGE(PG8_SA(1, 1), a1 + hstepA, voffA);
            PG8_WAIT_L(8); PG8_BAR; PG8_WAIT_L(0); PG8_MMA(0, 0, At, B0); PG8_BAR; PG8_SCHED;
            PG8_LDB(B1, 0, 1); PG8_STAGE(PG8_SB(0, 0), b2, voffB);
            PG8_BAR; PG8_WAIT_L(0); PG8_MMA(0, 1, At, B1); PG8_BAR;
            PG8_LDA(At, 0, 1); PG8_STAGE(PG8_SA(0, 0), a2, voffA);
            PG8_BAR; PG8_WAIT_L(0); PG8_MMA(1, 0, At, B0); PG8_BAR; PG8_SCHED;
            PG8_STAGE(PG8_SB(0, 1), b2 + hstepB, voffB);
            PG8_WAIT_V(6); PG8_BAR; PG8_MMA(1, 1, At, B1); PG8_BAR;
            PG8_LDB(B0, 1, 0); PG8_SCHED; PG8_LDA(At, 1, 0); PG8_STAGE(PG8_SA(0, 1), a2 + hstepA, voffA);
            PG8_WAIT_L(8); PG8_BAR; PG8_WAIT_L(0); PG8_MMA(0, 0, At, B0); PG8_BAR; PG8_SCHED;
            PG8_LDB(B1, 1, 1); PG8_STAGE(PG8_SB(1, 0), b3, voffB);
            PG8_BAR; PG8_WAIT_L(0); PG8_MMA(0, 1, At, B1); PG8_BAR;
            PG8_LDA(At, 1, 1); PG8_STAGE(PG8_SA(1, 0), a3, voffA);
            PG8_BAR; PG8_WAIT_L(0); PG8_MMA(1, 0, At, B0); PG8_BAR; PG8_SCHED;
            PG8_STAGE(PG8_SB(1, 1), b3 + hstepB, voffB);
            PG8_WAIT_V(6); PG8_BAR; PG8_MMA(1, 1, At, B1); PG8_BAR;
            }
        }
        if constexpr (ALIGN_EPI) { if (wr == 0) PG8_BAR; }
        if constexpr (F8) asm volatile("s_nop 15\n\ts_nop 15" ::: "memory");
        if constexpr (!Epi::AFTER_DRAIN) { E(acc, cur, wr, wc, fr, fq); S.done(cur); }
        if (!has_next) break;
#pragma unroll
        for (int a = 0; a < 2; ++a)
#pragma unroll
            for (int b = 0; b < 2; ++b)
#pragma unroll
                for (int m = 0; m < 4; ++m)
#pragma unroll
                    for (int n = 0; n < 2; ++n) acc[a][b][m][n] = (f32x4){0.f, 0.f, 0.f, 0.f};
        cur = nxt; cA = nA; cB = nB; ++ui;
        if constexpr (ALIGN_EPI) { if (wr == 1) PG8_BAR; }
    }
    PG8_WAIT_V(0);
    if constexpr (!ALIGN_EPI) { if (wr == 0) PG8_BAR; }
    PG8_BAR;
    if constexpr (Epi::AFTER_DRAIN) { E.fused(acc, cur, wr, wc, fr, fq, lds, wid, lane); S.done(cur); }
#undef PG8_SA
#undef PG8_SB
#undef PG8_STAGE
#undef PG8_LDA
#undef PG8_LDB
#undef PG8_MMA
#undef PG8_CAT
#undef PG8_LD32
#undef PG8_WAIT_V
#undef PG8_WAIT_L
#undef PG8_BAR
#undef PG8_SCHED
}
}

#define LAS __attribute__((address_space(3)))
typedef unsigned short bf16;
typedef short bf16x8 __attribute__((ext_vector_type(8)));
typedef short s16x4 __attribute__((ext_vector_type(4)));
typedef float f32x4 __attribute__((ext_vector_type(4)));
typedef float f32x16 __attribute__((ext_vector_type(16)));
typedef unsigned u32x4 __attribute__((ext_vector_type(4)));
typedef unsigned u32x2 __attribute__((ext_vector_type(2)));

constexpr int NB = 32, SEQ = 2048, DM = 1024, M = NB * SEQ, NPROJ = 3072, FF = 4096;
constexpr int PC_Q = 0, PC_R = 512, PC_K = 1024, PC_V = 1536, PC_QI = 2048, PC_CL = 2560, PC_KI = 2688, PC_XW = 2752, PC_XA = 2816, PC_XG = 2880, PC_WI = 3008;
constexpr size_t MiB = 1u << 20;
constexpr size_t WS_MOD = 0, WS_WUKT = 1 * MiB, WS_WUK = WS_WUKT + 131072, WS_WUVT = WS_WUK + 131072, WS_INVR = 2 * MiB, WS_WIN = 4 * MiB, WS_WOUT = 10 * MiB,
                 WS_W1 = 12 * MiB, WS_W2 = 20 * MiB, WS_CKV = 36 * MiB, WS_GAM = 52 * MiB, WS_C3 = 60 * MiB, WS_REGA = 64 * MiB, WS_PROJ = 192 * MiB, WS_CH = 576 * MiB,
                 WS_G = 960 * MiB, WS_U = 192 * MiB, WS_END = 1024 * MiB,
                 WS_BAR = 62 * MiB, WS_W2T = WS_WUVT + 131072, WS_A2T = WS_W2T + 65536, WS_G2T = WS_A2T + 65536;
constexpr int LDS_BAR_OFF = 158720;
constexpr int LDS_BYTES = 158976;
constexpr int NWAVES = 8;

struct Params {
    const float *x, *c, *w_ada, *b_ada, *g_mix, *g_ffn, *w_in, *g_q, *g_k, *g_kv, *w_uk, *w_uv, *mu, *w0, *w2, *a0, *a2, *g2, *k_k, *k_a, *r_k, *ln_w, *ln_b, *w_out, *w_ff1, *w_ff2;
    float* out; unsigned char* ws; int ph_lo, ph_hi;
};

__device__ __forceinline__ unsigned pk2(float lo, float hi) { return pg8::cvt_pk_bf16(lo, hi); }
__device__ __forceinline__ float bflo(unsigned w) { return __uint_as_float(w << 16); }
__device__ __forceinline__ float bfhi(unsigned w) { return __uint_as_float(w & 0xffff0000u); }
__device__ __forceinline__ float bf2f(bf16 h) { return __uint_as_float((unsigned)h << 16); }
__device__ __forceinline__ bf16 f2bf(float f) { return (bf16)(pk2(f, 0.f) & 0xffffu); }
__device__ __forceinline__ float wave_sum(float v) {
#pragma unroll
    for (int o = 1; o < 64; o <<= 1) v += __shfl_xor(v, o);
    return v;
}
__device__ __forceinline__ f32x16 mfma32(bf16x8 a, bf16x8 b, f32x16 c) { return __builtin_amdgcn_mfma_f32_32x32x16_bf16(a, b, c, 0, 0, 0); }
__device__ __forceinline__ f32x4 mfma16(bf16x8 a, bf16x8 b, f32x4 c) { return __builtin_amdgcn_mfma_f32_16x16x32_bf16(a, b, c, 0, 0, 0); }

__device__ __forceinline__ int win_src_col(int n) {
    if (n < 512) return n;
    if (n < 1024) return 1224 + (n - 512);
    if (n < 1536) return 1736 + (n - 1024);
    if (n < 2048) return 2248 + (n - 1536);
    if (n < 2560) return 640 + (n - 2048);
    if (n < 2688) return 512 + (n - 2560);
    if (n < 2752) return 1152 + (n - 2688);
    if (n < 2816) return 2760 + (n - 2752);
    if (n < 2880) return 2824 + (n - 2816);
    if (n < 3008) return 2888 + (n - 2880);
    if (n < 3016) return 1216 + (n - 3008);
    return -1;
}
__device__ __forceinline__ void conv_t_item(const float* W, int K, int Nsrc, bf16* WT, int nblk, int item, float* scr, int lane, bool is_win) {
    const int kb = item / nblk, nb = item % nblk, k0 = 64 * kb, n0 = 32 * nb;
    int ns = n0 + (lane & 31); if (is_win) ns = win_src_col(ns);
    float tv[32];
#pragma unroll
    for (int i = 0; i < 32; ++i) { const int kk = 2 * i + (lane >> 5); tv[i] = ns >= 0 ? W[(size_t)(k0 + kk) * Nsrc + ns] : 0.f; }
#pragma unroll
    for (int i = 0; i < 32; ++i) { const int kk = 2 * i + (lane >> 5); scr[kk * 33 + (lane & 31)] = tv[i]; }
    asm volatile("s_waitcnt lgkmcnt(0)" ::: "memory");
    const int c = lane & 7;
#pragma unroll
    for (int j = 0; j < 4; ++j) { const int n = (lane >> 3) + 8 * j; const float* s = scr + (8 * c) * 33 + n;
        u32x4 o; o.x = pk2(s[0 * 33], s[1 * 33]); o.y = pk2(s[2 * 33], s[3 * 33]); o.z = pk2(s[4 * 33], s[5 * 33]); o.w = pk2(s[6 * 33], s[7 * 33]);
        *(u32x4*)(WT + (size_t)(n0 + n) * K + k0 + 8 * c) = o; }
    asm volatile("s_waitcnt lgkmcnt(0)" ::: "memory");
}
__device__ __forceinline__ void conv_t_item_f8(const float* W, int K, int N, unsigned char* WT, int nblk, int item, float* scr, int lane, float scale, bool is_win = false) {
    const int kb = item / nblk, nb = item % nblk, k0 = 64 * kb, n0 = 32 * nb;
    int ns = n0 + (lane & 31); if (is_win) ns = win_src_col(ns);
    float tv[32];
#pragma unroll
    for (int i = 0; i < 32; ++i) { const int kk = 2 * i + (lane >> 5); tv[i] = ns >= 0 ? W[(size_t)(k0 + kk) * N + ns] * scale : 0.f; }
#pragma unroll
    for (int i = 0; i < 32; ++i) { const int kk = 2 * i + (lane >> 5); scr[kk * 33 + (lane & 31)] = tv[i]; }
    asm volatile("s_waitcnt lgkmcnt(0)" ::: "memory");
    const int c = lane & 7;
#pragma unroll
    for (int j = 0; j < 4; ++j) { const int n = (lane >> 3) + 8 * j; const float* s = scr + (8 * c) * 33 + n;
        u32x2 o; o.x = pg8::pk4_fp8(s[0 * 33], s[1 * 33], s[2 * 33], s[3 * 33]); o.y = pg8::pk4_fp8(s[4 * 33], s[5 * 33], s[6 * 33], s[7 * 33]);
        *(u32x2*)(WT + (size_t)(n0 + n) * K + k0 + 8 * c) = o; }
    asm volatile("s_waitcnt lgkmcnt(0)" ::: "memory");
}
__device__ __forceinline__ void adaln_block(const Params& p, float* ldsf, int cb, int tid) {
    const int lane = tid & 63, wv = tid >> 6, e = cb * 64 + lane;
    float* SC = ldsf; float* RED = ldsf + 16384; float* mod = (float*)(p.ws + WS_MOD);
    float wreg[128];
#pragma unroll
    for (int d = 0; d < 128; ++d) wreg[d] = p.w_ada[(size_t)(wv * 128 + d) * 6144 + e];
    for (int half = 0; half < 2; ++half) {
        const int b0 = half * 16;
        for (int i = tid; i < 16384; i += 512) { const float cv = p.c[b0 * 1024 + i]; SC[i] = cv / (1.f + __expf(-cv)); }
        __syncthreads();
        float acc[16];
#pragma unroll
        for (int bb = 0; bb < 16; ++bb) acc[bb] = 0.f;
#pragma unroll
        for (int dd = 0; dd < 128; dd += 4) { const int d = wv * 128 + dd;
            const float w0 = wreg[dd], w1 = wreg[dd + 1], w2 = wreg[dd + 2], w3 = wreg[dd + 3];
#pragma unroll
            for (int bb = 0; bb < 16; ++bb) { const f32x4 s = *(const f32x4*)(SC + bb * 1024 + d); acc[bb] += (s.x * w0 + s.y * w1) + (s.z * w2 + s.w * w3); }
        }
#pragma unroll
        for (int bb = 0; bb < 16; ++bb) RED[(wv * 16 + bb) * 64 + lane] = acc[bb];
        __syncthreads();
#pragma unroll
        for (int q = 0; q < 2; ++q) { const int bb = wv * 2 + q; float s = p.b_ada[e];
#pragma unroll
            for (int ww = 0; ww < 8; ++ww) s += RED[(ww * 16 + bb) * 64 + lane];
            mod[(size_t)(b0 + bb) * 6144 + e] = s; }
        __syncthreads();
    }
}
__device__ __forceinline__ void phase_pro(const Params& p, unsigned char* lds, int tid, int G) {
    const int lane = tid & 63, wv = tid >> 6;
    for (int cb = blockIdx.x; cb < 96; cb += G) adaln_block(p, (float*)lds, cb, tid);
    __syncthreads();
    float* scr = (float*)lds + wv * (64 * 33 + 16);
    const int gw = blockIdx.x * NWAVES + wv, NGW = G * NWAVES;
    bf16* WIN = (bf16*)(p.ws + WS_WIN); bf16* WOUT = (bf16*)(p.ws + WS_WOUT); bf16* W1 = (bf16*)(p.ws + WS_W1); bf16* W2 = (bf16*)(p.ws + WS_W2);
    bf16* WUKT = (bf16*)(p.ws + WS_WUKT); bf16* WUK = (bf16*)(p.ws + WS_WUK); bf16* WUVT = (bf16*)(p.ws + WS_WUVT);
    constexpr int I_IN = (DM / 64) * (NPROJ / 32), I_OUT = (DM / 64) * (DM / 32), I_1 = (DM / 64) * (FF / 32), I_2 = (FF / 64) * (DM / 32), I_UK = (128 / 64) * (512 / 32);
    constexpr int I_LR = 512 / 32;
    constexpr int NITEMS = I_IN + I_OUT + I_1 + I_2 + 2 * I_UK + 4 * I_LR;
    for (int it = gw; it < NITEMS; it += NGW) {
        int r = it;
        if (r < I_IN) { if (MK_F8_GEMM1) conv_t_item_f8(p.w_in, DM, 3016, (unsigned char*)WIN, NPROJ / 32, r, scr, lane, 32.f, true); else conv_t_item(p.w_in, DM, 3016, WIN, NPROJ / 32, r, scr, lane, true); continue; } r -= I_IN;
        if (r < I_OUT) { conv_t_item(p.w_out, DM, DM, WOUT, DM / 32, r, scr, lane, false); continue; } r -= I_OUT;
        if (r < I_1) { conv_t_item(p.w_ff1, DM, FF, W1, FF / 32, r, scr, lane, false); continue; } r -= I_1;
        if (r < I_2) { conv_t_item_f8(p.w_ff2, FF, DM, (unsigned char*)W2, DM / 32, r, scr, lane, 64.f); continue; } r -= I_2;
        if (r < I_UK) { conv_t_item(p.w_uk, 128, 512, WUKT, 512 / 32, r, scr, lane, false); continue; } r -= I_UK;
        if (r < I_UK) { conv_t_item(p.w_uv, 128, 512, WUVT, 512 / 32, r, scr, lane, false); continue; } r -= I_UK;
        if (r < I_LR) { conv_t_item(p.w2, 64, 512, (bf16*)(p.ws + WS_W2T), 512 / 32, r, scr, lane, false); continue; } r -= I_LR;
        if (r < I_LR) { conv_t_item(p.a2, 64, 512, (bf16*)(p.ws + WS_A2T), 512 / 32, r, scr, lane, false); continue; } r -= I_LR;
        conv_t_item(p.g2, 128, 512, (bf16*)(p.ws + WS_G2T), 512 / 32, r, scr, lane, false);
    }
    for (int i = blockIdx.x * 512 + tid; i < 128 * 512 / 2; i += G * 512) { const float a = p.w_uk[2 * i], b = p.w_uk[2 * i + 1]; ((unsigned*)WUK)[i] = pk2(a, b); }
}

template <bool F8OUT> __device__ __forceinline__ void hn_rows(const float* src, const float* g, const float* mod, int off_sh, int off_sc, bf16* dst, int gw, int NGW, int lane) {
    const int RPW = M / NGW;
    for (int m0 = gw * RPW; m0 < M; m0 += NGW * RPW) {
        const float* mb = mod + (size_t)(m0 >> 11) * 6144;
        f32x4 ga[4], sh[4];
#pragma unroll
        for (int j = 0; j < 4; ++j) { const int col = 4 * lane + 256 * j; const f32x4 gg = *(const f32x4*)(g + col), sc = *(const f32x4*)(mb + off_sc + col); ga[j] = gg * (1.f + sc); sh[j] = *(const f32x4*)(mb + off_sh + col); }
        for (int r0 = 0; r0 < RPW; r0 += 4) {
            f32x4 v[4][4]; float s[4];
#pragma unroll
            for (int r = 0; r < 4; ++r) { const f32x4* xr = (const f32x4*)(src + (size_t)(m0 + r0 + r) * DM) + lane;
#pragma unroll
                for (int j = 0; j < 4; ++j) v[r][j] = xr[64 * j]; }
#pragma unroll
            for (int r = 0; r < 4; ++r) { s[r] = 0.f;
#pragma unroll
                for (int j = 0; j < 4; ++j) s[r] += (v[r][j].x * v[r][j].x + v[r][j].y * v[r][j].y) + (v[r][j].z * v[r][j].z + v[r][j].w * v[r][j].w); }
#pragma unroll
            for (int o = 1; o < 64; o <<= 1) {
#pragma unroll
                for (int r = 0; r < 4; ++r) s[r] += __shfl_xor(s[r], o); }
#pragma unroll
            for (int r = 0; r < 4; ++r) { const int m = m0 + r0 + r; const float rstd = rsqrtf(s[r] * (1.f / DM) + 1e-6f);
                unsigned long long* o8 = (unsigned long long*)(dst + (size_t)m * DM) + lane;
#pragma unroll
                for (int j = 0; j < 4; ++j) { const f32x4 y = v[r][j] * rstd * ga[j] + sh[j];
                    if (F8OUT) ((unsigned*)((unsigned char*)dst + (size_t)m * DM))[lane + 64 * j] = pg8::pk4_fp8(y.x, y.y, y.z, y.w);
                    else o8[64 * j] = (unsigned long long)pk2(y.x, y.y) | ((unsigned long long)pk2(y.z, y.w) << 32); } }
        }
    }
}

typedef short s16x4 __attribute__((ext_vector_type(4)));
__device__ __forceinline__ f32x4 mfma16k(s16x4 a, s16x4 b, f32x4 c) { return __builtin_amdgcn_mfma_f32_16x16x16bf16_1k(a, b, c, 0, 0, 0); }
__device__ __forceinline__ s16x4 pack4(f32x4 v) { u32x2 o; o.x = pk2(v[0], v[1]); o.y = pk2(v[2], v[3]); return __builtin_bit_cast(s16x4, o); }

__device__ __forceinline__ float dpp_row_sum16(float x) {
    x += __builtin_bit_cast(float, __builtin_amdgcn_mov_dpp(__builtin_bit_cast(int, x), 0xB1, 0xF, 0xF, true));
    x += __builtin_bit_cast(float, __builtin_amdgcn_mov_dpp(__builtin_bit_cast(int, x), 0x4E, 0xF, 0xF, true));
    x += __builtin_bit_cast(float, __builtin_amdgcn_mov_dpp(__builtin_bit_cast(int, x), 0x141, 0xF, 0xF, true));
    x += __builtin_bit_cast(float, __builtin_amdgcn_mov_dpp(__builtin_bit_cast(int, x), 0x140, 0xF, 0xF, true));
    return x;
}
__device__ __forceinline__ void rwkv_prep_item(const Params& p, unsigned char* lds, int it, int tid_in) {
    int tid = tid_in; asm volatile("" : "+v"(tid));
    const int lane = tid & 63, wv = __builtin_amdgcn_readfirstlane(tid >> 6);
    bf16* XS = (bf16*)lds;
    bf16* STG = (bf16*)(lds + 32768) + wv * 4096;
    float* MAB = (float*)(lds + 98304) + wv * 256;
    bf16* RKV = (bf16*)(lds + 106496) + wv * 3264;
    const bf16* PROJ = (const bf16*)(p.ws + WS_PROJ);
    const bf16* W2T = (const bf16*)(p.ws + WS_W2T); const bf16* A2T = (const bf16*)(p.ws + WS_A2T); const bf16* G2T = (const bf16*)(p.ws + WS_G2T);
    float* GAM = (float*)(p.ws + WS_GAM); float* C3 = (float*)(p.ws + WS_C3); bf16* GB = (bf16*)(p.ws + WS_G);
    const int row0 = it * 64, t0 = (it & 31) * 64, b = it >> 5;
    __syncthreads();
    {   const int xt = tid >> 5, xch = tid & 31;
        const f32x4 m0_ = *(const f32x4*)(p.mu + 1536 + 8 * xch), m1_ = *(const f32x4*)(p.mu + 1536 + 8 * xch + 4); const float sc_ = xch < 8 ? 2.f : -1.f;
        u32x4 xc[4], xp[4];
#pragma unroll
        for (int qq = 0; qq < 4; ++qq) { const int t = xt + 16 * qq; const bf16* src_ = PROJ + (size_t)(row0 + t) * NPROJ + PC_XW + 8 * xch; xc[qq] = *(const u32x4*)src_;
            xp[qq] = (u32x4){0u, 0u, 0u, 0u}; if (t0 + t != 0) xp[qq] = *(const u32x4*)(src_ - NPROJ); }
#pragma unroll
        for (int qq = 0; qq < 4; ++qq) { float o_[8];
#pragma unroll
            for (int i = 0; i < 4; ++i) { const float c0_ = bflo(xc[qq][i]), c1_ = bfhi(xc[qq][i]), p0_ = bflo(xp[qq][i]), p1_ = bfhi(xp[qq][i]);
                const float ma_ = i < 2 ? m0_[2 * i] : m1_[2 * i - 4], mb_ = i < 2 ? m0_[2 * i + 1] : m1_[2 * i - 3];
                const float v0_ = c0_ + ma_ * (p0_ - c0_), v1_ = c1_ + mb_ * (p1_ - c1_);
                const float r0_ = 1.f / (1.f + __expf(sc_ * v0_)), r1_ = 1.f / (1.f + __expf(sc_ * v1_));
                o_[2 * i] = xch < 8 ? 1.f - 2.f * r0_ : (xch < 16 ? v0_ : r0_); o_[2 * i + 1] = xch < 8 ? 1.f - 2.f * r1_ : (xch < 16 ? v1_ : r1_); }
            *(u32x4*)(XS + (xt + 16 * qq) * 256 + 8 * xch) = (u32x4){pk2(o_[0], o_[1]), pk2(o_[2], o_[3]), pk2(o_[4], o_[5]), pk2(o_[6], o_[7])}; }
    }
    u32x4 RK[7];
#define RKV_LOAD(rowb, tb) do { _Pragma("unroll") for (int i = 0; i < 7; ++i) { const int id_ = i * 64 + lane, mat_ = id_ / 136, rem_ = id_ - 136 * mat_, rw_ = rem_ >> 3, ch_ = rem_ & 7; \
        RK[i] = (u32x4){0u, 0u, 0u, 0u}; if (id_ < 408 && (tb) - 1 + rw_ >= 0) RK[i] = *(const u32x4*)(PROJ + (size_t)((rowb) - 1 + rw_) * NPROJ + PC_R + 512 * mat_ + wv * 64 + 8 * ch_); } } while (0)
#define RKV_WRITE() do { _Pragma("unroll") for (int i = 0; i < 7; ++i) { const int id_ = i * 64 + lane, mat_ = id_ / 136, rem_ = id_ - 136 * mat_, rw_ = rem_ >> 3, ch_ = rem_ & 7; \
        if (id_ < 408) *(u32x4*)(RKV + mat_ * 1088 + rw_ * 64 + 8 * ch_) = RK[i]; } } while (0)
    RKV_LOAD(row0, t0);
    __syncthreads();
#pragma unroll 1
    for (int q = 0; q < 4; ++q) {
        const int rowq = row0 + 16 * q, tq = t0 + 16 * q;
        int lane_ = lane; asm volatile("" : "+v"(lane_));
        const int n_ = lane_ & 15, grp_ = lane_ >> 4;
        const size_t idx = (size_t)(b * 8 + wv) * 128 + (tq >> 4);
        unsigned char* CHp = p.ws + WS_CH + idx * 12288;
        RKV_WRITE();
        if (q < 3) RKV_LOAD(rowq + 16, tq + 16);
        f32x4 dw[4], da[4];
        {   bf16x8 xa[8];
#pragma unroll
            for (int ks = 0; ks < 8; ++ks) xa[ks] = *(const bf16x8*)(XS + (16 * q + n_) * 256 + 32 * ks + 8 * grp_);
#pragma unroll
            for (int ct = 0; ct < 4; ++ct) { const int cc = wv * 64 + 16 * ct + n_;
                f32x4 dg = {0.f, 0.f, 0.f, 0.f}; dw[ct] = dg; da[ct] = dg;
#pragma unroll
                for (int ks = 0; ks < 2; ++ks) dw[ct] = mfma16(xa[ks], *(const bf16x8*)(W2T + cc * 64 + 32 * ks + 8 * grp_), dw[ct]);
#pragma unroll
                for (int ks = 0; ks < 2; ++ks) da[ct] = mfma16(xa[2 + ks], *(const bf16x8*)(A2T + cc * 64 + 32 * ks + 8 * grp_), da[ct]);
#pragma unroll
                for (int ks = 0; ks < 4; ++ks) dg = mfma16(xa[4 + ks], *(const bf16x8*)(G2T + cc * 128 + 32 * ks + 8 * grp_), dg);
#pragma unroll
                for (int rg = 0; rg < 4; ++rg) GB[(size_t)(rowq + 4 * grp_ + rg) * 512 + cc] = f2bf(dg[rg]); }
        }
        asm volatile("s_waitcnt lgkmcnt(0)" ::: "memory");
        {   float kkvA[4][4], kkaA[4][4], kprA[4][4], rA[4][4], vA[4][4], wA[4][4], nrm[4], c3s[4];
#pragma unroll
            for (int rg = 0; rg < 4; ++rg) { nrm[rg] = 0.f; c3s[rg] = 0.f; }
#pragma unroll
            for (int ct = 0; ct < 4; ++ct) { const int j = 16 * ct + n_, c = wv * 64 + j;
                const float mu_r = p.mu[c], mu_k = p.mu[512 + c], mu_v = p.mu[1024 + c], w0c = p.w0[c], a0c = p.a0[c], kkc = p.k_k[c], kac = p.k_a[c], rkc = p.r_k[c];
#pragma unroll
                for (int rg = 0; rg < 4; ++rg) { const int t = 4 * grp_ + rg;
                    const float rp = bf2f(RKV[t * 64 + j]), rc = bf2f(RKV[(t + 1) * 64 + j]);
                    const float kp = bf2f(RKV[1088 + t * 64 + j]), kc = bf2f(RKV[1088 + (t + 1) * 64 + j]);
                    const float vp = bf2f(RKV[2176 + t * 64 + j]), vc = bf2f(RKV[2176 + (t + 1) * 64 + j]);
                    const float r = rc + mu_r * (rp - rc), k = kc + mu_k * (kp - kc); vA[ct][rg] = vc + mu_v * (vp - vc); rA[ct][rg] = r;
                    const float u = w0c + dw[ct][rg]; const float wlog = -__logf(1.f + __expf(-u)) - 0.5f; wA[ct][rg] = __expf(-__expf(wlog));
                    const float a = 1.f / (1.f + __expf(-(a0c + da[ct][rg])));
                    const float kkv = k * kkc, kpr = k * (1.f + (a - 1.f) * kac); kkvA[ct][rg] = kkv; kkaA[ct][rg] = kkv * a; kprA[ct][rg] = kpr;
                    nrm[rg] += kkv * kkv; c3s[rg] += r * kpr * rkc; } }
            float inrm[4];
#pragma unroll
            for (int rg = 0; rg < 4; ++rg) { nrm[rg] = dpp_row_sum16(nrm[rg]); c3s[rg] = dpp_row_sum16(c3s[rg]); inrm[rg] = 1.f / fmaxf(sqrtf(nrm[rg]), 1e-12f); }
            if (n_ == 0) {
#pragma unroll
                for (int rg = 0; rg < 4; ++rg) C3[(size_t)(rowq + 4 * grp_ + rg) * 8 + wv] = c3s[rg]; }
#pragma unroll
            for (int ct = 0; ct < 4; ++ct) { const int j = 16 * ct + n_;
                float lp[4]; lp[0] = wA[ct][0]; lp[1] = lp[0] * wA[ct][1]; lp[2] = lp[1] * wA[ct][2]; lp[3] = lp[2] * wA[ct][3];
                const float P0 = __shfl(lp[3], n_), P1 = __shfl(lp[3], n_ + 16), P2 = __shfl(lp[3], n_ + 32);
                const float E = grp_ == 0 ? 1.f : (grp_ == 1 ? P0 : (grp_ == 2 ? P0 * P1 : P0 * P1 * P2));
                float bt[4], kt[4];
#pragma unroll
                for (int rg = 0; rg < 4; ++rg) { const int t = 4 * grp_ + rg;
                    const float gam = E * lp[rg], gprev = rg == 0 ? E : E * lp[rg - 1], ig = 1.f / gam;
                    STG[t * 64 + j] = f2bf(-kkvA[ct][rg] * inrm[rg] * gprev); STG[1024 + t * 64 + j] = f2bf(rA[ct][rg] * gam);
                    bt[rg] = kkaA[ct][rg] * inrm[rg] * ig; kt[rg] = kprA[ct][rg] * ig;
                    STG[2048 + t * 64 + j] = f2bf(bt[rg]); STG[3072 + t * 64 + j] = f2bf(kt[rg]); }
                *(u32x2*)(CHp + 4096 + j * 32 + grp_ * 8) = (u32x2){pk2(bt[0], bt[1]), pk2(bt[2], bt[3])};
                *(u32x2*)(CHp + 6144 + j * 32 + grp_ * 8) = (u32x2){pk2(kt[0], kt[1]), pk2(kt[2], kt[3])};
                *(u32x2*)(CHp + 8192 + j * 32 + grp_ * 8) = (u32x2){pk2(vA[ct][0], vA[ct][1]), pk2(vA[ct][2], vA[ct][3])};
                if (grp_ == 3) GAM[idx * 64 + j] = E * lp[3]; }
        }
        asm volatile("s_waitcnt lgkmcnt(0)" ::: "memory");
        {   f32x4 mab = {0.f, 0.f, 0.f, 0.f}, mak = mab, nrb = mab, nrk = mab;
#pragma unroll
            for (int ks = 0; ks < 4; ++ks) { const int o = n_ * 64 + 16 * ks + 4 * grp_;
                const s16x4 fa = *(const s16x4*)(STG + o), fr = *(const s16x4*)(STG + 1024 + o), fb = *(const s16x4*)(STG + 2048 + o), fk = *(const s16x4*)(STG + 3072 + o);
                mab = mfma16k(fa, fb, mab); mak = mfma16k(fa, fk, mak); nrb = mfma16k(fr, fb, nrb); nrk = mfma16k(fr, fk, nrk); }
            asm volatile("s_waitcnt lgkmcnt(0)" ::: "memory");
            bf16* SM = STG + 2048;
#pragma unroll
            for (int rg = 0; rg < 4; ++rg) { const int t = 4 * grp_ + rg; const bool sl = t > n_, il = t >= n_;
                MAB[t * 16 + n_] = sl ? mab[rg] : 0.f;
                SM[256 + t * 16 + n_] = f2bf(sl ? mak[rg] : 0.f); SM[512 + t * 16 + n_] = f2bf(il ? nrb[rg] : 0.f); SM[768 + t * 16 + n_] = f2bf(il ? nrk[rg] : 0.f); }
            asm volatile("s_waitcnt lgkmcnt(0)" ::: "memory");
            if (lane_ < 16) {
                float Tc[16];
#pragma unroll
                for (int t = 0; t < 16; ++t) { float acc = (t == lane_) ? 1.f : 0.f;
#pragma unroll
                    for (int s2 = 0; s2 < t; ++s2) acc = fmaf(MAB[t * 16 + s2], Tc[s2], acc);
                    Tc[t] = acc; SM[t * 16 + lane_] = f2bf(acc); }
            }
            asm volatile("s_waitcnt lgkmcnt(0)" ::: "memory");
#pragma unroll
            for (int i = 0; i < 4; ++i) { const int id = i * 64 + lane_; *(u32x4*)(CHp + id * 16) = *(const u32x4*)((const unsigned char*)STG + id * 16); }
#pragma unroll
            for (int i = 0; i < 2; ++i) { const int id = i * 64 + lane_; *(u32x4*)(CHp + 10240 + id * 16) = *(const u32x4*)((const unsigned char*)SM + id * 16); }
        }
    }
#undef RKV_LOAD
#undef RKV_WRITE
}

__device__ __forceinline__ void stage_w_lds(const bf16* W, unsigned char* lds, int log2_cpr  , int tid) {
    const int cpr = 1 << log2_cpr;
#pragma unroll 4
    for (int i = 0; i < 16; ++i) { const int id = i * 512 + tid, row = id >> log2_cpr, ch = id & (cpr - 1);
        *(u32x4*)(lds + ((size_t)row << (log2_cpr + 4)) + (((ch & ~15) | ((ch ^ row) & 15)) << 4)) = *(const u32x4*)((const unsigned char*)W + (size_t)id * 16); }
}
__device__ __forceinline__ bf16x8 lds_wfrag(const unsigned char* lds, int row, int ch, int log2_cpr) {
    return *(const bf16x8*)(lds + ((size_t)row << (log2_cpr + 4)) + (((ch & ~15) | ((ch ^ row) & 15)) << 4));
}
__device__ __forceinline__ void dsa_prep_kv(const Params& p, const unsigned char* wl, int tile, int lane) {
    const bf16* PROJ = (const bf16*)(p.ws + WS_PROJ); bf16* CKV = (bf16*)(p.ws + WS_CKV); float* INVR = (float*)(p.ws + WS_INVR);
    const int r = lane & 31, hh = lane >> 5; const size_t row = (size_t)tile * 32 + r; const bf16* prow = PROJ + row * NPROJ;
    bf16x8 cf[8];
    {   u32x4 craw[8]; float ssq = 0.f;
#pragma unroll
        for (int s = 0; s < 8; ++s) { craw[s] = *(const u32x4*)(prow + PC_CL + 16 * s + 8 * hh);
#pragma unroll
            for (int w = 0; w < 4; ++w) { const float lo = bflo(craw[s][w]), hi = bfhi(craw[s][w]); ssq += lo * lo + hi * hi; } }
        ssq += __shfl_xor(ssq, 32);
        const float rstd = rsqrtf(ssq * (1.f / 128.f) + 1e-6f);
#pragma unroll
        for (int s = 0; s < 8; ++s) { const float* g = p.g_kv + 16 * s + 8 * hh; const f32x4 g0 = *(const f32x4*)g, g1 = *(const f32x4*)(g + 4);
            u32x4 o; o.x = pk2(bflo(craw[s].x) * rstd * g0.x, bfhi(craw[s].x) * rstd * g0.y); o.y = pk2(bflo(craw[s].y) * rstd * g0.z, bfhi(craw[s].y) * rstd * g0.w);
            o.z = pk2(bflo(craw[s].z) * rstd * g1.x, bfhi(craw[s].z) * rstd * g1.y); o.w = pk2(bflo(craw[s].w) * rstd * g1.z, bfhi(craw[s].w) * rstd * g1.w);
            cf[s] = __builtin_bit_cast(bf16x8, o); *(u32x4*)(CKV + row * 128 + 16 * s + 8 * hh) = o; }
    }
    unsigned wb[8];
#pragma unroll
    for (int s = 0; s < 8; ++s) wb[s] = (unsigned)(r * 256 + ((((2 * s + hh) ^ r) & 15) << 4));
#pragma unroll 1
    for (int h = 0; h < 8; ++h) { float ss = 0.f;
#pragma unroll
        for (int dt = 0; dt < 2; ++dt) { f32x16 acc = {}; const unsigned char* wg = wl + (h * 64 + dt * 32) * 256;
#pragma unroll
            for (int s = 0; s < 8; ++s) acc = mfma32(*(const bf16x8*)(wg + wb[s]), cf[s], acc);
#pragma unroll
            for (int i = 0; i < 16; ++i) ss += acc[i] * acc[i]; }
        ss += __shfl_xor(ss, 32);
        if (hh == 0) INVR[row * 8 + h] = rsqrtf(ss * (1.f / 64.f) + 1e-6f);
    }
}
__device__ __forceinline__ void dsa_prep_q(const Params& p, const unsigned char* wl, int tile, int lane) {
    const bf16* PROJ = (const bf16*)(p.ws + WS_PROJ); bf16* QABS = (bf16*)(p.ws + WS_REGA);
    const int r = lane & 31, hh = lane >> 5; const size_t row = (size_t)tile * 32 + r; const bf16* prow = PROJ + row * NPROJ;
    unsigned wb[2][4];
#pragma unroll
    for (int hp = 0; hp < 2; ++hp)
#pragma unroll
        for (int s = 0; s < 4; ++s) wb[hp][s] = (unsigned)(r * 1024 + ((((hp * 8 + 2 * s + hh) ^ r) & 15) << 4));
#pragma unroll 2
    for (int h = 0; h < 8; ++h) {
        u32x4 qraw[4]; float ssq = 0.f;
#pragma unroll
        for (int s = 0; s < 4; ++s) { qraw[s] = *(const u32x4*)(prow + PC_Q + h * 64 + 16 * s + 8 * hh);
#pragma unroll
            for (int w = 0; w < 4; ++w) { const float lo = bflo(qraw[s][w]), hi = bfhi(qraw[s][w]); ssq += lo * lo + hi * hi; } }
        ssq += __shfl_xor(ssq, 32);
        const float rstd = rsqrtf(ssq * (1.f / 64.f) + 1e-6f);
        bf16x8 qf[4];
#pragma unroll
        for (int s = 0; s < 4; ++s) { const int d0 = 16 * s + 8 * hh; float gg[8];
#pragma unroll
            for (int j = 0; j < 8; ++j) gg[j] = p.g_q[d0 + j] * p.g_k[d0 + j] * rstd;
            u32x4 o; o.x = pk2(bflo(qraw[s].x) * gg[0], bfhi(qraw[s].x) * gg[1]); o.y = pk2(bflo(qraw[s].y) * gg[2], bfhi(qraw[s].y) * gg[3]);
            o.z = pk2(bflo(qraw[s].z) * gg[4], bfhi(qraw[s].z) * gg[5]); o.w = pk2(bflo(qraw[s].w) * gg[6], bfhi(qraw[s].w) * gg[7]);
            qf[s] = __builtin_bit_cast(bf16x8, o); }
#pragma unroll
        for (int lt = 0; lt < 4; ++lt) { f32x16 acc = {}; const unsigned char* wg = wl + lt * 32768 + (h >> 1) * 256;
#pragma unroll
            for (int s = 0; s < 4; ++s) acc = mfma32(*(const bf16x8*)(wg + wb[h & 1][s]), qf[s], acc);
#pragma unroll
            for (int g4 = 0; g4 < 4; ++g4) { u32x2 o; o.x = pk2(acc[4 * g4] * 0.125f, acc[4 * g4 + 1] * 0.125f); o.y = pk2(acc[4 * g4 + 2] * 0.125f, acc[4 * g4 + 3] * 0.125f);
                *(u32x2*)(QABS + row * 1024 + h * 128 + lt * 32 + 8 * g4 + 4 * hh) = o; } }
    }
}

constexpr int SCAN_D = 8, SCAN_SLOT = 12288 + 256;
#define SCAN_BAR() do { asm volatile("s_waitcnt lgkmcnt(0)" ::: "memory"); __builtin_amdgcn_s_barrier(); asm volatile("" ::: "memory"); } while (0)
__device__ __forceinline__ void rwkv_scan_chain(const Params& p, unsigned char* lds, int chain, int wv, int lane) {
    const int b = chain >> 3, h = chain & 7;
    const size_t idx0 = (size_t)(b * 8 + h) * 128;
    if (wv >= 4) {
        const int li = (wv - 4) * 64 + lane;
        const unsigned char* src = p.ws + WS_CH + idx0 * 12288 + (size_t)li * 16; const float* gsrc = (const float*)(p.ws + WS_GAM) + idx0 * 64 + (li & 15) * 4;
        u32x4 R[SCAN_D][3]; f32x4 Rg[SCAN_D];
#pragma unroll
        for (int j = 0; j < SCAN_D; ++j) {
#pragma unroll
            for (int i = 0; i < 3; ++i) R[j][i] = *(const u32x4*)(src + (size_t)j * 12288 + i * 4096);
            Rg[j] = *(const f32x4*)(gsrc + (size_t)j * 64); }
        for (int k0 = 0; k0 < 128; k0 += SCAN_D) {
#pragma unroll
            for (int j = 0; j < SCAN_D; ++j) { const int k = k0 + j; unsigned char* slot = lds + (k & 1) * SCAN_SLOT;
#pragma unroll
                for (int i = 0; i < 3; ++i) *(u32x4*)(slot + li * 16 + i * 4096) = R[j][i];
                *(f32x4*)(slot + 12288 + (li & 15) * 16) = Rg[j];
                if (k + SCAN_D < 128) {
#pragma unroll
                    for (int i = 0; i < 3; ++i) R[j][i] = *(const u32x4*)(src + (size_t)(k + SCAN_D) * 12288 + i * 4096);
                    Rg[j] = *(const f32x4*)(gsrc + (size_t)(k + SCAN_D) * 64); }
                SCAN_BAR(); } }
    } else {
        const int w = wv, n = lane & 15, grp = lane >> 4;
        bf16* PROJ = (bf16*)(p.ws + WS_PROJ);
        f32x4 S[4];
#pragma unroll
        for (int jt = 0; jt < 4; ++jt) S[jt] = (f32x4){0.f, 0.f, 0.f, 0.f};
        for (int sc = 0; sc < 128; ++sc) {
            SCAN_BAR();
            const unsigned char* CHp = lds + (sc & 1) * SCAN_SLOT;
            s16x4 at[4], rt[4], bt[4], kt[4]; f32x4 gm[4];
#pragma unroll
            for (int jt = 0; jt < 4; ++jt) {
                at[jt] = *(const s16x4*)(CHp + n * 128 + (16 * jt + 4 * grp) * 2); rt[jt] = *(const s16x4*)(CHp + 2048 + n * 128 + (16 * jt + 4 * grp) * 2);
                bt[jt] = *(const s16x4*)(CHp + 4096 + (16 * jt + n) * 32 + grp * 8); kt[jt] = *(const s16x4*)(CHp + 6144 + (16 * jt + n) * 32 + grp * 8);
                gm[jt] = *(const f32x4*)(CHp + 12288 + (16 * jt + 4 * grp) * 4); }
            const s16x4 vt = *(const s16x4*)(CHp + 8192 + (16 * w + n) * 32 + grp * 8);
            const s16x4 Tm = *(const s16x4*)(CHp + 10240 + n * 32 + grp * 8), Mak = *(const s16x4*)(CHp + 10752 + n * 32 + grp * 8);
            const s16x4 Nrb = *(const s16x4*)(CHp + 11264 + n * 32 + grp * 8), Nrk = *(const s16x4*)(CHp + 11776 + n * 32 + grp * 8);
            s16x4 Sb[4];
#pragma unroll
            for (int jt = 0; jt < 4; ++jt) Sb[jt] = pack4(S[jt]);
            f32x4 X = {0.f, 0.f, 0.f, 0.f}, O = X;
#pragma unroll
            for (int jt = 0; jt < 4; ++jt) X = mfma16k(at[jt], Sb[jt], X);
            X = mfma16k(Mak, vt, X);
#pragma unroll
            for (int jt = 0; jt < 4; ++jt) O = mfma16k(rt[jt], Sb[jt], O);
            O = mfma16k(Nrk, vt, O);
            const f32x4 U = mfma16k(Tm, pack4(X), (f32x4){0.f, 0.f, 0.f, 0.f});
            const s16x4 Ub = pack4(U);
            O = mfma16k(Nrb, Ub, O);
#pragma unroll
            for (int jt = 0; jt < 4; ++jt) { S[jt] = mfma16k(kt[jt], vt, S[jt]); S[jt] = mfma16k(bt[jt], Ub, S[jt]); S[jt] = S[jt] * gm[jt]; }
            bf16* orow = PROJ + ((size_t)b * SEQ + sc * 16 + 4 * grp) * NPROJ + PC_R + h * 64 + 16 * w + n;
#pragma unroll
            for (int rg = 0; rg < 4; ++rg) orow[(size_t)rg * NPROJ] = f2bf(O[rg]);
        }
    }
}
__device__ __forceinline__ void rwkv_epi_rows(const Params& p, int gw, int NGW, int lane) {
    bf16* PROJ = (bf16*)(p.ws + WS_PROJ); const bf16* GB = (const bf16*)(p.ws + WS_G); const float* C3 = (const float*)(p.ws + WS_C3);
    const int c0 = lane * 8, h = lane >> 3, RPW = M / NGW;
    float muv[8], lw[8], lb[8];
#pragma unroll
    for (int i = 0; i < 8; ++i) { muv[i] = p.mu[1024 + c0 + i]; lw[i] = p.ln_w[c0 + i]; lb[i] = p.ln_b[c0 + i]; }
    for (int m0 = gw * RPW; m0 < M; m0 += NGW * RPW) {
        u32x4 vprev = {0u, 0u, 0u, 0u}; if ((m0 & (SEQ - 1)) != 0) vprev = *(const u32x4*)(PROJ + (size_t)(m0 - 1) * NPROJ + PC_V + c0);
        for (int r0 = 0; r0 < RPW; r0 += 4) {
            u32x4 oraw[4], vc[4], gr[4]; float c3[4];
#pragma unroll
            for (int r = 0; r < 4; ++r) { const size_t m = (size_t)(m0 + r0 + r); const bf16* prow = PROJ + m * NPROJ;
                oraw[r] = *(const u32x4*)(prow + PC_R + c0); vc[r] = *(const u32x4*)(prow + PC_V + c0); gr[r] = *(const u32x4*)(GB + m * 512 + c0); c3[r] = C3[m * 8 + h]; }
            float o[4][8], sm[4], q[4];
#pragma unroll
            for (int r = 0; r < 4; ++r) { sm[r] = 0.f;
#pragma unroll
                for (int i = 0; i < 4; ++i) { o[r][2 * i] = bflo(oraw[r][i]); o[r][2 * i + 1] = bfhi(oraw[r][i]); sm[r] += o[r][2 * i] + o[r][2 * i + 1]; } }
#pragma unroll
            for (int of = 1; of < 8; of <<= 1) {
#pragma unroll
                for (int r = 0; r < 4; ++r) sm[r] += __shfl_xor(sm[r], of); }
#pragma unroll
            for (int r = 0; r < 4; ++r) { const float mean = sm[r] * (1.f / 64.f); q[r] = 0.f;
#pragma unroll
                for (int i = 0; i < 8; ++i) { o[r][i] -= mean; q[r] += o[r][i] * o[r][i]; } }
#pragma unroll
            for (int of = 1; of < 8; of <<= 1) {
#pragma unroll
                for (int r = 0; r < 4; ++r) q[r] += __shfl_xor(q[r], of); }
#pragma unroll
            for (int r = 0; r < 4; ++r) { const float rstd = rsqrtf(q[r] * (1.f / 64.f) + 64e-5f); const u32x4 vp = r == 0 ? vprev : vc[r - 1];
                const bool first = ((m0 + r0 + r) & (SEQ - 1)) == 0;
                u32x4 out;
#pragma unroll
                for (int i = 0; i < 4; ++i) { float y[2];
#pragma unroll
                    for (int e = 0; e < 2; ++e) { const int ii = 2 * i + e; const float cv = e ? bfhi(vc[r][i]) : bflo(vc[r][i]), pv = first ? 0.f : (e ? bfhi(vp[i]) : bflo(vp[i]));
                        const float v = cv + muv[ii] * (pv - cv), g = e ? bfhi(gr[r][i]) : bflo(gr[r][i]);
                        y[e] = (o[r][ii] * rstd * lw[ii] + lb[ii] + c3[r] * v) * g; }
                    out[i] = pk2(y[0], y[1]); }
                *(u32x4*)(PROJ + (size_t)(m0 + r0 + r) * NPROJ + PC_R + c0) = out; }
            vprev = vc[3];
        }
    }
}

__device__ __forceinline__ unsigned f2key(float f) { unsigned b = __float_as_uint(f); if ((b << 1) == 0u) b = 0u; return (b & 0x80000000u) ? ~b : (b | 0x80000000u); }
__device__ __forceinline__ unsigned offb(unsigned row, unsigned ch) { return 2048u * (row >> 3) + 512u * (ch >> 2) + 64u * (row & 7) + 16u * ((ch & 3) ^ ((row >> 2) & 3)); }

__device__ __forceinline__ void topk_select(float* sc, int N, unsigned* hist, unsigned short* sel, int lane) {
    unsigned* kb = (unsigned*)sc;
    unsigned prefix = 0u, mask = 0u; int rem = 256, mbin = 0;
    const unsigned long long lt_mask = (1ull << lane) - 1ull;
    for (int pass = 0; pass < 4; ++pass) {
        const int shift = 24 - 8 * pass;
#pragma unroll
        for (int i = 0; i < 4; ++i) hist[lane * 4 + i] = 0u;
        asm volatile("s_waitcnt lgkmcnt(0)" ::: "memory");
        for (int base = 0; base < N; base += 256) { const int idx = base + 4 * lane;
            if (idx < N) { u32x4 k4;
                if (pass == 0) { const f32x4 v = *(const f32x4*)(sc + idx); k4 = (u32x4){f2key(v.x), f2key(v.y), f2key(v.z), f2key(v.w)}; *(u32x4*)(kb + idx) = k4; }
                else k4 = *(const u32x4*)(kb + idx);
#pragma unroll
                for (int e = 0; e < 4; ++e) if ((k4[e] & mask) == prefix) atomicAdd(&hist[(k4[e] >> shift) & 255u], 1u); } }
        asm volatile("s_waitcnt lgkmcnt(0)" ::: "memory");
        const unsigned c0 = hist[lane * 4], c1 = hist[lane * 4 + 1], c2 = hist[lane * 4 + 2], c3 = hist[lane * 4 + 3];
        const int cnt4 = (int)(c0 + c1 + c2 + c3);
        int incl = cnt4;
#pragma unroll
        for (int o = 1; o < 64; o <<= 1) { const int v = __shfl_down(incl, o); if (lane + o < 64) incl += v; }
        const int excl = incl - cnt4;
        const bool mine = (excl < rem) && (rem <= incl);
        const unsigned long long bal = __ballot(mine);
        const int L = (int)__builtin_ctzll(bal);
        const int ex = __shfl(excl, L); const int b3 = (int)__shfl((int)c3, L), b2 = (int)__shfl((int)c2, L), b1 = (int)__shfl((int)c1, L), b0 = (int)__shfl((int)c0, L);
        int above = ex, bin;
        if (above + b3 >= rem) { bin = 3; mbin = b3; } else { above += b3; if (above + b2 >= rem) { bin = 2; mbin = b2; } else { above += b2; if (above + b1 >= rem) { bin = 1; mbin = b1; } else { above += b1; bin = 0; mbin = b0; } } }
        rem -= above; prefix |= (unsigned)(L * 4 + bin) << shift; mask |= 0xffu << shift;
        if (pass == 1 && mbin <= 64) break;
    }
    const unsigned T = prefix; const int ngt = 256 - rem; int base_gt = 0, base_eq = 0;
    const bool partial = (mask != 0xffffffffu);
    unsigned short* cand = (unsigned short*)hist;
    for (int base = 0; base < N; base += 256) { const int idx = base + 4 * lane; const bool act = idx < N;
        u32x4 k4 = {0u, 0u, 0u, 0u}; if (act) k4 = *(const u32x4*)(kb + idx);
        bool gt[4], eq[4]; unsigned long long bg[4], be[4];
#pragma unroll
        for (int e = 0; e < 4; ++e) { const unsigned km = k4[e] & mask; gt[e] = act && km > T; eq[e] = act && km == T; bg[e] = __ballot(gt[e]); be[e] = __ballot(eq[e]); }
        int rg = base_gt, re = base_eq;
#pragma unroll
        for (int e = 0; e < 4; ++e) re += __popcll(be[e] & lt_mask);
#pragma unroll
        for (int e = 0; e < 4; ++e) {
            if (gt[e]) sel[rg + __popcll(bg[e] & lt_mask)] = (unsigned short)(idx + e);
            rg += __popcll(bg[e]);
            if (eq[e]) { if (partial) cand[re] = (unsigned short)(idx + e); else if (re < rem) sel[ngt + re] = (unsigned short)(idx + e); re += 1; } }
        base_gt = rg;
#pragma unroll
        for (int e = 0; e < 4; ++e) base_eq += __popcll(be[e]); }
    asm volatile("s_waitcnt lgkmcnt(0)" ::: "memory");
    if (partial) {
        const int m = mbin; const int ci = (lane < m) ? (int)cand[lane] : 0; const unsigned ck = (lane < m) ? kb[ci] : 0u;
        int rank = 0;
        for (int j = 0; j < m; ++j) { const unsigned kj = (unsigned)__shfl((int)ck, j); rank += (kj > ck || (kj == ck && j < lane)) ? 1 : 0; }
        if (lane < m && rank < rem) sel[ngt + rank] = (unsigned short)ci;
        asm volatile("s_waitcnt lgkmcnt(0)" ::: "memory");
    }
}

__device__ __forceinline__ float dpp_row_max16(float x) {
    x = fmaxf(x, __builtin_bit_cast(float, __builtin_amdgcn_mov_dpp(__builtin_bit_cast(int, x), 0xB1, 0xF, 0xF, true)));
    x = fmaxf(x, __builtin_bit_cast(float, __builtin_amdgcn_mov_dpp(__builtin_bit_cast(int, x), 0x4E, 0xF, 0xF, true)));
    x = fmaxf(x, __builtin_bit_cast(float, __builtin_amdgcn_mov_dpp(__builtin_bit_cast(int, x), 0x141, 0xF, 0xF, true)));
    x = fmaxf(x, __builtin_bit_cast(float, __builtin_amdgcn_mov_dpp(__builtin_bit_cast(int, x), 0x140, 0xF, 0xF, true)));
    return x;
}
__device__ __forceinline__ bool topk_select_fast(const float* sc, int N, float smax, unsigned* hist, unsigned short* sel, int lane) {
    const float scale = smax > 0.f ? 127.5f / smax : 0.f;
#define QBIN(x_) min(max((int)fmaf((x_), scale, 128.f), 0), 255)
#pragma unroll
    for (int i = 0; i < 4; ++i) hist[lane * 4 + i] = 0u;
    asm volatile("s_waitcnt lgkmcnt(0)" ::: "memory");
    for (int base = 0; base < N; base += 256) { const int idx = base + 4 * lane;
        if (idx < N) { const f32x4 v = *(const f32x4*)(sc + idx);
#pragma unroll
            for (int e = 0; e < 4; ++e) atomicAdd(&hist[QBIN(v[e])], 1u); } }
    asm volatile("s_waitcnt lgkmcnt(0)" ::: "memory");
    const unsigned c0 = hist[lane * 4], c1 = hist[lane * 4 + 1], c2 = hist[lane * 4 + 2], c3 = hist[lane * 4 + 3];
    const int cnt4 = (int)(c0 + c1 + c2 + c3);
    int incl = cnt4;
#pragma unroll
    for (int o = 1; o < 64; o <<= 1) { const int v = __shfl_down(incl, o); if (lane + o < 64) incl += v; }
    const int excl = incl - cnt4;
    const bool mine = (excl < 256) && (256 <= incl);
    const int L = (int)__builtin_ctzll(__ballot(mine));
    const int ex = __shfl(excl, L); const int b3 = (int)__shfl((int)c3, L), b2 = (int)__shfl((int)c2, L), b1 = (int)__shfl((int)c1, L), b0 = (int)__shfl((int)c0, L);
    int above = ex, bin, mbin;
    if (above + b3 >= 256) { bin = 3; mbin = b3; } else { above += b3; if (above + b2 >= 256) { bin = 2; mbin = b2; } else { above += b2; if (above + b1 >= 256) { bin = 1; mbin = b1; } else { above += b1; bin = 0; mbin = b0; } } }
    if (mbin > 64) return false;
    const int tb = L * 4 + bin, rem = 256 - above, ngt = above; int base_gt = 0, base_eq = 0;
    const unsigned long long lt_mask = (1ull << lane) - 1ull;
    unsigned short* cand = (unsigned short*)hist;
    for (int base = 0; base < N; base += 256) { const int idx = base + 4 * lane; const bool act = idx < N;
        f32x4 v = {0.f, 0.f, 0.f, 0.f}; if (act) v = *(const f32x4*)(sc + idx);
        bool gt[4], eq[4]; unsigned long long bg[4], be[4];
#pragma unroll
        for (int e = 0; e < 4; ++e) { const int qb = QBIN(v[e]); gt[e] = act && qb > tb; eq[e] = act && qb == tb; bg[e] = __ballot(gt[e]); be[e] = __ballot(eq[e]); }
        int rg = base_gt, re = base_eq;
#pragma unroll
        for (int e = 0; e < 4; ++e) re += __popcll(be[e] & lt_mask);
#pragma unroll
        for (int e = 0; e < 4; ++e) {
            if (gt[e]) sel[rg + __popcll(bg[e] & lt_mask)] = (unsigned short)(idx + e);
            rg += __popcll(bg[e]);
            if (eq[e]) { cand[re] = (unsigned short)(idx + e); re += 1; } }
        base_gt = rg;
#pragma unroll
        for (int e = 0; e < 4; ++e) base_eq += __popcll(be[e]); }
    asm volatile("s_waitcnt lgkmcnt(0)" ::: "memory");
    {   const int m = mbin; const int ci = (lane < m) ? (int)cand[lane] : 0; const unsigned ck = (lane < m) ? f2key(sc[ci]) : 0u;
        int rank = 0;
        for (int j = 0; j < m; ++j) { const unsigned kj = (unsigned)__shfl((int)ck, j); rank += (kj > ck || (kj == ck && j < lane)) ? 1 : 0; }
        if (lane < m && rank < rem) sel[ngt + rank] = (unsigned short)ci;
        asm volatile("s_waitcnt lgkmcnt(0)" ::: "memory"); }
#undef QBIN
    return true;
}

__device__ __forceinline__ void dsa_attend(const Params& p, int b, int t, const unsigned short* sel, int cnt, unsigned char* stage, int lane_in) {
    int lane = lane_in; asm volatile("" : "+v"(lane));
    const bf16* CKV = (const bf16*)(p.ws + WS_CKV) + (size_t)b * SEQ * 128; const float* INVR = (const float*)(p.ws + WS_INVR) + (size_t)b * SEQ * 8;
    bf16* QO = (bf16*)(p.ws + WS_REGA) + ((size_t)b * SEQ + t) * 1024;
    const int hd = lane & 15, grp = lane >> 4;
    bf16x8 bq[4];
#pragma unroll
    for (int s = 0; s < 4; ++s) { u32x4 z = {0u, 0u, 0u, 0u}; if (hd < 8) z = *(const u32x4*)(QO + hd * 128 + 32 * s + 8 * grp); bq[s] = __builtin_bit_cast(bf16x8, z); }
    const float slope = (hd < 8) ? exp2f(-(float)(hd + 1)) : 0.f;
    const int hsafe = hd & 7;
    float m_run = -INFINITY, l_part = 0.f;
    f32x4 O[8];
#pragma unroll
    for (int c = 0; c < 8; ++c) O[c] = (f32x4){0.f, 0.f, 0.f, 0.f};
    const LAS unsigned char* st3 = (const LAS unsigned char*)stage;
    const unsigned q4 = (lane & 15) >> 2, p4 = lane & 3;
    u32x4 G[8]; float IRn[8], PNn[8];
#define DA_ISSUE(ks_) do { \
    _Pragma("unroll") for (int i = 0; i < 8; ++i) { const int id = i * 64 + lane, row = id >> 4, ch = id & 15; const unsigned key = sel[(ks_) + row]; G[i] = *(const u32x4*)((const unsigned char*)CKV + (key * 256u + (unsigned)ch * 16u)); } } while (0)
#define DA_ISSUE2(ks_) do { \
    _Pragma("unroll") for (int i = 0; i < 8; ++i) { const int key = sel[(ks_) + 16 * (i >> 2) + 4 * grp + (i & 3)]; IRn[i] = *(const float*)((const unsigned char*)INVR + ((unsigned)key * 32u + (unsigned)hsafe * 4u)); PNn[i] = slope * fabsf((float)(t - key)); } } while (0)
    DA_ISSUE(cnt - 32); DA_ISSUE2(cnt - 32);
    for (int ks = cnt - 32; ks >= 0; ks -= 32) {
#pragma unroll
        for (int i = 0; i < 8; ++i) { const int id = i * 64 + lane, row = id >> 4, ch = id & 15; *(u32x4*)(stage + offb(row, ch)) = G[i]; }
        asm volatile("s_waitcnt lgkmcnt(0)" ::: "memory");
        if (ks >= 32) DA_ISSUE(ks - 32);
        float lg[8];
#pragma unroll
        for (int T = 0; T < 2; ++T) { f32x4 acc = {0.f, 0.f, 0.f, 0.f};
#pragma unroll
            for (int s = 0; s < 4; ++s) { const bf16x8 a = *(const bf16x8*)(stage + offb((lane & 15) + 16 * T, 4 * s + grp)); acc = mfma16(a, bq[s], acc); }
#pragma unroll
            for (int rg = 0; rg < 4; ++rg) lg[4 * T + rg] = acc[rg] * IRn[4 * T + rg] - PNn[4 * T + rg]; }
        if (ks >= 32) DA_ISSUE2(ks - 32);
        float mx = lg[0];
#pragma unroll
        for (int i = 1; i < 8; ++i) mx = fmaxf(mx, lg[i]);
        mx = fmaxf(mx, __shfl_xor(mx, 16)); mx = fmaxf(mx, __shfl_xor(mx, 32));
        const float m_new = fmaxf(m_run, mx);
        const float alpha = __expf(m_run - m_new);
        float ps = 0.f;
#pragma unroll
        for (int i = 0; i < 8; ++i) { lg[i] = __expf(lg[i] - m_new); ps += lg[i]; }
        l_part = l_part * alpha + ps; m_run = m_new;
        { float ar[4];
#pragma unroll
            for (int rg = 0; rg < 4; ++rg) ar[rg] = __shfl(alpha, 4 * grp + rg);
#pragma unroll
            for (int c = 0; c < 8; ++c)
#pragma unroll
                for (int rg = 0; rg < 4; ++rg) O[c][rg] *= ar[rg]; }
        {   u32x4 pw; pw.x = pk2(lg[0], lg[1]); pw.y = pk2(lg[2], lg[3]); pw.z = pk2(lg[4], lg[5]); pw.w = pk2(lg[6], lg[7]);
            const bf16x8 pa = __builtin_bit_cast(bf16x8, pw);
#pragma unroll
            for (int c = 0; c < 8; ++c) {
                const s16x4 lo = __builtin_bit_cast(s16x4, __builtin_amdgcn_ds_read_tr16_b64_v4i16((LAS s16x4*)(st3 + offb(4 * grp + q4, 2 * c + (p4 >> 1)) + 8 * (p4 & 1))));
                const s16x4 hi = __builtin_bit_cast(s16x4, __builtin_amdgcn_ds_read_tr16_b64_v4i16((LAS s16x4*)(st3 + offb(16 + 4 * grp + q4, 2 * c + (p4 >> 1)) + 8 * (p4 & 1))));
                const bf16x8 vb = {lo[0], lo[1], lo[2], lo[3], hi[0], hi[1], hi[2], hi[3]};
                O[c] = mfma16(pa, vb, O[c]); } }
        asm volatile("s_waitcnt lgkmcnt(0)" ::: "memory");
    }
#undef DA_ISSUE
#undef DA_ISSUE2
    float l = l_part; l += __shfl_xor(l, 16); l += __shfl_xor(l, 32);
    const float il = 1.f / l;
    float irr[4];
#pragma unroll
    for (int rg = 0; rg < 4; ++rg) irr[rg] = __shfl(il, 4 * grp + rg);
    if (grp < 2) {
#pragma unroll
        for (int rg = 0; rg < 4; ++rg)
#pragma unroll
            for (int c = 0; c < 8; ++c) QO[(4 * grp + rg) * 128 + 16 * c + hd] = f2bf(O[c][rg] * irr[rg]);
    }
}

#define DSA_LOAD_AF(af_, wqv_, b_, tq0_) do { const size_t rq_ = (size_t)(b_) * SEQ + (tq0_); const int r_ = lane & 31, g_ = lane >> 5, ql_ = 2 * ((r_ >> 2) & 1) + (r_ >> 4), hdm_ = 4 * ((r_ >> 3) & 1) + (r_ & 3); \
    _Pragma("unroll") for (int qg = 0; qg < 4; ++qg) _Pragma("unroll") for (int s = 0; s < 4; ++s) af_[qg][s] = *(const bf16x8*)(PROJ + (rq_ + 4 * qg + ql_) * NPROJ + PC_QI + hdm_ * 64 + 16 * s + 8 * g_); \
    wqv_ = (tid < 128) ? bf2f(PROJ[(rq_ + (tid >> 3)) * NPROJ + PC_WI + (tid & 7)]) * 0.044194173824159216f : 0.f; } while (0)
__device__ __forceinline__ void dsa_select_item(const Params& p, unsigned char* lds, int b, int tq0, int tid, bf16x8 (&af)[4][4], float& wqv, bool has_next, int nb, int ntq0) {
    bf16* PROJ = (bf16*)(p.ws + WS_PROJ);
    float* SC = (float*)lds;
    unsigned* HIST = (unsigned*)(lds + 131072);
    unsigned short* SEL = (unsigned short*)(lds + 131072 + 8192);
    float* WQ = (float*)(lds + 147456);
    unsigned* QMAX = (unsigned*)(lds + 147456 + 512);
    asm volatile("" : "+v"(tid));
    const int lane = tid & 63, wv = __builtin_amdgcn_readfirstlane(tid >> 6);
    const int N = ((tq0 >> 6) + 1) * 64; const size_t rowq0 = (size_t)b * SEQ + tq0;
    {
        const int r = lane & 31, g = lane >> 5;
        if (tid < 128) WQ[tid] = wqv;
        if (tid < 16) QMAX[tid] = 0u;
        float mxq[4][2];
#pragma unroll
        for (int qg = 0; qg < 4; ++qg) { mxq[qg][0] = 0.f; mxq[qg][1] = 0.f; }
        __syncthreads();
        bf16x8 bfr[4];
        { const bf16* krow = PROJ + ((size_t)b * SEQ + wv * 32 + r) * NPROJ + PC_KI + 8 * g;
#pragma unroll
          for (int s = 0; s < 4; ++s) bfr[s] = *(const bf16x8*)(krow + 16 * s); }
        for (int kt = wv; kt < N / 32; kt += NWAVES) {
            const int key = kt * 32 + r;
            bf16x8 bnx[4];
#pragma unroll
            for (int s = 0; s < 4; ++s) bnx[s] = bfr[s];
            if (kt + NWAVES < N / 32) { const bf16* krow = PROJ + ((size_t)b * SEQ + key + 32 * NWAVES) * NPROJ + PC_KI + 8 * g;
#pragma unroll
                for (int s = 0; s < 4; ++s) bnx[s] = *(const bf16x8*)(krow + 16 * s); }
#pragma unroll
            for (int qg = 0; qg < 4; ++qg) { f32x16 acc = {};
#pragma unroll
                for (int s = 0; s < 4; ++s) acc = mfma32(af[qg][s], bfr[s], acc);
#pragma unroll
                for (int qq = 0; qq < 2; ++qq) { float sc = 0.f; const f32x4 w0 = *(const f32x4*)(WQ + (4 * qg + 2 * g + qq) * 8), w1 = *(const f32x4*)(WQ + (4 * qg + 2 * g + qq) * 8 + 4);
#pragma unroll
                    for (int e = 0; e < 4; ++e) { sc = fmaf(w0[e], fmaxf(acc[8 * qq + e], 0.f), sc); sc = fmaf(w1[e], fmaxf(acc[8 * qq + 4 + e], 0.f), sc); }
                    SC[(4 * qg + 2 * g + qq) * 2048 + key] = sc; mxq[qg][qq] = fmaxf(mxq[qg][qq], fabsf(sc)); } }
#pragma unroll
            for (int s = 0; s < 4; ++s) bfr[s] = bnx[s];
        }
#pragma unroll
        for (int qg = 0; qg < 4; ++qg)
#pragma unroll
            for (int qq = 0; qq < 2; ++qq) { float m = dpp_row_max16(mxq[qg][qq]); m = fmaxf(m, __shfl_xor(m, 16));
                if (r == 0) atomicMax(&QMAX[4 * qg + 2 * g + qq], __float_as_uint(m)); }
        __syncthreads();
        if (has_next) DSA_LOAD_AF(af, wqv, nb, ntq0);
        bool fb[2];
        for (int q = 0; q < 2; ++q) fb[q] = !topk_select_fast(SC + (2 * wv + q) * 2048, N, __uint_as_float(QMAX[2 * wv + q]), HIST + wv * 256, SEL + (2 * wv + q) * 256, lane);
        for (int q = 0; q < 2; ++q) if (fb[q]) topk_select(SC + (2 * wv + q) * 2048, N, HIST + wv * 256, SEL + (2 * wv + q) * 256, lane);
    }
    asm volatile("s_waitcnt lgkmcnt(0)" ::: "memory");
    { const int q = lane >> 5; const u32x4 v = *(const u32x4*)(SEL + (2 * wv + q) * 256 + (lane & 31) * 8);
      *(u32x4*)(PROJ + (rowq0 + 2 * wv + q) * NPROJ + PC_Q + (lane & 31) * 8) = v; }
    __syncthreads();
}

__device__ __forceinline__ void dsa_attend_row(const Params& p, unsigned char* wlds, int row, int lane) {
    const bf16* PROJ = (const bf16*)(p.ws + WS_PROJ);
    const int b = row >> 11, t = row & (SEQ - 1), N = ((t >> 6) + 1) * 64, cnt = N > 256 ? 256 : N;
    unsigned short* SELW = (unsigned short*)(wlds + 8192);
    if (N > 256) { if (lane < 32) *(u32x4*)(SELW + lane * 8) = *(const u32x4*)(PROJ + (size_t)row * NPROJ + PC_Q + lane * 8); }
    else { for (int i = lane; i < cnt; i += 64) SELW[i] = (unsigned short)i; }
    asm volatile("s_waitcnt vmcnt(0) lgkmcnt(0)" ::: "memory");
    dsa_attend(p, b, t, SELW, cnt, wlds, lane);
    asm volatile("s_waitcnt lgkmcnt(0)" ::: "memory");
}

__device__ __forceinline__ void uv_item(const Params& p, const unsigned char* wl  , int tile, int lane) {
    bf16* PROJ = (bf16*)(p.ws + WS_PROJ); const bf16* OLAT = (const bf16*)(p.ws + WS_REGA);
    const int r = lane & 31, hh = lane >> 5; const size_t row = (size_t)tile * 32 + r;
    unsigned wb[8];
#pragma unroll
    for (int s = 0; s < 8; ++s) wb[s] = (unsigned)(r * 256 + ((((2 * s + hh) ^ r) & 15) << 4));
#pragma unroll 1
    for (int h = 0; h < 8; ++h) { bf16x8 of[8];
#pragma unroll
        for (int s = 0; s < 8; ++s) of[s] = *(const bf16x8*)(OLAT + row * 1024 + h * 128 + 16 * s + 8 * hh);
#pragma unroll
        for (int dt = 0; dt < 2; ++dt) { f32x16 acc = {}; const unsigned char* wg = wl + (h * 64 + dt * 32) * 256;
#pragma unroll
            for (int s = 0; s < 8; ++s) acc = mfma32(*(const bf16x8*)(wg + wb[s]), of[s], acc);
#pragma unroll
            for (int g4 = 0; g4 < 4; ++g4) { u32x2 o; o.x = pk2(acc[4 * g4], acc[4 * g4 + 1]); o.y = pk2(acc[4 * g4 + 2], acc[4 * g4 + 3]);
                *(u32x2*)(PROJ + row * NPROJ + PC_Q + h * 64 + dt * 32 + 8 * g4 + 4 * hh) = o; } }
    }
}

typedef __attribute__((address_space(1))) unsigned gu32;
#define RLX_AGENT __ATOMIC_RELAXED, __HIP_MEMORY_SCOPE_AGENT
#define XB_TMO      128
#define XB_XCNT(j)  (256  + 64 * (j))
#define XB_XSUB(j)  (1280 + 64 * (j))
#define XB_XGEN(j)  (2304 + 64 * (j))
#define XB_TOP      3328
#define XB_TOPGEN   3392
#define XCD_BAR_WORDS 3456
#define XB_SPIN_CAP (1u << 18)

__device__ __forceinline__ unsigned xb_ld(unsigned* p)              { return __hip_atomic_load(p, __ATOMIC_RELAXED, __HIP_MEMORY_SCOPE_AGENT); }
__device__ __forceinline__ unsigned xb_add(unsigned* p, unsigned v) { return __hip_atomic_fetch_add(p, v, __ATOMIC_RELAXED, __HIP_MEMORY_SCOPE_AGENT); }
__device__ __forceinline__ unsigned xb_xcc_id() { return (unsigned)__builtin_amdgcn_s_getreg((3 << 11) | 20) & 0xFu; }
#define XB_SPIN(cond, bar) do { unsigned _sp = 0; while (cond) { __builtin_amdgcn_s_sleep(1); \
    if ((++_sp & 255u) == 0u) { if (xb_ld(&(bar)[XB_TMO])) break; if (_sp > XB_SPIN_CAP) { atomicAdd(&(bar)[XB_TMO], 1u); break; } } } } while (0)

struct XcdBarrier {
    unsigned* bar; unsigned x;
    volatile LAS unsigned* st;
};

__device__ __forceinline__ XcdBarrier xcd_barrier_post(unsigned* bar, volatile LAS unsigned* st) {
    XcdBarrier b; b.bar = bar; b.x = xb_xcc_id(); b.st = st;
    if (threadIdx.x == 0) (void)xb_add(&bar[XB_XCNT(b.x)], 1u);
    return b;
}
__device__ __forceinline__ void xcd_barrier_complete(unsigned* bar, unsigned x, unsigned& nloc, unsigned& nx) {
    const unsigned G = gridDim.x * gridDim.y * gridDim.z;
    unsigned sum, cnt, mine, sp = 0u;
    for (;;) {
        sum = 0u; cnt = 0u; mine = 0u;
#pragma unroll
        for (unsigned j = 0; j < 16; ++j) { const unsigned c = xb_ld(&bar[XB_XCNT(j)]); sum += c; cnt += (c > 0u) ? 1u : 0u; mine = (j == x) ? c : mine; }
        if (sum == G) break;
        __builtin_amdgcn_s_sleep(1);
        if ((++sp & 255u) == 0u) { if (xb_ld(&bar[XB_TMO])) break; if (sp > XB_SPIN_CAP) { atomicAdd(&bar[XB_TMO], 1u); break; } }
    }
    nloc = mine > 0u ? mine : 1u; nx = cnt > 0u ? cnt : 1u;
}

__device__ __forceinline__ void xcd_barrier(const XcdBarrier& b) {
    asm volatile("s_waitcnt vmcnt(0)" ::: "memory");
    __syncthreads();
    if (threadIdx.x == 0) {
        unsigned* bar = b.bar;
        __builtin_amdgcn_s_waitcnt(0);
        unsigned nloc = b.st[0], nx = b.st[1];
        if (nloc == 0u) { xcd_barrier_complete(bar, b.x, nloc, nx); b.st[0] = nloc; b.st[1] = nx; }
        const unsigned old = xb_add(&bar[XB_XSUB(b.x)], 1u);
        const unsigned gen = old / nloc;
        if (old + 1u == (gen + 1u) * nloc) {
            __builtin_amdgcn_fence(__ATOMIC_RELEASE, "agent");
            asm volatile("s_waitcnt vmcnt(0)" ::: "memory");
            const unsigned og = xb_add(&bar[XB_TOP], 1u);
            const unsigned tg = og / nx;
            if (og + 1u == (tg + 1u) * nx) xb_add(&bar[XB_TOPGEN], 1u);
            else XB_SPIN(xb_ld(&bar[XB_TOPGEN]) == tg, bar);
            __builtin_amdgcn_fence(__ATOMIC_ACQUIRE, "agent");
            xb_add(&bar[XB_XGEN(b.x)], 1u);
            asm volatile("s_waitcnt vmcnt(0)" ::: "memory");
        } else {
            XB_SPIN(xb_ld(&bar[XB_XGEN(b.x)]) == gen, bar);
            __builtin_amdgcn_fence(__ATOMIC_ACQUIRE, "agent");
            asm volatile("s_waitcnt vmcnt(0)" ::: "memory");
        }
    }
    __syncthreads();
}

enum { PH_PRO = 0, PH_HN, PH_GEMM1, PH_PREP, PH_MIX, PH_ATT, PH_UV, PH_GOUT, PH_HN2, PH_UP, PH_DOWN, PH_COUNT };
#ifndef MK_SKIP_MIXER
#define MK_SKIP_MIXER 0
#endif
__global__ void __launch_bounds__(NWAVES * 64, 2) mk_fwd(Params p) {
    extern __shared__ __attribute__((aligned(16))) unsigned char lds[];
    cg::grid_group grid = cg::this_grid();
    const int tid = threadIdx.x, lane = tid & 63, wv = __builtin_amdgcn_readfirstlane(tid >> 6);
    const int G = gridDim.x, gw = blockIdx.x * NWAVES + wv, NGW = G * NWAVES;
    const int lo = p.ph_lo, hi = p.ph_hi;
    if (tid < 2) ((volatile LAS unsigned*)((LAS unsigned char*)lds + LDS_BAR_OFF))[tid] = 0u;
    __syncthreads();
    XcdBarrier xbar = xcd_barrier_post((unsigned*)(p.ws + WS_BAR), (volatile LAS unsigned*)((LAS unsigned char*)lds + LDS_BAR_OFF));
    float* MOD = (float*)(p.ws + WS_MOD); bf16* REGA = (bf16*)(p.ws + WS_REGA); bf16* PROJ = (bf16*)(p.ws + WS_PROJ);
#ifndef MK_PHASE_MASK
#define MK_PHASE_MASK 0x7ff
#endif
#define IN(k) (((MK_PHASE_MASK >> (k)) & 1) && lo <= (k) && (k) < hi)
#define SEAM(k) do { if (IN(k) && IN((k) + 1)) { if ((k) == PH_PRO) grid.sync(); else xcd_barrier(xbar); } if (MK_PROBE >= 0 && blockIdx.x == 0 && tid == 0) ((unsigned long long*)(p.ws + WS_MOD + 800 * 1024))[(k) + 1] = __builtin_amdgcn_s_memrealtime(); } while (0)
    if (MK_PROBE >= 0 && blockIdx.x == 0 && tid == 0) ((unsigned long long*)(p.ws + WS_MOD + 800 * 1024))[0] = __builtin_amdgcn_s_memrealtime();
    if (IN(PH_PRO)) { phase_pro(p, lds, tid, G); }
    SEAM(PH_PRO);
    if (IN(PH_HN)) { hn_rows<MK_F8_GEMM1 != 0>(p.x, p.g_mix, MOD, 0, 1024, REGA, gw, NGW, lane); }
    SEAM(PH_HN);
    if (IN(PH_GEMM1)) {
#if MK_F8_GEMM1
        pg8::Gemm g{REGA, (const bf16*)(p.ws + WS_WIN), M, NPROJ, DM / 2, DM / 2}; pg8::StaticOrder S; S.init(M, NPROJ, G, (int)blockIdx.x);
        pg8::EpiBf16<0> E{PROJ, NPROJ, 1.f / 32.f};
        pg8::gemm_phase<pg8::EpiBf16<0>, pg8::StaticOrder, true, true, true>((PG8_LAS unsigned char*)lds, g, S, E);
#else
        pg8::Gemm g{REGA, (const bf16*)(p.ws + WS_WIN), M, NPROJ, DM, DM}; pg8::StaticOrder S; S.init(M, NPROJ, G, (int)blockIdx.x);
        pg8::EpiBf16<0> E{PROJ, NPROJ, 1.f};
        pg8::gemm_phase<pg8::EpiBf16<0>, pg8::StaticOrder, true, true>((PG8_LAS unsigned char*)lds, g, S, E);
#endif
    }
    SEAM(PH_GEMM1);
    if (IN(PH_PREP)) {
#ifndef DBG_NO_RP
        for (int it = blockIdx.x; it < M / 64; it += G) rwkv_prep_item(p, lds, it, tid);
#endif
#ifndef DBG_NO_DP
        __syncthreads();
        stage_w_lds((const bf16*)(p.ws + WS_WUKT), lds, 4, tid); __syncthreads();
        for (int tile = gw; tile < M / 32; tile += NGW) dsa_prep_kv(p, lds, tile, lane);
        __syncthreads();
        stage_w_lds((const bf16*)(p.ws + WS_WUK), lds, 6, tid); __syncthreads();
        for (int tile = gw; tile < M / 32; tile += NGW) dsa_prep_q(p, lds, tile, lane);
#endif
    }
    SEAM(PH_PREP);
    if (IN(PH_MIX)) {
        for (int chain = blockIdx.x; chain < NB * 8; chain += G) { rwkv_scan_chain(p, lds, chain, wv, lane); __syncthreads(); }
        constexpr int NSEL = NB * 112;
        {   bf16x8 af[4][4]; float wqv = 0.f; const bf16* PROJ = (const bf16*)(p.ws + WS_PROJ);
            int idx = (int)blockIdx.x;
            if (idx < NSEL) DSA_LOAD_AF(af, wqv, idx / 112, 256 + 16 * (idx % 112));
            for (int k = 0; idx < NSEL; ++k) { const int nidx = (k + 1) * G + (((k + 1) & 1) ? (G - 1 - (int)blockIdx.x) : (int)blockIdx.x); const bool hn = nidx < NSEL;
                dsa_select_item(p, lds, idx / 112, 256 + 16 * (idx % 112), tid, af, wqv, hn, nidx / 112, 256 + 16 * (nidx % 112)); idx = nidx; } }
    }
    SEAM(PH_MIX);
    if (IN(PH_ATT)) {
        for (int row = gw; row < M; row += NGW) dsa_attend_row(p, lds + wv * 9216, row, lane);
    }

    SEAM(PH_ATT);
    if (IN(PH_UV)) {
#if MK_DBG == 7
        for (int m = gw; m < M; m += NGW) { *(u32x4*)(PROJ + (size_t)m * NPROJ + lane * 8) = *(const u32x4*)(REGA + (size_t)m * 1024 + lane * 8); }
#elif MK_DBG != 2
        stage_w_lds((const bf16*)(p.ws + WS_WUVT), lds, 4, tid); __syncthreads();
        for (int tile = gw; tile < M / 32; tile += NGW) uv_item(p, lds, tile, lane);
#endif
#if MK_DBG == 0
        rwkv_epi_rows(p, gw, NGW, lane);
#endif
#if MK_DBG == 1 || MK_DBG == 2
        for (int m = gw; m < M; m += NGW) { u32x4 z = {0u, 0u, 0u, 0u}; *(u32x4*)(PROJ + (size_t)m * NPROJ + (MK_DBG == 1 ? 512 : 0) + lane * 8) = z; }
#endif
    }
    SEAM(PH_UV);
    if (IN(PH_GOUT)) {
        pg8::Gemm g{PROJ, (const bf16*)(p.ws + WS_WOUT), M, DM, DM, NPROJ}; pg8::StaticOrder S; S.init(M, DM, G, (int)blockIdx.x);
        pg8::EpiResGate E{p.x, p.out, DM, MOD + 2048, 6144, 1.f};
        pg8::gemm_phase<pg8::EpiResGate, pg8::StaticOrder, true, true>((PG8_LAS unsigned char*)lds, g, S, E);
    }
    SEAM(PH_GOUT);
    if (IN(PH_HN2)) { hn_rows<false>(MK_SKIP_MIXER ? p.x : p.out, p.g_ffn, MOD, 3072, 4096, REGA, gw, NGW, lane); }
    SEAM(PH_HN2);
    if (IN(PH_UP)) {
        pg8::Gemm g{REGA, (const bf16*)(p.ws + WS_W1), M, FF, DM, DM}; pg8::StaticOrder S; S.init(M, FF, G, (int)blockIdx.x);
        pg8::EpiF8Relu2 E{p.ws + WS_U, FF, 4.f};
        pg8::gemm_phase<pg8::EpiF8Relu2, pg8::StaticOrder, true, true>((PG8_LAS unsigned char*)lds, g, S, E);
    }
    SEAM(PH_UP);
    if (IN(PH_DOWN)) {
        pg8::Gemm g{(const bf16*)(p.ws + WS_U), (const bf16*)(p.ws + WS_W2), M, DM, FF / 2, FF / 2}; pg8::StaticOrder S; S.init(M, DM, G, (int)blockIdx.x);
        pg8::EpiResGate E{MK_SKIP_MIXER ? p.x : p.out, p.out, DM, MOD + 5120, 6144, 1.f / 256.f};
        pg8::gemm_phase<pg8::EpiResGate, pg8::StaticOrder, true, true, true>((PG8_LAS unsigned char*)lds, g, S, E);
    }
#if MK_PROBE >= 0
    grid.sync();
    if (blockIdx.x == 0 && tid == 0) { unsigned long long* ts = (unsigned long long*)(p.ws + WS_MOD + 800 * 1024); ts[PH_COUNT] = __builtin_amdgcn_s_memrealtime();
        p.out[0] += (float)(ts[MK_PROBE + 1] - ts[MK_PROBE]) * 1e-3f; }
#endif
#undef IN
#undef SEAM
}

#ifndef MK_N_LAUNCHES
#define MK_N_LAUNCHES 1
#endif
extern "C" void kernel_launch(void* const* d_in, const int* in_sizes, int n_in, void* d_out, int out_size, void* d_ws, size_t ws_size, hipStream_t stream) {
    static int grid = 0;
    if (grid == 0) {
        if (n_in != 26 || out_size != M * DM || ws_size < WS_END) { fprintf(stderr, "kernel_launch: unexpected shapes (n_in %d out %d ws %zu)\n", n_in, out_size, ws_size); grid = -1; return; }
        int dev = 0, cus = 0, per_cu = 0;
        hipGetDevice(&dev); hipDeviceGetAttribute(&cus, hipDeviceAttributeMultiprocessorCount, dev);
        if (hipFuncSetAttribute((const void*)mk_fwd, hipFuncAttributeMaxDynamicSharedMemorySize, LDS_BYTES) != hipSuccess) { fprintf(stderr, "kernel_launch: hipFuncSetAttribute failed\n"); grid = -1; return; }
        if (hipOccupancyMaxActiveBlocksPerMultiprocessor(&per_cu, (const void*)mk_fwd, NWAVES * 64, LDS_BYTES) != hipSuccess || per_cu < 1) { fprintf(stderr, "kernel_launch: occupancy query says %d\n", per_cu); per_cu = 1; }
        (void)hipGetLastError();
        grid = cus * 1;
        if (per_cu < 1) grid = -1;
    }
    if (grid < 0) return;
    Params p{};
    const float** pp = (const float**)&p;
    for (int i = 0; i < 26; ++i) pp[i] = (const float*)d_in[i];
    p.out = (float*)d_out; p.ws = (unsigned char*)d_ws;
#if MK_N_LAUNCHES == 1
    if (hipMemsetAsync((char*)d_ws + WS_BAR, 0, 16384, stream) != hipSuccess) { fprintf(stderr, "kernel_launch: memset of the barrier words failed\n"); return; }
    p.ph_lo = 0; p.ph_hi = PH_COUNT;
    void* args[] = {&p};
    hipError_t e = hipLaunchCooperativeKernel((const void*)mk_fwd, dim3(grid), dim3(NWAVES * 64), args, LDS_BYTES, stream);
    if (e != hipSuccess) fprintf(stderr, "cooperative launch failed: %s (grid %d)\n", hipGetErrorString(e), grid);
#else
    for (int ph = 0; ph < PH_COUNT; ++ph) {
#if MK_SKIP_MIXER
        if (ph >= PH_HN && ph <= PH_GOUT) continue;
#endif
        p.ph_lo = ph; p.ph_hi = ph + 1;
        hipLaunchKernelGGL(mk_fwd, dim3(grid), dim3(NWAVES * 64), LDS_BYTES, stream, p);
    }
#endif
}
```

```cpp
#include <hip/hip_runtime.h>
#include <hip/hip_cooperative_groups.h>
#include <cstdio>
#include <cstdint>
#include <cmath>
namespace cg = cooperative_groups;
#ifndef MK_F8_GEMM1
#define MK_F8_GEMM1 0
#endif
#ifndef MK_PROBE
#define MK_PROBE -1
#endif
#ifndef MK_DBG
#define MK_DBG 0
#endif
#ifndef MK_DBG_NOTOPK
#define MK_DBG_NOTOPK 0
#endif
namespace pg8 {
#define PG8_LAS __attribute__((address_space(3)))
typedef unsigned short bf16_t;
typedef short bf16x8 __attribute__((ext_vector_type(8)));
typedef float f32x4 __attribute__((ext_vector_type(4)));
typedef unsigned u32x4 __attribute__((ext_vector_type(4)));
constexpr int BM = 256, BK = 64, HALF = 128, HTB = HALF * BK * 2  , STAGE_BYTES = 8 * HTB, NXCD = 8, WGM = 8;

__host__ __device__ __forceinline__ int lds_byte(int r, int c) { const int st = (r >> 4) * 2 + (c >> 5), rr = r & 15, cc = c & 31, ob = rr * 64 + cc * 2; return st * 1024 + (ob ^ (((ob >> 9) & 1) << 5)); }
__host__ __device__ __forceinline__ void stage_rc(int b, int& R, int& C) { const int st = b / 1024, sb = b % 1024, swz = sb ^ (((sb >> 9) & 1) << 5); R = (st >> 1) * 16 + swz / 64; C = (st & 1) * 32 + (swz % 64) / 2; }
__host__ __device__ __forceinline__ int perm32(int rho) { const int n = rho >> 4, i = rho & 15; return 8 * (i >> 2) + 4 * n + (i & 3); }

struct Unit { int pm, pn; };
struct Gemm { const bf16_t* A; const bf16_t* Bt; int M, N, K, lda; };

struct StaticOrder {
    int nM, nN, nwg, G, c;
    __host__ __device__ void init(int M, int N, int G_, int c_) { nM = M / BM; nN = N / BM; nwg = nM * nN; G = G_; c = c_; }
    __host__ __device__ bool next(int i, Unit& u) const {
        const long L = (long)i * G + c; if (L >= nwg) return false;
        int wgid = (int)L; { const int q = nwg / NXCD, r = nwg % NXCD, xcd = wgid % NXCD, off = wgid / NXCD; wgid = (xcd < r ? xcd * (q + 1) : r * (q + 1) + (xcd - r) * q) + off; }
        const int nig = WGM * nN, gid = wgid / nig, fm = gid * WGM, gsz = (nM - fm) < WGM ? (nM - fm) : WGM;
        u.pm = fm + ((wgid % nig) % gsz); u.pn = (wgid % nig) / gsz; return true;
    }
    __device__ __forceinline__ void a_ready(const Unit&) const {}
    __device__ __forceinline__ void done(const Unit&) const {}
};


typedef float f32x2_t __attribute__((ext_vector_type(2))); typedef __bf16 bf16x2_t __attribute__((ext_vector_type(2)));
__device__ __forceinline__ unsigned cvt_pk_bf16(float lo, float hi) { const f32x2_t v = {lo, hi}; const bf16x2_t b = __builtin_convertvector(v, bf16x2_t); return __builtin_bit_cast(unsigned, b); }

template <int ACT  > struct EpiBf16 {
    static constexpr bool PERM = true, AFTER_DRAIN = false;
    bf16_t* O; int ldc; float scale;
    __device__ __forceinline__ void operator()(const f32x4 (&acc)[2][2][4][2], const Unit& u, int wr, int wc, int fr, int fq) const {
        const int row0 = u.pm * BM + wr * 64 + fr; const int col0 = u.pn * BM + wc * 32 + 8 * fq;
#pragma unroll
        for (int ai = 0; ai < 2; ++ai)
#pragma unroll
            for (int m = 0; m < 4; ++m) { bf16_t* rowp = O + (size_t)(row0 + ai * HALF + m * 16) * ldc + col0;
#pragma unroll
                for (int bj = 0; bj < 2; ++bj) { f32x4 v0 = acc[ai][bj][m][0] * scale, v1 = acc[ai][bj][m][1] * scale;
                    if (ACT == 1) {
#pragma unroll
                        for (int j = 0; j < 4; ++j) { const float a = v0[j] > 0.f ? v0[j] : 0.f, b = v1[j] > 0.f ? v1[j] : 0.f; v0[j] = a * a; v1[j] = b * b; } }
                    u32x4 w; w.x = cvt_pk_bf16(v0[0], v0[1]); w.y = cvt_pk_bf16(v0[2], v0[3]); w.z = cvt_pk_bf16(v1[0], v1[1]); w.w = cvt_pk_bf16(v1[2], v1[3]);
                    *(u32x4*)(rowp + bj * HALF) = w; } }
    }
};
__device__ __forceinline__ unsigned pk4_fp8(float a, float b, float c, float d) { int r = __builtin_amdgcn_cvt_pk_fp8_f32(a, b, 0, false); r = __builtin_amdgcn_cvt_pk_fp8_f32(c, d, r, true); return (unsigned)r; }
struct EpiF8Relu2 {
    static constexpr bool PERM = true, AFTER_DRAIN = false;
    unsigned char* O; int ldc; float scale; const float* rowsq; const float* bias2;
    __device__ __forceinline__ void operator()(const f32x4 (&acc)[2][2][4][2], const Unit& u, int wr, int wc, int fr, int fq) const {
        const int row0 = u.pm * BM + wr * 64 + fr; const int col0 = u.pn * BM + wc * 32 + 8 * fq;
        const float* bp = bias2 + (size_t)(u.pm >> 3) * 4096 + col0;
        f32x4 bv[2][2];
#pragma unroll
        for (int bj = 0; bj < 2; ++bj) { bv[bj][0] = *(const f32x4*)(bp + bj * HALF); bv[bj][1] = *(const f32x4*)(bp + bj * HALF + 4); }
#pragma unroll
        for (int ai = 0; ai < 2; ++ai)
#pragma unroll
            for (int m = 0; m < 4; ++m) { const int row = row0 + ai * HALF + m * 16; unsigned char* rowp = O + (size_t)row * ldc + col0;
                const float rstd = rsqrtf(rowsq[row] * (1.f / 1024.f) + 1e-6f);
#pragma unroll
                for (int bj = 0; bj < 2; ++bj) { f32x4 v0 = acc[ai][bj][m][0] * rstd + bv[bj][0], v1 = acc[ai][bj][m][1] * rstd + bv[bj][1];
#pragma unroll
                    for (int j = 0; j < 4; ++j) { const float a = v0[j] > 0.f ? v0[j] : 0.f, b = v1[j] > 0.f ? v1[j] : 0.f; v0[j] = fminf(a * a * scale, 416.f); v1[j] = fminf(b * b * scale, 416.f); }
                    typedef unsigned u32x2_t __attribute__((ext_vector_type(2)));
                    u32x2_t w; w.x = pk4_fp8(v0[0], v0[1], v0[2], v0[3]); w.y = pk4_fp8(v1[0], v1[1], v1[2], v1[3]);
                    *(u32x2_t*)(rowp + bj * HALF) = w; } }
    }
};
struct EpiResGate {
    static constexpr bool PERM = false, AFTER_DRAIN = false;
    const float* base; float* out; int ldc; const float* gate; int gate_ld; float gscale;
    __device__ __forceinline__ void operator()(const f32x4 (&acc)[2][2][4][2], const Unit& u, int, int, int, int) const {
        int t_ = threadIdx.x; asm volatile("" : "+v"(t_));
        const int wr = t_ >> 8, wc = (t_ >> 6) & 3, fr = t_ & 15, fq = (t_ >> 4) & 3;
        const int row0 = u.pm * BM + wr * 64 + fr, col0 = u.pn * BM + wc * 32 + 4 * fq;
        const float* gp = gate + (size_t)(u.pm >> 3) * gate_ld + col0;
        f32x4 gv[2][2];
#pragma unroll
        for (int bj = 0; bj < 2; ++bj)
#pragma unroll
            for (int n = 0; n < 2; ++n) gv[bj][n] = *(const f32x4*)(gp + bj * HALF + n * 16) * gscale;
#pragma unroll
        for (int ai = 0; ai < 2; ++ai)
#pragma unroll
            for (int m = 0; m < 4; ++m) { const size_t off = (size_t)(row0 + ai * HALF + m * 16) * ldc + col0;
#pragma unroll
                for (int bj = 0; bj < 2; ++bj)
#pragma unroll
                    for (int n = 0; n < 2; ++n) { const f32x4 bs = *(const f32x4*)(base + off + bj * HALF + n * 16);
                        *(f32x4*)(out + off + bj * HALF + n * 16) = bs + gv[bj][n] * acc[ai][bj][m][n]; } }
    }
};
struct EpiResGateNorm {
    static constexpr bool PERM = false, AFTER_DRAIN = false;
    const float* base; float* out; int ldc; const float* gate; int gate_ld; const float* gffn; const float* sc2; bf16_t* a2; float* rowsq;
    __device__ __forceinline__ void operator()(const f32x4 (&acc)[2][2][4][2], const Unit& u, int, int, int, int) const {
        int t_ = threadIdx.x; asm volatile("" : "+v"(t_));
        const int wr = t_ >> 8, wc = (t_ >> 6) & 3, fr = t_ & 15, fq = (t_ >> 4) & 3;
        const int row0 = u.pm * BM + wr * 64 + fr, col0 = u.pn * BM + wc * 32 + 4 * fq;
        const float* gp = gate + (size_t)(u.pm >> 3) * gate_ld + col0; const float* sp = sc2 + (size_t)(u.pm >> 3) * gate_ld + col0;
        f32x4 gv[2][2], gm[2][2];
#pragma unroll
        for (int bj = 0; bj < 2; ++bj)
#pragma unroll
            for (int n = 0; n < 2; ++n) { gv[bj][n] = *(const f32x4*)(gp + bj * HALF + n * 16); gm[bj][n] = *(const f32x4*)(gffn + col0 + bj * HALF + n * 16) * (*(const f32x4*)(sp + bj * HALF + n * 16) + 1.f); }
#pragma unroll
        for (int ai = 0; ai < 2; ++ai)
#pragma unroll
            for (int m = 0; m < 4; ++m) { const int row = row0 + ai * HALF + m * 16; const size_t off = (size_t)row * ldc + col0; float ss = 0.f;
#pragma unroll
                for (int bj = 0; bj < 2; ++bj)
#pragma unroll
                    for (int n = 0; n < 2; ++n) { const f32x4 bs = *(const f32x4*)(base + off + bj * HALF + n * 16); const f32x4 x1 = bs + gv[bj][n] * acc[ai][bj][m][n];
                        ss += (x1.x * x1.x + x1.y * x1.y) + (x1.z * x1.z + x1.w * x1.w);
                        const f32x4 y = x1 * gm[bj][n]; typedef unsigned u32x2_t __attribute__((ext_vector_type(2)));
                        u32x2_t w; w.x = cvt_pk_bf16(y.x, y.y); w.y = cvt_pk_bf16(y.z, y.w); *(u32x2_t*)(a2 + off + bj * HALF + n * 16) = w; }
                ss += __shfl_xor(ss, 16); ss += __shfl_xor(ss, 32);
                if (fq == 0) atomicAdd(rowsq + row, ss); }
    }
};
struct EpiResGateA2 {
    static constexpr bool PERM = false, AFTER_DRAIN = false;
    const bf16_t* a2; float* out; int ldc; const float* gate; int gate_ld; const float* gffn;
    __device__ __forceinline__ void operator()(const f32x4 (&acc)[2][2][4][2], const Unit& u, int, int, int, int) const {
        constexpr float gscale = 1.f / 256.f;
        int t_ = threadIdx.x; asm volatile("" : "+v"(t_));
        const int wr = t_ >> 8, wc = (t_ >> 6) & 3, fr = t_ & 15, fq = (t_ >> 4) & 3;
        const int row0 = u.pm * BM + wr * 64 + fr, col0 = u.pn * BM + wc * 32 + 4 * fq;
        const float* gp = gate + (size_t)(u.pm >> 3) * gate_ld + col0; const float* sp = gp - 1024;
        f32x4 gv[2][2], ig[2][2];
#pragma unroll
        for (int bj = 0; bj < 2; ++bj)
#pragma unroll
            for (int n = 0; n < 2; ++n) { gv[bj][n] = *(const f32x4*)(gp + bj * HALF + n * 16) * gscale;
                const f32x4 gm = *(const f32x4*)(gffn + col0 + bj * HALF + n * 16) * (*(const f32x4*)(sp + bj * HALF + n * 16) + 1.f);
                ig[bj][n] = (f32x4){1.f / gm.x, 1.f / gm.y, 1.f / gm.z, 1.f / gm.w}; }
#pragma unroll
        for (int ai = 0; ai < 2; ++ai)
#pragma unroll
            for (int m = 0; m < 4; ++m) { const size_t off = (size_t)(row0 + ai * HALF + m * 16) * ldc + col0;
#pragma unroll
                for (int bj = 0; bj < 2; ++bj)
#pragma unroll
                    for (int n = 0; n < 2; ++n) { typedef unsigned u32x2_t __attribute__((ext_vector_type(2)));
                        const u32x2_t w = *(const u32x2_t*)(a2 + off + bj * HALF + n * 16);
                        const f32x4 xa = {__uint_as_float(w.x << 16), __uint_as_float(w.x & 0xffff0000u), __uint_as_float(w.y << 16), __uint_as_float(w.y & 0xffff0000u)};
                        *(f32x4*)(out + off + bj * HALF + n * 16) = xa * ig[bj][n] + gv[bj][n] * acc[ai][bj][m][n]; } }
    }
};
template <class Epi, class Sched, bool ALIGN_EPI = false, bool SP2 = false, bool F8 = false>
__device__ __forceinline__ void gemm_phase(PG8_LAS unsigned char* lds, const Gemm g, const Sched S, const Epi E) {
    const int tid = threadIdx.x, wid = __builtin_amdgcn_readfirstlane(tid >> 6), lane = tid & 63, wr = wid >> 2, wc = wid & 3, fr = lane & 15, fq = lane >> 4;
    const int K = g.K, nt = K / BK;
    unsigned voffA[2], voffB[2];
#pragma unroll
    for (int i = 0; i < 2; ++i) { int R, C; stage_rc(tid * 16 + i * 8192, R, C); const int Rb = Epi::PERM ? ((R & ~31) + perm32(R & 31)) : R;
        voffA[i] = (unsigned)(R * g.lda + C) * 2u; voffB[i] = (unsigned)(Rb * K + C) * 2u; }
    const size_t kstep = (size_t)(BK * 2);
    const size_t hstepB = (size_t)HALF * K * 2, hstepA = (size_t)HALF * g.lda * 2;
    const size_t tstepA = 2 * hstepA, tstepB = 2 * hstepB;
    const unsigned ldsw = (unsigned)wid * 1024u;
    const int f8in = (fq >> 1) * 1024 + ((fr * 64 + (fq & 1) * 32) ^ ((fr >> 3) << 5));
    const int aoff = F8 ? wr * 8192 + f8in : lds_byte(wr * 64 + fr, fq * 8), boff = F8 ? wc * 4096 + f8in : lds_byte(wc * 32 + fr, fq * 8);
    constexpr int KOFF = F8 ? 16 : 1024;
    typedef int v8i_t __attribute__((ext_vector_type(8)));
#define PG8_SA(b, h) (((b) * 2 + (h)) * HTB)
#define PG8_SB(b, h) ((4 + (b) * 2 + (h)) * HTB)
#define PG8_STAGE(bufoff, gbase, voff) do { _Pragma("unroll") for (int _i = 0; _i < 2; ++_i) \
        __builtin_amdgcn_global_load_lds((const unsigned*)((const char*)(gbase) + (voff)[_i]), (PG8_LAS unsigned*)(lds + (bufoff) + ldsw + _i * 8192), 16, 0, 0); } while (0)
#define PG8_LD32(p_) __builtin_shufflevector(*(const PG8_LAS u32x4*)(p_), *(const PG8_LAS u32x4*)((p_) + 16), 0, 1, 2, 3, 4, 5, 6, 7)
#define PG8_LDA(dst, b, h) do { if constexpr (F8) { _Pragma("unroll") for (int m = 0; m < 4; ++m) dst##8[m] = __builtin_bit_cast(v8i_t, PG8_LD32(lds + PG8_SA(b, h) + aoff + m * 2048)); } \
    else { _Pragma("unroll") for (int m = 0; m < 4; ++m) _Pragma("unroll") for (int k = 0; k < 2; ++k) dst[m][k] = *(const PG8_LAS bf16x8*)(lds + PG8_SA(b, h) + aoff + m * 2048 + k * KOFF); } } while (0)
#define PG8_LDB(dst, b, h) do { if constexpr (F8) { _Pragma("unroll") for (int n = 0; n < 2; ++n) dst##8[n] = __builtin_bit_cast(v8i_t, PG8_LD32(lds + PG8_SB(b, h) + boff + n * 2048)); } \
    else { _Pragma("unroll") for (int n = 0; n < 2; ++n) _Pragma("unroll") for (int k = 0; k < 2; ++k) dst[n][k] = *(const PG8_LAS bf16x8*)(lds + PG8_SB(b, h) + boff + n * 2048 + k * KOFF); } } while (0)
#define PG8_CAT(x) __builtin_shufflevector(__builtin_bit_cast(u32x4, (x)[0]), __builtin_bit_cast(u32x4, (x)[1]), 0, 1, 2, 3, 4, 5, 6, 7)
#define PG8_MMA(ai, bj, At, Bt) do { __builtin_amdgcn_s_setprio(1); if constexpr (F8) { _Pragma("unroll") for (int m = 0; m < 4; ++m) _Pragma("unroll") for (int n = 0; n < 2; ++n) \
        asm volatile("v_mfma_f32_16x16x128_f8f6f4 %0, %1, %2, %0" : "+v"(acc[ai][bj][m][n]) : "v"(Bt##8[n]), "v"(At##8[m])); } \
    else { _Pragma("unroll") for (int m = 0; m < 4; ++m) _Pragma("unroll") for (int n = 0; n < 2; ++n) _Pragma("unroll") for (int k = 0; k < 2; ++k) \
        acc[ai][bj][m][n] = __builtin_amdgcn_mfma_f32_16x16x32_bf16(Bt[n][k], At[m][k], acc[ai][bj][m][n], 0, 0, 0); } __builtin_amdgcn_s_setprio(0); } while (0)
#define PG8_WAIT_V(n) asm volatile("s_waitcnt vmcnt(" #n ")" ::: "memory")
#define PG8_WAIT_L(n) asm volatile("s_waitcnt lgkmcnt(" #n ")" ::: "memory")
#define PG8_BAR __builtin_amdgcn_s_barrier()
#define PG8_SCHED __builtin_amdgcn_sched_barrier(0)
    Unit cur, nxt; int ui = 0;
    if (!S.next(0, cur)) return;
    f32x4 acc[2][2][4][2];
#pragma unroll
    for (int a = 0; a < 2; ++a)
#pragma unroll
        for (int b = 0; b < 2; ++b)
#pragma unroll
            for (int m = 0; m < 4; ++m)
#pragma unroll
                for (int n = 0; n < 2; ++n) acc[a][b][m][n] = (f32x4){0.f, 0.f, 0.f, 0.f};
    bf16x8 At[4][2], B0[2][2], B1[2][2]; v8i_t At8[4], B08[2], B18[2];
    const char* cA = (const char*)g.A + (size_t)cur.pm * tstepA; const char* cB = (const char*)g.Bt + (size_t)cur.pn * tstepB;
    S.a_ready(cur);
    if constexpr (SP2) {
        PG8_STAGE(PG8_SB(0, 0), cB, voffB); PG8_STAGE(PG8_SB(0, 1), cB + hstepB, voffB); PG8_STAGE(PG8_SA(0, 0), cA, voffA); PG8_STAGE(PG8_SA(0, 1), cA + hstepA, voffA);
        if (wr == 1) PG8_BAR;
        PG8_WAIT_V(2); PG8_BAR;
        PG8_STAGE(PG8_SB(1, 0), cB + kstep, voffB); PG8_STAGE(PG8_SA(1, 0), cA + kstep, voffA); PG8_STAGE(PG8_SB(1, 1), cB + hstepB + kstep, voffB);
        PG8_WAIT_V(6); PG8_BAR;
    } else {
        PG8_STAGE(PG8_SB(0, 0), cB, voffB); PG8_STAGE(PG8_SA(0, 0), cA, voffA); PG8_STAGE(PG8_SB(0, 1), cB + hstepB, voffB); PG8_STAGE(PG8_SA(0, 1), cA + hstepA, voffA);
        if (wr == 1) PG8_BAR;
        PG8_WAIT_V(4); PG8_BAR;
        PG8_STAGE(PG8_SB(1, 0), cB + kstep, voffB); PG8_STAGE(PG8_SA(1, 0), cA + kstep, voffA); PG8_STAGE(PG8_SB(1, 1), cB + hstepB + kstep, voffB);
        PG8_WAIT_V(6); PG8_BAR;
    }
    for (;;) {
        const bool has_next = S.next(ui + 1, nxt);
        const char* nA = has_next ? (const char*)g.A + (size_t)nxt.pm * tstepA : cA; const char* nB = has_next ? (const char*)g.Bt + (size_t)nxt.pn * tstepB : cB;
        for (int t = 0; t < nt; t += 2) {
            const bool last = (t == nt - 2);
            const char* a1 = cA + (size_t)(t + 1) * kstep;
            const char* a2 = last ? nA : cA + (size_t)(t + 2) * kstep; const char* b2 = last ? nB : cB + (size_t)(t + 2) * kstep;
            const char* a3 = a2 + kstep; const char* b3 = b2 + kstep;
            if (last && has_next) S.a_ready(nxt);
            if constexpr (SP2) {
            PG8_LDB(B0, 0, 0); PG8_LDB(B1, 0, 1); PG8_SCHED; PG8_LDA(At, 0, 0); PG8_STAGE(PG8_SA(1, 1), a1 + hstepA, voffA);
            PG8_WAIT_V(8); PG8_WAIT_L(0); PG8_BAR; PG8_MMA(0, 0, At, B0); PG8_MMA(0, 1, At, B1); PG8_BAR; PG8_SCHED;
            PG8_LDA(At, 0, 1); PG8_STAGE(PG8_SB(0, 0), b2, voffB); PG8_STAGE(PG8_SB(0, 1), b2 + hstepB, voffB); PG8_STAGE(PG8_SA(0, 0), a2, voffA);
            PG8_WAIT_V(8); PG8_WAIT_L(0); PG8_BAR; PG8_MMA(1, 0, At, B0); PG8_MMA(1, 1, At, B1); PG8_BAR; PG8_SCHED;
            PG8_LDB(B0, 1, 0); PG8_LDB(B1, 1, 1); PG8_SCHED; PG8_LDA(At, 1, 0); PG8_STAGE(PG8_SA(0, 1), a2 + hstepA, voffA);
            PG8_WAIT_V(8); PG8_WAIT_L(0); PG8_BAR; PG8_MMA(0, 0, At, B0); PG8_MMA(0, 1, At, B1); PG8_BAR; PG8_SCHED;
            PG8_LDA(At, 1, 1); PG8_STAGE(PG8_SB(1, 0), b3, voffB); PG8_STAGE(PG8_SB(1, 1), b3 + hstepB, voffB); PG8_STAGE(PG8_SA(1, 0), a3, voffA);
            PG8_WAIT_V(8); PG8_WAIT_L(0); PG8_BAR; PG8_MMA(1, 0, At, B0); PG8_MMA(1, 1, At, B1); PG8_BAR; PG8_SCHED;
            } else {
            PG8_LDB(B0, 0, 0); PG8_SCHED; PG8_LDA(At, 0, 0); PG8_STAGE(PG8_SA(1, 1), a1 + hstepA, voffA);
            PG8_WAIT_L(8); PG8_BAR; PG8_WAIT_L(0); PG8_MMA(0, 0, At, B0); PG8_BAR; PG8_SCHED;
            PG8_LDB(B1, 0, 1); PG8_STAGE(PG8_SB(0, 0), b2, voffB);
            PG8_BAR; PG8_WAIT_L(0); PG8_MMA(0, 1, At, B1); PG8_BAR;
            PG8_LDA(At, 0, 1); PG8_STAGE(PG8_SA(0, 0), a2, voffA);
            PG8_BAR; PG8_WAIT_L(0); PG8_MMA(1, 0, At, B0); PG8_BAR; PG8_SCHED;
            PG8_STAGE(PG8_SB(0, 1), b2 + hstepB, voffB);
            PG8_WAIT_V(6); PG8_BAR; PG8_MMA(1, 1, At, B1); PG8_BAR;
            PG8_LDB(B0, 1, 0); PG8_SCHED; PG8_LDA(At, 1, 0); PG8_STAGE(PG8_SA(0, 1), a2 + hstepA, voffA);
            PG8_WAIT_L(8); PG8_BAR; PG8_WAIT_L(0); PG8_MMA(0, 0, At, B0); PG8_BAR; PG8_SCHED;
            PG8_LDB(B1, 1, 1); PG8_STAGE(PG8_SB(1, 0), b3, voffB);
            PG8_BAR; PG8_WAIT_L(0); PG8_MMA(0, 1, At, B1); PG8_BAR;
            PG8_LDA(At, 1, 1); PG8_STAGE(PG8_SA(1, 0), a3, voffA);
            PG8_BAR; PG8_WAIT_L(0); PG8_MMA(1, 0, At, B0); PG8_BAR; PG8_SCHED;
            PG8_STAGE(PG8_SB(1, 1), b3 + hstepB, voffB);
            PG8_WAIT_V(6); PG8_BAR; PG8_MMA(1, 1, At, B1); PG8_BAR;
            }
        }
        if constexpr (ALIGN_EPI) { if (wr == 0) PG8_BAR; }
        if constexpr (F8) asm volatile("s_nop 15\n\ts_nop 15");
        if constexpr (!Epi::AFTER_DRAIN) { E(acc, cur, wr, wc, fr, fq); S.done(cur); }
        if (!has_next) break;
#pragma unroll
        for (int a = 0; a < 2; ++a)
#pragma unroll
            for (int b = 0; b < 2; ++b)
#pragma unroll
                for (int m = 0; m < 4; ++m)
#pragma unroll
                    for (int n = 0; n < 2; ++n) acc[a][b][m][n] = (f32x4){0.f, 0.f, 0.f, 0.f};
        cur = nxt; cA = nA; cB = nB; ++ui;
        if constexpr (ALIGN_EPI) { if (wr == 1) PG8_BAR; }
    }
    PG8_WAIT_V(0);
    if constexpr (!ALIGN_EPI) { if (wr == 0) PG8_BAR; }
    PG8_BAR;
    if constexpr (Epi::AFTER_DRAIN) { E.fused(acc, cur, wr, wc, fr, fq, lds, wid, lane); S.done(cur); }
#undef PG8_SA
#undef PG8_SB
#undef PG8_STAGE
#undef PG8_LDA
#undef PG8_LDB
#undef PG8_MMA
#undef PG8_CAT
#undef PG8_LD32
#undef PG8_WAIT_V
#undef PG8_WAIT_L
#undef PG8_BAR
#undef PG8_SCHED
}
}

#define LAS __attribute__((address_space(3)))
typedef unsigned short bf16;
typedef short bf16x8 __attribute__((ext_vector_type(8)));
typedef short s16x4 __attribute__((ext_vector_type(4)));
typedef float f32x4 __attribute__((ext_vector_type(4)));
typedef float f32x16 __attribute__((ext_vector_type(16)));
typedef unsigned u32x4 __attribute__((ext_vector_type(4)));
typedef unsigned u32x2 __attribute__((ext_vector_type(2)));

constexpr int NB = 32, SEQ = 2048, DM = 1024, M = NB * SEQ, NPROJ = 3072, FF = 4096;
constexpr int PC_Q = 0, PC_R = 512, PC_K = 1024, PC_V = 1536, PC_QI = 2048, PC_CL = 2560, PC_KI = 2688, PC_XW = 2752, PC_XA = 2816, PC_XG = 2880, PC_WI = 3008;
constexpr size_t MiB = 1u << 20;
constexpr size_t WS_MOD = 0, WS_WUKT = 1 * MiB, WS_WUK = WS_WUKT + 131072, WS_WUVT = WS_WUK + 131072, WS_INVR = 2 * MiB, WS_WIN = 4 * MiB, WS_WOUT = 10 * MiB,
                 WS_W1 = 12 * MiB, WS_W2 = 20 * MiB, WS_CKV = 36 * MiB, WS_GAM = 52 * MiB, WS_C3 = 60 * MiB, WS_REGA = 64 * MiB, WS_PROJ = 192 * MiB, WS_CH = 576 * MiB,
                 WS_G = 960 * MiB, WS_U = 192 * MiB, WS_END = 1024 * MiB,
                 WS_BAR = 62 * MiB, WS_ROWSQ = WS_BAR + 65536, WS_BIAS2 = WS_ROWSQ + 262144, WS_W2T = WS_WUVT + 131072, WS_A2T = WS_W2T + 65536, WS_G2T = WS_A2T + 65536;
constexpr int LDS_BAR_OFF = 158720;
constexpr int LDS_BYTES = 158976;
constexpr int NWAVES = 8;

struct Params {
    const float *x, *c, *w_ada, *b_ada, *g_mix, *g_ffn, *w_in, *g_q, *g_k, *g_kv, *w_uk, *w_uv, *mu, *w0, *w2, *a0, *a2, *g2, *k_k, *k_a, *r_k, *ln_w, *ln_b, *w_out, *w_ff1, *w_ff2;
    float* out; unsigned char* ws; int ph_lo, ph_hi;
};

__device__ __forceinline__ unsigned pk2(float lo, float hi) { return pg8::cvt_pk_bf16(lo, hi); }
__device__ __forceinline__ float bflo(unsigned w) { return __uint_as_float(w << 16); }
__device__ __forceinline__ float bfhi(unsigned w) { return __uint_as_float(w & 0xffff0000u); }
__device__ __forceinline__ float bf2f(bf16 h) { return __uint_as_float((unsigned)h << 16); }
__device__ __forceinline__ bf16 f2bf(float f) { return (bf16)(pk2(f, 0.f) & 0xffffu); }
__device__ __forceinline__ float wave_sum(float v) {
#pragma unroll
    for (int o = 1; o < 64; o <<= 1) v += __shfl_xor(v, o);
    return v;
}
__device__ __forceinline__ f32x16 mfma32(bf16x8 a, bf16x8 b, f32x16 c) { return __builtin_amdgcn_mfma_f32_32x32x16_bf16(a, b, c, 0, 0, 0); }
__device__ __forceinline__ f32x4 mfma16(bf16x8 a, bf16x8 b, f32x4 c) { return __builtin_amdgcn_mfma_f32_16x16x32_bf16(a, b, c, 0, 0, 0); }

__device__ __forceinline__ int win_src_col(int n) {
    if (n < 512) return n;
    if (n < 1024) return 1224 + (n - 512);
    if (n < 1536) return 1736 + (n - 1024);
    if (n < 2048) return 2248 + (n - 1536);
    if (n < 2560) return 640 + (n - 2048);
    if (n < 2688) return 512 + (n - 2560);
    if (n < 2752) return 1152 + (n - 2688);
    if (n < 2816) return 2760 + (n - 2752);
    if (n < 2880) return 2824 + (n - 2816);
    if (n < 3008) return 2888 + (n - 2880);
    if (n < 3016) return 1216 + (n - 3008);
    return -1;
}
__device__ __forceinline__ void conv_t_item(const float* W, int K, int Nsrc, bf16* WT, int nblk, int item, float* scr, int lane, bool is_win) {
    const int kb = item / nblk, nb = item % nblk, k0 = 64 * kb, n0 = 32 * nb;
    int ns = n0 + (lane & 31); if (is_win) ns = win_src_col(ns);
    float tv[32];
#pragma unroll
    for (int i = 0; i < 32; ++i) { const int kk = 2 * i + (lane >> 5); tv[i] = ns >= 0 ? W[(size_t)(k0 + kk) * Nsrc + ns] : 0.f; }
#pragma unroll
    for (int i = 0; i < 32; ++i) { const int kk = 2 * i + (lane >> 5); scr[kk * 33 + (lane & 31)] = tv[i]; }
    asm volatile("s_waitcnt lgkmcnt(0)" ::: "memory");
    const int c = lane & 7;
#pragma unroll
    for (int j = 0; j < 4; ++j) { const int n = (lane >> 3) + 8 * j; const float* s = scr + (8 * c) * 33 + n;
        u32x4 o; o.x = pk2(s[0 * 33], s[1 * 33]); o.y = pk2(s[2 * 33], s[3 * 33]); o.z = pk2(s[4 * 33], s[5 * 33]); o.w = pk2(s[6 * 33], s[7 * 33]);
        *(u32x4*)(WT + (size_t)(n0 + n) * K + k0 + 8 * c) = o; }
    asm volatile("s_waitcnt lgkmcnt(0)" ::: "memory");
}
__device__ __forceinline__ void conv_t_item_f8(const float* W, int K, int N, unsigned char* WT, int nblk, int item, float* scr, int lane, float scale, bool is_win = false) {
    const int kb = item / nblk, nb = item % nblk, k0 = 64 * kb, n0 = 32 * nb;
    int ns = n0 + (lane & 31); if (is_win) ns = win_src_col(ns);
    float tv[32];
#pragma unroll
    for (int i = 0; i < 32; ++i) { const int kk = 2 * i + (lane >> 5); tv[i] = ns >= 0 ? W[(size_t)(k0 + kk) * N + ns] * scale : 0.f; }
#pragma unroll
    for (int i = 0; i < 32; ++i) { const int kk = 2 * i + (lane >> 5); scr[kk * 33 + (lane & 31)] = tv[i]; }
    asm volatile("s_waitcnt lgkmcnt(0)" ::: "memory");
    const int c = lane & 7;
#pragma unroll
    for (int j = 0; j < 4; ++j) { const int n = (lane >> 3) + 8 * j; const float* s = scr + (8 * c) * 33 + n;
        u32x2 o; o.x = pg8::pk4_fp8(s[0 * 33], s[1 * 33], s[2 * 33], s[3 * 33]); o.y = pg8::pk4_fp8(s[4 * 33], s[5 * 33], s[6 * 33], s[7 * 33]);
        *(u32x2*)(WT + (size_t)(n0 + n) * K + k0 + 8 * c) = o; }
    asm volatile("s_waitcnt lgkmcnt(0)" ::: "memory");
}
__device__ __forceinline__ void adaln_block(const Params& p, float* ldsf, int cb, int tid) {
    const int lane = tid & 63, wv = tid >> 6, e = cb * 64 + lane;
    float* SC = ldsf; float* RED = ldsf + 16384; float* mod = (float*)(p.ws + WS_MOD);
    float wreg[128];
#pragma unroll
    for (int d = 0; d < 128; ++d) wreg[d] = p.w_ada[(size_t)(wv * 128 + d) * 6144 + e];
    for (int half = 0; half < 2; ++half) {
        const int b0 = half * 16;
        for (int i = tid; i < 16384; i += 512) { const float cv = p.c[b0 * 1024 + i]; SC[i] = cv / (1.f + __expf(-cv)); }
        __syncthreads();
        float acc[16];
#pragma unroll
        for (int bb = 0; bb < 16; ++bb) acc[bb] = 0.f;
#pragma unroll
        for (int dd = 0; dd < 128; dd += 4) { const int d = wv * 128 + dd;
            const float w0 = wreg[dd], w1 = wreg[dd + 1], w2 = wreg[dd + 2], w3 = wreg[dd + 3];
#pragma unroll
            for (int bb = 0; bb < 16; ++bb) { const f32x4 s = *(const f32x4*)(SC + bb * 1024 + d); acc[bb] += (s.x * w0 + s.y * w1) + (s.z * w2 + s.w * w3); }
        }
#pragma unroll
        for (int bb = 0; bb < 16; ++bb) RED[(wv * 16 + bb) * 64 + lane] = acc[bb];
        __syncthreads();
#pragma unroll
        for (int q = 0; q < 2; ++q) { const int bb = wv * 2 + q; float s = p.b_ada[e];
#pragma unroll
            for (int ww = 0; ww < 8; ++ww) s += RED[(ww * 16 + bb) * 64 + lane];
            mod[(size_t)(b0 + bb) * 6144 + e] = s; }
        __syncthreads();
    }
}
__device__ __forceinline__ void phase_pro(const Params& p, unsigned char* lds, int tid, int G) {
    const int lane = tid & 63, wv = tid >> 6;
    for (int cb = blockIdx.x; cb < 96; cb += G) adaln_block(p, (float*)lds, cb, tid);
    __syncthreads();
    float* scr = (float*)lds + wv * (64 * 33 + 16);
    const int gw = blockIdx.x * NWAVES + wv, NGW = G * NWAVES;
    bf16* WIN = (bf16*)(p.ws + WS_WIN); bf16* WOUT = (bf16*)(p.ws + WS_WOUT); bf16* W1 = (bf16*)(p.ws + WS_W1); bf16* W2 = (bf16*)(p.ws + WS_W2);
    bf16* WUKT = (bf16*)(p.ws + WS_WUKT); bf16* WUK = (bf16*)(p.ws + WS_WUK); bf16* WUVT = (bf16*)(p.ws + WS_WUVT);
    constexpr int I_IN = (DM / 64) * (NPROJ / 32), I_OUT = (DM / 64) * (DM / 32), I_1 = (DM / 64) * (FF / 32), I_2 = (FF / 64) * (DM / 32), I_UK = (128 / 64) * (512 / 32);
    constexpr int I_LR = 512 / 32;
    constexpr int NITEMS = I_IN + I_OUT + I_1 + I_2 + 2 * I_UK + 4 * I_LR;
    for (int it = gw; it < NITEMS; it += NGW) {
        int r = it;
        if (r < I_IN) { if (MK_F8_GEMM1) conv_t_item_f8(p.w_in, DM, 3016, (unsigned char*)WIN, NPROJ / 32, r, scr, lane, 32.f, true); else conv_t_item(p.w_in, DM, 3016, WIN, NPROJ / 32, r, scr, lane, true); continue; } r -= I_IN;
        if (r < I_OUT) { conv_t_item(p.w_out, DM, DM, WOUT, DM / 32, r, scr, lane, false); continue; } r -= I_OUT;
        if (r < I_1) { conv_t_item(p.w_ff1, DM, FF, W1, FF / 32, r, scr, lane, false); continue; } r -= I_1;
        if (r < I_2) { conv_t_item_f8(p.w_ff2, FF, DM, (unsigned char*)W2, DM / 32, r, scr, lane, 64.f); continue; } r -= I_2;
        if (r < I_UK) { conv_t_item(p.w_uk, 128, 512, WUKT, 512 / 32, r, scr, lane, false); continue; } r -= I_UK;
        if (r < I_UK) { conv_t_item(p.w_uv, 128, 512, WUVT, 512 / 32, r, scr, lane, false); continue; } r -= I_UK;
        if (r < I_LR) { conv_t_item(p.w2, 64, 512, (bf16*)(p.ws + WS_W2T), 512 / 32, r, scr, lane, false); continue; } r -= I_LR;
        if (r < I_LR) { conv_t_item(p.a2, 64, 512, (bf16*)(p.ws + WS_A2T), 512 / 32, r, scr, lane, false); continue; } r -= I_LR;
        conv_t_item(p.g2, 128, 512, (bf16*)(p.ws + WS_G2T), 512 / 32, r, scr, lane, false);
    }
    { float* ROWSQ = (float*)(p.ws + WS_ROWSQ); for (int i = blockIdx.x * 512 + tid; i < M; i += G * 512) ROWSQ[i] = 0.f; }
    for (int i = blockIdx.x * 512 + tid; i < 128 * 512 / 2; i += G * 512) { const float a = p.w_uk[2 * i], b = p.w_uk[2 * i + 1]; ((unsigned*)WUK)[i] = pk2(a, b); }
}

template <bool F8OUT> __device__ __forceinline__ void hn_rows(const float* src, const float* g, const float* mod, int off_sh, int off_sc, bf16* dst, int gw, int NGW, int lane) {
    const int RPW = M / NGW;
    for (int m0 = gw * RPW; m0 < M; m0 += NGW * RPW) {
        const float* mb = mod + (size_t)(m0 >> 11) * 6144;
        f32x4 ga[4], sh[4];
#pragma unroll
        for (int j = 0; j < 4; ++j) { const int col = 4 * lane + 256 * j; const f32x4 gg = *(const f32x4*)(g + col), sc = *(const f32x4*)(mb + off_sc + col); ga[j] = gg * (1.f + sc); sh[j] = *(const f32x4*)(mb + off_sh + col); }
        for (int r0 = 0; r0 < RPW; r0 += 4) {
            f32x4 v[4][4]; float s[4];
#pragma unroll
            for (int r = 0; r < 4; ++r) { const f32x4* xr = (const f32x4*)(src + (size_t)(m0 + r0 + r) * DM) + lane;
#pragma unroll
                for (int j = 0; j < 4; ++j) v[r][j] = xr[64 * j]; }
#pragma unroll
            for (int r = 0; r < 4; ++r) { s[r] = 0.f;
#pragma unroll
                for (int j = 0; j < 4; ++j) s[r] += (v[r][j].x * v[r][j].x + v[r][j].y * v[r][j].y) + (v[r][j].z * v[r][j].z + v[r][j].w * v[r][j].w); }
#pragma unroll
            for (int o = 1; o < 64; o <<= 1) {
#pragma unroll
                for (int r = 0; r < 4; ++r) s[r] += __shfl_xor(s[r], o); }
#pragma unroll
            for (int r = 0; r < 4; ++r) { const int m = m0 + r0 + r; const float rstd = rsqrtf(s[r] * (1.f / DM) + 1e-6f);
                unsigned long long* o8 = (unsigned long long*)(dst + (size_t)m * DM) + lane;
#pragma unroll
                for (int j = 0; j < 4; ++j) { const f32x4 y = v[r][j] * rstd * ga[j] + sh[j];
                    if (F8OUT) ((unsigned*)((unsigned char*)dst + (size_t)m * DM))[lane + 64 * j] = pg8::pk4_fp8(y.x, y.y, y.z, y.w);
                    else o8[64 * j] = (unsigned long long)pk2(y.x, y.y) | ((unsigned long long)pk2(y.z, y.w) << 32); } }
        }
    }
}

typedef short s16x4 __attribute__((ext_vector_type(4)));
__device__ __forceinline__ f32x4 mfma16k(s16x4 a, s16x4 b, f32x4 c) { return __builtin_amdgcn_mfma_f32_16x16x16bf16_1k(a, b, c, 0, 0, 0); }
__device__ __forceinline__ s16x4 pack4(f32x4 v) { u32x2 o; o.x = pk2(v[0], v[1]); o.y = pk2(v[2], v[3]); return __builtin_bit_cast(s16x4, o); }

__device__ __forceinline__ float dpp_row_sum16(float x) {
    x += __builtin_bit_cast(float, __builtin_amdgcn_mov_dpp(__builtin_bit_cast(int, x), 0xB1, 0xF, 0xF, true));
    x += __builtin_bit_cast(float, __builtin_amdgcn_mov_dpp(__builtin_bit_cast(int, x), 0x4E, 0xF, 0xF, true));
    x += __builtin_bit_cast(float, __builtin_amdgcn_mov_dpp(__builtin_bit_cast(int, x), 0x141, 0xF, 0xF, true));
    x += __builtin_bit_cast(float, __builtin_amdgcn_mov_dpp(__builtin_bit_cast(int, x), 0x140, 0xF, 0xF, true));
    return x;
}
__device__ __forceinline__ void rwkv_prep_item(const Params& p, unsigned char* lds, int it, int tid_in) {
    int tid = tid_in; asm volatile("" : "+v"(tid));
    const int lane = tid & 63, wv = __builtin_amdgcn_readfirstlane(tid >> 6);
    bf16* XS = (bf16*)lds;
    bf16* STG = (bf16*)(lds + 32768) + wv * 4096;
    float* MAB = (float*)(lds + 98304) + wv * 256;
    bf16* RKV = (bf16*)(lds + 106496) + wv * 3264;
    const bf16* PROJ = (const bf16*)(p.ws + WS_PROJ);
    const bf16* W2T = (const bf16*)(p.ws + WS_W2T); const bf16* A2T = (const bf16*)(p.ws + WS_A2T); const bf16* G2T = (const bf16*)(p.ws + WS_G2T);
    float* GAM = (float*)(p.ws + WS_GAM); float* C3 = (float*)(p.ws + WS_C3); bf16* GB = (bf16*)(p.ws + WS_G);
    const int row0 = it * 64, t0 = (it & 31) * 64, b = it >> 5;
    __syncthreads();
    {   const int xt = tid >> 5, xch = tid & 31;
        const f32x4 m0_ = *(const f32x4*)(p.mu + 1536 + 8 * xch), m1_ = *(const f32x4*)(p.mu + 1536 + 8 * xch + 4); const float sc_ = xch < 8 ? 2.f : -1.f;
        u32x4 xc[4], xp[4];
#pragma unroll
        for (int qq = 0; qq < 4; ++qq) { const int t = xt + 16 * qq; const bf16* src_ = PROJ + (size_t)(row0 + t) * NPROJ + PC_XW + 8 * xch; xc[qq] = *(const u32x4*)src_;
            xp[qq] = (u32x4){0u, 0u, 0u, 0u}; if (t0 + t != 0) xp[qq] = *(const u32x4*)(src_ - NPROJ); }
#pragma unroll
        for (int qq = 0; qq < 4; ++qq) { float o_[8];
#pragma unroll
            for (int i = 0; i < 4; ++i) { const float c0_ = bflo(xc[qq][i]), c1_ = bfhi(xc[qq][i]), p0_ = bflo(xp[qq][i]), p1_ = bfhi(xp[qq][i]);
                const float ma_ = i < 2 ? m0_[2 * i] : m1_[2 * i - 4], mb_ = i < 2 ? m0_[2 * i + 1] : m1_[2 * i - 3];
                const float v0_ = c0_ + ma_ * (p0_ - c0_), v1_ = c1_ + mb_ * (p1_ - c1_);
                const float r0_ = 1.f / (1.f + __expf(sc_ * v0_)), r1_ = 1.f / (1.f + __expf(sc_ * v1_));
                o_[2 * i] = xch < 8 ? 1.f - 2.f * r0_ : (xch < 16 ? v0_ : r0_); o_[2 * i + 1] = xch < 8 ? 1.f - 2.f * r1_ : (xch < 16 ? v1_ : r1_); }
            *(u32x4*)(XS + (xt + 16 * qq) * 256 + 8 * xch) = (u32x4){pk2(o_[0], o_[1]), pk2(o_[2], o_[3]), pk2(o_[4], o_[5]), pk2(o_[6], o_[7])}; }
    }
    u32x4 RK[7];
#define RKV_LOAD(rowb, tb) do { _Pragma("unroll") for (int i = 0; i < 7; ++i) { const int id_ = i * 64 + lane, mat_ = id_ / 136, rem_ = id_ - 136 * mat_, rw_ = rem_ >> 3, ch_ = rem_ & 7; \
        RK[i] = (u32x4){0u, 0u, 0u, 0u}; if (id_ < 408 && (tb) - 1 + rw_ >= 0) RK[i] = *(const u32x4*)(PROJ + (size_t)((rowb) - 1 + rw_) * NPROJ + PC_R + 512 * mat_ + wv * 64 + 8 * ch_); } } while (0)
#define RKV_WRITE() do { _Pragma("unroll") for (int i = 0; i < 7; ++i) { const int id_ = i * 64 + lane, mat_ = id_ / 136, rem_ = id_ - 136 * mat_, rw_ = rem_ >> 3, ch_ = rem_ & 7; \
        if (id_ < 408) *(u32x4*)(RKV + mat_ * 1088 + rw_ * 64 + 8 * ch_) = RK[i]; } } while (0)
    RKV_LOAD(row0, t0);
    __syncthreads();
#pragma unroll 1
    for (int q = 0; q < 4; ++q) {
        const int rowq = row0 + 16 * q, tq = t0 + 16 * q;
        int lane_ = lane; asm volatile("" : "+v"(lane_));
        const int n_ = lane_ & 15, grp_ = lane_ >> 4;
        const size_t idx = (size_t)(b * 8 + wv) * 128 + (tq >> 4);
        unsigned char* CHp = p.ws + WS_CH + idx * 12288;
        RKV_WRITE();
        if (q < 3) RKV_LOAD(rowq + 16, tq + 16);
        f32x4 dw[4], da[4];
        {   bf16x8 xa[8];
#pragma unroll
            for (int ks = 0; ks < 8; ++ks) xa[ks] = *(const bf16x8*)(XS + (16 * q + n_) * 256 + 32 * ks + 8 * grp_);
#pragma unroll
            for (int ct = 0; ct < 4; ++ct) { const int cc = wv * 64 + 16 * ct + n_;
                f32x4 dg = {0.f, 0.f, 0.f, 0.f}; dw[ct] = dg; da[ct] = dg;
#pragma unroll
                for (int ks = 0; ks < 2; ++ks) dw[ct] = mfma16(xa[ks], *(const bf16x8*)(W2T + cc * 64 + 32 * ks + 8 * grp_), dw[ct]);
#pragma unroll
                for (int ks = 0; ks < 2; ++ks) da[ct] = mfma16(xa[2 + ks], *(const bf16x8*)(A2T + cc * 64 + 32 * ks + 8 * grp_), da[ct]);
#pragma unroll
                for (int ks = 0; ks < 4; ++ks) dg = mfma16(xa[4 + ks], *(const bf16x8*)(G2T + cc * 128 + 32 * ks + 8 * grp_), dg);
#pragma unroll
                for (int rg = 0; rg < 4; ++rg) GB[(size_t)(rowq + 4 * grp_ + rg) * 512 + cc] = f2bf(dg[rg]); }
        }
        asm volatile("s_waitcnt lgkmcnt(0)" ::: "memory");
        {   float kkvA[4][4], kkaA[4][4], kprA[4][4], rA[4][4], vA[4][4], wA[4][4], nrm[4], c3s[4];
#pragma unroll
            for (int rg = 0; rg < 4; ++rg) { nrm[rg] = 0.f; c3s[rg] = 0.f; }
#pragma unroll
            for (int ct = 0; ct < 4; ++ct) { const int j = 16 * ct + n_, c = wv * 64 + j;
                const float mu_r = p.mu[c], mu_k = p.mu[512 + c], mu_v = p.mu[1024 + c], w0c = p.w0[c], a0c = p.a0[c], kkc = p.k_k[c], kac = p.k_a[c], rkc = p.r_k[c];
#pragma unroll
                for (int rg = 0; rg < 4; ++rg) { const int t = 4 * grp_ + rg;
                    const float rp = bf2f(RKV[t * 64 + j]), rc = bf2f(RKV[(t + 1) * 64 + j]);
                    const float kp = bf2f(RKV[1088 + t * 64 + j]), kc = bf2f(RKV[1088 + (t + 1) * 64 + j]);
                    const float vp = bf2f(RKV[2176 + t * 64 + j]), vc = bf2f(RKV[2176 + (t + 1) * 64 + j]);
                    const float r = rc + mu_r * (rp - rc), k = kc + mu_k * (kp - kc); vA[ct][rg] = vc + mu_v * (vp - vc); rA[ct][rg] = r;
                    const float u = w0c + dw[ct][rg]; const float wlog = -__logf(1.f + __expf(-u)) - 0.5f; wA[ct][rg] = __expf(-__expf(wlog));
                    const float a = 1.f / (1.f + __expf(-(a0c + da[ct][rg])));
                    const float kkv = k * kkc, kpr = k * (1.f + (a - 1.f) * kac); kkvA[ct][rg] = kkv; kkaA[ct][rg] = kkv * a; kprA[ct][rg] = kpr;
                    nrm[rg] += kkv * kkv; c3s[rg] += r * kpr * rkc; } }
            float inrm[4];
#pragma unroll
            for (int rg = 0; rg < 4; ++rg) { nrm[rg] = dpp_row_sum16(nrm[rg]); c3s[rg] = dpp_row_sum16(c3s[rg]); inrm[rg] = 1.f / fmaxf(sqrtf(nrm[rg]), 1e-12f); }
            if (n_ == 0) {
#pragma unroll
                for (int rg = 0; rg < 4; ++rg) C3[(size_t)(rowq + 4 * grp_ + rg) * 8 + wv] = c3s[rg]; }
#pragma unroll
            for (int ct = 0; ct < 4; ++ct) { const int j = 16 * ct + n_;
                float lp[4]; lp[0] = wA[ct][0]; lp[1] = lp[0] * wA[ct][1]; lp[2] = lp[1] * wA[ct][2]; lp[3] = lp[2] * wA[ct][3];
                const float P0 = __shfl(lp[3], n_), P1 = __shfl(lp[3], n_ + 16), P2 = __shfl(lp[3], n_ + 32);
                const float E = grp_ == 0 ? 1.f : (grp_ == 1 ? P0 : (grp_ == 2 ? P0 * P1 : P0 * P1 * P2));
                float bt[4], kt[4];
#pragma unroll
                for (int rg = 0; rg < 4; ++rg) { const int t = 4 * grp_ + rg;
                    const float gam = E * lp[rg], gprev = rg == 0 ? E : E * lp[rg - 1], ig = 1.f / gam;
                    STG[t * 64 + j] = f2bf(-kkvA[ct][rg] * inrm[rg] * gprev); STG[1024 + t * 64 + j] = f2bf(rA[ct][rg] * gam);
                    bt[rg] = kkaA[ct][rg] * inrm[rg] * ig; kt[rg] = kprA[ct][rg] * ig;
                    STG[2048 + t * 64 + j] = f2bf(bt[rg]); STG[3072 + t * 64 + j] = f2bf(kt[rg]); }
                *(u32x2*)(CHp + 4096 + j * 32 + grp_ * 8) = (u32x2){pk2(bt[0], bt[1]), pk2(bt[2], bt[3])};
                *(u32x2*)(CHp + 6144 + j * 32 + grp_ * 8) = (u32x2){pk2(kt[0], kt[1]), pk2(kt[2], kt[3])};
                *(u32x2*)(CHp + 8192 + j * 32 + grp_ * 8) = (u32x2){pk2(vA[ct][0], vA[ct][1]), pk2(vA[ct][2], vA[ct][3])};
                if (grp_ == 3) GAM[idx * 64 + j] = E * lp[3]; }
        }
        asm volatile("s_waitcnt lgkmcnt(0)" ::: "memory");
        {   f32x4 mab = {0.f, 0.f, 0.f, 0.f}, mak = mab, nrb = mab, nrk = mab;
#pragma unroll
            for (int ks = 0; ks < 4; ++ks) { const int o = n_ * 64 + 16 * ks + 4 * grp_;
                const s16x4 fa = *(const s16x4*)(STG + o), fr = *(const s16x4*)(STG + 1024 + o), fb = *(const s16x4*)(STG + 2048 + o), fk = *(const s16x4*)(STG + 3072 + o);
                mab = mfma16k(fa, fb, mab); mak = mfma16k(fa, fk, mak); nrb = mfma16k(fr, fb, nrb); nrk = mfma16k(fr, fk, nrk); }
            asm volatile("s_waitcnt lgkmcnt(0)" ::: "memory");
            bf16* SM = STG + 2048;
#pragma unroll
            for (int rg = 0; rg < 4; ++rg) { const int t = 4 * grp_ + rg; const bool sl = t > n_, il = t >= n_;
                MAB[t * 16 + n_] = sl ? mab[rg] : 0.f;
                SM[256 + t * 16 + n_] = f2bf(sl ? mak[rg] : 0.f); SM[512 + t * 16 + n_] = f2bf(il ? nrb[rg] : 0.f); SM[768 + t * 16 + n_] = f2bf(il ? nrk[rg] : 0.f); }
            asm volatile("s_waitcnt lgkmcnt(0)" ::: "memory");
            if (lane_ < 16) {
                float Tc[16];
#pragma unroll
                for (int t = 0; t < 16; ++t) { float acc = (t == lane_) ? 1.f : 0.f;
#pragma unroll
                    for (int s2 = 0; s2 < t; ++s2) acc = fmaf(MAB[t * 16 + s2], Tc[s2], acc);
                    Tc[t] = acc; SM[t * 16 + lane_] = f2bf(acc); }
            }
            asm volatile("s_waitcnt lgkmcnt(0)" ::: "memory");
#pragma unroll
            for (int i = 0; i < 4; ++i) { const int id = i * 64 + lane_; *(u32x4*)(CHp + id * 16) = *(const u32x4*)((const unsigned char*)STG + id * 16); }
#pragma unroll
            for (int i = 0; i < 2; ++i) { const int id = i * 64 + lane_; *(u32x4*)(CHp + 10240 + id * 16) = *(const u32x4*)((const unsigned char*)SM + id * 16); }
        }
    }
#undef RKV_LOAD
#undef RKV_WRITE
}

__device__ __forceinline__ void stage_w_lds(const bf16* W, unsigned char* lds, int log2_cpr  , int tid) {
    const int cpr = 1 << log2_cpr;
#pragma unroll 4
    for (int i = 0; i < 16; ++i) { const int id = i * 512 + tid, row = id >> log2_cpr, ch = id & (cpr - 1);
        *(u32x4*)(lds + ((size_t)row << (log2_cpr + 4)) + (((ch & ~15) | ((ch ^ row) & 15)) << 4)) = *(const u32x4*)((const unsigned char*)W + (size_t)id * 16); }
}
__device__ __forceinline__ bf16x8 lds_wfrag(const unsigned char* lds, int row, int ch, int log2_cpr) {
    return *(const bf16x8*)(lds + ((size_t)row << (log2_cpr + 4)) + (((ch & ~15) | ((ch ^ row) & 15)) << 4));
}
__device__ __forceinline__ void dsa_prep_kv(const Params& p, const unsigned char* wl, int tile, int lane) {
    const bf16* PROJ = (const bf16*)(p.ws + WS_PROJ); bf16* CKV = (bf16*)(p.ws + WS_CKV); float* INVR = (float*)(p.ws + WS_INVR);
    const int r = lane & 31, hh = lane >> 5; const size_t row = (size_t)tile * 32 + r; const bf16* prow = PROJ + row * NPROJ;
    bf16x8 cf[8];
    {   u32x4 craw[8]; float ssq = 0.f;
#pragma unroll
        for (int s = 0; s < 8; ++s) { craw[s] = *(const u32x4*)(prow + PC_CL + 16 * s + 8 * hh);
#pragma unroll
            for (int w = 0; w < 4; ++w) { const float lo = bflo(craw[s][w]), hi = bfhi(craw[s][w]); ssq += lo * lo + hi * hi; } }
        ssq += __shfl_xor(ssq, 32);
        const float rstd = rsqrtf(ssq * (1.f / 128.f) + 1e-6f);
#pragma unroll
        for (int s = 0; s < 8; ++s) { const float* g = p.g_kv + 16 * s + 8 * hh; const f32x4 g0 = *(const f32x4*)g, g1 = *(const f32x4*)(g + 4);
            u32x4 o; o.x = pk2(bflo(craw[s].x) * rstd * g0.x, bfhi(craw[s].x) * rstd * g0.y); o.y = pk2(bflo(craw[s].y) * rstd * g0.z, bfhi(craw[s].y) * rstd * g0.w);
            o.z = pk2(bflo(craw[s].z) * rstd * g1.x, bfhi(craw[s].z) * rstd * g1.y); o.w = pk2(bflo(craw[s].w) * rstd * g1.z, bfhi(craw[s].w) * rstd * g1.w);
            cf[s] = __builtin_bit_cast(bf16x8, o); *(u32x4*)(CKV + row * 128 + 16 * s + 8 * hh) = o; }
    }
    unsigned wb[8];
#pragma unroll
    for (int s = 0; s < 8; ++s) wb[s] = (unsigned)(r * 256 + ((((2 * s + hh) ^ r) & 15) << 4));
#pragma unroll 1
    for (int h = 0; h < 8; ++h) { float ss = 0.f;
#pragma unroll
        for (int dt = 0; dt < 2; ++dt) { f32x16 acc = {}; const unsigned char* wg = wl + (h * 64 + dt * 32) * 256;
#pragma unroll
            for (int s = 0; s < 8; ++s) acc = mfma32(*(const bf16x8*)(wg + wb[s]), cf[s], acc);
#pragma unroll
            for (int i = 0; i < 16; ++i) ss += acc[i] * acc[i]; }
        ss += __shfl_xor(ss, 32);
        if (hh == 0) INVR[row * 8 + h] = rsqrtf(ss * (1.f / 64.f) + 1e-6f);
    }
}
__device__ __forceinline__ void dsa_prep_q(const Params& p, const unsigned char* wl, int tile, int lane) {
    const bf16* PROJ = (const bf16*)(p.ws + WS_PROJ); bf16* QABS = (bf16*)(p.ws + WS_REGA);
    const int r = lane & 31, hh = lane >> 5; const size_t row = (size_t)tile * 32 + r; const bf16* prow = PROJ + row * NPROJ;
    unsigned wb[2][4];
#pragma unroll
    for (int hp = 0; hp < 2; ++hp)
#pragma unroll
        for (int s = 0; s < 4; ++s) wb[hp][s] = (unsigned)(r * 1024 + ((((hp * 8 + 2 * s + hh) ^ r) & 15) << 4));
#pragma unroll 2
    for (int h = 0; h < 8; ++h) {
        u32x4 qraw[4]; float ssq = 0.f;
#pragma unroll
        for (int s = 0; s < 4; ++s) { qraw[s] = *(const u32x4*)(prow + PC_Q + h * 64 + 16 * s + 8 * hh);
#pragma unroll
            for (int w = 0; w < 4; ++w) { const float lo = bflo(qraw[s][w]), hi = bfhi(qraw[s][w]); ssq += lo * lo + hi * hi; } }
        ssq += __shfl_xor(ssq, 32);
        const float rstd = rsqrtf(ssq * (1.f / 64.f) + 1e-6f);
        bf16x8 qf[4];
#pragma unroll
        for (int s = 0; s < 4; ++s) { const int d0 = 16 * s + 8 * hh; float gg[8];
#pragma unroll
            for (int j = 0; j < 8; ++j) gg[j] = p.g_q[d0 + j] * p.g_k[d0 + j] * rstd;
            u32x4 o; o.x = pk2(bflo(qraw[s].x) * gg[0], bfhi(qraw[s].x) * gg[1]); o.y = pk2(bflo(qraw[s].y) * gg[2], bfhi(qraw[s].y) * gg[3]);
            o.z = pk2(bflo(qraw[s].z) * gg[4], bfhi(qraw[s].z) * gg[5]); o.w = pk2(bflo(qraw[s].w) * gg[6], bfhi(qraw[s].w) * gg[7]);
            qf[s] = __builtin_bit_cast(bf16x8, o); }
#pragma unroll
        for (int lt = 0; lt < 4; ++lt) { f32x16 acc = {}; const unsigned char* wg = wl + lt * 32768 + (h >> 1) * 256;
#pragma unroll
            for (int s = 0; s < 4; ++s) acc = mfma32(*(const bf16x8*)(wg + wb[h & 1][s]), qf[s], acc);
#pragma unroll
            for (int g4 = 0; g4 < 4; ++g4) { u32x2 o; o.x = pk2(acc[4 * g4] * 0.125f, acc[4 * g4 + 1] * 0.125f); o.y = pk2(acc[4 * g4 + 2] * 0.125f, acc[4 * g4 + 3] * 0.125f);
                *(u32x2*)(QABS + row * 1024 + h * 128 + lt * 32 + 8 * g4 + 4 * hh) = o; } }
    }
}

constexpr int SCAN_D = 8, SCAN_SLOT = 12288 + 256;
#define SCAN_BAR() do { asm volatile("s_waitcnt lgkmcnt(0)" ::: "memory"); __builtin_amdgcn_s_barrier(); asm volatile("" ::: "memory"); } while (0)
__device__ __forceinline__ void rwkv_scan_chain(const Params& p, unsigned char* lds, int chain, int wv, int lane) {
    const int b = chain >> 3, h = chain & 7;
    const size_t idx0 = (size_t)(b * 8 + h) * 128;
    if (wv >= 4) {
        const int li = (wv - 4) * 64 + lane;
        const unsigned char* src = p.ws + WS_CH + idx0 * 12288 + (size_t)li * 16; const float* gsrc = (const float*)(p.ws + WS_GAM) + idx0 * 64 + (li & 15) * 4;
        u32x4 R[SCAN_D][3]; f32x4 Rg[SCAN_D];
#pragma unroll
        for (int j = 0; j < SCAN_D; ++j) {
#pragma unroll
            for (int i = 0; i < 3; ++i) R[j][i] = *(const u32x4*)(src + (size_t)j * 12288 + i * 4096);
            Rg[j] = *(const f32x4*)(gsrc + (size_t)j * 64); }
        for (int k0 = 0; k0 < 128; k0 += SCAN_D) {
#pragma unroll
            for (int j = 0; j < SCAN_D; ++j) { const int k = k0 + j; unsigned char* slot = lds + (k & 1) * SCAN_SLOT;
#pragma unroll
                for (int i = 0; i < 3; ++i) *(u32x4*)(slot + li * 16 + i * 4096) = R[j][i];
                *(f32x4*)(slot + 12288 + (li & 15) * 16) = Rg[j];
                if (k + SCAN_D < 128) {
#pragma unroll
                    for (int i = 0; i < 3; ++i) R[j][i] = *(const u32x4*)(src + (size_t)(k + SCAN_D) * 12288 + i * 4096);
                    Rg[j] = *(const f32x4*)(gsrc + (size_t)(k + SCAN_D) * 64); }
                SCAN_BAR(); } }
    } else {
        const int w = wv, n = lane & 15, grp = lane >> 4;
        bf16* PROJ = (bf16*)(p.ws + WS_PROJ);
        f32x4 S[4];
#pragma unroll
        for (int jt = 0; jt < 4; ++jt) S[jt] = (f32x4){0.f, 0.f, 0.f, 0.f};
        for (int sc = 0; sc < 128; ++sc) {
            SCAN_BAR();
            const unsigned char* CHp = lds + (sc & 1) * SCAN_SLOT;
            s16x4 at[4], rt[4], bt[4], kt[4]; f32x4 gm[4];
#pragma unroll
            for (int jt = 0; jt < 4; ++jt) {
                at[jt] = *(const s16x4*)(CHp + n * 128 + (16 * jt + 4 * grp) * 2); rt[jt] = *(const s16x4*)(CHp + 2048 + n * 128 + (16 * jt + 4 * grp) * 2);
                bt[jt] = *(const s16x4*)(CHp + 4096 + (16 * jt + n) * 32 + grp * 8); kt[jt] = *(const s16x4*)(CHp + 6144 + (16 * jt + n) * 32 + grp * 8);
                gm[jt] = *(const f32x4*)(CHp + 12288 + (16 * jt + 4 * grp) * 4); }
            const s16x4 vt = *(const s16x4*)(CHp + 8192 + (16 * w + n) * 32 + grp * 8);
            const s16x4 Tm = *(const s16x4*)(CHp + 10240 + n * 32 + grp * 8), Mak = *(const s16x4*)(CHp + 10752 + n * 32 + grp * 8);
            const s16x4 Nrb = *(const s16x4*)(CHp + 11264 + n * 32 + grp * 8), Nrk = *(const s16x4*)(CHp + 11776 + n * 32 + grp * 8);
            s16x4 Sb[4];
#pragma unroll
            for (int jt = 0; jt < 4; ++jt) Sb[jt] = pack4(S[jt]);
            f32x4 X = {0.f, 0.f, 0.f, 0.f}, O = X;
#pragma unroll
            for (int jt = 0; jt < 4; ++jt) X = mfma16k(at[jt], Sb[jt], X);
            X = mfma16k(Mak, vt, X);
#pragma unroll
            for (int jt = 0; jt < 4; ++jt) O = mfma16k(rt[jt], Sb[jt], O);
            O = mfma16k(Nrk, vt, O);
            const f32x4 U = mfma16k(Tm, pack4(X), (f32x4){0.f, 0.f, 0.f, 0.f});
            const s16x4 Ub = pack4(U);
            O = mfma16k(Nrb, Ub, O);
#pragma unroll
            for (int jt = 0; jt < 4; ++jt) { S[jt] = mfma16k(kt[jt], vt, S[jt]); S[jt] = mfma16k(bt[jt], Ub, S[jt]); S[jt] = S[jt] * gm[jt]; }
            bf16* orow = PROJ + ((size_t)b * SEQ + sc * 16 + 4 * grp) * NPROJ + PC_R + h * 64 + 16 * w + n;
#pragma unroll
            for (int rg = 0; rg < 4; ++rg) orow[(size_t)rg * NPROJ] = f2bf(O[rg]);
        }
    }
}
__device__ __forceinline__ void rwkv_epi_rows(const Params& p, int gw, int NGW, int lane) {
    bf16* PROJ = (bf16*)(p.ws + WS_PROJ); const bf16* GB = (const bf16*)(p.ws + WS_G); const float* C3 = (const float*)(p.ws + WS_C3);
    const int c0 = lane * 8, h = lane >> 3, RPW = M / NGW;
    float muv[8], lw[8], lb[8];
#pragma unroll
    for (int i = 0; i < 8; ++i) { muv[i] = p.mu[1024 + c0 + i]; lw[i] = p.ln_w[c0 + i]; lb[i] = p.ln_b[c0 + i]; }
    for (int m0 = gw * RPW; m0 < M; m0 += NGW * RPW) {
        u32x4 vprev = {0u, 0u, 0u, 0u}; if ((m0 & (SEQ - 1)) != 0) vprev = *(const u32x4*)(PROJ + (size_t)(m0 - 1) * NPROJ + PC_V + c0);
        for (int r0 = 0; r0 < RPW; r0 += 4) {
            u32x4 oraw[4], vc[4], gr[4]; float c3[4];
#pragma unroll
            for (int r = 0; r < 4; ++r) { const size_t m = (size_t)(m0 + r0 + r); const bf16* prow = PROJ + m * NPROJ;
                oraw[r] = *(const u32x4*)(prow + PC_R + c0); vc[r] = *(const u32x4*)(prow + PC_V + c0); gr[r] = *(const u32x4*)(GB + m * 512 + c0); c3[r] = C3[m * 8 + h]; }
            float o[4][8], sm[4], q[4];
#pragma unroll
            for (int r = 0; r < 4; ++r) { sm[r] = 0.f;
#pragma unroll
                for (int i = 0; i < 4; ++i) { o[r][2 * i] = bflo(oraw[r][i]); o[r][2 * i + 1] = bfhi(oraw[r][i]); sm[r] += o[r][2 * i] + o[r][2 * i + 1]; } }
#pragma unroll
            for (int of = 1; of < 8; of <<= 1) {
#pragma unroll
                for (int r = 0; r < 4; ++r) sm[r] += __shfl_xor(sm[r], of); }
#pragma unroll
            for (int r = 0; r < 4; ++r) { const float mean = sm[r] * (1.f / 64.f); q[r] = 0.f;
#pragma unroll
                for (int i = 0; i < 8; ++i) { o[r][i] -= mean; q[r] += o[r][i] * o[r][i]; } }
#pragma unroll
            for (int of = 1; of < 8; of <<= 1) {
#pragma unroll
                for (int r = 0; r < 4; ++r) q[r] += __shfl_xor(q[r], of); }
#pragma unroll
            for (int r = 0; r < 4; ++r) { const float rstd = rsqrtf(q[r] * (1.f / 64.f) + 64e-5f); const u32x4 vp = r == 0 ? vprev : vc[r - 1];
                const bool first = ((m0 + r0 + r) & (SEQ - 1)) == 0;
                u32x4 out;
#pragma unroll
                for (int i = 0; i < 4; ++i) { float y[2];
#pragma unroll
                    for (int e = 0; e < 2; ++e) { const int ii = 2 * i + e; const float cv = e ? bfhi(vc[r][i]) : bflo(vc[r][i]), pv = first ? 0.f : (e ? bfhi(vp[i]) : bflo(vp[i]));
                        const float v = cv + muv[ii] * (pv - cv), g = e ? bfhi(gr[r][i]) : bflo(gr[r][i]);
                        y[e] = (o[r][ii] * rstd * lw[ii] + lb[ii] + c3[r] * v) * g; }
                    out[i] = pk2(y[0], y[1]); }
                *(u32x4*)(PROJ + (size_t)(m0 + r0 + r) * NPROJ + PC_R + c0) = out; }
            vprev = vc[3];
        }
    }
}

__device__ __forceinline__ unsigned f2key(float f) { unsigned b = __float_as_uint(f); if ((b << 1) == 0u) b = 0u; return (b & 0x80000000u) ? ~b : (b | 0x80000000u); }
__device__ __forceinline__ unsigned offb(unsigned row, unsigned ch) { return 2048u * (row >> 3) + 512u * (ch >> 2) + 64u * (row & 7) + 16u * ((ch & 3) ^ ((row >> 2) & 3)); }

__device__ __forceinline__ void topk_select(float* sc, int N, unsigned* hist, unsigned short* sel, int lane) {
    unsigned* kb = (unsigned*)sc;
    unsigned prefix = 0u, mask = 0u; int rem = 256, mbin = 0;
    const unsigned long long lt_mask = (1ull << lane) - 1ull;
    for (int pass = 0; pass < 4; ++pass) {
        const int shift = 24 - 8 * pass;
#pragma unroll
        for (int i = 0; i < 4; ++i) hist[lane * 4 + i] = 0u;
        asm volatile("s_waitcnt lgkmcnt(0)" ::: "memory");
        for (int base = 0; base < N; base += 256) { const int idx = base + 4 * lane;
            if (idx < N) { u32x4 k4;
                if (pass == 0) { const f32x4 v = *(const f32x4*)(sc + idx); k4 = (u32x4){f2key(v.x), f2key(v.y), f2key(v.z), f2key(v.w)}; *(u32x4*)(kb + idx) = k4; }
                else k4 = *(const u32x4*)(kb + idx);
#pragma unroll
                for (int e = 0; e < 4; ++e) if ((k4[e] & mask) == prefix) atomicAdd(&hist[(k4[e] >> shift) & 255u], 1u); } }
        asm volatile("s_waitcnt lgkmcnt(0)" ::: "memory");
        const unsigned c0 = hist[lane * 4], c1 = hist[lane * 4 + 1], c2 = hist[lane * 4 + 2], c3 = hist[lane * 4 + 3];
        const int cnt4 = (int)(c0 + c1 + c2 + c3);
        int incl = cnt4;
#pragma unroll
        for (int o = 1; o < 64; o <<= 1) { const int v = __shfl_down(incl, o); if (lane + o < 64) incl += v; }
        const int excl = incl - cnt4;
        const bool mine = (excl < rem) && (rem <= incl);
        const unsigned long long bal = __ballot(mine);
        const int L = (int)__builtin_ctzll(bal);
        const int ex = __shfl(excl, L); const int b3 = (int)__shfl((int)c3, L), b2 = (int)__shfl((int)c2, L), b1 = (int)__shfl((int)c1, L), b0 = (int)__shfl((int)c0, L);
        int above = ex, bin;
        if (above + b3 >= rem) { bin = 3; mbin = b3; } else { above += b3; if (above + b2 >= rem) { bin = 2; mbin = b2; } else { above += b2; if (above + b1 >= rem) { bin = 1; mbin = b1; } else { above += b1; bin = 0; mbin = b0; } } }
        rem -= above; prefix |= (unsigned)(L * 4 + bin) << shift; mask |= 0xffu << shift;
        if (pass == 1 && mbin <= 64) break;
    }
    const unsigned T = prefix; const int ngt = 256 - rem; int base_gt = 0, base_eq = 0;
    const bool partial = (mask != 0xffffffffu);
    unsigned short* cand = (unsigned short*)hist;
    for (int base = 0; base < N; base += 256) { const int idx = base + 4 * lane; const bool act = idx < N;
        u32x4 k4 = {0u, 0u, 0u, 0u}; if (act) k4 = *(const u32x4*)(kb + idx);
        bool gt[4], eq[4]; unsigned long long bg[4], be[4];
#pragma unroll
        for (int e = 0; e < 4; ++e) { const unsigned km = k4[e] & mask; gt[e] = act && km > T; eq[e] = act && km == T; bg[e] = __ballot(gt[e]); be[e] = __ballot(eq[e]); }
        int rg = base_gt, re = base_eq;
#pragma unroll
        for (int e = 0; e < 4; ++e) re += __popcll(be[e] & lt_mask);
#pragma unroll
        for (int e = 0; e < 4; ++e) {
            if (gt[e]) sel[rg + __popcll(bg[e] & lt_mask)] = (unsigned short)(idx + e);
            rg += __popcll(bg[e]);
            if (eq[e]) { if (partial) cand[re] = (unsigned short)(idx + e); else if (re < rem) sel[ngt + re] = (unsigned short)(idx + e); re += 1; } }
        base_gt = rg;
#pragma unroll
        for (int e = 0; e < 4; ++e) base_eq += __popcll(be[e]); }
    asm volatile("s_waitcnt lgkmcnt(0)" ::: "memory");
    if (partial) {
        const int m = mbin; const int ci = (lane < m) ? (int)cand[lane] : 0; const unsigned ck = (lane < m) ? kb[ci] : 0u;
        int rank = 0;
        for (int j = 0; j < m; ++j) { const unsigned kj = (unsigned)__shfl((int)ck, j); rank += (kj > ck || (kj == ck && j < lane)) ? 1 : 0; }
        if (lane < m && rank < rem) sel[ngt + rank] = (unsigned short)ci;
        asm volatile("s_waitcnt lgkmcnt(0)" ::: "memory");
    }
}

__device__ __forceinline__ float dpp_row_max16(float x) {
    x = fmaxf(x, __builtin_bit_cast(float, __builtin_amdgcn_mov_dpp(__builtin_bit_cast(int, x), 0xB1, 0xF, 0xF, true)));
    x = fmaxf(x, __builtin_bit_cast(float, __builtin_amdgcn_mov_dpp(__builtin_bit_cast(int, x), 0x4E, 0xF, 0xF, true)));
    x = fmaxf(x, __builtin_bit_cast(float, __builtin_amdgcn_mov_dpp(__builtin_bit_cast(int, x), 0x141, 0xF, 0xF, true)));
    x = fmaxf(x, __builtin_bit_cast(float, __builtin_amdgcn_mov_dpp(__builtin_bit_cast(int, x), 0x140, 0xF, 0xF, true)));
    return x;
}
__device__ __forceinline__ bool topk_select_fast(const float* sc, int N, float smax, unsigned* hist, unsigned short* sel, int lane) {
    const float scale = smax > 0.f ? 127.5f / smax : 0.f;
#define QBIN(x_) min(max((int)fmaf((x_), scale, 128.f), 0), 255)
#pragma unroll
    for (int i = 0; i < 4; ++i) hist[lane * 4 + i] = 0u;
    asm volatile("s_waitcnt lgkmcnt(0)" ::: "memory");
    for (int base = 0; base < N; base += 256) { const int idx = base + 4 * lane;
        if (idx < N) { const f32x4 v = *(const f32x4*)(sc + idx);
#pragma unroll
            for (int e = 0; e < 4; ++e) atomicAdd(&hist[QBIN(v[e])], 1u); } }
    asm volatile("s_waitcnt lgkmcnt(0)" ::: "memory");
    const unsigned c0 = hist[lane * 4], c1 = hist[lane * 4 + 1], c2 = hist[lane * 4 + 2], c3 = hist[lane * 4 + 3];
    const int cnt4 = (int)(c0 + c1 + c2 + c3);
    int incl = cnt4;
#pragma unroll
    for (int o = 1; o < 64; o <<= 1) { const int v = __shfl_down(incl, o); if (lane + o < 64) incl += v; }
    const int excl = incl - cnt4;
    const bool mine = (excl < 256) && (256 <= incl);
    const int L = (int)__builtin_ctzll(__ballot(mine));
    const int ex = __shfl(excl, L); const int b3 = (int)__shfl((int)c3, L), b2 = (int)__shfl((int)c2, L), b1 = (int)__shfl((int)c1, L), b0 = (int)__shfl((int)c0, L);
    int above = ex, bin, mbin;
    if (above + b3 >= 256) { bin = 3; mbin = b3; } else { above += b3; if (above + b2 >= 256) { bin = 2; mbin = b2; } else { above += b2; if (above + b1 >= 256) { bin = 1; mbin = b1; } else { above += b1; bin = 0; mbin = b0; } } }
    if (mbin > 64) return false;
    const int tb = L * 4 + bin, rem = 256 - above, ngt = above; int base_gt = 0, base_eq = 0;
    const unsigned long long lt_mask = (1ull << lane) - 1ull;
    unsigned short* cand = (unsigned short*)hist;
    for (int base = 0; base < N; base += 256) { const int idx = base + 4 * lane; const bool act = idx < N;
        f32x4 v = {0.f, 0.f, 0.f, 0.f}; if (act) v = *(const f32x4*)(sc + idx);
        bool gt[4], eq[4]; unsigned long long bg[4], be[4];
#pragma unroll
        for (int e = 0; e < 4; ++e) { const int qb = QBIN(v[e]); gt[e] = act && qb > tb; eq[e] = act && qb == tb; bg[e] = __ballot(gt[e]); be[e] = __ballot(eq[e]); }
        int rg = base_gt, re = base_eq;
#pragma unroll
        for (int e = 0; e < 4; ++e) re += __popcll(be[e] & lt_mask);
#pragma unroll
        for (int e = 0; e < 4; ++e) {
            if (gt[e]) sel[rg + __popcll(bg[e] & lt_mask)] = (unsigned short)(idx + e);
            rg += __popcll(bg[e]);
            if (eq[e]) { cand[re] = (unsigned short)(idx + e); re += 1; } }
        base_gt = rg;
#pragma unroll
        for (int e = 0; e < 4; ++e) base_eq += __popcll(be[e]); }
    asm volatile("s_waitcnt lgkmcnt(0)" ::: "memory");
    {   const int m = mbin; const int ci = (lane < m) ? (int)cand[lane] : 0; const unsigned ck = (lane < m) ? f2key(sc[ci]) : 0u;
        int rank = 0;
        for (int j = 0; j < m; ++j) { const unsigned kj = (unsigned)__shfl((int)ck, j); rank += (kj > ck || (kj == ck && j < lane)) ? 1 : 0; }
        if (lane < m && rank < rem) sel[ngt + rank] = (unsigned short)ci;
        asm volatile("s_waitcnt lgkmcnt(0)" ::: "memory"); }
#undef QBIN
    return true;
}

__device__ __forceinline__ void dsa_attend(const Params& p, int b, int t, const unsigned short* sel, int cnt, unsigned char* stage, int lane_in) {
    int lane = lane_in; asm volatile("" : "+v"(lane));
    const bf16* CKV = (const bf16*)(p.ws + WS_CKV) + (size_t)b * SEQ * 128; const float* INVR = (const float*)(p.ws + WS_INVR) + (size_t)b * SEQ * 8;
    bf16* QO = (bf16*)(p.ws + WS_REGA) + ((size_t)b * SEQ + t) * 1024;
    const int hd = lane & 15, grp = lane >> 4;
    bf16x8 bq[4];
#pragma unroll
    for (int s = 0; s < 4; ++s) { u32x4 z = {0u, 0u, 0u, 0u}; if (hd < 8) z = *(const u32x4*)(QO + hd * 128 + 32 * s + 8 * grp); bq[s] = __builtin_bit_cast(bf16x8, z); }
    const float slope = (hd < 8) ? exp2f(-(float)(hd + 1)) : 0.f;
    const int hsafe = hd & 7;
    float m_run = -INFINITY, l_part = 0.f;
    f32x4 O[8];
#pragma unroll
    for (int c = 0; c < 8; ++c) O[c] = (f32x4){0.f, 0.f, 0.f, 0.f};
    const LAS unsigned char* st3 = (const LAS unsigned char*)stage;
    const unsigned q4 = (lane & 15) >> 2, p4 = lane & 3;
    u32x4 G[8]; float IRn[8], PNn[8];
#define DA_ISSUE(ks_) do { \
    _Pragma("unroll") for (int i = 0; i < 8; ++i) { const int id = i * 64 + lane, row = id >> 4, ch = id & 15; const unsigned key = sel[(ks_) + row]; G[i] = *(const u32x4*)((const unsigned char*)CKV + (key * 256u + (unsigned)ch * 16u)); } } while (0)
#define DA_ISSUE2(ks_) do { \
    _Pragma("unroll") for (int i = 0; i < 8; ++i) { const int key = sel[(ks_) + 16 * (i >> 2) + 4 * grp + (i & 3)]; IRn[i] = *(const float*)((const unsigned char*)INVR + ((unsigned)key * 32u + (unsigned)hsafe * 4u)); PNn[i] = slope * fabsf((float)(t - key)); } } while (0)
    DA_ISSUE(cnt - 32); DA_ISSUE2(cnt - 32);
    for (int ks = cnt - 32; ks >= 0; ks -= 32) {
#pragma unroll
        for (int i = 0; i < 8; ++i) { const int id = i * 64 + lane, row = id >> 4, ch = id & 15; *(u32x4*)(stage + offb(row, ch)) = G[i]; }
        asm volatile("s_waitcnt lgkmcnt(0)" ::: "memory");
        if (ks >= 32) DA_ISSUE(ks - 32);
        float lg[8];
#pragma unroll
        for (int T = 0; T < 2; ++T) { f32x4 acc = {0.f, 0.f, 0.f, 0.f};
#pragma unroll
            for (int s = 0; s < 4; ++s) { const bf16x8 a = *(const bf16x8*)(stage + offb((lane & 15) + 16 * T, 4 * s + grp)); acc = mfma16(a, bq[s], acc); }
#pragma unroll
            for (int rg = 0; rg < 4; ++rg) lg[4 * T + rg] = acc[rg] * IRn[4 * T + rg] - PNn[4 * T + rg]; }
        if (ks >= 32) DA_ISSUE2(ks - 32);
        float mx = lg[0];
#pragma unroll
        for (int i = 1; i < 8; ++i) mx = fmaxf(mx, lg[i]);
        mx = fmaxf(mx, __shfl_xor(mx, 16)); mx = fmaxf(mx, __shfl_xor(mx, 32));
        const float m_new = fmaxf(m_run, mx);
        const float alpha = __expf(m_run - m_new);
        float ps = 0.f;
#pragma unroll
        for (int i = 0; i < 8; ++i) { lg[i] = __expf(lg[i] - m_new); ps += lg[i]; }
        l_part = l_part * alpha + ps; m_run = m_new;
        { float ar[4];
#pragma unroll
            for (int rg = 0; rg < 4; ++rg) ar[rg] = __shfl(alpha, 4 * grp + rg);
#pragma unroll
            for (int c = 0; c < 8; ++c)
#pragma unroll
                for (int rg = 0; rg < 4; ++rg) O[c][rg] *= ar[rg]; }
        {   u32x4 pw; pw.x = pk2(lg[0], lg[1]); pw.y = pk2(lg[2], lg[3]); pw.z = pk2(lg[4], lg[5]); pw.w = pk2(lg[6], lg[7]);
            const bf16x8 pa = __builtin_bit_cast(bf16x8, pw);
#pragma unroll
            for (int c = 0; c < 8; ++c) {
                const s16x4 lo = __builtin_bit_cast(s16x4, __builtin_amdgcn_ds_read_tr16_b64_v4i16((LAS s16x4*)(st3 + offb(4 * grp + q4, 2 * c + (p4 >> 1)) + 8 * (p4 & 1))));
                const s16x4 hi = __builtin_bit_cast(s16x4, __builtin_amdgcn_ds_read_tr16_b64_v4i16((LAS s16x4*)(st3 + offb(16 + 4 * grp + q4, 2 * c + (p4 >> 1)) + 8 * (p4 & 1))));
                const bf16x8 vb = {lo[0], lo[1], lo[2], lo[3], hi[0], hi[1], hi[2], hi[3]};
                O[c] = mfma16(pa, vb, O[c]); } }
        asm volatile("s_waitcnt lgkmcnt(0)" ::: "memory");
    }
#undef DA_ISSUE
#undef DA_ISSUE2
    float l = l_part; l += __shfl_xor(l, 16); l += __shfl_xor(l, 32);
    const float il = 1.f / l;
    float irr[4];
#pragma unroll
    for (int rg = 0; rg < 4; ++rg) irr[rg] = __shfl(il, 4 * grp + rg);
    if (grp < 2) {
#pragma unroll
        for (int rg = 0; rg < 4; ++rg)
#pragma unroll
            for (int c = 0; c < 8; ++c) QO[(4 * grp + rg) * 128 + 16 * c + hd] = f2bf(O[c][rg] * irr[rg]);
    }
}

#define DSA_LOAD_AF(af_, wqv_, b_, tq0_) do { const size_t rq_ = (size_t)(b_) * SEQ + (tq0_); const int r_ = lane & 31, g_ = lane >> 5, ql_ = 2 * ((r_ >> 2) & 1) + (r_ >> 4), hdm_ = 4 * ((r_ >> 3) & 1) + (r_ & 3); \
    _Pragma("unroll") for (int qg = 0; qg < 4; ++qg) _Pragma("unroll") for (int s = 0; s < 4; ++s) af_[qg][s] = *(const bf16x8*)(PROJ + (rq_ + 4 * qg + ql_) * NPROJ + PC_QI + hdm_ * 64 + 16 * s + 8 * g_); \
    wqv_ = (tid < 128) ? bf2f(PROJ[(rq_ + (tid >> 3)) * NPROJ + PC_WI + (tid & 7)]) * 0.044194173824159216f : 0.f; } while (0)
__device__ __forceinline__ void dsa_select_item(const Params& p, unsigned char* lds, int b, int tq0, int tid, bf16x8 (&af)[4][4], float& wqv, bool has_next, int nb, int ntq0) {
    bf16* PROJ = (bf16*)(p.ws + WS_PROJ);
    float* SC = (float*)lds;
    unsigned* HIST = (unsigned*)(lds + 131072);
    unsigned short* SEL = (unsigned short*)(lds + 131072 + 8192);
    float* WQ = (float*)(lds + 147456);
    unsigned* QMAX = (unsigned*)(lds + 147456 + 512);
    asm volatile("" : "+v"(tid));
    const int lane = tid & 63, wv = __builtin_amdgcn_readfirstlane(tid >> 6);
    const int N = ((tq0 >> 6) + 1) * 64; const size_t rowq0 = (size_t)b * SEQ + tq0;
    {
        const int r = lane & 31, g = lane >> 5;
        if (tid < 128) WQ[tid] = wqv;
        if (tid < 16) QMAX[tid] = 0u;
        float mxq[4][2];
#pragma unroll
        for (int qg = 0; qg < 4; ++qg) { mxq[qg][0] = 0.f; mxq[qg][1] = 0.f; }
        __syncthreads();
        bf16x8 bfr[4];
        { const bf16* krow = PROJ + ((size_t)b * SEQ + wv * 32 + r) * NPROJ + PC_KI + 8 * g;
#pragma unroll
          for (int s = 0; s < 4; ++s) bfr[s] = *(const bf16x8*)(krow + 16 * s); }
        for (int kt = wv; kt < N / 32; kt += NWAVES) {
            const int key = kt * 32 + r;
            bf16x8 bnx[4];
#pragma unroll
            for (int s = 0; s < 4; ++s) bnx[s] = bfr[s];
            if (kt + NWAVES < N / 32) { const bf16* krow = PROJ + ((size_t)b * SEQ + key + 32 * NWAVES) * NPROJ + PC_KI + 8 * g;
#pragma unroll
                for (int s = 0; s < 4; ++s) bnx[s] = *(const bf16x8*)(krow + 16 * s); }
#pragma unroll
            for (int qg = 0; qg < 4; ++qg) { f32x16 acc = {};
#pragma unroll
                for (int s = 0; s < 4; ++s) acc = mfma32(af[qg][s], bfr[s], acc);
#pragma unroll
                for (int qq = 0; qq < 2; ++qq) { float sc = 0.f; const f32x4 w0 = *(const f32x4*)(WQ + (4 * qg + 2 * g + qq) * 8), w1 = *(const f32x4*)(WQ + (4 * qg + 2 * g + qq) * 8 + 4);
#pragma unroll
                    for (int e = 0; e < 4; ++e) { sc = fmaf(w0[e], fmaxf(acc[8 * qq + e], 0.f), sc); sc = fmaf(w1[e], fmaxf(acc[8 * qq + 4 + e], 0.f), sc); }
                    SC[(4 * qg + 2 * g + qq) * 2048 + key] = sc; mxq[qg][qq] = fmaxf(mxq[qg][qq], fabsf(sc)); } }
#pragma unroll
            for (int s = 0; s < 4; ++s) bfr[s] = bnx[s];
        }
#pragma unroll
        for (int qg = 0; qg < 4; ++qg)
#pragma unroll
            for (int qq = 0; qq < 2; ++qq) { float m = dpp_row_max16(mxq[qg][qq]); m = fmaxf(m, __shfl_xor(m, 16));
                if (r == 0) atomicMax(&QMAX[4 * qg + 2 * g + qq], __float_as_uint(m)); }
        __syncthreads();
        if (has_next) DSA_LOAD_AF(af, wqv, nb, ntq0);
        bool fb[2];
        for (int q = 0; q < 2; ++q) fb[q] = !topk_select_fast(SC + (2 * wv + q) * 2048, N, __uint_as_float(QMAX[2 * wv + q]), HIST + wv * 256, SEL + (2 * wv + q) * 256, lane);
        for (int q = 0; q < 2; ++q) if (fb[q]) topk_select(SC + (2 * wv + q) * 2048, N, HIST + wv * 256, SEL + (2 * wv + q) * 256, lane);
    }
    asm volatile("s_waitcnt lgkmcnt(0)" ::: "memory");
    { const int q = lane >> 5; const u32x4 v = *(const u32x4*)(SEL + (2 * wv + q) * 256 + (lane & 31) * 8);
      *(u32x4*)(PROJ + (rowq0 + 2 * wv + q) * NPROJ + PC_Q + (lane & 31) * 8) = v; }
    __syncthreads();
}

__device__ __forceinline__ void dsa_attend_row(const Params& p, unsigned char* wlds, int row, int lane) {
    const bf16* PROJ = (const bf16*)(p.ws + WS_PROJ);
    const int b = row >> 11, t = row & (SEQ - 1), N = ((t >> 6) + 1) * 64, cnt = N > 256 ? 256 : N;
    unsigned short* SELW = (unsigned short*)(wlds + 8192);
    if (N > 256) { if (lane < 32) *(u32x4*)(SELW + lane * 8) = *(const u32x4*)(PROJ + (size_t)row * NPROJ + PC_Q + lane * 8); }
    else { for (int i = lane; i < cnt; i += 64) SELW[i] = (unsigned short)i; }
    asm volatile("s_waitcnt vmcnt(0) lgkmcnt(0)" ::: "memory");
    dsa_attend(p, b, t, SELW, cnt, wlds, lane);
    asm volatile("s_waitcnt lgkmcnt(0)" ::: "memory");
}

__device__ __forceinline__ void uv_item(const Params& p, const unsigned char* wl  , int tile, int lane) {
    bf16* PROJ = (bf16*)(p.ws + WS_PROJ); const bf16* OLAT = (const bf16*)(p.ws + WS_REGA);
    const int r = lane & 31, hh = lane >> 5; const size_t row = (size_t)tile * 32 + r;
    unsigned wb[8];
#pragma unroll
    for (int s = 0; s < 8; ++s) wb[s] = (unsigned)(r * 256 + ((((2 * s + hh) ^ r) & 15) << 4));
#pragma unroll 1
    for (int h = 0; h < 8; ++h) { bf16x8 of[8];
#pragma unroll
        for (int s = 0; s < 8; ++s) of[s] = *(const bf16x8*)(OLAT + row * 1024 + h * 128 + 16 * s + 8 * hh);
#pragma unroll
        for (int dt = 0; dt < 2; ++dt) { f32x16 acc = {}; const unsigned char* wg = wl + (h * 64 + dt * 32) * 256;
#pragma unroll
            for (int s = 0; s < 8; ++s) acc = mfma32(*(const bf16x8*)(wg + wb[s]), of[s], acc);
#pragma unroll
            for (int g4 = 0; g4 < 4; ++g4) { u32x2 o; o.x = pk2(acc[4 * g4], acc[4 * g4 + 1]); o.y = pk2(acc[4 * g4 + 2], acc[4 * g4 + 3]);
                *(u32x2*)(PROJ + row * NPROJ + PC_Q + h * 64 + dt * 32 + 8 * g4 + 4 * hh) = o; } }
    }
}

__device__ __forceinline__ void bias2_item(const Params& p, int item, int lane) {
    const bf16* W1T = (const bf16*)(p.ws + WS_W1); const float* MOD = (const float*)(p.ws + WS_MOD); float* BIAS2 = (float*)(p.ws + WS_BIAS2);
    const int r = lane & 31, hh = lane >> 5, f0 = item * 32;
    const bf16* wrow = W1T + (size_t)(f0 + r) * DM + 8 * hh; const float* srow = MOD + (size_t)r * 6144 + 3072 + 8 * hh;
    f32x16 acc = {};
#pragma unroll 8
    for (int s = 0; s < 64; ++s) { const bf16x8 a = *(const bf16x8*)(wrow + 16 * s); const f32x4 s0 = *(const f32x4*)(srow + 16 * s), s1 = *(const f32x4*)(srow + 16 * s + 4);
        const u32x4 bw = {pk2(s0.x, s0.y), pk2(s0.z, s0.w), pk2(s1.x, s1.y), pk2(s1.z, s1.w)};
        acc = mfma32(a, __builtin_bit_cast(bf16x8, bw), acc); }
#pragma unroll
    for (int i = 0; i < 16; ++i) BIAS2[(size_t)r * 4096 + f0 + (i & 3) + 8 * (i >> 2) + 4 * hh] = acc[i];
}

typedef __attribute__((address_space(1))) unsigned gu32;
#define RLX_AGENT __ATOMIC_RELAXED, __HIP_MEMORY_SCOPE_AGENT
#define XB_TMO      128
#define XB_XCNT(j)  (256  + 64 * (j))
#define XB_XSUB(j)  (1280 + 64 * (j))
#define XB_XGEN(j)  (2304 + 64 * (j))
#define XB_TOP      3328
#define XB_TOPGEN   3392
#define XCD_BAR_WORDS 3456
#define XB_SPIN_CAP (1u << 18)

__device__ __forceinline__ unsigned xb_ld(unsigned* p)              { return __hip_atomic_load(p, __ATOMIC_RELAXED, __HIP_MEMORY_SCOPE_AGENT); }
__device__ __forceinline__ unsigned xb_add(unsigned* p, unsigned v) { return __hip_atomic_fetch_add(p, v, __ATOMIC_RELAXED, __HIP_MEMORY_SCOPE_AGENT); }
__device__ __forceinline__ unsigned xb_xcc_id() { return (unsigned)__builtin_amdgcn_s_getreg((3 << 11) | 20) & 0xFu; }
#define XB_SPIN(cond, bar) do { unsigned _sp = 0; while (cond) { __builtin_amdgcn_s_sleep(1); \
    if ((++_sp & 255u) == 0u) { if (xb_ld(&(bar)[XB_TMO])) break; if (_sp > XB_SPIN_CAP) { atomicAdd(&(bar)[XB_TMO], 1u); break; } } } } while (0)

struct XcdBarrier {
    unsigned* bar; unsigned x;
    volatile LAS unsigned* st;
};

__device__ __forceinline__ XcdBarrier xcd_barrier_post(unsigned* bar, volatile LAS unsigned* st) {
    XcdBarrier b; b.bar = bar; b.x = xb_xcc_id(); b.st = st;
    if (threadIdx.x == 0) (void)xb_add(&bar[XB_XCNT(b.x)], 1u);
    return b;
}
__device__ __forceinline__ void xcd_barrier_complete(unsigned* bar, unsigned x, unsigned& nloc, unsigned& nx) {
    const unsigned G = gridDim.x * gridDim.y * gridDim.z;
    unsigned sum, cnt, mine, sp = 0u;
    for (;;) {
        sum = 0u; cnt = 0u; mine = 0u;
#pragma unroll
        for (unsigned j = 0; j < 16; ++j) { const unsigned c = xb_ld(&bar[XB_XCNT(j)]); sum += c; cnt += (c > 0u) ? 1u : 0u; mine = (j == x) ? c : mine; }
        if (sum == G) break;
        __builtin_amdgcn_s_sleep(1);
        if ((++sp & 255u) == 0u) { if (xb_ld(&bar[XB_TMO])) break; if (sp > XB_SPIN_CAP) { atomicAdd(&bar[XB_TMO], 1u); break; } }
    }
    nloc = mine > 0u ? mine : 1u; nx = cnt > 0u ? cnt : 1u;
}

__device__ __forceinline__ void xcd_barrier(const XcdBarrier& b) {
    asm volatile("s_waitcnt vmcnt(0)" ::: "memory");
    __syncthreads();
    if (threadIdx.x == 0) {
        unsigned* bar = b.bar;
        __builtin_amdgcn_s_waitcnt(0);
        unsigned nloc = b.st[0], nx = b.st[1];
        if (nloc == 0u) { xcd_barrier_complete(bar, b.x, nloc, nx); b.st[0] = nloc; b.st[1] = nx; }
        const unsigned old = xb_add(&bar[XB_XSUB(b.x)], 1u);
        const unsigned gen = old / nloc;
        if (old + 1u == (gen + 1u) * nloc) {
            __builtin_amdgcn_fence(__ATOMIC_RELEASE, "agent");
            asm volatile("s_waitcnt vmcnt(0)" ::: "memory");
            const unsigned og = xb_add(&bar[XB_TOP], 1u);
            const unsigned tg = og / nx;
            if (og + 1u == (tg + 1u) * nx) xb_add(&bar[XB_TOPGEN], 1u);
            else XB_SPIN(xb_ld(&bar[XB_TOPGEN]) == tg, bar);
            __builtin_amdgcn_fence(__ATOMIC_ACQUIRE, "agent");
            xb_add(&bar[XB_XGEN(b.x)], 1u);
            asm volatile("s_waitcnt vmcnt(0)" ::: "memory");
        } else {
            XB_SPIN(xb_ld(&bar[XB_XGEN(b.x)]) == gen, bar);
            __builtin_amdgcn_fence(__ATOMIC_ACQUIRE, "agent");
            asm volatile("s_waitcnt vmcnt(0)" ::: "memory");
        }
    }
    __syncthreads();
}

enum { PH_PRO = 0, PH_HN, PH_GEMM1, PH_PREP, PH_MIX, PH_ATT, PH_UV, PH_GOUT, PH_UP, PH_DOWN, PH_COUNT };
#ifndef MK_SKIP_MIXER
#define MK_SKIP_MIXER 0
#endif
__global__ void __launch_bounds__(NWAVES * 64, 2) mk_fwd(Params p) {
    extern __shared__ __attribute__((aligned(16))) unsigned char lds[];
    cg::grid_group grid = cg::this_grid();
    const int tid = threadIdx.x, lane = tid & 63, wv = __builtin_amdgcn_readfirstlane(tid >> 6);
    const int G = gridDim.x, gw = blockIdx.x * NWAVES + wv, NGW = G * NWAVES;
    const int lo = p.ph_lo, hi = p.ph_hi;
    if (tid < 2) ((volatile LAS unsigned*)((LAS unsigned char*)lds + LDS_BAR_OFF))[tid] = 0u;
    __syncthreads();
    XcdBarrier xbar = xcd_barrier_post((unsigned*)(p.ws + WS_BAR), (volatile LAS unsigned*)((LAS unsigned char*)lds + LDS_BAR_OFF));
    float* MOD = (float*)(p.ws + WS_MOD); bf16* REGA = (bf16*)(p.ws + WS_REGA); bf16* PROJ = (bf16*)(p.ws + WS_PROJ);
#ifndef MK_PHASE_MASK
#define MK_PHASE_MASK 0x3ff
#endif
#define IN(k) (((MK_PHASE_MASK >> (k)) & 1) && lo <= (k) && (k) < hi)
#define SEAM(k) do { if (IN(k) && IN((k) + 1)) { if ((k) == PH_PRO) grid.sync(); else xcd_barrier(xbar); } if (MK_PROBE >= 0 && blockIdx.x == 0 && tid == 0) ((unsigned long long*)(p.ws + WS_MOD + 800 * 1024))[(k) + 1] = __builtin_amdgcn_s_memrealtime(); } while (0)
    if (MK_PROBE >= 0 && blockIdx.x == 0 && tid == 0) ((unsigned long long*)(p.ws + WS_MOD + 800 * 1024))[0] = __builtin_amdgcn_s_memrealtime();
    if (IN(PH_PRO)) { phase_pro(p, lds, tid, G); }
    SEAM(PH_PRO);
    if (IN(PH_HN)) { hn_rows<MK_F8_GEMM1 != 0>(p.x, p.g_mix, MOD, 0, 1024, REGA, gw, NGW, lane); }
    SEAM(PH_HN);
    if (IN(PH_GEMM1)) {
#if MK_F8_GEMM1
        pg8::Gemm g{REGA, (const bf16*)(p.ws + WS_WIN), M, NPROJ, DM / 2, DM / 2}; pg8::StaticOrder S; S.init(M, NPROJ, G, (int)blockIdx.x);
        pg8::EpiBf16<0> E{PROJ, NPROJ, 1.f / 32.f};
        pg8::gemm_phase<pg8::EpiBf16<0>, pg8::StaticOrder, true, true, true>((PG8_LAS unsigned char*)lds, g, S, E);
#else
        pg8::Gemm g{REGA, (const bf16*)(p.ws + WS_WIN), M, NPROJ, DM, DM}; pg8::StaticOrder S; S.init(M, NPROJ, G, (int)blockIdx.x);
        pg8::EpiBf16<0> E{PROJ, NPROJ, 1.f};
        pg8::gemm_phase<pg8::EpiBf16<0>, pg8::StaticOrder, true, true>((PG8_LAS unsigned char*)lds, g, S, E);
#endif
    }
    SEAM(PH_GEMM1);
    if (IN(PH_PREP)) {
#ifndef DBG_NO_RP
        for (int it = blockIdx.x; it < M / 64; it += G) rwkv_prep_item(p, lds, it, tid);
#endif
#ifndef DBG_NO_DP
        __syncthreads();
        stage_w_lds((const bf16*)(p.ws + WS_WUKT), lds, 4, tid); __syncthreads();
        for (int tile = gw; tile < M / 32; tile += NGW) dsa_prep_kv(p, lds, tile, lane);
        __syncthreads();
        stage_w_lds((const bf16*)(p.ws + WS_WUK), lds, 6, tid); __syncthreads();
        for (int tile = gw; tile < M / 32; tile += NGW) dsa_prep_q(p, lds, tile, lane);
#endif
    }
    SEAM(PH_PREP);
    if (IN(PH_MIX)) {
        for (int chain = blockIdx.x; chain < NB * 8; chain += G) { rwkv_scan_chain(p, lds, chain, wv, lane); __syncthreads(); }
        constexpr int NSEL = NB * 112;
        {   bf16x8 af[4][4]; float wqv = 0.f; const bf16* PROJ = (const bf16*)(p.ws + WS_PROJ);
            int idx = (int)blockIdx.x;
            if (idx < NSEL) DSA_LOAD_AF(af, wqv, idx / 112, 256 + 16 * (idx % 112));
            for (int k = 0; idx < NSEL; ++k) { const int nidx = (k + 1) * G + (((k + 1) & 1) ? (G - 1 - (int)blockIdx.x) : (int)blockIdx.x); const bool hn = nidx < NSEL;
                dsa_select_item(p, lds, idx / 112, 256 + 16 * (idx % 112), tid, af, wqv, hn, nidx / 112, 256 + 16 * (nidx % 112)); idx = nidx; } }
    }
    SEAM(PH_MIX);
    if (IN(PH_ATT)) {
        if (gw < 128) bias2_item(p, gw, lane);
        for (int row = gw; row < M; row += NGW) dsa_attend_row(p, lds + wv * 9216, row, lane);
    }

    SEAM(PH_ATT);
    if (IN(PH_UV)) {
#if MK_DBG == 7
        for (int m = gw; m < M; m += NGW) { *(u32x4*)(PROJ + (size_t)m * NPROJ + lane * 8) = *(const u32x4*)(REGA + (size_t)m * 1024 + lane * 8); }
#elif MK_DBG != 2
        stage_w_lds((const bf16*)(p.ws + WS_WUVT), lds, 4, tid); __syncthreads();
        for (int tile = gw; tile < M / 32; tile += NGW) uv_item(p, lds, tile, lane);
#endif
#if MK_DBG == 0
        rwkv_epi_rows(p, gw, NGW, lane);
#endif
#if MK_DBG == 1 || MK_DBG == 2
        for (int m = gw; m < M; m += NGW) { u32x4 z = {0u, 0u, 0u, 0u}; *(u32x4*)(PROJ + (size_t)m * NPROJ + (MK_DBG == 1 ? 512 : 0) + lane * 8) = z; }
#endif
    }
    SEAM(PH_UV);
    if (IN(PH_GOUT)) {
        pg8::Gemm g{PROJ, (const bf16*)(p.ws + WS_WOUT), M, DM, DM, NPROJ}; pg8::StaticOrder S; S.init(M, DM, G, (int)blockIdx.x);
        pg8::EpiResGateNorm E{p.x, p.out, DM, MOD + 2048, 6144, p.g_ffn, MOD + 4096, REGA, (float*)(p.ws + WS_ROWSQ)};
        pg8::gemm_phase<pg8::EpiResGateNorm, pg8::StaticOrder, true, true>((PG8_LAS unsigned char*)lds, g, S, E);
    }
    SEAM(PH_GOUT);
    if (IN(PH_UP)) {
        pg8::Gemm g{REGA, (const bf16*)(p.ws + WS_W1), M, FF, DM, DM}; pg8::StaticOrder S; S.init(M, FF, G, (int)blockIdx.x);
        pg8::EpiF8Relu2 E{p.ws + WS_U, FF, 4.f, (const float*)(p.ws + WS_ROWSQ), (const float*)(p.ws + WS_BIAS2)};
        pg8::gemm_phase<pg8::EpiF8Relu2, pg8::StaticOrder, true, true>((PG8_LAS unsigned char*)lds, g, S, E);
    }
    SEAM(PH_UP);
    if (IN(PH_DOWN)) {
        pg8::Gemm g{(const bf16*)(p.ws + WS_U), (const bf16*)(p.ws + WS_W2), M, DM, FF / 2, FF / 2}; pg8::StaticOrder S; S.init(M, DM, G, (int)blockIdx.x);
        pg8::EpiResGateA2 E{REGA, p.out, DM, MOD + 5120, 6144, p.g_ffn};
        pg8::gemm_phase<pg8::EpiResGateA2, pg8::StaticOrder, true, true, true>((PG8_LAS unsigned char*)lds, g, S, E);
    }
#if MK_PROBE >= 0
    grid.sync();
    if (blockIdx.x == 0 && tid == 0) { unsigned long long* ts = (unsigned long long*)(p.ws + WS_MOD + 800 * 1024); ts[PH_COUNT] = __builtin_amdgcn_s_memrealtime();
        p.out[0] += (float)(ts[MK_PROBE + 1] - ts[MK_PROBE]) * 1e-3f; }
#endif
#undef IN
#undef SEAM
}

#ifndef MK_N_LAUNCHES
#define MK_N_LAUNCHES 1
#endif
extern "C" void kernel_launch(void* const* d_in, const int* in_sizes, int n_in, void* d_out, int out_size, void* d_ws, size_t ws_size, hipStream_t stream) {
    static int grid = 0;
    if (grid == 0) {
        if (n_in != 26 || out_size != M * DM || ws_size < WS_END) { fprintf(stderr, "kernel_launch: unexpected shapes (n_in %d out %d ws %zu)\n", n_in, out_size, ws_size); grid = -1; return; }
        int dev = 0, cus = 0, per_cu = 0;
        hipGetDevice(&dev); hipDeviceGetAttribute(&cus, hipDeviceAttributeMultiprocessorCount, dev);
        if (hipFuncSetAttribute((const void*)mk_fwd, hipFuncAttributeMaxDynamicSharedMemorySize, LDS_BYTES) != hipSuccess) { fprintf(stderr, "kernel_launch: hipFuncSetAttribute failed\n"); grid = -1; return; }
        if (hipOccupancyMaxActiveBlocksPerMultiprocessor(&per_cu, (const void*)mk_fwd, NWAVES * 64, LDS_BYTES) != hipSuccess || per_cu < 1) { fprintf(stderr, "kernel_launch: occupancy query says %d\n", per_cu); per_cu = 1; }
        (void)hipGetLastError();
        grid = cus * 1;
        if (per_cu < 1) grid = -1;
    }
    if (grid < 0) return;
    Params p{};
    const float** pp = (const float**)&p;
    for (int i = 0; i < 26; ++i) pp[i] = (const float*)d_in[i];
    p.out = (float*)d_out; p.ws = (unsigned char*)d_ws;
#if MK_N_LAUNCHES == 1
    if (hipMemsetAsync((char*)d_ws + WS_BAR, 0, 16384, stream) != hipSuccess) { fprintf(stderr, "kernel_launch: memset of the barrier words failed\n"); return; }
    p.ph_lo = 0; p.ph_hi = PH_COUNT;
    void* args[] = {&p};
    hipError_t e = hipLaunchCooperativeKernel((const void*)mk_fwd, dim3(grid), dim3(NWAVES * 64), args, LDS_BYTES, stream);
    if (e != hipSuccess) fprintf(stderr, "cooperative launch failed: %s (grid %d)\n", hipGetErrorString(e), grid);
#else
    for (int ph = 0; ph < PH_COUNT; ++ph) {
#if MK_SKIP_MIXER
        if (ph >= PH_HN && ph <= PH_GOUT) continue;
#endif
        p.ph_lo = ph; p.ph_hi = ph + 1;
        hipLaunchKernelGGL(mk_fwd, dim3(grid), dim3(NWAVES * 64), LDS_BYTES, stream, p);
    }
#endif
}
```

```cpp
#include <hip/hip_runtime.h>
#include <hip/hip_cooperative_groups.h>
#include <cstdio>
#include <cstdint>
#include <cmath>
namespace cg = cooperative_groups;
#ifndef MK_F8_GEMM1
#define MK_F8_GEMM1 0
#endif
#ifndef MK_PROBE
#define MK_PROBE -1
#endif
#ifndef MK_DBG
#define MK_DBG 0
#endif
#ifndef MK_DBG_NOTOPK
#define MK_DBG_NOTOPK 0
#endif
namespace pg8 {
#define PG8_LAS __attribute__((address_space(3)))
typedef unsigned short bf16_t;
typedef short bf16x8 __attribute__((ext_vector_type(8)));
typedef float f32x4 __attribute__((ext_vector_type(4)));
typedef unsigned u32x4 __attribute__((ext_vector_type(4)));
constexpr int BM = 256, BK = 64, HALF = 128, HTB = HALF * BK * 2  , STAGE_BYTES = 8 * HTB, NXCD = 8, WGM = 8;

__host__ __device__ __forceinline__ int lds_byte(int r, int c) { const int st = (r >> 4) * 2 + (c >> 5), rr = r & 15, cc = c & 31, ob = rr * 64 + cc * 2; return st * 1024 + (ob ^ (((ob >> 9) & 1) << 5)); }
__host__ __device__ __forceinline__ void stage_rc(int b, int& R, int& C) { const int st = b / 1024, sb = b % 1024, swz = sb ^ (((sb >> 9) & 1) << 5); R = (st >> 1) * 16 + swz / 64; C = (st & 1) * 32 + (swz % 64) / 2; }
__host__ __device__ __forceinline__ int perm32(int rho) { const int n = rho >> 4, i = rho & 15; return 8 * (i >> 2) + 4 * n + (i & 3); }

struct Unit { int pm, pn; };
struct Gemm { const bf16_t* A; const bf16_t* Bt; int M, N, K, lda; };

struct StaticOrder {
    int nM, nN, nwg, G, c;
    __host__ __device__ void init(int M, int N, int G_, int c_) { nM = M / BM; nN = N / BM; nwg = nM * nN; G = G_; c = c_; }
    __host__ __device__ bool next(int i, Unit& u) const {
        const long L = (long)i * G + c; if (L >= nwg) return false;
        int wgid = (int)L; { const int q = nwg / NXCD, r = nwg % NXCD, xcd = wgid % NXCD, off = wgid / NXCD; wgid = (xcd < r ? xcd * (q + 1) : r * (q + 1) + (xcd - r) * q) + off; }
        const int nig = WGM * nN, gid = wgid / nig, fm = gid * WGM, gsz = (nM - fm) < WGM ? (nM - fm) : WGM;
        u.pm = fm + ((wgid % nig) % gsz); u.pn = (wgid % nig) / gsz; return true;
    }
    __device__ __forceinline__ void a_ready(const Unit&) const {}
    __device__ __forceinline__ void done(const Unit&) const {}
};


typedef float f32x2_t __attribute__((ext_vector_type(2))); typedef __bf16 bf16x2_t __attribute__((ext_vector_type(2)));
__device__ __forceinline__ unsigned cvt_pk_bf16(float lo, float hi) { const f32x2_t v = {lo, hi}; const bf16x2_t b = __builtin_convertvector(v, bf16x2_t); return __builtin_bit_cast(unsigned, b); }

template <int ACT  > struct EpiBf16 {
    static constexpr bool PERM = true, AFTER_DRAIN = false;
    bf16_t* O; int ldc; float scale;
    __device__ __forceinline__ void operator()(const f32x4 (&acc)[2][2][4][2], const Unit& u, int wr, int wc, int fr, int fq) const {
        const int row0 = u.pm * BM + wr * 64 + fr; const int col0 = u.pn * BM + wc * 32 + 8 * fq;
#pragma unroll
        for (int ai = 0; ai < 2; ++ai)
#pragma unroll
            for (int m = 0; m < 4; ++m) { bf16_t* rowp = O + (size_t)(row0 + ai * HALF + m * 16) * ldc + col0;
#pragma unroll
                for (int bj = 0; bj < 2; ++bj) { f32x4 v0 = acc[ai][bj][m][0] * scale, v1 = acc[ai][bj][m][1] * scale;
                    if (ACT == 1) {
#pragma unroll
                        for (int j = 0; j < 4; ++j) { const float a = v0[j] > 0.f ? v0[j] : 0.f, b = v1[j] > 0.f ? v1[j] : 0.f; v0[j] = a * a; v1[j] = b * b; } }
                    u32x4 w; w.x = cvt_pk_bf16(v0[0], v0[1]); w.y = cvt_pk_bf16(v0[2], v0[3]); w.z = cvt_pk_bf16(v1[0], v1[1]); w.w = cvt_pk_bf16(v1[2], v1[3]);
                    *(u32x4*)(rowp + bj * HALF) = w; } }
    }
};
__device__ __forceinline__ unsigned pk4_fp8(float a, float b, float c, float d) { int r = __builtin_amdgcn_cvt_pk_fp8_f32(a, b, 0, false); r = __builtin_amdgcn_cvt_pk_fp8_f32(c, d, r, true); return (unsigned)r; }
struct EpiF8Relu2 {
    static constexpr bool PERM = true, AFTER_DRAIN = false;
    unsigned char* O; int ldc; float scale; const float* rowsq; const float* bias2;
    __device__ __forceinline__ void operator()(const f32x4 (&acc)[2][2][4][2], const Unit& u, int wr, int wc, int fr, int fq) const {
        const int row0 = u.pm * BM + wr * 64 + fr; const int col0 = u.pn * BM + wc * 32 + 8 * fq;
        const float* bp = bias2 + (size_t)(u.pm >> 3) * 4096 + col0;
        f32x4 bv[2][2];
#pragma unroll
        for (int bj = 0; bj < 2; ++bj) { bv[bj][0] = *(const f32x4*)(bp + bj * HALF); bv[bj][1] = *(const f32x4*)(bp + bj * HALF + 4); }
#pragma unroll
        for (int ai = 0; ai < 2; ++ai)
#pragma unroll
            for (int m = 0; m < 4; ++m) { const int row = row0 + ai * HALF + m * 16; unsigned char* rowp = O + (size_t)row * ldc + col0;
                const float rstd = rsqrtf(rowsq[row] * (1.f / 1024.f) + 1e-6f);
#pragma unroll
                for (int bj = 0; bj < 2; ++bj) { f32x4 v0 = acc[ai][bj][m][0] * rstd + bv[bj][0], v1 = acc[ai][bj][m][1] * rstd + bv[bj][1];
#pragma unroll
                    for (int j = 0; j < 4; ++j) { const float a = v0[j] > 0.f ? v0[j] : 0.f, b = v1[j] > 0.f ? v1[j] : 0.f; v0[j] = fminf(a * a * scale, 416.f); v1[j] = fminf(b * b * scale, 416.f); }
                    typedef unsigned u32x2_t __attribute__((ext_vector_type(2)));
                    u32x2_t w; w.x = pk4_fp8(v0[0], v0[1], v0[2], v0[3]); w.y = pk4_fp8(v1[0], v1[1], v1[2], v1[3]);
                    *(u32x2_t*)(rowp + bj * HALF) = w; } }
    }
};
struct EpiResGate {
    static constexpr bool PERM = false, AFTER_DRAIN = false;
    const float* base; float* out; int ldc; const float* gate; int gate_ld; float gscale;
    __device__ __forceinline__ void operator()(const f32x4 (&acc)[2][2][4][2], const Unit& u, int, int, int, int) const {
        int t_ = threadIdx.x; asm volatile("" : "+v"(t_));
        const int wr = t_ >> 8, wc = (t_ >> 6) & 3, fr = t_ & 15, fq = (t_ >> 4) & 3;
        const int row0 = u.pm * BM + wr * 64 + fr, col0 = u.pn * BM + wc * 32 + 4 * fq;
        const float* gp = gate + (size_t)(u.pm >> 3) * gate_ld + col0;
        f32x4 gv[2][2];
#pragma unroll
        for (int bj = 0; bj < 2; ++bj)
#pragma unroll
            for (int n = 0; n < 2; ++n) gv[bj][n] = *(const f32x4*)(gp + bj * HALF + n * 16) * gscale;
#pragma unroll
        for (int ai = 0; ai < 2; ++ai)
#pragma unroll
            for (int m = 0; m < 4; ++m) { const size_t off = (size_t)(row0 + ai * HALF + m * 16) * ldc + col0;
#pragma unroll
                for (int bj = 0; bj < 2; ++bj)
#pragma unroll
                    for (int n = 0; n < 2; ++n) { const f32x4 bs = *(const f32x4*)(base + off + bj * HALF + n * 16);
                        *(f32x4*)(out + off + bj * HALF + n * 16) = bs + gv[bj][n] * acc[ai][bj][m][n]; } }
    }
};
struct EpiResGateNorm {
    static constexpr bool PERM = false, AFTER_DRAIN = false;
    const float* base; float* out; int ldc; const float* gate; int gate_ld; const float* gffn; const float* sc2; bf16_t* a2; float* rowsq;
    __device__ __forceinline__ void operator()(const f32x4 (&acc)[2][2][4][2], const Unit& u, int, int, int, int) const {
        int t_ = threadIdx.x; asm volatile("" : "+v"(t_));
        const int wr = t_ >> 8, wc = (t_ >> 6) & 3, fr = t_ & 15, fq = (t_ >> 4) & 3;
        const int row0 = u.pm * BM + wr * 64 + fr, col0 = u.pn * BM + wc * 32 + 4 * fq;
        const float* gp = gate + (size_t)(u.pm >> 3) * gate_ld + col0; const float* sp = sc2 + (size_t)(u.pm >> 3) * gate_ld + col0;
        f32x4 gv[2][2], gm[2][2];
#pragma unroll
        for (int bj = 0; bj < 2; ++bj)
#pragma unroll
            for (int n = 0; n < 2; ++n) { gv[bj][n] = *(const f32x4*)(gp + bj * HALF + n * 16); gm[bj][n] = *(const f32x4*)(gffn + col0 + bj * HALF + n * 16) * (*(const f32x4*)(sp + bj * HALF + n * 16) + 1.f); }
#pragma unroll
        for (int ai = 0; ai < 2; ++ai)
#pragma unroll
            for (int m = 0; m < 4; ++m) { const int row = row0 + ai * HALF + m * 16; const size_t off = (size_t)row * ldc + col0; float ss = 0.f;
#pragma unroll
                for (int bj = 0; bj < 2; ++bj)
#pragma unroll
                    for (int n = 0; n < 2; ++n) { const f32x4 bs = *(const f32x4*)(base + off + bj * HALF + n * 16); const f32x4 x1 = bs + gv[bj][n] * acc[ai][bj][m][n];
                        ss += (x1.x * x1.x + x1.y * x1.y) + (x1.z * x1.z + x1.w * x1.w);
                        const f32x4 y = x1 * gm[bj][n]; typedef unsigned u32x2_t __attribute__((ext_vector_type(2)));
                        u32x2_t w; w.x = cvt_pk_bf16(y.x, y.y); w.y = cvt_pk_bf16(y.z, y.w); *(u32x2_t*)(a2 + off + bj * HALF + n * 16) = w; }
                ss += __shfl_xor(ss, 16); ss += __shfl_xor(ss, 32);
                if (fq == 0) atomicAdd(rowsq + row, ss); }
    }
};
struct EpiResGateA2 {
    static constexpr bool PERM = false, AFTER_DRAIN = false;
    const bf16_t* a2; float* out; int ldc; const float* gate; int gate_ld; const float* gffn;
    __device__ __forceinline__ void operator()(const f32x4 (&acc)[2][2][4][2], const Unit& u, int, int, int, int) const {
        constexpr float gscale = 1.f / 256.f;
        int t_ = threadIdx.x; asm volatile("" : "+v"(t_));
        const int wr = t_ >> 8, wc = (t_ >> 6) & 3, fr = t_ & 15, fq = (t_ >> 4) & 3;
        const int row0 = u.pm * BM + wr * 64 + fr, col0 = u.pn * BM + wc * 32 + 4 * fq;
        const float* gp = gate + (size_t)(u.pm >> 3) * gate_ld + col0; const float* sp = gp - 1024;
        f32x4 gv[2][2], ig[2][2];
#pragma unroll
        for (int bj = 0; bj < 2; ++bj)
#pragma unroll
            for (int n = 0; n < 2; ++n) { gv[bj][n] = *(const f32x4*)(gp + bj * HALF + n * 16) * gscale;
                const f32x4 gm = *(const f32x4*)(gffn + col0 + bj * HALF + n * 16) * (*(const f32x4*)(sp + bj * HALF + n * 16) + 1.f);
                ig[bj][n] = (f32x4){1.f / gm.x, 1.f / gm.y, 1.f / gm.z, 1.f / gm.w}; }
#pragma unroll
        for (int ai = 0; ai < 2; ++ai)
#pragma unroll
            for (int m = 0; m < 4; ++m) { const size_t off = (size_t)(row0 + ai * HALF + m * 16) * ldc + col0;
#pragma unroll
                for (int bj = 0; bj < 2; ++bj)
#pragma unroll
                    for (int n = 0; n < 2; ++n) { typedef unsigned u32x2_t __attribute__((ext_vector_type(2)));
                        const u32x2_t w = *(const u32x2_t*)(a2 + off + bj * HALF + n * 16);
                        const f32x4 xa = {__uint_as_float(w.x << 16), __uint_as_float(w.x & 0xffff0000u), __uint_as_float(w.y << 16), __uint_as_float(w.y & 0xffff0000u)};
                        *(f32x4*)(out + off + bj * HALF + n * 16) = xa * ig[bj][n] + gv[bj][n] * acc[ai][bj][m][n]; } }
    }
};
template <class Epi, class Sched, bool ALIGN_EPI = false, bool SP2 = false, bool F8 = false>
__device__ __forceinline__ void gemm_phase(PG8_LAS unsigned char* lds, const Gemm g, const Sched S, const Epi E) {
    const int tid = threadIdx.x, wid = __builtin_amdgcn_readfirstlane(tid >> 6), lane = tid & 63, wr = wid >> 2, wc = wid & 3, fr = lane & 15, fq = lane >> 4;
    const int K = g.K, nt = K / BK;
    unsigned voffA[2], voffB[2];
#pragma unroll
    for (int i = 0; i < 2; ++i) { int R, C; stage_rc(tid * 16 + i * 8192, R, C); const int Rb = Epi::PERM ? ((R & ~31) + perm32(R & 31)) : R;
        voffA[i] = (unsigned)(R * g.lda + C) * 2u; voffB[i] = (unsigned)(Rb * K + C) * 2u; }
    const size_t kstep = (size_t)(BK * 2);
    const size_t hstepB = (size_t)HALF * K * 2, hstepA = (size_t)HALF * g.lda * 2;
    const size_t tstepA = 2 * hstepA, tstepB = 2 * hstepB;
    const unsigned ldsw = (unsigned)wid * 1024u;
    const int f8in = (fq >> 1) * 1024 + ((fr * 64 + (fq & 1) * 32) ^ ((fr >> 3) << 5));
    const int aoff = F8 ? wr * 8192 + f8in : lds_byte(wr * 64 + fr, fq * 8), boff = F8 ? wc * 4096 + f8in : lds_byte(wc * 32 + fr, fq * 8);
    constexpr int KOFF = F8 ? 16 : 1024;
    typedef int v8i_t __attribute__((ext_vector_type(8)));
#define PG8_SA(b, h) (((b) * 2 + (h)) * HTB)
#define PG8_SB(b, h) ((4 + (b) * 2 + (h)) * HTB)
#define PG8_STAGE(bufoff, gbase, voff) do { _Pragma("unroll") for (int _i = 0; _i < 2; ++_i) \
        __builtin_amdgcn_global_load_lds((const unsigned*)((const char*)(gbase) + (voff)[_i]), (PG8_LAS unsigned*)(lds + (bufoff) + ldsw + _i * 8192), 16, 0, 0); } while (0)
#define PG8_LD32(p_) __builtin_shufflevector(*(const PG8_LAS u32x4*)(p_), *(const PG8_LAS u32x4*)((p_) + 16), 0, 1, 2, 3, 4, 5, 6, 7)
#define PG8_LDA(dst, b, h) do { if constexpr (F8) { _Pragma("unroll") for (int m = 0; m < 4; ++m) dst##8[m] = __builtin_bit_cast(v8i_t, PG8_LD32(lds + PG8_SA(b, h) + aoff + m * 2048)); } \
    else { _Pragma("unroll") for (int m = 0; m < 4; ++m) _Pragma("unroll") for (int k = 0; k < 2; ++k) dst[m][k] = *(const PG8_LAS bf16x8*)(lds + PG8_SA(b, h) + aoff + m * 2048 + k * KOFF); } } while (0)
#define PG8_LDB(dst, b, h) do { if constexpr (F8) { _Pragma("unroll") for (int n = 0; n < 2; ++n) dst##8[n] = __builtin_bit_cast(v8i_t, PG8_LD32(lds + PG8_SB(b, h) + boff + n * 2048)); } \
    else { _Pragma("unroll") for (int n = 0; n < 2; ++n) _Pragma("unroll") for (int k = 0; k < 2; ++k) dst[n][k] = *(const PG8_LAS bf16x8*)(lds + PG8_SB(b, h) + boff + n * 2048 + k * KOFF); } } while (0)
#define PG8_CAT(x) __builtin_shufflevector(__builtin_bit_cast(u32x4, (x)[0]), __builtin_bit_cast(u32x4, (x)[1]), 0, 1, 2, 3, 4, 5, 6, 7)
#define PG8_MMA(ai, bj, At, Bt) do { __builtin_amdgcn_s_setprio(1); if constexpr (F8) { _Pragma("unroll") for (int m = 0; m < 4; ++m) _Pragma("unroll") for (int n = 0; n < 2; ++n) \
        asm volatile("v_mfma_f32_16x16x128_f8f6f4 %0, %1, %2, %0" : "+v"(acc[ai][bj][m][n]) : "v"(Bt##8[n]), "v"(At##8[m])); } \
    else { _Pragma("unroll") for (int m = 0; m < 4; ++m) _Pragma("unroll") for (int n = 0; n < 2; ++n) _Pragma("unroll") for (int k = 0; k < 2; ++k) \
        acc[ai][bj][m][n] = __builtin_amdgcn_mfma_f32_16x16x32_bf16(Bt[n][k], At[m][k], acc[ai][bj][m][n], 0, 0, 0); } __builtin_amdgcn_s_setprio(0); } while (0)
#define PG8_WAIT_V(n) asm volatile("s_waitcnt vmcnt(" #n ")" ::: "memory")
#define PG8_WAIT_L(n) asm volatile("s_waitcnt lgkmcnt(" #n ")" ::: "memory")
#define PG8_BAR __builtin_amdgcn_s_barrier()
#define PG8_SCHED __builtin_amdgcn_sched_barrier(0)
    Unit cur, nxt; int ui = 0;
    if (!S.next(0, cur)) return;
    f32x4 acc[2][2][4][2];
#pragma unroll
    for (int a = 0; a < 2; ++a)
#pragma unroll
        for (int b = 0; b < 2; ++b)
#pragma unroll
            for (int m = 0; m < 4; ++m)
#pragma unroll
                for (int n = 0; n < 2; ++n) acc[a][b][m][n] = (f32x4){0.f, 0.f, 0.f, 0.f};
    bf16x8 At[4][2], B0[2][2], B1[2][2]; v8i_t At8[4], B08[2], B18[2];
    const char* cA = (const char*)g.A + (size_t)cur.pm * tstepA; const char* cB = (const char*)g.Bt + (size_t)cur.pn * tstepB;
    S.a_ready(cur);
    if constexpr (SP2) {
        PG8_STAGE(PG8_SB(0, 0), cB, voffB); PG8_STAGE(PG8_SB(0, 1), cB + hstepB, voffB); PG8_STAGE(PG8_SA(0, 0), cA, voffA); PG8_STAGE(PG8_SA(0, 1), cA + hstepA, voffA);
        if (wr == 1) PG8_BAR;
        PG8_WAIT_V(2); PG8_BAR;
        PG8_STAGE(PG8_SB(1, 0), cB + kstep, voffB); PG8_STAGE(PG8_SA(1, 0), cA + kstep, voffA); PG8_STAGE(PG8_SB(1, 1), cB + hstepB + kstep, voffB);
        PG8_WAIT_V(6); PG8_BAR;
    } else {
        PG8_STAGE(PG8_SB(0, 0), cB, voffB); PG8_STAGE(PG8_SA(0, 0), cA, voffA); PG8_STAGE(PG8_SB(0, 1), cB + hstepB, voffB); PG8_STAGE(PG8_SA(0, 1), cA + hstepA, voffA);
        if (wr == 1) PG8_BAR;
        PG8_WAIT_V(4); PG8_BAR;
        PG8_STAGE(PG8_SB(1, 0), cB + kstep, voffB); PG8_STAGE(PG8_SA(1, 0), cA + kstep, voffA); PG8_STAGE(PG8_SB(1, 1), cB + hstepB + kstep, voffB);
        PG8_WAIT_V(6); PG8_BAR;
    }
    for (;;) {
        const bool has_next = S.next(ui + 1, nxt);
        const char* nA = has_next ? (const char*)g.A + (size_t)nxt.pm * tstepA : cA; const char* nB = has_next ? (const char*)g.Bt + (size_t)nxt.pn * tstepB : cB;
        for (int t = 0; t < nt; t += 2) {
            const bool last = (t == nt - 2);
            const char* a1 = cA + (size_t)(t + 1) * kstep;
            const char* a2 = last ? nA : cA + (size_t)(t + 2) * kstep; const char* b2 = last ? nB : cB + (size_t)(t + 2) * kstep;
            const char* a3 = a2 + kstep; const char* b3 = b2 + kstep;
            if (last && has_next) S.a_ready(nxt);
            if constexpr (SP2) {
            PG8_LDB(B0, 0, 0); PG8_LDB(B1, 0, 1); PG8_SCHED; PG8_LDA(At, 0, 0); PG8_STAGE(PG8_SA(1, 1), a1 + hstepA, voffA);
            PG8_WAIT_V(8); PG8_WAIT_L(0); PG8_BAR; PG8_MMA(0, 0, At, B0); PG8_MMA(0, 1, At, B1); PG8_BAR; PG8_SCHED;
            PG8_LDA(At, 0, 1); PG8_STAGE(PG8_SB(0, 0), b2, voffB); PG8_STAGE(PG8_SB(0, 1), b2 + hstepB, voffB); PG8_STAGE(PG8_SA(0, 0), a2, voffA);
            PG8_WAIT_V(8); PG8_WAIT_L(0); PG8_BAR; PG8_MMA(1, 0, At, B0); PG8_MMA(1, 1, At, B1); PG8_BAR; PG8_SCHED;
            PG8_LDB(B0, 1, 0); PG8_LDB(B1, 1, 1); PG8_SCHED; PG8_LDA(At, 1, 0); PG8_STAGE(PG8_SA(0, 1), a2 + hstepA, voffA);
            PG8_WAIT_V(8); PG8_WAIT_L(0); PG8_BAR; PG8_MMA(0, 0, At, B0); PG8_MMA(0, 1, At, B1); PG8_BAR; PG8_SCHED;
            PG8_LDA(At, 1, 1); PG8_STAGE(PG8_SB(1, 0), b3, voffB); PG8_STAGE(PG8_SB(1, 1), b3 + hstepB, voffB); PG8_STAGE(PG8_SA(1, 0), a3, voffA);
            PG8_WAIT_V(8); PG8_WAIT_L(0); PG8_BAR; PG8_MMA(1, 0, At, B0); PG8_MMA(1, 1, At, B1); PG8_BAR; PG8_SCHED;
            } else {
            PG8_LDB(B0, 0, 0); PG8_SCHED; PG8_LDA(At, 0, 0); PG8_STAGE(PG8_SA(1, 1), a1 + hstepA, voffA);
            PG8_WAIT_L(8); PG8_BAR; PG8_WAIT_L(0); PG8_MMA(0, 0, At, B0); PG8_BAR; PG8_SCHED;
            PG8_LDB(B1, 0, 1); PG8_STAGE(PG8_SB(0, 0), b2, voffB);
            PG8_BAR; PG8_WAIT_L(0); PG8_MMA(0, 1, At, B1); PG8_BAR;
            PG8_LDA(At, 0, 1); PG8_STAGE(PG8_SA(0, 0), a2, voffA);
            PG8_BAR; PG8_WAIT_L(0); PG8_MMA(1, 0, At, B0); PG8_BAR; PG8_SCHED;
            PG8_STAGE(PG8_SB(0, 1), b2 + hstepB, voffB);
            PG8_WAIT_V(6); PG8_BAR; PG8_MMA(1, 1, At, B1); PG8_BAR;
            PG8_LDB(B0, 1, 0); PG8_SCHED; PG8_LDA(At, 1, 0); PG8_STAGE(PG8_SA(0, 1), a2 + hstepA, voffA);
            PG8_WAIT_L(8); PG8_BAR; PG8_WAIT_L(0); PG8_MMA(0, 0, At, B0); PG8_BAR; PG8_SCHED;
            PG8_LDB(B1, 1, 1); PG8_STAGE(PG8_SB(1, 0), b3, voffB);
            PG8_BAR; PG8_WAIT_L(0); PG8_MMA(0, 1, At, B1); PG8_BAR;
            PG8_LDA(At, 1, 1); PG8_STAGE(PG8_SA(1, 0), a3, voffA);
            PG8_BAR; PG8_WAIT_L(0); PG8_MMA(1, 0, At, B0); PG8_BAR; PG8_SCHED;
            PG8_STAGE(PG8_SB(1, 1), b3 + hstepB, voffB);
            PG8_WAIT_V(6); PG8_BAR; PG8_MMA(1, 1, At, B1); PG8_BAR;
            }
        }
        if constexpr (ALIGN_EPI) { if (wr == 0) PG8_BAR; }
        if constexpr (F8) asm volatile("s_nop 15\n\ts_nop 15");
        if constexpr (!Epi::AFTER_DRAIN) { E(acc, cur, wr, wc, fr, fq); S.done(cur); }
        if (!has_next) break;
#pragma unroll
        for (int a = 0; a < 2; ++a)
#pragma unroll
            for (int b = 0; b < 2; ++b)
#pragma unroll
                for (int m = 0; m < 4; ++m)
#pragma unroll
                    for (int n = 0; n < 2; ++n) acc[a][b][m][n] = (f32x4){0.f, 0.f, 0.f, 0.f};
        cur = nxt; cA = nA; cB = nB; ++ui;
        if constexpr (ALIGN_EPI) { if (wr == 1) PG8_BAR; }
    }
    PG8_WAIT_V(0);
    if constexpr (!ALIGN_EPI) { if (wr == 0) PG8_BAR; }
    PG8_BAR;
    if constexpr (Epi::AFTER_DRAIN) { E.fused(acc, cur, wr, wc, fr, fq, lds, wid, lane); S.done(cur); }
#undef PG8_SA
#undef PG8_SB
#undef PG8_STAGE
#undef PG8_LDA
#undef PG8_LDB
#undef PG8_MMA
#undef PG8_CAT
#undef PG8_LD32
#undef PG8_WAIT_V
#undef PG8_WAIT_L
#undef PG8_BAR
#undef PG8_SCHED
}
}

#define LAS __attribute__((address_space(3)))
typedef unsigned short bf16;
typedef short bf16x8 __attribute__((ext_vector_type(8)));
typedef short s16x4 __attribute__((ext_vector_type(4)));
typedef float f32x4 __attribute__((ext_vector_type(4)));
typedef float f32x16 __attribute__((ext_vector_type(16)));
typedef unsigned u32x4 __attribute__((ext_vector_type(4)));
typedef unsigned u32x2 __attribute__((ext_vector_type(2)));

constexpr int NB = 32, SEQ = 2048, DM = 1024, M = NB * SEQ, NPROJ = 3072, FF = 4096;
constexpr int PC_Q = 0, PC_R = 512, PC_K = 1024, PC_V = 1536, PC_QI = 2048, PC_CL = 2560, PC_KI = 2688, PC_XW = 2752, PC_XA = 2816, PC_XG = 2880, PC_WI = 3008;
constexpr size_t MiB = 1u << 20;
constexpr size_t WS_MOD = 0, WS_WUKT = 1 * MiB, WS_WUK = WS_WUKT + 131072, WS_WUVT = WS_WUK + 131072, WS_INVR = 2 * MiB, WS_WIN = 4 * MiB, WS_WOUT = 10 * MiB,
                 WS_W1 = 12 * MiB, WS_W2 = 20 * MiB, WS_CKV = 36 * MiB, WS_GAM = 52 * MiB, WS_C3 = 60 * MiB, WS_REGA = 64 * MiB, WS_PROJ = 192 * MiB, WS_CH = 576 * MiB,
                 WS_G = 960 * MiB, WS_U = 192 * MiB, WS_END = 1024 * MiB,
                 WS_BAR = 62 * MiB, WS_ROWSQ = WS_BAR + 65536, WS_BIAS2 = WS_ROWSQ + 262144, WS_W2T = WS_WUVT + 131072, WS_A2T = WS_W2T + 65536, WS_G2T = WS_A2T + 65536;
constexpr int LDS_BAR_OFF = 158720;
constexpr int LDS_BYTES = 158976;
constexpr int NWAVES = 8;

struct Params {
    const float *x, *c, *w_ada, *b_ada, *g_mix, *g_ffn, *w_in, *g_q, *g_k, *g_kv, *w_uk, *w_uv, *mu, *w0, *w2, *a0, *a2, *g2, *k_k, *k_a, *r_k, *ln_w, *ln_b, *w_out, *w_ff1, *w_ff2;
    float* out; unsigned char* ws; int ph_lo, ph_hi;
};

__device__ __forceinline__ unsigned pk2(float lo, float hi) { return pg8::cvt_pk_bf16(lo, hi); }
__device__ __forceinline__ float bflo(unsigned w) { return __uint_as_float(w << 16); }
__device__ __forceinline__ float bfhi(unsigned w) { return __uint_as_float(w & 0xffff0000u); }
__device__ __forceinline__ float bf2f(bf16 h) { return __uint_as_float((unsigned)h << 16); }
__device__ __forceinline__ bf16 f2bf(float f) { return (bf16)(pk2(f, 0.f) & 0xffffu); }
__device__ __forceinline__ float wave_sum(float v) {
#pragma unroll
    for (int o = 1; o < 64; o <<= 1) v += __shfl_xor(v, o);
    return v;
}
__device__ __forceinline__ f32x16 mfma32(bf16x8 a, bf16x8 b, f32x16 c) { return __builtin_amdgcn_mfma_f32_32x32x16_bf16(a, b, c, 0, 0, 0); }
__device__ __forceinline__ f32x4 mfma16(bf16x8 a, bf16x8 b, f32x4 c) { return __builtin_amdgcn_mfma_f32_16x16x32_bf16(a, b, c, 0, 0, 0); }

__device__ __forceinline__ int win_src_col(int n) {
    if (n < 512) return n;
    if (n < 1024) return 1224 + (n - 512);
    if (n < 1536) return 1736 + (n - 1024);
    if (n < 2048) return 2248 + (n - 1536);
    if (n < 2560) return 640 + (n - 2048);
    if (n < 2688) return 512 + (n - 2560);
    if (n < 2752) return 1152 + (n - 2688);
    if (n < 2816) return 2760 + (n - 2752);
    if (n < 2880) return 2824 + (n - 2816);
    if (n < 3008) return 2888 + (n - 2880);
    if (n < 3016) return 1216 + (n - 3008);
    return -1;
}
__device__ __forceinline__ void conv_t_item(const float* W, int K, int Nsrc, bf16* WT, int nblk, int item, float* scr, int lane, bool is_win) {
    const int kb = item / nblk, nb = item % nblk, k0 = 64 * kb, n0 = 32 * nb;
    int ns = n0 + (lane & 31); if (is_win) ns = win_src_col(ns);
    float tv[32];
#pragma unroll
    for (int i = 0; i < 32; ++i) { const int kk = 2 * i + (lane >> 5); tv[i] = ns >= 0 ? W[(size_t)(k0 + kk) * Nsrc + ns] : 0.f; }
#pragma unroll
    for (int i = 0; i < 32; ++i) { const int kk = 2 * i + (lane >> 5); scr[kk * 33 + (lane & 31)] = tv[i]; }
    asm volatile("s_waitcnt lgkmcnt(0)" ::: "memory");
    const int c = lane & 7;
#pragma unroll
    for (int j = 0; j < 4; ++j) { const int n = (lane >> 3) + 8 * j; const float* s = scr + (8 * c) * 33 + n;
        u32x4 o; o.x = pk2(s[0 * 33], s[1 * 33]); o.y = pk2(s[2 * 33], s[3 * 33]); o.z = pk2(s[4 * 33], s[5 * 33]); o.w = pk2(s[6 * 33], s[7 * 33]);
        *(u32x4*)(WT + (size_t)(n0 + n) * K + k0 + 8 * c) = o; }
    asm volatile("s_waitcnt lgkmcnt(0)" ::: "memory");
}
__device__ __forceinline__ void conv_t_item_f8(const float* W, int K, int N, unsigned char* WT, int nblk, int item, float* scr, int lane, float scale, bool is_win = false) {
    const int kb = item / nblk, nb = item % nblk, k0 = 64 * kb, n0 = 32 * nb;
    int ns = n0 + (lane & 31); if (is_win) ns = win_src_col(ns);
    float tv[32];
#pragma unroll
    for (int i = 0; i < 32; ++i) { const int kk = 2 * i + (lane >> 5); tv[i] = ns >= 0 ? W[(size_t)(k0 + kk) * N + ns] * scale : 0.f; }
#pragma unroll
    for (int i = 0; i < 32; ++i) { const int kk = 2 * i + (lane >> 5); scr[kk * 33 + (lane & 31)] = tv[i]; }
    asm volatile("s_waitcnt lgkmcnt(0)" ::: "memory");
    const int c = lane & 7;
#pragma unroll
    for (int j = 0; j < 4; ++j) { const int n = (lane >> 3) + 8 * j; const float* s = scr + (8 * c) * 33 + n;
        u32x2 o; o.x = pg8::pk4_fp8(s[0 * 33], s[1 * 33], s[2 * 33], s[3 * 33]); o.y = pg8::pk4_fp8(s[4 * 33], s[5 * 33], s[6 * 33], s[7 * 33]);
        *(u32x2*)(WT + (size_t)(n0 + n) * K + k0 + 8 * c) = o; }
    asm volatile("s_waitcnt lgkmcnt(0)" ::: "memory");
}
__device__ __forceinline__ void adaln_block(const Params& p, float* ldsf, int cb, int tid) {
    const int lane = tid & 63, wv = tid >> 6, e = cb * 64 + lane;
    float* SC = ldsf; float* RED = ldsf + 16384; float* mod = (float*)(p.ws + WS_MOD);
    float wreg[128];
#pragma unroll
    for (int d = 0; d < 128; ++d) wreg[d] = p.w_ada[(size_t)(wv * 128 + d) * 6144 + e];
    for (int half = 0; half < 2; ++half) {
        const int b0 = half * 16;
        for (int i = tid; i < 16384; i += 512) { const float cv = p.c[b0 * 1024 + i]; SC[i] = cv / (1.f + __expf(-cv)); }
        __syncthreads();
        float acc[16];
#pragma unroll
        for (int bb = 0; bb < 16; ++bb) acc[bb] = 0.f;
#pragma unroll
        for (int dd = 0; dd < 128; dd += 4) { const int d = wv * 128 + dd;
            const float w0 = wreg[dd], w1 = wreg[dd + 1], w2 = wreg[dd + 2], w3 = wreg[dd + 3];
#pragma unroll
            for (int bb = 0; bb < 16; ++bb) { const f32x4 s = *(const f32x4*)(SC + bb * 1024 + d); acc[bb] += (s.x * w0 + s.y * w1) + (s.z * w2 + s.w * w3); }
        }
#pragma unroll
        for (int bb = 0; bb < 16; ++bb) RED[(wv * 16 + bb) * 64 + lane] = acc[bb];
        __syncthreads();
#pragma unroll
        for (int q = 0; q < 2; ++q) { const int bb = wv * 2 + q; float s = p.b_ada[e];
#pragma unroll
            for (int ww = 0; ww < 8; ++ww) s += RED[(ww * 16 + bb) * 64 + lane];
            mod[(size_t)(b0 + bb) * 6144 + e] = s; }
        __syncthreads();
    }
}
__device__ __forceinline__ void phase_pro(const Params& p, unsigned char* lds, int tid, int G) {
    const int lane = tid & 63, wv = tid >> 6;
    for (int cb = blockIdx.x; cb < 96; cb += G) adaln_block(p, (float*)lds, cb, tid);
    __syncthreads();
    float* scr = (float*)lds + wv * (64 * 33 + 16);
    const int gw = blockIdx.x * NWAVES + wv, NGW = G * NWAVES;
    bf16* WIN = (bf16*)(p.ws + WS_WIN); bf16* WOUT = (bf16*)(p.ws + WS_WOUT); bf16* W1 = (bf16*)(p.ws + WS_W1); bf16* W2 = (bf16*)(p.ws + WS_W2);
    bf16* WUKT = (bf16*)(p.ws + WS_WUKT); bf16* WUK = (bf16*)(p.ws + WS_WUK); bf16* WUVT = (bf16*)(p.ws + WS_WUVT);
    constexpr int I_IN = (DM / 64) * (NPROJ / 32), I_OUT = (DM / 64) * (DM / 32), I_1 = (DM / 64) * (FF / 32), I_2 = (FF / 64) * (DM / 32), I_UK = (128 / 64) * (512 / 32);
    constexpr int I_LR = 512 / 32;
    constexpr int NITEMS = I_IN + I_OUT + I_1 + I_2 + 2 * I_UK + 4 * I_LR;
    for (int it = gw; it < NITEMS; it += NGW) {
        int r = it;
        if (r < I_IN) { if (MK_F8_GEMM1) conv_t_item_f8(p.w_in, DM, 3016, (unsigned char*)WIN, NPROJ / 32, r, scr, lane, 32.f, true); else conv_t_item(p.w_in, DM, 3016, WIN, NPROJ / 32, r, scr, lane, true); continue; } r -= I_IN;
        if (r < I_OUT) { conv_t_item(p.w_out, DM, DM, WOUT, DM / 32, r, scr, lane, false); continue; } r -= I_OUT;
        if (r < I_1) { conv_t_item(p.w_ff1, DM, FF, W1, FF / 32, r, scr, lane, false); continue; } r -= I_1;
        if (r < I_2) { conv_t_item_f8(p.w_ff2, FF, DM, (unsigned char*)W2, DM / 32, r, scr, lane, 64.f); continue; } r -= I_2;
        if (r < I_UK) { conv_t_item(p.w_uk, 128, 512, WUKT, 512 / 32, r, scr, lane, false); continue; } r -= I_UK;
        if (r < I_UK) { conv_t_item(p.w_uv, 128, 512, WUVT, 512 / 32, r, scr, lane, false); continue; } r -= I_UK;
        if (r < I_LR) { conv_t_item(p.w2, 64, 512, (bf16*)(p.ws + WS_W2T), 512 / 32, r, scr, lane, false); continue; } r -= I_LR;
        if (r < I_LR) { conv_t_item(p.a2, 64, 512, (bf16*)(p.ws + WS_A2T), 512 / 32, r, scr, lane, false); continue; } r -= I_LR;
        conv_t_item(p.g2, 128, 512, (bf16*)(p.ws + WS_G2T), 512 / 32, r, scr, lane, false);
    }
    { float* ROWSQ = (float*)(p.ws + WS_ROWSQ); for (int i = blockIdx.x * 512 + tid; i < M; i += G * 512) ROWSQ[i] = 0.f; }
    for (int i = blockIdx.x * 512 + tid; i < 128 * 512 / 2; i += G * 512) { const float a = p.w_uk[2 * i], b = p.w_uk[2 * i + 1]; ((unsigned*)WUK)[i] = pk2(a, b); }
}

template <bool F8OUT> __device__ __forceinline__ void hn_rows(const float* src, const float* g, const float* mod, int off_sh, int off_sc, bf16* dst, int gw, int NGW, int lane) {
    const int RPW = M / NGW;
    for (int m0 = gw * RPW; m0 < M; m0 += NGW * RPW) {
        const float* mb = mod + (size_t)(m0 >> 11) * 6144;
        f32x4 ga[4], sh[4];
#pragma unroll
        for (int j = 0; j < 4; ++j) { const int col = 4 * lane + 256 * j; const f32x4 gg = *(const f32x4*)(g + col), sc = *(const f32x4*)(mb + off_sc + col); ga[j] = gg * (1.f + sc); sh[j] = *(const f32x4*)(mb + off_sh + col); }
        for (int r0 = 0; r0 < RPW; r0 += 4) {
            f32x4 v[4][4]; float s[4];
#pragma unroll
            for (int r = 0; r < 4; ++r) { const f32x4* xr = (const f32x4*)(src + (size_t)(m0 + r0 + r) * DM) + lane;
#pragma unroll
                for (int j = 0; j < 4; ++j) v[r][j] = xr[64 * j]; }
#pragma unroll
            for (int r = 0; r < 4; ++r) { s[r] = 0.f;
#pragma unroll
                for (int j = 0; j < 4; ++j) s[r] += (v[r][j].x * v[r][j].x + v[r][j].y * v[r][j].y) + (v[r][j].z * v[r][j].z + v[r][j].w * v[r][j].w); }
#pragma unroll
            for (int o = 1; o < 64; o <<= 1) {
#pragma unroll
                for (int r = 0; r < 4; ++r) s[r] += __shfl_xor(s[r], o); }
#pragma unroll
            for (int r = 0; r < 4; ++r) { const int m = m0 + r0 + r; const float rstd = rsqrtf(s[r] * (1.f / DM) + 1e-6f);
                unsigned long long* o8 = (unsigned long long*)(dst + (size_t)m * DM) + lane;
#pragma unroll
                for (int j = 0; j < 4; ++j) { const f32x4 y = v[r][j] * rstd * ga[j] + sh[j];
                    if (F8OUT) ((unsigned*)((unsigned char*)dst + (size_t)m * DM))[lane + 64 * j] = pg8::pk4_fp8(y.x, y.y, y.z, y.w);
                    else o8[64 * j] = (unsigned long long)pk2(y.x, y.y) | ((unsigned long long)pk2(y.z, y.w) << 32); } }
        }
    }
}

typedef short s16x4 __attribute__((ext_vector_type(4)));
__device__ __forceinline__ f32x4 mfma16k(s16x4 a, s16x4 b, f32x4 c) { return __builtin_amdgcn_mfma_f32_16x16x16bf16_1k(a, b, c, 0, 0, 0); }
__device__ __forceinline__ s16x4 pack4(f32x4 v) { u32x2 o; o.x = pk2(v[0], v[1]); o.y = pk2(v[2], v[3]); return __builtin_bit_cast(s16x4, o); }

__device__ __forceinline__ float dpp_row_sum16(float x) {
    x += __builtin_bit_cast(float, __builtin_amdgcn_mov_dpp(__builtin_bit_cast(int, x), 0xB1, 0xF, 0xF, true));
    x += __builtin_bit_cast(float, __builtin_amdgcn_mov_dpp(__builtin_bit_cast(int, x), 0x4E, 0xF, 0xF, true));
    x += __builtin_bit_cast(float, __builtin_amdgcn_mov_dpp(__builtin_bit_cast(int, x), 0x141, 0xF, 0xF, true));
    x += __builtin_bit_cast(float, __builtin_amdgcn_mov_dpp(__builtin_bit_cast(int, x), 0x140, 0xF, 0xF, true));
    return x;
}
__device__ __forceinline__ void rwkv_prep_item(const Params& p, unsigned char* lds, int it, int tid_in) {
    int tid = tid_in; asm volatile("" : "+v"(tid));
    const int lane = tid & 63, wv = __builtin_amdgcn_readfirstlane(tid >> 6);
    bf16* XS = (bf16*)lds;
    bf16* STG = (bf16*)(lds + 32768) + wv * 4096;
    float* MAB = (float*)(lds + 98304) + wv * 256;
    bf16* RKV = (bf16*)(lds + 106496) + wv * 3264;
    const bf16* PROJ = (const bf16*)(p.ws + WS_PROJ);
    const bf16* W2T = (const bf16*)(p.ws + WS_W2T); const bf16* A2T = (const bf16*)(p.ws + WS_A2T); const bf16* G2T = (const bf16*)(p.ws + WS_G2T);
    float* GAM = (float*)(p.ws + WS_GAM); float* C3 = (float*)(p.ws + WS_C3); bf16* GB = (bf16*)(p.ws + WS_G);
    const int row0 = it * 64, t0 = (it & 31) * 64, b = it >> 5;
    __syncthreads();
    {   const int xt = tid >> 5, xch = tid & 31;
        const f32x4 m0_ = *(const f32x4*)(p.mu + 1536 + 8 * xch), m1_ = *(const f32x4*)(p.mu + 1536 + 8 * xch + 4); const float sc_ = xch < 8 ? 2.f : -1.f;
        u32x4 xc[4], xp[4];
#pragma unroll
        for (int qq = 0; qq < 4; ++qq) { const int t = xt + 16 * qq; const bf16* src_ = PROJ + (size_t)(row0 + t) * NPROJ + PC_XW + 8 * xch; xc[qq] = *(const u32x4*)src_;
            xp[qq] = (u32x4){0u, 0u, 0u, 0u}; if (t0 + t != 0) xp[qq] = *(const u32x4*)(src_ - NPROJ); }
#pragma unroll
        for (int qq = 0; qq < 4; ++qq) { float o_[8];
#pragma unroll
            for (int i = 0; i < 4; ++i) { const float c0_ = bflo(xc[qq][i]), c1_ = bfhi(xc[qq][i]), p0_ = bflo(xp[qq][i]), p1_ = bfhi(xp[qq][i]);
                const float ma_ = i < 2 ? m0_[2 * i] : m1_[2 * i - 4], mb_ = i < 2 ? m0_[2 * i + 1] : m1_[2 * i - 3];
                const float v0_ = c0_ + ma_ * (p0_ - c0_), v1_ = c1_ + mb_ * (p1_ - c1_);
                const float r0_ = 1.f / (1.f + __expf(sc_ * v0_)), r1_ = 1.f / (1.f + __expf(sc_ * v1_));
                o_[2 * i] = xch < 8 ? 1.f - 2.f * r0_ : (xch < 16 ? v0_ : r0_); o_[2 * i + 1] = xch < 8 ? 1.f - 2.f * r1_ : (xch < 16 ? v1_ : r1_); }
            *(u32x4*)(XS + (xt + 16 * qq) * 256 + 8 * xch) = (u32x4){pk2(o_[0], o_[1]), pk2(o_[2], o_[3]), pk2(o_[4], o_[5]), pk2(o_[6], o_[7])}; }
    }
    u32x4 RK[7];
#define RKV_LOAD(rowb, tb) do { _Pragma("unroll") for (int i = 0; i < 7; ++i) { const int id_ = i * 64 + lane, mat_ = id_ / 136, rem_ = id_ - 136 * mat_, rw_ = rem_ >> 3, ch_ = rem_ & 7; \
        RK[i] = (u32x4){0u, 0u, 0u, 0u}; if (id_ < 408 && (tb) - 1 + rw_ >= 0) RK[i] = *(const u32x4*)(PROJ + (size_t)((rowb) - 1 + rw_) * NPROJ + PC_R + 512 * mat_ + wv * 64 + 8 * ch_); } } while (0)
#define RKV_WRITE() do { _Pragma("unroll") for (int i = 0; i < 7; ++i) { const int id_ = i * 64 + lane, mat_ = id_ / 136, rem_ = id_ - 136 * mat_, rw_ = rem_ >> 3, ch_ = rem_ & 7; \
        if (id_ < 408) *(u32x4*)(RKV + mat_ * 1088 + rw_ * 64 + 8 * ch_) = RK[i]; } } while (0)
    RKV_LOAD(row0, t0);
    __syncthreads();
#pragma unroll 1
    for (int q = 0; q < 4; ++q) {
        const int rowq = row0 + 16 * q, tq = t0 + 16 * q;
        int lane_ = lane; asm volatile("" : "+v"(lane_));
        const int n_ = lane_ & 15, grp_ = lane_ >> 4;
        const size_t idx = (size_t)(b * 8 + wv) * 128 + (tq >> 4);
        unsigned char* CHp = p.ws + WS_CH + idx * 12288;
        RKV_WRITE();
        if (q < 3) RKV_LOAD(rowq + 16, tq + 16);
        f32x4 dw[4], da[4];
        {   bf16x8 xa[8];
#pragma unroll
            for (int ks = 0; ks < 8; ++ks) xa[ks] = *(const bf16x8*)(XS + (16 * q + n_) * 256 + 32 * ks + 8 * grp_);
            bf16x8 wf[2][8];
#define LORA_LOADW(dst_, ct_) do { const int cc_ = wv * 64 + 16 * (ct_) + n_; \
                _Pragma("unroll") for (int ks = 0; ks < 2; ++ks) { dst_[ks] = *(const bf16x8*)(W2T + cc_ * 64 + 32 * ks + 8 * grp_); dst_[2 + ks] = *(const bf16x8*)(A2T + cc_ * 64 + 32 * ks + 8 * grp_); } \
                _Pragma("unroll") for (int ks = 0; ks < 4; ++ks) dst_[4 + ks] = *(const bf16x8*)(G2T + cc_ * 128 + 32 * ks + 8 * grp_); } while (0)
            LORA_LOADW(wf[0], 0);
#pragma unroll
            for (int ct = 0; ct < 4; ++ct) { const int cc = wv * 64 + 16 * ct + n_;
                if (ct < 3) LORA_LOADW(wf[(ct + 1) & 1], ct + 1);
                f32x4 dg = {0.f, 0.f, 0.f, 0.f}; dw[ct] = dg; da[ct] = dg;
#pragma unroll
                for (int ks = 0; ks < 2; ++ks) dw[ct] = mfma16(xa[ks], wf[ct & 1][ks], dw[ct]);
#pragma unroll
                for (int ks = 0; ks < 2; ++ks) da[ct] = mfma16(xa[2 + ks], wf[ct & 1][2 + ks], da[ct]);
#pragma unroll
                for (int ks = 0; ks < 4; ++ks) dg = mfma16(xa[4 + ks], wf[ct & 1][4 + ks], dg);
#pragma unroll
                for (int rg = 0; rg < 4; ++rg) GB[(size_t)(rowq + 4 * grp_ + rg) * 512 + cc] = f2bf(dg[rg]); }
#undef LORA_LOADW
        }
        asm volatile("s_waitcnt lgkmcnt(0)" ::: "memory");
        {   float kkvA[4][4], kkaA[4][4], kprA[4][4], rA[4][4], vA[4][4], wA[4][4], nrm[4], c3s[4];
#pragma unroll
            for (int rg = 0; rg < 4; ++rg) { nrm[rg] = 0.f; c3s[rg] = 0.f; }
#pragma unroll
            for (int ct = 0; ct < 4; ++ct) { const int j = 16 * ct + n_, c = wv * 64 + j;
                const float mu_r = p.mu[c], mu_k = p.mu[512 + c], mu_v = p.mu[1024 + c], w0c = p.w0[c], a0c = p.a0[c], kkc = p.k_k[c], kac = p.k_a[c], rkc = p.r_k[c];
#pragma unroll
                for (int rg = 0; rg < 4; ++rg) { const int t = 4 * grp_ + rg;
                    const float rp = bf2f(RKV[t * 64 + j]), rc = bf2f(RKV[(t + 1) * 64 + j]);
                    const float kp = bf2f(RKV[1088 + t * 64 + j]), kc = bf2f(RKV[1088 + (t + 1) * 64 + j]);
                    const float vp = bf2f(RKV[2176 + t * 64 + j]), vc = bf2f(RKV[2176 + (t + 1) * 64 + j]);
                    const float r = rc + mu_r * (rp - rc), k = kc + mu_k * (kp - kc); vA[ct][rg] = vc + mu_v * (vp - vc); rA[ct][rg] = r;
                    const float u = w0c + dw[ct][rg]; const float wlog = -__logf(1.f + __expf(-u)) - 0.5f; wA[ct][rg] = __expf(-__expf(wlog));
                    const float a = 1.f / (1.f + __expf(-(a0c + da[ct][rg])));
                    const float kkv = k * kkc, kpr = k * (1.f + (a - 1.f) * kac); kkvA[ct][rg] = kkv; kkaA[ct][rg] = kkv * a; kprA[ct][rg] = kpr;
                    nrm[rg] += kkv * kkv; c3s[rg] += r * kpr * rkc; } }
            float inrm[4];
#pragma unroll
            for (int rg = 0; rg < 4; ++rg) { nrm[rg] = dpp_row_sum16(nrm[rg]); c3s[rg] = dpp_row_sum16(c3s[rg]); inrm[rg] = 1.f / fmaxf(sqrtf(nrm[rg]), 1e-12f); }
            if (n_ == 0) {
#pragma unroll
                for (int rg = 0; rg < 4; ++rg) C3[(size_t)(rowq + 4 * grp_ + rg) * 8 + wv] = c3s[rg]; }
#pragma unroll
            for (int ct = 0; ct < 4; ++ct) { const int j = 16 * ct + n_;
                float lp[4]; lp[0] = wA[ct][0]; lp[1] = lp[0] * wA[ct][1]; lp[2] = lp[1] * wA[ct][2]; lp[3] = lp[2] * wA[ct][3];
                const float P0 = __shfl(lp[3], n_), P1 = __shfl(lp[3], n_ + 16), P2 = __shfl(lp[3], n_ + 32);
                const float E = grp_ == 0 ? 1.f : (grp_ == 1 ? P0 : (grp_ == 2 ? P0 * P1 : P0 * P1 * P2));
                float bt[4], kt[4];
#pragma unroll
                for (int rg = 0; rg < 4; ++rg) { const int t = 4 * grp_ + rg;
                    const float gam = E * lp[rg], gprev = rg == 0 ? E : E * lp[rg - 1], ig = 1.f / gam;
                    STG[t * 64 + j] = f2bf(-kkvA[ct][rg] * inrm[rg] * gprev); STG[1024 + t * 64 + j] = f2bf(rA[ct][rg] * gam);
                    bt[rg] = kkaA[ct][rg] * inrm[rg] * ig; kt[rg] = kprA[ct][rg] * ig;
                    STG[2048 + t * 64 + j] = f2bf(bt[rg]); STG[3072 + t * 64 + j] = f2bf(kt[rg]); }
                *(u32x2*)(CHp + 4096 + j * 32 + grp_ * 8) = (u32x2){pk2(bt[0], bt[1]), pk2(bt[2], bt[3])};
                *(u32x2*)(CHp + 6144 + j * 32 + grp_ * 8) = (u32x2){pk2(kt[0], kt[1]), pk2(kt[2], kt[3])};
                *(u32x2*)(CHp + 8192 + j * 32 + grp_ * 8) = (u32x2){pk2(vA[ct][0], vA[ct][1]), pk2(vA[ct][2], vA[ct][3])};
                if (grp_ == 3) GAM[idx * 64 + j] = E * lp[3]; }
        }
        asm volatile("s_waitcnt lgkmcnt(0)" ::: "memory");
        {   f32x4 mab = {0.f, 0.f, 0.f, 0.f}, mak = mab, nrb = mab, nrk = mab;
#pragma unroll
            for (int ks = 0; ks < 4; ++ks) { const int o = n_ * 64 + 16 * ks + 4 * grp_;
                const s16x4 fa = *(const s16x4*)(STG + o), fr = *(const s16x4*)(STG + 1024 + o), fb = *(const s16x4*)(STG + 2048 + o), fk = *(const s16x4*)(STG + 3072 + o);
                mab = mfma16k(fa, fb, mab); mak = mfma16k(fa, fk, mak); nrb = mfma16k(fr, fb, nrb); nrk = mfma16k(fr, fk, nrk); }
            asm volatile("s_waitcnt lgkmcnt(0)" ::: "memory");
            bf16* SM = STG + 2048;
#pragma unroll
            for (int rg = 0; rg < 4; ++rg) { const int t = 4 * grp_ + rg; const bool sl = t > n_, il = t >= n_;
                MAB[t * 16 + n_] = sl ? mab[rg] : 0.f;
                SM[256 + t * 16 + n_] = f2bf(sl ? mak[rg] : 0.f); SM[512 + t * 16 + n_] = f2bf(il ? nrb[rg] : 0.f); SM[768 + t * 16 + n_] = f2bf(il ? nrk[rg] : 0.f); }
            asm volatile("s_waitcnt lgkmcnt(0)" ::: "memory");
            if (lane_ < 16) {
                float Tc[16];
#pragma unroll
                for (int t = 0; t < 16; ++t) { float acc = (t == lane_) ? 1.f : 0.f;
#pragma unroll
                    for (int s2 = 0; s2 < t; ++s2) acc = fmaf(MAB[t * 16 + s2], Tc[s2], acc);
                    Tc[t] = acc; SM[t * 16 + lane_] = f2bf(acc); }
            }
            asm volatile("s_waitcnt lgkmcnt(0)" ::: "memory");
#pragma unroll
            for (int i = 0; i < 4; ++i) { const int id = i * 64 + lane_; *(u32x4*)(CHp + id * 16) = *(const u32x4*)((const unsigned char*)STG + id * 16); }
#pragma unroll
            for (int i = 0; i < 2; ++i) { const int id = i * 64 + lane_; *(u32x4*)(CHp + 10240 + id * 16) = *(const u32x4*)((const unsigned char*)SM + id * 16); }
        }
    }
#undef RKV_LOAD
#undef RKV_WRITE
}

__device__ __forceinline__ void stage_w_lds(const bf16* W, unsigned char* lds, int log2_cpr  , int tid) {
    const int cpr = 1 << log2_cpr;
#pragma unroll 4
    for (int i = 0; i < 16; ++i) { const int id = i * 512 + tid, row = id >> log2_cpr, ch = id & (cpr - 1);
        *(u32x4*)(lds + ((size_t)row << (log2_cpr + 4)) + (((ch & ~15) | ((ch ^ row) & 15)) << 4)) = *(const u32x4*)((const unsigned char*)W + (size_t)id * 16); }
}
__device__ __forceinline__ bf16x8 lds_wfrag(const unsigned char* lds, int row, int ch, int log2_cpr) {
    return *(const bf16x8*)(lds + ((size_t)row << (log2_cpr + 4)) + (((ch & ~15) | ((ch ^ row) & 15)) << 4));
}
__device__ __forceinline__ void dsa_prep_kv(const Params& p, const unsigned char* wl, int tile, int lane) {
    const bf16* PROJ = (const bf16*)(p.ws + WS_PROJ); bf16* CKV = (bf16*)(p.ws + WS_CKV); float* INVR = (float*)(p.ws + WS_INVR);
    const int r = lane & 31, hh = lane >> 5; const size_t row = (size_t)tile * 32 + r; const bf16* prow = PROJ + row * NPROJ;
    bf16x8 cf[8];
    {   u32x4 craw[8]; float ssq = 0.f;
#pragma unroll
        for (int s = 0; s < 8; ++s) { craw[s] = *(const u32x4*)(prow + PC_CL + 16 * s + 8 * hh);
#pragma unroll
            for (int w = 0; w < 4; ++w) { const float lo = bflo(craw[s][w]), hi = bfhi(craw[s][w]); ssq += lo * lo + hi * hi; } }
        ssq += __shfl_xor(ssq, 32);
        const float rstd = rsqrtf(ssq * (1.f / 128.f) + 1e-6f);
#pragma unroll
        for (int s = 0; s < 8; ++s) { const float* g = p.g_kv + 16 * s + 8 * hh; const f32x4 g0 = *(const f32x4*)g, g1 = *(const f32x4*)(g + 4);
            u32x4 o; o.x = pk2(bflo(craw[s].x) * rstd * g0.x, bfhi(craw[s].x) * rstd * g0.y); o.y = pk2(bflo(craw[s].y) * rstd * g0.z, bfhi(craw[s].y) * rstd * g0.w);
            o.z = pk2(bflo(craw[s].z) * rstd * g1.x, bfhi(craw[s].z) * rstd * g1.y); o.w = pk2(bflo(craw[s].w) * rstd * g1.z, bfhi(craw[s].w) * rstd * g1.w);
            cf[s] = __builtin_bit_cast(bf16x8, o); *(u32x4*)(CKV + row * 128 + 16 * s + 8 * hh) = o; }
    }
    unsigned wb[8];
#pragma unroll
    for (int s = 0; s < 8; ++s) wb[s] = (unsigned)(r * 256 + ((((2 * s + hh) ^ r) & 15) << 4));
#pragma unroll 1
    for (int h = 0; h < 8; ++h) { float ss = 0.f;
#pragma unroll
        for (int dt = 0; dt < 2; ++dt) { f32x16 acc = {}; const unsigned char* wg = wl + (h * 64 + dt * 32) * 256;
#pragma unroll
            for (int s = 0; s < 8; ++s) acc = mfma32(*(const bf16x8*)(wg + wb[s]), cf[s], acc);
#pragma unroll
            for (int i = 0; i < 16; ++i) ss += acc[i] * acc[i]; }
        ss += __shfl_xor(ss, 32);
        if (hh == 0) INVR[row * 8 + h] = rsqrtf(ss * (1.f / 64.f) + 1e-6f);
    }
}
__device__ __forceinline__ void dsa_prep_q(const Params& p, const unsigned char* wl, int tile, int lane) {
    const bf16* PROJ = (const bf16*)(p.ws + WS_PROJ); bf16* QABS = (bf16*)(p.ws + WS_REGA);
    const int r = lane & 31, hh = lane >> 5; const size_t row = (size_t)tile * 32 + r; const bf16* prow = PROJ + row * NPROJ;
    unsigned wb[2][4];
#pragma unroll
    for (int hp = 0; hp < 2; ++hp)
#pragma unroll
        for (int s = 0; s < 4; ++s) wb[hp][s] = (unsigned)(r * 1024 + ((((hp * 8 + 2 * s + hh) ^ r) & 15) << 4));
#pragma unroll 2
    for (int h = 0; h < 8; ++h) {
        u32x4 qraw[4]; float ssq = 0.f;
#pragma unroll
        for (int s = 0; s < 4; ++s) { qraw[s] = *(const u32x4*)(prow + PC_Q + h * 64 + 16 * s + 8 * hh);
#pragma unroll
            for (int w = 0; w < 4; ++w) { const float lo = bflo(qraw[s][w]), hi = bfhi(qraw[s][w]); ssq += lo * lo + hi * hi; } }
        ssq += __shfl_xor(ssq, 32);
        const float rstd = rsqrtf(ssq * (1.f / 64.f) + 1e-6f);
        bf16x8 qf[4];
#pragma unroll
        for (int s = 0; s < 4; ++s) { const int d0 = 16 * s + 8 * hh; float gg[8];
#pragma unroll
            for (int j = 0; j < 8; ++j) gg[j] = p.g_q[d0 + j] * p.g_k[d0 + j] * rstd;
            u32x4 o; o.x = pk2(bflo(qraw[s].x) * gg[0], bfhi(qraw[s].x) * gg[1]); o.y = pk2(bflo(qraw[s].y) * gg[2], bfhi(qraw[s].y) * gg[3]);
            o.z = pk2(bflo(qraw[s].z) * gg[4], bfhi(qraw[s].z) * gg[5]); o.w = pk2(bflo(qraw[s].w) * gg[6], bfhi(qraw[s].w) * gg[7]);
            qf[s] = __builtin_bit_cast(bf16x8, o); }
#pragma unroll
        for (int lt = 0; lt < 4; ++lt) { f32x16 acc = {}; const unsigned char* wg = wl + lt * 32768 + (h >> 1) * 256;
#pragma unroll
            for (int s = 0; s < 4; ++s) acc = mfma32(*(const bf16x8*)(wg + wb[h & 1][s]), qf[s], acc);
#pragma unroll
            for (int g4 = 0; g4 < 4; ++g4) { u32x2 o; o.x = pk2(acc[4 * g4] * 0.125f, acc[4 * g4 + 1] * 0.125f); o.y = pk2(acc[4 * g4 + 2] * 0.125f, acc[4 * g4 + 3] * 0.125f);
                *(u32x2*)(QABS + row * 1024 + h * 128 + lt * 32 + 8 * g4 + 4 * hh) = o; } }
    }
}

constexpr int SCAN_D = 8, SCAN_SLOT = 12288 + 256;
#define SCAN_BAR() do { asm volatile("s_waitcnt lgkmcnt(0)" ::: "memory"); __builtin_amdgcn_s_barrier(); asm volatile("" ::: "memory"); } while (0)
__device__ __forceinline__ void rwkv_scan_chain(const Params& p, unsigned char* lds, int chain, int wv, int lane) {
    const int b = chain >> 3, h = chain & 7;
    const size_t idx0 = (size_t)(b * 8 + h) * 128;
    if (wv >= 4) {
        const int li = (wv - 4) * 64 + lane;
        const unsigned char* src = p.ws + WS_CH + idx0 * 12288 + (size_t)li * 16; const float* gsrc = (const float*)(p.ws + WS_GAM) + idx0 * 64 + (li & 15) * 4;
        u32x4 R[SCAN_D][3]; f32x4 Rg[SCAN_D];
#pragma unroll
        for (int j = 0; j < SCAN_D; ++j) {
#pragma unroll
            for (int i = 0; i < 3; ++i) R[j][i] = *(const u32x4*)(src + (size_t)j * 12288 + i * 4096);
            Rg[j] = *(const f32x4*)(gsrc + (size_t)j * 64); }
        for (int k0 = 0; k0 < 128; k0 += SCAN_D) {
#pragma unroll
            for (int j = 0; j < SCAN_D; ++j) { const int k = k0 + j; unsigned char* slot = lds + (k & 1) * SCAN_SLOT;
#pragma unroll
                for (int i = 0; i < 3; ++i) *(u32x4*)(slot + li * 16 + i * 4096) = R[j][i];
                *(f32x4*)(slot + 12288 + (li & 15) * 16) = Rg[j];
                if (k + SCAN_D < 128) {
#pragma unroll
                    for (int i = 0; i < 3; ++i) R[j][i] = *(const u32x4*)(src + (size_t)(k + SCAN_D) * 12288 + i * 4096);
                    Rg[j] = *(const f32x4*)(gsrc + (size_t)(k + SCAN_D) * 64); }
                SCAN_BAR(); } }
    } else {
        const int w = wv, n = lane & 15, grp = lane >> 4;
        bf16* PROJ = (bf16*)(p.ws + WS_PROJ);
        f32x4 S[4];
#pragma unroll
        for (int jt = 0; jt < 4; ++jt) S[jt] = (f32x4){0.f, 0.f, 0.f, 0.f};
        for (int sc = 0; sc < 128; ++sc) {
            SCAN_BAR();
            const unsigned char* CHp = lds + (sc & 1) * SCAN_SLOT;
            s16x4 at[4], rt[4], bt[4], kt[4]; f32x4 gm[4];
#pragma unroll
            for (int jt = 0; jt < 4; ++jt) {
                at[jt] = *(const s16x4*)(CHp + n * 128 + (16 * jt + 4 * grp) * 2); rt[jt] = *(const s16x4*)(CHp + 2048 + n * 128 + (16 * jt + 4 * grp) * 2);
                bt[jt] = *(const s16x4*)(CHp + 4096 + (16 * jt + n) * 32 + grp * 8); kt[jt] = *(const s16x4*)(CHp + 6144 + (16 * jt + n) * 32 + grp * 8);
                gm[jt] = *(const f32x4*)(CHp + 12288 + (16 * jt + 4 * grp) * 4); }
            const s16x4 vt = *(const s16x4*)(CHp + 8192 + (16 * w + n) * 32 + grp * 8);
            const s16x4 Tm = *(const s16x4*)(CHp + 10240 + n * 32 + grp * 8), Mak = *(const s16x4*)(CHp + 10752 + n * 32 + grp * 8);
            const s16x4 Nrb = *(const s16x4*)(CHp + 11264 + n * 32 + grp * 8), Nrk = *(const s16x4*)(CHp + 11776 + n * 32 + grp * 8);
            s16x4 Sb[4];
#pragma unroll
            for (int jt = 0; jt < 4; ++jt) Sb[jt] = pack4(S[jt]);
            f32x4 X = {0.f, 0.f, 0.f, 0.f}, O = X;
#pragma unroll
            for (int jt = 0; jt < 4; ++jt) X = mfma16k(at[jt], Sb[jt], X);
            X = mfma16k(Mak, vt, X);
#pragma unroll
            for (int jt = 0; jt < 4; ++jt) O = mfma16k(rt[jt], Sb[jt], O);
            O = mfma16k(Nrk, vt, O);
            const f32x4 U = mfma16k(Tm, pack4(X), (f32x4){0.f, 0.f, 0.f, 0.f});
            const s16x4 Ub = pack4(U);
            O = mfma16k(Nrb, Ub, O);
#pragma unroll
            for (int jt = 0; jt < 4; ++jt) { S[jt] = mfma16k(kt[jt], vt, S[jt]); S[jt] = mfma16k(bt[jt], Ub, S[jt]); S[jt] = S[jt] * gm[jt]; }
            bf16* orow = PROJ + ((size_t)b * SEQ + sc * 16 + 4 * grp) * NPROJ + PC_R + h * 64 + 16 * w + n;
#pragma unroll
            for (int rg = 0; rg < 4; ++rg) orow[(size_t)rg * NPROJ] = f2bf(O[rg]);
        }
    }
}
__device__ __forceinline__ void rwkv_epi_rows(const Params& p, int gw, int NGW, int lane) {
    bf16* PROJ = (bf16*)(p.ws + WS_PROJ); const bf16* GB = (const bf16*)(p.ws + WS_G); const float* C3 = (const float*)(p.ws + WS_C3);
    const int c0 = lane * 8, h = lane >> 3, RPW = M / NGW;
    float muv[8], lw[8], lb[8];
#pragma unroll
    for (int i = 0; i < 8; ++i) { muv[i] = p.mu[1024 + c0 + i]; lw[i] = p.ln_w[c0 + i]; lb[i] = p.ln_b[c0 + i]; }
    for (int m0 = gw * RPW; m0 < M; m0 += NGW * RPW) {
        u32x4 vprev = {0u, 0u, 0u, 0u}; if ((m0 & (SEQ - 1)) != 0) vprev = *(const u32x4*)(PROJ + (size_t)(m0 - 1) * NPROJ + PC_V + c0);
        for (int r0 = 0; r0 < RPW; r0 += 4) {
            u32x4 oraw[4], vc[4], gr[4]; float c3[4];
#pragma unroll
            for (int r = 0; r < 4; ++r) { const size_t m = (size_t)(m0 + r0 + r); const bf16* prow = PROJ + m * NPROJ;
                oraw[r] = *(const u32x4*)(prow + PC_R + c0); vc[r] = *(const u32x4*)(prow + PC_V + c0); gr[r] = *(const u32x4*)(GB + m * 512 + c0); c3[r] = C3[m * 8 + h]; }
            float o[4][8], sm[4], q[4];
#pragma unroll
            for (int r = 0; r < 4; ++r) { sm[r] = 0.f;
#pragma unroll
                for (int i = 0; i < 4; ++i) { o[r][2 * i] = bflo(oraw[r][i]); o[r][2 * i + 1] = bfhi(oraw[r][i]); sm[r] += o[r][2 * i] + o[r][2 * i + 1]; } }
#pragma unroll
            for (int of = 1; of < 8; of <<= 1) {
#pragma unroll
                for (int r = 0; r < 4; ++r) sm[r] += __shfl_xor(sm[r], of); }
#pragma unroll
            for (int r = 0; r < 4; ++r) { const float mean = sm[r] * (1.f / 64.f); q[r] = 0.f;
#pragma unroll
                for (int i = 0; i < 8; ++i) { o[r][i] -= mean; q[r] += o[r][i] * o[r][i]; } }
#pragma unroll
            for (int of = 1; of < 8; of <<= 1) {
#pragma unroll
                for (int r = 0; r < 4; ++r) q[r] += __shfl_xor(q[r], of); }
#pragma unroll
            for (int r = 0; r < 4; ++r) { const float rstd = rsqrtf(q[r] * (1.f / 64.f) + 64e-5f); const u32x4 vp = r == 0 ? vprev : vc[r - 1];
                const bool first = ((m0 + r0 + r) & (SEQ - 1)) == 0;
                u32x4 out;
#pragma unroll
                for (int i = 0; i < 4; ++i) { float y[2];
#pragma unroll
                    for (int e = 0; e < 2; ++e) { const int ii = 2 * i + e; const float cv = e ? bfhi(vc[r][i]) : bflo(vc[r][i]), pv = first ? 0.f : (e ? bfhi(vp[i]) : bflo(vp[i]));
                        const float v = cv + muv[ii] * (pv - cv), g = e ? bfhi(gr[r][i]) : bflo(gr[r][i]);
                        y[e] = (o[r][ii] * rstd * lw[ii] + lb[ii] + c3[r] * v) * g; }
                    out[i] = pk2(y[0], y[1]); }
                *(u32x4*)(PROJ + (size_t)(m0 + r0 + r) * NPROJ + PC_R + c0) = out; }
            vprev = vc[3];
        }
    }
}

__device__ __forceinline__ unsigned f2key(float f) { unsigned b = __float_as_uint(f); if ((b << 1) == 0u) b = 0u; return (b & 0x80000000u) ? ~b : (b | 0x80000000u); }
__device__ __forceinline__ unsigned offb(unsigned row, unsigned ch) { return 2048u * (row >> 3) + 512u * (ch >> 2) + 64u * (row & 7) + 16u * ((ch & 3) ^ ((row >> 2) & 3)); }

__device__ __forceinline__ void topk_select(float* sc, int N, unsigned* hist, unsigned short* sel, int lane) {
    unsigned* kb = (unsigned*)sc;
    unsigned prefix = 0u, mask = 0u; int rem = 256, mbin = 0;
    const unsigned long long lt_mask = (1ull << lane) - 1ull;
    for (int pass = 0; pass < 4; ++pass) {
        const int shift = 24 - 8 * pass;
#pragma unroll
        for (int i = 0; i < 4; ++i) hist[lane * 4 + i] = 0u;
        asm volatile("s_waitcnt lgkmcnt(0)" ::: "memory");
        for (int base = 0; base < N; base += 256) { const int idx = base + 4 * lane;
            if (idx < N) { u32x4 k4;
                if (pass == 0) { const f32x4 v = *(const f32x4*)(sc + idx); k4 = (u32x4){f2key(v.x), f2key(v.y), f2key(v.z), f2key(v.w)}; *(u32x4*)(kb + idx) = k4; }
                else k4 = *(const u32x4*)(kb + idx);
#pragma unroll
                for (int e = 0; e < 4; ++e) if ((k4[e] & mask) == prefix) atomicAdd(&hist[(k4[e] >> shift) & 255u], 1u); } }
        asm volatile("s_waitcnt lgkmcnt(0)" ::: "memory");
        const unsigned c0 = hist[lane * 4], c1 = hist[lane * 4 + 1], c2 = hist[lane * 4 + 2], c3 = hist[lane * 4 + 3];
        const int cnt4 = (int)(c0 + c1 + c2 + c3);
        int incl = cnt4;
#pragma unroll
        for (int o = 1; o < 64; o <<= 1) { const int v = __shfl_down(incl, o); if (lane + o < 64) incl += v; }
        const int excl = incl - cnt4;
        const bool mine = (excl < rem) && (rem <= incl);
        const unsigned long long bal = __ballot(mine);
        const int L = (int)__builtin_ctzll(bal);
        const int ex = __shfl(excl, L); const int b3 = (int)__shfl((int)c3, L), b2 = (int)__shfl((int)c2, L), b1 = (int)__shfl((int)c1, L), b0 = (int)__shfl((int)c0, L);
        int above = ex, bin;
        if (above + b3 >= rem) { bin = 3; mbin = b3; } else { above += b3; if (above + b2 >= rem) { bin = 2; mbin = b2; } else { above += b2; if (above + b1 >= rem) { bin = 1; mbin = b1; } else { above += b1; bin = 0; mbin = b0; } } }
        rem -= above; prefix |= (unsigned)(L * 4 + bin) << shift; mask |= 0xffu << shift;
        if (pass == 1 && mbin <= 64) break;
    }
    const unsigned T = prefix; const int ngt = 256 - rem; int base_gt = 0, base_eq = 0;
    const bool partial = (mask != 0xffffffffu);
    unsigned short* cand = (unsigned short*)hist;
    for (int base = 0; base < N; base += 256) { const int idx = base + 4 * lane; const bool act = idx < N;
        u32x4 k4 = {0u, 0u, 0u, 0u}; if (act) k4 = *(const u32x4*)(kb + idx);
        bool gt[4], eq[4]; unsigned long long bg[4], be[4];
#pragma unroll
        for (int e = 0; e < 4; ++e) { const unsigned km = k4[e] & mask; gt[e] = act && km > T; eq[e] = act && km == T; bg[e] = __ballot(gt[e]); be[e] = __ballot(eq[e]); }
        int rg = base_gt, re = base_eq;
#pragma unroll
        for (int e = 0; e < 4; ++e) re += __popcll(be[e] & lt_mask);
#pragma unroll
        for (int e = 0; e < 4; ++e) {
            if (gt[e]) sel[rg + __popcll(bg[e] & lt_mask)] = (unsigned short)(idx + e);
            rg += __popcll(bg[e]);
            if (eq[e]) { if (partial) cand[re] = (unsigned short)(idx + e); else if (re < rem) sel[ngt + re] = (unsigned short)(idx + e); re += 1; } }
        base_gt = rg;
#pragma unroll
        for (int e = 0; e < 4; ++e) base_eq += __popcll(be[e]); }
    asm volatile("s_waitcnt lgkmcnt(0)" ::: "memory");
    if (partial) {
        const int m = mbin; const int ci = (lane < m) ? (int)cand[lane] : 0; const unsigned ck = (lane < m) ? kb[ci] : 0u;
        int rank = 0;
        for (int j = 0; j < m; ++j) { const unsigned kj = (unsigned)__shfl((int)ck, j); rank += (kj > ck || (kj == ck && j < lane)) ? 1 : 0; }
        if (lane < m && rank < rem) sel[ngt + rank] = (unsigned short)ci;
        asm volatile("s_waitcnt lgkmcnt(0)" ::: "memory");
    }
}

__device__ __forceinline__ float dpp_row_max16(float x) {
    x = fmaxf(x, __builtin_bit_cast(float, __builtin_amdgcn_mov_dpp(__builtin_bit_cast(int, x), 0xB1, 0xF, 0xF, true)));
    x = fmaxf(x, __builtin_bit_cast(float, __builtin_amdgcn_mov_dpp(__builtin_bit_cast(int, x), 0x4E, 0xF, 0xF, true)));
    x = fmaxf(x, __builtin_bit_cast(float, __builtin_amdgcn_mov_dpp(__builtin_bit_cast(int, x), 0x141, 0xF, 0xF, true)));
    x = fmaxf(x, __builtin_bit_cast(float, __builtin_amdgcn_mov_dpp(__builtin_bit_cast(int, x), 0x140, 0xF, 0xF, true)));
    return x;
}
__device__ __forceinline__ bool topk_select_fast(const float* sc, int N, float smax, unsigned* hist, unsigned short* sel, int lane) {
    const float scale = smax > 0.f ? 127.5f / smax : 0.f;
#define QBIN(x_) min(max((int)fmaf((x_), scale, 128.f), 0), 255)
#pragma unroll
    for (int i = 0; i < 4; ++i) hist[lane * 4 + i] = 0u;
    asm volatile("s_waitcnt lgkmcnt(0)" ::: "memory");
    for (int base = 0; base < N; base += 256) { const int idx = base + 4 * lane;
        if (idx < N) { const f32x4 v = *(const f32x4*)(sc + idx);
#pragma unroll
            for (int e = 0; e < 4; ++e) atomicAdd(&hist[QBIN(v[e])], 1u); } }
    asm volatile("s_waitcnt lgkmcnt(0)" ::: "memory");
    const unsigned c0 = hist[lane * 4], c1 = hist[lane * 4 + 1], c2 = hist[lane * 4 + 2], c3 = hist[lane * 4 + 3];
    const int cnt4 = (int)(c0 + c1 + c2 + c3);
    int incl = cnt4;
#pragma unroll
    for (int o = 1; o < 64; o <<= 1) { const int v = __shfl_down(incl, o); if (lane + o < 64) incl += v; }
    const int excl = incl - cnt4;
    const bool mine = (excl < 256) && (256 <= incl);
    const int L = (int)__builtin_ctzll(__ballot(mine));
    const int ex = __shfl(excl, L); const int b3 = (int)__shfl((int)c3, L), b2 = (int)__shfl((int)c2, L), b1 = (int)__shfl((int)c1, L), b0 = (int)__shfl((int)c0, L);
    int above = ex, bin, mbin;
    if (above + b3 >= 256) { bin = 3; mbin = b3; } else { above += b3; if (above + b2 >= 256) { bin = 2; mbin = b2; } else { above += b2; if (above + b1 >= 256) { bin = 1; mbin = b1; } else { above += b1; bin = 0; mbin = b0; } } }
    if (mbin > 64) return false;
    const int tb = L * 4 + bin, rem = 256 - above, ngt = above; int base_gt = 0, base_eq = 0;
    const unsigned long long lt_mask = (1ull << lane) - 1ull;
    unsigned short* cand = (unsigned short*)hist;
    for (int base = 0; base < N; base += 256) { const int idx = base + 4 * lane; const bool act = idx < N;
        f32x4 v = {0.f, 0.f, 0.f, 0.f}; if (act) v = *(const f32x4*)(sc + idx);
        bool gt[4], eq[4]; unsigned long long bg[4], be[4];
#pragma unroll
        for (int e = 0; e < 4; ++e) { const int qb = QBIN(v[e]); gt[e] = act && qb > tb; eq[e] = act && qb == tb; bg[e] = __ballot(gt[e]); be[e] = __ballot(eq[e]); }
        int rg = base_gt, re = base_eq;
#pragma unroll
        for (int e = 0; e < 4; ++e) re += __popcll(be[e] & lt_mask);
#pragma unroll
        for (int e = 0; e < 4; ++e) {
            if (gt[e]) sel[rg + __popcll(bg[e] & lt_mask)] = (unsigned short)(idx + e);
            rg += __popcll(bg[e]);
            if (eq[e]) { cand[re] = (unsigned short)(idx + e); re += 1; } }
        base_gt = rg;
#pragma unroll
        for (int e = 0; e < 4; ++e) base_eq += __popcll(be[e]); }
    asm volatile("s_waitcnt lgkmcnt(0)" ::: "memory");
    {   const int m = mbin; const int ci = (lane < m) ? (int)cand[lane] : 0; const unsigned ck = (lane < m) ? f2key(sc[ci]) : 0u;
        int rank = 0;
        for (int j = 0; j < m; ++j) { const unsigned kj = (unsigned)__shfl((int)ck, j); rank += (kj > ck || (kj == ck && j < lane)) ? 1 : 0; }
        if (lane < m && rank < rem) sel[ngt + rank] = (unsigned short)ci;
        asm volatile("s_waitcnt lgkmcnt(0)" ::: "memory"); }
#undef QBIN
    return true;
}

__device__ __forceinline__ void dsa_attend(const Params& p, int b, int t, const unsigned short* sel, int cnt, unsigned char* stage, int lane_in) {
    int lane = lane_in; asm volatile("" : "+v"(lane));
    const bf16* CKV = (const bf16*)(p.ws + WS_CKV) + (size_t)b * SEQ * 128; const float* INVR = (const float*)(p.ws + WS_INVR) + (size_t)b * SEQ * 8;
    bf16* QO = (bf16*)(p.ws + WS_REGA) + ((size_t)b * SEQ + t) * 1024;
    const int hd = lane & 15, grp = lane >> 4;
    bf16x8 bq[4];
#pragma unroll
    for (int s = 0; s < 4; ++s) { u32x4 z = {0u, 0u, 0u, 0u}; if (hd < 8) z = *(const u32x4*)(QO + hd * 128 + 32 * s + 8 * grp); bq[s] = __builtin_bit_cast(bf16x8, z); }
    const float slope = (hd < 8) ? exp2f(-(float)(hd + 1)) : 0.f;
    const int hsafe = hd & 7;
    float m_run = -INFINITY, l_part = 0.f;
    f32x4 O[8];
#pragma unroll
    for (int c = 0; c < 8; ++c) O[c] = (f32x4){0.f, 0.f, 0.f, 0.f};
    const LAS unsigned char* st3 = (const LAS unsigned char*)stage;
    const unsigned q4 = (lane & 15) >> 2, p4 = lane & 3;
    u32x4 G[8]; float IRn[8], PNn[8];
#define DA_ISSUE(ks_) do { \
    _Pragma("unroll") for (int i = 0; i < 8; ++i) { const int id = i * 64 + lane, row = id >> 4, ch = id & 15; const unsigned key = sel[(ks_) + row]; G[i] = *(const u32x4*)((const unsigned char*)CKV + (key * 256u + (unsigned)ch * 16u)); } } while (0)
#define DA_ISSUE2(ks_) do { \
    _Pragma("unroll") for (int i = 0; i < 8; ++i) { const int key = sel[(ks_) + 16 * (i >> 2) + 4 * grp + (i & 3)]; IRn[i] = *(const float*)((const unsigned char*)INVR + ((unsigned)key * 32u + (unsigned)hsafe * 4u)); PNn[i] = slope * fabsf((float)(t - key)); } } while (0)
    DA_ISSUE(cnt - 32); DA_ISSUE2(cnt - 32);
    for (int ks = cnt - 32; ks >= 0; ks -= 32) {
#pragma unroll
        for (int i = 0; i < 8; ++i) { const int id = i * 64 + lane, row = id >> 4, ch = id & 15; *(u32x4*)(stage + offb(row, ch)) = G[i]; }
        asm volatile("s_waitcnt lgkmcnt(0)" ::: "memory");
        if (ks >= 32) DA_ISSUE(ks - 32);
        float lg[8];
#pragma unroll
        for (int T = 0; T < 2; ++T) { f32x4 acc = {0.f, 0.f, 0.f, 0.f};
#pragma unroll
            for (int s = 0; s < 4; ++s) { const bf16x8 a = *(const bf16x8*)(stage + offb((lane & 15) + 16 * T, 4 * s + grp)); acc = mfma16(a, bq[s], acc); }
#pragma unroll
            for (int rg = 0; rg < 4; ++rg) lg[4 * T + rg] = acc[rg] * IRn[4 * T + rg] - PNn[4 * T + rg]; }
        if (ks >= 32) DA_ISSUE2(ks - 32);
        float mx = lg[0];
#pragma unroll
        for (int i = 1; i < 8; ++i) mx = fmaxf(mx, lg[i]);
        mx = fmaxf(mx, __shfl_xor(mx, 16)); mx = fmaxf(mx, __shfl_xor(mx, 32));
        const float m_new = fmaxf(m_run, mx);
        const float alpha = __expf(m_run - m_new);
        float ps = 0.f;
#pragma unroll
        for (int i = 0; i < 8; ++i) { lg[i] = __expf(lg[i] - m_new); ps += lg[i]; }
        l_part = l_part * alpha + ps; m_run = m_new;
        { float ar[4];
#pragma unroll
            for (int rg = 0; rg < 4; ++rg) ar[rg] = __shfl(alpha, 4 * grp + rg);
#pragma unroll
            for (int c = 0; c < 8; ++c)
#pragma unroll
                for (int rg = 0; rg < 4; ++rg) O[c][rg] *= ar[rg]; }
        {   u32x4 pw; pw.x = pk2(lg[0], lg[1]); pw.y = pk2(lg[2], lg[3]); pw.z = pk2(lg[4], lg[5]); pw.w = pk2(lg[6], lg[7]);
            const bf16x8 pa = __builtin_bit_cast(bf16x8, pw);
#pragma unroll
            for (int c = 0; c < 8; ++c) {
                const s16x4 lo = __builtin_bit_cast(s16x4, __builtin_amdgcn_ds_read_tr16_b64_v4i16((LAS s16x4*)(st3 + offb(4 * grp + q4, 2 * c + (p4 >> 1)) + 8 * (p4 & 1))));
                const s16x4 hi = __builtin_bit_cast(s16x4, __builtin_amdgcn_ds_read_tr16_b64_v4i16((LAS s16x4*)(st3 + offb(16 + 4 * grp + q4, 2 * c + (p4 >> 1)) + 8 * (p4 & 1))));
                const bf16x8 vb = {lo[0], lo[1], lo[2], lo[3], hi[0], hi[1], hi[2], hi[3]};
                O[c] = mfma16(pa, vb, O[c]); } }
        asm volatile("s_waitcnt lgkmcnt(0)" ::: "memory");
    }
#undef DA_ISSUE
#undef DA_ISSUE2
    float l = l_part; l += __shfl_xor(l, 16); l += __shfl_xor(l, 32);
    const float il = 1.f / l;
    float irr[4];
#pragma unroll
    for (int rg = 0; rg < 4; ++rg) irr[rg] = __shfl(il, 4 * grp + rg);
    if (grp < 2) {
#pragma unroll
        for (int rg = 0; rg < 4; ++rg)
#pragma unroll
            for (int c = 0; c < 8; ++c) QO[(4 * grp + rg) * 128 + 16 * c + hd] = f2bf(O[c][rg] * irr[rg]);
    }
}

#define DSA_LOAD_AF(af_, wqv_, b_, tq0_) do { const size_t rq_ = (size_t)(b_) * SEQ + (tq0_); const int r_ = lane & 31, g_ = lane >> 5, ql_ = 2 * ((r_ >> 2) & 1) + (r_ >> 4), hdm_ = 4 * ((r_ >> 3) & 1) + (r_ & 3); \
    _Pragma("unroll") for (int qg = 0; qg < 4; ++qg) _Pragma("unroll") for (int s = 0; s < 4; ++s) af_[qg][s] = *(const bf16x8*)(PROJ + (rq_ + 4 * qg + ql_) * NPROJ + PC_QI + hdm_ * 64 + 16 * s + 8 * g_); \
    wqv_ = (tid < 128) ? bf2f(PROJ[(rq_ + (tid >> 3)) * NPROJ + PC_WI + (tid & 7)]) * 0.044194173824159216f : 0.f; } while (0)
__device__ __forceinline__ void dsa_select_item(const Params& p, unsigned char* lds, int b, int tq0, int tid, bf16x8 (&af)[4][4], float& wqv, bool has_next, int nb, int ntq0) {
    bf16* PROJ = (bf16*)(p.ws + WS_PROJ);
    float* SC = (float*)lds;
    unsigned* HIST = (unsigned*)(lds + 131072);
    unsigned short* SEL = (unsigned short*)(lds + 131072 + 8192);
    float* WQ = (float*)(lds + 147456);
    unsigned* QMAX = (unsigned*)(lds + 147456 + 512);
    asm volatile("" : "+v"(tid));
    const int lane = tid & 63, wv = __builtin_amdgcn_readfirstlane(tid >> 6);
    const int N = ((tq0 >> 6) + 1) * 64; const size_t rowq0 = (size_t)b * SEQ + tq0;
    {
        const int r = lane & 31, g = lane >> 5;
        if (tid < 128) WQ[tid] = wqv;
        if (tid < 16) QMAX[tid] = 0u;
        float mxq[4][2];
#pragma unroll
        for (int qg = 0; qg < 4; ++qg) { mxq[qg][0] = 0.f; mxq[qg][1] = 0.f; }
        __syncthreads();
        bf16x8 bfr[4];
        { const bf16* krow = PROJ + ((size_t)b * SEQ + wv * 32 + r) * NPROJ + PC_KI + 8 * g;
#pragma unroll
          for (int s = 0; s < 4; ++s) bfr[s] = *(const bf16x8*)(krow + 16 * s); }
        for (int kt = wv; kt < N / 32; kt += NWAVES) {
            const int key = kt * 32 + r;
            bf16x8 bnx[4];
#pragma unroll
            for (int s = 0; s < 4; ++s) bnx[s] = bfr[s];
            if (kt + NWAVES < N / 32) { const bf16* krow = PROJ + ((size_t)b * SEQ + key + 32 * NWAVES) * NPROJ + PC_KI + 8 * g;
#pragma unroll
                for (int s = 0; s < 4; ++s) bnx[s] = *(const bf16x8*)(krow + 16 * s); }
#pragma unroll
            for (int qg = 0; qg < 4; ++qg) { f32x16 acc = {};
#pragma unroll
                for (int s = 0; s < 4; ++s) acc = mfma32(af[qg][s], bfr[s], acc);
#pragma unroll
                for (int qq = 0; qq < 2; ++qq) { float sc = 0.f; const f32x4 w0 = *(const f32x4*)(WQ + (4 * qg + 2 * g + qq) * 8), w1 = *(const f32x4*)(WQ + (4 * qg + 2 * g + qq) * 8 + 4);
#pragma unroll
                    for (int e = 0; e < 4; ++e) { sc = fmaf(w0[e], fmaxf(acc[8 * qq + e], 0.f), sc); sc = fmaf(w1[e], fmaxf(acc[8 * qq + 4 + e], 0.f), sc); }
                    SC[(4 * qg + 2 * g + qq) * 2048 + key] = sc; mxq[qg][qq] = fmaxf(mxq[qg][qq], fabsf(sc)); } }
#pragma unroll
            for (int s = 0; s < 4; ++s) bfr[s] = bnx[s];
        }
#pragma unroll
        for (int qg = 0; qg < 4; ++qg)
#pragma unroll
            for (int qq = 0; qq < 2; ++qq) { float m = dpp_row_max16(mxq[qg][qq]); m = fmaxf(m, __shfl_xor(m, 16));
                if (r == 0) atomicMax(&QMAX[4 * qg + 2 * g + qq], __float_as_uint(m)); }
        __syncthreads();
        if (has_next) DSA_LOAD_AF(af, wqv, nb, ntq0);
        bool fb[2];
        for (int q = 0; q < 2; ++q) fb[q] = !topk_select_fast(SC + (2 * wv + q) * 2048, N, __uint_as_float(QMAX[2 * wv + q]), HIST + wv * 256, SEL + (2 * wv + q) * 256, lane);
        for (int q = 0; q < 2; ++q) if (fb[q]) topk_select(SC + (2 * wv + q) * 2048, N, HIST + wv * 256, SEL + (2 * wv + q) * 256, lane);
    }
    asm volatile("s_waitcnt lgkmcnt(0)" ::: "memory");
    { const int q = lane >> 5; const u32x4 v = *(const u32x4*)(SEL + (2 * wv + q) * 256 + (lane & 31) * 8);
      *(u32x4*)(PROJ + (rowq0 + 2 * wv + q) * NPROJ + PC_Q + (lane & 31) * 8) = v; }
    __syncthreads();
}

__device__ __forceinline__ void dsa_attend_row(const Params& p, unsigned char* wlds, int row, int lane) {
    const bf16* PROJ = (const bf16*)(p.ws + WS_PROJ);
    const int b = row >> 11, t = row & (SEQ - 1), N = ((t >> 6) + 1) * 64, cnt = N > 256 ? 256 : N;
    unsigned short* SELW = (unsigned short*)(wlds + 8192);
    if (N > 256) { if (lane < 32) *(u32x4*)(SELW + lane * 8) = *(const u32x4*)(PROJ + (size_t)row * NPROJ + PC_Q + lane * 8); }
    else { for (int i = lane; i < cnt; i += 64) SELW[i] = (unsigned short)i; }
    asm volatile("s_waitcnt vmcnt(0) lgkmcnt(0)" ::: "memory");
    dsa_attend(p, b, t, SELW, cnt, wlds, lane);
    asm volatile("s_waitcnt lgkmcnt(0)" ::: "memory");
}

__device__ __forceinline__ void uv_item(const Params& p, const unsigned char* wl  , int tile, int lane) {
    bf16* PROJ = (bf16*)(p.ws + WS_PROJ); const bf16* OLAT = (const bf16*)(p.ws + WS_REGA);
    const int r = lane & 31, hh = lane >> 5; const size_t row = (size_t)tile * 32 + r;
    unsigned wb[8];
#pragma unroll
    for (int s = 0; s < 8; ++s) wb[s] = (unsigned)(r * 256 + ((((2 * s + hh) ^ r) & 15) << 4));
#pragma unroll 1
    for (int h = 0; h < 8; ++h) { bf16x8 of[8];
#pragma unroll
        for (int s = 0; s < 8; ++s) of[s] = *(const bf16x8*)(OLAT + row * 1024 + h * 128 + 16 * s + 8 * hh);
#pragma unroll
        for (int dt = 0; dt < 2; ++dt) { f32x16 acc = {}; const unsigned char* wg = wl + (h * 64 + dt * 32) * 256;
#pragma unroll
            for (int s = 0; s < 8; ++s) acc = mfma32(*(const bf16x8*)(wg + wb[s]), of[s], acc);
#pragma unroll
            for (int g4 = 0; g4 < 4; ++g4) { u32x2 o; o.x = pk2(acc[4 * g4], acc[4 * g4 + 1]); o.y = pk2(acc[4 * g4 + 2], acc[4 * g4 + 3]);
                *(u32x2*)(PROJ + row * NPROJ + PC_Q + h * 64 + dt * 32 + 8 * g4 + 4 * hh) = o; } }
    }
}

__device__ __forceinline__ void bias2_item(const Params& p, int item, int lane) {
    const bf16* W1T = (const bf16*)(p.ws + WS_W1); const float* MOD = (const float*)(p.ws + WS_MOD); float* BIAS2 = (float*)(p.ws + WS_BIAS2);
    const int r = lane & 31, hh = lane >> 5, f0 = item * 32;
    const bf16* wrow = W1T + (size_t)(f0 + r) * DM + 8 * hh; const float* srow = MOD + (size_t)r * 6144 + 3072 + 8 * hh;
    f32x16 acc = {};
#pragma unroll 8
    for (int s = 0; s < 64; ++s) { const bf16x8 a = *(const bf16x8*)(wrow + 16 * s); const f32x4 s0 = *(const f32x4*)(srow + 16 * s), s1 = *(const f32x4*)(srow + 16 * s + 4);
        const u32x4 bw = {pk2(s0.x, s0.y), pk2(s0.z, s0.w), pk2(s1.x, s1.y), pk2(s1.z, s1.w)};
        acc = mfma32(a, __builtin_bit_cast(bf16x8, bw), acc); }
#pragma unroll
    for (int i = 0; i < 16; ++i) BIAS2[(size_t)r * 4096 + f0 + (i & 3) + 8 * (i >> 2) + 4 * hh] = acc[i];
}

typedef __attribute__((address_space(1))) unsigned gu32;
#define RLX_AGENT __ATOMIC_RELAXED, __HIP_MEMORY_SCOPE_AGENT
#define XB_TMO      128
#define XB_XCNT(j)  (256  + 64 * (j))
#define XB_XSUB(j)  (1280 + 64 * (j))
#define XB_XGEN(j)  (2304 + 64 * (j))
#define XB_TOP      3328
#define XB_TOPGEN   3392
#define XCD_BAR_WORDS 3456
#define XB_SPIN_CAP (1u << 18)

__device__ __forceinline__ unsigned xb_ld(unsigned* p)              { return __hip_atomic_load(p, __ATOMIC_RELAXED, __HIP_MEMORY_SCOPE_AGENT); }
__device__ __forceinline__ unsigned xb_add(unsigned* p, unsigned v) { return __hip_atomic_fetch_add(p, v, __ATOMIC_RELAXED, __HIP_MEMORY_SCOPE_AGENT); }
__device__ __forceinline__ unsigned xb_xcc_id() { return (unsigned)__builtin_amdgcn_s_getreg((3 << 11) | 20) & 0xFu; }
#define XB_SPIN(cond, bar) do { unsigned _sp = 0; while (cond) { __builtin_amdgcn_s_sleep(1); \
    if ((++_sp & 255u) == 0u) { if (xb_ld(&(bar)[XB_TMO])) break; if (_sp > XB_SPIN_CAP) { atomicAdd(&(bar)[XB_TMO], 1u); break; } } } } while (0)

struct XcdBarrier {
    unsigned* bar; unsigned x;
    volatile LAS unsigned* st;
};

__device__ __forceinline__ XcdBarrier xcd_barrier_post(unsigned* bar, volatile LAS unsigned* st) {
    XcdBarrier b; b.bar = bar; b.x = xb_xcc_id(); b.st = st;
    if (threadIdx.x == 0) (void)xb_add(&bar[XB_XCNT(b.x)], 1u);
    return b;
}
__device__ __forceinline__ void xcd_barrier_complete(unsigned* bar, unsigned x, unsigned& nloc, unsigned& nx) {
    const unsigned G = gridDim.x * gridDim.y * gridDim.z;
    unsigned sum, cnt, mine, sp = 0u;
    for (;;) {
        sum = 0u; cnt = 0u; mine = 0u;
#pragma unroll
        for (unsigned j = 0; j < 16; ++j) { const unsigned c = xb_ld(&bar[XB_XCNT(j)]); sum += c; cnt += (c > 0u) ? 1u : 0u; mine = (j == x) ? c : mine; }
        if (sum == G) break;
        __builtin_amdgcn_s_sleep(1);
        if ((++sp & 255u) == 0u) { if (xb_ld(&bar[XB_TMO])) break; if (sp > XB_SPIN_CAP) { atomicAdd(&bar[XB_TMO], 1u); break; } }
    }
    nloc = mine > 0u ? mine : 1u; nx = cnt > 0u ? cnt : 1u;
}

__device__ __forceinline__ void xcd_barrier(const XcdBarrier& b) {
    asm volatile("s_waitcnt vmcnt(0)" ::: "memory");
    __syncthreads();
    if (threadIdx.x == 0) {
        unsigned* bar = b.bar;
        __builtin_amdgcn_s_waitcnt(0);
        unsigned nloc = b.st[0], nx = b.st[1];
        if (nloc == 0u) { xcd_barrier_complete(bar, b.x, nloc, nx); b.st[0] = nloc; b.st[1] = nx; }
        const unsigned old = xb_add(&bar[XB_XSUB(b.x)], 1u);
        const unsigned gen = old / nloc;
        if (old + 1u == (gen + 1u) * nloc) {
            __builtin_amdgcn_fence(__ATOMIC_RELEASE, "agent");
            asm volatile("s_waitcnt vmcnt(0)" ::: "memory");
            const unsigned og = xb_add(&bar[XB_TOP], 1u);
            const unsigned tg = og / nx;
            if (og + 1u == (tg + 1u) * nx) xb_add(&bar[XB_TOPGEN], 1u);
            else XB_SPIN(xb_ld(&bar[XB_TOPGEN]) == tg, bar);
            __builtin_amdgcn_fence(__ATOMIC_ACQUIRE, "agent");
            xb_add(&bar[XB_XGEN(b.x)], 1u);
            asm volatile("s_waitcnt vmcnt(0)" ::: "memory");
        } else {
            XB_SPIN(xb_ld(&bar[XB_XGEN(b.x)]) == gen, bar);
            __builtin_amdgcn_fence(__ATOMIC_ACQUIRE, "agent");
            asm volatile("s_waitcnt vmcnt(0)" ::: "memory");
        }
    }
    __syncthreads();
}

enum { PH_PRO = 0, PH_HN, PH_GEMM1, PH_PREP, PH_MIX, PH_ATT, PH_UV, PH_GOUT, PH_UP, PH_DOWN, PH_COUNT };
#ifndef MK_SKIP_MIXER
#define MK_SKIP_MIXER 0
#endif
__global__ void __launch_bounds__(NWAVES * 64, 2) mk_fwd(Params p) {
    extern __shared__ __attribute__((aligned(16))) unsigned char lds[];
    cg::grid_group grid = cg::this_grid();
    const int tid = threadIdx.x, lane = tid & 63, wv = __builtin_amdgcn_readfirstlane(tid >> 6);
    const int G = gridDim.x, gw = blockIdx.x * NWAVES + wv, NGW = G * NWAVES;
    const int lo = p.ph_lo, hi = p.ph_hi;
    if (p.ph_hi < 0) grid.sync();
    if (tid < 2) ((volatile LAS unsigned*)((LAS unsigned char*)lds + LDS_BAR_OFF))[tid] = 0u;
    __syncthreads();
    XcdBarrier xbar = xcd_barrier_post((unsigned*)(p.ws + WS_BAR), (volatile LAS unsigned*)((LAS unsigned char*)lds + LDS_BAR_OFF));
    float* MOD = (float*)(p.ws + WS_MOD); bf16* REGA = (bf16*)(p.ws + WS_REGA); bf16* PROJ = (bf16*)(p.ws + WS_PROJ);
#ifndef MK_PHASE_MASK
#define MK_PHASE_MASK 0x3ff
#endif
#define IN(k) (((MK_PHASE_MASK >> (k)) & 1) && lo <= (k) && (k) < hi)
#define SEAM(k) do { if (IN(k) && IN((k) + 1)) { xcd_barrier(xbar); } if (MK_PROBE >= 0 && blockIdx.x == 0 && tid == 0) ((unsigned long long*)(p.ws + WS_MOD + 800 * 1024))[(k) + 1] = __builtin_amdgcn_s_memrealtime(); } while (0)
    if (MK_PROBE >= 0 && blockIdx.x == 0 && tid == 0) ((unsigned long long*)(p.ws + WS_MOD + 800 * 1024))[0] = __builtin_amdgcn_s_memrealtime();
    if (IN(PH_PRO)) { phase_pro(p, lds, tid, G); }
    SEAM(PH_PRO);
    if (IN(PH_HN)) { hn_rows<MK_F8_GEMM1 != 0>(p.x, p.g_mix, MOD, 0, 1024, REGA, gw, NGW, lane); }
    SEAM(PH_HN);
    if (IN(PH_GEMM1)) {
#if MK_F8_GEMM1
        pg8::Gemm g{REGA, (const bf16*)(p.ws + WS_WIN), M, NPROJ, DM / 2, DM / 2}; pg8::StaticOrder S; S.init(M, NPROJ, G, (int)blockIdx.x);
        pg8::EpiBf16<0> E{PROJ, NPROJ, 1.f / 32.f};
        pg8::gemm_phase<pg8::EpiBf16<0>, pg8::StaticOrder, true, true, true>((PG8_LAS unsigned char*)lds, g, S, E);
#else
        pg8::Gemm g{REGA, (const bf16*)(p.ws + WS_WIN), M, NPROJ, DM, DM}; pg8::StaticOrder S; S.init(M, NPROJ, G, (int)blockIdx.x);
        pg8::EpiBf16<0> E{PROJ, NPROJ, 1.f};
        pg8::gemm_phase<pg8::EpiBf16<0>, pg8::StaticOrder, true, true>((PG8_LAS unsigned char*)lds, g, S, E);
#endif
    }
    SEAM(PH_GEMM1);
    if (IN(PH_PREP)) {
#ifndef DBG_NO_RP
        for (int it = blockIdx.x; it < M / 64; it += G) rwkv_prep_item(p, lds, it, tid);
#endif
#ifndef DBG_NO_DP
        __syncthreads();
        stage_w_lds((const bf16*)(p.ws + WS_WUKT), lds, 4, tid); __syncthreads();
        for (int tile = gw; tile < M / 32; tile += NGW) dsa_prep_kv(p, lds, tile, lane);
        __syncthreads();
        stage_w_lds((const bf16*)(p.ws + WS_WUK), lds, 6, tid); __syncthreads();
        for (int tile = gw; tile < M / 32; tile += NGW) dsa_prep_q(p, lds, tile, lane);
#endif
    }
    SEAM(PH_PREP);
    if (IN(PH_MIX)) {
        for (int chain = blockIdx.x; chain < NB * 8; chain += G) { rwkv_scan_chain(p, lds, chain, wv, lane); __syncthreads(); }
        constexpr int NSEL = NB * 112;
        {   bf16x8 af[4][4]; float wqv = 0.f; const bf16* PROJ = (const bf16*)(p.ws + WS_PROJ);
            int idx = (int)blockIdx.x;
            if (idx < NSEL) DSA_LOAD_AF(af, wqv, idx / 112, 256 + 16 * (idx % 112));
            for (int k = 0; idx < NSEL; ++k) { const int nidx = (k + 1) * G + (((k + 1) & 1) ? (G - 1 - (int)blockIdx.x) : (int)blockIdx.x); const bool hn = nidx < NSEL;
                dsa_select_item(p, lds, idx / 112, 256 + 16 * (idx % 112), tid, af, wqv, hn, nidx / 112, 256 + 16 * (nidx % 112)); idx = nidx; } }
    }
    SEAM(PH_MIX);
    if (IN(PH_ATT)) {
        if (gw < 128) bias2_item(p, gw, lane);
        for (int row = gw; row < M; row += NGW) dsa_attend_row(p, lds + wv * 9216, row, lane);
    }

    SEAM(PH_ATT);
    if (IN(PH_UV)) {
#if MK_DBG == 7
        for (int m = gw; m < M; m += NGW) { *(u32x4*)(PROJ + (size_t)m * NPROJ + lane * 8) = *(const u32x4*)(REGA + (size_t)m * 1024 + lane * 8); }
#elif MK_DBG != 2
        stage_w_lds((const bf16*)(p.ws + WS_WUVT), lds, 4, tid); __syncthreads();
        for (int tile = gw; tile < M / 32; tile += NGW) uv_item(p, lds, tile, lane);
#endif
#if MK_DBG == 0
        rwkv_epi_rows(p, gw, NGW, lane);
#endif
#if MK_DBG == 1 || MK_DBG == 2
        for (int m = gw; m < M; m += NGW) { u32x4 z = {0u, 0u, 0u, 0u}; *(u32x4*)(PROJ + (size_t)m * NPROJ + (MK_DBG == 1 ? 512 : 0) + lane * 8) = z; }
#endif
    }
    SEAM(PH_UV);
    if (IN(PH_GOUT)) {
        pg8::Gemm g{PROJ, (const bf16*)(p.ws + WS_WOUT), M, DM, DM, NPROJ}; pg8::StaticOrder S; S.init(M, DM, G, (int)blockIdx.x);
        pg8::EpiResGateNorm E{p.x, p.out, DM, MOD + 2048, 6144, p.g_ffn, MOD + 4096, REGA, (float*)(p.ws + WS_ROWSQ)};
        pg8::gemm_phase<pg8::EpiResGateNorm, pg8::StaticOrder, true, true>((PG8_LAS unsigned char*)lds, g, S, E);
    }
    SEAM(PH_GOUT);
    if (IN(PH_UP)) {
        pg8::Gemm g{REGA, (const bf16*)(p.ws + WS_W1), M, FF, DM, DM}; pg8::StaticOrder S; S.init(M, FF, G, (int)blockIdx.x);
        pg8::EpiF8Relu2 E{p.ws + WS_U, FF, 4.f, (const float*)(p.ws + WS_ROWSQ), (const float*)(p.ws + WS_BIAS2)};
        pg8::gemm_phase<pg8::EpiF8Relu2, pg8::StaticOrder, true, true>((PG8_LAS unsigned char*)lds, g, S, E);
    }
    SEAM(PH_UP);
    if (IN(PH_DOWN)) {
        pg8::Gemm g{(const bf16*)(p.ws + WS_U), (const bf16*)(p.ws + WS_W2), M, DM, FF / 2, FF / 2}; pg8::StaticOrder S; S.init(M, DM, G, (int)blockIdx.x);
        pg8::EpiResGateA2 E{REGA, p.out, DM, MOD + 5120, 6144, p.g_ffn};
        pg8::gemm_phase<pg8::EpiResGateA2, pg8::StaticOrder, true, true, true>((PG8_LAS unsigned char*)lds, g, S, E);
    }
#if MK_PROBE >= 0
    grid.sync();
    if (blockIdx.x == 0 && tid == 0) { unsigned long long* ts = (unsigned long long*)(p.ws + WS_MOD + 800 * 1024); ts[PH_COUNT] = __builtin_amdgcn_s_memrealtime();
        p.out[0] += (float)(ts[MK_PROBE + 1] - ts[MK_PROBE]) * 1e-3f; }
#endif
#undef IN
#undef SEAM
}

#ifndef MK_N_LAUNCHES
#define MK_N_LAUNCHES 1
#endif
extern "C" void kernel_launch(void* const* d_in, const int* in_sizes, int n_in, void* d_out, int out_size, void* d_ws, size_t ws_size, hipStream_t stream) {
    static int grid = 0;
    if (grid == 0) {
        if (n_in != 26 || out_size != M * DM || ws_size < WS_END) { fprintf(stderr, "kernel_launch: unexpected shapes (n_in %d out %d ws %zu)\n", n_in, out_size, ws_size); grid = -1; return; }
        int dev = 0, cus = 0, per_cu = 0;
        hipGetDevice(&dev); hipDeviceGetAttribute(&cus, hipDeviceAttributeMultiprocessorCount, dev);
        if (hipFuncSetAttribute((const void*)mk_fwd, hipFuncAttributeMaxDynamicSharedMemorySize, LDS_BYTES) != hipSuccess) { fprintf(stderr, "kernel_launch: hipFuncSetAttribute failed\n"); grid = -1; return; }
        if (hipOccupancyMaxActiveBlocksPerMultiprocessor(&per_cu, (const void*)mk_fwd, NWAVES * 64, LDS_BYTES) != hipSuccess || per_cu < 1) { fprintf(stderr, "kernel_launch: occupancy query says %d\n", per_cu); per_cu = 1; }
        (void)hipGetLastError();
        grid = cus * 1;
        if (per_cu < 1) grid = -1;
    }
    if (grid < 0) return;
    Params p{};
    const float** pp = (const float**)&p;
    for (int i = 0; i < 26; ++i) pp[i] = (const float*)d_in[i];
    p.out = (float*)d_out; p.ws = (unsigned char*)d_ws;
#if MK_N_LAUNCHES == 1
    if (hipMemsetAsync((char*)d_ws + WS_BAR, 0, 16384, stream) != hipSuccess) { fprintf(stderr, "kernel_launch: memset of the barrier words failed\n"); return; }
    p.ph_lo = 0; p.ph_hi = PH_COUNT;
    void* args[] = {&p};
    hipError_t e = hipLaunchCooperativeKernel((const void*)mk_fwd, dim3(grid), dim3(NWAVES * 64), args, LDS_BYTES, stream);
    if (e != hipSuccess) fprintf(stderr, "cooperative launch failed: %s (grid %d)\n", hipGetErrorString(e), grid);
#else
    for (int ph = 0; ph < PH_COUNT; ++ph) {
#if MK_SKIP_MIXER
        if (ph >= PH_HN && ph <= PH_GOUT) continue;
#endif
        p.ph_lo = ph; p.ph_hi = ph + 1;
        hipLaunchKernelGGL(mk_fwd, dim3(grid), dim3(NWAVES * 64), LDS_BYTES, stream, p);
    }
#endif
}
```

```cpp
#include <hip/hip_runtime.h>
#include <hip/hip_cooperative_groups.h>
#include <cstdio>
#include <cstdint>
#include <cmath>
namespace cg = cooperative_groups;
#ifndef MK_F8_GEMM1
#define MK_F8_GEMM1 0
#endif
#ifndef MK_PROBE
#define MK_PROBE -1
#endif
#ifndef MK_DBG
#define MK_DBG 0
#endif
#ifndef MK_DBG_NOTOPK
#define MK_DBG_NOTOPK 0
#endif
namespace pg8 {
#define PG8_LAS __attribute__((address_space(3)))
typedef unsigned short bf16_t;
typedef short bf16x8 __attribute__((ext_vector_type(8)));
typedef float f32x4 __attribute__((ext_vector_type(4)));
typedef unsigned u32x4 __attribute__((ext_vector_type(4)));
constexpr int BM = 256, BK = 64, HALF = 128, HTB = HALF * BK * 2  , STAGE_BYTES = 8 * HTB, NXCD = 8, WGM = 8;

__host__ __device__ __forceinline__ int lds_byte(int r, int c) { const int st = (r >> 4) * 2 + (c >> 5), rr = r & 15, cc = c & 31, ob = rr * 64 + cc * 2; return st * 1024 + (ob ^ (((ob >> 9) & 1) << 5)); }
__host__ __device__ __forceinline__ void stage_rc(int b, int& R, int& C) { const int st = b / 1024, sb = b % 1024, swz = sb ^ (((sb >> 9) & 1) << 5); R = (st >> 1) * 16 + swz / 64; C = (st & 1) * 32 + (swz % 64) / 2; }
__host__ __device__ __forceinline__ int perm32(int rho) { const int n = rho >> 4, i = rho & 15; return 8 * (i >> 2) + 4 * n + (i & 3); }

struct Unit { int pm, pn; };
struct Gemm { const bf16_t* A; const bf16_t* Bt; int M, N, K, lda; };

struct StaticOrder {
    int nM, nN, nwg, G, c;
    __host__ __device__ void init(int M, int N, int G_, int c_) { nM = M / BM; nN = N / BM; nwg = nM * nN; G = G_; c = c_; }
    __host__ __device__ bool next(int i, Unit& u) const {
        const long L = (long)i * G + c; if (L >= nwg) return false;
        int wgid = (int)L; { const int q = nwg / NXCD, r = nwg % NXCD, xcd = wgid % NXCD, off = wgid / NXCD; wgid = (xcd < r ? xcd * (q + 1) : r * (q + 1) + (xcd - r) * q) + off; }
        const int nig = WGM * nN, gid = wgid / nig, fm = gid * WGM, gsz = (nM - fm) < WGM ? (nM - fm) : WGM;
        u.pm = fm + ((wgid % nig) % gsz); u.pn = (wgid % nig) / gsz; return true;
    }
    __device__ __forceinline__ void a_ready(const Unit&) const {}
    __device__ __forceinline__ void done(const Unit&) const {}
};


typedef float f32x2_t __attribute__((ext_vector_type(2))); typedef __bf16 bf16x2_t __attribute__((ext_vector_type(2)));
__device__ __forceinline__ unsigned cvt_pk_bf16(float lo, float hi) { const f32x2_t v = {lo, hi}; const bf16x2_t b = __builtin_convertvector(v, bf16x2_t); return __builtin_bit_cast(unsigned, b); }

template <int ACT  > struct EpiBf16 {
    static constexpr bool PERM = true, AFTER_DRAIN = false;
    bf16_t* O; int ldc; float scale;
    __device__ __forceinline__ void operator()(const f32x4 (&acc)[2][2][4][2], const Unit& u, int wr, int wc, int fr, int fq) const {
        const int row0 = u.pm * BM + wr * 64 + fr; const int col0 = u.pn * BM + wc * 32 + 8 * fq;
#pragma unroll
        for (int ai = 0; ai < 2; ++ai)
#pragma unroll
            for (int m = 0; m < 4; ++m) { bf16_t* rowp = O + (size_t)(row0 + ai * HALF + m * 16) * ldc + col0;
#pragma unroll
                for (int bj = 0; bj < 2; ++bj) { f32x4 v0 = acc[ai][bj][m][0] * scale, v1 = acc[ai][bj][m][1] * scale;
                    if (ACT == 1) {
#pragma unroll
                        for (int j = 0; j < 4; ++j) { const float a = v0[j] > 0.f ? v0[j] : 0.f, b = v1[j] > 0.f ? v1[j] : 0.f; v0[j] = a * a; v1[j] = b * b; } }
                    u32x4 w; w.x = cvt_pk_bf16(v0[0], v0[1]); w.y = cvt_pk_bf16(v0[2], v0[3]); w.z = cvt_pk_bf16(v1[0], v1[1]); w.w = cvt_pk_bf16(v1[2], v1[3]);
                    *(u32x4*)(rowp + bj * HALF) = w; } }
    }
};
__device__ __forceinline__ unsigned pk4_fp8(float a, float b, float c, float d) { int r = __builtin_amdgcn_cvt_pk_fp8_f32(a, b, 0, false); r = __builtin_amdgcn_cvt_pk_fp8_f32(c, d, r, true); return (unsigned)r; }
struct EpiF8Relu2 {
    static constexpr bool PERM = true, AFTER_DRAIN = false;
    unsigned char* O; int ldc; float scale; const float* rowsq; const float* bias2;
    __device__ __forceinline__ void operator()(const f32x4 (&acc)[2][2][4][2], const Unit& u, int wr, int wc, int fr, int fq) const {
        const int row0 = u.pm * BM + wr * 64 + fr; const int col0 = u.pn * BM + wc * 32 + 8 * fq;
        const float* bp = bias2 + (size_t)(u.pm >> 3) * 4096 + col0;
        f32x4 bv[2][2];
#pragma unroll
        for (int bj = 0; bj < 2; ++bj) { bv[bj][0] = *(const f32x4*)(bp + bj * HALF); bv[bj][1] = *(const f32x4*)(bp + bj * HALF + 4); }
#pragma unroll
        for (int ai = 0; ai < 2; ++ai)
#pragma unroll
            for (int m = 0; m < 4; ++m) { const int row = row0 + ai * HALF + m * 16; unsigned char* rowp = O + (size_t)row * ldc + col0;
                const float rstd = rsqrtf(rowsq[row] * (1.f / 1024.f) + 1e-6f);
#pragma unroll
                for (int bj = 0; bj < 2; ++bj) { f32x4 v0 = acc[ai][bj][m][0] * rstd + bv[bj][0], v1 = acc[ai][bj][m][1] * rstd + bv[bj][1];
#pragma unroll
                    for (int j = 0; j < 4; ++j) { const float a = v0[j] > 0.f ? v0[j] : 0.f, b = v1[j] > 0.f ? v1[j] : 0.f; v0[j] = fminf(a * a * scale, 416.f); v1[j] = fminf(b * b * scale, 416.f); }
                    typedef unsigned u32x2_t __attribute__((ext_vector_type(2)));
                    u32x2_t w; w.x = pk4_fp8(v0[0], v0[1], v0[2], v0[3]); w.y = pk4_fp8(v1[0], v1[1], v1[2], v1[3]);
                    *(u32x2_t*)(rowp + bj * HALF) = w; } }
    }
};
struct EpiResGate {
    static constexpr bool PERM = false, AFTER_DRAIN = false;
    const float* base; float* out; int ldc; const float* gate; int gate_ld; float gscale;
    __device__ __forceinline__ void operator()(const f32x4 (&acc)[2][2][4][2], const Unit& u, int, int, int, int) const {
        int t_ = threadIdx.x; asm volatile("" : "+v"(t_));
        const int wr = t_ >> 8, wc = (t_ >> 6) & 3, fr = t_ & 15, fq = (t_ >> 4) & 3;
        const int row0 = u.pm * BM + wr * 64 + fr, col0 = u.pn * BM + wc * 32 + 4 * fq;
        const float* gp = gate + (size_t)(u.pm >> 3) * gate_ld + col0;
        f32x4 gv[2][2];
#pragma unroll
        for (int bj = 0; bj < 2; ++bj)
#pragma unroll
            for (int n = 0; n < 2; ++n) gv[bj][n] = *(const f32x4*)(gp + bj * HALF + n * 16) * gscale;
#pragma unroll
        for (int ai = 0; ai < 2; ++ai)
#pragma unroll
            for (int m = 0; m < 4; ++m) { const size_t off = (size_t)(row0 + ai * HALF + m * 16) * ldc + col0;
#pragma unroll
                for (int bj = 0; bj < 2; ++bj)
#pragma unroll
                    for (int n = 0; n < 2; ++n) { const f32x4 bs = *(const f32x4*)(base + off + bj * HALF + n * 16);
                        *(f32x4*)(out + off + bj * HALF + n * 16) = bs + gv[bj][n] * acc[ai][bj][m][n]; } }
    }
};
struct EpiResGateNorm {
    static constexpr bool PERM = false, AFTER_DRAIN = false;
    const float* base; float* out; int ldc; const float* gate; int gate_ld; const float* gffn; const float* sc2; bf16_t* a2; float* rowsq;
    __device__ __forceinline__ void operator()(const f32x4 (&acc)[2][2][4][2], const Unit& u, int, int, int, int) const {
        int t_ = threadIdx.x; asm volatile("" : "+v"(t_));
        const int wr = t_ >> 8, wc = (t_ >> 6) & 3, fr = t_ & 15, fq = (t_ >> 4) & 3;
        const int row0 = u.pm * BM + wr * 64 + fr, col0 = u.pn * BM + wc * 32 + 4 * fq;
        const float* gp = gate + (size_t)(u.pm >> 3) * gate_ld + col0; const float* sp = sc2 + (size_t)(u.pm >> 3) * gate_ld + col0;
        f32x4 gv[2][2], gm[2][2];
#pragma unroll
        for (int bj = 0; bj < 2; ++bj)
#pragma unroll
            for (int n = 0; n < 2; ++n) { gv[bj][n] = *(const f32x4*)(gp + bj * HALF + n * 16); gm[bj][n] = *(const f32x4*)(gffn + col0 + bj * HALF + n * 16) * (*(const f32x4*)(sp + bj * HALF + n * 16) + 1.f); }
#pragma unroll
        for (int ai = 0; ai < 2; ++ai)
#pragma unroll
            for (int m = 0; m < 4; ++m) { const int row = row0 + ai * HALF + m * 16; const size_t off = (size_t)row * ldc + col0; float ss = 0.f;
#pragma unroll
                for (int bj = 0; bj < 2; ++bj)
#pragma unroll
                    for (int n = 0; n < 2; ++n) { const f32x4 bs = *(const f32x4*)(base + off + bj * HALF + n * 16); const f32x4 x1 = bs + gv[bj][n] * acc[ai][bj][m][n];
                        ss += (x1.x * x1.x + x1.y * x1.y) + (x1.z * x1.z + x1.w * x1.w);
                        const f32x4 y = x1 * gm[bj][n]; typedef unsigned u32x2_t __attribute__((ext_vector_type(2)));
                        u32x2_t w; w.x = cvt_pk_bf16(y.x, y.y); w.y = cvt_pk_bf16(y.z, y.w); *(u32x2_t*)(a2 + off + bj * HALF + n * 16) = w; }
                ss += __shfl_xor(ss, 16); ss += __shfl_xor(ss, 32);
                if (fq == 0) atomicAdd(rowsq + row, ss); }
    }
};
struct EpiResGateA2 {
    static constexpr bool PERM = false, AFTER_DRAIN = false;
    const bf16_t* a2; float* out; int ldc; const float* gate; int gate_ld; const float* gffn;
    __device__ __forceinline__ void operator()(const f32x4 (&acc)[2][2][4][2], const Unit& u, int, int, int, int) const {
        constexpr float gscale = 1.f / 256.f;
        int t_ = threadIdx.x; asm volatile("" : "+v"(t_));
        const int wr = t_ >> 8, wc = (t_ >> 6) & 3, fr = t_ & 15, fq = (t_ >> 4) & 3;
        const int row0 = u.pm * BM + wr * 64 + fr, col0 = u.pn * BM + wc * 32 + 4 * fq;
        const float* gp = gate + (size_t)(u.pm >> 3) * gate_ld + col0; const float* sp = gp - 1024;
        f32x4 gv[2][2], ig[2][2];
#pragma unroll
        for (int bj = 0; bj < 2; ++bj)
#pragma unroll
            for (int n = 0; n < 2; ++n) { gv[bj][n] = *(const f32x4*)(gp + bj * HALF + n * 16) * gscale;
                const f32x4 gm = *(const f32x4*)(gffn + col0 + bj * HALF + n * 16) * (*(const f32x4*)(sp + bj * HALF + n * 16) + 1.f);
                ig[bj][n] = (f32x4){1.f / gm.x, 1.f / gm.y, 1.f / gm.z, 1.f / gm.w}; }
#pragma unroll
        for (int ai = 0; ai < 2; ++ai)
#pragma unroll
            for (int m = 0; m < 4; ++m) { const size_t off = (size_t)(row0 + ai * HALF + m * 16) * ldc + col0;
#pragma unroll
                for (int bj = 0; bj < 2; ++bj)
#pragma unroll
                    for (int n = 0; n < 2; ++n) { typedef unsigned u32x2_t __attribute__((ext_vector_type(2)));
                        const u32x2_t w = *(const u32x2_t*)(a2 + off + bj * HALF + n * 16);
                        const f32x4 xa = {__uint_as_float(w.x << 16), __uint_as_float(w.x & 0xffff0000u), __uint_as_float(w.y << 16), __uint_as_float(w.y & 0xffff0000u)};
                        *(f32x4*)(out + off + bj * HALF + n * 16) = xa * ig[bj][n] + gv[bj][n] * acc[ai][bj][m][n]; } }
    }
};
template <class Epi, class Sched, bool ALIGN_EPI = false, bool SP2 = false, bool F8 = false>
__device__ __forceinline__ void gemm_phase(PG8_LAS unsigned char* lds, const Gemm g, const Sched S, const Epi E) {
    const int tid = threadIdx.x, wid = __builtin_amdgcn_readfirstlane(tid >> 6), lane = tid & 63, wr = wid >> 2, wc = wid & 3, fr = lane & 15, fq = lane >> 4;
    const int K = g.K, nt = K / BK;
    unsigned voffA[2], voffB[2];
#pragma unroll
    for (int i = 0; i < 2; ++i) { int R, C; stage_rc(tid * 16 + i * 8192, R, C); const int Rb = Epi::PERM ? ((R & ~31) + perm32(R & 31)) : R;
        voffA[i] = (unsigned)(R * g.lda + C) * 2u; voffB[i] = (unsigned)(Rb * K + C) * 2u; }
    const size_t kstep = (size_t)(BK * 2);
    const size_t hstepB = (size_t)HALF * K * 2, hstepA = (size_t)HALF * g.lda * 2;
    const size_t tstepA = 2 * hstepA, tstepB = 2 * hstepB;
    const unsigned ldsw = (unsigned)wid * 1024u;
    const int f8in = (fq >> 1) * 1024 + ((fr * 64 + (fq & 1) * 32) ^ ((fr >> 3) << 5));
    const int aoff = F8 ? wr * 8192 + f8in : lds_byte(wr * 64 + fr, fq * 8), boff = F8 ? wc * 4096 + f8in : lds_byte(wc * 32 + fr, fq * 8);
    constexpr int KOFF = F8 ? 16 : 1024;
    typedef int v8i_t __attribute__((ext_vector_type(8)));
#define PG8_SA(b, h) (((b) * 2 + (h)) * HTB)
#define PG8_SB(b, h) ((4 + (b) * 2 + (h)) * HTB)
#define PG8_STAGE(bufoff, gbase, voff) do { _Pragma("unroll") for (int _i = 0; _i < 2; ++_i) \
        __builtin_amdgcn_global_load_lds((const unsigned*)((const char*)(gbase) + (voff)[_i]), (PG8_LAS unsigned*)(lds + (bufoff) + ldsw + _i * 8192), 16, 0, 0); } while (0)
#define PG8_LD32(p_) __builtin_shufflevector(*(const PG8_LAS u32x4*)(p_), *(const PG8_LAS u32x4*)((p_) + 16), 0, 1, 2, 3, 4, 5, 6, 7)
#define PG8_LDA(dst, b, h) do { if constexpr (F8) { _Pragma("unroll") for (int m = 0; m < 4; ++m) dst##8[m] = __builtin_bit_cast(v8i_t, PG8_LD32(lds + PG8_SA(b, h) + aoff + m * 2048)); } \
    else { _Pragma("unroll") for (int m = 0; m < 4; ++m) _Pragma("unroll") for (int k = 0; k < 2; ++k) dst[m][k] = *(const PG8_LAS bf16x8*)(lds + PG8_SA(b, h) + aoff + m * 2048 + k * KOFF); } } while (0)
#define PG8_LDB(dst, b, h) do { if constexpr (F8) { _Pragma("unroll") for (int n = 0; n < 2; ++n) dst##8[n] = __builtin_bit_cast(v8i_t, PG8_LD32(lds + PG8_SB(b, h) + boff + n * 2048)); } \
    else { _Pragma("unroll") for (int n = 0; n < 2; ++n) _Pragma("unroll") for (int k = 0; k < 2; ++k) dst[n][k] = *(const PG8_LAS bf16x8*)(lds + PG8_SB(b, h) + boff + n * 2048 + k * KOFF); } } while (0)
#define PG8_CAT(x) __builtin_shufflevector(__builtin_bit_cast(u32x4, (x)[0]), __builtin_bit_cast(u32x4, (x)[1]), 0, 1, 2, 3, 4, 5, 6, 7)
#define PG8_MMA(ai, bj, At, Bt) do { __builtin_amdgcn_s_setprio(1); if constexpr (F8) { _Pragma("unroll") for (int m = 0; m < 4; ++m) _Pragma("unroll") for (int n = 0; n < 2; ++n) \
        asm volatile("v_mfma_f32_16x16x128_f8f6f4 %0, %1, %2, %0" : "+v"(acc[ai][bj][m][n]) : "v"(Bt##8[n]), "v"(At##8[m])); } \
    else { _Pragma("unroll") for (int m = 0; m < 4; ++m) _Pragma("unroll") for (int n = 0; n < 2; ++n) _Pragma("unroll") for (int k = 0; k < 2; ++k) \
        acc[ai][bj][m][n] = __builtin_amdgcn_mfma_f32_16x16x32_bf16(Bt[n][k], At[m][k], acc[ai][bj][m][n], 0, 0, 0); } __builtin_amdgcn_s_setprio(0); } while (0)
#define PG8_WAIT_V(n) asm volatile("s_waitcnt vmcnt(" #n ")" ::: "memory")
#define PG8_WAIT_L(n) asm volatile("s_waitcnt lgkmcnt(" #n ")" ::: "memory")
#define PG8_BAR __builtin_amdgcn_s_barrier()
#define PG8_SCHED __builtin_amdgcn_sched_barrier(0)
    Unit cur, nxt; int ui = 0;
    if (!S.next(0, cur)) return;
    f32x4 acc[2][2][4][2];
#pragma unroll
    for (int a = 0; a < 2; ++a)
#pragma unroll
        for (int b = 0; b < 2; ++b)
#pragma unroll
            for (int m = 0; m < 4; ++m)
#pragma unroll
                for (int n = 0; n < 2; ++n) acc[a][b][m][n] = (f32x4){0.f, 0.f, 0.f, 0.f};
    bf16x8 At[4][2], B0[2][2], B1[2][2]; v8i_t At8[4], B08[2], B18[2];
    const char* cA = (const char*)g.A + (size_t)cur.pm * tstepA; const char* cB = (const char*)g.Bt + (size_t)cur.pn * tstepB;
    S.a_ready(cur);
    if constexpr (SP2) {
        PG8_STAGE(PG8_SB(0, 0), cB, voffB); PG8_STAGE(PG8_SB(0, 1), cB + hstepB, voffB); PG8_STAGE(PG8_SA(0, 0), cA, voffA); PG8_STAGE(PG8_SA(0, 1), cA + hstepA, voffA);
        if (wr == 1) PG8_BAR;
        PG8_WAIT_V(2); PG8_BAR;
        PG8_STAGE(PG8_SB(1, 0), cB + kstep, voffB); PG8_STAGE(PG8_SA(1, 0), cA + kstep, voffA); PG8_STAGE(PG8_SB(1, 1), cB + hstepB + kstep, voffB);
        PG8_WAIT_V(6); PG8_BAR;
    } else {
        PG8_STAGE(PG8_SB(0, 0), cB, voffB); PG8_STAGE(PG8_SA(0, 0), cA, voffA); PG8_STAGE(PG8_SB(0, 1), cB + hstepB, voffB); PG8_STAGE(PG8_SA(0, 1), cA + hstepA, voffA);
        if (wr == 1) PG8_BAR;
        PG8_WAIT_V(4); PG8_BAR;
        PG8_STAGE(PG8_SB(1, 0), cB + kstep, voffB); PG8_STAGE(PG8_SA(1, 0), cA + kstep, voffA); PG8_STAGE(PG8_SB(1, 1), cB + hstepB + kstep, voffB);
        PG8_WAIT_V(6); PG8_BAR;
    }
    for (;;) {
        const bool has_next = S.next(ui + 1, nxt);
        const char* nA = has_next ? (const char*)g.A + (size_t)nxt.pm * tstepA : cA; const char* nB = has_next ? (const char*)g.Bt + (size_t)nxt.pn * tstepB : cB;
        for (int t = 0; t < nt; t += 2) {
            const bool last = (t == nt - 2);
            const char* a1 = cA + (size_t)(t + 1) * kstep;
            const char* a2 = last ? nA : cA + (size_t)(t + 2) * kstep; const char* b2 = last ? nB : cB + (size_t)(t + 2) * kstep;
            const char* a3 = a2 + kstep; const char* b3 = b2 + kstep;
            if (last && has_next) S.a_ready(nxt);
            if constexpr (SP2) {
            PG8_LDB(B0, 0, 0); PG8_LDB(B1, 0, 1); PG8_SCHED; PG8_LDA(At, 0, 0); PG8_STAGE(PG8_SA(1, 1), a1 + hstepA, voffA);
            PG8_WAIT_V(8); PG8_WAIT_L(0); PG8_BAR; PG8_MMA(0, 0, At, B0); PG8_MMA(0, 1, At, B1); PG8_BAR; PG8_SCHED;
            PG8_LDA(At, 0, 1); PG8_STAGE(PG8_SB(0, 0), b2, voffB); PG8_STAGE(PG8_SB(0, 1), b2 + hstepB, voffB); PG8_STAGE(PG8_SA(0, 0), a2, voffA);
            PG8_WAIT_V(8); PG8_WAIT_L(0); PG8_BAR; PG8_MMA(1, 0, At, B0); PG8_MMA(1, 1, At, B1); PG8_BAR; PG8_SCHED;
            PG8_LDB(B0, 1, 0); PG8_LDB(B1, 1, 1); PG8_SCHED; PG8_LDA(At, 1, 0); PG8_STAGE(PG8_SA(0, 1), a2 + hstepA, voffA);
            PG8_WAIT_V(8); PG8_WAIT_L(0); PG8_BAR; PG8_MMA(0, 0, At, B0); PG8_MMA(0, 1, At, B1); PG8_BAR; PG8_SCHED;
            PG8_LDA(At, 1, 1); PG8_STAGE(PG8_SB(1, 0), b3, voffB); PG8_STAGE(PG8_SB(1, 1), b3 + hstepB, voffB); PG8_STAGE(PG8_SA(1, 0), a3, voffA);
            PG8_WAIT_V(8); PG8_WAIT_L(0); PG8_BAR; PG8_MMA(1, 0, At, B0); PG8_MMA(1, 1, At, B1); PG8_BAR; PG8_SCHED;
            } else {
            PG8_LDB(B0, 0, 0); PG8_SCHED; PG8_LDA(At, 0, 0); PG8_STAGE(PG8_SA(1, 1), a1 + hstepA, voffA);
            PG8_WAIT_L(8); PG8_BAR; PG8_WAIT_L(0); PG8_MMA(0, 0, At, B0); PG8_BAR; PG8_SCHED;
            PG8_LDB(B1, 0, 1); PG8_STAGE(PG8_SB(0, 0), b2, voffB);
            PG8_BAR; PG8_WAIT_L(0); PG8_MMA(0, 1, At, B1); PG8_BAR;
            PG8_LDA(At, 0, 1); PG8_STAGE(PG8_SA(0, 0), a2, voffA);
            PG8_BAR; PG8_WAIT_L(0); PG8_MMA(1, 0, At, B0); PG8_BAR; PG8_SCHED;
            PG8_STAGE(PG8_SB(0, 1), b2 + hstepB, voffB);
            PG8_WAIT_V(6); PG8_BAR; PG8_MMA(1, 1, At, B1); PG8_BAR;
            PG8_LDB(B0, 1, 0); PG8_SCHED; PG8_LDA(At, 1, 0); PG8_STAGE(PG8_SA(0, 1), a2 + hstepA, voffA);
            PG8_WAIT_L(8); PG8_BAR; PG8_WAIT_L(0); PG8_MMA(0, 0, At, B0); PG8_BAR; PG8_SCHED;
            PG8_LDB(B1, 1, 1); PG8_STAGE(PG8_SB(1, 0), b3, voffB);
            PG8_BAR; PG8_WAIT_L(0); PG8_MMA(0, 1, At, B1); PG8_BAR;
            PG8_LDA(At, 1, 1); PG8_STAGE(PG8_SA(1, 0), a3, voffA);
            PG8_BAR; PG8_WAIT_L(0); PG8_MMA(1, 0, At, B0); PG8_BAR; PG8_SCHED;
            PG8_STAGE(PG8_SB(1, 1), b3 + hstepB, voffB);
            PG8_WAIT_V(6); PG8_BAR; PG8_MMA(1, 1, At, B1); PG8_BAR;
            }
        }
        if constexpr (ALIGN_EPI) { if (wr == 0) PG8_BAR; }
        if constexpr (F8) asm volatile("s_nop 15\n\ts_nop 15");
        if constexpr (!Epi::AFTER_DRAIN) { E(acc, cur, wr, wc, fr, fq); S.done(cur); }
        if (!has_next) break;
#pragma unroll
        for (int a = 0; a < 2; ++a)
#pragma unroll
            for (int b = 0; b < 2; ++b)
#pragma unroll
                for (int m = 0; m < 4; ++m)
#pragma unroll
                    for (int n = 0; n < 2; ++n) acc[a][b][m][n] = (f32x4){0.f, 0.f, 0.f, 0.f};
        cur = nxt; cA = nA; cB = nB; ++ui;
        if constexpr (ALIGN_EPI) { if (wr == 1) PG8_BAR; }
    }
    PG8_WAIT_V(0);
    if constexpr (!ALIGN_EPI) { if (wr == 0) PG8_BAR; }
    PG8_BAR;
    if constexpr (Epi::AFTER_DRAIN) { E.fused(acc, cur, wr, wc, fr, fq, lds, wid, lane); S.done(cur); }
#undef PG8_SA
#undef PG8_SB
#undef PG8_STAGE
#undef PG8_LDA
#undef PG8_LDB
#undef PG8_MMA
#undef PG8_CAT
#undef PG8_LD32
#undef PG8_WAIT_V
#undef PG8_WAIT_L
#undef PG8_BAR
#undef PG8_SCHED
}
}

#define LAS __attribute__((address_space(3)))
typedef unsigned short bf16;
typedef short bf16x8 __attribute__((ext_vector_type(8)));
typedef short s16x4 __attribute__((ext_vector_type(4)));
typedef float f32x4 __attribute__((ext_vector_type(4)));
typedef float f32x16 __attribute__((ext_vector_type(16)));
typedef unsigned u32x4 __attribute__((ext_vector_type(4)));
typedef unsigned u32x2 __attribute__((ext_vector_type(2)));

constexpr int NB = 32, SEQ = 2048, DM = 1024, M = NB * SEQ, NPROJ = 3072, FF = 4096;
constexpr int PC_Q = 0, PC_R = 512, PC_K = 1024, PC_V = 1536, PC_QI = 2048, PC_CL = 2560, PC_KI = 2688, PC_XW = 2752, PC_XA = 2816, PC_XG = 2880, PC_WI = 3008;
constexpr size_t MiB = 1u << 20;
constexpr size_t WS_MOD = 0, WS_WUKT = 1 * MiB, WS_WUK = WS_WUKT + 131072, WS_WUVT = WS_WUK + 131072, WS_INVR = 2 * MiB, WS_WIN = 4 * MiB, WS_WOUT = 10 * MiB,
                 WS_W1 = 12 * MiB, WS_W2 = 20 * MiB, WS_CKV = 36 * MiB, WS_GAM = 52 * MiB, WS_C3 = 60 * MiB, WS_REGA = 64 * MiB, WS_PROJ = 192 * MiB, WS_CH = 576 * MiB,
                 WS_G = 960 * MiB, WS_U = 192 * MiB, WS_END = 1024 * MiB,
                 WS_BAR = 62 * MiB, WS_ROWSQ = WS_BAR + 65536, WS_BIAS2 = WS_ROWSQ + 262144, WS_W2T = WS_WUVT + 131072, WS_A2T = WS_W2T + 65536, WS_G2T = WS_A2T + 65536;
constexpr int LDS_BAR_OFF = 158720;
constexpr int LDS_BYTES = 158976;
constexpr int NWAVES = 8;

struct Params {
    const float *x, *c, *w_ada, *b_ada, *g_mix, *g_ffn, *w_in, *g_q, *g_k, *g_kv, *w_uk, *w_uv, *mu, *w0, *w2, *a0, *a2, *g2, *k_k, *k_a, *r_k, *ln_w, *ln_b, *w_out, *w_ff1, *w_ff2;
    float* out; unsigned char* ws; int ph_lo, ph_hi;
};

__device__ __forceinline__ unsigned pk2(float lo, float hi) { return pg8::cvt_pk_bf16(lo, hi); }
__device__ __forceinline__ float bflo(unsigned w) { return __uint_as_float(w << 16); }
__device__ __forceinline__ float bfhi(unsigned w) { return __uint_as_float(w & 0xffff0000u); }
__device__ __forceinline__ float bf2f(bf16 h) { return __uint_as_float((unsigned)h << 16); }
__device__ __forceinline__ bf16 f2bf(float f) { return (bf16)(pk2(f, 0.f) & 0xffffu); }
__device__ __forceinline__ float wave_sum(float v) {
#pragma unroll
    for (int o = 1; o < 64; o <<= 1) v += __shfl_xor(v, o);
    return v;
}
__device__ __forceinline__ f32x16 mfma32(bf16x8 a, bf16x8 b, f32x16 c) { return __builtin_amdgcn_mfma_f32_32x32x16_bf16(a, b, c, 0, 0, 0); }
__device__ __forceinline__ f32x4 mfma16(bf16x8 a, bf16x8 b, f32x4 c) { return __builtin_amdgcn_mfma_f32_16x16x32_bf16(a, b, c, 0, 0, 0); }

__device__ __forceinline__ int win_src_col(int n) {
    if (n < 512) return n;
    if (n < 1024) return 1224 + (n - 512);
    if (n < 1536) return 1736 + (n - 1024);
    if (n < 2048) return 2248 + (n - 1536);
    if (n < 2560) return 640 + (n - 2048);
    if (n < 2688) return 512 + (n - 2560);
    if (n < 2752) return 1152 + (n - 2688);
    if (n < 2816) return 2760 + (n - 2752);
    if (n < 2880) return 2824 + (n - 2816);
    if (n < 3008) return 2888 + (n - 2880);
    if (n < 3016) return 1216 + (n - 3008);
    return -1;
}
__device__ __forceinline__ void conv_t_item(const float* W, int K, int Nsrc, bf16* WT, int nblk, int item, float* scr, int lane, bool is_win) {
    const int kb = item / nblk, nb = item % nblk, k0 = 64 * kb, n0 = 32 * nb;
    int ns = n0 + (lane & 31); if (is_win) ns = win_src_col(ns);
    float tv[32];
#pragma unroll
    for (int i = 0; i < 32; ++i) { const int kk = 2 * i + (lane >> 5); tv[i] = ns >= 0 ? W[(size_t)(k0 + kk) * Nsrc + ns] : 0.f; }
#pragma unroll
    for (int i = 0; i < 32; ++i) { const int kk = 2 * i + (lane >> 5); scr[kk * 33 + (lane & 31)] = tv[i]; }
    asm volatile("s_waitcnt lgkmcnt(0)" ::: "memory");
    const int c = lane & 7;
#pragma unroll
    for (int j = 0; j < 4; ++j) { const int n = (lane >> 3) + 8 * j; const float* s = scr + (8 * c) * 33 + n;
        u32x4 o; o.x = pk2(s[0 * 33], s[1 * 33]); o.y = pk2(s[2 * 33], s[3 * 33]); o.z = pk2(s[4 * 33], s[5 * 33]); o.w = pk2(s[6 * 33], s[7 * 33]);
        *(u32x4*)(WT + (size_t)(n0 + n) * K + k0 + 8 * c) = o; }
    asm volatile("s_waitcnt lgkmcnt(0)" ::: "memory");
}
__device__ __forceinline__ void conv_t_item_f8(const float* W, int K, int N, unsigned char* WT, int nblk, int item, float* scr, int lane, float scale, bool is_win = false) {
    const int kb = item / nblk, nb = item % nblk, k0 = 64 * kb, n0 = 32 * nb;
    int ns = n0 + (lane & 31); if (is_win) ns = win_src_col(ns);
    float tv[32];
#pragma unroll
    for (int i = 0; i < 32; ++i) { const int kk = 2 * i + (lane >> 5); tv[i] = ns >= 0 ? W[(size_t)(k0 + kk) * N + ns] * scale : 0.f; }
#pragma unroll
    for (int i = 0; i < 32; ++i) { const int kk = 2 * i + (lane >> 5); scr[kk * 33 + (lane & 31)] = tv[i]; }
    asm volatile("s_waitcnt lgkmcnt(0)" ::: "memory");
    const int c = lane & 7;
#pragma unroll
    for (int j = 0; j < 4; ++j) { const int n = (lane >> 3) + 8 * j; const float* s = scr + (8 * c) * 33 + n;
        u32x2 o; o.x = pg8::pk4_fp8(s[0 * 33], s[1 * 33], s[2 * 33], s[3 * 33]); o.y = pg8::pk4_fp8(s[4 * 33], s[5 * 33], s[6 * 33], s[7 * 33]);
        *(u32x2*)(WT + (size_t)(n0 + n) * K + k0 + 8 * c) = o; }
    asm volatile("s_waitcnt lgkmcnt(0)" ::: "memory");
}
__device__ __forceinline__ void adaln_block(const Params& p, float* ldsf, int cb, int tid) {
    const int lane = tid & 63, wv = tid >> 6, e = cb * 64 + lane;
    float* SC = ldsf; float* RED = ldsf + 16384; float* mod = (float*)(p.ws + WS_MOD);
    float wreg[128];
#pragma unroll
    for (int d = 0; d < 128; ++d) wreg[d] = p.w_ada[(size_t)(wv * 128 + d) * 6144 + e];
    for (int half = 0; half < 2; ++half) {
        const int b0 = half * 16;
        for (int i = tid; i < 16384; i += 512) { const float cv = p.c[b0 * 1024 + i]; SC[i] = cv / (1.f + __expf(-cv)); }
        __syncthreads();
        float acc[16];
#pragma unroll
        for (int bb = 0; bb < 16; ++bb) acc[bb] = 0.f;
#pragma unroll
        for (int dd = 0; dd < 128; dd += 4) { const int d = wv * 128 + dd;
            const float w0 = wreg[dd], w1 = wreg[dd + 1], w2 = wreg[dd + 2], w3 = wreg[dd + 3];
#pragma unroll
            for (int bb = 0; bb < 16; ++bb) { const f32x4 s = *(const f32x4*)(SC + bb * 1024 + d); acc[bb] += (s.x * w0 + s.y * w1) + (s.z * w2 + s.w * w3); }
        }
#pragma unroll
        for (int bb = 0; bb < 16; ++bb) RED[(wv * 16 + bb) * 64 + lane] = acc[bb];
        __syncthreads();
#pragma unroll
        for (int q = 0; q < 2; ++q) { const int bb = wv * 2 + q; float s = p.b_ada[e];
#pragma unroll
            for (int ww = 0; ww < 8; ++ww) s += RED[(ww * 16 + bb) * 64 + lane];
            mod[(size_t)(b0 + bb) * 6144 + e] = s; }
        __syncthreads();
    }
}
__device__ __forceinline__ void phase_pro(const Params& p, unsigned char* lds, int tid, int G) {
    const int lane = tid & 63, wv = tid >> 6;
    for (int cb = blockIdx.x; cb < 96; cb += G) adaln_block(p, (float*)lds, cb, tid);
    __syncthreads();
    float* scr = (float*)lds + wv * (64 * 33 + 16);
    const int gw = blockIdx.x * NWAVES + wv, NGW = G * NWAVES;
    bf16* WIN = (bf16*)(p.ws + WS_WIN); bf16* WOUT = (bf16*)(p.ws + WS_WOUT); bf16* W1 = (bf16*)(p.ws + WS_W1); bf16* W2 = (bf16*)(p.ws + WS_W2);
    bf16* WUKT = (bf16*)(p.ws + WS_WUKT); bf16* WUK = (bf16*)(p.ws + WS_WUK); bf16* WUVT = (bf16*)(p.ws + WS_WUVT);
    constexpr int I_IN = (DM / 64) * (NPROJ / 32), I_OUT = (DM / 64) * (DM / 32), I_1 = (DM / 64) * (FF / 32), I_2 = (FF / 64) * (DM / 32), I_UK = (128 / 64) * (512 / 32);
    constexpr int I_LR = 512 / 32;
    constexpr int NITEMS = I_IN + I_OUT + I_1 + I_2 + 2 * I_UK + 4 * I_LR;
    for (int it = gw; it < NITEMS; it += NGW) {
        int r = it;
        if (r < I_IN) { if (MK_F8_GEMM1) conv_t_item_f8(p.w_in, DM, 3016, (unsigned char*)WIN, NPROJ / 32, r, scr, lane, 32.f, true); else conv_t_item(p.w_in, DM, 3016, WIN, NPROJ / 32, r, scr, lane, true); continue; } r -= I_IN;
        if (r < I_OUT) { conv_t_item(p.w_out, DM, DM, WOUT, DM / 32, r, scr, lane, false); continue; } r -= I_OUT;
        if (r < I_1) { conv_t_item(p.w_ff1, DM, FF, W1, FF / 32, r, scr, lane, false); continue; } r -= I_1;
        if (r < I_2) { conv_t_item_f8(p.w_ff2, FF, DM, (unsigned char*)W2, DM / 32, r, scr, lane, 64.f); continue; } r -= I_2;
        if (r < I_UK) { conv_t_item(p.w_uk, 128, 512, WUKT, 512 / 32, r, scr, lane, false); continue; } r -= I_UK;
        if (r < I_UK) { conv_t_item(p.w_uv, 128, 512, WUVT, 512 / 32, r, scr, lane, false); continue; } r -= I_UK;
        if (r < I_LR) { conv_t_item(p.w2, 64, 512, (bf16*)(p.ws + WS_W2T), 512 / 32, r, scr, lane, false); continue; } r -= I_LR;
        if (r < I_LR) { conv_t_item(p.a2, 64, 512, (bf16*)(p.ws + WS_A2T), 512 / 32, r, scr, lane, false); continue; } r -= I_LR;
        conv_t_item(p.g2, 128, 512, (bf16*)(p.ws + WS_G2T), 512 / 32, r, scr, lane, false);
    }
    { float* ROWSQ = (float*)(p.ws + WS_ROWSQ); for (int i = blockIdx.x * 512 + tid; i < M; i += G * 512) ROWSQ[i] = 0.f; }
    for (int i = blockIdx.x * 512 + tid; i < 128 * 512 / 2; i += G * 512) { const float a = p.w_uk[2 * i], b = p.w_uk[2 * i + 1]; ((unsigned*)WUK)[i] = pk2(a, b); }
}

template <bool F8OUT> __device__ __forceinline__ void hn_rows(const float* src, const float* g, const float* mod, int off_sh, int off_sc, bf16* dst, int gw, int NGW, int lane) {
    const int RPW = M / NGW;
    for (int m0 = gw * RPW; m0 < M; m0 += NGW * RPW) {
        const float* mb = mod + (size_t)(m0 >> 11) * 6144;
        f32x4 ga[4], sh[4];
#pragma unroll
        for (int j = 0; j < 4; ++j) { const int col = 4 * lane + 256 * j; const f32x4 gg = *(const f32x4*)(g + col), sc = *(const f32x4*)(mb + off_sc + col); ga[j] = gg * (1.f + sc); sh[j] = *(const f32x4*)(mb + off_sh + col); }
        for (int r0 = 0; r0 < RPW; r0 += 4) {
            f32x4 v[4][4]; float s[4];
#pragma unroll
            for (int r = 0; r < 4; ++r) { const f32x4* xr = (const f32x4*)(src + (size_t)(m0 + r0 + r) * DM) + lane;
#pragma unroll
                for (int j = 0; j < 4; ++j) v[r][j] = xr[64 * j]; }
#pragma unroll
            for (int r = 0; r < 4; ++r) { s[r] = 0.f;
#pragma unroll
                for (int j = 0; j < 4; ++j) s[r] += (v[r][j].x * v[r][j].x + v[r][j].y * v[r][j].y) + (v[r][j].z * v[r][j].z + v[r][j].w * v[r][j].w); }
#pragma unroll
            for (int o = 1; o < 64; o <<= 1) {
#pragma unroll
                for (int r = 0; r < 4; ++r) s[r] += __shfl_xor(s[r], o); }
#pragma unroll
            for (int r = 0; r < 4; ++r) { const int m = m0 + r0 + r; const float rstd = rsqrtf(s[r] * (1.f / DM) + 1e-6f);
                unsigned long long* o8 = (unsigned long long*)(dst + (size_t)m * DM) + lane;
#pragma unroll
                for (int j = 0; j < 4; ++j) { const f32x4 y = v[r][j] * rstd * ga[j] + sh[j];
                    if (F8OUT) ((unsigned*)((unsigned char*)dst + (size_t)m * DM))[lane + 64 * j] = pg8::pk4_fp8(y.x, y.y, y.z, y.w);
                    else o8[64 * j] = (unsigned long long)pk2(y.x, y.y) | ((unsigned long long)pk2(y.z, y.w) << 32); } }
        }
    }
}

typedef short s16x4 __attribute__((ext_vector_type(4)));
__device__ __forceinline__ f32x4 mfma16k(s16x4 a, s16x4 b, f32x4 c) { return __builtin_amdgcn_mfma_f32_16x16x16bf16_1k(a, b, c, 0, 0, 0); }
__device__ __forceinline__ s16x4 pack4(f32x4 v) { u32x2 o; o.x = pk2(v[0], v[1]); o.y = pk2(v[2], v[3]); return __builtin_bit_cast(s16x4, o); }

__device__ __forceinline__ float dpp_row_sum16(float x) {
    x += __builtin_bit_cast(float, __builtin_amdgcn_mov_dpp(__builtin_bit_cast(int, x), 0xB1, 0xF, 0xF, true));
    x += __builtin_bit_cast(float, __builtin_amdgcn_mov_dpp(__builtin_bit_cast(int, x), 0x4E, 0xF, 0xF, true));
    x += __builtin_bit_cast(float, __builtin_amdgcn_mov_dpp(__builtin_bit_cast(int, x), 0x141, 0xF, 0xF, true));
    x += __builtin_bit_cast(float, __builtin_amdgcn_mov_dpp(__builtin_bit_cast(int, x), 0x140, 0xF, 0xF, true));
    return x;
}
__device__ __forceinline__ void rwkv_prep_item(const Params& p, unsigned char* lds, int it, int tid_in) {
    int tid = tid_in; asm volatile("" : "+v"(tid));
    const int lane = tid & 63, wv = __builtin_amdgcn_readfirstlane(tid >> 6);
    bf16* XS = (bf16*)lds;
    bf16* STG = (bf16*)(lds + 32768) + wv * 4096;
    float* MAB = (float*)(lds + 98304) + wv * 256;
    bf16* RKV = (bf16*)(lds + 106496) + wv * 3264;
    const bf16* PROJ = (const bf16*)(p.ws + WS_PROJ);
    const bf16* W2T = (const bf16*)(p.ws + WS_W2T); const bf16* A2T = (const bf16*)(p.ws + WS_A2T); const bf16* G2T = (const bf16*)(p.ws + WS_G2T);
    float* GAM = (float*)(p.ws + WS_GAM); float* C3 = (float*)(p.ws + WS_C3); bf16* GB = (bf16*)(p.ws + WS_G);
    const int row0 = it * 64, t0 = (it & 31) * 64, b = it >> 5;
    __syncthreads();
    {   const int xt = tid >> 5, xch = tid & 31;
        const f32x4 m0_ = *(const f32x4*)(p.mu + 1536 + 8 * xch), m1_ = *(const f32x4*)(p.mu + 1536 + 8 * xch + 4); const float sc_ = xch < 8 ? 2.f : -1.f;
        u32x4 xc[4], xp[4];
#pragma unroll
        for (int qq = 0; qq < 4; ++qq) { const int t = xt + 16 * qq; const bf16* src_ = PROJ + (size_t)(row0 + t) * NPROJ + PC_XW + 8 * xch; xc[qq] = *(const u32x4*)src_;
            xp[qq] = (u32x4){0u, 0u, 0u, 0u}; if (t0 + t != 0) xp[qq] = *(const u32x4*)(src_ - NPROJ); }
#pragma unroll
        for (int qq = 0; qq < 4; ++qq) { float o_[8];
#pragma unroll
            for (int i = 0; i < 4; ++i) { const float c0_ = bflo(xc[qq][i]), c1_ = bfhi(xc[qq][i]), p0_ = bflo(xp[qq][i]), p1_ = bfhi(xp[qq][i]);
                const float ma_ = i < 2 ? m0_[2 * i] : m1_[2 * i - 4], mb_ = i < 2 ? m0_[2 * i + 1] : m1_[2 * i - 3];
                const float v0_ = c0_ + ma_ * (p0_ - c0_), v1_ = c1_ + mb_ * (p1_ - c1_);
                const float r0_ = 1.f / (1.f + __expf(sc_ * v0_)), r1_ = 1.f / (1.f + __expf(sc_ * v1_));
                o_[2 * i] = xch < 8 ? 1.f - 2.f * r0_ : (xch < 16 ? v0_ : r0_); o_[2 * i + 1] = xch < 8 ? 1.f - 2.f * r1_ : (xch < 16 ? v1_ : r1_); }
            *(u32x4*)(XS + (xt + 16 * qq) * 256 + 8 * xch) = (u32x4){pk2(o_[0], o_[1]), pk2(o_[2], o_[3]), pk2(o_[4], o_[5]), pk2(o_[6], o_[7])}; }
    }
    u32x4 RK[7];
#define RKV_LOAD(rowb, tb) do { _Pragma("unroll") for (int i = 0; i < 7; ++i) { const int id_ = i * 64 + lane, mat_ = id_ / 136, rem_ = id_ - 136 * mat_, rw_ = rem_ >> 3, ch_ = rem_ & 7; \
        RK[i] = (u32x4){0u, 0u, 0u, 0u}; if (id_ < 408 && (tb) - 1 + rw_ >= 0) RK[i] = *(const u32x4*)(PROJ + (size_t)((rowb) - 1 + rw_) * NPROJ + PC_R + 512 * mat_ + wv * 64 + 8 * ch_); } } while (0)
#define RKV_WRITE() do { _Pragma("unroll") for (int i = 0; i < 7; ++i) { const int id_ = i * 64 + lane, mat_ = id_ / 136, rem_ = id_ - 136 * mat_, rw_ = rem_ >> 3, ch_ = rem_ & 7; \
        if (id_ < 408) *(u32x4*)(RKV + mat_ * 1088 + rw_ * 64 + 8 * ch_) = RK[i]; } } while (0)
    RKV_LOAD(row0, t0);
    __syncthreads();
#pragma unroll 1
    for (int q = 0; q < 4; ++q) {
        const int rowq = row0 + 16 * q, tq = t0 + 16 * q;
        int lane_ = lane; asm volatile("" : "+v"(lane_));
        const int n_ = lane_ & 15, grp_ = lane_ >> 4;
        const size_t idx = (size_t)(b * 8 + wv) * 128 + (tq >> 4);
        unsigned char* CHp = p.ws + WS_CH + idx * 12288;
        RKV_WRITE();
        if (q < 3) RKV_LOAD(rowq + 16, tq + 16);
        f32x4 dw[4], da[4];
        {   bf16x8 xa[8];
#pragma unroll
            for (int ks = 0; ks < 8; ++ks) xa[ks] = *(const bf16x8*)(XS + (16 * q + n_) * 256 + 32 * ks + 8 * grp_);
            bf16x8 wf[2][8];
#define LORA_LOADW(dst_, ct_) do { const int cc_ = wv * 64 + 16 * (ct_) + n_; \
                _Pragma("unroll") for (int ks = 0; ks < 2; ++ks) { dst_[ks] = *(const bf16x8*)(W2T + cc_ * 64 + 32 * ks + 8 * grp_); dst_[2 + ks] = *(const bf16x8*)(A2T + cc_ * 64 + 32 * ks + 8 * grp_); } \
                _Pragma("unroll") for (int ks = 0; ks < 4; ++ks) dst_[4 + ks] = *(const bf16x8*)(G2T + cc_ * 128 + 32 * ks + 8 * grp_); } while (0)
            LORA_LOADW(wf[0], 0);
#pragma unroll
            for (int ct = 0; ct < 4; ++ct) { const int cc = wv * 64 + 16 * ct + n_;
                if (ct < 3) LORA_LOADW(wf[(ct + 1) & 1], ct + 1);
                f32x4 dg = {0.f, 0.f, 0.f, 0.f}; dw[ct] = dg; da[ct] = dg;
#pragma unroll
                for (int ks = 0; ks < 2; ++ks) dw[ct] = mfma16(xa[ks], wf[ct & 1][ks], dw[ct]);
#pragma unroll
                for (int ks = 0; ks < 2; ++ks) da[ct] = mfma16(xa[2 + ks], wf[ct & 1][2 + ks], da[ct]);
#pragma unroll
                for (int ks = 0; ks < 4; ++ks) dg = mfma16(xa[4 + ks], wf[ct & 1][4 + ks], dg);
#pragma unroll
                for (int rg = 0; rg < 4; ++rg) GB[(size_t)(rowq + 4 * grp_ + rg) * 512 + cc] = f2bf(dg[rg]); }
#undef LORA_LOADW
        }
        asm volatile("s_waitcnt lgkmcnt(0)" ::: "memory");
        {   float kkvA[4][4], kkaA[4][4], kprA[4][4], rA[4][4], vA[4][4], wA[4][4], nrm[4], c3s[4];
#pragma unroll
            for (int rg = 0; rg < 4; ++rg) { nrm[rg] = 0.f; c3s[rg] = 0.f; }
#pragma unroll
            for (int ct = 0; ct < 4; ++ct) { const int j = 16 * ct + n_, c = wv * 64 + j;
                const float mu_r = p.mu[c], mu_k = p.mu[512 + c], mu_v = p.mu[1024 + c], w0c = p.w0[c], a0c = p.a0[c], kkc = p.k_k[c], kac = p.k_a[c], rkc = p.r_k[c];
#pragma unroll
                for (int rg = 0; rg < 4; ++rg) { const int t = 4 * grp_ + rg;
                    const float rp = bf2f(RKV[t * 64 + j]), rc = bf2f(RKV[(t + 1) * 64 + j]);
                    const float kp = bf2f(RKV[1088 + t * 64 + j]), kc = bf2f(RKV[1088 + (t + 1) * 64 + j]);
                    const float vp = bf2f(RKV[2176 + t * 64 + j]), vc = bf2f(RKV[2176 + (t + 1) * 64 + j]);
                    const float r = rc + mu_r * (rp - rc), k = kc + mu_k * (kp - kc); vA[ct][rg] = vc + mu_v * (vp - vc); rA[ct][rg] = r;
                    const float u = w0c + dw[ct][rg]; const float wlog = -__logf(1.f + __expf(-u)) - 0.5f; wA[ct][rg] = __expf(-__expf(wlog));
                    const float a = 1.f / (1.f + __expf(-(a0c + da[ct][rg])));
                    const float kkv = k * kkc, kpr = k * (1.f + (a - 1.f) * kac); kkvA[ct][rg] = kkv; kkaA[ct][rg] = kkv * a; kprA[ct][rg] = kpr;
                    nrm[rg] += kkv * kkv; c3s[rg] += r * kpr * rkc; } }
            float inrm[4];
#pragma unroll
            for (int rg = 0; rg < 4; ++rg) { nrm[rg] = dpp_row_sum16(nrm[rg]); c3s[rg] = dpp_row_sum16(c3s[rg]); inrm[rg] = 1.f / fmaxf(sqrtf(nrm[rg]), 1e-12f); }
            if (n_ == 0) {
#pragma unroll
                for (int rg = 0; rg < 4; ++rg) C3[(size_t)(rowq + 4 * grp_ + rg) * 8 + wv] = c3s[rg]; }
#pragma unroll
            for (int ct = 0; ct < 4; ++ct) { const int j = 16 * ct + n_;
                float lp[4]; lp[0] = wA[ct][0]; lp[1] = lp[0] * wA[ct][1]; lp[2] = lp[1] * wA[ct][2]; lp[3] = lp[2] * wA[ct][3];
                const float P0 = __shfl(lp[3], n_), P1 = __shfl(lp[3], n_ + 16), P2 = __shfl(lp[3], n_ + 32);
                const float E = grp_ == 0 ? 1.f : (grp_ == 1 ? P0 : (grp_ == 2 ? P0 * P1 : P0 * P1 * P2));
                float bt[4], kt[4];
#pragma unroll
                for (int rg = 0; rg < 4; ++rg) { const int t = 4 * grp_ + rg;
                    const float gam = E * lp[rg], gprev = rg == 0 ? E : E * lp[rg - 1], ig = 1.f / gam;
                    STG[t * 64 + j] = f2bf(-kkvA[ct][rg] * inrm[rg] * gprev); STG[1024 + t * 64 + j] = f2bf(rA[ct][rg] * gam);
                    bt[rg] = kkaA[ct][rg] * inrm[rg] * ig; kt[rg] = kprA[ct][rg] * ig;
                    STG[2048 + t * 64 + j] = f2bf(bt[rg]); STG[3072 + t * 64 + j] = f2bf(kt[rg]); }
                *(u32x2*)(CHp + 4096 + j * 32 + grp_ * 8) = (u32x2){pk2(bt[0], bt[1]), pk2(bt[2], bt[3])};
                *(u32x2*)(CHp + 6144 + j * 32 + grp_ * 8) = (u32x2){pk2(kt[0], kt[1]), pk2(kt[2], kt[3])};
                *(u32x2*)(CHp + 8192 + j * 32 + grp_ * 8) = (u32x2){pk2(vA[ct][0], vA[ct][1]), pk2(vA[ct][2], vA[ct][3])};
                if (grp_ == 3) GAM[idx * 64 + j] = E * lp[3]; }
        }
        asm volatile("s_waitcnt lgkmcnt(0)" ::: "memory");
        {   f32x4 mab = {0.f, 0.f, 0.f, 0.f}, mak = mab, nrb = mab, nrk = mab;
#pragma unroll
            for (int ks = 0; ks < 4; ++ks) { const int o = n_ * 64 + 16 * ks + 4 * grp_;
                const s16x4 fa = *(const s16x4*)(STG + o), fr = *(const s16x4*)(STG + 1024 + o), fb = *(const s16x4*)(STG + 2048 + o), fk = *(const s16x4*)(STG + 3072 + o);
                mab = mfma16k(fa, fb, mab); mak = mfma16k(fa, fk, mak); nrb = mfma16k(fr, fb, nrb); nrk = mfma16k(fr, fk, nrk); }
            asm volatile("s_waitcnt lgkmcnt(0)" ::: "memory");
            bf16* SM = STG + 2048;
#pragma unroll
            for (int rg = 0; rg < 4; ++rg) { const int t = 4 * grp_ + rg; const bool sl = t > n_, il = t >= n_;
                MAB[t * 16 + n_] = sl ? mab[rg] : 0.f;
                SM[256 + t * 16 + n_] = f2bf(sl ? mak[rg] : 0.f); SM[512 + t * 16 + n_] = f2bf(il ? nrb[rg] : 0.f); SM[768 + t * 16 + n_] = f2bf(il ? nrk[rg] : 0.f); }
            asm volatile("s_waitcnt lgkmcnt(0)" ::: "memory");
            if (lane_ < 16) {
                float Tc[16];
#pragma unroll
                for (int t = 0; t < 16; ++t) { float acc = (t == lane_) ? 1.f : 0.f;
#pragma unroll
                    for (int s2 = 0; s2 < t; ++s2) acc = fmaf(MAB[t * 16 + s2], Tc[s2], acc);
                    Tc[t] = acc; SM[t * 16 + lane_] = f2bf(acc); }
            }
            asm volatile("s_waitcnt lgkmcnt(0)" ::: "memory");
#pragma unroll
            for (int i = 0; i < 4; ++i) { const int id = i * 64 + lane_; *(u32x4*)(CHp + id * 16) = *(const u32x4*)((const unsigned char*)STG + id * 16); }
#pragma unroll
            for (int i = 0; i < 2; ++i) { const int id = i * 64 + lane_; *(u32x4*)(CHp + 10240 + id * 16) = *(const u32x4*)((const unsigned char*)SM + id * 16); }
        }
    }
#undef RKV_LOAD
#undef RKV_WRITE
}

__device__ __forceinline__ void stage_w_lds(const bf16* W, unsigned char* lds, int log2_cpr  , int tid) {
    const int cpr = 1 << log2_cpr;
#pragma unroll 4
    for (int i = 0; i < 16; ++i) { const int id = i * 512 + tid, row = id >> log2_cpr, ch = id & (cpr - 1);
        *(u32x4*)(lds + ((size_t)row << (log2_cpr + 4)) + (((ch & ~15) | ((ch ^ row) & 15)) << 4)) = *(const u32x4*)((const unsigned char*)W + (size_t)id * 16); }
}
__device__ __forceinline__ bf16x8 lds_wfrag(const unsigned char* lds, int row, int ch, int log2_cpr) {
    return *(const bf16x8*)(lds + ((size_t)row << (log2_cpr + 4)) + (((ch & ~15) | ((ch ^ row) & 15)) << 4));
}
__device__ __forceinline__ void dsa_prep_kv(const Params& p, const unsigned char* wl, int tile, int lane) {
    const bf16* PROJ = (const bf16*)(p.ws + WS_PROJ); bf16* CKV = (bf16*)(p.ws + WS_CKV); float* INVR = (float*)(p.ws + WS_INVR);
    const int r = lane & 31, hh = lane >> 5; const size_t row = (size_t)tile * 32 + r; const bf16* prow = PROJ + row * NPROJ;
    bf16x8 cf[8];
    {   u32x4 craw[8]; float ssq = 0.f;
#pragma unroll
        for (int s = 0; s < 8; ++s) { craw[s] = *(const u32x4*)(prow + PC_CL + 16 * s + 8 * hh);
#pragma unroll
            for (int w = 0; w < 4; ++w) { const float lo = bflo(craw[s][w]), hi = bfhi(craw[s][w]); ssq += lo * lo + hi * hi; } }
        ssq += __shfl_xor(ssq, 32);
        const float rstd = rsqrtf(ssq * (1.f / 128.f) + 1e-6f);
#pragma unroll
        for (int s = 0; s < 8; ++s) { const float* g = p.g_kv + 16 * s + 8 * hh; const f32x4 g0 = *(const f32x4*)g, g1 = *(const f32x4*)(g + 4);
            u32x4 o; o.x = pk2(bflo(craw[s].x) * rstd * g0.x, bfhi(craw[s].x) * rstd * g0.y); o.y = pk2(bflo(craw[s].y) * rstd * g0.z, bfhi(craw[s].y) * rstd * g0.w);
            o.z = pk2(bflo(craw[s].z) * rstd * g1.x, bfhi(craw[s].z) * rstd * g1.y); o.w = pk2(bflo(craw[s].w) * rstd * g1.z, bfhi(craw[s].w) * rstd * g1.w);
            cf[s] = __builtin_bit_cast(bf16x8, o); *(u32x4*)(CKV + row * 128 + 16 * s + 8 * hh) = o; }
    }
    unsigned wb[8];
#pragma unroll
    for (int s = 0; s < 8; ++s) wb[s] = (unsigned)(r * 256 + ((((2 * s + hh) ^ r) & 15) << 4));
#pragma unroll 1
    for (int h = 0; h < 8; ++h) { float ss = 0.f;
#pragma unroll
        for (int dt = 0; dt < 2; ++dt) { f32x16 acc = {}; const unsigned char* wg = wl + (h * 64 + dt * 32) * 256;
#pragma unroll
            for (int s = 0; s < 8; ++s) acc = mfma32(*(const bf16x8*)(wg + wb[s]), cf[s], acc);
#pragma unroll
            for (int i = 0; i < 16; ++i) ss += acc[i] * acc[i]; }
        ss += __shfl_xor(ss, 32);
        if (hh == 0) INVR[row * 8 + h] = rsqrtf(ss * (1.f / 64.f) + 1e-6f);
    }
}
__device__ __forceinline__ void dsa_prep_q(const Params& p, const unsigned char* wl, int tile, int lane) {
    const bf16* PROJ = (const bf16*)(p.ws + WS_PROJ); bf16* QABS = (bf16*)(p.ws + WS_REGA);
    const int r = lane & 31, hh = lane >> 5; const size_t row = (size_t)tile * 32 + r; const bf16* prow = PROJ + row * NPROJ;
    unsigned wb[2][4];
#pragma unroll
    for (int hp = 0; hp < 2; ++hp)
#pragma unroll
        for (int s = 0; s < 4; ++s) wb[hp][s] = (unsigned)(r * 1024 + ((((hp * 8 + 2 * s + hh) ^ r) & 15) << 4));
#pragma unroll 2
    for (int h = 0; h < 8; ++h) {
        u32x4 qraw[4]; float ssq = 0.f;
#pragma unroll
        for (int s = 0; s < 4; ++s) { qraw[s] = *(const u32x4*)(prow + PC_Q + h * 64 + 16 * s + 8 * hh);
#pragma unroll
            for (int w = 0; w < 4; ++w) { const float lo = bflo(qraw[s][w]), hi = bfhi(qraw[s][w]); ssq += lo * lo + hi * hi; } }
        ssq += __shfl_xor(ssq, 32);
        const float rstd = rsqrtf(ssq * (1.f / 64.f) + 1e-6f);
        bf16x8 qf[4];
#pragma unroll
        for (int s = 0; s < 4; ++s) { const int d0 = 16 * s + 8 * hh; float gg[8];
#pragma unroll
            for (int j = 0; j < 8; ++j) gg[j] = p.g_q[d0 + j] * p.g_k[d0 + j] * rstd;
            u32x4 o; o.x = pk2(bflo(qraw[s].x) * gg[0], bfhi(qraw[s].x) * gg[1]); o.y = pk2(bflo(qraw[s].y) * gg[2], bfhi(qraw[s].y) * gg[3]);
            o.z = pk2(bflo(qraw[s].z) * gg[4], bfhi(qraw[s].z) * gg[5]); o.w = pk2(bflo(qraw[s].w) * gg[6], bfhi(qraw[s].w) * gg[7]);
            qf[s] = __builtin_bit_cast(bf16x8, o); }
#pragma unroll
        for (int lt = 0; lt < 4; ++lt) { f32x16 acc = {}; const unsigned char* wg = wl + lt * 32768 + (h >> 1) * 256;
#pragma unroll
            for (int s = 0; s < 4; ++s) acc = mfma32(*(const bf16x8*)(wg + wb[h & 1][s]), qf[s], acc);
#pragma unroll
            for (int g4 = 0; g4 < 4; ++g4) { u32x2 o; o.x = pk2(acc[4 * g4] * 0.125f, acc[4 * g4 + 1] * 0.125f); o.y = pk2(acc[4 * g4 + 2] * 0.125f, acc[4 * g4 + 3] * 0.125f);
                *(u32x2*)(QABS + row * 1024 + h * 128 + lt * 32 + 8 * g4 + 4 * hh) = o; } }
    }
}

constexpr int SCAN_D = 8, SCAN_SLOT = 12288 + 256;
#define SCAN_BAR() do { asm volatile("s_waitcnt lgkmcnt(0)" ::: "memory"); __builtin_amdgcn_s_barrier(); asm volatile("" ::: "memory"); } while (0)
__device__ __forceinline__ void rwkv_scan_chain(const Params& p, unsigned char* lds, int chain, int wv, int lane) {
    const int b = chain >> 3, h = chain & 7;
    const size_t idx0 = (size_t)(b * 8 + h) * 128;
    if (wv >= 4) {
        const int li = (wv - 4) * 64 + lane;
        const unsigned char* src = p.ws + WS_CH + idx0 * 12288 + (size_t)li * 16; const float* gsrc = (const float*)(p.ws + WS_GAM) + idx0 * 64 + (li & 15) * 4;
        const int d0 = (li >> 3) * 128 + ((((li & 7) ^ ((li >> 4) & 7))) << 4);
        u32x4 R[SCAN_D][3]; f32x4 Rg[SCAN_D];
#pragma unroll
        for (int j = 0; j < SCAN_D; ++j) {
#pragma unroll
            for (int i = 0; i < 3; ++i) R[j][i] = *(const u32x4*)(src + (size_t)j * 12288 + i * 4096);
            Rg[j] = *(const f32x4*)(gsrc + (size_t)j * 64); }
        for (int k0 = 0; k0 < 128; k0 += SCAN_D) {
#pragma unroll
            for (int j = 0; j < SCAN_D; ++j) { const int k = k0 + j; unsigned char* slot = lds + (k & 1) * SCAN_SLOT;
                *(u32x4*)(slot + d0) = R[j][0];
#pragma unroll
                for (int i = 1; i < 3; ++i) *(u32x4*)(slot + li * 16 + i * 4096) = R[j][i];
                *(f32x4*)(slot + 12288 + (li & 15) * 16) = Rg[j];
                if (k + SCAN_D < 128) {
#pragma unroll
                    for (int i = 0; i < 3; ++i) R[j][i] = *(const u32x4*)(src + (size_t)(k + SCAN_D) * 12288 + i * 4096);
                    Rg[j] = *(const f32x4*)(gsrc + (size_t)(k + SCAN_D) * 64); }
                SCAN_BAR(); } }
        SCAN_BAR();
    } else {
        const int w = wv, n = lane & 15, grp = lane >> 4;
        bf16* PROJ = (bf16*)(p.ws + WS_PROJ);
        f32x4 S[4];
#pragma unroll
        for (int jt = 0; jt < 4; ++jt) S[jt] = (f32x4){0.f, 0.f, 0.f, 0.f};
        int aoffs[4];
#pragma unroll
        for (int jt = 0; jt < 4; ++jt) aoffs[jt] = n * 128 + ((((2 * jt + (grp >> 1)) ^ ((n >> 1) & 7))) << 4) + 8 * (grp & 1);
        s16x4 at[4], rt[4], bt[4], kt[4], vt, Tm, Mak, Nrb, Nrk; f32x4 gm[4];
#define SCAN_LDF(slot_) do { const unsigned char* CHp = lds + (slot_) * SCAN_SLOT; \
        _Pragma("unroll") for (int jt = 0; jt < 4; ++jt) { at[jt] = *(const s16x4*)(CHp + aoffs[jt]); rt[jt] = *(const s16x4*)(CHp + 2048 + aoffs[jt]); \
            bt[jt] = *(const s16x4*)(CHp + 4096 + (16 * jt + n) * 32 + grp * 8); kt[jt] = *(const s16x4*)(CHp + 6144 + (16 * jt + n) * 32 + grp * 8); \
            gm[jt] = *(const f32x4*)(CHp + 12288 + (16 * jt + 4 * grp) * 4); } \
        vt = *(const s16x4*)(CHp + 8192 + (16 * w + n) * 32 + grp * 8); Tm = *(const s16x4*)(CHp + 10240 + n * 32 + grp * 8); Mak = *(const s16x4*)(CHp + 10752 + n * 32 + grp * 8); \
        Nrb = *(const s16x4*)(CHp + 11264 + n * 32 + grp * 8); Nrk = *(const s16x4*)(CHp + 11776 + n * 32 + grp * 8); } while (0)
        SCAN_BAR();
        SCAN_LDF(0);
        for (int sc = 0; sc < 128; ++sc) {
            s16x4 at_[4], rt_[4], bt_[4], kt_[4]; f32x4 gm_[4];
#pragma unroll
            for (int jt = 0; jt < 4; ++jt) { at_[jt] = at[jt]; rt_[jt] = rt[jt]; bt_[jt] = bt[jt]; kt_[jt] = kt[jt]; gm_[jt] = gm[jt]; }
            const s16x4 vt_ = vt, Tm_ = Tm, Mak_ = Mak, Nrb_ = Nrb, Nrk_ = Nrk;
            SCAN_BAR();
            if (sc + 1 < 128) SCAN_LDF((sc + 1) & 1);
            s16x4 Sb[4];
#pragma unroll
            for (int jt = 0; jt < 4; ++jt) Sb[jt] = pack4(S[jt]);
            f32x4 X = {0.f, 0.f, 0.f, 0.f}, O = X;
#pragma unroll
            for (int jt = 0; jt < 4; ++jt) X = mfma16k(at_[jt], Sb[jt], X);
            X = mfma16k(Mak_, vt_, X);
#pragma unroll
            for (int jt = 0; jt < 4; ++jt) O = mfma16k(rt_[jt], Sb[jt], O);
            O = mfma16k(Nrk_, vt_, O);
            const f32x4 U = mfma16k(Tm_, pack4(X), (f32x4){0.f, 0.f, 0.f, 0.f});
            const s16x4 Ub = pack4(U);
            O = mfma16k(Nrb_, Ub, O);
#pragma unroll
            for (int jt = 0; jt < 4; ++jt) { S[jt] = mfma16k(kt_[jt], vt_, S[jt]); S[jt] = mfma16k(bt_[jt], Ub, S[jt]); S[jt] = S[jt] * gm_[jt]; }
            bf16* orow = PROJ + ((size_t)b * SEQ + sc * 16 + 4 * grp) * NPROJ + PC_R + h * 64 + 16 * w + n;
#pragma unroll
            for (int rg = 0; rg < 4; ++rg) orow[(size_t)rg * NPROJ] = f2bf(O[rg]);
        }
#undef SCAN_LDF
    }
}
__device__ __forceinline__ void rwkv_epi_rows(const Params& p, int gw, int NGW, int lane) {
    bf16* PROJ = (bf16*)(p.ws + WS_PROJ); const bf16* GB = (const bf16*)(p.ws + WS_G); const float* C3 = (const float*)(p.ws + WS_C3);
    const int c0 = lane * 8, h = lane >> 3, RPW = M / NGW;
    float muv[8], lw[8], lb[8];
#pragma unroll
    for (int i = 0; i < 8; ++i) { muv[i] = p.mu[1024 + c0 + i]; lw[i] = p.ln_w[c0 + i]; lb[i] = p.ln_b[c0 + i]; }
    for (int m0 = gw * RPW; m0 < M; m0 += NGW * RPW) {
        u32x4 vprev = {0u, 0u, 0u, 0u}; if ((m0 & (SEQ - 1)) != 0) vprev = *(const u32x4*)(PROJ + (size_t)(m0 - 1) * NPROJ + PC_V + c0);
        for (int r0 = 0; r0 < RPW; r0 += 4) {
            u32x4 oraw[4], vc[4], gr[4]; float c3[4];
#pragma unroll
            for (int r = 0; r < 4; ++r) { const size_t m = (size_t)(m0 + r0 + r); const bf16* prow = PROJ + m * NPROJ;
                oraw[r] = *(const u32x4*)(prow + PC_R + c0); vc[r] = *(const u32x4*)(prow + PC_V + c0); gr[r] = *(const u32x4*)(GB + m * 512 + c0); c3[r] = C3[m * 8 + h]; }
            float o[4][8], sm[4], q[4];
#pragma unroll
            for (int r = 0; r < 4; ++r) { sm[r] = 0.f;
#pragma unroll
                for (int i = 0; i < 4; ++i) { o[r][2 * i] = bflo(oraw[r][i]); o[r][2 * i + 1] = bfhi(oraw[r][i]); sm[r] += o[r][2 * i] + o[r][2 * i + 1]; } }
#pragma unroll
            for (int of = 1; of < 8; of <<= 1) {
#pragma unroll
                for (int r = 0; r < 4; ++r) sm[r] += __shfl_xor(sm[r], of); }
#pragma unroll
            for (int r = 0; r < 4; ++r) { const float mean = sm[r] * (1.f / 64.f); q[r] = 0.f;
#pragma unroll
                for (int i = 0; i < 8; ++i) { o[r][i] -= mean; q[r] += o[r][i] * o[r][i]; } }
#pragma unroll
            for (int of = 1; of < 8; of <<= 1) {
#pragma unroll
                for (int r = 0; r < 4; ++r) q[r] += __shfl_xor(q[r], of); }
#pragma unroll
            for (int r = 0; r < 4; ++r) { const float rstd = rsqrtf(q[r] * (1.f / 64.f) + 64e-5f); const u32x4 vp = r == 0 ? vprev : vc[r - 1];
                const bool first = ((m0 + r0 + r) & (SEQ - 1)) == 0;
                u32x4 out;
#pragma unroll
                for (int i = 0; i < 4; ++i) { float y[2];
#pragma unroll
                    for (int e = 0; e < 2; ++e) { const int ii = 2 * i + e; const float cv = e ? bfhi(vc[r][i]) : bflo(vc[r][i]), pv = first ? 0.f : (e ? bfhi(vp[i]) : bflo(vp[i]));
                        const float v = cv + muv[ii] * (pv - cv), g = e ? bfhi(gr[r][i]) : bflo(gr[r][i]);
                        y[e] = (o[r][ii] * rstd * lw[ii] + lb[ii] + c3[r] * v) * g; }
                    out[i] = pk2(y[0], y[1]); }
                *(u32x4*)(PROJ + (size_t)(m0 + r0 + r) * NPROJ + PC_R + c0) = out; }
            vprev = vc[3];
        }
    }
}

__device__ __forceinline__ unsigned f2key(float f) { unsigned b = __float_as_uint(f); if ((b << 1) == 0u) b = 0u; return (b & 0x80000000u) ? ~b : (b | 0x80000000u); }
__device__ __forceinline__ unsigned offb(unsigned row, unsigned ch) { return 2048u * (row >> 3) + 512u * (ch >> 2) + 64u * (row & 7) + 16u * ((ch & 3) ^ ((row >> 2) & 3)); }

__device__ __forceinline__ void topk_select(float* sc, int N, unsigned* hist, unsigned short* sel, int lane) {
    unsigned* kb = (unsigned*)sc;
    unsigned prefix = 0u, mask = 0u; int rem = 256, mbin = 0;
    const unsigned long long lt_mask = (1ull << lane) - 1ull;
    for (int pass = 0; pass < 4; ++pass) {
        const int shift = 24 - 8 * pass;
#pragma unroll
        for (int i = 0; i < 4; ++i) hist[lane * 4 + i] = 0u;
        asm volatile("s_waitcnt lgkmcnt(0)" ::: "memory");
        for (int base = 0; base < N; base += 256) { const int idx = base + 4 * lane;
            if (idx < N) { u32x4 k4;
                if (pass == 0) { const f32x4 v = *(const f32x4*)(sc + idx); k4 = (u32x4){f2key(v.x), f2key(v.y), f2key(v.z), f2key(v.w)}; *(u32x4*)(kb + idx) = k4; }
                else k4 = *(const u32x4*)(kb + idx);
#pragma unroll
                for (int e = 0; e < 4; ++e) if ((k4[e] & mask) == prefix) atomicAdd(&hist[(k4[e] >> shift) & 255u], 1u); } }
        asm volatile("s_waitcnt lgkmcnt(0)" ::: "memory");
        const unsigned c0 = hist[lane * 4], c1 = hist[lane * 4 + 1], c2 = hist[lane * 4 + 2], c3 = hist[lane * 4 + 3];
        const int cnt4 = (int)(c0 + c1 + c2 + c3);
        int incl = cnt4;
#pragma unroll
        for (int o = 1; o < 64; o <<= 1) { const int v = __shfl_down(incl, o); if (lane + o < 64) incl += v; }
        const int excl = incl - cnt4;
        const bool mine = (excl < rem) && (rem <= incl);
        const unsigned long long bal = __ballot(mine);
        const int L = (int)__builtin_ctzll(bal);
        const int ex = __shfl(excl, L); const int b3 = (int)__shfl((int)c3, L), b2 = (int)__shfl((int)c2, L), b1 = (int)__shfl((int)c1, L), b0 = (int)__shfl((int)c0, L);
        int above = ex, bin;
        if (above + b3 >= rem) { bin = 3; mbin = b3; } else { above += b3; if (above + b2 >= rem) { bin = 2; mbin = b2; } else { above += b2; if (above + b1 >= rem) { bin = 1; mbin = b1; } else { above += b1; bin = 0; mbin = b0; } } }
        rem -= above; prefix |= (unsigned)(L * 4 + bin) << shift; mask |= 0xffu << shift;
        if (pass == 1 && mbin <= 64) break;
    }
    const unsigned T = prefix; const int ngt = 256 - rem; int base_gt = 0, base_eq = 0;
    const bool partial = (mask != 0xffffffffu);
    unsigned short* cand = (unsigned short*)hist;
    for (int base = 0; base < N; base += 256) { const int idx = base + 4 * lane; const bool act = idx < N;
        u32x4 k4 = {0u, 0u, 0u, 0u}; if (act) k4 = *(const u32x4*)(kb + idx);
        bool gt[4], eq[4]; unsigned long long bg[4], be[4];
#pragma unroll
        for (int e = 0; e < 4; ++e) { const unsigned km = k4[e] & mask; gt[e] = act && km > T; eq[e] = act && km == T; bg[e] = __ballot(gt[e]); be[e] = __ballot(eq[e]); }
        int rg = base_gt, re = base_eq;
#pragma unroll
        for (int e = 0; e < 4; ++e) re += __popcll(be[e] & lt_mask);
#pragma unroll
        for (int e = 0; e < 4; ++e) {
            if (gt[e]) sel[rg + __popcll(bg[e] & lt_mask)] = (unsigned short)(idx + e);
            rg += __popcll(bg[e]);
            if (eq[e]) { if (partial) cand[re] = (unsigned short)(idx + e); else if (re < rem) sel[ngt + re] = (unsigned short)(idx + e); re += 1; } }
        base_gt = rg;
#pragma unroll
        for (int e = 0; e < 4; ++e) base_eq += __popcll(be[e]); }
    asm volatile("s_waitcnt lgkmcnt(0)" ::: "memory");
    if (partial) {
        const int m = mbin; const int ci = (lane < m) ? (int)cand[lane] : 0; const unsigned ck = (lane < m) ? kb[ci] : 0u;
        int rank = 0;
        for (int j = 0; j < m; ++j) { const unsigned kj = (unsigned)__shfl((int)ck, j); rank += (kj > ck || (kj == ck && j < lane)) ? 1 : 0; }
        if (lane < m && rank < rem) sel[ngt + rank] = (unsigned short)ci;
        asm volatile("s_waitcnt lgkmcnt(0)" ::: "memory");
    }
}

__device__ __forceinline__ float dpp_row_max16(float x) {
    x = fmaxf(x, __builtin_bit_cast(float, __builtin_amdgcn_mov_dpp(__builtin_bit_cast(int, x), 0xB1, 0xF, 0xF, true)));
    x = fmaxf(x, __builtin_bit_cast(float, __builtin_amdgcn_mov_dpp(__builtin_bit_cast(int, x), 0x4E, 0xF, 0xF, true)));
    x = fmaxf(x, __builtin_bit_cast(float, __builtin_amdgcn_mov_dpp(__builtin_bit_cast(int, x), 0x141, 0xF, 0xF, true)));
    x = fmaxf(x, __builtin_bit_cast(float, __builtin_amdgcn_mov_dpp(__builtin_bit_cast(int, x), 0x140, 0xF, 0xF, true)));
    return x;
}
__device__ __forceinline__ bool topk_select_fast(const float* sc, int N, float smax, unsigned* hist, unsigned short* sel, int lane) {
    const float scale = smax > 0.f ? 127.5f / smax : 0.f;
#define QBIN(x_) min(max((int)fmaf((x_), scale, 128.f), 0), 255)
#pragma unroll
    for (int i = 0; i < 4; ++i) hist[lane * 4 + i] = 0u;
    asm volatile("s_waitcnt lgkmcnt(0)" ::: "memory");
    for (int base = 0; base < N; base += 256) { const int idx = base + 4 * lane;
        if (idx < N) { const f32x4 v = *(const f32x4*)(sc + idx);
#pragma unroll
            for (int e = 0; e < 4; ++e) atomicAdd(&hist[QBIN(v[e])], 1u); } }
    asm volatile("s_waitcnt lgkmcnt(0)" ::: "memory");
    const unsigned c0 = hist[lane * 4], c1 = hist[lane * 4 + 1], c2 = hist[lane * 4 + 2], c3 = hist[lane * 4 + 3];
    const int cnt4 = (int)(c0 + c1 + c2 + c3);
    int incl = cnt4;
#pragma unroll
    for (int o = 1; o < 64; o <<= 1) { const int v = __shfl_down(incl, o); if (lane + o < 64) incl += v; }
    const int excl = incl - cnt4;
    const bool mine = (excl < 256) && (256 <= incl);
    const int L = (int)__builtin_ctzll(__ballot(mine));
    const int ex = __shfl(excl, L); const int b3 = (int)__shfl((int)c3, L), b2 = (int)__shfl((int)c2, L), b1 = (int)__shfl((int)c1, L), b0 = (int)__shfl((int)c0, L);
    int above = ex, bin, mbin;
    if (above + b3 >= 256) { bin = 3; mbin = b3; } else { above += b3; if (above + b2 >= 256) { bin = 2; mbin = b2; } else { above += b2; if (above + b1 >= 256) { bin = 1; mbin = b1; } else { above += b1; bin = 0; mbin = b0; } } }
    if (mbin > 64) return false;
    const int tb = L * 4 + bin, rem = 256 - above, ngt = above; int base_gt = 0, base_eq = 0;
    const unsigned long long lt_mask = (1ull << lane) - 1ull;
    unsigned short* cand = (unsigned short*)hist;
    for (int base = 0; base < N; base += 256) { const int idx = base + 4 * lane; const bool act = idx < N;
        f32x4 v = {0.f, 0.f, 0.f, 0.f}; if (act) v = *(const f32x4*)(sc + idx);
        bool gt[4], eq[4]; unsigned long long bg[4], be[4];
#pragma unroll
        for (int e = 0; e < 4; ++e) { const int qb = QBIN(v[e]); gt[e] = act && qb > tb; eq[e] = act && qb == tb; bg[e] = __ballot(gt[e]); be[e] = __ballot(eq[e]); }
        int rg = base_gt, re = base_eq;
#pragma unroll
        for (int e = 0; e < 4; ++e) re += __popcll(be[e] & lt_mask);
#pragma unroll
        for (int e = 0; e < 4; ++e) {
            if (gt[e]) sel[rg + __popcll(bg[e] & lt_mask)] = (unsigned short)(idx + e);
            rg += __popcll(bg[e]);
            if (eq[e]) { cand[re] = (unsigned short)(idx + e); re += 1; } }
        base_gt = rg;
#pragma unroll
        for (int e = 0; e < 4; ++e) base_eq += __popcll(be[e]); }
    asm volatile("s_waitcnt lgkmcnt(0)" ::: "memory");
    {   const int m = mbin; const int ci = (lane < m) ? (int)cand[lane] : 0; const unsigned ck = (lane < m) ? f2key(sc[ci]) : 0u;
        int rank = 0;
        for (int j = 0; j < m; ++j) { const unsigned kj = (unsigned)__shfl((int)ck, j); rank += (kj > ck || (kj == ck && j < lane)) ? 1 : 0; }
        if (lane < m && rank < rem) sel[ngt + rank] = (unsigned short)ci;
        asm volatile("s_waitcnt lgkmcnt(0)" ::: "memory"); }
#undef QBIN
    return true;
}

__device__ __forceinline__ void dsa_attend(const Params& p, int b, int t, const unsigned short* sel, int cnt, unsigned char* stage, int lane_in) {
    int lane = lane_in; asm volatile("" : "+v"(lane));
    const bf16* CKV = (const bf16*)(p.ws + WS_CKV) + (size_t)b * SEQ * 128; const float* INVR = (const float*)(p.ws + WS_INVR) + (size_t)b * SEQ * 8;
    bf16* QO = (bf16*)(p.ws + WS_REGA) + ((size_t)b * SEQ + t) * 1024;
    const int hd = lane & 15, grp = lane >> 4;
    bf16x8 bq[4];
#pragma unroll
    for (int s = 0; s < 4; ++s) { u32x4 z = {0u, 0u, 0u, 0u}; if (hd < 8) z = *(const u32x4*)(QO + hd * 128 + 32 * s + 8 * grp); bq[s] = __builtin_bit_cast(bf16x8, z); }
    const float slope = (hd < 8) ? exp2f(-(float)(hd + 1)) : 0.f;
    const int hsafe = hd & 7;
    float m_run = -INFINITY, l_part = 0.f;
    f32x4 O[8];
#pragma unroll
    for (int c = 0; c < 8; ++c) O[c] = (f32x4){0.f, 0.f, 0.f, 0.f};
    const LAS unsigned char* st3 = (const LAS unsigned char*)stage;
    const unsigned q4 = (lane & 15) >> 2, p4 = lane & 3;
    u32x4 G[8]; float IRn[8], PNn[8];
#define DA_ISSUE(ks_) do { \
    _Pragma("unroll") for (int i = 0; i < 8; ++i) { const int id = i * 64 + lane, row = id >> 4, ch = id & 15; const unsigned key = sel[(ks_) + row]; G[i] = *(const u32x4*)((const unsigned char*)CKV + (key * 256u + (unsigned)ch * 16u)); } } while (0)
#define DA_ISSUE2(ks_) do { \
    _Pragma("unroll") for (int i = 0; i < 8; ++i) { const int key = sel[(ks_) + 16 * (i >> 2) + 4 * grp + (i & 3)]; IRn[i] = *(const float*)((const unsigned char*)INVR + ((unsigned)key * 32u + (unsigned)hsafe * 4u)); PNn[i] = slope * fabsf((float)(t - key)); } } while (0)
    DA_ISSUE(cnt - 32); DA_ISSUE2(cnt - 32);
    for (int ks = cnt - 32; ks >= 0; ks -= 32) {
#pragma unroll
        for (int i = 0; i < 8; ++i) { const int id = i * 64 + lane, row = id >> 4, ch = id & 15; *(u32x4*)(stage + offb(row, ch)) = G[i]; }
        asm volatile("s_waitcnt lgkmcnt(0)" ::: "memory");
        if (ks >= 32) DA_ISSUE(ks - 32);
        float lg[8];
#pragma unroll
        for (int T = 0; T < 2; ++T) { f32x4 acc = {0.f, 0.f, 0.f, 0.f};
#pragma unroll
            for (int s = 0; s < 4; ++s) { const bf16x8 a = *(const bf16x8*)(stage + offb((lane & 15) + 16 * T, 4 * s + grp)); acc = mfma16(a, bq[s], acc); }
#pragma unroll
            for (int rg = 0; rg < 4; ++rg) lg[4 * T + rg] = acc[rg] * IRn[4 * T + rg] - PNn[4 * T + rg]; }
        if (ks >= 32) DA_ISSUE2(ks - 32);
        float mx = lg[0];
#pragma unroll
        for (int i = 1; i < 8; ++i) mx = fmaxf(mx, lg[i]);
        mx = fmaxf(mx, __shfl_xor(mx, 16)); mx = fmaxf(mx, __shfl_xor(mx, 32));
        const float m_new = fmaxf(m_run, mx);
        const float alpha = __expf(m_run - m_new);
        float ps = 0.f;
#pragma unroll
        for (int i = 0; i < 8; ++i) { lg[i] = __expf(lg[i] - m_new); ps += lg[i]; }
        l_part = l_part * alpha + ps; m_run = m_new;
        { float ar[4];
#pragma unroll
            for (int rg = 0; rg < 4; ++rg) ar[rg] = __shfl(alpha, 4 * grp + rg);
#pragma unroll
            for (int c = 0; c < 8; ++c)
#pragma unroll
                for (int rg = 0; rg < 4; ++rg) O[c][rg] *= ar[rg]; }
        {   u32x4 pw; pw.x = pk2(lg[0], lg[1]); pw.y = pk2(lg[2], lg[3]); pw.z = pk2(lg[4], lg[5]); pw.w = pk2(lg[6], lg[7]);
            const bf16x8 pa = __builtin_bit_cast(bf16x8, pw);
#pragma unroll
            for (int c = 0; c < 8; ++c) {
                const s16x4 lo = __builtin_bit_cast(s16x4, __builtin_amdgcn_ds_read_tr16_b64_v4i16((LAS s16x4*)(st3 + offb(4 * grp + q4, 2 * c + (p4 >> 1)) + 8 * (p4 & 1))));
                const s16x4 hi = __builtin_bit_cast(s16x4, __builtin_amdgcn_ds_read_tr16_b64_v4i16((LAS s16x4*)(st3 + offb(16 + 4 * grp + q4, 2 * c + (p4 >> 1)) + 8 * (p4 & 1))));
                const bf16x8 vb = {lo[0], lo[1], lo[2], lo[3], hi[0], hi[1], hi[2], hi[3]};
                O[c] = mfma16(pa, vb, O[c]); } }
        asm volatile("s_waitcnt lgkmcnt(0)" ::: "memory");
    }
#undef DA_ISSUE
#undef DA_ISSUE2
    float l = l_part; l += __shfl_xor(l, 16); l += __shfl_xor(l, 32);
    const float il = 1.f / l;
    float irr[4];
#pragma unroll
    for (int rg = 0; rg < 4; ++rg) irr[rg] = __shfl(il, 4 * grp + rg);
    if (grp < 2) {
#pragma unroll
        for (int rg = 0; rg < 4; ++rg)
#pragma unroll
            for (int c = 0; c < 8; ++c) QO[(4 * grp + rg) * 128 + 16 * c + hd] = f2bf(O[c][rg] * irr[rg]);
    }
}

#define DSA_LOAD_AF(af_, wqv_, b_, tq0_) do { const size_t rq_ = (size_t)(b_) * SEQ + (tq0_); const int r_ = lane & 31, g_ = lane >> 5, ql_ = 2 * ((r_ >> 2) & 1) + (r_ >> 4), hdm_ = 4 * ((r_ >> 3) & 1) + (r_ & 3); \
    _Pragma("unroll") for (int qg = 0; qg < 4; ++qg) _Pragma("unroll") for (int s = 0; s < 4; ++s) af_[qg][s] = *(const bf16x8*)(PROJ + (rq_ + 4 * qg + ql_) * NPROJ + PC_QI + hdm_ * 64 + 16 * s + 8 * g_); \
    wqv_ = (tid < 128) ? bf2f(PROJ[(rq_ + (tid >> 3)) * NPROJ + PC_WI + (tid & 7)]) * 0.044194173824159216f : 0.f; } while (0)
__device__ __forceinline__ void dsa_select_item(const Params& p, unsigned char* lds, int b, int tq0, int tid, bf16x8 (&af)[4][4], float& wqv, bool has_next, int nb, int ntq0) {
    bf16* PROJ = (bf16*)(p.ws + WS_PROJ);
    float* SC = (float*)lds;
    unsigned* HIST = (unsigned*)(lds + 131072);
    unsigned short* SEL = (unsigned short*)(lds + 131072 + 8192);
    float* WQ = (float*)(lds + 147456);
    unsigned* QMAX = (unsigned*)(lds + 147456 + 512);
    asm volatile("" : "+v"(tid));
    const int lane = tid & 63, wv = __builtin_amdgcn_readfirstlane(tid >> 6);
    const int N = ((tq0 >> 6) + 1) * 64; const size_t rowq0 = (size_t)b * SEQ + tq0;
    {
        const int r = lane & 31, g = lane >> 5;
        if (tid < 128) WQ[tid] = wqv;
        if (tid < 16) QMAX[tid] = 0u;
        float mxq[4][2];
#pragma unroll
        for (int qg = 0; qg < 4; ++qg) { mxq[qg][0] = 0.f; mxq[qg][1] = 0.f; }
        __syncthreads();
        bf16x8 bfr[4];
        { const bf16* krow = PROJ + ((size_t)b * SEQ + wv * 32 + r) * NPROJ + PC_KI + 8 * g;
#pragma unroll
          for (int s = 0; s < 4; ++s) bfr[s] = *(const bf16x8*)(krow + 16 * s); }
        for (int kt = wv; kt < N / 32; kt += NWAVES) {
            const int key = kt * 32 + r;
            bf16x8 bnx[4];
#pragma unroll
            for (int s = 0; s < 4; ++s) bnx[s] = bfr[s];
            if (kt + NWAVES < N / 32) { const bf16* krow = PROJ + ((size_t)b * SEQ + key + 32 * NWAVES) * NPROJ + PC_KI + 8 * g;
#pragma unroll
                for (int s = 0; s < 4; ++s) bnx[s] = *(const bf16x8*)(krow + 16 * s); }
#pragma unroll
            for (int qg = 0; qg < 4; ++qg) { f32x16 acc = {};
#pragma unroll
                for (int s = 0; s < 4; ++s) acc = mfma32(af[qg][s], bfr[s], acc);
#pragma unroll
                for (int qq = 0; qq < 2; ++qq) { float sc = 0.f; const f32x4 w0 = *(const f32x4*)(WQ + (4 * qg + 2 * g + qq) * 8), w1 = *(const f32x4*)(WQ + (4 * qg + 2 * g + qq) * 8 + 4);
#pragma unroll
                    for (int e = 0; e < 4; ++e) { sc = fmaf(w0[e], fmaxf(acc[8 * qq + e], 0.f), sc); sc = fmaf(w1[e], fmaxf(acc[8 * qq + 4 + e], 0.f), sc); }
                    SC[(4 * qg + 2 * g + qq) * 2048 + key] = sc; mxq[qg][qq] = fmaxf(mxq[qg][qq], fabsf(sc)); } }
#pragma unroll
            for (int s = 0; s < 4; ++s) bfr[s] = bnx[s];
        }
#pragma unroll
        for (int qg = 0; qg < 4; ++qg)
#pragma unroll
            for (int qq = 0; qq < 2; ++qq) { float m = dpp_row_max16(mxq[qg][qq]); m = fmaxf(m, __shfl_xor(m, 16));
                if (r == 0) atomicMax(&QMAX[4 * qg + 2 * g + qq], __float_as_uint(m)); }
        __syncthreads();
        if (has_next) DSA_LOAD_AF(af, wqv, nb, ntq0);
        bool fb[2];
        for (int q = 0; q < 2; ++q) fb[q] = !topk_select_fast(SC + (2 * wv + q) * 2048, N, __uint_as_float(QMAX[2 * wv + q]), HIST + wv * 256, SEL + (2 * wv + q) * 256, lane);
        for (int q = 0; q < 2; ++q) if (fb[q]) topk_select(SC + (2 * wv + q) * 2048, N, HIST + wv * 256, SEL + (2 * wv + q) * 256, lane);
    }
    asm volatile("s_waitcnt lgkmcnt(0)" ::: "memory");
    { const int q = lane >> 5; const u32x4 v = *(const u32x4*)(SEL + (2 * wv + q) * 256 + (lane & 31) * 8);
      *(u32x4*)(PROJ + (rowq0 + 2 * wv + q) * NPROJ + PC_Q + (lane & 31) * 8) = v; }
    __syncthreads();
}

__device__ __forceinline__ void dsa_attend_row(const Params& p, unsigned char* wlds, int row, int lane) {
    const bf16* PROJ = (const bf16*)(p.ws + WS_PROJ);
    const int b = row >> 11, t = row & (SEQ - 1), N = ((t >> 6) + 1) * 64, cnt = N > 256 ? 256 : N;
    unsigned short* SELW = (unsigned short*)(wlds + 8192);
    if (N > 256) { if (lane < 32) *(u32x4*)(SELW + lane * 8) = *(const u32x4*)(PROJ + (size_t)row * NPROJ + PC_Q + lane * 8); }
    else { for (int i = lane; i < cnt; i += 64) SELW[i] = (unsigned short)i; }
    asm volatile("s_waitcnt vmcnt(0) lgkmcnt(0)" ::: "memory");
    dsa_attend(p, b, t, SELW, cnt, wlds, lane);
    asm volatile("s_waitcnt lgkmcnt(0)" ::: "memory");
}

__device__ __forceinline__ void uv_item(const Params& p, const unsigned char* wl  , int tile, int lane) {
    bf16* PROJ = (bf16*)(p.ws + WS_PROJ); const bf16* OLAT = (const bf16*)(p.ws + WS_REGA);
    const int r = lane & 31, hh = lane >> 5; const size_t row = (size_t)tile * 32 + r;
    unsigned wb[8];
#pragma unroll
    for (int s = 0; s < 8; ++s) wb[s] = (unsigned)(r * 256 + ((((2 * s + hh) ^ r) & 15) << 4));
#pragma unroll 1
    for (int h = 0; h < 8; ++h) { bf16x8 of[8];
#pragma unroll
        for (int s = 0; s < 8; ++s) of[s] = *(const bf16x8*)(OLAT + row * 1024 + h * 128 + 16 * s + 8 * hh);
#pragma unroll
        for (int dt = 0; dt < 2; ++dt) { f32x16 acc = {}; const unsigned char* wg = wl + (h * 64 + dt * 32) * 256;
#pragma unroll
            for (int s = 0; s < 8; ++s) acc = mfma32(*(const bf16x8*)(wg + wb[s]), of[s], acc);
#pragma unroll
            for (int g4 = 0; g4 < 4; ++g4) { u32x2 o; o.x = pk2(acc[4 * g4], acc[4 * g4 + 1]); o.y = pk2(acc[4 * g4 + 2], acc[4 * g4 + 3]);
                *(u32x2*)(PROJ + row * NPROJ + PC_Q + h * 64 + dt * 32 + 8 * g4 + 4 * hh) = o; } }
    }
}

__device__ __forceinline__ void bias2_item(const Params& p, int item, int lane) {
    const bf16* W1T = (const bf16*)(p.ws + WS_W1); const float* MOD = (const float*)(p.ws + WS_MOD); float* BIAS2 = (float*)(p.ws + WS_BIAS2);
    const int r = lane & 31, hh = lane >> 5, f0 = item * 32;
    const bf16* wrow = W1T + (size_t)(f0 + r) * DM + 8 * hh; const float* srow = MOD + (size_t)r * 6144 + 3072 + 8 * hh;
    f32x16 acc = {};
#pragma unroll 8
    for (int s = 0; s < 64; ++s) { const bf16x8 a = *(const bf16x8*)(wrow + 16 * s); const f32x4 s0 = *(const f32x4*)(srow + 16 * s), s1 = *(const f32x4*)(srow + 16 * s + 4);
        const u32x4 bw = {pk2(s0.x, s0.y), pk2(s0.z, s0.w), pk2(s1.x, s1.y), pk2(s1.z, s1.w)};
        acc = mfma32(a, __builtin_bit_cast(bf16x8, bw), acc); }
#pragma unroll
    for (int i = 0; i < 16; ++i) BIAS2[(size_t)r * 4096 + f0 + (i & 3) + 8 * (i >> 2) + 4 * hh] = acc[i];
}

typedef __attribute__((address_space(1))) unsigned gu32;
#define RLX_AGENT __ATOMIC_RELAXED, __HIP_MEMORY_SCOPE_AGENT
#define XB_TMO      128
#define XB_XCNT(j)  (256  + 64 * (j))
#define XB_XSUB(j)  (1280 + 64 * (j))
#define XB_XGEN(j)  (2304 + 64 * (j))
#define XB_TOP      3328
#define XB_TOPGEN   3392
#define XCD_BAR_WORDS 3456
#define XB_SPIN_CAP (1u << 18)

__device__ __forceinline__ unsigned xb_ld(unsigned* p)              { return __hip_atomic_load(p, __ATOMIC_RELAXED, __HIP_MEMORY_SCOPE_AGENT); }
__device__ __forceinline__ unsigned xb_add(unsigned* p, unsigned v) { return __hip_atomic_fetch_add(p, v, __ATOMIC_RELAXED, __HIP_MEMORY_SCOPE_AGENT); }
__device__ __forceinline__ unsigned xb_xcc_id() { return (unsigned)__builtin_amdgcn_s_getreg((3 << 11) | 20) & 0xFu; }
#define XB_SPIN(cond, bar) do { unsigned _sp = 0; while (cond) { __builtin_amdgcn_s_sleep(1); \
    if ((++_sp & 255u) == 0u) { if (xb_ld(&(bar)[XB_TMO])) break; if (_sp > XB_SPIN_CAP) { atomicAdd(&(bar)[XB_TMO], 1u); break; } } } } while (0)

struct XcdBarrier {
    unsigned* bar; unsigned x;
    volatile LAS unsigned* st;
};

__device__ __forceinline__ XcdBarrier xcd_barrier_post(unsigned* bar, volatile LAS unsigned* st) {
    XcdBarrier b; b.bar = bar; b.x = xb_xcc_id(); b.st = st;
    if (threadIdx.x == 0) (void)xb_add(&bar[XB_XCNT(b.x)], 1u);
    return b;
}
__device__ __forceinline__ void xcd_barrier_complete(unsigned* bar, unsigned x, unsigned& nloc, unsigned& nx) {
    const unsigned G = gridDim.x * gridDim.y * gridDim.z;
    unsigned sum, cnt, mine, sp = 0u;
    for (;;) {
        sum = 0u; cnt = 0u; mine = 0u;
#pragma unroll
        for (unsigned j = 0; j < 16; ++j) { const unsigned c = xb_ld(&bar[XB_XCNT(j)]); sum += c; cnt += (c > 0u) ? 1u : 0u; mine = (j == x) ? c : mine; }
        if (sum == G) break;
        __builtin_amdgcn_s_sleep(1);
        if ((++sp & 255u) == 0u) { if (xb_ld(&bar[XB_TMO])) break; if (sp > XB_SPIN_CAP) { atomicAdd(&bar[XB_TMO], 1u); break; } }
    }
    nloc = mine > 0u ? mine : 1u; nx = cnt > 0u ? cnt : 1u;
}

__device__ __forceinline__ void xcd_barrier(const XcdBarrier& b) {
    asm volatile("s_waitcnt vmcnt(0)" ::: "memory");
    __syncthreads();
    if (threadIdx.x == 0) {
        unsigned* bar = b.bar;
        __builtin_amdgcn_s_waitcnt(0);
        unsigned nloc = b.st[0], nx = b.st[1];
        if (nloc == 0u) { xcd_barrier_complete(bar, b.x, nloc, nx); b.st[0] = nloc; b.st[1] = nx; }
        const unsigned old = xb_add(&bar[XB_XSUB(b.x)], 1u);
        const unsigned gen = old / nloc;
        if (old + 1u == (gen + 1u) * nloc) {
            __builtin_amdgcn_fence(__ATOMIC_RELEASE, "agent");
            asm volatile("s_waitcnt vmcnt(0)" ::: "memory");
            const unsigned og = xb_add(&bar[XB_TOP], 1u);
            const unsigned tg = og / nx;
            if (og + 1u == (tg + 1u) * nx) xb_add(&bar[XB_TOPGEN], 1u);
            else XB_SPIN(xb_ld(&bar[XB_TOPGEN]) == tg, bar);
            __builtin_amdgcn_fence(__ATOMIC_ACQUIRE, "agent");
            xb_add(&bar[XB_XGEN(b.x)], 1u);
            asm volatile("s_waitcnt vmcnt(0)" ::: "memory");
        } else {
            XB_SPIN(xb_ld(&bar[XB_XGEN(b.x)]) == gen, bar);
            __builtin_amdgcn_fence(__ATOMIC_ACQUIRE, "agent");
            asm volatile("s_waitcnt vmcnt(0)" ::: "memory");
        }
    }
    __syncthreads();
}

enum { PH_PRO = 0, PH_HN, PH_GEMM1, PH_PREP, PH_MIX, PH_ATT, PH_UV, PH_GOUT, PH_UP, PH_DOWN, PH_COUNT };
#ifndef MK_SKIP_MIXER
#define MK_SKIP_MIXER 0
#endif
__global__ void __launch_bounds__(NWAVES * 64, 2) mk_fwd(Params p) {
    extern __shared__ __attribute__((aligned(16))) unsigned char lds[];
    cg::grid_group grid = cg::this_grid();
    const int tid = threadIdx.x, lane = tid & 63, wv = __builtin_amdgcn_readfirstlane(tid >> 6);
    const int G = gridDim.x, gw = blockIdx.x * NWAVES + wv, NGW = G * NWAVES;
    const int lo = p.ph_lo, hi = p.ph_hi;
    if (p.ph_hi < 0) grid.sync();
    if (tid < 2) ((volatile LAS unsigned*)((LAS unsigned char*)lds + LDS_BAR_OFF))[tid] = 0u;
    __syncthreads();
    XcdBarrier xbar = xcd_barrier_post((unsigned*)(p.ws + WS_BAR), (volatile LAS unsigned*)((LAS unsigned char*)lds + LDS_BAR_OFF));
    float* MOD = (float*)(p.ws + WS_MOD); bf16* REGA = (bf16*)(p.ws + WS_REGA); bf16* PROJ = (bf16*)(p.ws + WS_PROJ);
#ifndef MK_PHASE_MASK
#define MK_PHASE_MASK 0x3ff
#endif
#define IN(k) (((MK_PHASE_MASK >> (k)) & 1) && lo <= (k) && (k) < hi)
#define SEAM(k) do { if (IN(k) && IN((k) + 1)) { xcd_barrier(xbar); } if (MK_PROBE >= 0 && blockIdx.x == 0 && tid == 0) ((unsigned long long*)(p.ws + WS_MOD + 800 * 1024))[(k) + 1] = __builtin_amdgcn_s_memrealtime(); } while (0)
    if (MK_PROBE >= 0 && blockIdx.x == 0 && tid == 0) ((unsigned long long*)(p.ws + WS_MOD + 800 * 1024))[0] = __builtin_amdgcn_s_memrealtime();
    if (IN(PH_PRO)) { phase_pro(p, lds, tid, G); }
    SEAM(PH_PRO);
    if (IN(PH_HN)) { hn_rows<MK_F8_GEMM1 != 0>(p.x, p.g_mix, MOD, 0, 1024, REGA, gw, NGW, lane); }
    SEAM(PH_HN);
    if (IN(PH_GEMM1)) {
#if MK_F8_GEMM1
        pg8::Gemm g{REGA, (const bf16*)(p.ws + WS_WIN), M, NPROJ, DM / 2, DM / 2}; pg8::StaticOrder S; S.init(M, NPROJ, G, (int)blockIdx.x);
        pg8::EpiBf16<0> E{PROJ, NPROJ, 1.f / 32.f};
        pg8::gemm_phase<pg8::EpiBf16<0>, pg8::StaticOrder, true, true, true>((PG8_LAS unsigned char*)lds, g, S, E);
#else
        pg8::Gemm g{REGA, (const bf16*)(p.ws + WS_WIN), M, NPROJ, DM, DM}; pg8::StaticOrder S; S.init(M, NPROJ, G, (int)blockIdx.x);
        pg8::EpiBf16<0> E{PROJ, NPROJ, 1.f};
        pg8::gemm_phase<pg8::EpiBf16<0>, pg8::StaticOrder, true, true>((PG8_LAS unsigned char*)lds, g, S, E);
#endif
    }
    SEAM(PH_GEMM1);
    if (IN(PH_PREP)) {
#ifndef DBG_NO_RP
        for (int it = blockIdx.x; it < M / 64; it += G) rwkv_prep_item(p, lds, it, tid);
#endif
#ifndef DBG_NO_DP
        __syncthreads();
        stage_w_lds((const bf16*)(p.ws + WS_WUKT), lds, 4, tid); __syncthreads();
        for (int tile = gw; tile < M / 32; tile += NGW) dsa_prep_kv(p, lds, tile, lane);
        __syncthreads();
        stage_w_lds((const bf16*)(p.ws + WS_WUK), lds, 6, tid); __syncthreads();
        for (int tile = gw; tile < M / 32; tile += NGW) dsa_prep_q(p, lds, tile, lane);
#endif
    }
    SEAM(PH_PREP);
    if (IN(PH_MIX)) {
        for (int chain = blockIdx.x; chain < NB * 8; chain += G) { rwkv_scan_chain(p, lds, chain, wv, lane); __syncthreads(); }
        constexpr int NSEL = NB * 112;
        {   bf16x8 af[4][4]; float wqv = 0.f; const bf16* PROJ = (const bf16*)(p.ws + WS_PROJ);
            int idx = (int)blockIdx.x;
            if (idx < NSEL) DSA_LOAD_AF(af, wqv, idx / 112, 256 + 16 * (idx % 112));
            for (int k = 0; idx < NSEL; ++k) { const int nidx = (k + 1) * G + (((k + 1) & 1) ? (G - 1 - (int)blockIdx.x) : (int)blockIdx.x); const bool hn = nidx < NSEL;
                dsa_select_item(p, lds, idx / 112, 256 + 16 * (idx % 112), tid, af, wqv, hn, nidx / 112, 256 + 16 * (nidx % 112)); idx = nidx; } }
    }
    SEAM(PH_MIX);
    if (IN(PH_ATT)) {
        if (gw < 128) bias2_item(p, gw, lane);
        for (int row = gw; row < M; row += NGW) dsa_attend_row(p, lds + wv * 9216, row, lane);
    }

    SEAM(PH_ATT);
    if (IN(PH_UV)) {
#if MK_DBG == 7
        for (int m = gw; m < M; m += NGW) { *(u32x4*)(PROJ + (size_t)m * NPROJ + lane * 8) = *(const u32x4*)(REGA + (size_t)m * 1024 + lane * 8); }
#elif MK_DBG != 2
        stage_w_lds((const bf16*)(p.ws + WS_WUVT), lds, 4, tid); __syncthreads();
        for (int tile = gw; tile < M / 32; tile += NGW) uv_item(p, lds, tile, lane);
#endif
#if MK_DBG == 0
        rwkv_epi_rows(p, gw, NGW, lane);
#endif
#if MK_DBG == 1 || MK_DBG == 2
        for (int m = gw; m < M; m += NGW) { u32x4 z = {0u, 0u, 0u, 0u}; *(u32x4*)(PROJ + (size_t)m * NPROJ + (MK_DBG == 1 ? 512 : 0) + lane * 8) = z; }
#endif
    }
    SEAM(PH_UV);
    if (IN(PH_GOUT)) {
        pg8::Gemm g{PROJ, (const bf16*)(p.ws + WS_WOUT), M, DM, DM, NPROJ}; pg8::StaticOrder S; S.init(M, DM, G, (int)blockIdx.x);
        pg8::EpiResGateNorm E{p.x, p.out, DM, MOD + 2048, 6144, p.g_ffn, MOD + 4096, REGA, (float*)(p.ws + WS_ROWSQ)};
        pg8::gemm_phase<pg8::EpiResGateNorm, pg8::StaticOrder, true, true>((PG8_LAS unsigned char*)lds, g, S, E);
    }
    SEAM(PH_GOUT);
    if (IN(PH_UP)) {
        pg8::Gemm g{REGA, (const bf16*)(p.ws + WS_W1), M, FF, DM, DM}; pg8::StaticOrder S; S.init(M, FF, G, (int)blockIdx.x);
        pg8::EpiF8Relu2 E{p.ws + WS_U, FF, 4.f, (const float*)(p.ws + WS_ROWSQ), (const float*)(p.ws + WS_BIAS2)};
        pg8::gemm_phase<pg8::EpiF8Relu2, pg8::StaticOrder, true, true>((PG8_LAS unsigned char*)lds, g, S, E);
    }
    SEAM(PH_UP);
    if (IN(PH_DOWN)) {
        pg8::Gemm g{(const bf16*)(p.ws + WS_U), (const bf16*)(p.ws + WS_W2), M, DM, FF / 2, FF / 2}; pg8::StaticOrder S; S.init(M, DM, G, (int)blockIdx.x);
        pg8::EpiResGateA2 E{REGA, p.out, DM, MOD + 5120, 6144, p.g_ffn};
        pg8::gemm_phase<pg8::EpiResGateA2, pg8::StaticOrder, true, true, true>((PG8_LAS unsigned char*)lds, g, S, E);
    }
#if MK_PROBE >= 0
    grid.sync();
    if (blockIdx.x == 0 && tid == 0) { unsigned long long* ts = (unsigned long long*)(p.ws + WS_MOD + 800 * 1024); ts[PH_COUNT] = __builtin_amdgcn_s_memrealtime();
        p.out[0] += (float)(ts[MK_PROBE + 1] - ts[MK_PROBE]) * 1e-3f; }
#endif
#undef IN
#undef SEAM
}

#ifndef MK_N_LAUNCHES
#define MK_N_LAUNCHES 1
#endif
extern "C" void kernel_launch(void* const* d_in, const int* in_sizes, int n_in, void* d_out, int out_size, void* d_ws, size_t ws_size, hipStream_t stream) {
    static int grid = 0;
    if (grid == 0) {
        if (n_in != 26 || out_size != M * DM || ws_size < WS_END) { fprintf(stderr, "kernel_launch: unexpected shapes (n_in %d out %d ws %zu)\n", n_in, out_size, ws_size); grid = -1; return; }
        int dev = 0, cus = 0, per_cu = 0;
        hipGetDevice(&dev); hipDeviceGetAttribute(&cus, hipDeviceAttributeMultiprocessorCount, dev);
        if (hipFuncSetAttribute((const void*)mk_fwd, hipFuncAttributeMaxDynamicSharedMemorySize, LDS_BYTES) != hipSuccess) { fprintf(stderr, "kernel_launch: hipFuncSetAttribute failed\n"); grid = -1; return; }
        if (hipOccupancyMaxActiveBlocksPerMultiprocessor(&per_cu, (const void*)mk_fwd, NWAVES * 64, LDS_BYTES) != hipSuccess || per_cu < 1) { fprintf(stderr, "kernel_launch: occupancy query says %d\n", per_cu); per_cu = 1; }
        (void)hipGetLastError();
        grid = cus * 1;
        if (per_cu < 1) grid = -1;
    }
    if (grid < 0) return;
    Params p{};
    const float** pp = (const float**)&p;
    for (int i = 0; i < 26; ++i) pp[i] = (const float*)d_in[i];
    p.out = (float*)d_out; p.ws = (unsigned char*)d_ws;
#if MK_N_LAUNCHES == 1
    if (hipMemsetAsync((char*)d_ws + WS_BAR, 0, 16384, stream) != hipSuccess) { fprintf(stderr, "kernel_launch: memset of the barrier words failed\n"); return; }
    p.ph_lo = 0; p.ph_hi = PH_COUNT;
    void* args[] = {&p};
    hipError_t e = hipLaunchCooperativeKernel((const void*)mk_fwd, dim3(grid), dim3(NWAVES * 64), args, LDS_BYTES, stream);
    if (e != hipSuccess) fprintf(stderr, "cooperative launch failed: %s (grid %d)\n", hipGetErrorString(e), grid);
#else
    for (int ph = 0; ph < PH_COUNT; ++ph) {
#if MK_SKIP_MIXER
        if (ph >= PH_HN && ph <= PH_GOUT) continue;
#endif
        p.ph_lo = ph; p.ph_hi = ph + 1;
        hipLaunchKernelGGL(mk_fwd, dim3(grid), dim3(NWAVES * 64), LDS_BYTES, stream, p);
    }
#endif
}
```

```cpp
#include <hip/hip_runtime.h>
#include <hip/hip_cooperative_groups.h>
#include <cstdio>
#include <cstdint>
#include <cmath>
namespace cg = cooperative_groups;
#ifndef MK_F8_GEMM1
#define MK_F8_GEMM1 0
#endif
#ifndef MK_PROBE
#define MK_PROBE -1
#endif
#ifndef MK_DBG
#define MK_DBG 0
#endif
#ifndef MK_DBG_NOTOPK
#define MK_DBG_NOTOPK 0
#endif
namespace pg8 {
#define PG8_LAS __attribute__((address_space(3)))
typedef unsigned short bf16_t;
typedef short bf16x8 __attribute__((ext_vector_type(8)));
typedef float f32x4 __attribute__((ext_vector_type(4)));
typedef unsigned u32x4 __attribute__((ext_vector_type(4)));
constexpr int BM = 256, BK = 64, HALF = 128, HTB = HALF * BK * 2  , STAGE_BYTES = 8 * HTB, NXCD = 8, WGM = 8;

__host__ __device__ __forceinline__ int lds_byte(int r, int c) { const int st = (r >> 4) * 2 + (c >> 5), rr = r & 15, cc = c & 31, ob = rr * 64 + cc * 2; return st * 1024 + (ob ^ (((ob >> 9) & 1) << 5)); }
__host__ __device__ __forceinline__ void stage_rc(int b, int& R, int& C) { const int st = b / 1024, sb = b % 1024, swz = sb ^ (((sb >> 9) & 1) << 5); R = (st >> 1) * 16 + swz / 64; C = (st & 1) * 32 + (swz % 64) / 2; }
__host__ __device__ __forceinline__ int perm32(int rho) { const int n = rho >> 4, i = rho & 15; return 8 * (i >> 2) + 4 * n + (i & 3); }

struct Unit { int pm, pn; };
struct Gemm { const bf16_t* A; const bf16_t* Bt; int M, N, K, lda; };

struct StaticOrder {
    int nM, nN, nwg, G, c;
    __host__ __device__ void init(int M, int N, int G_, int c_) { nM = M / BM; nN = N / BM; nwg = nM * nN; G = G_; c = c_; }
    __host__ __device__ bool next(int i, Unit& u) const {
        const long L = (long)i * G + c; if (L >= nwg) return false;
        int wgid = (int)L; { const int q = nwg / NXCD, r = nwg % NXCD, xcd = wgid % NXCD, off = wgid / NXCD; wgid = (xcd < r ? xcd * (q + 1) : r * (q + 1) + (xcd - r) * q) + off; }
        const int nig = WGM * nN, gid = wgid / nig, fm = gid * WGM, gsz = (nM - fm) < WGM ? (nM - fm) : WGM;
        u.pm = fm + ((wgid % nig) % gsz); u.pn = (wgid % nig) / gsz; return true;
    }
    __device__ __forceinline__ void a_ready(const Unit&) const {}
    __device__ __forceinline__ void done(const Unit&) const {}
};


typedef float f32x2_t __attribute__((ext_vector_type(2))); typedef __bf16 bf16x2_t __attribute__((ext_vector_type(2)));
__device__ __forceinline__ unsigned cvt_pk_bf16(float lo, float hi) { const f32x2_t v = {lo, hi}; const bf16x2_t b = __builtin_convertvector(v, bf16x2_t); return __builtin_bit_cast(unsigned, b); }

template <int ACT  > struct EpiBf16 {
    static constexpr bool PERM = true, AFTER_DRAIN = false;
    bf16_t* O; int ldc; float scale;
    __device__ __forceinline__ void operator()(const f32x4 (&acc)[2][2][4][2], const Unit& u, int wr, int wc, int fr, int fq) const {
        const int row0 = u.pm * BM + wr * 64 + fr; const int col0 = u.pn * BM + wc * 32 + 8 * fq;
#pragma unroll
        for (int ai = 0; ai < 2; ++ai)
#pragma unroll
            for (int m = 0; m < 4; ++m) { bf16_t* rowp = O + (size_t)(row0 + ai * HALF + m * 16) * ldc + col0;
#pragma unroll
                for (int bj = 0; bj < 2; ++bj) { f32x4 v0 = acc[ai][bj][m][0] * scale, v1 = acc[ai][bj][m][1] * scale;
                    if (ACT == 1) {
#pragma unroll
                        for (int j = 0; j < 4; ++j) { const float a = v0[j] > 0.f ? v0[j] : 0.f, b = v1[j] > 0.f ? v1[j] : 0.f; v0[j] = a * a; v1[j] = b * b; } }
                    u32x4 w; w.x = cvt_pk_bf16(v0[0], v0[1]); w.y = cvt_pk_bf16(v0[2], v0[3]); w.z = cvt_pk_bf16(v1[0], v1[1]); w.w = cvt_pk_bf16(v1[2], v1[3]);
                    *(u32x4*)(rowp + bj * HALF) = w; } }
    }
};
__device__ __forceinline__ unsigned pk4_fp8(float a, float b, float c, float d) { int r = __builtin_amdgcn_cvt_pk_fp8_f32(a, b, 0, false); r = __builtin_amdgcn_cvt_pk_fp8_f32(c, d, r, true); return (unsigned)r; }
struct EpiF8Relu2 {
    static constexpr bool PERM = true, AFTER_DRAIN = false;
    unsigned char* O; int ldc; float scale; const float* rowsq; const float* bias2;
    __device__ __forceinline__ void operator()(const f32x4 (&acc)[2][2][4][2], const Unit& u, int wr, int wc, int fr, int fq) const {
        const int row0 = u.pm * BM + wr * 64 + fr; const int col0 = u.pn * BM + wc * 32 + 8 * fq;
        const float* bp = bias2 + (size_t)(u.pm >> 3) * 4096 + col0;
        f32x4 bv[2][2];
#pragma unroll
        for (int bj = 0; bj < 2; ++bj) { bv[bj][0] = *(const f32x4*)(bp + bj * HALF); bv[bj][1] = *(const f32x4*)(bp + bj * HALF + 4); }
#pragma unroll
        for (int ai = 0; ai < 2; ++ai)
#pragma unroll
            for (int m = 0; m < 4; ++m) { const int row = row0 + ai * HALF + m * 16; unsigned char* rowp = O + (size_t)row * ldc + col0;
                const float rstd = rsqrtf(rowsq[row] * (1.f / 1024.f) + 1e-6f);
#pragma unroll
                for (int bj = 0; bj < 2; ++bj) { f32x4 v0 = acc[ai][bj][m][0] * rstd + bv[bj][0], v1 = acc[ai][bj][m][1] * rstd + bv[bj][1];
#pragma unroll
                    for (int j = 0; j < 4; ++j) { const float a = v0[j] > 0.f ? v0[j] : 0.f, b = v1[j] > 0.f ? v1[j] : 0.f; v0[j] = fminf(a * a * scale, 416.f); v1[j] = fminf(b * b * scale, 416.f); }
                    typedef unsigned u32x2_t __attribute__((ext_vector_type(2)));
                    u32x2_t w; w.x = pk4_fp8(v0[0], v0[1], v0[2], v0[3]); w.y = pk4_fp8(v1[0], v1[1], v1[2], v1[3]);
                    *(u32x2_t*)(rowp + bj * HALF) = w; } }
    }
};
struct EpiResGate {
    static constexpr bool PERM = false, AFTER_DRAIN = false;
    const float* base; float* out; int ldc; const float* gate; int gate_ld; float gscale;
    __device__ __forceinline__ void operator()(const f32x4 (&acc)[2][2][4][2], const Unit& u, int, int, int, int) const {
        int t_ = threadIdx.x; asm volatile("" : "+v"(t_));
        const int wr = t_ >> 8, wc = (t_ >> 6) & 3, fr = t_ & 15, fq = (t_ >> 4) & 3;
        const int row0 = u.pm * BM + wr * 64 + fr, col0 = u.pn * BM + wc * 32 + 4 * fq;
        const float* gp = gate + (size_t)(u.pm >> 3) * gate_ld + col0;
        f32x4 gv[2][2];
#pragma unroll
        for (int bj = 0; bj < 2; ++bj)
#pragma unroll
            for (int n = 0; n < 2; ++n) gv[bj][n] = *(const f32x4*)(gp + bj * HALF + n * 16) * gscale;
#pragma unroll
        for (int ai = 0; ai < 2; ++ai)
#pragma unroll
            for (int m = 0; m < 4; ++m) { const size_t off = (size_t)(row0 + ai * HALF + m * 16) * ldc + col0;
#pragma unroll
                for (int bj = 0; bj < 2; ++bj)
#pragma unroll
                    for (int n = 0; n < 2; ++n) { const f32x4 bs = *(const f32x4*)(base + off + bj * HALF + n * 16);
                        *(f32x4*)(out + off + bj * HALF + n * 16) = bs + gv[bj][n] * acc[ai][bj][m][n]; } }
    }
};
struct EpiResGateNorm {
    static constexpr bool PERM = false, AFTER_DRAIN = false;
    const float* base; float* out; int ldc; const float* gate; int gate_ld; const float* gffn; const float* sc2; bf16_t* a2; float* rowsq;
    __device__ __forceinline__ void operator()(const f32x4 (&acc)[2][2][4][2], const Unit& u, int, int, int, int) const {
        int t_ = threadIdx.x; asm volatile("" : "+v"(t_));
        const int wr = t_ >> 8, wc = (t_ >> 6) & 3, fr = t_ & 15, fq = (t_ >> 4) & 3;
        const int row0 = u.pm * BM + wr * 64 + fr, col0 = u.pn * BM + wc * 32 + 4 * fq;
        const float* gp = gate + (size_t)(u.pm >> 3) * gate_ld + col0; const float* sp = sc2 + (size_t)(u.pm >> 3) * gate_ld + col0;
        f32x4 gv[2][2], gm[2][2];
#pragma unroll
        for (int bj = 0; bj < 2; ++bj)
#pragma unroll
            for (int n = 0; n < 2; ++n) { gv[bj][n] = *(const f32x4*)(gp + bj * HALF + n * 16); gm[bj][n] = *(const f32x4*)(gffn + col0 + bj * HALF + n * 16) * (*(const f32x4*)(sp + bj * HALF + n * 16) + 1.f); }
#pragma unroll
        for (int ai = 0; ai < 2; ++ai)
#pragma unroll
            for (int m = 0; m < 4; ++m) { const int row = row0 + ai * HALF + m * 16; const size_t off = (size_t)row * ldc + col0; float ss = 0.f;
#pragma unroll
                for (int bj = 0; bj < 2; ++bj)
#pragma unroll
                    for (int n = 0; n < 2; ++n) { const f32x4 bs = *(const f32x4*)(base + off + bj * HALF + n * 16); const f32x4 x1 = bs + gv[bj][n] * acc[ai][bj][m][n];
                        ss += (x1.x * x1.x + x1.y * x1.y) + (x1.z * x1.z + x1.w * x1.w);
                        const f32x4 y = x1 * gm[bj][n]; typedef unsigned u32x2_t __attribute__((ext_vector_type(2)));
                        u32x2_t w; w.x = cvt_pk_bf16(y.x, y.y); w.y = cvt_pk_bf16(y.z, y.w); *(u32x2_t*)(a2 + off + bj * HALF + n * 16) = w; }
                ss += __shfl_xor(ss, 16); ss += __shfl_xor(ss, 32);
                if (fq == 0) atomicAdd(rowsq + row, ss); }
    }
};
struct EpiResGateA2 {
    static constexpr bool PERM = false, AFTER_DRAIN = false;
    const bf16_t* a2; float* out; int ldc; const float* gate; int gate_ld; const float* gffn;
    __device__ __forceinline__ void operator()(const f32x4 (&acc)[2][2][4][2], const Unit& u, int, int, int, int) const {
        constexpr float gscale = 1.f / 256.f;
        int t_ = threadIdx.x; asm volatile("" : "+v"(t_));
        const int wr = t_ >> 8, wc = (t_ >> 6) & 3, fr = t_ & 15, fq = (t_ >> 4) & 3;
        const int row0 = u.pm * BM + wr * 64 + fr, col0 = u.pn * BM + wc * 32 + 4 * fq;
        const float* gp = gate + (size_t)(u.pm >> 3) * gate_ld + col0; const float* sp = gp - 1024;
        f32x4 gv[2][2], ig[2][2];
#pragma unroll
        for (int bj = 0; bj < 2; ++bj)
#pragma unroll
            for (int n = 0; n < 2; ++n) { gv[bj][n] = *(const f32x4*)(gp + bj * HALF + n * 16) * gscale;
                const f32x4 gm = *(const f32x4*)(gffn + col0 + bj * HALF + n * 16) * (*(const f32x4*)(sp + bj * HALF + n * 16) + 1.f);
                ig[bj][n] = (f32x4){1.f / gm.x, 1.f / gm.y, 1.f / gm.z, 1.f / gm.w}; }
#pragma unroll
        for (int ai = 0; ai < 2; ++ai)
#pragma unroll
            for (int m = 0; m < 4; ++m) { const size_t off = (size_t)(row0 + ai * HALF + m * 16) * ldc + col0;
#pragma unroll
                for (int bj = 0; bj < 2; ++bj)
#pragma unroll
                    for (int n = 0; n < 2; ++n) { typedef unsigned u32x2_t __attribute__((ext_vector_type(2)));
                        const u32x2_t w = *(const u32x2_t*)(a2 + off + bj * HALF + n * 16);
                        const f32x4 xa = {__uint_as_float(w.x << 16), __uint_as_float(w.x & 0xffff0000u), __uint_as_float(w.y << 16), __uint_as_float(w.y & 0xffff0000u)};
                        *(f32x4*)(out + off + bj * HALF + n * 16) = xa * ig[bj][n] + gv[bj][n] * acc[ai][bj][m][n]; } }
    }
};
template <class Epi, class Sched, bool ALIGN_EPI = false, bool SP2 = false, bool F8 = false>
__device__ __forceinline__ void gemm_phase(PG8_LAS unsigned char* lds, const Gemm g, const Sched S, const Epi E) {
    const int tid = threadIdx.x, wid = __builtin_amdgcn_readfirstlane(tid >> 6), lane = tid & 63, wr = wid >> 2, wc = wid & 3, fr = lane & 15, fq = lane >> 4;
    const int K = g.K, nt = K / BK;
    unsigned voffA[2], voffB[2];
#pragma unroll
    for (int i = 0; i < 2; ++i) { int R, C; stage_rc(tid * 16 + i * 8192, R, C); const int Rb = Epi::PERM ? ((R & ~31) + perm32(R & 31)) : R;
        voffA[i] = (unsigned)(R * g.lda + C) * 2u; voffB[i] = (unsigned)(Rb * K + C) * 2u; }
    const size_t kstep = (size_t)(BK * 2);
    const size_t hstepB = (size_t)HALF * K * 2, hstepA = (size_t)HALF * g.lda * 2;
    const size_t tstepA = 2 * hstepA, tstepB = 2 * hstepB;
    const unsigned ldsw = (unsigned)wid * 1024u;
    const int f8in = (fq >> 1) * 1024 + ((fr * 64 + (fq & 1) * 32) ^ ((fr >> 3) << 5));
    const int aoff = F8 ? wr * 8192 + f8in : lds_byte(wr * 64 + fr, fq * 8), boff = F8 ? wc * 4096 + f8in : lds_byte(wc * 32 + fr, fq * 8);
    constexpr int KOFF = F8 ? 16 : 1024;
    typedef int v8i_t __attribute__((ext_vector_type(8)));
#define PG8_SA(b, h) (((b) * 2 + (h)) * HTB)
#define PG8_SB(b, h) ((4 + (b) * 2 + (h)) * HTB)
#define PG8_STAGE(bufoff, gbase, voff) do { _Pragma("unroll") for (int _i = 0; _i < 2; ++_i) \
        __builtin_amdgcn_global_load_lds((const unsigned*)((const char*)(gbase) + (voff)[_i]), (PG8_LAS unsigned*)(lds + (bufoff) + ldsw + _i * 8192), 16, 0, 0); } while (0)
#define PG8_LD32(p_) __builtin_shufflevector(*(const PG8_LAS u32x4*)(p_), *(const PG8_LAS u32x4*)((p_) + 16), 0, 1, 2, 3, 4, 5, 6, 7)
#define PG8_LDA(dst, b, h) do { if constexpr (F8) { _Pragma("unroll") for (int m = 0; m < 4; ++m) dst##8[m] = __builtin_bit_cast(v8i_t, PG8_LD32(lds + PG8_SA(b, h) + aoff + m * 2048)); } \
    else { _Pragma("unroll") for (int m = 0; m < 4; ++m) _Pragma("unroll") for (int k = 0; k < 2; ++k) dst[m][k] = *(const PG8_LAS bf16x8*)(lds + PG8_SA(b, h) + aoff + m * 2048 + k * KOFF); } } while (0)
#define PG8_LDB(dst, b, h) do { if constexpr (F8) { _Pragma("unroll") for (int n = 0; n < 2; ++n) dst##8[n] = __builtin_bit_cast(v8i_t, PG8_LD32(lds + PG8_SB(b, h) + boff + n * 2048)); } \
    else { _Pragma("unroll") for (int n = 0; n < 2; ++n) _Pragma("unroll") for (int k = 0; k < 2; ++k) dst[n][k] = *(const PG8_LAS bf16x8*)(lds + PG8_SB(b, h) + boff + n * 2048 + k * KOFF); } } while (0)
#define PG8_CAT(x) __builtin_shufflevector(__builtin_bit_cast(u32x4, (x)[0]), __builtin_bit_cast(u32x4, (x)[1]), 0, 1, 2, 3, 4, 5, 6, 7)
#define PG8_MMA(ai, bj, At, Bt) do { __builtin_amdgcn_s_setprio(1); if constexpr (F8) { _Pragma("unroll") for (int m = 0; m < 4; ++m) _Pragma("unroll") for (int n = 0; n < 2; ++n) \
        asm volatile("v_mfma_f32_16x16x128_f8f6f4 %0, %1, %2, %0" : "+v"(acc[ai][bj][m][n]) : "v"(Bt##8[n]), "v"(At##8[m])); } \
    else { _Pragma("unroll") for (int m = 0; m < 4; ++m) _Pragma("unroll") for (int n = 0; n < 2; ++n) _Pragma("unroll") for (int k = 0; k < 2; ++k) \
        acc[ai][bj][m][n] = __builtin_amdgcn_mfma_f32_16x16x32_bf16(Bt[n][k], At[m][k], acc[ai][bj][m][n], 0, 0, 0); } __builtin_amdgcn_s_setprio(0); } while (0)
#define PG8_WAIT_V(n) asm volatile("s_waitcnt vmcnt(" #n ")" ::: "memory")
#define PG8_WAIT_L(n) asm volatile("s_waitcnt lgkmcnt(" #n ")" ::: "memory")
#define PG8_BAR __builtin_amdgcn_s_barrier()
#define PG8_SCHED __builtin_amdgcn_sched_barrier(0)
    Unit cur, nxt; int ui = 0;
    if (!S.next(0, cur)) return;
    f32x4 acc[2][2][4][2];
#pragma unroll
    for (int a = 0; a < 2; ++a)
#pragma unroll
        for (int b = 0; b < 2; ++b)
#pragma unroll
            for (int m = 0; m < 4; ++m)
#pragma unroll
                for (int n = 0; n < 2; ++n) acc[a][b][m][n] = (f32x4){0.f, 0.f, 0.f, 0.f};
    bf16x8 At[4][2], B0[2][2], B1[2][2]; v8i_t At8[4], B08[2], B18[2];
    const char* cA = (const char*)g.A + (size_t)cur.pm * tstepA; const char* cB = (const char*)g.Bt + (size_t)cur.pn * tstepB;
    S.a_ready(cur);
    if constexpr (SP2) {
        PG8_STAGE(PG8_SB(0, 0), cB, voffB); PG8_STAGE(PG8_SB(0, 1), cB + hstepB, voffB); PG8_STAGE(PG8_SA(0, 0), cA, voffA); PG8_STAGE(PG8_SA(0, 1), cA + hstepA, voffA);
        if (wr == 1) PG8_BAR;
        PG8_WAIT_V(2); PG8_BAR;
        PG8_STAGE(PG8_SB(1, 0), cB + kstep, voffB); PG8_STAGE(PG8_SA(1, 0), cA + kstep, voffA); PG8_STAGE(PG8_SB(1, 1), cB + hstepB + kstep, voffB);
        PG8_WAIT_V(6); PG8_BAR;
    } else {
        PG8_STAGE(PG8_SB(0, 0), cB, voffB); PG8_STAGE(PG8_SA(0, 0), cA, voffA); PG8_STAGE(PG8_SB(0, 1), cB + hstepB, voffB); PG8_STAGE(PG8_SA(0, 1), cA + hstepA, voffA);
        if (wr == 1) PG8_BAR;
        PG8_WAIT_V(4); PG8_BAR;
        PG8_STAGE(PG8_SB(1, 0), cB + kstep, voffB); PG8_STAGE(PG8_SA(1, 0), cA + kstep, voffA); PG8_STAGE(PG8_SB(1, 1), cB + hstepB + kstep, voffB);
        PG8_WAIT_V(6); PG8_BAR;
    }
    for (;;) {
        const bool has_next = S.next(ui + 1, nxt);
        const char* nA = has_next ? (const char*)g.A + (size_t)nxt.pm * tstepA : cA; const char* nB = has_next ? (const char*)g.Bt + (size_t)nxt.pn * tstepB : cB;
        for (int t = 0; t < nt; t += 2) {
            const bool last = (t == nt - 2);
            const char* a1 = cA + (size_t)(t + 1) * kstep;
            const char* a2 = last ? nA : cA + (size_t)(t + 2) * kstep; const char* b2 = last ? nB : cB + (size_t)(t + 2) * kstep;
            const char* a3 = a2 + kstep; const char* b3 = b2 + kstep;
            if (last && has_next) S.a_ready(nxt);
            if constexpr (SP2) {
            PG8_LDB(B0, 0, 0); PG8_LDB(B1, 0, 1); PG8_SCHED; PG8_LDA(At, 0, 0); PG8_STAGE(PG8_SA(1, 1), a1 + hstepA, voffA);
            PG8_WAIT_V(8); PG8_WAIT_L(0); PG8_BAR; PG8_MMA(0, 0, At, B0); PG8_MMA(0, 1, At, B1); PG8_BAR; PG8_SCHED;
            PG8_LDA(At, 0, 1); PG8_STAGE(PG8_SB(0, 0), b2, voffB); PG8_STAGE(PG8_SB(0, 1), b2 + hstepB, voffB); PG8_STAGE(PG8_SA(0, 0), a2, voffA);
            PG8_WAIT_V(8); PG8_WAIT_L(0); PG8_BAR; PG8_MMA(1, 0, At, B0); PG8_MMA(1, 1, At, B1); PG8_BAR; PG8_SCHED;
            PG8_LDB(B0, 1, 0); PG8_LDB(B1, 1, 1); PG8_SCHED; PG8_LDA(At, 1, 0); PG8_STAGE(PG8_SA(0, 1), a2 + hstepA, voffA);
            PG8_WAIT_V(8); PG8_WAIT_L(0); PG8_BAR; PG8_MMA(0, 0, At, B0); PG8_MMA(0, 1, At, B1); PG8_BAR; PG8_SCHED;
            PG8_LDA(At, 1, 1); PG8_STAGE(PG8_SB(1, 0), b3, voffB); PG8_STAGE(PG8_SB(1, 1), b3 + hstepB, voffB); PG8_STAGE(PG8_SA(1, 0), a3, voffA);
            PG8_WAIT_V(8); PG8_WAIT_L(0); PG8_BAR; PG8_MMA(1, 0, At, B0); PG8_MMA(1, 1, At, B1); PG8_BAR; PG8_SCHED;
            } else {
            PG8_LDB(B0, 0, 0); PG8_SCHED; PG8_LDA(At, 0, 0); PG8_STAGE(PG8_SA(1, 1), a1 + hstepA, voffA);
            PG8_WAIT_L(8); PG8_BAR; PG8_WAIT_L(0); PG8_MMA(0, 0, At, B0); PG8_BAR; PG8_SCHED;
            PG8_LDB(B1, 0, 1); PG8_STAGE(PG8_SB(0, 0), b2, voffB);
            PG8_BAR; PG8_WAIT_L(0); PG8_MMA(0, 1, At, B1); PG8_BAR;
            PG8_LDA(At, 0, 1); PG8_STAGE(PG8_SA(0, 0), a2, voffA);
            PG8_BAR; PG8_WAIT_L(0); PG8_MMA(1, 0, At, B0); PG8_BAR; PG8_SCHED;
            PG8_STAGE(PG8_SB(0, 1), b2 + hstepB, voffB);
            PG8_WAIT_V(6); PG8_BAR; PG8_MMA(1, 1, At, B1); PG8_BAR;
            PG8_LDB(B0, 1, 0); PG8_SCHED; PG8_LDA(At, 1, 0); PG8_STAGE(PG8_SA(0, 1), a2 + hstepA, voffA);
            PG8_WAIT_L(8); PG8_BAR; PG8_WAIT_L(0); PG8_MMA(0, 0, At, B0); PG8_BAR; PG8_SCHED;
            PG8_LDB(B1, 1, 1); PG8_STAGE(PG8_SB(1, 0), b3, voffB);
            PG8_BAR; PG8_WAIT_L(0); PG8_MMA(0, 1, At, B1); PG8_BAR;
            PG8_LDA(At, 1, 1); PG8_STAGE(PG8_SA(1, 0), a3, voffA);
            PG8_BAR; PG8_WAIT_L(0); PG8_MMA(1, 0, At, B0); PG8_BAR; PG8_SCHED;
            PG8_STAGE(PG8_SB(1, 1), b3 + hstepB, voffB);
            PG8_WAIT_V(6); PG8_BAR; PG8_MMA(1, 1, At, B1); PG8_BAR;
            }
        }
        if constexpr (ALIGN_EPI) { if (wr == 0) PG8_BAR; }
        if constexpr (F8) asm volatile("s_nop 15\n\ts_nop 15");
        if constexpr (!Epi::AFTER_DRAIN) { E(acc, cur, wr, wc, fr, fq); S.done(cur); }
        if (!has_next) break;
#pragma unroll
        for (int a = 0; a < 2; ++a)
#pragma unroll
            for (int b = 0; b < 2; ++b)
#pragma unroll
                for (int m = 0; m < 4; ++m)
#pragma unroll
                    for (int n = 0; n < 2; ++n) acc[a][b][m][n] = (f32x4){0.f, 0.f, 0.f, 0.f};
        cur = nxt; cA = nA; cB = nB; ++ui;
        if constexpr (ALIGN_EPI) { if (wr == 1) PG8_BAR; }
    }
    PG8_WAIT_V(0);
    if constexpr (!ALIGN_EPI) { if (wr == 0) PG8_BAR; }
    PG8_BAR;
    if constexpr (Epi::AFTER_DRAIN) { E.fused(acc, cur, wr, wc, fr, fq, lds, wid, lane); S.done(cur); }
#undef PG8_SA
#undef PG8_SB
#undef PG8_STAGE
#undef PG8_LDA
#undef PG8_LDB
#undef PG8_MMA
#undef PG8_CAT
#undef PG8_LD32
#undef PG8_WAIT_V
#undef PG8_WAIT_L
#undef PG8_BAR
#undef PG8_SCHED
}
}

#define LAS __attribute__((address_space(3)))
typedef unsigned short bf16;
typedef short bf16x8 __attribute__((ext_vector_type(8)));
typedef short s16x4 __attribute__((ext_vector_type(4)));
typedef float f32x4 __attribute__((ext_vector_type(4)));
typedef float f32x16 __attribute__((ext_vector_type(16)));
typedef unsigned u32x4 __attribute__((ext_vector_type(4)));
typedef unsigned u32x2 __attribute__((ext_vector_type(2)));

constexpr int NB = 32, SEQ = 2048, DM = 1024, M = NB * SEQ, NPROJ = 3072, FF = 4096;
constexpr int PC_Q = 0, PC_R = 512, PC_K = 1024, PC_V = 1536, PC_QI = 2048, PC_CL = 2560, PC_KI = 2688, PC_XW = 2752, PC_XA = 2816, PC_XG = 2880, PC_WI = 3008;
constexpr size_t MiB = 1u << 20;
constexpr size_t WS_MOD = 0, WS_WUKT = 1 * MiB, WS_WUK = WS_WUKT + 131072, WS_WUVT = WS_WUK + 131072, WS_INVR = 2 * MiB, WS_WIN = 4 * MiB, WS_WOUT = 10 * MiB,
                 WS_W1 = 12 * MiB, WS_W2 = 20 * MiB, WS_CKV = 36 * MiB, WS_GAM = 52 * MiB, WS_C3 = 60 * MiB, WS_REGA = 64 * MiB, WS_PROJ = 192 * MiB, WS_CH = 576 * MiB,
                 WS_G = 960 * MiB, WS_U = 192 * MiB, WS_END = 1024 * MiB,
                 WS_BAR = 62 * MiB, WS_ROWSQ = WS_BAR + 65536, WS_BIAS2 = WS_ROWSQ + 262144, WS_W2T = WS_WUVT + 131072, WS_A2T = WS_W2T + 65536, WS_G2T = WS_A2T + 65536;
constexpr int LDS_BAR_OFF = 163072;
constexpr int LDS_BYTES = 163328;
constexpr int NWAVES = 8;

struct Params {
    const float *x, *c, *w_ada, *b_ada, *g_mix, *g_ffn, *w_in, *g_q, *g_k, *g_kv, *w_uk, *w_uv, *mu, *w0, *w2, *a0, *a2, *g2, *k_k, *k_a, *r_k, *ln_w, *ln_b, *w_out, *w_ff1, *w_ff2;
    float* out; unsigned char* ws; int ph_lo, ph_hi;
};

__device__ __forceinline__ unsigned pk2(float lo, float hi) { return pg8::cvt_pk_bf16(lo, hi); }
__device__ __forceinline__ float bflo(unsigned w) { return __uint_as_float(w << 16); }
__device__ __forceinline__ float bfhi(unsigned w) { return __uint_as_float(w & 0xffff0000u); }
__device__ __forceinline__ float bf2f(bf16 h) { return __uint_as_float((unsigned)h << 16); }
__device__ __forceinline__ bf16 f2bf(float f) { return (bf16)(pk2(f, 0.f) & 0xffffu); }
__device__ __forceinline__ float wave_sum(float v) {
#pragma unroll
    for (int o = 1; o < 64; o <<= 1) v += __shfl_xor(v, o);
    return v;
}
__device__ __forceinline__ f32x16 mfma32(bf16x8 a, bf16x8 b, f32x16 c) { return __builtin_amdgcn_mfma_f32_32x32x16_bf16(a, b, c, 0, 0, 0); }
__device__ __forceinline__ f32x4 mfma16(bf16x8 a, bf16x8 b, f32x4 c) { return __builtin_amdgcn_mfma_f32_16x16x32_bf16(a, b, c, 0, 0, 0); }

__device__ __forceinline__ int win_src_col(int n) {
    if (n < 512) return n;
    if (n < 1024) return 1224 + (n - 512);
    if (n < 1536) return 1736 + (n - 1024);
    if (n < 2048) return 2248 + (n - 1536);
    if (n < 2560) return 640 + (n - 2048);
    if (n < 2688) return 512 + (n - 2560);
    if (n < 2752) return 1152 + (n - 2688);
    if (n < 2816) return 2760 + (n - 2752);
    if (n < 2880) return 2824 + (n - 2816);
    if (n < 3008) return 2888 + (n - 2880);
    if (n < 3016) return 1216 + (n - 3008);
    return -1;
}
__device__ __forceinline__ void conv_t_item(const float* W, int K, int Nsrc, bf16* WT, int nblk, int item, float* scr, int lane, bool is_win) {
    const int kb = item / nblk, nb = item % nblk, k0 = 64 * kb, n0 = 32 * nb;
    int ns = n0 + (lane & 31); if (is_win) ns = win_src_col(ns);
    float tv[32];
#pragma unroll
    for (int i = 0; i < 32; ++i) { const int kk = 2 * i + (lane >> 5); tv[i] = ns >= 0 ? W[(size_t)(k0 + kk) * Nsrc + ns] : 0.f; }
#pragma unroll
    for (int i = 0; i < 32; ++i) { const int kk = 2 * i + (lane >> 5); scr[kk * 33 + (lane & 31)] = tv[i]; }
    asm volatile("s_waitcnt lgkmcnt(0)" ::: "memory");
    const int c = lane & 7;
#pragma unroll
    for (int j = 0; j < 4; ++j) { const int n = (lane >> 3) + 8 * j; const float* s = scr + (8 * c) * 33 + n;
        u32x4 o; o.x = pk2(s[0 * 33], s[1 * 33]); o.y = pk2(s[2 * 33], s[3 * 33]); o.z = pk2(s[4 * 33], s[5 * 33]); o.w = pk2(s[6 * 33], s[7 * 33]);
        *(u32x4*)(WT + (size_t)(n0 + n) * K + k0 + 8 * c) = o; }
    asm volatile("s_waitcnt lgkmcnt(0)" ::: "memory");
}
__device__ __forceinline__ void conv_t_item_f8(const float* W, int K, int N, unsigned char* WT, int nblk, int item, float* scr, int lane, float scale, bool is_win = false) {
    const int kb = item / nblk, nb = item % nblk, k0 = 64 * kb, n0 = 32 * nb;
    int ns = n0 + (lane & 31); if (is_win) ns = win_src_col(ns);
    float tv[32];
#pragma unroll
    for (int i = 0; i < 32; ++i) { const int kk = 2 * i + (lane >> 5); tv[i] = ns >= 0 ? W[(size_t)(k0 + kk) * N + ns] * scale : 0.f; }
#pragma unroll
    for (int i = 0; i < 32; ++i) { const int kk = 2 * i + (lane >> 5); scr[kk * 33 + (lane & 31)] = tv[i]; }
    asm volatile("s_waitcnt lgkmcnt(0)" ::: "memory");
    const int c = lane & 7;
#pragma unroll
    for (int j = 0; j < 4; ++j) { const int n = (lane >> 3) + 8 * j; const float* s = scr + (8 * c) * 33 + n;
        u32x2 o; o.x = pg8::pk4_fp8(s[0 * 33], s[1 * 33], s[2 * 33], s[3 * 33]); o.y = pg8::pk4_fp8(s[4 * 33], s[5 * 33], s[6 * 33], s[7 * 33]);
        *(u32x2*)(WT + (size_t)(n0 + n) * K + k0 + 8 * c) = o; }
    asm volatile("s_waitcnt lgkmcnt(0)" ::: "memory");
}
__device__ __forceinline__ void adaln_block(const Params& p, float* ldsf, int cb, int tid) {
    const int lane = tid & 63, wv = tid >> 6, e = cb * 64 + lane;
    float* SC = ldsf; float* RED = ldsf + 16384; float* mod = (float*)(p.ws + WS_MOD);
    float wreg[128];
#pragma unroll
    for (int d = 0; d < 128; ++d) wreg[d] = p.w_ada[(size_t)(wv * 128 + d) * 6144 + e];
    for (int half = 0; half < 2; ++half) {
        const int b0 = half * 16;
        for (int i = tid; i < 16384; i += 512) { const float cv = p.c[b0 * 1024 + i]; SC[i] = cv / (1.f + __expf(-cv)); }
        __syncthreads();
        float acc[16];
#pragma unroll
        for (int bb = 0; bb < 16; ++bb) acc[bb] = 0.f;
#pragma unroll
        for (int dd = 0; dd < 128; dd += 4) { const int d = wv * 128 + dd;
            const float w0 = wreg[dd], w1 = wreg[dd + 1], w2 = wreg[dd + 2], w3 = wreg[dd + 3];
#pragma unroll
            for (int bb = 0; bb < 16; ++bb) { const f32x4 s = *(const f32x4*)(SC + bb * 1024 + d); acc[bb] += (s.x * w0 + s.y * w1) + (s.z * w2 + s.w * w3); }
        }
#pragma unroll
        for (int bb = 0; bb < 16; ++bb) RED[(wv * 16 + bb) * 64 + lane] = acc[bb];
        __syncthreads();
#pragma unroll
        for (int q = 0; q < 2; ++q) { const int bb = wv * 2 + q; float s = p.b_ada[e];
#pragma unroll
            for (int ww = 0; ww < 8; ++ww) s += RED[(ww * 16 + bb) * 64 + lane];
            mod[(size_t)(b0 + bb) * 6144 + e] = s; }
        __syncthreads();
    }
}
__device__ __forceinline__ void phase_pro(const Params& p, unsigned char* lds, int tid, int G) {
    const int lane = tid & 63, wv = tid >> 6;
    for (int cb = blockIdx.x; cb < 96; cb += G) adaln_block(p, (float*)lds, cb, tid);
    __syncthreads();
    float* scr = (float*)lds + wv * (64 * 33 + 16);
    const int gw = blockIdx.x * NWAVES + wv, NGW = G * NWAVES;
    bf16* WIN = (bf16*)(p.ws + WS_WIN); bf16* WOUT = (bf16*)(p.ws + WS_WOUT); bf16* W1 = (bf16*)(p.ws + WS_W1); bf16* W2 = (bf16*)(p.ws + WS_W2);
    bf16* WUKT = (bf16*)(p.ws + WS_WUKT); bf16* WUK = (bf16*)(p.ws + WS_WUK); bf16* WUVT = (bf16*)(p.ws + WS_WUVT);
    constexpr int I_IN = (DM / 64) * (NPROJ / 32), I_OUT = (DM / 64) * (DM / 32), I_1 = (DM / 64) * (FF / 32), I_2 = (FF / 64) * (DM / 32), I_UK = (128 / 64) * (512 / 32);
    constexpr int I_LR = 512 / 32;
    constexpr int NITEMS = I_IN + I_OUT + I_1 + I_2 + 2 * I_UK + 4 * I_LR;
    for (int it = gw; it < NITEMS; it += NGW) {
        int r = it;
        if (r < I_IN) { if (MK_F8_GEMM1) conv_t_item_f8(p.w_in, DM, 3016, (unsigned char*)WIN, NPROJ / 32, r, scr, lane, 32.f, true); else conv_t_item(p.w_in, DM, 3016, WIN, NPROJ / 32, r, scr, lane, true); continue; } r -= I_IN;
        if (r < I_OUT) { conv_t_item(p.w_out, DM, DM, WOUT, DM / 32, r, scr, lane, false); continue; } r -= I_OUT;
        if (r < I_1) { conv_t_item(p.w_ff1, DM, FF, W1, FF / 32, r, scr, lane, false); continue; } r -= I_1;
        if (r < I_2) { conv_t_item_f8(p.w_ff2, FF, DM, (unsigned char*)W2, DM / 32, r, scr, lane, 64.f); continue; } r -= I_2;
        if (r < I_UK) { conv_t_item(p.w_uk, 128, 512, WUKT, 512 / 32, r, scr, lane, false); continue; } r -= I_UK;
        if (r < I_UK) { conv_t_item(p.w_uv, 128, 512, WUVT, 512 / 32, r, scr, lane, false); continue; } r -= I_UK;
        if (r < I_LR) { conv_t_item(p.w2, 64, 512, (bf16*)(p.ws + WS_W2T), 512 / 32, r, scr, lane, false); continue; } r -= I_LR;
        if (r < I_LR) { conv_t_item(p.a2, 64, 512, (bf16*)(p.ws + WS_A2T), 512 / 32, r, scr, lane, false); continue; } r -= I_LR;
        conv_t_item(p.g2, 128, 512, (bf16*)(p.ws + WS_G2T), 512 / 32, r, scr, lane, false);
    }
    { float* ROWSQ = (float*)(p.ws + WS_ROWSQ); for (int i = blockIdx.x * 512 + tid; i < M; i += G * 512) ROWSQ[i] = 0.f; }
    for (int i = blockIdx.x * 512 + tid; i < 128 * 512 / 2; i += G * 512) { const float a = p.w_uk[2 * i], b = p.w_uk[2 * i + 1]; ((unsigned*)WUK)[i] = pk2(a, b); }
}

template <bool F8OUT> __device__ __forceinline__ void hn_rows(const float* src, const float* g, const float* mod, int off_sh, int off_sc, bf16* dst, int gw, int NGW, int lane) {
    const int RPW = M / NGW;
    for (int m0 = gw * RPW; m0 < M; m0 += NGW * RPW) {
        const float* mb = mod + (size_t)(m0 >> 11) * 6144;
        f32x4 ga[4], sh[4];
#pragma unroll
        for (int j = 0; j < 4; ++j) { const int col = 4 * lane + 256 * j; const f32x4 gg = *(const f32x4*)(g + col), sc = *(const f32x4*)(mb + off_sc + col); ga[j] = gg * (1.f + sc); sh[j] = *(const f32x4*)(mb + off_sh + col); }
        for (int r0 = 0; r0 < RPW; r0 += 4) {
            f32x4 v[4][4]; float s[4];
#pragma unroll
            for (int r = 0; r < 4; ++r) { const f32x4* xr = (const f32x4*)(src + (size_t)(m0 + r0 + r) * DM) + lane;
#pragma unroll
                for (int j = 0; j < 4; ++j) v[r][j] = xr[64 * j]; }
#pragma unroll
            for (int r = 0; r < 4; ++r) { s[r] = 0.f;
#pragma unroll
                for (int j = 0; j < 4; ++j) s[r] += (v[r][j].x * v[r][j].x + v[r][j].y * v[r][j].y) + (v[r][j].z * v[r][j].z + v[r][j].w * v[r][j].w); }
#pragma unroll
            for (int o = 1; o < 64; o <<= 1) {
#pragma unroll
                for (int r = 0; r < 4; ++r) s[r] += __shfl_xor(s[r], o); }
#pragma unroll
            for (int r = 0; r < 4; ++r) { const int m = m0 + r0 + r; const float rstd = rsqrtf(s[r] * (1.f / DM) + 1e-6f);
                unsigned long long* o8 = (unsigned long long*)(dst + (size_t)m * DM) + lane;
#pragma unroll
                for (int j = 0; j < 4; ++j) { const f32x4 y = v[r][j] * rstd * ga[j] + sh[j];
                    if (F8OUT) ((unsigned*)((unsigned char*)dst + (size_t)m * DM))[lane + 64 * j] = pg8::pk4_fp8(y.x, y.y, y.z, y.w);
                    else o8[64 * j] = (unsigned long long)pk2(y.x, y.y) | ((unsigned long long)pk2(y.z, y.w) << 32); } }
        }
    }
}

typedef short s16x4 __attribute__((ext_vector_type(4)));
__device__ __forceinline__ f32x4 mfma16k(s16x4 a, s16x4 b, f32x4 c) { return __builtin_amdgcn_mfma_f32_16x16x16bf16_1k(a, b, c, 0, 0, 0); }
__device__ __forceinline__ s16x4 pack4(f32x4 v) { u32x2 o; o.x = pk2(v[0], v[1]); o.y = pk2(v[2], v[3]); return __builtin_bit_cast(s16x4, o); }

__device__ __forceinline__ float dpp_row_sum16(float x) {
    x += __builtin_bit_cast(float, __builtin_amdgcn_mov_dpp(__builtin_bit_cast(int, x), 0xB1, 0xF, 0xF, true));
    x += __builtin_bit_cast(float, __builtin_amdgcn_mov_dpp(__builtin_bit_cast(int, x), 0x4E, 0xF, 0xF, true));
    x += __builtin_bit_cast(float, __builtin_amdgcn_mov_dpp(__builtin_bit_cast(int, x), 0x141, 0xF, 0xF, true));
    x += __builtin_bit_cast(float, __builtin_amdgcn_mov_dpp(__builtin_bit_cast(int, x), 0x140, 0xF, 0xF, true));
    return x;
}
__device__ __forceinline__ void rwkv_prep_item(const Params& p, unsigned char* lds, int it, int tid_in) {
    int tid = tid_in; asm volatile("" : "+v"(tid));
    const int lane = tid & 63, wv = __builtin_amdgcn_readfirstlane(tid >> 6);
    bf16* XS = (bf16*)lds;
    bf16* STG = (bf16*)(lds + 33792) + wv * 4096;
    float* MAB = (float*)(lds + 99328) + wv * 256;
    bf16* RKV = (bf16*)(lds + 107520) + wv * 3468;
    const bf16* PROJ = (const bf16*)(p.ws + WS_PROJ);
    const bf16* W2T = (const bf16*)(p.ws + WS_W2T); const bf16* A2T = (const bf16*)(p.ws + WS_A2T); const bf16* G2T = (const bf16*)(p.ws + WS_G2T);
    float* GAM = (float*)(p.ws + WS_GAM); float* C3 = (float*)(p.ws + WS_C3); bf16* GB = (bf16*)(p.ws + WS_G);
    const int row0 = it * 64, t0 = (it & 31) * 64, b = it >> 5;
    __syncthreads();
    {   const int xt = tid >> 5, xch = tid & 31;
        const f32x4 m0_ = *(const f32x4*)(p.mu + 1536 + 8 * xch), m1_ = *(const f32x4*)(p.mu + 1536 + 8 * xch + 4); const float sc_ = xch < 8 ? 2.f : -1.f;
        u32x4 xc[4], xp[4];
#pragma unroll
        for (int qq = 0; qq < 4; ++qq) { const int t = xt + 16 * qq; const bf16* src_ = PROJ + (size_t)(row0 + t) * NPROJ + PC_XW + 8 * xch; xc[qq] = *(const u32x4*)src_;
            xp[qq] = (u32x4){0u, 0u, 0u, 0u}; if (t0 + t != 0) xp[qq] = *(const u32x4*)(src_ - NPROJ); }
#pragma unroll
        for (int qq = 0; qq < 4; ++qq) { float o_[8];
#pragma unroll
            for (int i = 0; i < 4; ++i) { const float c0_ = bflo(xc[qq][i]), c1_ = bfhi(xc[qq][i]), p0_ = bflo(xp[qq][i]), p1_ = bfhi(xp[qq][i]);
                const float ma_ = i < 2 ? m0_[2 * i] : m1_[2 * i - 4], mb_ = i < 2 ? m0_[2 * i + 1] : m1_[2 * i - 3];
                const float v0_ = c0_ + ma_ * (p0_ - c0_), v1_ = c1_ + mb_ * (p1_ - c1_);
                const float r0_ = 1.f / (1.f + __expf(sc_ * v0_)), r1_ = 1.f / (1.f + __expf(sc_ * v1_));
                o_[2 * i] = xch < 8 ? 1.f - 2.f * r0_ : (xch < 16 ? v0_ : r0_); o_[2 * i + 1] = xch < 8 ? 1.f - 2.f * r1_ : (xch < 16 ? v1_ : r1_); }
            *(u32x4*)(XS + (xt + 16 * qq) * 264 + 8 * xch) = (u32x4){pk2(o_[0], o_[1]), pk2(o_[2], o_[3]), pk2(o_[4], o_[5]), pk2(o_[6], o_[7])}; }
    }
    u32x4 RK[7];
#define RKV_LOAD(rowb, tb) do { _Pragma("unroll") for (int i = 0; i < 7; ++i) { const int id_ = i * 64 + lane, mat_ = id_ / 136, rem_ = id_ - 136 * mat_, rw_ = rem_ >> 3, ch_ = rem_ & 7; \
        RK[i] = (u32x4){0u, 0u, 0u, 0u}; if (id_ < 408 && (tb) - 1 + rw_ >= 0) RK[i] = *(const u32x4*)(PROJ + (size_t)((rowb) - 1 + rw_) * NPROJ + PC_R + 512 * mat_ + wv * 64 + 8 * ch_); } } while (0)
#define RKV_WRITE() do { _Pragma("unroll") for (int i = 0; i < 7; ++i) { const int id_ = i * 64 + lane, mat_ = id_ / 136, rem_ = id_ - 136 * mat_, rw_ = rem_ >> 3, ch_ = rem_ & 7; \
        if (id_ < 408) { bf16* d_ = RKV + mat_ * 1156 + rw_ * 68 + 8 * ch_; *(u32x2*)d_ = (u32x2){RK[i].x, RK[i].y}; *(u32x2*)(d_ + 4) = (u32x2){RK[i].z, RK[i].w}; } } } while (0)
    RKV_LOAD(row0, t0);
    __syncthreads();
#pragma unroll 1
    for (int q = 0; q < 4; ++q) {
        const int rowq = row0 + 16 * q, tq = t0 + 16 * q;
        int lane_ = lane; asm volatile("" : "+v"(lane_));
        const int n_ = lane_ & 15, grp_ = lane_ >> 4;
        const size_t idx = (size_t)(b * 8 + wv) * 128 + (tq >> 4);
        unsigned char* CHp = p.ws + WS_CH + idx * 12288;
        RKV_WRITE();
        if (q < 3) RKV_LOAD(rowq + 16, tq + 16);
        f32x4 dw[4], da[4];
        {   bf16x8 xa[8];
#pragma unroll
            for (int ks = 0; ks < 8; ++ks) xa[ks] = *(const bf16x8*)(XS + (16 * q + n_) * 264 + 32 * ks + 8 * grp_);
            bf16x8 wf[2][8];
#define LORA_LOADW(dst_, ct_) do { const int cc_ = wv * 64 + 16 * (ct_) + n_; \
                _Pragma("unroll") for (int ks = 0; ks < 2; ++ks) { dst_[ks] = *(const bf16x8*)(W2T + cc_ * 64 + 32 * ks + 8 * grp_); dst_[2 + ks] = *(const bf16x8*)(A2T + cc_ * 64 + 32 * ks + 8 * grp_); } \
                _Pragma("unroll") for (int ks = 0; ks < 4; ++ks) dst_[4 + ks] = *(const bf16x8*)(G2T + cc_ * 128 + 32 * ks + 8 * grp_); } while (0)
            LORA_LOADW(wf[0], 0);
#pragma unroll
            for (int ct = 0; ct < 4; ++ct) { const int cc = wv * 64 + 16 * ct + n_;
                if (ct < 3) LORA_LOADW(wf[(ct + 1) & 1], ct + 1);
                f32x4 dg = {0.f, 0.f, 0.f, 0.f}; dw[ct] = dg; da[ct] = dg;
#pragma unroll
                for (int ks = 0; ks < 2; ++ks) dw[ct] = mfma16(xa[ks], wf[ct & 1][ks], dw[ct]);
#pragma unroll
                for (int ks = 0; ks < 2; ++ks) da[ct] = mfma16(xa[2 + ks], wf[ct & 1][2 + ks], da[ct]);
#pragma unroll
                for (int ks = 0; ks < 4; ++ks) dg = mfma16(xa[4 + ks], wf[ct & 1][4 + ks], dg);
#pragma unroll
                for (int rg = 0; rg < 4; ++rg) GB[(size_t)(rowq + 4 * grp_ + rg) * 512 + cc] = f2bf(dg[rg]); }
#undef LORA_LOADW
        }
        asm volatile("s_waitcnt lgkmcnt(0)" ::: "memory");
        {   float kkvA[4][4], kkaA[4][4], kprA[4][4], rA[4][4], vA[4][4], wA[4][4], nrm[4], c3s[4];
#pragma unroll
            for (int rg = 0; rg < 4; ++rg) { nrm[rg] = 0.f; c3s[rg] = 0.f; }
#pragma unroll
            for (int ct = 0; ct < 4; ++ct) { const int j = 16 * ct + n_, c = wv * 64 + j;
                const float mu_r = p.mu[c], mu_k = p.mu[512 + c], mu_v = p.mu[1024 + c], w0c = p.w0[c], a0c = p.a0[c], kkc = p.k_k[c], kac = p.k_a[c], rkc = p.r_k[c];
#pragma unroll
                for (int rg = 0; rg < 4; ++rg) { const int t = 4 * grp_ + rg;
                    const float rp = bf2f(RKV[t * 68 + j]), rc = bf2f(RKV[(t + 1) * 68 + j]);
                    const float kp = bf2f(RKV[1156 + t * 68 + j]), kc = bf2f(RKV[1156 + (t + 1) * 68 + j]);
                    const float vp = bf2f(RKV[2312 + t * 68 + j]), vc = bf2f(RKV[2312 + (t + 1) * 68 + j]);
                    const float r = rc + mu_r * (rp - rc), k = kc + mu_k * (kp - kc); vA[ct][rg] = vc + mu_v * (vp - vc); rA[ct][rg] = r;
                    const float u = w0c + dw[ct][rg]; const float wlog = -__logf(1.f + __expf(-u)) - 0.5f; wA[ct][rg] = __expf(-__expf(wlog));
                    const float a = 1.f / (1.f + __expf(-(a0c + da[ct][rg])));
                    const float kkv = k * kkc, kpr = k * (1.f + (a - 1.f) * kac); kkvA[ct][rg] = kkv; kkaA[ct][rg] = kkv * a; kprA[ct][rg] = kpr;
                    nrm[rg] += kkv * kkv; c3s[rg] += r * kpr * rkc; } }
            float inrm[4];
#pragma unroll
            for (int rg = 0; rg < 4; ++rg) { nrm[rg] = dpp_row_sum16(nrm[rg]); c3s[rg] = dpp_row_sum16(c3s[rg]); inrm[rg] = 1.f / fmaxf(sqrtf(nrm[rg]), 1e-12f); }
            if (n_ == 0) {
#pragma unroll
                for (int rg = 0; rg < 4; ++rg) C3[(size_t)(rowq + 4 * grp_ + rg) * 8 + wv] = c3s[rg]; }
#pragma unroll
            for (int ct = 0; ct < 4; ++ct) { const int j = 16 * ct + n_;
                float lp[4]; lp[0] = wA[ct][0]; lp[1] = lp[0] * wA[ct][1]; lp[2] = lp[1] * wA[ct][2]; lp[3] = lp[2] * wA[ct][3];
                const float P0 = __shfl(lp[3], n_), P1 = __shfl(lp[3], n_ + 16), P2 = __shfl(lp[3], n_ + 32);
                const float E = grp_ == 0 ? 1.f : (grp_ == 1 ? P0 : (grp_ == 2 ? P0 * P1 : P0 * P1 * P2));
                float bt[4], kt[4];
#pragma unroll
                for (int rg = 0; rg < 4; ++rg) { const int t = 4 * grp_ + rg;
                    const float gam = E * lp[rg], gprev = rg == 0 ? E : E * lp[rg - 1], ig = 1.f / gam;
                    const int so = t * 64 + (j ^ (((t >> 1) & 7) << 3));
                    STG[so] = f2bf(-kkvA[ct][rg] * inrm[rg] * gprev); STG[1024 + so] = f2bf(rA[ct][rg] * gam);
                    bt[rg] = kkaA[ct][rg] * inrm[rg] * ig; kt[rg] = kprA[ct][rg] * ig;
                    STG[2048 + so] = f2bf(bt[rg]); STG[3072 + so] = f2bf(kt[rg]); }
                *(u32x2*)(CHp + 4096 + j * 32 + grp_ * 8) = (u32x2){pk2(bt[0], bt[1]), pk2(bt[2], bt[3])};
                *(u32x2*)(CHp + 6144 + j * 32 + grp_ * 8) = (u32x2){pk2(kt[0], kt[1]), pk2(kt[2], kt[3])};
                *(u32x2*)(CHp + 8192 + j * 32 + grp_ * 8) = (u32x2){pk2(vA[ct][0], vA[ct][1]), pk2(vA[ct][2], vA[ct][3])};
                if (grp_ == 3) GAM[idx * 64 + j] = E * lp[3]; }
        }
        asm volatile("s_waitcnt lgkmcnt(0)" ::: "memory");
        {   f32x4 mab = {0.f, 0.f, 0.f, 0.f}, mak = mab, nrb = mab, nrk = mab;
#pragma unroll
            for (int ks = 0; ks < 4; ++ks) { const int o = n_ * 64 + ((16 * ks + 4 * grp_) ^ (((n_ >> 1) & 7) << 3));
                const s16x4 fa = *(const s16x4*)(STG + o), fr = *(const s16x4*)(STG + 1024 + o), fb = *(const s16x4*)(STG + 2048 + o), fk = *(const s16x4*)(STG + 3072 + o);
                mab = mfma16k(fa, fb, mab); mak = mfma16k(fa, fk, mak); nrb = mfma16k(fr, fb, nrb); nrk = mfma16k(fr, fk, nrk); }
            asm volatile("s_waitcnt lgkmcnt(0)" ::: "memory");
            bf16* SM = STG + 2048;
#pragma unroll
            for (int rg = 0; rg < 4; ++rg) { const int t = 4 * grp_ + rg; const bool sl = t > n_, il = t >= n_;
                MAB[t * 16 + n_] = sl ? mab[rg] : 0.f;
                SM[256 + t * 16 + n_] = f2bf(sl ? mak[rg] : 0.f); SM[512 + t * 16 + n_] = f2bf(il ? nrb[rg] : 0.f); SM[768 + t * 16 + n_] = f2bf(il ? nrk[rg] : 0.f); }
            asm volatile("s_waitcnt lgkmcnt(0)" ::: "memory");
            if (lane_ < 16) {
                float Tc[16];
#pragma unroll
                for (int t = 0; t < 16; ++t) { float acc = (t == lane_) ? 1.f : 0.f;
#pragma unroll
                    for (int s2 = 0; s2 < t; ++s2) acc = fmaf(MAB[t * 16 + s2], Tc[s2], acc);
                    Tc[t] = acc; SM[t * 16 + lane_] = f2bf(acc); }
            }
            asm volatile("s_waitcnt lgkmcnt(0)" ::: "memory");
#pragma unroll
            for (int i = 0; i < 4; ++i) { const int id = i * 64 + lane_, rw = id >> 3, c16 = id & 7; *(u32x4*)(CHp + id * 16) = *(const u32x4*)((const unsigned char*)STG + rw * 128 + ((c16 ^ ((rw >> 1) & 7)) << 4)); }
#pragma unroll
            for (int i = 0; i < 2; ++i) { const int id = i * 64 + lane_; *(u32x4*)(CHp + 10240 + id * 16) = *(const u32x4*)((const unsigned char*)SM + id * 16); }
        }
    }
#undef RKV_LOAD
#undef RKV_WRITE
}

__device__ __forceinline__ void stage_w_lds(const bf16* W, unsigned char* lds, int log2_cpr  , int tid) {
    const int cpr = 1 << log2_cpr;
#pragma unroll 4
    for (int i = 0; i < 16; ++i) { const int id = i * 512 + tid, row = id >> log2_cpr, ch = id & (cpr - 1);
        *(u32x4*)(lds + ((size_t)row << (log2_cpr + 4)) + (((ch & ~15) | ((ch ^ row) & 15)) << 4)) = *(const u32x4*)((const unsigned char*)W + (size_t)id * 16); }
}
__device__ __forceinline__ bf16x8 lds_wfrag(const unsigned char* lds, int row, int ch, int log2_cpr) {
    return *(const bf16x8*)(lds + ((size_t)row << (log2_cpr + 4)) + (((ch & ~15) | ((ch ^ row) & 15)) << 4));
}
__device__ __forceinline__ void dsa_prep_kv(const Params& p, const unsigned char* wl, int tile, int lane) {
    const bf16* PROJ = (const bf16*)(p.ws + WS_PROJ); bf16* CKV = (bf16*)(p.ws + WS_CKV); float* INVR = (float*)(p.ws + WS_INVR);
    const int r = lane & 31, hh = lane >> 5; const size_t row = (size_t)tile * 32 + r; const bf16* prow = PROJ + row * NPROJ;
    bf16x8 cf[8];
    {   u32x4 craw[8]; float ssq = 0.f;
#pragma unroll
        for (int s = 0; s < 8; ++s) { craw[s] = *(const u32x4*)(prow + PC_CL + 16 * s + 8 * hh);
#pragma unroll
            for (int w = 0; w < 4; ++w) { const float lo = bflo(craw[s][w]), hi = bfhi(craw[s][w]); ssq += lo * lo + hi * hi; } }
        ssq += __shfl_xor(ssq, 32);
        const float rstd = rsqrtf(ssq * (1.f / 128.f) + 1e-6f);
#pragma unroll
        for (int s = 0; s < 8; ++s) { const float* g = p.g_kv + 16 * s + 8 * hh; const f32x4 g0 = *(const f32x4*)g, g1 = *(const f32x4*)(g + 4);
            u32x4 o; o.x = pk2(bflo(craw[s].x) * rstd * g0.x, bfhi(craw[s].x) * rstd * g0.y); o.y = pk2(bflo(craw[s].y) * rstd * g0.z, bfhi(craw[s].y) * rstd * g0.w);
            o.z = pk2(bflo(craw[s].z) * rstd * g1.x, bfhi(craw[s].z) * rstd * g1.y); o.w = pk2(bflo(craw[s].w) * rstd * g1.z, bfhi(craw[s].w) * rstd * g1.w);
            cf[s] = __builtin_bit_cast(bf16x8, o); *(u32x4*)(CKV + row * 128 + 16 * s + 8 * hh) = o; }
    }
    unsigned wb[8];
#pragma unroll
    for (int s = 0; s < 8; ++s) wb[s] = (unsigned)(r * 256 + ((((2 * s + hh) ^ r) & 15) << 4));
#pragma unroll 1
    for (int h = 0; h < 8; ++h) { float ss = 0.f;
#pragma unroll
        for (int dt = 0; dt < 2; ++dt) { f32x16 acc = {}; const unsigned char* wg = wl + (h * 64 + dt * 32) * 256;
#pragma unroll
            for (int s = 0; s < 8; ++s) acc = mfma32(*(const bf16x8*)(wg + wb[s]), cf[s], acc);
#pragma unroll
            for (int i = 0; i < 16; ++i) ss += acc[i] * acc[i]; }
        ss += __shfl_xor(ss, 32);
        if (hh == 0) INVR[row * 8 + h] = rsqrtf(ss * (1.f / 64.f) + 1e-6f);
    }
}
__device__ __forceinline__ void dsa_prep_q(const Params& p, const unsigned char* wl, int tile, int lane) {
    const bf16* PROJ = (const bf16*)(p.ws + WS_PROJ); bf16* QABS = (bf16*)(p.ws + WS_REGA);
    const int r = lane & 31, hh = lane >> 5; const size_t row = (size_t)tile * 32 + r; const bf16* prow = PROJ + row * NPROJ;
    unsigned wb[2][4];
#pragma unroll
    for (int hp = 0; hp < 2; ++hp)
#pragma unroll
        for (int s = 0; s < 4; ++s) wb[hp][s] = (unsigned)(r * 1024 + ((((hp * 8 + 2 * s + hh) ^ r) & 15) << 4));
#pragma unroll 2
    for (int h = 0; h < 8; ++h) {
        u32x4 qraw[4]; float ssq = 0.f;
#pragma unroll
        for (int s = 0; s < 4; ++s) { qraw[s] = *(const u32x4*)(prow + PC_Q + h * 64 + 16 * s + 8 * hh);
#pragma unroll
            for (int w = 0; w < 4; ++w) { const float lo = bflo(qraw[s][w]), hi = bfhi(qraw[s][w]); ssq += lo * lo + hi * hi; } }
        ssq += __shfl_xor(ssq, 32);
        const float rstd = rsqrtf(ssq * (1.f / 64.f) + 1e-6f);
        bf16x8 qf[4];
#pragma unroll
        for (int s = 0; s < 4; ++s) { const int d0 = 16 * s + 8 * hh; float gg[8];
#pragma unroll
            for (int j = 0; j < 8; ++j) gg[j] = p.g_q[d0 + j] * p.g_k[d0 + j] * rstd;
            u32x4 o; o.x = pk2(bflo(qraw[s].x) * gg[0], bfhi(qraw[s].x) * gg[1]); o.y = pk2(bflo(qraw[s].y) * gg[2], bfhi(qraw[s].y) * gg[3]);
            o.z = pk2(bflo(qraw[s].z) * gg[4], bfhi(qraw[s].z) * gg[5]); o.w = pk2(bflo(qraw[s].w) * gg[6], bfhi(qraw[s].w) * gg[7]);
            qf[s] = __builtin_bit_cast(bf16x8, o); }
#pragma unroll
        for (int lt = 0; lt < 4; ++lt) { f32x16 acc = {}; const unsigned char* wg = wl + lt * 32768 + (h >> 1) * 256;
#pragma unroll
            for (int s = 0; s < 4; ++s) acc = mfma32(*(const bf16x8*)(wg + wb[h & 1][s]), qf[s], acc);
#pragma unroll
            for (int g4 = 0; g4 < 4; ++g4) { u32x2 o; o.x = pk2(acc[4 * g4] * 0.125f, acc[4 * g4 + 1] * 0.125f); o.y = pk2(acc[4 * g4 + 2] * 0.125f, acc[4 * g4 + 3] * 0.125f);
                *(u32x2*)(QABS + row * 1024 + h * 128 + lt * 32 + 8 * g4 + 4 * hh) = o; } }
    }
}

constexpr int SCAN_D = 8, SCAN_SLOT = 12288 + 256;
#define SCAN_BAR() do { asm volatile("s_waitcnt lgkmcnt(0)" ::: "memory"); __builtin_amdgcn_s_barrier(); asm volatile("" ::: "memory"); } while (0)
__device__ __forceinline__ void rwkv_scan_chain(const Params& p, unsigned char* lds, int chain, int wv, int lane) {
    const int b = chain >> 3, h = chain & 7;
    const size_t idx0 = (size_t)(b * 8 + h) * 128;
    if (wv >= 4) {
        const int li = (wv - 4) * 64 + lane;
        const unsigned char* src = p.ws + WS_CH + idx0 * 12288 + (size_t)li * 16; const float* gsrc = (const float*)(p.ws + WS_GAM) + idx0 * 64 + (li & 15) * 4;
        const int d0 = (li >> 3) * 128 + ((((li & 7) ^ ((li >> 4) & 7))) << 4);
        u32x4 R[SCAN_D][3]; f32x4 Rg[SCAN_D];
#pragma unroll
        for (int j = 0; j < SCAN_D; ++j) {
#pragma unroll
            for (int i = 0; i < 3; ++i) R[j][i] = *(const u32x4*)(src + (size_t)j * 12288 + i * 4096);
            Rg[j] = *(const f32x4*)(gsrc + (size_t)j * 64); }
        for (int k0 = 0; k0 < 128; k0 += SCAN_D) {
#pragma unroll
            for (int j = 0; j < SCAN_D; ++j) { const int k = k0 + j; unsigned char* slot = lds + (k & 1) * SCAN_SLOT;
                *(u32x4*)(slot + d0) = R[j][0];
#pragma unroll
                for (int i = 1; i < 3; ++i) *(u32x4*)(slot + li * 16 + i * 4096) = R[j][i];
                *(f32x4*)(slot + 12288 + (li & 15) * 16) = Rg[j];
                if (k + SCAN_D < 128) {
#pragma unroll
                    for (int i = 0; i < 3; ++i) R[j][i] = *(const u32x4*)(src + (size_t)(k + SCAN_D) * 12288 + i * 4096);
                    Rg[j] = *(const f32x4*)(gsrc + (size_t)(k + SCAN_D) * 64); }
                SCAN_BAR(); } }
        SCAN_BAR();
    } else {
        const int w = wv, n = lane & 15, grp = lane >> 4;
        bf16* PROJ = (bf16*)(p.ws + WS_PROJ);
        f32x4 S[4];
#pragma unroll
        for (int jt = 0; jt < 4; ++jt) S[jt] = (f32x4){0.f, 0.f, 0.f, 0.f};
        int aoffs[4];
#pragma unroll
        for (int jt = 0; jt < 4; ++jt) aoffs[jt] = n * 128 + ((((2 * jt + (grp >> 1)) ^ ((n >> 1) & 7))) << 4) + 8 * (grp & 1);
        s16x4 at[4], rt[4], bt[4], kt[4], vt, Tm, Mak, Nrb, Nrk; f32x4 gm[4];
#define SCAN_LDF(slot_) do { const unsigned char* CHp = lds + (slot_) * SCAN_SLOT; \
        _Pragma("unroll") for (int jt = 0; jt < 4; ++jt) { at[jt] = *(const s16x4*)(CHp + aoffs[jt]); rt[jt] = *(const s16x4*)(CHp + 2048 + aoffs[jt]); \
            bt[jt] = *(const s16x4*)(CHp + 4096 + (16 * jt + n) * 32 + grp * 8); kt[jt] = *(const s16x4*)(CHp + 6144 + (16 * jt + n) * 32 + grp * 8); \
            gm[jt] = *(const f32x4*)(CHp + 12288 + (16 * jt + 4 * grp) * 4); } \
        vt = *(const s16x4*)(CHp + 8192 + (16 * w + n) * 32 + grp * 8); Tm = *(const s16x4*)(CHp + 10240 + n * 32 + grp * 8); Mak = *(const s16x4*)(CHp + 10752 + n * 32 + grp * 8); \
        Nrb = *(const s16x4*)(CHp + 11264 + n * 32 + grp * 8); Nrk = *(const s16x4*)(CHp + 11776 + n * 32 + grp * 8); } while (0)
        SCAN_BAR();
        SCAN_LDF(0);
        for (int sc = 0; sc < 128; ++sc) {
            s16x4 at_[4], rt_[4], bt_[4], kt_[4]; f32x4 gm_[4];
#pragma unroll
            for (int jt = 0; jt < 4; ++jt) { at_[jt] = at[jt]; rt_[jt] = rt[jt]; bt_[jt] = bt[jt]; kt_[jt] = kt[jt]; gm_[jt] = gm[jt]; }
            const s16x4 vt_ = vt, Tm_ = Tm, Mak_ = Mak, Nrb_ = Nrb, Nrk_ = Nrk;
            SCAN_BAR();
            if (sc + 1 < 128) SCAN_LDF((sc + 1) & 1);
            s16x4 Sb[4];
#pragma unroll
            for (int jt = 0; jt < 4; ++jt) Sb[jt] = pack4(S[jt]);
            f32x4 X = {0.f, 0.f, 0.f, 0.f}, O = X;
#pragma unroll
            for (int jt = 0; jt < 4; ++jt) X = mfma16k(at_[jt], Sb[jt], X);
            X = mfma16k(Mak_, vt_, X);
#pragma unroll
            for (int jt = 0; jt < 4; ++jt) O = mfma16k(rt_[jt], Sb[jt], O);
            O = mfma16k(Nrk_, vt_, O);
            const f32x4 U = mfma16k(Tm_, pack4(X), (f32x4){0.f, 0.f, 0.f, 0.f});
            const s16x4 Ub = pack4(U);
            O = mfma16k(Nrb_, Ub, O);
#pragma unroll
            for (int jt = 0; jt < 4; ++jt) { S[jt] = mfma16k(kt_[jt], vt_, S[jt]); S[jt] = mfma16k(bt_[jt], Ub, S[jt]); S[jt] = S[jt] * gm_[jt]; }
            bf16* orow = PROJ + ((size_t)b * SEQ + sc * 16 + 4 * grp) * NPROJ + PC_R + h * 64 + 16 * w + n;
#pragma unroll
            for (int rg = 0; rg < 4; ++rg) orow[(size_t)rg * NPROJ] = f2bf(O[rg]);
        }
#undef SCAN_LDF
    }
}
__device__ __forceinline__ void rwkv_epi_rows(const Params& p, int gw, int NGW, int lane) {
    bf16* PROJ = (bf16*)(p.ws + WS_PROJ); const bf16* GB = (const bf16*)(p.ws + WS_G); const float* C3 = (const float*)(p.ws + WS_C3);
    const int c0 = lane * 8, h = lane >> 3, RPW = M / NGW;
    float muv[8], lw[8], lb[8];
#pragma unroll
    for (int i = 0; i < 8; ++i) { muv[i] = p.mu[1024 + c0 + i]; lw[i] = p.ln_w[c0 + i]; lb[i] = p.ln_b[c0 + i]; }
    for (int m0 = gw * RPW; m0 < M; m0 += NGW * RPW) {
        u32x4 vprev = {0u, 0u, 0u, 0u}; if ((m0 & (SEQ - 1)) != 0) vprev = *(const u32x4*)(PROJ + (size_t)(m0 - 1) * NPROJ + PC_V + c0);
        for (int r0 = 0; r0 < RPW; r0 += 4) {
            u32x4 oraw[4], vc[4], gr[4]; float c3[4];
#pragma unroll
            for (int r = 0; r < 4; ++r) { const size_t m = (size_t)(m0 + r0 + r); const bf16* prow = PROJ + m * NPROJ;
                oraw[r] = *(const u32x4*)(prow + PC_R + c0); vc[r] = *(const u32x4*)(prow + PC_V + c0); gr[r] = *(const u32x4*)(GB + m * 512 + c0); c3[r] = C3[m * 8 + h]; }
            float o[4][8], sm[4], q[4];
#pragma unroll
            for (int r = 0; r < 4; ++r) { sm[r] = 0.f;
#pragma unroll
                for (int i = 0; i < 4; ++i) { o[r][2 * i] = bflo(oraw[r][i]); o[r][2 * i + 1] = bfhi(oraw[r][i]); sm[r] += o[r][2 * i] + o[r][2 * i + 1]; } }
#pragma unroll
            for (int of = 1; of < 8; of <<= 1) {
#pragma unroll
                for (int r = 0; r < 4; ++r) sm[r] += __shfl_xor(sm[r], of); }
#pragma unroll
            for (int r = 0; r < 4; ++r) { const float mean = sm[r] * (1.f / 64.f); q[r] = 0.f;
#pragma unroll
                for (int i = 0; i < 8; ++i) { o[r][i] -= mean; q[r] += o[r][i] * o[r][i]; } }
#pragma unroll
            for (int of = 1; of < 8; of <<= 1) {
#pragma unroll
                for (int r = 0; r < 4; ++r) q[r] += __shfl_xor(q[r], of); }
#pragma unroll
            for (int r = 0; r < 4; ++r) { const float rstd = rsqrtf(q[r] * (1.f / 64.f) + 64e-5f); const u32x4 vp = r == 0 ? vprev : vc[r - 1];
                const bool first = ((m0 + r0 + r) & (SEQ - 1)) == 0;
                u32x4 out;
#pragma unroll
                for (int i = 0; i < 4; ++i) { float y[2];
#pragma unroll
                    for (int e = 0; e < 2; ++e) { const int ii = 2 * i + e; const float cv = e ? bfhi(vc[r][i]) : bflo(vc[r][i]), pv = first ? 0.f : (e ? bfhi(vp[i]) : bflo(vp[i]));
                        const float v = cv + muv[ii] * (pv - cv), g = e ? bfhi(gr[r][i]) : bflo(gr[r][i]);
                        y[e] = (o[r][ii] * rstd * lw[ii] + lb[ii] + c3[r] * v) * g; }
                    out[i] = pk2(y[0], y[1]); }
                *(u32x4*)(PROJ + (size_t)(m0 + r0 + r) * NPROJ + PC_R + c0) = out; }
            vprev = vc[3];
        }
    }
}

__device__ __forceinline__ unsigned f2key(float f) { unsigned b = __float_as_uint(f); if ((b << 1) == 0u) b = 0u; return (b & 0x80000000u) ? ~b : (b | 0x80000000u); }
__device__ __forceinline__ unsigned offb(unsigned row, unsigned ch) { return 2048u * (row >> 3) + 512u * (ch >> 2) + 64u * (row & 7) + 16u * ((ch & 3) ^ ((row >> 2) & 3)); }

__device__ __forceinline__ void topk_select(float* sc, int N, unsigned* hist, unsigned short* sel, int lane) {
    unsigned* kb = (unsigned*)sc;
    unsigned prefix = 0u, mask = 0u; int rem = 256, mbin = 0;
    const unsigned long long lt_mask = (1ull << lane) - 1ull;
    for (int pass = 0; pass < 4; ++pass) {
        const int shift = 24 - 8 * pass;
#pragma unroll
        for (int i = 0; i < 4; ++i) hist[lane * 4 + i] = 0u;
        asm volatile("s_waitcnt lgkmcnt(0)" ::: "memory");
        for (int base = 0; base < N; base += 256) { const int idx = base + 4 * lane;
            if (idx < N) { u32x4 k4;
                if (pass == 0) { const f32x4 v = *(const f32x4*)(sc + idx); k4 = (u32x4){f2key(v.x), f2key(v.y), f2key(v.z), f2key(v.w)}; *(u32x4*)(kb + idx) = k4; }
                else k4 = *(const u32x4*)(kb + idx);
#pragma unroll
                for (int e = 0; e < 4; ++e) if ((k4[e] & mask) == prefix) atomicAdd(&hist[(k4[e] >> shift) & 255u], 1u); } }
        asm volatile("s_waitcnt lgkmcnt(0)" ::: "memory");
        const unsigned c0 = hist[lane * 4], c1 = hist[lane * 4 + 1], c2 = hist[lane * 4 + 2], c3 = hist[lane * 4 + 3];
        const int cnt4 = (int)(c0 + c1 + c2 + c3);
        int incl = cnt4;
#pragma unroll
        for (int o = 1; o < 64; o <<= 1) { const int v = __shfl_down(incl, o); if (lane + o < 64) incl += v; }
        const int excl = incl - cnt4;
        const bool mine = (excl < rem) && (rem <= incl);
        const unsigned long long bal = __ballot(mine);
        const int L = (int)__builtin_ctzll(bal);
        const int ex = __shfl(excl, L); const int b3 = (int)__shfl((int)c3, L), b2 = (int)__shfl((int)c2, L), b1 = (int)__shfl((int)c1, L), b0 = (int)__shfl((int)c0, L);
        int above = ex, bin;
        if (above + b3 >= rem) { bin = 3; mbin = b3; } else { above += b3; if (above + b2 >= rem) { bin = 2; mbin = b2; } else { above += b2; if (above + b1 >= rem) { bin = 1; mbin = b1; } else { above += b1; bin = 0; mbin = b0; } } }
        rem -= above; prefix |= (unsigned)(L * 4 + bin) << shift; mask |= 0xffu << shift;
        if (pass == 1 && mbin <= 64) break;
    }
    const unsigned T = prefix; const int ngt = 256 - rem; int base_gt = 0, base_eq = 0;
    const bool partial = (mask != 0xffffffffu);
    unsigned short* cand = (unsigned short*)hist;
    for (int base = 0; base < N; base += 256) { const int idx = base + 4 * lane; const bool act = idx < N;
        u32x4 k4 = {0u, 0u, 0u, 0u}; if (act) k4 = *(const u32x4*)(kb + idx);
        bool gt[4], eq[4]; unsigned long long bg[4], be[4];
#pragma unroll
        for (int e = 0; e < 4; ++e) { const unsigned km = k4[e] & mask; gt[e] = act && km > T; eq[e] = act && km == T; bg[e] = __ballot(gt[e]); be[e] = __ballot(eq[e]); }
        int rg = base_gt, re = base_eq;
#pragma unroll
        for (int e = 0; e < 4; ++e) re += __popcll(be[e] & lt_mask);
#pragma unroll
        for (int e = 0; e < 4; ++e) {
            if (gt[e]) sel[rg + __popcll(bg[e] & lt_mask)] = (unsigned short)(idx + e);
            rg += __popcll(bg[e]);
            if (eq[e]) { if (partial) cand[re] = (unsigned short)(idx + e); else if (re < rem) sel[ngt + re] = (unsigned short)(idx + e); re += 1; } }
        base_gt = rg;
#pragma unroll
        for (int e = 0; e < 4; ++e) base_eq += __popcll(be[e]); }
    asm volatile("s_waitcnt lgkmcnt(0)" ::: "memory");
    if (partial) {
        const int m = mbin; const int ci = (lane < m) ? (int)cand[lane] : 0; const unsigned ck = (lane < m) ? kb[ci] : 0u;
        int rank = 0;
        for (int j = 0; j < m; ++j) { const unsigned kj = (unsigned)__shfl((int)ck, j); rank += (kj > ck || (kj == ck && j < lane)) ? 1 : 0; }
        if (lane < m && rank < rem) sel[ngt + rank] = (unsigned short)ci;
        asm volatile("s_waitcnt lgkmcnt(0)" ::: "memory");
    }
}

__device__ __forceinline__ float dpp_row_max16(float x) {
    x = fmaxf(x, __builtin_bit_cast(float, __builtin_amdgcn_mov_dpp(__builtin_bit_cast(int, x), 0xB1, 0xF, 0xF, true)));
    x = fmaxf(x, __builtin_bit_cast(float, __builtin_amdgcn_mov_dpp(__builtin_bit_cast(int, x), 0x4E, 0xF, 0xF, true)));
    x = fmaxf(x, __builtin_bit_cast(float, __builtin_amdgcn_mov_dpp(__builtin_bit_cast(int, x), 0x141, 0xF, 0xF, true)));
    x = fmaxf(x, __builtin_bit_cast(float, __builtin_amdgcn_mov_dpp(__builtin_bit_cast(int, x), 0x140, 0xF, 0xF, true)));
    return x;
}
__device__ __forceinline__ bool topk_select_fast(const float* sc, int N, float smax, unsigned* hist, unsigned short* sel, int lane) {
    const float scale = smax > 0.f ? 127.5f / smax : 0.f;
#define QBIN(x_) min(max((int)fmaf((x_), scale, 128.f), 0), 255)
#pragma unroll
    for (int i = 0; i < 4; ++i) hist[lane * 4 + i] = 0u;
    asm volatile("s_waitcnt lgkmcnt(0)" ::: "memory");
    for (int base = 0; base < N; base += 256) { const int idx = base + 4 * lane;
        if (idx < N) { const f32x4 v = *(const f32x4*)(sc + idx);
#pragma unroll
            for (int e = 0; e < 4; ++e) atomicAdd(&hist[QBIN(v[e])], 1u); } }
    asm volatile("s_waitcnt lgkmcnt(0)" ::: "memory");
    const unsigned c0 = hist[lane * 4], c1 = hist[lane * 4 + 1], c2 = hist[lane * 4 + 2], c3 = hist[lane * 4 + 3];
    const int cnt4 = (int)(c0 + c1 + c2 + c3);
    int incl = cnt4;
#pragma unroll
    for (int o = 1; o < 64; o <<= 1) { const int v = __shfl_down(incl, o); if (lane + o < 64) incl += v; }
    const int excl = incl - cnt4;
    const bool mine = (excl < 256) && (256 <= incl);
    const int L = (int)__builtin_ctzll(__ballot(mine));
    const int ex = __shfl(excl, L); const int b3 = (int)__shfl((int)c3, L), b2 = (int)__shfl((int)c2, L), b1 = (int)__shfl((int)c1, L), b0 = (int)__shfl((int)c0, L);
    int above = ex, bin, mbin;
    if (above + b3 >= 256) { bin = 3; mbin = b3; } else { above += b3; if (above + b2 >= 256) { bin = 2; mbin = b2; } else { above += b2; if (above + b1 >= 256) { bin = 1; mbin = b1; } else { above += b1; bin = 0; mbin = b0; } } }
    if (mbin > 64) return false;
    const int tb = L * 4 + bin, rem = 256 - above, ngt = above; int base_gt = 0, base_eq = 0;
    const unsigned long long lt_mask = (1ull << lane) - 1ull;
    unsigned short* cand = (unsigned short*)hist;
    for (int base = 0; base < N; base += 256) { const int idx = base + 4 * lane; const bool act = idx < N;
        f32x4 v = {0.f, 0.f, 0.f, 0.f}; if (act) v = *(const f32x4*)(sc + idx);
        bool gt[4], eq[4]; unsigned long long bg[4], be[4];
#pragma unroll
        for (int e = 0; e < 4; ++e) { const int qb = QBIN(v[e]); gt[e] = act && qb > tb; eq[e] = act && qb == tb; bg[e] = __ballot(gt[e]); be[e] = __ballot(eq[e]); }
        int rg = base_gt, re = base_eq;
#pragma unroll
        for (int e = 0; e < 4; ++e) re += __popcll(be[e] & lt_mask);
#pragma unroll
        for (int e = 0; e < 4; ++e) {
            if (gt[e]) sel[rg + __popcll(bg[e] & lt_mask)] = (unsigned short)(idx + e);
            rg += __popcll(bg[e]);
            if (eq[e]) { cand[re] = (unsigned short)(idx + e); re += 1; } }
        base_gt = rg;
#pragma unroll
        for (int e = 0; e < 4; ++e) base_eq += __popcll(be[e]); }
    asm volatile("s_waitcnt lgkmcnt(0)" ::: "memory");
    {   const int m = mbin; const int ci = (lane < m) ? (int)cand[lane] : 0; const unsigned ck = (lane < m) ? f2key(sc[ci]) : 0u;
        int rank = 0;
        for (int j = 0; j < m; ++j) { const unsigned kj = (unsigned)__shfl((int)ck, j); rank += (kj > ck || (kj == ck && j < lane)) ? 1 : 0; }
        if (lane < m && rank < rem) sel[ngt + rank] = (unsigned short)ci;
        asm volatile("s_waitcnt lgkmcnt(0)" ::: "memory"); }
#undef QBIN
    return true;
}

__device__ __forceinline__ void dsa_attend(const Params& p, int b, int t, const unsigned short* sel, int cnt, unsigned char* stage, int lane_in) {
    int lane = lane_in; asm volatile("" : "+v"(lane));
    const bf16* CKV = (const bf16*)(p.ws + WS_CKV) + (size_t)b * SEQ * 128; const float* INVR = (const float*)(p.ws + WS_INVR) + (size_t)b * SEQ * 8;
    bf16* QO = (bf16*)(p.ws + WS_REGA) + ((size_t)b * SEQ + t) * 1024;
    const int hd = lane & 15, grp = lane >> 4;
    bf16x8 bq[4];
#pragma unroll
    for (int s = 0; s < 4; ++s) { u32x4 z = {0u, 0u, 0u, 0u}; if (hd < 8) z = *(const u32x4*)(QO + hd * 128 + 32 * s + 8 * grp); bq[s] = __builtin_bit_cast(bf16x8, z); }
    const float slope = (hd < 8) ? exp2f(-(float)(hd + 1)) : 0.f;
    const int hsafe = hd & 7;
    float m_run = -INFINITY, l_part = 0.f;
    f32x4 O[8];
#pragma unroll
    for (int c = 0; c < 8; ++c) O[c] = (f32x4){0.f, 0.f, 0.f, 0.f};
    const LAS unsigned char* st3 = (const LAS unsigned char*)stage;
    const unsigned q4 = (lane & 15) >> 2, p4 = lane & 3;
    u32x4 G[8]; float IRn[8], PNn[8];
#define DA_ISSUE(ks_) do { \
    _Pragma("unroll") for (int i = 0; i < 8; ++i) { const int id = i * 64 + lane, row = id >> 4, ch = id & 15; const unsigned key = sel[(ks_) + row]; G[i] = *(const u32x4*)((const unsigned char*)CKV + (key * 256u + (unsigned)ch * 16u)); } } while (0)
#define DA_ISSUE2(ks_) do { \
    _Pragma("unroll") for (int i = 0; i < 8; ++i) { const int key = sel[(ks_) + 16 * (i >> 2) + 4 * grp + (i & 3)]; IRn[i] = *(const float*)((const unsigned char*)INVR + ((unsigned)key * 32u + (unsigned)hsafe * 4u)); PNn[i] = slope * fabsf((float)(t - key)); } } while (0)
    DA_ISSUE(cnt - 32); DA_ISSUE2(cnt - 32);
    for (int ks = cnt - 32; ks >= 0; ks -= 32) {
#pragma unroll
        for (int i = 0; i < 8; ++i) { const int id = i * 64 + lane, row = id >> 4, ch = id & 15; *(u32x4*)(stage + offb(row, ch)) = G[i]; }
        asm volatile("s_waitcnt lgkmcnt(0)" ::: "memory");
        if (ks >= 32) DA_ISSUE(ks - 32);
        float lg[8];
#pragma unroll
        for (int T = 0; T < 2; ++T) { f32x4 acc = {0.f, 0.f, 0.f, 0.f};
#pragma unroll
            for (int s = 0; s < 4; ++s) { const bf16x8 a = *(const bf16x8*)(stage + offb((lane & 15) + 16 * T, 4 * s + grp)); acc = mfma16(a, bq[s], acc); }
#pragma unroll
            for (int rg = 0; rg < 4; ++rg) lg[4 * T + rg] = acc[rg] * IRn[4 * T + rg] - PNn[4 * T + rg]; }
        if (ks >= 32) DA_ISSUE2(ks - 32);
        float mx = lg[0];
#pragma unroll
        for (int i = 1; i < 8; ++i) mx = fmaxf(mx, lg[i]);
        mx = fmaxf(mx, __shfl_xor(mx, 16)); mx = fmaxf(mx, __shfl_xor(mx, 32));
        const float m_new = fmaxf(m_run, mx);
        const float alpha = __expf(m_run - m_new);
        float ps = 0.f;
#pragma unroll
        for (int i = 0; i < 8; ++i) { lg[i] = __expf(lg[i] - m_new); ps += lg[i]; }
        l_part = l_part * alpha + ps; m_run = m_new;
        { float ar[4];
#pragma unroll
            for (int rg = 0; rg < 4; ++rg) ar[rg] = __shfl(alpha, 4 * grp + rg);
#pragma unroll
            for (int c = 0; c < 8; ++c)
#pragma unroll
                for (int rg = 0; rg < 4; ++rg) O[c][rg] *= ar[rg]; }
        {   u32x4 pw; pw.x = pk2(lg[0], lg[1]); pw.y = pk2(lg[2], lg[3]); pw.z = pk2(lg[4], lg[5]); pw.w = pk2(lg[6], lg[7]);
            const bf16x8 pa = __builtin_bit_cast(bf16x8, pw);
#pragma unroll
            for (int c = 0; c < 8; ++c) {
                const s16x4 lo = __builtin_bit_cast(s16x4, __builtin_amdgcn_ds_read_tr16_b64_v4i16((LAS s16x4*)(st3 + offb(4 * grp + q4, 2 * c + (p4 >> 1)) + 8 * (p4 & 1))));
                const s16x4 hi = __builtin_bit_cast(s16x4, __builtin_amdgcn_ds_read_tr16_b64_v4i16((LAS s16x4*)(st3 + offb(16 + 4 * grp + q4, 2 * c + (p4 >> 1)) + 8 * (p4 & 1))));
                const bf16x8 vb = {lo[0], lo[1], lo[2], lo[3], hi[0], hi[1], hi[2], hi[3]};
                O[c] = mfma16(pa, vb, O[c]); } }
        asm volatile("s_waitcnt lgkmcnt(0)" ::: "memory");
    }
#undef DA_ISSUE
#undef DA_ISSUE2
    float l = l_part; l += __shfl_xor(l, 16); l += __shfl_xor(l, 32);
    const float il = 1.f / l;
    float irr[4];
#pragma unroll
    for (int rg = 0; rg < 4; ++rg) irr[rg] = __shfl(il, 4 * grp + rg);
    if (grp < 2) {
#pragma unroll
        for (int rg = 0; rg < 4; ++rg)
#pragma unroll
            for (int c = 0; c < 8; ++c) QO[(4 * grp + rg) * 128 + 16 * c + hd] = f2bf(O[c][rg] * irr[rg]);
    }
}

#define DSA_LOAD_AF(af_, wqv_, b_, tq0_) do { const size_t rq_ = (size_t)(b_) * SEQ + (tq0_); const int r_ = lane & 31, g_ = lane >> 5, ql_ = 2 * ((r_ >> 2) & 1) + (r_ >> 4), hdm_ = 4 * ((r_ >> 3) & 1) + (r_ & 3); \
    _Pragma("unroll") for (int qg = 0; qg < 4; ++qg) _Pragma("unroll") for (int s = 0; s < 4; ++s) af_[qg][s] = *(const bf16x8*)(PROJ + (rq_ + 4 * qg + ql_) * NPROJ + PC_QI + hdm_ * 64 + 16 * s + 8 * g_); \
    wqv_ = (tid < 128) ? bf2f(PROJ[(rq_ + (tid >> 3)) * NPROJ + PC_WI + (tid & 7)]) * 0.044194173824159216f : 0.f; } while (0)
__device__ __forceinline__ void dsa_select_item(const Params& p, unsigned char* lds, int b, int tq0, int tid, bf16x8 (&af)[4][4], float& wqv, bool has_next, int nb, int ntq0) {
    bf16* PROJ = (bf16*)(p.ws + WS_PROJ);
    float* SC = (float*)lds;
    unsigned* HIST = (unsigned*)(lds + 131072);
    unsigned short* SEL = (unsigned short*)(lds + 131072 + 8192);
    float* WQ = (float*)(lds + 147456);
    unsigned* QMAX = (unsigned*)(lds + 147456 + 512);
    asm volatile("" : "+v"(tid));
    const int lane = tid & 63, wv = __builtin_amdgcn_readfirstlane(tid >> 6);
    const int N = ((tq0 >> 6) + 1) * 64; const size_t rowq0 = (size_t)b * SEQ + tq0;
    {
        const int r = lane & 31, g = lane >> 5;
        if (tid < 128) WQ[tid] = wqv;
        if (tid < 16) QMAX[tid] = 0u;
        float mxq[4][2];
#pragma unroll
        for (int qg = 0; qg < 4; ++qg) { mxq[qg][0] = 0.f; mxq[qg][1] = 0.f; }
        __syncthreads();
        bf16x8 bfr[4];
        { const bf16* krow = PROJ + ((size_t)b * SEQ + wv * 32 + r) * NPROJ + PC_KI + 8 * g;
#pragma unroll
          for (int s = 0; s < 4; ++s) bfr[s] = *(const bf16x8*)(krow + 16 * s); }
        for (int kt = wv; kt < N / 32; kt += NWAVES) {
            const int key = kt * 32 + r;
            bf16x8 bnx[4];
#pragma unroll
            for (int s = 0; s < 4; ++s) bnx[s] = bfr[s];
            if (kt + NWAVES < N / 32) { const bf16* krow = PROJ + ((size_t)b * SEQ + key + 32 * NWAVES) * NPROJ + PC_KI + 8 * g;
#pragma unroll
                for (int s = 0; s < 4; ++s) bnx[s] = *(const bf16x8*)(krow + 16 * s); }
#pragma unroll
            for (int qg = 0; qg < 4; ++qg) { f32x16 acc = {};
#pragma unroll
                for (int s = 0; s < 4; ++s) acc = mfma32(af[qg][s], bfr[s], acc);
#pragma unroll
                for (int qq = 0; qq < 2; ++qq) { float sc = 0.f; const f32x4 w0 = *(const f32x4*)(WQ + (4 * qg + 2 * g + qq) * 8), w1 = *(const f32x4*)(WQ + (4 * qg + 2 * g + qq) * 8 + 4);
#pragma unroll
                    for (int e = 0; e < 4; ++e) { sc = fmaf(w0[e], fmaxf(acc[8 * qq + e], 0.f), sc); sc = fmaf(w1[e], fmaxf(acc[8 * qq + 4 + e], 0.f), sc); }
                    SC[(4 * qg + 2 * g + qq) * 2048 + key] = sc; mxq[qg][qq] = fmaxf(mxq[qg][qq], fabsf(sc)); } }
#pragma unroll
            for (int s = 0; s < 4; ++s) bfr[s] = bnx[s];
        }
#pragma unroll
        for (int qg = 0; qg < 4; ++qg)
#pragma unroll
            for (int qq = 0; qq < 2; ++qq) { float m = dpp_row_max16(mxq[qg][qq]); m = fmaxf(m, __shfl_xor(m, 16));
                if (r == 0) atomicMax(&QMAX[4 * qg + 2 * g + qq], __float_as_uint(m)); }
        __syncthreads();
        if (has_next) DSA_LOAD_AF(af, wqv, nb, ntq0);
        bool fb[2];
        for (int q = 0; q < 2; ++q) fb[q] = !topk_select_fast(SC + (2 * wv + q) * 2048, N, __uint_as_float(QMAX[2 * wv + q]), HIST + wv * 256, SEL + (2 * wv + q) * 256, lane);
        for (int q = 0; q < 2; ++q) if (fb[q]) topk_select(SC + (2 * wv + q) * 2048, N, HIST + wv * 256, SEL + (2 * wv + q) * 256, lane);
    }
    asm volatile("s_waitcnt lgkmcnt(0)" ::: "memory");
    { const int q = lane >> 5; const u32x4 v = *(const u32x4*)(SEL + (2 * wv + q) * 256 + (lane & 31) * 8);
      *(u32x4*)(PROJ + (rowq0 + 2 * wv + q) * NPROJ + PC_Q + (lane & 31) * 8) = v; }
    __syncthreads();
}

__device__ __forceinline__ void dsa_attend_row(const Params& p, unsigned char* wlds, int row, int lane) {
    const bf16* PROJ = (const bf16*)(p.ws + WS_PROJ);
    const int b = row >> 11, t = row & (SEQ - 1), N = ((t >> 6) + 1) * 64, cnt = N > 256 ? 256 : N;
    unsigned short* SELW = (unsigned short*)(wlds + 8192);
    if (N > 256) { if (lane < 32) *(u32x4*)(SELW + lane * 8) = *(const u32x4*)(PROJ + (size_t)row * NPROJ + PC_Q + lane * 8); }
    else { for (int i = lane; i < cnt; i += 64) SELW[i] = (unsigned short)i; }
    asm volatile("s_waitcnt vmcnt(0) lgkmcnt(0)" ::: "memory");
    dsa_attend(p, b, t, SELW, cnt, wlds, lane);
    asm volatile("s_waitcnt lgkmcnt(0)" ::: "memory");
}

__device__ __forceinline__ void uv_item(const Params& p, const unsigned char* wl  , int tile, int lane) {
    bf16* PROJ = (bf16*)(p.ws + WS_PROJ); const bf16* OLAT = (const bf16*)(p.ws + WS_REGA);
    const int r = lane & 31, hh = lane >> 5; const size_t row = (size_t)tile * 32 + r;
    unsigned wb[8];
#pragma unroll
    for (int s = 0; s < 8; ++s) wb[s] = (unsigned)(r * 256 + ((((2 * s + hh) ^ r) & 15) << 4));
#pragma unroll 1
    for (int h = 0; h < 8; ++h) { bf16x8 of[8];
#pragma unroll
        for (int s = 0; s < 8; ++s) of[s] = *(const bf16x8*)(OLAT + row * 1024 + h * 128 + 16 * s + 8 * hh);
#pragma unroll
        for (int dt = 0; dt < 2; ++dt) { f32x16 acc = {}; const unsigned char* wg = wl + (h * 64 + dt * 32) * 256;
#pragma unroll
            for (int s = 0; s < 8; ++s) acc = mfma32(*(const bf16x8*)(wg + wb[s]), of[s], acc);
#pragma unroll
            for (int g4 = 0; g4 < 4; ++g4) { u32x2 o; o.x = pk2(acc[4 * g4], acc[4 * g4 + 1]); o.y = pk2(acc[4 * g4 + 2], acc[4 * g4 + 3]);
                *(u32x2*)(PROJ + row * NPROJ + PC_Q + h * 64 + dt * 32 + 8 * g4 + 4 * hh) = o; } }
    }
}

__device__ __forceinline__ void bias2_item(const Params& p, int item, int lane) {
    const bf16* W1T = (const bf16*)(p.ws + WS_W1); const float* MOD = (const float*)(p.ws + WS_MOD); float* BIAS2 = (float*)(p.ws + WS_BIAS2);
    const int r = lane & 31, hh = lane >> 5, f0 = item * 32;
    const bf16* wrow = W1T + (size_t)(f0 + r) * DM + 8 * hh; const float* srow = MOD + (size_t)r * 6144 + 3072 + 8 * hh;
    f32x16 acc = {};
#pragma unroll 8
    for (int s = 0; s < 64; ++s) { const bf16x8 a = *(const bf16x8*)(wrow + 16 * s); const f32x4 s0 = *(const f32x4*)(srow + 16 * s), s1 = *(const f32x4*)(srow + 16 * s + 4);
        const u32x4 bw = {pk2(s0.x, s0.y), pk2(s0.z, s0.w), pk2(s1.x, s1.y), pk2(s1.z, s1.w)};
        acc = mfma32(a, __builtin_bit_cast(bf16x8, bw), acc); }
#pragma unroll
    for (int i = 0; i < 16; ++i) BIAS2[(size_t)r * 4096 + f0 + (i & 3) + 8 * (i >> 2) + 4 * hh] = acc[i];
}

typedef __attribute__((address_space(1))) unsigned gu32;
#define RLX_AGENT __ATOMIC_RELAXED, __HIP_MEMORY_SCOPE_AGENT
#define XB_TMO      128
#define XB_XCNT(j)  (256  + 64 * (j))
#define XB_XSUB(j)  (1280 + 64 * (j))
#define XB_XGEN(j)  (2304 + 64 * (j))
#define XB_TOP      3328
#define XB_TOPGEN   3392
#define XCD_BAR_WORDS 3456
#define XB_SPIN_CAP (1u << 18)

__device__ __forceinline__ unsigned xb_ld(unsigned* p)              { return __hip_atomic_load(p, __ATOMIC_RELAXED, __HIP_MEMORY_SCOPE_AGENT); }
__device__ __forceinline__ unsigned xb_add(unsigned* p, unsigned v) { return __hip_atomic_fetch_add(p, v, __ATOMIC_RELAXED, __HIP_MEMORY_SCOPE_AGENT); }
__device__ __forceinline__ unsigned xb_xcc_id() { return (unsigned)__builtin_amdgcn_s_getreg((3 << 11) | 20) & 0xFu; }
#define XB_SPIN(cond, bar) do { unsigned _sp = 0; while (cond) { __builtin_amdgcn_s_sleep(1); \
    if ((++_sp & 255u) == 0u) { if (xb_ld(&(bar)[XB_TMO])) break; if (_sp > XB_SPIN_CAP) { atomicAdd(&(bar)[XB_TMO], 1u); break; } } } } while (0)

struct XcdBarrier {
    unsigned* bar; unsigned x;
    volatile LAS unsigned* st;
};

__device__ __forceinline__ XcdBarrier xcd_barrier_post(unsigned* bar, volatile LAS unsigned* st) {
    XcdBarrier b; b.bar = bar; b.x = xb_xcc_id(); b.st = st;
    if (threadIdx.x == 0) (void)xb_add(&bar[XB_XCNT(b.x)], 1u);
    return b;
}
__device__ __forceinline__ void xcd_barrier_complete(unsigned* bar, unsigned x, unsigned& nloc, unsigned& nx) {
    const unsigned G = gridDim.x * gridDim.y * gridDim.z;
    unsigned sum, cnt, mine, sp = 0u;
    for (;;) {
        sum = 0u; cnt = 0u; mine = 0u;
#pragma unroll
        for (unsigned j = 0; j < 16; ++j) { const unsigned c = xb_ld(&bar[XB_XCNT(j)]); sum += c; cnt += (c > 0u) ? 1u : 0u; mine = (j == x) ? c : mine; }
        if (sum == G) break;
        __builtin_amdgcn_s_sleep(1);
        if ((++sp & 255u) == 0u) { if (xb_ld(&bar[XB_TMO])) break; if (sp > XB_SPIN_CAP) { atomicAdd(&bar[XB_TMO], 1u); break; } }
    }
    nloc = mine > 0u ? mine : 1u; nx = cnt > 0u ? cnt : 1u;
}

__device__ __forceinline__ void xcd_barrier(const XcdBarrier& b) {
    asm volatile("s_waitcnt vmcnt(0)" ::: "memory");
    __syncthreads();
    if (threadIdx.x == 0) {
        unsigned* bar = b.bar;
        __builtin_amdgcn_s_waitcnt(0);
        unsigned nloc = b.st[0], nx = b.st[1];
        if (nloc == 0u) { xcd_barrier_complete(bar, b.x, nloc, nx); b.st[0] = nloc; b.st[1] = nx; }
        const unsigned old = xb_add(&bar[XB_XSUB(b.x)], 1u);
        const unsigned gen = old / nloc;
        if (old + 1u == (gen + 1u) * nloc) {
            __builtin_amdgcn_fence(__ATOMIC_RELEASE, "agent");
            asm volatile("s_waitcnt vmcnt(0)" ::: "memory");
            const unsigned og = xb_add(&bar[XB_TOP], 1u);
            const unsigned tg = og / nx;
            if (og + 1u == (tg + 1u) * nx) xb_add(&bar[XB_TOPGEN], 1u);
            else XB_SPIN(xb_ld(&bar[XB_TOPGEN]) == tg, bar);
            __builtin_amdgcn_fence(__ATOMIC_ACQUIRE, "agent");
            xb_add(&bar[XB_XGEN(b.x)], 1u);
            asm volatile("s_waitcnt vmcnt(0)" ::: "memory");
        } else {
            XB_SPIN(xb_ld(&bar[XB_XGEN(b.x)]) == gen, bar);
            __builtin_amdgcn_fence(__ATOMIC_ACQUIRE, "agent");
            asm volatile("s_waitcnt vmcnt(0)" ::: "memory");
        }
    }
    __syncthreads();
}

enum { PH_PRO = 0, PH_HN, PH_GEMM1, PH_PREP, PH_MIX, PH_ATT, PH_UV, PH_GOUT, PH_UP, PH_DOWN, PH_COUNT };
#ifndef MK_SKIP_MIXER
#define MK_SKIP_MIXER 0
#endif
__global__ void __launch_bounds__(NWAVES * 64, 2) mk_fwd(Params p) {
    extern __shared__ __attribute__((aligned(16))) unsigned char lds[];
    cg::grid_group grid = cg::this_grid();
    const int tid = threadIdx.x, lane = tid & 63, wv = __builtin_amdgcn_readfirstlane(tid >> 6);
    const int G = gridDim.x, gw = blockIdx.x * NWAVES + wv, NGW = G * NWAVES;
    const int lo = p.ph_lo, hi = p.ph_hi;
    if (p.ph_hi < 0) grid.sync();
    if (tid < 2) ((volatile LAS unsigned*)((LAS unsigned char*)lds + LDS_BAR_OFF))[tid] = 0u;
    __syncthreads();
    XcdBarrier xbar = xcd_barrier_post((unsigned*)(p.ws + WS_BAR), (volatile LAS unsigned*)((LAS unsigned char*)lds + LDS_BAR_OFF));
    float* MOD = (float*)(p.ws + WS_MOD); bf16* REGA = (bf16*)(p.ws + WS_REGA); bf16* PROJ = (bf16*)(p.ws + WS_PROJ);
#ifndef MK_PHASE_MASK
#define MK_PHASE_MASK 0x3ff
#endif
#define IN(k) (((MK_PHASE_MASK >> (k)) & 1) && lo <= (k) && (k) < hi)
#define SEAM(k) do { if (IN(k) && IN((k) + 1)) { xcd_barrier(xbar); } if (MK_PROBE >= 0 && blockIdx.x == 0 && tid == 0) ((unsigned long long*)(p.ws + WS_MOD + 800 * 1024))[(k) + 1] = __builtin_amdgcn_s_memrealtime(); } while (0)
    if (MK_PROBE >= 0 && blockIdx.x == 0 && tid == 0) ((unsigned long long*)(p.ws + WS_MOD + 800 * 1024))[0] = __builtin_amdgcn_s_memrealtime();
    if (IN(PH_PRO)) { phase_pro(p, lds, tid, G); }
    SEAM(PH_PRO);
    if (IN(PH_HN)) { hn_rows<MK_F8_GEMM1 != 0>(p.x, p.g_mix, MOD, 0, 1024, REGA, gw, NGW, lane); }
    SEAM(PH_HN);
    if (IN(PH_GEMM1)) {
#if MK_F8_GEMM1
        pg8::Gemm g{REGA, (const bf16*)(p.ws + WS_WIN), M, NPROJ, DM / 2, DM / 2}; pg8::StaticOrder S; S.init(M, NPROJ, G, (int)blockIdx.x);
        pg8::EpiBf16<0> E{PROJ, NPROJ, 1.f / 32.f};
        pg8::gemm_phase<pg8::EpiBf16<0>, pg8::StaticOrder, true, true, true>((PG8_LAS unsigned char*)lds, g, S, E);
#else
        pg8::Gemm g{REGA, (const bf16*)(p.ws + WS_WIN), M, NPROJ, DM, DM}; pg8::StaticOrder S; S.init(M, NPROJ, G, (int)blockIdx.x);
        pg8::EpiBf16<0> E{PROJ, NPROJ, 1.f};
        pg8::gemm_phase<pg8::EpiBf16<0>, pg8::StaticOrder, true, true>((PG8_LAS unsigned char*)lds, g, S, E);
#endif
    }
    SEAM(PH_GEMM1);
    if (IN(PH_PREP)) {
#ifndef DBG_NO_RP
        for (int it = blockIdx.x; it < M / 64; it += G) rwkv_prep_item(p, lds, it, tid);
#endif
#ifndef DBG_NO_DP
        __syncthreads();
        stage_w_lds((const bf16*)(p.ws + WS_WUKT), lds, 4, tid); __syncthreads();
        for (int tile = gw; tile < M / 32; tile += NGW) dsa_prep_kv(p, lds, tile, lane);
        __syncthreads();
        stage_w_lds((const bf16*)(p.ws + WS_WUK), lds, 6, tid); __syncthreads();
        for (int tile = gw; tile < M / 32; tile += NGW) dsa_prep_q(p, lds, tile, lane);
#endif
    }
    SEAM(PH_PREP);
    if (IN(PH_MIX)) {
        for (int chain = blockIdx.x; chain < NB * 8; chain += G) { rwkv_scan_chain(p, lds, chain, wv, lane); __syncthreads(); }
        constexpr int NSEL = NB * 112;
        {   bf16x8 af[4][4]; float wqv = 0.f; const bf16* PROJ = (const bf16*)(p.ws + WS_PROJ);
            int idx = (int)blockIdx.x;
            if (idx < NSEL) DSA_LOAD_AF(af, wqv, idx / 112, 256 + 16 * (idx % 112));
            for (int k = 0; idx < NSEL; ++k) { const int nidx = (k + 1) * G + (((k + 1) & 1) ? (G - 1 - (int)blockIdx.x) : (int)blockIdx.x); const bool hn = nidx < NSEL;
                dsa_select_item(p, lds, idx / 112, 256 + 16 * (idx % 112), tid, af, wqv, hn, nidx / 112, 256 + 16 * (nidx % 112)); idx = nidx; } }
    }
    SEAM(PH_MIX);
    if (IN(PH_ATT)) {
        if (gw < 128) bias2_item(p, gw, lane);
        for (int row = gw; row < M; row += NGW) dsa_attend_row(p, lds + wv * 9216, row, lane);
    }

    SEAM(PH_ATT);
    if (IN(PH_UV)) {
#if MK_DBG == 7
        for (int m = gw; m < M; m += NGW) { *(u32x4*)(PROJ + (size_t)m * NPROJ + lane * 8) = *(const u32x4*)(REGA + (size_t)m * 1024 + lane * 8); }
#elif MK_DBG != 2
        stage_w_lds((const bf16*)(p.ws + WS_WUVT), lds, 4, tid); __syncthreads();
        for (int tile = gw; tile < M / 32; tile += NGW) uv_item(p, lds, tile, lane);
#endif
#if MK_DBG == 0
        rwkv_epi_rows(p, gw, NGW, lane);
#endif
#if MK_DBG == 1 || MK_DBG == 2
        for (int m = gw; m < M; m += NGW) { u32x4 z = {0u, 0u, 0u, 0u}; *(u32x4*)(PROJ + (size_t)m * NPROJ + (MK_DBG == 1 ? 512 : 0) + lane * 8) = z; }
#endif
    }
    SEAM(PH_UV);
    if (IN(PH_GOUT)) {
        pg8::Gemm g{PROJ, (const bf16*)(p.ws + WS_WOUT), M, DM, DM, NPROJ}; pg8::StaticOrder S; S.init(M, DM, G, (int)blockIdx.x);
        pg8::EpiResGateNorm E{p.x, p.out, DM, MOD + 2048, 6144, p.g_ffn, MOD + 4096, REGA, (float*)(p.ws + WS_ROWSQ)};
        pg8::gemm_phase<pg8::EpiResGateNorm, pg8::StaticOrder, true, true>((PG8_LAS unsigned char*)lds, g, S, E);
    }
    SEAM(PH_GOUT);
    if (IN(PH_UP)) {
        pg8::Gemm g{REGA, (const bf16*)(p.ws + WS_W1), M, FF, DM, DM}; pg8::StaticOrder S; S.init(M, FF, G, (int)blockIdx.x);
        pg8::EpiF8Relu2 E{p.ws + WS_U, FF, 4.f, (const float*)(p.ws + WS_ROWSQ), (const float*)(p.ws + WS_BIAS2)};
        pg8::gemm_phase<pg8::EpiF8Relu2, pg8::StaticOrder, true, true>((PG8_LAS unsigned char*)lds, g, S, E);
    }
    SEAM(PH_UP);
    if (IN(PH_DOWN)) {
        pg8::Gemm g{(const bf16*)(p.ws + WS_U), (const bf16*)(p.ws + WS_W2), M, DM, FF / 2, FF / 2}; pg8::StaticOrder S; S.init(M, DM, G, (int)blockIdx.x);
        pg8::EpiResGateA2 E{REGA, p.out, DM, MOD + 5120, 6144, p.g_ffn};
        pg8::gemm_phase<pg8::EpiResGateA2, pg8::StaticOrder, true, true, true>((PG8_LAS unsigned char*)lds, g, S, E);
    }
#if MK_PROBE >= 0
    grid.sync();
    if (blockIdx.x == 0 && tid == 0) { unsigned long long* ts = (unsigned long long*)(p.ws + WS_MOD + 800 * 1024); ts[PH_COUNT] = __builtin_amdgcn_s_memrealtime();
        p.out[0] += (float)(ts[MK_PROBE + 1] - ts[MK_PROBE]) * 1e-3f; }
#endif
#undef IN
#undef SEAM
}

#ifndef MK_N_LAUNCHES
#define MK_N_LAUNCHES 1
#endif
extern "C" void kernel_launch(void* const* d_in, const int* in_sizes, int n_in, void* d_out, int out_size, void* d_ws, size_t ws_size, hipStream_t stream) {
    static int grid = 0;
    if (grid == 0) {
        if (n_in != 26 || out_size != M * DM || ws_size < WS_END) { fprintf(stderr, "kernel_launch: unexpected shapes (n_in %d out %d ws %zu)\n", n_in, out_size, ws_size); grid = -1; return; }
        int dev = 0, cus = 0, per_cu = 0;
        hipGetDevice(&dev); hipDeviceGetAttribute(&cus, hipDeviceAttributeMultiprocessorCount, dev);
        if (hipFuncSetAttribute((const void*)mk_fwd, hipFuncAttributeMaxDynamicSharedMemorySize, LDS_BYTES) != hipSuccess) { fprintf(stderr, "kernel_launch: hipFuncSetAttribute failed\n"); grid = -1; return; }
        if (hipOccupancyMaxActiveBlocksPerMultiprocessor(&per_cu, (const void*)mk_fwd, NWAVES * 64, LDS_BYTES) != hipSuccess || per_cu < 1) { fprintf(stderr, "kernel_launch: occupancy query says %d\n", per_cu); per_cu = 1; }
        (void)hipGetLastError();
        grid = cus * 1;
        if (per_cu < 1) grid = -1;
    }
    if (grid < 0) return;
    Params p{};
    const float** pp = (const float**)&p;
    for (int i = 0; i < 26; ++i) pp[i] = (const float*)d_in[i];
    p.out = (float*)d_out; p.ws = (unsigned char*)d_ws;
#if MK_N_LAUNCHES == 1
    if (hipMemsetAsync((char*)d_ws + WS_BAR, 0, 16384, stream) != hipSuccess) { fprintf(stderr, "kernel_launch: memset of the barrier words failed\n"); return; }
    p.ph_lo = 0; p.ph_hi = PH_COUNT;
    void* args[] = {&p};
    hipError_t e = hipLaunchCooperativeKernel((const void*)mk_fwd, dim3(grid), dim3(NWAVES * 64), args, LDS_BYTES, stream);
    if (e != hipSuccess) fprintf(stderr, "cooperative launch failed: %s (grid %d)\n", hipGetErrorString(e), grid);
#else
    for (int ph = 0; ph < PH_COUNT; ++ph) {
#if MK_SKIP_MIXER
        if (ph >= PH_HN && ph <= PH_GOUT) continue;
#endif
        p.ph_lo = ph; p.ph_hi = ph + 1;
        hipLaunchKernelGGL(mk_fwd, dim3(grid), dim3(NWAVES * 64), LDS_BYTES, stream, p);
    }
#endif
}
```

```cpp
#include <hip/hip_runtime.h>
#include <hip/hip_cooperative_groups.h>
#include <cstdio>
#include <cstdint>
#include <cmath>
namespace cg = cooperative_groups;
#ifndef MK_F8_GEMM1
#define MK_F8_GEMM1 0
#endif
#ifndef MK_PROBE
#define MK_PROBE -1
#endif
#ifndef MK_F8_GOUT
#define MK_F8_GOUT 1
#endif
#ifndef MK_DBG
#define MK_DBG 0
#endif
#ifndef MK_DBG_NOTOPK
#define MK_DBG_NOTOPK 0
#endif
namespace pg8 {
#define PG8_LAS __attribute__((address_space(3)))
typedef unsigned short bf16_t;
typedef short bf16x8 __attribute__((ext_vector_type(8)));
typedef float f32x4 __attribute__((ext_vector_type(4)));
typedef unsigned u32x4 __attribute__((ext_vector_type(4)));
constexpr int BM = 256, BK = 64, HALF = 128, HTB = HALF * BK * 2  , STAGE_BYTES = 8 * HTB, NXCD = 8, WGM = 8;

__host__ __device__ __forceinline__ int lds_byte(int r, int c) { const int st = (r >> 4) * 2 + (c >> 5), rr = r & 15, cc = c & 31, ob = rr * 64 + cc * 2; return st * 1024 + (ob ^ (((ob >> 9) & 1) << 5)); }
__host__ __device__ __forceinline__ void stage_rc(int b, int& R, int& C) { const int st = b / 1024, sb = b % 1024, swz = sb ^ (((sb >> 9) & 1) << 5); R = (st >> 1) * 16 + swz / 64; C = (st & 1) * 32 + (swz % 64) / 2; }
__host__ __device__ __forceinline__ int perm32(int rho) { const int n = rho >> 4, i = rho & 15; return 8 * (i >> 2) + 4 * n + (i & 3); }

struct Unit { int pm, pn; };
struct Gemm { const bf16_t* A; const bf16_t* Bt; int M, N, K, lda; };

struct StaticOrder {
    int nM, nN, nwg, G, c;
    __host__ __device__ void init(int M, int N, int G_, int c_) { nM = M / BM; nN = N / BM; nwg = nM * nN; G = G_; c = c_; }
    __host__ __device__ bool next(int i, Unit& u) const {
        const long L = (long)i * G + c; if (L >= nwg) return false;
        int wgid = (int)L; { const int q = nwg / NXCD, r = nwg % NXCD, xcd = wgid % NXCD, off = wgid / NXCD; wgid = (xcd < r ? xcd * (q + 1) : r * (q + 1) + (xcd - r) * q) + off; }
        const int nig = WGM * nN, gid = wgid / nig, fm = gid * WGM, gsz = (nM - fm) < WGM ? (nM - fm) : WGM;
        u.pm = fm + ((wgid % nig) % gsz); u.pn = (wgid % nig) / gsz; return true;
    }
    __device__ __forceinline__ void a_ready(const Unit&) const {}
    __device__ __forceinline__ void done(const Unit&) const {}
};


typedef float f32x2_t __attribute__((ext_vector_type(2))); typedef __bf16 bf16x2_t __attribute__((ext_vector_type(2)));
__device__ __forceinline__ unsigned cvt_pk_bf16(float lo, float hi) { const f32x2_t v = {lo, hi}; const bf16x2_t b = __builtin_convertvector(v, bf16x2_t); return __builtin_bit_cast(unsigned, b); }

template <int ACT  > struct EpiBf16 {
    static constexpr bool PERM = true, AFTER_DRAIN = false;
    bf16_t* O; int ldc; float scale;
    __device__ __forceinline__ void operator()(const f32x4 (&acc)[2][2][4][2], const Unit& u, int wr, int wc, int fr, int fq) const {
        const int row0 = u.pm * BM + wr * 64 + fr; const int col0 = u.pn * BM + wc * 32 + 8 * fq;
#pragma unroll
        for (int ai = 0; ai < 2; ++ai)
#pragma unroll
            for (int m = 0; m < 4; ++m) { bf16_t* rowp = O + (size_t)(row0 + ai * HALF + m * 16) * ldc + col0;
#pragma unroll
                for (int bj = 0; bj < 2; ++bj) { f32x4 v0 = acc[ai][bj][m][0] * scale, v1 = acc[ai][bj][m][1] * scale;
                    if (ACT == 1) {
#pragma unroll
                        for (int j = 0; j < 4; ++j) { const float a = v0[j] > 0.f ? v0[j] : 0.f, b = v1[j] > 0.f ? v1[j] : 0.f; v0[j] = a * a; v1[j] = b * b; } }
                    u32x4 w; w.x = cvt_pk_bf16(v0[0], v0[1]); w.y = cvt_pk_bf16(v0[2], v0[3]); w.z = cvt_pk_bf16(v1[0], v1[1]); w.w = cvt_pk_bf16(v1[2], v1[3]);
                    *(u32x4*)(rowp + bj * HALF) = w; } }
    }
};
__device__ __forceinline__ unsigned pk4_fp8(float a, float b, float c, float d) { int r = __builtin_amdgcn_cvt_pk_fp8_f32(a, b, 0, false); r = __builtin_amdgcn_cvt_pk_fp8_f32(c, d, r, true); return (unsigned)r; }
struct EpiF8Relu2 {
    static constexpr bool PERM = true, AFTER_DRAIN = false;
    unsigned char* O; int ldc; float scale; const float* rowsq; const float* bias2;
    __device__ __forceinline__ void operator()(const f32x4 (&acc)[2][2][4][2], const Unit& u, int wr, int wc, int fr, int fq) const {
        const int row0 = u.pm * BM + wr * 64 + fr; const int col0 = u.pn * BM + wc * 32 + 8 * fq;
        const float* bp = bias2 + (size_t)(u.pm >> 3) * 4096 + col0;
        f32x4 bv[2][2];
#pragma unroll
        for (int bj = 0; bj < 2; ++bj) { bv[bj][0] = *(const f32x4*)(bp + bj * HALF); bv[bj][1] = *(const f32x4*)(bp + bj * HALF + 4); }
#pragma unroll
        for (int ai = 0; ai < 2; ++ai)
#pragma unroll
            for (int m = 0; m < 4; ++m) { const int row = row0 + ai * HALF + m * 16; unsigned char* rowp = O + (size_t)row * ldc + col0;
                const float rstd = rsqrtf(rowsq[row] * (1.f / 1024.f) + 1e-6f);
#pragma unroll
                for (int bj = 0; bj < 2; ++bj) { f32x4 v0 = acc[ai][bj][m][0] * rstd + bv[bj][0], v1 = acc[ai][bj][m][1] * rstd + bv[bj][1];
#pragma unroll
                    for (int j = 0; j < 4; ++j) { const float a = v0[j] > 0.f ? v0[j] : 0.f, b = v1[j] > 0.f ? v1[j] : 0.f; v0[j] = fminf(a * a * scale, 416.f); v1[j] = fminf(b * b * scale, 416.f); }
                    typedef unsigned u32x2_t __attribute__((ext_vector_type(2)));
                    u32x2_t w; w.x = pk4_fp8(v0[0], v0[1], v0[2], v0[3]); w.y = pk4_fp8(v1[0], v1[1], v1[2], v1[3]);
                    *(u32x2_t*)(rowp + bj * HALF) = w; } }
    }
};
struct EpiResGate {
    static constexpr bool PERM = false, AFTER_DRAIN = false;
    const float* base; float* out; int ldc; const float* gate; int gate_ld; float gscale;
    __device__ __forceinline__ void operator()(const f32x4 (&acc)[2][2][4][2], const Unit& u, int, int, int, int) const {
        int t_ = threadIdx.x; asm volatile("" : "+v"(t_));
        const int wr = t_ >> 8, wc = (t_ >> 6) & 3, fr = t_ & 15, fq = (t_ >> 4) & 3;
        const int row0 = u.pm * BM + wr * 64 + fr, col0 = u.pn * BM + wc * 32 + 4 * fq;
        const float* gp = gate + (size_t)(u.pm >> 3) * gate_ld + col0;
        f32x4 gv[2][2];
#pragma unroll
        for (int bj = 0; bj < 2; ++bj)
#pragma unroll
            for (int n = 0; n < 2; ++n) gv[bj][n] = *(const f32x4*)(gp + bj * HALF + n * 16) * gscale;
#pragma unroll
        for (int ai = 0; ai < 2; ++ai)
#pragma unroll
            for (int m = 0; m < 4; ++m) { const size_t off = (size_t)(row0 + ai * HALF + m * 16) * ldc + col0;
#pragma unroll
                for (int bj = 0; bj < 2; ++bj)
#pragma unroll
                    for (int n = 0; n < 2; ++n) { const f32x4 bs = *(const f32x4*)(base + off + bj * HALF + n * 16);
                        *(f32x4*)(out + off + bj * HALF + n * 16) = bs + gv[bj][n] * acc[ai][bj][m][n]; } }
    }
};
struct EpiResGateNorm {
    static constexpr bool PERM = false, AFTER_DRAIN = false;
    const float* base; float* out; int ldc; const float* gate; int gate_ld; const float* gffn; const float* sc2; bf16_t* a2; float* rowsq; float gscale;
    __device__ __forceinline__ void operator()(const f32x4 (&acc)[2][2][4][2], const Unit& u, int, int, int, int) const {
        int t_ = threadIdx.x; asm volatile("" : "+v"(t_));
        const int wr = t_ >> 8, wc = (t_ >> 6) & 3, fr = t_ & 15, fq = (t_ >> 4) & 3;
        const int row0 = u.pm * BM + wr * 64 + fr, col0 = u.pn * BM + wc * 32 + 4 * fq;
        const float* gp = gate + (size_t)(u.pm >> 3) * gate_ld + col0; const float* sp = sc2 + (size_t)(u.pm >> 3) * gate_ld + col0;
        f32x4 gv[2][2], gm[2][2];
#pragma unroll
        for (int bj = 0; bj < 2; ++bj)
#pragma unroll
            for (int n = 0; n < 2; ++n) { gv[bj][n] = *(const f32x4*)(gp + bj * HALF + n * 16) * gscale; gm[bj][n] = *(const f32x4*)(gffn + col0 + bj * HALF + n * 16) * (*(const f32x4*)(sp + bj * HALF + n * 16) + 1.f); }
#pragma unroll
        for (int ai = 0; ai < 2; ++ai)
#pragma unroll
            for (int m = 0; m < 4; ++m) { const int row = row0 + ai * HALF + m * 16; const size_t off = (size_t)row * ldc + col0; float ss = 0.f;
#pragma unroll
                for (int bj = 0; bj < 2; ++bj)
#pragma unroll
                    for (int n = 0; n < 2; ++n) { const f32x4 bs = *(const f32x4*)(base + off + bj * HALF + n * 16); const f32x4 x1 = bs + gv[bj][n] * acc[ai][bj][m][n];
                        ss += (x1.x * x1.x + x1.y * x1.y) + (x1.z * x1.z + x1.w * x1.w);
                        const f32x4 y = x1 * gm[bj][n]; typedef unsigned u32x2_t __attribute__((ext_vector_type(2)));
                        u32x2_t w; w.x = cvt_pk_bf16(y.x, y.y); w.y = cvt_pk_bf16(y.z, y.w); *(u32x2_t*)(a2 + off + bj * HALF + n * 16) = w; }
                ss += __shfl_xor(ss, 16); ss += __shfl_xor(ss, 32);
                if (fq == 0) atomicAdd(rowsq + row, ss); }
    }
};
struct EpiResGateA2 {
    static constexpr bool PERM = false, AFTER_DRAIN = false;
    const bf16_t* a2; float* out; int ldc; const float* gate; int gate_ld; const float* gffn;
    __device__ __forceinline__ void operator()(const f32x4 (&acc)[2][2][4][2], const Unit& u, int, int, int, int) const {
        constexpr float gscale = 1.f / 256.f;
        int t_ = threadIdx.x; asm volatile("" : "+v"(t_));
        const int wr = t_ >> 8, wc = (t_ >> 6) & 3, fr = t_ & 15, fq = (t_ >> 4) & 3;
        const int row0 = u.pm * BM + wr * 64 + fr, col0 = u.pn * BM + wc * 32 + 4 * fq;
        const float* gp = gate + (size_t)(u.pm >> 3) * gate_ld + col0; const float* sp = gp - 1024;
        f32x4 gv[2][2], ig[2][2];
#pragma unroll
        for (int bj = 0; bj < 2; ++bj)
#pragma unroll
            for (int n = 0; n < 2; ++n) { gv[bj][n] = *(const f32x4*)(gp + bj * HALF + n * 16) * gscale;
                const f32x4 gm = *(const f32x4*)(gffn + col0 + bj * HALF + n * 16) * (*(const f32x4*)(sp + bj * HALF + n * 16) + 1.f);
                ig[bj][n] = (f32x4){1.f / gm.x, 1.f / gm.y, 1.f / gm.z, 1.f / gm.w}; }
#pragma unroll
        for (int ai = 0; ai < 2; ++ai)
#pragma unroll
            for (int m = 0; m < 4; ++m) { const size_t off = (size_t)(row0 + ai * HALF + m * 16) * ldc + col0;
#pragma unroll
                for (int bj = 0; bj < 2; ++bj)
#pragma unroll
                    for (int n = 0; n < 2; ++n) { typedef unsigned u32x2_t __attribute__((ext_vector_type(2)));
                        const u32x2_t w = *(const u32x2_t*)(a2 + off + bj * HALF + n * 16);
                        const f32x4 xa = {__uint_as_float(w.x << 16), __uint_as_float(w.x & 0xffff0000u), __uint_as_float(w.y << 16), __uint_as_float(w.y & 0xffff0000u)};
                        *(f32x4*)(out + off + bj * HALF + n * 16) = xa * ig[bj][n] + gv[bj][n] * acc[ai][bj][m][n]; } }
    }
};
template <class Epi, class Sched, bool ALIGN_EPI = false, bool SP2 = false, bool F8 = false>
__device__ __forceinline__ void gemm_phase(PG8_LAS unsigned char* lds, const Gemm g, const Sched S, const Epi E) {
    const int tid = threadIdx.x, wid = __builtin_amdgcn_readfirstlane(tid >> 6), lane = tid & 63, wr = wid >> 2, wc = wid & 3, fr = lane & 15, fq = lane >> 4;
    const int K = g.K, nt = K / BK;
    unsigned voffA[2], voffB[2];
#pragma unroll
    for (int i = 0; i < 2; ++i) { int R, C; stage_rc(tid * 16 + i * 8192, R, C); const int Rb = Epi::PERM ? ((R & ~31) + perm32(R & 31)) : R;
        voffA[i] = (unsigned)(R * g.lda + C) * 2u; voffB[i] = (unsigned)(Rb * K + C) * 2u; }
    const size_t kstep = (size_t)(BK * 2);
    const size_t hstepB = (size_t)HALF * K * 2, hstepA = (size_t)HALF * g.lda * 2;
    const size_t tstepA = 2 * hstepA, tstepB = 2 * hstepB;
    const unsigned ldsw = (unsigned)wid * 1024u;
    const int f8in = (fq >> 1) * 1024 + ((fr * 64 + (fq & 1) * 32) ^ ((fr >> 3) << 5));
    const int aoff = F8 ? wr * 8192 + f8in : lds_byte(wr * 64 + fr, fq * 8), boff = F8 ? wc * 4096 + f8in : lds_byte(wc * 32 + fr, fq * 8);
    constexpr int KOFF = F8 ? 16 : 1024;
    typedef int v8i_t __attribute__((ext_vector_type(8)));
#define PG8_SA(b, h) (((b) * 2 + (h)) * HTB)
#define PG8_SB(b, h) ((4 + (b) * 2 + (h)) * HTB)
#define PG8_STAGE(bufoff, gbase, voff) do { _Pragma("unroll") for (int _i = 0; _i < 2; ++_i) \
        __builtin_amdgcn_global_load_lds((const unsigned*)((const char*)(gbase) + (voff)[_i]), (PG8_LAS unsigned*)(lds + (bufoff) + ldsw + _i * 8192), 16, 0, 0); } while (0)
#define PG8_LD32(p_) __builtin_shufflevector(*(const PG8_LAS u32x4*)(p_), *(const PG8_LAS u32x4*)((p_) + 16), 0, 1, 2, 3, 4, 5, 6, 7)
#define PG8_LDA(dst, b, h) do { if constexpr (F8) { _Pragma("unroll") for (int m = 0; m < 4; ++m) dst##8[m] = __builtin_bit_cast(v8i_t, PG8_LD32(lds + PG8_SA(b, h) + aoff + m * 2048)); } \
    else { _Pragma("unroll") for (int m = 0; m < 4; ++m) _Pragma("unroll") for (int k = 0; k < 2; ++k) dst[m][k] = *(const PG8_LAS bf16x8*)(lds + PG8_SA(b, h) + aoff + m * 2048 + k * KOFF); } } while (0)
#define PG8_LDB(dst, b, h) do { if constexpr (F8) { _Pragma("unroll") for (int n = 0; n < 2; ++n) dst##8[n] = __builtin_bit_cast(v8i_t, PG8_LD32(lds + PG8_SB(b, h) + boff + n * 2048)); } \
    else { _Pragma("unroll") for (int n = 0; n < 2; ++n) _Pragma("unroll") for (int k = 0; k < 2; ++k) dst[n][k] = *(const PG8_LAS bf16x8*)(lds + PG8_SB(b, h) + boff + n * 2048 + k * KOFF); } } while (0)
#define PG8_CAT(x) __builtin_shufflevector(__builtin_bit_cast(u32x4, (x)[0]), __builtin_bit_cast(u32x4, (x)[1]), 0, 1, 2, 3, 4, 5, 6, 7)
#define PG8_MMA(ai, bj, At, Bt) do { __builtin_amdgcn_s_setprio(1); if constexpr (F8) { _Pragma("unroll") for (int m = 0; m < 4; ++m) _Pragma("unroll") for (int n = 0; n < 2; ++n) \
        asm volatile("v_mfma_f32_16x16x128_f8f6f4 %0, %1, %2, %0" : "+v"(acc[ai][bj][m][n]) : "v"(Bt##8[n]), "v"(At##8[m])); } \
    else { _Pragma("unroll") for (int m = 0; m < 4; ++m) _Pragma("unroll") for (int n = 0; n < 2; ++n) _Pragma("unroll") for (int k = 0; k < 2; ++k) \
        acc[ai][bj][m][n] = __builtin_amdgcn_mfma_f32_16x16x32_bf16(Bt[n][k], At[m][k], acc[ai][bj][m][n], 0, 0, 0); } __builtin_amdgcn_s_setprio(0); } while (0)
#define PG8_WAIT_V(n) asm volatile("s_waitcnt vmcnt(" #n ")" ::: "memory")
#define PG8_WAIT_L(n) asm volatile("s_waitcnt lgkmcnt(" #n ")" ::: "memory")
#define PG8_BAR __builtin_amdgcn_s_barrier()
#define PG8_SCHED __builtin_amdgcn_sched_barrier(0)
    Unit cur, nxt; int ui = 0;
    if (!S.next(0, cur)) return;
    f32x4 acc[2][2][4][2];
#pragma unroll
    for (int a = 0; a < 2; ++a)
#pragma unroll
        for (int b = 0; b < 2; ++b)
#pragma unroll
            for (int m = 0; m < 4; ++m)
#pragma unroll
                for (int n = 0; n < 2; ++n) acc[a][b][m][n] = (f32x4){0.f, 0.f, 0.f, 0.f};
    bf16x8 At[4][2], B0[2][2], B1[2][2]; v8i_t At8[4], B08[2], B18[2];
    const char* cA = (const char*)g.A + (size_t)cur.pm * tstepA; const char* cB = (const char*)g.Bt + (size_t)cur.pn * tstepB;
    S.a_ready(cur);
    if constexpr (SP2) {
        PG8_STAGE(PG8_SB(0, 0), cB, voffB); PG8_STAGE(PG8_SB(0, 1), cB + hstepB, voffB); PG8_STAGE(PG8_SA(0, 0), cA, voffA); PG8_STAGE(PG8_SA(0, 1), cA + hstepA, voffA);
        if (wr == 1) PG8_BAR;
        PG8_WAIT_V(2); PG8_BAR;
        PG8_STAGE(PG8_SB(1, 0), cB + kstep, voffB); PG8_STAGE(PG8_SA(1, 0), cA + kstep, voffA); PG8_STAGE(PG8_SB(1, 1), cB + hstepB + kstep, voffB);
        PG8_WAIT_V(6); PG8_BAR;
    } else {
        PG8_STAGE(PG8_SB(0, 0), cB, voffB); PG8_STAGE(PG8_SA(0, 0), cA, voffA); PG8_STAGE(PG8_SB(0, 1), cB + hstepB, voffB); PG8_STAGE(PG8_SA(0, 1), cA + hstepA, voffA);
        if (wr == 1) PG8_BAR;
        PG8_WAIT_V(4); PG8_BAR;
        PG8_STAGE(PG8_SB(1, 0), cB + kstep, voffB); PG8_STAGE(PG8_SA(1, 0), cA + kstep, voffA); PG8_STAGE(PG8_SB(1, 1), cB + hstepB + kstep, voffB);
        PG8_WAIT_V(6); PG8_BAR;
    }
    for (;;) {
        const bool has_next = S.next(ui + 1, nxt);
        const char* nA = has_next ? (const char*)g.A + (size_t)nxt.pm * tstepA : cA; const char* nB = has_next ? (const char*)g.Bt + (size_t)nxt.pn * tstepB : cB;
        for (int t = 0; t < nt; t += 2) {
            const bool last = (t == nt - 2);
            const char* a1 = cA + (size_t)(t + 1) * kstep;
            const char* a2 = last ? nA : cA + (size_t)(t + 2) * kstep; const char* b2 = last ? nB : cB + (size_t)(t + 2) * kstep;
            const char* a3 = a2 + kstep; const char* b3 = b2 + kstep;
            if (last && has_next) S.a_ready(nxt);
            if constexpr (SP2) {
            PG8_LDB(B0, 0, 0); PG8_LDB(B1, 0, 1); PG8_SCHED; PG8_LDA(At, 0, 0); PG8_STAGE(PG8_SA(1, 1), a1 + hstepA, voffA);
            PG8_WAIT_V(8); PG8_WAIT_L(0); PG8_BAR; PG8_MMA(0, 0, At, B0); PG8_MMA(0, 1, At, B1); PG8_BAR; PG8_SCHED;
            PG8_LDA(At, 0, 1); PG8_STAGE(PG8_SB(0, 0), b2, voffB); PG8_STAGE(PG8_SB(0, 1), b2 + hstepB, voffB); PG8_STAGE(PG8_SA(0, 0), a2, voffA);
            PG8_WAIT_V(8); PG8_WAIT_L(0); PG8_BAR; PG8_MMA(1, 0, At, B0); PG8_MMA(1, 1, At, B1); PG8_BAR; PG8_SCHED;
            PG8_LDB(B0, 1, 0); PG8_LDB(B1, 1, 1); PG8_SCHED; PG8_LDA(At, 1, 0); PG8_STAGE(PG8_SA(0, 1), a2 + hstepA, voffA);
            PG8_WAIT_V(8); PG8_WAIT_L(0); PG8_BAR; PG8_MMA(0, 0, At, B0); PG8_MMA(0, 1, At, B1); PG8_BAR; PG8_SCHED;
            PG8_LDA(At, 1, 1); PG8_STAGE(PG8_SB(1, 0), b3, voffB); PG8_STAGE(PG8_SB(1, 1), b3 + hstepB, voffB); PG8_STAGE(PG8_SA(1, 0), a3, voffA);
            PG8_WAIT_V(8); PG8_WAIT_L(0); PG8_BAR; PG8_MMA(1, 0, At, B0); PG8_MMA(1, 1, At, B1); PG8_BAR; PG8_SCHED;
            } else {
            PG8_LDB(B0, 0, 0); PG8_SCHED; PG8_LDA(At, 0, 0); PG8_STAGE(PG8_SA(1, 1), a1 + hstepA, voffA);
            PG8_WAIT_L(8); PG8_BAR; PG8_WAIT_L(0); PG8_MMA(0, 0, At, B0); PG8_BAR; PG8_SCHED;
            PG8_LDB(B1, 0, 1); PG8_STAGE(PG8_SB(0, 0), b2, voffB);
            PG8_BAR; PG8_WAIT_L(0); PG8_MMA(0, 1, At, B1); PG8_BAR;
            PG8_LDA(At, 0, 1); PG8_STAGE(PG8_SA(0, 0), a2, voffA);
            PG8_BAR; PG8_WAIT_L(0); PG8_MMA(1, 0, At, B0); PG8_BAR; PG8_SCHED;
            PG8_STAGE(PG8_SB(0, 1), b2 + hstepB, voffB);
            PG8_WAIT_V(6); PG8_BAR; PG8_MMA(1, 1, At, B1); PG8_BAR;
            PG8_LDB(B0, 1, 0); PG8_SCHED; PG8_LDA(At, 1, 0); PG8_STAGE(PG8_SA(0, 1), a2 + hstepA, voffA);
            PG8_WAIT_L(8); PG8_BAR; PG8_WAIT_L(0); PG8_MMA(0, 0, At, B0); PG8_BAR; PG8_SCHED;
            PG8_LDB(B1, 1, 1); PG8_STAGE(PG8_SB(1, 0), b3, voffB);
            PG8_BAR; PG8_WAIT_L(0); PG8_MMA(0, 1, At, B1); PG8_BAR;
            PG8_LDA(At, 1, 1); PG8_STAGE(PG8_SA(1, 0), a3, voffA);
            PG8_BAR; PG8_WAIT_L(0); PG8_MMA(1, 0, At, B0); PG8_BAR; PG8_SCHED;
            PG8_STAGE(PG8_SB(1, 1), b3 + hstepB, voffB);
            PG8_WAIT_V(6); PG8_BAR; PG8_MMA(1, 1, At, B1); PG8_BAR;
            }
        }
        if constexpr (ALIGN_EPI) { if (wr == 0) PG8_BAR; }
        if constexpr (F8) asm volatile("s_nop 15\n\ts_nop 15");
        if constexpr (!Epi::AFTER_DRAIN) { E(acc, cur, wr, wc, fr, fq); S.done(cur); }
        if (!has_next) break;
#pragma unroll
        for (int a = 0; a < 2; ++a)
#pragma unroll
            for (int b = 0; b < 2; ++b)
#pragma unroll
                for (int m = 0; m < 4; ++m)
#pragma unroll
                    for (int n = 0; n < 2; ++n) acc[a][b][m][n] = (f32x4){0.f, 0.f, 0.f, 0.f};
        cur = nxt; cA = nA; cB = nB; ++ui;
        if constexpr (ALIGN_EPI) { if (wr == 1) PG8_BAR; }
    }
    PG8_WAIT_V(0);
    if constexpr (!ALIGN_EPI) { if (wr == 0) PG8_BAR; }
    PG8_BAR;
    if constexpr (Epi::AFTER_DRAIN) { E.fused(acc, cur, wr, wc, fr, fq, lds, wid, lane); S.done(cur); }
#undef PG8_SA
#undef PG8_SB
#undef PG8_STAGE
#undef PG8_LDA
#undef PG8_LDB
#undef PG8_MMA
#undef PG8_CAT
#undef PG8_LD32
#undef PG8_WAIT_V
#undef PG8_WAIT_L
#undef PG8_BAR
#undef PG8_SCHED
}
}

#define LAS __attribute__((address_space(3)))
typedef unsigned short bf16;
typedef short bf16x8 __attribute__((ext_vector_type(8)));
typedef short s16x4 __attribute__((ext_vector_type(4)));
typedef float f32x4 __attribute__((ext_vector_type(4)));
typedef float f32x16 __attribute__((ext_vector_type(16)));
typedef unsigned u32x4 __attribute__((ext_vector_type(4)));
typedef unsigned u32x2 __attribute__((ext_vector_type(2)));

constexpr int NB = 32, SEQ = 2048, DM = 1024, M = NB * SEQ, NPROJ = 3072, FF = 4096;
constexpr int PC_Q = 0, PC_R = 512, PC_K = 1024, PC_V = 1536, PC_QI = 2048, PC_CL = 2560, PC_KI = 2688, PC_XW = 2752, PC_XA = 2816, PC_XG = 2880, PC_WI = 3008;
constexpr size_t MiB = 1u << 20;
constexpr size_t WS_MOD = 0, WS_WUKT = 1 * MiB, WS_WUK = WS_WUKT + 131072, WS_WUVT = WS_WUK + 131072, WS_INVR = 2 * MiB, WS_WIN = 4 * MiB, WS_WOUT = 10 * MiB,
                 WS_W1 = 12 * MiB, WS_W2 = 20 * MiB, WS_CKV = 36 * MiB, WS_GAM = 52 * MiB, WS_C3 = 60 * MiB, WS_REGA = 64 * MiB, WS_PROJ = 192 * MiB, WS_CH = 576 * MiB,
                 WS_G = 960 * MiB, WS_U = 192 * MiB, WS_END = 1024 * MiB,
                 WS_BAR = 62 * MiB, WS_ROWSQ = WS_BAR + 65536, WS_BIAS2 = WS_ROWSQ + 262144, WS_W2T = WS_WUVT + 131072, WS_A2T = WS_W2T + 65536, WS_G2T = WS_A2T + 65536;
constexpr int LDS_BAR_OFF = 163072;
constexpr int LDS_BYTES = 163328;
constexpr int NWAVES = 8;

struct Params {
    const float *x, *c, *w_ada, *b_ada, *g_mix, *g_ffn, *w_in, *g_q, *g_k, *g_kv, *w_uk, *w_uv, *mu, *w0, *w2, *a0, *a2, *g2, *k_k, *k_a, *r_k, *ln_w, *ln_b, *w_out, *w_ff1, *w_ff2;
    float* out; unsigned char* ws; int ph_lo, ph_hi;
};

__device__ __forceinline__ unsigned pk2(float lo, float hi) { return pg8::cvt_pk_bf16(lo, hi); }
__device__ __forceinline__ float bflo(unsigned w) { return __uint_as_float(w << 16); }
__device__ __forceinline__ float bfhi(unsigned w) { return __uint_as_float(w & 0xffff0000u); }
__device__ __forceinline__ float bf2f(bf16 h) { return __uint_as_float((unsigned)h << 16); }
__device__ __forceinline__ bf16 f2bf(float f) { return (bf16)(pk2(f, 0.f) & 0xffffu); }
__device__ __forceinline__ float wave_sum(float v) {
#pragma unroll
    for (int o = 1; o < 64; o <<= 1) v += __shfl_xor(v, o);
    return v;
}
__device__ __forceinline__ f32x16 mfma32(bf16x8 a, bf16x8 b, f32x16 c) { return __builtin_amdgcn_mfma_f32_32x32x16_bf16(a, b, c, 0, 0, 0); }
__device__ __forceinline__ f32x4 mfma16(bf16x8 a, bf16x8 b, f32x4 c) { return __builtin_amdgcn_mfma_f32_16x16x32_bf16(a, b, c, 0, 0, 0); }

__device__ __forceinline__ int win_src_col(int n) {
    if (n < 512) return n;
    if (n < 1024) return 1224 + (n - 512);
    if (n < 1536) return 1736 + (n - 1024);
    if (n < 2048) return 2248 + (n - 1536);
    if (n < 2560) return 640 + (n - 2048);
    if (n < 2688) return 512 + (n - 2560);
    if (n < 2752) return 1152 + (n - 2688);
    if (n < 2816) return 2760 + (n - 2752);
    if (n < 2880) return 2824 + (n - 2816);
    if (n < 3008) return 2888 + (n - 2880);
    if (n < 3016) return 1216 + (n - 3008);
    return -1;
}
__device__ __forceinline__ void conv_t_item(const float* W, int K, int Nsrc, bf16* WT, int nblk, int item, float* scr, int lane, bool is_win) {
    const int kb = item / nblk, nb = item % nblk, k0 = 64 * kb, n0 = 32 * nb;
    int ns = n0 + (lane & 31); if (is_win) ns = win_src_col(ns);
    float tv[32];
#pragma unroll
    for (int i = 0; i < 32; ++i) { const int kk = 2 * i + (lane >> 5); tv[i] = ns >= 0 ? W[(size_t)(k0 + kk) * Nsrc + ns] : 0.f; }
#pragma unroll
    for (int i = 0; i < 32; ++i) { const int kk = 2 * i + (lane >> 5); scr[kk * 33 + (lane & 31)] = tv[i]; }
    asm volatile("s_waitcnt lgkmcnt(0)" ::: "memory");
    const int c = lane & 7;
#pragma unroll
    for (int j = 0; j < 4; ++j) { const int n = (lane >> 3) + 8 * j; const float* s = scr + (8 * c) * 33 + n;
        u32x4 o; o.x = pk2(s[0 * 33], s[1 * 33]); o.y = pk2(s[2 * 33], s[3 * 33]); o.z = pk2(s[4 * 33], s[5 * 33]); o.w = pk2(s[6 * 33], s[7 * 33]);
        *(u32x4*)(WT + (size_t)(n0 + n) * K + k0 + 8 * c) = o; }
    asm volatile("s_waitcnt lgkmcnt(0)" ::: "memory");
}
__device__ __forceinline__ void conv_t_item_f8(const float* W, int K, int N, unsigned char* WT, int nblk, int item, float* scr, int lane, float scale, bool is_win = false) {
    const int kb = item / nblk, nb = item % nblk, k0 = 64 * kb, n0 = 32 * nb;
    int ns = n0 + (lane & 31); if (is_win) ns = win_src_col(ns);
    float tv[32];
#pragma unroll
    for (int i = 0; i < 32; ++i) { const int kk = 2 * i + (lane >> 5); tv[i] = ns >= 0 ? W[(size_t)(k0 + kk) * N + ns] * scale : 0.f; }
#pragma unroll
    for (int i = 0; i < 32; ++i) { const int kk = 2 * i + (lane >> 5); scr[kk * 33 + (lane & 31)] = tv[i]; }
    asm volatile("s_waitcnt lgkmcnt(0)" ::: "memory");
    const int c = lane & 7;
#pragma unroll
    for (int j = 0; j < 4; ++j) { const int n = (lane >> 3) + 8 * j; const float* s = scr + (8 * c) * 33 + n;
        u32x2 o; o.x = pg8::pk4_fp8(s[0 * 33], s[1 * 33], s[2 * 33], s[3 * 33]); o.y = pg8::pk4_fp8(s[4 * 33], s[5 * 33], s[6 * 33], s[7 * 33]);
        *(u32x2*)(WT + (size_t)(n0 + n) * K + k0 + 8 * c) = o; }
    asm volatile("s_waitcnt lgkmcnt(0)" ::: "memory");
}
__device__ __forceinline__ void adaln_block(const Params& p, float* ldsf, int cb, int tid) {
    const int lane = tid & 63, wv = tid >> 6, e = cb * 64 + lane;
    float* SC = ldsf; float* RED = ldsf + 16384; float* mod = (float*)(p.ws + WS_MOD);
    float wreg[128];
#pragma unroll
    for (int d = 0; d < 128; ++d) wreg[d] = p.w_ada[(size_t)(wv * 128 + d) * 6144 + e];
    for (int half = 0; half < 2; ++half) {
        const int b0 = half * 16;
        for (int i = tid; i < 16384; i += 512) { const float cv = p.c[b0 * 1024 + i]; SC[i] = cv / (1.f + __expf(-cv)); }
        __syncthreads();
        float acc[16];
#pragma unroll
        for (int bb = 0; bb < 16; ++bb) acc[bb] = 0.f;
#pragma unroll
        for (int dd = 0; dd < 128; dd += 4) { const int d = wv * 128 + dd;
            const float w0 = wreg[dd], w1 = wreg[dd + 1], w2 = wreg[dd + 2], w3 = wreg[dd + 3];
#pragma unroll
            for (int bb = 0; bb < 16; ++bb) { const f32x4 s = *(const f32x4*)(SC + bb * 1024 + d); acc[bb] += (s.x * w0 + s.y * w1) + (s.z * w2 + s.w * w3); }
        }
#pragma unroll
        for (int bb = 0; bb < 16; ++bb) RED[(wv * 16 + bb) * 64 + lane] = acc[bb];
        __syncthreads();
#pragma unroll
        for (int q = 0; q < 2; ++q) { const int bb = wv * 2 + q; float s = p.b_ada[e];
#pragma unroll
            for (int ww = 0; ww < 8; ++ww) s += RED[(ww * 16 + bb) * 64 + lane];
            mod[(size_t)(b0 + bb) * 6144 + e] = s; }
        __syncthreads();
    }
}
__device__ __forceinline__ void phase_pro(const Params& p, unsigned char* lds, int tid, int G) {
    const int lane = tid & 63, wv = tid >> 6;
    for (int cb = blockIdx.x; cb < 96; cb += G) adaln_block(p, (float*)lds, cb, tid);
    __syncthreads();
    float* scr = (float*)lds + wv * (64 * 33 + 16);
    const int gw = blockIdx.x * NWAVES + wv, NGW = G * NWAVES;
    bf16* WIN = (bf16*)(p.ws + WS_WIN); bf16* WOUT = (bf16*)(p.ws + WS_WOUT); bf16* W1 = (bf16*)(p.ws + WS_W1); bf16* W2 = (bf16*)(p.ws + WS_W2);
    bf16* WUKT = (bf16*)(p.ws + WS_WUKT); bf16* WUK = (bf16*)(p.ws + WS_WUK); bf16* WUVT = (bf16*)(p.ws + WS_WUVT);
    constexpr int I_IN = (DM / 64) * (NPROJ / 32), I_OUT = (DM / 64) * (DM / 32), I_1 = (DM / 64) * (FF / 32), I_2 = (FF / 64) * (DM / 32), I_UK = (128 / 64) * (512 / 32);
    constexpr int I_LR = 512 / 32;
    constexpr int NITEMS = I_IN + I_OUT + I_1 + I_2 + 2 * I_UK + 4 * I_LR;
    for (int it = gw; it < NITEMS; it += NGW) {
        int r = it;
        if (r < I_IN) { if (MK_F8_GEMM1) conv_t_item_f8(p.w_in, DM, 3016, (unsigned char*)WIN, NPROJ / 32, r, scr, lane, 32.f, true); else conv_t_item(p.w_in, DM, 3016, WIN, NPROJ / 32, r, scr, lane, true); continue; } r -= I_IN;
        if (r < I_OUT) { if (MK_F8_GOUT) conv_t_item_f8(p.w_out, DM, DM, (unsigned char*)WOUT, DM / 32, r, scr, lane, 32.f); else conv_t_item(p.w_out, DM, DM, WOUT, DM / 32, r, scr, lane, false); continue; } r -= I_OUT;
        if (r < I_1) { conv_t_item(p.w_ff1, DM, FF, W1, FF / 32, r, scr, lane, false); continue; } r -= I_1;
        if (r < I_2) { conv_t_item_f8(p.w_ff2, FF, DM, (unsigned char*)W2, DM / 32, r, scr, lane, 64.f); continue; } r -= I_2;
        if (r < I_UK) { conv_t_item(p.w_uk, 128, 512, WUKT, 512 / 32, r, scr, lane, false); continue; } r -= I_UK;
        if (r < I_UK) { conv_t_item(p.w_uv, 128, 512, WUVT, 512 / 32, r, scr, lane, false); continue; } r -= I_UK;
        if (r < I_LR) { conv_t_item(p.w2, 64, 512, (bf16*)(p.ws + WS_W2T), 512 / 32, r, scr, lane, false); continue; } r -= I_LR;
        if (r < I_LR) { conv_t_item(p.a2, 64, 512, (bf16*)(p.ws + WS_A2T), 512 / 32, r, scr, lane, false); continue; } r -= I_LR;
        conv_t_item(p.g2, 128, 512, (bf16*)(p.ws + WS_G2T), 512 / 32, r, scr, lane, false);
    }
    { float* ROWSQ = (float*)(p.ws + WS_ROWSQ); for (int i = blockIdx.x * 512 + tid; i < M; i += G * 512) ROWSQ[i] = 0.f; }
    for (int i = blockIdx.x * 512 + tid; i < 128 * 512 / 2; i += G * 512) { const float a = p.w_uk[2 * i], b = p.w_uk[2 * i + 1]; ((unsigned*)WUK)[i] = pk2(a, b); }
}

template <bool F8OUT> __device__ __forceinline__ void hn_rows(const float* src, const float* g, const float* mod, int off_sh, int off_sc, bf16* dst, int gw, int NGW, int lane) {
    const int RPW = M / NGW;
    for (int m0 = gw * RPW; m0 < M; m0 += NGW * RPW) {
        const float* mb = mod + (size_t)(m0 >> 11) * 6144;
        f32x4 ga[4], sh[4];
#pragma unroll
        for (int j = 0; j < 4; ++j) { const int col = 4 * lane + 256 * j; const f32x4 gg = *(const f32x4*)(g + col), sc = *(const f32x4*)(mb + off_sc + col); ga[j] = gg * (1.f + sc); sh[j] = *(const f32x4*)(mb + off_sh + col); }
        for (int r0 = 0; r0 < RPW; r0 += 4) {
            f32x4 v[4][4]; float s[4];
#pragma unroll
            for (int r = 0; r < 4; ++r) { const f32x4* xr = (const f32x4*)(src + (size_t)(m0 + r0 + r) * DM) + lane;
#pragma unroll
                for (int j = 0; j < 4; ++j) v[r][j] = xr[64 * j]; }
#pragma unroll
            for (int r = 0; r < 4; ++r) { s[r] = 0.f;
#pragma unroll
                for (int j = 0; j < 4; ++j) s[r] += (v[r][j].x * v[r][j].x + v[r][j].y * v[r][j].y) + (v[r][j].z * v[r][j].z + v[r][j].w * v[r][j].w); }
#pragma unroll
            for (int o = 1; o < 64; o <<= 1) {
#pragma unroll
                for (int r = 0; r < 4; ++r) s[r] += __shfl_xor(s[r], o); }
#pragma unroll
            for (int r = 0; r < 4; ++r) { const int m = m0 + r0 + r; const float rstd = rsqrtf(s[r] * (1.f / DM) + 1e-6f);
                unsigned long long* o8 = (unsigned long long*)(dst + (size_t)m * DM) + lane;
#pragma unroll
                for (int j = 0; j < 4; ++j) { const f32x4 y = v[r][j] * rstd * ga[j] + sh[j];
                    if (F8OUT) ((unsigned*)((unsigned char*)dst + (size_t)m * DM))[lane + 64 * j] = pg8::pk4_fp8(y.x, y.y, y.z, y.w);
                    else o8[64 * j] = (unsigned long long)pk2(y.x, y.y) | ((unsigned long long)pk2(y.z, y.w) << 32); } }
        }
    }
}

typedef short s16x4 __attribute__((ext_vector_type(4)));
__device__ __forceinline__ f32x4 mfma16k(s16x4 a, s16x4 b, f32x4 c) { return __builtin_amdgcn_mfma_f32_16x16x16bf16_1k(a, b, c, 0, 0, 0); }
__device__ __forceinline__ s16x4 pack4(f32x4 v) { u32x2 o; o.x = pk2(v[0], v[1]); o.y = pk2(v[2], v[3]); return __builtin_bit_cast(s16x4, o); }

__device__ __forceinline__ float dpp_row_sum16(float x) {
    x += __builtin_bit_cast(float, __builtin_amdgcn_mov_dpp(__builtin_bit_cast(int, x), 0xB1, 0xF, 0xF, true));
    x += __builtin_bit_cast(float, __builtin_amdgcn_mov_dpp(__builtin_bit_cast(int, x), 0x4E, 0xF, 0xF, true));
    x += __builtin_bit_cast(float, __builtin_amdgcn_mov_dpp(__builtin_bit_cast(int, x), 0x141, 0xF, 0xF, true));
    x += __builtin_bit_cast(float, __builtin_amdgcn_mov_dpp(__builtin_bit_cast(int, x), 0x140, 0xF, 0xF, true));
    return x;
}
__device__ __forceinline__ void rwkv_prep_item(const Params& p, unsigned char* lds, int it, int tid_in) {
    int tid = tid_in; asm volatile("" : "+v"(tid));
    const int lane = tid & 63, wv = __builtin_amdgcn_readfirstlane(tid >> 6);
    bf16* XS = (bf16*)lds;
    bf16* STG = (bf16*)(lds + 33792) + wv * 4096;
    float* MAB = (float*)(lds + 99328) + wv * 256;
    bf16* RKV = (bf16*)(lds + 107520) + wv * 3468;
    const bf16* PROJ = (const bf16*)(p.ws + WS_PROJ);
    const bf16* W2T = (const bf16*)(p.ws + WS_W2T); const bf16* A2T = (const bf16*)(p.ws + WS_A2T); const bf16* G2T = (const bf16*)(p.ws + WS_G2T);
    float* GAM = (float*)(p.ws + WS_GAM); float* C3 = (float*)(p.ws + WS_C3); bf16* GB = (bf16*)(p.ws + WS_G);
    const int row0 = it * 64, t0 = (it & 31) * 64, b = it >> 5;
    __syncthreads();
    {   const int xt = tid >> 5, xch = tid & 31;
        const f32x4 m0_ = *(const f32x4*)(p.mu + 1536 + 8 * xch), m1_ = *(const f32x4*)(p.mu + 1536 + 8 * xch + 4); const float sc_ = xch < 8 ? 2.f : -1.f;
        u32x4 xc[4], xp[4];
#pragma unroll
        for (int qq = 0; qq < 4; ++qq) { const int t = xt + 16 * qq; const bf16* src_ = PROJ + (size_t)(row0 + t) * NPROJ + PC_XW + 8 * xch; xc[qq] = *(const u32x4*)src_;
            xp[qq] = (u32x4){0u, 0u, 0u, 0u}; if (t0 + t != 0) xp[qq] = *(const u32x4*)(src_ - NPROJ); }
#pragma unroll
        for (int qq = 0; qq < 4; ++qq) { float o_[8];
#pragma unroll
            for (int i = 0; i < 4; ++i) { const float c0_ = bflo(xc[qq][i]), c1_ = bfhi(xc[qq][i]), p0_ = bflo(xp[qq][i]), p1_ = bfhi(xp[qq][i]);
                const float ma_ = i < 2 ? m0_[2 * i] : m1_[2 * i - 4], mb_ = i < 2 ? m0_[2 * i + 1] : m1_[2 * i - 3];
                const float v0_ = c0_ + ma_ * (p0_ - c0_), v1_ = c1_ + mb_ * (p1_ - c1_);
                const float r0_ = 1.f / (1.f + __expf(sc_ * v0_)), r1_ = 1.f / (1.f + __expf(sc_ * v1_));
                o_[2 * i] = xch < 8 ? 1.f - 2.f * r0_ : (xch < 16 ? v0_ : r0_); o_[2 * i + 1] = xch < 8 ? 1.f - 2.f * r1_ : (xch < 16 ? v1_ : r1_); }
            *(u32x4*)(XS + (xt + 16 * qq) * 264 + 8 * xch) = (u32x4){pk2(o_[0], o_[1]), pk2(o_[2], o_[3]), pk2(o_[4], o_[5]), pk2(o_[6], o_[7])}; }
    }
    u32x4 RK[7];
#define RKV_LOAD(rowb, tb) do { _Pragma("unroll") for (int i = 0; i < 7; ++i) { const int id_ = i * 64 + lane, mat_ = id_ / 136, rem_ = id_ - 136 * mat_, rw_ = rem_ >> 3, ch_ = rem_ & 7; \
        RK[i] = (u32x4){0u, 0u, 0u, 0u}; if (id_ < 408 && (tb) - 1 + rw_ >= 0) RK[i] = *(const u32x4*)(PROJ + (size_t)((rowb) - 1 + rw_) * NPROJ + PC_R + 512 * mat_ + wv * 64 + 8 * ch_); } } while (0)
#define RKV_WRITE() do { _Pragma("unroll") for (int i = 0; i < 7; ++i) { const int id_ = i * 64 + lane, mat_ = id_ / 136, rem_ = id_ - 136 * mat_, rw_ = rem_ >> 3, ch_ = rem_ & 7; \
        if (id_ < 408) { bf16* d_ = RKV + mat_ * 1156 + rw_ * 68 + 8 * ch_; *(u32x2*)d_ = (u32x2){RK[i].x, RK[i].y}; *(u32x2*)(d_ + 4) = (u32x2){RK[i].z, RK[i].w}; } } } while (0)
    RKV_LOAD(row0, t0);
    __syncthreads();
#pragma unroll 1
    for (int q = 0; q < 4; ++q) {
        const int rowq = row0 + 16 * q, tq = t0 + 16 * q;
        int lane_ = lane; asm volatile("" : "+v"(lane_));
        const int n_ = lane_ & 15, grp_ = lane_ >> 4;
        const size_t idx = (size_t)(b * 8 + wv) * 128 + (tq >> 4);
        unsigned char* CHp = p.ws + WS_CH + idx * 12288;
        RKV_WRITE();
        if (q < 3) RKV_LOAD(rowq + 16, tq + 16);
        f32x4 dw[4], da[4];
        {   bf16x8 xa[8];
#pragma unroll
            for (int ks = 0; ks < 8; ++ks) xa[ks] = *(const bf16x8*)(XS + (16 * q + n_) * 264 + 32 * ks + 8 * grp_);
            bf16x8 wf[2][8];
#define LORA_LOADW(dst_, ct_) do { const int cc_ = wv * 64 + 16 * (ct_) + n_; \
                _Pragma("unroll") for (int ks = 0; ks < 2; ++ks) { dst_[ks] = *(const bf16x8*)(W2T + cc_ * 64 + 32 * ks + 8 * grp_); dst_[2 + ks] = *(const bf16x8*)(A2T + cc_ * 64 + 32 * ks + 8 * grp_); } \
                _Pragma("unroll") for (int ks = 0; ks < 4; ++ks) dst_[4 + ks] = *(const bf16x8*)(G2T + cc_ * 128 + 32 * ks + 8 * grp_); } while (0)
            LORA_LOADW(wf[0], 0);
#pragma unroll
            for (int ct = 0; ct < 4; ++ct) { const int cc = wv * 64 + 16 * ct + n_;
                if (ct < 3) LORA_LOADW(wf[(ct + 1) & 1], ct + 1);
                f32x4 dg = {0.f, 0.f, 0.f, 0.f}; dw[ct] = dg; da[ct] = dg;
#pragma unroll
                for (int ks = 0; ks < 2; ++ks) dw[ct] = mfma16(xa[ks], wf[ct & 1][ks], dw[ct]);
#pragma unroll
                for (int ks = 0; ks < 2; ++ks) da[ct] = mfma16(xa[2 + ks], wf[ct & 1][2 + ks], da[ct]);
#pragma unroll
                for (int ks = 0; ks < 4; ++ks) dg = mfma16(xa[4 + ks], wf[ct & 1][4 + ks], dg);
#pragma unroll
                for (int rg = 0; rg < 4; ++rg) GB[(size_t)(rowq + 4 * grp_ + rg) * 512 + cc] = f2bf(dg[rg]); }
#undef LORA_LOADW
        }
        asm volatile("s_waitcnt lgkmcnt(0)" ::: "memory");
        {   float kkvA[4][4], kkaA[4][4], kprA[4][4], rA[4][4], vA[4][4], wA[4][4], nrm[4], c3s[4];
#pragma unroll
            for (int rg = 0; rg < 4; ++rg) { nrm[rg] = 0.f; c3s[rg] = 0.f; }
#pragma unroll
            for (int ct = 0; ct < 4; ++ct) { const int j = 16 * ct + n_, c = wv * 64 + j;
                const float mu_r = p.mu[c], mu_k = p.mu[512 + c], mu_v = p.mu[1024 + c], w0c = p.w0[c], a0c = p.a0[c], kkc = p.k_k[c], kac = p.k_a[c], rkc = p.r_k[c];
#pragma unroll
                for (int rg = 0; rg < 4; ++rg) { const int t = 4 * grp_ + rg;
                    const float rp = bf2f(RKV[t * 68 + j]), rc = bf2f(RKV[(t + 1) * 68 + j]);
                    const float kp = bf2f(RKV[1156 + t * 68 + j]), kc = bf2f(RKV[1156 + (t + 1) * 68 + j]);
                    const float vp = bf2f(RKV[2312 + t * 68 + j]), vc = bf2f(RKV[2312 + (t + 1) * 68 + j]);
                    const float r = rc + mu_r * (rp - rc), k = kc + mu_k * (kp - kc); vA[ct][rg] = vc + mu_v * (vp - vc); rA[ct][rg] = r;
                    const float u = w0c + dw[ct][rg]; const float wlog = -__logf(1.f + __expf(-u)) - 0.5f; wA[ct][rg] = __expf(-__expf(wlog));
                    const float a = 1.f / (1.f + __expf(-(a0c + da[ct][rg])));
                    const float kkv = k * kkc, kpr = k * (1.f + (a - 1.f) * kac); kkvA[ct][rg] = kkv; kkaA[ct][rg] = kkv * a; kprA[ct][rg] = kpr;
                    nrm[rg] += kkv * kkv; c3s[rg] += r * kpr * rkc; } }
            float inrm[4];
#pragma unroll
            for (int rg = 0; rg < 4; ++rg) { nrm[rg] = dpp_row_sum16(nrm[rg]); c3s[rg] = dpp_row_sum16(c3s[rg]); inrm[rg] = 1.f / fmaxf(sqrtf(nrm[rg]), 1e-12f); }
            if (n_ == 0) {
#pragma unroll
                for (int rg = 0; rg < 4; ++rg) C3[(size_t)(rowq + 4 * grp_ + rg) * 8 + wv] = c3s[rg]; }
#pragma unroll
            for (int ct = 0; ct < 4; ++ct) { const int j = 16 * ct + n_;
                float lp[4]; lp[0] = wA[ct][0]; lp[1] = lp[0] * wA[ct][1]; lp[2] = lp[1] * wA[ct][2]; lp[3] = lp[2] * wA[ct][3];
                const float P0 = __shfl(lp[3], n_), P1 = __shfl(lp[3], n_ + 16), P2 = __shfl(lp[3], n_ + 32);
                const float E = grp_ == 0 ? 1.f : (grp_ == 1 ? P0 : (grp_ == 2 ? P0 * P1 : P0 * P1 * P2));
                float bt[4], kt[4];
#pragma unroll
                for (int rg = 0; rg < 4; ++rg) { const int t = 4 * grp_ + rg;
                    const float gam = E * lp[rg], gprev = rg == 0 ? E : E * lp[rg - 1], ig = 1.f / gam;
                    const int so = t * 64 + (j ^ (((t >> 1) & 7) << 3));
                    STG[so] = f2bf(-kkvA[ct][rg] * inrm[rg] * gprev); STG[1024 + so] = f2bf(rA[ct][rg] * gam);
                    bt[rg] = kkaA[ct][rg] * inrm[rg] * ig; kt[rg] = kprA[ct][rg] * ig;
                    STG[2048 + so] = f2bf(bt[rg]); STG[3072 + so] = f2bf(kt[rg]); }
                *(u32x2*)(CHp + 4096 + j * 32 + grp_ * 8) = (u32x2){pk2(bt[0], bt[1]), pk2(bt[2], bt[3])};
                *(u32x2*)(CHp + 6144 + j * 32 + grp_ * 8) = (u32x2){pk2(kt[0], kt[1]), pk2(kt[2], kt[3])};
                *(u32x2*)(CHp + 8192 + j * 32 + grp_ * 8) = (u32x2){pk2(vA[ct][0], vA[ct][1]), pk2(vA[ct][2], vA[ct][3])};
                if (grp_ == 3) GAM[idx * 64 + j] = E * lp[3]; }
        }
        asm volatile("s_waitcnt lgkmcnt(0)" ::: "memory");
        {   f32x4 mab = {0.f, 0.f, 0.f, 0.f}, mak = mab, nrb = mab, nrk = mab;
#pragma unroll
            for (int ks = 0; ks < 4; ++ks) { const int o = n_ * 64 + ((16 * ks + 4 * grp_) ^ (((n_ >> 1) & 7) << 3));
                const s16x4 fa = *(const s16x4*)(STG + o), fr = *(const s16x4*)(STG + 1024 + o), fb = *(const s16x4*)(STG + 2048 + o), fk = *(const s16x4*)(STG + 3072 + o);
                mab = mfma16k(fa, fb, mab); mak = mfma16k(fa, fk, mak); nrb = mfma16k(fr, fb, nrb); nrk = mfma16k(fr, fk, nrk); }
            asm volatile("s_waitcnt lgkmcnt(0)" ::: "memory");
            bf16* SM = STG + 2048;
#pragma unroll
            for (int rg = 0; rg < 4; ++rg) { const int t = 4 * grp_ + rg; const bool sl = t > n_, il = t >= n_;
                MAB[t * 16 + n_] = sl ? mab[rg] : 0.f;
                SM[256 + t * 16 + n_] = f2bf(sl ? mak[rg] : 0.f); SM[512 + t * 16 + n_] = f2bf(il ? nrb[rg] : 0.f); SM[768 + t * 16 + n_] = f2bf(il ? nrk[rg] : 0.f); }
            asm volatile("s_waitcnt lgkmcnt(0)" ::: "memory");
            if (lane_ < 16) {
                float Tc[16];
#pragma unroll
                for (int t = 0; t < 16; ++t) { float acc = (t == lane_) ? 1.f : 0.f;
#pragma unroll
                    for (int s2 = 0; s2 < t; ++s2) acc = fmaf(MAB[t * 16 + s2], Tc[s2], acc);
                    Tc[t] = acc; SM[t * 16 + lane_] = f2bf(acc); }
            }
            asm volatile("s_waitcnt lgkmcnt(0)" ::: "memory");
#pragma unroll
            for (int i = 0; i < 4; ++i) { const int id = i * 64 + lane_, rw = id >> 3, c16 = id & 7; *(u32x4*)(CHp + id * 16) = *(const u32x4*)((const unsigned char*)STG + rw * 128 + ((c16 ^ ((rw >> 1) & 7)) << 4)); }
#pragma unroll
            for (int i = 0; i < 2; ++i) { const int id = i * 64 + lane_; *(u32x4*)(CHp + 10240 + id * 16) = *(const u32x4*)((const unsigned char*)SM + id * 16); }
        }
    }
#undef RKV_LOAD
#undef RKV_WRITE
}

__device__ __forceinline__ void stage_w_lds(const bf16* W, unsigned char* lds, int log2_cpr  , int tid) {
    const int cpr = 1 << log2_cpr;
#pragma unroll 4
    for (int i = 0; i < 16; ++i) { const int id = i * 512 + tid, row = id >> log2_cpr, ch = id & (cpr - 1);
        *(u32x4*)(lds + ((size_t)row << (log2_cpr + 4)) + (((ch & ~15) | ((ch ^ row) & 15)) << 4)) = *(const u32x4*)((const unsigned char*)W + (size_t)id * 16); }
}
__device__ __forceinline__ bf16x8 lds_wfrag(const unsigned char* lds, int row, int ch, int log2_cpr) {
    return *(const bf16x8*)(lds + ((size_t)row << (log2_cpr + 4)) + (((ch & ~15) | ((ch ^ row) & 15)) << 4));
}
__device__ __forceinline__ void dsa_prep_kv(const Params& p, const unsigned char* wl, int tile, int lane) {
    const bf16* PROJ = (const bf16*)(p.ws + WS_PROJ); bf16* CKV = (bf16*)(p.ws + WS_CKV); float* INVR = (float*)(p.ws + WS_INVR);
    const int r = lane & 31, hh = lane >> 5; const size_t row = (size_t)tile * 32 + r; const bf16* prow = PROJ + row * NPROJ;
    bf16x8 cf[8];
    {   u32x4 craw[8]; float ssq = 0.f;
#pragma unroll
        for (int s = 0; s < 8; ++s) { craw[s] = *(const u32x4*)(prow + PC_CL + 16 * s + 8 * hh);
#pragma unroll
            for (int w = 0; w < 4; ++w) { const float lo = bflo(craw[s][w]), hi = bfhi(craw[s][w]); ssq += lo * lo + hi * hi; } }
        ssq += __shfl_xor(ssq, 32);
        const float rstd = rsqrtf(ssq * (1.f / 128.f) + 1e-6f);
#pragma unroll
        for (int s = 0; s < 8; ++s) { const float* g = p.g_kv + 16 * s + 8 * hh; const f32x4 g0 = *(const f32x4*)g, g1 = *(const f32x4*)(g + 4);
            u32x4 o; o.x = pk2(bflo(craw[s].x) * rstd * g0.x, bfhi(craw[s].x) * rstd * g0.y); o.y = pk2(bflo(craw[s].y) * rstd * g0.z, bfhi(craw[s].y) * rstd * g0.w);
            o.z = pk2(bflo(craw[s].z) * rstd * g1.x, bfhi(craw[s].z) * rstd * g1.y); o.w = pk2(bflo(craw[s].w) * rstd * g1.z, bfhi(craw[s].w) * rstd * g1.w);
            cf[s] = __builtin_bit_cast(bf16x8, o); *(u32x4*)(CKV + row * 128 + 16 * s + 8 * hh) = o; }
    }
    unsigned wb[8];
#pragma unroll
    for (int s = 0; s < 8; ++s) wb[s] = (unsigned)(r * 256 + ((((2 * s + hh) ^ r) & 15) << 4));
#pragma unroll 1
    for (int h = 0; h < 8; ++h) { float ss = 0.f;
#pragma unroll
        for (int dt = 0; dt < 2; ++dt) { f32x16 acc = {}; const unsigned char* wg = wl + (h * 64 + dt * 32) * 256;
#pragma unroll
            for (int s = 0; s < 8; ++s) acc = mfma32(*(const bf16x8*)(wg + wb[s]), cf[s], acc);
#pragma unroll
            for (int i = 0; i < 16; ++i) ss += acc[i] * acc[i]; }
        ss += __shfl_xor(ss, 32);
        if (hh == 0) INVR[row * 8 + h] = rsqrtf(ss * (1.f / 64.f) + 1e-6f);
    }
}
__device__ __forceinline__ void dsa_prep_q(const Params& p, const unsigned char* wl, int tile, int lane) {
    const bf16* PROJ = (const bf16*)(p.ws + WS_PROJ); bf16* QABS = (bf16*)(p.ws + WS_REGA);
    const int r = lane & 31, hh = lane >> 5; const size_t row = (size_t)tile * 32 + r; const bf16* prow = PROJ + row * NPROJ;
    unsigned wb[2][4];
#pragma unroll
    for (int hp = 0; hp < 2; ++hp)
#pragma unroll
        for (int s = 0; s < 4; ++s) wb[hp][s] = (unsigned)(r * 1024 + ((((hp * 8 + 2 * s + hh) ^ r) & 15) << 4));
#pragma unroll 2
    for (int h = 0; h < 8; ++h) {
        u32x4 qraw[4]; float ssq = 0.f;
#pragma unroll
        for (int s = 0; s < 4; ++s) { qraw[s] = *(const u32x4*)(prow + PC_Q + h * 64 + 16 * s + 8 * hh);
#pragma unroll
            for (int w = 0; w < 4; ++w) { const float lo = bflo(qraw[s][w]), hi = bfhi(qraw[s][w]); ssq += lo * lo + hi * hi; } }
        ssq += __shfl_xor(ssq, 32);
        const float rstd = rsqrtf(ssq * (1.f / 64.f) + 1e-6f);
        bf16x8 qf[4];
#pragma unroll
        for (int s = 0; s < 4; ++s) { const int d0 = 16 * s + 8 * hh; float gg[8];
#pragma unroll
            for (int j = 0; j < 8; ++j) gg[j] = p.g_q[d0 + j] * p.g_k[d0 + j] * rstd;
            u32x4 o; o.x = pk2(bflo(qraw[s].x) * gg[0], bfhi(qraw[s].x) * gg[1]); o.y = pk2(bflo(qraw[s].y) * gg[2], bfhi(qraw[s].y) * gg[3]);
            o.z = pk2(bflo(qraw[s].z) * gg[4], bfhi(qraw[s].z) * gg[5]); o.w = pk2(bflo(qraw[s].w) * gg[6], bfhi(qraw[s].w) * gg[7]);
            qf[s] = __builtin_bit_cast(bf16x8, o); }
#pragma unroll
        for (int lt = 0; lt < 4; ++lt) { f32x16 acc = {}; const unsigned char* wg = wl + lt * 32768 + (h >> 1) * 256;
#pragma unroll
            for (int s = 0; s < 4; ++s) acc = mfma32(*(const bf16x8*)(wg + wb[h & 1][s]), qf[s], acc);
#pragma unroll
            for (int g4 = 0; g4 < 4; ++g4) { u32x2 o; o.x = pk2(acc[4 * g4] * 0.125f, acc[4 * g4 + 1] * 0.125f); o.y = pk2(acc[4 * g4 + 2] * 0.125f, acc[4 * g4 + 3] * 0.125f);
                *(u32x2*)(QABS + row * 1024 + h * 128 + lt * 32 + 8 * g4 + 4 * hh) = o; } }
    }
}

constexpr int SCAN_D = 8, SCAN_SLOT = 12288 + 256;
#define SCAN_BAR() do { asm volatile("s_waitcnt lgkmcnt(0)" ::: "memory"); __builtin_amdgcn_s_barrier(); asm volatile("" ::: "memory"); } while (0)
__device__ __forceinline__ void rwkv_scan_chain(const Params& p, unsigned char* lds, int chain, int wv, int lane) {
    const int b = chain >> 3, h = chain & 7;
    const size_t idx0 = (size_t)(b * 8 + h) * 128;
    if (wv >= 4) {
        const int li = (wv - 4) * 64 + lane;
        const unsigned char* src = p.ws + WS_CH + idx0 * 12288 + (size_t)li * 16; const float* gsrc = (const float*)(p.ws + WS_GAM) + idx0 * 64 + (li & 15) * 4;
        const int d0 = (li >> 3) * 128 + ((((li & 7) ^ ((li >> 4) & 7))) << 4);
        u32x4 R[SCAN_D][3]; f32x4 Rg[SCAN_D];
#pragma unroll
        for (int j = 0; j < SCAN_D; ++j) {
#pragma unroll
            for (int i = 0; i < 3; ++i) R[j][i] = *(const u32x4*)(src + (size_t)j * 12288 + i * 4096);
            Rg[j] = *(const f32x4*)(gsrc + (size_t)j * 64); }
        for (int k0 = 0; k0 < 128; k0 += SCAN_D) {
#pragma unroll
            for (int j = 0; j < SCAN_D; ++j) { const int k = k0 + j; unsigned char* slot = lds + (k & 1) * SCAN_SLOT;
                *(u32x4*)(slot + d0) = R[j][0];
#pragma unroll
                for (int i = 1; i < 3; ++i) *(u32x4*)(slot + li * 16 + i * 4096) = R[j][i];
                *(f32x4*)(slot + 12288 + (li & 15) * 16) = Rg[j];
                if (k + SCAN_D < 128) {
#pragma unroll
                    for (int i = 0; i < 3; ++i) R[j][i] = *(const u32x4*)(src + (size_t)(k + SCAN_D) * 12288 + i * 4096);
                    Rg[j] = *(const f32x4*)(gsrc + (size_t)(k + SCAN_D) * 64); }
                SCAN_BAR(); } }
        SCAN_BAR();
    } else {
        const int w = wv, n = lane & 15, grp = lane >> 4;
        bf16* PROJ = (bf16*)(p.ws + WS_PROJ);
        f32x4 S[4];
#pragma unroll
        for (int jt = 0; jt < 4; ++jt) S[jt] = (f32x4){0.f, 0.f, 0.f, 0.f};
        int aoffs[4];
#pragma unroll
        for (int jt = 0; jt < 4; ++jt) aoffs[jt] = n * 128 + ((((2 * jt + (grp >> 1)) ^ ((n >> 1) & 7))) << 4) + 8 * (grp & 1);
        s16x4 at[4], rt[4], bt[4], kt[4], vt, Tm, Mak, Nrb, Nrk; f32x4 gm[4];
#define SCAN_LDF(slot_) do { const unsigned char* CHp = lds + (slot_) * SCAN_SLOT; \
        _Pragma("unroll") for (int jt = 0; jt < 4; ++jt) { at[jt] = *(const s16x4*)(CHp + aoffs[jt]); rt[jt] = *(const s16x4*)(CHp + 2048 + aoffs[jt]); \
            bt[jt] = *(const s16x4*)(CHp + 4096 + (16 * jt + n) * 32 + grp * 8); kt[jt] = *(const s16x4*)(CHp + 6144 + (16 * jt + n) * 32 + grp * 8); \
            gm[jt] = *(const f32x4*)(CHp + 12288 + (16 * jt + 4 * grp) * 4); } \
        vt = *(const s16x4*)(CHp + 8192 + (16 * w + n) * 32 + grp * 8); Tm = *(const s16x4*)(CHp + 10240 + n * 32 + grp * 8); Mak = *(const s16x4*)(CHp + 10752 + n * 32 + grp * 8); \
        Nrb = *(const s16x4*)(CHp + 11264 + n * 32 + grp * 8); Nrk = *(const s16x4*)(CHp + 11776 + n * 32 + grp * 8); } while (0)
        SCAN_BAR();
        SCAN_LDF(0);
        for (int sc = 0; sc < 128; ++sc) {
            s16x4 at_[4], rt_[4], bt_[4], kt_[4]; f32x4 gm_[4];
#pragma unroll
            for (int jt = 0; jt < 4; ++jt) { at_[jt] = at[jt]; rt_[jt] = rt[jt]; bt_[jt] = bt[jt]; kt_[jt] = kt[jt]; gm_[jt] = gm[jt]; }
            const s16x4 vt_ = vt, Tm_ = Tm, Mak_ = Mak, Nrb_ = Nrb, Nrk_ = Nrk;
            SCAN_BAR();
            if (sc + 1 < 128) SCAN_LDF((sc + 1) & 1);
            s16x4 Sb[4];
#pragma unroll
            for (int jt = 0; jt < 4; ++jt) Sb[jt] = pack4(S[jt]);
            f32x4 X = {0.f, 0.f, 0.f, 0.f}, O = X;
#pragma unroll
            for (int jt = 0; jt < 4; ++jt) X = mfma16k(at_[jt], Sb[jt], X);
            X = mfma16k(Mak_, vt_, X);
#pragma unroll
            for (int jt = 0; jt < 4; ++jt) O = mfma16k(rt_[jt], Sb[jt], O);
            O = mfma16k(Nrk_, vt_, O);
            const f32x4 U = mfma16k(Tm_, pack4(X), (f32x4){0.f, 0.f, 0.f, 0.f});
            const s16x4 Ub = pack4(U);
            O = mfma16k(Nrb_, Ub, O);
#pragma unroll
            for (int jt = 0; jt < 4; ++jt) { S[jt] = mfma16k(kt_[jt], vt_, S[jt]); S[jt] = mfma16k(bt_[jt], Ub, S[jt]); S[jt] = S[jt] * gm_[jt]; }
            bf16* orow = PROJ + ((size_t)b * SEQ + sc * 16 + 4 * grp) * NPROJ + PC_R + h * 64 + 16 * w + n;
#pragma unroll
            for (int rg = 0; rg < 4; ++rg) orow[(size_t)rg * NPROJ] = f2bf(O[rg]);
        }
#undef SCAN_LDF
    }
}
__device__ __forceinline__ void rwkv_epi_rows(const Params& p, int gw, int NGW, int lane) {
    bf16* PROJ = (bf16*)(p.ws + WS_PROJ); const bf16* GB = (const bf16*)(p.ws + WS_G); const float* C3 = (const float*)(p.ws + WS_C3);
    const int c0 = lane * 8, h = lane >> 3, RPW = M / NGW;
    float muv[8], lw[8], lb[8];
#pragma unroll
    for (int i = 0; i < 8; ++i) { muv[i] = p.mu[1024 + c0 + i]; lw[i] = p.ln_w[c0 + i]; lb[i] = p.ln_b[c0 + i]; }
    for (int m0 = gw * RPW; m0 < M; m0 += NGW * RPW) {
        u32x4 vprev = {0u, 0u, 0u, 0u}; if ((m0 & (SEQ - 1)) != 0) vprev = *(const u32x4*)(PROJ + (size_t)(m0 - 1) * NPROJ + PC_V + c0);
        for (int r0 = 0; r0 < RPW; r0 += 4) {
            u32x4 oraw[4], vc[4], gr[4]; float c3[4];
#pragma unroll
            for (int r = 0; r < 4; ++r) { const size_t m = (size_t)(m0 + r0 + r); const bf16* prow = PROJ + m * NPROJ;
                oraw[r] = *(const u32x4*)(prow + PC_R + c0); vc[r] = *(const u32x4*)(prow + PC_V + c0); gr[r] = *(const u32x4*)(GB + m * 512 + c0); c3[r] = C3[m * 8 + h]; }
            float o[4][8], sm[4], q[4];
#pragma unroll
            for (int r = 0; r < 4; ++r) { sm[r] = 0.f;
#pragma unroll
                for (int i = 0; i < 4; ++i) { o[r][2 * i] = bflo(oraw[r][i]); o[r][2 * i + 1] = bfhi(oraw[r][i]); sm[r] += o[r][2 * i] + o[r][2 * i + 1]; } }
#pragma unroll
            for (int of = 1; of < 8; of <<= 1) {
#pragma unroll
                for (int r = 0; r < 4; ++r) sm[r] += __shfl_xor(sm[r], of); }
#pragma unroll
            for (int r = 0; r < 4; ++r) { const float mean = sm[r] * (1.f / 64.f); q[r] = 0.f;
#pragma unroll
                for (int i = 0; i < 8; ++i) { o[r][i] -= mean; q[r] += o[r][i] * o[r][i]; } }
#pragma unroll
            for (int of = 1; of < 8; of <<= 1) {
#pragma unroll
                for (int r = 0; r < 4; ++r) q[r] += __shfl_xor(q[r], of); }
#pragma unroll
            for (int r = 0; r < 4; ++r) { const float rstd = rsqrtf(q[r] * (1.f / 64.f) + 64e-5f); const u32x4 vp = r == 0 ? vprev : vc[r - 1];
                const bool first = ((m0 + r0 + r) & (SEQ - 1)) == 0;
                u32x4 out; float y8[8];
#pragma unroll
                for (int i = 0; i < 4; ++i) { float y[2];
#pragma unroll
                    for (int e = 0; e < 2; ++e) { const int ii = 2 * i + e; const float cv = e ? bfhi(vc[r][i]) : bflo(vc[r][i]), pv = first ? 0.f : (e ? bfhi(vp[i]) : bflo(vp[i]));
                        const float v = cv + muv[ii] * (pv - cv), g = e ? bfhi(gr[r][i]) : bflo(gr[r][i]);
                        y[e] = (o[r][ii] * rstd * lw[ii] + lb[ii] + c3[r] * v) * g; }
                    out[i] = pk2(y[0], y[1]);
#if MK_F8_GOUT
                    y8[2 * i] = y[0] * 8.f; y8[2 * i + 1] = y[1] * 8.f;
#endif
                }
#if MK_F8_GOUT
                *(u32x2*)((unsigned char*)(PROJ + (size_t)(m0 + r0 + r) * NPROJ) + 512 + c0) = (u32x2){pg8::pk4_fp8(y8[0], y8[1], y8[2], y8[3]), pg8::pk4_fp8(y8[4], y8[5], y8[6], y8[7])};
#else
                *(u32x4*)(PROJ + (size_t)(m0 + r0 + r) * NPROJ + PC_R + c0) = out;
#endif
            }
            vprev = vc[3];
        }
    }
}

__device__ __forceinline__ unsigned f2key(float f) { unsigned b = __float_as_uint(f); if ((b << 1) == 0u) b = 0u; return (b & 0x80000000u) ? ~b : (b | 0x80000000u); }
__device__ __forceinline__ unsigned offb(unsigned row, unsigned ch) { return 2048u * (row >> 3) + 512u * (ch >> 2) + 64u * (row & 7) + 16u * ((ch & 3) ^ ((row >> 2) & 3)); }

__device__ __forceinline__ void topk_select(float* sc, int N, unsigned* hist, unsigned short* sel, int lane) {
    unsigned* kb = (unsigned*)sc;
    unsigned prefix = 0u, mask = 0u; int rem = 256, mbin = 0;
    const unsigned long long lt_mask = (1ull << lane) - 1ull;
    for (int pass = 0; pass < 4; ++pass) {
        const int shift = 24 - 8 * pass;
#pragma unroll
        for (int i = 0; i < 4; ++i) hist[lane * 4 + i] = 0u;
        asm volatile("s_waitcnt lgkmcnt(0)" ::: "memory");
        for (int base = 0; base < N; base += 256) { const int idx = base + 4 * lane;
            if (idx < N) { u32x4 k4;
                if (pass == 0) { const f32x4 v = *(const f32x4*)(sc + idx); k4 = (u32x4){f2key(v.x), f2key(v.y), f2key(v.z), f2key(v.w)}; *(u32x4*)(kb + idx) = k4; }
                else k4 = *(const u32x4*)(kb + idx);
#pragma unroll
                for (int e = 0; e < 4; ++e) if ((k4[e] & mask) == prefix) atomicAdd(&hist[(k4[e] >> shift) & 255u], 1u); } }
        asm volatile("s_waitcnt lgkmcnt(0)" ::: "memory");
        const unsigned c0 = hist[lane * 4], c1 = hist[lane * 4 + 1], c2 = hist[lane * 4 + 2], c3 = hist[lane * 4 + 3];
        const int cnt4 = (int)(c0 + c1 + c2 + c3);
        int incl = cnt4;
#pragma unroll
        for (int o = 1; o < 64; o <<= 1) { const int v = __shfl_down(incl, o); if (lane + o < 64) incl += v; }
        const int excl = incl - cnt4;
        const bool mine = (excl < rem) && (rem <= incl);
        const unsigned long long bal = __ballot(mine);
        const int L = (int)__builtin_ctzll(bal);
        const int ex = __shfl(excl, L); const int b3 = (int)__shfl((int)c3, L), b2 = (int)__shfl((int)c2, L), b1 = (int)__shfl((int)c1, L), b0 = (int)__shfl((int)c0, L);
        int above = ex, bin;
        if (above + b3 >= rem) { bin = 3; mbin = b3; } else { above += b3; if (above + b2 >= rem) { bin = 2; mbin = b2; } else { above += b2; if (above + b1 >= rem) { bin = 1; mbin = b1; } else { above += b1; bin = 0; mbin = b0; } } }
        rem -= above; prefix |= (unsigned)(L * 4 + bin) << shift; mask |= 0xffu << shift;
        if (pass == 1 && mbin <= 64) break;
    }
    const unsigned T = prefix; const int ngt = 256 - rem; int base_gt = 0, base_eq = 0;
    const bool partial = (mask != 0xffffffffu);
    unsigned short* cand = (unsigned short*)hist;
    for (int base = 0; base < N; base += 256) { const int idx = base + 4 * lane; const bool act = idx < N;
        u32x4 k4 = {0u, 0u, 0u, 0u}; if (act) k4 = *(const u32x4*)(kb + idx);
        bool gt[4], eq[4]; unsigned long long bg[4], be[4];
#pragma unroll
        for (int e = 0; e < 4; ++e) { const unsigned km = k4[e] & mask; gt[e] = act && km > T; eq[e] = act && km == T; bg[e] = __ballot(gt[e]); be[e] = __ballot(eq[e]); }
        int rg = base_gt, re = base_eq;
#pragma unroll
        for (int e = 0; e < 4; ++e) re += __popcll(be[e] & lt_mask);
#pragma unroll
        for (int e = 0; e < 4; ++e) {
            if (gt[e]) sel[rg + __popcll(bg[e] & lt_mask)] = (unsigned short)(idx + e);
            rg += __popcll(bg[e]);
            if (eq[e]) { if (partial) cand[re] = (unsigned short)(idx + e); else if (re < rem) sel[ngt + re] = (unsigned short)(idx + e); re += 1; } }
        base_gt = rg;
#pragma unroll
        for (int e = 0; e < 4; ++e) base_eq += __popcll(be[e]); }
    asm volatile("s_waitcnt lgkmcnt(0)" ::: "memory");
    if (partial) {
        const int m = mbin; const int ci = (lane < m) ? (int)cand[lane] : 0; const unsigned ck = (lane < m) ? kb[ci] : 0u;
        int rank = 0;
        for (int j = 0; j < m; ++j) { const unsigned kj = (unsigned)__shfl((int)ck, j); rank += (kj > ck || (kj == ck && j < lane)) ? 1 : 0; }
        if (lane < m && rank < rem) sel[ngt + rank] = (unsigned short)ci;
        asm volatile("s_waitcnt lgkmcnt(0)" ::: "memory");
    }
}

__device__ __forceinline__ float dpp_row_max16(float x) {
    x = fmaxf(x, __builtin_bit_cast(float, __builtin_amdgcn_mov_dpp(__builtin_bit_cast(int, x), 0xB1, 0xF, 0xF, true)));
    x = fmaxf(x, __builtin_bit_cast(float, __builtin_amdgcn_mov_dpp(__builtin_bit_cast(int, x), 0x4E, 0xF, 0xF, true)));
    x = fmaxf(x, __builtin_bit_cast(float, __builtin_amdgcn_mov_dpp(__builtin_bit_cast(int, x), 0x141, 0xF, 0xF, true)));
    x = fmaxf(x, __builtin_bit_cast(float, __builtin_amdgcn_mov_dpp(__builtin_bit_cast(int, x), 0x140, 0xF, 0xF, true)));
    return x;
}
__device__ __forceinline__ bool topk_select_fast(const float* sc, int N, float smax, unsigned* hist, unsigned short* sel, int lane) {
    const float scale = smax > 0.f ? 127.5f / smax : 0.f;
#define QBIN(x_) min(max((int)fmaf((x_), scale, 128.f), 0), 255)
#pragma unroll
    for (int i = 0; i < 4; ++i) hist[lane * 4 + i] = 0u;
    asm volatile("s_waitcnt lgkmcnt(0)" ::: "memory");
    for (int base = 0; base < N; base += 256) { const int idx = base + 4 * lane;
        if (idx < N) { const f32x4 v = *(const f32x4*)(sc + idx);
#pragma unroll
            for (int e = 0; e < 4; ++e) atomicAdd(&hist[QBIN(v[e])], 1u); } }
    asm volatile("s_waitcnt lgkmcnt(0)" ::: "memory");
    const unsigned c0 = hist[lane * 4], c1 = hist[lane * 4 + 1], c2 = hist[lane * 4 + 2], c3 = hist[lane * 4 + 3];
    const int cnt4 = (int)(c0 + c1 + c2 + c3);
    int incl = cnt4;
#pragma unroll
    for (int o = 1; o < 64; o <<= 1) { const int v = __shfl_down(incl, o); if (lane + o < 64) incl += v; }
    const int excl = incl - cnt4;
    const bool mine = (excl < 256) && (256 <= incl);
    const int L = (int)__builtin_ctzll(__ballot(mine));
    const int ex = __shfl(excl, L); const int b3 = (int)__shfl((int)c3, L), b2 = (int)__shfl((int)c2, L), b1 = (int)__shfl((int)c1, L), b0 = (int)__shfl((int)c0, L);
    int above = ex, bin, mbin;
    if (above + b3 >= 256) { bin = 3; mbin = b3; } else { above += b3; if (above + b2 >= 256) { bin = 2; mbin = b2; } else { above += b2; if (above + b1 >= 256) { bin = 1; mbin = b1; } else { above += b1; bin = 0; mbin = b0; } } }
    if (mbin > 64) return false;
    const int tb = L * 4 + bin, rem = 256 - above, ngt = above; int base_gt = 0, base_eq = 0;
    const unsigned long long lt_mask = (1ull << lane) - 1ull;
    unsigned short* cand = (unsigned short*)hist;
    for (int base = 0; base < N; base += 256) { const int idx = base + 4 * lane; const bool act = idx < N;
        f32x4 v = {0.f, 0.f, 0.f, 0.f}; if (act) v = *(const f32x4*)(sc + idx);
        bool gt[4], eq[4]; unsigned long long bg[4], be[4];
#pragma unroll
        for (int e = 0; e < 4; ++e) { const int qb = QBIN(v[e]); gt[e] = act && qb > tb; eq[e] = act && qb == tb; bg[e] = __ballot(gt[e]); be[e] = __ballot(eq[e]); }
        int rg = base_gt, re = base_eq;
#pragma unroll
        for (int e = 0; e < 4; ++e) re += __popcll(be[e] & lt_mask);
#pragma unroll
        for (int e = 0; e < 4; ++e) {
            if (gt[e]) sel[rg + __popcll(bg[e] & lt_mask)] = (unsigned short)(idx + e);
            rg += __popcll(bg[e]);
            if (eq[e]) { cand[re] = (unsigned short)(idx + e); re += 1; } }
        base_gt = rg;
#pragma unroll
        for (int e = 0; e < 4; ++e) base_eq += __popcll(be[e]); }
    asm volatile("s_waitcnt lgkmcnt(0)" ::: "memory");
    {   const int m = mbin; const int ci = (lane < m) ? (int)cand[lane] : 0; const unsigned ck = (lane < m) ? f2key(sc[ci]) : 0u;
        int rank = 0;
        for (int j = 0; j < m; ++j) { const unsigned kj = (unsigned)__shfl((int)ck, j); rank += (kj > ck || (kj == ck && j < lane)) ? 1 : 0; }
        if (lane < m && rank < rem) sel[ngt + rank] = (unsigned short)ci;
        asm volatile("s_waitcnt lgkmcnt(0)" ::: "memory"); }
#undef QBIN
    return true;
}

__device__ __forceinline__ void dsa_attend(const Params& p, int b, int t, const unsigned short* sel, int cnt, unsigned char* stage, int lane_in) {
    int lane = lane_in; asm volatile("" : "+v"(lane));
    const bf16* CKV = (const bf16*)(p.ws + WS_CKV) + (size_t)b * SEQ * 128; const float* INVR = (const float*)(p.ws + WS_INVR) + (size_t)b * SEQ * 8;
    bf16* QO = (bf16*)(p.ws + WS_REGA) + ((size_t)b * SEQ + t) * 1024;
    const int hd = lane & 15, grp = lane >> 4;
    bf16x8 bq[4];
#pragma unroll
    for (int s = 0; s < 4; ++s) { u32x4 z = {0u, 0u, 0u, 0u}; if (hd < 8) z = *(const u32x4*)(QO + hd * 128 + 32 * s + 8 * grp); bq[s] = __builtin_bit_cast(bf16x8, z); }
    const float slope = (hd < 8) ? exp2f(-(float)(hd + 1)) : 0.f;
    const int hsafe = hd & 7;
    float m_run = -INFINITY, l_part = 0.f;
    f32x4 O[8];
#pragma unroll
    for (int c = 0; c < 8; ++c) O[c] = (f32x4){0.f, 0.f, 0.f, 0.f};
    const LAS unsigned char* st3 = (const LAS unsigned char*)stage;
    const unsigned q4 = (lane & 15) >> 2, p4 = lane & 3;
    u32x4 G[8]; float IRn[8], PNn[8];
#define DA_ISSUE(ks_) do { \
    _Pragma("unroll") for (int i = 0; i < 8; ++i) { const int id = i * 64 + lane, row = id >> 4, ch = id & 15; const unsigned key = sel[(ks_) + row]; G[i] = *(const u32x4*)((const unsigned char*)CKV + (key * 256u + (unsigned)ch * 16u)); } } while (0)
#define DA_ISSUE2(ks_) do { \
    _Pragma("unroll") for (int i = 0; i < 8; ++i) { const int key = sel[(ks_) + 16 * (i >> 2) + 4 * grp + (i & 3)]; IRn[i] = *(const float*)((const unsigned char*)INVR + ((unsigned)key * 32u + (unsigned)hsafe * 4u)); PNn[i] = slope * fabsf((float)(t - key)); } } while (0)
    DA_ISSUE(cnt - 32); DA_ISSUE2(cnt - 32);
    for (int ks = cnt - 32; ks >= 0; ks -= 32) {
#pragma unroll
        for (int i = 0; i < 8; ++i) { const int id = i * 64 + lane, row = id >> 4, ch = id & 15; *(u32x4*)(stage + offb(row, ch)) = G[i]; }
        asm volatile("s_waitcnt lgkmcnt(0)" ::: "memory");
        if (ks >= 32) DA_ISSUE(ks - 32);
        float lg[8];
#pragma unroll
        for (int T = 0; T < 2; ++T) { f32x4 acc = {0.f, 0.f, 0.f, 0.f};
#pragma unroll
            for (int s = 0; s < 4; ++s) { const bf16x8 a = *(const bf16x8*)(stage + offb((lane & 15) + 16 * T, 4 * s + grp)); acc = mfma16(a, bq[s], acc); }
#pragma unroll
            for (int rg = 0; rg < 4; ++rg) lg[4 * T + rg] = acc[rg] * IRn[4 * T + rg] - PNn[4 * T + rg]; }
        if (ks >= 32) DA_ISSUE2(ks - 32);
        float mx = lg[0];
#pragma unroll
        for (int i = 1; i < 8; ++i) mx = fmaxf(mx, lg[i]);
        mx = fmaxf(mx, __shfl_xor(mx, 16)); mx = fmaxf(mx, __shfl_xor(mx, 32));
        const float m_new = fmaxf(m_run, mx);
        const float alpha = __expf(m_run - m_new);
        float ps = 0.f;
#pragma unroll
        for (int i = 0; i < 8; ++i) { lg[i] = __expf(lg[i] - m_new); ps += lg[i]; }
        l_part = l_part * alpha + ps; m_run = m_new;
        { float ar[4];
#pragma unroll
            for (int rg = 0; rg < 4; ++rg) ar[rg] = __shfl(alpha, 4 * grp + rg);
#pragma unroll
            for (int c = 0; c < 8; ++c)
#pragma unroll
                for (int rg = 0; rg < 4; ++rg) O[c][rg] *= ar[rg]; }
        {   u32x4 pw; pw.x = pk2(lg[0], lg[1]); pw.y = pk2(lg[2], lg[3]); pw.z = pk2(lg[4], lg[5]); pw.w = pk2(lg[6], lg[7]);
            const bf16x8 pa = __builtin_bit_cast(bf16x8, pw);
#pragma unroll
            for (int c = 0; c < 8; ++c) {
                const s16x4 lo = __builtin_bit_cast(s16x4, __builtin_amdgcn_ds_read_tr16_b64_v4i16((LAS s16x4*)(st3 + offb(4 * grp + q4, 2 * c + (p4 >> 1)) + 8 * (p4 & 1))));
                const s16x4 hi = __builtin_bit_cast(s16x4, __builtin_amdgcn_ds_read_tr16_b64_v4i16((LAS s16x4*)(st3 + offb(16 + 4 * grp + q4, 2 * c + (p4 >> 1)) + 8 * (p4 & 1))));
                const bf16x8 vb = {lo[0], lo[1], lo[2], lo[3], hi[0], hi[1], hi[2], hi[3]};
                O[c] = mfma16(pa, vb, O[c]); } }
        asm volatile("s_waitcnt lgkmcnt(0)" ::: "memory");
    }
#undef DA_ISSUE
#undef DA_ISSUE2
    float l = l_part; l += __shfl_xor(l, 16); l += __shfl_xor(l, 32);
    const float il = 1.f / l;
    float irr[4];
#pragma unroll
    for (int rg = 0; rg < 4; ++rg) irr[rg] = __shfl(il, 4 * grp + rg);
    if (grp < 2) {
#pragma unroll
        for (int rg = 0; rg < 4; ++rg)
#pragma unroll
            for (int c = 0; c < 8; ++c) QO[(4 * grp + rg) * 128 + 16 * c + hd] = f2bf(O[c][rg] * irr[rg]);
    }
}

#define DSA_LOAD_AF(af_, wqv_, b_, tq0_) do { const size_t rq_ = (size_t)(b_) * SEQ + (tq0_); const int r_ = lane & 31, g_ = lane >> 5, ql_ = 2 * ((r_ >> 2) & 1) + (r_ >> 4), hdm_ = 4 * ((r_ >> 3) & 1) + (r_ & 3); \
    _Pragma("unroll") for (int qg = 0; qg < 4; ++qg) _Pragma("unroll") for (int s = 0; s < 4; ++s) af_[qg][s] = *(const bf16x8*)(PROJ + (rq_ + 4 * qg + ql_) * NPROJ + PC_QI + hdm_ * 64 + 16 * s + 8 * g_); \
    wqv_ = (tid < 128) ? bf2f(PROJ[(rq_ + (tid >> 3)) * NPROJ + PC_WI + (tid & 7)]) * 0.044194173824159216f : 0.f; } while (0)
__device__ __forceinline__ void dsa_select_item(const Params& p, unsigned char* lds, int b, int tq0, int tid, bf16x8 (&af)[4][4], float& wqv, bool has_next, int nb, int ntq0) {
    bf16* PROJ = (bf16*)(p.ws + WS_PROJ);
    float* SC = (float*)lds;
    unsigned* HIST = (unsigned*)(lds + 131072);
    unsigned short* SEL = (unsigned short*)(lds + 131072 + 8192);
    float* WQ = (float*)(lds + 147456);
    unsigned* QMAX = (unsigned*)(lds + 147456 + 512);
    asm volatile("" : "+v"(tid));
    const int lane = tid & 63, wv = __builtin_amdgcn_readfirstlane(tid >> 6);
    const int N = ((tq0 >> 6) + 1) * 64; const size_t rowq0 = (size_t)b * SEQ + tq0;
    {
        const int r = lane & 31, g = lane >> 5;
        if (tid < 128) WQ[tid] = wqv;
        if (tid < 16) QMAX[tid] = 0u;
        float mxq[4][2];
#pragma unroll
        for (int qg = 0; qg < 4; ++qg) { mxq[qg][0] = 0.f; mxq[qg][1] = 0.f; }
        __syncthreads();
        bf16x8 bfr[4];
        { const bf16* krow = PROJ + ((size_t)b * SEQ + wv * 32 + r) * NPROJ + PC_KI + 8 * g;
#pragma unroll
          for (int s = 0; s < 4; ++s) bfr[s] = *(const bf16x8*)(krow + 16 * s); }
        for (int kt = wv; kt < N / 32; kt += NWAVES) {
            const int key = kt * 32 + r;
            bf16x8 bnx[4];
#pragma unroll
            for (int s = 0; s < 4; ++s) bnx[s] = bfr[s];
            if (kt + NWAVES < N / 32) { const bf16* krow = PROJ + ((size_t)b * SEQ + key + 32 * NWAVES) * NPROJ + PC_KI + 8 * g;
#pragma unroll
                for (int s = 0; s < 4; ++s) bnx[s] = *(const bf16x8*)(krow + 16 * s); }
#pragma unroll
            for (int qg = 0; qg < 4; ++qg) { f32x16 acc = {};
#pragma unroll
                for (int s = 0; s < 4; ++s) acc = mfma32(af[qg][s], bfr[s], acc);
#pragma unroll
                for (int qq = 0; qq < 2; ++qq) { float sc = 0.f; const f32x4 w0 = *(const f32x4*)(WQ + (4 * qg + 2 * g + qq) * 8), w1 = *(const f32x4*)(WQ + (4 * qg + 2 * g + qq) * 8 + 4);
#pragma unroll
                    for (int e = 0; e < 4; ++e) { sc = fmaf(w0[e], fmaxf(acc[8 * qq + e], 0.f), sc); sc = fmaf(w1[e], fmaxf(acc[8 * qq + 4 + e], 0.f), sc); }
                    SC[(4 * qg + 2 * g + qq) * 2048 + key] = sc; mxq[qg][qq] = fmaxf(mxq[qg][qq], fabsf(sc)); } }
#pragma unroll
            for (int s = 0; s < 4; ++s) bfr[s] = bnx[s];
        }
#pragma unroll
        for (int qg = 0; qg < 4; ++qg)
#pragma unroll
            for (int qq = 0; qq < 2; ++qq) { float m = dpp_row_max16(mxq[qg][qq]); m = fmaxf(m, __shfl_xor(m, 16));
                if (r == 0) atomicMax(&QMAX[4 * qg + 2 * g + qq], __float_as_uint(m)); }
        __syncthreads();
        if (has_next) DSA_LOAD_AF(af, wqv, nb, ntq0);
        bool fb[2];
        for (int q = 0; q < 2; ++q) fb[q] = !topk_select_fast(SC + (2 * wv + q) * 2048, N, __uint_as_float(QMAX[2 * wv + q]), HIST + wv * 256, SEL + (2 * wv + q) * 256, lane);
        for (int q = 0; q < 2; ++q) if (fb[q]) topk_select(SC + (2 * wv + q) * 2048, N, HIST + wv * 256, SEL + (2 * wv + q) * 256, lane);
    }
    asm volatile("s_waitcnt lgkmcnt(0)" ::: "memory");
    { const int q = lane >> 5; const u32x4 v = *(const u32x4*)(SEL + (2 * wv + q) * 256 + (lane & 31) * 8);
      *(u32x4*)(PROJ + (rowq0 + 2 * wv + q) * NPROJ + PC_Q + (lane & 31) * 8) = v; }
    __syncthreads();
}

__device__ __forceinline__ void dsa_attend_row(const Params& p, unsigned char* wlds, int row, int lane) {
    const bf16* PROJ = (const bf16*)(p.ws + WS_PROJ);
    const int b = row >> 11, t = row & (SEQ - 1), N = ((t >> 6) + 1) * 64, cnt = N > 256 ? 256 : N;
    unsigned short* SELW = (unsigned short*)(wlds + 8192);
    if (N > 256) { if (lane < 32) *(u32x4*)(SELW + lane * 8) = *(const u32x4*)(PROJ + (size_t)row * NPROJ + PC_Q + lane * 8); }
    else { for (int i = lane; i < cnt; i += 64) SELW[i] = (unsigned short)i; }
    asm volatile("s_waitcnt vmcnt(0) lgkmcnt(0)" ::: "memory");
    dsa_attend(p, b, t, SELW, cnt, wlds, lane);
    asm volatile("s_waitcnt lgkmcnt(0)" ::: "memory");
}

__device__ __forceinline__ void uv_item(const Params& p, const unsigned char* wl  , int tile, int lane) {
    bf16* PROJ = (bf16*)(p.ws + WS_PROJ); const bf16* OLAT = (const bf16*)(p.ws + WS_REGA);
    const int r = lane & 31, hh = lane >> 5; const size_t row = (size_t)tile * 32 + r;
    unsigned wb[8];
#pragma unroll
    for (int s = 0; s < 8; ++s) wb[s] = (unsigned)(r * 256 + ((((2 * s + hh) ^ r) & 15) << 4));
#pragma unroll 1
    for (int h = 0; h < 8; ++h) { bf16x8 of[8];
#pragma unroll
        for (int s = 0; s < 8; ++s) of[s] = *(const bf16x8*)(OLAT + row * 1024 + h * 128 + 16 * s + 8 * hh);
#pragma unroll
        for (int dt = 0; dt < 2; ++dt) { f32x16 acc = {}; const unsigned char* wg = wl + (h * 64 + dt * 32) * 256;
#pragma unroll
            for (int s = 0; s < 8; ++s) acc = mfma32(*(const bf16x8*)(wg + wb[s]), of[s], acc);
#pragma unroll
            for (int g4 = 0; g4 < 4; ++g4) {
#if MK_F8_GOUT
                *(unsigned*)((unsigned char*)(PROJ + row * NPROJ) + h * 64 + dt * 32 + 8 * g4 + 4 * hh) = pg8::pk4_fp8(acc[4 * g4] * 8.f, acc[4 * g4 + 1] * 8.f, acc[4 * g4 + 2] * 8.f, acc[4 * g4 + 3] * 8.f);
#else
                u32x2 o; o.x = pk2(acc[4 * g4], acc[4 * g4 + 1]); o.y = pk2(acc[4 * g4 + 2], acc[4 * g4 + 3]);
                *(u32x2*)(PROJ + row * NPROJ + PC_Q + h * 64 + dt * 32 + 8 * g4 + 4 * hh) = o;
#endif
            } }
    }
}

__device__ __forceinline__ void bias2_item(const Params& p, int item, int lane) {
    const bf16* W1T = (const bf16*)(p.ws + WS_W1); const float* MOD = (const float*)(p.ws + WS_MOD); float* BIAS2 = (float*)(p.ws + WS_BIAS2);
    const int r = lane & 31, hh = lane >> 5, f0 = item * 32;
    const bf16* wrow = W1T + (size_t)(f0 + r) * DM + 8 * hh; const float* srow = MOD + (size_t)r * 6144 + 3072 + 8 * hh;
    f32x16 acc = {};
#pragma unroll 8
    for (int s = 0; s < 64; ++s) { const bf16x8 a = *(const bf16x8*)(wrow + 16 * s); const f32x4 s0 = *(const f32x4*)(srow + 16 * s), s1 = *(const f32x4*)(srow + 16 * s + 4);
        const u32x4 bw = {pk2(s0.x, s0.y), pk2(s0.z, s0.w), pk2(s1.x, s1.y), pk2(s1.z, s1.w)};
        acc = mfma32(a, __builtin_bit_cast(bf16x8, bw), acc); }
#pragma unroll
    for (int i = 0; i < 16; ++i) BIAS2[(size_t)r * 4096 + f0 + (i & 3) + 8 * (i >> 2) + 4 * hh] = acc[i];
}

typedef __attribute__((address_space(1))) unsigned gu32;
#define RLX_AGENT __ATOMIC_RELAXED, __HIP_MEMORY_SCOPE_AGENT
#define XB_TMO      128
#define XB_XCNT(j)  (256  + 64 * (j))
#define XB_XSUB(j)  (1280 + 64 * (j))
#define XB_XGEN(j)  (2304 + 64 * (j))
#define XB_TOP      3328
#define XB_TOPGEN   3392
#define XCD_BAR_WORDS 3456
#define XB_SPIN_CAP (1u << 18)

__device__ __forceinline__ unsigned xb_ld(unsigned* p)              { return __hip_atomic_load(p, __ATOMIC_RELAXED, __HIP_MEMORY_SCOPE_AGENT); }
__device__ __forceinline__ unsigned xb_add(unsigned* p, unsigned v) { return __hip_atomic_fetch_add(p, v, __ATOMIC_RELAXED, __HIP_MEMORY_SCOPE_AGENT); }
__device__ __forceinline__ unsigned xb_xcc_id() { return (unsigned)__builtin_amdgcn_s_getreg((3 << 11) | 20) & 0xFu; }
#define XB_SPIN(cond, bar) do { unsigned _sp = 0; while (cond) { __builtin_amdgcn_s_sleep(1); \
    if ((++_sp & 255u) == 0u) { if (xb_ld(&(bar)[XB_TMO])) break; if (_sp > XB_SPIN_CAP) { atomicAdd(&(bar)[XB_TMO], 1u); break; } } } } while (0)

struct XcdBarrier {
    unsigned* bar; unsigned x;
    volatile LAS unsigned* st;
};

__device__ __forceinline__ XcdBarrier xcd_barrier_post(unsigned* bar, volatile LAS unsigned* st) {
    XcdBarrier b; b.bar = bar; b.x = xb_xcc_id(); b.st = st;
    if (threadIdx.x == 0) (void)xb_add(&bar[XB_XCNT(b.x)], 1u);
    return b;
}
__device__ __forceinline__ void xcd_barrier_complete(unsigned* bar, unsigned x, unsigned& nloc, unsigned& nx) {
    const unsigned G = gridDim.x * gridDim.y * gridDim.z;
    unsigned sum, cnt, mine, sp = 0u;
    for (;;) {
        sum = 0u; cnt = 0u; mine = 0u;
#pragma unroll
        for (unsigned j = 0; j < 16; ++j) { const unsigned c = xb_ld(&bar[XB_XCNT(j)]); sum += c; cnt += (c > 0u) ? 1u : 0u; mine = (j == x) ? c : mine; }
        if (sum == G) break;
        __builtin_amdgcn_s_sleep(1);
        if ((++sp & 255u) == 0u) { if (xb_ld(&bar[XB_TMO])) break; if (sp > XB_SPIN_CAP) { atomicAdd(&bar[XB_TMO], 1u); break; } }
    }
    nloc = mine > 0u ? mine : 1u; nx = cnt > 0u ? cnt : 1u;
}

__device__ __forceinline__ void xcd_barrier(const XcdBarrier& b) {
    asm volatile("s_waitcnt vmcnt(0)" ::: "memory");
    __syncthreads();
    if (threadIdx.x == 0) {
        unsigned* bar = b.bar;
        __builtin_amdgcn_s_waitcnt(0);
        unsigned nloc = b.st[0], nx = b.st[1];
        if (nloc == 0u) { xcd_barrier_complete(bar, b.x, nloc, nx); b.st[0] = nloc; b.st[1] = nx; }
        const unsigned old = xb_add(&bar[XB_XSUB(b.x)], 1u);
        const unsigned gen = old / nloc;
        if (old + 1u == (gen + 1u) * nloc) {
            __builtin_amdgcn_fence(__ATOMIC_RELEASE, "agent");
            asm volatile("s_waitcnt vmcnt(0)" ::: "memory");
            const unsigned og = xb_add(&bar[XB_TOP], 1u);
            const unsigned tg = og / nx;
            if (og + 1u == (tg + 1u) * nx) xb_add(&bar[XB_TOPGEN], 1u);
            else XB_SPIN(xb_ld(&bar[XB_TOPGEN]) == tg, bar);
            __builtin_amdgcn_fence(__ATOMIC_ACQUIRE, "agent");
            xb_add(&bar[XB_XGEN(b.x)], 1u);
            asm volatile("s_waitcnt vmcnt(0)" ::: "memory");
        } else {
            XB_SPIN(xb_ld(&bar[XB_XGEN(b.x)]) == gen, bar);
            __builtin_amdgcn_fence(__ATOMIC_ACQUIRE, "agent");
            asm volatile("s_waitcnt vmcnt(0)" ::: "memory");
        }
    }
    __syncthreads();
}

enum { PH_PRO = 0, PH_HN, PH_GEMM1, PH_PREP, PH_MIX, PH_ATT, PH_UV, PH_GOUT, PH_UP, PH_DOWN, PH_COUNT };
#ifndef MK_SKIP_MIXER
#define MK_SKIP_MIXER 0
#endif
__global__ void __launch_bounds__(NWAVES * 64, 2) mk_fwd(Params p) {
    extern __shared__ __attribute__((aligned(16))) unsigned char lds[];
    cg::grid_group grid = cg::this_grid();
    const int tid = threadIdx.x, lane = tid & 63, wv = __builtin_amdgcn_readfirstlane(tid >> 6);
    const int G = gridDim.x, gw = blockIdx.x * NWAVES + wv, NGW = G * NWAVES;
    const int lo = p.ph_lo, hi = p.ph_hi;
    if (p.ph_hi < 0) grid.sync();
    if (tid < 2) ((volatile LAS unsigned*)((LAS unsigned char*)lds + LDS_BAR_OFF))[tid] = 0u;
    __syncthreads();
    XcdBarrier xbar = xcd_barrier_post((unsigned*)(p.ws + WS_BAR), (volatile LAS unsigned*)((LAS unsigned char*)lds + LDS_BAR_OFF));
    float* MOD = (float*)(p.ws + WS_MOD); bf16* REGA = (bf16*)(p.ws + WS_REGA); bf16* PROJ = (bf16*)(p.ws + WS_PROJ);
#ifndef MK_PHASE_MASK
#define MK_PHASE_MASK 0x3ff
#endif
#define IN(k) (((MK_PHASE_MASK >> (k)) & 1) && lo <= (k) && (k) < hi)
#define SEAM(k) do { if (IN(k) && IN((k) + 1)) { xcd_barrier(xbar); } if (MK_PROBE >= 0 && blockIdx.x == 0 && tid == 0) ((unsigned long long*)(p.ws + WS_MOD + 800 * 1024))[(k) + 1] = __builtin_amdgcn_s_memrealtime(); } while (0)
    if (MK_PROBE >= 0 && blockIdx.x == 0 && tid == 0) ((unsigned long long*)(p.ws + WS_MOD + 800 * 1024))[0] = __builtin_amdgcn_s_memrealtime();
    if (IN(PH_PRO)) { phase_pro(p, lds, tid, G); }
    SEAM(PH_PRO);
    if (IN(PH_HN)) { hn_rows<MK_F8_GEMM1 != 0>(p.x, p.g_mix, MOD, 0, 1024, REGA, gw, NGW, lane); }
    SEAM(PH_HN);
    if (IN(PH_GEMM1)) {
#if MK_F8_GEMM1
        pg8::Gemm g{REGA, (const bf16*)(p.ws + WS_WIN), M, NPROJ, DM / 2, DM / 2}; pg8::StaticOrder S; S.init(M, NPROJ, G, (int)blockIdx.x);
        pg8::EpiBf16<0> E{PROJ, NPROJ, 1.f / 32.f};
        pg8::gemm_phase<pg8::EpiBf16<0>, pg8::StaticOrder, true, true, true>((PG8_LAS unsigned char*)lds, g, S, E);
#else
        pg8::Gemm g{REGA, (const bf16*)(p.ws + WS_WIN), M, NPROJ, DM, DM}; pg8::StaticOrder S; S.init(M, NPROJ, G, (int)blockIdx.x);
        pg8::EpiBf16<0> E{PROJ, NPROJ, 1.f};
        pg8::gemm_phase<pg8::EpiBf16<0>, pg8::StaticOrder, true, true>((PG8_LAS unsigned char*)lds, g, S, E);
#endif
    }
    SEAM(PH_GEMM1);
    if (IN(PH_PREP)) {
#ifndef DBG_NO_RP
        for (int it = blockIdx.x; it < M / 64; it += G) rwkv_prep_item(p, lds, it, tid);
#endif
#ifndef DBG_NO_DP
        __syncthreads();
        stage_w_lds((const bf16*)(p.ws + WS_WUKT), lds, 4, tid); __syncthreads();
        for (int tile = gw; tile < M / 32; tile += NGW) dsa_prep_kv(p, lds, tile, lane);
        __syncthreads();
        stage_w_lds((const bf16*)(p.ws + WS_WUK), lds, 6, tid); __syncthreads();
        for (int tile = gw; tile < M / 32; tile += NGW) dsa_prep_q(p, lds, tile, lane);
#endif
    }
    SEAM(PH_PREP);
    if (IN(PH_MIX)) {
        for (int chain = blockIdx.x; chain < NB * 8; chain += G) { rwkv_scan_chain(p, lds, chain, wv, lane); __syncthreads(); }
        constexpr int NSEL = NB * 112;
        {   bf16x8 af[4][4]; float wqv = 0.f; const bf16* PROJ = (const bf16*)(p.ws + WS_PROJ);
            int idx = (int)blockIdx.x;
            if (idx < NSEL) DSA_LOAD_AF(af, wqv, idx / 112, 256 + 16 * (idx % 112));
            for (int k = 0; idx < NSEL; ++k) { const int nidx = (k + 1) * G + (((k + 1) & 1) ? (G - 1 - (int)blockIdx.x) : (int)blockIdx.x); const bool hn = nidx < NSEL;
                dsa_select_item(p, lds, idx / 112, 256 + 16 * (idx % 112), tid, af, wqv, hn, nidx / 112, 256 + 16 * (nidx % 112)); idx = nidx; } }
    }
    SEAM(PH_MIX);
    if (IN(PH_ATT)) {
        if (gw < 128) bias2_item(p, gw, lane);
        for (int row = gw; row < M; row += NGW) dsa_attend_row(p, lds + wv * 9216, row, lane);
    }

    SEAM(PH_ATT);
    if (IN(PH_UV)) {
#if MK_DBG == 7
        for (int m = gw; m < M; m += NGW) { *(u32x4*)(PROJ + (size_t)m * NPROJ + lane * 8) = *(const u32x4*)(REGA + (size_t)m * 1024 + lane * 8); }
#elif MK_DBG != 2
        stage_w_lds((const bf16*)(p.ws + WS_WUVT), lds, 4, tid); __syncthreads();
        for (int tile = gw; tile < M / 32; tile += NGW) uv_item(p, lds, tile, lane);
#endif
#if MK_DBG == 0
        rwkv_epi_rows(p, gw, NGW, lane);
#endif
#if MK_DBG == 1 || MK_DBG == 2
        for (int m = gw; m < M; m += NGW) { u32x4 z = {0u, 0u, 0u, 0u}; *(u32x4*)(PROJ + (size_t)m * NPROJ + (MK_DBG == 1 ? 512 : 0) + lane * 8) = z; }
#endif
    }
    SEAM(PH_UV);
    if (IN(PH_GOUT)) {
#if MK_F8_GOUT
        pg8::Gemm g{PROJ, (const bf16*)(p.ws + WS_WOUT), M, DM, DM / 2, NPROJ}; pg8::StaticOrder S; S.init(M, DM, G, (int)blockIdx.x);
        pg8::EpiResGateNorm E{p.x, p.out, DM, MOD + 2048, 6144, p.g_ffn, MOD + 4096, REGA, (float*)(p.ws + WS_ROWSQ), 1.f / 256.f};
        pg8::gemm_phase<pg8::EpiResGateNorm, pg8::StaticOrder, true, true, true>((PG8_LAS unsigned char*)lds, g, S, E);
#else
        pg8::Gemm g{PROJ, (const bf16*)(p.ws + WS_WOUT), M, DM, DM, NPROJ}; pg8::StaticOrder S; S.init(M, DM, G, (int)blockIdx.x);
        pg8::EpiResGateNorm E{p.x, p.out, DM, MOD + 2048, 6144, p.g_ffn, MOD + 4096, REGA, (float*)(p.ws + WS_ROWSQ), 1.f};
        pg8::gemm_phase<pg8::EpiResGateNorm, pg8::StaticOrder, true, true>((PG8_LAS unsigned char*)lds, g, S, E);
#endif
    }
    SEAM(PH_GOUT);
    if (IN(PH_UP)) {
        pg8::Gemm g{REGA, (const bf16*)(p.ws + WS_W1), M, FF, DM, DM}; pg8::StaticOrder S; S.init(M, FF, G, (int)blockIdx.x);
        pg8::EpiF8Relu2 E{p.ws + WS_U, FF, 4.f, (const float*)(p.ws + WS_ROWSQ), (const float*)(p.ws + WS_BIAS2)};
        pg8::gemm_phase<pg8::EpiF8Relu2, pg8::StaticOrder, true, true>((PG8_LAS unsigned char*)lds, g, S, E);
    }
    SEAM(PH_UP);
    if (IN(PH_DOWN)) {
        pg8::Gemm g{(const bf16*)(p.ws + WS_U), (const bf16*)(p.ws + WS_W2), M, DM, FF / 2, FF / 2}; pg8::StaticOrder S; S.init(M, DM, G, (int)blockIdx.x);
        pg8::EpiResGateA2 E{REGA, p.out, DM, MOD + 5120, 6144, p.g_ffn};
        pg8::gemm_phase<pg8::EpiResGateA2, pg8::StaticOrder, true, true, true>((PG8_LAS unsigned char*)lds, g, S, E);
    }
#if MK_PROBE >= 0
    grid.sync();
    if (blockIdx.x == 0 && tid == 0) { unsigned long long* ts = (unsigned long long*)(p.ws + WS_MOD + 800 * 1024); ts[PH_COUNT] = __builtin_amdgcn_s_memrealtime();
        p.out[0] += (float)(ts[MK_PROBE + 1] - ts[MK_PROBE]) * 1e-3f; }
#endif
#undef IN
#undef SEAM
}

#ifndef MK_N_LAUNCHES
#define MK_N_LAUNCHES 1
#endif
extern "C" void kernel_launch(void* const* d_in, const int* in_sizes, int n_in, void* d_out, int out_size, void* d_ws, size_t ws_size, hipStream_t stream) {
    static int grid = 0;
    if (grid == 0) {
        if (n_in != 26 || out_size != M * DM || ws_size < WS_END) { fprintf(stderr, "kernel_launch: unexpected shapes (n_in %d out %d ws %zu)\n", n_in, out_size, ws_size); grid = -1; return; }
        int dev = 0, cus = 0, per_cu = 0;
        hipGetDevice(&dev); hipDeviceGetAttribute(&cus, hipDeviceAttributeMultiprocessorCount, dev);
        if (hipFuncSetAttribute((const void*)mk_fwd, hipFuncAttributeMaxDynamicSharedMemorySize, LDS_BYTES) != hipSuccess) { fprintf(stderr, "kernel_launch: hipFuncSetAttribute failed\n"); grid = -1; return; }
        if (hipOccupancyMaxActiveBlocksPerMultiprocessor(&per_cu, (const void*)mk_fwd, NWAVES * 64, LDS_BYTES) != hipSuccess || per_cu < 1) { fprintf(stderr, "kernel_launch: occupancy query says %d\n", per_cu); per_cu = 1; }
        (void)hipGetLastError();
        grid = cus * 1;
        if (per_cu < 1) grid = -1;
    }
    if (grid < 0) return;
    Params p{};
    const float** pp = (const float**)&p;
    for (int i = 0; i < 26; ++i) pp[i] = (const float*)d_in[i];
    p.out = (float*)d_out; p.ws = (unsigned char*)d_ws;
#if MK_N_LAUNCHES == 1
    if (hipMemsetAsync((char*)d_ws + WS_BAR, 0, 16384, stream) != hipSuccess) { fprintf(stderr, "kernel_launch: memset of the barrier words failed\n"); return; }
    p.ph_lo = 0; p.ph_hi = PH_COUNT;
    void* args[] = {&p};
    hipError_t e = hipLaunchCooperativeKernel((const void*)mk_fwd, dim3(grid), dim3(NWAVES * 64), args, LDS_BYTES, stream);
    if (e != hipSuccess) fprintf(stderr, "cooperative launch failed: %s (grid %d)\n", hipGetErrorString(e), grid);
#else
    for (int ph = 0; ph < PH_COUNT; ++ph) {
#if MK_SKIP_MIXER
        if (ph >= PH_HN && ph <= PH_GOUT) continue;
#endif
        p.ph_lo = ph; p.ph_hi = ph + 1;
        hipLaunchKernelGGL(mk_fwd, dim3(grid), dim3(NWAVES * 64), LDS_BYTES, stream, p);
    }
#endif
}
```

```cpp
#include <hip/hip_runtime.h>
#include <hip/hip_cooperative_groups.h>
#include <cstdio>
#include <cstdint>
#include <cmath>
namespace cg = cooperative_groups;
#ifndef MK_F8_GEMM1
#define MK_F8_GEMM1 0
#endif
#ifndef MK_PROBE
#define MK_PROBE -1
#endif
#ifndef MK_F8_GOUT
#define MK_F8_GOUT 1
#endif
#ifndef MK_DBG
#define MK_DBG 0
#endif
#ifndef MK_DBG_NOTOPK
#define MK_DBG_NOTOPK 0
#endif
namespace pg8 {
#define PG8_LAS __attribute__((address_space(3)))
typedef unsigned short bf16_t;
typedef short bf16x8 __attribute__((ext_vector_type(8)));
typedef float f32x4 __attribute__((ext_vector_type(4)));
typedef unsigned u32x4 __attribute__((ext_vector_type(4)));
constexpr int BM = 256, BK = 64, HALF = 128, HTB = HALF * BK * 2  , STAGE_BYTES = 8 * HTB, NXCD = 8, WGM = 8;

__host__ __device__ __forceinline__ int lds_byte(int r, int c) { const int st = (r >> 4) * 2 + (c >> 5), rr = r & 15, cc = c & 31, ob = rr * 64 + cc * 2; return st * 1024 + (ob ^ (((ob >> 9) & 1) << 5)); }
__host__ __device__ __forceinline__ void stage_rc(int b, int& R, int& C) { const int st = b / 1024, sb = b % 1024, swz = sb ^ (((sb >> 9) & 1) << 5); R = (st >> 1) * 16 + swz / 64; C = (st & 1) * 32 + (swz % 64) / 2; }
__host__ __device__ __forceinline__ int perm32(int rho) { const int n = rho >> 4, i = rho & 15; return 8 * (i >> 2) + 4 * n + (i & 3); }

struct Unit { int pm, pn; };
struct Gemm { const bf16_t* A; const bf16_t* Bt; int M, N, K, lda; };

struct StaticOrder {
    int nM, nN, nwg, G, c;
    __host__ __device__ void init(int M, int N, int G_, int c_) { nM = M / BM; nN = N / BM; nwg = nM * nN; G = G_; c = c_; }
    __host__ __device__ bool next(int i, Unit& u) const {
        const long L = (long)i * G + c; if (L >= nwg) return false;
        int wgid = (int)L; { const int q = nwg / NXCD, r = nwg % NXCD, xcd = wgid % NXCD, off = wgid / NXCD; wgid = (xcd < r ? xcd * (q + 1) : r * (q + 1) + (xcd - r) * q) + off; }
        const int nig = WGM * nN, gid = wgid / nig, fm = gid * WGM, gsz = (nM - fm) < WGM ? (nM - fm) : WGM;
        u.pm = fm + ((wgid % nig) % gsz); u.pn = (wgid % nig) / gsz; return true;
    }
    __device__ __forceinline__ void a_ready(const Unit&) const {}
    __device__ __forceinline__ void done(const Unit&) const {}
};


typedef float f32x2_t __attribute__((ext_vector_type(2))); typedef __bf16 bf16x2_t __attribute__((ext_vector_type(2)));
__device__ __forceinline__ unsigned cvt_pk_bf16(float lo, float hi) { const f32x2_t v = {lo, hi}; const bf16x2_t b = __builtin_convertvector(v, bf16x2_t); return __builtin_bit_cast(unsigned, b); }

template <int ACT  > struct EpiBf16 {
    static constexpr bool PERM = true, AFTER_DRAIN = false;
    bf16_t* O; int ldc; float scale;
    __device__ __forceinline__ void operator()(const f32x4 (&acc)[2][2][4][2], const Unit& u, int wr, int wc, int fr, int fq) const {
        const int row0 = u.pm * BM + wr * 64 + fr; const int col0 = u.pn * BM + wc * 32 + 8 * fq;
#pragma unroll
        for (int ai = 0; ai < 2; ++ai)
#pragma unroll
            for (int m = 0; m < 4; ++m) { bf16_t* rowp = O + (size_t)(row0 + ai * HALF + m * 16) * ldc + col0;
#pragma unroll
                for (int bj = 0; bj < 2; ++bj) { f32x4 v0 = acc[ai][bj][m][0] * scale, v1 = acc[ai][bj][m][1] * scale;
                    if (ACT == 1) {
#pragma unroll
                        for (int j = 0; j < 4; ++j) { const float a = v0[j] > 0.f ? v0[j] : 0.f, b = v1[j] > 0.f ? v1[j] : 0.f; v0[j] = a * a; v1[j] = b * b; } }
                    u32x4 w; w.x = cvt_pk_bf16(v0[0], v0[1]); w.y = cvt_pk_bf16(v0[2], v0[3]); w.z = cvt_pk_bf16(v1[0], v1[1]); w.w = cvt_pk_bf16(v1[2], v1[3]);
                    *(u32x4*)(rowp + bj * HALF) = w; } }
    }
};
__device__ __forceinline__ unsigned pk4_fp8(float a, float b, float c, float d) { int r = __builtin_amdgcn_cvt_pk_fp8_f32(a, b, 0, false); r = __builtin_amdgcn_cvt_pk_fp8_f32(c, d, r, true); return (unsigned)r; }
struct EpiF8Relu2 {
    static constexpr bool PERM = true, AFTER_DRAIN = false;
    unsigned char* O; int ldc; float scale; const float* rowsq; const float* bias2;
    __device__ __forceinline__ void operator()(const f32x4 (&acc)[2][2][4][2], const Unit& u, int wr, int wc, int fr, int fq) const {
        const int row0 = u.pm * BM + wr * 64 + fr; const int col0 = u.pn * BM + wc * 32 + 8 * fq;
        const float* bp = bias2 + (size_t)(u.pm >> 3) * 4096 + col0;
        f32x4 bv[2][2];
#pragma unroll
        for (int bj = 0; bj < 2; ++bj) { bv[bj][0] = *(const f32x4*)(bp + bj * HALF); bv[bj][1] = *(const f32x4*)(bp + bj * HALF + 4); }
#pragma unroll
        for (int ai = 0; ai < 2; ++ai)
#pragma unroll
            for (int m = 0; m < 4; ++m) { const int row = row0 + ai * HALF + m * 16; unsigned char* rowp = O + (size_t)row * ldc + col0;
                const float rstd = rsqrtf(rowsq[row] * (1.f / 1024.f) + 1e-6f);
#pragma unroll
                for (int bj = 0; bj < 2; ++bj) { f32x4 v0 = acc[ai][bj][m][0] * rstd + bv[bj][0], v1 = acc[ai][bj][m][1] * rstd + bv[bj][1];
#pragma unroll
                    for (int j = 0; j < 4; ++j) { const float a = v0[j] > 0.f ? v0[j] : 0.f, b = v1[j] > 0.f ? v1[j] : 0.f; v0[j] = fminf(a * a * scale, 416.f); v1[j] = fminf(b * b * scale, 416.f); }
                    typedef unsigned u32x2_t __attribute__((ext_vector_type(2)));
                    u32x2_t w; w.x = pk4_fp8(v0[0], v0[1], v0[2], v0[3]); w.y = pk4_fp8(v1[0], v1[1], v1[2], v1[3]);
                    *(u32x2_t*)(rowp + bj * HALF) = w; } }
    }
};
struct EpiResGate {
    static constexpr bool PERM = false, AFTER_DRAIN = false;
    const float* base; float* out; int ldc; const float* gate; int gate_ld; float gscale;
    __device__ __forceinline__ void operator()(const f32x4 (&acc)[2][2][4][2], const Unit& u, int, int, int, int) const {
        int t_ = threadIdx.x; asm volatile("" : "+v"(t_));
        const int wr = t_ >> 8, wc = (t_ >> 6) & 3, fr = t_ & 15, fq = (t_ >> 4) & 3;
        const int row0 = u.pm * BM + wr * 64 + fr, col0 = u.pn * BM + wc * 32 + 4 * fq;
        const float* gp = gate + (size_t)(u.pm >> 3) * gate_ld + col0;
        f32x4 gv[2][2];
#pragma unroll
        for (int bj = 0; bj < 2; ++bj)
#pragma unroll
            for (int n = 0; n < 2; ++n) gv[bj][n] = *(const f32x4*)(gp + bj * HALF + n * 16) * gscale;
#pragma unroll
        for (int ai = 0; ai < 2; ++ai)
#pragma unroll
            for (int m = 0; m < 4; ++m) { const size_t off = (size_t)(row0 + ai * HALF + m * 16) * ldc + col0;
#pragma unroll
                for (int bj = 0; bj < 2; ++bj)
#pragma unroll
                    for (int n = 0; n < 2; ++n) { const f32x4 bs = *(const f32x4*)(base + off + bj * HALF + n * 16);
                        *(f32x4*)(out + off + bj * HALF + n * 16) = bs + gv[bj][n] * acc[ai][bj][m][n]; } }
    }
};
struct EpiResGateNorm {
    static constexpr bool PERM = false, AFTER_DRAIN = false;
    const float* base; float* out; int ldc; const float* gate; int gate_ld; const float* gffn; const float* sc2; bf16_t* a2; float* rowsq; float gscale;
    __device__ __forceinline__ void operator()(const f32x4 (&acc)[2][2][4][2], const Unit& u, int, int, int, int) const {
        int t_ = threadIdx.x; asm volatile("" : "+v"(t_));
        const int wr = t_ >> 8, wc = (t_ >> 6) & 3, fr = t_ & 15, fq = (t_ >> 4) & 3;
        const int row0 = u.pm * BM + wr * 64 + fr, col0 = u.pn * BM + wc * 32 + 4 * fq;
        const float* gp = gate + (size_t)(u.pm >> 3) * gate_ld + col0; const float* sp = sc2 + (size_t)(u.pm >> 3) * gate_ld + col0;
        f32x4 gv[2][2], gm[2][2];
#pragma unroll
        for (int bj = 0; bj < 2; ++bj)
#pragma unroll
            for (int n = 0; n < 2; ++n) { gv[bj][n] = *(const f32x4*)(gp + bj * HALF + n * 16) * gscale; gm[bj][n] = *(const f32x4*)(gffn + col0 + bj * HALF + n * 16) * (*(const f32x4*)(sp + bj * HALF + n * 16) + 1.f); }
#pragma unroll
        for (int ai = 0; ai < 2; ++ai)
#pragma unroll
            for (int m = 0; m < 4; ++m) { const int row = row0 + ai * HALF + m * 16; const size_t off = (size_t)row * ldc + col0; float ss = 0.f;
#pragma unroll
                for (int bj = 0; bj < 2; ++bj)
#pragma unroll
                    for (int n = 0; n < 2; ++n) { const f32x4 bs = *(const f32x4*)(base + off + bj * HALF + n * 16); const f32x4 x1 = bs + gv[bj][n] * acc[ai][bj][m][n];
                        ss += (x1.x * x1.x + x1.y * x1.y) + (x1.z * x1.z + x1.w * x1.w);
                        const f32x4 y = x1 * gm[bj][n]; typedef unsigned u32x2_t __attribute__((ext_vector_type(2)));
                        u32x2_t w; w.x = cvt_pk_bf16(y.x, y.y); w.y = cvt_pk_bf16(y.z, y.w); *(u32x2_t*)(a2 + off + bj * HALF + n * 16) = w; }
                ss += __shfl_xor(ss, 16); ss += __shfl_xor(ss, 32);
                if (fq == 0) atomicAdd(rowsq + row, ss); }
    }
};
struct EpiResGateA2 {
    static constexpr bool PERM = false, AFTER_DRAIN = false;
    const bf16_t* a2; float* out; int ldc; const float* gate; int gate_ld; const float* gffn;
    __device__ __forceinline__ void operator()(const f32x4 (&acc)[2][2][4][2], const Unit& u, int, int, int, int) const {
        constexpr float gscale = 1.f / 256.f;
        int t_ = threadIdx.x; asm volatile("" : "+v"(t_));
        const int wr = t_ >> 8, wc = (t_ >> 6) & 3, fr = t_ & 15, fq = (t_ >> 4) & 3;
        const int row0 = u.pm * BM + wr * 64 + fr, col0 = u.pn * BM + wc * 32 + 4 * fq;
        const float* gp = gate + (size_t)(u.pm >> 3) * gate_ld + col0; const float* sp = gp - 1024;
        f32x4 gv[2][2], ig[2][2];
#pragma unroll
        for (int bj = 0; bj < 2; ++bj)
#pragma unroll
            for (int n = 0; n < 2; ++n) { gv[bj][n] = *(const f32x4*)(gp + bj * HALF + n * 16) * gscale;
                const f32x4 gm = *(const f32x4*)(gffn + col0 + bj * HALF + n * 16) * (*(const f32x4*)(sp + bj * HALF + n * 16) + 1.f);
                ig[bj][n] = (f32x4){1.f / gm.x, 1.f / gm.y, 1.f / gm.z, 1.f / gm.w}; }
#pragma unroll
        for (int ai = 0; ai < 2; ++ai)
#pragma unroll
            for (int m = 0; m < 4; ++m) { const size_t off = (size_t)(row0 + ai * HALF + m * 16) * ldc + col0;
#pragma unroll
                for (int bj = 0; bj < 2; ++bj)
#pragma unroll
                    for (int n = 0; n < 2; ++n) { typedef unsigned u32x2_t __attribute__((ext_vector_type(2)));
                        const u32x2_t w = *(const u32x2_t*)(a2 + off + bj * HALF + n * 16);
                        const f32x4 xa = {__uint_as_float(w.x << 16), __uint_as_float(w.x & 0xffff0000u), __uint_as_float(w.y << 16), __uint_as_float(w.y & 0xffff0000u)};
                        *(f32x4*)(out + off + bj * HALF + n * 16) = xa * ig[bj][n] + gv[bj][n] * acc[ai][bj][m][n]; } }
    }
};
template <class Epi, class Sched, bool ALIGN_EPI = false, bool SP2 = false, bool F8 = false>
__device__ __forceinline__ void gemm_phase(PG8_LAS unsigned char* lds, const Gemm g, const Sched S, const Epi E) {
    const int tid = threadIdx.x, wid = __builtin_amdgcn_readfirstlane(tid >> 6), lane = tid & 63, wr = wid >> 2, wc = wid & 3, fr = lane & 15, fq = lane >> 4;
    const int K = g.K, nt = K / BK;
    unsigned voffA[2], voffB[2];
#pragma unroll
    for (int i = 0; i < 2; ++i) { int R, C; stage_rc(tid * 16 + i * 8192, R, C); const int Rb = Epi::PERM ? ((R & ~31) + perm32(R & 31)) : R;
        voffA[i] = (unsigned)(R * g.lda + C) * 2u; voffB[i] = (unsigned)(Rb * K + C) * 2u; }
    const size_t kstep = (size_t)(BK * 2);
    const size_t hstepB = (size_t)HALF * K * 2, hstepA = (size_t)HALF * g.lda * 2;
    const size_t tstepA = 2 * hstepA, tstepB = 2 * hstepB;
    const unsigned ldsw = (unsigned)wid * 1024u;
    const int f8in = (fq >> 1) * 1024 + ((fr * 64 + (fq & 1) * 32) ^ ((fr >> 3) << 5));
    const int aoff = F8 ? wr * 8192 + f8in : lds_byte(wr * 64 + fr, fq * 8), boff = F8 ? wc * 4096 + f8in : lds_byte(wc * 32 + fr, fq * 8);
    constexpr int KOFF = F8 ? 16 : 1024;
    typedef int v8i_t __attribute__((ext_vector_type(8)));
#define PG8_SA(b, h) (((b) * 2 + (h)) * HTB)
#define PG8_SB(b, h) ((4 + (b) * 2 + (h)) * HTB)
#define PG8_STAGE(bufoff, gbase, voff) do { _Pragma("unroll") for (int _i = 0; _i < 2; ++_i) \
        __builtin_amdgcn_global_load_lds((const unsigned*)((const char*)(gbase) + (voff)[_i]), (PG8_LAS unsigned*)(lds + (bufoff) + ldsw + _i * 8192), 16, 0, 0); } while (0)
#define PG8_LD32(p_) __builtin_shufflevector(*(const PG8_LAS u32x4*)(p_), *(const PG8_LAS u32x4*)((p_) + 16), 0, 1, 2, 3, 4, 5, 6, 7)
#define PG8_LDA(dst, b, h) do { if constexpr (F8) { _Pragma("unroll") for (int m = 0; m < 4; ++m) dst##8[m] = __builtin_bit_cast(v8i_t, PG8_LD32(lds + PG8_SA(b, h) + aoff + m * 2048)); } \
    else { _Pragma("unroll") for (int m = 0; m < 4; ++m) _Pragma("unroll") for (int k = 0; k < 2; ++k) dst[m][k] = *(const PG8_LAS bf16x8*)(lds + PG8_SA(b, h) + aoff + m * 2048 + k * KOFF); } } while (0)
#define PG8_LDB(dst, b, h) do { if constexpr (F8) { _Pragma("unroll") for (int n = 0; n < 2; ++n) dst##8[n] = __builtin_bit_cast(v8i_t, PG8_LD32(lds + PG8_SB(b, h) + boff + n * 2048)); } \
    else { _Pragma("unroll") for (int n = 0; n < 2; ++n) _Pragma("unroll") for (int k = 0; k < 2; ++k) dst[n][k] = *(const PG8_LAS bf16x8*)(lds + PG8_SB(b, h) + boff + n * 2048 + k * KOFF); } } while (0)
#define PG8_CAT(x) __builtin_shufflevector(__builtin_bit_cast(u32x4, (x)[0]), __builtin_bit_cast(u32x4, (x)[1]), 0, 1, 2, 3, 4, 5, 6, 7)
#define PG8_MMA(ai, bj, At, Bt) do { __builtin_amdgcn_s_setprio(1); if constexpr (F8) { _Pragma("unroll") for (int m = 0; m < 4; ++m) _Pragma("unroll") for (int n = 0; n < 2; ++n) \
        asm volatile("v_mfma_f32_16x16x128_f8f6f4 %0, %1, %2, %0" : "+v"(acc[ai][bj][m][n]) : "v"(Bt##8[n]), "v"(At##8[m])); } \
    else { _Pragma("unroll") for (int m = 0; m < 4; ++m) _Pragma("unroll") for (int n = 0; n < 2; ++n) _Pragma("unroll") for (int k = 0; k < 2; ++k) \
        acc[ai][bj][m][n] = __builtin_amdgcn_mfma_f32_16x16x32_bf16(Bt[n][k], At[m][k], acc[ai][bj][m][n], 0, 0, 0); } __builtin_amdgcn_s_setprio(0); } while (0)
#define PG8_WAIT_V(n) asm volatile("s_waitcnt vmcnt(" #n ")" ::: "memory")
#define PG8_WAIT_L(n) asm volatile("s_waitcnt lgkmcnt(" #n ")" ::: "memory")
#define PG8_BAR __builtin_amdgcn_s_barrier()
#define PG8_SCHED __builtin_amdgcn_sched_barrier(0)
    Unit cur, nxt; int ui = 0;
    if (!S.next(0, cur)) return;
    f32x4 acc[2][2][4][2];
#pragma unroll
    for (int a = 0; a < 2; ++a)
#pragma unroll
        for (int b = 0; b < 2; ++b)
#pragma unroll
            for (int m = 0; m < 4; ++m)
#pragma unroll
                for (int n = 0; n < 2; ++n) acc[a][b][m][n] = (f32x4){0.f, 0.f, 0.f, 0.f};
    bf16x8 At[4][2], B0[2][2], B1[2][2]; v8i_t At8[4], B08[2], B18[2];
    const char* cA = (const char*)g.A + (size_t)cur.pm * tstepA; const char* cB = (const char*)g.Bt + (size_t)cur.pn * tstepB;
    S.a_ready(cur);
    if constexpr (SP2) {
        PG8_STAGE(PG8_SB(0, 0), cB, voffB); PG8_STAGE(PG8_SB(0, 1), cB + hstepB, voffB); PG8_STAGE(PG8_SA(0, 0), cA, voffA); PG8_STAGE(PG8_SA(0, 1), cA + hstepA, voffA);
        if (wr == 1) PG8_BAR;
        PG8_WAIT_V(2); PG8_BAR;
        PG8_STAGE(PG8_SB(1, 0), cB + kstep, voffB); PG8_STAGE(PG8_SA(1, 0), cA + kstep, voffA); PG8_STAGE(PG8_SB(1, 1), cB + hstepB + kstep, voffB);
        PG8_WAIT_V(6); PG8_BAR;
    } else {
        PG8_STAGE(PG8_SB(0, 0), cB, voffB); PG8_STAGE(PG8_SA(0, 0), cA, voffA); PG8_STAGE(PG8_SB(0, 1), cB + hstepB, voffB); PG8_STAGE(PG8_SA(0, 1), cA + hstepA, voffA);
        if (wr == 1) PG8_BAR;
        PG8_WAIT_V(4); PG8_BAR;
        PG8_STAGE(PG8_SB(1, 0), cB + kstep, voffB); PG8_STAGE(PG8_SA(1, 0), cA + kstep, voffA); PG8_STAGE(PG8_SB(1, 1), cB + hstepB + kstep, voffB);
        PG8_WAIT_V(6); PG8_BAR;
    }
    for (;;) {
        const bool has_next = S.next(ui + 1, nxt);
        const char* nA = has_next ? (const char*)g.A + (size_t)nxt.pm * tstepA : cA; const char* nB = has_next ? (const char*)g.Bt + (size_t)nxt.pn * tstepB : cB;
        for (int t = 0; t < nt; t += 2) {
            const bool last = (t == nt - 2);
            const char* a1 = cA + (size_t)(t + 1) * kstep;
            const char* a2 = last ? nA : cA + (size_t)(t + 2) * kstep; const char* b2 = last ? nB : cB + (size_t)(t + 2) * kstep;
            const char* a3 = a2 + kstep; const char* b3 = b2 + kstep;
            if (last && has_next) S.a_ready(nxt);
            if constexpr (SP2) {
            PG8_LDB(B0, 0, 0); PG8_LDB(B1, 0, 1); PG8_SCHED; PG8_LDA(At, 0, 0); PG8_STAGE(PG8_SA(1, 1), a1 + hstepA, voffA);
            PG8_WAIT_V(8); PG8_WAIT_L(0); PG8_BAR; PG8_MMA(0, 0, At, B0); PG8_MMA(0, 1, At, B1); PG8_BAR; PG8_SCHED;
            PG8_LDA(At, 0, 1); PG8_STAGE(PG8_SB(0, 0), b2, voffB); PG8_STAGE(PG8_SB(0, 1), b2 + hstepB, voffB); PG8_STAGE(PG8_SA(0, 0), a2, voffA);
            PG8_WAIT_V(8); PG8_WAIT_L(0); PG8_BAR; PG8_MMA(1, 0, At, B0); PG8_MMA(1, 1, At, B1); PG8_BAR; PG8_SCHED;
            PG8_LDB(B0, 1, 0); PG8_LDB(B1, 1, 1); PG8_SCHED; PG8_LDA(At, 1, 0); PG8_STAGE(PG8_SA(0, 1), a2 + hstepA, voffA);
            PG8_WAIT_V(8); PG8_WAIT_L(0); PG8_BAR; PG8_MMA(0, 0, At, B0); PG8_MMA(0, 1, At, B1); PG8_BAR; PG8_SCHED;
            PG8_LDA(At, 1, 1); PG8_STAGE(PG8_SB(1, 0), b3, voffB); PG8_STAGE(PG8_SB(1, 1), b3 + hstepB, voffB); PG8_STAGE(PG8_SA(1, 0), a3, voffA);
            PG8_WAIT_V(8); PG8_WAIT_L(0); PG8_BAR; PG8_MMA(1, 0, At, B0); PG8_MMA(1, 1, At, B1); PG8_BAR; PG8_SCHED;
            } else {
            PG8_LDB(B0, 0, 0); PG8_SCHED; PG8_LDA(At, 0, 0); PG8_STAGE(PG8_SA(1, 1), a1 + hstepA, voffA);
            PG8_WAIT_L(8); PG8_BAR; PG8_WAIT_L(0); PG8_MMA(0, 0, At, B0); PG8_BAR; PG8_SCHED;
            PG8_LDB(B1, 0, 1); PG8_STAGE(PG8_SB(0, 0), b2, voffB);
            PG8_BAR; PG8_WAIT_L(0); PG8_MMA(0, 1, At, B1); PG8_BAR;
            PG8_LDA(At, 0, 1); PG8_STAGE(PG8_SA(0, 0), a2, voffA);
            PG8_BAR; PG8_WAIT_L(0); PG8_MMA(1, 0, At, B0); PG8_BAR; PG8_SCHED;
            PG8_STAGE(PG8_SB(0, 1), b2 + hstepB, voffB);
            PG8_WAIT_V(6); PG8_BAR; PG8_MMA(1, 1, At, B1); PG8_BAR;
            PG8_LDB(B0, 1, 0); PG8_SCHED; PG8_LDA(At, 1, 0); PG8_STAGE(PG8_SA(0, 1), a2 + hstepA, voffA);
            PG8_WAIT_L(8); PG8_BAR; PG8_WAIT_L(0); PG8_MMA(0, 0, At, B0); PG8_BAR; PG8_SCHED;
            PG8_LDB(B1, 1, 1); PG8_STAGE(PG8_SB(1, 0), b3, voffB);
            PG8_BAR; PG8_WAIT_L(0); PG8_MMA(0, 1, At, B1); PG8_BAR;
            PG8_LDA(At, 1, 1); PG8_STAGE(PG8_SA(1, 0), a3, voffA);
            PG8_BAR; PG8_WAIT_L(0); PG8_MMA(1, 0, At, B0); PG8_BAR; PG8_SCHED;
            PG8_STAGE(PG8_SB(1, 1), b3 + hstepB, voffB);
            PG8_WAIT_V(6); PG8_BAR; PG8_MMA(1, 1, At, B1); PG8_BAR;
            }
        }
        if constexpr (ALIGN_EPI) { if (wr == 0) PG8_BAR; }
        if constexpr (F8) asm volatile("s_nop 15\n\ts_nop 15");
        if constexpr (!Epi::AFTER_DRAIN) { E(acc, cur, wr, wc, fr, fq); S.done(cur); }
        if (!has_next) break;
#pragma unroll
        for (int a = 0; a < 2; ++a)
#pragma unroll
            for (int b = 0; b < 2; ++b)
#pragma unroll
                for (int m = 0; m < 4; ++m)
#pragma unroll
                    for (int n = 0; n < 2; ++n) acc[a][b][m][n] = (f32x4){0.f, 0.f, 0.f, 0.f};
        cur = nxt; cA = nA; cB = nB; ++ui;
        if constexpr (ALIGN_EPI) { if (wr == 1) PG8_BAR; }
    }
    PG8_WAIT_V(0);
    if constexpr (!ALIGN_EPI) { if (wr == 0) PG8_BAR; }
    PG8_BAR;
    if constexpr (Epi::AFTER_DRAIN) { E.fused(acc, cur, wr, wc, fr, fq, lds, wid, lane); S.done(cur); }
#undef PG8_SA
#undef PG8_SB
#undef PG8_STAGE
#undef PG8_LDA
#undef PG8_LDB
#undef PG8_MMA
#undef PG8_CAT
#undef PG8_LD32
#undef PG8_WAIT_V
#undef PG8_WAIT_L
#undef PG8_BAR
#undef PG8_SCHED
}
}

#define LAS __attribute__((address_space(3)))
typedef unsigned short bf16;
typedef short bf16x8 __attribute__((ext_vector_type(8)));
typedef short s16x4 __attribute__((ext_vector_type(4)));
typedef float f32x4 __attribute__((ext_vector_type(4)));
typedef float f32x16 __attribute__((ext_vector_type(16)));
typedef unsigned u32x4 __attribute__((ext_vector_type(4)));
typedef unsigned u32x2 __attribute__((ext_vector_type(2)));

constexpr int NB = 32, SEQ = 2048, DM = 1024, M = NB * SEQ, NPROJ = 3072, FF = 4096;
constexpr int PC_Q = 0, PC_R = 512, PC_K = 1024, PC_V = 1536, PC_QI = 2048, PC_CL = 2560, PC_KI = 2688, PC_XW = 2752, PC_XA = 2816, PC_XG = 2880, PC_WI = 3008;
constexpr size_t MiB = 1u << 20;
constexpr size_t WS_MOD = 0, WS_WUKT = 1 * MiB, WS_WUK = WS_WUKT + 131072, WS_WUVT = WS_WUK + 131072, WS_INVR = 2 * MiB, WS_WIN = 4 * MiB, WS_WOUT = 10 * MiB,
                 WS_W1 = 12 * MiB, WS_W2 = 20 * MiB, WS_CKV = 36 * MiB, WS_GAM = 52 * MiB, WS_C3 = 60 * MiB, WS_REGA = 64 * MiB, WS_PROJ = 192 * MiB, WS_CH = 576 * MiB,
                 WS_G = 960 * MiB, WS_U = 192 * MiB, WS_END = 1024 * MiB,
                 WS_BAR = 62 * MiB, WS_ROWSQ = WS_BAR + 65536, WS_BIAS2 = WS_ROWSQ + 262144, WS_W2T = WS_WUVT + 131072, WS_A2T = WS_W2T + 65536, WS_G2T = WS_A2T + 65536;
constexpr int LDS_BAR_OFF = 163072;
constexpr int LDS_BYTES = 163328;
constexpr int NWAVES = 8;

struct Params {
    const float *x, *c, *w_ada, *b_ada, *g_mix, *g_ffn, *w_in, *g_q, *g_k, *g_kv, *w_uk, *w_uv, *mu, *w0, *w2, *a0, *a2, *g2, *k_k, *k_a, *r_k, *ln_w, *ln_b, *w_out, *w_ff1, *w_ff2;
    float* out; unsigned char* ws; int ph_lo, ph_hi;
};

__device__ __forceinline__ unsigned pk2(float lo, float hi) { return pg8::cvt_pk_bf16(lo, hi); }
__device__ __forceinline__ float bflo(unsigned w) { return __uint_as_float(w << 16); }
__device__ __forceinline__ float bfhi(unsigned w) { return __uint_as_float(w & 0xffff0000u); }
__device__ __forceinline__ float bf2f(bf16 h) { return __uint_as_float((unsigned)h << 16); }
__device__ __forceinline__ bf16 f2bf(float f) { return (bf16)(pk2(f, 0.f) & 0xffffu); }
__device__ __forceinline__ float wave_sum(float v) {
#pragma unroll
    for (int o = 1; o < 64; o <<= 1) v += __shfl_xor(v, o);
    return v;
}
__device__ __forceinline__ f32x16 mfma32(bf16x8 a, bf16x8 b, f32x16 c) { return __builtin_amdgcn_mfma_f32_32x32x16_bf16(a, b, c, 0, 0, 0); }
__device__ __forceinline__ f32x4 mfma16(bf16x8 a, bf16x8 b, f32x4 c) { return __builtin_amdgcn_mfma_f32_16x16x32_bf16(a, b, c, 0, 0, 0); }

__device__ __forceinline__ int win_src_col(int n) {
    if (n < 512) return n;
    if (n < 1024) return 1224 + (n - 512);
    if (n < 1536) return 1736 + (n - 1024);
    if (n < 2048) return 2248 + (n - 1536);
    if (n < 2560) return 640 + (n - 2048);
    if (n < 2688) return 512 + (n - 2560);
    if (n < 2752) return 1152 + (n - 2688);
    if (n < 2816) return 2760 + (n - 2752);
    if (n < 2880) return 2824 + (n - 2816);
    if (n < 3008) return 2888 + (n - 2880);
    if (n < 3016) return 1216 + (n - 3008);
    return -1;
}
__device__ __forceinline__ void conv_t_item(const float* W, int K, int Nsrc, bf16* WT, int nblk, int item, float* scr, int lane, bool is_win) {
    const int kb = item / nblk, nb = item % nblk, k0 = 64 * kb, n0 = 32 * nb;
    int ns = n0 + (lane & 31); if (is_win) ns = win_src_col(ns);
    float tv[32];
#pragma unroll
    for (int i = 0; i < 32; ++i) { const int kk = 2 * i + (lane >> 5); tv[i] = ns >= 0 ? W[(size_t)(k0 + kk) * Nsrc + ns] : 0.f; }
#pragma unroll
    for (int i = 0; i < 32; ++i) { const int kk = 2 * i + (lane >> 5); scr[kk * 33 + (lane & 31)] = tv[i]; }
    asm volatile("s_waitcnt lgkmcnt(0)" ::: "memory");
    const int c = lane & 7;
#pragma unroll
    for (int j = 0; j < 4; ++j) { const int n = (lane >> 3) + 8 * j; const float* s = scr + (8 * c) * 33 + n;
        u32x4 o; o.x = pk2(s[0 * 33], s[1 * 33]); o.y = pk2(s[2 * 33], s[3 * 33]); o.z = pk2(s[4 * 33], s[5 * 33]); o.w = pk2(s[6 * 33], s[7 * 33]);
        *(u32x4*)(WT + (size_t)(n0 + n) * K + k0 + 8 * c) = o; }
    asm volatile("s_waitcnt lgkmcnt(0)" ::: "memory");
}
__device__ __forceinline__ void conv_t_item_f8(const float* W, int K, int N, unsigned char* WT, int nblk, int item, float* scr, int lane, float scale, bool is_win = false) {
    const int kb = item / nblk, nb = item % nblk, k0 = 64 * kb, n0 = 32 * nb;
    int ns = n0 + (lane & 31); if (is_win) ns = win_src_col(ns);
    float tv[32];
#pragma unroll
    for (int i = 0; i < 32; ++i) { const int kk = 2 * i + (lane >> 5); tv[i] = ns >= 0 ? W[(size_t)(k0 + kk) * N + ns] * scale : 0.f; }
#pragma unroll
    for (int i = 0; i < 32; ++i) { const int kk = 2 * i + (lane >> 5); scr[kk * 33 + (lane & 31)] = tv[i]; }
    asm volatile("s_waitcnt lgkmcnt(0)" ::: "memory");
    const int c = lane & 7;
#pragma unroll
    for (int j = 0; j < 4; ++j) { const int n = (lane >> 3) + 8 * j; const float* s = scr + (8 * c) * 33 + n;
        u32x2 o; o.x = pg8::pk4_fp8(s[0 * 33], s[1 * 33], s[2 * 33], s[3 * 33]); o.y = pg8::pk4_fp8(s[4 * 33], s[5 * 33], s[6 * 33], s[7 * 33]);
        *(u32x2*)(WT + (size_t)(n0 + n) * K + k0 + 8 * c) = o; }
    asm volatile("s_waitcnt lgkmcnt(0)" ::: "memory");
}
__device__ __forceinline__ void adaln_block(const Params& p, float* ldsf, int cb, int tid) {
    const int lane = tid & 63, wv = tid >> 6, e = cb * 64 + lane;
    float* SC = ldsf; float* RED = ldsf + 16384; float* mod = (float*)(p.ws + WS_MOD);
    float wreg[128];
#pragma unroll
    for (int d = 0; d < 128; ++d) wreg[d] = p.w_ada[(size_t)(wv * 128 + d) * 6144 + e];
    for (int half = 0; half < 2; ++half) {
        const int b0 = half * 16;
        for (int i = tid; i < 16384; i += 512) { const float cv = p.c[b0 * 1024 + i]; SC[i] = cv / (1.f + __expf(-cv)); }
        __syncthreads();
        float acc[16];
#pragma unroll
        for (int bb = 0; bb < 16; ++bb) acc[bb] = 0.f;
#pragma unroll
        for (int dd = 0; dd < 128; dd += 4) { const int d = wv * 128 + dd;
            const float w0 = wreg[dd], w1 = wreg[dd + 1], w2 = wreg[dd + 2], w3 = wreg[dd + 3];
#pragma unroll
            for (int bb = 0; bb < 16; ++bb) { const f32x4 s = *(const f32x4*)(SC + bb * 1024 + d); acc[bb] += (s.x * w0 + s.y * w1) + (s.z * w2 + s.w * w3); }
        }
#pragma unroll
        for (int bb = 0; bb < 16; ++bb) RED[(wv * 16 + bb) * 64 + lane] = acc[bb];
        __syncthreads();
#pragma unroll
        for (int q = 0; q < 2; ++q) { const int bb = wv * 2 + q; float s = p.b_ada[e];
#pragma unroll
            for (int ww = 0; ww < 8; ++ww) s += RED[(ww * 16 + bb) * 64 + lane];
            mod[(size_t)(b0 + bb) * 6144 + e] = s; }
        __syncthreads();
    }
}
__device__ __forceinline__ void phase_pro(const Params& p, unsigned char* lds, int tid, int G) {
    const int lane = tid & 63, wv = tid >> 6;
    for (int cb = blockIdx.x; cb < 96; cb += G) adaln_block(p, (float*)lds, cb, tid);
    __syncthreads();
    float* scr = (float*)lds + wv * (64 * 33 + 16);
    const int gw = blockIdx.x * NWAVES + wv, NGW = G * NWAVES;
    bf16* WIN = (bf16*)(p.ws + WS_WIN); bf16* WOUT = (bf16*)(p.ws + WS_WOUT); bf16* W1 = (bf16*)(p.ws + WS_W1); bf16* W2 = (bf16*)(p.ws + WS_W2);
    bf16* WUKT = (bf16*)(p.ws + WS_WUKT); bf16* WUK = (bf16*)(p.ws + WS_WUK); bf16* WUVT = (bf16*)(p.ws + WS_WUVT);
    constexpr int I_IN = (DM / 64) * (NPROJ / 32), I_OUT = (DM / 64) * (DM / 32), I_1 = (DM / 64) * (FF / 32), I_2 = (FF / 64) * (DM / 32), I_UK = (128 / 64) * (512 / 32);
    constexpr int I_LR = 512 / 32;
    constexpr int NITEMS = I_IN + I_OUT + I_1 + I_2 + 2 * I_UK + 4 * I_LR;
    for (int it = gw; it < NITEMS; it += NGW) {
        int r = it;
        if (r < I_IN) { if (MK_F8_GEMM1) conv_t_item_f8(p.w_in, DM, 3016, (unsigned char*)WIN, NPROJ / 32, r, scr, lane, 32.f, true); else conv_t_item(p.w_in, DM, 3016, WIN, NPROJ / 32, r, scr, lane, true); continue; } r -= I_IN;
        if (r < I_OUT) { if (MK_F8_GOUT) conv_t_item_f8(p.w_out, DM, DM, (unsigned char*)WOUT, DM / 32, r, scr, lane, 32.f); else conv_t_item(p.w_out, DM, DM, WOUT, DM / 32, r, scr, lane, false); continue; } r -= I_OUT;
        if (r < I_1) { conv_t_item(p.w_ff1, DM, FF, W1, FF / 32, r, scr, lane, false); continue; } r -= I_1;
        if (r < I_2) { conv_t_item_f8(p.w_ff2, FF, DM, (unsigned char*)W2, DM / 32, r, scr, lane, 64.f); continue; } r -= I_2;
        if (r < I_UK) { conv_t_item(p.w_uk, 128, 512, WUKT, 512 / 32, r, scr, lane, false); continue; } r -= I_UK;
        if (r < I_UK) { conv_t_item(p.w_uv, 128, 512, WUVT, 512 / 32, r, scr, lane, false); continue; } r -= I_UK;
        if (r < I_LR) { conv_t_item(p.w2, 64, 512, (bf16*)(p.ws + WS_W2T), 512 / 32, r, scr, lane, false); continue; } r -= I_LR;
        if (r < I_LR) { conv_t_item(p.a2, 64, 512, (bf16*)(p.ws + WS_A2T), 512 / 32, r, scr, lane, false); continue; } r -= I_LR;
        conv_t_item(p.g2, 128, 512, (bf16*)(p.ws + WS_G2T), 512 / 32, r, scr, lane, false);
    }
    { float* ROWSQ = (float*)(p.ws + WS_ROWSQ); for (int i = blockIdx.x * 512 + tid; i < M; i += G * 512) ROWSQ[i] = 0.f; }
    for (int i = blockIdx.x * 512 + tid; i < 128 * 512 / 2; i += G * 512) { const float a = p.w_uk[2 * i], b = p.w_uk[2 * i + 1]; ((unsigned*)WUK)[i] = pk2(a, b); }
}

template <bool F8OUT> __device__ __forceinline__ void hn_rows(const float* src, const float* g, const float* mod, int off_sh, int off_sc, bf16* dst, int gw, int NGW, int lane) {
    const int RPW = M / NGW;
    for (int m0 = gw * RPW; m0 < M; m0 += NGW * RPW) {
        const float* mb = mod + (size_t)(m0 >> 11) * 6144;
        f32x4 ga[4], sh[4];
#pragma unroll
        for (int j = 0; j < 4; ++j) { const int col = 4 * lane + 256 * j; const f32x4 gg = *(const f32x4*)(g + col), sc = *(const f32x4*)(mb + off_sc + col); ga[j] = gg * (1.f + sc); sh[j] = *(const f32x4*)(mb + off_sh + col); }
        for (int r0 = 0; r0 < RPW; r0 += 4) {
            f32x4 v[4][4]; float s[4];
#pragma unroll
            for (int r = 0; r < 4; ++r) { const f32x4* xr = (const f32x4*)(src + (size_t)(m0 + r0 + r) * DM) + lane;
#pragma unroll
                for (int j = 0; j < 4; ++j) v[r][j] = xr[64 * j]; }
#pragma unroll
            for (int r = 0; r < 4; ++r) { s[r] = 0.f;
#pragma unroll
                for (int j = 0; j < 4; ++j) s[r] += (v[r][j].x * v[r][j].x + v[r][j].y * v[r][j].y) + (v[r][j].z * v[r][j].z + v[r][j].w * v[r][j].w); }
#pragma unroll
            for (int o = 1; o < 64; o <<= 1) {
#pragma unroll
                for (int r = 0; r < 4; ++r) s[r] += __shfl_xor(s[r], o); }
#pragma unroll
            for (int r = 0; r < 4; ++r) { const int m = m0 + r0 + r; const float rstd = rsqrtf(s[r] * (1.f / DM) + 1e-6f);
                unsigned long long* o8 = (unsigned long long*)(dst + (size_t)m * DM) + lane;
#pragma unroll
                for (int j = 0; j < 4; ++j) { const f32x4 y = v[r][j] * rstd * ga[j] + sh[j];
                    if (F8OUT) ((unsigned*)((unsigned char*)dst + (size_t)m * DM))[lane + 64 * j] = pg8::pk4_fp8(y.x, y.y, y.z, y.w);
                    else o8[64 * j] = (unsigned long long)pk2(y.x, y.y) | ((unsigned long long)pk2(y.z, y.w) << 32); } }
        }
    }
}

typedef short s16x4 __attribute__((ext_vector_type(4)));
__device__ __forceinline__ f32x4 mfma16k(s16x4 a, s16x4 b, f32x4 c) { return __builtin_amdgcn_mfma_f32_16x16x16bf16_1k(a, b, c, 0, 0, 0); }
__device__ __forceinline__ s16x4 pack4(f32x4 v) { u32x2 o; o.x = pk2(v[0], v[1]); o.y = pk2(v[2], v[3]); return __builtin_bit_cast(s16x4, o); }

__device__ __forceinline__ float dpp_row_sum16(float x) {
    x += __builtin_bit_cast(float, __builtin_amdgcn_mov_dpp(__builtin_bit_cast(int, x), 0xB1, 0xF, 0xF, true));
    x += __builtin_bit_cast(float, __builtin_amdgcn_mov_dpp(__builtin_bit_cast(int, x), 0x4E, 0xF, 0xF, true));
    x += __builtin_bit_cast(float, __builtin_amdgcn_mov_dpp(__builtin_bit_cast(int, x), 0x141, 0xF, 0xF, true));
    x += __builtin_bit_cast(float, __builtin_amdgcn_mov_dpp(__builtin_bit_cast(int, x), 0x140, 0xF, 0xF, true));
    return x;
}
__device__ __forceinline__ void rwkv_prep_item(const Params& p, unsigned char* lds, int it, int tid_in) {
    int tid = tid_in; asm volatile("" : "+v"(tid));
    const int lane = tid & 63, wv = __builtin_amdgcn_readfirstlane(tid >> 6);
    bf16* XS = (bf16*)lds;
    bf16* STG = (bf16*)(lds + 33792) + wv * 4096;
    float* MAB = (float*)(lds + 99328) + wv * 256;
    bf16* RKV = (bf16*)(lds + 107520) + wv * 3468;
    const bf16* PROJ = (const bf16*)(p.ws + WS_PROJ);
    const bf16* W2T = (const bf16*)(p.ws + WS_W2T); const bf16* A2T = (const bf16*)(p.ws + WS_A2T); const bf16* G2T = (const bf16*)(p.ws + WS_G2T);
    float* GAM = (float*)(p.ws + WS_GAM); float* C3 = (float*)(p.ws + WS_C3); bf16* GB = (bf16*)(p.ws + WS_G);
    const int row0 = it * 64, t0 = (it & 31) * 64, b = it >> 5;
    __syncthreads();
    {   const int xt = tid >> 5, xch = tid & 31;
        const f32x4 m0_ = *(const f32x4*)(p.mu + 1536 + 8 * xch), m1_ = *(const f32x4*)(p.mu + 1536 + 8 * xch + 4); const float sc_ = xch < 8 ? 2.f : -1.f;
        u32x4 xc[4], xp[4];
#pragma unroll
        for (int qq = 0; qq < 4; ++qq) { const int t = xt + 16 * qq; const bf16* src_ = PROJ + (size_t)(row0 + t) * NPROJ + PC_XW + 8 * xch; xc[qq] = *(const u32x4*)src_;
            xp[qq] = (u32x4){0u, 0u, 0u, 0u}; if (t0 + t != 0) xp[qq] = *(const u32x4*)(src_ - NPROJ); }
#pragma unroll
        for (int qq = 0; qq < 4; ++qq) { float o_[8];
#pragma unroll
            for (int i = 0; i < 4; ++i) { const float c0_ = bflo(xc[qq][i]), c1_ = bfhi(xc[qq][i]), p0_ = bflo(xp[qq][i]), p1_ = bfhi(xp[qq][i]);
                const float ma_ = i < 2 ? m0_[2 * i] : m1_[2 * i - 4], mb_ = i < 2 ? m0_[2 * i + 1] : m1_[2 * i - 3];
                const float v0_ = c0_ + ma_ * (p0_ - c0_), v1_ = c1_ + mb_ * (p1_ - c1_);
                const float r0_ = 1.f / (1.f + __expf(sc_ * v0_)), r1_ = 1.f / (1.f + __expf(sc_ * v1_));
                o_[2 * i] = xch < 8 ? 1.f - 2.f * r0_ : (xch < 16 ? v0_ : r0_); o_[2 * i + 1] = xch < 8 ? 1.f - 2.f * r1_ : (xch < 16 ? v1_ : r1_); }
            *(u32x4*)(XS + (xt + 16 * qq) * 264 + 8 * xch) = (u32x4){pk2(o_[0], o_[1]), pk2(o_[2], o_[3]), pk2(o_[4], o_[5]), pk2(o_[6], o_[7])}; }
    }
    u32x4 RK[7];
#define RKV_LOAD(rowb, tb) do { _Pragma("unroll") for (int i = 0; i < 7; ++i) { const int id_ = i * 64 + lane, mat_ = id_ / 136, rem_ = id_ - 136 * mat_, rw_ = rem_ >> 3, ch_ = rem_ & 7; \
        RK[i] = (u32x4){0u, 0u, 0u, 0u}; if (id_ < 408 && (tb) - 1 + rw_ >= 0) RK[i] = *(const u32x4*)(PROJ + (size_t)((rowb) - 1 + rw_) * NPROJ + PC_R + 512 * mat_ + wv * 64 + 8 * ch_); } } while (0)
#define RKV_WRITE() do { _Pragma("unroll") for (int i = 0; i < 7; ++i) { const int id_ = i * 64 + lane, mat_ = id_ / 136, rem_ = id_ - 136 * mat_, rw_ = rem_ >> 3, ch_ = rem_ & 7; \
        if (id_ < 408) { bf16* d_ = RKV + mat_ * 1156 + rw_ * 68 + 8 * ch_; *(u32x2*)d_ = (u32x2){RK[i].x, RK[i].y}; *(u32x2*)(d_ + 4) = (u32x2){RK[i].z, RK[i].w}; } } } while (0)
    RKV_LOAD(row0, t0);
    __syncthreads();
#pragma unroll 1
    for (int q = 0; q < 4; ++q) {
        const int rowq = row0 + 16 * q, tq = t0 + 16 * q;
        int lane_ = lane; asm volatile("" : "+v"(lane_));
        const int n_ = lane_ & 15, grp_ = lane_ >> 4;
        const size_t idx = (size_t)(b * 8 + wv) * 128 + (tq >> 4);
        unsigned char* CHp = p.ws + WS_CH + idx * 12288;
        RKV_WRITE();
        if (q < 3) RKV_LOAD(rowq + 16, tq + 16);
        f32x4 dw[4], da[4];
        {   bf16x8 xa[8];
#pragma unroll
            for (int ks = 0; ks < 8; ++ks) xa[ks] = *(const bf16x8*)(XS + (16 * q + n_) * 264 + 32 * ks + 8 * grp_);
            bf16x8 wf[2][8];
#define LORA_LOADW(dst_, ct_) do { const int cc_ = wv * 64 + 16 * (ct_) + n_; \
                _Pragma("unroll") for (int ks = 0; ks < 2; ++ks) { dst_[ks] = *(const bf16x8*)(W2T + cc_ * 64 + 32 * ks + 8 * grp_); dst_[2 + ks] = *(const bf16x8*)(A2T + cc_ * 64 + 32 * ks + 8 * grp_); } \
                _Pragma("unroll") for (int ks = 0; ks < 4; ++ks) dst_[4 + ks] = *(const bf16x8*)(G2T + cc_ * 128 + 32 * ks + 8 * grp_); } while (0)
            LORA_LOADW(wf[0], 0);
#pragma unroll
            for (int ct = 0; ct < 4; ++ct) { const int cc = wv * 64 + 16 * ct + n_;
                if (ct < 3) LORA_LOADW(wf[(ct + 1) & 1], ct + 1);
                f32x4 dg = {0.f, 0.f, 0.f, 0.f}; dw[ct] = dg; da[ct] = dg;
#pragma unroll
                for (int ks = 0; ks < 2; ++ks) dw[ct] = mfma16(xa[ks], wf[ct & 1][ks], dw[ct]);
#pragma unroll
                for (int ks = 0; ks < 2; ++ks) da[ct] = mfma16(xa[2 + ks], wf[ct & 1][2 + ks], da[ct]);
#pragma unroll
                for (int ks = 0; ks < 4; ++ks) dg = mfma16(xa[4 + ks], wf[ct & 1][4 + ks], dg);
#pragma unroll
                for (int rg = 0; rg < 4; ++rg) GB[(size_t)(rowq + 4 * grp_ + rg) * 512 + cc] = f2bf(dg[rg]); }
#undef LORA_LOADW
        }
        asm volatile("s_waitcnt lgkmcnt(0)" ::: "memory");
        {   float kkvA[4][4], kkaA[4][4], kprA[4][4], rA[4][4], vA[4][4], wA[4][4], nrm[4], c3s[4];
#pragma unroll
            for (int rg = 0; rg < 4; ++rg) { nrm[rg] = 0.f; c3s[rg] = 0.f; }
#pragma unroll
            for (int ct = 0; ct < 4; ++ct) { const int j = 16 * ct + n_, c = wv * 64 + j;
                const float mu_r = p.mu[c], mu_k = p.mu[512 + c], mu_v = p.mu[1024 + c], w0c = p.w0[c], a0c = p.a0[c], kkc = p.k_k[c], kac = p.k_a[c], rkc = p.r_k[c];
#pragma unroll
                for (int rg = 0; rg < 4; ++rg) { const int t = 4 * grp_ + rg;
                    const float rp = bf2f(RKV[t * 68 + j]), rc = bf2f(RKV[(t + 1) * 68 + j]);
                    const float kp = bf2f(RKV[1156 + t * 68 + j]), kc = bf2f(RKV[1156 + (t + 1) * 68 + j]);
                    const float vp = bf2f(RKV[2312 + t * 68 + j]), vc = bf2f(RKV[2312 + (t + 1) * 68 + j]);
                    const float r = rc + mu_r * (rp - rc), k = kc + mu_k * (kp - kc); vA[ct][rg] = vc + mu_v * (vp - vc); rA[ct][rg] = r;
                    const float u = w0c + dw[ct][rg]; const float wlog = -__logf(1.f + __expf(-u)) - 0.5f; wA[ct][rg] = __expf(-__expf(wlog));
                    const float a = 1.f / (1.f + __expf(-(a0c + da[ct][rg])));
                    const float kkv = k * kkc, kpr = k * (1.f + (a - 1.f) * kac); kkvA[ct][rg] = kkv; kkaA[ct][rg] = kkv * a; kprA[ct][rg] = kpr;
                    nrm[rg] += kkv * kkv; c3s[rg] += r * kpr * rkc; } }
            float inrm[4];
#pragma unroll
            for (int rg = 0; rg < 4; ++rg) { nrm[rg] = dpp_row_sum16(nrm[rg]); c3s[rg] = dpp_row_sum16(c3s[rg]); inrm[rg] = 1.f / fmaxf(sqrtf(nrm[rg]), 1e-12f); }
            if (n_ == 0) {
#pragma unroll
                for (int rg = 0; rg < 4; ++rg) C3[(size_t)(rowq + 4 * grp_ + rg) * 8 + wv] = c3s[rg]; }
#pragma unroll
            for (int ct = 0; ct < 4; ++ct) { const int j = 16 * ct + n_;
                float lp[4]; lp[0] = wA[ct][0]; lp[1] = lp[0] * wA[ct][1]; lp[2] = lp[1] * wA[ct][2]; lp[3] = lp[2] * wA[ct][3];
                const float P0 = __shfl(lp[3], n_), P1 = __shfl(lp[3], n_ + 16), P2 = __shfl(lp[3], n_ + 32);
                const float E = grp_ == 0 ? 1.f : (grp_ == 1 ? P0 : (grp_ == 2 ? P0 * P1 : P0 * P1 * P2));
                float bt[4], kt[4];
#pragma unroll
                for (int rg = 0; rg < 4; ++rg) { const int t = 4 * grp_ + rg;
                    const float gam = E * lp[rg], gprev = rg == 0 ? E : E * lp[rg - 1], ig = 1.f / gam;
                    const int so = t * 64 + (j ^ (((t >> 1) & 7) << 3));
                    STG[so] = f2bf(-kkvA[ct][rg] * inrm[rg] * gprev); STG[1024 + so] = f2bf(rA[ct][rg] * gam);
                    bt[rg] = kkaA[ct][rg] * inrm[rg] * ig; kt[rg] = kprA[ct][rg] * ig;
                    STG[2048 + so] = f2bf(bt[rg]); STG[3072 + so] = f2bf(kt[rg]); }
                *(u32x2*)(CHp + 4096 + j * 32 + grp_ * 8) = (u32x2){pk2(bt[0], bt[1]), pk2(bt[2], bt[3])};
                *(u32x2*)(CHp + 6144 + j * 32 + grp_ * 8) = (u32x2){pk2(kt[0], kt[1]), pk2(kt[2], kt[3])};
                *(u32x2*)(CHp + 8192 + j * 32 + grp_ * 8) = (u32x2){pk2(vA[ct][0], vA[ct][1]), pk2(vA[ct][2], vA[ct][3])};
                if (grp_ == 3) GAM[idx * 64 + j] = E * lp[3]; }
        }
        asm volatile("s_waitcnt lgkmcnt(0)" ::: "memory");
        {   f32x4 mab = {0.f, 0.f, 0.f, 0.f}, mak = mab, nrb = mab, nrk = mab;
#pragma unroll
            for (int ks = 0; ks < 4; ++ks) { const int o = n_ * 64 + ((16 * ks + 4 * grp_) ^ (((n_ >> 1) & 7) << 3));
                const s16x4 fa = *(const s16x4*)(STG + o), fr = *(const s16x4*)(STG + 1024 + o), fb = *(const s16x4*)(STG + 2048 + o), fk = *(const s16x4*)(STG + 3072 + o);
                mab = mfma16k(fa, fb, mab); mak = mfma16k(fa, fk, mak); nrb = mfma16k(fr, fb, nrb); nrk = mfma16k(fr, fk, nrk); }
            asm volatile("s_waitcnt lgkmcnt(0)" ::: "memory");
            bf16* SM = STG + 2048;
#pragma unroll
            for (int rg = 0; rg < 4; ++rg) { const int t = 4 * grp_ + rg; const bool sl = t > n_, il = t >= n_;
                MAB[t * 16 + n_] = sl ? mab[rg] : 0.f;
                SM[256 + t * 16 + n_] = f2bf(sl ? mak[rg] : 0.f); SM[512 + t * 16 + n_] = f2bf(il ? nrb[rg] : 0.f); SM[768 + t * 16 + n_] = f2bf(il ? nrk[rg] : 0.f); }
            asm volatile("s_waitcnt lgkmcnt(0)" ::: "memory");
            if (lane_ < 16) {
                float Tc[16];
#pragma unroll
                for (int t = 0; t < 16; ++t) { float acc = (t == lane_) ? 1.f : 0.f;
#pragma unroll
                    for (int s2 = 0; s2 < t; ++s2) acc = fmaf(MAB[t * 16 + s2], Tc[s2], acc);
                    Tc[t] = acc; SM[t * 16 + lane_] = f2bf(acc); }
            }
            asm volatile("s_waitcnt lgkmcnt(0)" ::: "memory");
#pragma unroll
            for (int i = 0; i < 4; ++i) { const int id = i * 64 + lane_, rw = id >> 3, c16 = id & 7; *(u32x4*)(CHp + id * 16) = *(const u32x4*)((const unsigned char*)STG + rw * 128 + ((c16 ^ ((rw >> 1) & 7)) << 4)); }
#pragma unroll
            for (int i = 0; i < 2; ++i) { const int id = i * 64 + lane_; *(u32x4*)(CHp + 10240 + id * 16) = *(const u32x4*)((const unsigned char*)SM + id * 16); }
        }
    }
#undef RKV_LOAD
#undef RKV_WRITE
}

__device__ __forceinline__ void stage_w_lds(const bf16* W, unsigned char* lds, int log2_cpr  , int tid) {
    const int cpr = 1 << log2_cpr;
#pragma unroll 4
    for (int i = 0; i < 16; ++i) { const int id = i * 512 + tid, row = id >> log2_cpr, ch = id & (cpr - 1);
        *(u32x4*)(lds + ((size_t)row << (log2_cpr + 4)) + (((ch & ~15) | ((ch ^ row) & 15)) << 4)) = *(const u32x4*)((const unsigned char*)W + (size_t)id * 16); }
}
__device__ __forceinline__ bf16x8 lds_wfrag(const unsigned char* lds, int row, int ch, int log2_cpr) {
    return *(const bf16x8*)(lds + ((size_t)row << (log2_cpr + 4)) + (((ch & ~15) | ((ch ^ row) & 15)) << 4));
}
__device__ __forceinline__ void dsa_prep_kv(const Params& p, const unsigned char* wl, int tile, int lane) {
    const bf16* PROJ = (const bf16*)(p.ws + WS_PROJ); bf16* CKV = (bf16*)(p.ws + WS_CKV); float* INVR = (float*)(p.ws + WS_INVR);
    const int r = lane & 31, hh = lane >> 5; const size_t row = (size_t)tile * 32 + r; const bf16* prow = PROJ + row * NPROJ;
    bf16x8 cf[8];
    {   u32x4 craw[8]; float ssq = 0.f;
#pragma unroll
        for (int s = 0; s < 8; ++s) { craw[s] = *(const u32x4*)(prow + PC_CL + 16 * s + 8 * hh);
#pragma unroll
            for (int w = 0; w < 4; ++w) { const float lo = bflo(craw[s][w]), hi = bfhi(craw[s][w]); ssq += lo * lo + hi * hi; } }
        ssq += __shfl_xor(ssq, 32);
        const float rstd = rsqrtf(ssq * (1.f / 128.f) + 1e-6f);
#pragma unroll
        for (int s = 0; s < 8; ++s) { const float* g = p.g_kv + 16 * s + 8 * hh; const f32x4 g0 = *(const f32x4*)g, g1 = *(const f32x4*)(g + 4);
            u32x4 o; o.x = pk2(bflo(craw[s].x) * rstd * g0.x, bfhi(craw[s].x) * rstd * g0.y); o.y = pk2(bflo(craw[s].y) * rstd * g0.z, bfhi(craw[s].y) * rstd * g0.w);
            o.z = pk2(bflo(craw[s].z) * rstd * g1.x, bfhi(craw[s].z) * rstd * g1.y); o.w = pk2(bflo(craw[s].w) * rstd * g1.z, bfhi(craw[s].w) * rstd * g1.w);
            cf[s] = __builtin_bit_cast(bf16x8, o); *(u32x4*)(CKV + row * 128 + 16 * s + 8 * hh) = o; }
    }
    unsigned wb[8];
#pragma unroll
    for (int s = 0; s < 8; ++s) wb[s] = (unsigned)(r * 256 + ((((2 * s + hh) ^ r) & 15) << 4));
#pragma unroll 1
    for (int h = 0; h < 8; ++h) { float ss = 0.f;
#pragma unroll
        for (int dt = 0; dt < 2; ++dt) { f32x16 acc = {}; const unsigned char* wg = wl + (h * 64 + dt * 32) * 256;
#pragma unroll
            for (int s = 0; s < 8; ++s) acc = mfma32(*(const bf16x8*)(wg + wb[s]), cf[s], acc);
#pragma unroll
            for (int i = 0; i < 16; ++i) ss += acc[i] * acc[i]; }
        ss += __shfl_xor(ss, 32);
        if (hh == 0) INVR[row * 8 + h] = rsqrtf(ss * (1.f / 64.f) + 1e-6f);
    }
}
__device__ __forceinline__ void dsa_prep_q(const Params& p, const unsigned char* wl, int tile, int lane) {
    const bf16* PROJ = (const bf16*)(p.ws + WS_PROJ); bf16* QABS = (bf16*)(p.ws + WS_REGA);
    const int r = lane & 31, hh = lane >> 5; const size_t row = (size_t)tile * 32 + r; const bf16* prow = PROJ + row * NPROJ;
    unsigned wb[2][4];
#pragma unroll
    for (int hp = 0; hp < 2; ++hp)
#pragma unroll
        for (int s = 0; s < 4; ++s) wb[hp][s] = (unsigned)(r * 1024 + ((((hp * 8 + 2 * s + hh) ^ r) & 15) << 4));
#pragma unroll 2
    for (int h = 0; h < 8; ++h) {
        u32x4 qraw[4]; float ssq = 0.f;
#pragma unroll
        for (int s = 0; s < 4; ++s) { qraw[s] = *(const u32x4*)(prow + PC_Q + h * 64 + 16 * s + 8 * hh);
#pragma unroll
            for (int w = 0; w < 4; ++w) { const float lo = bflo(qraw[s][w]), hi = bfhi(qraw[s][w]); ssq += lo * lo + hi * hi; } }
        ssq += __shfl_xor(ssq, 32);
        const float rstd = rsqrtf(ssq * (1.f / 64.f) + 1e-6f);
        bf16x8 qf[4];
#pragma unroll
        for (int s = 0; s < 4; ++s) { const int d0 = 16 * s + 8 * hh; float gg[8];
#pragma unroll
            for (int j = 0; j < 8; ++j) gg[j] = p.g_q[d0 + j] * p.g_k[d0 + j] * rstd;
            u32x4 o; o.x = pk2(bflo(qraw[s].x) * gg[0], bfhi(qraw[s].x) * gg[1]); o.y = pk2(bflo(qraw[s].y) * gg[2], bfhi(qraw[s].y) * gg[3]);
            o.z = pk2(bflo(qraw[s].z) * gg[4], bfhi(qraw[s].z) * gg[5]); o.w = pk2(bflo(qraw[s].w) * gg[6], bfhi(qraw[s].w) * gg[7]);
            qf[s] = __builtin_bit_cast(bf16x8, o); }
#pragma unroll
        for (int lt = 0; lt < 4; ++lt) { f32x16 acc = {}; const unsigned char* wg = wl + lt * 32768 + (h >> 1) * 256;
#pragma unroll
            for (int s = 0; s < 4; ++s) acc = mfma32(*(const bf16x8*)(wg + wb[h & 1][s]), qf[s], acc);
#pragma unroll
            for (int g4 = 0; g4 < 4; ++g4) { u32x2 o; o.x = pk2(acc[4 * g4] * 0.125f, acc[4 * g4 + 1] * 0.125f); o.y = pk2(acc[4 * g4 + 2] * 0.125f, acc[4 * g4 + 3] * 0.125f);
                *(u32x2*)(QABS + row * 1024 + h * 128 + lt * 32 + 8 * g4 + 4 * hh) = o; } }
    }
}

constexpr int SCAN_D = 8, SCAN_SLOT = 12288 + 256;
#define SCAN_BAR() do { asm volatile("s_waitcnt lgkmcnt(0)" ::: "memory"); __builtin_amdgcn_s_barrier(); asm volatile("" ::: "memory"); } while (0)
__device__ __forceinline__ void rwkv_scan_chain(const Params& p, unsigned char* lds, int chain, int wv, int lane) {
    const int b = chain >> 3, h = chain & 7;
    const size_t idx0 = (size_t)(b * 8 + h) * 128;
    if (wv >= 4) {
        const int li = (wv - 4) * 64 + lane;
        const unsigned char* src = p.ws + WS_CH + idx0 * 12288 + (size_t)li * 16; const float* gsrc = (const float*)(p.ws + WS_GAM) + idx0 * 64 + (li & 15) * 4;
        const int d0 = (li >> 3) * 128 + ((((li & 7) ^ ((li >> 4) & 7))) << 4);
        u32x4 R[SCAN_D][3]; f32x4 Rg[SCAN_D];
#pragma unroll
        for (int j = 0; j < SCAN_D; ++j) {
#pragma unroll
            for (int i = 0; i < 3; ++i) R[j][i] = *(const u32x4*)(src + (size_t)j * 12288 + i * 4096);
            Rg[j] = *(const f32x4*)(gsrc + (size_t)j * 64); }
        for (int k0 = 0; k0 < 128; k0 += SCAN_D) {
#pragma unroll
            for (int j = 0; j < SCAN_D; ++j) { const int k = k0 + j; unsigned char* slot = lds + (k & 1) * SCAN_SLOT;
                *(u32x4*)(slot + d0) = R[j][0];
#pragma unroll
                for (int i = 1; i < 3; ++i) *(u32x4*)(slot + li * 16 + i * 4096) = R[j][i];
                *(f32x4*)(slot + 12288 + (li & 15) * 16) = Rg[j];
                if (k + SCAN_D < 128) {
#pragma unroll
                    for (int i = 0; i < 3; ++i) R[j][i] = *(const u32x4*)(src + (size_t)(k + SCAN_D) * 12288 + i * 4096);
                    Rg[j] = *(const f32x4*)(gsrc + (size_t)(k + SCAN_D) * 64); }
                SCAN_BAR(); } }
        SCAN_BAR();
    } else {
        const int w = wv, n = lane & 15, grp = lane >> 4;
        bf16* PROJ = (bf16*)(p.ws + WS_PROJ);
        f32x4 S[4];
#pragma unroll
        for (int jt = 0; jt < 4; ++jt) S[jt] = (f32x4){0.f, 0.f, 0.f, 0.f};
        int aoffs[4];
#pragma unroll
        for (int jt = 0; jt < 4; ++jt) aoffs[jt] = n * 128 + ((((2 * jt + (grp >> 1)) ^ ((n >> 1) & 7))) << 4) + 8 * (grp & 1);
        s16x4 at[4], rt[4], bt[4], kt[4], vt, Tm, Mak, Nrb, Nrk; f32x4 gm[4];
#define SCAN_LDF(slot_) do { const unsigned char* CHp = lds + (slot_) * SCAN_SLOT; \
        _Pragma("unroll") for (int jt = 0; jt < 4; ++jt) { at[jt] = *(const s16x4*)(CHp + aoffs[jt]); rt[jt] = *(const s16x4*)(CHp + 2048 + aoffs[jt]); \
            bt[jt] = *(const s16x4*)(CHp + 4096 + (16 * jt + n) * 32 + grp * 8); kt[jt] = *(const s16x4*)(CHp + 6144 + (16 * jt + n) * 32 + grp * 8); \
            gm[jt] = *(const f32x4*)(CHp + 12288 + (16 * jt + 4 * grp) * 4); } \
        vt = *(const s16x4*)(CHp + 8192 + (16 * w + n) * 32 + grp * 8); Tm = *(const s16x4*)(CHp + 10240 + n * 32 + grp * 8); Mak = *(const s16x4*)(CHp + 10752 + n * 32 + grp * 8); \
        Nrb = *(const s16x4*)(CHp + 11264 + n * 32 + grp * 8); Nrk = *(const s16x4*)(CHp + 11776 + n * 32 + grp * 8); } while (0)
        SCAN_BAR();
        SCAN_LDF(0);
        for (int sc = 0; sc < 128; ++sc) {
            s16x4 at_[4], rt_[4], bt_[4], kt_[4]; f32x4 gm_[4];
#pragma unroll
            for (int jt = 0; jt < 4; ++jt) { at_[jt] = at[jt]; rt_[jt] = rt[jt]; bt_[jt] = bt[jt]; kt_[jt] = kt[jt]; gm_[jt] = gm[jt]; }
            const s16x4 vt_ = vt, Tm_ = Tm, Mak_ = Mak, Nrb_ = Nrb, Nrk_ = Nrk;
            SCAN_BAR();
            if (sc + 1 < 128) SCAN_LDF((sc + 1) & 1);
            s16x4 Sb[4];
#pragma unroll
            for (int jt = 0; jt < 4; ++jt) Sb[jt] = pack4(S[jt]);
            f32x4 X = {0.f, 0.f, 0.f, 0.f}, O = X;
#pragma unroll
            for (int jt = 0; jt < 4; ++jt) X = mfma16k(at_[jt], Sb[jt], X);
            X = mfma16k(Mak_, vt_, X);
#pragma unroll
            for (int jt = 0; jt < 4; ++jt) O = mfma16k(rt_[jt], Sb[jt], O);
            O = mfma16k(Nrk_, vt_, O);
            const f32x4 U = mfma16k(Tm_, pack4(X), (f32x4){0.f, 0.f, 0.f, 0.f});
            const s16x4 Ub = pack4(U);
            O = mfma16k(Nrb_, Ub, O);
#pragma unroll
            for (int jt = 0; jt < 4; ++jt) { S[jt] = mfma16k(kt_[jt], vt_, S[jt]); S[jt] = mfma16k(bt_[jt], Ub, S[jt]); S[jt] = S[jt] * gm_[jt]; }
            bf16* orow = PROJ + ((size_t)b * SEQ + sc * 16 + 4 * grp) * NPROJ + PC_R + h * 64 + 16 * w + n;
#pragma unroll
            for (int rg = 0; rg < 4; ++rg) orow[(size_t)rg * NPROJ] = f2bf(O[rg]);
        }
#undef SCAN_LDF
    }
}
__device__ __forceinline__ void rwkv_epi_rows(const Params& p, int gw, int NGW, int lane) {
    bf16* PROJ = (bf16*)(p.ws + WS_PROJ); const bf16* GB = (const bf16*)(p.ws + WS_G); const float* C3 = (const float*)(p.ws + WS_C3);
    const int c0 = lane * 8, h = lane >> 3, RPW = M / NGW;
    float muv[8], lw[8], lb[8];
#pragma unroll
    for (int i = 0; i < 8; ++i) { muv[i] = p.mu[1024 + c0 + i]; lw[i] = p.ln_w[c0 + i]; lb[i] = p.ln_b[c0 + i]; }
    for (int m0 = gw * RPW; m0 < M; m0 += NGW * RPW) {
        u32x4 vprev = {0u, 0u, 0u, 0u}; if ((m0 & (SEQ - 1)) != 0) vprev = *(const u32x4*)(PROJ + (size_t)(m0 - 1) * NPROJ + PC_V + c0);
        for (int r0 = 0; r0 < RPW; r0 += 4) {
            u32x4 oraw[4], vc[4], gr[4]; float c3[4];
#pragma unroll
            for (int r = 0; r < 4; ++r) { const size_t m = (size_t)(m0 + r0 + r); const bf16* prow = PROJ + m * NPROJ;
                oraw[r] = *(const u32x4*)(prow + PC_R + c0); vc[r] = *(const u32x4*)(prow + PC_V + c0); gr[r] = *(const u32x4*)(GB + m * 512 + c0); c3[r] = C3[m * 8 + h]; }
            float o[4][8], sm[4], q[4];
#pragma unroll
            for (int r = 0; r < 4; ++r) { sm[r] = 0.f;
#pragma unroll
                for (int i = 0; i < 4; ++i) { o[r][2 * i] = bflo(oraw[r][i]); o[r][2 * i + 1] = bfhi(oraw[r][i]); sm[r] += o[r][2 * i] + o[r][2 * i + 1]; } }
#pragma unroll
            for (int of = 1; of < 8; of <<= 1) {
#pragma unroll
                for (int r = 0; r < 4; ++r) sm[r] += __shfl_xor(sm[r], of); }
#pragma unroll
            for (int r = 0; r < 4; ++r) { const float mean = sm[r] * (1.f / 64.f); q[r] = 0.f;
#pragma unroll
                for (int i = 0; i < 8; ++i) { o[r][i] -= mean; q[r] += o[r][i] * o[r][i]; } }
#pragma unroll
            for (int of = 1; of < 8; of <<= 1) {
#pragma unroll
                for (int r = 0; r < 4; ++r) q[r] += __shfl_xor(q[r], of); }
#pragma unroll
            for (int r = 0; r < 4; ++r) { const float rstd = rsqrtf(q[r] * (1.f / 64.f) + 64e-5f); const u32x4 vp = r == 0 ? vprev : vc[r - 1];
                const bool first = ((m0 + r0 + r) & (SEQ - 1)) == 0;
                u32x4 out; float y8[8];
#pragma unroll
                for (int i = 0; i < 4; ++i) { float y[2];
#pragma unroll
                    for (int e = 0; e < 2; ++e) { const int ii = 2 * i + e; const float cv = e ? bfhi(vc[r][i]) : bflo(vc[r][i]), pv = first ? 0.f : (e ? bfhi(vp[i]) : bflo(vp[i]));
                        const float v = cv + muv[ii] * (pv - cv), g = e ? bfhi(gr[r][i]) : bflo(gr[r][i]);
                        y[e] = (o[r][ii] * rstd * lw[ii] + lb[ii] + c3[r] * v) * g; }
                    out[i] = pk2(y[0], y[1]);
#if MK_F8_GOUT
                    y8[2 * i] = y[0] * 8.f; y8[2 * i + 1] = y[1] * 8.f;
#endif
                }
#if MK_F8_GOUT
                *(u32x2*)((unsigned char*)(PROJ + (size_t)(m0 + r0 + r) * NPROJ) + 512 + c0) = (u32x2){pg8::pk4_fp8(y8[0], y8[1], y8[2], y8[3]), pg8::pk4_fp8(y8[4], y8[5], y8[6], y8[7])};
#else
                *(u32x4*)(PROJ + (size_t)(m0 + r0 + r) * NPROJ + PC_R + c0) = out;
#endif
            }
            vprev = vc[3];
        }
    }
}

__device__ __forceinline__ unsigned f2key(float f) { unsigned b = __float_as_uint(f); if ((b << 1) == 0u) b = 0u; return (b & 0x80000000u) ? ~b : (b | 0x80000000u); }
__device__ __forceinline__ unsigned offb(unsigned row, unsigned ch) { return 2048u * (row >> 3) + 512u * (ch >> 2) + 64u * (row & 7) + 16u * ((ch & 3) ^ ((row >> 2) & 3)); }

__device__ __forceinline__ void topk_select(float* sc, int N, unsigned* hist, unsigned short* sel, int lane) {
    unsigned* kb = (unsigned*)sc;
    unsigned prefix = 0u, mask = 0u; int rem = 256, mbin = 0;
    const unsigned long long lt_mask = (1ull << lane) - 1ull;
    for (int pass = 0; pass < 4; ++pass) {
        const int shift = 24 - 8 * pass;
#pragma unroll
        for (int i = 0; i < 4; ++i) hist[lane * 4 + i] = 0u;
        asm volatile("s_waitcnt lgkmcnt(0)" ::: "memory");
        for (int base = 0; base < N; base += 256) { const int idx = base + 4 * lane;
            if (idx < N) { u32x4 k4;
                if (pass == 0) { const f32x4 v = *(const f32x4*)(sc + idx); k4 = (u32x4){f2key(v.x), f2key(v.y), f2key(v.z), f2key(v.w)}; *(u32x4*)(kb + idx) = k4; }
                else k4 = *(const u32x4*)(kb + idx);
#pragma unroll
                for (int e = 0; e < 4; ++e) if ((k4[e] & mask) == prefix) atomicAdd(&hist[(k4[e] >> shift) & 255u], 1u); } }
        asm volatile("s_waitcnt lgkmcnt(0)" ::: "memory");
        const unsigned c0 = hist[lane * 4], c1 = hist[lane * 4 + 1], c2 = hist[lane * 4 + 2], c3 = hist[lane * 4 + 3];
        const int cnt4 = (int)(c0 + c1 + c2 + c3);
        int incl = cnt4;
#pragma unroll
        for (int o = 1; o < 64; o <<= 1) { const int v = __shfl_down(incl, o); if (lane + o < 64) incl += v; }
        const int excl = incl - cnt4;
        const bool mine = (excl < rem) && (rem <= incl);
        const unsigned long long bal = __ballot(mine);
        const int L = (int)__builtin_ctzll(bal);
        const int ex = __shfl(excl, L); const int b3 = (int)__shfl((int)c3, L), b2 = (int)__shfl((int)c2, L), b1 = (int)__shfl((int)c1, L), b0 = (int)__shfl((int)c0, L);
        int above = ex, bin;
        if (above + b3 >= rem) { bin = 3; mbin = b3; } else { above += b3; if (above + b2 >= rem) { bin = 2; mbin = b2; } else { above += b2; if (above + b1 >= rem) { bin = 1; mbin = b1; } else { above += b1; bin = 0; mbin = b0; } } }
        rem -= above; prefix |= (unsigned)(L * 4 + bin) << shift; mask |= 0xffu << shift;
        if (pass == 1 && mbin <= 64) break;
    }
    const unsigned T = prefix; const int ngt = 256 - rem; int base_gt = 0, base_eq = 0;
    const bool partial = (mask != 0xffffffffu);
    unsigned short* cand = (unsigned short*)hist;
    for (int base = 0; base < N; base += 256) { const int idx = base + 4 * lane; const bool act = idx < N;
        u32x4 k4 = {0u, 0u, 0u, 0u}; if (act) k4 = *(const u32x4*)(kb + idx);
        bool gt[4], eq[4]; unsigned long long bg[4], be[4];
#pragma unroll
        for (int e = 0; e < 4; ++e) { const unsigned km = k4[e] & mask; gt[e] = act && km > T; eq[e] = act && km == T; bg[e] = __ballot(gt[e]); be[e] = __ballot(eq[e]); }
        int rg = base_gt, re = base_eq;
#pragma unroll
        for (int e = 0; e < 4; ++e) re += __popcll(be[e] & lt_mask);
#pragma unroll
        for (int e = 0; e < 4; ++e) {
            if (gt[e]) sel[rg + __popcll(bg[e] & lt_mask)] = (unsigned short)(idx + e);
            rg += __popcll(bg[e]);
            if (eq[e]) { if (partial) cand[re] = (unsigned short)(idx + e); else if (re < rem) sel[ngt + re] = (unsigned short)(idx + e); re += 1; } }
        base_gt = rg;
#pragma unroll
        for (int e = 0; e < 4; ++e) base_eq += __popcll(be[e]); }
    asm volatile("s_waitcnt lgkmcnt(0)" ::: "memory");
    if (partial) {
        const int m = mbin; const int ci = (lane < m) ? (int)cand[lane] : 0; const unsigned ck = (lane < m) ? kb[ci] : 0u;
        int rank = 0;
        for (int j = 0; j < m; ++j) { const unsigned kj = (unsigned)__shfl((int)ck, j); rank += (kj > ck || (kj == ck && j < lane)) ? 1 : 0; }
        if (lane < m && rank < rem) sel[ngt + rank] = (unsigned short)ci;
        asm volatile("s_waitcnt lgkmcnt(0)" ::: "memory");
    }
}

__device__ __forceinline__ float dpp_row_max16(float x) {
    x = fmaxf(x, __builtin_bit_cast(float, __builtin_amdgcn_mov_dpp(__builtin_bit_cast(int, x), 0xB1, 0xF, 0xF, true)));
    x = fmaxf(x, __builtin_bit_cast(float, __builtin_amdgcn_mov_dpp(__builtin_bit_cast(int, x), 0x4E, 0xF, 0xF, true)));
    x = fmaxf(x, __builtin_bit_cast(float, __builtin_amdgcn_mov_dpp(__builtin_bit_cast(int, x), 0x141, 0xF, 0xF, true)));
    x = fmaxf(x, __builtin_bit_cast(float, __builtin_amdgcn_mov_dpp(__builtin_bit_cast(int, x), 0x140, 0xF, 0xF, true)));
    return x;
}
__device__ __forceinline__ bool topk_select_fast(const float* sc, int N, float smax, unsigned* hist, unsigned short* sel, int lane) {
    const float scale = smax > 0.f ? 127.5f / smax : 0.f;
#define QBIN(x_) min(max((int)fmaf((x_), scale, 128.f), 0), 255)
#pragma unroll
    for (int i = 0; i < 4; ++i) hist[lane * 4 + i] = 0u;
    asm volatile("s_waitcnt lgkmcnt(0)" ::: "memory");
    for (int base = 0; base < N; base += 256) { const int idx = base + 4 * lane;
        if (idx < N) { const f32x4 v = *(const f32x4*)(sc + idx);
#pragma unroll
            for (int e = 0; e < 4; ++e) atomicAdd(&hist[QBIN(v[e])], 1u); } }
    asm volatile("s_waitcnt lgkmcnt(0)" ::: "memory");
    const unsigned c0 = hist[lane * 4], c1 = hist[lane * 4 + 1], c2 = hist[lane * 4 + 2], c3 = hist[lane * 4 + 3];
    const int cnt4 = (int)(c0 + c1 + c2 + c3);
    int incl = cnt4;
#pragma unroll
    for (int o = 1; o < 64; o <<= 1) { const int v = __shfl_down(incl, o); if (lane + o < 64) incl += v; }
    const int excl = incl - cnt4;
    const bool mine = (excl < 256) && (256 <= incl);
    const int L = (int)__builtin_ctzll(__ballot(mine));
    const int ex = __shfl(excl, L); const int b3 = (int)__shfl((int)c3, L), b2 = (int)__shfl((int)c2, L), b1 = (int)__shfl((int)c1, L), b0 = (int)__shfl((int)c0, L);
    int above = ex, bin, mbin;
    if (above + b3 >= 256) { bin = 3; mbin = b3; } else { above += b3; if (above + b2 >= 256) { bin = 2; mbin = b2; } else { above += b2; if (above + b1 >= 256) { bin = 1; mbin = b1; } else { above += b1; bin = 0; mbin = b0; } } }
    if (mbin > 64) return false;
    const int tb = L * 4 + bin, rem = 256 - above, ngt = above; int base_gt = 0, base_eq = 0;
    const unsigned long long lt_mask = (1ull << lane) - 1ull;
    unsigned short* cand = (unsigned short*)hist;
    for (int base = 0; base < N; base += 256) { const int idx = base + 4 * lane; const bool act = idx < N;
        f32x4 v = {0.f, 0.f, 0.f, 0.f}; if (act) v = *(const f32x4*)(sc + idx);
        bool gt[4], eq[4]; unsigned long long bg[4], be[4];
#pragma unroll
        for (int e = 0; e < 4; ++e) { const int qb = QBIN(v[e]); gt[e] = act && qb > tb; eq[e] = act && qb == tb; bg[e] = __ballot(gt[e]); be[e] = __ballot(eq[e]); }
        int rg = base_gt, re = base_eq;
#pragma unroll
        for (int e = 0; e < 4; ++e) re += __popcll(be[e] & lt_mask);
#pragma unroll
        for (int e = 0; e < 4; ++e) {
            if (gt[e]) sel[rg + __popcll(bg[e] & lt_mask)] = (unsigned short)(idx + e);
            rg += __popcll(bg[e]);
            if (eq[e]) { cand[re] = (unsigned short)(idx + e); re += 1; } }
        base_gt = rg;
#pragma unroll
        for (int e = 0; e < 4; ++e) base_eq += __popcll(be[e]); }
    asm volatile("s_waitcnt lgkmcnt(0)" ::: "memory");
    {   const int m = mbin; const int ci = (lane < m) ? (int)cand[lane] : 0; const unsigned ck = (lane < m) ? f2key(sc[ci]) : 0u;
        int rank = 0;
        for (int j = 0; j < m; ++j) { const unsigned kj = (unsigned)__shfl((int)ck, j); rank += (kj > ck || (kj == ck && j < lane)) ? 1 : 0; }
        if (lane < m && rank < rem) sel[ngt + rank] = (unsigned short)ci;
        asm volatile("s_waitcnt lgkmcnt(0)" ::: "memory"); }
#undef QBIN
    return true;
}

__device__ __forceinline__ void dsa_attend(const Params& p, int b, int t, const unsigned short* sel, int cnt, unsigned char* stage, int lane_in, const u32x4 (&bqv)[4]) {
    int lane = lane_in; asm volatile("" : "+v"(lane));
    const bf16* CKV = (const bf16*)(p.ws + WS_CKV) + (size_t)b * SEQ * 128; const float* INVR = (const float*)(p.ws + WS_INVR) + (size_t)b * SEQ * 8;
    bf16* QO = (bf16*)(p.ws + WS_REGA) + ((size_t)b * SEQ + t) * 1024;
    const int hd = lane & 15, grp = lane >> 4;
    bf16x8 bq[4];
#pragma unroll
    for (int s = 0; s < 4; ++s) bq[s] = __builtin_bit_cast(bf16x8, bqv[s]);
    const float slope = (hd < 8) ? exp2f(-(float)(hd + 1)) : 0.f;
    const int hsafe = hd & 7;
    float m_run = -INFINITY, l_part = 0.f;
    f32x4 O[8];
#pragma unroll
    for (int c = 0; c < 8; ++c) O[c] = (f32x4){0.f, 0.f, 0.f, 0.f};
    const LAS unsigned char* st3 = (const LAS unsigned char*)stage;
    const unsigned q4 = (lane & 15) >> 2, p4 = lane & 3;
    u32x4 G[8]; float IRn[8], PNn[8];
#define DA_ISSUE(ks_) do { \
    _Pragma("unroll") for (int i = 0; i < 8; ++i) { const int id = i * 64 + lane, row = id >> 4, ch = id & 15; const unsigned key = sel[(ks_) + row]; G[i] = *(const u32x4*)((const unsigned char*)CKV + (key * 256u + (unsigned)ch * 16u)); } } while (0)
#define DA_ISSUE2(ks_) do { \
    _Pragma("unroll") for (int i = 0; i < 8; ++i) { const int key = sel[(ks_) + 16 * (i >> 2) + 4 * grp + (i & 3)]; IRn[i] = *(const float*)((const unsigned char*)INVR + ((unsigned)key * 32u + (unsigned)hsafe * 4u)); PNn[i] = slope * fabsf((float)(t - key)); } } while (0)
    DA_ISSUE(cnt - 32); DA_ISSUE2(cnt - 32);
    for (int ks = cnt - 32; ks >= 0; ks -= 32) {
#pragma unroll
        for (int i = 0; i < 8; ++i) { const int id = i * 64 + lane, row = id >> 4, ch = id & 15; *(u32x4*)(stage + offb(row, ch)) = G[i]; }
        asm volatile("s_waitcnt lgkmcnt(0)" ::: "memory");
        if (ks >= 32) DA_ISSUE(ks - 32);
        float lg[8];
#pragma unroll
        for (int T = 0; T < 2; ++T) { f32x4 acc = {0.f, 0.f, 0.f, 0.f};
#pragma unroll
            for (int s = 0; s < 4; ++s) { const bf16x8 a = *(const bf16x8*)(stage + offb((lane & 15) + 16 * T, 4 * s + grp)); acc = mfma16(a, bq[s], acc); }
#pragma unroll
            for (int rg = 0; rg < 4; ++rg) lg[4 * T + rg] = acc[rg] * IRn[4 * T + rg] - PNn[4 * T + rg]; }
        if (ks >= 32) DA_ISSUE2(ks - 32);
        float mx = lg[0];
#pragma unroll
        for (int i = 1; i < 8; ++i) mx = fmaxf(mx, lg[i]);
        mx = fmaxf(mx, __shfl_xor(mx, 16)); mx = fmaxf(mx, __shfl_xor(mx, 32));
        const float m_new = fmaxf(m_run, mx);
        const float alpha = __expf(m_run - m_new);
        float ps = 0.f;
#pragma unroll
        for (int i = 0; i < 8; ++i) { lg[i] = __expf(lg[i] - m_new); ps += lg[i]; }
        l_part = l_part * alpha + ps; m_run = m_new;
        { float ar[4];
#pragma unroll
            for (int rg = 0; rg < 4; ++rg) ar[rg] = __shfl(alpha, 4 * grp + rg);
#pragma unroll
            for (int c = 0; c < 8; ++c)
#pragma unroll
                for (int rg = 0; rg < 4; ++rg) O[c][rg] *= ar[rg]; }
        {   u32x4 pw; pw.x = pk2(lg[0], lg[1]); pw.y = pk2(lg[2], lg[3]); pw.z = pk2(lg[4], lg[5]); pw.w = pk2(lg[6], lg[7]);
            const bf16x8 pa = __builtin_bit_cast(bf16x8, pw);
#pragma unroll
            for (int c = 0; c < 8; ++c) {
                const s16x4 lo = __builtin_bit_cast(s16x4, __builtin_amdgcn_ds_read_tr16_b64_v4i16((LAS s16x4*)(st3 + offb(4 * grp + q4, 2 * c + (p4 >> 1)) + 8 * (p4 & 1))));
                const s16x4 hi = __builtin_bit_cast(s16x4, __builtin_amdgcn_ds_read_tr16_b64_v4i16((LAS s16x4*)(st3 + offb(16 + 4 * grp + q4, 2 * c + (p4 >> 1)) + 8 * (p4 & 1))));
                const bf16x8 vb = {lo[0], lo[1], lo[2], lo[3], hi[0], hi[1], hi[2], hi[3]};
                O[c] = mfma16(pa, vb, O[c]); } }
        asm volatile("s_waitcnt lgkmcnt(0)" ::: "memory");
    }
#undef DA_ISSUE
#undef DA_ISSUE2
    float l = l_part; l += __shfl_xor(l, 16); l += __shfl_xor(l, 32);
    const float il = 1.f / l;
    float irr[4];
#pragma unroll
    for (int rg = 0; rg < 4; ++rg) irr[rg] = __shfl(il, 4 * grp + rg);
    if (grp < 2) {
#pragma unroll
        for (int rg = 0; rg < 4; ++rg)
#pragma unroll
            for (int c = 0; c < 8; ++c) QO[(4 * grp + rg) * 128 + 16 * c + hd] = f2bf(O[c][rg] * irr[rg]);
    }
}

#define DSA_LOAD_AF(af_, wqv_, b_, tq0_) do { const size_t rq_ = (size_t)(b_) * SEQ + (tq0_); const int r_ = lane & 31, g_ = lane >> 5, ql_ = 2 * ((r_ >> 2) & 1) + (r_ >> 4), hdm_ = 4 * ((r_ >> 3) & 1) + (r_ & 3); \
    _Pragma("unroll") for (int qg = 0; qg < 4; ++qg) _Pragma("unroll") for (int s = 0; s < 4; ++s) af_[qg][s] = *(const bf16x8*)(PROJ + (rq_ + 4 * qg + ql_) * NPROJ + PC_QI + hdm_ * 64 + 16 * s + 8 * g_); \
    wqv_ = (tid < 128) ? bf2f(PROJ[(rq_ + (tid >> 3)) * NPROJ + PC_WI + (tid & 7)]) * 0.044194173824159216f : 0.f; } while (0)
__device__ __forceinline__ void dsa_select_item(const Params& p, unsigned char* lds, int b, int tq0, int tid, bf16x8 (&af)[4][4], float& wqv, bool has_next, int nb, int ntq0) {
    bf16* PROJ = (bf16*)(p.ws + WS_PROJ);
    float* SC = (float*)lds;
    unsigned* HIST = (unsigned*)(lds + 131072);
    unsigned short* SEL = (unsigned short*)(lds + 131072 + 8192);
    float* WQ = (float*)(lds + 147456);
    unsigned* QMAX = (unsigned*)(lds + 147456 + 512);
    asm volatile("" : "+v"(tid));
    const int lane = tid & 63, wv = __builtin_amdgcn_readfirstlane(tid >> 6);
    const int N = ((tq0 >> 6) + 1) * 64; const size_t rowq0 = (size_t)b * SEQ + tq0;
    {
        const int r = lane & 31, g = lane >> 5;
        if (tid < 128) WQ[tid] = wqv;
        if (tid < 16) QMAX[tid] = 0u;
        float mxq[4][2];
#pragma unroll
        for (int qg = 0; qg < 4; ++qg) { mxq[qg][0] = 0.f; mxq[qg][1] = 0.f; }
        __syncthreads();
        bf16x8 bfr[4];
        { const bf16* krow = PROJ + ((size_t)b * SEQ + wv * 32 + r) * NPROJ + PC_KI + 8 * g;
#pragma unroll
          for (int s = 0; s < 4; ++s) bfr[s] = *(const bf16x8*)(krow + 16 * s); }
        for (int kt = wv; kt < N / 32; kt += NWAVES) {
            const int key = kt * 32 + r;
            bf16x8 bnx[4];
#pragma unroll
            for (int s = 0; s < 4; ++s) bnx[s] = bfr[s];
            if (kt + NWAVES < N / 32) { const bf16* krow = PROJ + ((size_t)b * SEQ + key + 32 * NWAVES) * NPROJ + PC_KI + 8 * g;
#pragma unroll
                for (int s = 0; s < 4; ++s) bnx[s] = *(const bf16x8*)(krow + 16 * s); }
#pragma unroll
            for (int qg = 0; qg < 4; ++qg) { f32x16 acc = {};
#pragma unroll
                for (int s = 0; s < 4; ++s) acc = mfma32(af[qg][s], bfr[s], acc);
#pragma unroll
                for (int qq = 0; qq < 2; ++qq) { float sc = 0.f; const f32x4 w0 = *(const f32x4*)(WQ + (4 * qg + 2 * g + qq) * 8), w1 = *(const f32x4*)(WQ + (4 * qg + 2 * g + qq) * 8 + 4);
#pragma unroll
                    for (int e = 0; e < 4; ++e) { sc = fmaf(w0[e], fmaxf(acc[8 * qq + e], 0.f), sc); sc = fmaf(w1[e], fmaxf(acc[8 * qq + 4 + e], 0.f), sc); }
                    SC[(4 * qg + 2 * g + qq) * 2048 + key] = sc; mxq[qg][qq] = fmaxf(mxq[qg][qq], fabsf(sc)); } }
#pragma unroll
            for (int s = 0; s < 4; ++s) bfr[s] = bnx[s];
        }
#pragma unroll
        for (int qg = 0; qg < 4; ++qg)
#pragma unroll
            for (int qq = 0; qq < 2; ++qq) { float m = dpp_row_max16(mxq[qg][qq]); m = fmaxf(m, __shfl_xor(m, 16));
                if (r == 0) atomicMax(&QMAX[4 * qg + 2 * g + qq], __float_as_uint(m)); }
        __syncthreads();
        if (has_next) DSA_LOAD_AF(af, wqv, nb, ntq0);
        bool fb[2];
        for (int q = 0; q < 2; ++q) fb[q] = !topk_select_fast(SC + (2 * wv + q) * 2048, N, __uint_as_float(QMAX[2 * wv + q]), HIST + wv * 256, SEL + (2 * wv + q) * 256, lane);
        for (int q = 0; q < 2; ++q) if (fb[q]) topk_select(SC + (2 * wv + q) * 2048, N, HIST + wv * 256, SEL + (2 * wv + q) * 256, lane);
    }
    asm volatile("s_waitcnt lgkmcnt(0)" ::: "memory");
    { const int q = lane >> 5; const u32x4 v = *(const u32x4*)(SEL + (2 * wv + q) * 256 + (lane & 31) * 8);
      *(u32x4*)(PROJ + (rowq0 + 2 * wv + q) * NPROJ + PC_Q + (lane & 31) * 8) = v; }
    __syncthreads();
}

__device__ __forceinline__ void dsa_attend_rows(const Params& p, unsigned char* wlds, int gw, int NGW, int lane) {
    const bf16* PROJ = (const bf16*)(p.ws + WS_PROJ); const bf16* QA = (const bf16*)(p.ws + WS_REGA);
    unsigned short* SELW = (unsigned short*)(wlds + 8192);
    const int hd = lane & 15, grp = lane >> 4;
    u32x4 selv = {0u, 0u, 0u, 0u}, bqv[4];
#define ATT_PREFETCH(row_) do { const int t_ = (row_) & (SEQ - 1); \
        if (t_ >= 256 && lane < 32) selv = *(const u32x4*)(PROJ + (size_t)(row_) * NPROJ + PC_Q + lane * 8); \
        _Pragma("unroll") for (int s = 0; s < 4; ++s) { bqv[s] = (u32x4){0u, 0u, 0u, 0u}; if (hd < 8) bqv[s] = *(const u32x4*)(QA + (size_t)(row_) * 1024 + hd * 128 + 32 * s + 8 * grp); } } while (0)
    if (gw < M) ATT_PREFETCH(gw);
    for (int row = gw; row < M; row += NGW) {
        const int b = row >> 11, t = row & (SEQ - 1), N = ((t >> 6) + 1) * 64, cnt = N > 256 ? 256 : N;
        if (N > 256) { if (lane < 32) *(u32x4*)(SELW + lane * 8) = selv; }
        else { for (int i = lane; i < cnt; i += 64) SELW[i] = (unsigned short)i; }
        u32x4 bqc[4];
#pragma unroll
        for (int s = 0; s < 4; ++s) bqc[s] = bqv[s];
        asm volatile("s_waitcnt lgkmcnt(0)" ::: "memory");
        if (row + NGW < M) ATT_PREFETCH(row + NGW);
        dsa_attend(p, b, t, SELW, cnt, wlds, lane, bqc);
        asm volatile("s_waitcnt lgkmcnt(0)" ::: "memory");
    }
#undef ATT_PREFETCH
}

__device__ __forceinline__ void uv_item(const Params& p, const unsigned char* wl  , int tile, int lane) {
    bf16* PROJ = (bf16*)(p.ws + WS_PROJ); const bf16* OLAT = (const bf16*)(p.ws + WS_REGA);
    const int r = lane & 31, hh = lane >> 5; const size_t row = (size_t)tile * 32 + r;
    unsigned wb[8];
#pragma unroll
    for (int s = 0; s < 8; ++s) wb[s] = (unsigned)(r * 256 + ((((2 * s + hh) ^ r) & 15) << 4));
#pragma unroll 1
    for (int h = 0; h < 8; ++h) { bf16x8 of[8];
#pragma unroll
        for (int s = 0; s < 8; ++s) of[s] = *(const bf16x8*)(OLAT + row * 1024 + h * 128 + 16 * s + 8 * hh);
#pragma unroll
        for (int dt = 0; dt < 2; ++dt) { f32x16 acc = {}; const unsigned char* wg = wl + (h * 64 + dt * 32) * 256;
#pragma unroll
            for (int s = 0; s < 8; ++s) acc = mfma32(*(const bf16x8*)(wg + wb[s]), of[s], acc);
#pragma unroll
            for (int g4 = 0; g4 < 4; ++g4) {
#if MK_F8_GOUT
                *(unsigned*)((unsigned char*)(PROJ + row * NPROJ) + h * 64 + dt * 32 + 8 * g4 + 4 * hh) = pg8::pk4_fp8(acc[4 * g4] * 8.f, acc[4 * g4 + 1] * 8.f, acc[4 * g4 + 2] * 8.f, acc[4 * g4 + 3] * 8.f);
#else
                u32x2 o; o.x = pk2(acc[4 * g4], acc[4 * g4 + 1]); o.y = pk2(acc[4 * g4 + 2], acc[4 * g4 + 3]);
                *(u32x2*)(PROJ + row * NPROJ + PC_Q + h * 64 + dt * 32 + 8 * g4 + 4 * hh) = o;
#endif
            } }
    }
}

__device__ __forceinline__ void bias2_item(const Params& p, int item, int lane) {
    const bf16* W1T = (const bf16*)(p.ws + WS_W1); const float* MOD = (const float*)(p.ws + WS_MOD); float* BIAS2 = (float*)(p.ws + WS_BIAS2);
    const int r = lane & 31, hh = lane >> 5, f0 = item * 32;
    const bf16* wrow = W1T + (size_t)(f0 + r) * DM + 8 * hh; const float* srow = MOD + (size_t)r * 6144 + 3072 + 8 * hh;
    f32x16 acc = {};
#pragma unroll 8
    for (int s = 0; s < 64; ++s) { const bf16x8 a = *(const bf16x8*)(wrow + 16 * s); const f32x4 s0 = *(const f32x4*)(srow + 16 * s), s1 = *(const f32x4*)(srow + 16 * s + 4);
        const u32x4 bw = {pk2(s0.x, s0.y), pk2(s0.z, s0.w), pk2(s1.x, s1.y), pk2(s1.z, s1.w)};
        acc = mfma32(a, __builtin_bit_cast(bf16x8, bw), acc); }
#pragma unroll
    for (int i = 0; i < 16; ++i) BIAS2[(size_t)r * 4096 + f0 + (i & 3) + 8 * (i >> 2) + 4 * hh] = acc[i];
}

typedef __attribute__((address_space(1))) unsigned gu32;
#define RLX_AGENT __ATOMIC_RELAXED, __HIP_MEMORY_SCOPE_AGENT
#define XB_TMO      128
#define XB_XCNT(j)  (256  + 64 * (j))
#define XB_XSUB(j)  (1280 + 64 * (j))
#define XB_XGEN(j)  (2304 + 64 * (j))
#define XB_TOP      3328
#define XB_TOPGEN   3392
#define XCD_BAR_WORDS 3456
#define XB_SPIN_CAP (1u << 18)

__device__ __forceinline__ unsigned xb_ld(unsigned* p)              { return __hip_atomic_load(p, __ATOMIC_RELAXED, __HIP_MEMORY_SCOPE_AGENT); }
__device__ __forceinline__ unsigned xb_add(unsigned* p, unsigned v) { return __hip_atomic_fetch_add(p, v, __ATOMIC_RELAXED, __HIP_MEMORY_SCOPE_AGENT); }
__device__ __forceinline__ unsigned xb_xcc_id() { return (unsigned)__builtin_amdgcn_s_getreg((3 << 11) | 20) & 0xFu; }
#define XB_SPIN(cond, bar) do { unsigned _sp = 0; while (cond) { __builtin_amdgcn_s_sleep(1); \
    if ((++_sp & 255u) == 0u) { if (xb_ld(&(bar)[XB_TMO])) break; if (_sp > XB_SPIN_CAP) { atomicAdd(&(bar)[XB_TMO], 1u); break; } } } } while (0)

struct XcdBarrier {
    unsigned* bar; unsigned x;
    volatile LAS unsigned* st;
};

__device__ __forceinline__ XcdBarrier xcd_barrier_post(unsigned* bar, volatile LAS unsigned* st) {
    XcdBarrier b; b.bar = bar; b.x = xb_xcc_id(); b.st = st;
    if (threadIdx.x == 0) (void)xb_add(&bar[XB_XCNT(b.x)], 1u);
    return b;
}
__device__ __forceinline__ void xcd_barrier_complete(unsigned* bar, unsigned x, unsigned& nloc, unsigned& nx) {
    const unsigned G = gridDim.x * gridDim.y * gridDim.z;
    unsigned sum, cnt, mine, sp = 0u;
    for (;;) {
        sum = 0u; cnt = 0u; mine = 0u;
#pragma unroll
        for (unsigned j = 0; j < 16; ++j) { const unsigned c = xb_ld(&bar[XB_XCNT(j)]); sum += c; cnt += (c > 0u) ? 1u : 0u; mine = (j == x) ? c : mine; }
        if (sum == G) break;
        __builtin_amdgcn_s_sleep(1);
        if ((++sp & 255u) == 0u) { if (xb_ld(&bar[XB_TMO])) break; if (sp > XB_SPIN_CAP) { atomicAdd(&bar[XB_TMO], 1u); break; } }
    }
    nloc = mine > 0u ? mine : 1u; nx = cnt > 0u ? cnt : 1u;
}

__device__ __forceinline__ void xcd_barrier(const XcdBarrier& b) {
    asm volatile("s_waitcnt vmcnt(0)" ::: "memory");
    __syncthreads();
    if (threadIdx.x == 0) {
        unsigned* bar = b.bar;
        __builtin_amdgcn_s_waitcnt(0);
        unsigned nloc = b.st[0], nx = b.st[1];
        if (nloc == 0u) { xcd_barrier_complete(bar, b.x, nloc, nx); b.st[0] = nloc; b.st[1] = nx; }
        const unsigned old = xb_add(&bar[XB_XSUB(b.x)], 1u);
        const unsigned gen = old / nloc;
        if (old + 1u == (gen + 1u) * nloc) {
            __builtin_amdgcn_fence(__ATOMIC_RELEASE, "agent");
            asm volatile("s_waitcnt vmcnt(0)" ::: "memory");
            const unsigned og = xb_add(&bar[XB_TOP], 1u);
            const unsigned tg = og / nx;
            if (og + 1u == (tg + 1u) * nx) xb_add(&bar[XB_TOPGEN], 1u);
            else XB_SPIN(xb_ld(&bar[XB_TOPGEN]) == tg, bar);
            __builtin_amdgcn_fence(__ATOMIC_ACQUIRE, "agent");
            xb_add(&bar[XB_XGEN(b.x)], 1u);
            asm volatile("s_waitcnt vmcnt(0)" ::: "memory");
        } else {
            XB_SPIN(xb_ld(&bar[XB_XGEN(b.x)]) == gen, bar);
            __builtin_amdgcn_fence(__ATOMIC_ACQUIRE, "agent");
            asm volatile("s_waitcnt vmcnt(0)" ::: "memory");
        }
    }
    __syncthreads();
}

enum { PH_PRO = 0, PH_HN, PH_GEMM1, PH_PREP, PH_MIX, PH_ATT, PH_UV, PH_GOUT, PH_UP, PH_DOWN, PH_COUNT };
#ifndef MK_SKIP_MIXER
#define MK_SKIP_MIXER 0
#endif
__global__ void __launch_bounds__(NWAVES * 64, 2) mk_fwd(Params p) {
    extern __shared__ __attribute__((aligned(16))) unsigned char lds[];
    cg::grid_group grid = cg::this_grid();
    const int tid = threadIdx.x, lane = tid & 63, wv = __builtin_amdgcn_readfirstlane(tid >> 6);
    const int G = gridDim.x, gw = blockIdx.x * NWAVES + wv, NGW = G * NWAVES;
    const int lo = p.ph_lo, hi = p.ph_hi;
    if (p.ph_hi < 0) grid.sync();
    if (tid < 2) ((volatile LAS unsigned*)((LAS unsigned char*)lds + LDS_BAR_OFF))[tid] = 0u;
    __syncthreads();
    XcdBarrier xbar = xcd_barrier_post((unsigned*)(p.ws + WS_BAR), (volatile LAS unsigned*)((LAS unsigned char*)lds + LDS_BAR_OFF));
    float* MOD = (float*)(p.ws + WS_MOD); bf16* REGA = (bf16*)(p.ws + WS_REGA); bf16* PROJ = (bf16*)(p.ws + WS_PROJ);
#ifndef MK_PHASE_MASK
#define MK_PHASE_MASK 0x3ff
#endif
#define IN(k) (((MK_PHASE_MASK >> (k)) & 1) && lo <= (k) && (k) < hi)
#define SEAM(k) do { if (IN(k) && IN((k) + 1)) { xcd_barrier(xbar); } if (MK_PROBE >= 0 && blockIdx.x == 0 && tid == 0) ((unsigned long long*)(p.ws + WS_MOD + 800 * 1024))[(k) + 1] = __builtin_amdgcn_s_memrealtime(); } while (0)
    if (MK_PROBE >= 0 && blockIdx.x == 0 && tid == 0) ((unsigned long long*)(p.ws + WS_MOD + 800 * 1024))[0] = __builtin_amdgcn_s_memrealtime();
    if (IN(PH_PRO)) { phase_pro(p, lds, tid, G); }
    SEAM(PH_PRO);
    if (IN(PH_HN)) { hn_rows<MK_F8_GEMM1 != 0>(p.x, p.g_mix, MOD, 0, 1024, REGA, gw, NGW, lane); }
    SEAM(PH_HN);
    if (IN(PH_GEMM1)) {
#if MK_F8_GEMM1
        pg8::Gemm g{REGA, (const bf16*)(p.ws + WS_WIN), M, NPROJ, DM / 2, DM / 2}; pg8::StaticOrder S; S.init(M, NPROJ, G, (int)blockIdx.x);
        pg8::EpiBf16<0> E{PROJ, NPROJ, 1.f / 32.f};
        pg8::gemm_phase<pg8::EpiBf16<0>, pg8::StaticOrder, true, true, true>((PG8_LAS unsigned char*)lds, g, S, E);
#else
        pg8::Gemm g{REGA, (const bf16*)(p.ws + WS_WIN), M, NPROJ, DM, DM}; pg8::StaticOrder S; S.init(M, NPROJ, G, (int)blockIdx.x);
        pg8::EpiBf16<0> E{PROJ, NPROJ, 1.f};
        pg8::gemm_phase<pg8::EpiBf16<0>, pg8::StaticOrder, true, true>((PG8_LAS unsigned char*)lds, g, S, E);
#endif
    }
    SEAM(PH_GEMM1);
    if (IN(PH_PREP)) {
#ifndef DBG_NO_RP
        for (int it = blockIdx.x; it < M / 64; it += G) rwkv_prep_item(p, lds, it, tid);
#endif
#ifndef DBG_NO_DP
        __syncthreads();
        stage_w_lds((const bf16*)(p.ws + WS_WUKT), lds, 4, tid); __syncthreads();
        for (int tile = gw; tile < M / 32; tile += NGW) dsa_prep_kv(p, lds, tile, lane);
        __syncthreads();
        stage_w_lds((const bf16*)(p.ws + WS_WUK), lds, 6, tid); __syncthreads();
        for (int tile = gw; tile < M / 32; tile += NGW) dsa_prep_q(p, lds, tile, lane);
#endif
    }
    SEAM(PH_PREP);
    if (IN(PH_MIX)) {
        for (int chain = blockIdx.x; chain < NB * 8; chain += G) { rwkv_scan_chain(p, lds, chain, wv, lane); __syncthreads(); }
        constexpr int NSEL = NB * 112;
        {   bf16x8 af[4][4]; float wqv = 0.f; const bf16* PROJ = (const bf16*)(p.ws + WS_PROJ);
            int idx = (int)blockIdx.x;
            if (idx < NSEL) DSA_LOAD_AF(af, wqv, idx / 112, 256 + 16 * (idx % 112));
            for (int k = 0; idx < NSEL; ++k) { const int nidx = (k + 1) * G + (((k + 1) & 1) ? (G - 1 - (int)blockIdx.x) : (int)blockIdx.x); const bool hn = nidx < NSEL;
                dsa_select_item(p, lds, idx / 112, 256 + 16 * (idx % 112), tid, af, wqv, hn, nidx / 112, 256 + 16 * (nidx % 112)); idx = nidx; } }
    }
    SEAM(PH_MIX);
    if (IN(PH_ATT)) {
        if (gw < 128) bias2_item(p, gw, lane);
        dsa_attend_rows(p, lds + wv * 9216, gw, NGW, lane);
    }

    SEAM(PH_ATT);
    if (IN(PH_UV)) {
#if MK_DBG == 7
        for (int m = gw; m < M; m += NGW) { *(u32x4*)(PROJ + (size_t)m * NPROJ + lane * 8) = *(const u32x4*)(REGA + (size_t)m * 1024 + lane * 8); }
#elif MK_DBG != 2
        stage_w_lds((const bf16*)(p.ws + WS_WUVT), lds, 4, tid); __syncthreads();
        for (int tile = gw; tile < M / 32; tile += NGW) uv_item(p, lds, tile, lane);
#endif
#if MK_DBG == 0
        rwkv_epi_rows(p, gw, NGW, lane);
#endif
#if MK_DBG == 1 || MK_DBG == 2
        for (int m = gw; m < M; m += NGW) { u32x4 z = {0u, 0u, 0u, 0u}; *(u32x4*)(PROJ + (size_t)m * NPROJ + (MK_DBG == 1 ? 512 : 0) + lane * 8) = z; }
#endif
    }
    SEAM(PH_UV);
    if (IN(PH_GOUT)) {
#if MK_F8_GOUT
        pg8::Gemm g{PROJ, (const bf16*)(p.ws + WS_WOUT), M, DM, DM / 2, NPROJ}; pg8::StaticOrder S; S.init(M, DM, G, (int)blockIdx.x);
        pg8::EpiResGateNorm E{p.x, p.out, DM, MOD + 2048, 6144, p.g_ffn, MOD + 4096, REGA, (float*)(p.ws + WS_ROWSQ), 1.f / 256.f};
        pg8::gemm_phase<pg8::EpiResGateNorm, pg8::StaticOrder, true, true, true>((PG8_LAS unsigned char*)lds, g, S, E);
#else
        pg8::Gemm g{PROJ, (const bf16*)(p.ws + WS_WOUT), M, DM, DM, NPROJ}; pg8::StaticOrder S; S.init(M, DM, G, (int)blockIdx.x);
        pg8::EpiResGateNorm E{p.x, p.out, DM, MOD + 2048, 6144, p.g_ffn, MOD + 4096, REGA, (float*)(p.ws + WS_ROWSQ), 1.f};
        pg8::gemm_phase<pg8::EpiResGateNorm, pg8::StaticOrder, true, true>((PG8_LAS unsigned char*)lds, g, S, E);
#endif
    }
    SEAM(PH_GOUT);
    if (IN(PH_UP)) {
        pg8::Gemm g{REGA, (const bf16*)(p.ws + WS_W1), M, FF, DM, DM}; pg8::StaticOrder S; S.init(M, FF, G, (int)blockIdx.x);
        pg8::EpiF8Relu2 E{p.ws + WS_U, FF, 4.f, (const float*)(p.ws + WS_ROWSQ), (const float*)(p.ws + WS_BIAS2)};
        pg8::gemm_phase<pg8::EpiF8Relu2, pg8::StaticOrder, true, true>((PG8_LAS unsigned char*)lds, g, S, E);
    }
    SEAM(PH_UP);
    if (IN(PH_DOWN)) {
        pg8::Gemm g{(const bf16*)(p.ws + WS_U), (const bf16*)(p.ws + WS_W2), M, DM, FF / 2, FF / 2}; pg8::StaticOrder S; S.init(M, DM, G, (int)blockIdx.x);
        pg8::EpiResGateA2 E{REGA, p.out, DM, MOD + 5120, 6144, p.g_ffn};
        pg8::gemm_phase<pg8::EpiResGateA2, pg8::StaticOrder, true, true, true>((PG8_LAS unsigned char*)lds, g, S, E);
    }
#if MK_PROBE >= 0
    grid.sync();
    if (blockIdx.x == 0 && tid == 0) { unsigned long long* ts = (unsigned long long*)(p.ws + WS_MOD + 800 * 1024); ts[PH_COUNT] = __builtin_amdgcn_s_memrealtime();
        p.out[0] += (float)(ts[MK_PROBE + 1] - ts[MK_PROBE]) * 1e-3f; }
#endif
#undef IN
#undef SEAM
}

#ifndef MK_N_LAUNCHES
#define MK_N_LAUNCHES 1
#endif
extern "C" void kernel_launch(void* const* d_in, const int* in_sizes, int n_in, void* d_out, int out_size, void* d_ws, size_t ws_size, hipStream_t stream) {
    static int grid = 0;
    if (grid == 0) {
        if (n_in != 26 || out_size != M * DM || ws_size < WS_END) { fprintf(stderr, "kernel_launch: unexpected shapes (n_in %d out %d ws %zu)\n", n_in, out_size, ws_size); grid = -1; return; }
        int dev = 0, cus = 0, per_cu = 0;
        hipGetDevice(&dev); hipDeviceGetAttribute(&cus, hipDeviceAttributeMultiprocessorCount, dev);
        if (hipFuncSetAttribute((const void*)mk_fwd, hipFuncAttributeMaxDynamicSharedMemorySize, LDS_BYTES) != hipSuccess) { fprintf(stderr, "kernel_launch: hipFuncSetAttribute failed\n"); grid = -1; return; }
        if (hipOccupancyMaxActiveBlocksPerMultiprocessor(&per_cu, (const void*)mk_fwd, NWAVES * 64, LDS_BYTES) != hipSuccess || per_cu < 1) { fprintf(stderr, "kernel_launch: occupancy query says %d\n", per_cu); per_cu = 1; }
        (void)hipGetLastError();
        grid = cus * 1;
        if (per_cu < 1) grid = -1;
    }
    if (grid < 0) return;
    Params p{};
    const float** pp = (const float**)&p;
    for (int i = 0; i < 26; ++i) pp[i] = (const float*)d_in[i];
    p.out = (float*)d_out; p.ws = (unsigned char*)d_ws;
#if MK_N_LAUNCHES == 1
    if (hipMemsetAsync((char*)d_ws + WS_BAR, 0, 16384, stream) != hipSuccess) { fprintf(stderr, "kernel_launch: memset of the barrier words failed\n"); return; }
    p.ph_lo = 0; p.ph_hi = PH_COUNT;
    void* args[] = {&p};
    hipError_t e = hipLaunchCooperativeKernel((const void*)mk_fwd, dim3(grid), dim3(NWAVES * 64), args, LDS_BYTES, stream);
    if (e != hipSuccess) fprintf(stderr, "cooperative launch failed: %s (grid %d)\n", hipGetErrorString(e), grid);
#else
    for (int ph = 0; ph < PH_COUNT; ++ph) {
#if MK_SKIP_MIXER
        if (ph >= PH_HN && ph <= PH_GOUT) continue;
#endif
        p.ph_lo = ph; p.ph_hi = ph + 1;
        hipLaunchKernelGGL(mk_fwd, dim3(grid), dim3(NWAVES * 64), LDS_BYTES, stream, p);
    }
#endif
}
```

```cpp
#include <hip/hip_runtime.h>
#include <hip/hip_cooperative_groups.h>
#include <cstdio>
#include <cstdint>
#include <cmath>
namespace cg = cooperative_groups;
#ifndef MK_F8_GEMM1
#define MK_F8_GEMM1 0
#endif
#ifndef MK_PROBE
#define MK_PROBE -1
#endif
#ifndef MK_F8_GOUT
#define MK_F8_GOUT 1
#endif
#ifndef MK_DBG
#define MK_DBG 0
#endif
#ifndef MK_DBG_NOTOPK
#define MK_DBG_NOTOPK 0
#endif
namespace pg8 {
#define PG8_LAS __attribute__((address_space(3)))
typedef unsigned short bf16_t;
typedef short bf16x8 __attribute__((ext_vector_type(8)));
typedef float f32x4 __attribute__((ext_vector_type(4)));
typedef unsigned u32x4 __attribute__((ext_vector_type(4)));
constexpr int BM = 256, BK = 64, HALF = 128, HTB = HALF * BK * 2  , STAGE_BYTES = 8 * HTB, NXCD = 8, WGM = 8;

__host__ __device__ __forceinline__ int lds_byte(int r, int c) { const int st = (r >> 4) * 2 + (c >> 5), rr = r & 15, cc = c & 31, ob = rr * 64 + cc * 2; return st * 1024 + (ob ^ (((ob >> 9) & 1) << 5)); }
__host__ __device__ __forceinline__ void stage_rc(int b, int& R, int& C) { const int st = b / 1024, sb = b % 1024, swz = sb ^ (((sb >> 9) & 1) << 5); R = (st >> 1) * 16 + swz / 64; C = (st & 1) * 32 + (swz % 64) / 2; }
__host__ __device__ __forceinline__ int perm32(int rho) { const int n = rho >> 4, i = rho & 15; return 8 * (i >> 2) + 4 * n + (i & 3); }

struct Unit { int pm, pn; };
struct Gemm { const bf16_t* A; const bf16_t* Bt; int M, N, K, lda; };

struct StaticOrder {
    int nM, nN, nwg, G, c;
    __host__ __device__ void init(int M, int N, int G_, int c_) { nM = M / BM; nN = N / BM; nwg = nM * nN; G = G_; c = c_; }
    __host__ __device__ bool next(int i, Unit& u) const {
        const long L = (long)i * G + c; if (L >= nwg) return false;
        int wgid = (int)L; { const int q = nwg / NXCD, r = nwg % NXCD, xcd = wgid % NXCD, off = wgid / NXCD; wgid = (xcd < r ? xcd * (q + 1) : r * (q + 1) + (xcd - r) * q) + off; }
        const int nig = WGM * nN, gid = wgid / nig, fm = gid * WGM, gsz = (nM - fm) < WGM ? (nM - fm) : WGM;
        u.pm = fm + ((wgid % nig) % gsz); u.pn = (wgid % nig) / gsz; return true;
    }
    __device__ __forceinline__ void a_ready(const Unit&) const {}
    __device__ __forceinline__ void done(const Unit&) const {}
};


typedef float f32x2_t __attribute__((ext_vector_type(2))); typedef __bf16 bf16x2_t __attribute__((ext_vector_type(2)));
__device__ __forceinline__ unsigned cvt_pk_bf16(float lo, float hi) { const f32x2_t v = {lo, hi}; const bf16x2_t b = __builtin_convertvector(v, bf16x2_t); return __builtin_bit_cast(unsigned, b); }

template <int ACT  > struct EpiBf16 {
    static constexpr bool PERM = true, AFTER_DRAIN = false;
    bf16_t* O; int ldc; float scale;
    __device__ __forceinline__ void operator()(const f32x4 (&acc)[2][2][4][2], const Unit& u, int wr, int wc, int fr, int fq) const {
        const int row0 = u.pm * BM + wr * 64 + fr; const int col0 = u.pn * BM + wc * 32 + 8 * fq;
#pragma unroll
        for (int ai = 0; ai < 2; ++ai)
#pragma unroll
            for (int m = 0; m < 4; ++m) { bf16_t* rowp = O + (size_t)(row0 + ai * HALF + m * 16) * ldc + col0;
#pragma unroll
                for (int bj = 0; bj < 2; ++bj) { f32x4 v0 = acc[ai][bj][m][0] * scale, v1 = acc[ai][bj][m][1] * scale;
                    if (ACT == 1) {
#pragma unroll
                        for (int j = 0; j < 4; ++j) { const float a = v0[j] > 0.f ? v0[j] : 0.f, b = v1[j] > 0.f ? v1[j] : 0.f; v0[j] = a * a; v1[j] = b * b; } }
                    u32x4 w; w.x = cvt_pk_bf16(v0[0], v0[1]); w.y = cvt_pk_bf16(v0[2], v0[3]); w.z = cvt_pk_bf16(v1[0], v1[1]); w.w = cvt_pk_bf16(v1[2], v1[3]);
                    *(u32x4*)(rowp + bj * HALF) = w; } }
    }
};
__device__ __forceinline__ unsigned pk4_fp8(float a, float b, float c, float d) { int r = __builtin_amdgcn_cvt_pk_fp8_f32(a, b, 0, false); r = __builtin_amdgcn_cvt_pk_fp8_f32(c, d, r, true); return (unsigned)r; }
struct EpiF8Relu2 {
    static constexpr bool PERM = true, AFTER_DRAIN = false;
    unsigned char* O; int ldc; float scale; const float* rowsq; const float* bias2;
    __device__ __forceinline__ void operator()(const f32x4 (&acc)[2][2][4][2], const Unit& u, int wr, int wc, int fr, int fq) const {
        const int row0 = u.pm * BM + wr * 64 + fr; const int col0 = u.pn * BM + wc * 32 + 8 * fq;
        const float* bp = bias2 + (size_t)(u.pm >> 3) * 4096 + col0;
        f32x4 bv[2][2];
#pragma unroll
        for (int bj = 0; bj < 2; ++bj) { bv[bj][0] = *(const f32x4*)(bp + bj * HALF); bv[bj][1] = *(const f32x4*)(bp + bj * HALF + 4); }
#pragma unroll
        for (int ai = 0; ai < 2; ++ai)
#pragma unroll
            for (int m = 0; m < 4; ++m) { const int row = row0 + ai * HALF + m * 16; unsigned char* rowp = O + (size_t)row * ldc + col0;
                const float rstd = rsqrtf(rowsq[row] * (1.f / 1024.f) + 1e-6f);
#pragma unroll
                for (int bj = 0; bj < 2; ++bj) { f32x4 v0 = acc[ai][bj][m][0] * rstd + bv[bj][0], v1 = acc[ai][bj][m][1] * rstd + bv[bj][1];
#pragma unroll
                    for (int j = 0; j < 4; ++j) { const float a = v0[j] > 0.f ? v0[j] : 0.f, b = v1[j] > 0.f ? v1[j] : 0.f; v0[j] = fminf(a * a * scale, 416.f); v1[j] = fminf(b * b * scale, 416.f); }
                    typedef unsigned u32x2_t __attribute__((ext_vector_type(2)));
                    u32x2_t w; w.x = pk4_fp8(v0[0], v0[1], v0[2], v0[3]); w.y = pk4_fp8(v1[0], v1[1], v1[2], v1[3]);
                    *(u32x2_t*)(rowp + bj * HALF) = w; } }
    }
};
struct EpiResGate {
    static constexpr bool PERM = false, AFTER_DRAIN = false;
    const float* base; float* out; int ldc; const float* gate; int gate_ld; float gscale;
    __device__ __forceinline__ void operator()(const f32x4 (&acc)[2][2][4][2], const Unit& u, int, int, int, int) const {
        int t_ = threadIdx.x; asm volatile("" : "+v"(t_));
        const int wr = t_ >> 8, wc = (t_ >> 6) & 3, fr = t_ & 15, fq = (t_ >> 4) & 3;
        const int row0 = u.pm * BM + wr * 64 + fr, col0 = u.pn * BM + wc * 32 + 4 * fq;
        const float* gp = gate + (size_t)(u.pm >> 3) * gate_ld + col0;
        f32x4 gv[2][2];
#pragma unroll
        for (int bj = 0; bj < 2; ++bj)
#pragma unroll
            for (int n = 0; n < 2; ++n) gv[bj][n] = *(const f32x4*)(gp + bj * HALF + n * 16) * gscale;
#pragma unroll
        for (int ai = 0; ai < 2; ++ai)
#pragma unroll
            for (int m = 0; m < 4; ++m) { const size_t off = (size_t)(row0 + ai * HALF + m * 16) * ldc + col0;
#pragma unroll
                for (int bj = 0; bj < 2; ++bj)
#pragma unroll
                    for (int n = 0; n < 2; ++n) { const f32x4 bs = *(const f32x4*)(base + off + bj * HALF + n * 16);
                        *(f32x4*)(out + off + bj * HALF + n * 16) = bs + gv[bj][n] * acc[ai][bj][m][n]; } }
    }
};
struct EpiResGateNorm {
    static constexpr bool PERM = false, AFTER_DRAIN = false;
    const float* base; float* out; int ldc; const float* gate; int gate_ld; const float* gffn; const float* sc2; bf16_t* a2; float* rowsq; float gscale;
    __device__ __forceinline__ void operator()(const f32x4 (&acc)[2][2][4][2], const Unit& u, int, int, int, int) const {
        int t_ = threadIdx.x; asm volatile("" : "+v"(t_));
        const int wr = t_ >> 8, wc = (t_ >> 6) & 3, fr = t_ & 15, fq = (t_ >> 4) & 3;
        const int row0 = u.pm * BM + wr * 64 + fr, col0 = u.pn * BM + wc * 32 + 4 * fq;
        const float* gp = gate + (size_t)(u.pm >> 3) * gate_ld + col0; const float* sp = sc2 + (size_t)(u.pm >> 3) * gate_ld + col0;
        f32x4 gv[2][2], gm[2][2];
#pragma unroll
        for (int bj = 0; bj < 2; ++bj)
#pragma unroll
            for (int n = 0; n < 2; ++n) { gv[bj][n] = *(const f32x4*)(gp + bj * HALF + n * 16) * gscale; gm[bj][n] = *(const f32x4*)(gffn + col0 + bj * HALF + n * 16) * (*(const f32x4*)(sp + bj * HALF + n * 16) + 1.f); }
#pragma unroll
        for (int ai = 0; ai < 2; ++ai)
#pragma unroll
            for (int m = 0; m < 4; ++m) { const int row = row0 + ai * HALF + m * 16; const size_t off = (size_t)row * ldc + col0; float ss = 0.f;
#pragma unroll
                for (int bj = 0; bj < 2; ++bj)
#pragma unroll
                    for (int n = 0; n < 2; ++n) { const f32x4 bs = *(const f32x4*)(base + off + bj * HALF + n * 16); const f32x4 x1 = bs + gv[bj][n] * acc[ai][bj][m][n];
                        ss += (x1.x * x1.x + x1.y * x1.y) + (x1.z * x1.z + x1.w * x1.w);
                        const f32x4 y = x1 * gm[bj][n]; typedef unsigned u32x2_t __attribute__((ext_vector_type(2)));
                        u32x2_t w; w.x = cvt_pk_bf16(y.x, y.y); w.y = cvt_pk_bf16(y.z, y.w); *(u32x2_t*)(a2 + off + bj * HALF + n * 16) = w; }
                ss += __shfl_xor(ss, 16); ss += __shfl_xor(ss, 32);
                if (fq == 0) atomicAdd(rowsq + row, ss); }
    }
};
struct EpiResGateA2 {
    static constexpr bool PERM = false, AFTER_DRAIN = false;
    const bf16_t* a2; float* out; int ldc; const float* gate; int gate_ld; const float* gffn;
    __device__ __forceinline__ void operator()(const f32x4 (&acc)[2][2][4][2], const Unit& u, int, int, int, int) const {
        constexpr float gscale = 1.f / 256.f;
        int t_ = threadIdx.x; asm volatile("" : "+v"(t_));
        const int wr = t_ >> 8, wc = (t_ >> 6) & 3, fr = t_ & 15, fq = (t_ >> 4) & 3;
        const int row0 = u.pm * BM + wr * 64 + fr, col0 = u.pn * BM + wc * 32 + 4 * fq;
        const float* gp = gate + (size_t)(u.pm >> 3) * gate_ld + col0; const float* sp = gp - 1024;
        f32x4 gv[2][2], ig[2][2];
#pragma unroll
        for (int bj = 0; bj < 2; ++bj)
#pragma unroll
            for (int n = 0; n < 2; ++n) { gv[bj][n] = *(const f32x4*)(gp + bj * HALF + n * 16) * gscale;
                const f32x4 gm = *(const f32x4*)(gffn + col0 + bj * HALF + n * 16) * (*(const f32x4*)(sp + bj * HALF + n * 16) + 1.f);
                ig[bj][n] = (f32x4){1.f / gm.x, 1.f / gm.y, 1.f / gm.z, 1.f / gm.w}; }
#pragma unroll
        for (int ai = 0; ai < 2; ++ai)
#pragma unroll
            for (int m = 0; m < 4; ++m) { const size_t off = (size_t)(row0 + ai * HALF + m * 16) * ldc + col0;
#pragma unroll
                for (int bj = 0; bj < 2; ++bj)
#pragma unroll
                    for (int n = 0; n < 2; ++n) { typedef unsigned u32x2_t __attribute__((ext_vector_type(2)));
                        const u32x2_t w = *(const u32x2_t*)(a2 + off + bj * HALF + n * 16);
                        const f32x4 xa = {__uint_as_float(w.x << 16), __uint_as_float(w.x & 0xffff0000u), __uint_as_float(w.y << 16), __uint_as_float(w.y & 0xffff0000u)};
                        *(f32x4*)(out + off + bj * HALF + n * 16) = xa * ig[bj][n] + gv[bj][n] * acc[ai][bj][m][n]; } }
    }
};
template <class Epi, class Sched, bool ALIGN_EPI = false, bool SP2 = false, bool F8 = false>
__device__ __forceinline__ void gemm_phase(PG8_LAS unsigned char* lds, const Gemm g, const Sched S, const Epi E) {
    const int tid = threadIdx.x, wid = __builtin_amdgcn_readfirstlane(tid >> 6), lane = tid & 63, wr = wid >> 2, wc = wid & 3, fr = lane & 15, fq = lane >> 4;
    const int K = g.K, nt = K / BK;
    unsigned voffA[2], voffB[2];
#pragma unroll
    for (int i = 0; i < 2; ++i) { int R, C; stage_rc(tid * 16 + i * 8192, R, C); const int Rb = Epi::PERM ? ((R & ~31) + perm32(R & 31)) : R;
        voffA[i] = (unsigned)(R * g.lda + C) * 2u; voffB[i] = (unsigned)(Rb * K + C) * 2u; }
    const size_t kstep = (size_t)(BK * 2);
    const size_t hstepB = (size_t)HALF * K * 2, hstepA = (size_t)HALF * g.lda * 2;
    const size_t tstepA = 2 * hstepA, tstepB = 2 * hstepB;
    const unsigned ldsw = (unsigned)wid * 1024u;
    const int f8in = (fq >> 1) * 1024 + ((fr * 64 + (fq & 1) * 32) ^ ((fr >> 3) << 5));
    const int aoff = F8 ? wr * 8192 + f8in : lds_byte(wr * 64 + fr, fq * 8), boff = F8 ? wc * 4096 + f8in : lds_byte(wc * 32 + fr, fq * 8);
    constexpr int KOFF = F8 ? 16 : 1024;
    typedef int v8i_t __attribute__((ext_vector_type(8)));
#define PG8_SA(b, h) (((b) * 2 + (h)) * HTB)
#define PG8_SB(b, h) ((4 + (b) * 2 + (h)) * HTB)
#define PG8_STAGE(bufoff, gbase, voff) do { _Pragma("unroll") for (int _i = 0; _i < 2; ++_i) \
        __builtin_amdgcn_global_load_lds((const unsigned*)((const char*)(gbase) + (voff)[_i]), (PG8_LAS unsigned*)(lds + (bufoff) + ldsw + _i * 8192), 16, 0, 0); } while (0)
#define PG8_LD32(p_) __builtin_shufflevector(*(const PG8_LAS u32x4*)(p_), *(const PG8_LAS u32x4*)((p_) + 16), 0, 1, 2, 3, 4, 5, 6, 7)
#define PG8_LDA(dst, b, h) do { if constexpr (F8) { _Pragma("unroll") for (int m = 0; m < 4; ++m) dst##8[m] = __builtin_bit_cast(v8i_t, PG8_LD32(lds + PG8_SA(b, h) + aoff + m * 2048)); } \
    else { _Pragma("unroll") for (int m = 0; m < 4; ++m) _Pragma("unroll") for (int k = 0; k < 2; ++k) dst[m][k] = *(const PG8_LAS bf16x8*)(lds + PG8_SA(b, h) + aoff + m * 2048 + k * KOFF); } } while (0)
#define PG8_LDB(dst, b, h) do { if constexpr (F8) { _Pragma("unroll") for (int n = 0; n < 2; ++n) dst##8[n] = __builtin_bit_cast(v8i_t, PG8_LD32(lds + PG8_SB(b, h) + boff + n * 2048)); } \
    else { _Pragma("unroll") for (int n = 0; n < 2; ++n) _Pragma("unroll") for (int k = 0; k < 2; ++k) dst[n][k] = *(const PG8_LAS bf16x8*)(lds + PG8_SB(b, h) + boff + n * 2048 + k * KOFF); } } while (0)
#define PG8_CAT(x) __builtin_shufflevector(__builtin_bit_cast(u32x4, (x)[0]), __builtin_bit_cast(u32x4, (x)[1]), 0, 1, 2, 3, 4, 5, 6, 7)
#define PG8_MMA(ai, bj, At, Bt) do { __builtin_amdgcn_s_setprio(1); if constexpr (F8) { _Pragma("unroll") for (int m = 0; m < 4; ++m) _Pragma("unroll") for (int n = 0; n < 2; ++n) \
        asm volatile("v_mfma_f32_16x16x128_f8f6f4 %0, %1, %2, %0" : "+v"(acc[ai][bj][m][n]) : "v"(Bt##8[n]), "v"(At##8[m])); } \
    else { _Pragma("unroll") for (int m = 0; m < 4; ++m) _Pragma("unroll") for (int n = 0; n < 2; ++n) _Pragma("unroll") for (int k = 0; k < 2; ++k) \
        acc[ai][bj][m][n] = __builtin_amdgcn_mfma_f32_16x16x32_bf16(Bt[n][k], At[m][k], acc[ai][bj][m][n], 0, 0, 0); } __builtin_amdgcn_s_setprio(0); } while (0)
#define PG8_WAIT_V(n) asm volatile("s_waitcnt vmcnt(" #n ")" ::: "memory")
#define PG8_WAIT_L(n) asm volatile("s_waitcnt lgkmcnt(" #n ")" ::: "memory")
#define PG8_BAR __builtin_amdgcn_s_barrier()
#define PG8_SCHED __builtin_amdgcn_sched_barrier(0)
    Unit cur, nxt; int ui = 0;
    if (!S.next(0, cur)) return;
    f32x4 acc[2][2][4][2];
#pragma unroll
    for (int a = 0; a < 2; ++a)
#pragma unroll
        for (int b = 0; b < 2; ++b)
#pragma unroll
            for (int m = 0; m < 4; ++m)
#pragma unroll
                for (int n = 0; n < 2; ++n) acc[a][b][m][n] = (f32x4){0.f, 0.f, 0.f, 0.f};
    bf16x8 At[4][2], B0[2][2], B1[2][2]; v8i_t At8[4], B08[2], B18[2];
    const char* cA = (const char*)g.A + (size_t)cur.pm * tstepA; const char* cB = (const char*)g.Bt + (size_t)cur.pn * tstepB;
    S.a_ready(cur);
    if constexpr (SP2) {
        PG8_STAGE(PG8_SB(0, 0), cB, voffB); PG8_STAGE(PG8_SB(0, 1), cB + hstepB, voffB); PG8_STAGE(PG8_SA(0, 0), cA, voffA); PG8_STAGE(PG8_SA(0, 1), cA + hstepA, voffA);
        if (wr == 1) PG8_BAR;
        PG8_WAIT_V(2); PG8_BAR;
        PG8_STAGE(PG8_SB(1, 0), cB + kstep, voffB); PG8_STAGE(PG8_SA(1, 0), cA + kstep, voffA); PG8_STAGE(PG8_SB(1, 1), cB + hstepB + kstep, voffB);
        PG8_WAIT_V(6); PG8_BAR;
    } else {
        PG8_STAGE(PG8_SB(0, 0), cB, voffB); PG8_STAGE(PG8_SA(0, 0), cA, voffA); PG8_STAGE(PG8_SB(0, 1), cB + hstepB, voffB); PG8_STAGE(PG8_SA(0, 1), cA + hstepA, voffA);
        if (wr == 1) PG8_BAR;
        PG8_WAIT_V(4); PG8_BAR;
        PG8_STAGE(PG8_SB(1, 0), cB + kstep, voffB); PG8_STAGE(PG8_SA(1, 0), cA + kstep, voffA); PG8_STAGE(PG8_SB(1, 1), cB + hstepB + kstep, voffB);
        PG8_WAIT_V(6); PG8_BAR;
    }
    for (;;) {
        const bool has_next = S.next(ui + 1, nxt);
        const char* nA = has_next ? (const char*)g.A + (size_t)nxt.pm * tstepA : cA; const char* nB = has_next ? (const char*)g.Bt + (size_t)nxt.pn * tstepB : cB;
        for (int t = 0; t < nt; t += 2) {
            const bool last = (t == nt - 2);
            const char* a1 = cA + (size_t)(t + 1) * kstep;
            const char* a2 = last ? nA : cA + (size_t)(t + 2) * kstep; const char* b2 = last ? nB : cB + (size_t)(t + 2) * kstep;
            const char* a3 = a2 + kstep; const char* b3 = b2 + kstep;
            if (last && has_next) S.a_ready(nxt);
            if constexpr (SP2) {
            PG8_LDB(B0, 0, 0); PG8_LDB(B1, 0, 1); PG8_SCHED; PG8_LDA(At, 0, 0); PG8_STAGE(PG8_SA(1, 1), a1 + hstepA, voffA);
            PG8_WAIT_V(8); PG8_WAIT_L(0); PG8_BAR; PG8_MMA(0, 0, At, B0); PG8_MMA(0, 1, At, B1); PG8_BAR; PG8_SCHED;
            PG8_LDA(At, 0, 1); PG8_STAGE(PG8_SB(0, 0), b2, voffB); PG8_STAGE(PG8_SB(0, 1), b2 + hstepB, voffB); PG8_STAGE(PG8_SA(0, 0), a2, voffA);
            PG8_WAIT_V(8); PG8_WAIT_L(0); PG8_BAR; PG8_MMA(1, 0, At, B0); PG8_MMA(1, 1, At, B1); PG8_BAR; PG8_SCHED;
            PG8_LDB(B0, 1, 0); PG8_LDB(B1, 1, 1); PG8_SCHED; PG8_LDA(At, 1, 0); PG8_STAGE(PG8_SA(0, 1), a2 + hstepA, voffA);
            PG8_WAIT_V(8); PG8_WAIT_L(0); PG8_BAR; PG8_MMA(0, 0, At, B0); PG8_MMA(0, 1, At, B1); PG8_BAR; PG8_SCHED;
            PG8_LDA(At, 1, 1); PG8_STAGE(PG8_SB(1, 0), b3, voffB); PG8_STAGE(PG8_SB(1, 1), b3 + hstepB, voffB); PG8_STAGE(PG8_SA(1, 0), a3, voffA);
            PG8_WAIT_V(8); PG8_WAIT_L(0); PG8_BAR; PG8_MMA(1, 0, At, B0); PG8_MMA(1, 1, At, B1); PG8_BAR; PG8_SCHED;
            } else {
            PG8_LDB(B0, 0, 0); PG8_SCHED; PG8_LDA(At, 0, 0); PG8_STAGE(PG8_SA(1, 1), a1 + hstepA, voffA);
            PG8_WAIT_L(8); PG8_BAR; PG8_WAIT_L(0); PG8_MMA(0, 0, At, B0); PG8_BAR; PG8_SCHED;
            PG8_LDB(B1, 0, 1); PG8_STAGE(PG8_SB(0, 0), b2, voffB);
            PG8_BAR; PG8_WAIT_L(0); PG8_MMA(0, 1, At, B1); PG8_BAR;
            PG8_LDA(At, 0, 1); PG8_STAGE(PG8_SA(0, 0), a2, voffA);
            PG8_BAR; PG8_WAIT_L(0); PG8_MMA(1, 0, At, B0); PG8_BAR; PG8_SCHED;
            PG8_STAGE(PG8_SB(0, 1), b2 + hstepB, voffB);
            PG8_WAIT_V(6); PG8_BAR; PG8_MMA(1, 1, At, B1); PG8_BAR;
            PG8_LDB(B0, 1, 0); PG8_SCHED; PG8_LDA(At, 1, 0); PG8_STAGE(PG8_SA(0, 1), a2 + hstepA, voffA);
            PG8_WAIT_L(8); PG8_BAR; PG8_WAIT_L(0); PG8_MMA(0, 0, At, B0); PG8_BAR; PG8_SCHED;
            PG8_LDB(B1, 1, 1); PG8_STAGE(PG8_SB(1, 0), b3, voffB);
            PG8_BAR; PG8_WAIT_L(0); PG8_MMA(0, 1, At, B1); PG8_BAR;
            PG8_LDA(At, 1, 1); PG8_STAGE(PG8_SA(1, 0), a3, voffA);
            PG8_BAR; PG8_WAIT_L(0); PG8_MMA(1, 0, At, B0); PG8_BAR; PG8_SCHED;
            PG8_STAGE(PG8_SB(1, 1), b3 + hstepB, voffB);
            PG8_WAIT_V(6); PG8_BAR; PG8_MMA(1, 1, At, B1); PG8_BAR;
            }
        }
        if constexpr (ALIGN_EPI) { if (wr == 0) PG8_BAR; }
        if constexpr (F8) asm volatile("s_nop 15\n\ts_nop 15");
        if constexpr (!Epi::AFTER_DRAIN) { E(acc, cur, wr, wc, fr, fq); S.done(cur); }
        if (!has_next) break;
#pragma unroll
        for (int a = 0; a < 2; ++a)
#pragma unroll
            for (int b = 0; b < 2; ++b)
#pragma unroll
                for (int m = 0; m < 4; ++m)
#pragma unroll
                    for (int n = 0; n < 2; ++n) acc[a][b][m][n] = (f32x4){0.f, 0.f, 0.f, 0.f};
        cur = nxt; cA = nA; cB = nB; ++ui;
        if constexpr (ALIGN_EPI) { if (wr == 1) PG8_BAR; }
    }
    PG8_WAIT_V(0);
    if constexpr (!ALIGN_EPI) { if (wr == 0) PG8_BAR; }
    PG8_BAR;
    if constexpr (Epi::AFTER_DRAIN) { E.fused(acc, cur, wr, wc, fr, fq, lds, wid, lane); S.done(cur); }
#undef PG8_SA
#undef PG8_SB
#undef PG8_STAGE
#undef PG8_LDA
#undef PG8_LDB
#undef PG8_MMA
#undef PG8_CAT
#undef PG8_LD32
#undef PG8_WAIT_V
#undef PG8_WAIT_L
#undef PG8_BAR
#undef PG8_SCHED
}
}

#define LAS __attribute__((address_space(3)))
typedef unsigned short bf16;
typedef short bf16x8 __attribute__((ext_vector_type(8)));
typedef short s16x4 __attribute__((ext_vector_type(4)));
typedef float f32x4 __attribute__((ext_vector_type(4)));
typedef float f32x16 __attribute__((ext_vector_type(16)));
typedef unsigned u32x4 __attribute__((ext_vector_type(4)));
typedef unsigned u32x2 __attribute__((ext_vector_type(2)));

constexpr int NB = 32, SEQ = 2048, DM = 1024, M = NB * SEQ, NPROJ = 3072, FF = 4096;
constexpr int PC_Q = 0, PC_R = 512, PC_K = 1024, PC_V = 1536, PC_QI = 2048, PC_CL = 2560, PC_KI = 2688, PC_XW = 2752, PC_XA = 2816, PC_XG = 2880, PC_WI = 3008;
constexpr size_t MiB = 1u << 20;
constexpr size_t WS_MOD = 0, WS_WUKT = 1 * MiB, WS_WUK = WS_WUKT + 131072, WS_WUVT = WS_WUK + 131072, WS_INVR = 2 * MiB, WS_WIN = 4 * MiB, WS_WOUT = 10 * MiB,
                 WS_W1 = 12 * MiB, WS_W2 = 20 * MiB, WS_CKV = 36 * MiB, WS_GAM = 52 * MiB, WS_C3 = 60 * MiB, WS_REGA = 64 * MiB, WS_PROJ = 192 * MiB, WS_CH = 576 * MiB,
                 WS_G = 960 * MiB, WS_U = 192 * MiB, WS_END = 1024 * MiB,
                 WS_BAR = 62 * MiB, WS_ROWSQ = WS_BAR + 65536, WS_BIAS2 = WS_ROWSQ + 262144, WS_W2T = WS_WUVT + 131072, WS_A2T = WS_W2T + 65536, WS_G2T = WS_A2T + 65536;
constexpr int LDS_BAR_OFF = 163072;
constexpr int LDS_BYTES = 163328;
constexpr int NWAVES = 8;

struct Params {
    const float *x, *c, *w_ada, *b_ada, *g_mix, *g_ffn, *w_in, *g_q, *g_k, *g_kv, *w_uk, *w_uv, *mu, *w0, *w2, *a0, *a2, *g2, *k_k, *k_a, *r_k, *ln_w, *ln_b, *w_out, *w_ff1, *w_ff2;
    float* out; unsigned char* ws; int ph_lo, ph_hi;
};

__device__ __forceinline__ unsigned pk2(float lo, float hi) { return pg8::cvt_pk_bf16(lo, hi); }
__device__ __forceinline__ float bflo(unsigned w) { return __uint_as_float(w << 16); }
__device__ __forceinline__ float bfhi(unsigned w) { return __uint_as_float(w & 0xffff0000u); }
__device__ __forceinline__ float bf2f(bf16 h) { return __uint_as_float((unsigned)h << 16); }
__device__ __forceinline__ bf16 f2bf(float f) { return (bf16)(pk2(f, 0.f) & 0xffffu); }
__device__ __forceinline__ float wave_sum(float v) {
#pragma unroll
    for (int o = 1; o < 64; o <<= 1) v += __shfl_xor(v, o);
    return v;
}
__device__ __forceinline__ f32x16 mfma32(bf16x8 a, bf16x8 b, f32x16 c) { return __builtin_amdgcn_mfma_f32_32x32x16_bf16(a, b, c, 0, 0, 0); }
__device__ __forceinline__ f32x4 mfma16(bf16x8 a, bf16x8 b, f32x4 c) { return __builtin_amdgcn_mfma_f32_16x16x32_bf16(a, b, c, 0, 0, 0); }

__device__ __forceinline__ int win_src_col(int n) {
    if (n < 512) return n;
    if (n < 1024) return 1224 + (n - 512);
    if (n < 1536) return 1736 + (n - 1024);
    if (n < 2048) return 2248 + (n - 1536);
    if (n < 2560) return 640 + (n - 2048);
    if (n < 2688) return 512 + (n - 2560);
    if (n < 2752) return 1152 + (n - 2688);
    if (n < 2816) return 2760 + (n - 2752);
    if (n < 2880) return 2824 + (n - 2816);
    if (n < 3008) return 2888 + (n - 2880);
    if (n < 3016) return 1216 + (n - 3008);
    return -1;
}
__device__ __forceinline__ void conv_t_item(const float* W, int K, int Nsrc, bf16* WT, int nblk, int item, float* scr, int lane, bool is_win) {
    const int kb = item / nblk, nb = item % nblk, k0 = 64 * kb, n0 = 32 * nb;
    int ns = n0 + (lane & 31); if (is_win) ns = win_src_col(ns);
    float tv[32];
#pragma unroll
    for (int i = 0; i < 32; ++i) { const int kk = 2 * i + (lane >> 5); tv[i] = ns >= 0 ? W[(size_t)(k0 + kk) * Nsrc + ns] : 0.f; }
#pragma unroll
    for (int i = 0; i < 32; ++i) { const int kk = 2 * i + (lane >> 5); scr[kk * 33 + (lane & 31)] = tv[i]; }
    asm volatile("s_waitcnt lgkmcnt(0)" ::: "memory");
    const int c = lane & 7;
#pragma unroll
    for (int j = 0; j < 4; ++j) { const int n = (lane >> 3) + 8 * j; const float* s = scr + (8 * c) * 33 + n;
        u32x4 o; o.x = pk2(s[0 * 33], s[1 * 33]); o.y = pk2(s[2 * 33], s[3 * 33]); o.z = pk2(s[4 * 33], s[5 * 33]); o.w = pk2(s[6 * 33], s[7 * 33]);
        *(u32x4*)(WT + (size_t)(n0 + n) * K + k0 + 8 * c) = o; }
    asm volatile("s_waitcnt lgkmcnt(0)" ::: "memory");
}
__device__ __forceinline__ void conv_t_item_f8(const float* W, int K, int N, unsigned char* WT, int nblk, int item, float* scr, int lane, float scale, bool is_win = false) {
    const int kb = item / nblk, nb = item % nblk, k0 = 64 * kb, n0 = 32 * nb;
    int ns = n0 + (lane & 31); if (is_win) ns = win_src_col(ns);
    float tv[32];
#pragma unroll
    for (int i = 0; i < 32; ++i) { const int kk = 2 * i + (lane >> 5); tv[i] = ns >= 0 ? W[(size_t)(k0 + kk) * N + ns] * scale : 0.f; }
#pragma unroll
    for (int i = 0; i < 32; ++i) { const int kk = 2 * i + (lane >> 5); scr[kk * 33 + (lane & 31)] = tv[i]; }
    asm volatile("s_waitcnt lgkmcnt(0)" ::: "memory");
    const int c = lane & 7;
#pragma unroll
    for (int j = 0; j < 4; ++j) { const int n = (lane >> 3) + 8 * j; const float* s = scr + (8 * c) * 33 + n;
        u32x2 o; o.x = pg8::pk4_fp8(s[0 * 33], s[1 * 33], s[2 * 33], s[3 * 33]); o.y = pg8::pk4_fp8(s[4 * 33], s[5 * 33], s[6 * 33], s[7 * 33]);
        *(u32x2*)(WT + (size_t)(n0 + n) * K + k0 + 8 * c) = o; }
    asm volatile("s_waitcnt lgkmcnt(0)" ::: "memory");
}
__device__ __forceinline__ void adaln_block(const Params& p, float* ldsf, int cb, int tid) {
    const int lane = tid & 63, wv = tid >> 6, e = cb * 64 + lane;
    float* SC = ldsf; float* RED = ldsf + 16384; float* mod = (float*)(p.ws + WS_MOD);
    float wreg[128];
#pragma unroll
    for (int d = 0; d < 128; ++d) wreg[d] = p.w_ada[(size_t)(wv * 128 + d) * 6144 + e];
    for (int half = 0; half < 2; ++half) {
        const int b0 = half * 16;
        for (int i = tid; i < 16384; i += 512) { const float cv = p.c[b0 * 1024 + i]; SC[i] = cv / (1.f + __expf(-cv)); }
        __syncthreads();
        float acc[16];
#pragma unroll
        for (int bb = 0; bb < 16; ++bb) acc[bb] = 0.f;
#pragma unroll
        for (int dd = 0; dd < 128; dd += 4) { const int d = wv * 128 + dd;
            const float w0 = wreg[dd], w1 = wreg[dd + 1], w2 = wreg[dd + 2], w3 = wreg[dd + 3];
#pragma unroll
            for (int bb = 0; bb < 16; ++bb) { const f32x4 s = *(const f32x4*)(SC + bb * 1024 + d); acc[bb] += (s.x * w0 + s.y * w1) + (s.z * w2 + s.w * w3); }
        }
#pragma unroll
        for (int bb = 0; bb < 16; ++bb) RED[(wv * 16 + bb) * 64 + lane] = acc[bb];
        __syncthreads();
#pragma unroll
        for (int q = 0; q < 2; ++q) { const int bb = wv * 2 + q; float s = p.b_ada[e];
#pragma unroll
            for (int ww = 0; ww < 8; ++ww) s += RED[(ww * 16 + bb) * 64 + lane];
            mod[(size_t)(b0 + bb) * 6144 + e] = s; }
        __syncthreads();
    }
}
__device__ __forceinline__ void phase_pro(const Params& p, unsigned char* lds, int tid, int G) {
    const int lane = tid & 63, wv = tid >> 6;
    for (int cb = blockIdx.x; cb < 96; cb += G) adaln_block(p, (float*)lds, cb, tid);
    __syncthreads();
    float* scr = (float*)lds + wv * (64 * 33 + 16);
    const int gw = blockIdx.x * NWAVES + wv, NGW = G * NWAVES;
    bf16* WIN = (bf16*)(p.ws + WS_WIN); bf16* WOUT = (bf16*)(p.ws + WS_WOUT); bf16* W1 = (bf16*)(p.ws + WS_W1); bf16* W2 = (bf16*)(p.ws + WS_W2);
    bf16* WUKT = (bf16*)(p.ws + WS_WUKT); bf16* WUK = (bf16*)(p.ws + WS_WUK); bf16* WUVT = (bf16*)(p.ws + WS_WUVT);
    constexpr int I_IN = (DM / 64) * (NPROJ / 32), I_OUT = (DM / 64) * (DM / 32), I_1 = (DM / 64) * (FF / 32), I_2 = (FF / 64) * (DM / 32), I_UK = (128 / 64) * (512 / 32);
    constexpr int I_LR = 512 / 32;
    constexpr int NITEMS = I_IN + I_OUT + I_1 + I_2 + 2 * I_UK + 4 * I_LR;
    for (int it = gw; it < NITEMS; it += NGW) {
        int r = it;
        if (r < I_IN) { if (MK_F8_GEMM1) conv_t_item_f8(p.w_in, DM, 3016, (unsigned char*)WIN, NPROJ / 32, r, scr, lane, 32.f, true); else conv_t_item(p.w_in, DM, 3016, WIN, NPROJ / 32, r, scr, lane, true); continue; } r -= I_IN;
        if (r < I_OUT) { if (MK_F8_GOUT) conv_t_item_f8(p.w_out, DM, DM, (unsigned char*)WOUT, DM / 32, r, scr, lane, 32.f); else conv_t_item(p.w_out, DM, DM, WOUT, DM / 32, r, scr, lane, false); continue; } r -= I_OUT;
        if (r < I_1) { conv_t_item(p.w_ff1, DM, FF, W1, FF / 32, r, scr, lane, false); continue; } r -= I_1;
        if (r < I_2) { conv_t_item_f8(p.w_ff2, FF, DM, (unsigned char*)W2, DM / 32, r, scr, lane, 64.f); continue; } r -= I_2;
        if (r < I_UK) { conv_t_item(p.w_uk, 128, 512, WUKT, 512 / 32, r, scr, lane, false); continue; } r -= I_UK;
        if (r < I_UK) { conv_t_item(p.w_uv, 128, 512, WUVT, 512 / 32, r, scr, lane, false); continue; } r -= I_UK;
        if (r < I_LR) { conv_t_item(p.w2, 64, 512, (bf16*)(p.ws + WS_W2T), 512 / 32, r, scr, lane, false); continue; } r -= I_LR;
        if (r < I_LR) { conv_t_item(p.a2, 64, 512, (bf16*)(p.ws + WS_A2T), 512 / 32, r, scr, lane, false); continue; } r -= I_LR;
        conv_t_item(p.g2, 128, 512, (bf16*)(p.ws + WS_G2T), 512 / 32, r, scr, lane, false);
    }
    { float* ROWSQ = (float*)(p.ws + WS_ROWSQ); for (int i = blockIdx.x * 512 + tid; i < M; i += G * 512) ROWSQ[i] = 0.f; }
    for (int i = blockIdx.x * 512 + tid; i < 128 * 512 / 2; i += G * 512) { const float a = p.w_uk[2 * i], b = p.w_uk[2 * i + 1]; ((unsigned*)WUK)[i] = pk2(a, b); }
}

template <bool F8OUT> __device__ __forceinline__ void hn_rows(const float* src, const float* g, const float* mod, int off_sh, int off_sc, bf16* dst, int gw, int NGW, int lane) {
    const int RPW = M / NGW;
    for (int m0 = gw * RPW; m0 < M; m0 += NGW * RPW) {
        const float* mb = mod + (size_t)(m0 >> 11) * 6144;
        f32x4 ga[4], sh[4];
#pragma unroll
        for (int j = 0; j < 4; ++j) { const int col = 4 * lane + 256 * j; const f32x4 gg = *(const f32x4*)(g + col), sc = *(const f32x4*)(mb + off_sc + col); ga[j] = gg * (1.f + sc); sh[j] = *(const f32x4*)(mb + off_sh + col); }
        for (int r0 = 0; r0 < RPW; r0 += 4) {
            f32x4 v[4][4]; float s[4];
#pragma unroll
            for (int r = 0; r < 4; ++r) { const f32x4* xr = (const f32x4*)(src + (size_t)(m0 + r0 + r) * DM) + lane;
#pragma unroll
                for (int j = 0; j < 4; ++j) v[r][j] = xr[64 * j]; }
#pragma unroll
            for (int r = 0; r < 4; ++r) { s[r] = 0.f;
#pragma unroll
                for (int j = 0; j < 4; ++j) s[r] += (v[r][j].x * v[r][j].x + v[r][j].y * v[r][j].y) + (v[r][j].z * v[r][j].z + v[r][j].w * v[r][j].w); }
#pragma unroll
            for (int o = 1; o < 64; o <<= 1) {
#pragma unroll
                for (int r = 0; r < 4; ++r) s[r] += __shfl_xor(s[r], o); }
#pragma unroll
            for (int r = 0; r < 4; ++r) { const int m = m0 + r0 + r; const float rstd = rsqrtf(s[r] * (1.f / DM) + 1e-6f);
                unsigned long long* o8 = (unsigned long long*)(dst + (size_t)m * DM) + lane;
#pragma unroll
                for (int j = 0; j < 4; ++j) { const f32x4 y = v[r][j] * rstd * ga[j] + sh[j];
                    if (F8OUT) ((unsigned*)((unsigned char*)dst + (size_t)m * DM))[lane + 64 * j] = pg8::pk4_fp8(y.x, y.y, y.z, y.w);
                    else o8[64 * j] = (unsigned long long)pk2(y.x, y.y) | ((unsigned long long)pk2(y.z, y.w) << 32); } }
        }
    }
}

typedef short s16x4 __attribute__((ext_vector_type(4)));
__device__ __forceinline__ f32x4 mfma16k(s16x4 a, s16x4 b, f32x4 c) { return __builtin_amdgcn_mfma_f32_16x16x16bf16_1k(a, b, c, 0, 0, 0); }
__device__ __forceinline__ s16x4 pack4(f32x4 v) { u32x2 o; o.x = pk2(v[0], v[1]); o.y = pk2(v[2], v[3]); return __builtin_bit_cast(s16x4, o); }

__device__ __forceinline__ float dpp_row_sum16(float x) {
    x += __builtin_bit_cast(float, __builtin_amdgcn_mov_dpp(__builtin_bit_cast(int, x), 0xB1, 0xF, 0xF, true));
    x += __builtin_bit_cast(float, __builtin_amdgcn_mov_dpp(__builtin_bit_cast(int, x), 0x4E, 0xF, 0xF, true));
    x += __builtin_bit_cast(float, __builtin_amdgcn_mov_dpp(__builtin_bit_cast(int, x), 0x141, 0xF, 0xF, true));
    x += __builtin_bit_cast(float, __builtin_amdgcn_mov_dpp(__builtin_bit_cast(int, x), 0x140, 0xF, 0xF, true));
    return x;
}
__device__ __forceinline__ void rwkv_prep_item(const Params& p, unsigned char* lds, int it, int tid_in) {
    int tid = tid_in; asm volatile("" : "+v"(tid));
    const int lane = tid & 63, wv = __builtin_amdgcn_readfirstlane(tid >> 6);
    bf16* XS = (bf16*)lds;
    bf16* STG = (bf16*)(lds + 33792) + wv * 4096;
    float* MAB = (float*)(lds + 99328) + wv * 256;
    bf16* RKV = (bf16*)(lds + 107520) + wv * 3468;
    const bf16* PROJ = (const bf16*)(p.ws + WS_PROJ);
    const bf16* W2T = (const bf16*)(p.ws + WS_W2T); const bf16* A2T = (const bf16*)(p.ws + WS_A2T); const bf16* G2T = (const bf16*)(p.ws + WS_G2T);
    float* GAM = (float*)(p.ws + WS_GAM); float* C3 = (float*)(p.ws + WS_C3); bf16* GB = (bf16*)(p.ws + WS_G);
    const int row0 = it * 64, t0 = (it & 31) * 64, b = it >> 5;
    __syncthreads();
    {   const int xt = tid >> 5, xch = tid & 31;
        const f32x4 m0_ = *(const f32x4*)(p.mu + 1536 + 8 * xch), m1_ = *(const f32x4*)(p.mu + 1536 + 8 * xch + 4); const float sc_ = xch < 8 ? 2.f : -1.f;
        u32x4 xc[4], xp[4];
#pragma unroll
        for (int qq = 0; qq < 4; ++qq) { const int t = xt + 16 * qq; const bf16* src_ = PROJ + (size_t)(row0 + t) * NPROJ + PC_XW + 8 * xch; xc[qq] = *(const u32x4*)src_;
            xp[qq] = (u32x4){0u, 0u, 0u, 0u}; if (t0 + t != 0) xp[qq] = *(const u32x4*)(src_ - NPROJ); }
#pragma unroll
        for (int qq = 0; qq < 4; ++qq) { float o_[8];
#pragma unroll
            for (int i = 0; i < 4; ++i) { const float c0_ = bflo(xc[qq][i]), c1_ = bfhi(xc[qq][i]), p0_ = bflo(xp[qq][i]), p1_ = bfhi(xp[qq][i]);
                const float ma_ = i < 2 ? m0_[2 * i] : m1_[2 * i - 4], mb_ = i < 2 ? m0_[2 * i + 1] : m1_[2 * i - 3];
                const float v0_ = c0_ + ma_ * (p0_ - c0_), v1_ = c1_ + mb_ * (p1_ - c1_);
                const float r0_ = 1.f / (1.f + __expf(sc_ * v0_)), r1_ = 1.f / (1.f + __expf(sc_ * v1_));
                o_[2 * i] = xch < 8 ? 1.f - 2.f * r0_ : (xch < 16 ? v0_ : r0_); o_[2 * i + 1] = xch < 8 ? 1.f - 2.f * r1_ : (xch < 16 ? v1_ : r1_); }
            *(u32x4*)(XS + (xt + 16 * qq) * 264 + 8 * xch) = (u32x4){pk2(o_[0], o_[1]), pk2(o_[2], o_[3]), pk2(o_[4], o_[5]), pk2(o_[6], o_[7])}; }
    }
    u32x4 RK[7];
#define RKV_LOAD(rowb, tb) do { _Pragma("unroll") for (int i = 0; i < 7; ++i) { const int id_ = i * 64 + lane, mat_ = id_ / 136, rem_ = id_ - 136 * mat_, rw_ = rem_ >> 3, ch_ = rem_ & 7; \
        RK[i] = (u32x4){0u, 0u, 0u, 0u}; if (id_ < 408 && (tb) - 1 + rw_ >= 0) RK[i] = *(const u32x4*)(PROJ + (size_t)((rowb) - 1 + rw_) * NPROJ + PC_R + 512 * mat_ + wv * 64 + 8 * ch_); } } while (0)
#define RKV_WRITE() do { _Pragma("unroll") for (int i = 0; i < 7; ++i) { const int id_ = i * 64 + lane, mat_ = id_ / 136, rem_ = id_ - 136 * mat_, rw_ = rem_ >> 3, ch_ = rem_ & 7; \
        if (id_ < 408) { bf16* d_ = RKV + mat_ * 1156 + rw_ * 68 + 8 * ch_; *(u32x2*)d_ = (u32x2){RK[i].x, RK[i].y}; *(u32x2*)(d_ + 4) = (u32x2){RK[i].z, RK[i].w}; } } } while (0)
    RKV_LOAD(row0, t0);
    __syncthreads();
#pragma unroll 1
    for (int q = 0; q < 4; ++q) {
        const int rowq = row0 + 16 * q, tq = t0 + 16 * q;
        int lane_ = lane; asm volatile("" : "+v"(lane_));
        const int n_ = lane_ & 15, grp_ = lane_ >> 4;
        const size_t idx = (size_t)(b * 8 + wv) * 128 + (tq >> 4);
        unsigned char* CHp = p.ws + WS_CH + idx * 12288;
        RKV_WRITE();
        if (q < 3) RKV_LOAD(rowq + 16, tq + 16);
        f32x4 dw[4], da[4];
        {   bf16x8 xa[8];
#pragma unroll
            for (int ks = 0; ks < 8; ++ks) xa[ks] = *(const bf16x8*)(XS + (16 * q + n_) * 264 + 32 * ks + 8 * grp_);
            bf16x8 wf[2][8];
#define LORA_LOADW(dst_, ct_) do { const int cc_ = wv * 64 + 16 * (ct_) + n_; \
                _Pragma("unroll") for (int ks = 0; ks < 2; ++ks) { dst_[ks] = *(const bf16x8*)(W2T + cc_ * 64 + 32 * ks + 8 * grp_); dst_[2 + ks] = *(const bf16x8*)(A2T + cc_ * 64 + 32 * ks + 8 * grp_); } \
                _Pragma("unroll") for (int ks = 0; ks < 4; ++ks) dst_[4 + ks] = *(const bf16x8*)(G2T + cc_ * 128 + 32 * ks + 8 * grp_); } while (0)
            LORA_LOADW(wf[0], 0);
#pragma unroll
            for (int ct = 0; ct < 4; ++ct) { const int cc = wv * 64 + 16 * ct + n_;
                if (ct < 3) LORA_LOADW(wf[(ct + 1) & 1], ct + 1);
                f32x4 dg = {0.f, 0.f, 0.f, 0.f}; dw[ct] = dg; da[ct] = dg;
#pragma unroll
                for (int ks = 0; ks < 2; ++ks) dw[ct] = mfma16(xa[ks], wf[ct & 1][ks], dw[ct]);
#pragma unroll
                for (int ks = 0; ks < 2; ++ks) da[ct] = mfma16(xa[2 + ks], wf[ct & 1][2 + ks], da[ct]);
#pragma unroll
                for (int ks = 0; ks < 4; ++ks) dg = mfma16(xa[4 + ks], wf[ct & 1][4 + ks], dg);
#pragma unroll
                for (int rg = 0; rg < 4; ++rg) GB[(size_t)(rowq + 4 * grp_ + rg) * 512 + cc] = f2bf(dg[rg]); }
#undef LORA_LOADW
        }
        asm volatile("s_waitcnt lgkmcnt(0)" ::: "memory");
        {   float kkvA[4][4], kkaA[4][4], kprA[4][4], rA[4][4], vA[4][4], wA[4][4], nrm[4], c3s[4];
#pragma unroll
            for (int rg = 0; rg < 4; ++rg) { nrm[rg] = 0.f; c3s[rg] = 0.f; }
#pragma unroll
            for (int ct = 0; ct < 4; ++ct) { const int j = 16 * ct + n_, c = wv * 64 + j;
                const float mu_r = p.mu[c], mu_k = p.mu[512 + c], mu_v = p.mu[1024 + c], w0c = p.w0[c], a0c = p.a0[c], kkc = p.k_k[c], kac = p.k_a[c], rkc = p.r_k[c];
#pragma unroll
                for (int rg = 0; rg < 4; ++rg) { const int t = 4 * grp_ + rg;
                    const float rp = bf2f(RKV[t * 68 + j]), rc = bf2f(RKV[(t + 1) * 68 + j]);
                    const float kp = bf2f(RKV[1156 + t * 68 + j]), kc = bf2f(RKV[1156 + (t + 1) * 68 + j]);
                    const float vp = bf2f(RKV[2312 + t * 68 + j]), vc = bf2f(RKV[2312 + (t + 1) * 68 + j]);
                    const float r = rc + mu_r * (rp - rc), k = kc + mu_k * (kp - kc); vA[ct][rg] = vc + mu_v * (vp - vc); rA[ct][rg] = r;
                    const float u = w0c + dw[ct][rg]; const float wlog = -__logf(1.f + __expf(-u)) - 0.5f; wA[ct][rg] = __expf(-__expf(wlog));
                    const float a = 1.f / (1.f + __expf(-(a0c + da[ct][rg])));
                    const float kkv = k * kkc, kpr = k * (1.f + (a - 1.f) * kac); kkvA[ct][rg] = kkv; kkaA[ct][rg] = kkv * a; kprA[ct][rg] = kpr;
                    nrm[rg] += kkv * kkv; c3s[rg] += r * kpr * rkc; } }
            float inrm[4];
#pragma unroll
            for (int rg = 0; rg < 4; ++rg) { nrm[rg] = dpp_row_sum16(nrm[rg]); c3s[rg] = dpp_row_sum16(c3s[rg]); inrm[rg] = 1.f / fmaxf(sqrtf(nrm[rg]), 1e-12f); }
            if (n_ == 0) {
#pragma unroll
                for (int rg = 0; rg < 4; ++rg) C3[(size_t)(rowq + 4 * grp_ + rg) * 8 + wv] = c3s[rg]; }
#pragma unroll
            for (int ct = 0; ct < 4; ++ct) { const int j = 16 * ct + n_;
                float lp[4]; lp[0] = wA[ct][0]; lp[1] = lp[0] * wA[ct][1]; lp[2] = lp[1] * wA[ct][2]; lp[3] = lp[2] * wA[ct][3];
                const float P0 = __shfl(lp[3], n_), P1 = __shfl(lp[3], n_ + 16), P2 = __shfl(lp[3], n_ + 32);
                const float E = grp_ == 0 ? 1.f : (grp_ == 1 ? P0 : (grp_ == 2 ? P0 * P1 : P0 * P1 * P2));
                float bt[4], kt[4];
#pragma unroll
                for (int rg = 0; rg < 4; ++rg) { const int t = 4 * grp_ + rg;
                    const float gam = E * lp[rg], gprev = rg == 0 ? E : E * lp[rg - 1], ig = 1.f / gam;
                    const int so = t * 64 + (j ^ (((t >> 1) & 7) << 3));
                    STG[so] = f2bf(-kkvA[ct][rg] * inrm[rg] * gprev); STG[1024 + so] = f2bf(rA[ct][rg] * gam);
                    bt[rg] = kkaA[ct][rg] * inrm[rg] * ig; kt[rg] = kprA[ct][rg] * ig;
                    STG[2048 + so] = f2bf(bt[rg]); STG[3072 + so] = f2bf(kt[rg]); }
                *(u32x2*)(CHp + 4096 + j * 32 + grp_ * 8) = (u32x2){pk2(bt[0], bt[1]), pk2(bt[2], bt[3])};
                *(u32x2*)(CHp + 6144 + j * 32 + grp_ * 8) = (u32x2){pk2(kt[0], kt[1]), pk2(kt[2], kt[3])};
                *(u32x2*)(CHp + 8192 + j * 32 + grp_ * 8) = (u32x2){pk2(vA[ct][0], vA[ct][1]), pk2(vA[ct][2], vA[ct][3])};
                if (grp_ == 3) GAM[idx * 64 + j] = E * lp[3]; }
        }
        asm volatile("s_waitcnt lgkmcnt(0)" ::: "memory");
        {   f32x4 mab = {0.f, 0.f, 0.f, 0.f}, mak = mab, nrb = mab, nrk = mab;
#pragma unroll
            for (int ks = 0; ks < 4; ++ks) { const int o = n_ * 64 + ((16 * ks + 4 * grp_) ^ (((n_ >> 1) & 7) << 3));
                const s16x4 fa = *(const s16x4*)(STG + o), fr = *(const s16x4*)(STG + 1024 + o), fb = *(const s16x4*)(STG + 2048 + o), fk = *(const s16x4*)(STG + 3072 + o);
                mab = mfma16k(fa, fb, mab); mak = mfma16k(fa, fk, mak); nrb = mfma16k(fr, fb, nrb); nrk = mfma16k(fr, fk, nrk); }
            asm volatile("s_waitcnt lgkmcnt(0)" ::: "memory");
            bf16* SM = STG + 2048;
#pragma unroll
            for (int rg = 0; rg < 4; ++rg) { const int t = 4 * grp_ + rg; const bool sl = t > n_, il = t >= n_;
                MAB[t * 16 + n_] = sl ? mab[rg] : 0.f;
                SM[256 + t * 16 + n_] = f2bf(sl ? mak[rg] : 0.f); SM[512 + t * 16 + n_] = f2bf(il ? nrb[rg] : 0.f); SM[768 + t * 16 + n_] = f2bf(il ? nrk[rg] : 0.f); }
            asm volatile("s_waitcnt lgkmcnt(0)" ::: "memory");
            if (lane_ < 16) {
                float Tc[16];
#pragma unroll
                for (int t = 0; t < 16; ++t) { float acc = (t == lane_) ? 1.f : 0.f;
#pragma unroll
                    for (int s2 = 0; s2 < t; ++s2) acc = fmaf(MAB[t * 16 + s2], Tc[s2], acc);
                    Tc[t] = acc; SM[t * 16 + lane_] = f2bf(acc); }
            }
            asm volatile("s_waitcnt lgkmcnt(0)" ::: "memory");
#pragma unroll
            for (int i = 0; i < 4; ++i) { const int id = i * 64 + lane_, rw = id >> 3, c16 = id & 7; *(u32x4*)(CHp + id * 16) = *(const u32x4*)((const unsigned char*)STG + rw * 128 + ((c16 ^ ((rw >> 1) & 7)) << 4)); }
#pragma unroll
            for (int i = 0; i < 2; ++i) { const int id = i * 64 + lane_; *(u32x4*)(CHp + 10240 + id * 16) = *(const u32x4*)((const unsigned char*)SM + id * 16); }
        }
    }
#undef RKV_LOAD
#undef RKV_WRITE
}

__device__ __forceinline__ void stage_w_lds(const bf16* W, unsigned char* lds, int log2_cpr  , int tid) {
    const int cpr = 1 << log2_cpr;
#pragma unroll 4
    for (int i = 0; i < 16; ++i) { const int id = i * 512 + tid, row = id >> log2_cpr, ch = id & (cpr - 1);
        *(u32x4*)(lds + ((size_t)row << (log2_cpr + 4)) + (((ch & ~15) | ((ch ^ row) & 15)) << 4)) = *(const u32x4*)((const unsigned char*)W + (size_t)id * 16); }
}
__device__ __forceinline__ bf16x8 lds_wfrag(const unsigned char* lds, int row, int ch, int log2_cpr) {
    return *(const bf16x8*)(lds + ((size_t)row << (log2_cpr + 4)) + (((ch & ~15) | ((ch ^ row) & 15)) << 4));
}
__device__ __forceinline__ void dsa_prep_kv(const Params& p, const unsigned char* wl, int tile, int lane) {
    const bf16* PROJ = (const bf16*)(p.ws + WS_PROJ); bf16* CKV = (bf16*)(p.ws + WS_CKV); float* INVR = (float*)(p.ws + WS_INVR);
    const int r = lane & 31, hh = lane >> 5; const size_t row = (size_t)tile * 32 + r; const bf16* prow = PROJ + row * NPROJ;
    bf16x8 cf[8];
    {   u32x4 craw[8]; float ssq = 0.f;
#pragma unroll
        for (int s = 0; s < 8; ++s) { craw[s] = *(const u32x4*)(prow + PC_CL + 16 * s + 8 * hh);
#pragma unroll
            for (int w = 0; w < 4; ++w) { const float lo = bflo(craw[s][w]), hi = bfhi(craw[s][w]); ssq += lo * lo + hi * hi; } }
        ssq += __shfl_xor(ssq, 32);
        const float rstd = rsqrtf(ssq * (1.f / 128.f) + 1e-6f);
#pragma unroll
        for (int s = 0; s < 8; ++s) { const float* g = p.g_kv + 16 * s + 8 * hh; const f32x4 g0 = *(const f32x4*)g, g1 = *(const f32x4*)(g + 4);
            u32x4 o; o.x = pk2(bflo(craw[s].x) * rstd * g0.x, bfhi(craw[s].x) * rstd * g0.y); o.y = pk2(bflo(craw[s].y) * rstd * g0.z, bfhi(craw[s].y) * rstd * g0.w);
            o.z = pk2(bflo(craw[s].z) * rstd * g1.x, bfhi(craw[s].z) * rstd * g1.y); o.w = pk2(bflo(craw[s].w) * rstd * g1.z, bfhi(craw[s].w) * rstd * g1.w);
            cf[s] = __builtin_bit_cast(bf16x8, o); *(u32x4*)(CKV + row * 128 + 16 * s + 8 * hh) = o; }
    }
    unsigned wb[8];
#pragma unroll
    for (int s = 0; s < 8; ++s) wb[s] = (unsigned)(r * 256 + ((((2 * s + hh) ^ r) & 15) << 4));
#pragma unroll 1
    for (int h = 0; h < 8; ++h) { float ss = 0.f;
#pragma unroll
        for (int dt = 0; dt < 2; ++dt) { f32x16 acc = {}; const unsigned char* wg = wl + (h * 64 + dt * 32) * 256;
#pragma unroll
            for (int s = 0; s < 8; ++s) acc = mfma32(*(const bf16x8*)(wg + wb[s]), cf[s], acc);
#pragma unroll
            for (int i = 0; i < 16; ++i) ss += acc[i] * acc[i]; }
        ss += __shfl_xor(ss, 32);
        if (hh == 0) INVR[row * 8 + h] = rsqrtf(ss * (1.f / 64.f) + 1e-6f);
    }
}
__device__ __forceinline__ void dsa_prep_q(const Params& p, const unsigned char* wl, int tile, int lane) {
    const bf16* PROJ = (const bf16*)(p.ws + WS_PROJ); bf16* QABS = (bf16*)(p.ws + WS_REGA);
    const int r = lane & 31, hh = lane >> 5; const size_t row = (size_t)tile * 32 + r; const bf16* prow = PROJ + row * NPROJ;
    unsigned wb[2][4];
#pragma unroll
    for (int hp = 0; hp < 2; ++hp)
#pragma unroll
        for (int s = 0; s < 4; ++s) wb[hp][s] = (unsigned)(r * 1024 + ((((hp * 8 + 2 * s + hh) ^ r) & 15) << 4));
#pragma unroll 2
    for (int h = 0; h < 8; ++h) {
        u32x4 qraw[4]; float ssq = 0.f;
#pragma unroll
        for (int s = 0; s < 4; ++s) { qraw[s] = *(const u32x4*)(prow + PC_Q + h * 64 + 16 * s + 8 * hh);
#pragma unroll
            for (int w = 0; w < 4; ++w) { const float lo = bflo(qraw[s][w]), hi = bfhi(qraw[s][w]); ssq += lo * lo + hi * hi; } }
        ssq += __shfl_xor(ssq, 32);
        const float rstd = rsqrtf(ssq * (1.f / 64.f) + 1e-6f);
        bf16x8 qf[4];
#pragma unroll
        for (int s = 0; s < 4; ++s) { const int d0 = 16 * s + 8 * hh; float gg[8];
#pragma unroll
            for (int j = 0; j < 8; ++j) gg[j] = p.g_q[d0 + j] * p.g_k[d0 + j] * rstd;
            u32x4 o; o.x = pk2(bflo(qraw[s].x) * gg[0], bfhi(qraw[s].x) * gg[1]); o.y = pk2(bflo(qraw[s].y) * gg[2], bfhi(qraw[s].y) * gg[3]);
            o.z = pk2(bflo(qraw[s].z) * gg[4], bfhi(qraw[s].z) * gg[5]); o.w = pk2(bflo(qraw[s].w) * gg[6], bfhi(qraw[s].w) * gg[7]);
            qf[s] = __builtin_bit_cast(bf16x8, o); }
#pragma unroll
        for (int lt = 0; lt < 4; ++lt) { f32x16 acc = {}; const unsigned char* wg = wl + lt * 32768 + (h >> 1) * 256;
#pragma unroll
            for (int s = 0; s < 4; ++s) acc = mfma32(*(const bf16x8*)(wg + wb[h & 1][s]), qf[s], acc);
#pragma unroll
            for (int g4 = 0; g4 < 4; ++g4) { u32x2 o; o.x = pk2(acc[4 * g4] * 0.125f, acc[4 * g4 + 1] * 0.125f); o.y = pk2(acc[4 * g4 + 2] * 0.125f, acc[4 * g4 + 3] * 0.125f);
                *(u32x2*)(QABS + row * 1024 + h * 128 + lt * 32 + 8 * g4 + 4 * hh) = o; } }
    }
}

constexpr int SCAN_D = 8, SCAN_R = SCAN_D + 1, SCAN_SLOT = 12288 + 256;
#define SCAN_BAR() do { asm volatile("s_waitcnt lgkmcnt(0)" ::: "memory"); __builtin_amdgcn_s_barrier(); asm volatile("" ::: "memory"); } while (0)
__device__ __forceinline__ void rwkv_scan_chain(const Params& p, unsigned char* lds, int chain, int wv, int lane) {
    const int b = chain >> 3, h = chain & 7;
    const size_t idx0 = (size_t)(b * 8 + h) * 128;
    if (wv >= 4) {
        const int lw = wv - 4;
        const unsigned char* rec0 = p.ws + WS_CH + idx0 * 12288; const unsigned char* gam0 = p.ws + WS_GAM + idx0 * 256;
        unsigned soff[3];
#pragma unroll
        for (int i = 0; i < 3; ++i) { const int c = (i * 4 + lw) * 64 + lane; soff[i] = (unsigned)((c < 256 ? ((c >> 3) * 8 + ((c & 7) ^ ((c >> 4) & 7))) : c) * 16); }
        const unsigned goff = (unsigned)((lane & 15) * 16);
#define SCAN_DMA(k_) do { const unsigned char* r_ = rec0 + (size_t)(k_) * 12288; LAS unsigned char* sl_ = (LAS unsigned char*)lds + ((k_) % SCAN_R) * SCAN_SLOT; \
        _Pragma("unroll") for (int i = 0; i < 3; ++i) __builtin_amdgcn_global_load_lds((const unsigned*)(r_ + soff[i]), (LAS unsigned*)(sl_ + (i * 4 + lw) * 1024), 16, 0, 0); \
        if (lane < 16) __builtin_amdgcn_global_load_lds((const unsigned*)(gam0 + (size_t)(k_) * 256 + goff), (LAS unsigned*)(sl_ + 12288), 16, 0, 0); } while (0)
#pragma unroll
        for (int j = 0; j < SCAN_D; ++j) SCAN_DMA(j);
        for (int k = 0; k < 128; ++k) {
            if (k + SCAN_D <= 128) asm volatile("s_waitcnt vmcnt(%0)" :: "n"(4 * (SCAN_D - 1)) : "memory"); else asm volatile("s_waitcnt vmcnt(0)" ::: "memory");
            __builtin_amdgcn_s_barrier(); asm volatile("" ::: "memory");
            if (k + SCAN_D < 128) SCAN_DMA(k + SCAN_D);
        }
        asm volatile("s_waitcnt vmcnt(0)" ::: "memory");
        __builtin_amdgcn_s_barrier(); asm volatile("" ::: "memory");
#undef SCAN_DMA
    } else {
        const int w = wv, n = lane & 15, grp = lane >> 4;
        bf16* PROJ = (bf16*)(p.ws + WS_PROJ);
        f32x4 S[4];
#pragma unroll
        for (int jt = 0; jt < 4; ++jt) S[jt] = (f32x4){0.f, 0.f, 0.f, 0.f};
        int aoffs[4];
#pragma unroll
        for (int jt = 0; jt < 4; ++jt) aoffs[jt] = n * 128 + ((((2 * jt + (grp >> 1)) ^ ((n >> 1) & 7))) << 4) + 8 * (grp & 1);
        s16x4 at[4], rt[4], bt[4], kt[4], vt, Tm, Mak, Nrb, Nrk; f32x4 gm[4];
#define SCAN_LDF(slot_) do { const unsigned char* CHp = lds + (slot_) * SCAN_SLOT; \
        _Pragma("unroll") for (int jt = 0; jt < 4; ++jt) { at[jt] = *(const s16x4*)(CHp + aoffs[jt]); rt[jt] = *(const s16x4*)(CHp + 2048 + aoffs[jt]); \
            bt[jt] = *(const s16x4*)(CHp + 4096 + (16 * jt + n) * 32 + grp * 8); kt[jt] = *(const s16x4*)(CHp + 6144 + (16 * jt + n) * 32 + grp * 8); \
            gm[jt] = *(const f32x4*)(CHp + 12288 + (16 * jt + 4 * grp) * 4); } \
        vt = *(const s16x4*)(CHp + 8192 + (16 * w + n) * 32 + grp * 8); Tm = *(const s16x4*)(CHp + 10240 + n * 32 + grp * 8); Mak = *(const s16x4*)(CHp + 10752 + n * 32 + grp * 8); \
        Nrb = *(const s16x4*)(CHp + 11264 + n * 32 + grp * 8); Nrk = *(const s16x4*)(CHp + 11776 + n * 32 + grp * 8); } while (0)
        SCAN_BAR();
        SCAN_LDF(0);
        for (int sc = 0; sc < 128; ++sc) {
            s16x4 at_[4], rt_[4], bt_[4], kt_[4]; f32x4 gm_[4];
#pragma unroll
            for (int jt = 0; jt < 4; ++jt) { at_[jt] = at[jt]; rt_[jt] = rt[jt]; bt_[jt] = bt[jt]; kt_[jt] = kt[jt]; gm_[jt] = gm[jt]; }
            const s16x4 vt_ = vt, Tm_ = Tm, Mak_ = Mak, Nrb_ = Nrb, Nrk_ = Nrk;
            SCAN_BAR();
            if (sc + 1 < 128) SCAN_LDF((sc + 1) % SCAN_R);
            s16x4 Sb[4];
#pragma unroll
            for (int jt = 0; jt < 4; ++jt) Sb[jt] = pack4(S[jt]);
            f32x4 X = {0.f, 0.f, 0.f, 0.f}, O = X;
#pragma unroll
            for (int jt = 0; jt < 4; ++jt) X = mfma16k(at_[jt], Sb[jt], X);
            X = mfma16k(Mak_, vt_, X);
#pragma unroll
            for (int jt = 0; jt < 4; ++jt) O = mfma16k(rt_[jt], Sb[jt], O);
            O = mfma16k(Nrk_, vt_, O);
            const f32x4 U = mfma16k(Tm_, pack4(X), (f32x4){0.f, 0.f, 0.f, 0.f});
            const s16x4 Ub = pack4(U);
            O = mfma16k(Nrb_, Ub, O);
#pragma unroll
            for (int jt = 0; jt < 4; ++jt) { S[jt] = mfma16k(kt_[jt], vt_, S[jt]); S[jt] = mfma16k(bt_[jt], Ub, S[jt]); S[jt] = S[jt] * gm_[jt]; }
            bf16* orow = PROJ + ((size_t)b * SEQ + sc * 16 + 4 * grp) * NPROJ + PC_R + h * 64 + 16 * w + n;
#pragma unroll
            for (int rg = 0; rg < 4; ++rg) orow[(size_t)rg * NPROJ] = f2bf(O[rg]);
        }
#undef SCAN_LDF
    }
}
__device__ __forceinline__ void rwkv_epi_rows(const Params& p, int gw, int NGW, int lane) {
    bf16* PROJ = (bf16*)(p.ws + WS_PROJ); const bf16* GB = (const bf16*)(p.ws + WS_G); const float* C3 = (const float*)(p.ws + WS_C3);
    const int c0 = lane * 8, h = lane >> 3, RPW = M / NGW;
    float muv[8], lw[8], lb[8];
#pragma unroll
    for (int i = 0; i < 8; ++i) { muv[i] = p.mu[1024 + c0 + i]; lw[i] = p.ln_w[c0 + i]; lb[i] = p.ln_b[c0 + i]; }
    for (int m0 = gw * RPW; m0 < M; m0 += NGW * RPW) {
        u32x4 vprev = {0u, 0u, 0u, 0u}; if ((m0 & (SEQ - 1)) != 0) vprev = *(const u32x4*)(PROJ + (size_t)(m0 - 1) * NPROJ + PC_V + c0);
        for (int r0 = 0; r0 < RPW; r0 += 4) {
            u32x4 oraw[4], vc[4], gr[4]; float c3[4];
#pragma unroll
            for (int r = 0; r < 4; ++r) { const size_t m = (size_t)(m0 + r0 + r); const bf16* prow = PROJ + m * NPROJ;
                oraw[r] = *(const u32x4*)(prow + PC_R + c0); vc[r] = *(const u32x4*)(prow + PC_V + c0); gr[r] = *(const u32x4*)(GB + m * 512 + c0); c3[r] = C3[m * 8 + h]; }
            float o[4][8], sm[4], q[4];
#pragma unroll
            for (int r = 0; r < 4; ++r) { sm[r] = 0.f;
#pragma unroll
                for (int i = 0; i < 4; ++i) { o[r][2 * i] = bflo(oraw[r][i]); o[r][2 * i + 1] = bfhi(oraw[r][i]); sm[r] += o[r][2 * i] + o[r][2 * i + 1]; } }
#pragma unroll
            for (int of = 1; of < 8; of <<= 1) {
#pragma unroll
                for (int r = 0; r < 4; ++r) sm[r] += __shfl_xor(sm[r], of); }
#pragma unroll
            for (int r = 0; r < 4; ++r) { const float mean = sm[r] * (1.f / 64.f); q[r] = 0.f;
#pragma unroll
                for (int i = 0; i < 8; ++i) { o[r][i] -= mean; q[r] += o[r][i] * o[r][i]; } }
#pragma unroll
            for (int of = 1; of < 8; of <<= 1) {
#pragma unroll
                for (int r = 0; r < 4; ++r) q[r] += __shfl_xor(q[r], of); }
#pragma unroll
            for (int r = 0; r < 4; ++r) { const float rstd = rsqrtf(q[r] * (1.f / 64.f) + 64e-5f); const u32x4 vp = r == 0 ? vprev : vc[r - 1];
                const bool first = ((m0 + r0 + r) & (SEQ - 1)) == 0;
                u32x4 out; float y8[8];
#pragma unroll
                for (int i = 0; i < 4; ++i) { float y[2];
#pragma unroll
                    for (int e = 0; e < 2; ++e) { const int ii = 2 * i + e; const float cv = e ? bfhi(vc[r][i]) : bflo(vc[r][i]), pv = first ? 0.f : (e ? bfhi(vp[i]) : bflo(vp[i]));
                        const float v = cv + muv[ii] * (pv - cv), g = e ? bfhi(gr[r][i]) : bflo(gr[r][i]);
                        y[e] = (o[r][ii] * rstd * lw[ii] + lb[ii] + c3[r] * v) * g; }
                    out[i] = pk2(y[0], y[1]);
#if MK_F8_GOUT
                    y8[2 * i] = y[0] * 8.f; y8[2 * i + 1] = y[1] * 8.f;
#endif
                }
#if MK_F8_GOUT
                *(u32x2*)((unsigned char*)(PROJ + (size_t)(m0 + r0 + r) * NPROJ) + 512 + c0) = (u32x2){pg8::pk4_fp8(y8[0], y8[1], y8[2], y8[3]), pg8::pk4_fp8(y8[4], y8[5], y8[6], y8[7])};
#else
                *(u32x4*)(PROJ + (size_t)(m0 + r0 + r) * NPROJ + PC_R + c0) = out;
#endif
            }
            vprev = vc[3];
        }
    }
}

__device__ __forceinline__ unsigned f2key(float f) { unsigned b = __float_as_uint(f); if ((b << 1) == 0u) b = 0u; return (b & 0x80000000u) ? ~b : (b | 0x80000000u); }
__device__ __forceinline__ unsigned offb(unsigned row, unsigned ch) { return 2048u * (row >> 3) + 512u * (ch >> 2) + 64u * (row & 7) + 16u * ((ch & 3) ^ ((row >> 2) & 3)); }

__device__ __forceinline__ void topk_select(float* sc, int N, unsigned* hist, unsigned short* sel, int lane) {
    unsigned* kb = (unsigned*)sc;
    unsigned prefix = 0u, mask = 0u; int rem = 256, mbin = 0;
    const unsigned long long lt_mask = (1ull << lane) - 1ull;
    for (int pass = 0; pass < 4; ++pass) {
        const int shift = 24 - 8 * pass;
#pragma unroll
        for (int i = 0; i < 4; ++i) hist[lane * 4 + i] = 0u;
        asm volatile("s_waitcnt lgkmcnt(0)" ::: "memory");
        for (int base = 0; base < N; base += 256) { const int idx = base + 4 * lane;
            if (idx < N) { u32x4 k4;
                if (pass == 0) { const f32x4 v = *(const f32x4*)(sc + idx); k4 = (u32x4){f2key(v.x), f2key(v.y), f2key(v.z), f2key(v.w)}; *(u32x4*)(kb + idx) = k4; }
                else k4 = *(const u32x4*)(kb + idx);
#pragma unroll
                for (int e = 0; e < 4; ++e) if ((k4[e] & mask) == prefix) atomicAdd(&hist[(k4[e] >> shift) & 255u], 1u); } }
        asm volatile("s_waitcnt lgkmcnt(0)" ::: "memory");
        const unsigned c0 = hist[lane * 4], c1 = hist[lane * 4 + 1], c2 = hist[lane * 4 + 2], c3 = hist[lane * 4 + 3];
        const int cnt4 = (int)(c0 + c1 + c2 + c3);
        int incl = cnt4;
#pragma unroll
        for (int o = 1; o < 64; o <<= 1) { const int v = __shfl_down(incl, o); if (lane + o < 64) incl += v; }
        const int excl = incl - cnt4;
        const bool mine = (excl < rem) && (rem <= incl);
        const unsigned long long bal = __ballot(mine);
        const int L = (int)__builtin_ctzll(bal);
        const int ex = __shfl(excl, L); const int b3 = (int)__shfl((int)c3, L), b2 = (int)__shfl((int)c2, L), b1 = (int)__shfl((int)c1, L), b0 = (int)__shfl((int)c0, L);
        int above = ex, bin;
        if (above + b3 >= rem) { bin = 3; mbin = b3; } else { above += b3; if (above + b2 >= rem) { bin = 2; mbin = b2; } else { above += b2; if (above + b1 >= rem) { bin = 1; mbin = b1; } else { above += b1; bin = 0; mbin = b0; } } }
        rem -= above; prefix |= (unsigned)(L * 4 + bin) << shift; mask |= 0xffu << shift;
        if (pass == 1 && mbin <= 64) break;
    }
    const unsigned T = prefix; const int ngt = 256 - rem; int base_gt = 0, base_eq = 0;
    const bool partial = (mask != 0xffffffffu);
    unsigned short* cand = (unsigned short*)hist;
    for (int base = 0; base < N; base += 256) { const int idx = base + 4 * lane; const bool act = idx < N;
        u32x4 k4 = {0u, 0u, 0u, 0u}; if (act) k4 = *(const u32x4*)(kb + idx);
        bool gt[4], eq[4]; unsigned long long bg[4], be[4];
#pragma unroll
        for (int e = 0; e < 4; ++e) { const unsigned km = k4[e] & mask; gt[e] = act && km > T; eq[e] = act && km == T; bg[e] = __ballot(gt[e]); be[e] = __ballot(eq[e]); }
        int rg = base_gt, re = base_eq;
#pragma unroll
        for (int e = 0; e < 4; ++e) re += __popcll(be[e] & lt_mask);
#pragma unroll
        for (int e = 0; e < 4; ++e) {
            if (gt[e]) sel[rg + __popcll(bg[e] & lt_mask)] = (unsigned short)(idx + e);
            rg += __popcll(bg[e]);
            if (eq[e]) { if (partial) cand[re] = (unsigned short)(idx + e); else if (re < rem) sel[ngt + re] = (unsigned short)(idx + e); re += 1; } }
        base_gt = rg;
#pragma unroll
        for (int e = 0; e < 4; ++e) base_eq += __popcll(be[e]); }
    asm volatile("s_waitcnt lgkmcnt(0)" ::: "memory");
    if (partial) {
        const int m = mbin; const int ci = (lane < m) ? (int)cand[lane] : 0; const unsigned ck = (lane < m) ? kb[ci] : 0u;
        int rank = 0;
        for (int j = 0; j < m; ++j) { const unsigned kj = (unsigned)__shfl((int)ck, j); rank += (kj > ck || (kj == ck && j < lane)) ? 1 : 0; }
        if (lane < m && rank < rem) sel[ngt + rank] = (unsigned short)ci;
        asm volatile("s_waitcnt lgkmcnt(0)" ::: "memory");
    }
}

__device__ __forceinline__ float dpp_row_max16(float x) {
    x = fmaxf(x, __builtin_bit_cast(float, __builtin_amdgcn_mov_dpp(__builtin_bit_cast(int, x), 0xB1, 0xF, 0xF, true)));
    x = fmaxf(x, __builtin_bit_cast(float, __builtin_amdgcn_mov_dpp(__builtin_bit_cast(int, x), 0x4E, 0xF, 0xF, true)));
    x = fmaxf(x, __builtin_bit_cast(float, __builtin_amdgcn_mov_dpp(__builtin_bit_cast(int, x), 0x141, 0xF, 0xF, true)));
    x = fmaxf(x, __builtin_bit_cast(float, __builtin_amdgcn_mov_dpp(__builtin_bit_cast(int, x), 0x140, 0xF, 0xF, true)));
    return x;
}
__device__ __forceinline__ bool topk_select_fast(const float* sc, int N, float smax, unsigned* hist, unsigned short* sel, int lane) {
    const float scale = smax > 0.f ? 127.5f / smax : 0.f;
#define QBIN(x_) min(max((int)fmaf((x_), scale, 128.f), 0), 255)
#pragma unroll
    for (int i = 0; i < 4; ++i) hist[lane * 4 + i] = 0u;
    asm volatile("s_waitcnt lgkmcnt(0)" ::: "memory");
    for (int base = 0; base < N; base += 256) { const int idx = base + 4 * lane;
        if (idx < N) { const f32x4 v = *(const f32x4*)(sc + idx);
#pragma unroll
            for (int e = 0; e < 4; ++e) atomicAdd(&hist[QBIN(v[e])], 1u); } }
    asm volatile("s_waitcnt lgkmcnt(0)" ::: "memory");
    const unsigned c0 = hist[lane * 4], c1 = hist[lane * 4 + 1], c2 = hist[lane * 4 + 2], c3 = hist[lane * 4 + 3];
    const int cnt4 = (int)(c0 + c1 + c2 + c3);
    int incl = cnt4;
#pragma unroll
    for (int o = 1; o < 64; o <<= 1) { const int v = __shfl_down(incl, o); if (lane + o < 64) incl += v; }
    const int excl = incl - cnt4;
    const bool mine = (excl < 256) && (256 <= incl);
    const int L = (int)__builtin_ctzll(__ballot(mine));
    const int ex = __shfl(excl, L); const int b3 = (int)__shfl((int)c3, L), b2 = (int)__shfl((int)c2, L), b1 = (int)__shfl((int)c1, L), b0 = (int)__shfl((int)c0, L);
    int above = ex, bin, mbin;
    if (above + b3 >= 256) { bin = 3; mbin = b3; } else { above += b3; if (above + b2 >= 256) { bin = 2; mbin = b2; } else { above += b2; if (above + b1 >= 256) { bin = 1; mbin = b1; } else { above += b1; bin = 0; mbin = b0; } } }
    if (mbin > 64) return false;
    const int tb = L * 4 + bin, rem = 256 - above, ngt = above; int base_gt = 0, base_eq = 0;
    const unsigned long long lt_mask = (1ull << lane) - 1ull;
    unsigned short* cand = (unsigned short*)hist;
    for (int base = 0; base < N; base += 256) { const int idx = base + 4 * lane; const bool act = idx < N;
        f32x4 v = {0.f, 0.f, 0.f, 0.f}; if (act) v = *(const f32x4*)(sc + idx);
        bool gt[4], eq[4]; unsigned long long bg[4], be[4];
#pragma unroll
        for (int e = 0; e < 4; ++e) { const int qb = QBIN(v[e]); gt[e] = act && qb > tb; eq[e] = act && qb == tb; bg[e] = __ballot(gt[e]); be[e] = __ballot(eq[e]); }
        int rg = base_gt, re = base_eq;
#pragma unroll
        for (int e = 0; e < 4; ++e) re += __popcll(be[e] & lt_mask);
#pragma unroll
        for (int e = 0; e < 4; ++e) {
            if (gt[e]) sel[rg + __popcll(bg[e] & lt_mask)] = (unsigned short)(idx + e);
            rg += __popcll(bg[e]);
            if (eq[e]) { cand[re] = (unsigned short)(idx + e); re += 1; } }
        base_gt = rg;
#pragma unroll
        for (int e = 0; e < 4; ++e) base_eq += __popcll(be[e]); }
    asm volatile("s_waitcnt lgkmcnt(0)" ::: "memory");
    {   const int m = mbin; const int ci = (lane < m) ? (int)cand[lane] : 0; const unsigned ck = (lane < m) ? f2key(sc[ci]) : 0u;
        int rank = 0;
        for (int j = 0; j < m; ++j) { const unsigned kj = (unsigned)__shfl((int)ck, j); rank += (kj > ck || (kj == ck && j < lane)) ? 1 : 0; }
        if (lane < m && rank < rem) sel[ngt + rank] = (unsigned short)ci;
        asm volatile("s_waitcnt lgkmcnt(0)" ::: "memory"); }
#undef QBIN
    return true;
}

__device__ __forceinline__ void dsa_attend(const Params& p, int b, int t, const unsigned short* sel, int cnt, unsigned char* stage, int lane_in, const u32x4 (&bqv)[4]) {
    int lane = lane_in; asm volatile("" : "+v"(lane));
    const bf16* CKV = (const bf16*)(p.ws + WS_CKV) + (size_t)b * SEQ * 128; const float* INVR = (const float*)(p.ws + WS_INVR) + (size_t)b * SEQ * 8;
    bf16* QO = (bf16*)(p.ws + WS_REGA) + ((size_t)b * SEQ + t) * 1024;
    const int hd = lane & 15, grp = lane >> 4;
    bf16x8 bq[4];
#pragma unroll
    for (int s = 0; s < 4; ++s) bq[s] = __builtin_bit_cast(bf16x8, bqv[s]);
    const float slope = (hd < 8) ? exp2f(-(float)(hd + 1)) : 0.f;
    const int hsafe = hd & 7;
    float m_run = -INFINITY, l_part = 0.f;
    f32x4 O[8];
#pragma unroll
    for (int c = 0; c < 8; ++c) O[c] = (f32x4){0.f, 0.f, 0.f, 0.f};
    const LAS unsigned char* st3 = (const LAS unsigned char*)stage;
    const unsigned q4 = (lane & 15) >> 2, p4 = lane & 3;
    u32x4 G[8]; float IRn[8], PNn[8];
#define DA_ISSUE(ks_) do { \
    _Pragma("unroll") for (int i = 0; i < 8; ++i) { const int id = i * 64 + lane, row = id >> 4, ch = id & 15; const unsigned key = sel[(ks_) + row]; G[i] = *(const u32x4*)((const unsigned char*)CKV + (key * 256u + (unsigned)ch * 16u)); } } while (0)
#define DA_ISSUE2(ks_) do { \
    _Pragma("unroll") for (int i = 0; i < 8; ++i) { const int key = sel[(ks_) + 16 * (i >> 2) + 4 * grp + (i & 3)]; IRn[i] = *(const float*)((const unsigned char*)INVR + ((unsigned)key * 32u + (unsigned)hsafe * 4u)); PNn[i] = slope * fabsf((float)(t - key)); } } while (0)
    DA_ISSUE(cnt - 32); DA_ISSUE2(cnt - 32);
    for (int ks = cnt - 32; ks >= 0; ks -= 32) {
#pragma unroll
        for (int i = 0; i < 8; ++i) { const int id = i * 64 + lane, row = id >> 4, ch = id & 15; *(u32x4*)(stage + offb(row, ch)) = G[i]; }
        asm volatile("s_waitcnt lgkmcnt(0)" ::: "memory");
        if (ks >= 32) DA_ISSUE(ks - 32);
        float lg[8];
#pragma unroll
        for (int T = 0; T < 2; ++T) { f32x4 acc = {0.f, 0.f, 0.f, 0.f};
#pragma unroll
            for (int s = 0; s < 4; ++s) { const bf16x8 a = *(const bf16x8*)(stage + offb((lane & 15) + 16 * T, 4 * s + grp)); acc = mfma16(a, bq[s], acc); }
#pragma unroll
            for (int rg = 0; rg < 4; ++rg) lg[4 * T + rg] = acc[rg] * IRn[4 * T + rg] - PNn[4 * T + rg]; }
        if (ks >= 32) DA_ISSUE2(ks - 32);
        float mx = lg[0];
#pragma unroll
        for (int i = 1; i < 8; ++i) mx = fmaxf(mx, lg[i]);
        mx = fmaxf(mx, __shfl_xor(mx, 16)); mx = fmaxf(mx, __shfl_xor(mx, 32));
        const float m_new = fmaxf(m_run, mx);
        const float alpha = __expf(m_run - m_new);
        float ps = 0.f;
#pragma unroll
        for (int i = 0; i < 8; ++i) { lg[i] = __expf(lg[i] - m_new); ps += lg[i]; }
        l_part = l_part * alpha + ps; m_run = m_new;
        { float ar[4];
#pragma unroll
            for (int rg = 0; rg < 4; ++rg) ar[rg] = __shfl(alpha, 4 * grp + rg);
#pragma unroll
            for (int c = 0; c < 8; ++c)
#pragma unroll
                for (int rg = 0; rg < 4; ++rg) O[c][rg] *= ar[rg]; }
        {   u32x4 pw; pw.x = pk2(lg[0], lg[1]); pw.y = pk2(lg[2], lg[3]); pw.z = pk2(lg[4], lg[5]); pw.w = pk2(lg[6], lg[7]);
            const bf16x8 pa = __builtin_bit_cast(bf16x8, pw);
#pragma unroll
            for (int c = 0; c < 8; ++c) {
                const s16x4 lo = __builtin_bit_cast(s16x4, __builtin_amdgcn_ds_read_tr16_b64_v4i16((LAS s16x4*)(st3 + offb(4 * grp + q4, 2 * c + (p4 >> 1)) + 8 * (p4 & 1))));
                const s16x4 hi = __builtin_bit_cast(s16x4, __builtin_amdgcn_ds_read_tr16_b64_v4i16((LAS s16x4*)(st3 + offb(16 + 4 * grp + q4, 2 * c + (p4 >> 1)) + 8 * (p4 & 1))));
                const bf16x8 vb = {lo[0], lo[1], lo[2], lo[3], hi[0], hi[1], hi[2], hi[3]};
                O[c] = mfma16(pa, vb, O[c]); } }
        asm volatile("s_waitcnt lgkmcnt(0)" ::: "memory");
    }
#undef DA_ISSUE
#undef DA_ISSUE2
    float l = l_part; l += __shfl_xor(l, 16); l += __shfl_xor(l, 32);
    const float il = 1.f / l;
    float irr[4];
#pragma unroll
    for (int rg = 0; rg < 4; ++rg) irr[rg] = __shfl(il, 4 * grp + rg);
    if (grp < 2) {
#pragma unroll
        for (int rg = 0; rg < 4; ++rg)
#pragma unroll
            for (int c = 0; c < 8; ++c) QO[(4 * grp + rg) * 128 + 16 * c + hd] = f2bf(O[c][rg] * irr[rg]);
    }
}

#define DSA_LOAD_AF(af_, wqv_, b_, tq0_) do { const size_t rq_ = (size_t)(b_) * SEQ + (tq0_); const int r_ = lane & 31, g_ = lane >> 5, ql_ = 2 * ((r_ >> 2) & 1) + (r_ >> 4), hdm_ = 4 * ((r_ >> 3) & 1) + (r_ & 3); \
    _Pragma("unroll") for (int qg = 0; qg < 4; ++qg) _Pragma("unroll") for (int s = 0; s < 4; ++s) af_[qg][s] = *(const bf16x8*)(PROJ + (rq_ + 4 * qg + ql_) * NPROJ + PC_QI + hdm_ * 64 + 16 * s + 8 * g_); \
    wqv_ = (tid < 128) ? bf2f(PROJ[(rq_ + (tid >> 3)) * NPROJ + PC_WI + (tid & 7)]) * 0.044194173824159216f : 0.f; } while (0)
__device__ __forceinline__ void dsa_select_item(const Params& p, unsigned char* lds, int b, int tq0, int tid, bf16x8 (&af)[4][4], float& wqv, bool has_next, int nb, int ntq0) {
    bf16* PROJ = (bf16*)(p.ws + WS_PROJ);
    float* SC = (float*)lds;
    unsigned* HIST = (unsigned*)(lds + 131072);
    unsigned short* SEL = (unsigned short*)(lds + 131072 + 8192);
    float* WQ = (float*)(lds + 147456);
    unsigned* QMAX = (unsigned*)(lds + 147456 + 512);
    asm volatile("" : "+v"(tid));
    const int lane = tid & 63, wv = __builtin_amdgcn_readfirstlane(tid >> 6);
    const int N = ((tq0 >> 6) + 1) * 64; const size_t rowq0 = (size_t)b * SEQ + tq0;
    {
        const int r = lane & 31, g = lane >> 5;
        if (tid < 128) WQ[tid] = wqv;
        if (tid < 16) QMAX[tid] = 0u;
        float mxq[4][2];
#pragma unroll
        for (int qg = 0; qg < 4; ++qg) { mxq[qg][0] = 0.f; mxq[qg][1] = 0.f; }
        __syncthreads();
        bf16x8 bfr[4];
        { const bf16* krow = PROJ + ((size_t)b * SEQ + wv * 32 + r) * NPROJ + PC_KI + 8 * g;
#pragma unroll
          for (int s = 0; s < 4; ++s) bfr[s] = *(const bf16x8*)(krow + 16 * s); }
        for (int kt = wv; kt < N / 32; kt += NWAVES) {
            const int key = kt * 32 + r;
            bf16x8 bnx[4];
#pragma unroll
            for (int s = 0; s < 4; ++s) bnx[s] = bfr[s];
            if (kt + NWAVES < N / 32) { const bf16* krow = PROJ + ((size_t)b * SEQ + key + 32 * NWAVES) * NPROJ + PC_KI + 8 * g;
#pragma unroll
                for (int s = 0; s < 4; ++s) bnx[s] = *(const bf16x8*)(krow + 16 * s); }
#pragma unroll
            for (int qg = 0; qg < 4; ++qg) { f32x16 acc = {};
#pragma unroll
                for (int s = 0; s < 4; ++s) acc = mfma32(af[qg][s], bfr[s], acc);
#pragma unroll
                for (int qq = 0; qq < 2; ++qq) { float sc = 0.f; const f32x4 w0 = *(const f32x4*)(WQ + (4 * qg + 2 * g + qq) * 8), w1 = *(const f32x4*)(WQ + (4 * qg + 2 * g + qq) * 8 + 4);
#pragma unroll
                    for (int e = 0; e < 4; ++e) { sc = fmaf(w0[e], fmaxf(acc[8 * qq + e], 0.f), sc); sc = fmaf(w1[e], fmaxf(acc[8 * qq + 4 + e], 0.f), sc); }
                    SC[(4 * qg + 2 * g + qq) * 2048 + key] = sc; mxq[qg][qq] = fmaxf(mxq[qg][qq], fabsf(sc)); } }
#pragma unroll
            for (int s = 0; s < 4; ++s) bfr[s] = bnx[s];
        }
#pragma unroll
        for (int qg = 0; qg < 4; ++qg)
#pragma unroll
            for (int qq = 0; qq < 2; ++qq) { float m = dpp_row_max16(mxq[qg][qq]); m = fmaxf(m, __shfl_xor(m, 16));
                if (r == 0) atomicMax(&QMAX[4 * qg + 2 * g + qq], __float_as_uint(m)); }
        __syncthreads();
        if (has_next) DSA_LOAD_AF(af, wqv, nb, ntq0);
        bool fb[2];
        for (int q = 0; q < 2; ++q) fb[q] = !topk_select_fast(SC + (2 * wv + q) * 2048, N, __uint_as_float(QMAX[2 * wv + q]), HIST + wv * 256, SEL + (2 * wv + q) * 256, lane);
        for (int q = 0; q < 2; ++q) if (fb[q]) topk_select(SC + (2 * wv + q) * 2048, N, HIST + wv * 256, SEL + (2 * wv + q) * 256, lane);
    }
    asm volatile("s_waitcnt lgkmcnt(0)" ::: "memory");
    { const int q = lane >> 5; const u32x4 v = *(const u32x4*)(SEL + (2 * wv + q) * 256 + (lane & 31) * 8);
      *(u32x4*)(PROJ + (rowq0 + 2 * wv + q) * NPROJ + PC_Q + (lane & 31) * 8) = v; }
    __syncthreads();
}

__device__ __forceinline__ void dsa_attend_rows(const Params& p, unsigned char* wlds, int gw, int NGW, int lane) {
    const bf16* PROJ = (const bf16*)(p.ws + WS_PROJ); const bf16* QA = (const bf16*)(p.ws + WS_REGA);
    unsigned short* SELW = (unsigned short*)(wlds + 8192);
    const int hd = lane & 15, grp = lane >> 4;
    u32x4 selv = {0u, 0u, 0u, 0u}, bqv[4];
#define ATT_PREFETCH(row_) do { const int t_ = (row_) & (SEQ - 1); \
        if (t_ >= 256 && lane < 32) selv = *(const u32x4*)(PROJ + (size_t)(row_) * NPROJ + PC_Q + lane * 8); \
        _Pragma("unroll") for (int s = 0; s < 4; ++s) { bqv[s] = (u32x4){0u, 0u, 0u, 0u}; if (hd < 8) bqv[s] = *(const u32x4*)(QA + (size_t)(row_) * 1024 + hd * 128 + 32 * s + 8 * grp); } } while (0)
    if (gw < M) ATT_PREFETCH(gw);
    for (int row = gw; row < M; row += NGW) {
        const int b = row >> 11, t = row & (SEQ - 1), N = ((t >> 6) + 1) * 64, cnt = N > 256 ? 256 : N;
        if (N > 256) { if (lane < 32) *(u32x4*)(SELW + lane * 8) = selv; }
        else { for (int i = lane; i < cnt; i += 64) SELW[i] = (unsigned short)i; }
        u32x4 bqc[4];
#pragma unroll
        for (int s = 0; s < 4; ++s) bqc[s] = bqv[s];
        asm volatile("s_waitcnt lgkmcnt(0)" ::: "memory");
        if (row + NGW < M) ATT_PREFETCH(row + NGW);
        dsa_attend(p, b, t, SELW, cnt, wlds, lane, bqc);
        asm volatile("s_waitcnt lgkmcnt(0)" ::: "memory");
    }
#undef ATT_PREFETCH
}

__device__ __forceinline__ void uv_item(const Params& p, const unsigned char* wl  , int tile, int lane) {
    bf16* PROJ = (bf16*)(p.ws + WS_PROJ); const bf16* OLAT = (const bf16*)(p.ws + WS_REGA);
    const int r = lane & 31, hh = lane >> 5; const size_t row = (size_t)tile * 32 + r;
    unsigned wb[8];
#pragma unroll
    for (int s = 0; s < 8; ++s) wb[s] = (unsigned)(r * 256 + ((((2 * s + hh) ^ r) & 15) << 4));
#pragma unroll 1
    for (int h = 0; h < 8; ++h) { bf16x8 of[8];
#pragma unroll
        for (int s = 0; s < 8; ++s) of[s] = *(const bf16x8*)(OLAT + row * 1024 + h * 128 + 16 * s + 8 * hh);
#pragma unroll
        for (int dt = 0; dt < 2; ++dt) { f32x16 acc = {}; const unsigned char* wg = wl + (h * 64 + dt * 32) * 256;
#pragma unroll
            for (int s = 0; s < 8; ++s) acc = mfma32(*(const bf16x8*)(wg + wb[s]), of[s], acc);
#pragma unroll
            for (int g4 = 0; g4 < 4; ++g4) {
#if MK_F8_GOUT
                *(unsigned*)((unsigned char*)(PROJ + row * NPROJ) + h * 64 + dt * 32 + 8 * g4 + 4 * hh) = pg8::pk4_fp8(acc[4 * g4] * 8.f, acc[4 * g4 + 1] * 8.f, acc[4 * g4 + 2] * 8.f, acc[4 * g4 + 3] * 8.f);
#else
                u32x2 o; o.x = pk2(acc[4 * g4], acc[4 * g4 + 1]); o.y = pk2(acc[4 * g4 + 2], acc[4 * g4 + 3]);
                *(u32x2*)(PROJ + row * NPROJ + PC_Q + h * 64 + dt * 32 + 8 * g4 + 4 * hh) = o;
#endif
            } }
    }
}

__device__ __forceinline__ void bias2_item(const Params& p, int item, int lane) {
    const bf16* W1T = (const bf16*)(p.ws + WS_W1); const float* MOD = (const float*)(p.ws + WS_MOD); float* BIAS2 = (float*)(p.ws + WS_BIAS2);
    const int r = lane & 31, hh = lane >> 5, f0 = item * 32;
    const bf16* wrow = W1T + (size_t)(f0 + r) * DM + 8 * hh; const float* srow = MOD + (size_t)r * 6144 + 3072 + 8 * hh;
    f32x16 acc = {};
#pragma unroll 8
    for (int s = 0; s < 64; ++s) { const bf16x8 a = *(const bf16x8*)(wrow + 16 * s); const f32x4 s0 = *(const f32x4*)(srow + 16 * s), s1 = *(const f32x4*)(srow + 16 * s + 4);
        const u32x4 bw = {pk2(s0.x, s0.y), pk2(s0.z, s0.w), pk2(s1.x, s1.y), pk2(s1.z, s1.w)};
        acc = mfma32(a, __builtin_bit_cast(bf16x8, bw), acc); }
#pragma unroll
    for (int i = 0; i < 16; ++i) BIAS2[(size_t)r * 4096 + f0 + (i & 3) + 8 * (i >> 2) + 4 * hh] = acc[i];
}

typedef __attribute__((address_space(1))) unsigned gu32;
#define RLX_AGENT __ATOMIC_RELAXED, __HIP_MEMORY_SCOPE_AGENT
#define XB_TMO      128
#define XB_XCNT(j)  (256  + 64 * (j))
#define XB_XSUB(j)  (1280 + 64 * (j))
#define XB_XGEN(j)  (2304 + 64 * (j))
#define XB_TOP      3328
#define XB_TOPGEN   3392
#define XCD_BAR_WORDS 3456
#define XB_SPIN_CAP (1u << 18)

__device__ __forceinline__ unsigned xb_ld(unsigned* p)              { return __hip_atomic_load(p, __ATOMIC_RELAXED, __HIP_MEMORY_SCOPE_AGENT); }
__device__ __forceinline__ unsigned xb_add(unsigned* p, unsigned v) { return __hip_atomic_fetch_add(p, v, __ATOMIC_RELAXED, __HIP_MEMORY_SCOPE_AGENT); }
__device__ __forceinline__ unsigned xb_xcc_id() { return (unsigned)__builtin_amdgcn_s_getreg((3 << 11) | 20) & 0xFu; }
#define XB_SPIN(cond, bar) do { unsigned _sp = 0; while (cond) { __builtin_amdgcn_s_sleep(1); \
    if ((++_sp & 255u) == 0u) { if (xb_ld(&(bar)[XB_TMO])) break; if (_sp > XB_SPIN_CAP) { atomicAdd(&(bar)[XB_TMO], 1u); break; } } } } while (0)

struct XcdBarrier {
    unsigned* bar; unsigned x;
    volatile LAS unsigned* st;
};

__device__ __forceinline__ XcdBarrier xcd_barrier_post(unsigned* bar, volatile LAS unsigned* st) {
    XcdBarrier b; b.bar = bar; b.x = xb_xcc_id(); b.st = st;
    if (threadIdx.x == 0) (void)xb_add(&bar[XB_XCNT(b.x)], 1u);
    return b;
}
__device__ __forceinline__ void xcd_barrier_complete(unsigned* bar, unsigned x, unsigned& nloc, unsigned& nx) {
    const unsigned G = gridDim.x * gridDim.y * gridDim.z;
    unsigned sum, cnt, mine, sp = 0u;
    for (;;) {
        sum = 0u; cnt = 0u; mine = 0u;
#pragma unroll
        for (unsigned j = 0; j < 16; ++j) { const unsigned c = xb_ld(&bar[XB_XCNT(j)]); sum += c; cnt += (c > 0u) ? 1u : 0u; mine = (j == x) ? c : mine; }
        if (sum == G) break;
        __builtin_amdgcn_s_sleep(1);
        if ((++sp & 255u) == 0u) { if (xb_ld(&bar[XB_TMO])) break; if (sp > XB_SPIN_CAP) { atomicAdd(&bar[XB_TMO], 1u); break; } }
    }
    nloc = mine > 0u ? mine : 1u; nx = cnt > 0u ? cnt : 1u;
}

__device__ __forceinline__ void xcd_barrier(const XcdBarrier& b) {
    asm volatile("s_waitcnt vmcnt(0)" ::: "memory");
    __syncthreads();
    if (threadIdx.x == 0) {
        unsigned* bar = b.bar;
        __builtin_amdgcn_s_waitcnt(0);
        unsigned nloc = b.st[0], nx = b.st[1];
        if (nloc == 0u) { xcd_barrier_complete(bar, b.x, nloc, nx); b.st[0] = nloc; b.st[1] = nx; }
        const unsigned old = xb_add(&bar[XB_XSUB(b.x)], 1u);
        const unsigned gen = old / nloc;
        if (old + 1u == (gen + 1u) * nloc) {
            __builtin_amdgcn_fence(__ATOMIC_RELEASE, "agent");
            asm volatile("s_waitcnt vmcnt(0)" ::: "memory");
            const unsigned og = xb_add(&bar[XB_TOP], 1u);
            const unsigned tg = og / nx;
            if (og + 1u == (tg + 1u) * nx) xb_add(&bar[XB_TOPGEN], 1u);
            else XB_SPIN(xb_ld(&bar[XB_TOPGEN]) == tg, bar);
            __builtin_amdgcn_fence(__ATOMIC_ACQUIRE, "agent");
            xb_add(&bar[XB_XGEN(b.x)], 1u);
            asm volatile("s_waitcnt vmcnt(0)" ::: "memory");
        } else {
            XB_SPIN(xb_ld(&bar[XB_XGEN(b.x)]) == gen, bar);
            __builtin_amdgcn_fence(__ATOMIC_ACQUIRE, "agent");
            asm volatile("s_waitcnt vmcnt(0)" ::: "memory");
        }
    }
    __syncthreads();
}

enum { PH_PRO = 0, PH_HN, PH_GEMM1, PH_PREP, PH_MIX, PH_ATT, PH_UV, PH_GOUT, PH_UP, PH_DOWN, PH_COUNT };
#ifndef MK_SKIP_MIXER
#define MK_SKIP_MIXER 0
#endif
__global__ void __launch_bounds__(NWAVES * 64, 2) mk_fwd(Params p) {
    extern __shared__ __attribute__((aligned(16))) unsigned char lds[];
    cg::grid_group grid = cg::this_grid();
    const int tid = threadIdx.x, lane = tid & 63, wv = __builtin_amdgcn_readfirstlane(tid >> 6);
    const int G = gridDim.x, gw = blockIdx.x * NWAVES + wv, NGW = G * NWAVES;
    const int lo = p.ph_lo, hi = p.ph_hi;
    if (p.ph_hi < 0) grid.sync();
    if (tid < 2) ((volatile LAS unsigned*)((LAS unsigned char*)lds + LDS_BAR_OFF))[tid] = 0u;
    __syncthreads();
    XcdBarrier xbar = xcd_barrier_post((unsigned*)(p.ws + WS_BAR), (volatile LAS unsigned*)((LAS unsigned char*)lds + LDS_BAR_OFF));
    float* MOD = (float*)(p.ws + WS_MOD); bf16* REGA = (bf16*)(p.ws + WS_REGA); bf16* PROJ = (bf16*)(p.ws + WS_PROJ);
#ifndef MK_PHASE_MASK
#define MK_PHASE_MASK 0x3ff
#endif
#define IN(k) (((MK_PHASE_MASK >> (k)) & 1) && lo <= (k) && (k) < hi)
#define SEAM(k) do { if (IN(k) && IN((k) + 1)) { xcd_barrier(xbar); } if (MK_PROBE >= 0 && blockIdx.x == 0 && tid == 0) ((unsigned long long*)(p.ws + WS_MOD + 800 * 1024))[(k) + 1] = __builtin_amdgcn_s_memrealtime(); } while (0)
    if (MK_PROBE >= 0 && blockIdx.x == 0 && tid == 0) ((unsigned long long*)(p.ws + WS_MOD + 800 * 1024))[0] = __builtin_amdgcn_s_memrealtime();
    if (IN(PH_PRO)) { phase_pro(p, lds, tid, G); }
    SEAM(PH_PRO);
    if (IN(PH_HN)) { hn_rows<MK_F8_GEMM1 != 0>(p.x, p.g_mix, MOD, 0, 1024, REGA, gw, NGW, lane); }
    SEAM(PH_HN);
    if (IN(PH_GEMM1)) {
#if MK_F8_GEMM1
        pg8::Gemm g{REGA, (const bf16*)(p.ws + WS_WIN), M, NPROJ, DM / 2, DM / 2}; pg8::StaticOrder S; S.init(M, NPROJ, G, (int)blockIdx.x);
        pg8::EpiBf16<0> E{PROJ, NPROJ, 1.f / 32.f};
        pg8::gemm_phase<pg8::EpiBf16<0>, pg8::StaticOrder, true, true, true>((PG8_LAS unsigned char*)lds, g, S, E);
#else
        pg8::Gemm g{REGA, (const bf16*)(p.ws + WS_WIN), M, NPROJ, DM, DM}; pg8::StaticOrder S; S.init(M, NPROJ, G, (int)blockIdx.x);
        pg8::EpiBf16<0> E{PROJ, NPROJ, 1.f};
        pg8::gemm_phase<pg8::EpiBf16<0>, pg8::StaticOrder, true, true>((PG8_LAS unsigned char*)lds, g, S, E);
#endif
    }
    SEAM(PH_GEMM1);
    if (IN(PH_PREP)) {
#ifndef DBG_NO_RP
        for (int it = blockIdx.x; it < M / 64; it += G) rwkv_prep_item(p, lds, it, tid);
#endif
#ifndef DBG_NO_DP
        __syncthreads();
        stage_w_lds((const bf16*)(p.ws + WS_WUKT), lds, 4, tid); __syncthreads();
        for (int tile = gw; tile < M / 32; tile += NGW) dsa_prep_kv(p, lds, tile, lane);
        __syncthreads();
        stage_w_lds((const bf16*)(p.ws + WS_WUK), lds, 6, tid); __syncthreads();
        for (int tile = gw; tile < M / 32; tile += NGW) dsa_prep_q(p, lds, tile, lane);
#endif
    }
    SEAM(PH_PREP);
    if (IN(PH_MIX)) {
        for (int chain = blockIdx.x; chain < NB * 8; chain += G) { rwkv_scan_chain(p, lds, chain, wv, lane); __syncthreads(); }
        constexpr int NSEL = NB * 112;
        {   bf16x8 af[4][4]; float wqv = 0.f; const bf16* PROJ = (const bf16*)(p.ws + WS_PROJ);
            int idx = (int)blockIdx.x;
            if (idx < NSEL) DSA_LOAD_AF(af, wqv, idx / 112, 256 + 16 * (idx % 112));
            for (int k = 0; idx < NSEL; ++k) { const int nidx = (k + 1) * G + (((k + 1) & 1) ? (G - 1 - (int)blockIdx.x) : (int)blockIdx.x); const bool hn = nidx < NSEL;
                dsa_select_item(p, lds, idx / 112, 256 + 16 * (idx % 112), tid, af, wqv, hn, nidx / 112, 256 + 16 * (nidx % 112)); idx = nidx; } }
    }
    SEAM(PH_MIX);
    if (IN(PH_ATT)) {
        if (gw < 128) bias2_item(p, gw, lane);
        dsa_attend_rows(p, lds + wv * 9216, gw, NGW, lane);
    }

    SEAM(PH_ATT);
    if (IN(PH_UV)) {
#if MK_DBG == 7
        for (int m = gw; m < M; m += NGW) { *(u32x4*)(PROJ + (size_t)m * NPROJ + lane * 8) = *(const u32x4*)(REGA + (size_t)m * 1024 + lane * 8); }
#elif MK_DBG != 2
        stage_w_lds((const bf16*)(p.ws + WS_WUVT), lds, 4, tid); __syncthreads();
        for (int tile = gw; tile < M / 32; tile += NGW) uv_item(p, lds, tile, lane);
#endif
#if MK_DBG == 0
        rwkv_epi_rows(p, gw, NGW, lane);
#endif
#if MK_DBG == 1 || MK_DBG == 2
        for (int m = gw; m < M; m += NGW) { u32x4 z = {0u, 0u, 0u, 0u}; *(u32x4*)(PROJ + (size_t)m * NPROJ + (MK_DBG == 1 ? 512 : 0) + lane * 8) = z; }
#endif
    }
    SEAM(PH_UV);
    if (IN(PH_GOUT)) {
#if MK_F8_GOUT
        pg8::Gemm g{PROJ, (const bf16*)(p.ws + WS_WOUT), M, DM, DM / 2, NPROJ}; pg8::StaticOrder S; S.init(M, DM, G, (int)blockIdx.x);
        pg8::EpiResGateNorm E{p.x, p.out, DM, MOD + 2048, 6144, p.g_ffn, MOD + 4096, REGA, (float*)(p.ws + WS_ROWSQ), 1.f / 256.f};
        pg8::gemm_phase<pg8::EpiResGateNorm, pg8::StaticOrder, true, true, true>((PG8_LAS unsigned char*)lds, g, S, E);
#else
        pg8::Gemm g{PROJ, (const bf16*)(p.ws + WS_WOUT), M, DM, DM, NPROJ}; pg8::StaticOrder S; S.init(M, DM, G, (int)blockIdx.x);
        pg8::EpiResGateNorm E{p.x, p.out, DM, MOD + 2048, 6144, p.g_ffn, MOD + 4096, REGA, (float*)(p.ws + WS_ROWSQ), 1.f};
        pg8::gemm_phase<pg8::EpiResGateNorm, pg8::StaticOrder, true, true>((PG8_LAS unsigned char*)lds, g, S, E);
#endif
    }
    SEAM(PH_GOUT);
    if (IN(PH_UP)) {
        pg8::Gemm g{REGA, (const bf16*)(p.ws + WS_W1), M, FF, DM, DM}; pg8::StaticOrder S; S.init(M, FF, G, (int)blockIdx.x);
        pg8::EpiF8Relu2 E{p.ws + WS_U, FF, 4.f, (const float*)(p.ws + WS_ROWSQ), (const float*)(p.ws + WS_BIAS2)};
        pg8::gemm_phase<pg8::EpiF8Relu2, pg8::StaticOrder, true, true>((PG8_LAS unsigned char*)lds, g, S, E);
    }
    SEAM(PH_UP);
    if (IN(PH_DOWN)) {
        pg8::Gemm g{(const bf16*)(p.ws + WS_U), (const bf16*)(p.ws + WS_W2), M, DM, FF / 2, FF / 2}; pg8::StaticOrder S; S.init(M, DM, G, (int)blockIdx.x);
        pg8::EpiResGateA2 E{REGA, p.out, DM, MOD + 5120, 6144, p.g_ffn};
        pg8::gemm_phase<pg8::EpiResGateA2, pg8::StaticOrder, true, true, true>((PG8_LAS unsigned char*)lds, g, S, E);
    }
#if MK_PROBE >= 0
    grid.sync();
    if (blockIdx.x == 0 && tid == 0) { unsigned long long* ts = (unsigned long long*)(p.ws + WS_MOD + 800 * 1024); ts[PH_COUNT] = __builtin_amdgcn_s_memrealtime();
        p.out[0] += (float)(ts[MK_PROBE + 1] - ts[MK_PROBE]) * 1e-3f; }
#endif
#undef IN
#undef SEAM
}

#ifndef MK_N_LAUNCHES
#define MK_N_LAUNCHES 1
#endif
extern "C" void kernel_launch(void* const* d_in, const int* in_sizes, int n_in, void* d_out, int out_size, void* d_ws, size_t ws_size, hipStream_t stream) {
    static int grid = 0;
    if (grid == 0) {
        if (n_in != 26 || out_size != M * DM || ws_size < WS_END) { fprintf(stderr, "kernel_launch: unexpected shapes (n_in %d out %d ws %zu)\n", n_in, out_size, ws_size); grid = -1; return; }
        int dev = 0, cus = 0, per_cu = 0;
        hipGetDevice(&dev); hipDeviceGetAttribute(&cus, hipDeviceAttributeMultiprocessorCount, dev);
        if (hipFuncSetAttribute((const void*)mk_fwd, hipFuncAttributeMaxDynamicSharedMemorySize, LDS_BYTES) != hipSuccess) { fprintf(stderr, "kernel_launch: hipFuncSetAttribute failed\n"); grid = -1; return; }
        if (hipOccupancyMaxActiveBlocksPerMultiprocessor(&per_cu, (const void*)mk_fwd, NWAVES * 64, LDS_BYTES) != hipSuccess || per_cu < 1) { fprintf(stderr, "kernel_launch: occupancy query says %d\n", per_cu); per_cu = 1; }
        (void)hipGetLastError();
        grid = cus * 1;
        if (per_cu < 1) grid = -1;
    }
    if (grid < 0) return;
    Params p{};
    const float** pp = (const float**)&p;
    for (int i = 0; i < 26; ++i) pp[i] = (const float*)d_in[i];
    p.out = (float*)d_out; p.ws = (unsigned char*)d_ws;
#if MK_N_LAUNCHES == 1
    if (hipMemsetAsync((char*)d_ws + WS_BAR, 0, 16384, stream) != hipSuccess) { fprintf(stderr, "kernel_launch: memset of the barrier words failed\n"); return; }
    p.ph_lo = 0; p.ph_hi = PH_COUNT;
    void* args[] = {&p};
    hipError_t e = hipLaunchCooperativeKernel((const void*)mk_fwd, dim3(grid), dim3(NWAVES * 64), args, LDS_BYTES, stream);
    if (e != hipSuccess) fprintf(stderr, "cooperative launch failed: %s (grid %d)\n", hipGetErrorString(e), grid);
#else
    for (int ph = 0; ph < PH_COUNT; ++ph) {
#if MK_SKIP_MIXER
        if (ph >= PH_HN && ph <= PH_GOUT) continue;
#endif
        p.ph_lo = ph; p.ph_hi = ph + 1;
        hipLaunchKernelGGL(mk_fwd, dim3(grid), dim3(NWAVES * 64), LDS_BYTES, stream, p);
    }
#endif
}
```

```cpp
#include <hip/hip_runtime.h>
#include <hip/hip_cooperative_groups.h>
#include <cstdio>
#include <cstdint>
#include <cmath>
namespace cg = cooperative_groups;
#ifndef MK_F8_GEMM1
#define MK_F8_GEMM1 0
#endif
#ifndef MK_PANEL_ATT
#define MK_PANEL_ATT 1
#endif
#ifndef MK_PROBE
#define MK_PROBE -1
#endif
#ifndef MK_F8_GOUT
#define MK_F8_GOUT 1
#endif
#ifndef MK_DBG
#define MK_DBG 0
#endif
#ifndef MK_DBG_NOTOPK
#define MK_DBG_NOTOPK 0
#endif
#define MK_DPPF(x_, ctrl_) __builtin_bit_cast(float, __builtin_amdgcn_mov_dpp(__builtin_bit_cast(int, (x_)), (ctrl_), 0xF, 0xF, true))
__device__ __forceinline__ float dpp_sum8(float x)  { x += MK_DPPF(x, 0xB1); x += MK_DPPF(x, 0x4E); x += MK_DPPF(x, 0x141); return x; }
__device__ __forceinline__ float dpp_row_sum16(float x) { x = dpp_sum8(x); x += MK_DPPF(x, 0x140); return x; }
__device__ __forceinline__ float dpp_row_max16(float x) { x = fmaxf(x, MK_DPPF(x, 0xB1)); x = fmaxf(x, MK_DPPF(x, 0x4E)); x = fmaxf(x, MK_DPPF(x, 0x141)); x = fmaxf(x, MK_DPPF(x, 0x140)); return x; }
__device__ __forceinline__ float xor16_max(float x) { const auto r = __builtin_amdgcn_permlane16_swap(__float_as_uint(x), __float_as_uint(x), false, false); return fmaxf(__uint_as_float(r[0]), __uint_as_float(r[1])); }
__device__ __forceinline__ float xor32_max(float x) { const auto r = __builtin_amdgcn_permlane32_swap(__float_as_uint(x), __float_as_uint(x), false, false); return fmaxf(__uint_as_float(r[0]), __uint_as_float(r[1])); }
__device__ __forceinline__ float xor16_sum(float x) { const auto r = __builtin_amdgcn_permlane16_swap(__float_as_uint(x), __float_as_uint(x), false, false); return __uint_as_float(r[0]) + __uint_as_float(r[1]); }
__device__ __forceinline__ float xor32_sum(float x) { const auto r = __builtin_amdgcn_permlane32_swap(__float_as_uint(x), __float_as_uint(x), false, false); return __uint_as_float(r[0]) + __uint_as_float(r[1]); }
__device__ __forceinline__ float wave_sum(float v) { return xor32_sum(xor16_sum(dpp_row_sum16(v))); }
namespace pg8 {
#define PG8_LAS __attribute__((address_space(3)))
typedef unsigned short bf16_t;
typedef short bf16x8 __attribute__((ext_vector_type(8)));
typedef float f32x4 __attribute__((ext_vector_type(4)));
typedef unsigned u32x4 __attribute__((ext_vector_type(4)));
constexpr int BM = 256, BK = 64, HALF = 128, HTB = HALF * BK * 2  , STAGE_BYTES = 8 * HTB, NXCD = 8, WGM = 8;

__host__ __device__ __forceinline__ int lds_byte(int r, int c) { const int st = (r >> 4) * 2 + (c >> 5), rr = r & 15, cc = c & 31, ob = rr * 64 + cc * 2; return st * 1024 + (ob ^ (((ob >> 9) & 1) << 5)); }
__host__ __device__ __forceinline__ void stage_rc(int b, int& R, int& C) { const int st = b / 1024, sb = b % 1024, swz = sb ^ (((sb >> 9) & 1) << 5); R = (st >> 1) * 16 + swz / 64; C = (st & 1) * 32 + (swz % 64) / 2; }
__host__ __device__ __forceinline__ int perm32(int rho) { const int n = rho >> 4, i = rho & 15; return 8 * (i >> 2) + 4 * n + (i & 3); }

struct Unit { int pm, pn; };
struct Gemm { const bf16_t* A; const bf16_t* Bt; int M, N, K, lda; };

struct StaticOrder {
    int nM, nN, nwg, G, c;
    __host__ __device__ void init(int M, int N, int G_, int c_) { nM = M / BM; nN = N / BM; nwg = nM * nN; G = G_; c = c_; }
    __host__ __device__ bool next(int i, Unit& u) const {
        const long L = (long)i * G + c; if (L >= nwg) return false;
        int wgid = (int)L; { const int q = nwg / NXCD, r = nwg % NXCD, xcd = wgid % NXCD, off = wgid / NXCD; wgid = (xcd < r ? xcd * (q + 1) : r * (q + 1) + (xcd - r) * q) + off; }
        const int nig = WGM * nN, gid = wgid / nig, fm = gid * WGM, gsz = (nM - fm) < WGM ? (nM - fm) : WGM;
        u.pm = fm + ((wgid % nig) % gsz); u.pn = (wgid % nig) / gsz; return true;
    }
    __device__ __forceinline__ void a_ready(const Unit&) const {}
    __device__ __forceinline__ void done(const Unit&) const {}
};
struct PanelOrder {
    int nM, nN, G, c;
    __host__ __device__ void init(int M, int N, int G_, int c_) { nM = M / BM; nN = N / BM; G = G_; c = c_; }
    __host__ __device__ bool next(int i, Unit& u) const { u.pm = c + (i / nN) * G; u.pn = i % nN; return u.pm < nM; }
    __device__ __forceinline__ void a_ready(const Unit&) const {}
    __device__ __forceinline__ void done(const Unit&) const {}
};


typedef float f32x2_t __attribute__((ext_vector_type(2))); typedef __bf16 bf16x2_t __attribute__((ext_vector_type(2)));
__device__ __forceinline__ unsigned cvt_pk_bf16(float lo, float hi) { const f32x2_t v = {lo, hi}; const bf16x2_t b = __builtin_convertvector(v, bf16x2_t); return __builtin_bit_cast(unsigned, b); }

template <int ACT  > struct EpiBf16 {
    static constexpr bool PERM = true, AFTER_DRAIN = false;
    bf16_t* O; int ldc; float scale;
    __device__ __forceinline__ void operator()(const f32x4 (&acc)[2][2][4][2], const Unit& u, int wr, int wc, int fr, int fq) const {
        const int row0 = u.pm * BM + wr * 64 + fr; const int col0 = u.pn * BM + wc * 32 + 8 * fq;
#pragma unroll
        for (int ai = 0; ai < 2; ++ai)
#pragma unroll
            for (int m = 0; m < 4; ++m) { bf16_t* rowp = O + (size_t)(row0 + ai * HALF + m * 16) * ldc + col0;
#pragma unroll
                for (int bj = 0; bj < 2; ++bj) { f32x4 v0 = acc[ai][bj][m][0] * scale, v1 = acc[ai][bj][m][1] * scale;
                    if (ACT == 1) {
#pragma unroll
                        for (int j = 0; j < 4; ++j) { const float a = v0[j] > 0.f ? v0[j] : 0.f, b = v1[j] > 0.f ? v1[j] : 0.f; v0[j] = a * a; v1[j] = b * b; } }
                    u32x4 w; w.x = cvt_pk_bf16(v0[0], v0[1]); w.y = cvt_pk_bf16(v0[2], v0[3]); w.z = cvt_pk_bf16(v1[0], v1[1]); w.w = cvt_pk_bf16(v1[2], v1[3]);
                    *(u32x4*)(rowp + bj * HALF) = w; } }
    }
};
__device__ __forceinline__ unsigned pk4_fp8(float a, float b, float c, float d) { int r = __builtin_amdgcn_cvt_pk_fp8_f32(a, b, 0, false); r = __builtin_amdgcn_cvt_pk_fp8_f32(c, d, r, true); return (unsigned)r; }
struct EpiF8Relu2 {
    static constexpr bool PERM = true, AFTER_DRAIN = false;
    unsigned char* O; int ldc; float scale; const float* rowsq; const float* bias2;
    __device__ __forceinline__ void operator()(const f32x4 (&acc)[2][2][4][2], const Unit& u, int wr, int wc, int fr, int fq) const {
        const int row0 = u.pm * BM + wr * 64 + fr; const int col0 = u.pn * BM + wc * 32 + 8 * fq;
        const float* bp = bias2 + (size_t)(u.pm >> 3) * 4096 + col0;
        f32x4 bv[2][2];
#pragma unroll
        for (int bj = 0; bj < 2; ++bj) { bv[bj][0] = *(const f32x4*)(bp + bj * HALF); bv[bj][1] = *(const f32x4*)(bp + bj * HALF + 4); }
#pragma unroll
        for (int ai = 0; ai < 2; ++ai)
#pragma unroll
            for (int m = 0; m < 4; ++m) { const int row = row0 + ai * HALF + m * 16; unsigned char* rowp = O + (size_t)row * ldc + col0;
                const float rstd = rsqrtf(rowsq[row] * (1.f / 1024.f) + 1e-6f);
#pragma unroll
                for (int bj = 0; bj < 2; ++bj) { f32x4 v0 = acc[ai][bj][m][0] * rstd + bv[bj][0], v1 = acc[ai][bj][m][1] * rstd + bv[bj][1];
#pragma unroll
                    for (int j = 0; j < 4; ++j) { const float a = v0[j] > 0.f ? v0[j] : 0.f, b = v1[j] > 0.f ? v1[j] : 0.f; v0[j] = fminf(a * a * scale, 416.f); v1[j] = fminf(b * b * scale, 416.f); }
                    typedef unsigned u32x2_t __attribute__((ext_vector_type(2)));
                    u32x2_t w; w.x = pk4_fp8(v0[0], v0[1], v0[2], v0[3]); w.y = pk4_fp8(v1[0], v1[1], v1[2], v1[3]);
                    *(u32x2_t*)(rowp + bj * HALF) = w; } }
    }
};
struct EpiResGate {
    static constexpr bool PERM = false, AFTER_DRAIN = false;
    const float* base; float* out; int ldc; const float* gate; int gate_ld; float gscale;
    __device__ __forceinline__ void operator()(const f32x4 (&acc)[2][2][4][2], const Unit& u, int, int, int, int) const {
        int t_ = threadIdx.x; asm volatile("" : "+v"(t_));
        const int wr = t_ >> 8, wc = (t_ >> 6) & 3, fr = t_ & 15, fq = (t_ >> 4) & 3;
        const int row0 = u.pm * BM + wr * 64 + fr, col0 = u.pn * BM + wc * 32 + 4 * fq;
        const float* gp = gate + (size_t)(u.pm >> 3) * gate_ld + col0;
        f32x4 gv[2][2];
#pragma unroll
        for (int bj = 0; bj < 2; ++bj)
#pragma unroll
            for (int n = 0; n < 2; ++n) gv[bj][n] = *(const f32x4*)(gp + bj * HALF + n * 16) * gscale;
#pragma unroll
        for (int ai = 0; ai < 2; ++ai)
#pragma unroll
            for (int m = 0; m < 4; ++m) { const size_t off = (size_t)(row0 + ai * HALF + m * 16) * ldc + col0;
#pragma unroll
                for (int bj = 0; bj < 2; ++bj)
#pragma unroll
                    for (int n = 0; n < 2; ++n) { const f32x4 bs = *(const f32x4*)(base + off + bj * HALF + n * 16);
                        *(f32x4*)(out + off + bj * HALF + n * 16) = bs + gv[bj][n] * acc[ai][bj][m][n]; } }
    }
};
struct EpiResGateNorm {
    static constexpr bool PERM = false, AFTER_DRAIN = false;
    const float* base; float* out; int ldc; const float* gate; int gate_ld; const float* gffn; const float* sc2; bf16_t* a2; float* rowsq; float gscale;
    __device__ __forceinline__ void operator()(const f32x4 (&acc)[2][2][4][2], const Unit& u, int, int, int, int) const {
        int t_ = threadIdx.x; asm volatile("" : "+v"(t_));
        const int wr = t_ >> 8, wc = (t_ >> 6) & 3, fr = t_ & 15, fq = (t_ >> 4) & 3;
        const int row0 = u.pm * BM + wr * 64 + fr, col0 = u.pn * BM + wc * 32 + 4 * fq;
        const float* gp = gate + (size_t)(u.pm >> 3) * gate_ld + col0; const float* sp = sc2 + (size_t)(u.pm >> 3) * gate_ld + col0;
        f32x4 gv[2][2], gm[2][2];
#pragma unroll
        for (int bj = 0; bj < 2; ++bj)
#pragma unroll
            for (int n = 0; n < 2; ++n) { gv[bj][n] = *(const f32x4*)(gp + bj * HALF + n * 16) * gscale; gm[bj][n] = *(const f32x4*)(gffn + col0 + bj * HALF + n * 16) * (*(const f32x4*)(sp + bj * HALF + n * 16) + 1.f); }
#pragma unroll
        for (int ai = 0; ai < 2; ++ai)
#pragma unroll
            for (int m = 0; m < 4; ++m) { const int row = row0 + ai * HALF + m * 16; const size_t off = (size_t)row * ldc + col0; float ss = 0.f;
#pragma unroll
                for (int bj = 0; bj < 2; ++bj)
#pragma unroll
                    for (int n = 0; n < 2; ++n) { const f32x4 bs = *(const f32x4*)(base + off + bj * HALF + n * 16); const f32x4 x1 = bs + gv[bj][n] * acc[ai][bj][m][n];
                        ss += (x1.x * x1.x + x1.y * x1.y) + (x1.z * x1.z + x1.w * x1.w);
                        const f32x4 y = x1 * gm[bj][n]; typedef unsigned u32x2_t __attribute__((ext_vector_type(2)));
                        u32x2_t w; w.x = cvt_pk_bf16(y.x, y.y); w.y = cvt_pk_bf16(y.z, y.w); *(u32x2_t*)(a2 + off + bj * HALF + n * 16) = w; }
                ss = xor32_sum(xor16_sum(ss));
                if (fq == 0) atomicAdd(rowsq + row, ss); }
    }
};
struct EpiResGateA2 {
    static constexpr bool PERM = false, AFTER_DRAIN = false;
    const bf16_t* a2; float* out; int ldc; const float* gate; int gate_ld; const float* gffn;
    __device__ __forceinline__ void operator()(const f32x4 (&acc)[2][2][4][2], const Unit& u, int, int, int, int) const {
        constexpr float gscale = 1.f / 256.f;
        int t_ = threadIdx.x; asm volatile("" : "+v"(t_));
        const int wr = t_ >> 8, wc = (t_ >> 6) & 3, fr = t_ & 15, fq = (t_ >> 4) & 3;
        const int row0 = u.pm * BM + wr * 64 + fr, col0 = u.pn * BM + wc * 32 + 4 * fq;
        const float* gp = gate + (size_t)(u.pm >> 3) * gate_ld + col0; const float* sp = gp - 1024;
        f32x4 gv[2][2], ig[2][2];
#pragma unroll
        for (int bj = 0; bj < 2; ++bj)
#pragma unroll
            for (int n = 0; n < 2; ++n) { gv[bj][n] = *(const f32x4*)(gp + bj * HALF + n * 16) * gscale;
                const f32x4 gm = *(const f32x4*)(gffn + col0 + bj * HALF + n * 16) * (*(const f32x4*)(sp + bj * HALF + n * 16) + 1.f);
                ig[bj][n] = (f32x4){1.f / gm.x, 1.f / gm.y, 1.f / gm.z, 1.f / gm.w}; }
#pragma unroll
        for (int ai = 0; ai < 2; ++ai)
#pragma unroll
            for (int m = 0; m < 4; ++m) { const size_t off = (size_t)(row0 + ai * HALF + m * 16) * ldc + col0;
#pragma unroll
                for (int bj = 0; bj < 2; ++bj)
#pragma unroll
                    for (int n = 0; n < 2; ++n) { typedef unsigned u32x2_t __attribute__((ext_vector_type(2)));
                        const u32x2_t w = *(const u32x2_t*)(a2 + off + bj * HALF + n * 16);
                        const f32x4 xa = {__uint_as_float(w.x << 16), __uint_as_float(w.x & 0xffff0000u), __uint_as_float(w.y << 16), __uint_as_float(w.y & 0xffff0000u)};
                        *(f32x4*)(out + off + bj * HALF + n * 16) = xa * ig[bj][n] + gv[bj][n] * acc[ai][bj][m][n]; } }
    }
};
template <class Epi, class Sched, bool ALIGN_EPI = false, bool SP2 = false, bool F8 = false>
__device__ __forceinline__ void gemm_phase(PG8_LAS unsigned char* lds, const Gemm g, const Sched S, const Epi E) {
    const int tid = threadIdx.x, wid = __builtin_amdgcn_readfirstlane(tid >> 6), lane = tid & 63, wr = wid >> 2, wc = wid & 3, fr = lane & 15, fq = lane >> 4;
    const int K = g.K, nt = K / BK;
    unsigned voffA[2], voffB[2];
#pragma unroll
    for (int i = 0; i < 2; ++i) { int R, C; stage_rc(tid * 16 + i * 8192, R, C); const int Rb = Epi::PERM ? ((R & ~31) + perm32(R & 31)) : R;
        voffA[i] = (unsigned)(R * g.lda + C) * 2u; voffB[i] = (unsigned)(Rb * K + C) * 2u; }
    const size_t kstep = (size_t)(BK * 2);
    const size_t hstepB = (size_t)HALF * K * 2, hstepA = (size_t)HALF * g.lda * 2;
    const size_t tstepA = 2 * hstepA, tstepB = 2 * hstepB;
    const unsigned ldsw = (unsigned)wid * 1024u;
    const int f8in = (fq >> 1) * 1024 + ((fr * 64 + (fq & 1) * 32) ^ ((fr >> 3) << 5));
    const int aoff = F8 ? wr * 8192 + f8in : lds_byte(wr * 64 + fr, fq * 8), boff = F8 ? wc * 4096 + f8in : lds_byte(wc * 32 + fr, fq * 8);
    constexpr int KOFF = F8 ? 16 : 1024;
    typedef int v8i_t __attribute__((ext_vector_type(8)));
#define PG8_SA(b, h) (((b) * 2 + (h)) * HTB)
#define PG8_SB(b, h) ((4 + (b) * 2 + (h)) * HTB)
#define PG8_STAGE(bufoff, gbase, voff) do { _Pragma("unroll") for (int _i = 0; _i < 2; ++_i) \
        __builtin_amdgcn_global_load_lds((const unsigned*)((const char*)(gbase) + (voff)[_i]), (PG8_LAS unsigned*)(lds + (bufoff) + ldsw + _i * 8192), 16, 0, 0); } while (0)
#define PG8_LD32(p_) __builtin_shufflevector(*(const PG8_LAS u32x4*)(p_), *(const PG8_LAS u32x4*)((p_) + 16), 0, 1, 2, 3, 4, 5, 6, 7)
#define PG8_LDA(dst, b, h) do { if constexpr (F8) { _Pragma("unroll") for (int m = 0; m < 4; ++m) dst##8[m] = __builtin_bit_cast(v8i_t, PG8_LD32(lds + PG8_SA(b, h) + aoff + m * 2048)); } \
    else { _Pragma("unroll") for (int m = 0; m < 4; ++m) _Pragma("unroll") for (int k = 0; k < 2; ++k) dst[m][k] = *(const PG8_LAS bf16x8*)(lds + PG8_SA(b, h) + aoff + m * 2048 + k * KOFF); } } while (0)
#define PG8_LDB(dst, b, h) do { if constexpr (F8) { _Pragma("unroll") for (int n = 0; n < 2; ++n) dst##8[n] = __builtin_bit_cast(v8i_t, PG8_LD32(lds + PG8_SB(b, h) + boff + n * 2048)); } \
    else { _Pragma("unroll") for (int n = 0; n < 2; ++n) _Pragma("unroll") for (int k = 0; k < 2; ++k) dst[n][k] = *(const PG8_LAS bf16x8*)(lds + PG8_SB(b, h) + boff + n * 2048 + k * KOFF); } } while (0)
#define PG8_CAT(x) __builtin_shufflevector(__builtin_bit_cast(u32x4, (x)[0]), __builtin_bit_cast(u32x4, (x)[1]), 0, 1, 2, 3, 4, 5, 6, 7)
#define PG8_MMA(ai, bj, At, Bt) do { __builtin_amdgcn_s_setprio(1); if constexpr (F8) { _Pragma("unroll") for (int m = 0; m < 4; ++m) _Pragma("unroll") for (int n = 0; n < 2; ++n) \
        asm volatile("v_mfma_f32_16x16x128_f8f6f4 %0, %1, %2, %0" : "+v"(acc[ai][bj][m][n]) : "v"(Bt##8[n]), "v"(At##8[m])); } \
    else { _Pragma("unroll") for (int m = 0; m < 4; ++m) _Pragma("unroll") for (int n = 0; n < 2; ++n) _Pragma("unroll") for (int k = 0; k < 2; ++k) \
        acc[ai][bj][m][n] = __builtin_amdgcn_mfma_f32_16x16x32_bf16(Bt[n][k], At[m][k], acc[ai][bj][m][n], 0, 0, 0); } __builtin_amdgcn_s_setprio(0); } while (0)
#define PG8_WAIT_V(n) asm volatile("s_waitcnt vmcnt(" #n ")" ::: "memory")
#define PG8_WAIT_L(n) asm volatile("s_waitcnt lgkmcnt(" #n ")" ::: "memory")
#define PG8_BAR __builtin_amdgcn_s_barrier()
#define PG8_SCHED __builtin_amdgcn_sched_barrier(0)
    Unit cur, nxt; int ui = 0;
    if (!S.next(0, cur)) return;
    f32x4 acc[2][2][4][2];
#pragma unroll
    for (int a = 0; a < 2; ++a)
#pragma unroll
        for (int b = 0; b < 2; ++b)
#pragma unroll
            for (int m = 0; m < 4; ++m)
#pragma unroll
                for (int n = 0; n < 2; ++n) acc[a][b][m][n] = (f32x4){0.f, 0.f, 0.f, 0.f};
    bf16x8 At[4][2], B0[2][2], B1[2][2]; v8i_t At8[4], B08[2], B18[2];
    const char* cA = (const char*)g.A + (size_t)cur.pm * tstepA; const char* cB = (const char*)g.Bt + (size_t)cur.pn * tstepB;
    S.a_ready(cur);
    if constexpr (SP2) {
        PG8_STAGE(PG8_SB(0, 0), cB, voffB); PG8_STAGE(PG8_SB(0, 1), cB + hstepB, voffB); PG8_STAGE(PG8_SA(0, 0), cA, voffA); PG8_STAGE(PG8_SA(0, 1), cA + hstepA, voffA);
        if (wr == 1) PG8_BAR;
        PG8_WAIT_V(2); PG8_BAR;
        PG8_STAGE(PG8_SB(1, 0), cB + kstep, voffB); PG8_STAGE(PG8_SA(1, 0), cA + kstep, voffA); PG8_STAGE(PG8_SB(1, 1), cB + hstepB + kstep, voffB);
        PG8_WAIT_V(6); PG8_BAR;
    } else {
        PG8_STAGE(PG8_SB(0, 0), cB, voffB); PG8_STAGE(PG8_SA(0, 0), cA, voffA); PG8_STAGE(PG8_SB(0, 1), cB + hstepB, voffB); PG8_STAGE(PG8_SA(0, 1), cA + hstepA, voffA);
        if (wr == 1) PG8_BAR;
        PG8_WAIT_V(4); PG8_BAR;
        PG8_STAGE(PG8_SB(1, 0), cB + kstep, voffB); PG8_STAGE(PG8_SA(1, 0), cA + kstep, voffA); PG8_STAGE(PG8_SB(1, 1), cB + hstepB + kstep, voffB);
        PG8_WAIT_V(6); PG8_BAR;
    }
    for (;;) {
        const bool has_next = S.next(ui + 1, nxt);
        const char* nA = has_next ? (const char*)g.A + (size_t)nxt.pm * tstepA : cA; const char* nB = has_next ? (const char*)g.Bt + (size_t)nxt.pn * tstepB : cB;
        for (int t = 0; t < nt; t += 2) {
            const bool last = (t == nt - 2);
            const char* a1 = cA + (size_t)(t + 1) * kstep;
            const char* a2 = last ? nA : cA + (size_t)(t + 2) * kstep; const char* b2 = last ? nB : cB + (size_t)(t + 2) * kstep;
            const char* a3 = a2 + kstep; const char* b3 = b2 + kstep;
            if (last && has_next) S.a_ready(nxt);
            if constexpr (SP2) {
            PG8_LDB(B0, 0, 0); PG8_LDB(B1, 0, 1); PG8_SCHED; PG8_LDA(At, 0, 0); PG8_STAGE(PG8_SA(1, 1), a1 + hstepA, voffA);
            PG8_WAIT_V(8); PG8_WAIT_L(0); PG8_BAR; PG8_MMA(0, 0, At, B0); PG8_MMA(0, 1, At, B1); PG8_BAR; PG8_SCHED;
            PG8_LDA(At, 0, 1); PG8_STAGE(PG8_SB(0, 0), b2, voffB); PG8_STAGE(PG8_SB(0, 1), b2 + hstepB, voffB); PG8_STAGE(PG8_SA(0, 0), a2, voffA);
            PG8_WAIT_V(8); PG8_WAIT_L(0); PG8_BAR; PG8_MMA(1, 0, At, B0); PG8_MMA(1, 1, At, B1); PG8_BAR; PG8_SCHED;
            PG8_LDB(B0, 1, 0); PG8_LDB(B1, 1, 1); PG8_SCHED; PG8_LDA(At, 1, 0); PG8_STAGE(PG8_SA(0, 1), a2 + hstepA, voffA);
            PG8_WAIT_V(8); PG8_WAIT_L(0); PG8_BAR; PG8_MMA(0, 0, At, B0); PG8_MMA(0, 1, At, B1); PG8_BAR; PG8_SCHED;
            PG8_LDA(At, 1, 1); PG8_STAGE(PG8_SB(1, 0), b3, voffB); PG8_STAGE(PG8_SB(1, 1), b3 + hstepB, voffB); PG8_STAGE(PG8_SA(1, 0), a3, voffA);
            PG8_WAIT_V(8); PG8_WAIT_L(0); PG8_BAR; PG8_MMA(1, 0, At, B0); PG8_MMA(1, 1, At, B1); PG8_BAR; PG8_SCHED;
            } else {
            PG8_LDB(B0, 0, 0); PG8_SCHED; PG8_LDA(At, 0, 0); PG8_STAGE(PG8_SA(1, 1), a1 + hstepA, voffA);
            PG8_WAIT_L(8); PG8_BAR; PG8_WAIT_L(0); PG8_MMA(0, 0, At, B0); PG8_BAR; PG8_SCHED;
            PG8_LDB(B1, 0, 1); PG8_STAGE(PG8_SB(0, 0), b2, voffB);
            PG8_BAR; PG8_WAIT_L(0); PG8_MMA(0, 1, At, B1); PG8_BAR;
            PG8_LDA(At, 0, 1); PG8_STAGE(PG8_SA(0, 0), a2, voffA);
            PG8_BAR; PG8_WAIT_L(0); PG8_MMA(1, 0, At, B0); PG8_BAR; PG8_SCHED;
            PG8_STAGE(PG8_SB(0, 1), b2 + hstepB, voffB);
            PG8_WAIT_V(6); PG8_BAR; PG8_MMA(1, 1, At, B1); PG8_BAR;
            PG8_LDB(B0, 1, 0); PG8_SCHED; PG8_LDA(At, 1, 0); PG8_STAGE(PG8_SA(0, 1), a2 + hstepA, voffA);
            PG8_WAIT_L(8); PG8_BAR; PG8_WAIT_L(0); PG8_MMA(0, 0, At, B0); PG8_BAR; PG8_SCHED;
            PG8_LDB(B1, 1, 1); PG8_STAGE(PG8_SB(1, 0), b3, voffB);
            PG8_BAR; PG8_WAIT_L(0); PG8_MMA(0, 1, At, B1); PG8_BAR;
            PG8_LDA(At, 1, 1); PG8_STAGE(PG8_SA(1, 0), a3, voffA);
            PG8_BAR; PG8_WAIT_L(0); PG8_MMA(1, 0, At, B0); PG8_BAR; PG8_SCHED;
            PG8_STAGE(PG8_SB(1, 1), b3 + hstepB, voffB);
            PG8_WAIT_V(6); PG8_BAR; PG8_MMA(1, 1, At, B1); PG8_BAR;
            }
        }
        if constexpr (ALIGN_EPI) { if (wr == 0) PG8_BAR; }
        if constexpr (F8) asm volatile("s_nop 15\n\ts_nop 15");
        if constexpr (!Epi::AFTER_DRAIN) { E(acc, cur, wr, wc, fr, fq); S.done(cur); }
        if (!has_next) break;
#pragma unroll
        for (int a = 0; a < 2; ++a)
#pragma unroll
            for (int b = 0; b < 2; ++b)
#pragma unroll
                for (int m = 0; m < 4; ++m)
#pragma unroll
                    for (int n = 0; n < 2; ++n) acc[a][b][m][n] = (f32x4){0.f, 0.f, 0.f, 0.f};
        cur = nxt; cA = nA; cB = nB; ++ui;
        if constexpr (ALIGN_EPI) { if (wr == 1) PG8_BAR; }
    }
    PG8_WAIT_V(0);
    if constexpr (!ALIGN_EPI) { if (wr == 0) PG8_BAR; }
    PG8_BAR;
    if constexpr (Epi::AFTER_DRAIN) { E.fused(acc, cur, wr, wc, fr, fq, lds, wid, lane); S.done(cur); }
#undef PG8_SA
#undef PG8_SB
#undef PG8_STAGE
#undef PG8_LDA
#undef PG8_LDB
#undef PG8_MMA
#undef PG8_CAT
#undef PG8_LD32
#undef PG8_WAIT_V
#undef PG8_WAIT_L
#undef PG8_BAR
#undef PG8_SCHED
}
}

#define LAS __attribute__((address_space(3)))
typedef unsigned short bf16;
typedef short bf16x8 __attribute__((ext_vector_type(8)));
typedef short s16x4 __attribute__((ext_vector_type(4)));
typedef float f32x4 __attribute__((ext_vector_type(4)));
typedef float f32x16 __attribute__((ext_vector_type(16)));
typedef unsigned u32x4 __attribute__((ext_vector_type(4)));
typedef unsigned u32x2 __attribute__((ext_vector_type(2)));

constexpr int NB = 32, SEQ = 2048, DM = 1024, M = NB * SEQ, NPROJ = 3072, FF = 4096;
constexpr int PC_Q = 0, PC_R = 512, PC_K = 1024, PC_V = 1536, PC_QI = 2048, PC_CL = 2560, PC_KI = 2688, PC_XW = 2752, PC_XA = 2816, PC_XG = 2880, PC_WI = 3008;
constexpr size_t MiB = 1u << 20;
constexpr size_t WS_MOD = 0, WS_WUKT = 1 * MiB, WS_WUK = WS_WUKT + 131072, WS_WUVT = WS_WUK + 131072, WS_INVR = 2 * MiB, WS_WIN = 4 * MiB, WS_WOUT = 10 * MiB,
                 WS_W1 = 12 * MiB, WS_W2 = 20 * MiB, WS_CKV = 36 * MiB, WS_GAM = 52 * MiB, WS_C3 = 60 * MiB, WS_REGA = 64 * MiB, WS_PROJ = 192 * MiB, WS_CH = 576 * MiB,
                 WS_G = 960 * MiB, WS_U = 192 * MiB, WS_END = 1024 * MiB,
                 WS_BAR = 62 * MiB, WS_ROWSQ = WS_BAR + 65536, WS_BIAS2 = WS_ROWSQ + 262144, WS_W2T = WS_WUVT + 131072, WS_A2T = WS_W2T + 65536, WS_G2T = WS_A2T + 65536;
constexpr int LDS_BAR_OFF = 163072;
constexpr int LDS_BYTES = 163328;
constexpr int NWAVES = 8;

struct Params {
    const float *x, *c, *w_ada, *b_ada, *g_mix, *g_ffn, *w_in, *g_q, *g_k, *g_kv, *w_uk, *w_uv, *mu, *w0, *w2, *a0, *a2, *g2, *k_k, *k_a, *r_k, *ln_w, *ln_b, *w_out, *w_ff1, *w_ff2;
    float* out; unsigned char* ws; int ph_lo, ph_hi;
};

__device__ __forceinline__ unsigned pk2(float lo, float hi) { return pg8::cvt_pk_bf16(lo, hi); }
__device__ __forceinline__ float bflo(unsigned w) { return __uint_as_float(w << 16); }
__device__ __forceinline__ float bfhi(unsigned w) { return __uint_as_float(w & 0xffff0000u); }
__device__ __forceinline__ float bf2f(bf16 h) { return __uint_as_float((unsigned)h << 16); }
__device__ __forceinline__ bf16 f2bf(float f) { return (bf16)(pk2(f, 0.f) & 0xffffu); }
__device__ __forceinline__ f32x16 mfma32(bf16x8 a, bf16x8 b, f32x16 c) { return __builtin_amdgcn_mfma_f32_32x32x16_bf16(a, b, c, 0, 0, 0); }
__device__ __forceinline__ f32x4 mfma16(bf16x8 a, bf16x8 b, f32x4 c) { return __builtin_amdgcn_mfma_f32_16x16x32_bf16(a, b, c, 0, 0, 0); }

__device__ __forceinline__ int win_src_col(int n) {
    if (n < 512) return n;
    if (n < 1024) return 1224 + (n - 512);
    if (n < 1536) return 1736 + (n - 1024);
    if (n < 2048) return 2248 + (n - 1536);
    if (n < 2560) return 640 + (n - 2048);
    if (n < 2688) return 512 + (n - 2560);
    if (n < 2752) return 1152 + (n - 2688);
    if (n < 2816) return 2760 + (n - 2752);
    if (n < 2880) return 2824 + (n - 2816);
    if (n < 3008) return 2888 + (n - 2880);
    if (n < 3016) return 1216 + (n - 3008);
    return -1;
}
__device__ __forceinline__ void conv_t_item(const float* W, int K, int Nsrc, bf16* WT, int nblk, int item, float* scr, int lane, bool is_win) {
    const int kb = item / nblk, nb = item % nblk, k0 = 64 * kb, n0 = 32 * nb;
    int ns = n0 + (lane & 31); if (is_win) ns = win_src_col(ns);
    float tv[32];
#pragma unroll
    for (int i = 0; i < 32; ++i) { const int kk = 2 * i + (lane >> 5); tv[i] = ns >= 0 ? W[(size_t)(k0 + kk) * Nsrc + ns] : 0.f; }
#pragma unroll
    for (int i = 0; i < 32; ++i) { const int kk = 2 * i + (lane >> 5); scr[kk * 33 + (lane & 31)] = tv[i]; }
    asm volatile("s_waitcnt lgkmcnt(0)" ::: "memory");
    const int c = lane & 7;
#pragma unroll
    for (int j = 0; j < 4; ++j) { const int n = (lane >> 3) + 8 * j; const float* s = scr + (8 * c) * 33 + n;
        u32x4 o; o.x = pk2(s[0 * 33], s[1 * 33]); o.y = pk2(s[2 * 33], s[3 * 33]); o.z = pk2(s[4 * 33], s[5 * 33]); o.w = pk2(s[6 * 33], s[7 * 33]);
        *(u32x4*)(WT + (size_t)(n0 + n) * K + k0 + 8 * c) = o; }
    asm volatile("s_waitcnt lgkmcnt(0)" ::: "memory");
}
__device__ __forceinline__ void conv_t_item_f8(const float* W, int K, int N, unsigned char* WT, int nblk, int item, float* scr, int lane, float scale, bool is_win = false) {
    const int kb = item / nblk, nb = item % nblk, k0 = 64 * kb, n0 = 32 * nb;
    int ns = n0 + (lane & 31); if (is_win) ns = win_src_col(ns);
    float tv[32];
#pragma unroll
    for (int i = 0; i < 32; ++i) { const int kk = 2 * i + (lane >> 5); tv[i] = ns >= 0 ? W[(size_t)(k0 + kk) * N + ns] * scale : 0.f; }
#pragma unroll
    for (int i = 0; i < 32; ++i) { const int kk = 2 * i + (lane >> 5); scr[kk * 33 + (lane & 31)] = tv[i]; }
    asm volatile("s_waitcnt lgkmcnt(0)" ::: "memory");
    const int c = lane & 7;
#pragma unroll
    for (int j = 0; j < 4; ++j) { const int n = (lane >> 3) + 8 * j; const float* s = scr + (8 * c) * 33 + n;
        u32x2 o; o.x = pg8::pk4_fp8(s[0 * 33], s[1 * 33], s[2 * 33], s[3 * 33]); o.y = pg8::pk4_fp8(s[4 * 33], s[5 * 33], s[6 * 33], s[7 * 33]);
        *(u32x2*)(WT + (size_t)(n0 + n) * K + k0 + 8 * c) = o; }
    asm volatile("s_waitcnt lgkmcnt(0)" ::: "memory");
}
__device__ __forceinline__ void adaln_block(const Params& p, float* ldsf, int cb, int tid) {
    const int lane = tid & 63, wv = tid >> 6, r = lane & 31, kg = lane >> 5, e0 = cb * 64;
    float* RED = ldsf;
    float* mod = (float*)(p.ws + WS_MOD);
    float wreg[2][8][8];
#pragma unroll
    for (int nt = 0; nt < 2; ++nt)
#pragma unroll
        for (int ks = 0; ks < 8; ++ks)
#pragma unroll
            for (int j = 0; j < 8; ++j) wreg[nt][ks][j] = p.w_ada[(size_t)(wv * 128 + 16 * ks + 8 * kg + j) * 6144 + e0 + 32 * nt + r];
    f32x16 acc[2]; acc[0] = (f32x16){}; acc[1] = (f32x16){};
#pragma unroll
    for (int ks = 0; ks < 8; ++ks) {
        const float* cp = p.c + (size_t)r * 1024 + wv * 128 + 16 * ks + 8 * kg;
        const f32x4 c0 = *(const f32x4*)cp, c1 = *(const f32x4*)(cp + 4);
        float sv[8];
#pragma unroll
        for (int j = 0; j < 4; ++j) { sv[j] = c0[j] * __builtin_amdgcn_rcpf(1.f + __expf(-c0[j])); sv[4 + j] = c1[j] * __builtin_amdgcn_rcpf(1.f + __expf(-c1[j])); }
        const u32x4 au = {pk2(sv[0], sv[1]), pk2(sv[2], sv[3]), pk2(sv[4], sv[5]), pk2(sv[6], sv[7])};
#pragma unroll
        for (int nt = 0; nt < 2; ++nt) { const u32x4 bu = {pk2(wreg[nt][ks][0], wreg[nt][ks][1]), pk2(wreg[nt][ks][2], wreg[nt][ks][3]), pk2(wreg[nt][ks][4], wreg[nt][ks][5]), pk2(wreg[nt][ks][6], wreg[nt][ks][7])};
            acc[nt] = mfma32(__builtin_bit_cast(bf16x8, au), __builtin_bit_cast(bf16x8, bu), acc[nt]); }
    }
#pragma unroll
    for (int nt = 0; nt < 2; ++nt)
#pragma unroll
        for (int i = 0; i < 16; ++i) RED[(wv * 32 + (i & 3) + 8 * (i >> 2) + 4 * kg) * 64 + 32 * nt + r] = acc[nt][i];
    __syncthreads();
    {   const int o = tid * 4, bb = o >> 6, col = o & 63;
        f32x4 s = *(const f32x4*)(p.b_ada + e0 + col);
#pragma unroll
        for (int ww = 0; ww < 8; ++ww) s += *(const f32x4*)(RED + (ww * 32 + bb) * 64 + col);
        *(f32x4*)(mod + (size_t)bb * 6144 + e0 + col) = s; }
    __syncthreads();
}
__device__ __forceinline__ void phase_pro(const Params& p, unsigned char* lds, int tid, int G) {
    const int lane = tid & 63, wv = tid >> 6;
    for (int cb = blockIdx.x; cb < 96; cb += G) adaln_block(p, (float*)lds, cb, tid);
    __syncthreads();
    float* scr = (float*)lds + wv * (64 * 33 + 16);
    const int gw = blockIdx.x * NWAVES + wv, NGW = G * NWAVES;
    bf16* WIN = (bf16*)(p.ws + WS_WIN); bf16* WOUT = (bf16*)(p.ws + WS_WOUT); bf16* W1 = (bf16*)(p.ws + WS_W1); bf16* W2 = (bf16*)(p.ws + WS_W2);
    bf16* WUKT = (bf16*)(p.ws + WS_WUKT); bf16* WUK = (bf16*)(p.ws + WS_WUK); bf16* WUVT = (bf16*)(p.ws + WS_WUVT);
    constexpr int I_IN = (DM / 64) * (NPROJ / 32), I_OUT = (DM / 64) * (DM / 32), I_1 = (DM / 64) * (FF / 32), I_2 = (FF / 64) * (DM / 32), I_UK = (128 / 64) * (512 / 32);
    constexpr int I_LR = 512 / 32;
    constexpr int NITEMS = I_IN + I_OUT + I_1 + I_2 + 2 * I_UK + 4 * I_LR;
    for (int it = gw; it < NITEMS; it += NGW) {
        int r = it;
        if (r < I_IN) { if (MK_F8_GEMM1) conv_t_item_f8(p.w_in, DM, 3016, (unsigned char*)WIN, NPROJ / 32, r, scr, lane, 32.f, true); else conv_t_item(p.w_in, DM, 3016, WIN, NPROJ / 32, r, scr, lane, true); continue; } r -= I_IN;
        if (r < I_OUT) { if (MK_F8_GOUT) conv_t_item_f8(p.w_out, DM, DM, (unsigned char*)WOUT, DM / 32, r, scr, lane, 32.f); else conv_t_item(p.w_out, DM, DM, WOUT, DM / 32, r, scr, lane, false); continue; } r -= I_OUT;
        if (r < I_1) { conv_t_item(p.w_ff1, DM, FF, W1, FF / 32, r, scr, lane, false); continue; } r -= I_1;
        if (r < I_2) { conv_t_item_f8(p.w_ff2, FF, DM, (unsigned char*)W2, DM / 32, r, scr, lane, 64.f); continue; } r -= I_2;
        if (r < I_UK) { conv_t_item(p.w_uk, 128, 512, WUKT, 512 / 32, r, scr, lane, false); continue; } r -= I_UK;
        if (r < I_UK) { conv_t_item(p.w_uv, 128, 512, WUVT, 512 / 32, r, scr, lane, false); continue; } r -= I_UK;
        if (r < I_LR) { conv_t_item(p.w2, 64, 512, (bf16*)(p.ws + WS_W2T), 512 / 32, r, scr, lane, false); continue; } r -= I_LR;
        if (r < I_LR) { conv_t_item(p.a2, 64, 512, (bf16*)(p.ws + WS_A2T), 512 / 32, r, scr, lane, false); continue; } r -= I_LR;
        conv_t_item(p.g2, 128, 512, (bf16*)(p.ws + WS_G2T), 512 / 32, r, scr, lane, false);
    }
    { float* ROWSQ = (float*)(p.ws + WS_ROWSQ); for (int i = blockIdx.x * 512 + tid; i < M; i += G * 512) ROWSQ[i] = 0.f; }
    for (int i = blockIdx.x * 512 + tid; i < 128 * 512 / 2; i += G * 512) { const float a = p.w_uk[2 * i], b = p.w_uk[2 * i + 1]; ((unsigned*)WUK)[i] = pk2(a, b); }
}

template <bool F8OUT> __device__ __forceinline__ void hn_rows(const float* src, const float* g, const float* mod, int off_sh, int off_sc, bf16* dst, int gw, int NGW, int lane) {
    const int RPW = M / NGW;
    for (int m0 = gw * RPW; m0 < M; m0 += NGW * RPW) {
        const float* mb = mod + (size_t)(m0 >> 11) * 6144;
        f32x4 ga[4], sh[4];
#pragma unroll
        for (int j = 0; j < 4; ++j) { const int col = 4 * lane + 256 * j; const f32x4 gg = *(const f32x4*)(g + col), sc = *(const f32x4*)(mb + off_sc + col); ga[j] = gg * (1.f + sc); sh[j] = *(const f32x4*)(mb + off_sh + col); }
        for (int r0 = 0; r0 < RPW; r0 += 4) {
            f32x4 v[4][4]; float s[4];
#pragma unroll
            for (int r = 0; r < 4; ++r) { const f32x4* xr = (const f32x4*)(src + (size_t)(m0 + r0 + r) * DM) + lane;
#pragma unroll
                for (int j = 0; j < 4; ++j) v[r][j] = xr[64 * j]; }
#pragma unroll
            for (int r = 0; r < 4; ++r) { s[r] = 0.f;
#pragma unroll
                for (int j = 0; j < 4; ++j) s[r] += (v[r][j].x * v[r][j].x + v[r][j].y * v[r][j].y) + (v[r][j].z * v[r][j].z + v[r][j].w * v[r][j].w); }
#pragma unroll
            for (int r = 0; r < 4; ++r) s[r] = wave_sum(s[r]);
#pragma unroll
            for (int r = 0; r < 4; ++r) { const int m = m0 + r0 + r; const float rstd = rsqrtf(s[r] * (1.f / DM) + 1e-6f);
                unsigned long long* o8 = (unsigned long long*)(dst + (size_t)m * DM) + lane;
#pragma unroll
                for (int j = 0; j < 4; ++j) { const f32x4 y = v[r][j] * rstd * ga[j] + sh[j];
                    if (F8OUT) ((unsigned*)((unsigned char*)dst + (size_t)m * DM))[lane + 64 * j] = pg8::pk4_fp8(y.x, y.y, y.z, y.w);
                    else o8[64 * j] = (unsigned long long)pk2(y.x, y.y) | ((unsigned long long)pk2(y.z, y.w) << 32); } }
        }
    }
}

typedef short s16x4 __attribute__((ext_vector_type(4)));
__device__ __forceinline__ f32x4 mfma16k(s16x4 a, s16x4 b, f32x4 c) { return __builtin_amdgcn_mfma_f32_16x16x16bf16_1k(a, b, c, 0, 0, 0); }
__device__ __forceinline__ s16x4 pack4(f32x4 v) { u32x2 o; o.x = pk2(v[0], v[1]); o.y = pk2(v[2], v[3]); return __builtin_bit_cast(s16x4, o); }

__device__ __forceinline__ float frcp(float x) { return __builtin_amdgcn_rcpf(x); }
__device__ __forceinline__ void rwkv_prep_item(const Params& p, unsigned char* lds, int it, int tid_in) {
    int tid = tid_in; asm volatile("" : "+v"(tid));
    const int lane = tid & 63, wv = __builtin_amdgcn_readfirstlane(tid >> 6);
    bf16* XS = (bf16*)lds;
    bf16* STG = (bf16*)(lds + 33792) + wv * 4096;
    float* MAB = (float*)(lds + 99328) + wv * 256;
    bf16* RKV = (bf16*)(lds + 107520) + wv * 3468;
    const bf16* PROJ = (const bf16*)(p.ws + WS_PROJ);
    const bf16* W2T = (const bf16*)(p.ws + WS_W2T); const bf16* A2T = (const bf16*)(p.ws + WS_A2T); const bf16* G2T = (const bf16*)(p.ws + WS_G2T);
    float* GAM = (float*)(p.ws + WS_GAM); float* C3 = (float*)(p.ws + WS_C3); bf16* GB = (bf16*)(p.ws + WS_G);
    const int row0 = it * 64, t0 = (it & 31) * 64, b = it >> 5;
    __syncthreads();
    {   const int xt = tid >> 5, xch = tid & 31;
        const f32x4 m0_ = *(const f32x4*)(p.mu + 1536 + 8 * xch), m1_ = *(const f32x4*)(p.mu + 1536 + 8 * xch + 4); const float sc_ = xch < 8 ? 2.f : -1.f;
        u32x4 xc[4], xp[4];
#pragma unroll
        for (int qq = 0; qq < 4; ++qq) { const int t = xt + 16 * qq; const bf16* src_ = PROJ + (size_t)(row0 + t) * NPROJ + PC_XW + 8 * xch; xc[qq] = *(const u32x4*)src_;
            xp[qq] = (u32x4){0u, 0u, 0u, 0u}; if (t0 + t != 0) xp[qq] = *(const u32x4*)(src_ - NPROJ); }
#pragma unroll
        for (int qq = 0; qq < 4; ++qq) { float o_[8];
#pragma unroll
            for (int i = 0; i < 4; ++i) { const float c0_ = bflo(xc[qq][i]), c1_ = bfhi(xc[qq][i]), p0_ = bflo(xp[qq][i]), p1_ = bfhi(xp[qq][i]);
                const float ma_ = i < 2 ? m0_[2 * i] : m1_[2 * i - 4], mb_ = i < 2 ? m0_[2 * i + 1] : m1_[2 * i - 3];
                const float v0_ = c0_ + ma_ * (p0_ - c0_), v1_ = c1_ + mb_ * (p1_ - c1_);
                const float r0_ = frcp(1.f + __expf(sc_ * v0_)), r1_ = frcp(1.f + __expf(sc_ * v1_));
                o_[2 * i] = xch < 8 ? 1.f - 2.f * r0_ : (xch < 16 ? v0_ : r0_); o_[2 * i + 1] = xch < 8 ? 1.f - 2.f * r1_ : (xch < 16 ? v1_ : r1_); }
            *(u32x4*)(XS + (xt + 16 * qq) * 264 + 8 * xch) = (u32x4){pk2(o_[0], o_[1]), pk2(o_[2], o_[3]), pk2(o_[4], o_[5]), pk2(o_[6], o_[7])}; }
    }
    u32x4 RK[7];
#define RKV_LOAD(rowb, tb) do { _Pragma("unroll") for (int i = 0; i < 7; ++i) { const int id_ = i * 64 + lane, mat_ = id_ / 136, rem_ = id_ - 136 * mat_, rw_ = rem_ >> 3, ch_ = rem_ & 7; \
        RK[i] = (u32x4){0u, 0u, 0u, 0u}; if (id_ < 408 && (tb) - 1 + rw_ >= 0) RK[i] = *(const u32x4*)(PROJ + (size_t)((rowb) - 1 + rw_) * NPROJ + PC_R + 512 * mat_ + wv * 64 + 8 * ch_); } } while (0)
#define RKV_WRITE() do { _Pragma("unroll") for (int i = 0; i < 7; ++i) { const int id_ = i * 64 + lane, mat_ = id_ / 136, rem_ = id_ - 136 * mat_, rw_ = rem_ >> 3, ch_ = rem_ & 7; \
        if (id_ < 408) { bf16* d_ = RKV + mat_ * 1156 + rw_ * 68 + 8 * ch_; *(u32x2*)d_ = (u32x2){RK[i].x, RK[i].y}; *(u32x2*)(d_ + 4) = (u32x2){RK[i].z, RK[i].w}; } } } while (0)
    RKV_LOAD(row0, t0);
    __syncthreads();
    bf16x8 wf[2][8];
#define LORA_LOADW(dst_, ct_, n__, grp__) do { const int cc_ = wv * 64 + 4 * (n__) + (ct_); \
                _Pragma("unroll") for (int ks = 0; ks < 2; ++ks) { dst_[ks] = *(const bf16x8*)(W2T + cc_ * 64 + 32 * ks + 8 * (grp__)); dst_[2 + ks] = *(const bf16x8*)(A2T + cc_ * 64 + 32 * ks + 8 * (grp__)); } \
                _Pragma("unroll") for (int ks = 0; ks < 4; ++ks) dst_[4 + ks] = *(const bf16x8*)(G2T + cc_ * 128 + 32 * ks + 8 * (grp__)); } while (0)
    LORA_LOADW(wf[0], 0, (lane & 15), (lane >> 4));
#pragma unroll 1
    for (int q = 0; q < 4; ++q) {
        const int rowq = row0 + 16 * q, tq = t0 + 16 * q;
        int lane_ = lane; asm volatile("" : "+v"(lane_));
        const int n_ = lane_ & 15, grp_ = lane_ >> 4;
        const size_t idx = (size_t)(b * 8 + wv) * 128 + (tq >> 4);
        unsigned char* CHp = p.ws + WS_CH + idx * 12288;
        RKV_WRITE();
        if (q < 3) RKV_LOAD(rowq + 16, tq + 16);
        f32x4 dw[4], da[4];
        {   bf16x8 xa[8];
#pragma unroll
            for (int ks = 0; ks < 8; ++ks) xa[ks] = *(const bf16x8*)(XS + (16 * q + n_) * 264 + 32 * ks + 8 * grp_);
            f32x4 dgs[4];
#pragma unroll
            for (int ct = 0; ct < 4; ++ct) {
                if (ct < 3) LORA_LOADW(wf[(ct + 1) & 1], ct + 1, n_, grp_);
                f32x4 dg = {0.f, 0.f, 0.f, 0.f}; dw[ct] = dg; da[ct] = dg;
#pragma unroll
                for (int ks = 0; ks < 2; ++ks) dw[ct] = mfma16(xa[ks], wf[ct & 1][ks], dw[ct]);
#pragma unroll
                for (int ks = 0; ks < 2; ++ks) da[ct] = mfma16(xa[2 + ks], wf[ct & 1][2 + ks], da[ct]);
#pragma unroll
                for (int ks = 0; ks < 4; ++ks) dg = mfma16(xa[4 + ks], wf[ct & 1][4 + ks], dg);
                dgs[ct] = dg; }
#pragma unroll
            for (int rg = 0; rg < 4; ++rg) *(u32x2*)(GB + (size_t)(rowq + 4 * grp_ + rg) * 512 + wv * 64 + 4 * n_) = (u32x2){pk2(dgs[0][rg], dgs[1][rg]), pk2(dgs[2][rg], dgs[3][rg])};
        }
        asm volatile("s_waitcnt lgkmcnt(0)" ::: "memory");
        {   float kkvA[4][4], kkaA[4][4], kprA[4][4], rA[4][4], vA[4][4], wA[4][4], nrm[4], c3s[4];
            const int c0 = wv * 64 + 4 * n_;
            const f32x4 mur4 = *(const f32x4*)(p.mu + c0), muk4 = *(const f32x4*)(p.mu + 512 + c0), muv4 = *(const f32x4*)(p.mu + 1024 + c0), w04 = *(const f32x4*)(p.w0 + c0),
                        a04 = *(const f32x4*)(p.a0 + c0), kk4 = *(const f32x4*)(p.k_k + c0), ka4 = *(const f32x4*)(p.k_a + c0), rk4 = *(const f32x4*)(p.r_k + c0);
            const bf16* RKn = RKV + 4 * n_;
            u32x2 rpv = *(const u32x2*)(RKn + (4 * grp_) * 68), kpv = *(const u32x2*)(RKn + 1156 + (4 * grp_) * 68), vpv = *(const u32x2*)(RKn + 2312 + (4 * grp_) * 68);
#pragma unroll
            for (int rg = 0; rg < 4; ++rg) { const int t = 4 * grp_ + rg;
                const u32x2 rcv = *(const u32x2*)(RKn + (t + 1) * 68), kcv = *(const u32x2*)(RKn + 1156 + (t + 1) * 68), vcv = *(const u32x2*)(RKn + 2312 + (t + 1) * 68);
                nrm[rg] = 0.f; c3s[rg] = 0.f;
#pragma unroll
                for (int ct = 0; ct < 4; ++ct) {
                    const float rp = (ct & 1) ? bfhi(rpv[ct >> 1]) : bflo(rpv[ct >> 1]), rc = (ct & 1) ? bfhi(rcv[ct >> 1]) : bflo(rcv[ct >> 1]);
                    const float kp = (ct & 1) ? bfhi(kpv[ct >> 1]) : bflo(kpv[ct >> 1]), kc = (ct & 1) ? bfhi(kcv[ct >> 1]) : bflo(kcv[ct >> 1]);
                    const float vp = (ct & 1) ? bfhi(vpv[ct >> 1]) : bflo(vpv[ct >> 1]), vc = (ct & 1) ? bfhi(vcv[ct >> 1]) : bflo(vcv[ct >> 1]);
                    const float r = rc + mur4[ct] * (rp - rc), k = kc + muk4[ct] * (kp - kc); vA[ct][rg] = vc + muv4[ct] * (vp - vc); rA[ct][rg] = r;
                    const float u = w04[ct] + dw[ct][rg]; wA[ct][rg] = __expf(-0.6065306597126334f * frcp(1.f + __expf(-u)));
                    const float a = frcp(1.f + __expf(-(a04[ct] + da[ct][rg])));
                    const float kkv = k * kk4[ct], kpr = k * (1.f + (a - 1.f) * ka4[ct]); kkvA[ct][rg] = kkv; kkaA[ct][rg] = kkv * a; kprA[ct][rg] = kpr;
                    nrm[rg] += kkv * kkv; c3s[rg] += r * kpr * rk4[ct]; }
                rpv = rcv; kpv = kcv; vpv = vcv; }
            float inrm[4];
#pragma unroll
            for (int rg = 0; rg < 4; ++rg) { nrm[rg] = dpp_row_sum16(nrm[rg]); c3s[rg] = dpp_row_sum16(c3s[rg]); inrm[rg] = fminf(__builtin_amdgcn_rsqf(nrm[rg]), 1e12f); }
            if (n_ == 0) {
#pragma unroll
                for (int rg = 0; rg < 4; ++rg) C3[(size_t)(rowq + 4 * grp_ + rg) * 8 + wv] = c3s[rg]; }
            float E[4];
#pragma unroll
            for (int ct = 0; ct < 4; ++ct) {
                wA[ct][1] *= wA[ct][0]; wA[ct][2] *= wA[ct][1]; wA[ct][3] *= wA[ct][2];
                const auto sw16 = __builtin_amdgcn_permlane16_swap(__float_as_uint(wA[ct][3]), __float_as_uint(wA[ct][3]), false, false);
                const float e0 = __uint_as_float(sw16[0]), e01 = e0 * __uint_as_float(sw16[1]);
                const auto sw32 = __builtin_amdgcn_permlane32_swap(__float_as_uint(e01), __float_as_uint(e01), false, false);
                const float lo01 = __uint_as_float(sw32[0]);
                E[ct] = grp_ == 0 ? 1.f : (grp_ == 1 ? e0 : (grp_ == 2 ? lo01 : lo01 * e0)); }
#pragma unroll
            for (int rg = 0; rg < 4; ++rg) { const int t = 4 * grp_ + rg;
                float at[4], rt[4];
#pragma unroll
                for (int ct = 0; ct < 4; ++ct) { const float gam = E[ct] * wA[ct][rg], gprev = rg == 0 ? E[ct] : E[ct] * wA[ct][rg - 1], ig = frcp(gam);
                    at[ct] = -kkvA[ct][rg] * inrm[rg] * gprev; rt[ct] = rA[ct][rg] * gam;
                    kkaA[ct][rg] = kkaA[ct][rg] * inrm[rg] * ig; kprA[ct][rg] = kprA[ct][rg] * ig; }
                const int so = t * 64 + ((4 * n_) ^ (((t >> 1) & 7) << 3));
                *(u32x2*)(STG + so) = (u32x2){pk2(at[0], at[1]), pk2(at[2], at[3])}; *(u32x2*)(STG + 1024 + so) = (u32x2){pk2(rt[0], rt[1]), pk2(rt[2], rt[3])};
                *(u32x2*)(STG + 2048 + so) = (u32x2){pk2(kkaA[0][rg], kkaA[1][rg]), pk2(kkaA[2][rg], kkaA[3][rg])};
                *(u32x2*)(STG + 3072 + so) = (u32x2){pk2(kprA[0][rg], kprA[1][rg]), pk2(kprA[2][rg], kprA[3][rg])}; }
#pragma unroll
            for (int ct = 0; ct < 4; ++ct) { const int j = 4 * n_ + ct;
                *(u32x2*)(CHp + 4096 + j * 32 + grp_ * 8) = (u32x2){pk2(kkaA[ct][0], kkaA[ct][1]), pk2(kkaA[ct][2], kkaA[ct][3])};
                *(u32x2*)(CHp + 6144 + j * 32 + grp_ * 8) = (u32x2){pk2(kprA[ct][0], kprA[ct][1]), pk2(kprA[ct][2], kprA[ct][3])};
                *(u32x2*)(CHp + 8192 + j * 32 + grp_ * 8) = (u32x2){pk2(vA[ct][0], vA[ct][1]), pk2(vA[ct][2], vA[ct][3])}; }
            if (grp_ == 3) *(f32x4*)(GAM + idx * 64 + 4 * n_) = (f32x4){E[0] * wA[0][3], E[1] * wA[1][3], E[2] * wA[2][3], E[3] * wA[3][3]};
        }
        asm volatile("s_waitcnt lgkmcnt(0)" ::: "memory");
        if (q < 3) LORA_LOADW(wf[0], 0, n_, grp_);
        {   f32x4 mab = {0.f, 0.f, 0.f, 0.f}, mak = mab, nrb = mab, nrk = mab;
#pragma unroll
            for (int ks = 0; ks < 4; ++ks) { const int o = n_ * 64 + ((16 * ks + 4 * grp_) ^ (((n_ >> 1) & 7) << 3));
                const s16x4 fa = *(const s16x4*)(STG + o), fr = *(const s16x4*)(STG + 1024 + o), fb = *(const s16x4*)(STG + 2048 + o), fk = *(const s16x4*)(STG + 3072 + o);
                mab = mfma16k(fa, fb, mab); mak = mfma16k(fa, fk, mak); nrb = mfma16k(fr, fb, nrb); nrk = mfma16k(fr, fk, nrk); }
            asm volatile("s_waitcnt lgkmcnt(0)" ::: "memory");
            bf16* SM = STG + 2048;
#pragma unroll
            for (int rg = 0; rg < 4; ++rg) { const int t = 4 * grp_ + rg; const bool sl = t > n_, il = t >= n_;
                MAB[t * 16 + n_] = sl ? mab[rg] : 0.f;
                SM[256 + t * 16 + n_] = f2bf(sl ? mak[rg] : 0.f); SM[512 + t * 16 + n_] = f2bf(il ? nrb[rg] : 0.f); SM[768 + t * 16 + n_] = f2bf(il ? nrk[rg] : 0.f); }
            asm volatile("s_waitcnt lgkmcnt(0)" ::: "memory");
            if (lane_ < 16) {
                float Tc[16];
#pragma unroll
                for (int t = 0; t < 16; ++t) { float acc = (t == lane_) ? 1.f : 0.f;
#pragma unroll
                    for (int s2 = 0; s2 < t; ++s2) acc = fmaf(MAB[t * 16 + s2], Tc[s2], acc);
                    Tc[t] = acc; SM[t * 16 + lane_] = f2bf(acc); }
            }
            asm volatile("s_waitcnt lgkmcnt(0)" ::: "memory");
#pragma unroll
            for (int i = 0; i < 4; ++i) { const int id = i * 64 + lane_, rw = id >> 3, c16 = id & 7; *(u32x4*)(CHp + id * 16) = *(const u32x4*)((const unsigned char*)STG + rw * 128 + ((c16 ^ ((rw >> 1) & 7)) << 4)); }
#pragma unroll
            for (int i = 0; i < 2; ++i) { const int id = i * 64 + lane_; *(u32x4*)(CHp + 10240 + id * 16) = *(const u32x4*)((const unsigned char*)SM + id * 16); }
        }
    }
#undef RKV_LOAD
#undef RKV_WRITE
#undef LORA_LOADW
}

__device__ __forceinline__ void stage_w_lds(const bf16* W, unsigned char* lds, int log2_cpr  , int tid) {
    const int cpr = 1 << log2_cpr;
#pragma unroll 4
    for (int i = 0; i < 16; ++i) { const int id = i * 512 + tid, row = id >> log2_cpr, ch = id & (cpr - 1);
        *(u32x4*)(lds + ((size_t)row << (log2_cpr + 4)) + (((ch & ~15) | ((ch ^ row) & 15)) << 4)) = *(const u32x4*)((const unsigned char*)W + (size_t)id * 16); }
}
__device__ __forceinline__ bf16x8 lds_wfrag(const unsigned char* lds, int row, int ch, int log2_cpr) {
    return *(const bf16x8*)(lds + ((size_t)row << (log2_cpr + 4)) + (((ch & ~15) | ((ch ^ row) & 15)) << 4));
}
__device__ __forceinline__ void dsa_prep_kv(const Params& p, const unsigned char* wl, int tile, int lane) {
    const bf16* PROJ = (const bf16*)(p.ws + WS_PROJ); bf16* CKV = (bf16*)(p.ws + WS_CKV); float* INVR = (float*)(p.ws + WS_INVR);
    const int r = lane & 31, hh = lane >> 5; const size_t row = (size_t)tile * 32 + r; const bf16* prow = PROJ + row * NPROJ;
    bf16x8 cf[8];
    {   u32x4 craw[8]; float ssq = 0.f;
#pragma unroll
        for (int s = 0; s < 8; ++s) { craw[s] = *(const u32x4*)(prow + PC_CL + 16 * s + 8 * hh);
#pragma unroll
            for (int w = 0; w < 4; ++w) { const float lo = bflo(craw[s][w]), hi = bfhi(craw[s][w]); ssq += lo * lo + hi * hi; } }
        ssq = xor32_sum(ssq);
        const float rstd = rsqrtf(ssq * (1.f / 128.f) + 1e-6f);
#pragma unroll
        for (int s = 0; s < 8; ++s) { const float* g = p.g_kv + 16 * s + 8 * hh; const f32x4 g0 = *(const f32x4*)g, g1 = *(const f32x4*)(g + 4);
            u32x4 o; o.x = pk2(bflo(craw[s].x) * rstd * g0.x, bfhi(craw[s].x) * rstd * g0.y); o.y = pk2(bflo(craw[s].y) * rstd * g0.z, bfhi(craw[s].y) * rstd * g0.w);
            o.z = pk2(bflo(craw[s].z) * rstd * g1.x, bfhi(craw[s].z) * rstd * g1.y); o.w = pk2(bflo(craw[s].w) * rstd * g1.z, bfhi(craw[s].w) * rstd * g1.w);
            cf[s] = __builtin_bit_cast(bf16x8, o); *(u32x4*)(CKV + row * 128 + 16 * s + 8 * hh) = o; }
    }
    unsigned wb[8];
#pragma unroll
    for (int s = 0; s < 8; ++s) wb[s] = (unsigned)(r * 256 + ((((2 * s + hh) ^ r) & 15) << 4));
#pragma unroll 1
    for (int h = 0; h < 8; ++h) { float ss = 0.f;
#pragma unroll
        for (int dt = 0; dt < 2; ++dt) { f32x16 acc = {}; const unsigned char* wg = wl + (h * 64 + dt * 32) * 256;
#pragma unroll
            for (int s = 0; s < 8; ++s) acc = mfma32(*(const bf16x8*)(wg + wb[s]), cf[s], acc);
#pragma unroll
            for (int i = 0; i < 16; ++i) ss += acc[i] * acc[i]; }
        ss = xor32_sum(ss);
        if (hh == 0) INVR[row * 8 + h] = rsqrtf(ss * (1.f / 64.f) + 1e-6f);
    }
}
__device__ __forceinline__ void dsa_prep_q(const Params& p, const unsigned char* wl, int tile, int lane) {
    const bf16* PROJ = (const bf16*)(p.ws + WS_PROJ); bf16* QABS = (bf16*)(p.ws + WS_REGA);
    const int r = lane & 31, hh = lane >> 5; const size_t row = (size_t)tile * 32 + r; const bf16* prow = PROJ + row * NPROJ;
    unsigned wb[2][4];
#pragma unroll
    for (int hp = 0; hp < 2; ++hp)
#pragma unroll
        for (int s = 0; s < 4; ++s) wb[hp][s] = (unsigned)(r * 1024 + ((((hp * 8 + 2 * s + hh) ^ r) & 15) << 4));
#pragma unroll 2
    for (int h = 0; h < 8; ++h) {
        u32x4 qraw[4]; float ssq = 0.f;
#pragma unroll
        for (int s = 0; s < 4; ++s) { qraw[s] = *(const u32x4*)(prow + PC_Q + h * 64 + 16 * s + 8 * hh);
#pragma unroll
            for (int w = 0; w < 4; ++w) { const float lo = bflo(qraw[s][w]), hi = bfhi(qraw[s][w]); ssq += lo * lo + hi * hi; } }
        ssq = xor32_sum(ssq);
        const float rstd = rsqrtf(ssq * (1.f / 64.f) + 1e-6f);
        bf16x8 qf[4];
#pragma unroll
        for (int s = 0; s < 4; ++s) { const int d0 = 16 * s + 8 * hh; float gg[8];
#pragma unroll
            for (int j = 0; j < 8; ++j) gg[j] = p.g_q[d0 + j] * p.g_k[d0 + j] * rstd;
            u32x4 o; o.x = pk2(bflo(qraw[s].x) * gg[0], bfhi(qraw[s].x) * gg[1]); o.y = pk2(bflo(qraw[s].y) * gg[2], bfhi(qraw[s].y) * gg[3]);
            o.z = pk2(bflo(qraw[s].z) * gg[4], bfhi(qraw[s].z) * gg[5]); o.w = pk2(bflo(qraw[s].w) * gg[6], bfhi(qraw[s].w) * gg[7]);
            qf[s] = __builtin_bit_cast(bf16x8, o); }
#pragma unroll
        for (int lt = 0; lt < 4; ++lt) { f32x16 acc = {}; const unsigned char* wg = wl + lt * 32768 + (h >> 1) * 256;
#pragma unroll
            for (int s = 0; s < 4; ++s) acc = mfma32(*(const bf16x8*)(wg + wb[h & 1][s]), qf[s], acc);
#pragma unroll
            for (int g4 = 0; g4 < 4; ++g4) { u32x2 o; o.x = pk2(acc[4 * g4] * 0.125f, acc[4 * g4 + 1] * 0.125f); o.y = pk2(acc[4 * g4 + 2] * 0.125f, acc[4 * g4 + 3] * 0.125f);
                *(u32x2*)(QABS + row * 1024 + h * 128 + lt * 32 + 8 * g4 + 4 * hh) = o; } }
    }
}

constexpr int SCAN_D = 8, SCAN_R = SCAN_D + 1, SCAN_SLOT = 12288 + 256;
#define SCAN_BAR() do { asm volatile("s_waitcnt lgkmcnt(0)" ::: "memory"); __builtin_amdgcn_s_barrier(); asm volatile("" ::: "memory"); } while (0)
__device__ __forceinline__ void rwkv_scan_chain(const Params& p, unsigned char* lds, int chain, int wv, int lane) {
    const int b = chain >> 3, h = chain & 7;
    const size_t idx0 = (size_t)(b * 8 + h) * 128;
    if (wv >= 4) {
        const int lw = wv - 4;
        const unsigned char* rec0 = p.ws + WS_CH + idx0 * 12288; const unsigned char* gam0 = p.ws + WS_GAM + idx0 * 256;
        unsigned soff[3];
#pragma unroll
        for (int i = 0; i < 3; ++i) { const int c = (i * 4 + lw) * 64 + lane; soff[i] = (unsigned)((c < 256 ? ((c >> 3) * 8 + ((c & 7) ^ ((c >> 4) & 7))) : c) * 16); }
        const unsigned goff = (unsigned)((lane & 15) * 16);
#define SCAN_DMA(k_) do { const unsigned char* r_ = rec0 + (size_t)(k_) * 12288; LAS unsigned char* sl_ = (LAS unsigned char*)lds + ((k_) % SCAN_R) * SCAN_SLOT; \
        _Pragma("unroll") for (int i = 0; i < 3; ++i) __builtin_amdgcn_global_load_lds((const unsigned*)(r_ + soff[i]), (LAS unsigned*)(sl_ + (i * 4 + lw) * 1024), 16, 0, 0); \
        if (lane < 16) __builtin_amdgcn_global_load_lds((const unsigned*)(gam0 + (size_t)(k_) * 256 + goff), (LAS unsigned*)(sl_ + 12288), 16, 0, 0); } while (0)
#pragma unroll
        for (int j = 0; j < SCAN_D; ++j) SCAN_DMA(j);
        for (int k = 0; k < 128; ++k) {
            if (k + SCAN_D <= 128) asm volatile("s_waitcnt vmcnt(%0)" :: "n"(4 * (SCAN_D - 1)) : "memory"); else asm volatile("s_waitcnt vmcnt(0)" ::: "memory");
            __builtin_amdgcn_s_barrier(); asm volatile("" ::: "memory");
            if (k + SCAN_D < 128) SCAN_DMA(k + SCAN_D);
        }
        asm volatile("s_waitcnt vmcnt(0)" ::: "memory");
        __builtin_amdgcn_s_barrier(); asm volatile("" ::: "memory");
#undef SCAN_DMA
    } else {
        const int w = wv, n = lane & 15, grp = lane >> 4;
        bf16* PROJ = (bf16*)(p.ws + WS_PROJ);
        f32x4 S[4];
#pragma unroll
        for (int jt = 0; jt < 4; ++jt) S[jt] = (f32x4){0.f, 0.f, 0.f, 0.f};
        int aoffs[4];
#pragma unroll
        for (int jt = 0; jt < 4; ++jt) aoffs[jt] = n * 128 + ((((2 * jt + (grp >> 1)) ^ ((n >> 1) & 7))) << 4) + 8 * (grp & 1);
        s16x4 at[4], rt[4], bt[4], kt[4], vt, Tm, Mak, Nrb, Nrk; f32x4 gm[4];
#define SCAN_LDF(slot_) do { const unsigned char* CHp = lds + (slot_) * SCAN_SLOT; \
        _Pragma("unroll") for (int jt = 0; jt < 4; ++jt) { at[jt] = *(const s16x4*)(CHp + aoffs[jt]); rt[jt] = *(const s16x4*)(CHp + 2048 + aoffs[jt]); \
            bt[jt] = *(const s16x4*)(CHp + 4096 + (16 * jt + n) * 32 + grp * 8); kt[jt] = *(const s16x4*)(CHp + 6144 + (16 * jt + n) * 32 + grp * 8); \
            gm[jt] = *(const f32x4*)(CHp + 12288 + (16 * jt + 4 * grp) * 4); } \
        vt = *(const s16x4*)(CHp + 8192 + (16 * w + n) * 32 + grp * 8); Tm = *(const s16x4*)(CHp + 10240 + n * 32 + grp * 8); Mak = *(const s16x4*)(CHp + 10752 + n * 32 + grp * 8); \
        Nrb = *(const s16x4*)(CHp + 11264 + n * 32 + grp * 8); Nrk = *(const s16x4*)(CHp + 11776 + n * 32 + grp * 8); } while (0)
        SCAN_BAR();
        SCAN_LDF(0);
        for (int sc = 0; sc < 128; ++sc) {
            s16x4 at_[4], rt_[4], bt_[4], kt_[4]; f32x4 gm_[4];
#pragma unroll
            for (int jt = 0; jt < 4; ++jt) { at_[jt] = at[jt]; rt_[jt] = rt[jt]; bt_[jt] = bt[jt]; kt_[jt] = kt[jt]; gm_[jt] = gm[jt]; }
            const s16x4 vt_ = vt, Tm_ = Tm, Mak_ = Mak, Nrb_ = Nrb, Nrk_ = Nrk;
            SCAN_BAR();
            if (sc + 1 < 128) SCAN_LDF((sc + 1) % SCAN_R);
            s16x4 Sb[4];
#pragma unroll
            for (int jt = 0; jt < 4; ++jt) Sb[jt] = pack4(S[jt]);
            f32x4 X = {0.f, 0.f, 0.f, 0.f}, O = X;
#pragma unroll
            for (int jt = 0; jt < 4; ++jt) X = mfma16k(at_[jt], Sb[jt], X);
            X = mfma16k(Mak_, vt_, X);
#pragma unroll
            for (int jt = 0; jt < 4; ++jt) O = mfma16k(rt_[jt], Sb[jt], O);
            O = mfma16k(Nrk_, vt_, O);
            const f32x4 U = mfma16k(Tm_, pack4(X), (f32x4){0.f, 0.f, 0.f, 0.f});
            const s16x4 Ub = pack4(U);
            O = mfma16k(Nrb_, Ub, O);
#pragma unroll
            for (int jt = 0; jt < 4; ++jt) { S[jt] = mfma16k(kt_[jt], vt_, S[jt]); S[jt] = mfma16k(bt_[jt], Ub, S[jt]); S[jt] = S[jt] * gm_[jt]; }
            bf16* orow = PROJ + ((size_t)b * SEQ + sc * 16 + 4 * grp) * NPROJ + PC_R + h * 64 + 16 * w + n;
#pragma unroll
            for (int rg = 0; rg < 4; ++rg) orow[(size_t)rg * NPROJ] = f2bf(O[rg]);
        }
#undef SCAN_LDF
    }
}
__device__ __forceinline__ void rwkv_epi_rows(const Params& p, int gw, int NGW, int lane) {
    bf16* PROJ = (bf16*)(p.ws + WS_PROJ); const bf16* GB = (const bf16*)(p.ws + WS_G); const float* C3 = (const float*)(p.ws + WS_C3);
    const int c0 = lane * 8, h = lane >> 3, RPW = M / NGW;
    float muv[8], lw[8], lb[8];
#pragma unroll
    for (int i = 0; i < 8; ++i) { muv[i] = p.mu[1024 + c0 + i]; lw[i] = p.ln_w[c0 + i]; lb[i] = p.ln_b[c0 + i]; }
    for (int m0 = gw * RPW; m0 < M; m0 += NGW * RPW) {
        u32x4 vprev = {0u, 0u, 0u, 0u}; if ((m0 & (SEQ - 1)) != 0) vprev = *(const u32x4*)(PROJ + (size_t)(m0 - 1) * NPROJ + PC_V + c0);
        for (int r0 = 0; r0 < RPW; r0 += 4) {
            u32x4 oraw[4], vc[4], gr[4]; float c3[4];
#pragma unroll
            for (int r = 0; r < 4; ++r) { const size_t m = (size_t)(m0 + r0 + r); const bf16* prow = PROJ + m * NPROJ;
                oraw[r] = *(const u32x4*)(prow + PC_R + c0); vc[r] = *(const u32x4*)(prow + PC_V + c0); gr[r] = *(const u32x4*)(GB + m * 512 + c0); c3[r] = C3[m * 8 + h]; }
            float o[4][8], sm[4], q[4];
#pragma unroll
            for (int r = 0; r < 4; ++r) { sm[r] = 0.f;
#pragma unroll
                for (int i = 0; i < 4; ++i) { o[r][2 * i] = bflo(oraw[r][i]); o[r][2 * i + 1] = bfhi(oraw[r][i]); sm[r] += o[r][2 * i] + o[r][2 * i + 1]; } }
#pragma unroll
            for (int r = 0; r < 4; ++r) sm[r] = dpp_sum8(sm[r]);
#pragma unroll
            for (int r = 0; r < 4; ++r) { const float mean = sm[r] * (1.f / 64.f); q[r] = 0.f;
#pragma unroll
                for (int i = 0; i < 8; ++i) { o[r][i] -= mean; q[r] += o[r][i] * o[r][i]; } }
#pragma unroll
            for (int r = 0; r < 4; ++r) q[r] = dpp_sum8(q[r]);
#pragma unroll
            for (int r = 0; r < 4; ++r) { const float rstd = rsqrtf(q[r] * (1.f / 64.f) + 64e-5f); const u32x4 vp = r == 0 ? vprev : vc[r - 1];
                const bool first = ((m0 + r0 + r) & (SEQ - 1)) == 0;
                u32x4 out; float y8[8];
#pragma unroll
                for (int i = 0; i < 4; ++i) { float y[2];
#pragma unroll
                    for (int e = 0; e < 2; ++e) { const int ii = 2 * i + e; const float cv = e ? bfhi(vc[r][i]) : bflo(vc[r][i]), pv = first ? 0.f : (e ? bfhi(vp[i]) : bflo(vp[i]));
                        const float v = cv + muv[ii] * (pv - cv), g = e ? bfhi(gr[r][i]) : bflo(gr[r][i]);
                        y[e] = (o[r][ii] * rstd * lw[ii] + lb[ii] + c3[r] * v) * g; }
                    out[i] = pk2(y[0], y[1]);
#if MK_F8_GOUT
                    y8[2 * i] = y[0] * 8.f; y8[2 * i + 1] = y[1] * 8.f;
#endif
                }
#if MK_F8_GOUT
                *(u32x2*)((unsigned char*)(PROJ + (size_t)(m0 + r0 + r) * NPROJ) + 512 + c0) = (u32x2){pg8::pk4_fp8(y8[0], y8[1], y8[2], y8[3]), pg8::pk4_fp8(y8[4], y8[5], y8[6], y8[7])};
#else
                *(u32x4*)(PROJ + (size_t)(m0 + r0 + r) * NPROJ + PC_R + c0) = out;
#endif
            }
            vprev = vc[3];
        }
    }
}

__device__ __forceinline__ unsigned f2key(float f) { unsigned b = __float_as_uint(f); if ((b << 1) == 0u) b = 0u; return (b & 0x80000000u) ? ~b : (b | 0x80000000u); }
__device__ __forceinline__ unsigned offb(unsigned row, unsigned ch) { return 2048u * (row >> 3) + 512u * (ch >> 2) + 64u * (row & 7) + 16u * ((ch & 3) ^ ((row >> 2) & 3)); }

__device__ __forceinline__ void topk_select(float* sc, int N, unsigned* hist, unsigned short* sel, int lane) {
    unsigned* kb = (unsigned*)sc;
    unsigned prefix = 0u, mask = 0u; int rem = 256, mbin = 0;
    const unsigned long long lt_mask = (1ull << lane) - 1ull;
    for (int pass = 0; pass < 4; ++pass) {
        const int shift = 24 - 8 * pass;
#pragma unroll
        for (int i = 0; i < 4; ++i) hist[lane * 4 + i] = 0u;
        asm volatile("s_waitcnt lgkmcnt(0)" ::: "memory");
        for (int base = 0; base < N; base += 256) { const int idx = base + 4 * lane;
            if (idx < N) { u32x4 k4;
                if (pass == 0) { const f32x4 v = *(const f32x4*)(sc + idx); k4 = (u32x4){f2key(v.x), f2key(v.y), f2key(v.z), f2key(v.w)}; *(u32x4*)(kb + idx) = k4; }
                else k4 = *(const u32x4*)(kb + idx);
#pragma unroll
                for (int e = 0; e < 4; ++e) if ((k4[e] & mask) == prefix) atomicAdd(&hist[(k4[e] >> shift) & 255u], 1u); } }
        asm volatile("s_waitcnt lgkmcnt(0)" ::: "memory");
        const unsigned c0 = hist[lane * 4], c1 = hist[lane * 4 + 1], c2 = hist[lane * 4 + 2], c3 = hist[lane * 4 + 3];
        const int cnt4 = (int)(c0 + c1 + c2 + c3);
        int incl = cnt4;
#pragma unroll
        for (int o = 1; o < 64; o <<= 1) { const int v = __shfl_down(incl, o); if (lane + o < 64) incl += v; }
        const int excl = incl - cnt4;
        const bool mine = (excl < rem) && (rem <= incl);
        const unsigned long long bal = __ballot(mine);
        const int L = (int)__builtin_ctzll(bal);
        const int ex = __shfl(excl, L); const int b3 = (int)__shfl((int)c3, L), b2 = (int)__shfl((int)c2, L), b1 = (int)__shfl((int)c1, L), b0 = (int)__shfl((int)c0, L);
        int above = ex, bin;
        if (above + b3 >= rem) { bin = 3; mbin = b3; } else { above += b3; if (above + b2 >= rem) { bin = 2; mbin = b2; } else { above += b2; if (above + b1 >= rem) { bin = 1; mbin = b1; } else { above += b1; bin = 0; mbin = b0; } } }
        rem -= above; prefix |= (unsigned)(L * 4 + bin) << shift; mask |= 0xffu << shift;
        if (pass == 1 && mbin <= 64) break;
    }
    const unsigned T = prefix; const int ngt = 256 - rem; int base_gt = 0, base_eq = 0;
    const bool partial = (mask != 0xffffffffu);
    unsigned short* cand = (unsigned short*)hist;
    for (int base = 0; base < N; base += 256) { const int idx = base + 4 * lane; const bool act = idx < N;
        u32x4 k4 = {0u, 0u, 0u, 0u}; if (act) k4 = *(const u32x4*)(kb + idx);
        bool gt[4], eq[4]; unsigned long long bg[4], be[4];
#pragma unroll
        for (int e = 0; e < 4; ++e) { const unsigned km = k4[e] & mask; gt[e] = act && km > T; eq[e] = act && km == T; bg[e] = __ballot(gt[e]); be[e] = __ballot(eq[e]); }
        int rg = base_gt, re = base_eq;
#pragma unroll
        for (int e = 0; e < 4; ++e) re += __popcll(be[e] & lt_mask);
#pragma unroll
        for (int e = 0; e < 4; ++e) {
            if (gt[e]) sel[rg + __popcll(bg[e] & lt_mask)] = (unsigned short)(idx + e);
            rg += __popcll(bg[e]);
            if (eq[e]) { if (partial) cand[re] = (unsigned short)(idx + e); else if (re < rem) sel[ngt + re] = (unsigned short)(idx + e); re += 1; } }
        base_gt = rg;
#pragma unroll
        for (int e = 0; e < 4; ++e) base_eq += __popcll(be[e]); }
    asm volatile("s_waitcnt lgkmcnt(0)" ::: "memory");
    if (partial) {
        const int m = mbin; const int ci = (lane < m) ? (int)cand[lane] : 0; const unsigned ck = (lane < m) ? kb[ci] : 0u;
        int rank = 0;
        for (int j = 0; j < m; ++j) { const unsigned kj = (unsigned)__builtin_amdgcn_readlane((int)ck, j);     rank += (kj > ck || (kj == ck && j < lane)) ? 1 : 0; }
        if (lane < m && rank < rem) sel[ngt + rank] = (unsigned short)ci;
        asm volatile("s_waitcnt lgkmcnt(0)" ::: "memory");
    }
}

__device__ __forceinline__ int wave_incl_scan(int v) {
    v += __builtin_amdgcn_update_dpp(0, v, 0x111, 0xF, 0xF, false);
    v += __builtin_amdgcn_update_dpp(0, v, 0x112, 0xF, 0xF, false);
    v += __builtin_amdgcn_update_dpp(0, v, 0x114, 0xF, 0xF, false);
    v += __builtin_amdgcn_update_dpp(0, v, 0x118, 0xF, 0xF, false);
    v += __builtin_amdgcn_update_dpp(0, v, 0x142, 0xA, 0xF, false);
    v += __builtin_amdgcn_update_dpp(0, v, 0x143, 0xC, 0xF, false);
    return v;
}
__device__ __forceinline__ bool topk_select_fast(const float* sc, int N, float smax, unsigned* hist, unsigned short* sel, int lane) {
    const float scale = smax > 0.f ? 127.5f / smax : 0.f;
#define QBIN(x_) ((int)fmaf((x_), scale, 128.f))
#pragma unroll
    for (int i = 0; i < 4; ++i) hist[lane * 4 + i] = 0u;
    asm volatile("s_waitcnt lgkmcnt(0)" ::: "memory");
    for (int base = 0; base < N; base += 256) { const int idx = base + 4 * lane;
        if (idx < N) { const f32x4 v = *(const f32x4*)(sc + idx);
#pragma unroll
            for (int e = 0; e < 4; ++e) atomicAdd(&hist[QBIN(v[e])], 1u); } }
    asm volatile("s_waitcnt lgkmcnt(0)" ::: "memory");
    const unsigned c0 = hist[lane * 4], c1 = hist[lane * 4 + 1], c2 = hist[lane * 4 + 2], c3 = hist[lane * 4 + 3];
    const int cnt4 = (int)(c0 + c1 + c2 + c3);
    const int pin = wave_incl_scan(cnt4), tot = __builtin_amdgcn_readlane(pin, 63);
    const int incl = tot - pin + cnt4;
    const int excl = incl - cnt4;
    const bool mine = (excl < 256) && (256 <= incl);
    const int L = (int)__builtin_ctzll(__ballot(mine));
    const int ex = __builtin_amdgcn_readlane(excl, L); const int b3 = __builtin_amdgcn_readlane((int)c3, L), b2 = __builtin_amdgcn_readlane((int)c2, L), b1 = __builtin_amdgcn_readlane((int)c1, L), b0 = __builtin_amdgcn_readlane((int)c0, L);
    int above = ex, bin, mbin;
    if (above + b3 >= 256) { bin = 3; mbin = b3; } else { above += b3; if (above + b2 >= 256) { bin = 2; mbin = b2; } else { above += b2; if (above + b1 >= 256) { bin = 1; mbin = b1; } else { above += b1; bin = 0; mbin = b0; } } }
    if (mbin > 64) return false;
    const int tb = L * 4 + bin, rem = 256 - above, ngt = above;
    unsigned short* cand = (unsigned short*)hist;
    int cg = 0, ce = 0;
    for (int base = 0; base < N; base += 256) { const int idx = base + 4 * lane;
        if (idx < N) { const f32x4 v = *(const f32x4*)(sc + idx);
#pragma unroll
            for (int e = 0; e < 4; ++e) { const int qb = QBIN(v[e]); cg += (qb > tb) ? 1 : 0; ce += (qb == tb) ? 1 : 0; } } }
    int pg = wave_incl_scan(cg) - cg, pe = wave_incl_scan(ce) - ce;
    unsigned short* const dump = cand + 128 + 2 * lane;
    for (int base = 0; base < N; base += 256) { const int idx = base + 4 * lane;
        if (idx < N) { const f32x4 v = *(const f32x4*)(sc + idx);
#pragma unroll
            for (int e = 0; e < 4; ++e) { const int qb = QBIN(v[e]); const bool gt = qb > tb, eq = qb == tb;
                *(gt ? sel + pg : dump) = (unsigned short)(idx + e); pg += gt ? 1 : 0;
                *(eq ? cand + pe : dump) = (unsigned short)(idx + e); pe += eq ? 1 : 0; } } }
    asm volatile("s_waitcnt lgkmcnt(0)" ::: "memory");
    {   const int m = mbin; const int ci = (lane < m) ? (int)cand[lane] : 0; const unsigned ck = (lane < m) ? f2key(sc[ci]) : 0u;
        int rank = 0;
        for (int j = 0; j < m; ++j) { const unsigned kj = (unsigned)__builtin_amdgcn_readlane((int)ck, j);     rank += (kj > ck || (kj == ck && j < lane)) ? 1 : 0; }
        if (lane < m && rank < rem) sel[ngt + rank] = (unsigned short)ci;
        asm volatile("s_waitcnt lgkmcnt(0)" ::: "memory"); }
#undef QBIN
    return true;
}

__device__ __forceinline__ void dsa_attend(const Params& p, int b, int t, const unsigned short* sel, int cnt, unsigned char* stage, int lane_in, const u32x4 (&bqv)[4]) {
    int lane = lane_in; asm volatile("" : "+v"(lane));
    const bf16* CKV = (const bf16*)(p.ws + WS_CKV) + (size_t)b * SEQ * 128; const float* INVR = (const float*)(p.ws + WS_INVR) + (size_t)b * SEQ * 8;
    bf16* QO = (bf16*)(p.ws + WS_REGA) + ((size_t)b * SEQ + t) * 1024;
    const int hd = lane & 15, grp = lane >> 4;
    bf16x8 bq[4];
#pragma unroll
    for (int s = 0; s < 4; ++s) bq[s] = __builtin_bit_cast(bf16x8, bqv[s]);
    const float slope = (hd < 8) ? exp2f(-(float)(hd + 1)) : 0.f;
    const int hsafe = hd & 7;
    float m_run = -INFINITY, l_part = 0.f;
    f32x4 O[8];
#pragma unroll
    for (int c = 0; c < 8; ++c) O[c] = (f32x4){0.f, 0.f, 0.f, 0.f};
    const LAS unsigned char* st3 = (const LAS unsigned char*)stage;
    const unsigned q4 = (lane & 15) >> 2, p4 = lane & 3;
    u32x4 G[8]; float IRn[8], PNn[8];
#define DA_ISSUE(ks_) do { \
    _Pragma("unroll") for (int i = 0; i < 8; ++i) { const int id = i * 64 + lane, row = id >> 4, ch = id & 15; const unsigned key = sel[(ks_) + row]; G[i] = *(const u32x4*)((const unsigned char*)CKV + (key * 256u + (unsigned)ch * 16u)); } } while (0)
#define DA_ISSUE2(ks_) do { \
    _Pragma("unroll") for (int i = 0; i < 8; ++i) { const int key = sel[(ks_) + 16 * (i >> 2) + 4 * grp + (i & 3)]; IRn[i] = *(const float*)((const unsigned char*)INVR + ((unsigned)key * 32u + (unsigned)hsafe * 4u)); PNn[i] = slope * fabsf((float)(t - key)); } } while (0)
    DA_ISSUE(cnt - 32); DA_ISSUE2(cnt - 32);
    for (int ks = cnt - 32; ks >= 0; ks -= 32) {
#pragma unroll
        for (int i = 0; i < 8; ++i) { const int id = i * 64 + lane, row = id >> 4, ch = id & 15; *(u32x4*)(stage + offb(row, ch)) = G[i]; }
        asm volatile("s_waitcnt lgkmcnt(0)" ::: "memory");
        if (ks >= 32) DA_ISSUE(ks - 32);
        float lg[8];
#pragma unroll
        for (int T = 0; T < 2; ++T) { f32x4 acc = {0.f, 0.f, 0.f, 0.f};
#pragma unroll
            for (int s = 0; s < 4; ++s) { const bf16x8 a = *(const bf16x8*)(stage + offb((lane & 15) + 16 * T, 4 * s + grp)); acc = mfma16(a, bq[s], acc); }
#pragma unroll
            for (int rg = 0; rg < 4; ++rg) lg[4 * T + rg] = acc[rg] * IRn[4 * T + rg] - PNn[4 * T + rg]; }
        if (ks >= 32) DA_ISSUE2(ks - 32);
        float mx = lg[0];
#pragma unroll
        for (int i = 1; i < 8; ++i) mx = fmaxf(mx, lg[i]);
        mx = xor32_max(xor16_max(mx));
        const float m_new = fmaxf(m_run, mx);
        const float alpha = __expf(m_run - m_new);
        float ps = 0.f;
#pragma unroll
        for (int i = 0; i < 8; ++i) { lg[i] = __expf(lg[i] - m_new); ps += lg[i]; }
        l_part = l_part * alpha + ps; m_run = m_new;
#pragma unroll
        for (int c = 0; c < 8; ++c) O[c] = O[c] * alpha;
        {   u32x4 pw; pw.x = pk2(lg[0], lg[1]); pw.y = pk2(lg[2], lg[3]); pw.z = pk2(lg[4], lg[5]); pw.w = pk2(lg[6], lg[7]);
            const bf16x8 pa = __builtin_bit_cast(bf16x8, pw);
#pragma unroll
            for (int c = 0; c < 8; ++c) {
                const s16x4 lo = __builtin_bit_cast(s16x4, __builtin_amdgcn_ds_read_tr16_b64_v4i16((LAS s16x4*)(st3 + offb(4 * grp + q4, 2 * c + (p4 >> 1)) + 8 * (p4 & 1))));
                const s16x4 hi = __builtin_bit_cast(s16x4, __builtin_amdgcn_ds_read_tr16_b64_v4i16((LAS s16x4*)(st3 + offb(16 + 4 * grp + q4, 2 * c + (p4 >> 1)) + 8 * (p4 & 1))));
                const bf16x8 vb = {lo[0], lo[1], lo[2], lo[3], hi[0], hi[1], hi[2], hi[3]};
                O[c] = mfma16(vb, pa, O[c]); } }
        asm volatile("s_waitcnt lgkmcnt(0)" ::: "memory");
    }
#undef DA_ISSUE
#undef DA_ISSUE2
    float l = xor32_sum(xor16_sum(l_part));
    const float il = 1.f / l;
    if (hd < 8) {
#pragma unroll
        for (int c = 0; c < 8; ++c) *(u32x2*)(QO + hd * 128 + 16 * c + 4 * grp) = (u32x2){pk2(O[c][0] * il, O[c][1] * il), pk2(O[c][2] * il, O[c][3] * il)};
    }
}

#define DSA_LOAD_AF(af_, wqv_, b_, tq0_) do { const size_t rq_ = (size_t)(b_) * SEQ + (tq0_); const int r_ = lane & 31, g_ = lane >> 5, ql_ = 2 * ((r_ >> 2) & 1) + (r_ >> 4), hdm_ = 4 * ((r_ >> 3) & 1) + (r_ & 3); \
    _Pragma("unroll") for (int qg = 0; qg < 4; ++qg) _Pragma("unroll") for (int s = 0; s < 4; ++s) af_[qg][s] = *(const bf16x8*)(PROJ + (rq_ + 4 * qg + ql_) * NPROJ + PC_QI + hdm_ * 64 + 16 * s + 8 * g_); \
    wqv_ = (tid < 128) ? bf2f(PROJ[(rq_ + (tid >> 3)) * NPROJ + PC_WI + (tid & 7)]) * 0.044194173824159216f : 0.f; } while (0)
typedef float f32x2 __attribute__((ext_vector_type(2)));
__device__ __forceinline__ float relu_bits(float x) { return __int_as_float(max(__float_as_int(x), 0)); }
__device__ __forceinline__ void dsa_select_item(const Params& p, unsigned char* lds, int b, int tq0, int tid, bf16x8 (&af)[4][4], float& wqv, bool has_next, int nb, int ntq0) {
    bf16* PROJ = (bf16*)(p.ws + WS_PROJ);
    float* SC = (float*)lds;
    unsigned* HIST = (unsigned*)(lds + 131072);
    unsigned short* SEL = (unsigned short*)(lds + 131072 + 8192);
    float* WQ = (float*)(lds + 147456);
    unsigned* QMAX = (unsigned*)(lds + 147456 + 512);
    asm volatile("" : "+v"(tid));
    const int lane = tid & 63, wv = __builtin_amdgcn_readfirstlane(tid >> 6);
    const int N = ((tq0 >> 6) + 1) * 64; const size_t rowq0 = (size_t)b * SEQ + tq0;
    {
        const int r = lane & 31, g = lane >> 5;
        if (tid < 128) WQ[tid] = wqv;
        if (tid < 16) QMAX[tid] = 0u;
        float mxq[4][2];
#pragma unroll
        for (int qg = 0; qg < 4; ++qg) { mxq[qg][0] = 0.f; mxq[qg][1] = 0.f; }
        __syncthreads();
        f32x4 wqa[4][2], wqb[4][2];
#pragma unroll
        for (int qg = 0; qg < 4; ++qg)
#pragma unroll
            for (int qq = 0; qq < 2; ++qq) { wqa[qg][qq] = *(const f32x4*)(WQ + (4 * qg + 2 * g + qq) * 8); wqb[qg][qq] = *(const f32x4*)(WQ + (4 * qg + 2 * g + qq) * 8 + 4); }
#define SEL_LOADK(dst_, kt_) do { const bf16* krow_ = PROJ + ((size_t)b * SEQ + (kt_) * 32 + r) * NPROJ + PC_KI + 8 * g; \
            _Pragma("unroll") for (int s = 0; s < 4; ++s) dst_[s] = *(const bf16x8*)(krow_ + 16 * s); } while (0)
#define SEL_MMA(dst_, bf_, qg_) do { dst_ = (f32x16){}; _Pragma("unroll") for (int s = 0; s < 4; ++s) dst_ = mfma32(af[qg_][s], bf_[s], dst_); } while (0)
#define SEL_TILE(bf_, kt_) do { const int key = (kt_) * 32 + r; f32x16 accn; SEL_MMA(accn, bf_, 0); \
            _Pragma("unroll") for (int qg = 0; qg < 4; ++qg) { const f32x16 acc = accn; if (qg < 3) SEL_MMA(accn, bf_, qg + 1);     \
                _Pragma("unroll") for (int qq = 0; qq < 2; ++qq) { f32x2 s2 = {0.f, 0.f};        \
                    _Pragma("unroll") for (int e = 0; e < 4; e += 2) { \
                        s2 = __builtin_elementwise_fma((f32x2){wqa[qg][qq][e], wqa[qg][qq][e + 1]}, (f32x2){relu_bits(acc[8 * qq + e]), relu_bits(acc[8 * qq + e + 1])}, s2); \
                        s2 = __builtin_elementwise_fma((f32x2){wqb[qg][qq][e], wqb[qg][qq][e + 1]}, (f32x2){relu_bits(acc[8 * qq + 4 + e]), relu_bits(acc[8 * qq + 4 + e + 1])}, s2); } \
                    const float sc = s2.x + s2.y; \
                    SC[(4 * qg + 2 * g + qq) * 2048 + key] = sc; mxq[qg][qq] = fmaxf(mxq[qg][qq], fabsf(sc)); } } } while (0)
        const int nkt = N / 32;
        bf16x8 bfa[4], bfb[4];
        SEL_LOADK(bfa, wv);
        for (int kt = wv; kt < nkt; kt += 2 * NWAVES) {
            const bool hb = kt + NWAVES < nkt;
            if (hb) SEL_LOADK(bfb, kt + NWAVES);
            SEL_TILE(bfa, kt);
            if (hb) { if (kt + 2 * NWAVES < nkt) SEL_LOADK(bfa, kt + 2 * NWAVES);
                SEL_TILE(bfb, kt + NWAVES); }
        }
#undef SEL_LOADK
#undef SEL_TILE
#undef SEL_MMA
#pragma unroll
        for (int qg = 0; qg < 4; ++qg)
#pragma unroll
            for (int qq = 0; qq < 2; ++qq) { float m = xor16_max(dpp_row_max16(mxq[qg][qq]));
                if (r == 0) atomicMax(&QMAX[4 * qg + 2 * g + qq], __float_as_uint(m)); }
        __syncthreads();
        if (has_next) DSA_LOAD_AF(af, wqv, nb, ntq0);
        bool fb[2];
        for (int q = 0; q < 2; ++q) fb[q] = !topk_select_fast(SC + (2 * wv + q) * 2048, N, __uint_as_float(QMAX[2 * wv + q]), HIST + wv * 256, SEL + (2 * wv + q) * 256, lane);
        for (int q = 0; q < 2; ++q) if (fb[q]) topk_select(SC + (2 * wv + q) * 2048, N, HIST + wv * 256, SEL + (2 * wv + q) * 256, lane);
    }
    asm volatile("s_waitcnt lgkmcnt(0)" ::: "memory");
    { const int q = lane >> 5; const u32x4 v = *(const u32x4*)(SEL + (2 * wv + q) * 256 + (lane & 31) * 8);
      *(u32x4*)(PROJ + (rowq0 + 2 * wv + q) * NPROJ + PC_Q + (lane & 31) * 8) = v; }
    __syncthreads();
}

__device__ __forceinline__ void dsa_attend_rows(const Params& p, unsigned char* wlds, int row0, int rstride, int rend, int lane) {
    const bf16* PROJ = (const bf16*)(p.ws + WS_PROJ); const bf16* QA = (const bf16*)(p.ws + WS_REGA);
    unsigned short* SELW = (unsigned short*)(wlds + 8192);
    const int hd = lane & 15, grp = lane >> 4;
    u32x4 selv = {0u, 0u, 0u, 0u}, bqv[4];
#define ATT_PREFETCH(row_) do { const int t_ = (row_) & (SEQ - 1); \
        if (t_ >= 256 && lane < 32) selv = *(const u32x4*)(PROJ + (size_t)(row_) * NPROJ + PC_Q + lane * 8); \
        _Pragma("unroll") for (int s = 0; s < 4; ++s) { bqv[s] = (u32x4){0u, 0u, 0u, 0u}; if (hd < 8) bqv[s] = *(const u32x4*)(QA + (size_t)(row_) * 1024 + hd * 128 + 32 * s + 8 * grp); } } while (0)
    if (row0 < rend) ATT_PREFETCH(row0);
    for (int row = row0; row < rend; row += rstride) {
        const int b = row >> 11, t = row & (SEQ - 1), N = ((t >> 6) + 1) * 64, cnt = N > 256 ? 256 : N;
        if (N > 256) { if (lane < 32) *(u32x4*)(SELW + lane * 8) = selv; }
        else { for (int i = lane; i < cnt; i += 64) SELW[i] = (unsigned short)i; }
        u32x4 bqc[4];
#pragma unroll
        for (int s = 0; s < 4; ++s) bqc[s] = bqv[s];
        asm volatile("s_waitcnt lgkmcnt(0)" ::: "memory");
        if (row + rstride < rend) ATT_PREFETCH(row + rstride);
        dsa_attend(p, b, t, SELW, cnt, wlds, lane, bqc);
        asm volatile("s_waitcnt lgkmcnt(0)" ::: "memory");
    }
#undef ATT_PREFETCH
}

__device__ __forceinline__ void uv_item(const Params& p, const unsigned char* wl  , int tile, int lane) {
    bf16* PROJ = (bf16*)(p.ws + WS_PROJ); const bf16* OLAT = (const bf16*)(p.ws + WS_REGA);
    const int r = lane & 31, hh = lane >> 5; const size_t row = (size_t)tile * 32 + r;
    unsigned wb[8];
#pragma unroll
    for (int s = 0; s < 8; ++s) wb[s] = (unsigned)(r * 256 + ((((2 * s + hh) ^ r) & 15) << 4));
#pragma unroll 1
    for (int h = 0; h < 8; ++h) { bf16x8 of[8];
#pragma unroll
        for (int s = 0; s < 8; ++s) of[s] = *(const bf16x8*)(OLAT + row * 1024 + h * 128 + 16 * s + 8 * hh);
#pragma unroll
        for (int dt = 0; dt < 2; ++dt) { f32x16 acc = {}; const unsigned char* wg = wl + (h * 64 + dt * 32) * 256;
#pragma unroll
            for (int s = 0; s < 8; ++s) acc = mfma32(*(const bf16x8*)(wg + wb[s]), of[s], acc);
#pragma unroll
            for (int g4 = 0; g4 < 4; ++g4) {
#if MK_F8_GOUT
                *(unsigned*)((unsigned char*)(PROJ + row * NPROJ) + h * 64 + dt * 32 + 8 * g4 + 4 * hh) = pg8::pk4_fp8(acc[4 * g4] * 8.f, acc[4 * g4 + 1] * 8.f, acc[4 * g4 + 2] * 8.f, acc[4 * g4 + 3] * 8.f);
#else
                u32x2 o; o.x = pk2(acc[4 * g4], acc[4 * g4 + 1]); o.y = pk2(acc[4 * g4 + 2], acc[4 * g4 + 3]);
                *(u32x2*)(PROJ + row * NPROJ + PC_Q + h * 64 + dt * 32 + 8 * g4 + 4 * hh) = o;
#endif
            } }
    }
}

__device__ __forceinline__ void bias2_item(const Params& p, int item, int lane) {
    const bf16* W1T = (const bf16*)(p.ws + WS_W1); const float* MOD = (const float*)(p.ws + WS_MOD); float* BIAS2 = (float*)(p.ws + WS_BIAS2);
    const int r = lane & 31, hh = lane >> 5, f0 = item * 32;
    const bf16* wrow = W1T + (size_t)(f0 + r) * DM + 8 * hh; const float* srow = MOD + (size_t)r * 6144 + 3072 + 8 * hh;
    f32x16 acc = {};
#pragma unroll 8
    for (int s = 0; s < 64; ++s) { const bf16x8 a = *(const bf16x8*)(wrow + 16 * s); const f32x4 s0 = *(const f32x4*)(srow + 16 * s), s1 = *(const f32x4*)(srow + 16 * s + 4);
        const u32x4 bw = {pk2(s0.x, s0.y), pk2(s0.z, s0.w), pk2(s1.x, s1.y), pk2(s1.z, s1.w)};
        acc = mfma32(a, __builtin_bit_cast(bf16x8, bw), acc); }
#pragma unroll
    for (int i = 0; i < 16; ++i) BIAS2[(size_t)r * 4096 + f0 + (i & 3) + 8 * (i >> 2) + 4 * hh] = acc[i];
}

typedef __attribute__((address_space(1))) unsigned gu32;
#define RLX_AGENT __ATOMIC_RELAXED, __HIP_MEMORY_SCOPE_AGENT
#define XB_TMO      128
#define XB_XCNT(j)  (256  + 64 * (j))
#define XB_XSUB(j)  (1280 + 64 * (j))
#define XB_XGEN(j)  (2304 + 64 * (j))
#define XB_TOP      3328
#define XB_TOPGEN   3392
#define XCD_BAR_WORDS 3456
#define XB_SPIN_CAP (1u << 18)

__device__ __forceinline__ unsigned xb_ld(unsigned* p)              { return __hip_atomic_load(p, __ATOMIC_RELAXED, __HIP_MEMORY_SCOPE_AGENT); }
__device__ __forceinline__ unsigned xb_add(unsigned* p, unsigned v) { return __hip_atomic_fetch_add(p, v, __ATOMIC_RELAXED, __HIP_MEMORY_SCOPE_AGENT); }
__device__ __forceinline__ unsigned xb_xcc_id() { return (unsigned)__builtin_amdgcn_s_getreg((3 << 11) | 20) & 0xFu; }
#define XB_SPIN(cond, bar) do { unsigned _sp = 0; while (cond) { __builtin_amdgcn_s_sleep(1); \
    if ((++_sp & 255u) == 0u) { if (xb_ld(&(bar)[XB_TMO])) break; if (_sp > XB_SPIN_CAP) { atomicAdd(&(bar)[XB_TMO], 1u); break; } } } } while (0)

struct XcdBarrier {
    unsigned* bar; unsigned x;
    volatile LAS unsigned* st;
};

__device__ __forceinline__ XcdBarrier xcd_barrier_post(unsigned* bar, volatile LAS unsigned* st) {
    XcdBarrier b; b.bar = bar; b.x = xb_xcc_id(); b.st = st;
    if (threadIdx.x == 0) (void)xb_add(&bar[XB_XCNT(b.x)], 1u);
    return b;
}
__device__ __forceinline__ void xcd_barrier_complete(unsigned* bar, unsigned x, unsigned& nloc, unsigned& nx) {
    const unsigned G = gridDim.x * gridDim.y * gridDim.z;
    unsigned sum, cnt, mine, sp = 0u;
    for (;;) {
        sum = 0u; cnt = 0u; mine = 0u;
#pragma unroll
        for (unsigned j = 0; j < 16; ++j) { const unsigned c = xb_ld(&bar[XB_XCNT(j)]); sum += c; cnt += (c > 0u) ? 1u : 0u; mine = (j == x) ? c : mine; }
        if (sum == G) break;
        __builtin_amdgcn_s_sleep(1);
        if ((++sp & 255u) == 0u) { if (xb_ld(&bar[XB_TMO])) break; if (sp > XB_SPIN_CAP) { atomicAdd(&bar[XB_TMO], 1u); break; } }
    }
    nloc = mine > 0u ? mine : 1u; nx = cnt > 0u ? cnt : 1u;
}

__device__ __forceinline__ void xcd_barrier(const XcdBarrier& b) {
    asm volatile("s_waitcnt vmcnt(0)" ::: "memory");
    __syncthreads();
    if (threadIdx.x == 0) {
        unsigned* bar = b.bar;
        __builtin_amdgcn_s_waitcnt(0);
        unsigned nloc = b.st[0], nx = b.st[1];
        if (nloc == 0u) { xcd_barrier_complete(bar, b.x, nloc, nx); b.st[0] = nloc; b.st[1] = nx; }
        const unsigned old = xb_add(&bar[XB_XSUB(b.x)], 1u);
        const unsigned gen = old / nloc;
        if (old + 1u == (gen + 1u) * nloc) {
            __builtin_amdgcn_fence(__ATOMIC_RELEASE, "agent");
            asm volatile("s_waitcnt vmcnt(0)" ::: "memory");
            const unsigned og = xb_add(&bar[XB_TOP], 1u);
            const unsigned tg = og / nx;
            if (og + 1u == (tg + 1u) * nx) xb_add(&bar[XB_TOPGEN], 1u);
            else XB_SPIN(xb_ld(&bar[XB_TOPGEN]) == tg, bar);
            __builtin_amdgcn_fence(__ATOMIC_ACQUIRE, "agent");
            xb_add(&bar[XB_XGEN(b.x)], 1u);
            asm volatile("s_waitcnt vmcnt(0)" ::: "memory");
        } else {
            XB_SPIN(xb_ld(&bar[XB_XGEN(b.x)]) == gen, bar);
            __builtin_amdgcn_fence(__ATOMIC_ACQUIRE, "agent");
            asm volatile("s_waitcnt vmcnt(0)" ::: "memory");
        }
    }
    __syncthreads();
}

enum { PH_PRO = 0, PH_HN, PH_GEMM1, PH_PREP, PH_MIX, PH_ATT, PH_UV, PH_GOUT, PH_UP, PH_DOWN, PH_COUNT };
#ifndef MK_SKIP_MIXER
#define MK_SKIP_MIXER 0
#endif
__global__ void __launch_bounds__(NWAVES * 64, 2) mk_fwd(Params p) {
    extern __shared__ __attribute__((aligned(16))) unsigned char lds[];
    cg::grid_group grid = cg::this_grid();
    const int tid = threadIdx.x, lane = tid & 63, wv = __builtin_amdgcn_readfirstlane(tid >> 6);
    const int G = gridDim.x, gw = blockIdx.x * NWAVES + wv, NGW = G * NWAVES;
    const int lo = p.ph_lo, hi = p.ph_hi;
    if (p.ph_hi < 0) grid.sync();
    if (tid < 2) ((volatile LAS unsigned*)((LAS unsigned char*)lds + LDS_BAR_OFF))[tid] = 0u;
    __syncthreads();
    XcdBarrier xbar = xcd_barrier_post((unsigned*)(p.ws + WS_BAR), (volatile LAS unsigned*)((LAS unsigned char*)lds + LDS_BAR_OFF));
    float* MOD = (float*)(p.ws + WS_MOD); bf16* REGA = (bf16*)(p.ws + WS_REGA); bf16* PROJ = (bf16*)(p.ws + WS_PROJ);
#ifndef MK_PHASE_MASK
#define MK_PHASE_MASK 0x3ff
#endif
#define IN(k) (((MK_PHASE_MASK >> (k)) & 1) && lo <= (k) && (k) < hi)
#define SEAM(k) do { if (IN(k) && IN((k) + 1)) { xcd_barrier(xbar); } if (MK_PROBE >= 0 && blockIdx.x == 0 && tid == 0) ((unsigned long long*)(p.ws + WS_MOD + 800 * 1024))[(k) + 1] = __builtin_amdgcn_s_memrealtime(); } while (0)
    if (MK_PROBE >= 0 && blockIdx.x == 0 && tid == 0) ((unsigned long long*)(p.ws + WS_MOD + 800 * 1024))[0] = __builtin_amdgcn_s_memrealtime();
    if (IN(PH_PRO)) { phase_pro(p, lds, tid, G); }
    SEAM(PH_PRO);
    if (IN(PH_HN)) { hn_rows<MK_F8_GEMM1 != 0>(p.x, p.g_mix, MOD, 0, 1024, REGA, gw, NGW, lane); }
    SEAM(PH_HN);
    if (IN(PH_GEMM1)) {
#if MK_F8_GEMM1
        pg8::Gemm g{REGA, (const bf16*)(p.ws + WS_WIN), M, NPROJ, DM / 2, DM / 2}; pg8::StaticOrder S; S.init(M, NPROJ, G, (int)blockIdx.x);
        pg8::EpiBf16<0> E{PROJ, NPROJ, 1.f / 32.f};
        pg8::gemm_phase<pg8::EpiBf16<0>, pg8::StaticOrder, true, true, true>((PG8_LAS unsigned char*)lds, g, S, E);
#else
        pg8::Gemm g{REGA, (const bf16*)(p.ws + WS_WIN), M, NPROJ, DM, DM}; pg8::StaticOrder S; S.init(M, NPROJ, G, (int)blockIdx.x);
        pg8::EpiBf16<0> E{PROJ, NPROJ, 1.f};
        pg8::gemm_phase<pg8::EpiBf16<0>, pg8::StaticOrder, true, true>((PG8_LAS unsigned char*)lds, g, S, E);
#endif
    }
    SEAM(PH_GEMM1);
    if (IN(PH_PREP)) {
#ifndef DBG_NO_RP
        for (int it = blockIdx.x; it < M / 64; it += G) rwkv_prep_item(p, lds, it, tid);
#endif
#ifndef DBG_NO_DP
        __syncthreads();
        stage_w_lds((const bf16*)(p.ws + WS_WUKT), lds, 4, tid); __syncthreads();
        for (int tile = gw; tile < M / 32; tile += NGW) dsa_prep_kv(p, lds, tile, lane);
        __syncthreads();
        stage_w_lds((const bf16*)(p.ws + WS_WUK), lds, 6, tid); __syncthreads();
        for (int tile = gw; tile < M / 32; tile += NGW) dsa_prep_q(p, lds, tile, lane);
#endif
    }
    SEAM(PH_PREP);
    if (IN(PH_MIX)) {
        for (int chain = blockIdx.x; chain < NB * 8; chain += G) { rwkv_scan_chain(p, lds, chain, wv, lane); __syncthreads(); }
        constexpr int NSEL = NB * 112;
        {   bf16x8 af[4][4]; float wqv = 0.f; const bf16* PROJ = (const bf16*)(p.ws + WS_PROJ);
            int idx = (int)blockIdx.x;
            if (idx < NSEL) DSA_LOAD_AF(af, wqv, idx / 112, 256 + 16 * (idx % 112));
            for (int k = 0; idx < NSEL; ++k) { const int nidx = (k + 1) * G + (((k + 1) & 1) ? (G - 1 - (int)blockIdx.x) : (int)blockIdx.x); const bool hn = nidx < NSEL;
                dsa_select_item(p, lds, idx / 112, 256 + 16 * (idx % 112), tid, af, wqv, hn, nidx / 112, 256 + 16 * (nidx % 112)); idx = nidx; } }
    }
    SEAM(PH_MIX);
    const bool pan_local = MK_PANEL_ATT && (M / 256 == G) && (M / 32 == NGW) && (G % 8 == 0);
    const int vb = pan_local ? (int)(blockIdx.x & 7) * (G >> 3) + (int)(blockIdx.x >> 3) : (int)blockIdx.x, vgw = vb * NWAVES + wv;
    if (IN(PH_ATT)) {
        if (pan_local) {
            if ((vb & 7) == 0 && wv < 4) bias2_item(p, (vb >> 3) * 4 + wv, lane);
            dsa_attend_rows(p, lds + wv * 9216, vb * 256 + wv, NWAVES, vb * 256 + 256, lane);
        } else {
            if (gw < 128) bias2_item(p, gw, lane);
            dsa_attend_rows(p, lds + wv * 9216, gw, NGW, M, lane);
        }
    }
    if (pan_local && IN(PH_ATT) && IN(PH_UV)) { __syncthreads(); if (MK_PROBE >= 0 && blockIdx.x == 0 && tid == 0) ((unsigned long long*)(p.ws + WS_MOD + 800 * 1024))[PH_ATT + 1] = __builtin_amdgcn_s_memrealtime(); }
    else { SEAM(PH_ATT); }
    if (IN(PH_UV)) {
#if MK_DBG == 7
        for (int m = gw; m < M; m += NGW) { *(u32x4*)(PROJ + (size_t)m * NPROJ + lane * 8) = *(const u32x4*)(REGA + (size_t)m * 1024 + lane * 8); }
#elif MK_DBG != 2
        stage_w_lds((const bf16*)(p.ws + WS_WUVT), lds, 4, tid); __syncthreads();
        for (int tile = vgw; tile < M / 32; tile += NGW) uv_item(p, lds, tile, lane);
#endif
#if MK_DBG == 0
        rwkv_epi_rows(p, vgw, NGW, lane);
#endif
#if MK_DBG == 1 || MK_DBG == 2
        for (int m = gw; m < M; m += NGW) { u32x4 z = {0u, 0u, 0u, 0u}; *(u32x4*)(PROJ + (size_t)m * NPROJ + (MK_DBG == 1 ? 512 : 0) + lane * 8) = z; }
#endif
    }
    const bool uv_local = (M / 256 == G) && (M / 32 == NGW);
    if (uv_local && IN(PH_UV) && IN(PH_GOUT)) { __syncthreads(); if (MK_PROBE >= 0 && blockIdx.x == 0 && tid == 0) ((unsigned long long*)(p.ws + WS_MOD + 800 * 1024))[PH_UV + 1] = __builtin_amdgcn_s_memrealtime(); }
    else { SEAM(PH_UV); }
    if (IN(PH_GOUT)) {
#if MK_F8_GOUT
        pg8::Gemm g{PROJ, (const bf16*)(p.ws + WS_WOUT), M, DM, DM / 2, NPROJ};
        pg8::EpiResGateNorm E{p.x, p.out, DM, MOD + 2048, 6144, p.g_ffn, MOD + 4096, REGA, (float*)(p.ws + WS_ROWSQ), 1.f / 256.f};
        if (uv_local) { pg8::PanelOrder S; S.init(M, DM, G, vb); pg8::gemm_phase<pg8::EpiResGateNorm, pg8::PanelOrder, true, true, true>((PG8_LAS unsigned char*)lds, g, S, E); }
        else { pg8::StaticOrder S; S.init(M, DM, G, (int)blockIdx.x); pg8::gemm_phase<pg8::EpiResGateNorm, pg8::StaticOrder, true, true, true>((PG8_LAS unsigned char*)lds, g, S, E); }
#else
        pg8::Gemm g{PROJ, (const bf16*)(p.ws + WS_WOUT), M, DM, DM, NPROJ}; pg8::StaticOrder S; S.init(M, DM, G, (int)blockIdx.x);
        pg8::EpiResGateNorm E{p.x, p.out, DM, MOD + 2048, 6144, p.g_ffn, MOD + 4096, REGA, (float*)(p.ws + WS_ROWSQ), 1.f};
        pg8::gemm_phase<pg8::EpiResGateNorm, pg8::StaticOrder, true, true>((PG8_LAS unsigned char*)lds, g, S, E);
#endif
    }
    SEAM(PH_GOUT);
    if (IN(PH_UP)) {
        pg8::Gemm g{REGA, (const bf16*)(p.ws + WS_W1), M, FF, DM, DM}; pg8::StaticOrder S; S.init(M, FF, G, (int)blockIdx.x);
        pg8::EpiF8Relu2 E{p.ws + WS_U, FF, 4.f, (const float*)(p.ws + WS_ROWSQ), (const float*)(p.ws + WS_BIAS2)};
        pg8::gemm_phase<pg8::EpiF8Relu2, pg8::StaticOrder, true, true>((PG8_LAS unsigned char*)lds, g, S, E);
    }
    SEAM(PH_UP);
    if (IN(PH_DOWN)) {
        pg8::Gemm g{(const bf16*)(p.ws + WS_U), (const bf16*)(p.ws + WS_W2), M, DM, FF / 2, FF / 2}; pg8::StaticOrder S; S.init(M, DM, G, (int)blockIdx.x);
        pg8::EpiResGateA2 E{REGA, p.out, DM, MOD + 5120, 6144, p.g_ffn};
        pg8::gemm_phase<pg8::EpiResGateA2, pg8::StaticOrder, true, true, true>((PG8_LAS unsigned char*)lds, g, S, E);
    }
#if MK_PROBE >= 0
    grid.sync();
    if (blockIdx.x == 0 && tid == 0) { unsigned long long* ts = (unsigned long long*)(p.ws + WS_MOD + 800 * 1024); ts[PH_COUNT] = __builtin_amdgcn_s_memrealtime();
        p.out[0] += (float)(ts[MK_PROBE + 1] - ts[MK_PROBE]) * 1e-3f; }
#endif
#undef IN
#undef SEAM
}

#ifndef MK_N_LAUNCHES
#define MK_N_LAUNCHES 1
#endif
extern "C" void kernel_launch(void* const* d_in, const int* in_sizes, int n_in, void* d_out, int out_size, void* d_ws, size_t ws_size, hipStream_t stream) {
    static int grid = 0;
    if (grid == 0) {
        if (n_in != 26 || out_size != M * DM || ws_size < WS_END) { fprintf(stderr, "kernel_launch: unexpected shapes (n_in %d out %d ws %zu)\n", n_in, out_size, ws_size); grid = -1; return; }
        int dev = 0, cus = 0, per_cu = 0;
        hipGetDevice(&dev); hipDeviceGetAttribute(&cus, hipDeviceAttributeMultiprocessorCount, dev);
        if (hipFuncSetAttribute((const void*)mk_fwd, hipFuncAttributeMaxDynamicSharedMemorySize, LDS_BYTES) != hipSuccess) { fprintf(stderr, "kernel_launch: hipFuncSetAttribute failed\n"); grid = -1; return; }
        if (hipOccupancyMaxActiveBlocksPerMultiprocessor(&per_cu, (const void*)mk_fwd, NWAVES * 64, LDS_BYTES) != hipSuccess || per_cu < 1) { fprintf(stderr, "kernel_launch: occupancy query says %d\n", per_cu); per_cu = 1; }
        (void)hipGetLastError();
        grid = cus * 1;
        if (per_cu < 1) grid = -1;
    }
    if (grid < 0) return;
    Params p{};
    const float** pp = (const float**)&p;
    for (int i = 0; i < 26; ++i) pp[i] = (const float*)d_in[i];
    p.out = (float*)d_out; p.ws = (unsigned char*)d_ws;
#if MK_N_LAUNCHES == 1
    if (hipMemsetAsync((char*)d_ws + WS_BAR, 0, 16384, stream) != hipSuccess) { fprintf(stderr, "kernel_launch: memset of the barrier words failed\n"); return; }
    p.ph_lo = 0; p.ph_hi = PH_COUNT;
    void* args[] = {&p};
    hipError_t e = hipLaunchCooperativeKernel((const void*)mk_fwd, dim3(grid), dim3(NWAVES * 64), args, LDS_BYTES, stream);
    if (e != hipSuccess) fprintf(stderr, "cooperative launch failed: %s (grid %d)\n", hipGetErrorString(e), grid);
#else
    for (int ph = 0; ph < PH_COUNT; ++ph) {
#if MK_SKIP_MIXER
        if (ph >= PH_HN && ph <= PH_GOUT) continue;
#endif
        p.ph_lo = ph; p.ph_hi = ph + 1;
        hipLaunchKernelGGL(mk_fwd, dim3(grid), dim3(NWAVES * 64), LDS_BYTES, stream, p);
    }
#endif
}
```

```cpp
#include <hip/hip_runtime.h>
#include <hip/hip_cooperative_groups.h>
#include <cstdio>
#include <cstdint>
#include <cmath>
namespace cg = cooperative_groups;
#ifndef MK_F8_GEMM1
#define MK_F8_GEMM1 0
#endif
#ifndef MK_PANEL_ATT
#define MK_PANEL_ATT 1
#endif
#ifndef MK_PROBE
#define MK_PROBE -1
#endif
#ifndef MK_F8_GOUT
#define MK_F8_GOUT 1
#endif
#ifndef MK_DBG
#define MK_DBG 0
#endif
#ifndef MK_DBG_NOTOPK
#define MK_DBG_NOTOPK 0
#endif
#define MK_DPPF(x_, ctrl_) __builtin_bit_cast(float, __builtin_amdgcn_mov_dpp(__builtin_bit_cast(int, (x_)), (ctrl_), 0xF, 0xF, true))
__device__ __forceinline__ float dpp_sum8(float x)  { x += MK_DPPF(x, 0xB1); x += MK_DPPF(x, 0x4E); x += MK_DPPF(x, 0x141); return x; }
__device__ __forceinline__ float dpp_row_sum16(float x) { x = dpp_sum8(x); x += MK_DPPF(x, 0x140); return x; }
__device__ __forceinline__ float dpp_row_max16(float x) { x = fmaxf(x, MK_DPPF(x, 0xB1)); x = fmaxf(x, MK_DPPF(x, 0x4E)); x = fmaxf(x, MK_DPPF(x, 0x141)); x = fmaxf(x, MK_DPPF(x, 0x140)); return x; }
__device__ __forceinline__ float xor16_max(float x) { const auto r = __builtin_amdgcn_permlane16_swap(__float_as_uint(x), __float_as_uint(x), false, false); return fmaxf(__uint_as_float(r[0]), __uint_as_float(r[1])); }
__device__ __forceinline__ float xor32_max(float x) { const auto r = __builtin_amdgcn_permlane32_swap(__float_as_uint(x), __float_as_uint(x), false, false); return fmaxf(__uint_as_float(r[0]), __uint_as_float(r[1])); }
__device__ __forceinline__ float xor16_sum(float x) { const auto r = __builtin_amdgcn_permlane16_swap(__float_as_uint(x), __float_as_uint(x), false, false); return __uint_as_float(r[0]) + __uint_as_float(r[1]); }
__device__ __forceinline__ float xor32_sum(float x) { const auto r = __builtin_amdgcn_permlane32_swap(__float_as_uint(x), __float_as_uint(x), false, false); return __uint_as_float(r[0]) + __uint_as_float(r[1]); }
__device__ __forceinline__ float wave_sum(float v) { return xor32_sum(xor16_sum(dpp_row_sum16(v))); }
namespace pg8 {
#define PG8_LAS __attribute__((address_space(3)))
typedef unsigned short bf16_t;
typedef short bf16x8 __attribute__((ext_vector_type(8)));
typedef float f32x4 __attribute__((ext_vector_type(4)));
typedef unsigned u32x4 __attribute__((ext_vector_type(4)));
constexpr int BM = 256, BK = 64, HALF = 128, HTB = HALF * BK * 2  , STAGE_BYTES = 8 * HTB, NXCD = 8, WGM = 8;

__host__ __device__ __forceinline__ int lds_byte(int r, int c) { const int st = (r >> 4) * 2 + (c >> 5), rr = r & 15, cc = c & 31, ob = rr * 64 + cc * 2; return st * 1024 + (ob ^ (((ob >> 9) & 1) << 5)); }
__host__ __device__ __forceinline__ void stage_rc(int b, int& R, int& C) { const int st = b / 1024, sb = b % 1024, swz = sb ^ (((sb >> 9) & 1) << 5); R = (st >> 1) * 16 + swz / 64; C = (st & 1) * 32 + (swz % 64) / 2; }
__host__ __device__ __forceinline__ int perm32(int rho) { const int n = rho >> 4, i = rho & 15; return 8 * (i >> 2) + 4 * n + (i & 3); }

struct Unit { int pm, pn; };
struct Gemm { const bf16_t* A; const bf16_t* Bt; int M, N, K, lda; };

struct StaticOrder {
    int nM, nN, nwg, G, c;
    __host__ __device__ void init(int M, int N, int G_, int c_) { nM = M / BM; nN = N / BM; nwg = nM * nN; G = G_; c = c_; }
    __host__ __device__ bool next(int i, Unit& u) const {
        const long L = (long)i * G + c; if (L >= nwg) return false;
        int wgid = (int)L; { const int q = nwg / NXCD, r = nwg % NXCD, xcd = wgid % NXCD, off = wgid / NXCD; wgid = (xcd < r ? xcd * (q + 1) : r * (q + 1) + (xcd - r) * q) + off; }
        const int nig = WGM * nN, gid = wgid / nig, fm = gid * WGM, gsz = (nM - fm) < WGM ? (nM - fm) : WGM;
        u.pm = fm + ((wgid % nig) % gsz); u.pn = (wgid % nig) / gsz; return true;
    }
    __device__ __forceinline__ void a_ready(const Unit&) const {}
    __device__ __forceinline__ void done(const Unit&) const {}
};
struct PanelOrder {
    int nM, nN, G, c;
    __host__ __device__ void init(int M, int N, int G_, int c_) { nM = M / BM; nN = N / BM; G = G_; c = c_; }
    __host__ __device__ bool next(int i, Unit& u) const { u.pm = c + (i / nN) * G; u.pn = i % nN; return u.pm < nM; }
    __device__ __forceinline__ void a_ready(const Unit&) const {}
    __device__ __forceinline__ void done(const Unit&) const {}
};


typedef float f32x2_t __attribute__((ext_vector_type(2))); typedef __bf16 bf16x2_t __attribute__((ext_vector_type(2)));
__device__ __forceinline__ unsigned cvt_pk_bf16(float lo, float hi) { const f32x2_t v = {lo, hi}; const bf16x2_t b = __builtin_convertvector(v, bf16x2_t); return __builtin_bit_cast(unsigned, b); }

template <int ACT  > struct EpiBf16 {
    static constexpr bool PERM = true, AFTER_DRAIN = false;
    bf16_t* O; int ldc; float scale;
    __device__ __forceinline__ void operator()(const f32x4 (&acc)[2][2][4][2], const Unit& u, int wr, int wc, int fr, int fq) const {
        const int row0 = u.pm * BM + wr * 64 + fr; const int col0 = u.pn * BM + wc * 32 + 8 * fq;
#pragma unroll
        for (int ai = 0; ai < 2; ++ai)
#pragma unroll
            for (int m = 0; m < 4; ++m) { bf16_t* rowp = O + (size_t)(row0 + ai * HALF + m * 16) * ldc + col0;
#pragma unroll
                for (int bj = 0; bj < 2; ++bj) { f32x4 v0 = acc[ai][bj][m][0] * scale, v1 = acc[ai][bj][m][1] * scale;
                    if (ACT == 1) {
#pragma unroll
                        for (int j = 0; j < 4; ++j) { const float a = v0[j] > 0.f ? v0[j] : 0.f, b = v1[j] > 0.f ? v1[j] : 0.f; v0[j] = a * a; v1[j] = b * b; } }
                    u32x4 w; w.x = cvt_pk_bf16(v0[0], v0[1]); w.y = cvt_pk_bf16(v0[2], v0[3]); w.z = cvt_pk_bf16(v1[0], v1[1]); w.w = cvt_pk_bf16(v1[2], v1[3]);
                    *(u32x4*)(rowp + bj * HALF) = w; } }
    }
};
__device__ __forceinline__ unsigned pk4_fp8(float a, float b, float c, float d) { int r = __builtin_amdgcn_cvt_pk_fp8_f32(a, b, 0, false); r = __builtin_amdgcn_cvt_pk_fp8_f32(c, d, r, true); return (unsigned)r; }
struct EpiF8Relu2 {
    static constexpr bool PERM = true, AFTER_DRAIN = false;
    unsigned char* O; int ldc; float scale; const float* rowsq; const float* bias2;
    __device__ __forceinline__ void operator()(const f32x4 (&acc)[2][2][4][2], const Unit& u, int wr, int wc, int fr, int fq) const {
        const int row0 = u.pm * BM + wr * 64 + fr; const int col0 = u.pn * BM + wc * 32 + 8 * fq;
        const float* bp = bias2 + (size_t)(u.pm >> 3) * 4096 + col0;
        f32x4 bv[2][2];
#pragma unroll
        for (int bj = 0; bj < 2; ++bj) { bv[bj][0] = *(const f32x4*)(bp + bj * HALF); bv[bj][1] = *(const f32x4*)(bp + bj * HALF + 4); }
#pragma unroll
        for (int ai = 0; ai < 2; ++ai)
#pragma unroll
            for (int m = 0; m < 4; ++m) { const int row = row0 + ai * HALF + m * 16; unsigned char* rowp = O + (size_t)row * ldc + col0;
                const float rstd = rsqrtf(rowsq[row] * (1.f / 1024.f) + 1e-6f);
#pragma unroll
                for (int bj = 0; bj < 2; ++bj) { f32x4 v0 = acc[ai][bj][m][0] * rstd + bv[bj][0], v1 = acc[ai][bj][m][1] * rstd + bv[bj][1];
#pragma unroll
                    for (int j = 0; j < 4; ++j) { const float a = v0[j] > 0.f ? v0[j] : 0.f, b = v1[j] > 0.f ? v1[j] : 0.f; v0[j] = fminf(a * a * scale, 416.f); v1[j] = fminf(b * b * scale, 416.f); }
                    typedef unsigned u32x2_t __attribute__((ext_vector_type(2)));
                    u32x2_t w; w.x = pk4_fp8(v0[0], v0[1], v0[2], v0[3]); w.y = pk4_fp8(v1[0], v1[1], v1[2], v1[3]);
                    *(u32x2_t*)(rowp + bj * HALF) = w; } }
    }
};
struct EpiResGate {
    static constexpr bool PERM = false, AFTER_DRAIN = false;
    const float* base; float* out; int ldc; const float* gate; int gate_ld; float gscale;
    __device__ __forceinline__ void operator()(const f32x4 (&acc)[2][2][4][2], const Unit& u, int, int, int, int) const {
        int t_ = threadIdx.x; asm volatile("" : "+v"(t_));
        const int wr = t_ >> 8, wc = (t_ >> 6) & 3, fr = t_ & 15, fq = (t_ >> 4) & 3;
        const int row0 = u.pm * BM + wr * 64 + fr, col0 = u.pn * BM + wc * 32 + 4 * fq;
        const float* gp = gate + (size_t)(u.pm >> 3) * gate_ld + col0;
        f32x4 gv[2][2];
#pragma unroll
        for (int bj = 0; bj < 2; ++bj)
#pragma unroll
            for (int n = 0; n < 2; ++n) gv[bj][n] = *(const f32x4*)(gp + bj * HALF + n * 16) * gscale;
#pragma unroll
        for (int ai = 0; ai < 2; ++ai)
#pragma unroll
            for (int m = 0; m < 4; ++m) { const size_t off = (size_t)(row0 + ai * HALF + m * 16) * ldc + col0;
#pragma unroll
                for (int bj = 0; bj < 2; ++bj)
#pragma unroll
                    for (int n = 0; n < 2; ++n) { const f32x4 bs = *(const f32x4*)(base + off + bj * HALF + n * 16);
                        *(f32x4*)(out + off + bj * HALF + n * 16) = bs + gv[bj][n] * acc[ai][bj][m][n]; } }
    }
};
struct EpiResGateNorm {
    static constexpr bool PERM = false, AFTER_DRAIN = false;
    const float* base; float* out; int ldc; const float* gate; int gate_ld; const float* gffn; const float* sc2; bf16_t* a2; float* rowsq; float gscale;
    __device__ __forceinline__ void operator()(const f32x4 (&acc)[2][2][4][2], const Unit& u, int, int, int, int) const {
        int t_ = threadIdx.x; asm volatile("" : "+v"(t_));
        const int wr = t_ >> 8, wc = (t_ >> 6) & 3, fr = t_ & 15, fq = (t_ >> 4) & 3;
        const int row0 = u.pm * BM + wr * 64 + fr, col0 = u.pn * BM + wc * 32 + 4 * fq;
        const float* gp = gate + (size_t)(u.pm >> 3) * gate_ld + col0; const float* sp = sc2 + (size_t)(u.pm >> 3) * gate_ld + col0;
        f32x4 gv[2][2], gm[2][2];
#pragma unroll
        for (int bj = 0; bj < 2; ++bj)
#pragma unroll
            for (int n = 0; n < 2; ++n) { gv[bj][n] = *(const f32x4*)(gp + bj * HALF + n * 16) * gscale; gm[bj][n] = *(const f32x4*)(gffn + col0 + bj * HALF + n * 16) * (*(const f32x4*)(sp + bj * HALF + n * 16) + 1.f); }
#pragma unroll
        for (int ai = 0; ai < 2; ++ai)
#pragma unroll
            for (int m = 0; m < 4; ++m) { const int row = row0 + ai * HALF + m * 16; const size_t off = (size_t)row * ldc + col0; float ss = 0.f;
#pragma unroll
                for (int bj = 0; bj < 2; ++bj)
#pragma unroll
                    for (int n = 0; n < 2; ++n) { const f32x4 bs = *(const f32x4*)(base + off + bj * HALF + n * 16); const f32x4 x1 = bs + gv[bj][n] * acc[ai][bj][m][n];
                        ss += (x1.x * x1.x + x1.y * x1.y) + (x1.z * x1.z + x1.w * x1.w);
                        const f32x4 y = x1 * gm[bj][n]; typedef unsigned u32x2_t __attribute__((ext_vector_type(2)));
                        u32x2_t w; w.x = cvt_pk_bf16(y.x, y.y); w.y = cvt_pk_bf16(y.z, y.w); *(u32x2_t*)(a2 + off + bj * HALF + n * 16) = w; }
                ss = xor32_sum(xor16_sum(ss));
                if (fq == 0) atomicAdd(rowsq + row, ss); }
    }
};
struct EpiResGateA2 {
    static constexpr bool PERM = false, AFTER_DRAIN = false;
    const bf16_t* a2; float* out; int ldc; const float* gate; int gate_ld; const float* gffn;
    __device__ __forceinline__ void operator()(const f32x4 (&acc)[2][2][4][2], const Unit& u, int, int, int, int) const {
        constexpr float gscale = 1.f / 256.f;
        int t_ = threadIdx.x; asm volatile("" : "+v"(t_));
        const int wr = t_ >> 8, wc = (t_ >> 6) & 3, fr = t_ & 15, fq = (t_ >> 4) & 3;
        const int row0 = u.pm * BM + wr * 64 + fr, col0 = u.pn * BM + wc * 32 + 4 * fq;
        const float* gp = gate + (size_t)(u.pm >> 3) * gate_ld + col0; const float* sp = gp - 1024;
        f32x4 gv[2][2], ig[2][2];
#pragma unroll
        for (int bj = 0; bj < 2; ++bj)
#pragma unroll
            for (int n = 0; n < 2; ++n) { gv[bj][n] = *(const f32x4*)(gp + bj * HALF + n * 16) * gscale;
                const f32x4 gm = *(const f32x4*)(gffn + col0 + bj * HALF + n * 16) * (*(const f32x4*)(sp + bj * HALF + n * 16) + 1.f);
                ig[bj][n] = (f32x4){1.f / gm.x, 1.f / gm.y, 1.f / gm.z, 1.f / gm.w}; }
#pragma unroll
        for (int ai = 0; ai < 2; ++ai)
#pragma unroll
            for (int m = 0; m < 4; ++m) { const size_t off = (size_t)(row0 + ai * HALF + m * 16) * ldc + col0;
#pragma unroll
                for (int bj = 0; bj < 2; ++bj)
#pragma unroll
                    for (int n = 0; n < 2; ++n) { typedef unsigned u32x2_t __attribute__((ext_vector_type(2)));
                        const u32x2_t w = *(const u32x2_t*)(a2 + off + bj * HALF + n * 16);
                        const f32x4 xa = {__uint_as_float(w.x << 16), __uint_as_float(w.x & 0xffff0000u), __uint_as_float(w.y << 16), __uint_as_float(w.y & 0xffff0000u)};
                        *(f32x4*)(out + off + bj * HALF + n * 16) = xa * ig[bj][n] + gv[bj][n] * acc[ai][bj][m][n]; } }
    }
};
template <class Epi, class Sched, bool ALIGN_EPI = false, bool SP2 = false, bool F8 = false>
__device__ __forceinline__ void gemm_phase(PG8_LAS unsigned char* lds, const Gemm g, const Sched S, const Epi E) {
    const int tid = threadIdx.x, wid = __builtin_amdgcn_readfirstlane(tid >> 6), lane = tid & 63, wr = wid >> 2, wc = wid & 3, fr = lane & 15, fq = lane >> 4;
    const int K = g.K, nt = K / BK;
    unsigned voffA[2], voffB[2];
#pragma unroll
    for (int i = 0; i < 2; ++i) { int R, C; stage_rc(tid * 16 + i * 8192, R, C); const int Rb = Epi::PERM ? ((R & ~31) + perm32(R & 31)) : R;
        voffA[i] = (unsigned)(R * g.lda + C) * 2u; voffB[i] = (unsigned)(Rb * K + C) * 2u; }
    const size_t kstep = (size_t)(BK * 2);
    const size_t hstepB = (size_t)HALF * K * 2, hstepA = (size_t)HALF * g.lda * 2;
    const size_t tstepA = 2 * hstepA, tstepB = 2 * hstepB;
    const unsigned ldsw = (unsigned)wid * 1024u;
    const int f8in = (fq >> 1) * 1024 + ((fr * 64 + (fq & 1) * 32) ^ ((fr >> 3) << 5));
    const int aoff = F8 ? wr * 8192 + f8in : lds_byte(wr * 64 + fr, fq * 8), boff = F8 ? wc * 4096 + f8in : lds_byte(wc * 32 + fr, fq * 8);
    constexpr int KOFF = F8 ? 16 : 1024;
    typedef int v8i_t __attribute__((ext_vector_type(8)));
#define PG8_SA(b, h) (((b) * 2 + (h)) * HTB)
#define PG8_SB(b, h) ((4 + (b) * 2 + (h)) * HTB)
#define PG8_STAGE(bufoff, gbase, voff) do { _Pragma("unroll") for (int _i = 0; _i < 2; ++_i) \
        __builtin_amdgcn_global_load_lds((const unsigned*)((const char*)(gbase) + (voff)[_i]), (PG8_LAS unsigned*)(lds + (bufoff) + ldsw + _i * 8192), 16, 0, 0); } while (0)
#define PG8_LD32(p_) __builtin_shufflevector(*(const PG8_LAS u32x4*)(p_), *(const PG8_LAS u32x4*)((p_) + 16), 0, 1, 2, 3, 4, 5, 6, 7)
#define PG8_LDA(dst, b, h) do { if constexpr (F8) { _Pragma("unroll") for (int m = 0; m < 4; ++m) dst##8[m] = __builtin_bit_cast(v8i_t, PG8_LD32(lds + PG8_SA(b, h) + aoff + m * 2048)); } \
    else { _Pragma("unroll") for (int m = 0; m < 4; ++m) _Pragma("unroll") for (int k = 0; k < 2; ++k) dst[m][k] = *(const PG8_LAS bf16x8*)(lds + PG8_SA(b, h) + aoff + m * 2048 + k * KOFF); } } while (0)
#define PG8_LDB(dst, b, h) do { if constexpr (F8) { _Pragma("unroll") for (int n = 0; n < 2; ++n) dst##8[n] = __builtin_bit_cast(v8i_t, PG8_LD32(lds + PG8_SB(b, h) + boff + n * 2048)); } \
    else { _Pragma("unroll") for (int n = 0; n < 2; ++n) _Pragma("unroll") for (int k = 0; k < 2; ++k) dst[n][k] = *(const PG8_LAS bf16x8*)(lds + PG8_SB(b, h) + boff + n * 2048 + k * KOFF); } } while (0)
#define PG8_CAT(x) __builtin_shufflevector(__builtin_bit_cast(u32x4, (x)[0]), __builtin_bit_cast(u32x4, (x)[1]), 0, 1, 2, 3, 4, 5, 6, 7)
#define PG8_MMA(ai, bj, At, Bt) do { __builtin_amdgcn_s_setprio(1); if constexpr (F8) { _Pragma("unroll") for (int m = 0; m < 4; ++m) _Pragma("unroll") for (int n = 0; n < 2; ++n) \
        asm volatile("v_mfma_f32_16x16x128_f8f6f4 %0, %1, %2, %0" : "+v"(acc[ai][bj][m][n]) : "v"(Bt##8[n]), "v"(At##8[m])); } \
    else { _Pragma("unroll") for (int m = 0; m < 4; ++m) _Pragma("unroll") for (int n = 0; n < 2; ++n) _Pragma("unroll") for (int k = 0; k < 2; ++k) \
        acc[ai][bj][m][n] = __builtin_amdgcn_mfma_f32_16x16x32_bf16(Bt[n][k], At[m][k], acc[ai][bj][m][n], 0, 0, 0); } __builtin_amdgcn_s_setprio(0); } while (0)
#define PG8_WAIT_V(n) asm volatile("s_waitcnt vmcnt(" #n ")" ::: "memory")
#define PG8_WAIT_L(n) asm volatile("s_waitcnt lgkmcnt(" #n ")" ::: "memory")
#define PG8_BAR __builtin_amdgcn_s_barrier()
#define PG8_SCHED __builtin_amdgcn_sched_barrier(0)
    Unit cur, nxt; int ui = 0;
    if (!S.next(0, cur)) return;
    f32x4 acc[2][2][4][2];
#pragma unroll
    for (int a = 0; a < 2; ++a)
#pragma unroll
        for (int b = 0; b < 2; ++b)
#pragma unroll
            for (int m = 0; m < 4; ++m)
#pragma unroll
                for (int n = 0; n < 2; ++n) acc[a][b][m][n] = (f32x4){0.f, 0.f, 0.f, 0.f};
    bf16x8 At[4][2], B0[2][2], B1[2][2]; v8i_t At8[4], B08[2], B18[2];
    const char* cA = (const char*)g.A + (size_t)cur.pm * tstepA; const char* cB = (const char*)g.Bt + (size_t)cur.pn * tstepB;
    S.a_ready(cur);
    if constexpr (SP2) {
        PG8_STAGE(PG8_SB(0, 0), cB, voffB); PG8_STAGE(PG8_SB(0, 1), cB + hstepB, voffB); PG8_STAGE(PG8_SA(0, 0), cA, voffA); PG8_STAGE(PG8_SA(0, 1), cA + hstepA, voffA);
        if (wr == 1) PG8_BAR;
        PG8_WAIT_V(2); PG8_BAR;
        PG8_STAGE(PG8_SB(1, 0), cB + kstep, voffB); PG8_STAGE(PG8_SA(1, 0), cA + kstep, voffA); PG8_STAGE(PG8_SB(1, 1), cB + hstepB + kstep, voffB);
        PG8_WAIT_V(6); PG8_BAR;
    } else {
        PG8_STAGE(PG8_SB(0, 0), cB, voffB); PG8_STAGE(PG8_SA(0, 0), cA, voffA); PG8_STAGE(PG8_SB(0, 1), cB + hstepB, voffB); PG8_STAGE(PG8_SA(0, 1), cA + hstepA, voffA);
        if (wr == 1) PG8_BAR;
        PG8_WAIT_V(4); PG8_BAR;
        PG8_STAGE(PG8_SB(1, 0), cB + kstep, voffB); PG8_STAGE(PG8_SA(1, 0), cA + kstep, voffA); PG8_STAGE(PG8_SB(1, 1), cB + hstepB + kstep, voffB);
        PG8_WAIT_V(6); PG8_BAR;
    }
    for (;;) {
        const bool has_next = S.next(ui + 1, nxt);
        const char* nA = has_next ? (const char*)g.A + (size_t)nxt.pm * tstepA : cA; const char* nB = has_next ? (const char*)g.Bt + (size_t)nxt.pn * tstepB : cB;
        for (int t = 0; t < nt; t += 2) {
            const bool last = (t == nt - 2);
            const char* a1 = cA + (size_t)(t + 1) * kstep;
            const char* a2 = last ? nA : cA + (size_t)(t + 2) * kstep; const char* b2 = last ? nB : cB + (size_t)(t + 2) * kstep;
            const char* a3 = a2 + kstep; const char* b3 = b2 + kstep;
            if (last && has_next) S.a_ready(nxt);
            if constexpr (SP2) {
            PG8_LDB(B0, 0, 0); PG8_LDB(B1, 0, 1); PG8_SCHED; PG8_LDA(At, 0, 0); PG8_STAGE(PG8_SA(1, 1), a1 + hstepA, voffA);
            PG8_WAIT_V(8); PG8_WAIT_L(0); PG8_BAR; PG8_MMA(0, 0, At, B0); PG8_MMA(0, 1, At, B1); PG8_BAR; PG8_SCHED;
            PG8_LDA(At, 0, 1); PG8_STAGE(PG8_SB(0, 0), b2, voffB); PG8_STAGE(PG8_SB(0, 1), b2 + hstepB, voffB); PG8_STAGE(PG8_SA(0, 0), a2, voffA);
            PG8_WAIT_V(8); PG8_WAIT_L(0); PG8_BAR; PG8_MMA(1, 0, At, B0); PG8_MMA(1, 1, At, B1); PG8_BAR; PG8_SCHED;
            PG8_LDB(B0, 1, 0); PG8_LDB(B1, 1, 1); PG8_SCHED; PG8_LDA(At, 1, 0); PG8_STAGE(PG8_SA(0, 1), a2 + hstepA, voffA);
            PG8_WAIT_V(8); PG8_WAIT_L(0); PG8_BAR; PG8_MMA(0, 0, At, B0); PG8_MMA(0, 1, At, B1); PG8_BAR; PG8_SCHED;
            PG8_LDA(At, 1, 1); PG8_STAGE(PG8_SB(1, 0), b3, voffB); PG8_STAGE(PG8_SB(1, 1), b3 + hstepB, voffB); PG8_STAGE(PG8_SA(1, 0), a3, voffA);
            PG8_WAIT_V(8); PG8_WAIT_L(0); PG8_BAR; PG8_MMA(1, 0, At, B0); PG8_MMA(1, 1, At, B1); PG8_BAR; PG8_SCHED;
            } else {
            PG8_LDB(B0, 0, 0); PG8_SCHED; PG8_LDA(At, 0, 0); PG8_STAGE(PG8_SA(1, 1), a1 + hstepA, voffA);
            PG8_WAIT_L(8); PG8_BAR; PG8_WAIT_L(0); PG8_MMA(0, 0, At, B0); PG8_BAR; PG8_SCHED;
            PG8_LDB(B1, 0, 1); PG8_STAGE(PG8_SB(0, 0), b2, voffB);
            PG8_BAR; PG8_WAIT_L(0); PG8_MMA(0, 1, At, B1); PG8_BAR;
            PG8_LDA(At, 0, 1); PG8_STAGE(PG8_SA(0, 0), a2, voffA);
            PG8_BAR; PG8_WAIT_L(0); PG8_MMA(1, 0, At, B0); PG8_BAR; PG8_SCHED;
            PG8_STAGE(PG8_SB(0, 1), b2 + hstepB, voffB);
            PG8_WAIT_V(6); PG8_BAR; PG8_MMA(1, 1, At, B1); PG8_BAR;
            PG8_LDB(B0, 1, 0); PG8_SCHED; PG8_LDA(At, 1, 0); PG8_STAGE(PG8_SA(0, 1), a2 + hstepA, voffA);
            PG8_WAIT_L(8); PG8_BAR; PG8_WAIT_L(0); PG8_MMA(0, 0, At, B0); PG8_BAR; PG8_SCHED;
            PG8_LDB(B1, 1, 1); PG8_STAGE(PG8_SB(1, 0), b3, voffB);
            PG8_BAR; PG8_WAIT_L(0); PG8_MMA(0, 1, At, B1); PG8_BAR;
            PG8_LDA(At, 1, 1); PG8_STAGE(PG8_SA(1, 0), a3, voffA);
            PG8_BAR; PG8_WAIT_L(0); PG8_MMA(1, 0, At, B0); PG8_BAR; PG8_SCHED;
            PG8_STAGE(PG8_SB(1, 1), b3 + hstepB, voffB);
            PG8_WAIT_V(6); PG8_BAR; PG8_MMA(1, 1, At, B1); PG8_BAR;
            }
        }
        if constexpr (ALIGN_EPI) { if (wr == 0) PG8_BAR; }
        if constexpr (F8) asm volatile("s_nop 15\n\ts_nop 15");
        if constexpr (!Epi::AFTER_DRAIN) { E(acc, cur, wr, wc, fr, fq); S.done(cur); }
        if (!has_next) break;
#pragma unroll
        for (int a = 0; a < 2; ++a)
#pragma unroll
            for (int b = 0; b < 2; ++b)
#pragma unroll
                for (int m = 0; m < 4; ++m)
#pragma unroll
                    for (int n = 0; n < 2; ++n) acc[a][b][m][n] = (f32x4){0.f, 0.f, 0.f, 0.f};
        cur = nxt; cA = nA; cB = nB; ++ui;
        if constexpr (ALIGN_EPI) { if (wr == 1) PG8_BAR; }
    }
    PG8_WAIT_V(0);
    if constexpr (!ALIGN_EPI) { if (wr == 0) PG8_BAR; }
    PG8_BAR;
    if constexpr (Epi::AFTER_DRAIN) { E.fused(acc, cur, wr, wc, fr, fq, lds, wid, lane); S.done(cur); }
#undef PG8_SA
#undef PG8_SB
#undef PG8_STAGE
#undef PG8_LDA
#undef PG8_LDB
#undef PG8_MMA
#undef PG8_CAT
#undef PG8_LD32
#undef PG8_WAIT_V
#undef PG8_WAIT_L
#undef PG8_BAR
#undef PG8_SCHED
}
}

#define LAS __attribute__((address_space(3)))
typedef unsigned short bf16;
typedef short bf16x8 __attribute__((ext_vector_type(8)));
typedef short s16x4 __attribute__((ext_vector_type(4)));
typedef float f32x4 __attribute__((ext_vector_type(4)));
typedef float f32x16 __attribute__((ext_vector_type(16)));
typedef unsigned u32x4 __attribute__((ext_vector_type(4)));
typedef unsigned u32x2 __attribute__((ext_vector_type(2)));

constexpr int NB = 32, SEQ = 2048, DM = 1024, M = NB * SEQ, NPROJ = 3072, FF = 4096;
constexpr int PC_Q = 0, PC_R = 512, PC_K = 1024, PC_V = 1536, PC_QI = 2048, PC_CL = 2560, PC_KI = 2688, PC_XW = 2752, PC_XA = 2816, PC_XG = 2880, PC_WI = 3008;
constexpr size_t MiB = 1u << 20;
constexpr size_t WS_MOD = 0, WS_WUKT = 1 * MiB, WS_WUK = WS_WUKT + 131072, WS_WUVT = WS_WUK + 131072, WS_INVR = 2 * MiB, WS_WIN = 4 * MiB, WS_WOUT = 10 * MiB,
                 WS_W1 = 12 * MiB, WS_W2 = 20 * MiB, WS_CKV = 36 * MiB, WS_GAM = 52 * MiB, WS_C3 = 60 * MiB, WS_REGA = 64 * MiB, WS_PROJ = 192 * MiB, WS_CH = 576 * MiB,
                 WS_G = 960 * MiB, WS_U = 192 * MiB, WS_END = 1024 * MiB,
                 WS_BAR = 62 * MiB, WS_ROWSQ = WS_BAR + 65536, WS_BIAS2 = WS_ROWSQ + 262144, WS_W2T = WS_WUVT + 131072, WS_A2T = WS_W2T + 65536, WS_G2T = WS_A2T + 65536;
constexpr int LDS_BAR_OFF = 163072;
constexpr int LDS_BYTES = 163328;
constexpr int NWAVES = 8;

struct Params {
    const float *x, *c, *w_ada, *b_ada, *g_mix, *g_ffn, *w_in, *g_q, *g_k, *g_kv, *w_uk, *w_uv, *mu, *w0, *w2, *a0, *a2, *g2, *k_k, *k_a, *r_k, *ln_w, *ln_b, *w_out, *w_ff1, *w_ff2;
    float* out; unsigned char* ws; int ph_lo, ph_hi;
};

__device__ __forceinline__ unsigned pk2(float lo, float hi) { return pg8::cvt_pk_bf16(lo, hi); }
__device__ __forceinline__ float bflo(unsigned w) { return __uint_as_float(w << 16); }
__device__ __forceinline__ float bfhi(unsigned w) { return __uint_as_float(w & 0xffff0000u); }
__device__ __forceinline__ float bf2f(bf16 h) { return __uint_as_float((unsigned)h << 16); }
__device__ __forceinline__ bf16 f2bf(float f) { return (bf16)(pk2(f, 0.f) & 0xffffu); }
__device__ __forceinline__ f32x16 mfma32(bf16x8 a, bf16x8 b, f32x16 c) { return __builtin_amdgcn_mfma_f32_32x32x16_bf16(a, b, c, 0, 0, 0); }
__device__ __forceinline__ f32x4 mfma16(bf16x8 a, bf16x8 b, f32x4 c) { return __builtin_amdgcn_mfma_f32_16x16x32_bf16(a, b, c, 0, 0, 0); }

__device__ __forceinline__ int win_src_col(int n) {
    if (n < 512) return n;
    if (n < 1024) return 1224 + (n - 512);
    if (n < 1536) return 1736 + (n - 1024);
    if (n < 2048) return 2248 + (n - 1536);
    if (n < 2560) return 640 + (n - 2048);
    if (n < 2688) return 512 + (n - 2560);
    if (n < 2752) return 1152 + (n - 2688);
    if (n < 2816) return 2760 + (n - 2752);
    if (n < 2880) return 2824 + (n - 2816);
    if (n < 3008) return 2888 + (n - 2880);
    if (n < 3016) return 1216 + (n - 3008);
    return -1;
}
__device__ __forceinline__ void conv_t_item(const float* W, int K, int Nsrc, bf16* WT, int nblk, int item, float* scr, int lane, bool is_win) {
    const int kb = item / nblk, nb = item % nblk, k0 = 64 * kb, n0 = 32 * nb;
    int ns = n0 + (lane & 31); if (is_win) ns = win_src_col(ns);
    float tv[32];
#pragma unroll
    for (int i = 0; i < 32; ++i) { const int kk = 2 * i + (lane >> 5); tv[i] = ns >= 0 ? W[(size_t)(k0 + kk) * Nsrc + ns] : 0.f; }
#pragma unroll
    for (int i = 0; i < 32; ++i) { const int kk = 2 * i + (lane >> 5); scr[kk * 33 + (lane & 31)] = tv[i]; }
    asm volatile("s_waitcnt lgkmcnt(0)" ::: "memory");
    const int c = lane & 7;
#pragma unroll
    for (int j = 0; j < 4; ++j) { const int n = (lane >> 3) + 8 * j; const float* s = scr + (8 * c) * 33 + n;
        u32x4 o; o.x = pk2(s[0 * 33], s[1 * 33]); o.y = pk2(s[2 * 33], s[3 * 33]); o.z = pk2(s[4 * 33], s[5 * 33]); o.w = pk2(s[6 * 33], s[7 * 33]);
        *(u32x4*)(WT + (size_t)(n0 + n) * K + k0 + 8 * c) = o; }
    asm volatile("s_waitcnt lgkmcnt(0)" ::: "memory");
}
__device__ __forceinline__ void conv_t_item_f8(const float* W, int K, int N, unsigned char* WT, int nblk, int item, float* scr, int lane, float scale, bool is_win = false) {
    const int kb = item / nblk, nb = item % nblk, k0 = 64 * kb, n0 = 32 * nb;
    int ns = n0 + (lane & 31); if (is_win) ns = win_src_col(ns);
    float tv[32];
#pragma unroll
    for (int i = 0; i < 32; ++i) { const int kk = 2 * i + (lane >> 5); tv[i] = ns >= 0 ? W[(size_t)(k0 + kk) * N + ns] * scale : 0.f; }
#pragma unroll
    for (int i = 0; i < 32; ++i) { const int kk = 2 * i + (lane >> 5); scr[kk * 33 + (lane & 31)] = tv[i]; }
    asm volatile("s_waitcnt lgkmcnt(0)" ::: "memory");
    const int c = lane & 7;
#pragma unroll
    for (int j = 0; j < 4; ++j) { const int n = (lane >> 3) + 8 * j; const float* s = scr + (8 * c) * 33 + n;
        u32x2 o; o.x = pg8::pk4_fp8(s[0 * 33], s[1 * 33], s[2 * 33], s[3 * 33]); o.y = pg8::pk4_fp8(s[4 * 33], s[5 * 33], s[6 * 33], s[7 * 33]);
        *(u32x2*)(WT + (size_t)(n0 + n) * K + k0 + 8 * c) = o; }
    asm volatile("s_waitcnt lgkmcnt(0)" ::: "memory");
}
__device__ __forceinline__ void adaln_block(const Params& p, float* ldsf, int cb, int tid) {
    const int lane = tid & 63, wv = tid >> 6, r = lane & 31, kg = lane >> 5, e0 = cb * 64;
    float* RED = ldsf;
    float* mod = (float*)(p.ws + WS_MOD);
    float wreg[2][8][8];
#pragma unroll
    for (int nt = 0; nt < 2; ++nt)
#pragma unroll
        for (int ks = 0; ks < 8; ++ks)
#pragma unroll
            for (int j = 0; j < 8; ++j) wreg[nt][ks][j] = p.w_ada[(size_t)(wv * 128 + 16 * ks + 8 * kg + j) * 6144 + e0 + 32 * nt + r];
    f32x16 acc[2]; acc[0] = (f32x16){}; acc[1] = (f32x16){};
#pragma unroll
    for (int ks = 0; ks < 8; ++ks) {
        const float* cp = p.c + (size_t)r * 1024 + wv * 128 + 16 * ks + 8 * kg;
        const f32x4 c0 = *(const f32x4*)cp, c1 = *(const f32x4*)(cp + 4);
        float sv[8];
#pragma unroll
        for (int j = 0; j < 4; ++j) { sv[j] = c0[j] * __builtin_amdgcn_rcpf(1.f + __expf(-c0[j])); sv[4 + j] = c1[j] * __builtin_amdgcn_rcpf(1.f + __expf(-c1[j])); }
        const u32x4 au = {pk2(sv[0], sv[1]), pk2(sv[2], sv[3]), pk2(sv[4], sv[5]), pk2(sv[6], sv[7])};
#pragma unroll
        for (int nt = 0; nt < 2; ++nt) { const u32x4 bu = {pk2(wreg[nt][ks][0], wreg[nt][ks][1]), pk2(wreg[nt][ks][2], wreg[nt][ks][3]), pk2(wreg[nt][ks][4], wreg[nt][ks][5]), pk2(wreg[nt][ks][6], wreg[nt][ks][7])};
            acc[nt] = mfma32(__builtin_bit_cast(bf16x8, au), __builtin_bit_cast(bf16x8, bu), acc[nt]); }
    }
#pragma unroll
    for (int nt = 0; nt < 2; ++nt)
#pragma unroll
        for (int i = 0; i < 16; ++i) RED[(wv * 32 + (i & 3) + 8 * (i >> 2) + 4 * kg) * 64 + 32 * nt + r] = acc[nt][i];
    __syncthreads();
    {   const int o = tid * 4, bb = o >> 6, col = o & 63;
        f32x4 s = *(const f32x4*)(p.b_ada + e0 + col);
#pragma unroll
        for (int ww = 0; ww < 8; ++ww) s += *(const f32x4*)(RED + (ww * 32 + bb) * 64 + col);
        *(f32x4*)(mod + (size_t)bb * 6144 + e0 + col) = s; }
    __syncthreads();
}
__device__ __forceinline__ void phase_pro(const Params& p, unsigned char* lds, int tid, int G) {
    const int lane = tid & 63, wv = tid >> 6;
    for (int cb = blockIdx.x; cb < 96; cb += G) adaln_block(p, (float*)lds, cb, tid);
    __syncthreads();
    float* scr = (float*)lds + wv * (64 * 33 + 16);
    const int gw = blockIdx.x * NWAVES + wv, NGW = G * NWAVES;
    bf16* WIN = (bf16*)(p.ws + WS_WIN); bf16* WOUT = (bf16*)(p.ws + WS_WOUT); bf16* W1 = (bf16*)(p.ws + WS_W1); bf16* W2 = (bf16*)(p.ws + WS_W2);
    bf16* WUKT = (bf16*)(p.ws + WS_WUKT); bf16* WUK = (bf16*)(p.ws + WS_WUK); bf16* WUVT = (bf16*)(p.ws + WS_WUVT);
    constexpr int I_IN = (DM / 64) * (NPROJ / 32), I_OUT = (DM / 64) * (DM / 32), I_1 = (DM / 64) * (FF / 32), I_2 = (FF / 64) * (DM / 32), I_UK = (128 / 64) * (512 / 32);
    constexpr int I_LR = 512 / 32;
    constexpr int NITEMS = I_IN + I_OUT + I_1 + I_2 + 2 * I_UK + 4 * I_LR;
    for (int it = gw; it < NITEMS; it += NGW) {
        int r = it;
        if (r < I_IN) { if (MK_F8_GEMM1) conv_t_item_f8(p.w_in, DM, 3016, (unsigned char*)WIN, NPROJ / 32, r, scr, lane, 32.f, true); else conv_t_item(p.w_in, DM, 3016, WIN, NPROJ / 32, r, scr, lane, true); continue; } r -= I_IN;
        if (r < I_OUT) { if (MK_F8_GOUT) conv_t_item_f8(p.w_out, DM, DM, (unsigned char*)WOUT, DM / 32, r, scr, lane, 32.f); else conv_t_item(p.w_out, DM, DM, WOUT, DM / 32, r, scr, lane, false); continue; } r -= I_OUT;
        if (r < I_1) { conv_t_item(p.w_ff1, DM, FF, W1, FF / 32, r, scr, lane, false); continue; } r -= I_1;
        if (r < I_2) { conv_t_item_f8(p.w_ff2, FF, DM, (unsigned char*)W2, DM / 32, r, scr, lane, 64.f); continue; } r -= I_2;
        if (r < I_UK) { conv_t_item(p.w_uk, 128, 512, WUKT, 512 / 32, r, scr, lane, false); continue; } r -= I_UK;
        if (r < I_UK) { conv_t_item(p.w_uv, 128, 512, WUVT, 512 / 32, r, scr, lane, false); continue; } r -= I_UK;
        if (r < I_LR) { conv_t_item(p.w2, 64, 512, (bf16*)(p.ws + WS_W2T), 512 / 32, r, scr, lane, false); continue; } r -= I_LR;
        if (r < I_LR) { conv_t_item(p.a2, 64, 512, (bf16*)(p.ws + WS_A2T), 512 / 32, r, scr, lane, false); continue; } r -= I_LR;
        conv_t_item(p.g2, 128, 512, (bf16*)(p.ws + WS_G2T), 512 / 32, r, scr, lane, false);
    }
    { float* ROWSQ = (float*)(p.ws + WS_ROWSQ); for (int i = blockIdx.x * 512 + tid; i < M; i += G * 512) ROWSQ[i] = 0.f; }
    for (int i = blockIdx.x * 512 + tid; i < 128 * 512 / 2; i += G * 512) { const float a = p.w_uk[2 * i], b = p.w_uk[2 * i + 1]; ((unsigned*)WUK)[i] = pk2(a, b); }
}

template <bool F8OUT> __device__ __forceinline__ void hn_rows(const float* src, const float* g, const float* mod, int off_sh, int off_sc, bf16* dst, int gw, int NGW, int lane) {
    const int RPW = M / NGW;
    for (int m0 = gw * RPW; m0 < M; m0 += NGW * RPW) {
        const float* mb = mod + (size_t)(m0 >> 11) * 6144;
        f32x4 ga[4], sh[4];
#pragma unroll
        for (int j = 0; j < 4; ++j) { const int col = 4 * lane + 256 * j; const f32x4 gg = *(const f32x4*)(g + col), sc = *(const f32x4*)(mb + off_sc + col); ga[j] = gg * (1.f + sc); sh[j] = *(const f32x4*)(mb + off_sh + col); }
        for (int r0 = 0; r0 < RPW; r0 += 4) {
            f32x4 v[4][4]; float s[4];
#pragma unroll
            for (int r = 0; r < 4; ++r) { const f32x4* xr = (const f32x4*)(src + (size_t)(m0 + r0 + r) * DM) + lane;
#pragma unroll
                for (int j = 0; j < 4; ++j) v[r][j] = xr[64 * j]; }
#pragma unroll
            for (int r = 0; r < 4; ++r) { s[r] = 0.f;
#pragma unroll
                for (int j = 0; j < 4; ++j) s[r] += (v[r][j].x * v[r][j].x + v[r][j].y * v[r][j].y) + (v[r][j].z * v[r][j].z + v[r][j].w * v[r][j].w); }
#pragma unroll
            for (int r = 0; r < 4; ++r) s[r] = wave_sum(s[r]);
#pragma unroll
            for (int r = 0; r < 4; ++r) { const int m = m0 + r0 + r; const float rstd = rsqrtf(s[r] * (1.f / DM) + 1e-6f);
                unsigned long long* o8 = (unsigned long long*)(dst + (size_t)m * DM) + lane;
#pragma unroll
                for (int j = 0; j < 4; ++j) { const f32x4 y = v[r][j] * rstd * ga[j] + sh[j];
                    if (F8OUT) ((unsigned*)((unsigned char*)dst + (size_t)m * DM))[lane + 64 * j] = pg8::pk4_fp8(y.x, y.y, y.z, y.w);
                    else o8[64 * j] = (unsigned long long)pk2(y.x, y.y) | ((unsigned long long)pk2(y.z, y.w) << 32); } }
        }
    }
}

typedef short s16x4 __attribute__((ext_vector_type(4)));
__device__ __forceinline__ f32x4 mfma16k(s16x4 a, s16x4 b, f32x4 c) { return __builtin_amdgcn_mfma_f32_16x16x16bf16_1k(a, b, c, 0, 0, 0); }
__device__ __forceinline__ s16x4 pack4(f32x4 v) { u32x2 o; o.x = pk2(v[0], v[1]); o.y = pk2(v[2], v[3]); return __builtin_bit_cast(s16x4, o); }

__device__ __forceinline__ float frcp(float x) { return __builtin_amdgcn_rcpf(x); }
__device__ __forceinline__ void rwkv_prep_item(const Params& p, unsigned char* lds, int it, int tid_in) {
    int tid = tid_in; asm volatile("" : "+v"(tid));
    const int lane = tid & 63, wv = __builtin_amdgcn_readfirstlane(tid >> 6);
    bf16* XS = (bf16*)lds;
    bf16* STG = (bf16*)(lds + 33792) + wv * 4096;
    float* MAB = (float*)(lds + 99328) + wv * 256;
    bf16* RKV = (bf16*)(lds + 107520) + wv * 3468;
    const bf16* PROJ = (const bf16*)(p.ws + WS_PROJ);
    const bf16* W2T = (const bf16*)(p.ws + WS_W2T); const bf16* A2T = (const bf16*)(p.ws + WS_A2T); const bf16* G2T = (const bf16*)(p.ws + WS_G2T);
    float* GAM = (float*)(p.ws + WS_GAM); float* C3 = (float*)(p.ws + WS_C3); bf16* GB = (bf16*)(p.ws + WS_G);
    const int row0 = it * 64, t0 = (it & 31) * 64, b = it >> 5;
    __syncthreads();
    {   const int xt = tid >> 5, xch = tid & 31;
        const f32x4 m0_ = *(const f32x4*)(p.mu + 1536 + 8 * xch), m1_ = *(const f32x4*)(p.mu + 1536 + 8 * xch + 4); const float sc_ = xch < 8 ? 2.f : -1.f;
        u32x4 xc[4], xp[4];
#pragma unroll
        for (int qq = 0; qq < 4; ++qq) { const int t = xt + 16 * qq; const bf16* src_ = PROJ + (size_t)(row0 + t) * NPROJ + PC_XW + 8 * xch; xc[qq] = *(const u32x4*)src_;
            xp[qq] = (u32x4){0u, 0u, 0u, 0u}; if (t0 + t != 0) xp[qq] = *(const u32x4*)(src_ - NPROJ); }
#pragma unroll
        for (int qq = 0; qq < 4; ++qq) { float o_[8];
#pragma unroll
            for (int i = 0; i < 4; ++i) { const float c0_ = bflo(xc[qq][i]), c1_ = bfhi(xc[qq][i]), p0_ = bflo(xp[qq][i]), p1_ = bfhi(xp[qq][i]);
                const float ma_ = i < 2 ? m0_[2 * i] : m1_[2 * i - 4], mb_ = i < 2 ? m0_[2 * i + 1] : m1_[2 * i - 3];
                const float v0_ = c0_ + ma_ * (p0_ - c0_), v1_ = c1_ + mb_ * (p1_ - c1_);
                const float r0_ = frcp(1.f + __expf(sc_ * v0_)), r1_ = frcp(1.f + __expf(sc_ * v1_));
                o_[2 * i] = xch < 8 ? 1.f - 2.f * r0_ : (xch < 16 ? v0_ : r0_); o_[2 * i + 1] = xch < 8 ? 1.f - 2.f * r1_ : (xch < 16 ? v1_ : r1_); }
            *(u32x4*)(XS + (xt + 16 * qq) * 264 + 8 * xch) = (u32x4){pk2(o_[0], o_[1]), pk2(o_[2], o_[3]), pk2(o_[4], o_[5]), pk2(o_[6], o_[7])}; }
    }
    u32x4 RK[7];
#define RKV_LOAD(rowb, tb) do { _Pragma("unroll") for (int i = 0; i < 7; ++i) { const int id_ = i * 64 + lane, mat_ = id_ / 136, rem_ = id_ - 136 * mat_, rw_ = rem_ >> 3, ch_ = rem_ & 7; \
        RK[i] = (u32x4){0u, 0u, 0u, 0u}; if (id_ < 408 && (tb) - 1 + rw_ >= 0) RK[i] = *(const u32x4*)(PROJ + (size_t)((rowb) - 1 + rw_) * NPROJ + PC_R + 512 * mat_ + wv * 64 + 8 * ch_); } } while (0)
#define RKV_WRITE() do { _Pragma("unroll") for (int i = 0; i < 7; ++i) { const int id_ = i * 64 + lane, mat_ = id_ / 136, rem_ = id_ - 136 * mat_, rw_ = rem_ >> 3, ch_ = rem_ & 7; \
        if (id_ < 408) { bf16* d_ = RKV + mat_ * 1156 + rw_ * 68 + 8 * ch_; *(u32x2*)d_ = (u32x2){RK[i].x, RK[i].y}; *(u32x2*)(d_ + 4) = (u32x2){RK[i].z, RK[i].w}; } } } while (0)
    RKV_LOAD(row0, t0);
    __syncthreads();
    bf16x8 wf[2][8];
#define LORA_LOADW(dst_, ct_, n__, grp__) do { const int cc_ = wv * 64 + 4 * (n__) + (ct_); \
                _Pragma("unroll") for (int ks = 0; ks < 2; ++ks) { dst_[ks] = *(const bf16x8*)(W2T + cc_ * 64 + 32 * ks + 8 * (grp__)); dst_[2 + ks] = *(const bf16x8*)(A2T + cc_ * 64 + 32 * ks + 8 * (grp__)); } \
                _Pragma("unroll") for (int ks = 0; ks < 4; ++ks) dst_[4 + ks] = *(const bf16x8*)(G2T + cc_ * 128 + 32 * ks + 8 * (grp__)); } while (0)
    LORA_LOADW(wf[0], 0, (lane & 15), (lane >> 4));
#pragma unroll 1
    for (int q = 0; q < 4; ++q) {
        const int rowq = row0 + 16 * q, tq = t0 + 16 * q;
        int lane_ = lane; asm volatile("" : "+v"(lane_));
        const int n_ = lane_ & 15, grp_ = lane_ >> 4;
        const size_t idx = (size_t)(b * 8 + wv) * 128 + (tq >> 4);
        unsigned char* CHp = p.ws + WS_CH + idx * 12288;
        RKV_WRITE();
        if (q < 3) RKV_LOAD(rowq + 16, tq + 16);
        const int c0 = wv * 64 + 4 * n_;
        const f32x4 mur4 = *(const f32x4*)(p.mu + c0), muk4 = *(const f32x4*)(p.mu + 512 + c0), muv4 = *(const f32x4*)(p.mu + 1024 + c0), w04 = *(const f32x4*)(p.w0 + c0),
                    a04 = *(const f32x4*)(p.a0 + c0), kk4 = *(const f32x4*)(p.k_k + c0), ka4 = *(const f32x4*)(p.k_a + c0), rk4 = *(const f32x4*)(p.r_k + c0);
        f32x4 dw[4], da[4];
        {   bf16x8 xa[8];
#pragma unroll
            for (int ks = 0; ks < 8; ++ks) xa[ks] = *(const bf16x8*)(XS + (16 * q + n_) * 264 + 32 * ks + 8 * grp_);
            f32x4 dgs[4];
#pragma unroll
            for (int ct = 0; ct < 4; ++ct) {
                if (ct < 3) LORA_LOADW(wf[(ct + 1) & 1], ct + 1, n_, grp_);
                f32x4 dg = {0.f, 0.f, 0.f, 0.f}; dw[ct] = dg; da[ct] = dg;
#pragma unroll
                for (int ks = 0; ks < 2; ++ks) dw[ct] = mfma16(xa[ks], wf[ct & 1][ks], dw[ct]);
#pragma unroll
                for (int ks = 0; ks < 2; ++ks) da[ct] = mfma16(xa[2 + ks], wf[ct & 1][2 + ks], da[ct]);
#pragma unroll
                for (int ks = 0; ks < 4; ++ks) dg = mfma16(xa[4 + ks], wf[ct & 1][4 + ks], dg);
                dgs[ct] = dg; }
#pragma unroll
            for (int rg = 0; rg < 4; ++rg) *(u32x2*)(GB + (size_t)(rowq + 4 * grp_ + rg) * 512 + wv * 64 + 4 * n_) = (u32x2){pk2(dgs[0][rg], dgs[1][rg]), pk2(dgs[2][rg], dgs[3][rg])};
        }
        asm volatile("s_waitcnt lgkmcnt(0)" ::: "memory");
        {   float kkvA[4][4], kkaA[4][4], kprA[4][4], rA[4][4], vA[4][4], wA[4][4], nrm[4], c3s[4];
            const bf16* RKn = RKV + 4 * n_;
            u32x2 rpv = *(const u32x2*)(RKn + (4 * grp_) * 68), kpv = *(const u32x2*)(RKn + 1156 + (4 * grp_) * 68), vpv = *(const u32x2*)(RKn + 2312 + (4 * grp_) * 68);
#pragma unroll
            for (int rg = 0; rg < 4; ++rg) { const int t = 4 * grp_ + rg;
                const u32x2 rcv = *(const u32x2*)(RKn + (t + 1) * 68), kcv = *(const u32x2*)(RKn + 1156 + (t + 1) * 68), vcv = *(const u32x2*)(RKn + 2312 + (t + 1) * 68);
                nrm[rg] = 0.f; c3s[rg] = 0.f;
#pragma unroll
                for (int ct = 0; ct < 4; ++ct) {
                    const float rp = (ct & 1) ? bfhi(rpv[ct >> 1]) : bflo(rpv[ct >> 1]), rc = (ct & 1) ? bfhi(rcv[ct >> 1]) : bflo(rcv[ct >> 1]);
                    const float kp = (ct & 1) ? bfhi(kpv[ct >> 1]) : bflo(kpv[ct >> 1]), kc = (ct & 1) ? bfhi(kcv[ct >> 1]) : bflo(kcv[ct >> 1]);
                    const float vp = (ct & 1) ? bfhi(vpv[ct >> 1]) : bflo(vpv[ct >> 1]), vc = (ct & 1) ? bfhi(vcv[ct >> 1]) : bflo(vcv[ct >> 1]);
                    const float r = rc + mur4[ct] * (rp - rc), k = kc + muk4[ct] * (kp - kc); vA[ct][rg] = vc + muv4[ct] * (vp - vc); rA[ct][rg] = r;
                    const float u = w04[ct] + dw[ct][rg]; wA[ct][rg] = __expf(-0.6065306597126334f * frcp(1.f + __expf(-u)));
                    const float a = frcp(1.f + __expf(-(a04[ct] + da[ct][rg])));
                    const float kkv = k * kk4[ct], kpr = k * (1.f + (a - 1.f) * ka4[ct]); kkvA[ct][rg] = kkv; kkaA[ct][rg] = kkv * a; kprA[ct][rg] = kpr;
                    nrm[rg] += kkv * kkv; c3s[rg] += r * kpr * rk4[ct]; }
                rpv = rcv; kpv = kcv; vpv = vcv; }
            float inrm[4];
#pragma unroll
            for (int rg = 0; rg < 4; ++rg) { nrm[rg] = dpp_row_sum16(nrm[rg]); c3s[rg] = dpp_row_sum16(c3s[rg]); inrm[rg] = fminf(__builtin_amdgcn_rsqf(nrm[rg]), 1e12f); }
            if (n_ == 0) {
#pragma unroll
                for (int rg = 0; rg < 4; ++rg) C3[(size_t)(rowq + 4 * grp_ + rg) * 8 + wv] = c3s[rg]; }
            float E[4];
#pragma unroll
            for (int ct = 0; ct < 4; ++ct) {
                wA[ct][1] *= wA[ct][0]; wA[ct][2] *= wA[ct][1]; wA[ct][3] *= wA[ct][2];
                const auto sw16 = __builtin_amdgcn_permlane16_swap(__float_as_uint(wA[ct][3]), __float_as_uint(wA[ct][3]), false, false);
                const float e0 = __uint_as_float(sw16[0]), e01 = e0 * __uint_as_float(sw16[1]);
                const auto sw32 = __builtin_amdgcn_permlane32_swap(__float_as_uint(e01), __float_as_uint(e01), false, false);
                const float lo01 = __uint_as_float(sw32[0]);
                E[ct] = grp_ == 0 ? 1.f : (grp_ == 1 ? e0 : (grp_ == 2 ? lo01 : lo01 * e0)); }
#pragma unroll
            for (int rg = 0; rg < 4; ++rg) { const int t = 4 * grp_ + rg;
                float at[4], rt[4];
#pragma unroll
                for (int ct = 0; ct < 4; ++ct) { const float gam = E[ct] * wA[ct][rg], gprev = rg == 0 ? E[ct] : E[ct] * wA[ct][rg - 1], ig = frcp(gam);
                    at[ct] = -kkvA[ct][rg] * inrm[rg] * gprev; rt[ct] = rA[ct][rg] * gam;
                    kkaA[ct][rg] = kkaA[ct][rg] * inrm[rg] * ig; kprA[ct][rg] = kprA[ct][rg] * ig; }
                const int so = t * 64 + ((4 * n_) ^ (((t >> 1) & 7) << 3));
                *(u32x2*)(STG + so) = (u32x2){pk2(at[0], at[1]), pk2(at[2], at[3])}; *(u32x2*)(STG + 1024 + so) = (u32x2){pk2(rt[0], rt[1]), pk2(rt[2], rt[3])};
                *(u32x2*)(STG + 2048 + so) = (u32x2){pk2(kkaA[0][rg], kkaA[1][rg]), pk2(kkaA[2][rg], kkaA[3][rg])};
                *(u32x2*)(STG + 3072 + so) = (u32x2){pk2(kprA[0][rg], kprA[1][rg]), pk2(kprA[2][rg], kprA[3][rg])}; }
#pragma unroll
#define REC_T_STORE(base_, X_) do { \
                _Pragma("unroll") for (int c = 0; c < 2; ++c) { \
                    const unsigned lo0 = pk2(X_[c][0], X_[c][1]), lo1 = pk2(X_[c][2], X_[c][3]), hi0 = pk2(X_[c + 2][0], X_[c + 2][1]), hi1 = pk2(X_[c + 2][2], X_[c + 2][3]); \
                    const auto s0 = __builtin_amdgcn_permlane16_swap(lo0, hi0, false, false), s1 = __builtin_amdgcn_permlane16_swap(lo1, hi1, false, false); \
                    *(u32x4*)(CHp + (base_) + (4 * n_ + c + 2 * (grp_ & 1)) * 32 + 8 * (grp_ & 2)) = (u32x4){s0[0], s1[0], s0[1], s1[1]}; } } while (0)
            REC_T_STORE(4096, kkaA); REC_T_STORE(6144, kprA); REC_T_STORE(8192, vA);
#undef REC_T_STORE
            if (grp_ == 3) *(f32x4*)(GAM + idx * 64 + 4 * n_) = (f32x4){E[0] * wA[0][3], E[1] * wA[1][3], E[2] * wA[2][3], E[3] * wA[3][3]};
        }
        asm volatile("s_waitcnt lgkmcnt(0)" ::: "memory");
        if (q < 3) LORA_LOADW(wf[0], 0, n_, grp_);
        {   f32x4 mab = {0.f, 0.f, 0.f, 0.f}, mak = mab, nrb = mab, nrk = mab;
#pragma unroll
            for (int ks = 0; ks < 4; ++ks) { const int o = n_ * 64 + ((16 * ks + 4 * grp_) ^ (((n_ >> 1) & 7) << 3));
                const s16x4 fa = *(const s16x4*)(STG + o), fr = *(const s16x4*)(STG + 1024 + o), fb = *(const s16x4*)(STG + 2048 + o), fk = *(const s16x4*)(STG + 3072 + o);
                mab = mfma16k(fa, fb, mab); mak = mfma16k(fa, fk, mak); nrb = mfma16k(fr, fb, nrb); nrk = mfma16k(fr, fk, nrk); }
            asm volatile("s_waitcnt lgkmcnt(0)" ::: "memory");
            bf16* SM = STG + 2048;
#pragma unroll
            for (int rg = 0; rg < 4; ++rg) { const int t = 4 * grp_ + rg; const bool sl = t > n_, il = t >= n_;
                MAB[t * 16 + n_] = sl ? mab[rg] : 0.f;
                SM[256 + t * 16 + n_] = f2bf(sl ? mak[rg] : 0.f); SM[512 + t * 16 + n_] = f2bf(il ? nrb[rg] : 0.f); SM[768 + t * 16 + n_] = f2bf(il ? nrk[rg] : 0.f); }
            asm volatile("s_waitcnt lgkmcnt(0)" ::: "memory");
            if (lane_ < 16) {
                float Tc[16];
#pragma unroll
                for (int t = 0; t < 16; ++t) { float acc = (t == lane_) ? 1.f : 0.f;
#pragma unroll
                    for (int s2 = 0; s2 < t; ++s2) acc = fmaf(MAB[t * 16 + s2], Tc[s2], acc);
                    Tc[t] = acc; SM[t * 16 + lane_] = f2bf(acc); }
            }
            asm volatile("s_waitcnt lgkmcnt(0)" ::: "memory");
#pragma unroll
            for (int i = 0; i < 4; ++i) { const int id = i * 64 + lane_, rw = id >> 3, c16 = id & 7; *(u32x4*)(CHp + id * 16) = *(const u32x4*)((const unsigned char*)STG + rw * 128 + ((c16 ^ ((rw >> 1) & 7)) << 4)); }
#pragma unroll
            for (int i = 0; i < 2; ++i) { const int id = i * 64 + lane_; *(u32x4*)(CHp + 10240 + id * 16) = *(const u32x4*)((const unsigned char*)SM + id * 16); }
        }
    }
#undef RKV_LOAD
#undef RKV_WRITE
#undef LORA_LOADW
}

__device__ __forceinline__ void stage_w_lds(const bf16* W, unsigned char* lds, int log2_cpr  , int tid) {
    const int cpr = 1 << log2_cpr;
    u32x4 v[16];
#pragma unroll
    for (int i = 0; i < 16; ++i) v[i] = *(const u32x4*)((const unsigned char*)W + (size_t)(i * 512 + tid) * 16);
#pragma unroll
    for (int i = 0; i < 16; ++i) { const int id = i * 512 + tid, row = id >> log2_cpr, ch = id & (cpr - 1);
        *(u32x4*)(lds + ((size_t)row << (log2_cpr + 4)) + (((ch & ~15) | ((ch ^ row) & 15)) << 4)) = v[i]; }
}
__device__ __forceinline__ bf16x8 lds_wfrag(const unsigned char* lds, int row, int ch, int log2_cpr) {
    return *(const bf16x8*)(lds + ((size_t)row << (log2_cpr + 4)) + (((ch & ~15) | ((ch ^ row) & 15)) << 4));
}
__device__ __forceinline__ void dsa_prep_kv(const Params& p, const unsigned char* wl, int tile, int lane) {
    const bf16* PROJ = (const bf16*)(p.ws + WS_PROJ); bf16* CKV = (bf16*)(p.ws + WS_CKV); float* INVR = (float*)(p.ws + WS_INVR);
    const int r = lane & 31, hh = lane >> 5; const size_t row = (size_t)tile * 32 + r; const bf16* prow = PROJ + row * NPROJ;
    bf16x8 cf[8];
    {   u32x4 craw[8]; float ssq = 0.f;
#pragma unroll
        for (int s = 0; s < 8; ++s) { craw[s] = *(const u32x4*)(prow + PC_CL + 16 * s + 8 * hh);
#pragma unroll
            for (int w = 0; w < 4; ++w) { const float lo = bflo(craw[s][w]), hi = bfhi(craw[s][w]); ssq += lo * lo + hi * hi; } }
        ssq = xor32_sum(ssq);
        const float rstd = rsqrtf(ssq * (1.f / 128.f) + 1e-6f);
#pragma unroll
        for (int s = 0; s < 8; ++s) { const float* g = p.g_kv + 16 * s + 8 * hh; const f32x4 g0 = *(const f32x4*)g, g1 = *(const f32x4*)(g + 4);
            u32x4 o; o.x = pk2(bflo(craw[s].x) * rstd * g0.x, bfhi(craw[s].x) * rstd * g0.y); o.y = pk2(bflo(craw[s].y) * rstd * g0.z, bfhi(craw[s].y) * rstd * g0.w);
            o.z = pk2(bflo(craw[s].z) * rstd * g1.x, bfhi(craw[s].z) * rstd * g1.y); o.w = pk2(bflo(craw[s].w) * rstd * g1.z, bfhi(craw[s].w) * rstd * g1.w);
            cf[s] = __builtin_bit_cast(bf16x8, o); *(u32x4*)(CKV + row * 128 + 16 * s + 8 * hh) = o; }
    }
    unsigned wb[8];
#pragma unroll
    for (int s = 0; s < 8; ++s) wb[s] = (unsigned)(r * 256 + ((((2 * s + hh) ^ r) & 15) << 4));
#pragma unroll 1
    for (int h = 0; h < 8; ++h) { float ss = 0.f;
#pragma unroll
        for (int dt = 0; dt < 2; ++dt) { f32x16 acc = {}; const unsigned char* wg = wl + (h * 64 + dt * 32) * 256;
#pragma unroll
            for (int s = 0; s < 8; ++s) acc = mfma32(*(const bf16x8*)(wg + wb[s]), cf[s], acc);
#pragma unroll
            for (int i = 0; i < 16; ++i) ss += acc[i] * acc[i]; }
        ss = xor32_sum(ss);
        if (hh == 0) INVR[row * 8 + h] = rsqrtf(ss * (1.f / 64.f) + 1e-6f);
    }
}
__device__ __forceinline__ void dsa_prep_q(const Params& p, const unsigned char* wl, int tile, int lane) {
    const bf16* PROJ = (const bf16*)(p.ws + WS_PROJ); bf16* QABS = (bf16*)(p.ws + WS_REGA);
    const int r = lane & 31, hh = lane >> 5; const size_t row = (size_t)tile * 32 + r; const bf16* prow = PROJ + row * NPROJ;
    unsigned wb[2][4];
#pragma unroll
    for (int hp = 0; hp < 2; ++hp)
#pragma unroll
        for (int s = 0; s < 4; ++s) wb[hp][s] = (unsigned)(r * 1024 + ((((hp * 8 + 2 * s + hh) ^ r) & 15) << 4));
    u32x4 qnext[4];
#pragma unroll
    for (int s = 0; s < 4; ++s) qnext[s] = *(const u32x4*)(prow + PC_Q + 16 * s + 8 * hh);
#pragma unroll 2
    for (int h = 0; h < 8; ++h) {
        u32x4 qraw[4]; float ssq = 0.f;
#pragma unroll
        for (int s = 0; s < 4; ++s) qraw[s] = qnext[s];
        if (h + 1 < 8) {
#pragma unroll
            for (int s = 0; s < 4; ++s) qnext[s] = *(const u32x4*)(prow + PC_Q + (h + 1) * 64 + 16 * s + 8 * hh); }
#pragma unroll
        for (int s = 0; s < 4; ++s) {
#pragma unroll
            for (int w = 0; w < 4; ++w) { const float lo = bflo(qraw[s][w]), hi = bfhi(qraw[s][w]); ssq += lo * lo + hi * hi; } }
        ssq = xor32_sum(ssq);
        const float rstd = rsqrtf(ssq * (1.f / 64.f) + 1e-6f);
        bf16x8 qf[4];
#pragma unroll
        for (int s = 0; s < 4; ++s) { const int d0 = 16 * s + 8 * hh; float gg[8];
#pragma unroll
            for (int j = 0; j < 8; ++j) gg[j] = p.g_q[d0 + j] * p.g_k[d0 + j] * rstd;
            u32x4 o; o.x = pk2(bflo(qraw[s].x) * gg[0], bfhi(qraw[s].x) * gg[1]); o.y = pk2(bflo(qraw[s].y) * gg[2], bfhi(qraw[s].y) * gg[3]);
            o.z = pk2(bflo(qraw[s].z) * gg[4], bfhi(qraw[s].z) * gg[5]); o.w = pk2(bflo(qraw[s].w) * gg[6], bfhi(qraw[s].w) * gg[7]);
            qf[s] = __builtin_bit_cast(bf16x8, o); }
#pragma unroll
        for (int lt = 0; lt < 4; ++lt) { f32x16 acc = {}; const unsigned char* wg = wl + lt * 32768 + (h >> 1) * 256;
#pragma unroll
            for (int s = 0; s < 4; ++s) acc = mfma32(*(const bf16x8*)(wg + wb[h & 1][s]), qf[s], acc);
#pragma unroll
            for (int g4 = 0; g4 < 4; ++g4) { u32x2 o; o.x = pk2(acc[4 * g4] * 0.125f, acc[4 * g4 + 1] * 0.125f); o.y = pk2(acc[4 * g4 + 2] * 0.125f, acc[4 * g4 + 3] * 0.125f);
                *(u32x2*)(QABS + row * 1024 + h * 128 + lt * 32 + 8 * g4 + 4 * hh) = o; } }
    }
}

constexpr int SCAN_D = 8, SCAN_R = SCAN_D + 1, SCAN_SLOT = 12288 + 256;
#define SCAN_BAR() do { asm volatile("s_waitcnt lgkmcnt(0)" ::: "memory"); __builtin_amdgcn_s_barrier(); asm volatile("" ::: "memory"); } while (0)
__device__ __forceinline__ void rwkv_scan_chain(const Params& p, unsigned char* lds, int chain, int wv, int lane) {
    const int b = chain >> 3, h = chain & 7;
    const size_t idx0 = (size_t)(b * 8 + h) * 128;
    if (wv >= 4) {
        const int lw = wv - 4;
        const unsigned char* rec0 = p.ws + WS_CH + idx0 * 12288; const unsigned char* gam0 = p.ws + WS_GAM + idx0 * 256;
        unsigned soff[3];
#pragma unroll
        for (int i = 0; i < 3; ++i) { const int c = (i * 4 + lw) * 64 + lane; soff[i] = (unsigned)((c < 256 ? ((c >> 3) * 8 + ((c & 7) ^ ((c >> 4) & 7))) : c) * 16); }
        const unsigned goff = (unsigned)((lane & 15) * 16);
#define SCAN_DMA(k_) do { const unsigned char* r_ = rec0 + (size_t)(k_) * 12288; LAS unsigned char* sl_ = (LAS unsigned char*)lds + ((k_) % SCAN_R) * SCAN_SLOT; \
        _Pragma("unroll") for (int i = 0; i < 3; ++i) __builtin_amdgcn_global_load_lds((const unsigned*)(r_ + soff[i]), (LAS unsigned*)(sl_ + (i * 4 + lw) * 1024), 16, 0, 0); \
        if (lane < 16) __builtin_amdgcn_global_load_lds((const unsigned*)(gam0 + (size_t)(k_) * 256 + goff), (LAS unsigned*)(sl_ + 12288), 16, 0, 0); } while (0)
#pragma unroll
        for (int j = 0; j < SCAN_D; ++j) SCAN_DMA(j);
        for (int k = 0; k < 128; ++k) {
            if (k + SCAN_D <= 128) asm volatile("s_waitcnt vmcnt(%0)" :: "n"(4 * (SCAN_D - 1)) : "memory"); else asm volatile("s_waitcnt vmcnt(0)" ::: "memory");
            __builtin_amdgcn_s_barrier(); asm volatile("" ::: "memory");
            if (k + SCAN_D < 128) SCAN_DMA(k + SCAN_D);
        }
        asm volatile("s_waitcnt vmcnt(0)" ::: "memory");
        __builtin_amdgcn_s_barrier(); asm volatile("" ::: "memory");
#undef SCAN_DMA
    } else {
        const int w = wv, n = lane & 15, grp = lane >> 4;
        bf16* PROJ = (bf16*)(p.ws + WS_PROJ);
        f32x4 S[4];
#pragma unroll
        for (int jt = 0; jt < 4; ++jt) S[jt] = (f32x4){0.f, 0.f, 0.f, 0.f};
        int aoffs[4];
#pragma unroll
        for (int jt = 0; jt < 4; ++jt) aoffs[jt] = n * 128 + ((((2 * jt + (grp >> 1)) ^ ((n >> 1) & 7))) << 4) + 8 * (grp & 1);
        s16x4 at[4], rt[4], bt[4], kt[4], vt, Tm, Mak, Nrb, Nrk; f32x4 gm[4];
#define SCAN_LDF(slot_) do { const unsigned char* CHp = lds + (slot_) * SCAN_SLOT; \
        _Pragma("unroll") for (int jt = 0; jt < 4; ++jt) { at[jt] = *(const s16x4*)(CHp + aoffs[jt]); rt[jt] = *(const s16x4*)(CHp + 2048 + aoffs[jt]); \
            bt[jt] = *(const s16x4*)(CHp + 4096 + (16 * jt + n) * 32 + grp * 8); kt[jt] = *(const s16x4*)(CHp + 6144 + (16 * jt + n) * 32 + grp * 8); \
            gm[jt] = *(const f32x4*)(CHp + 12288 + (16 * jt + 4 * grp) * 4); } \
        vt = *(const s16x4*)(CHp + 8192 + (16 * w + n) * 32 + grp * 8); Tm = *(const s16x4*)(CHp + 10240 + n * 32 + grp * 8); Mak = *(const s16x4*)(CHp + 10752 + n * 32 + grp * 8); \
        Nrb = *(const s16x4*)(CHp + 11264 + n * 32 + grp * 8); Nrk = *(const s16x4*)(CHp + 11776 + n * 32 + grp * 8); } while (0)
        SCAN_BAR();
        SCAN_LDF(0);
        for (int sc = 0; sc < 128; ++sc) {
            s16x4 at_[4], rt_[4], bt_[4], kt_[4]; f32x4 gm_[4];
#pragma unroll
            for (int jt = 0; jt < 4; ++jt) { at_[jt] = at[jt]; rt_[jt] = rt[jt]; bt_[jt] = bt[jt]; kt_[jt] = kt[jt]; gm_[jt] = gm[jt]; }
            const s16x4 vt_ = vt, Tm_ = Tm, Mak_ = Mak, Nrb_ = Nrb, Nrk_ = Nrk;
            SCAN_BAR();
            if (sc + 1 < 128) SCAN_LDF((sc + 1) % SCAN_R);
            s16x4 Sb[4];
#pragma unroll
            for (int jt = 0; jt < 4; ++jt) Sb[jt] = pack4(S[jt]);
            f32x4 X = {0.f, 0.f, 0.f, 0.f}, O = X;
#pragma unroll
            for (int jt = 0; jt < 4; ++jt) X = mfma16k(at_[jt], Sb[jt], X);
            X = mfma16k(Mak_, vt_, X);
#pragma unroll
            for (int jt = 0; jt < 4; ++jt) O = mfma16k(Sb[jt], rt_[jt], O);
            O = mfma16k(vt_, Nrk_, O);
            const f32x4 U = mfma16k(Tm_, pack4(X), (f32x4){0.f, 0.f, 0.f, 0.f});
            const s16x4 Ub = pack4(U);
            O = mfma16k(Ub, Nrb_, O);
#pragma unroll
            for (int jt = 0; jt < 4; ++jt) { S[jt] = mfma16k(kt_[jt], vt_, S[jt]); S[jt] = mfma16k(bt_[jt], Ub, S[jt]); S[jt] = S[jt] * gm_[jt]; }
            *(u32x2*)(PROJ + ((size_t)b * SEQ + sc * 16 + n) * NPROJ + PC_R + h * 64 + 16 * w + 4 * grp) = (u32x2){pk2(O[0], O[1]), pk2(O[2], O[3])};
        }
#undef SCAN_LDF
    }
}
__device__ __forceinline__ void rwkv_epi_rows(const Params& p, int gw, int NGW, int lane) {
    bf16* PROJ = (bf16*)(p.ws + WS_PROJ); const bf16* GB = (const bf16*)(p.ws + WS_G); const float* C3 = (const float*)(p.ws + WS_C3);
    const int c0 = lane * 8, h = lane >> 3, RPW = M / NGW;
    float muv[8], lw[8], lb[8];
#pragma unroll
    for (int i = 0; i < 8; ++i) { muv[i] = p.mu[1024 + c0 + i]; lw[i] = p.ln_w[c0 + i]; lb[i] = p.ln_b[c0 + i]; }
    for (int m0 = gw * RPW; m0 < M; m0 += NGW * RPW) {
        u32x4 vprev = {0u, 0u, 0u, 0u}; if ((m0 & (SEQ - 1)) != 0) vprev = *(const u32x4*)(PROJ + (size_t)(m0 - 1) * NPROJ + PC_V + c0);
        u32x4 orawn[4], vcn[4], grn[4]; float c3n[4];
#define EPI_LOAD(r0_) do { _Pragma("unroll") for (int r = 0; r < 4; ++r) { const size_t m = (size_t)(m0 + (r0_) + r); const bf16* prow = PROJ + m * NPROJ; \
                orawn[r] = *(const u32x4*)(prow + PC_R + c0); vcn[r] = *(const u32x4*)(prow + PC_V + c0); grn[r] = *(const u32x4*)(GB + m * 512 + c0); c3n[r] = C3[m * 8 + h]; } } while (0)
        EPI_LOAD(0);
        for (int r0 = 0; r0 < RPW; r0 += 4) {
            u32x4 oraw[4], vc[4], gr[4]; float c3[4];
#pragma unroll
            for (int r = 0; r < 4; ++r) { oraw[r] = orawn[r]; vc[r] = vcn[r]; gr[r] = grn[r]; c3[r] = c3n[r]; }
            if (r0 + 4 < RPW) EPI_LOAD(r0 + 4);
            float o[4][8], sm[4], q[4];
#pragma unroll
            for (int r = 0; r < 4; ++r) { sm[r] = 0.f;
#pragma unroll
                for (int i = 0; i < 4; ++i) { o[r][2 * i] = bflo(oraw[r][i]); o[r][2 * i + 1] = bfhi(oraw[r][i]); sm[r] += o[r][2 * i] + o[r][2 * i + 1]; } }
#pragma unroll
            for (int r = 0; r < 4; ++r) sm[r] = dpp_sum8(sm[r]);
#pragma unroll
            for (int r = 0; r < 4; ++r) { const float mean = sm[r] * (1.f / 64.f); q[r] = 0.f;
#pragma unroll
                for (int i = 0; i < 8; ++i) { o[r][i] -= mean; q[r] += o[r][i] * o[r][i]; } }
#pragma unroll
            for (int r = 0; r < 4; ++r) q[r] = dpp_sum8(q[r]);
#pragma unroll
            for (int r = 0; r < 4; ++r) { const float rstd = rsqrtf(q[r] * (1.f / 64.f) + 64e-5f); const u32x4 vp = r == 0 ? vprev : vc[r - 1];
                const bool first = ((m0 + r0 + r) & (SEQ - 1)) == 0;
                u32x4 out; float y8[8];
#pragma unroll
                for (int i = 0; i < 4; ++i) { float y[2];
#pragma unroll
                    for (int e = 0; e < 2; ++e) { const int ii = 2 * i + e; const float cv = e ? bfhi(vc[r][i]) : bflo(vc[r][i]), pv = first ? 0.f : (e ? bfhi(vp[i]) : bflo(vp[i]));
                        const float v = cv + muv[ii] * (pv - cv), g = e ? bfhi(gr[r][i]) : bflo(gr[r][i]);
                        y[e] = (o[r][ii] * rstd * lw[ii] + lb[ii] + c3[r] * v) * g; }
                    out[i] = pk2(y[0], y[1]);
#if MK_F8_GOUT
                    y8[2 * i] = y[0] * 8.f; y8[2 * i + 1] = y[1] * 8.f;
#endif
                }
#if MK_F8_GOUT
                *(u32x2*)((unsigned char*)(PROJ + (size_t)(m0 + r0 + r) * NPROJ) + 512 + c0) = (u32x2){pg8::pk4_fp8(y8[0], y8[1], y8[2], y8[3]), pg8::pk4_fp8(y8[4], y8[5], y8[6], y8[7])};
#else
                *(u32x4*)(PROJ + (size_t)(m0 + r0 + r) * NPROJ + PC_R + c0) = out;
#endif
            }
            vprev = vc[3];
        }
#undef EPI_LOAD
    }
}

__device__ __forceinline__ unsigned f2key(float f) { unsigned b = __float_as_uint(f); if ((b << 1) == 0u) b = 0u; return (b & 0x80000000u) ? ~b : (b | 0x80000000u); }
__device__ __forceinline__ unsigned offb(unsigned row, unsigned ch) { return 2048u * (row >> 3) + 512u * (ch >> 2) + 64u * (row & 7) + 16u * ((ch & 3) ^ ((row >> 2) & 3)); }

__device__ __forceinline__ void topk_select(float* sc, int N, unsigned* hist, unsigned short* sel, int lane) {
    unsigned* kb = (unsigned*)sc;
    unsigned prefix = 0u, mask = 0u; int rem = 256, mbin = 0;
    const unsigned long long lt_mask = (1ull << lane) - 1ull;
    for (int pass = 0; pass < 4; ++pass) {
        const int shift = 24 - 8 * pass;
#pragma unroll
        for (int i = 0; i < 4; ++i) hist[lane * 4 + i] = 0u;
        asm volatile("s_waitcnt lgkmcnt(0)" ::: "memory");
        for (int base = 0; base < N; base += 256) { const int idx = base + 4 * lane;
            if (idx < N) { u32x4 k4;
                if (pass == 0) { const f32x4 v = *(const f32x4*)(sc + idx); k4 = (u32x4){f2key(v.x), f2key(v.y), f2key(v.z), f2key(v.w)}; *(u32x4*)(kb + idx) = k4; }
                else k4 = *(const u32x4*)(kb + idx);
#pragma unroll
                for (int e = 0; e < 4; ++e) if ((k4[e] & mask) == prefix) atomicAdd(&hist[(k4[e] >> shift) & 255u], 1u); } }
        asm volatile("s_waitcnt lgkmcnt(0)" ::: "memory");
        const unsigned c0 = hist[lane * 4], c1 = hist[lane * 4 + 1], c2 = hist[lane * 4 + 2], c3 = hist[lane * 4 + 3];
        const int cnt4 = (int)(c0 + c1 + c2 + c3);
        int incl = cnt4;
#pragma unroll
        for (int o = 1; o < 64; o <<= 1) { const int v = __shfl_down(incl, o); if (lane + o < 64) incl += v; }
        const int excl = incl - cnt4;
        const bool mine = (excl < rem) && (rem <= incl);
        const unsigned long long bal = __ballot(mine);
        const int L = (int)__builtin_ctzll(bal);
        const int ex = __shfl(excl, L); const int b3 = (int)__shfl((int)c3, L), b2 = (int)__shfl((int)c2, L), b1 = (int)__shfl((int)c1, L), b0 = (int)__shfl((int)c0, L);
        int above = ex, bin;
        if (above + b3 >= rem) { bin = 3; mbin = b3; } else { above += b3; if (above + b2 >= rem) { bin = 2; mbin = b2; } else { above += b2; if (above + b1 >= rem) { bin = 1; mbin = b1; } else { above += b1; bin = 0; mbin = b0; } } }
        rem -= above; prefix |= (unsigned)(L * 4 + bin) << shift; mask |= 0xffu << shift;
        if (pass == 1 && mbin <= 64) break;
    }
    const unsigned T = prefix; const int ngt = 256 - rem; int base_gt = 0, base_eq = 0;
    const bool partial = (mask != 0xffffffffu);
    unsigned short* cand = (unsigned short*)hist;
    for (int base = 0; base < N; base += 256) { const int idx = base + 4 * lane; const bool act = idx < N;
        u32x4 k4 = {0u, 0u, 0u, 0u}; if (act) k4 = *(const u32x4*)(kb + idx);
        bool gt[4], eq[4]; unsigned long long bg[4], be[4];
#pragma unroll
        for (int e = 0; e < 4; ++e) { const unsigned km = k4[e] & mask; gt[e] = act && km > T; eq[e] = act && km == T; bg[e] = __ballot(gt[e]); be[e] = __ballot(eq[e]); }
        int rg = base_gt, re = base_eq;
#pragma unroll
        for (int e = 0; e < 4; ++e) re += __popcll(be[e] & lt_mask);
#pragma unroll
        for (int e = 0; e < 4; ++e) {
            if (gt[e]) sel[rg + __popcll(bg[e] & lt_mask)] = (unsigned short)(idx + e);
            rg += __popcll(bg[e]);
            if (eq[e]) { if (partial) cand[re] = (unsigned short)(idx + e); else if (re < rem) sel[ngt + re] = (unsigned short)(idx + e); re += 1; } }
        base_gt = rg;
#pragma unroll
        for (int e = 0; e < 4; ++e) base_eq += __popcll(be[e]); }
    asm volatile("s_waitcnt lgkmcnt(0)" ::: "memory");
    if (partial) {
        const int m = mbin; const int ci = (lane < m) ? (int)cand[lane] : 0; const unsigned ck = (lane < m) ? kb[ci] : 0u;
        int rank = 0;
        for (int j = 0; j < m; ++j) { const unsigned kj = (unsigned)__builtin_amdgcn_readlane((int)ck, j);     rank += (kj > ck || (kj == ck && j < lane)) ? 1 : 0; }
        if (lane < m && rank < rem) sel[ngt + rank] = (unsigned short)ci;
        asm volatile("s_waitcnt lgkmcnt(0)" ::: "memory");
    }
}

__device__ __forceinline__ int wave_incl_scan(int v) {
    v += __builtin_amdgcn_update_dpp(0, v, 0x111, 0xF, 0xF, false);
    v += __builtin_amdgcn_update_dpp(0, v, 0x112, 0xF, 0xF, false);
    v += __builtin_amdgcn_update_dpp(0, v, 0x114, 0xF, 0xF, false);
    v += __builtin_amdgcn_update_dpp(0, v, 0x118, 0xF, 0xF, false);
    v += __builtin_amdgcn_update_dpp(0, v, 0x142, 0xA, 0xF, false);
    v += __builtin_amdgcn_update_dpp(0, v, 0x143, 0xC, 0xF, false);
    return v;
}
__device__ __forceinline__ bool topk_select_fast(const float* sc, int N, float smax, unsigned* hist, unsigned short* sel, int lane) {
    const float scale = smax > 0.f ? 127.5f / smax : 0.f;
#define QBIN(x_) ((int)fmaf((x_), scale, 128.f))
#pragma unroll
    for (int i = 0; i < 4; ++i) hist[lane * 4 + i] = 0u;
    asm volatile("s_waitcnt lgkmcnt(0)" ::: "memory");
    for (int base = 0; base < N; base += 256) { const int idx = base + 4 * lane;
        if (idx < N) { const f32x4 v = *(const f32x4*)(sc + idx);
#pragma unroll
            for (int e = 0; e < 4; ++e) atomicAdd(&hist[QBIN(v[e])], 1u); } }
    asm volatile("s_waitcnt lgkmcnt(0)" ::: "memory");
    const unsigned c0 = hist[lane * 4], c1 = hist[lane * 4 + 1], c2 = hist[lane * 4 + 2], c3 = hist[lane * 4 + 3];
    const int cnt4 = (int)(c0 + c1 + c2 + c3);
    const int pin = wave_incl_scan(cnt4), tot = __builtin_amdgcn_readlane(pin, 63);
    const int incl = tot - pin + cnt4;
    const int excl = incl - cnt4;
    const bool mine = (excl < 256) && (256 <= incl);
    const int L = (int)__builtin_ctzll(__ballot(mine));
    const int ex = __builtin_amdgcn_readlane(excl, L); const int b3 = __builtin_amdgcn_readlane((int)c3, L), b2 = __builtin_amdgcn_readlane((int)c2, L), b1 = __builtin_amdgcn_readlane((int)c1, L), b0 = __builtin_amdgcn_readlane((int)c0, L);
    int above = ex, bin, mbin;
    if (above + b3 >= 256) { bin = 3; mbin = b3; } else { above += b3; if (above + b2 >= 256) { bin = 2; mbin = b2; } else { above += b2; if (above + b1 >= 256) { bin = 1; mbin = b1; } else { above += b1; bin = 0; mbin = b0; } } }
    if (mbin > 64) return false;
    const int tb = L * 4 + bin, rem = 256 - above, ngt = above;
    unsigned short* cand = (unsigned short*)hist;
    int cg = 0, ce = 0;
    for (int base = 0; base < N; base += 256) { const int idx = base + 4 * lane;
        if (idx < N) { const f32x4 v = *(const f32x4*)(sc + idx);
#pragma unroll
            for (int e = 0; e < 4; ++e) { const int qb = QBIN(v[e]); cg += (qb > tb) ? 1 : 0; ce += (qb == tb) ? 1 : 0; } } }
    int pg = wave_incl_scan(cg) - cg, pe = wave_incl_scan(ce) - ce;
    unsigned short* const dump = cand + 128 + 2 * lane;
    for (int base = 0; base < N; base += 256) { const int idx = base + 4 * lane;
        if (idx < N) { const f32x4 v = *(const f32x4*)(sc + idx);
#pragma unroll
            for (int e = 0; e < 4; ++e) { const int qb = QBIN(v[e]); const bool gt = qb > tb, eq = qb == tb;
                *(gt ? sel + pg : dump) = (unsigned short)(idx + e); pg += gt ? 1 : 0;
                *(eq ? cand + pe : dump) = (unsigned short)(idx + e); pe += eq ? 1 : 0; } } }
    asm volatile("s_waitcnt lgkmcnt(0)" ::: "memory");
    {   const int m = mbin; const int ci = (lane < m) ? (int)cand[lane] : 0; const unsigned ck = (lane < m) ? f2key(sc[ci]) : 0u;
        int rank = 0;
        for (int j = 0; j < m; ++j) { const unsigned kj = (unsigned)__builtin_amdgcn_readlane((int)ck, j);     rank += (kj > ck || (kj == ck && j < lane)) ? 1 : 0; }
        if (lane < m && rank < rem) sel[ngt + rank] = (unsigned short)ci;
        asm volatile("s_waitcnt lgkmcnt(0)" ::: "memory"); }
#undef QBIN
    return true;
}

__device__ __forceinline__ void dsa_attend(const Params& p, int b, int t, const unsigned short* sel, int cnt, unsigned char* stage, int lane_in, const u32x4 (&bqv)[4]) {
    int lane = lane_in; asm volatile("" : "+v"(lane));
    const bf16* CKV = (const bf16*)(p.ws + WS_CKV) + (size_t)b * SEQ * 128; const float* INVR = (const float*)(p.ws + WS_INVR) + (size_t)b * SEQ * 8;
    bf16* QO = (bf16*)(p.ws + WS_REGA) + ((size_t)b * SEQ + t) * 1024;
    const int hd = lane & 15, grp = lane >> 4;
    bf16x8 bq[4];
#pragma unroll
    for (int s = 0; s < 4; ++s) bq[s] = __builtin_bit_cast(bf16x8, bqv[s]);
    const float slope = (hd < 8) ? exp2f(-(float)(hd + 1)) : 0.f;
    const int hsafe = hd & 7;
    float m_run = -INFINITY, l_part = 0.f;
    f32x4 O[8];
#pragma unroll
    for (int c = 0; c < 8; ++c) O[c] = (f32x4){0.f, 0.f, 0.f, 0.f};
    const LAS unsigned char* st3 = (const LAS unsigned char*)stage;
    const unsigned q4 = (lane & 15) >> 2, p4 = lane & 3;
    u32x4 G[8]; float IRn[8], PNn[8];
#define DA_ISSUE(ks_) do { \
    _Pragma("unroll") for (int i = 0; i < 8; ++i) { const int id = i * 64 + lane, row = id >> 4, ch = id & 15; const unsigned key = sel[(ks_) + row]; G[i] = *(const u32x4*)((const unsigned char*)CKV + (key * 256u + (unsigned)ch * 16u)); } } while (0)
#define DA_ISSUE2(ks_) do { \
    _Pragma("unroll") for (int i = 0; i < 8; ++i) { const int key = sel[(ks_) + 16 * (i >> 2) + 4 * grp + (i & 3)]; IRn[i] = *(const float*)((const unsigned char*)INVR + ((unsigned)key * 32u + (unsigned)hsafe * 4u)); PNn[i] = slope * fabsf((float)(t - key)); } } while (0)
    DA_ISSUE(cnt - 32); DA_ISSUE2(cnt - 32);
    for (int ks = cnt - 32; ks >= 0; ks -= 32) {
#pragma unroll
        for (int i = 0; i < 8; ++i) { const int id = i * 64 + lane, row = id >> 4, ch = id & 15; *(u32x4*)(stage + offb(row, ch)) = G[i]; }
        asm volatile("s_waitcnt lgkmcnt(0)" ::: "memory");
        if (ks >= 32) DA_ISSUE(ks - 32);
        float lg[8];
#pragma unroll
        for (int T = 0; T < 2; ++T) { f32x4 acc = {0.f, 0.f, 0.f, 0.f};
#pragma unroll
            for (int s = 0; s < 4; ++s) { const bf16x8 a = *(const bf16x8*)(stage + offb((lane & 15) + 16 * T, 4 * s + grp)); acc = mfma16(a, bq[s], acc); }
#pragma unroll
            for (int rg = 0; rg < 4; ++rg) lg[4 * T + rg] = acc[rg] * IRn[4 * T + rg] - PNn[4 * T + rg]; }
        if (ks >= 32) DA_ISSUE2(ks - 32);
        float mx = lg[0];
#pragma unroll
        for (int i = 1; i < 8; ++i) mx = fmaxf(mx, lg[i]);
        mx = xor32_max(xor16_max(mx));
        const float m_new = fmaxf(m_run, mx);
        const float alpha = __expf(m_run - m_new);
        float ps = 0.f;
#pragma unroll
        for (int i = 0; i < 8; ++i) { lg[i] = __expf(lg[i] - m_new); ps += lg[i]; }
        l_part = l_part * alpha + ps; m_run = m_new;
#pragma unroll
        for (int c = 0; c < 8; ++c) O[c] = O[c] * alpha;
        {   u32x4 pw; pw.x = pk2(lg[0], lg[1]); pw.y = pk2(lg[2], lg[3]); pw.z = pk2(lg[4], lg[5]); pw.w = pk2(lg[6], lg[7]);
            const bf16x8 pa = __builtin_bit_cast(bf16x8, pw);
#pragma unroll
            for (int c = 0; c < 8; ++c) {
                const s16x4 lo = __builtin_bit_cast(s16x4, __builtin_amdgcn_ds_read_tr16_b64_v4i16((LAS s16x4*)(st3 + offb(4 * grp + q4, 2 * c + (p4 >> 1)) + 8 * (p4 & 1))));
                const s16x4 hi = __builtin_bit_cast(s16x4, __builtin_amdgcn_ds_read_tr16_b64_v4i16((LAS s16x4*)(st3 + offb(16 + 4 * grp + q4, 2 * c + (p4 >> 1)) + 8 * (p4 & 1))));
                const bf16x8 vb = {lo[0], lo[1], lo[2], lo[3], hi[0], hi[1], hi[2], hi[3]};
                O[c] = mfma16(vb, pa, O[c]); } }
        asm volatile("s_waitcnt lgkmcnt(0)" ::: "memory");
    }
#undef DA_ISSUE
#undef DA_ISSUE2
    float l = xor32_sum(xor16_sum(l_part));
    const float il = 1.f / l;
    if (hd < 8) {
#pragma unroll
        for (int c = 0; c < 8; ++c) *(u32x2*)(QO + hd * 128 + 16 * c + 4 * grp) = (u32x2){pk2(O[c][0] * il, O[c][1] * il), pk2(O[c][2] * il, O[c][3] * il)};
    }
}

#define DSA_LOAD_K0(kf_, b_, tid_) do { const int r_ = (tid_) & 31, g_ = ((tid_) >> 5) & 1, wv_ = (tid_) >> 6; const bf16* krow_ = PROJ + ((size_t)(b_) * SEQ + wv_ * 32 + r_) * NPROJ + PC_KI + 8 * g_; \
    _Pragma("unroll") for (int s = 0; s < 4; ++s) kf_[s] = *(const bf16x8*)(krow_ + 16 * s); } while (0)
#define DSA_LOAD_AF(af_, wqv_, b_, tq0_) do { const size_t rq_ = (size_t)(b_) * SEQ + (tq0_); const int r_ = lane & 31, g_ = lane >> 5, ql_ = 2 * ((r_ >> 2) & 1) + (r_ >> 4), hdm_ = 4 * ((r_ >> 3) & 1) + (r_ & 3); \
    _Pragma("unroll") for (int qg = 0; qg < 4; ++qg) _Pragma("unroll") for (int s = 0; s < 4; ++s) af_[qg][s] = *(const bf16x8*)(PROJ + (rq_ + 4 * qg + ql_) * NPROJ + PC_QI + hdm_ * 64 + 16 * s + 8 * g_); \
    wqv_ = (tid < 128) ? bf2f(PROJ[(rq_ + (tid >> 3)) * NPROJ + PC_WI + (tid & 7)]) * 0.044194173824159216f : 0.f; } while (0)
__device__ __forceinline__ float relu_bits(float x) { return __int_as_float(max(__float_as_int(x), 0)); }
__device__ __forceinline__ void dsa_select_item(const Params& p, unsigned char* lds, int b, int tq0, int tid, bf16x8 (&af)[4][4], float& wqv, bf16x8 (&kf0)[4], bool has_next, int nb, int ntq0) {
    bf16* PROJ = (bf16*)(p.ws + WS_PROJ);
    float* SC = (float*)lds;
    unsigned* HIST = (unsigned*)(lds + 131072);
    unsigned short* SEL = (unsigned short*)(lds + 131072 + 8192);
    float* WQ = (float*)(lds + 147456);
    unsigned* QMAX = (unsigned*)(lds + 147456 + 512);
    asm volatile("" : "+v"(tid));
    const int lane = tid & 63, wv = __builtin_amdgcn_readfirstlane(tid >> 6);
    const int N = ((tq0 >> 6) + 1) * 64; const size_t rowq0 = (size_t)b * SEQ + tq0;
    {
        const int r = lane & 31, g = lane >> 5;
        float mxq[4][2];
#pragma unroll
        for (int qg = 0; qg < 4; ++qg) { mxq[qg][0] = 0.f; mxq[qg][1] = 0.f; }
        f32x4 wqa[4][2], wqb[4][2];
#pragma unroll
        for (int qg = 0; qg < 4; ++qg)
#pragma unroll
            for (int qq = 0; qq < 2; ++qq) { wqa[qg][qq] = *(const f32x4*)(WQ + (4 * qg + 2 * g + qq) * 8); wqb[qg][qq] = *(const f32x4*)(WQ + (4 * qg + 2 * g + qq) * 8 + 4); }
#define SEL_LOADK(dst_, kt_) do { const bf16* krow_ = PROJ + ((size_t)b * SEQ + (kt_) * 32 + r) * NPROJ + PC_KI + 8 * g; \
            _Pragma("unroll") for (int s = 0; s < 4; ++s) dst_[s] = *(const bf16x8*)(krow_ + 16 * s); } while (0)
#define SEL_MMA(dst_, bf_, qg_) do { dst_ = (f32x16){}; _Pragma("unroll") for (int s = 0; s < 4; ++s) dst_ = mfma32(af[qg_][s], bf_[s], dst_); } while (0)
#define SEL_TILE(bf_, kt_) do { const int key = (kt_) * 32 + r; f32x16 accn; SEL_MMA(accn, bf_, 0); \
            _Pragma("unroll") for (int qg = 0; qg < 4; ++qg) { const f32x16 acc = accn; if (qg < 3) SEL_MMA(accn, bf_, qg + 1);     \
                _Pragma("unroll") for (int qq = 0; qq < 2; ++qq) { float sc = 0.f; \
                    _Pragma("unroll") for (int e = 0; e < 4; ++e) { sc = fmaf(wqa[qg][qq][e], relu_bits(acc[8 * qq + e]), sc); sc = fmaf(wqb[qg][qq][e], relu_bits(acc[8 * qq + 4 + e]), sc); } \
                    SC[(4 * qg + 2 * g + qq) * 2048 + key] = sc; mxq[qg][qq] = fmaxf(mxq[qg][qq], fabsf(sc)); } } } while (0)
        const int nkt = N / 32;
        bf16x8 bfa[4], bfb[4];
#pragma unroll
        for (int s = 0; s < 4; ++s) bfa[s] = kf0[s];
        for (int kt = wv; kt < nkt; kt += 2 * NWAVES) {
            const bool hb = kt + NWAVES < nkt;
            if (hb) SEL_LOADK(bfb, kt + NWAVES);
            SEL_TILE(bfa, kt);
            if (hb) { if (kt + 2 * NWAVES < nkt) SEL_LOADK(bfa, kt + 2 * NWAVES);
                SEL_TILE(bfb, kt + NWAVES); }
        }
#undef SEL_LOADK
#undef SEL_TILE
#undef SEL_MMA
#pragma unroll
        for (int qg = 0; qg < 4; ++qg)
#pragma unroll
            for (int qq = 0; qq < 2; ++qq) { float m = xor16_max(dpp_row_max16(mxq[qg][qq]));
                if (r == 0) atomicMax(&QMAX[4 * qg + 2 * g + qq], __float_as_uint(m)); }
        __syncthreads();
        if (has_next) DSA_LOAD_AF(af, wqv, nb, ntq0);
        if (has_next) DSA_LOAD_K0(kf0, nb, tid);
        bool fb[2];
        for (int q = 0; q < 2; ++q) fb[q] = !topk_select_fast(SC + (2 * wv + q) * 2048, N, __uint_as_float(QMAX[2 * wv + q]), HIST + wv * 256, SEL + (2 * wv + q) * 256, lane);
        for (int q = 0; q < 2; ++q) if (fb[q]) topk_select(SC + (2 * wv + q) * 2048, N, HIST + wv * 256, SEL + (2 * wv + q) * 256, lane);
    }
    asm volatile("s_waitcnt lgkmcnt(0)" ::: "memory");
    { const int q = lane >> 5; const u32x4 v = *(const u32x4*)(SEL + (2 * wv + q) * 256 + (lane & 31) * 8);
      *(u32x4*)(PROJ + (rowq0 + 2 * wv + q) * NPROJ + PC_Q + (lane & 31) * 8) = v; }
    if (has_next && tid < 128) WQ[tid] = wqv;
    if (lane < 2) QMAX[2 * wv + lane] = 0u;
    __syncthreads();
}

__device__ __forceinline__ void dsa_attend_rows(const Params& p, unsigned char* wlds, int row0, int rstride, int rend, int lane) {
    const bf16* PROJ = (const bf16*)(p.ws + WS_PROJ); const bf16* QA = (const bf16*)(p.ws + WS_REGA);
    unsigned short* SELW = (unsigned short*)(wlds + 8192);
    const int hd = lane & 15, grp = lane >> 4;
    u32x4 selv = {0u, 0u, 0u, 0u}, bqv[4];
#define ATT_PREFETCH(row_) do { const int t_ = (row_) & (SEQ - 1); \
        if (t_ >= 256 && lane < 32) selv = *(const u32x4*)(PROJ + (size_t)(row_) * NPROJ + PC_Q + lane * 8); \
        _Pragma("unroll") for (int s = 0; s < 4; ++s) { bqv[s] = (u32x4){0u, 0u, 0u, 0u}; if (hd < 8) bqv[s] = *(const u32x4*)(QA + (size_t)(row_) * 1024 + hd * 128 + 32 * s + 8 * grp); } } while (0)
    if (row0 < rend) ATT_PREFETCH(row0);
    for (int row = row0; row < rend; row += rstride) {
        const int b = row >> 11, t = row & (SEQ - 1), N = ((t >> 6) + 1) * 64, cnt = N > 256 ? 256 : N;
        if (N > 256) { if (lane < 32) *(u32x4*)(SELW + lane * 8) = selv; }
        else { for (int i = lane; i < cnt; i += 64) SELW[i] = (unsigned short)i; }
        u32x4 bqc[4];
#pragma unroll
        for (int s = 0; s < 4; ++s) bqc[s] = bqv[s];
        asm volatile("s_waitcnt lgkmcnt(0)" ::: "memory");
        if (row + rstride < rend) ATT_PREFETCH(row + rstride);
        dsa_attend(p, b, t, SELW, cnt, wlds, lane, bqc);
        asm volatile("s_waitcnt lgkmcnt(0)" ::: "memory");
    }
#undef ATT_PREFETCH
}

__device__ __forceinline__ void uv_item(const Params& p, const unsigned char* wl  , int tile, int lane) {
    bf16* PROJ = (bf16*)(p.ws + WS_PROJ); const bf16* OLAT = (const bf16*)(p.ws + WS_REGA);
    const int r = lane & 31, hh = lane >> 5; const size_t row = (size_t)tile * 32 + r;
    unsigned wb[8];
#pragma unroll
    for (int s = 0; s < 8; ++s) wb[s] = (unsigned)(r * 256 + ((((2 * s + hh) ^ r) & 15) << 4));
    bf16x8 ofA[8], ofB[8];
#define UV_LOAD(of_, h_) do { _Pragma("unroll") for (int s = 0; s < 8; ++s) of_[s] = *(const bf16x8*)(OLAT + row * 1024 + (h_) * 128 + 16 * s + 8 * hh); } while (0)
#if MK_F8_GOUT
#define UV_STORE(h_, dt_, g4_) *(unsigned*)((unsigned char*)(PROJ + row * NPROJ) + (h_) * 64 + (dt_) * 32 + 8 * (g4_) + 4 * hh) = pg8::pk4_fp8(acc[4 * (g4_)] * 8.f, acc[4 * (g4_) + 1] * 8.f, acc[4 * (g4_) + 2] * 8.f, acc[4 * (g4_) + 3] * 8.f)
#else
#define UV_STORE(h_, dt_, g4_) *(u32x2*)(PROJ + row * NPROJ + PC_Q + (h_) * 64 + (dt_) * 32 + 8 * (g4_) + 4 * hh) = (u32x2){pk2(acc[4 * (g4_)], acc[4 * (g4_) + 1]), pk2(acc[4 * (g4_) + 2], acc[4 * (g4_) + 3])}
#endif
#define UV_HEAD(of_, h_) do { _Pragma("unroll") for (int dt = 0; dt < 2; ++dt) { f32x16 acc = {}; const unsigned char* wg = wl + ((h_) * 64 + dt * 32) * 256; \
            _Pragma("unroll") for (int s = 0; s < 8; ++s) acc = mfma32(*(const bf16x8*)(wg + wb[s]), of_[s], acc); \
            _Pragma("unroll") for (int g4 = 0; g4 < 4; ++g4) UV_STORE(h_, dt, g4); } } while (0)
    UV_LOAD(ofA, 0);
#pragma unroll 1
    for (int h = 0; h < 8; h += 2) { UV_LOAD(ofB, h + 1); UV_HEAD(ofA, h); if (h + 2 < 8) UV_LOAD(ofA, h + 2); UV_HEAD(ofB, h + 1); }
#undef UV_LOAD
#undef UV_STORE
#undef UV_HEAD
}

__device__ __forceinline__ void bias2_item(const Params& p, int item, int lane) {
    const bf16* W1T = (const bf16*)(p.ws + WS_W1); const float* MOD = (const float*)(p.ws + WS_MOD); float* BIAS2 = (float*)(p.ws + WS_BIAS2);
    const int r = lane & 31, hh = lane >> 5, f0 = item * 32;
    const bf16* wrow = W1T + (size_t)(f0 + r) * DM + 8 * hh; const float* srow = MOD + (size_t)r * 6144 + 3072 + 8 * hh;
    f32x16 acc = {};
#pragma unroll 8
    for (int s = 0; s < 64; ++s) { const bf16x8 a = *(const bf16x8*)(wrow + 16 * s); const f32x4 s0 = *(const f32x4*)(srow + 16 * s), s1 = *(const f32x4*)(srow + 16 * s + 4);
        const u32x4 bw = {pk2(s0.x, s0.y), pk2(s0.z, s0.w), pk2(s1.x, s1.y), pk2(s1.z, s1.w)};
        acc = mfma32(a, __builtin_bit_cast(bf16x8, bw), acc); }
#pragma unroll
    for (int i = 0; i < 16; ++i) BIAS2[(size_t)r * 4096 + f0 + (i & 3) + 8 * (i >> 2) + 4 * hh] = acc[i];
}

typedef __attribute__((address_space(1))) unsigned gu32;
#define RLX_AGENT __ATOMIC_RELAXED, __HIP_MEMORY_SCOPE_AGENT
#define XB_TMO      128
#define XB_XCNT(j)  (256  + 64 * (j))
#define XB_XSUB(j)  (1280 + 64 * (j))
#define XB_XGEN(j)  (2304 + 64 * (j))
#define XB_TOP      3328
#define XB_TOPGEN   3392
#define XCD_BAR_WORDS 3456
#define XB_SPIN_CAP (1u << 18)

__device__ __forceinline__ unsigned xb_ld(unsigned* p)              { return __hip_atomic_load(p, __ATOMIC_RELAXED, __HIP_MEMORY_SCOPE_AGENT); }
__device__ __forceinline__ unsigned xb_add(unsigned* p, unsigned v) { return __hip_atomic_fetch_add(p, v, __ATOMIC_RELAXED, __HIP_MEMORY_SCOPE_AGENT); }
__device__ __forceinline__ unsigned xb_xcc_id() { return (unsigned)__builtin_amdgcn_s_getreg((3 << 11) | 20) & 0xFu; }
#define XB_SPIN(cond, bar) do { unsigned _sp = 0; while (cond) { __builtin_amdgcn_s_sleep(1); \
    if ((++_sp & 255u) == 0u) { if (xb_ld(&(bar)[XB_TMO])) break; if (_sp > XB_SPIN_CAP) { atomicAdd(&(bar)[XB_TMO], 1u); break; } } } } while (0)

struct XcdBarrier {
    unsigned* bar; unsigned x;
    volatile LAS unsigned* st;
};

__device__ __forceinline__ XcdBarrier xcd_barrier_post(unsigned* bar, volatile LAS unsigned* st) {
    XcdBarrier b; b.bar = bar; b.x = xb_xcc_id(); b.st = st;
    if (threadIdx.x == 0) (void)xb_add(&bar[XB_XCNT(b.x)], 1u);
    return b;
}
__device__ __forceinline__ void xcd_barrier_complete(unsigned* bar, unsigned x, unsigned& nloc, unsigned& nx) {
    const unsigned G = gridDim.x * gridDim.y * gridDim.z;
    unsigned sum, cnt, mine, sp = 0u;
    for (;;) {
        sum = 0u; cnt = 0u; mine = 0u;
#pragma unroll
        for (unsigned j = 0; j < 16; ++j) { const unsigned c = xb_ld(&bar[XB_XCNT(j)]); sum += c; cnt += (c > 0u) ? 1u : 0u; mine = (j == x) ? c : mine; }
        if (sum == G) break;
        __builtin_amdgcn_s_sleep(1);
        if ((++sp & 255u) == 0u) { if (xb_ld(&bar[XB_TMO])) break; if (sp > XB_SPIN_CAP) { atomicAdd(&bar[XB_TMO], 1u); break; } }
    }
    nloc = mine > 0u ? mine : 1u; nx = cnt > 0u ? cnt : 1u;
}

__device__ __forceinline__ void xcd_barrier(const XcdBarrier& b) {
    asm volatile("s_waitcnt vmcnt(0)" ::: "memory");
    __syncthreads();
    if (threadIdx.x == 0) {
        unsigned* bar = b.bar;
        __builtin_amdgcn_s_waitcnt(0);
        unsigned nloc = b.st[0], nx = b.st[1];
        if (nloc == 0u) { xcd_barrier_complete(bar, b.x, nloc, nx); b.st[0] = nloc; b.st[1] = nx; }
        const unsigned old = xb_add(&bar[XB_XSUB(b.x)], 1u);
        const unsigned gen = old / nloc;
        if (old + 1u == (gen + 1u) * nloc) {
            __builtin_amdgcn_fence(__ATOMIC_RELEASE, "agent");
            asm volatile("s_waitcnt vmcnt(0)" ::: "memory");
            const unsigned og = xb_add(&bar[XB_TOP], 1u);
            const unsigned tg = og / nx;
            if (og + 1u == (tg + 1u) * nx) xb_add(&bar[XB_TOPGEN], 1u);
            else XB_SPIN(xb_ld(&bar[XB_TOPGEN]) == tg, bar);
            __builtin_amdgcn_fence(__ATOMIC_ACQUIRE, "agent");
            xb_add(&bar[XB_XGEN(b.x)], 1u);
            asm volatile("s_waitcnt vmcnt(0)" ::: "memory");
        } else {
            XB_SPIN(xb_ld(&bar[XB_XGEN(b.x)]) == gen, bar);
            __builtin_amdgcn_fence(__ATOMIC_ACQUIRE, "agent");
            asm volatile("s_waitcnt vmcnt(0)" ::: "memory");
        }
    }
    __syncthreads();
}

enum { PH_PRO = 0, PH_HN, PH_GEMM1, PH_PREP, PH_MIX, PH_ATT, PH_UV, PH_GOUT, PH_UP, PH_DOWN, PH_COUNT };
#ifndef MK_SKIP_MIXER
#define MK_SKIP_MIXER 0
#endif
__global__ void __launch_bounds__(NWAVES * 64, 2) mk_fwd(Params p) {
    extern __shared__ __attribute__((aligned(16))) unsigned char lds[];
    cg::grid_group grid = cg::this_grid();
    const int tid = threadIdx.x, lane = tid & 63, wv = __builtin_amdgcn_readfirstlane(tid >> 6);
    const int G = gridDim.x, gw = blockIdx.x * NWAVES + wv, NGW = G * NWAVES;
    const int lo = p.ph_lo, hi = p.ph_hi;
    if (p.ph_hi < 0) grid.sync();
    if (tid < 2) ((volatile LAS unsigned*)((LAS unsigned char*)lds + LDS_BAR_OFF))[tid] = 0u;
    __syncthreads();
    XcdBarrier xbar = xcd_barrier_post((unsigned*)(p.ws + WS_BAR), (volatile LAS unsigned*)((LAS unsigned char*)lds + LDS_BAR_OFF));
    float* MOD = (float*)(p.ws + WS_MOD); bf16* REGA = (bf16*)(p.ws + WS_REGA); bf16* PROJ = (bf16*)(p.ws + WS_PROJ);
#ifndef MK_PHASE_MASK
#define MK_PHASE_MASK 0x3ff
#endif
#define IN(k) (((MK_PHASE_MASK >> (k)) & 1) && lo <= (k) && (k) < hi)
#define SEAM(k) do { if (IN(k) && IN((k) + 1)) { xcd_barrier(xbar); } if (MK_PROBE >= 0 && blockIdx.x == 0 && tid == 0) ((unsigned long long*)(p.ws + WS_MOD + 800 * 1024))[(k) + 1] = __builtin_amdgcn_s_memrealtime(); } while (0)
    if (MK_PROBE >= 0 && blockIdx.x == 0 && tid == 0) ((unsigned long long*)(p.ws + WS_MOD + 800 * 1024))[0] = __builtin_amdgcn_s_memrealtime();
    if (IN(PH_PRO)) { phase_pro(p, lds, tid, G); }
    SEAM(PH_PRO);
    if (IN(PH_HN)) { hn_rows<MK_F8_GEMM1 != 0>(p.x, p.g_mix, MOD, 0, 1024, REGA, gw, NGW, lane); }
    SEAM(PH_HN);
    if (IN(PH_GEMM1)) {
#if MK_F8_GEMM1
        pg8::Gemm g{REGA, (const bf16*)(p.ws + WS_WIN), M, NPROJ, DM / 2, DM / 2}; pg8::StaticOrder S; S.init(M, NPROJ, G, (int)blockIdx.x);
        pg8::EpiBf16<0> E{PROJ, NPROJ, 1.f / 32.f};
        pg8::gemm_phase<pg8::EpiBf16<0>, pg8::StaticOrder, true, true, true>((PG8_LAS unsigned char*)lds, g, S, E);
#else
        pg8::Gemm g{REGA, (const bf16*)(p.ws + WS_WIN), M, NPROJ, DM, DM}; pg8::StaticOrder S; S.init(M, NPROJ, G, (int)blockIdx.x);
        pg8::EpiBf16<0> E{PROJ, NPROJ, 1.f};
        pg8::gemm_phase<pg8::EpiBf16<0>, pg8::StaticOrder, true, true>((PG8_LAS unsigned char*)lds, g, S, E);
#endif
    }
    SEAM(PH_GEMM1);
    if (IN(PH_PREP)) {
#ifndef DBG_NO_DP
        stage_w_lds((const bf16*)(p.ws + WS_WUKT), lds, 4, tid); __syncthreads();
        for (int tile = gw; tile < M / 32; tile += NGW) dsa_prep_kv(p, lds, tile, lane);
        __syncthreads();
        stage_w_lds((const bf16*)(p.ws + WS_WUK), lds, 6, tid); __syncthreads();
        for (int tile = gw; tile < M / 32; tile += NGW) dsa_prep_q(p, lds, tile, lane);
        __syncthreads();
#endif
#ifndef DBG_NO_RP
        for (int k = 0; (int)blockIdx.x + k * G < M / 64; ++k) {
            const int it = (G == 256) ? (int)(blockIdx.x >> 3) * 32 + (24 - 8 * k) + (int)(blockIdx.x & 7)
                                      : (int)blockIdx.x + k * G;
            rwkv_prep_item(p, lds, it, tid); }
#endif
    }
    SEAM(PH_PREP);
    if (IN(PH_MIX)) {
        for (int chain = blockIdx.x; chain < NB * 8; chain += G) { rwkv_scan_chain(p, lds, chain, wv, lane); __syncthreads(); }
        constexpr int NSEL = NB * 112;
        {   bf16x8 af[4][4], kf0[4]; float wqv = 0.f; const bf16* PROJ = (const bf16*)(p.ws + WS_PROJ);
            int idx = (int)blockIdx.x;
            if (idx < NSEL) { DSA_LOAD_AF(af, wqv, idx / 112, 256 + 16 * (idx % 112)); DSA_LOAD_K0(kf0, idx / 112, tid); }
            if (tid < 128) ((float*)(lds + 147456))[tid] = wqv; if (tid < 16) ((unsigned*)(lds + 147456 + 512))[tid] = 0u;
            __syncthreads();
            for (int k = 0; idx < NSEL; ++k) { const int nidx = (k + 1) * G + (((k + 1) & 1) ? (G - 1 - (int)blockIdx.x) : (int)blockIdx.x); const bool hn = nidx < NSEL;
                dsa_select_item(p, lds, idx / 112, 256 + 16 * (idx % 112), tid, af, wqv, kf0, hn, nidx / 112, 256 + 16 * (nidx % 112)); idx = nidx; } }
    }
    SEAM(PH_MIX);
    const bool pan_local = MK_PANEL_ATT && (M / 256 == G) && (M / 32 == NGW) && (G % 8 == 0);
    const int vb = pan_local ? (int)(blockIdx.x & 7) * (G >> 3) + (int)(blockIdx.x >> 3) : (int)blockIdx.x, vgw = vb * NWAVES + wv;
    if (IN(PH_ATT)) {
        if (pan_local) {
            if ((vb & 7) == 0 && wv < 4) bias2_item(p, (vb >> 3) * 4 + wv, lane);
            dsa_attend_rows(p, lds + wv * 9216, vb * 256 + wv, NWAVES, vb * 256 + 256, lane);
        } else {
            if (gw < 128) bias2_item(p, gw, lane);
            dsa_attend_rows(p, lds + wv * 9216, gw, NGW, M, lane);
        }
    }
    if (pan_local && IN(PH_ATT) && IN(PH_UV)) { __syncthreads(); if (MK_PROBE >= 0 && blockIdx.x == 0 && tid == 0) ((unsigned long long*)(p.ws + WS_MOD + 800 * 1024))[PH_ATT + 1] = __builtin_amdgcn_s_memrealtime(); }
    else { SEAM(PH_ATT); }
    if (IN(PH_UV)) {
#if MK_DBG == 7
        for (int m = gw; m < M; m += NGW) { *(u32x4*)(PROJ + (size_t)m * NPROJ + lane * 8) = *(const u32x4*)(REGA + (size_t)m * 1024 + lane * 8); }
#elif MK_DBG != 2
        stage_w_lds((const bf16*)(p.ws + WS_WUVT), lds, 4, tid); __syncthreads();
        for (int tile = vgw; tile < M / 32; tile += NGW) uv_item(p, lds, tile, lane);
#endif
#if MK_DBG == 0
        rwkv_epi_rows(p, vgw, NGW, lane);
#endif
#if MK_DBG == 1 || MK_DBG == 2
        for (int m = gw; m < M; m += NGW) { u32x4 z = {0u, 0u, 0u, 0u}; *(u32x4*)(PROJ + (size_t)m * NPROJ + (MK_DBG == 1 ? 512 : 0) + lane * 8) = z; }
#endif
    }
    const bool uv_local = (M / 256 == G) && (M / 32 == NGW);
    if (uv_local && IN(PH_UV) && IN(PH_GOUT)) { __syncthreads(); if (MK_PROBE >= 0 && blockIdx.x == 0 && tid == 0) ((unsigned long long*)(p.ws + WS_MOD + 800 * 1024))[PH_UV + 1] = __builtin_amdgcn_s_memrealtime(); }
    else { SEAM(PH_UV); }
    if (IN(PH_GOUT)) {
#if MK_F8_GOUT
        pg8::Gemm g{PROJ, (const bf16*)(p.ws + WS_WOUT), M, DM, DM / 2, NPROJ};
        pg8::EpiResGateNorm E{p.x, p.out, DM, MOD + 2048, 6144, p.g_ffn, MOD + 4096, REGA, (float*)(p.ws + WS_ROWSQ), 1.f / 256.f};
        if (uv_local) { pg8::PanelOrder S; S.init(M, DM, G, vb); pg8::gemm_phase<pg8::EpiResGateNorm, pg8::PanelOrder, true, true, true>((PG8_LAS unsigned char*)lds, g, S, E); }
        else { pg8::StaticOrder S; S.init(M, DM, G, (int)blockIdx.x); pg8::gemm_phase<pg8::EpiResGateNorm, pg8::StaticOrder, true, true, true>((PG8_LAS unsigned char*)lds, g, S, E); }
#else
        pg8::Gemm g{PROJ, (const bf16*)(p.ws + WS_WOUT), M, DM, DM, NPROJ}; pg8::StaticOrder S; S.init(M, DM, G, (int)blockIdx.x);
        pg8::EpiResGateNorm E{p.x, p.out, DM, MOD + 2048, 6144, p.g_ffn, MOD + 4096, REGA, (float*)(p.ws + WS_ROWSQ), 1.f};
        pg8::gemm_phase<pg8::EpiResGateNorm, pg8::StaticOrder, true, true>((PG8_LAS unsigned char*)lds, g, S, E);
#endif
    }
    SEAM(PH_GOUT);
    if (IN(PH_UP)) {
        pg8::Gemm g{REGA, (const bf16*)(p.ws + WS_W1), M, FF, DM, DM}; pg8::StaticOrder S; S.init(M, FF, G, (int)blockIdx.x);
        pg8::EpiF8Relu2 E{p.ws + WS_U, FF, 4.f, (const float*)(p.ws + WS_ROWSQ), (const float*)(p.ws + WS_BIAS2)};
        pg8::gemm_phase<pg8::EpiF8Relu2, pg8::StaticOrder, true, true>((PG8_LAS unsigned char*)lds, g, S, E);
    }
    SEAM(PH_UP);
    if (IN(PH_DOWN)) {
        pg8::Gemm g{(const bf16*)(p.ws + WS_U), (const bf16*)(p.ws + WS_W2), M, DM, FF / 2, FF / 2}; pg8::StaticOrder S; S.init(M, DM, G, (int)blockIdx.x);
        pg8::EpiResGateA2 E{REGA, p.out, DM, MOD + 5120, 6144, p.g_ffn};
        pg8::gemm_phase<pg8::EpiResGateA2, pg8::StaticOrder, true, true, true>((PG8_LAS unsigned char*)lds, g, S, E);
    }
#if MK_PROBE >= 0
    grid.sync();
    if (blockIdx.x == 0 && tid == 0) { unsigned long long* ts = (unsigned long long*)(p.ws + WS_MOD + 800 * 1024); ts[PH_COUNT] = __builtin_amdgcn_s_memrealtime();
        p.out[0] += (float)(ts[MK_PROBE + 1] - ts[MK_PROBE]) * 1e-3f; }
#endif
#undef IN
#undef SEAM
}

#ifndef MK_N_LAUNCHES
#define MK_N_LAUNCHES 1
#endif
extern "C" void kernel_launch(void* const* d_in, const int* in_sizes, int n_in, void* d_out, int out_size, void* d_ws, size_t ws_size, hipStream_t stream) {
    static int grid = 0;
    if (grid == 0) {
        if (n_in != 26 || out_size != M * DM || ws_size < WS_END) { fprintf(stderr, "kernel_launch: unexpected shapes (n_in %d out %d ws %zu)\n", n_in, out_size, ws_size); grid = -1; return; }
        int dev = 0, cus = 0, per_cu = 0;
        hipGetDevice(&dev); hipDeviceGetAttribute(&cus, hipDeviceAttributeMultiprocessorCount, dev);
        if (hipFuncSetAttribute((const void*)mk_fwd, hipFuncAttributeMaxDynamicSharedMemorySize, LDS_BYTES) != hipSuccess) { fprintf(stderr, "kernel_launch: hipFuncSetAttribute failed\n"); grid = -1; return; }
        if (hipOccupancyMaxActiveBlocksPerMultiprocessor(&per_cu, (const void*)mk_fwd, NWAVES * 64, LDS_BYTES) != hipSuccess || per_cu < 1) { fprintf(stderr, "kernel_launch: occupancy query says %d\n", per_cu); per_cu = 1; }
        (void)hipGetLastError();
        grid = cus * 1;
        if (per_cu < 1) grid = -1;
    }
    if (grid < 0) return;
    Params p{};
    const float** pp = (const float**)&p;
    for (int i = 0; i < 26; ++i) pp[i] = (const float*)d_in[i];
    p.out = (float*)d_out; p.ws = (unsigned char*)d_ws;
#if MK_N_LAUNCHES == 1
    if (hipMemsetAsync((char*)d_ws + WS_BAR, 0, 16384, stream) != hipSuccess) { fprintf(stderr, "kernel_launch: memset of the barrier words failed\n"); return; }
    p.ph_lo = 0; p.ph_hi = PH_COUNT;
    void* args[] = {&p};
    hipError_t e = hipLaunchCooperativeKernel((const void*)mk_fwd, dim3(grid), dim3(NWAVES * 64), args, LDS_BYTES, stream);
    if (e != hipSuccess) fprintf(stderr, "cooperative launch failed: %s (grid %d)\n", hipGetErrorString(e), grid);
#else
    for (int ph = 0; ph < PH_COUNT; ++ph) {
#if MK_SKIP_MIXER
        if (ph >= PH_HN && ph <= PH_GOUT) continue;
#endif
        p.ph_lo = ph; p.ph_hi = ph + 1;
        hipLaunchKernelGGL(mk_fwd, dim3(grid), dim3(NWAVES * 64), LDS_BYTES, stream, p);
    }
#endif
}
```
